# Optimizing an MI355X kernel written in HIP

```python
import math
import jax, jax.numpy as jnp
from jax import lax
import numpy as np

D_MODEL = 1024
BATCH = 4
SEQ = 4096
DEPTH = 2
DEC_BATCH = 32
DEC_SEQ = 8
PAST_LEN = 8192
PAGE_SIZE = 128

N_META = 16
N_BRANCH = 4
BRANCH_W = 256
D_FF = 2816
CONV_C = 256
CONV_K = 31
RET_HEADS = 4
RET_DK = 64
RET_DV = 64
GLA_HEADS = 4
GLA_DK = 32
GLA_DV = 64
GLA_RANK = 16
GLA_TAU = 16.0
DIFF_HEADS = 4
DIFF_HD = 32
DIFF_VD = 2 * DIFF_HD
REL_BUCKETS = 32
REL_MAX_DIST = 128
CHUNK = 128
Q_BLOCK = 128
ROPE_BASE = 10000.0
EPS = 1e-6
IN_SIZES = (CONV_C, CONV_C,
            RET_HEADS * RET_DK, RET_HEADS * RET_DK, RET_HEADS * RET_DV, RET_HEADS * RET_DV,
            GLA_HEADS * GLA_DK, GLA_HEADS * GLA_DK, GLA_HEADS * GLA_DV, GLA_HEADS * GLA_DV, GLA_RANK,
            DIFF_HEADS * 2 * DIFF_HD, DIFF_HEADS * 2 * DIFF_HD, DIFF_HEADS * DIFF_VD,
            N_BRANCH * D_MODEL)
N_IN = sum(IN_SIZES)

kernel_name = "hybrid_gated_branch_decoder_step"


def rmsnorm(x, g):
    xf = x.astype(jnp.float32)
    y = xf * lax.rsqrt(jnp.mean(xf * xf, axis=-1, keepdims=True) + EPS)
    return (y * g.astype(jnp.float32)).astype(x.dtype)


def layernorm(x, g, b):
    xf = x.astype(jnp.float32)
    mu = jnp.mean(xf, axis=-1, keepdims=True)
    xc = xf - mu
    y = xc * lax.rsqrt(jnp.mean(xc * xc, axis=-1, keepdims=True) + EPS)
    return (y * g.astype(jnp.float32) + b.astype(jnp.float32)).astype(x.dtype)


def head_norm(o, g, center):
    of = o.astype(jnp.float32)
    if center:
        of = of - jnp.mean(of, axis=-1, keepdims=True)
    y = of * lax.rsqrt(jnp.mean(of * of, axis=-1, keepdims=True) + EPS) * g.astype(jnp.float32)
    return y.reshape(o.shape[0], o.shape[1], -1).astype(o.dtype)


def swiglu(x, wg, wu, wd):
    return (jax.nn.silu(x @ wg) * (x @ wu)) @ wd


def rope(x, pos):
    half = x.shape[-1] // 2
    inv = ROPE_BASE ** (-jnp.arange(half, dtype=jnp.float32) / half)
    ang = pos.astype(jnp.float32)[:, None] * inv[None, :]
    cos = jnp.cos(ang)[None, :, None, :]
    sin = jnp.sin(ang)[None, :, None, :]
    xf = x.astype(jnp.float32)
    x1, x2 = xf[..., :half], xf[..., half:]
    return jnp.concatenate([x1 * cos - x2 * sin, x1 * sin + x2 * cos], axis=-1).astype(x.dtype)


def decayed_linear_attention(q, k, v, log_decay, state0, front_pad):
    B, L, H, _ = q.shape
    DV = v.shape[-1]
    total = L + front_pad
    c = min(CHUNK, total)
    n = -(-total // c)
    back = n * c - total

    def to_chunks(a):
        a = jnp.pad(a.astype(jnp.float32), ((0, 0), (front_pad, back), (0, 0), (0, 0)))
        return a.reshape(B, n, c, H, a.shape[-1]).transpose(1, 0, 3, 2, 4)

    qc, kc, vc, gc = to_chunks(q), to_chunks(k), to_chunks(v), to_chunks(log_decay)
    causal = jnp.tril(jnp.ones((c, c), dtype=bool))[None, None, :, :, None]

    def step(S, inp):
        qb, kb, vb, gb = inp
        b = jnp.cumsum(gb, axis=2)
        rel = b[:, :, :, None, :] - b[:, :, None, :, :]
        decay = jnp.exp(jnp.where(causal, rel, -jnp.inf))
        scores = jnp.sum(qb[:, :, :, None, :] * kb[:, :, None, :, :] * decay, axis=-1)
        o = (jnp.einsum('bhts,bhsv->bhtv', scores, vb)
             + jnp.einsum('bhtk,bhkv->bhtv', qb * jnp.exp(b), S))
        b_last = b[:, :, -1:, :]
        S_new = (jnp.exp(b_last[:, :, 0, :])[..., None] * S
                 + jnp.einsum('bhsk,bhsv->bhkv', kb * jnp.exp(b_last - b), vb))
        return S_new, o

    S_fin, o = lax.scan(step, state0.astype(jnp.float32), (qc, kc, vc, gc))
    o = o.transpose(1, 0, 3, 2, 4).reshape(B, n * c, H, DV)[:, front_pad:front_pad + L]
    return o.astype(v.dtype), S_fin.astype(state0.dtype)


def t5_bucket(rel):
    n = jnp.maximum(rel, 0)
    max_exact = REL_BUCKETS // 2
    nf = jnp.maximum(n, 1).astype(jnp.float32)
    large = max_exact + (jnp.log(nf / max_exact) / math.log(REL_MAX_DIST / max_exact)
                         * (REL_BUCKETS - max_exact)).astype(jnp.int32)
    large = jnp.minimum(large, REL_BUCKETS - 1)
    return jnp.where(n < max_exact, n, large)


def diff_attention(q1, q2, k1, k2, v, q_pos, k_pos, rel_bias, lam):
    B, Lq, H, d = q1.shape
    qb = min(Q_BLOCK, Lq)
    nb = -(-Lq // qb)
    padq = nb * qb - Lq

    def prep(a):
        a = jnp.pad(a, ((0, 0), (0, padq), (0, 0), (0, 0)))
        return a.reshape(B, nb, qb, H, d).transpose(1, 0, 2, 3, 4)

    pos_blocks = jnp.pad(q_pos, (0, padq), mode='edge').reshape(nb, qb)
    scale = d ** -0.5
    lam32 = lam.astype(jnp.float32)

    def block(args):
        a1, a2, p = args
        rel = p[:, None] - k_pos[None, :]
        bias = rel_bias[t5_bucket(rel)].transpose(2, 0, 1).astype(jnp.float32)
        mask = rel >= 0

        def probs(a, kk):
            s = jnp.einsum('bqhd,bkhd->bhqk', a, kk).astype(jnp.float32) * scale + bias
            return jax.nn.softmax(jnp.where(mask, s, -jnp.inf), axis=-1)

        attn = probs(a1, k1) - lam32 * probs(a2, k2)
        return jnp.einsum('bhqk,bkhv->bqhv', attn.astype(v.dtype), v)

    o = lax.map(block, (prep(q1), prep(q2), pos_blocks))
    return o.transpose(1, 0, 2, 3, 4).reshape(B, nb * qb, H, v.shape[-1])[:, :Lq]


def trunk_layer(h, pos, k_pos, front_pad, conv_past, ret_s0, gla_s0, k_past, v_past,
                rel_bias, lam_init, w):
    B, L, _ = h.shape
    h = h + 0.5 * swiglu(rmsnorm(h, w['norm_ffn1']), w['ffn1_gate'], w['ffn1_up'], w['ffn1_down'])
    x = rmsnorm(h, w['norm_mix'])
    z = x @ w['w_in'] + w['b_in']
    split_at = [int(s) for s in np.cumsum(IN_SIZES)[:-1]]
    (c_a, c_g, r_q, r_k, r_v, r_g, g_q, g_k, g_v, g_r, g_low,
     d_q, d_k, d_v, gates) = jnp.split(z, split_at, axis=-1)

    u = c_a * jax.nn.sigmoid(c_g)
    u_ext = jnp.concatenate([conv_past.astype(u.dtype), u], axis=1)
    conv = lax.conv_general_dilated(u_ext, w['conv_w'][:, None, :], window_strides=(1,),
                                    padding='VALID', dimension_numbers=('NWC', 'WIO', 'NWC'),
                                    feature_group_count=CONV_C)
    br_conv = jax.nn.silu(layernorm(conv + w['conv_b'], w['conv_ln_g'], w['conv_ln_b']))
    conv_state = u_ext[:, u_ext.shape[1] - (CONV_K - 1):]

    rq = rope(r_q.reshape(B, L, RET_HEADS, RET_DK), pos)
    rk = rope(r_k.reshape(B, L, RET_HEADS, RET_DK), pos) * RET_DK ** -0.5
    rv = r_v.reshape(B, L, RET_HEADS, RET_DV)
    log_gamma = jnp.log1p(-jnp.exp2(-5.0 - jnp.arange(RET_HEADS, dtype=jnp.float32)))
    ret_decay = jnp.broadcast_to(log_gamma[:, None], (B, L, RET_HEADS, 1))
    r_o, ret_state = decayed_linear_attention(rq, rk, rv, ret_decay, ret_s0, front_pad)
    br_ret = jax.nn.silu(r_g) * head_norm(r_o, w['ret_gn'], center=True)

    gq = g_q.reshape(B, L, GLA_HEADS, GLA_DK) * GLA_DK ** -0.5
    gk = g_k.reshape(B, L, GLA_HEADS, GLA_DK)
    gv = g_v.reshape(B, L, GLA_HEADS, GLA_DV)
    g_pre = (g_low @ w['gla_alpha_w'] + w['gla_alpha_b']).astype(jnp.float32)
    gla_decay = (jax.nn.log_sigmoid(g_pre) / GLA_TAU).reshape(B, L, GLA_HEADS, GLA_DK)
    g_o, gla_state = decayed_linear_attention(gq, gk, gv, gla_decay, gla_s0, front_pad)
    br_gla = jax.nn.silu(g_r) * head_norm(g_o, w['gla_gn'], center=False)

    dq = rmsnorm(d_q.reshape(B, L, DIFF_HEADS, 2, DIFF_HD), w['q_norm'])
    dk = rmsnorm(d_k.reshape(B, L, DIFF_HEADS, 2, DIFF_HD), w['k_norm'])
    dv = d_v.reshape(B, L, DIFF_HEADS, DIFF_VD)
    k_rows = dk.reshape(B, L, DIFF_HEADS, 2 * DIFF_HD)
    if k_past is None:
        k_all, v_all = dk, dv
    else:
        k_all = jnp.concatenate([k_past.astype(dk.dtype).reshape(B, -1, DIFF_HEADS, 2, DIFF_HD), dk], axis=1)
        v_all = jnp.concatenate([v_past.astype(dv.dtype), dv], axis=1)
    lam = (jnp.exp(jnp.sum(w['lam_q1'].astype(jnp.float32) * w['lam_k1'].astype(jnp.float32)))
           - jnp.exp(jnp.sum(w['lam_q2'].astype(jnp.float32) * w['lam_k2'].astype(jnp.float32)))
           + lam_init)
    d_o = diff_attention(dq[..., 0, :], dq[..., 1, :], k_all[..., 0, :], k_all[..., 1, :], v_all,
                         pos, k_pos, rel_bias, lam)
    br_diff = head_norm(d_o, w['diff_subln'], center=False) * (1.0 - lam_init)

    branches = jnp.stack([br_conv, br_ret, br_gla, br_diff], axis=2)
    gate = jax.nn.sigmoid(gates.reshape(B, L, N_BRANCH, D_MODEL))
    merged = jnp.einsum('blnc,ncd,blnd->bld', branches, w['w_branch'], gate)
    h = h + merged @ w['w_out']
    h = h + 0.5 * swiglu(rmsnorm(h, w['norm_ffn2']), w['ffn2_gate'], w['ffn2_up'], w['ffn2_down'])
    return h, (k_rows, dv, ret_state, gla_state, conv_state)


def setup_inputs(seed: int = 0) -> dict:
    key = jax.random.key(seed)
    keys = iter(jax.random.split(key, 64))
    f32 = jnp.float32

    def nrm(shape, scale):
        return jax.random.normal(next(keys), shape, f32) * scale

    def gain(shape):
        return 1.0 + nrm(shape, 0.05)

    n_pages = PAST_LEN // PAGE_SIZE
    n_pool = (DEC_BATCH * n_pages * 5) // 4
    page_table = jax.random.permutation(next(keys), n_pool)[:DEC_BATCH * n_pages]
    page_table = page_table.reshape(DEC_BATCH, n_pages).astype(jnp.int32)
    return {
        'x_prompt': nrm((BATCH, SEQ, D_MODEL), 1.0),
        'x_sample': nrm((DEC_BATCH, DEC_SEQ, D_MODEL), 1.0),
        'cache_k': nrm((DEPTH, n_pool, PAGE_SIZE, DIFF_HEADS, 2 * DIFF_HD), 1.0),
        'cache_v': nrm((DEPTH, n_pool, PAGE_SIZE, DIFF_HEADS, DIFF_VD), 1.0),
        'page_table': page_table,
        'state_ret': nrm((DEPTH, DEC_BATCH, RET_HEADS, RET_DK, RET_DV), 0.3),
        'state_gla': nrm((DEPTH, DEC_BATCH, GLA_HEADS, GLA_DK, GLA_DV), 0.3),
        'state_conv': nrm((DEPTH, DEC_BATCH, CONV_K - 1, CONV_C), 0.5),
        'meta_tokens': nrm((N_META, D_MODEL), 1.0),
        'rel_bias': nrm((REL_BUCKETS, DIFF_HEADS), 0.5),
        'norm_ffn1': gain((DEPTH, D_MODEL)),
        'ffn1_gate': nrm((DEPTH, D_MODEL, D_FF), D_MODEL ** -0.5),
        'ffn1_up': nrm((DEPTH, D_MODEL, D_FF), D_MODEL ** -0.5),
        'ffn1_down': nrm((DEPTH, D_FF, D_MODEL), D_FF ** -0.5),
        'norm_mix': gain((DEPTH, D_MODEL)),
        'w_in': nrm((DEPTH, D_MODEL, N_IN), D_MODEL ** -0.5),
        'b_in': nrm((DEPTH, N_IN), 0.02),
        'conv_w': nrm((DEPTH, CONV_K, CONV_C), CONV_K ** -0.5),
        'conv_b': nrm((DEPTH, CONV_C), 0.02),
        'conv_ln_g': gain((DEPTH, CONV_C)),
        'conv_ln_b': nrm((DEPTH, CONV_C), 0.02),
        'ret_gn': gain((DEPTH, RET_HEADS, RET_DV)),
        'gla_alpha_w': nrm((DEPTH, GLA_RANK, GLA_HEADS * GLA_DK), GLA_RANK ** -0.5),
        'gla_alpha_b': nrm((DEPTH, GLA_HEADS * GLA_DK), 0.02),
        'gla_gn': gain((DEPTH, GLA_HEADS, GLA_DV)),
        'q_norm': gain((DEPTH, DIFF_HD)),
        'k_norm': gain((DEPTH, DIFF_HD)),
        'lam_q1': nrm((DEPTH, DIFF_HD), 0.1),
        'lam_k1': nrm((DEPTH, DIFF_HD), 0.1),
        'lam_q2': nrm((DEPTH, DIFF_HD), 0.1),
        'lam_k2': nrm((DEPTH, DIFF_HD), 0.1),
        'diff_subln': gain((DEPTH, DIFF_VD)),
        'w_branch': nrm((DEPTH, N_BRANCH, BRANCH_W, D_MODEL), BRANCH_W ** -0.5),
        'w_out': nrm((DEPTH, D_MODEL, D_MODEL), D_MODEL ** -0.5),
        'norm_ffn2': gain((DEPTH, D_MODEL)),
        'ffn2_gate': nrm((DEPTH, D_MODEL, D_FF), D_MODEL ** -0.5),
        'ffn2_up': nrm((DEPTH, D_MODEL, D_FF), D_MODEL ** -0.5),
        'ffn2_down': nrm((DEPTH, D_FF, D_MODEL), D_FF ** -0.5),
    }


def reference(x_prompt, x_sample, cache_k, cache_v, page_table, state_ret, state_gla, state_conv,
              meta_tokens, rel_bias, norm_ffn1, ffn1_gate, ffn1_up, ffn1_down, norm_mix, w_in, b_in,
              conv_w, conv_b, conv_ln_g, conv_ln_b, ret_gn, gla_alpha_w, gla_alpha_b, gla_gn,
              q_norm, k_norm, lam_q1, lam_k1, lam_q2, lam_k2, diff_subln, w_branch, w_out,
              norm_ffn2, ffn2_gate, ffn2_up, ffn2_down):
    B, S, _ = x_prompt.shape
    DB, DS, _ = x_sample.shape
    L = S + N_META
    meta = jnp.broadcast_to(meta_tokens[None].astype(x_prompt.dtype), (B, N_META, D_MODEL))
    h_p = jnp.concatenate([meta, x_prompt], axis=1)
    h_s = x_sample
    pos_p = jnp.arange(L, dtype=jnp.int32)
    pos_s = PAST_LEN + jnp.arange(DS, dtype=jnp.int32)
    kpos_s = jnp.arange(PAST_LEN + DS, dtype=jnp.int32)
    front_pad = (CHUNK - N_META % CHUNK) % CHUNK

    kp_l, vp_l, rp_l, gp_l, cp_l = [], [], [], [], []
    ks_l, vs_l, rs_l, gs_l, cs_l = [], [], [], [], []
    for l in range(DEPTH):
        w = dict(norm_ffn1=norm_ffn1[l], ffn1_gate=ffn1_gate[l], ffn1_up=ffn1_up[l],
                 ffn1_down=ffn1_down[l], norm_mix=norm_mix[l], w_in=w_in[l], b_in=b_in[l],
                 conv_w=conv_w[l], conv_b=conv_b[l], conv_ln_g=conv_ln_g[l], conv_ln_b=conv_ln_b[l],
                 ret_gn=ret_gn[l], gla_alpha_w=gla_alpha_w[l], gla_alpha_b=gla_alpha_b[l],
                 gla_gn=gla_gn[l], q_norm=q_norm[l], k_norm=k_norm[l], lam_q1=lam_q1[l],
                 lam_k1=lam_k1[l], lam_q2=lam_q2[l], lam_k2=lam_k2[l], diff_subln=diff_subln[l],
                 w_branch=w_branch[l], w_out=w_out[l], norm_ffn2=norm_ffn2[l],
                 ffn2_gate=ffn2_gate[l], ffn2_up=ffn2_up[l], ffn2_down=ffn2_down[l])
        lam_init = 0.8 - 0.6 * math.exp(-0.3 * l)
        h_p, (kp, vp, rp, gp, cp) = trunk_layer(
            h_p, pos_p, pos_p, front_pad,
            jnp.zeros((B, CONV_K - 1, CONV_C), h_p.dtype),
            jnp.zeros((B, RET_HEADS, RET_DK, RET_DV), state_ret.dtype),
            jnp.zeros((B, GLA_HEADS, GLA_DK, GLA_DV), state_gla.dtype),
            None, None, rel_bias, lam_init, w)
        k_past = jnp.take(cache_k[l], page_table, axis=0).reshape(DB, PAST_LEN, DIFF_HEADS, 2 * DIFF_HD)
        v_past = jnp.take(cache_v[l], page_table, axis=0).reshape(DB, PAST_LEN, DIFF_HEADS, DIFF_VD)
        h_s, (ks, vs, rs, gs, cs) = trunk_layer(
            h_s, pos_s, kpos_s, 0, state_conv[l], state_ret[l], state_gla[l],
            k_past, v_past, rel_bias, lam_init, w)
        kp_l.append(kp); vp_l.append(vp); rp_l.append(rp); gp_l.append(gp); cp_l.append(cp)
        ks_l.append(ks); vs_l.append(vs); rs_l.append(rs); gs_l.append(gs); cs_l.append(cs)

    y_prompt = h_p[:, N_META:]
    y_sample = h_s
    k_prompt = jnp.stack(kp_l, axis=0)
    v_prompt = jnp.stack(vp_l, axis=0)
    k_sample = jnp.stack(ks_l, axis=0)
    v_sample = jnp.stack(vs_l, axis=0)
    ret_prompt = jnp.stack(rp_l, axis=0)
    ret_sample = jnp.stack(rs_l, axis=0)
    gla_prompt = jnp.stack(gp_l, axis=0)
    gla_sample = jnp.stack(gs_l, axis=0)
    conv_prompt = jnp.stack(cp_l, axis=0)
    conv_sample = jnp.stack(cs_l, axis=0)
    return (y_prompt, y_sample, k_prompt, v_prompt, k_sample, v_sample,
            ret_prompt, ret_sample, gla_prompt, gla_sample, conv_prompt, conv_sample)
```

```cpp
#include <hip/hip_runtime.h>
#include <cstdio>
#include <cstdint>
#include <cmath>

namespace pg8 {
#define PG8_LAS __attribute__((address_space(3)))
typedef unsigned short bf16_t;
typedef short bf16x8 __attribute__((ext_vector_type(8)));
typedef float f32x4 __attribute__((ext_vector_type(4)));
typedef unsigned u32x4 __attribute__((ext_vector_type(4)));
constexpr int BM = 256, BK = 64, HALF = 128, HTB = HALF * BK * 2  , STAGE_BYTES = 8 * HTB, NXCD = 8, WGM = 8;

__host__ __device__ __forceinline__ int lds_byte(int r, int c) { const int st = (r >> 4) * 2 + (c >> 5), rr = r & 15, cc = c & 31, ob = rr * 64 + cc * 2; return st * 1024 + (ob ^ (((ob >> 9) & 1) << 5)); }
__host__ __device__ __forceinline__ void stage_rc(int b, int& R, int& C) { const int st = b / 1024, sb = b % 1024, swz = sb ^ (((sb >> 9) & 1) << 5); R = (st >> 1) * 16 + swz / 64; C = (st & 1) * 32 + (swz % 64) / 2; }
__host__ __device__ __forceinline__ int perm32(int rho) { const int n = rho >> 4, i = rho & 15; return 8 * (i >> 2) + 4 * n + (i & 3); }

struct Unit { int pm, pn, acol; };
struct Gemm { const bf16_t* A; const bf16_t* Bt; int lda, ldb, K; };

struct StaticOrder {
    int nM, nN, nwg, G, c;
    __host__ __device__ void init(int M, int N, int G_, int c_) { nM = M / BM; nN = N / BM; nwg = nM * nN; G = G_; c = c_; }
    __host__ __device__ bool next(int i, Unit& u) const {
        const long L = (long)i * G + c; if (L >= nwg) return false;
        int wgid = (int)L; { const int q = nwg / NXCD, r = nwg % NXCD, xcd = wgid % NXCD, off = wgid / NXCD; wgid = (xcd < r ? xcd * (q + 1) : r * (q + 1) + (xcd - r) * q) + off; }
        const int nig = WGM * nN, gid = wgid / nig, fm = gid * WGM, gsz = (nM - fm) < WGM ? (nM - fm) : WGM;
        u.pm = fm + ((wgid % nig) % gsz); u.pn = (wgid % nig) / gsz; u.acol = 0; return true;
    }
};
struct MergeOrder {
    int ntile, G, c;
    __host__ __device__ void init(int M, int G_, int c_) { ntile = (M / BM) * 4; G = G_; c = c_; }
    __host__ __device__ bool next(int i, Unit& u) const {
        const int T = (i >> 2) * G + c; if (T >= ntile) return false;
        const int n = i & 3; u.pm = T >> 2; u.pn = n * 4 + (T & 3); u.acol = n * 256; return true;
    }
};

__device__ __forceinline__ unsigned cvt_pk_bf16(float lo, float hi) { unsigned r; asm volatile("v_cvt_pk_bf16_f32 %0, %1, %2" : "=v"(r) : "v"(lo), "v"(hi)); return r; }

template <class Epi, class Sched, bool ALIGN_EPI = false, bool SP2 = false>
__device__ __forceinline__ void gemm_phase(PG8_LAS unsigned char* lds, const Gemm g, const Sched& S, const Epi& E) {
    int tid_ = threadIdx.x; asm volatile("" : "+v"(tid_));
    const int tid = tid_, wid = __builtin_amdgcn_readfirstlane(tid >> 6), lane = tid & 63, wr = wid >> 2, wc = wid & 3, fr = lane & 15, fq = lane >> 4;
    const int nt = g.K / BK;
    unsigned voffA[2], voffB[2];
#pragma unroll
    for (int i = 0; i < 2; ++i) { int R, C; stage_rc(tid * 16 + i * 8192, R, C); const int Rb = Epi::PERM ? ((R & ~31) + perm32(R & 31)) : R;
        voffA[i] = (unsigned)(R * g.lda + C) * 2u; voffB[i] = (unsigned)(Rb * g.ldb + C) * 2u; }
    const size_t kstep = (size_t)(BK * 2);
    const size_t hstepA = (size_t)HALF * g.lda * 2, hstepB = (size_t)HALF * g.ldb * 2;
    const size_t tstepA = 2 * hstepA, tstepB = 2 * hstepB;
    const unsigned ldsw = (unsigned)wid * 1024u;
    const int aoff = lds_byte(wr * 64 + fr, fq * 8), boff = lds_byte(wc * 32 + fr, fq * 8);
#define PG8_SA(b, h) (((b) * 2 + (h)) * HTB)
#define PG8_SB(b, h) ((4 + (b) * 2 + (h)) * HTB)
#define PG8_STAGE(bufoff, gbase, voff) do { _Pragma("unroll") for (int _i = 0; _i < 2; ++_i) \
        __builtin_amdgcn_global_load_lds((const unsigned*)((const char*)(gbase) + (voff)[_i]), (PG8_LAS unsigned*)(lds + (bufoff) + ldsw + _i * 8192), 16, 0, 0); } while (0)
#define PG8_LDA(dst, b, h) do { _Pragma("unroll") for (int m = 0; m < 4; ++m) _Pragma("unroll") for (int k = 0; k < 2; ++k) dst[m][k] = *(const PG8_LAS bf16x8*)(lds + PG8_SA(b, h) + aoff + m * 2048 + k * 1024); } while (0)
#define PG8_LDB(dst, b, h) do { _Pragma("unroll") for (int n = 0; n < 2; ++n) _Pragma("unroll") for (int k = 0; k < 2; ++k) dst[n][k] = *(const PG8_LAS bf16x8*)(lds + PG8_SB(b, h) + boff + n * 2048 + k * 1024); } while (0)
#define PG8_MMA(ai, bj, At, Bt) do { __builtin_amdgcn_s_setprio(1); _Pragma("unroll") for (int m = 0; m < 4; ++m) _Pragma("unroll") for (int n = 0; n < 2; ++n) _Pragma("unroll") for (int k = 0; k < 2; ++k) \
        acc[ai][bj][m][n] = __builtin_amdgcn_mfma_f32_16x16x32_bf16(Bt[n][k], At[m][k], acc[ai][bj][m][n], 0, 0, 0); __builtin_amdgcn_s_setprio(0); } while (0)
#define PG8_WAIT_V(n) asm volatile("s_waitcnt vmcnt(" #n ")" ::: "memory")
#define PG8_WAIT_L(n) asm volatile("s_waitcnt lgkmcnt(" #n ")" ::: "memory")
#define PG8_BAR __builtin_amdgcn_s_barrier()
#define PG8_SCHED __builtin_amdgcn_sched_barrier(0)
    Unit cur, nxt; int ui = 0;
    if (!S.next(0, cur)) return;
    f32x4 acc[2][2][4][2];
#pragma unroll
    for (int a = 0; a < 2; ++a)
#pragma unroll
        for (int b = 0; b < 2; ++b)
#pragma unroll
            for (int m = 0; m < 4; ++m)
#pragma unroll
                for (int n = 0; n < 2; ++n) acc[a][b][m][n] = (f32x4){0.f, 0.f, 0.f, 0.f};
    bf16x8 At[4][2], B0[2][2], B1[2][2];
    const char* cA = (const char*)g.A + (size_t)cur.pm * tstepA + (size_t)cur.acol * 2; const char* cB = (const char*)g.Bt + (size_t)cur.pn * tstepB;
    if constexpr (SP2) {
        PG8_STAGE(PG8_SB(0, 0), cB, voffB); PG8_STAGE(PG8_SB(0, 1), cB + hstepB, voffB); PG8_STAGE(PG8_SA(0, 0), cA, voffA); PG8_STAGE(PG8_SA(0, 1), cA + hstepA, voffA);
        if (wr == 1) PG8_BAR;
        PG8_WAIT_V(2); PG8_BAR;
        PG8_STAGE(PG8_SB(1, 0), cB + kstep, voffB); PG8_STAGE(PG8_SA(1, 0), cA + kstep, voffA); PG8_STAGE(PG8_SB(1, 1), cB + hstepB + kstep, voffB);
        PG8_WAIT_V(6); PG8_BAR;
    } else {
        PG8_STAGE(PG8_SB(0, 0), cB, voffB); PG8_STAGE(PG8_SA(0, 0), cA, voffA); PG8_STAGE(PG8_SB(0, 1), cB + hstepB, voffB); PG8_STAGE(PG8_SA(0, 1), cA + hstepA, voffA);
        if (wr == 1) PG8_BAR;
        PG8_WAIT_V(4); PG8_BAR;
        PG8_STAGE(PG8_SB(1, 0), cB + kstep, voffB); PG8_STAGE(PG8_SA(1, 0), cA + kstep, voffA); PG8_STAGE(PG8_SB(1, 1), cB + hstepB + kstep, voffB);
        PG8_WAIT_V(6); PG8_BAR;
    }
    for (;;) {
        const bool has_next = S.next(ui + 1, nxt);
        const char* nA = has_next ? (const char*)g.A + (size_t)nxt.pm * tstepA + (size_t)nxt.acol * 2 : cA; const char* nB = has_next ? (const char*)g.Bt + (size_t)nxt.pn * tstepB : cB;
        for (int t = 0; t < nt; t += 2) {
            const bool last = (t == nt - 2);
            const char* a1 = cA + (size_t)(t + 1) * kstep;
            const char* a2 = last ? nA : cA + (size_t)(t + 2) * kstep; const char* b2 = last ? nB : cB + (size_t)(t + 2) * kstep;
            const char* a3 = a2 + kstep; const char* b3 = b2 + kstep;
            if constexpr (SP2) {
            PG8_LDB(B0, 0, 0); PG8_LDB(B1, 0, 1); PG8_SCHED; PG8_LDA(At, 0, 0); PG8_STAGE(PG8_SA(1, 1), a1 + hstepA, voffA);
            PG8_WAIT_V(8); PG8_WAIT_L(0); PG8_BAR; PG8_MMA(0, 0, At, B0); PG8_MMA(0, 1, At, B1); PG8_BAR; PG8_SCHED;
            PG8_LDA(At, 0, 1); PG8_STAGE(PG8_SB(0, 0), b2, voffB); PG8_STAGE(PG8_SB(0, 1), b2 + hstepB, voffB); PG8_STAGE(PG8_SA(0, 0), a2, voffA);
            PG8_WAIT_V(8); PG8_WAIT_L(0); PG8_BAR; PG8_MMA(1, 0, At, B0); PG8_MMA(1, 1, At, B1); PG8_BAR; PG8_SCHED;
            PG8_LDB(B0, 1, 0); PG8_LDB(B1, 1, 1); PG8_SCHED; PG8_LDA(At, 1, 0); PG8_STAGE(PG8_SA(0, 1), a2 + hstepA, voffA);
            PG8_WAIT_V(8); PG8_WAIT_L(0); PG8_BAR; PG8_MMA(0, 0, At, B0); PG8_MMA(0, 1, At, B1); PG8_BAR; PG8_SCHED;
            PG8_LDA(At, 1, 1); PG8_STAGE(PG8_SB(1, 0), b3, voffB); PG8_STAGE(PG8_SB(1, 1), b3 + hstepB, voffB); PG8_STAGE(PG8_SA(1, 0), a3, voffA);
            PG8_WAIT_V(8); PG8_WAIT_L(0); PG8_BAR; PG8_MMA(1, 0, At, B0); PG8_MMA(1, 1, At, B1); PG8_BAR; PG8_SCHED;
            } else {
            PG8_LDB(B0, 0, 0); PG8_SCHED; PG8_LDA(At, 0, 0); PG8_STAGE(PG8_SA(1, 1), a1 + hstepA, voffA);
            PG8_WAIT_L(8); PG8_BAR; PG8_WAIT_L(0); PG8_MMA(0, 0, At, B0); PG8_BAR; PG8_SCHED;
            PG8_LDB(B1, 0, 1); PG8_STAGE(PG8_SB(0, 0), b2, voffB);
            PG8_BAR; PG8_WAIT_L(0); PG8_MMA(0, 1, At, B1); PG8_BAR;
            PG8_LDA(At, 0, 1); PG8_STAGE(PG8_SA(0, 0), a2, voffA);
            PG8_BAR; PG8_WAIT_L(0); PG8_MMA(1, 0, At, B0); PG8_BAR; PG8_SCHED;
            PG8_STAGE(PG8_SB(0, 1), b2 + hstepB, voffB);
            PG8_WAIT_V(6); PG8_BAR; PG8_MMA(1, 1, At, B1); PG8_BAR;
            PG8_LDB(B0, 1, 0); PG8_SCHED; PG8_LDA(At, 1, 0); PG8_STAGE(PG8_SA(0, 1), a2 + hstepA, voffA);
            PG8_WAIT_L(8); PG8_BAR; PG8_WAIT_L(0); PG8_MMA(0, 0, At, B0); PG8_BAR; PG8_SCHED;
            PG8_LDB(B1, 1, 1); PG8_STAGE(PG8_SB(1, 0), b3, voffB);
            PG8_BAR; PG8_WAIT_L(0); PG8_MMA(0, 1, At, B1); PG8_BAR;
            PG8_LDA(At, 1, 1); PG8_STAGE(PG8_SA(1, 0), a3, voffA);
            PG8_BAR; PG8_WAIT_L(0); PG8_MMA(1, 0, At, B0); PG8_BAR; PG8_SCHED;
            PG8_STAGE(PG8_SB(1, 1), b3 + hstepB, voffB);
            PG8_WAIT_V(6); PG8_BAR; PG8_MMA(1, 1, At, B1); PG8_BAR;
            }
        }
        if constexpr (ALIGN_EPI) { if (wr == 0) PG8_BAR; }
        E(acc, cur, wr, wc, fr, fq);
        if (!has_next) break;
#pragma unroll
        for (int a = 0; a < 2; ++a)
#pragma unroll
            for (int b = 0; b < 2; ++b)
#pragma unroll
                for (int m = 0; m < 4; ++m)
#pragma unroll
                    for (int n = 0; n < 2; ++n) acc[a][b][m][n] = (f32x4){0.f, 0.f, 0.f, 0.f};
        cur = nxt; cA = nA; cB = nB; ++ui;
        if constexpr (ALIGN_EPI) { if (wr == 1) PG8_BAR; }
    }
    PG8_WAIT_V(0);
    if constexpr (!ALIGN_EPI) { if (wr == 0) PG8_BAR; }
    PG8_BAR;
#undef PG8_SA
#undef PG8_SB
#undef PG8_STAGE
#undef PG8_LDA
#undef PG8_LDB
#undef PG8_MMA
#undef PG8_WAIT_V
#undef PG8_WAIT_L
#undef PG8_BAR
#undef PG8_SCHED
}
}

constexpr int NWAVES = 8;
constexpr int D = 1024, DFF = 2816, NIN = 7184, NMIX = 3088, NMIXP = 3328, NGATE = 4096, NINP = NMIXP + NGATE;
constexpr int SEQ = 4096, NMETA = 16, L = SEQ + NMETA, BATCH = 4, DB = 32, DS = 8, PAST = 8192, PAGE = 128, NPAGES = PAST / PAGE, NPOOL = 2560, DEPTH = 2;
constexpr int MP = BATCH * L, MS = DB * DS, MR = MP + MS, M = 16896;
constexpr int NPOS = L + DS;
constexpr float EPS = 1e-6f;
constexpr int C_A = 0, C_G = 256, R_Q = 512, R_K = 768, R_V = 1024, R_G = 1280, G_Q = 1536, G_K = 1664, G_V = 1792, G_R = 2048, G_LOW = 2304, D_Q = 2320, D_K = 2576, D_V = 2832;
constexpr size_t O_YP = 0, O_YS = O_YP + (size_t)BATCH * SEQ * D, O_KP = O_YS + (size_t)MS * D, O_VP = O_KP + (size_t)DEPTH * MP * 256, O_KS = O_VP + (size_t)DEPTH * MP * 256,
                 O_VS = O_KS + (size_t)DEPTH * MS * 256, O_RP = O_VS + (size_t)DEPTH * MS * 256, O_RS = O_RP + (size_t)DEPTH * BATCH * 4 * 64 * 64, O_GP = O_RS + (size_t)DEPTH * DB * 4 * 64 * 64,
                 O_GS = O_GP + (size_t)DEPTH * BATCH * 4 * 32 * 64, O_CP = O_GS + (size_t)DEPTH * DB * 4 * 32 * 64, O_CS = O_CP + (size_t)DEPTH * BATCH * 30 * 256, O_END = O_CS + (size_t)DEPTH * DB * 30 * 256;
enum { I_XP = 0, I_XS, I_CK, I_CV, I_PT, I_SRET, I_SGLA, I_SCONV, I_META, I_RELB, I_NF1, I_F1G, I_F1U, I_F1D, I_NMIX, I_WIN, I_BIN, I_CW, I_CB, I_CLG, I_CLB, I_RGN, I_GAW, I_GAB, I_GGN,
       I_QN, I_KN, I_LQ1, I_LK1, I_LQ2, I_LK2, I_SUBLN, I_WBR, I_WOUT, I_NF2, I_F2G, I_F2U, I_F2D, N_INPUTS };

constexpr size_t MiB = 1u << 20;
constexpr size_t WS_CTL = 0, CTL_ZERO_BYTES = 1 * MiB;
constexpr size_t SZ_SS = (size_t)M * 16 * 4;
constexpr size_t SZ_W1 = (size_t)2 * DFF * D * 2, SZ_WD = (size_t)D * DFF * 2, SZ_WIN = (size_t)NINP * D * 2, SZ_WBR = (size_t)4 * D * 256 * 2, SZ_WOUT = (size_t)D * D * 2;
constexpr size_t WS_W1 = 4 * MiB;
constexpr size_t WS_WD = WS_W1 + 4 * SZ_W1;
constexpr size_t WS_WIN = WS_WD + 4 * SZ_WD;
constexpr size_t WS_WBR = WS_WIN + 2 * SZ_WIN;
constexpr size_t WS_WOUT = WS_WBR + 2 * SZ_WBR;
constexpr size_t WS_BINP = WS_WOUT + 2 * SZ_WOUT;
constexpr size_t WS_ROPE = WS_BINP + 64 * 1024;
constexpr size_t WS_SS = WS_ROPE + 2 * MiB;
constexpr size_t WS_H = 128 * MiB;
constexpr size_t WS_HB = WS_H + (size_t)M * D * 4;
constexpr size_t WS_ACT = WS_HB + (size_t)M * D * 2;
constexpr size_t WS_ZMIX = WS_ACT + (size_t)M * DFF * 2;
constexpr size_t WS_GATES = WS_ZMIX + (size_t)M * NMIXP * 2;
constexpr size_t WS_BR = WS_GATES + (size_t)M * NGATE * 2;
constexpr size_t WS_MERGED = WS_BR + (size_t)M * D * 2;
constexpr size_t WS_UBUF = WS_MERGED + (size_t)M * D * 2;
constexpr size_t WS_RQ = WS_UBUF + (size_t)M * 256 * 4, WS_RK = WS_RQ + (size_t)M * 256 * 4, WS_QN = WS_RK + (size_t)M * 256 * 4, WS_KN = WS_QN + (size_t)M * 256 * 4, WS_VB = WS_KN + (size_t)M * 256 * 4;
constexpr size_t WS_LDEC = WS_VB + (size_t)M * 256 * 4;
constexpr size_t WS_END = WS_LDEC + (size_t)M * 128 * 4;
static_assert(WS_ROPE + 2 * NPOS * 32 * 4 <= WS_SS && WS_SS + 6 * SZ_SS <= WS_H, "weights region overflows");
constexpr int CW_BAR = 4096;

constexpr int RING_OFF = 0, RING_BYTES = 131072;
constexpr int LDSCTL_OFF = 144384, MISC_OFF = LDSCTL_OFF + 320;
constexpr int LDS_BYTES = 147456;
static_assert(MISC_OFF + 128 <= LDS_BYTES, "LDS map");

#define GAS __attribute__((address_space(1)))
#define LAS __attribute__((address_space(3)))
typedef unsigned short bf16;
typedef unsigned v4u __attribute__((ext_vector_type(4)));
typedef float f32x4 __attribute__((ext_vector_type(4)));
#define LDS_WAIT() asm volatile("s_waitcnt lgkmcnt(0)" ::: "memory")
#define VM_WAIT() asm volatile("s_waitcnt vmcnt(0)" ::: "memory")
__device__ __forceinline__ unsigned f2bf(float f) { unsigned u = __builtin_bit_cast(unsigned, f); return (u + 0x7fffu + ((u >> 16) & 1u)) >> 16; }
__device__ __forceinline__ unsigned pk2(float lo, float hi) { return f2bf(lo) | (f2bf(hi) << 16); }
__device__ __forceinline__ float bf2f(bf16 b) { return __builtin_bit_cast(float, ((unsigned)b) << 16); }
__device__ __forceinline__ float bflo(unsigned w) { return __builtin_bit_cast(float, w << 16); }
__device__ __forceinline__ float bfhi(unsigned w) { return __builtin_bit_cast(float, w & 0xffff0000u); }
__device__ __forceinline__ float wave_sum(float v) {
#pragma unroll
    for (int o = 1; o < 64; o <<= 1) v += __shfl_xor(v, o);
    return v;
}
__device__ __forceinline__ float sigmoidf_(float x) { return 1.0f / (1.0f + __expf(-x)); }
__device__ __forceinline__ float siluf_(float x) { return x / (1.0f + __expf(-x)); }

#define XB_TMO      128
#define XB_XCNT(j)  (256  + 64 * (j))
#define XB_XSUB(j)  (1280 + 64 * (j))
#define XB_XGEN(j)  (2304 + 64 * (j))
#define XB_TOP      3328
#define XB_TOPGEN   3392
#define XCD_BAR_WORDS 3456
#define XB_SPIN_CAP (1u << 22)

__device__ __forceinline__ unsigned xb_ld(unsigned* p)              { return __hip_atomic_load(p, __ATOMIC_RELAXED, __HIP_MEMORY_SCOPE_AGENT); }
__device__ __forceinline__ unsigned xb_add(unsigned* p, unsigned v) { return __hip_atomic_fetch_add(p, v, __ATOMIC_RELAXED, __HIP_MEMORY_SCOPE_AGENT); }
__device__ __forceinline__ unsigned xb_xcc_id() { return (unsigned)__builtin_amdgcn_s_getreg((3 << 11) | 20) & 0xFu; }
#define XB_SPIN(cond, bar) do { unsigned _sp = 0; while (cond) { __builtin_amdgcn_s_sleep(1); \
    if ((++_sp & 255u) == 0u) { if (xb_ld(&(bar)[XB_TMO])) break; if (_sp > XB_SPIN_CAP) { atomicAdd(&(bar)[XB_TMO], 1u); break; } } } } while (0)

struct XcdBarrier { unsigned* bar; unsigned x; volatile LAS unsigned* st; };

__device__ __forceinline__ XcdBarrier xcd_barrier_post(unsigned* bar, volatile LAS unsigned* st) {
    XcdBarrier b; b.bar = bar; b.x = xb_xcc_id(); b.st = st;
    if (threadIdx.x == 0) (void)xb_add(&bar[XB_XCNT(b.x)], 1u);
    return b;
}
__device__ __forceinline__ void xcd_barrier_complete(unsigned* bar, unsigned x, unsigned& nloc, unsigned& nx) {
    const unsigned G = gridDim.x * gridDim.y * gridDim.z;
    unsigned sum, cnt, mine, sp = 0u;
    for (;;) {
        sum = 0u; cnt = 0u; mine = 0u;
#pragma unroll
        for (unsigned j = 0; j < 16; ++j) { const unsigned c = xb_ld(&bar[XB_XCNT(j)]); sum += c; cnt += (c > 0u) ? 1u : 0u; mine = (j == x) ? c : mine; }
        if (sum == G) break;
        __builtin_amdgcn_s_sleep(1);
        if ((++sp & 255u) == 0u) { if (xb_ld(&bar[XB_TMO])) break; if (sp > XB_SPIN_CAP) { atomicAdd(&bar[XB_TMO], 1u); break; } }
    }
    nloc = mine > 0u ? mine : 1u; nx = cnt > 0u ? cnt : 1u;
}
template <bool FIRST> __device__ __forceinline__ void xcd_barrier(const XcdBarrier& b) {
    asm volatile("s_waitcnt vmcnt(0)" ::: "memory");
    __syncthreads();
    if (threadIdx.x == 0) {
        unsigned* bar = b.bar;
        asm volatile("" : "+s"(bar));
        __builtin_amdgcn_s_waitcnt(0);
        unsigned nloc = b.st[0], nx = b.st[1];
        if (FIRST) { if (nloc == 0u) { xcd_barrier_complete(bar, b.x, nloc, nx); b.st[0] = nloc; b.st[1] = nx; } }
        const unsigned old = xb_add(&bar[XB_XSUB(b.x)], 1u);
        const unsigned gen = old / nloc;
        if (old + 1u == (gen + 1u) * nloc) {
            __builtin_amdgcn_fence(__ATOMIC_RELEASE, "agent");
            asm volatile("s_waitcnt vmcnt(0)" ::: "memory");
            const unsigned og = xb_add(&bar[XB_TOP], 1u);
            const unsigned tg = og / nx;
            if (og + 1u == (tg + 1u) * nx) xb_add(&bar[XB_TOPGEN], 1u);
            else XB_SPIN(xb_ld(&bar[XB_TOPGEN]) == tg, bar);
            __builtin_amdgcn_fence(__ATOMIC_ACQUIRE, "agent");
            xb_add(&bar[XB_XGEN(b.x)], 1u);
            asm volatile("s_waitcnt vmcnt(0)" ::: "memory");
        } else {
            XB_SPIN(xb_ld(&bar[XB_XGEN(b.x)]) == gen, bar);
            __builtin_amdgcn_fence(__ATOMIC_ACQUIRE, "agent");
            asm volatile("s_waitcnt vmcnt(0)" ::: "memory");
        }
    }
    __syncthreads();
}

struct Params { const float* in[N_INPUTS]; float* out; unsigned char* ws; float inv_freq[32]; };
static_assert(sizeof(Params) == N_INPUTS * 8 + 16 + 128, "Params has no padding");

struct Ctx {
    const float* const* in; float* out; unsigned char* ws;
    LAS unsigned char* lds;
    int G;
};
#define THREAD_IDS() int tid_ = threadIdx.x; asm volatile("" : "+v"(tid_)); const int tid = tid_, lane = tid & 63, wave = __builtin_amdgcn_readfirstlane(tid >> 6), gw = blockIdx.x * NWAVES + wave, NGW = C.G * NWAVES; (void)tid; (void)lane; (void)wave; (void)gw; (void)NGW
#define WSP(T, off) ((T*)(C.ws + (off)))

__device__ __forceinline__ float rstd_of(const float* ssp, int row) {
    const f32x4 a = *(const f32x4*)(ssp + (size_t)row * 16), b = *(const f32x4*)(ssp + (size_t)row * 16 + 4), c = *(const f32x4*)(ssp + (size_t)row * 16 + 8), d = *(const f32x4*)(ssp + (size_t)row * 16 + 12);
    const float s = (((a[0] + a[1]) + (a[2] + a[3])) + ((b[0] + b[1]) + (b[2] + b[3]))) + (((c[0] + c[1]) + (c[2] + c[3])) + ((d[0] + d[1]) + (d[2] + d[3])));
    return rsqrtf(s * (1.0f / D) + EPS);
}
#define EPI_IDS() int t_ = threadIdx.x; asm volatile("" : "+v"(t_)); const int wid_ = __builtin_amdgcn_readfirstlane(t_ >> 6), wr = wid_ >> 2, wc = wid_ & 3, fr = t_ & 15, fq = (t_ & 63) >> 4
struct EpiGLU {
    static constexpr bool PERM = true;
    bf16* act; const float* ss;
    __device__ __forceinline__ void operator()(const pg8::f32x4 (&acc)[2][2][4][2], const pg8::Unit& u, int, int, int, int) const {
        EPI_IDS();
        const int row0 = u.pm * 256 + wr * 64 + fr, col0 = u.pn * 128 + wc * 32 + 8 * fq;
#pragma unroll
        for (int ai = 0; ai < 2; ++ai)
#pragma unroll
            for (int m = 0; m < 4; ++m) {
                const int row = row0 + ai * 128 + m * 16; const float rstd = rstd_of(ss, row);
                float o[8];
#pragma unroll
                for (int n = 0; n < 2; ++n)
#pragma unroll
                    for (int j = 0; j < 4; ++j) { const float g = acc[ai][0][m][n][j] * rstd, up = acc[ai][1][m][n][j] * rstd; o[n * 4 + j] = siluf_(g) * up; }
                v4u w; w.x = pk2(o[0], o[1]); w.y = pk2(o[2], o[3]); w.z = pk2(o[4], o[5]); w.w = pk2(o[6], o[7]);
                *(v4u*)(act + (size_t)row * DFF + col0) = w;
            }
    }
};
template <bool FINAL, int SCALE2> struct EpiRes {
    static constexpr bool PERM = true;
    float* h; bf16* hb; float* ssout; float* out;
    __device__ __forceinline__ void operator()(const pg8::f32x4 (&acc)[2][2][4][2], const pg8::Unit& u, int, int, int, int) const {
        EPI_IDS();
        const int row0 = u.pm * 256 + wr * 64 + fr, col0 = u.pn * 256 + wc * 32 + 8 * fq;
#pragma unroll
        for (int ai = 0; ai < 2; ++ai)
#pragma unroll
            for (int m = 0; m < 4; ++m) {
                const int row = row0 + ai * 128 + m * 16; float sq = 0.f;
                constexpr float scale = 0.5f * SCALE2;
                long yoff = -1;
                if (FINAL) { if (row < MP) { const int b = row / L, pos = row - b * L; if (pos >= NMETA) yoff = (long)O_YP + ((long)b * SEQ + (pos - NMETA)) * D; } else if (row < MR) yoff = (long)O_YS + (long)(row - MP) * D; }
#pragma unroll
                for (int bj = 0; bj < 2; ++bj) {
                    const size_t off = (size_t)row * D + col0 + bj * 128;
                    f32x4 h0 = *(const f32x4*)(h + off), h1 = *(const f32x4*)(h + off + 4);
                    h0 = h0 + acc[ai][bj][m][0] * scale; h1 = h1 + acc[ai][bj][m][1] * scale;
                    *(f32x4*)(h + off) = h0; *(f32x4*)(h + off + 4) = h1;
                    v4u w; w.x = pk2(h0[0], h0[1]); w.y = pk2(h0[2], h0[3]); w.z = pk2(h1[0], h1[1]); w.w = pk2(h1[2], h1[3]);
                    *(v4u*)(hb + off) = w;
                    sq += (h0[0] * h0[0] + h0[1] * h0[1]) + (h0[2] * h0[2] + h0[3] * h0[3]) + (h1[0] * h1[0] + h1[1] * h1[1]) + (h1[2] * h1[2] + h1[3] * h1[3]);
                    if (FINAL && yoff >= 0) { *(f32x4*)(out + yoff + col0 + bj * 128) = h0; *(f32x4*)(out + yoff + col0 + bj * 128 + 4) = h1; }
                }
                sq += __shfl_xor(sq, 16); sq += __shfl_xor(sq, 32);
                if (fq == 0 && ssout) ssout[(size_t)row * 16 + u.pn * 4 + wc] = sq;
                asm volatile("" ::: "memory");
            }
    }
};
struct EpiZ {
    static constexpr bool PERM = true;
    bf16* zmix; bf16* gates; const float* ss; const float* bias;
    __device__ __forceinline__ void operator()(const pg8::f32x4 (&acc)[2][2][4][2], const pg8::Unit& u, int, int, int, int) const {
        EPI_IDS();
        const int row0 = u.pm * 256 + wr * 64 + fr, col0 = u.pn * 256 + wc * 32 + 8 * fq; const bool isgate = u.pn >= NMIXP / 256;
        f32x4 bv[2][2];
#pragma unroll
        for (int bj = 0; bj < 2; ++bj)
#pragma unroll
            for (int n = 0; n < 2; ++n) bv[bj][n] = *(const f32x4*)(bias + col0 + bj * 128 + 4 * n);
#pragma unroll
        for (int ai = 0; ai < 2; ++ai)
#pragma unroll
            for (int m = 0; m < 4; ++m) {
                const int row = row0 + ai * 128 + m * 16; const float rstd = rstd_of(ss, row);
#pragma unroll
                for (int bj = 0; bj < 2; ++bj) {
                    f32x4 v0 = acc[ai][bj][m][0] * rstd + bv[bj][0], v1 = acc[ai][bj][m][1] * rstd + bv[bj][1];
                    if (isgate) {
#pragma unroll
                        for (int j = 0; j < 4; ++j) { v0[j] = sigmoidf_(v0[j]); v1[j] = sigmoidf_(v1[j]); } }
                    v4u w; w.x = pk2(v0[0], v0[1]); w.y = pk2(v0[2], v0[3]); w.z = pk2(v1[0], v1[1]); w.w = pk2(v1[2], v1[3]);
                    if (isgate) *(v4u*)(gates + (size_t)row * NGATE + (col0 - NMIXP) + bj * 128) = w;
                    else *(v4u*)(zmix + (size_t)row * NMIXP + col0 + bj * 128) = w;
                }
            }
    }
};
struct EpiMerge {
    static constexpr bool PERM = true;
    bf16* merged; const bf16* gates;
    __device__ __forceinline__ void operator()(const pg8::f32x4 (&acc)[2][2][4][2], const pg8::Unit& u, int, int, int, int) const {
        EPI_IDS();
        const int n = u.pn >> 2, dt = u.pn & 3;
        const int row0 = u.pm * 256 + wr * 64 + fr, col0 = dt * 256 + wc * 32 + 8 * fq;
#pragma unroll
        for (int ai = 0; ai < 2; ++ai)
#pragma unroll
            for (int m = 0; m < 4; ++m) {
                const int row = row0 + ai * 128 + m * 16;
#pragma unroll
                for (int bj = 0; bj < 2; ++bj) {
                    const v4u gw = *(const v4u*)(gates + (size_t)row * NGATE + n * D + col0 + bj * 128);
                    bf16* mp = merged + (size_t)row * D + col0 + bj * 128;
                    float o[8];
                    o[0] = acc[ai][bj][m][0][0] * bflo(gw.x); o[1] = acc[ai][bj][m][0][1] * bfhi(gw.x); o[2] = acc[ai][bj][m][0][2] * bflo(gw.y); o[3] = acc[ai][bj][m][0][3] * bfhi(gw.y);
                    o[4] = acc[ai][bj][m][1][0] * bflo(gw.z); o[5] = acc[ai][bj][m][1][1] * bfhi(gw.z); o[6] = acc[ai][bj][m][1][2] * bflo(gw.w); o[7] = acc[ai][bj][m][1][3] * bfhi(gw.w);
                    if (n > 0) { const v4u pw = *(const v4u*)mp;
                        o[0] += bflo(pw.x); o[1] += bfhi(pw.x); o[2] += bflo(pw.y); o[3] += bfhi(pw.y); o[4] += bflo(pw.z); o[5] += bfhi(pw.z); o[6] += bflo(pw.w); o[7] += bfhi(pw.w); }
                    v4u w; w.x = pk2(o[0], o[1]); w.y = pk2(o[2], o[3]); w.z = pk2(o[4], o[5]); w.w = pk2(o[6], o[7]);
                    *(v4u*)mp = w;
                }
                asm volatile("" ::: "memory");
            }
    }
};

struct RowMap { int mode, a; __device__ __forceinline__ int operator()(int n) const { return mode == 0 ? n + a : (mode == 1 ? 256 * (n >> 7) + (n & 127) + a : (n < NMIX ? n : n + (NMIXP - NMIX))); } };
__device__ __forceinline__ void tr_item(const float* W, int K, int N, const float* gain, bf16* WT, int pitch, RowMap rm, LAS float* scr, int kb, int nb, int lane) {
    const int k0 = 64 * kb, n0 = 32 * nb; const int nn = n0 + (lane & 31);
#pragma unroll 8
    for (int i = 0; i < 32; ++i) { const int kk = 2 * i + (lane >> 5); float v = (nn < N) ? W[(size_t)(k0 + kk) * N + nn] : 0.f; if (gain) v *= gain[k0 + kk]; scr[kk * 33 + (lane & 31)] = v; }
    LDS_WAIT(); asm volatile("" ::: "memory");
    const int c = lane & 7;
#pragma unroll
    for (int j = 0; j < 4; ++j) { const int nl = (lane >> 3) + 8 * j; const int n = n0 + nl; const LAS float* s = scr + (8 * c) * 33 + nl;
        v4u o; o.x = pk2(s[0 * 33], s[1 * 33]); o.y = pk2(s[2 * 33], s[3 * 33]); o.z = pk2(s[4 * 33], s[5 * 33]); o.w = pk2(s[6 * 33], s[7 * 33]);
        if (n < N) *(v4u*)(WT + (size_t)rm(n) * pitch + k0 + 8 * c) = o; }
    LDS_WAIT(); asm volatile("" ::: "memory");
}
__device__ __forceinline__ void p0_prologue(const Ctx& C, const Params& P) {
    THREAD_IDS();
    LAS float* scr = (LAS float*)(C.lds + RING_OFF + wave * 16384);
    constexpr int I_FF = 16 * 88, I_DN = 44 * 32, I_IN = 16 * 225, I_BR = 4 * 4 * 32, I_OUT = 16 * 32;
    constexpr int PER_LAYER = 4 * I_FF + 2 * I_DN + I_IN + I_BR + I_OUT;
    for (int it = gw; it < DEPTH * PER_LAYER; it += NGW) {
        const int l = it / PER_LAYER; int r = it - l * PER_LAYER;
        bf16* W1a = WSP(bf16, WS_W1 + (size_t)(l * 2 + 0) * SZ_W1); bf16* W1b = WSP(bf16, WS_W1 + (size_t)(l * 2 + 1) * SZ_W1);
        bf16* Wda = WSP(bf16, WS_WD + (size_t)(l * 2 + 0) * SZ_WD); bf16* Wdb = WSP(bf16, WS_WD + (size_t)(l * 2 + 1) * SZ_WD);
        if (r < I_FF) { tr_item(C.in[I_F1G] + (size_t)l * D * DFF, D, DFF, C.in[I_NF1] + l * D, W1a, D, RowMap{1, 0}, scr, r / 88, r % 88, lane); continue; } r -= I_FF;
        if (r < I_FF) { tr_item(C.in[I_F1U] + (size_t)l * D * DFF, D, DFF, C.in[I_NF1] + l * D, W1a, D, RowMap{1, 128}, scr, r / 88, r % 88, lane); continue; } r -= I_FF;
        if (r < I_DN) { tr_item(C.in[I_F1D] + (size_t)l * D * DFF, DFF, D, nullptr, Wda, DFF, RowMap{0, 0}, scr, r / 32, r % 32, lane); continue; } r -= I_DN;
        if (r < I_FF) { tr_item(C.in[I_F2G] + (size_t)l * D * DFF, D, DFF, C.in[I_NF2] + l * D, W1b, D, RowMap{1, 0}, scr, r / 88, r % 88, lane); continue; } r -= I_FF;
        if (r < I_FF) { tr_item(C.in[I_F2U] + (size_t)l * D * DFF, D, DFF, C.in[I_NF2] + l * D, W1b, D, RowMap{1, 128}, scr, r / 88, r % 88, lane); continue; } r -= I_FF;
        if (r < I_DN) { tr_item(C.in[I_F2D] + (size_t)l * D * DFF, DFF, D, nullptr, Wdb, DFF, RowMap{0, 0}, scr, r / 32, r % 32, lane); continue; } r -= I_DN;
        if (r < I_IN) { tr_item(C.in[I_WIN] + (size_t)l * D * NIN, D, NIN, C.in[I_NMIX] + l * D, WSP(bf16, WS_WIN + (size_t)l * SZ_WIN), D, RowMap{2, 0}, scr, r / 225, r % 225, lane); continue; } r -= I_IN;
        if (r < I_BR) { const int n4 = r / 128, rr = r % 128; tr_item(C.in[I_WBR] + (size_t)(l * 4 + n4) * 256 * D, 256, D, nullptr, WSP(bf16, WS_WBR + (size_t)l * SZ_WBR), 256, RowMap{0, n4 * D}, scr, rr / 32, rr % 32, lane); continue; } r -= I_BR;
        tr_item(C.in[I_WOUT] + (size_t)l * D * D, D, D, nullptr, WSP(bf16, WS_WOUT + (size_t)l * SZ_WOUT), D, RowMap{0, 0}, scr, r / 32, r % 32, lane);
    }
    const int gt = gw * 64 + lane, NGT = NGW * 64;
    for (int i = gt; i < 2 * 240 * 128; i += NGT) { const int l = i / (240 * 128), r = i % (240 * 128); *(v4u*)(C.ws + WS_WIN + (size_t)l * SZ_WIN + ((size_t)NMIX * D) * 2 + (size_t)r * 16) = (v4u){0u, 0u, 0u, 0u}; }
    for (int i = gt; i < (M - MR) * 128; i += NGT) *(v4u*)(C.ws + WS_BR + (size_t)MR * D * 2 + (size_t)i * 16) = (v4u){0u, 0u, 0u, 0u};
    for (int i = gt; i < 2 * NINP; i += NGT) { const int l = i / NINP, j = i % NINP; float v = 0.f; if (j < NMIX) v = C.in[I_BIN][l * NIN + j]; else if (j >= NMIXP) v = C.in[I_BIN][l * NIN + NMIX + (j - NMIXP)]; WSP(float, WS_BINP)[i] = v; }
    for (int i = gt; i < NPOS * 32; i += NGT) { const int pi = i >> 5, fi = i & 31; const int pos = pi < L ? pi : PAST + (pi - L);
        const float angf = (float)pos * P.inv_freq[fi];
        const double a = (double)angf; const double k = rint(a * 0.15915494309189535); const double rr = (a - k * 6.283185307179586) - k * 2.4492935982947064e-16;
        const float rf = (float)rr; WSP(float, WS_ROPE)[i] = cosf(rf); WSP(float, WS_ROPE)[NPOS * 32 + i] = sinf(rf); }
    float* H = WSP(float, WS_H); bf16* HB = WSP(bf16, WS_HB); float* SS0 = WSP(float, WS_SS);
    for (int row = gw; row < M; row += NGW) {
        const float* src = nullptr;
        if (row < MP) { const int b = row / L, pos = row - b * L; src = pos < NMETA ? C.in[I_META] + (size_t)pos * D : C.in[I_XP] + ((size_t)b * SEQ + (pos - NMETA)) * D; }
        else if (row < MR) src = C.in[I_XS] + (size_t)(row - MP) * D;
        float s = 0.f;
#pragma unroll
        for (int j = 0; j < 4; ++j) { f32x4 v = src ? *(const f32x4*)(src + 256 * j + 4 * lane) : (f32x4){0.f, 0.f, 0.f, 0.f};
            *(f32x4*)(H + (size_t)row * D + 256 * j + 4 * lane) = v; s += (v[0] * v[0] + v[1] * v[1]) + (v[2] * v[2] + v[3] * v[3]);
            unsigned long long w = (unsigned long long)pk2(v[0], v[1]) | ((unsigned long long)pk2(v[2], v[3]) << 32);
            *(unsigned long long*)(HB + (size_t)row * D + 256 * j + 4 * lane) = w; }
        s = wave_sum(s); if (lane < 16) SS0[(size_t)row * 16 + lane] = lane == 0 ? s : 0.f;
    }
}

__device__ __forceinline__ float lam_of(const Ctx& C, int l, float lam_init) {
    THREAD_IDS();
    float a = 0.f, b = 0.f;
    for (int i = 0; i < 32; ++i) { a += C.in[I_LQ1][l * 32 + i] * C.in[I_LK1][l * 32 + i]; b += C.in[I_LQ2][l * 32 + i] * C.in[I_LK2][l * 32 + i]; }
    return __expf(a) - __expf(b) + lam_init;
}
__device__ __forceinline__ int t5_bucket(int n) {
    if (n < 16) return n;
    return 16 + (n >= 19) + (n >= 21) + (n >= 24) + (n >= 27) + (n >= 31) + (n >= 35) + (n >= 40) + (n >= 46) + (n >= 52) + (n >= 59) + (n >= 67) + (n >= 77) + (n >= 87) + (n >= 99) + (n >= 113);
}
__device__ __forceinline__ void n1_prep(const Ctx& C, int l) {
    THREAD_IDS();
    const bf16* ZM = WSP(bf16, WS_ZMIX); float* UB = WSP(float, WS_UBUF); float* RQ = WSP(float, WS_RQ); float* RK = WSP(float, WS_RK); float* QN = WSP(float, WS_QN); float* KN = WSP(float, WS_KN);
    float* VB = WSP(float, WS_VB); float* LD = WSP(float, WS_LDEC); const float* COS = WSP(float, WS_ROPE); const float* SIN = COS + NPOS * 32;
    for (int r = gw; r < MR; r += NGW) {
        const bf16* z = ZM + (size_t)r * NMIXP;
        const int pi = r < MP ? r % L : L + ((r - MP) & 7);
        float* kout = r < MP ? C.out + O_KP + ((size_t)l * MP + r) * 256 : C.out + O_KS + ((size_t)l * MS + (r - MP)) * 256;
        float* vout = r < MP ? C.out + O_VP + ((size_t)l * MP + r) * 256 : C.out + O_VS + ((size_t)l * MS + (r - MP)) * 256;
#pragma unroll
        for (int k = 0; k < 4; ++k) { const int c = lane + 64 * k;
            UB[(size_t)r * 256 + c] = bf2f(z[C_A + c]) * sigmoidf_(bf2f(z[C_G + c]));
            const float vv = bf2f(z[D_V + c]); VB[(size_t)r * 256 + c] = vv; vout[c] = vv;
            { float x = bf2f(z[D_Q + c]); float s = x * x; s += __shfl_xor(s, 1); s += __shfl_xor(s, 2); s += __shfl_xor(s, 4); s += __shfl_xor(s, 8); s += __shfl_xor(s, 16);
              QN[(size_t)r * 256 + c] = x * rsqrtf(s * (1.0f / 32) + EPS) * C.in[I_QN][l * 32 + (c & 31)]; }
            { float x = bf2f(z[D_K + c]); float s = x * x; s += __shfl_xor(s, 1); s += __shfl_xor(s, 2); s += __shfl_xor(s, 4); s += __shfl_xor(s, 8); s += __shfl_xor(s, 16);
              const float y = x * rsqrtf(s * (1.0f / 32) + EPS) * C.in[I_KN][l * 32 + (c & 31)]; KN[(size_t)r * 256 + c] = y; kout[c] = y; }
        }
#pragma unroll
        for (int k = 0; k < 2; ++k) { const int p = lane + 64 * k, h = p >> 5, i = p & 31; const float cs = COS[pi * 32 + i], sn = SIN[pi * 32 + i];
            { const float x1 = bf2f(z[R_Q + h * 64 + i]), x2 = bf2f(z[R_Q + h * 64 + 32 + i]); RQ[(size_t)r * 256 + h * 64 + i] = x1 * cs - x2 * sn; RQ[(size_t)r * 256 + h * 64 + 32 + i] = x1 * sn + x2 * cs; }
            { const float x1 = bf2f(z[R_K + h * 64 + i]), x2 = bf2f(z[R_K + h * 64 + 32 + i]); RK[(size_t)r * 256 + h * 64 + i] = (x1 * cs - x2 * sn) * 0.125f; RK[(size_t)r * 256 + h * 64 + 32 + i] = (x1 * sn + x2 * cs) * 0.125f; }
            { const int j = p; float gp = C.in[I_GAB][l * 128 + j];
              for (int i2 = 0; i2 < 16; ++i2) gp += bf2f(z[G_LOW + i2]) * C.in[I_GAW][(l * 16 + i2) * 128 + j];
              const float ls = fminf(gp, 0.f) - log1pf(__expf(-fabsf(gp)));
              LD[(size_t)r * 128 + j] = ls * (1.0f / 16.0f); }
        }
    }
}
__device__ __forceinline__ void n2_conv(const Ctx& C, int l) {
    THREAD_IDS();
    const float* UB = WSP(float, WS_UBUF); bf16* BR = WSP(bf16, WS_BR);
    const float* cw = C.in[I_CW] + (size_t)l * 31 * 256; const float* sc = C.in[I_SCONV];
    for (int r = gw; r < MR; r += NGW) {
        const bool smp = r >= MP; const int b = smp ? (r - MP) >> 3 : r / L; const int p = smp ? (r - MP) & 7 : r - b * L; const int rb = smp ? MP + b * 8 : b * L;
        float cv[4];
#pragma unroll
        for (int k = 0; k < 4; ++k) cv[k] = C.in[I_CB][l * 256 + lane + 64 * k];
        for (int j = 0; j < 31; ++j) { const int q = p + j - 30;
#pragma unroll
            for (int k = 0; k < 4; ++k) { const int c = lane + 64 * k; float uv;
                if (q >= 0) uv = UB[(size_t)(rb + q) * 256 + c]; else uv = smp ? sc[(((size_t)l * DB + b) * 30 + (p + j)) * 256 + c] : 0.f;
                cv[k] += cw[j * 256 + c] * uv; } }
        float s = (cv[0] + cv[1]) + (cv[2] + cv[3]); const float mean = wave_sum(s) * (1.0f / 256);
        float q2 = 0.f;
#pragma unroll
        for (int k = 0; k < 4; ++k) { cv[k] -= mean; q2 += cv[k] * cv[k]; }
        const float rstd = rsqrtf(wave_sum(q2) * (1.0f / 256) + EPS);
#pragma unroll
        for (int k = 0; k < 4; ++k) { const int c = lane + 64 * k; const float y = cv[k] * rstd * C.in[I_CLG][l * 256 + c] + C.in[I_CLB][l * 256 + c]; BR[(size_t)r * D + c] = (bf16)f2bf(siluf_(y)); }
    }
    const int gt = gw * 64 + lane, NGT = NGW * 64;
    for (int i = gt; i < BATCH * 30 * 256; i += NGT) { const int c = i & 255, ii = (i >> 8) % 30, b = i / (30 * 256); C.out[O_CP + (size_t)l * BATCH * 30 * 256 + i] = UB[(size_t)(b * L + L - 30 + ii) * 256 + c]; }
    for (int i = gt; i < DB * 30 * 256; i += NGT) { const int c = i & 255, ii = (i >> 8) % 30, b = i / (30 * 256);
        C.out[O_CS + (size_t)l * DB * 30 * 256 + i] = ii < 22 ? sc[(((size_t)l * DB + b) * 30 + 8 + ii) * 256 + c] : UB[(size_t)(MP + b * 8 + ii - 22) * 256 + c]; }
}
template <int DK, bool RET> __device__ __forceinline__ void la_seq(const Ctx& C, int l, bool smp, int b, int h) {
    THREAD_IDS();
    const bf16* ZM = WSP(bf16, WS_ZMIX); const float* RQ = WSP(float, WS_RQ); const float* RK = WSP(float, WS_RK); const float* LD = WSP(float, WS_LDEC); bf16* BR = WSP(bf16, WS_BR);
    const int nt = smp ? DS : L; const int row0 = smp ? MP + b * DS : b * L;
    float S[DK];
    if (smp) { const float* s0 = (RET ? C.in[I_SRET] : C.in[I_SGLA]) + (((size_t)l * DB + b) * 4 + h) * DK * 64;
#pragma unroll
        for (int k = 0; k < DK; ++k) S[k] = s0[k * 64 + lane]; }
    else {
#pragma unroll
        for (int k = 0; k < DK; ++k) S[k] = 0.f; }
    const float gamma = 1.0f - exp2f(-5.0f - (float)h);
    const float gn = RET ? C.in[I_RGN][(l * 4 + h) * 64 + lane] : C.in[I_GGN][(l * 4 + h) * 64 + lane];
    for (int t = 0; t < nt; ++t) {
        const int r = row0 + t; const bf16* z = ZM + (size_t)r * NMIXP;
        float ql, kl, dl = 1.f;
        if (RET) { ql = RQ[(size_t)r * 256 + h * 64 + lane]; kl = RK[(size_t)r * 256 + h * 64 + lane]; }
        else { const int lk = lane & 31; ql = bf2f(z[G_Q + h * 32 + lk]) * 0.17677669529663687f; kl = bf2f(z[G_K + h * 32 + lk]); dl = __expf(LD[(size_t)r * 128 + h * 32 + lk]); }
        const float v = bf2f(z[(RET ? R_V : G_V) + h * 64 + lane]);
        float o = 0.f;
#pragma unroll
        for (int k = 0; k < DK; ++k) { const float qk = __shfl(ql, k), kk = __shfl(kl, k); const float dk = RET ? gamma : __shfl(dl, k);
            S[k] = dk * S[k] + kk * v; o += qk * S[k]; if ((k & 7) == 7) __builtin_amdgcn_sched_barrier(0); }
        float y;
        if (RET) { const float mean = wave_sum(o) * (1.0f / 64); const float d = o - mean; const float var = wave_sum(d * d) * (1.0f / 64); y = d * rsqrtf(var + EPS) * gn; }
        else { const float ms = wave_sum(o * o) * (1.0f / 64); y = o * rsqrtf(ms + EPS) * gn; }
        const float g = bf2f(z[(RET ? R_G : G_R) + h * 64 + lane]);
        BR[(size_t)r * D + (RET ? 256 : 512) + h * 64 + lane] = (bf16)f2bf(siluf_(g) * y);
    }
    float* so = C.out + (RET ? (smp ? O_RS + (((size_t)l * DB + b) * 4 + h) * DK * 64 : O_RP + (((size_t)l * BATCH + b) * 4 + h) * DK * 64)
                             : (smp ? O_GS + (((size_t)l * DB + b) * 4 + h) * DK * 64 : O_GP + (((size_t)l * BATCH + b) * 4 + h) * DK * 64));
#pragma unroll
    for (int k = 0; k < DK; ++k) so[k * 64 + lane] = S[k];
}
__device__ __forceinline__ void n2_la(const Ctx& C, int l) {
    THREAD_IDS();
    if ((gw & 63) == 0 && (gw >> 6) < 32) { const int it = gw >> 6; const int b = (it >> 2) & 3, h = it & 3;
        if (it < 16) la_seq<64, true>(C, l, false, b, h); else la_seq<32, false>(C, l, false, b, h); }
    for (int it = gw; it < 256; it += NGW) { const int typ = it >> 7, b = (it >> 2) & 31, h = it & 3;
        if (typ == 0) la_seq<64, true>(C, l, true, b, h); else la_seq<32, false>(C, l, true, b, h); }
}
__device__ __forceinline__ void n2_attn_prompt(const Ctx& C, int l, float lam_init) {
    THREAD_IDS();
    const float* QN = WSP(float, WS_QN); const float* KN = WSP(float, WS_KN); const float* VB = WSP(float, WS_VB); bf16* BR = WSP(bf16, WS_BR);
    const float lam = lam_of(C, l, lam_init);
    LAS float* park = (LAS float*)(C.lds) + wave * (64 * 65);
    constexpr int NQG = (L + 63) / 64;
    for (int it = gw; it < BATCH * 4 * NQG; it += NGW) {
        const int qg = NQG - 1 - it / 16, bh = it % 16, b = bh >> 2, h = bh & 3;
        const int qpos = min(qg * 64 + lane, L - 1); const bool valid = (qg * 64 + lane) < L; const int qrow = b * L + qpos;
        const int nkeys = min(qg * 64 + 64, L);
        float bias_near[1]; (void)bias_near;
        for (int s = 0; s < 2; ++s) {
            float q[32];
#pragma unroll
            for (int i = 0; i < 32; i += 4) { const f32x4 t = *(const f32x4*)(QN + (size_t)qrow * 256 + h * 64 + s * 32 + i); q[i] = t[0] * 0.17677669529663687f; q[i + 1] = t[1] * 0.17677669529663687f; q[i + 2] = t[2] * 0.17677669529663687f; q[i + 3] = t[3] * 0.17677669529663687f; }
            float m = -INFINITY, lsum = 0.f; float acc[64];
#pragma unroll
            for (int i = 0; i < 64; ++i) acc[i] = 0.f;
            for (int j = 0; j < nkeys; ++j) {
                const float* kp = KN + (size_t)(b * L + j) * 256 + h * 64 + s * 32; const float* vp = VB + (size_t)(b * L + j) * 256 + h * 64;
                float sc = 0.f;
#pragma unroll
                for (int i = 0; i < 32; i += 4) { const f32x4 kv = *(const f32x4*)(kp + i); sc += q[i] * kv[0] + q[i + 1] * kv[1] + q[i + 2] * kv[2] + q[i + 3] * kv[3]; }
                const int n = qpos - j;
                sc += C.in[I_RELB][t5_bucket(n < 0 ? 0 : n) * 4 + h];
                if (n < 0) sc = -INFINITY;
                const float mn = fmaxf(m, sc); const float corr = __expf(m - mn); const float p = __expf(sc - mn);
                m = mn; lsum = lsum * corr + p;
#pragma unroll
                for (int i = 0; i < 64; i += 4) { const f32x4 vv = *(const f32x4*)(vp + i); acc[i] = acc[i] * corr + p * vv[0]; acc[i + 1] = acc[i + 1] * corr + p * vv[1]; acc[i + 2] = acc[i + 2] * corr + p * vv[2]; acc[i + 3] = acc[i + 3] * corr + p * vv[3]; }
            }
            const float inv = 1.0f / lsum;
            if (s == 0) {
#pragma unroll
                for (int i = 0; i < 64; ++i) park[lane * 65 + i] = acc[i] * inv;
                LDS_WAIT();
            } else {
                float ms = 0.f;
#pragma unroll
                for (int i = 0; i < 64; ++i) { acc[i] = park[lane * 65 + i] - lam * (acc[i] * inv); ms += acc[i] * acc[i]; }
                const float rn = rsqrtf(ms * (1.0f / 64) + EPS) * (1.0f - lam_init);
                if (valid) {
#pragma unroll
                    for (int i = 0; i < 64; i += 2) { const unsigned w = pk2(acc[i] * rn * C.in[I_SUBLN][l * 64 + i], acc[i + 1] * rn * C.in[I_SUBLN][l * 64 + i + 1]); *(unsigned*)(BR + (size_t)qrow * D + 768 + h * 64 + i) = w; } }
                LDS_WAIT();
            }
        }
    }
}
__device__ __forceinline__ void n2_attn_sample(const Ctx& C, int l, float lam_init) {
    THREAD_IDS();
    const float* QN = WSP(float, WS_QN); const float* KN = WSP(float, WS_KN); const float* VB = WSP(float, WS_VB); bf16* BR = WSP(bf16, WS_BR);
    const int* PT = (const int*)C.in[I_PT]; const float* CK = C.in[I_CK] + (size_t)l * NPOOL * PAGE * 256; const float* CV = C.in[I_CV] + (size_t)l * NPOOL * PAGE * 256;
    const float lam = lam_of(C, l, lam_init);
    LAS float* part = (LAS float*)C.lds;
    for (int b = blockIdx.x; b < DB; b += C.G) {
        const int row = tid & 63, split = tid >> 6, h = row >> 4, s = (row >> 3) & 1, t = row & 7;
        float q[32];
#pragma unroll
        for (int i = 0; i < 32; ++i) q[i] = QN[(size_t)(MP + b * 8 + t) * 256 + h * 64 + s * 32 + i] * 0.17677669529663687f;
        float m = -INFINITY, lsum = 0.f; float acc[64];
#pragma unroll
        for (int i = 0; i < 64; ++i) acc[i] = 0.f;
        for (int j = split; j < PAST + DS; j += 8) {
            const float* kp; const float* vp; bool vis = true;
            if (j < PAST) { const int page = PT[b * NPAGES + (j >> 7)]; const size_t base = (((size_t)page * PAGE + (j & 127)) * 4 + h) * 64; kp = CK + base + s * 32; vp = CV + base; }
            else { const int jj = j - PAST; const size_t r2 = (size_t)(MP + b * 8 + jj); kp = KN + r2 * 256 + h * 64 + s * 32; vp = VB + r2 * 256 + h * 64; vis = jj <= t; }
            float sc = 0.f;
#pragma unroll
            for (int i = 0; i < 32; i += 4) { const f32x4 kv = *(const f32x4*)(kp + i); sc += q[i] * kv[0] + q[i + 1] * kv[1] + q[i + 2] * kv[2] + q[i + 3] * kv[3]; }
            const int n = PAST + t - j;
            sc += C.in[I_RELB][t5_bucket(n < 0 ? 0 : n) * 4 + h];
            if (!vis) sc = -INFINITY;
            const float mn = fmaxf(m, sc); const float corr = __expf(m - mn); const float p = __expf(sc - mn);
            m = mn; lsum = lsum * corr + p;
#pragma unroll
            for (int i = 0; i < 64; i += 4) { const f32x4 vv = *(const f32x4*)(vp + i); acc[i] = acc[i] * corr + p * vv[0]; acc[i + 1] = acc[i + 1] * corr + p * vv[1]; acc[i + 2] = acc[i + 2] * corr + p * vv[2]; acc[i + 3] = acc[i + 3] * corr + p * vv[3]; }
        }
        LAS float* pr = part + (split * 64 + row) * 66;
        pr[64] = m; pr[65] = lsum;
#pragma unroll
        for (int i = 0; i < 64; ++i) pr[i] = acc[i];
        __syncthreads();
        for (int k = 0; k < 4; ++k) { const int p = wave * 4 + k, h2 = p >> 3, t2 = p & 7; float os[2];
#pragma unroll
            for (int s2 = 0; s2 < 2; ++s2) { const int rw = h2 * 16 + s2 * 8 + t2; float mm = -INFINITY;
                for (int sp = 0; sp < 8; ++sp) mm = fmaxf(mm, part[(sp * 64 + rw) * 66 + 64]);
                float ll = 0.f, oo = 0.f;
                for (int sp = 0; sp < 8; ++sp) { const float w = __expf(part[(sp * 64 + rw) * 66 + 64] - mm); ll += part[(sp * 64 + rw) * 66 + 65] * w; oo += part[(sp * 64 + rw) * 66 + lane] * w; }
                os[s2] = oo / ll; }
            const float o = os[0] - lam * os[1]; const float ms = wave_sum(o * o) * (1.0f / 64);
            const float y = o * rsqrtf(ms + EPS) * C.in[I_SUBLN][l * 64 + lane] * (1.0f - lam_init);
            BR[(size_t)(MP + b * 8 + t2) * D + 768 + h2 * 64 + lane] = (bf16)f2bf(y); }
        __syncthreads();
    }
}

template <int l> __device__ __forceinline__ void layer_fwd(const Ctx& C, const XcdBarrier& bar) {
#define GRID_BAR() xcd_barrier<false>(bar)
    LAS unsigned char* ring = C.lds + RING_OFF;
    float* SS = WSP(float, WS_SS); float* H = WSP(float, WS_H); bf16* HB = WSP(bf16, WS_HB); bf16* ACT = WSP(bf16, WS_ACT); bf16* ZMIX = WSP(bf16, WS_ZMIX); bf16* GATES = WSP(bf16, WS_GATES);
    bf16* BR = WSP(bf16, WS_BR); bf16* MERGED = WSP(bf16, WS_MERGED);
    constexpr float lam_init = l == 0 ? 0.2f : 0.35550906759096926f;
    constexpr bool last = (l == DEPTH - 1);
    { pg8::Gemm g{HB, WSP(bf16, WS_W1 + (size_t)(l * 2 + 0) * SZ_W1), D, D, D}; pg8::StaticOrder S; S.init(M, 2 * DFF, C.G, (int)blockIdx.x);
      EpiGLU E{ACT, SS + (size_t)(l * 3 + 0) * M * 16}; pg8::gemm_phase<EpiGLU, pg8::StaticOrder, true, true>(ring, g, S, E); }
    GRID_BAR();
    { pg8::Gemm g{ACT, WSP(bf16, WS_WD + (size_t)(l * 2 + 0) * SZ_WD), DFF, DFF, DFF}; pg8::StaticOrder S; S.init(M, D, C.G, (int)blockIdx.x);
      EpiRes<false, 1> E{H, HB, SS + (size_t)(l * 3 + 1) * M * 16, nullptr}; pg8::gemm_phase<EpiRes<false, 1>, pg8::StaticOrder, true, true>(ring, g, S, E); }
    GRID_BAR();
    { pg8::Gemm g{HB, WSP(bf16, WS_WIN + (size_t)l * SZ_WIN), D, D, D}; pg8::StaticOrder S; S.init(M, NINP, C.G, (int)blockIdx.x);
      EpiZ E{ZMIX, GATES, SS + (size_t)(l * 3 + 1) * M * 16, WSP(float, WS_BINP) + l * NINP}; pg8::gemm_phase<EpiZ, pg8::StaticOrder, true, true>(ring, g, S, E); }
    GRID_BAR();
    n1_prep(C, l);
    GRID_BAR();
    n2_attn_sample(C, l, lam_init);
    n2_la(C, l);
    n2_attn_prompt(C, l, lam_init);
    n2_conv(C, l);
    GRID_BAR();
    { pg8::Gemm g{BR, WSP(bf16, WS_WBR + (size_t)l * SZ_WBR), D, 256, 256}; pg8::MergeOrder S; S.init(M, C.G, (int)blockIdx.x);
      EpiMerge E{MERGED, GATES}; pg8::gemm_phase<EpiMerge, pg8::MergeOrder, true, true>(ring, g, S, E); }
    GRID_BAR();
    { pg8::Gemm g{MERGED, WSP(bf16, WS_WOUT + (size_t)l * SZ_WOUT), D, D, D}; pg8::StaticOrder S; S.init(M, D, C.G, (int)blockIdx.x);
      EpiRes<false, 2> E{H, HB, SS + (size_t)(l * 3 + 2) * M * 16, nullptr}; pg8::gemm_phase<EpiRes<false, 2>, pg8::StaticOrder, true, true>(ring, g, S, E); }
    GRID_BAR();
    { pg8::Gemm g{HB, WSP(bf16, WS_W1 + (size_t)(l * 2 + 1) * SZ_W1), D, D, D}; pg8::StaticOrder S; S.init(M, 2 * DFF, C.G, (int)blockIdx.x);
      EpiGLU E{ACT, SS + (size_t)(l * 3 + 2) * M * 16}; pg8::gemm_phase<EpiGLU, pg8::StaticOrder, true, true>(ring, g, S, E); }
    GRID_BAR();
    { pg8::Gemm g{ACT, WSP(bf16, WS_WD + (size_t)(l * 2 + 1) * SZ_WD), DFF, DFF, DFF}; pg8::StaticOrder S; S.init(M, D, C.G, (int)blockIdx.x);
      EpiRes<last, 1> E{H, HB, last ? nullptr : SS + (size_t)((l + 1) * 3) * M * 16, C.out};
      pg8::gemm_phase<EpiRes<last, 1>, pg8::StaticOrder, true, true>(ring, g, S, E); }
#undef GRID_BAR
}

__global__ void __launch_bounds__(NWAVES * 64, 2) fwd(Params P) {
    extern __shared__ __attribute__((aligned(16))) unsigned char lds[];
    Ctx C;
    C.in = P.in; C.out = P.out; C.ws = P.ws; C.lds = (LAS unsigned char*)lds;
    C.G = gridDim.x;
    volatile LAS unsigned* MISC = (volatile LAS unsigned*)(C.lds + MISC_OFF);
    for (int u = threadIdx.x; u < (LDS_BYTES - LDSCTL_OFF) / 4; u += NWAVES * 64) ((LAS unsigned*)(C.lds + LDSCTL_OFF))[u] = 0u;
    __syncthreads();
    unsigned* ctl = (unsigned*)(C.ws + WS_CTL);
    XcdBarrier bar = xcd_barrier_post(ctl + CW_BAR, MISC + 8);
    p0_prologue(C, P);
    xcd_barrier<true>(bar);
    layer_fwd<0>(C, bar);
    xcd_barrier<false>(bar);
    layer_fwd<1>(C, bar);
}

extern "C" void kernel_launch(void* const* d_in, const int* in_sizes, int n_in, void* d_out, int out_size, void* d_ws, size_t ws_size, hipStream_t stream) {
    static int grid = 0;
    if (grid == 0) {
        if (n_in != N_INPUTS || (size_t)out_size != O_END || ws_size < WS_END) { fprintf(stderr, "kernel_launch: unexpected shapes: n_in %d out %d (want %zu) ws %zu (want %zu)\n", n_in, out_size, (size_t)O_END, ws_size, (size_t)WS_END); grid = -1; return; }
        int dev = 0, cus = 0, per_cu = 0;
        if (hipGetDevice(&dev) != hipSuccess || hipDeviceGetAttribute(&cus, hipDeviceAttributeMultiprocessorCount, dev) != hipSuccess) { grid = -1; return; }
        if (hipFuncSetAttribute((const void*)fwd, hipFuncAttributeMaxDynamicSharedMemorySize, LDS_BYTES) != hipSuccess) { fprintf(stderr, "kernel_launch: hipFuncSetAttribute failed\n"); grid = -1; return; }
        if (hipOccupancyMaxActiveBlocksPerMultiprocessor(&per_cu, (const void*)fwd, NWAVES * 64, LDS_BYTES) != hipSuccess || per_cu < 1) { fprintf(stderr, "kernel_launch: occupancy query says %d blocks per CU\n", per_cu); }
        (void)hipGetLastError();
        grid = cus;
    }
    if (grid < 0) return;
    if (hipMemsetAsync((char*)d_ws + WS_CTL, 0, CTL_ZERO_BYTES, stream) != hipSuccess) return;
    Params p{};
    for (int i = 0; i < N_INPUTS; ++i) p.in[i] = (const float*)d_in[i];
    p.out = (float*)d_out; p.ws = (unsigned char*)d_ws;
    for (int i = 0; i < 32; ++i) p.inv_freq[i] = (float)pow(10000.0, -(double)i / 32.0);
    hipLaunchKernelGGL(fwd, dim3(grid), dim3(NWAVES * 64), LDS_BYTES, stream, p);
}
```

```cpp
#include <hip/hip_runtime.h>
#include <cstdio>
#include <cstdint>
#include <cmath>

namespace pg8 {
#define PG8_LAS __attribute__((address_space(3)))
typedef unsigned short bf16_t;
typedef short bf16x8 __attribute__((ext_vector_type(8)));
typedef float f32x4 __attribute__((ext_vector_type(4)));
typedef unsigned u32x4 __attribute__((ext_vector_type(4)));
constexpr int BM = 256, BK = 64, HALF = 128, HTB = HALF * BK * 2  , STAGE_BYTES = 8 * HTB, NXCD = 8, WGM = 8;

__host__ __device__ __forceinline__ int lds_byte(int r, int c) { const int st = (r >> 4) * 2 + (c >> 5), rr = r & 15, cc = c & 31, ob = rr * 64 + cc * 2; return st * 1024 + (ob ^ (((ob >> 9) & 1) << 5)); }
__host__ __device__ __forceinline__ void stage_rc(int b, int& R, int& C) { const int st = b / 1024, sb = b % 1024, swz = sb ^ (((sb >> 9) & 1) << 5); R = (st >> 1) * 16 + swz / 64; C = (st & 1) * 32 + (swz % 64) / 2; }
__host__ __device__ __forceinline__ int perm32(int rho) { const int n = rho >> 4, i = rho & 15; return 8 * (i >> 2) + 4 * n + (i & 3); }

struct Unit { int pm, pn, acol; };
struct Gemm { const bf16_t* A; const bf16_t* Bt; int lda, ldb, K; };

struct StaticOrder {
    int nM, nN, nwg, G, c;
    __host__ __device__ void init(int M, int N, int G_, int c_) { nM = M / BM; nN = N / BM; nwg = nM * nN; G = G_; c = c_; }
    __host__ __device__ bool next(int i, Unit& u) const {
        const long L = (long)i * G + c; if (L >= nwg) return false;
        int wgid = (int)L; { const int q = nwg / NXCD, r = nwg % NXCD, xcd = wgid % NXCD, off = wgid / NXCD; wgid = (xcd < r ? xcd * (q + 1) : r * (q + 1) + (xcd - r) * q) + off; }
        const int nig = WGM * nN, gid = wgid / nig, fm = gid * WGM, gsz = (nM - fm) < WGM ? (nM - fm) : WGM;
        u.pm = fm + ((wgid % nig) % gsz); u.pn = (wgid % nig) / gsz; u.acol = 0; return true;
    }
};
struct MergeOrder {
    int ntile, G, c;
    __host__ __device__ void init(int M, int G_, int c_) { ntile = (M / BM) * 4; G = G_; c = c_; }
    __host__ __device__ bool next(int i, Unit& u) const {
        const int T = (i >> 2) * G + c; if (T >= ntile) return false;
        const int n = i & 3; u.pm = T >> 2; u.pn = n * 4 + (T & 3); u.acol = n * 256; return true;
    }
};

__device__ __forceinline__ unsigned cvt_pk_bf16(float lo, float hi) { unsigned r; asm volatile("v_cvt_pk_bf16_f32 %0, %1, %2" : "=v"(r) : "v"(lo), "v"(hi)); return r; }

template <class Epi, class Sched, bool ALIGN_EPI = false, bool SP2 = false>
__device__ __forceinline__ void gemm_phase(PG8_LAS unsigned char* lds, const Gemm g, const Sched& S, const Epi& E) {
    int tid_ = threadIdx.x; asm volatile("" : "+v"(tid_));
    const int tid = tid_, wid = __builtin_amdgcn_readfirstlane(tid >> 6), lane = tid & 63, wr = wid >> 2, wc = wid & 3, fr = lane & 15, fq = lane >> 4;
    const int nt = g.K / BK;
    unsigned voffA[2], voffB[2];
#pragma unroll
    for (int i = 0; i < 2; ++i) { int R, C; stage_rc(tid * 16 + i * 8192, R, C); const int Rb = Epi::PERM ? ((R & ~31) + perm32(R & 31)) : R;
        voffA[i] = (unsigned)(R * g.lda + C) * 2u; voffB[i] = (unsigned)(Rb * g.ldb + C) * 2u; }
    const size_t kstep = (size_t)(BK * 2);
    const size_t hstepA = (size_t)HALF * g.lda * 2, hstepB = (size_t)HALF * g.ldb * 2;
    const size_t tstepA = 2 * hstepA, tstepB = 2 * hstepB;
    const unsigned ldsw = (unsigned)wid * 1024u;
    const int aoff = lds_byte(wr * 64 + fr, fq * 8), boff = lds_byte(wc * 32 + fr, fq * 8);
#define PG8_SA(b, h) (((b) * 2 + (h)) * HTB)
#define PG8_SB(b, h) ((4 + (b) * 2 + (h)) * HTB)
#define PG8_STAGE(bufoff, gbase, voff) do { _Pragma("unroll") for (int _i = 0; _i < 2; ++_i) \
        __builtin_amdgcn_global_load_lds((const unsigned*)((const char*)(gbase) + (voff)[_i]), (PG8_LAS unsigned*)(lds + (bufoff) + ldsw + _i * 8192), 16, 0, 0); } while (0)
#define PG8_LDA(dst, b, h) do { _Pragma("unroll") for (int m = 0; m < 4; ++m) _Pragma("unroll") for (int k = 0; k < 2; ++k) dst[m][k] = *(const PG8_LAS bf16x8*)(lds + PG8_SA(b, h) + aoff + m * 2048 + k * 1024); } while (0)
#define PG8_LDB(dst, b, h) do { _Pragma("unroll") for (int n = 0; n < 2; ++n) _Pragma("unroll") for (int k = 0; k < 2; ++k) dst[n][k] = *(const PG8_LAS bf16x8*)(lds + PG8_SB(b, h) + boff + n * 2048 + k * 1024); } while (0)
#define PG8_MMA(ai, bj, At, Bt) do { __builtin_amdgcn_s_setprio(1); _Pragma("unroll") for (int m = 0; m < 4; ++m) _Pragma("unroll") for (int n = 0; n < 2; ++n) _Pragma("unroll") for (int k = 0; k < 2; ++k) \
        acc[ai][bj][m][n] = __builtin_amdgcn_mfma_f32_16x16x32_bf16(Bt[n][k], At[m][k], acc[ai][bj][m][n], 0, 0, 0); __builtin_amdgcn_s_setprio(0); } while (0)
#define PG8_WAIT_V(n) asm volatile("s_waitcnt vmcnt(" #n ")" ::: "memory")
#define PG8_WAIT_L(n) asm volatile("s_waitcnt lgkmcnt(" #n ")" ::: "memory")
#define PG8_BAR __builtin_amdgcn_s_barrier()
#define PG8_SCHED __builtin_amdgcn_sched_barrier(0)
    Unit cur, nxt; int ui = 0;
    if (!S.next(0, cur)) return;
    f32x4 acc[2][2][4][2];
#pragma unroll
    for (int a = 0; a < 2; ++a)
#pragma unroll
        for (int b = 0; b < 2; ++b)
#pragma unroll
            for (int m = 0; m < 4; ++m)
#pragma unroll
                for (int n = 0; n < 2; ++n) acc[a][b][m][n] = (f32x4){0.f, 0.f, 0.f, 0.f};
    bf16x8 At[4][2], B0[2][2], B1[2][2];
    const char* cA = (const char*)g.A + (size_t)cur.pm * tstepA + (size_t)cur.acol * 2; const char* cB = (const char*)g.Bt + (size_t)cur.pn * tstepB;
    if constexpr (SP2) {
        PG8_STAGE(PG8_SB(0, 0), cB, voffB); PG8_STAGE(PG8_SB(0, 1), cB + hstepB, voffB); PG8_STAGE(PG8_SA(0, 0), cA, voffA); PG8_STAGE(PG8_SA(0, 1), cA + hstepA, voffA);
        if (wr == 1) PG8_BAR;
        PG8_WAIT_V(2); PG8_BAR;
        PG8_STAGE(PG8_SB(1, 0), cB + kstep, voffB); PG8_STAGE(PG8_SA(1, 0), cA + kstep, voffA); PG8_STAGE(PG8_SB(1, 1), cB + hstepB + kstep, voffB);
        PG8_WAIT_V(6); PG8_BAR;
    } else {
        PG8_STAGE(PG8_SB(0, 0), cB, voffB); PG8_STAGE(PG8_SA(0, 0), cA, voffA); PG8_STAGE(PG8_SB(0, 1), cB + hstepB, voffB); PG8_STAGE(PG8_SA(0, 1), cA + hstepA, voffA);
        if (wr == 1) PG8_BAR;
        PG8_WAIT_V(4); PG8_BAR;
        PG8_STAGE(PG8_SB(1, 0), cB + kstep, voffB); PG8_STAGE(PG8_SA(1, 0), cA + kstep, voffA); PG8_STAGE(PG8_SB(1, 1), cB + hstepB + kstep, voffB);
        PG8_WAIT_V(6); PG8_BAR;
    }
    for (;;) {
        const bool has_next = S.next(ui + 1, nxt);
        const char* nA = has_next ? (const char*)g.A + (size_t)nxt.pm * tstepA + (size_t)nxt.acol * 2 : cA; const char* nB = has_next ? (const char*)g.Bt + (size_t)nxt.pn * tstepB : cB;
        for (int t = 0; t < nt; t += 2) {
            const bool last = (t == nt - 2);
            const char* a1 = cA + (size_t)(t + 1) * kstep;
            const char* a2 = last ? nA : cA + (size_t)(t + 2) * kstep; const char* b2 = last ? nB : cB + (size_t)(t + 2) * kstep;
            const char* a3 = a2 + kstep; const char* b3 = b2 + kstep;
            if constexpr (SP2) {
            PG8_LDB(B0, 0, 0); PG8_LDB(B1, 0, 1); PG8_SCHED; PG8_LDA(At, 0, 0); PG8_STAGE(PG8_SA(1, 1), a1 + hstepA, voffA);
            PG8_WAIT_V(8); PG8_WAIT_L(0); PG8_BAR; PG8_MMA(0, 0, At, B0); PG8_MMA(0, 1, At, B1); PG8_BAR; PG8_SCHED;
            PG8_LDA(At, 0, 1); PG8_STAGE(PG8_SB(0, 0), b2, voffB); PG8_STAGE(PG8_SB(0, 1), b2 + hstepB, voffB); PG8_STAGE(PG8_SA(0, 0), a2, voffA);
            PG8_WAIT_V(8); PG8_WAIT_L(0); PG8_BAR; PG8_MMA(1, 0, At, B0); PG8_MMA(1, 1, At, B1); PG8_BAR; PG8_SCHED;
            PG8_LDB(B0, 1, 0); PG8_LDB(B1, 1, 1); PG8_SCHED; PG8_LDA(At, 1, 0); PG8_STAGE(PG8_SA(0, 1), a2 + hstepA, voffA);
            PG8_WAIT_V(8); PG8_WAIT_L(0); PG8_BAR; PG8_MMA(0, 0, At, B0); PG8_MMA(0, 1, At, B1); PG8_BAR; PG8_SCHED;
            PG8_LDA(At, 1, 1); PG8_STAGE(PG8_SB(1, 0), b3, voffB); PG8_STAGE(PG8_SB(1, 1), b3 + hstepB, voffB); PG8_STAGE(PG8_SA(1, 0), a3, voffA);
            PG8_WAIT_V(8); PG8_WAIT_L(0); PG8_BAR; PG8_MMA(1, 0, At, B0); PG8_MMA(1, 1, At, B1); PG8_BAR; PG8_SCHED;
            } else {
            PG8_LDB(B0, 0, 0); PG8_SCHED; PG8_LDA(At, 0, 0); PG8_STAGE(PG8_SA(1, 1), a1 + hstepA, voffA);
            PG8_WAIT_L(8); PG8_BAR; PG8_WAIT_L(0); PG8_MMA(0, 0, At, B0); PG8_BAR; PG8_SCHED;
            PG8_LDB(B1, 0, 1); PG8_STAGE(PG8_SB(0, 0), b2, voffB);
            PG8_BAR; PG8_WAIT_L(0); PG8_MMA(0, 1, At, B1); PG8_BAR;
            PG8_LDA(At, 0, 1); PG8_STAGE(PG8_SA(0, 0), a2, voffA);
            PG8_BAR; PG8_WAIT_L(0); PG8_MMA(1, 0, At, B0); PG8_BAR; PG8_SCHED;
            PG8_STAGE(PG8_SB(0, 1), b2 + hstepB, voffB);
            PG8_WAIT_V(6); PG8_BAR; PG8_MMA(1, 1, At, B1); PG8_BAR;
            PG8_LDB(B0, 1, 0); PG8_SCHED; PG8_LDA(At, 1, 0); PG8_STAGE(PG8_SA(0, 1), a2 + hstepA, voffA);
            PG8_WAIT_L(8); PG8_BAR; PG8_WAIT_L(0); PG8_MMA(0, 0, At, B0); PG8_BAR; PG8_SCHED;
            PG8_LDB(B1, 1, 1); PG8_STAGE(PG8_SB(1, 0), b3, voffB);
            PG8_BAR; PG8_WAIT_L(0); PG8_MMA(0, 1, At, B1); PG8_BAR;
            PG8_LDA(At, 1, 1); PG8_STAGE(PG8_SA(1, 0), a3, voffA);
            PG8_BAR; PG8_WAIT_L(0); PG8_MMA(1, 0, At, B0); PG8_BAR; PG8_SCHED;
            PG8_STAGE(PG8_SB(1, 1), b3 + hstepB, voffB);
            PG8_WAIT_V(6); PG8_BAR; PG8_MMA(1, 1, At, B1); PG8_BAR;
            }
        }
        if constexpr (ALIGN_EPI) { if (wr == 0) PG8_BAR; }
        E(acc, cur, wr, wc, fr, fq);
        if (!has_next) break;
#pragma unroll
        for (int a = 0; a < 2; ++a)
#pragma unroll
            for (int b = 0; b < 2; ++b)
#pragma unroll
                for (int m = 0; m < 4; ++m)
#pragma unroll
                    for (int n = 0; n < 2; ++n) acc[a][b][m][n] = (f32x4){0.f, 0.f, 0.f, 0.f};
        cur = nxt; cA = nA; cB = nB; ++ui;
        if constexpr (ALIGN_EPI) { if (wr == 1) PG8_BAR; }
    }
    PG8_WAIT_V(0);
    if constexpr (!ALIGN_EPI) { if (wr == 0) PG8_BAR; }
    PG8_BAR;
#undef PG8_SA
#undef PG8_SB
#undef PG8_STAGE
#undef PG8_LDA
#undef PG8_LDB
#undef PG8_MMA
#undef PG8_WAIT_V
#undef PG8_WAIT_L
#undef PG8_BAR
#undef PG8_SCHED
}
}

constexpr int NWAVES = 8;
constexpr int D = 1024, DFF = 2816, NIN = 7184, NMIX = 3088, NMIXP = 3328, NGATE = 4096, NINP = NMIXP + NGATE;
constexpr int SEQ = 4096, NMETA = 16, L = SEQ + NMETA, BATCH = 4, DB = 32, DS = 8, PAST = 8192, PAGE = 128, NPAGES = PAST / PAGE, NPOOL = 2560, DEPTH = 2;
constexpr int MP = BATCH * L, MS = DB * DS, MR = MP + MS, M = 16896;
constexpr int NPOS = L + DS;
constexpr float EPS = 1e-6f;
constexpr int C_A = 0, C_G = 256, R_Q = 512, R_K = 768, R_V = 1024, R_G = 1280, G_Q = 1536, G_K = 1664, G_V = 1792, G_R = 2048, G_LOW = 2304, D_Q = 2320, D_K = 2576, D_V = 2832;
constexpr size_t O_YP = 0, O_YS = O_YP + (size_t)BATCH * SEQ * D, O_KP = O_YS + (size_t)MS * D, O_VP = O_KP + (size_t)DEPTH * MP * 256, O_KS = O_VP + (size_t)DEPTH * MP * 256,
                 O_VS = O_KS + (size_t)DEPTH * MS * 256, O_RP = O_VS + (size_t)DEPTH * MS * 256, O_RS = O_RP + (size_t)DEPTH * BATCH * 4 * 64 * 64, O_GP = O_RS + (size_t)DEPTH * DB * 4 * 64 * 64,
                 O_GS = O_GP + (size_t)DEPTH * BATCH * 4 * 32 * 64, O_CP = O_GS + (size_t)DEPTH * DB * 4 * 32 * 64, O_CS = O_CP + (size_t)DEPTH * BATCH * 30 * 256, O_END = O_CS + (size_t)DEPTH * DB * 30 * 256;
enum { I_XP = 0, I_XS, I_CK, I_CV, I_PT, I_SRET, I_SGLA, I_SCONV, I_META, I_RELB, I_NF1, I_F1G, I_F1U, I_F1D, I_NMIX, I_WIN, I_BIN, I_CW, I_CB, I_CLG, I_CLB, I_RGN, I_GAW, I_GAB, I_GGN,
       I_QN, I_KN, I_LQ1, I_LK1, I_LQ2, I_LK2, I_SUBLN, I_WBR, I_WOUT, I_NF2, I_F2G, I_F2U, I_F2D, N_INPUTS };

constexpr size_t MiB = 1u << 20;
constexpr size_t WS_CTL = 0, CTL_ZERO_BYTES = 1 * MiB;
constexpr size_t SZ_SS = (size_t)M * 16 * 4;
constexpr size_t SZ_W1 = (size_t)2 * DFF * D * 2, SZ_WD = (size_t)D * DFF * 2, SZ_WIN = (size_t)NINP * D * 2, SZ_WBR = (size_t)4 * D * 256 * 2, SZ_WOUT = (size_t)D * D * 2;
constexpr size_t WS_W1 = 4 * MiB;
constexpr size_t WS_WD = WS_W1 + 4 * SZ_W1;
constexpr size_t WS_WIN = WS_WD + 4 * SZ_WD;
constexpr size_t WS_WBR = WS_WIN + 2 * SZ_WIN;
constexpr size_t WS_WOUT = WS_WBR + 2 * SZ_WBR;
constexpr size_t WS_BINP = WS_WOUT + 2 * SZ_WOUT;
constexpr size_t WS_ROPE = WS_BINP + 64 * 1024;
constexpr size_t WS_SS = WS_ROPE + 2 * MiB;
constexpr size_t WS_H = 128 * MiB;
constexpr size_t WS_HB = WS_H + (size_t)M * D * 4;
constexpr size_t WS_ACT = WS_HB + (size_t)M * D * 2;
constexpr size_t WS_ZMIX = WS_ACT + (size_t)M * DFF * 2;
constexpr size_t WS_GATES = WS_ZMIX + (size_t)M * NMIXP * 2;
constexpr size_t WS_BR = WS_GATES + (size_t)M * NGATE * 2;
constexpr size_t WS_MERGED = WS_BR + (size_t)M * D * 2;
constexpr size_t WS_UBUF = WS_MERGED + (size_t)M * D * 2;
constexpr size_t WS_RQ = WS_UBUF + (size_t)M * 256 * 4, WS_RK = WS_RQ + (size_t)M * 256 * 4, WS_QN = WS_RK + (size_t)M * 256 * 4, WS_KN = WS_QN + (size_t)M * 256 * 4, WS_VB = WS_KN + (size_t)M * 256 * 4;
constexpr size_t WS_LDEC = WS_VB + (size_t)M * 256 * 4;
constexpr size_t WS_END = WS_LDEC + (size_t)M * 128 * 4;
static_assert(WS_ROPE + 2 * NPOS * 32 * 4 <= WS_SS && WS_SS + 6 * SZ_SS <= WS_H, "weights region overflows");
constexpr int CW_BAR = 4096;

constexpr int RING_OFF = 0, RING_BYTES = 131072;
constexpr int LDSCTL_OFF = 144384, MISC_OFF = LDSCTL_OFF + 320;
constexpr int LDS_BYTES = 147456;
static_assert(MISC_OFF + 128 <= LDS_BYTES, "LDS map");

#define GAS __attribute__((address_space(1)))
#define LAS __attribute__((address_space(3)))
typedef unsigned short bf16;
typedef unsigned v4u __attribute__((ext_vector_type(4)));
typedef float f32x4 __attribute__((ext_vector_type(4)));
#define LDS_WAIT() asm volatile("s_waitcnt lgkmcnt(0)" ::: "memory")
#define VM_WAIT() asm volatile("s_waitcnt vmcnt(0)" ::: "memory")
__device__ __forceinline__ unsigned f2bf(float f) { unsigned u = __builtin_bit_cast(unsigned, f); return (u + 0x7fffu + ((u >> 16) & 1u)) >> 16; }
__device__ __forceinline__ unsigned pk2(float lo, float hi) { return f2bf(lo) | (f2bf(hi) << 16); }
__device__ __forceinline__ float bf2f(bf16 b) { return __builtin_bit_cast(float, ((unsigned)b) << 16); }
__device__ __forceinline__ float bflo(unsigned w) { return __builtin_bit_cast(float, w << 16); }
__device__ __forceinline__ float bfhi(unsigned w) { return __builtin_bit_cast(float, w & 0xffff0000u); }
__device__ __forceinline__ float wave_sum(float v) {
#pragma unroll
    for (int o = 1; o < 64; o <<= 1) v += __shfl_xor(v, o);
    return v;
}
__device__ __forceinline__ float sigmoidf_(float x) { return 1.0f / (1.0f + __expf(-x)); }
__device__ __forceinline__ float siluf_(float x) { return x / (1.0f + __expf(-x)); }

#define XB_TMO      128
#define XB_XCNT(j)  (256  + 64 * (j))
#define XB_XSUB(j)  (1280 + 64 * (j))
#define XB_XGEN(j)  (2304 + 64 * (j))
#define XB_TOP      3328
#define XB_TOPGEN   3392
#define XCD_BAR_WORDS 3456
#define XB_SPIN_CAP (1u << 22)

__device__ __forceinline__ unsigned xb_ld(unsigned* p)              { return __hip_atomic_load(p, __ATOMIC_RELAXED, __HIP_MEMORY_SCOPE_AGENT); }
__device__ __forceinline__ unsigned xb_add(unsigned* p, unsigned v) { return __hip_atomic_fetch_add(p, v, __ATOMIC_RELAXED, __HIP_MEMORY_SCOPE_AGENT); }
__device__ __forceinline__ unsigned xb_xcc_id() { return (unsigned)__builtin_amdgcn_s_getreg((3 << 11) | 20) & 0xFu; }
#define XB_SPIN(cond, bar) do { unsigned _sp = 0; while (cond) { __builtin_amdgcn_s_sleep(1); \
    if ((++_sp & 255u) == 0u) { if (xb_ld(&(bar)[XB_TMO])) break; if (_sp > XB_SPIN_CAP) { atomicAdd(&(bar)[XB_TMO], 1u); break; } } } } while (0)

struct XcdBarrier { unsigned* bar; unsigned x; volatile LAS unsigned* st; };

__device__ __forceinline__ XcdBarrier xcd_barrier_post(unsigned* bar, volatile LAS unsigned* st) {
    XcdBarrier b; b.bar = bar; b.x = xb_xcc_id(); b.st = st;
    if (threadIdx.x == 0) (void)xb_add(&bar[XB_XCNT(b.x)], 1u);
    return b;
}
__device__ __forceinline__ void xcd_barrier_complete(unsigned* bar, unsigned x, unsigned& nloc, unsigned& nx) {
    const unsigned G = gridDim.x * gridDim.y * gridDim.z;
    unsigned sum, cnt, mine, sp = 0u;
    for (;;) {
        sum = 0u; cnt = 0u; mine = 0u;
#pragma unroll
        for (unsigned j = 0; j < 16; ++j) { const unsigned c = xb_ld(&bar[XB_XCNT(j)]); sum += c; cnt += (c > 0u) ? 1u : 0u; mine = (j == x) ? c : mine; }
        if (sum == G) break;
        __builtin_amdgcn_s_sleep(1);
        if ((++sp & 255u) == 0u) { if (xb_ld(&bar[XB_TMO])) break; if (sp > XB_SPIN_CAP) { atomicAdd(&bar[XB_TMO], 1u); break; } }
    }
    nloc = mine > 0u ? mine : 1u; nx = cnt > 0u ? cnt : 1u;
}
template <bool FIRST> __device__ __forceinline__ void xcd_barrier(const XcdBarrier& b) {
    asm volatile("s_waitcnt vmcnt(0)" ::: "memory");
    __syncthreads();
    if (threadIdx.x == 0) {
        unsigned* bar = b.bar;
        asm volatile("" : "+s"(bar));
        __builtin_amdgcn_s_waitcnt(0);
        unsigned nloc = b.st[0], nx = b.st[1];
        if (FIRST) { if (nloc == 0u) { xcd_barrier_complete(bar, b.x, nloc, nx); b.st[0] = nloc; b.st[1] = nx; } }
        const unsigned old = xb_add(&bar[XB_XSUB(b.x)], 1u);
        const unsigned gen = old / nloc;
        if (old + 1u == (gen + 1u) * nloc) {
            __builtin_amdgcn_fence(__ATOMIC_RELEASE, "agent");
            asm volatile("s_waitcnt vmcnt(0)" ::: "memory");
            const unsigned og = xb_add(&bar[XB_TOP], 1u);
            const unsigned tg = og / nx;
            if (og + 1u == (tg + 1u) * nx) xb_add(&bar[XB_TOPGEN], 1u);
            else XB_SPIN(xb_ld(&bar[XB_TOPGEN]) == tg, bar);
            __builtin_amdgcn_fence(__ATOMIC_ACQUIRE, "agent");
            xb_add(&bar[XB_XGEN(b.x)], 1u);
            asm volatile("s_waitcnt vmcnt(0)" ::: "memory");
        } else {
            XB_SPIN(xb_ld(&bar[XB_XGEN(b.x)]) == gen, bar);
            __builtin_amdgcn_fence(__ATOMIC_ACQUIRE, "agent");
            asm volatile("s_waitcnt vmcnt(0)" ::: "memory");
        }
    }
    __syncthreads();
}

struct Params { const float* in[N_INPUTS]; float* out; unsigned char* ws; float inv_freq[32]; };
static_assert(sizeof(Params) == N_INPUTS * 8 + 16 + 128, "Params has no padding");

struct Ctx {
    const float* const* in; float* out; unsigned char* ws;
    LAS unsigned char* lds;
    int G;
};
#define THREAD_IDS() int tid_ = threadIdx.x; asm volatile("" : "+v"(tid_)); const int tid = tid_, lane = tid & 63, wave = __builtin_amdgcn_readfirstlane(tid >> 6), gw = blockIdx.x * NWAVES + wave, NGW = C.G * NWAVES; (void)tid; (void)lane; (void)wave; (void)gw; (void)NGW
#define WSP(T, off) ((T*)(C.ws + (off)))

__device__ __forceinline__ float rstd_of(const float* ssp, int row) {
    const f32x4 a = *(const f32x4*)(ssp + (size_t)row * 16), b = *(const f32x4*)(ssp + (size_t)row * 16 + 4), c = *(const f32x4*)(ssp + (size_t)row * 16 + 8), d = *(const f32x4*)(ssp + (size_t)row * 16 + 12);
    const float s = (((a[0] + a[1]) + (a[2] + a[3])) + ((b[0] + b[1]) + (b[2] + b[3]))) + (((c[0] + c[1]) + (c[2] + c[3])) + ((d[0] + d[1]) + (d[2] + d[3])));
    return rsqrtf(s * (1.0f / D) + EPS);
}
#define EPI_IDS() int t_ = threadIdx.x; asm volatile("" : "+v"(t_)); const int wid_ = __builtin_amdgcn_readfirstlane(t_ >> 6), wr = wid_ >> 2, wc = wid_ & 3, fr = t_ & 15, fq = (t_ & 63) >> 4
struct EpiGLU {
    static constexpr bool PERM = true;
    bf16* act; const float* ss;
    __device__ __forceinline__ void operator()(const pg8::f32x4 (&acc)[2][2][4][2], const pg8::Unit& u, int, int, int, int) const {
        EPI_IDS();
        const int row0 = u.pm * 256 + wr * 64 + fr, col0 = u.pn * 128 + wc * 32 + 8 * fq;
#pragma unroll
        for (int ai = 0; ai < 2; ++ai)
#pragma unroll
            for (int m = 0; m < 4; ++m) {
                const int row = row0 + ai * 128 + m * 16; const float rstd = rstd_of(ss, row);
                float o[8];
#pragma unroll
                for (int n = 0; n < 2; ++n)
#pragma unroll
                    for (int j = 0; j < 4; ++j) { const float g = acc[ai][0][m][n][j] * rstd, up = acc[ai][1][m][n][j] * rstd; o[n * 4 + j] = siluf_(g) * up; }
                v4u w; w.x = pk2(o[0], o[1]); w.y = pk2(o[2], o[3]); w.z = pk2(o[4], o[5]); w.w = pk2(o[6], o[7]);
                *(v4u*)(act + (size_t)row * DFF + col0) = w;
            }
    }
};
template <bool FINAL, int SCALE2> struct EpiRes {
    static constexpr bool PERM = true;
    float* h; bf16* hb; float* ssout; float* out;
    __device__ __forceinline__ void operator()(const pg8::f32x4 (&acc)[2][2][4][2], const pg8::Unit& u, int, int, int, int) const {
        EPI_IDS();
        const int row0 = u.pm * 256 + wr * 64 + fr, col0 = u.pn * 256 + wc * 32 + 8 * fq;
#pragma unroll
        for (int ai = 0; ai < 2; ++ai)
#pragma unroll
            for (int m = 0; m < 4; ++m) {
                const int row = row0 + ai * 128 + m * 16; float sq = 0.f;
                constexpr float scale = 0.5f * SCALE2;
                long yoff = -1;
                if (FINAL) { if (row < MP) { const int b = row / L, pos = row - b * L; if (pos >= NMETA) yoff = (long)O_YP + ((long)b * SEQ + (pos - NMETA)) * D; } else if (row < MR) yoff = (long)O_YS + (long)(row - MP) * D; }
#pragma unroll
                for (int bj = 0; bj < 2; ++bj) {
                    const size_t off = (size_t)row * D + col0 + bj * 128;
                    f32x4 h0 = *(const f32x4*)(h + off), h1 = *(const f32x4*)(h + off + 4);
                    h0 = h0 + acc[ai][bj][m][0] * scale; h1 = h1 + acc[ai][bj][m][1] * scale;
                    *(f32x4*)(h + off) = h0; *(f32x4*)(h + off + 4) = h1;
                    v4u w; w.x = pk2(h0[0], h0[1]); w.y = pk2(h0[2], h0[3]); w.z = pk2(h1[0], h1[1]); w.w = pk2(h1[2], h1[3]);
                    *(v4u*)(hb + off) = w;
                    sq += (h0[0] * h0[0] + h0[1] * h0[1]) + (h0[2] * h0[2] + h0[3] * h0[3]) + (h1[0] * h1[0] + h1[1] * h1[1]) + (h1[2] * h1[2] + h1[3] * h1[3]);
                    if (FINAL && yoff >= 0) { *(f32x4*)(out + yoff + col0 + bj * 128) = h0; *(f32x4*)(out + yoff + col0 + bj * 128 + 4) = h1; }
                }
                sq += __shfl_xor(sq, 16); sq += __shfl_xor(sq, 32);
                if (fq == 0 && ssout) ssout[(size_t)row * 16 + u.pn * 4 + wc] = sq;
                asm volatile("" ::: "memory");
            }
    }
};
struct EpiZ {
    static constexpr bool PERM = true;
    bf16* zmix; bf16* gates; const float* ss; const float* bias;
    __device__ __forceinline__ void operator()(const pg8::f32x4 (&acc)[2][2][4][2], const pg8::Unit& u, int, int, int, int) const {
        EPI_IDS();
        const int row0 = u.pm * 256 + wr * 64 + fr, col0 = u.pn * 256 + wc * 32 + 8 * fq; const bool isgate = u.pn >= NMIXP / 256;
        f32x4 bv[2][2];
#pragma unroll
        for (int bj = 0; bj < 2; ++bj)
#pragma unroll
            for (int n = 0; n < 2; ++n) bv[bj][n] = *(const f32x4*)(bias + col0 + bj * 128 + 4 * n);
#pragma unroll
        for (int ai = 0; ai < 2; ++ai)
#pragma unroll
            for (int m = 0; m < 4; ++m) {
                const int row = row0 + ai * 128 + m * 16; const float rstd = rstd_of(ss, row);
#pragma unroll
                for (int bj = 0; bj < 2; ++bj) {
                    f32x4 v0 = acc[ai][bj][m][0] * rstd + bv[bj][0], v1 = acc[ai][bj][m][1] * rstd + bv[bj][1];
                    if (isgate) {
#pragma unroll
                        for (int j = 0; j < 4; ++j) { v0[j] = sigmoidf_(v0[j]); v1[j] = sigmoidf_(v1[j]); } }
                    v4u w; w.x = pk2(v0[0], v0[1]); w.y = pk2(v0[2], v0[3]); w.z = pk2(v1[0], v1[1]); w.w = pk2(v1[2], v1[3]);
                    if (isgate) *(v4u*)(gates + (size_t)row * NGATE + (col0 - NMIXP) + bj * 128) = w;
                    else *(v4u*)(zmix + (size_t)row * NMIXP + col0 + bj * 128) = w;
                }
            }
    }
};
struct EpiMerge {
    static constexpr bool PERM = true;
    bf16* merged; const bf16* gates;
    __device__ __forceinline__ void operator()(const pg8::f32x4 (&acc)[2][2][4][2], const pg8::Unit& u, int, int, int, int) const {
        EPI_IDS();
        const int n = u.pn >> 2, dt = u.pn & 3;
        const int row0 = u.pm * 256 + wr * 64 + fr, col0 = dt * 256 + wc * 32 + 8 * fq;
#pragma unroll
        for (int ai = 0; ai < 2; ++ai)
#pragma unroll
            for (int m = 0; m < 4; ++m) {
                const int row = row0 + ai * 128 + m * 16;
#pragma unroll
                for (int bj = 0; bj < 2; ++bj) {
                    const v4u gw = *(const v4u*)(gates + (size_t)row * NGATE + n * D + col0 + bj * 128);
                    bf16* mp = merged + (size_t)row * D + col0 + bj * 128;
                    float o[8];
                    o[0] = acc[ai][bj][m][0][0] * bflo(gw.x); o[1] = acc[ai][bj][m][0][1] * bfhi(gw.x); o[2] = acc[ai][bj][m][0][2] * bflo(gw.y); o[3] = acc[ai][bj][m][0][3] * bfhi(gw.y);
                    o[4] = acc[ai][bj][m][1][0] * bflo(gw.z); o[5] = acc[ai][bj][m][1][1] * bfhi(gw.z); o[6] = acc[ai][bj][m][1][2] * bflo(gw.w); o[7] = acc[ai][bj][m][1][3] * bfhi(gw.w);
                    if (n > 0) { const v4u pw = *(const v4u*)mp;
                        o[0] += bflo(pw.x); o[1] += bfhi(pw.x); o[2] += bflo(pw.y); o[3] += bfhi(pw.y); o[4] += bflo(pw.z); o[5] += bfhi(pw.z); o[6] += bflo(pw.w); o[7] += bfhi(pw.w); }
                    v4u w; w.x = pk2(o[0], o[1]); w.y = pk2(o[2], o[3]); w.z = pk2(o[4], o[5]); w.w = pk2(o[6], o[7]);
                    *(v4u*)mp = w;
                }
                asm volatile("" ::: "memory");
            }
    }
};

struct RowMap { int mode, a; __device__ __forceinline__ int operator()(int n) const { return mode == 0 ? n + a : (mode == 1 ? 256 * (n >> 7) + (n & 127) + a : (n < NMIX ? n : n + (NMIXP - NMIX))); } };
__device__ __forceinline__ void tr_item(const float* W, int K, int N, const float* gain, bf16* WT, int pitch, RowMap rm, LAS float* scr, int kb, int nb, int lane) {
    const int k0 = 64 * kb, n0 = 32 * nb; const int nn = n0 + (lane & 31);
#pragma unroll 8
    for (int i = 0; i < 32; ++i) { const int kk = 2 * i + (lane >> 5); float v = (nn < N) ? W[(size_t)(k0 + kk) * N + nn] : 0.f; if (gain) v *= gain[k0 + kk]; scr[kk * 33 + (lane & 31)] = v; }
    LDS_WAIT(); asm volatile("" ::: "memory");
    const int c = lane & 7;
#pragma unroll
    for (int j = 0; j < 4; ++j) { const int nl = (lane >> 3) + 8 * j; const int n = n0 + nl; const LAS float* s = scr + (8 * c) * 33 + nl;
        v4u o; o.x = pk2(s[0 * 33], s[1 * 33]); o.y = pk2(s[2 * 33], s[3 * 33]); o.z = pk2(s[4 * 33], s[5 * 33]); o.w = pk2(s[6 * 33], s[7 * 33]);
        if (n < N) *(v4u*)(WT + (size_t)rm(n) * pitch + k0 + 8 * c) = o; }
    LDS_WAIT(); asm volatile("" ::: "memory");
}
__device__ __forceinline__ void p0_prologue(const Ctx& C, const Params& P) {
    THREAD_IDS();
    LAS float* scr = (LAS float*)(C.lds + RING_OFF + wave * 16384);
    constexpr int I_FF = 16 * 88, I_DN = 44 * 32, I_IN = 16 * 225, I_BR = 4 * 4 * 32, I_OUT = 16 * 32;
    constexpr int PER_LAYER = 4 * I_FF + 2 * I_DN + I_IN + I_BR + I_OUT;
    for (int it = gw; it < DEPTH * PER_LAYER; it += NGW) {
        const int l = it / PER_LAYER; int r = it - l * PER_LAYER;
        bf16* W1a = WSP(bf16, WS_W1 + (size_t)(l * 2 + 0) * SZ_W1); bf16* W1b = WSP(bf16, WS_W1 + (size_t)(l * 2 + 1) * SZ_W1);
        bf16* Wda = WSP(bf16, WS_WD + (size_t)(l * 2 + 0) * SZ_WD); bf16* Wdb = WSP(bf16, WS_WD + (size_t)(l * 2 + 1) * SZ_WD);
        if (r < I_FF) { tr_item(C.in[I_F1G] + (size_t)l * D * DFF, D, DFF, C.in[I_NF1] + l * D, W1a, D, RowMap{1, 0}, scr, r / 88, r % 88, lane); continue; } r -= I_FF;
        if (r < I_FF) { tr_item(C.in[I_F1U] + (size_t)l * D * DFF, D, DFF, C.in[I_NF1] + l * D, W1a, D, RowMap{1, 128}, scr, r / 88, r % 88, lane); continue; } r -= I_FF;
        if (r < I_DN) { tr_item(C.in[I_F1D] + (size_t)l * D * DFF, DFF, D, nullptr, Wda, DFF, RowMap{0, 0}, scr, r / 32, r % 32, lane); continue; } r -= I_DN;
        if (r < I_FF) { tr_item(C.in[I_F2G] + (size_t)l * D * DFF, D, DFF, C.in[I_NF2] + l * D, W1b, D, RowMap{1, 0}, scr, r / 88, r % 88, lane); continue; } r -= I_FF;
        if (r < I_FF) { tr_item(C.in[I_F2U] + (size_t)l * D * DFF, D, DFF, C.in[I_NF2] + l * D, W1b, D, RowMap{1, 128}, scr, r / 88, r % 88, lane); continue; } r -= I_FF;
        if (r < I_DN) { tr_item(C.in[I_F2D] + (size_t)l * D * DFF, DFF, D, nullptr, Wdb, DFF, RowMap{0, 0}, scr, r / 32, r % 32, lane); continue; } r -= I_DN;
        if (r < I_IN) { tr_item(C.in[I_WIN] + (size_t)l * D * NIN, D, NIN, C.in[I_NMIX] + l * D, WSP(bf16, WS_WIN + (size_t)l * SZ_WIN), D, RowMap{2, 0}, scr, r / 225, r % 225, lane); continue; } r -= I_IN;
        if (r < I_BR) { const int n4 = r / 128, rr = r % 128; tr_item(C.in[I_WBR] + (size_t)(l * 4 + n4) * 256 * D, 256, D, nullptr, WSP(bf16, WS_WBR + (size_t)l * SZ_WBR), 256, RowMap{0, n4 * D}, scr, rr / 32, rr % 32, lane); continue; } r -= I_BR;
        tr_item(C.in[I_WOUT] + (size_t)l * D * D, D, D, nullptr, WSP(bf16, WS_WOUT + (size_t)l * SZ_WOUT), D, RowMap{0, 0}, scr, r / 32, r % 32, lane);
    }
    const int gt = gw * 64 + lane, NGT = NGW * 64;
    for (int i = gt; i < 2 * 240 * 128; i += NGT) { const int l = i / (240 * 128), r = i % (240 * 128); *(v4u*)(C.ws + WS_WIN + (size_t)l * SZ_WIN + ((size_t)NMIX * D) * 2 + (size_t)r * 16) = (v4u){0u, 0u, 0u, 0u}; }
    for (int i = gt; i < (M - MR) * 128; i += NGT) *(v4u*)(C.ws + WS_BR + (size_t)MR * D * 2 + (size_t)i * 16) = (v4u){0u, 0u, 0u, 0u};
    for (int i = gt; i < 2 * NINP; i += NGT) { const int l = i / NINP, j = i % NINP; float v = 0.f; if (j < NMIX) v = C.in[I_BIN][l * NIN + j]; else if (j >= NMIXP) v = C.in[I_BIN][l * NIN + NMIX + (j - NMIXP)]; WSP(float, WS_BINP)[i] = v; }
    for (int i = gt; i < NPOS * 32; i += NGT) { const int pi = i >> 5, fi = i & 31; const int pos = pi < L ? pi : PAST + (pi - L);
        const float angf = (float)pos * P.inv_freq[fi];
        const double a = (double)angf; const double k = rint(a * 0.15915494309189535); const double rr = (a - k * 6.283185307179586) - k * 2.4492935982947064e-16;
        const float rf = (float)rr; WSP(float, WS_ROPE)[i] = cosf(rf); WSP(float, WS_ROPE)[NPOS * 32 + i] = sinf(rf); }
    float* H = WSP(float, WS_H); bf16* HB = WSP(bf16, WS_HB); float* SS0 = WSP(float, WS_SS);
    for (int row = gw; row < M; row += NGW) {
        const float* src = nullptr;
        if (row < MP) { const int b = row / L, pos = row - b * L; src = pos < NMETA ? C.in[I_META] + (size_t)pos * D : C.in[I_XP] + ((size_t)b * SEQ + (pos - NMETA)) * D; }
        else if (row < MR) src = C.in[I_XS] + (size_t)(row - MP) * D;
        float s = 0.f;
#pragma unroll
        for (int j = 0; j < 4; ++j) { f32x4 v = src ? *(const f32x4*)(src + 256 * j + 4 * lane) : (f32x4){0.f, 0.f, 0.f, 0.f};
            *(f32x4*)(H + (size_t)row * D + 256 * j + 4 * lane) = v; s += (v[0] * v[0] + v[1] * v[1]) + (v[2] * v[2] + v[3] * v[3]);
            unsigned long long w = (unsigned long long)pk2(v[0], v[1]) | ((unsigned long long)pk2(v[2], v[3]) << 32);
            *(unsigned long long*)(HB + (size_t)row * D + 256 * j + 4 * lane) = w; }
        s = wave_sum(s); if (lane < 16) SS0[(size_t)row * 16 + lane] = lane == 0 ? s : 0.f;
    }
}

__device__ __forceinline__ float lam_of(const Ctx& C, int l, float lam_init) {
    THREAD_IDS();
    float a = 0.f, b = 0.f;
    for (int i = 0; i < 32; ++i) { a += C.in[I_LQ1][l * 32 + i] * C.in[I_LK1][l * 32 + i]; b += C.in[I_LQ2][l * 32 + i] * C.in[I_LK2][l * 32 + i]; }
    return __expf(a) - __expf(b) + lam_init;
}
__device__ __forceinline__ int t5_bucket(int n) {
    if (n < 16) return n;
    return 16 + (n >= 19) + (n >= 21) + (n >= 24) + (n >= 27) + (n >= 31) + (n >= 35) + (n >= 40) + (n >= 46) + (n >= 52) + (n >= 59) + (n >= 67) + (n >= 77) + (n >= 87) + (n >= 99) + (n >= 113);
}
__device__ __forceinline__ void n1_prep(const Ctx& C, int l) {
    THREAD_IDS();
    const bf16* ZM = WSP(bf16, WS_ZMIX); float* UB = WSP(float, WS_UBUF); float* RQ = WSP(float, WS_RQ); float* RK = WSP(float, WS_RK); float* QN = WSP(float, WS_QN); float* KN = WSP(float, WS_KN);
    float* VB = WSP(float, WS_VB); float* LD = WSP(float, WS_LDEC); const float* COS = WSP(float, WS_ROPE); const float* SIN = COS + NPOS * 32;
    for (int r = gw; r < MR; r += NGW) {
        const bf16* z = ZM + (size_t)r * NMIXP;
        const int pi = r < MP ? r % L : L + ((r - MP) & 7);
        float* kout = r < MP ? C.out + O_KP + ((size_t)l * MP + r) * 256 : C.out + O_KS + ((size_t)l * MS + (r - MP)) * 256;
        float* vout = r < MP ? C.out + O_VP + ((size_t)l * MP + r) * 256 : C.out + O_VS + ((size_t)l * MS + (r - MP)) * 256;
#pragma unroll
        for (int k = 0; k < 4; ++k) { const int c = lane + 64 * k;
            UB[(size_t)r * 256 + c] = bf2f(z[C_A + c]) * sigmoidf_(bf2f(z[C_G + c]));
            const float vv = bf2f(z[D_V + c]); VB[(size_t)r * 256 + c] = vv; vout[c] = vv;
            { float x = bf2f(z[D_Q + c]); float s = x * x; s += __shfl_xor(s, 1); s += __shfl_xor(s, 2); s += __shfl_xor(s, 4); s += __shfl_xor(s, 8); s += __shfl_xor(s, 16);
              QN[(size_t)r * 256 + c] = x * rsqrtf(s * (1.0f / 32) + EPS) * C.in[I_QN][l * 32 + (c & 31)]; }
            { float x = bf2f(z[D_K + c]); float s = x * x; s += __shfl_xor(s, 1); s += __shfl_xor(s, 2); s += __shfl_xor(s, 4); s += __shfl_xor(s, 8); s += __shfl_xor(s, 16);
              const float y = x * rsqrtf(s * (1.0f / 32) + EPS) * C.in[I_KN][l * 32 + (c & 31)]; KN[(size_t)r * 256 + c] = y; kout[c] = y; }
        }
#pragma unroll
        for (int k = 0; k < 2; ++k) { const int p = lane + 64 * k, h = p >> 5, i = p & 31; const float cs = COS[pi * 32 + i], sn = SIN[pi * 32 + i];
            { const float x1 = bf2f(z[R_Q + h * 64 + i]), x2 = bf2f(z[R_Q + h * 64 + 32 + i]); RQ[(size_t)r * 256 + h * 64 + i] = x1 * cs - x2 * sn; RQ[(size_t)r * 256 + h * 64 + 32 + i] = x1 * sn + x2 * cs; }
            { const float x1 = bf2f(z[R_K + h * 64 + i]), x2 = bf2f(z[R_K + h * 64 + 32 + i]); RK[(size_t)r * 256 + h * 64 + i] = (x1 * cs - x2 * sn) * 0.125f; RK[(size_t)r * 256 + h * 64 + 32 + i] = (x1 * sn + x2 * cs) * 0.125f; }
            { const int j = p; float gp = C.in[I_GAB][l * 128 + j];
              for (int i2 = 0; i2 < 16; ++i2) gp += bf2f(z[G_LOW + i2]) * C.in[I_GAW][(l * 16 + i2) * 128 + j];
              const float ls = fminf(gp, 0.f) - log1pf(__expf(-fabsf(gp)));
              LD[(size_t)r * 128 + j] = ls * (1.0f / 16.0f); }
        }
    }
}
__device__ __forceinline__ void n2_conv(const Ctx& C, int l) {
    THREAD_IDS();
    const float* UB = WSP(float, WS_UBUF); bf16* BR = WSP(bf16, WS_BR);
    const float* cw = C.in[I_CW] + (size_t)l * 31 * 256; const float* sc = C.in[I_SCONV];
    for (int r = gw; r < MR; r += NGW) {
        const bool smp = r >= MP; const int b = smp ? (r - MP) >> 3 : r / L; const int p = smp ? (r - MP) & 7 : r - b * L; const int rb = smp ? MP + b * 8 : b * L;
        float cv[4];
#pragma unroll
        for (int k = 0; k < 4; ++k) cv[k] = C.in[I_CB][l * 256 + lane + 64 * k];
        for (int j = 0; j < 31; ++j) { const int q = p + j - 30;
#pragma unroll
            for (int k = 0; k < 4; ++k) { const int c = lane + 64 * k; float uv;
                if (q >= 0) uv = UB[(size_t)(rb + q) * 256 + c]; else uv = smp ? sc[(((size_t)l * DB + b) * 30 + (p + j)) * 256 + c] : 0.f;
                cv[k] += cw[j * 256 + c] * uv; } }
        float s = (cv[0] + cv[1]) + (cv[2] + cv[3]); const float mean = wave_sum(s) * (1.0f / 256);
        float q2 = 0.f;
#pragma unroll
        for (int k = 0; k < 4; ++k) { cv[k] -= mean; q2 += cv[k] * cv[k]; }
        const float rstd = rsqrtf(wave_sum(q2) * (1.0f / 256) + EPS);
#pragma unroll
        for (int k = 0; k < 4; ++k) { const int c = lane + 64 * k; const float y = cv[k] * rstd * C.in[I_CLG][l * 256 + c] + C.in[I_CLB][l * 256 + c]; BR[(size_t)r * D + c] = (bf16)f2bf(siluf_(y)); }
    }
    const int gt = gw * 64 + lane, NGT = NGW * 64;
    for (int i = gt; i < BATCH * 30 * 256; i += NGT) { const int c = i & 255, ii = (i >> 8) % 30, b = i / (30 * 256); C.out[O_CP + (size_t)l * BATCH * 30 * 256 + i] = UB[(size_t)(b * L + L - 30 + ii) * 256 + c]; }
    for (int i = gt; i < DB * 30 * 256; i += NGT) { const int c = i & 255, ii = (i >> 8) % 30, b = i / (30 * 256);
        C.out[O_CS + (size_t)l * DB * 30 * 256 + i] = ii < 22 ? sc[(((size_t)l * DB + b) * 30 + 8 + ii) * 256 + c] : UB[(size_t)(MP + b * 8 + ii - 22) * 256 + c]; }
}
template <int DK, bool RET> __device__ __forceinline__ void la_seq(const Ctx& C, int l, bool smp, int b, int h) {
    THREAD_IDS();
    const bf16* ZM = WSP(bf16, WS_ZMIX); const float* RQ = WSP(float, WS_RQ); const float* RK = WSP(float, WS_RK); const float* LD = WSP(float, WS_LDEC); bf16* BR = WSP(bf16, WS_BR);
    const int nt = smp ? DS : L; const int row0 = smp ? MP + b * DS : b * L;
    float S[DK];
    if (smp) { const float* s0 = (RET ? C.in[I_SRET] : C.in[I_SGLA]) + (((size_t)l * DB + b) * 4 + h) * DK * 64;
#pragma unroll
        for (int k = 0; k < DK; ++k) S[k] = s0[k * 64 + lane]; }
    else {
#pragma unroll
        for (int k = 0; k < DK; ++k) S[k] = 0.f; }
    const float gamma = 1.0f - exp2f(-5.0f - (float)h);
    const float gn = RET ? C.in[I_RGN][(l * 4 + h) * 64 + lane] : C.in[I_GGN][(l * 4 + h) * 64 + lane];
    for (int t = 0; t < nt; ++t) {
        const int r = row0 + t; const bf16* z = ZM + (size_t)r * NMIXP;
        float ql, kl, dl = 1.f;
        if (RET) { ql = RQ[(size_t)r * 256 + h * 64 + lane]; kl = RK[(size_t)r * 256 + h * 64 + lane]; }
        else { const int lk = lane & 31; ql = bf2f(z[G_Q + h * 32 + lk]) * 0.17677669529663687f; kl = bf2f(z[G_K + h * 32 + lk]); dl = __expf(LD[(size_t)r * 128 + h * 32 + lk]); }
        const float v = bf2f(z[(RET ? R_V : G_V) + h * 64 + lane]);
        float o = 0.f;
#pragma unroll
        for (int k = 0; k < DK; ++k) { const float qk = __shfl(ql, k), kk = __shfl(kl, k); const float dk = RET ? gamma : __shfl(dl, k);
            S[k] = dk * S[k] + kk * v; o += qk * S[k]; if ((k & 7) == 7) __builtin_amdgcn_sched_barrier(0); }
        float y;
        if (RET) { const float mean = wave_sum(o) * (1.0f / 64); const float d = o - mean; const float var = wave_sum(d * d) * (1.0f / 64); y = d * rsqrtf(var + EPS) * gn; }
        else { const float ms = wave_sum(o * o) * (1.0f / 64); y = o * rsqrtf(ms + EPS) * gn; }
        const float g = bf2f(z[(RET ? R_G : G_R) + h * 64 + lane]);
        BR[(size_t)r * D + (RET ? 256 : 512) + h * 64 + lane] = (bf16)f2bf(siluf_(g) * y);
    }
    float* so = C.out + (RET ? (smp ? O_RS + (((size_t)l * DB + b) * 4 + h) * DK * 64 : O_RP + (((size_t)l * BATCH + b) * 4 + h) * DK * 64)
                             : (smp ? O_GS + (((size_t)l * DB + b) * 4 + h) * DK * 64 : O_GP + (((size_t)l * BATCH + b) * 4 + h) * DK * 64));
#pragma unroll
    for (int k = 0; k < DK; ++k) so[k * 64 + lane] = S[k];
}
__device__ __forceinline__ void n2_la(const Ctx& C, int l) {
    THREAD_IDS();
    if ((gw & 63) == 0 && (gw >> 6) < 32) { const int it = gw >> 6; const int b = (it >> 2) & 3, h = it & 3;
        if (it < 16) la_seq<64, true>(C, l, false, b, h); else la_seq<32, false>(C, l, false, b, h); }
    for (int it = gw; it < 256; it += NGW) { const int typ = it >> 7, b = (it >> 2) & 31, h = it & 3;
        if (typ == 0) la_seq<64, true>(C, l, true, b, h); else la_seq<32, false>(C, l, true, b, h); }
}
__device__ __forceinline__ void n2_attn_prompt(const Ctx& C, int l, float lam_init) {
    THREAD_IDS();
    const float* QN = WSP(float, WS_QN); const float* KN = WSP(float, WS_KN); const float* VB = WSP(float, WS_VB); bf16* BR = WSP(bf16, WS_BR);
    const float lam = lam_of(C, l, lam_init);
    LAS float* park = (LAS float*)(C.lds) + wave * (64 * 65);
    constexpr int NQG = (L + 63) / 64;
    for (int it = gw; it < BATCH * 4 * NQG; it += NGW) {
        const int qg = NQG - 1 - it / 16, bh = it % 16, b = bh >> 2, h = bh & 3;
        const int qpos = min(qg * 64 + lane, L - 1); const bool valid = (qg * 64 + lane) < L; const int qrow = b * L + qpos;
        const int nkeys = min(qg * 64 + 64, L);
        float bias_near[1]; (void)bias_near;
        for (int s = 0; s < 2; ++s) {
            float q[32];
#pragma unroll
            for (int i = 0; i < 32; i += 4) { const f32x4 t = *(const f32x4*)(QN + (size_t)qrow * 256 + h * 64 + s * 32 + i); q[i] = t[0] * 0.17677669529663687f; q[i + 1] = t[1] * 0.17677669529663687f; q[i + 2] = t[2] * 0.17677669529663687f; q[i + 3] = t[3] * 0.17677669529663687f; }
            float m = -INFINITY, lsum = 0.f; float acc[64];
#pragma unroll
            for (int i = 0; i < 64; ++i) acc[i] = 0.f;
            for (int j = 0; j < nkeys; ++j) {
                const float* kp = KN + (size_t)(b * L + j) * 256 + h * 64 + s * 32; const float* vp = VB + (size_t)(b * L + j) * 256 + h * 64;
                float sc = 0.f;
#pragma unroll
                for (int i = 0; i < 32; i += 4) { const f32x4 kv = *(const f32x4*)(kp + i); sc += q[i] * kv[0] + q[i + 1] * kv[1] + q[i + 2] * kv[2] + q[i + 3] * kv[3]; }
                const int n = qpos - j;
                sc += C.in[I_RELB][t5_bucket(n < 0 ? 0 : n) * 4 + h];
                if (n < 0) sc = -INFINITY;
                const float mn = fmaxf(m, sc); const float corr = __expf(m - mn); const float p = __expf(sc - mn);
                m = mn; lsum = lsum * corr + p;
#pragma unroll
                for (int i = 0; i < 64; i += 4) { const f32x4 vv = *(const f32x4*)(vp + i); acc[i] = acc[i] * corr + p * vv[0]; acc[i + 1] = acc[i + 1] * corr + p * vv[1]; acc[i + 2] = acc[i + 2] * corr + p * vv[2]; acc[i + 3] = acc[i + 3] * corr + p * vv[3]; }
            }
            const float inv = 1.0f / lsum;
            if (s == 0) {
#pragma unroll
                for (int i = 0; i < 64; ++i) park[lane * 65 + i] = acc[i] * inv;
                LDS_WAIT();
            } else {
                float ms = 0.f;
#pragma unroll
                for (int i = 0; i < 64; ++i) { acc[i] = park[lane * 65 + i] - lam * (acc[i] * inv); ms += acc[i] * acc[i]; }
                const float rn = rsqrtf(ms * (1.0f / 64) + EPS) * (1.0f - lam_init);
                if (valid) {
#pragma unroll
                    for (int i = 0; i < 64; i += 2) { const unsigned w = pk2(acc[i] * rn * C.in[I_SUBLN][l * 64 + i], acc[i + 1] * rn * C.in[I_SUBLN][l * 64 + i + 1]); *(unsigned*)(BR + (size_t)qrow * D + 768 + h * 64 + i) = w; } }
                LDS_WAIT();
            }
        }
    }
}
__device__ __forceinline__ void n2_attn_sample(const Ctx& C, int l, float lam_init) {
    THREAD_IDS();
    const float* QN = WSP(float, WS_QN); const float* KN = WSP(float, WS_KN); const float* VB = WSP(float, WS_VB); bf16* BR = WSP(bf16, WS_BR);
    const int* PT = (const int*)C.in[I_PT]; const float* CK = C.in[I_CK] + (size_t)l * NPOOL * PAGE * 256; const float* CV = C.in[I_CV] + (size_t)l * NPOOL * PAGE * 256;
    const float lam = lam_of(C, l, lam_init);
    LAS float* part = (LAS float*)C.lds;
    for (int b = blockIdx.x; b < DB; b += C.G) {
        const int row = tid & 63, split = tid >> 6, h = row >> 4, s = (row >> 3) & 1, t = row & 7;
        float q[32];
#pragma unroll
        for (int i = 0; i < 32; ++i) q[i] = QN[(size_t)(MP + b * 8 + t) * 256 + h * 64 + s * 32 + i] * 0.17677669529663687f;
        float m = -INFINITY, lsum = 0.f; float acc[64];
#pragma unroll
        for (int i = 0; i < 64; ++i) acc[i] = 0.f;
        for (int j = split; j < PAST + DS; j += 8) {
            const float* kp; const float* vp; bool vis = true;
            if (j < PAST) { const int page = PT[b * NPAGES + (j >> 7)]; const size_t base = (((size_t)page * PAGE + (j & 127)) * 4 + h) * 64; kp = CK + base + s * 32; vp = CV + base; }
            else { const int jj = j - PAST; const size_t r2 = (size_t)(MP + b * 8 + jj); kp = KN + r2 * 256 + h * 64 + s * 32; vp = VB + r2 * 256 + h * 64; vis = jj <= t; }
            float sc = 0.f;
#pragma unroll
            for (int i = 0; i < 32; i += 4) { const f32x4 kv = *(const f32x4*)(kp + i); sc += q[i] * kv[0] + q[i + 1] * kv[1] + q[i + 2] * kv[2] + q[i + 3] * kv[3]; }
            const int n = PAST + t - j;
            sc += C.in[I_RELB][t5_bucket(n < 0 ? 0 : n) * 4 + h];
            if (!vis) sc = -INFINITY;
            const float mn = fmaxf(m, sc); const float corr = __expf(m - mn); const float p = __expf(sc - mn);
            m = mn; lsum = lsum * corr + p;
#pragma unroll
            for (int i = 0; i < 64; i += 4) { const f32x4 vv = *(const f32x4*)(vp + i); acc[i] = acc[i] * corr + p * vv[0]; acc[i + 1] = acc[i + 1] * corr + p * vv[1]; acc[i + 2] = acc[i + 2] * corr + p * vv[2]; acc[i + 3] = acc[i + 3] * corr + p * vv[3]; }
        }
        LAS float* pr = part + (split * 64 + row) * 66;
        pr[64] = m; pr[65] = lsum;
#pragma unroll
        for (int i = 0; i < 64; ++i) pr[i] = acc[i];
        __syncthreads();
        for (int k = 0; k < 4; ++k) { const int p = wave * 4 + k, h2 = p >> 3, t2 = p & 7; float os[2];
#pragma unroll
            for (int s2 = 0; s2 < 2; ++s2) { const int rw = h2 * 16 + s2 * 8 + t2; float mm = -INFINITY;
                for (int sp = 0; sp < 8; ++sp) mm = fmaxf(mm, part[(sp * 64 + rw) * 66 + 64]);
                float ll = 0.f, oo = 0.f;
                for (int sp = 0; sp < 8; ++sp) { const float w = __expf(part[(sp * 64 + rw) * 66 + 64] - mm); ll += part[(sp * 64 + rw) * 66 + 65] * w; oo += part[(sp * 64 + rw) * 66 + lane] * w; }
                os[s2] = oo / ll; }
            const float o = os[0] - lam * os[1]; const float ms = wave_sum(o * o) * (1.0f / 64);
            const float y = o * rsqrtf(ms + EPS) * C.in[I_SUBLN][l * 64 + lane] * (1.0f - lam_init);
            BR[(size_t)(MP + b * 8 + t2) * D + 768 + h2 * 64 + lane] = (bf16)f2bf(y); }
        __syncthreads();
    }
}
typedef short bf16x8_t __attribute__((ext_vector_type(8)));
template <int DK, bool RET> __device__ __forceinline__ void la_chunked(const Ctx& C, int l, bool smp, int b, int h) {
    THREAD_IDS();
    constexpr int QS = DK + 8, TS = 72, NKB = DK / 16, NKS = DK / 32;
    LAS bf16* QT = (LAS bf16*)(C.lds);
    LAS bf16* KT = QT + 64 * QS;
    LAS bf16* VT = KT + 64 * QS;
    LAS bf16* KE = VT + 64 * TS;
    LAS bf16* AL = KE + DK * TS;
    LAS bf16* ST = AL + 64 * TS;
    LAS float* WT = (LAS float*)(ST + 2 * 64 * QS);
    const bf16* ZM = WSP(bf16, WS_ZMIX); const float* RQ = WSP(float, WS_RQ); const float* RK = WSP(float, WS_RK); const float* LD = WSP(float, WS_LDEC); bf16* BR = WSP(bf16, WS_BR);
    const int nt = smp ? DS : L, row0 = smp ? MP + b * DS : b * L, nch = (nt + 63) >> 6;
    const float lg2 = RET ? log2f(1.0f - exp2f(-5.0f - (float)h)) : 0.f;
    const int g4 = lane >> 4, c16 = lane & 15;
    const bool qwave = wave < 4; const int w4 = wave & 3;
    float Sreg[NKB][4];
    if (wave >= 4) {
        const float* s0 = (RET ? C.in[I_SRET] : C.in[I_SGLA]) + (((size_t)l * DB + b) * 4 + h) * DK * 64;
#pragma unroll
        for (int cb = 0; cb < NKB; ++cb)
#pragma unroll
            for (int r = 0; r < 4; ++r) { const int dk = cb * 16 + c16, dv = (wave - 4) * 16 + 4 * g4 + r; const float v = smp ? s0[dk * 64 + dv] : 0.f; Sreg[cb][r] = v; ST[dv * QS + dk] = (bf16)f2bf(v); }
    }
    float gnv[4];
#pragma unroll
    for (int cb = 0; cb < 4; ++cb) gnv[cb] = (RET ? C.in[I_RGN] : C.in[I_GGN])[(l * 4 + h) * 64 + cb * 16 + c16];
    float a[16]; v4u vr;
#define LA_LOAD(c) do { const size_t r_ = (size_t)(row0 + (c) * 64 + lane); const bf16* z_ = ZM + r_ * NMIXP; \
        vr = *(const v4u*)(z_ + (RET ? R_V : G_V) + h * 64 + 8 * wave); \
        if (RET) { const float* p_ = (qwave ? RQ : RK) + r_ * 256 + h * 64 + 8 * w4; const f32x4 x0 = *(const f32x4*)p_, x1 = *(const f32x4*)(p_ + 4), x2 = *(const f32x4*)(p_ + 32), x3 = *(const f32x4*)(p_ + 36); \
            a[0] = x0[0]; a[1] = x0[1]; a[2] = x0[2]; a[3] = x0[3]; a[4] = x1[0]; a[5] = x1[1]; a[6] = x1[2]; a[7] = x1[3]; a[8] = x2[0]; a[9] = x2[1]; a[10] = x2[2]; a[11] = x2[3]; a[12] = x3[0]; a[13] = x3[1]; a[14] = x3[2]; a[15] = x3[3]; } \
        else { const v4u q_ = *(const v4u*)(z_ + (qwave ? G_Q : G_K) + h * 32 + 8 * w4); const float* p_ = LD + r_ * 128 + h * 32 + 8 * w4; const f32x4 x0 = *(const f32x4*)p_, x1 = *(const f32x4*)(p_ + 4); \
            a[0] = bflo(q_.x); a[1] = bfhi(q_.x); a[2] = bflo(q_.y); a[3] = bfhi(q_.y); a[4] = bflo(q_.z); a[5] = bfhi(q_.z); a[6] = bflo(q_.w); a[7] = bfhi(q_.w); \
            a[8] = x0[0]; a[9] = x0[1]; a[10] = x0[2]; a[11] = x0[3]; a[12] = x1[0]; a[13] = x1[1]; a[14] = x1[2]; a[15] = x1[3]; } } while (0)
    LA_LOAD(0);
    int cur = 0;
    for (int c = 0; c < nch; ++c) {
        const int nvc = min(64, nt - c * 64); const bool valid = lane < nvc;
        if (RET) {
            const float tq = (float)(lane + 1);
            if (qwave) { const float e = valid ? exp2f(lg2 * tq) : 0.f;
                v4u w0, w1; w0.x = pk2(a[0] * e, a[1] * e); w0.y = pk2(a[2] * e, a[3] * e); w0.z = pk2(a[4] * e, a[5] * e); w0.w = pk2(a[6] * e, a[7] * e);
                w1.x = pk2(a[8] * e, a[9] * e); w1.y = pk2(a[10] * e, a[11] * e); w1.z = pk2(a[12] * e, a[13] * e); w1.w = pk2(a[14] * e, a[15] * e);
                *(LAS v4u*)(QT + lane * QS + 8 * w4) = w0; *(LAS v4u*)(QT + lane * QS + 32 + 8 * w4) = w1; }
            else { const float e = valid ? exp2f(-lg2 * tq) : 0.f, ee = valid ? exp2f(lg2 * ((float)nvc - tq)) : 0.f;
                v4u w0, w1; w0.x = pk2(a[0] * e, a[1] * e); w0.y = pk2(a[2] * e, a[3] * e); w0.z = pk2(a[4] * e, a[5] * e); w0.w = pk2(a[6] * e, a[7] * e);
                w1.x = pk2(a[8] * e, a[9] * e); w1.y = pk2(a[10] * e, a[11] * e); w1.z = pk2(a[12] * e, a[13] * e); w1.w = pk2(a[14] * e, a[15] * e);
                *(LAS v4u*)(KT + lane * QS + 8 * w4) = w0; *(LAS v4u*)(KT + lane * QS + 32 + 8 * w4) = w1;
#pragma unroll
                for (int i = 0; i < 8; ++i) { KE[(8 * w4 + i) * TS + lane] = (bf16)f2bf(a[i] * ee); KE[(32 + 8 * w4 + i) * TS + lane] = (bf16)f2bf(a[8 + i] * ee); } }
        } else {
            float bb[8];
#pragma unroll
            for (int i = 0; i < 8; ++i) bb[i] = valid ? a[8 + i] : 0.f;
#pragma unroll
            for (int off = 1; off < 64; off <<= 1) {
#pragma unroll
                for (int i = 0; i < 8; ++i) { const float x = __shfl_up(bb[i], off); if (lane >= off) bb[i] += x; } }
            if (qwave) {
                if (lane == 63) {
#pragma unroll
                    for (int i = 0; i < 8; ++i) WT[8 * w4 + i] = bb[i]; }
                float o8[8];
#pragma unroll
                for (int i = 0; i < 8; ++i) o8[i] = valid ? a[i] * 0.17677669529663687f * __expf(bb[i]) : 0.f;
                v4u w0; w0.x = pk2(o8[0], o8[1]); w0.y = pk2(o8[2], o8[3]); w0.z = pk2(o8[4], o8[5]); w0.w = pk2(o8[6], o8[7]);
                *(LAS v4u*)(QT + lane * QS + 8 * w4) = w0;
            } else {
                float o8[8];
#pragma unroll
                for (int i = 0; i < 8; ++i) { const float tot = __shfl(bb[i], 63); o8[i] = valid ? a[i] * __expf(-bb[i]) : 0.f; KE[(8 * w4 + i) * TS + lane] = (bf16)f2bf(valid ? a[i] * __expf(tot - bb[i]) : 0.f); }
                v4u w0; w0.x = pk2(o8[0], o8[1]); w0.y = pk2(o8[2], o8[3]); w0.z = pk2(o8[4], o8[5]); w0.w = pk2(o8[6], o8[7]);
                *(LAS v4u*)(KT + lane * QS + 8 * w4) = w0;
            }
        }
        { const unsigned vv[4] = {valid ? vr.x : 0u, valid ? vr.y : 0u, valid ? vr.z : 0u, valid ? vr.w : 0u};
#pragma unroll
          for (int i = 0; i < 4; ++i) { VT[(8 * wave + 2 * i) * TS + lane] = (bf16)(vv[i] & 0xffffu); VT[(8 * wave + 2 * i + 1) * TS + lane] = (bf16)(vv[i] >> 16); } }
        if (c + 1 < nch) LA_LOAD(c + 1);
        LDS_WAIT(); __builtin_amdgcn_s_barrier(); asm volatile("" ::: "memory");
        { const int rb = wave >> 1;
#pragma unroll
          for (int ci = 0; ci < 2; ++ci) { const int cb = (wave & 1) * 2 + ci; f32x4 acc = {0.f, 0.f, 0.f, 0.f};
              if (cb <= rb) {
#pragma unroll
                  for (int ks = 0; ks < NKS; ++ks) { const bf16x8_t af = *(const LAS bf16x8_t*)(QT + (rb * 16 + c16) * QS + ks * 32 + 8 * g4), bf = *(const LAS bf16x8_t*)(KT + (cb * 16 + c16) * QS + ks * 32 + 8 * g4);
                      acc = __builtin_amdgcn_mfma_f32_16x16x32_bf16(af, bf, acc, 0, 0, 0); } }
#pragma unroll
              for (int r = 0; r < 4; ++r) { const int tt = rb * 16 + 4 * g4 + r, ss = cb * 16 + c16; AL[tt * TS + ss] = (bf16)f2bf(ss <= tt ? acc[r] : 0.f); } } }
        LDS_WAIT(); __builtin_amdgcn_s_barrier(); asm volatile("" ::: "memory");
        if (wave < 4) {
            const int rb = wave; const LAS bf16* STc = ST + cur * 64 * QS;
            f32x4 o[4];
#pragma unroll
            for (int cb = 0; cb < 4; ++cb) o[cb] = (f32x4){0.f, 0.f, 0.f, 0.f};
#pragma unroll
            for (int ks = 0; ks < 2; ++ks) { const bf16x8_t af = *(const LAS bf16x8_t*)(AL + (rb * 16 + c16) * TS + ks * 32 + 8 * g4);
#pragma unroll
                for (int cb = 0; cb < 4; ++cb) { const bf16x8_t bf = *(const LAS bf16x8_t*)(VT + (cb * 16 + c16) * TS + ks * 32 + 8 * g4); o[cb] = __builtin_amdgcn_mfma_f32_16x16x32_bf16(af, bf, o[cb], 0, 0, 0); } }
#pragma unroll
            for (int ks = 0; ks < NKS; ++ks) { const bf16x8_t af = *(const LAS bf16x8_t*)(QT + (rb * 16 + c16) * QS + ks * 32 + 8 * g4);
#pragma unroll
                for (int cb = 0; cb < 4; ++cb) { const bf16x8_t bf = *(const LAS bf16x8_t*)(STc + (cb * 16 + c16) * QS + ks * 32 + 8 * g4); o[cb] = __builtin_amdgcn_mfma_f32_16x16x32_bf16(af, bf, o[cb], 0, 0, 0); } }
#pragma unroll
            for (int r = 0; r < 4; ++r) {
                float s = (o[0][r] + o[1][r]) + (o[2][r] + o[3][r]); float y[4];
                if (RET) { s += __shfl_xor(s, 1); s += __shfl_xor(s, 2); s += __shfl_xor(s, 4); s += __shfl_xor(s, 8); const float mean = s * (1.0f / 64);
                    float q2 = 0.f;
#pragma unroll
                    for (int cb = 0; cb < 4; ++cb) { y[cb] = o[cb][r] - mean; q2 += y[cb] * y[cb]; }
                    q2 += __shfl_xor(q2, 1); q2 += __shfl_xor(q2, 2); q2 += __shfl_xor(q2, 4); q2 += __shfl_xor(q2, 8); const float rs = rsqrtf(q2 * (1.0f / 64) + EPS);
#pragma unroll
                    for (int cb = 0; cb < 4; ++cb) y[cb] *= rs;
                } else { float q2 = (o[0][r] * o[0][r] + o[1][r] * o[1][r]) + (o[2][r] * o[2][r] + o[3][r] * o[3][r]);
                    q2 += __shfl_xor(q2, 1); q2 += __shfl_xor(q2, 2); q2 += __shfl_xor(q2, 4); q2 += __shfl_xor(q2, 8); const float rs = rsqrtf(q2 * (1.0f / 64) + EPS);
#pragma unroll
                    for (int cb = 0; cb < 4; ++cb) y[cb] = o[cb][r] * rs; }
                const int tok = c * 64 + rb * 16 + 4 * g4 + r;
                if (tok < nt) { const size_t row = (size_t)(row0 + tok);
#pragma unroll
                    for (int cb = 0; cb < 4; ++cb) { const int dv = cb * 16 + c16; const float g = bf2f(ZM[row * NMIXP + (RET ? R_G : G_R) + h * 64 + dv]);
                        BR[row * D + (RET ? 256 : 512) + h * 64 + dv] = (bf16)f2bf(siluf_(g) * y[cb] * gnv[cb]); } }
            }
        } else {
            const int dvb = wave - 4; LAS bf16* STn = ST + (cur ^ 1) * 64 * QS;
            f32x4 ds[NKB];
#pragma unroll
            for (int cb = 0; cb < NKB; ++cb) ds[cb] = (f32x4){0.f, 0.f, 0.f, 0.f};
#pragma unroll
            for (int ks = 0; ks < 2; ++ks) { const bf16x8_t af = *(const LAS bf16x8_t*)(VT + (dvb * 16 + c16) * TS + ks * 32 + 8 * g4);
#pragma unroll
                for (int cb = 0; cb < NKB; ++cb) { const bf16x8_t bf = *(const LAS bf16x8_t*)(KE + (cb * 16 + c16) * TS + ks * 32 + 8 * g4); ds[cb] = __builtin_amdgcn_mfma_f32_16x16x32_bf16(af, bf, ds[cb], 0, 0, 0); } }
#pragma unroll
            for (int cb = 0; cb < NKB; ++cb) { const float eB = RET ? exp2f(lg2 * (float)nvc) : __expf(WT[cb * 16 + c16]);
#pragma unroll
                for (int r = 0; r < 4; ++r) { Sreg[cb][r] = eB * Sreg[cb][r] + ds[cb][r]; STn[(dvb * 16 + 4 * g4 + r) * QS + cb * 16 + c16] = (bf16)f2bf(Sreg[cb][r]); } }
        }
        LDS_WAIT(); __builtin_amdgcn_s_barrier(); asm volatile("" ::: "memory");
        cur ^= 1;
    }
#undef LA_LOAD
    if (wave >= 4) {
        float* so = C.out + (RET ? (smp ? O_RS + (((size_t)l * DB + b) * 4 + h) * DK * 64 : O_RP + (((size_t)l * BATCH + b) * 4 + h) * DK * 64)
                                 : (smp ? O_GS + (((size_t)l * DB + b) * 4 + h) * DK * 64 : O_GP + (((size_t)l * BATCH + b) * 4 + h) * DK * 64));
#pragma unroll
        for (int cb = 0; cb < NKB; ++cb)
#pragma unroll
            for (int r = 0; r < 4; ++r) so[(cb * 16 + c16) * 64 + (wave - 4) * 16 + 4 * g4 + r] = Sreg[cb][r];
    }
}
__device__ __forceinline__ void n2_la_chunked(const Ctx& C, int l) {
    const int bx = blockIdx.x;
    if (bx < 32) { const int b = (bx >> 2) & 3, h = bx & 3; if (bx < 16) la_chunked<64, true>(C, l, false, b, h); else la_chunked<32, false>(C, l, false, b, h); }
    else { for (int it = bx - 32; it < 256; it += C.G - 32) { const int b = (it >> 2) & 31, h = it & 3; if (it < 128) la_chunked<64, true>(C, l, true, b, h); else la_chunked<32, false>(C, l, true, b, h); } }
}

template <int l> __device__ __forceinline__ void layer_fwd(const Ctx& C, const XcdBarrier& bar) {
#define GRID_BAR() xcd_barrier<false>(bar)
    LAS unsigned char* ring = C.lds + RING_OFF;
    float* SS = WSP(float, WS_SS); float* H = WSP(float, WS_H); bf16* HB = WSP(bf16, WS_HB); bf16* ACT = WSP(bf16, WS_ACT); bf16* ZMIX = WSP(bf16, WS_ZMIX); bf16* GATES = WSP(bf16, WS_GATES);
    bf16* BR = WSP(bf16, WS_BR); bf16* MERGED = WSP(bf16, WS_MERGED);
    constexpr float lam_init = l == 0 ? 0.2f : 0.35550906759096926f;
    constexpr bool last = (l == DEPTH - 1);
    { pg8::Gemm g{HB, WSP(bf16, WS_W1 + (size_t)(l * 2 + 0) * SZ_W1), D, D, D}; pg8::StaticOrder S; S.init(M, 2 * DFF, C.G, (int)blockIdx.x);
      EpiGLU E{ACT, SS + (size_t)(l * 3 + 0) * M * 16}; pg8::gemm_phase<EpiGLU, pg8::StaticOrder, true, true>(ring, g, S, E); }
    GRID_BAR();
    { pg8::Gemm g{ACT, WSP(bf16, WS_WD + (size_t)(l * 2 + 0) * SZ_WD), DFF, DFF, DFF}; pg8::StaticOrder S; S.init(M, D, C.G, (int)blockIdx.x);
      EpiRes<false, 1> E{H, HB, SS + (size_t)(l * 3 + 1) * M * 16, nullptr}; pg8::gemm_phase<EpiRes<false, 1>, pg8::StaticOrder, true, true>(ring, g, S, E); }
    GRID_BAR();
    { pg8::Gemm g{HB, WSP(bf16, WS_WIN + (size_t)l * SZ_WIN), D, D, D}; pg8::StaticOrder S; S.init(M, NINP, C.G, (int)blockIdx.x);
      EpiZ E{ZMIX, GATES, SS + (size_t)(l * 3 + 1) * M * 16, WSP(float, WS_BINP) + l * NINP}; pg8::gemm_phase<EpiZ, pg8::StaticOrder, true, true>(ring, g, S, E); }
    GRID_BAR();
    n1_prep(C, l);
    GRID_BAR();
    n2_attn_sample(C, l, lam_init);
    n2_la_chunked(C, l);
    n2_attn_prompt(C, l, lam_init);
    n2_conv(C, l);
    GRID_BAR();
    { pg8::Gemm g{BR, WSP(bf16, WS_WBR + (size_t)l * SZ_WBR), D, 256, 256}; pg8::MergeOrder S; S.init(M, C.G, (int)blockIdx.x);
      EpiMerge E{MERGED, GATES}; pg8::gemm_phase<EpiMerge, pg8::MergeOrder, true, true>(ring, g, S, E); }
    GRID_BAR();
    { pg8::Gemm g{MERGED, WSP(bf16, WS_WOUT + (size_t)l * SZ_WOUT), D, D, D}; pg8::StaticOrder S; S.init(M, D, C.G, (int)blockIdx.x);
      EpiRes<false, 2> E{H, HB, SS + (size_t)(l * 3 + 2) * M * 16, nullptr}; pg8::gemm_phase<EpiRes<false, 2>, pg8::StaticOrder, true, true>(ring, g, S, E); }
    GRID_BAR();
    { pg8::Gemm g{HB, WSP(bf16, WS_W1 + (size_t)(l * 2 + 1) * SZ_W1), D, D, D}; pg8::StaticOrder S; S.init(M, 2 * DFF, C.G, (int)blockIdx.x);
      EpiGLU E{ACT, SS + (size_t)(l * 3 + 2) * M * 16}; pg8::gemm_phase<EpiGLU, pg8::StaticOrder, true, true>(ring, g, S, E); }
    GRID_BAR();
    { pg8::Gemm g{ACT, WSP(bf16, WS_WD + (size_t)(l * 2 + 1) * SZ_WD), DFF, DFF, DFF}; pg8::StaticOrder S; S.init(M, D, C.G, (int)blockIdx.x);
      EpiRes<last, 1> E{H, HB, last ? nullptr : SS + (size_t)((l + 1) * 3) * M * 16, C.out};
      pg8::gemm_phase<EpiRes<last, 1>, pg8::StaticOrder, true, true>(ring, g, S, E); }
#undef GRID_BAR
}

__global__ void __launch_bounds__(NWAVES * 64, 2) fwd(Params P) {
    extern __shared__ __attribute__((aligned(16))) unsigned char lds[];
    Ctx C;
    C.in = P.in; C.out = P.out; C.ws = P.ws; C.lds = (LAS unsigned char*)lds;
    C.G = gridDim.x;
    volatile LAS unsigned* MISC = (volatile LAS unsigned*)(C.lds + MISC_OFF);
    for (int u = threadIdx.x; u < (LDS_BYTES - LDSCTL_OFF) / 4; u += NWAVES * 64) ((LAS unsigned*)(C.lds + LDSCTL_OFF))[u] = 0u;
    __syncthreads();
    unsigned* ctl = (unsigned*)(C.ws + WS_CTL);
    XcdBarrier bar = xcd_barrier_post(ctl + CW_BAR, MISC + 8);
    p0_prologue(C, P);
    xcd_barrier<true>(bar);
    layer_fwd<0>(C, bar);
    xcd_barrier<false>(bar);
    layer_fwd<1>(C, bar);
}

extern "C" void kernel_launch(void* const* d_in, const int* in_sizes, int n_in, void* d_out, int out_size, void* d_ws, size_t ws_size, hipStream_t stream) {
    static int grid = 0;
    if (grid == 0) {
        if (n_in != N_INPUTS || (size_t)out_size != O_END || ws_size < WS_END) { fprintf(stderr, "kernel_launch: unexpected shapes: n_in %d out %d (want %zu) ws %zu (want %zu)\n", n_in, out_size, (size_t)O_END, ws_size, (size_t)WS_END); grid = -1; return; }
        int dev = 0, cus = 0, per_cu = 0;
        if (hipGetDevice(&dev) != hipSuccess || hipDeviceGetAttribute(&cus, hipDeviceAttributeMultiprocessorCount, dev) != hipSuccess) { grid = -1; return; }
        if (hipFuncSetAttribute((const void*)fwd, hipFuncAttributeMaxDynamicSharedMemorySize, LDS_BYTES) != hipSuccess) { fprintf(stderr, "kernel_launch: hipFuncSetAttribute failed\n"); grid = -1; return; }
        if (hipOccupancyMaxActiveBlocksPerMultiprocessor(&per_cu, (const void*)fwd, NWAVES * 64, LDS_BYTES) != hipSuccess || per_cu < 1) { fprintf(stderr, "kernel_launch: occupancy query says %d blocks per CU\n", per_cu); }
        (void)hipGetLastError();
        grid = cus;
    }
    if (grid < 0) return;
    if (hipMemsetAsync((char*)d_ws + WS_CTL, 0, CTL_ZERO_BYTES, stream) != hipSuccess) return;
    Params p{};
    for (int i = 0; i < N_INPUTS; ++i) p.in[i] = (const float*)d_in[i];
    p.out = (float*)d_out; p.ws = (unsigned char*)d_ws;
    for (int i = 0; i < 32; ++i) p.inv_freq[i] = (float)pow(10000.0, -(double)i / 32.0);
    hipLaunchKernelGGL(fwd, dim3(grid), dim3(NWAVES * 64), LDS_BYTES, stream, p);
}
```

```cpp
#include <hip/hip_runtime.h>
#include <cstdio>
#include <cstdint>
#include <cmath>

namespace pg8 {
#define PG8_LAS __attribute__((address_space(3)))
typedef unsigned short bf16_t;
typedef short bf16x8 __attribute__((ext_vector_type(8)));
typedef float f32x4 __attribute__((ext_vector_type(4)));
typedef unsigned u32x4 __attribute__((ext_vector_type(4)));
constexpr int BM = 256, BK = 64, HALF = 128, HTB = HALF * BK * 2  , STAGE_BYTES = 8 * HTB, NXCD = 8, WGM = 8;

__host__ __device__ __forceinline__ int lds_byte(int r, int c) { const int st = (r >> 4) * 2 + (c >> 5), rr = r & 15, cc = c & 31, ob = rr * 64 + cc * 2; return st * 1024 + (ob ^ (((ob >> 9) & 1) << 5)); }
__host__ __device__ __forceinline__ void stage_rc(int b, int& R, int& C) { const int st = b / 1024, sb = b % 1024, swz = sb ^ (((sb >> 9) & 1) << 5); R = (st >> 1) * 16 + swz / 64; C = (st & 1) * 32 + (swz % 64) / 2; }
__host__ __device__ __forceinline__ int perm32(int rho) { const int n = rho >> 4, i = rho & 15; return 8 * (i >> 2) + 4 * n + (i & 3); }

struct Unit { int pm, pn, acol; };
struct Gemm { const bf16_t* A; const bf16_t* Bt; int lda, ldb, K; };

struct StaticOrder {
    int nM, nN, nwg, G, c;
    __host__ __device__ void init(int M, int N, int G_, int c_) { nM = M / BM; nN = N / BM; nwg = nM * nN; G = G_; c = c_; }
    __host__ __device__ bool next(int i, Unit& u) const {
        const long L = (long)i * G + c; if (L >= nwg) return false;
        int wgid = (int)L; { const int q = nwg / NXCD, r = nwg % NXCD, xcd = wgid % NXCD, off = wgid / NXCD; wgid = (xcd < r ? xcd * (q + 1) : r * (q + 1) + (xcd - r) * q) + off; }
        const int nig = WGM * nN, gid = wgid / nig, fm = gid * WGM, gsz = (nM - fm) < WGM ? (nM - fm) : WGM;
        u.pm = fm + ((wgid % nig) % gsz); u.pn = (wgid % nig) / gsz; u.acol = 0; return true;
    }
};
struct MergeOrder {
    int ntile, G, c;
    __host__ __device__ void init(int M, int G_, int c_) { ntile = (M / BM) * 4; G = G_; c = c_; }
    __host__ __device__ bool next(int i, Unit& u) const {
        const int T = (i >> 2) * G + c; if (T >= ntile) return false;
        const int n = i & 3; u.pm = T >> 2; u.pn = n * 4 + (T & 3); u.acol = n * 256; return true;
    }
};

__device__ __forceinline__ unsigned cvt_pk_bf16(float lo, float hi) { unsigned r; asm volatile("v_cvt_pk_bf16_f32 %0, %1, %2" : "=v"(r) : "v"(lo), "v"(hi)); return r; }

template <class Epi, class Sched, bool ALIGN_EPI = false, bool SP2 = false>
__device__ __forceinline__ void gemm_phase(PG8_LAS unsigned char* lds, const Gemm g, const Sched& S, const Epi& E) {
    int tid_ = threadIdx.x; asm volatile("" : "+v"(tid_));
    const int tid = tid_, wid = __builtin_amdgcn_readfirstlane(tid >> 6), lane = tid & 63, wr = wid >> 2, wc = wid & 3, fr = lane & 15, fq = lane >> 4;
    const int nt = g.K / BK;
    unsigned voffA[2], voffB[2];
#pragma unroll
    for (int i = 0; i < 2; ++i) { int R, C; stage_rc(tid * 16 + i * 8192, R, C); const int Rb = Epi::PERM ? ((R & ~31) + perm32(R & 31)) : R;
        voffA[i] = (unsigned)(R * g.lda + C) * 2u; voffB[i] = (unsigned)(Rb * g.ldb + C) * 2u; }
    const size_t kstep = (size_t)(BK * 2);
    const size_t hstepA = (size_t)HALF * g.lda * 2, hstepB = (size_t)HALF * g.ldb * 2;
    const size_t tstepA = 2 * hstepA, tstepB = 2 * hstepB;
    const unsigned ldsw = (unsigned)wid * 1024u;
    const int aoff = lds_byte(wr * 64 + fr, fq * 8), boff = lds_byte(wc * 32 + fr, fq * 8);
#define PG8_SA(b, h) (((b) * 2 + (h)) * HTB)
#define PG8_SB(b, h) ((4 + (b) * 2 + (h)) * HTB)
#define PG8_STAGE(bufoff, gbase, voff) do { _Pragma("unroll") for (int _i = 0; _i < 2; ++_i) \
        __builtin_amdgcn_global_load_lds((const unsigned*)((const char*)(gbase) + (voff)[_i]), (PG8_LAS unsigned*)(lds + (bufoff) + ldsw + _i * 8192), 16, 0, 0); } while (0)
#define PG8_LDA(dst, b, h) do { _Pragma("unroll") for (int m = 0; m < 4; ++m) _Pragma("unroll") for (int k = 0; k < 2; ++k) dst[m][k] = *(const PG8_LAS bf16x8*)(lds + PG8_SA(b, h) + aoff + m * 2048 + k * 1024); } while (0)
#define PG8_LDB(dst, b, h) do { _Pragma("unroll") for (int n = 0; n < 2; ++n) _Pragma("unroll") for (int k = 0; k < 2; ++k) dst[n][k] = *(const PG8_LAS bf16x8*)(lds + PG8_SB(b, h) + boff + n * 2048 + k * 1024); } while (0)
#define PG8_MMA(ai, bj, At, Bt) do { __builtin_amdgcn_s_setprio(1); _Pragma("unroll") for (int m = 0; m < 4; ++m) _Pragma("unroll") for (int n = 0; n < 2; ++n) _Pragma("unroll") for (int k = 0; k < 2; ++k) \
        acc[ai][bj][m][n] = __builtin_amdgcn_mfma_f32_16x16x32_bf16(Bt[n][k], At[m][k], acc[ai][bj][m][n], 0, 0, 0); __builtin_amdgcn_s_setprio(0); } while (0)
#define PG8_WAIT_V(n) asm volatile("s_waitcnt vmcnt(" #n ")" ::: "memory")
#define PG8_WAIT_L(n) asm volatile("s_waitcnt lgkmcnt(" #n ")" ::: "memory")
#define PG8_BAR __builtin_amdgcn_s_barrier()
#define PG8_SCHED __builtin_amdgcn_sched_barrier(0)
    Unit cur, nxt; int ui = 0;
    if (!S.next(0, cur)) return;
    f32x4 acc[2][2][4][2];
#pragma unroll
    for (int a = 0; a < 2; ++a)
#pragma unroll
        for (int b = 0; b < 2; ++b)
#pragma unroll
            for (int m = 0; m < 4; ++m)
#pragma unroll
                for (int n = 0; n < 2; ++n) acc[a][b][m][n] = (f32x4){0.f, 0.f, 0.f, 0.f};
    bf16x8 At[4][2], B0[2][2], B1[2][2];
    const char* cA = (const char*)g.A + (size_t)cur.pm * tstepA + (size_t)cur.acol * 2; const char* cB = (const char*)g.Bt + (size_t)cur.pn * tstepB;
    if constexpr (SP2) {
        PG8_STAGE(PG8_SB(0, 0), cB, voffB); PG8_STAGE(PG8_SB(0, 1), cB + hstepB, voffB); PG8_STAGE(PG8_SA(0, 0), cA, voffA); PG8_STAGE(PG8_SA(0, 1), cA + hstepA, voffA);
        if (wr == 1) PG8_BAR;
        PG8_WAIT_V(2); PG8_BAR;
        PG8_STAGE(PG8_SB(1, 0), cB + kstep, voffB); PG8_STAGE(PG8_SA(1, 0), cA + kstep, voffA); PG8_STAGE(PG8_SB(1, 1), cB + hstepB + kstep, voffB);
        PG8_WAIT_V(6); PG8_BAR;
    } else {
        PG8_STAGE(PG8_SB(0, 0), cB, voffB); PG8_STAGE(PG8_SA(0, 0), cA, voffA); PG8_STAGE(PG8_SB(0, 1), cB + hstepB, voffB); PG8_STAGE(PG8_SA(0, 1), cA + hstepA, voffA);
        if (wr == 1) PG8_BAR;
        PG8_WAIT_V(4); PG8_BAR;
        PG8_STAGE(PG8_SB(1, 0), cB + kstep, voffB); PG8_STAGE(PG8_SA(1, 0), cA + kstep, voffA); PG8_STAGE(PG8_SB(1, 1), cB + hstepB + kstep, voffB);
        PG8_WAIT_V(6); PG8_BAR;
    }
    for (;;) {
        const bool has_next = S.next(ui + 1, nxt);
        const char* nA = has_next ? (const char*)g.A + (size_t)nxt.pm * tstepA + (size_t)nxt.acol * 2 : cA; const char* nB = has_next ? (const char*)g.Bt + (size_t)nxt.pn * tstepB : cB;
        for (int t = 0; t < nt; t += 2) {
            const bool last = (t == nt - 2);
            const char* a1 = cA + (size_t)(t + 1) * kstep;
            const char* a2 = last ? nA : cA + (size_t)(t + 2) * kstep; const char* b2 = last ? nB : cB + (size_t)(t + 2) * kstep;
            const char* a3 = a2 + kstep; const char* b3 = b2 + kstep;
            if constexpr (SP2) {
            PG8_LDB(B0, 0, 0); PG8_LDB(B1, 0, 1); PG8_SCHED; PG8_LDA(At, 0, 0); PG8_STAGE(PG8_SA(1, 1), a1 + hstepA, voffA);
            PG8_WAIT_V(8); PG8_WAIT_L(0); PG8_BAR; PG8_MMA(0, 0, At, B0); PG8_MMA(0, 1, At, B1); PG8_BAR; PG8_SCHED;
            PG8_LDA(At, 0, 1); PG8_STAGE(PG8_SB(0, 0), b2, voffB); PG8_STAGE(PG8_SB(0, 1), b2 + hstepB, voffB); PG8_STAGE(PG8_SA(0, 0), a2, voffA);
            PG8_WAIT_V(8); PG8_WAIT_L(0); PG8_BAR; PG8_MMA(1, 0, At, B0); PG8_MMA(1, 1, At, B1); PG8_BAR; PG8_SCHED;
            PG8_LDB(B0, 1, 0); PG8_LDB(B1, 1, 1); PG8_SCHED; PG8_LDA(At, 1, 0); PG8_STAGE(PG8_SA(0, 1), a2 + hstepA, voffA);
            PG8_WAIT_V(8); PG8_WAIT_L(0); PG8_BAR; PG8_MMA(0, 0, At, B0); PG8_MMA(0, 1, At, B1); PG8_BAR; PG8_SCHED;
            PG8_LDA(At, 1, 1); PG8_STAGE(PG8_SB(1, 0), b3, voffB); PG8_STAGE(PG8_SB(1, 1), b3 + hstepB, voffB); PG8_STAGE(PG8_SA(1, 0), a3, voffA);
            PG8_WAIT_V(8); PG8_WAIT_L(0); PG8_BAR; PG8_MMA(1, 0, At, B0); PG8_MMA(1, 1, At, B1); PG8_BAR; PG8_SCHED;
            } else {
            PG8_LDB(B0, 0, 0); PG8_SCHED; PG8_LDA(At, 0, 0); PG8_STAGE(PG8_SA(1, 1), a1 + hstepA, voffA);
            PG8_WAIT_L(8); PG8_BAR; PG8_WAIT_L(0); PG8_MMA(0, 0, At, B0); PG8_BAR; PG8_SCHED;
            PG8_LDB(B1, 0, 1); PG8_STAGE(PG8_SB(0, 0), b2, voffB);
            PG8_BAR; PG8_WAIT_L(0); PG8_MMA(0, 1, At, B1); PG8_BAR;
            PG8_LDA(At, 0, 1); PG8_STAGE(PG8_SA(0, 0), a2, voffA);
            PG8_BAR; PG8_WAIT_L(0); PG8_MMA(1, 0, At, B0); PG8_BAR; PG8_SCHED;
            PG8_STAGE(PG8_SB(0, 1), b2 + hstepB, voffB);
            PG8_WAIT_V(6); PG8_BAR; PG8_MMA(1, 1, At, B1); PG8_BAR;
            PG8_LDB(B0, 1, 0); PG8_SCHED; PG8_LDA(At, 1, 0); PG8_STAGE(PG8_SA(0, 1), a2 + hstepA, voffA);
            PG8_WAIT_L(8); PG8_BAR; PG8_WAIT_L(0); PG8_MMA(0, 0, At, B0); PG8_BAR; PG8_SCHED;
            PG8_LDB(B1, 1, 1); PG8_STAGE(PG8_SB(1, 0), b3, voffB);
            PG8_BAR; PG8_WAIT_L(0); PG8_MMA(0, 1, At, B1); PG8_BAR;
            PG8_LDA(At, 1, 1); PG8_STAGE(PG8_SA(1, 0), a3, voffA);
            PG8_BAR; PG8_WAIT_L(0); PG8_MMA(1, 0, At, B0); PG8_BAR; PG8_SCHED;
            PG8_STAGE(PG8_SB(1, 1), b3 + hstepB, voffB);
            PG8_WAIT_V(6); PG8_BAR; PG8_MMA(1, 1, At, B1); PG8_BAR;
            }
        }
        if constexpr (ALIGN_EPI) { if (wr == 0) PG8_BAR; }
        E(acc, cur, wr, wc, fr, fq);
        if (!has_next) break;
#pragma unroll
        for (int a = 0; a < 2; ++a)
#pragma unroll
            for (int b = 0; b < 2; ++b)
#pragma unroll
                for (int m = 0; m < 4; ++m)
#pragma unroll
                    for (int n = 0; n < 2; ++n) acc[a][b][m][n] = (f32x4){0.f, 0.f, 0.f, 0.f};
        cur = nxt; cA = nA; cB = nB; ++ui;
        if constexpr (ALIGN_EPI) { if (wr == 1) PG8_BAR; }
    }
    PG8_WAIT_V(0);
    if constexpr (!ALIGN_EPI) { if (wr == 0) PG8_BAR; }
    PG8_BAR;
#undef PG8_SA
#undef PG8_SB
#undef PG8_STAGE
#undef PG8_LDA
#undef PG8_LDB
#undef PG8_MMA
#undef PG8_WAIT_V
#undef PG8_WAIT_L
#undef PG8_BAR
#undef PG8_SCHED
}
}

constexpr int NWAVES = 8;
constexpr int D = 1024, DFF = 2816, NIN = 7184, NMIX = 3088, NMIXP = 3328, NGATE = 4096, NINP = NMIXP + NGATE;
constexpr int SEQ = 4096, NMETA = 16, L = SEQ + NMETA, BATCH = 4, DB = 32, DS = 8, PAST = 8192, PAGE = 128, NPAGES = PAST / PAGE, NPOOL = 2560, DEPTH = 2;
constexpr int MP = BATCH * L, MS = DB * DS, MR = MP + MS, M = 16896;
constexpr int NPOS = L + DS;
constexpr float EPS = 1e-6f;
constexpr int C_A = 0, C_G = 256, R_Q = 512, R_K = 768, R_V = 1024, R_G = 1280, G_Q = 1536, G_K = 1664, G_V = 1792, G_R = 2048, G_LOW = 2304, D_Q = 2320, D_K = 2576, D_V = 2832;
constexpr size_t O_YP = 0, O_YS = O_YP + (size_t)BATCH * SEQ * D, O_KP = O_YS + (size_t)MS * D, O_VP = O_KP + (size_t)DEPTH * MP * 256, O_KS = O_VP + (size_t)DEPTH * MP * 256,
                 O_VS = O_KS + (size_t)DEPTH * MS * 256, O_RP = O_VS + (size_t)DEPTH * MS * 256, O_RS = O_RP + (size_t)DEPTH * BATCH * 4 * 64 * 64, O_GP = O_RS + (size_t)DEPTH * DB * 4 * 64 * 64,
                 O_GS = O_GP + (size_t)DEPTH * BATCH * 4 * 32 * 64, O_CP = O_GS + (size_t)DEPTH * DB * 4 * 32 * 64, O_CS = O_CP + (size_t)DEPTH * BATCH * 30 * 256, O_END = O_CS + (size_t)DEPTH * DB * 30 * 256;
enum { I_XP = 0, I_XS, I_CK, I_CV, I_PT, I_SRET, I_SGLA, I_SCONV, I_META, I_RELB, I_NF1, I_F1G, I_F1U, I_F1D, I_NMIX, I_WIN, I_BIN, I_CW, I_CB, I_CLG, I_CLB, I_RGN, I_GAW, I_GAB, I_GGN,
       I_QN, I_KN, I_LQ1, I_LK1, I_LQ2, I_LK2, I_SUBLN, I_WBR, I_WOUT, I_NF2, I_F2G, I_F2U, I_F2D, N_INPUTS };

constexpr size_t MiB = 1u << 20;
constexpr size_t WS_CTL = 0, CTL_ZERO_BYTES = 1 * MiB;
constexpr size_t SZ_SS = (size_t)M * 16 * 4;
constexpr size_t SZ_W1 = (size_t)2 * DFF * D * 2, SZ_WD = (size_t)D * DFF * 2, SZ_WIN = (size_t)NINP * D * 2, SZ_WBR = (size_t)4 * D * 256 * 2, SZ_WOUT = (size_t)D * D * 2;
constexpr size_t WS_W1 = 4 * MiB;
constexpr size_t WS_WD = WS_W1 + 4 * SZ_W1;
constexpr size_t WS_WIN = WS_WD + 4 * SZ_WD;
constexpr size_t WS_WBR = WS_WIN + 2 * SZ_WIN;
constexpr size_t WS_WOUT = WS_WBR + 2 * SZ_WBR;
constexpr size_t WS_BINP = WS_WOUT + 2 * SZ_WOUT;
constexpr size_t WS_ROPE = WS_BINP + 64 * 1024;
constexpr size_t WS_SS = WS_ROPE + 2 * MiB;
constexpr size_t WS_H = 128 * MiB;
constexpr size_t WS_HB = WS_H + (size_t)M * D * 4;
constexpr size_t WS_ACT = WS_HB + (size_t)M * D * 2;
constexpr size_t WS_ZMIX = WS_ACT + (size_t)M * DFF * 2;
constexpr size_t WS_GATES = WS_ZMIX + (size_t)M * NMIXP * 2;
constexpr size_t WS_BR = WS_GATES + (size_t)M * NGATE * 2;
constexpr size_t WS_MERGED = WS_BR + (size_t)M * D * 2;
constexpr size_t WS_UBUF = WS_MERGED + (size_t)M * D * 2;
constexpr size_t WS_RQ = WS_UBUF + (size_t)M * 256 * 4, WS_RK = WS_RQ + (size_t)M * 256 * 4, WS_QN = WS_RK + (size_t)M * 256 * 4, WS_KN = WS_QN + (size_t)M * 256 * 4, WS_VB = WS_KN + (size_t)M * 256 * 4;
constexpr size_t WS_LDEC = WS_VB + (size_t)M * 256 * 4;
constexpr size_t WS_QNB = WS_LDEC + (size_t)M * 128 * 4;
constexpr size_t WS_KNB = WS_QNB + (size_t)M * 256 * 2;
constexpr size_t WS_END = WS_KNB + (size_t)M * 256 * 2;
static_assert(WS_ROPE + 2 * NPOS * 32 * 4 <= WS_SS && WS_SS + 6 * SZ_SS <= WS_H, "weights region overflows");
constexpr int CW_BAR = 4096, CW_QUEUE = 8192;

constexpr int RING_OFF = 0, RING_BYTES = 131072;
constexpr int LDSCTL_OFF = 144384, MISC_OFF = LDSCTL_OFF + 320;
constexpr int LDS_BYTES = 147456;
static_assert(MISC_OFF + 128 <= LDS_BYTES, "LDS map");

#define GAS __attribute__((address_space(1)))
#define LAS __attribute__((address_space(3)))
typedef unsigned short bf16;
typedef unsigned v4u __attribute__((ext_vector_type(4)));
typedef float f32x4 __attribute__((ext_vector_type(4)));
#define LDS_WAIT() asm volatile("s_waitcnt lgkmcnt(0)" ::: "memory")
#define VM_WAIT() asm volatile("s_waitcnt vmcnt(0)" ::: "memory")
__device__ __forceinline__ unsigned f2bf(float f) { unsigned u = __builtin_bit_cast(unsigned, f); return (u + 0x7fffu + ((u >> 16) & 1u)) >> 16; }
__device__ __forceinline__ unsigned pk2(float lo, float hi) { return f2bf(lo) | (f2bf(hi) << 16); }
__device__ __forceinline__ float bf2f(bf16 b) { return __builtin_bit_cast(float, ((unsigned)b) << 16); }
__device__ __forceinline__ float bflo(unsigned w) { return __builtin_bit_cast(float, w << 16); }
__device__ __forceinline__ float bfhi(unsigned w) { return __builtin_bit_cast(float, w & 0xffff0000u); }
__device__ __forceinline__ float wave_sum(float v) {
#pragma unroll
    for (int o = 1; o < 64; o <<= 1) v += __shfl_xor(v, o);
    return v;
}
__device__ __forceinline__ float sigmoidf_(float x) { return 1.0f / (1.0f + __expf(-x)); }
__device__ __forceinline__ float siluf_(float x) { return x / (1.0f + __expf(-x)); }

#define XB_TMO      128
#define XB_XCNT(j)  (256  + 64 * (j))
#define XB_XSUB(j)  (1280 + 64 * (j))
#define XB_XGEN(j)  (2304 + 64 * (j))
#define XB_TOP      3328
#define XB_TOPGEN   3392
#define XCD_BAR_WORDS 3456
#define XB_SPIN_CAP (1u << 22)

__device__ __forceinline__ unsigned xb_ld(unsigned* p)              { return __hip_atomic_load(p, __ATOMIC_RELAXED, __HIP_MEMORY_SCOPE_AGENT); }
__device__ __forceinline__ unsigned xb_add(unsigned* p, unsigned v) { return __hip_atomic_fetch_add(p, v, __ATOMIC_RELAXED, __HIP_MEMORY_SCOPE_AGENT); }
__device__ __forceinline__ unsigned xb_xcc_id() { return (unsigned)__builtin_amdgcn_s_getreg((3 << 11) | 20) & 0xFu; }
#define XB_SPIN(cond, bar) do { unsigned _sp = 0; while (cond) { __builtin_amdgcn_s_sleep(1); \
    if ((++_sp & 255u) == 0u) { if (xb_ld(&(bar)[XB_TMO])) break; if (_sp > XB_SPIN_CAP) { atomicAdd(&(bar)[XB_TMO], 1u); break; } } } } while (0)

struct XcdBarrier { unsigned* bar; unsigned x; volatile LAS unsigned* st; };

__device__ __forceinline__ XcdBarrier xcd_barrier_post(unsigned* bar, volatile LAS unsigned* st) {
    XcdBarrier b; b.bar = bar; b.x = xb_xcc_id(); b.st = st;
    if (threadIdx.x == 0) (void)xb_add(&bar[XB_XCNT(b.x)], 1u);
    return b;
}
__device__ __forceinline__ void xcd_barrier_complete(unsigned* bar, unsigned x, unsigned& nloc, unsigned& nx) {
    const unsigned G = gridDim.x * gridDim.y * gridDim.z;
    unsigned sum, cnt, mine, sp = 0u;
    for (;;) {
        sum = 0u; cnt = 0u; mine = 0u;
#pragma unroll
        for (unsigned j = 0; j < 16; ++j) { const unsigned c = xb_ld(&bar[XB_XCNT(j)]); sum += c; cnt += (c > 0u) ? 1u : 0u; mine = (j == x) ? c : mine; }
        if (sum == G) break;
        __builtin_amdgcn_s_sleep(1);
        if ((++sp & 255u) == 0u) { if (xb_ld(&bar[XB_TMO])) break; if (sp > XB_SPIN_CAP) { atomicAdd(&bar[XB_TMO], 1u); break; } }
    }
    nloc = mine > 0u ? mine : 1u; nx = cnt > 0u ? cnt : 1u;
}
template <bool FIRST> __device__ __forceinline__ void xcd_barrier(const XcdBarrier& b) {
    asm volatile("s_waitcnt vmcnt(0)" ::: "memory");
    __syncthreads();
    if (threadIdx.x == 0) {
        unsigned* bar = b.bar;
        asm volatile("" : "+s"(bar));
        __builtin_amdgcn_s_waitcnt(0);
        unsigned nloc = b.st[0], nx = b.st[1];
        if (FIRST) { if (nloc == 0u) { xcd_barrier_complete(bar, b.x, nloc, nx); b.st[0] = nloc; b.st[1] = nx; } }
        const unsigned old = xb_add(&bar[XB_XSUB(b.x)], 1u);
        const unsigned gen = old / nloc;
        if (old + 1u == (gen + 1u) * nloc) {
            __builtin_amdgcn_fence(__ATOMIC_RELEASE, "agent");
            asm volatile("s_waitcnt vmcnt(0)" ::: "memory");
            const unsigned og = xb_add(&bar[XB_TOP], 1u);
            const unsigned tg = og / nx;
            if (og + 1u == (tg + 1u) * nx) xb_add(&bar[XB_TOPGEN], 1u);
            else XB_SPIN(xb_ld(&bar[XB_TOPGEN]) == tg, bar);
            __builtin_amdgcn_fence(__ATOMIC_ACQUIRE, "agent");
            xb_add(&bar[XB_XGEN(b.x)], 1u);
            asm volatile("s_waitcnt vmcnt(0)" ::: "memory");
        } else {
            XB_SPIN(xb_ld(&bar[XB_XGEN(b.x)]) == gen, bar);
            __builtin_amdgcn_fence(__ATOMIC_ACQUIRE, "agent");
            asm volatile("s_waitcnt vmcnt(0)" ::: "memory");
        }
    }
    __syncthreads();
}

struct Params { const float* in[N_INPUTS]; float* out; unsigned char* ws; float inv_freq[32]; };
static_assert(sizeof(Params) == N_INPUTS * 8 + 16 + 128, "Params has no padding");

struct Ctx {
    const float* const* in; float* out; unsigned char* ws;
    LAS unsigned char* lds;
    int G;
};
#define THREAD_IDS() int tid_ = threadIdx.x; asm volatile("" : "+v"(tid_)); const int tid = tid_, lane = tid & 63, wave = __builtin_amdgcn_readfirstlane(tid >> 6), gw = blockIdx.x * NWAVES + wave, NGW = C.G * NWAVES; (void)tid; (void)lane; (void)wave; (void)gw; (void)NGW
#define WSP(T, off) ((T*)(C.ws + (off)))

__device__ __forceinline__ float rstd_of(const float* ssp, int row) {
    const f32x4 a = *(const f32x4*)(ssp + (size_t)row * 16), b = *(const f32x4*)(ssp + (size_t)row * 16 + 4), c = *(const f32x4*)(ssp + (size_t)row * 16 + 8), d = *(const f32x4*)(ssp + (size_t)row * 16 + 12);
    const float s = (((a[0] + a[1]) + (a[2] + a[3])) + ((b[0] + b[1]) + (b[2] + b[3]))) + (((c[0] + c[1]) + (c[2] + c[3])) + ((d[0] + d[1]) + (d[2] + d[3])));
    return rsqrtf(s * (1.0f / D) + EPS);
}
#define EPI_IDS() int t_ = threadIdx.x; asm volatile("" : "+v"(t_)); const int wid_ = __builtin_amdgcn_readfirstlane(t_ >> 6), wr = wid_ >> 2, wc = wid_ & 3, fr = t_ & 15, fq = (t_ & 63) >> 4
struct EpiGLU {
    static constexpr bool PERM = true;
    bf16* act; const float* ss;
    __device__ __forceinline__ void operator()(const pg8::f32x4 (&acc)[2][2][4][2], const pg8::Unit& u, int, int, int, int) const {
        EPI_IDS();
        const int row0 = u.pm * 256 + wr * 64 + fr, col0 = u.pn * 128 + wc * 32 + 8 * fq;
#pragma unroll
        for (int ai = 0; ai < 2; ++ai)
#pragma unroll
            for (int m = 0; m < 4; ++m) {
                const int row = row0 + ai * 128 + m * 16; const float rstd = rstd_of(ss, row);
                float o[8];
#pragma unroll
                for (int n = 0; n < 2; ++n)
#pragma unroll
                    for (int j = 0; j < 4; ++j) { const float g = acc[ai][0][m][n][j] * rstd, up = acc[ai][1][m][n][j] * rstd; o[n * 4 + j] = siluf_(g) * up; }
                v4u w; w.x = pk2(o[0], o[1]); w.y = pk2(o[2], o[3]); w.z = pk2(o[4], o[5]); w.w = pk2(o[6], o[7]);
                *(v4u*)(act + (size_t)row * DFF + col0) = w;
            }
    }
};
template <bool FINAL, int SCALE2> struct EpiRes {
    static constexpr bool PERM = true;
    float* h; bf16* hb; float* ssout; float* out;
    __device__ __forceinline__ void operator()(const pg8::f32x4 (&acc)[2][2][4][2], const pg8::Unit& u, int, int, int, int) const {
        EPI_IDS();
        const int row0 = u.pm * 256 + wr * 64 + fr, col0 = u.pn * 256 + wc * 32 + 8 * fq;
#pragma unroll
        for (int ai = 0; ai < 2; ++ai)
#pragma unroll
            for (int m = 0; m < 4; ++m) {
                const int row = row0 + ai * 128 + m * 16; float sq = 0.f;
                constexpr float scale = 0.5f * SCALE2;
                long yoff = -1;
                if (FINAL) { if (row < MP) { const int b = row / L, pos = row - b * L; if (pos >= NMETA) yoff = (long)O_YP + ((long)b * SEQ + (pos - NMETA)) * D; } else if (row < MR) yoff = (long)O_YS + (long)(row - MP) * D; }
#pragma unroll
                for (int bj = 0; bj < 2; ++bj) {
                    const size_t off = (size_t)row * D + col0 + bj * 128;
                    f32x4 h0 = *(const f32x4*)(h + off), h1 = *(const f32x4*)(h + off + 4);
                    h0 = h0 + acc[ai][bj][m][0] * scale; h1 = h1 + acc[ai][bj][m][1] * scale;
                    *(f32x4*)(h + off) = h0; *(f32x4*)(h + off + 4) = h1;
                    v4u w; w.x = pk2(h0[0], h0[1]); w.y = pk2(h0[2], h0[3]); w.z = pk2(h1[0], h1[1]); w.w = pk2(h1[2], h1[3]);
                    *(v4u*)(hb + off) = w;
                    sq += (h0[0] * h0[0] + h0[1] * h0[1]) + (h0[2] * h0[2] + h0[3] * h0[3]) + (h1[0] * h1[0] + h1[1] * h1[1]) + (h1[2] * h1[2] + h1[3] * h1[3]);
                    if (FINAL && yoff >= 0) { *(f32x4*)(out + yoff + col0 + bj * 128) = h0; *(f32x4*)(out + yoff + col0 + bj * 128 + 4) = h1; }
                }
                sq += __shfl_xor(sq, 16); sq += __shfl_xor(sq, 32);
                if (fq == 0 && ssout) ssout[(size_t)row * 16 + u.pn * 4 + wc] = sq;
                asm volatile("" ::: "memory");
            }
    }
};
struct EpiZ {
    static constexpr bool PERM = true;
    bf16* zmix; bf16* gates; const float* ss; const float* bias;
    __device__ __forceinline__ void operator()(const pg8::f32x4 (&acc)[2][2][4][2], const pg8::Unit& u, int, int, int, int) const {
        EPI_IDS();
        const int row0 = u.pm * 256 + wr * 64 + fr, col0 = u.pn * 256 + wc * 32 + 8 * fq; const bool isgate = u.pn >= NMIXP / 256;
        f32x4 bv[2][2];
#pragma unroll
        for (int bj = 0; bj < 2; ++bj)
#pragma unroll
            for (int n = 0; n < 2; ++n) bv[bj][n] = *(const f32x4*)(bias + col0 + bj * 128 + 4 * n);
#pragma unroll
        for (int ai = 0; ai < 2; ++ai)
#pragma unroll
            for (int m = 0; m < 4; ++m) {
                const int row = row0 + ai * 128 + m * 16; const float rstd = rstd_of(ss, row);
#pragma unroll
                for (int bj = 0; bj < 2; ++bj) {
                    f32x4 v0 = acc[ai][bj][m][0] * rstd + bv[bj][0], v1 = acc[ai][bj][m][1] * rstd + bv[bj][1];
                    if (isgate) {
#pragma unroll
                        for (int j = 0; j < 4; ++j) { v0[j] = sigmoidf_(v0[j]); v1[j] = sigmoidf_(v1[j]); } }
                    v4u w; w.x = pk2(v0[0], v0[1]); w.y = pk2(v0[2], v0[3]); w.z = pk2(v1[0], v1[1]); w.w = pk2(v1[2], v1[3]);
                    if (isgate) *(v4u*)(gates + (size_t)row * NGATE + (col0 - NMIXP) + bj * 128) = w;
                    else *(v4u*)(zmix + (size_t)row * NMIXP + col0 + bj * 128) = w;
                }
            }
    }
};
struct EpiMerge {
    static constexpr bool PERM = true;
    bf16* merged; const bf16* gates;
    __device__ __forceinline__ void operator()(const pg8::f32x4 (&acc)[2][2][4][2], const pg8::Unit& u, int, int, int, int) const {
        EPI_IDS();
        const int n = u.pn >> 2, dt = u.pn & 3;
        const int row0 = u.pm * 256 + wr * 64 + fr, col0 = dt * 256 + wc * 32 + 8 * fq;
#pragma unroll
        for (int ai = 0; ai < 2; ++ai)
#pragma unroll
            for (int m = 0; m < 4; ++m) {
                const int row = row0 + ai * 128 + m * 16;
#pragma unroll
                for (int bj = 0; bj < 2; ++bj) {
                    const v4u gw = *(const v4u*)(gates + (size_t)row * NGATE + n * D + col0 + bj * 128);
                    bf16* mp = merged + (size_t)row * D + col0 + bj * 128;
                    float o[8];
                    o[0] = acc[ai][bj][m][0][0] * bflo(gw.x); o[1] = acc[ai][bj][m][0][1] * bfhi(gw.x); o[2] = acc[ai][bj][m][0][2] * bflo(gw.y); o[3] = acc[ai][bj][m][0][3] * bfhi(gw.y);
                    o[4] = acc[ai][bj][m][1][0] * bflo(gw.z); o[5] = acc[ai][bj][m][1][1] * bfhi(gw.z); o[6] = acc[ai][bj][m][1][2] * bflo(gw.w); o[7] = acc[ai][bj][m][1][3] * bfhi(gw.w);
                    if (n > 0) { const v4u pw = *(const v4u*)mp;
                        o[0] += bflo(pw.x); o[1] += bfhi(pw.x); o[2] += bflo(pw.y); o[3] += bfhi(pw.y); o[4] += bflo(pw.z); o[5] += bfhi(pw.z); o[6] += bflo(pw.w); o[7] += bfhi(pw.w); }
                    v4u w; w.x = pk2(o[0], o[1]); w.y = pk2(o[2], o[3]); w.z = pk2(o[4], o[5]); w.w = pk2(o[6], o[7]);
                    *(v4u*)mp = w;
                }
                asm volatile("" ::: "memory");
            }
    }
};

struct RowMap { int mode, a; __device__ __forceinline__ int operator()(int n) const { return mode == 0 ? n + a : (mode == 1 ? 256 * (n >> 7) + (n & 127) + a : (n < NMIX ? n : n + (NMIXP - NMIX))); } };
__device__ __forceinline__ void tr_item(const float* W, int K, int N, const float* gain, bf16* WT, int pitch, RowMap rm, LAS float* scr, int kb, int nb, int lane) {
    const int k0 = 64 * kb, n0 = 32 * nb; const int nn = n0 + (lane & 31);
#pragma unroll 8
    for (int i = 0; i < 32; ++i) { const int kk = 2 * i + (lane >> 5); float v = (nn < N) ? W[(size_t)(k0 + kk) * N + nn] : 0.f; if (gain) v *= gain[k0 + kk]; scr[kk * 33 + (lane & 31)] = v; }
    LDS_WAIT(); asm volatile("" ::: "memory");
    const int c = lane & 7;
#pragma unroll
    for (int j = 0; j < 4; ++j) { const int nl = (lane >> 3) + 8 * j; const int n = n0 + nl; const LAS float* s = scr + (8 * c) * 33 + nl;
        v4u o; o.x = pk2(s[0 * 33], s[1 * 33]); o.y = pk2(s[2 * 33], s[3 * 33]); o.z = pk2(s[4 * 33], s[5 * 33]); o.w = pk2(s[6 * 33], s[7 * 33]);
        if (n < N) *(v4u*)(WT + (size_t)rm(n) * pitch + k0 + 8 * c) = o; }
    LDS_WAIT(); asm volatile("" ::: "memory");
}
__device__ __forceinline__ void p0_prologue(const Ctx& C, const Params& P) {
    THREAD_IDS();
    LAS float* scr = (LAS float*)(C.lds + RING_OFF + wave * 16384);
    constexpr int I_FF = 16 * 88, I_DN = 44 * 32, I_IN = 16 * 225, I_BR = 4 * 4 * 32, I_OUT = 16 * 32;
    constexpr int PER_LAYER = 4 * I_FF + 2 * I_DN + I_IN + I_BR + I_OUT;
    for (int it = gw; it < DEPTH * PER_LAYER; it += NGW) {
        const int l = it / PER_LAYER; int r = it - l * PER_LAYER;
        bf16* W1a = WSP(bf16, WS_W1 + (size_t)(l * 2 + 0) * SZ_W1); bf16* W1b = WSP(bf16, WS_W1 + (size_t)(l * 2 + 1) * SZ_W1);
        bf16* Wda = WSP(bf16, WS_WD + (size_t)(l * 2 + 0) * SZ_WD); bf16* Wdb = WSP(bf16, WS_WD + (size_t)(l * 2 + 1) * SZ_WD);
        if (r < I_FF) { tr_item(C.in[I_F1G] + (size_t)l * D * DFF, D, DFF, C.in[I_NF1] + l * D, W1a, D, RowMap{1, 0}, scr, r / 88, r % 88, lane); continue; } r -= I_FF;
        if (r < I_FF) { tr_item(C.in[I_F1U] + (size_t)l * D * DFF, D, DFF, C.in[I_NF1] + l * D, W1a, D, RowMap{1, 128}, scr, r / 88, r % 88, lane); continue; } r -= I_FF;
        if (r < I_DN) { tr_item(C.in[I_F1D] + (size_t)l * D * DFF, DFF, D, nullptr, Wda, DFF, RowMap{0, 0}, scr, r / 32, r % 32, lane); continue; } r -= I_DN;
        if (r < I_FF) { tr_item(C.in[I_F2G] + (size_t)l * D * DFF, D, DFF, C.in[I_NF2] + l * D, W1b, D, RowMap{1, 0}, scr, r / 88, r % 88, lane); continue; } r -= I_FF;
        if (r < I_FF) { tr_item(C.in[I_F2U] + (size_t)l * D * DFF, D, DFF, C.in[I_NF2] + l * D, W1b, D, RowMap{1, 128}, scr, r / 88, r % 88, lane); continue; } r -= I_FF;
        if (r < I_DN) { tr_item(C.in[I_F2D] + (size_t)l * D * DFF, DFF, D, nullptr, Wdb, DFF, RowMap{0, 0}, scr, r / 32, r % 32, lane); continue; } r -= I_DN;
        if (r < I_IN) { tr_item(C.in[I_WIN] + (size_t)l * D * NIN, D, NIN, C.in[I_NMIX] + l * D, WSP(bf16, WS_WIN + (size_t)l * SZ_WIN), D, RowMap{2, 0}, scr, r / 225, r % 225, lane); continue; } r -= I_IN;
        if (r < I_BR) { const int n4 = r / 128, rr = r % 128; tr_item(C.in[I_WBR] + (size_t)(l * 4 + n4) * 256 * D, 256, D, nullptr, WSP(bf16, WS_WBR + (size_t)l * SZ_WBR), 256, RowMap{0, n4 * D}, scr, rr / 32, rr % 32, lane); continue; } r -= I_BR;
        tr_item(C.in[I_WOUT] + (size_t)l * D * D, D, D, nullptr, WSP(bf16, WS_WOUT + (size_t)l * SZ_WOUT), D, RowMap{0, 0}, scr, r / 32, r % 32, lane);
    }
    const int gt = gw * 64 + lane, NGT = NGW * 64;
    for (int i = gt; i < 2 * 240 * 128; i += NGT) { const int l = i / (240 * 128), r = i % (240 * 128); *(v4u*)(C.ws + WS_WIN + (size_t)l * SZ_WIN + ((size_t)NMIX * D) * 2 + (size_t)r * 16) = (v4u){0u, 0u, 0u, 0u}; }
    for (int i = gt; i < (M - MR) * 128; i += NGT) *(v4u*)(C.ws + WS_BR + (size_t)MR * D * 2 + (size_t)i * 16) = (v4u){0u, 0u, 0u, 0u};
    for (int i = gt; i < 2 * NINP; i += NGT) { const int l = i / NINP, j = i % NINP; float v = 0.f; if (j < NMIX) v = C.in[I_BIN][l * NIN + j]; else if (j >= NMIXP) v = C.in[I_BIN][l * NIN + NMIX + (j - NMIXP)]; WSP(float, WS_BINP)[i] = v; }
    for (int i = gt; i < NPOS * 32; i += NGT) { const int pi = i >> 5, fi = i & 31; const int pos = pi < L ? pi : PAST + (pi - L);
        const float angf = (float)pos * P.inv_freq[fi];
        const double a = (double)angf; const double k = rint(a * 0.15915494309189535); const double rr = (a - k * 6.283185307179586) - k * 2.4492935982947064e-16;
        const float rf = (float)rr; WSP(float, WS_ROPE)[i] = cosf(rf); WSP(float, WS_ROPE)[NPOS * 32 + i] = sinf(rf); }
    float* H = WSP(float, WS_H); bf16* HB = WSP(bf16, WS_HB); float* SS0 = WSP(float, WS_SS);
    for (int row = gw; row < M; row += NGW) {
        const float* src = nullptr;
        if (row < MP) { const int b = row / L, pos = row - b * L; src = pos < NMETA ? C.in[I_META] + (size_t)pos * D : C.in[I_XP] + ((size_t)b * SEQ + (pos - NMETA)) * D; }
        else if (row < MR) src = C.in[I_XS] + (size_t)(row - MP) * D;
        float s = 0.f;
#pragma unroll
        for (int j = 0; j < 4; ++j) { f32x4 v = src ? *(const f32x4*)(src + 256 * j + 4 * lane) : (f32x4){0.f, 0.f, 0.f, 0.f};
            *(f32x4*)(H + (size_t)row * D + 256 * j + 4 * lane) = v; s += (v[0] * v[0] + v[1] * v[1]) + (v[2] * v[2] + v[3] * v[3]);
            unsigned long long w = (unsigned long long)pk2(v[0], v[1]) | ((unsigned long long)pk2(v[2], v[3]) << 32);
            *(unsigned long long*)(HB + (size_t)row * D + 256 * j + 4 * lane) = w; }
        s = wave_sum(s); if (lane < 16) SS0[(size_t)row * 16 + lane] = lane == 0 ? s : 0.f;
    }
}

__device__ __forceinline__ float lam_of(const Ctx& C, int l, float lam_init) {
    THREAD_IDS();
    float a = 0.f, b = 0.f;
    for (int i = 0; i < 32; ++i) { a += C.in[I_LQ1][l * 32 + i] * C.in[I_LK1][l * 32 + i]; b += C.in[I_LQ2][l * 32 + i] * C.in[I_LK2][l * 32 + i]; }
    return __expf(a) - __expf(b) + lam_init;
}
__device__ __forceinline__ int t5_bucket(int n) {
    if (n < 16) return n;
    return 16 + (n >= 19) + (n >= 21) + (n >= 24) + (n >= 27) + (n >= 31) + (n >= 35) + (n >= 40) + (n >= 46) + (n >= 52) + (n >= 59) + (n >= 67) + (n >= 77) + (n >= 87) + (n >= 99) + (n >= 113);
}
__device__ __forceinline__ void n1_prep(const Ctx& C, int l) {
    THREAD_IDS();
    const bf16* ZM = WSP(bf16, WS_ZMIX); float* UB = WSP(float, WS_UBUF); float* RQ = WSP(float, WS_RQ); float* RK = WSP(float, WS_RK); float* QN = WSP(float, WS_QN); float* KN = WSP(float, WS_KN);
    float* VB = WSP(float, WS_VB); float* LD = WSP(float, WS_LDEC); const float* COS = WSP(float, WS_ROPE); const float* SIN = COS + NPOS * 32;
    for (int r = gw; r < MR; r += NGW) {
        const bf16* z = ZM + (size_t)r * NMIXP;
        const int pi = r < MP ? r % L : L + ((r - MP) & 7);
        float* kout = r < MP ? C.out + O_KP + ((size_t)l * MP + r) * 256 : C.out + O_KS + ((size_t)l * MS + (r - MP)) * 256;
        float* vout = r < MP ? C.out + O_VP + ((size_t)l * MP + r) * 256 : C.out + O_VS + ((size_t)l * MS + (r - MP)) * 256;
#pragma unroll
        for (int k = 0; k < 4; ++k) { const int c = lane + 64 * k;
            UB[(size_t)r * 256 + c] = bf2f(z[C_A + c]) * sigmoidf_(bf2f(z[C_G + c]));
            const float vv = bf2f(z[D_V + c]); VB[(size_t)r * 256 + c] = vv; vout[c] = vv;
            { float x = bf2f(z[D_Q + c]); float s = x * x; s += __shfl_xor(s, 1); s += __shfl_xor(s, 2); s += __shfl_xor(s, 4); s += __shfl_xor(s, 8); s += __shfl_xor(s, 16);
              const float y = x * rsqrtf(s * (1.0f / 32) + EPS) * C.in[I_QN][l * 32 + (c & 31)]; QN[(size_t)r * 256 + c] = y; WSP(bf16, WS_QNB)[(size_t)r * 256 + c] = (bf16)f2bf(y * (0.17677669529663687f * 1.4426950408889634f)); }
            { float x = bf2f(z[D_K + c]); float s = x * x; s += __shfl_xor(s, 1); s += __shfl_xor(s, 2); s += __shfl_xor(s, 4); s += __shfl_xor(s, 8); s += __shfl_xor(s, 16);
              const float y = x * rsqrtf(s * (1.0f / 32) + EPS) * C.in[I_KN][l * 32 + (c & 31)]; KN[(size_t)r * 256 + c] = y; kout[c] = y; WSP(bf16, WS_KNB)[(size_t)r * 256 + c] = (bf16)f2bf(y); }
        }
#pragma unroll
        for (int k = 0; k < 2; ++k) { const int p = lane + 64 * k, h = p >> 5, i = p & 31; const float cs = COS[pi * 32 + i], sn = SIN[pi * 32 + i];
            { const float x1 = bf2f(z[R_Q + h * 64 + i]), x2 = bf2f(z[R_Q + h * 64 + 32 + i]); RQ[(size_t)r * 256 + h * 64 + i] = x1 * cs - x2 * sn; RQ[(size_t)r * 256 + h * 64 + 32 + i] = x1 * sn + x2 * cs; }
            { const float x1 = bf2f(z[R_K + h * 64 + i]), x2 = bf2f(z[R_K + h * 64 + 32 + i]); RK[(size_t)r * 256 + h * 64 + i] = (x1 * cs - x2 * sn) * 0.125f; RK[(size_t)r * 256 + h * 64 + 32 + i] = (x1 * sn + x2 * cs) * 0.125f; }
            { const int j = p; float gp = C.in[I_GAB][l * 128 + j];
              for (int i2 = 0; i2 < 16; ++i2) gp += bf2f(z[G_LOW + i2]) * C.in[I_GAW][(l * 16 + i2) * 128 + j];
              const float ls = fminf(gp, 0.f) - log1pf(__expf(-fabsf(gp)));
              LD[(size_t)r * 128 + j] = ls * (1.0f / 16.0f); }
        }
    }
}
__device__ __forceinline__ void n2_conv(const Ctx& C, int l) {
    THREAD_IDS();
    const float* UB = WSP(float, WS_UBUF); bf16* BR = WSP(bf16, WS_BR);
    const float* cw = C.in[I_CW] + (size_t)l * 31 * 256; const float* sc = C.in[I_SCONV];
    for (int r = gw; r < MR; r += NGW) {
        const bool smp = r >= MP; const int b = smp ? (r - MP) >> 3 : r / L; const int p = smp ? (r - MP) & 7 : r - b * L; const int rb = smp ? MP + b * 8 : b * L;
        float cv[4];
#pragma unroll
        for (int k = 0; k < 4; ++k) cv[k] = C.in[I_CB][l * 256 + lane + 64 * k];
        for (int j = 0; j < 31; ++j) { const int q = p + j - 30;
#pragma unroll
            for (int k = 0; k < 4; ++k) { const int c = lane + 64 * k; float uv;
                if (q >= 0) uv = UB[(size_t)(rb + q) * 256 + c]; else uv = smp ? sc[(((size_t)l * DB + b) * 30 + (p + j)) * 256 + c] : 0.f;
                cv[k] += cw[j * 256 + c] * uv; } }
        float s = (cv[0] + cv[1]) + (cv[2] + cv[3]); const float mean = wave_sum(s) * (1.0f / 256);
        float q2 = 0.f;
#pragma unroll
        for (int k = 0; k < 4; ++k) { cv[k] -= mean; q2 += cv[k] * cv[k]; }
        const float rstd = rsqrtf(wave_sum(q2) * (1.0f / 256) + EPS);
#pragma unroll
        for (int k = 0; k < 4; ++k) { const int c = lane + 64 * k; const float y = cv[k] * rstd * C.in[I_CLG][l * 256 + c] + C.in[I_CLB][l * 256 + c]; BR[(size_t)r * D + c] = (bf16)f2bf(siluf_(y)); }
    }
    const int gt = gw * 64 + lane, NGT = NGW * 64;
    for (int i = gt; i < BATCH * 30 * 256; i += NGT) { const int c = i & 255, ii = (i >> 8) % 30, b = i / (30 * 256); C.out[O_CP + (size_t)l * BATCH * 30 * 256 + i] = UB[(size_t)(b * L + L - 30 + ii) * 256 + c]; }
    for (int i = gt; i < DB * 30 * 256; i += NGT) { const int c = i & 255, ii = (i >> 8) % 30, b = i / (30 * 256);
        C.out[O_CS + (size_t)l * DB * 30 * 256 + i] = ii < 22 ? sc[(((size_t)l * DB + b) * 30 + 8 + ii) * 256 + c] : UB[(size_t)(MP + b * 8 + ii - 22) * 256 + c]; }
}
template <int DK, bool RET> __device__ __forceinline__ void la_seq(const Ctx& C, int l, bool smp, int b, int h) {
    THREAD_IDS();
    const bf16* ZM = WSP(bf16, WS_ZMIX); const float* RQ = WSP(float, WS_RQ); const float* RK = WSP(float, WS_RK); const float* LD = WSP(float, WS_LDEC); bf16* BR = WSP(bf16, WS_BR);
    const int nt = smp ? DS : L; const int row0 = smp ? MP + b * DS : b * L;
    float S[DK];
    if (smp) { const float* s0 = (RET ? C.in[I_SRET] : C.in[I_SGLA]) + (((size_t)l * DB + b) * 4 + h) * DK * 64;
#pragma unroll
        for (int k = 0; k < DK; ++k) S[k] = s0[k * 64 + lane]; }
    else {
#pragma unroll
        for (int k = 0; k < DK; ++k) S[k] = 0.f; }
    const float gamma = 1.0f - exp2f(-5.0f - (float)h);
    const float gn = RET ? C.in[I_RGN][(l * 4 + h) * 64 + lane] : C.in[I_GGN][(l * 4 + h) * 64 + lane];
    for (int t = 0; t < nt; ++t) {
        const int r = row0 + t; const bf16* z = ZM + (size_t)r * NMIXP;
        float ql, kl, dl = 1.f;
        if (RET) { ql = RQ[(size_t)r * 256 + h * 64 + lane]; kl = RK[(size_t)r * 256 + h * 64 + lane]; }
        else { const int lk = lane & 31; ql = bf2f(z[G_Q + h * 32 + lk]) * 0.17677669529663687f; kl = bf2f(z[G_K + h * 32 + lk]); dl = __expf(LD[(size_t)r * 128 + h * 32 + lk]); }
        const float v = bf2f(z[(RET ? R_V : G_V) + h * 64 + lane]);
        float o = 0.f;
#pragma unroll
        for (int k = 0; k < DK; ++k) { const float qk = __shfl(ql, k), kk = __shfl(kl, k); const float dk = RET ? gamma : __shfl(dl, k);
            S[k] = dk * S[k] + kk * v; o += qk * S[k]; if ((k & 7) == 7) __builtin_amdgcn_sched_barrier(0); }
        float y;
        if (RET) { const float mean = wave_sum(o) * (1.0f / 64); const float d = o - mean; const float var = wave_sum(d * d) * (1.0f / 64); y = d * rsqrtf(var + EPS) * gn; }
        else { const float ms = wave_sum(o * o) * (1.0f / 64); y = o * rsqrtf(ms + EPS) * gn; }
        const float g = bf2f(z[(RET ? R_G : G_R) + h * 64 + lane]);
        BR[(size_t)r * D + (RET ? 256 : 512) + h * 64 + lane] = (bf16)f2bf(siluf_(g) * y);
    }
    float* so = C.out + (RET ? (smp ? O_RS + (((size_t)l * DB + b) * 4 + h) * DK * 64 : O_RP + (((size_t)l * BATCH + b) * 4 + h) * DK * 64)
                             : (smp ? O_GS + (((size_t)l * DB + b) * 4 + h) * DK * 64 : O_GP + (((size_t)l * BATCH + b) * 4 + h) * DK * 64));
#pragma unroll
    for (int k = 0; k < DK; ++k) so[k * 64 + lane] = S[k];
}
__device__ __forceinline__ void n2_la(const Ctx& C, int l) {
    THREAD_IDS();
    if ((gw & 63) == 0 && (gw >> 6) < 32) { const int it = gw >> 6; const int b = (it >> 2) & 3, h = it & 3;
        if (it < 16) la_seq<64, true>(C, l, false, b, h); else la_seq<32, false>(C, l, false, b, h); }
    for (int it = gw; it < 256; it += NGW) { const int typ = it >> 7, b = (it >> 2) & 31, h = it & 3;
        if (typ == 0) la_seq<64, true>(C, l, true, b, h); else la_seq<32, false>(C, l, true, b, h); }
}
__device__ __forceinline__ void n2_attn_prompt(const Ctx& C, int l, float lam_init) {
    THREAD_IDS();
    const float* QN = WSP(float, WS_QN); const float* KN = WSP(float, WS_KN); const float* VB = WSP(float, WS_VB); bf16* BR = WSP(bf16, WS_BR);
    const float lam = lam_of(C, l, lam_init);
    LAS float* park = (LAS float*)(C.lds) + wave * (64 * 65);
    constexpr int NQG = (L + 63) / 64;
    for (int it = gw; it < BATCH * 4 * NQG; it += NGW) {
        const int qg = NQG - 1 - it / 16, bh = it % 16, b = bh >> 2, h = bh & 3;
        const int qpos = min(qg * 64 + lane, L - 1); const bool valid = (qg * 64 + lane) < L; const int qrow = b * L + qpos;
        const int nkeys = min(qg * 64 + 64, L);
        float bias_near[1]; (void)bias_near;
        for (int s = 0; s < 2; ++s) {
            float q[32];
#pragma unroll
            for (int i = 0; i < 32; i += 4) { const f32x4 t = *(const f32x4*)(QN + (size_t)qrow * 256 + h * 64 + s * 32 + i); q[i] = t[0] * 0.17677669529663687f; q[i + 1] = t[1] * 0.17677669529663687f; q[i + 2] = t[2] * 0.17677669529663687f; q[i + 3] = t[3] * 0.17677669529663687f; }
            float m = -INFINITY, lsum = 0.f; float acc[64];
#pragma unroll
            for (int i = 0; i < 64; ++i) acc[i] = 0.f;
            for (int j = 0; j < nkeys; ++j) {
                const float* kp = KN + (size_t)(b * L + j) * 256 + h * 64 + s * 32; const float* vp = VB + (size_t)(b * L + j) * 256 + h * 64;
                float sc = 0.f;
#pragma unroll
                for (int i = 0; i < 32; i += 4) { const f32x4 kv = *(const f32x4*)(kp + i); sc += q[i] * kv[0] + q[i + 1] * kv[1] + q[i + 2] * kv[2] + q[i + 3] * kv[3]; }
                const int n = qpos - j;
                sc += C.in[I_RELB][t5_bucket(n < 0 ? 0 : n) * 4 + h];
                if (n < 0) sc = -INFINITY;
                const float mn = fmaxf(m, sc); const float corr = __expf(m - mn); const float p = __expf(sc - mn);
                m = mn; lsum = lsum * corr + p;
#pragma unroll
                for (int i = 0; i < 64; i += 4) { const f32x4 vv = *(const f32x4*)(vp + i); acc[i] = acc[i] * corr + p * vv[0]; acc[i + 1] = acc[i + 1] * corr + p * vv[1]; acc[i + 2] = acc[i + 2] * corr + p * vv[2]; acc[i + 3] = acc[i + 3] * corr + p * vv[3]; }
            }
            const float inv = 1.0f / lsum;
            if (s == 0) {
#pragma unroll
                for (int i = 0; i < 64; ++i) park[lane * 65 + i] = acc[i] * inv;
                LDS_WAIT();
            } else {
                float ms = 0.f;
#pragma unroll
                for (int i = 0; i < 64; ++i) { acc[i] = park[lane * 65 + i] - lam * (acc[i] * inv); ms += acc[i] * acc[i]; }
                const float rn = rsqrtf(ms * (1.0f / 64) + EPS) * (1.0f - lam_init);
                if (valid) {
#pragma unroll
                    for (int i = 0; i < 64; i += 2) { const unsigned w = pk2(acc[i] * rn * C.in[I_SUBLN][l * 64 + i], acc[i + 1] * rn * C.in[I_SUBLN][l * 64 + i + 1]); *(unsigned*)(BR + (size_t)qrow * D + 768 + h * 64 + i) = w; } }
                LDS_WAIT();
            }
        }
    }
}
__device__ __forceinline__ void n2_attn_sample(const Ctx& C, int l, float lam_init) {
    THREAD_IDS();
    const float* QN = WSP(float, WS_QN); const float* KN = WSP(float, WS_KN); const float* VB = WSP(float, WS_VB); bf16* BR = WSP(bf16, WS_BR);
    const int* PT = (const int*)C.in[I_PT]; const float* CK = C.in[I_CK] + (size_t)l * NPOOL * PAGE * 256; const float* CV = C.in[I_CV] + (size_t)l * NPOOL * PAGE * 256;
    const float lam = lam_of(C, l, lam_init);
    LAS float* part = (LAS float*)C.lds;
    for (int b = blockIdx.x; b < DB; b += C.G) {
        const int row = tid & 63, split = tid >> 6, h = row >> 4, s = (row >> 3) & 1, t = row & 7;
        float q[32];
#pragma unroll
        for (int i = 0; i < 32; ++i) q[i] = QN[(size_t)(MP + b * 8 + t) * 256 + h * 64 + s * 32 + i] * 0.17677669529663687f;
        float m = -INFINITY, lsum = 0.f; float acc[64];
#pragma unroll
        for (int i = 0; i < 64; ++i) acc[i] = 0.f;
        for (int j = split; j < PAST + DS; j += 8) {
            const float* kp; const float* vp; bool vis = true;
            if (j < PAST) { const int page = PT[b * NPAGES + (j >> 7)]; const size_t base = (((size_t)page * PAGE + (j & 127)) * 4 + h) * 64; kp = CK + base + s * 32; vp = CV + base; }
            else { const int jj = j - PAST; const size_t r2 = (size_t)(MP + b * 8 + jj); kp = KN + r2 * 256 + h * 64 + s * 32; vp = VB + r2 * 256 + h * 64; vis = jj <= t; }
            float sc = 0.f;
#pragma unroll
            for (int i = 0; i < 32; i += 4) { const f32x4 kv = *(const f32x4*)(kp + i); sc += q[i] * kv[0] + q[i + 1] * kv[1] + q[i + 2] * kv[2] + q[i + 3] * kv[3]; }
            const int n = PAST + t - j;
            sc += C.in[I_RELB][t5_bucket(n < 0 ? 0 : n) * 4 + h];
            if (!vis) sc = -INFINITY;
            const float mn = fmaxf(m, sc); const float corr = __expf(m - mn); const float p = __expf(sc - mn);
            m = mn; lsum = lsum * corr + p;
#pragma unroll
            for (int i = 0; i < 64; i += 4) { const f32x4 vv = *(const f32x4*)(vp + i); acc[i] = acc[i] * corr + p * vv[0]; acc[i + 1] = acc[i + 1] * corr + p * vv[1]; acc[i + 2] = acc[i + 2] * corr + p * vv[2]; acc[i + 3] = acc[i + 3] * corr + p * vv[3]; }
        }
        LAS float* pr = part + (split * 64 + row) * 66;
        pr[64] = m; pr[65] = lsum;
#pragma unroll
        for (int i = 0; i < 64; ++i) pr[i] = acc[i];
        __syncthreads();
        for (int k = 0; k < 4; ++k) { const int p = wave * 4 + k, h2 = p >> 3, t2 = p & 7; float os[2];
#pragma unroll
            for (int s2 = 0; s2 < 2; ++s2) { const int rw = h2 * 16 + s2 * 8 + t2; float mm = -INFINITY;
                for (int sp = 0; sp < 8; ++sp) mm = fmaxf(mm, part[(sp * 64 + rw) * 66 + 64]);
                float ll = 0.f, oo = 0.f;
                for (int sp = 0; sp < 8; ++sp) { const float w = __expf(part[(sp * 64 + rw) * 66 + 64] - mm); ll += part[(sp * 64 + rw) * 66 + 65] * w; oo += part[(sp * 64 + rw) * 66 + lane] * w; }
                os[s2] = oo / ll; }
            const float o = os[0] - lam * os[1]; const float ms = wave_sum(o * o) * (1.0f / 64);
            const float y = o * rsqrtf(ms + EPS) * C.in[I_SUBLN][l * 64 + lane] * (1.0f - lam_init);
            BR[(size_t)(MP + b * 8 + t2) * D + 768 + h2 * 64 + lane] = (bf16)f2bf(y); }
        __syncthreads();
    }
}
typedef short bf16x8_t __attribute__((ext_vector_type(8)));
template <int DK, bool RET> __device__ __forceinline__ void la_chunked(const Ctx& C, int l, bool smp, int b, int h) {
    THREAD_IDS();
    constexpr int QS = DK + 8, TS = 72, NKB = DK / 16, NKS = DK / 32;
    LAS bf16* QT = (LAS bf16*)(C.lds);
    LAS bf16* KT = QT + 64 * QS;
    LAS bf16* VT = KT + 64 * QS;
    LAS bf16* KE = VT + 64 * TS;
    LAS bf16* AL = KE + DK * TS;
    LAS bf16* ST = AL + 64 * TS;
    LAS float* WT = (LAS float*)(ST + 2 * 64 * QS);
    const bf16* ZM = WSP(bf16, WS_ZMIX); const float* RQ = WSP(float, WS_RQ); const float* RK = WSP(float, WS_RK); const float* LD = WSP(float, WS_LDEC); bf16* BR = WSP(bf16, WS_BR);
    const int nt = smp ? DS : L, row0 = smp ? MP + b * DS : b * L, nch = (nt + 63) >> 6;
    const float lg2 = RET ? log2f(1.0f - exp2f(-5.0f - (float)h)) : 0.f;
    const int g4 = lane >> 4, c16 = lane & 15;
    const bool qwave = wave < 4; const int w4 = wave & 3;
    float Sreg[NKB][4];
    if (wave >= 4) {
        const float* s0 = (RET ? C.in[I_SRET] : C.in[I_SGLA]) + (((size_t)l * DB + b) * 4 + h) * DK * 64;
#pragma unroll
        for (int cb = 0; cb < NKB; ++cb)
#pragma unroll
            for (int r = 0; r < 4; ++r) { const int dk = cb * 16 + c16, dv = (wave - 4) * 16 + 4 * g4 + r; const float v = smp ? s0[dk * 64 + dv] : 0.f; Sreg[cb][r] = v; ST[dv * QS + dk] = (bf16)f2bf(v); }
    }
    float gnv[4];
#pragma unroll
    for (int cb = 0; cb < 4; ++cb) gnv[cb] = (RET ? C.in[I_RGN] : C.in[I_GGN])[(l * 4 + h) * 64 + cb * 16 + c16];
    float a[16]; v4u vr;
#define LA_LOAD(c) do { const size_t r_ = (size_t)(row0 + (c) * 64 + lane); const bf16* z_ = ZM + r_ * NMIXP; \
        vr = *(const v4u*)(z_ + (RET ? R_V : G_V) + h * 64 + 8 * wave); \
        if (RET) { const float* p_ = (qwave ? RQ : RK) + r_ * 256 + h * 64 + 8 * w4; const f32x4 x0 = *(const f32x4*)p_, x1 = *(const f32x4*)(p_ + 4), x2 = *(const f32x4*)(p_ + 32), x3 = *(const f32x4*)(p_ + 36); \
            a[0] = x0[0]; a[1] = x0[1]; a[2] = x0[2]; a[3] = x0[3]; a[4] = x1[0]; a[5] = x1[1]; a[6] = x1[2]; a[7] = x1[3]; a[8] = x2[0]; a[9] = x2[1]; a[10] = x2[2]; a[11] = x2[3]; a[12] = x3[0]; a[13] = x3[1]; a[14] = x3[2]; a[15] = x3[3]; } \
        else { const v4u q_ = *(const v4u*)(z_ + (qwave ? G_Q : G_K) + h * 32 + 8 * w4); const float* p_ = LD + r_ * 128 + h * 32 + 8 * w4; const f32x4 x0 = *(const f32x4*)p_, x1 = *(const f32x4*)(p_ + 4); \
            a[0] = bflo(q_.x); a[1] = bfhi(q_.x); a[2] = bflo(q_.y); a[3] = bfhi(q_.y); a[4] = bflo(q_.z); a[5] = bfhi(q_.z); a[6] = bflo(q_.w); a[7] = bfhi(q_.w); \
            a[8] = x0[0]; a[9] = x0[1]; a[10] = x0[2]; a[11] = x0[3]; a[12] = x1[0]; a[13] = x1[1]; a[14] = x1[2]; a[15] = x1[3]; } } while (0)
    LA_LOAD(0);
    int cur = 0;
    for (int c = 0; c < nch; ++c) {
        const int nvc = min(64, nt - c * 64); const bool valid = lane < nvc;
        if (RET) {
            const float tq = (float)(lane + 1);
            if (qwave) { const float e = valid ? exp2f(lg2 * tq) : 0.f;
                v4u w0, w1; w0.x = pk2(a[0] * e, a[1] * e); w0.y = pk2(a[2] * e, a[3] * e); w0.z = pk2(a[4] * e, a[5] * e); w0.w = pk2(a[6] * e, a[7] * e);
                w1.x = pk2(a[8] * e, a[9] * e); w1.y = pk2(a[10] * e, a[11] * e); w1.z = pk2(a[12] * e, a[13] * e); w1.w = pk2(a[14] * e, a[15] * e);
                *(LAS v4u*)(QT + lane * QS + 8 * w4) = w0; *(LAS v4u*)(QT + lane * QS + 32 + 8 * w4) = w1; }
            else { const float e = valid ? exp2f(-lg2 * tq) : 0.f, ee = valid ? exp2f(lg2 * ((float)nvc - tq)) : 0.f;
                v4u w0, w1; w0.x = pk2(a[0] * e, a[1] * e); w0.y = pk2(a[2] * e, a[3] * e); w0.z = pk2(a[4] * e, a[5] * e); w0.w = pk2(a[6] * e, a[7] * e);
                w1.x = pk2(a[8] * e, a[9] * e); w1.y = pk2(a[10] * e, a[11] * e); w1.z = pk2(a[12] * e, a[13] * e); w1.w = pk2(a[14] * e, a[15] * e);
                *(LAS v4u*)(KT + lane * QS + 8 * w4) = w0; *(LAS v4u*)(KT + lane * QS + 32 + 8 * w4) = w1;
#pragma unroll
                for (int i = 0; i < 8; ++i) { KE[(8 * w4 + i) * TS + lane] = (bf16)f2bf(a[i] * ee); KE[(32 + 8 * w4 + i) * TS + lane] = (bf16)f2bf(a[8 + i] * ee); } }
        } else {
            float bb[8];
#pragma unroll
            for (int i = 0; i < 8; ++i) bb[i] = valid ? a[8 + i] : 0.f;
#pragma unroll
            for (int off = 1; off < 64; off <<= 1) {
#pragma unroll
                for (int i = 0; i < 8; ++i) { const float x = __shfl_up(bb[i], off); if (lane >= off) bb[i] += x; } }
            if (qwave) {
                if (lane == 63) {
#pragma unroll
                    for (int i = 0; i < 8; ++i) WT[8 * w4 + i] = bb[i]; }
                float o8[8];
#pragma unroll
                for (int i = 0; i < 8; ++i) o8[i] = valid ? a[i] * 0.17677669529663687f * __expf(bb[i]) : 0.f;
                v4u w0; w0.x = pk2(o8[0], o8[1]); w0.y = pk2(o8[2], o8[3]); w0.z = pk2(o8[4], o8[5]); w0.w = pk2(o8[6], o8[7]);
                *(LAS v4u*)(QT + lane * QS + 8 * w4) = w0;
            } else {
                float o8[8];
#pragma unroll
                for (int i = 0; i < 8; ++i) { const float tot = __shfl(bb[i], 63); o8[i] = valid ? a[i] * __expf(-bb[i]) : 0.f; KE[(8 * w4 + i) * TS + lane] = (bf16)f2bf(valid ? a[i] * __expf(tot - bb[i]) : 0.f); }
                v4u w0; w0.x = pk2(o8[0], o8[1]); w0.y = pk2(o8[2], o8[3]); w0.z = pk2(o8[4], o8[5]); w0.w = pk2(o8[6], o8[7]);
                *(LAS v4u*)(KT + lane * QS + 8 * w4) = w0;
            }
        }
        { const unsigned vv[4] = {valid ? vr.x : 0u, valid ? vr.y : 0u, valid ? vr.z : 0u, valid ? vr.w : 0u};
#pragma unroll
          for (int i = 0; i < 4; ++i) { VT[(8 * wave + 2 * i) * TS + lane] = (bf16)(vv[i] & 0xffffu); VT[(8 * wave + 2 * i + 1) * TS + lane] = (bf16)(vv[i] >> 16); } }
        if (c + 1 < nch) LA_LOAD(c + 1);
        LDS_WAIT(); __builtin_amdgcn_s_barrier(); asm volatile("" ::: "memory");
        { const int rb = wave >> 1;
#pragma unroll
          for (int ci = 0; ci < 2; ++ci) { const int cb = (wave & 1) * 2 + ci; f32x4 acc = {0.f, 0.f, 0.f, 0.f};
              if (cb <= rb) {
#pragma unroll
                  for (int ks = 0; ks < NKS; ++ks) { const bf16x8_t af = *(const LAS bf16x8_t*)(QT + (rb * 16 + c16) * QS + ks * 32 + 8 * g4), bf = *(const LAS bf16x8_t*)(KT + (cb * 16 + c16) * QS + ks * 32 + 8 * g4);
                      acc = __builtin_amdgcn_mfma_f32_16x16x32_bf16(af, bf, acc, 0, 0, 0); } }
#pragma unroll
              for (int r = 0; r < 4; ++r) { const int tt = rb * 16 + 4 * g4 + r, ss = cb * 16 + c16; AL[tt * TS + ss] = (bf16)f2bf(ss <= tt ? acc[r] : 0.f); } } }
        LDS_WAIT(); __builtin_amdgcn_s_barrier(); asm volatile("" ::: "memory");
        if (wave < 4) {
            const int rb = wave; const LAS bf16* STc = ST + cur * 64 * QS;
            f32x4 o[4];
#pragma unroll
            for (int cb = 0; cb < 4; ++cb) o[cb] = (f32x4){0.f, 0.f, 0.f, 0.f};
#pragma unroll
            for (int ks = 0; ks < 2; ++ks) { const bf16x8_t af = *(const LAS bf16x8_t*)(AL + (rb * 16 + c16) * TS + ks * 32 + 8 * g4);
#pragma unroll
                for (int cb = 0; cb < 4; ++cb) { const bf16x8_t bf = *(const LAS bf16x8_t*)(VT + (cb * 16 + c16) * TS + ks * 32 + 8 * g4); o[cb] = __builtin_amdgcn_mfma_f32_16x16x32_bf16(af, bf, o[cb], 0, 0, 0); } }
#pragma unroll
            for (int ks = 0; ks < NKS; ++ks) { const bf16x8_t af = *(const LAS bf16x8_t*)(QT + (rb * 16 + c16) * QS + ks * 32 + 8 * g4);
#pragma unroll
                for (int cb = 0; cb < 4; ++cb) { const bf16x8_t bf = *(const LAS bf16x8_t*)(STc + (cb * 16 + c16) * QS + ks * 32 + 8 * g4); o[cb] = __builtin_amdgcn_mfma_f32_16x16x32_bf16(af, bf, o[cb], 0, 0, 0); } }
#pragma unroll
            for (int r = 0; r < 4; ++r) {
                float s = (o[0][r] + o[1][r]) + (o[2][r] + o[3][r]); float y[4];
                if (RET) { s += __shfl_xor(s, 1); s += __shfl_xor(s, 2); s += __shfl_xor(s, 4); s += __shfl_xor(s, 8); const float mean = s * (1.0f / 64);
                    float q2 = 0.f;
#pragma unroll
                    for (int cb = 0; cb < 4; ++cb) { y[cb] = o[cb][r] - mean; q2 += y[cb] * y[cb]; }
                    q2 += __shfl_xor(q2, 1); q2 += __shfl_xor(q2, 2); q2 += __shfl_xor(q2, 4); q2 += __shfl_xor(q2, 8); const float rs = rsqrtf(q2 * (1.0f / 64) + EPS);
#pragma unroll
                    for (int cb = 0; cb < 4; ++cb) y[cb] *= rs;
                } else { float q2 = (o[0][r] * o[0][r] + o[1][r] * o[1][r]) + (o[2][r] * o[2][r] + o[3][r] * o[3][r]);
                    q2 += __shfl_xor(q2, 1); q2 += __shfl_xor(q2, 2); q2 += __shfl_xor(q2, 4); q2 += __shfl_xor(q2, 8); const float rs = rsqrtf(q2 * (1.0f / 64) + EPS);
#pragma unroll
                    for (int cb = 0; cb < 4; ++cb) y[cb] = o[cb][r] * rs; }
                const int tok = c * 64 + rb * 16 + 4 * g4 + r;
                if (tok < nt) { const size_t row = (size_t)(row0 + tok);
#pragma unroll
                    for (int cb = 0; cb < 4; ++cb) { const int dv = cb * 16 + c16; const float g = bf2f(ZM[row * NMIXP + (RET ? R_G : G_R) + h * 64 + dv]);
                        BR[row * D + (RET ? 256 : 512) + h * 64 + dv] = (bf16)f2bf(siluf_(g) * y[cb] * gnv[cb]); } }
            }
        } else {
            const int dvb = wave - 4; LAS bf16* STn = ST + (cur ^ 1) * 64 * QS;
            f32x4 ds[NKB];
#pragma unroll
            for (int cb = 0; cb < NKB; ++cb) ds[cb] = (f32x4){0.f, 0.f, 0.f, 0.f};
#pragma unroll
            for (int ks = 0; ks < 2; ++ks) { const bf16x8_t af = *(const LAS bf16x8_t*)(VT + (dvb * 16 + c16) * TS + ks * 32 + 8 * g4);
#pragma unroll
                for (int cb = 0; cb < NKB; ++cb) { const bf16x8_t bf = *(const LAS bf16x8_t*)(KE + (cb * 16 + c16) * TS + ks * 32 + 8 * g4); ds[cb] = __builtin_amdgcn_mfma_f32_16x16x32_bf16(af, bf, ds[cb], 0, 0, 0); } }
#pragma unroll
            for (int cb = 0; cb < NKB; ++cb) { const float eB = RET ? exp2f(lg2 * (float)nvc) : __expf(WT[cb * 16 + c16]);
#pragma unroll
                for (int r = 0; r < 4; ++r) { Sreg[cb][r] = eB * Sreg[cb][r] + ds[cb][r]; STn[(dvb * 16 + 4 * g4 + r) * QS + cb * 16 + c16] = (bf16)f2bf(Sreg[cb][r]); } }
        }
        LDS_WAIT(); __builtin_amdgcn_s_barrier(); asm volatile("" ::: "memory");
        cur ^= 1;
    }
#undef LA_LOAD
    if (wave >= 4) {
        float* so = C.out + (RET ? (smp ? O_RS + (((size_t)l * DB + b) * 4 + h) * DK * 64 : O_RP + (((size_t)l * BATCH + b) * 4 + h) * DK * 64)
                                 : (smp ? O_GS + (((size_t)l * DB + b) * 4 + h) * DK * 64 : O_GP + (((size_t)l * BATCH + b) * 4 + h) * DK * 64));
#pragma unroll
        for (int cb = 0; cb < NKB; ++cb)
#pragma unroll
            for (int r = 0; r < 4; ++r) so[(cb * 16 + c16) * 64 + (wave - 4) * 16 + 4 * g4 + r] = Sreg[cb][r];
    }
}
__device__ __forceinline__ void n2_la_chunked(const Ctx& C, int l) {
    const int bx = blockIdx.x;
    if (bx < 32) { const int b = (bx >> 2) & 3, h = bx & 3; if (bx < 16) la_chunked<64, true>(C, l, false, b, h); else la_chunked<32, false>(C, l, false, b, h); }
    else { for (int it = bx - 32; it < 256; it += C.G - 32) { const int b = (it >> 2) & 31, h = it & 3; if (it < 128) la_chunked<64, true>(C, l, true, b, h); else la_chunked<32, false>(C, l, true, b, h); } }
}
typedef float f32x16_t __attribute__((ext_vector_type(16)));
__device__ __forceinline__ int crow_(int r, int hi) { return (r & 3) + 8 * (r >> 2) + 4 * hi; }
__device__ __forceinline__ float swapmax32(float m) { auto rr = __builtin_amdgcn_permlane32_swap(__float_as_uint(m), __float_as_uint(m), false, false); return fmaxf(__uint_as_float(rr[0]), __uint_as_float(rr[1])); }
__device__ __forceinline__ float swapadd32(float m) { auto rr = __builtin_amdgcn_permlane32_swap(__float_as_uint(m), __float_as_uint(m), false, false); return __uint_as_float(rr[0]) + __uint_as_float(rr[1]); }
constexpr float LOG2E = 1.4426950408889634f;
__device__ __forceinline__ void attn_prompt_item(const Ctx& C, int l, int b, int h, int qb, float lam, float lam_init) {
    THREAD_IDS();
    constexpr int KS = 72;
    LAS bf16* Kt = (LAS bf16*)C.lds;
    LAS bf16* Vt = Kt + 2 * 64 * KS;
    LAS float* BT = (LAS float*)(Vt + 2 * 64 * KS);
    LAS float* OX = BT + 128;
    const bf16* ZM = WSP(bf16, WS_ZMIX); const bf16* QNB = WSP(bf16, WS_QNB); const bf16* KNB = WSP(bf16, WS_KNB); bf16* BR = WSP(bf16, WS_BR);
    const int r32 = lane & 31, hi = lane >> 5, qs = wave >> 1, s = wave & 1;
    const int q0 = qb * 128 + qs * 32; const int rowb = b * L;
    if (tid < 128) BT[tid] = (C.in[I_RELB][t5_bucket(tid) * 4 + h] - C.in[I_RELB][31 * 4 + h]) * LOG2E;
    pg8::bf16x8 qf[2];
#pragma unroll
    for (int d0 = 0; d0 < 2; ++d0) qf[d0] = *(const pg8::bf16x8*)(QNB + (size_t)(rowb + q0 + r32) * 256 + h * 64 + s * 32 + 16 * d0 + 8 * hi);
    const int pl = (lane & ~15) | ((lane & 8) >> 1) | ((lane & 4) << 1) | (lane & 3);
    const int NT = (min(128 * (qb + 1), L) + 63) >> 6;
    v4u kreg, vreg;
#define AT_LOAD(j) do { const size_t r_ = (size_t)(rowb + (j) * 64 + lane); kreg = *(const v4u*)(KNB + r_ * 256 + h * 64 + 8 * wave); vreg = *(const v4u*)(ZM + r_ * NMIXP + D_V + h * 64 + 8 * wave); } while (0)
#define AT_STORE(buf) do { *(LAS v4u*)(Kt + (buf) * 64 * KS + lane * KS + 8 * wave) = kreg; LAS bf16* v_ = Vt + (buf) * 64 * KS + (8 * wave) * KS + pl; \
        v_[0] = (bf16)(vreg.x & 0xffffu); v_[KS] = (bf16)(vreg.x >> 16); v_[2 * KS] = (bf16)(vreg.y & 0xffffu); v_[3 * KS] = (bf16)(vreg.y >> 16); \
        v_[4 * KS] = (bf16)(vreg.z & 0xffffu); v_[5 * KS] = (bf16)(vreg.z >> 16); v_[6 * KS] = (bf16)(vreg.w & 0xffffu); v_[7 * KS] = (bf16)(vreg.w >> 16); } while (0)
    AT_LOAD(0); AT_STORE(0); if (NT > 1) AT_LOAD(1);
    LDS_WAIT(); __builtin_amdgcn_s_barrier(); asm volatile("" ::: "memory");
    float m = -INFINITY, lsum = 0.f; f32x16_t o[2];
#pragma unroll
    for (int i = 0; i < 16; ++i) { o[0][i] = 0.f; o[1][i] = 0.f; }
    for (int j = 0; j < NT; ++j) {
        const int k0 = 64 * j, buf = j & 1;
        if (k0 <= q0 + 31) {
            const LAS bf16* kb = Kt + buf * 64 * KS; const LAS bf16* vb = Vt + buf * 64 * KS;
            f32x16_t p0, p1;
#pragma unroll
            for (int i = 0; i < 16; ++i) { p0[i] = 0.f; p1[i] = 0.f; }
#pragma unroll
            for (int d0 = 0; d0 < 2; ++d0) { const pg8::bf16x8 a0 = *(const LAS pg8::bf16x8*)(kb + r32 * KS + s * 32 + 16 * d0 + 8 * hi), a1 = *(const LAS pg8::bf16x8*)(kb + (32 + r32) * KS + s * 32 + 16 * d0 + 8 * hi);
                p0 = __builtin_amdgcn_mfma_f32_32x32x16_bf16(a0, qf[d0], p0, 0, 0, 0); p1 = __builtin_amdgcn_mfma_f32_32x32x16_bf16(a1, qf[d0], p1, 0, 0, 0); }
            if (q0 - k0 - 63 < 113) {
#pragma unroll
                for (int r = 0; r < 16; ++r) { const int n0 = (q0 + r32) - (k0 + crow_(r, hi)), n1 = n0 - 32;
                    p0[r] = n0 < 0 ? -INFINITY : p0[r] + (n0 < 128 ? BT[n0] : 0.f); p1[r] = n1 < 0 ? -INFINITY : p1[r] + (n1 < 128 ? BT[n1] : 0.f); } }
            float mt = fmaxf(p0[0], p1[0]);
#pragma unroll
            for (int r = 1; r < 16; ++r) mt = fmaxf(mt, fmaxf(p0[r], p1[r]));
            mt = swapmax32(mt);
            const float mn = fmaxf(m, mt);
            if (__any(mn > m)) { const float al = exp2f(m - mn);
#pragma unroll
                for (int i = 0; i < 16; ++i) { o[0][i] *= al; o[1][i] *= al; }
                lsum *= al; m = mn; }
            float ps = 0.f;
#pragma unroll
            for (int r = 0; r < 16; ++r) { p0[r] = exp2f(p0[r] - m); p1[r] = exp2f(p1[r] - m); ps += p0[r] + p1[r]; }
            lsum += ps;
            pg8::bf16x8 pb[4];
#pragma unroll
            for (int ks = 0; ks < 4; ++ks) { v4u w;
                if (ks < 2) { w.x = pg8::cvt_pk_bf16(p0[8 * ks], p0[8 * ks + 1]); w.y = pg8::cvt_pk_bf16(p0[8 * ks + 2], p0[8 * ks + 3]); w.z = pg8::cvt_pk_bf16(p0[8 * ks + 4], p0[8 * ks + 5]); w.w = pg8::cvt_pk_bf16(p0[8 * ks + 6], p0[8 * ks + 7]); }
                else { w.x = pg8::cvt_pk_bf16(p1[8 * ks - 16], p1[8 * ks - 15]); w.y = pg8::cvt_pk_bf16(p1[8 * ks - 14], p1[8 * ks - 13]); w.z = pg8::cvt_pk_bf16(p1[8 * ks - 12], p1[8 * ks - 11]); w.w = pg8::cvt_pk_bf16(p1[8 * ks - 10], p1[8 * ks - 9]); }
                pb[ks] = __builtin_bit_cast(pg8::bf16x8, w); }
#pragma unroll
            for (int d0 = 0; d0 < 2; ++d0)
#pragma unroll
                for (int ks = 0; ks < 4; ++ks) { const pg8::bf16x8 af = *(const LAS pg8::bf16x8*)(vb + (32 * d0 + r32) * KS + 16 * ks + 8 * hi); o[d0] = __builtin_amdgcn_mfma_f32_32x32x16_bf16(af, pb[ks], o[d0], 0, 0, 0); }
        }
        if (j + 1 < NT) AT_STORE(buf ^ 1);
        if (j + 2 < NT) AT_LOAD(j + 2);
        LDS_WAIT(); __builtin_amdgcn_s_barrier(); asm volatile("" ::: "memory");
    }
#undef AT_LOAD
#undef AT_STORE
    lsum = swapadd32(lsum); const float inv = 1.0f / lsum;
    LAS float* ox = OX + (qs * 32 + r32) * 65;
    if (s == 1) {
#pragma unroll
        for (int d0 = 0; d0 < 2; ++d0)
#pragma unroll
            for (int r = 0; r < 16; ++r) ox[32 * d0 + crow_(r, hi)] = o[d0][r] * inv; }
    LDS_WAIT(); __builtin_amdgcn_s_barrier(); asm volatile("" ::: "memory");
    if (s == 0) {
        float ss = 0.f;
#pragma unroll
        for (int d0 = 0; d0 < 2; ++d0)
#pragma unroll
            for (int r = 0; r < 16; ++r) { const float v = o[d0][r] * inv - lam * ox[32 * d0 + crow_(r, hi)]; o[d0][r] = v; ss += v * v; }
        ss = swapadd32(ss); const float rs = rsqrtf(ss * (1.0f / 64) + EPS) * (1.0f - lam_init);
        const int qpos = q0 + r32;
        if (qpos < L) { bf16* brp = BR + (size_t)(rowb + qpos) * D + 768 + h * 64;
#pragma unroll
            for (int d0 = 0; d0 < 2; ++d0)
#pragma unroll
                for (int r4 = 0; r4 < 4; ++r4) { const int dv = 32 * d0 + 8 * r4 + 4 * hi; const float* sl = C.in[I_SUBLN] + l * 64 + dv;
                    const unsigned w0 = pk2(o[d0][4 * r4] * rs * sl[0], o[d0][4 * r4 + 1] * rs * sl[1]), w1 = pk2(o[d0][4 * r4 + 2] * rs * sl[2], o[d0][4 * r4 + 3] * rs * sl[3]);
                    *(unsigned long long*)(brp + dv) = (unsigned long long)w0 | ((unsigned long long)w1 << 32); } }
    }
    LDS_WAIT(); __builtin_amdgcn_s_barrier(); asm volatile("" ::: "memory");
}
__device__ __forceinline__ void n2_attn_prompt_mfma(const Ctx& C, int l, float lam_init) {
    THREAD_IDS();
    const float lam = lam_of(C, l, lam_init);
    unsigned* qw = (unsigned*)(C.ws + WS_CTL) + CW_QUEUE + 64 * l;
    volatile LAS int* slot = (volatile LAS int*)(C.lds + MISC_OFF + 64);
    constexpr int NQB = (L + 127) / 128;
    for (;;) {
        if (tid == 0) slot[0] = (int)__hip_atomic_fetch_add(qw, 1u, __ATOMIC_RELAXED, __HIP_MEMORY_SCOPE_AGENT);
        __syncthreads();
        const int it = slot[0];
        if (it >= 16 * NQB) break;
        attn_prompt_item(C, l, (it & 15) >> 2, it & 3, NQB - 1 - (it >> 4), lam, lam_init);
    }
}

template <int l> __device__ __forceinline__ void layer_fwd(const Ctx& C, const XcdBarrier& bar) {
#define GRID_BAR() xcd_barrier<false>(bar)
    LAS unsigned char* ring = C.lds + RING_OFF;
    float* SS = WSP(float, WS_SS); float* H = WSP(float, WS_H); bf16* HB = WSP(bf16, WS_HB); bf16* ACT = WSP(bf16, WS_ACT); bf16* ZMIX = WSP(bf16, WS_ZMIX); bf16* GATES = WSP(bf16, WS_GATES);
    bf16* BR = WSP(bf16, WS_BR); bf16* MERGED = WSP(bf16, WS_MERGED);
    constexpr float lam_init = l == 0 ? 0.2f : 0.35550906759096926f;
    constexpr bool last = (l == DEPTH - 1);
    { pg8::Gemm g{HB, WSP(bf16, WS_W1 + (size_t)(l * 2 + 0) * SZ_W1), D, D, D}; pg8::StaticOrder S; S.init(M, 2 * DFF, C.G, (int)blockIdx.x);
      EpiGLU E{ACT, SS + (size_t)(l * 3 + 0) * M * 16}; pg8::gemm_phase<EpiGLU, pg8::StaticOrder, true, true>(ring, g, S, E); }
    GRID_BAR();
    { pg8::Gemm g{ACT, WSP(bf16, WS_WD + (size_t)(l * 2 + 0) * SZ_WD), DFF, DFF, DFF}; pg8::StaticOrder S; S.init(M, D, C.G, (int)blockIdx.x);
      EpiRes<false, 1> E{H, HB, SS + (size_t)(l * 3 + 1) * M * 16, nullptr}; pg8::gemm_phase<EpiRes<false, 1>, pg8::StaticOrder, true, true>(ring, g, S, E); }
    GRID_BAR();
    { pg8::Gemm g{HB, WSP(bf16, WS_WIN + (size_t)l * SZ_WIN), D, D, D}; pg8::StaticOrder S; S.init(M, NINP, C.G, (int)blockIdx.x);
      EpiZ E{ZMIX, GATES, SS + (size_t)(l * 3 + 1) * M * 16, WSP(float, WS_BINP) + l * NINP}; pg8::gemm_phase<EpiZ, pg8::StaticOrder, true, true>(ring, g, S, E); }
    GRID_BAR();
    n1_prep(C, l);
    GRID_BAR();
    n2_attn_sample(C, l, lam_init);
    n2_la_chunked(C, l);
    n2_attn_prompt_mfma(C, l, lam_init);
    n2_conv(C, l);
    GRID_BAR();
    { pg8::Gemm g{BR, WSP(bf16, WS_WBR + (size_t)l * SZ_WBR), D, 256, 256}; pg8::MergeOrder S; S.init(M, C.G, (int)blockIdx.x);
      EpiMerge E{MERGED, GATES}; pg8::gemm_phase<EpiMerge, pg8::MergeOrder, true, true>(ring, g, S, E); }
    GRID_BAR();
    { pg8::Gemm g{MERGED, WSP(bf16, WS_WOUT + (size_t)l * SZ_WOUT), D, D, D}; pg8::StaticOrder S; S.init(M, D, C.G, (int)blockIdx.x);
      EpiRes<false, 2> E{H, HB, SS + (size_t)(l * 3 + 2) * M * 16, nullptr}; pg8::gemm_phase<EpiRes<false, 2>, pg8::StaticOrder, true, true>(ring, g, S, E); }
    GRID_BAR();
    { pg8::Gemm g{HB, WSP(bf16, WS_W1 + (size_t)(l * 2 + 1) * SZ_W1), D, D, D}; pg8::StaticOrder S; S.init(M, 2 * DFF, C.G, (int)blockIdx.x);
      EpiGLU E{ACT, SS + (size_t)(l * 3 + 2) * M * 16}; pg8::gemm_phase<EpiGLU, pg8::StaticOrder, true, true>(ring, g, S, E); }
    GRID_BAR();
    { pg8::Gemm g{ACT, WSP(bf16, WS_WD + (size_t)(l * 2 + 1) * SZ_WD), DFF, DFF, DFF}; pg8::StaticOrder S; S.init(M, D, C.G, (int)blockIdx.x);
      EpiRes<last, 1> E{H, HB, last ? nullptr : SS + (size_t)((l + 1) * 3) * M * 16, C.out};
      pg8::gemm_phase<EpiRes<last, 1>, pg8::StaticOrder, true, true>(ring, g, S, E); }
#undef GRID_BAR
}

__global__ void __launch_bounds__(NWAVES * 64, 2) fwd(Params P) {
    extern __shared__ __attribute__((aligned(16))) unsigned char lds[];
    Ctx C;
    C.in = P.in; C.out = P.out; C.ws = P.ws; C.lds = (LAS unsigned char*)lds;
    C.G = gridDim.x;
    volatile LAS unsigned* MISC = (volatile LAS unsigned*)(C.lds + MISC_OFF);
    for (int u = threadIdx.x; u < (LDS_BYTES - LDSCTL_OFF) / 4; u += NWAVES * 64) ((LAS unsigned*)(C.lds + LDSCTL_OFF))[u] = 0u;
    __syncthreads();
    unsigned* ctl = (unsigned*)(C.ws + WS_CTL);
    XcdBarrier bar = xcd_barrier_post(ctl + CW_BAR, MISC + 8);
    p0_prologue(C, P);
    xcd_barrier<true>(bar);
    layer_fwd<0>(C, bar);
    xcd_barrier<false>(bar);
    layer_fwd<1>(C, bar);
}

extern "C" void kernel_launch(void* const* d_in, const int* in_sizes, int n_in, void* d_out, int out_size, void* d_ws, size_t ws_size, hipStream_t stream) {
    static int grid = 0;
    if (grid == 0) {
        if (n_in != N_INPUTS || (size_t)out_size != O_END || ws_size < WS_END) { fprintf(stderr, "kernel_launch: unexpected shapes: n_in %d out %d (want %zu) ws %zu (want %zu)\n", n_in, out_size, (size_t)O_END, ws_size, (size_t)WS_END); grid = -1; return; }
        int dev = 0, cus = 0, per_cu = 0;
        if (hipGetDevice(&dev) != hipSuccess || hipDeviceGetAttribute(&cus, hipDeviceAttributeMultiprocessorCount, dev) != hipSuccess) { grid = -1; return; }
        if (hipFuncSetAttribute((const void*)fwd, hipFuncAttributeMaxDynamicSharedMemorySize, LDS_BYTES) != hipSuccess) { fprintf(stderr, "kernel_launch: hipFuncSetAttribute failed\n"); grid = -1; return; }
        if (hipOccupancyMaxActiveBlocksPerMultiprocessor(&per_cu, (const void*)fwd, NWAVES * 64, LDS_BYTES) != hipSuccess || per_cu < 1) { fprintf(stderr, "kernel_launch: occupancy query says %d blocks per CU\n", per_cu); }
        (void)hipGetLastError();
        grid = cus;
    }
    if (grid < 0) return;
    if (hipMemsetAsync((char*)d_ws + WS_CTL, 0, CTL_ZERO_BYTES, stream) != hipSuccess) return;
    Params p{};
    for (int i = 0; i < N_INPUTS; ++i) p.in[i] = (const float*)d_in[i];
    p.out = (float*)d_out; p.ws = (unsigned char*)d_ws;
    for (int i = 0; i < 32; ++i) p.inv_freq[i] = (float)pow(10000.0, -(double)i / 32.0);
    hipLaunchKernelGGL(fwd, dim3(grid), dim3(NWAVES * 64), LDS_BYTES, stream, p);
}
```

```cpp
#include <hip/hip_runtime.h>
#include <cstdio>
#include <cstdint>
#include <cmath>

namespace pg8 {
#define PG8_LAS __attribute__((address_space(3)))
typedef unsigned short bf16_t;
typedef short bf16x8 __attribute__((ext_vector_type(8)));
typedef float f32x4 __attribute__((ext_vector_type(4)));
typedef unsigned u32x4 __attribute__((ext_vector_type(4)));
constexpr int BM = 256, BK = 64, HALF = 128, HTB = HALF * BK * 2  , STAGE_BYTES = 8 * HTB, NXCD = 8, WGM = 8;

__host__ __device__ __forceinline__ int lds_byte(int r, int c) { const int st = (r >> 4) * 2 + (c >> 5), rr = r & 15, cc = c & 31, ob = rr * 64 + cc * 2; return st * 1024 + (ob ^ (((ob >> 9) & 1) << 5)); }
__host__ __device__ __forceinline__ void stage_rc(int b, int& R, int& C) { const int st = b / 1024, sb = b % 1024, swz = sb ^ (((sb >> 9) & 1) << 5); R = (st >> 1) * 16 + swz / 64; C = (st & 1) * 32 + (swz % 64) / 2; }
__host__ __device__ __forceinline__ int perm32(int rho) { const int n = rho >> 4, i = rho & 15; return 8 * (i >> 2) + 4 * n + (i & 3); }

struct Unit { int pm, pn, acol; };
struct Gemm { const bf16_t* A; const bf16_t* Bt; int lda, ldb, K; };

struct StaticOrder {
    int nM, nN, nwg, G, c;
    __host__ __device__ void init(int M, int N, int G_, int c_) { nM = M / BM; nN = N / BM; nwg = nM * nN; G = G_; c = c_; }
    __host__ __device__ bool next(int i, Unit& u) const {
        const long L = (long)i * G + c; if (L >= nwg) return false;
        int wgid = (int)L; { const int q = nwg / NXCD, r = nwg % NXCD, xcd = wgid % NXCD, off = wgid / NXCD; wgid = (xcd < r ? xcd * (q + 1) : r * (q + 1) + (xcd - r) * q) + off; }
        const int nig = WGM * nN, gid = wgid / nig, fm = gid * WGM, gsz = (nM - fm) < WGM ? (nM - fm) : WGM;
        u.pm = fm + ((wgid % nig) % gsz); u.pn = (wgid % nig) / gsz; u.acol = 0; return true;
    }
};
struct MergeOrder {
    int ntile, G, c;
    __host__ __device__ void init(int M, int G_, int c_) { ntile = (M / BM) * 4; G = G_; c = c_; }
    __host__ __device__ bool next(int i, Unit& u) const {
        const int T = (i >> 2) * G + c; if (T >= ntile) return false;
        const int n = i & 3; u.pm = T >> 2; u.pn = n * 4 + (T & 3); u.acol = n * 256; return true;
    }
};

__device__ __forceinline__ unsigned cvt_pk_bf16(float lo, float hi) { unsigned r; asm volatile("v_cvt_pk_bf16_f32 %0, %1, %2" : "=v"(r) : "v"(lo), "v"(hi)); return r; }

template <class Epi, class Sched, bool ALIGN_EPI = false, bool SP2 = false>
__device__ __forceinline__ void gemm_phase(PG8_LAS unsigned char* lds, const Gemm g, const Sched& S, const Epi& E) {
    int tid_ = threadIdx.x; asm volatile("" : "+v"(tid_));
    const int tid = tid_, wid = __builtin_amdgcn_readfirstlane(tid >> 6), lane = tid & 63, wr = wid >> 2, wc = wid & 3, fr = lane & 15, fq = lane >> 4;
    const int nt = g.K / BK;
    unsigned voffA[2], voffB[2];
#pragma unroll
    for (int i = 0; i < 2; ++i) { int R, C; stage_rc(tid * 16 + i * 8192, R, C); const int Rb = Epi::PERM ? ((R & ~31) + perm32(R & 31)) : R;
        voffA[i] = (unsigned)(R * g.lda + C) * 2u; voffB[i] = (unsigned)(Rb * g.ldb + C) * 2u; }
    const size_t kstep = (size_t)(BK * 2);
    const size_t hstepA = (size_t)HALF * g.lda * 2, hstepB = (size_t)HALF * g.ldb * 2;
    const size_t tstepA = 2 * hstepA, tstepB = 2 * hstepB;
    const unsigned ldsw = (unsigned)wid * 1024u;
    const int aoff = lds_byte(wr * 64 + fr, fq * 8), boff = lds_byte(wc * 32 + fr, fq * 8);
#define PG8_SA(b, h) (((b) * 2 + (h)) * HTB)
#define PG8_SB(b, h) ((4 + (b) * 2 + (h)) * HTB)
#define PG8_STAGE(bufoff, gbase, voff) do { _Pragma("unroll") for (int _i = 0; _i < 2; ++_i) \
        __builtin_amdgcn_global_load_lds((const unsigned*)((const char*)(gbase) + (voff)[_i]), (PG8_LAS unsigned*)(lds + (bufoff) + ldsw + _i * 8192), 16, 0, 0); } while (0)
#define PG8_LDA(dst, b, h) do { _Pragma("unroll") for (int m = 0; m < 4; ++m) _Pragma("unroll") for (int k = 0; k < 2; ++k) dst[m][k] = *(const PG8_LAS bf16x8*)(lds + PG8_SA(b, h) + aoff + m * 2048 + k * 1024); } while (0)
#define PG8_LDB(dst, b, h) do { _Pragma("unroll") for (int n = 0; n < 2; ++n) _Pragma("unroll") for (int k = 0; k < 2; ++k) dst[n][k] = *(const PG8_LAS bf16x8*)(lds + PG8_SB(b, h) + boff + n * 2048 + k * 1024); } while (0)
#define PG8_MMA(ai, bj, At, Bt) do { __builtin_amdgcn_s_setprio(1); _Pragma("unroll") for (int m = 0; m < 4; ++m) _Pragma("unroll") for (int n = 0; n < 2; ++n) _Pragma("unroll") for (int k = 0; k < 2; ++k) \
        acc[ai][bj][m][n] = __builtin_amdgcn_mfma_f32_16x16x32_bf16(Bt[n][k], At[m][k], acc[ai][bj][m][n], 0, 0, 0); __builtin_amdgcn_s_setprio(0); } while (0)
#define PG8_WAIT_V(n) asm volatile("s_waitcnt vmcnt(" #n ")" ::: "memory")
#define PG8_WAIT_L(n) asm volatile("s_waitcnt lgkmcnt(" #n ")" ::: "memory")
#define PG8_BAR __builtin_amdgcn_s_barrier()
#define PG8_SCHED __builtin_amdgcn_sched_barrier(0)
    Unit cur, nxt; int ui = 0;
    if (!S.next(0, cur)) return;
    f32x4 acc[2][2][4][2];
#pragma unroll
    for (int a = 0; a < 2; ++a)
#pragma unroll
        for (int b = 0; b < 2; ++b)
#pragma unroll
            for (int m = 0; m < 4; ++m)
#pragma unroll
                for (int n = 0; n < 2; ++n) acc[a][b][m][n] = (f32x4){0.f, 0.f, 0.f, 0.f};
    bf16x8 At[4][2], B0[2][2], B1[2][2];
    const char* cA = (const char*)g.A + (size_t)cur.pm * tstepA + (size_t)cur.acol * 2; const char* cB = (const char*)g.Bt + (size_t)cur.pn * tstepB;
    if constexpr (SP2) {
        PG8_STAGE(PG8_SB(0, 0), cB, voffB); PG8_STAGE(PG8_SB(0, 1), cB + hstepB, voffB); PG8_STAGE(PG8_SA(0, 0), cA, voffA); PG8_STAGE(PG8_SA(0, 1), cA + hstepA, voffA);
        if (wr == 1) PG8_BAR;
        PG8_WAIT_V(2); PG8_BAR;
        PG8_STAGE(PG8_SB(1, 0), cB + kstep, voffB); PG8_STAGE(PG8_SA(1, 0), cA + kstep, voffA); PG8_STAGE(PG8_SB(1, 1), cB + hstepB + kstep, voffB);
        PG8_WAIT_V(6); PG8_BAR;
    } else {
        PG8_STAGE(PG8_SB(0, 0), cB, voffB); PG8_STAGE(PG8_SA(0, 0), cA, voffA); PG8_STAGE(PG8_SB(0, 1), cB + hstepB, voffB); PG8_STAGE(PG8_SA(0, 1), cA + hstepA, voffA);
        if (wr == 1) PG8_BAR;
        PG8_WAIT_V(4); PG8_BAR;
        PG8_STAGE(PG8_SB(1, 0), cB + kstep, voffB); PG8_STAGE(PG8_SA(1, 0), cA + kstep, voffA); PG8_STAGE(PG8_SB(1, 1), cB + hstepB + kstep, voffB);
        PG8_WAIT_V(6); PG8_BAR;
    }
    for (;;) {
        const bool has_next = S.next(ui + 1, nxt);
        const char* nA = has_next ? (const char*)g.A + (size_t)nxt.pm * tstepA + (size_t)nxt.acol * 2 : cA; const char* nB = has_next ? (const char*)g.Bt + (size_t)nxt.pn * tstepB : cB;
        for (int t = 0; t < nt; t += 2) {
            const bool last = (t == nt - 2);
            const char* a1 = cA + (size_t)(t + 1) * kstep;
            const char* a2 = last ? nA : cA + (size_t)(t + 2) * kstep; const char* b2 = last ? nB : cB + (size_t)(t + 2) * kstep;
            const char* a3 = a2 + kstep; const char* b3 = b2 + kstep;
            if constexpr (SP2) {
            PG8_LDB(B0, 0, 0); PG8_LDB(B1, 0, 1); PG8_SCHED; PG8_LDA(At, 0, 0); PG8_STAGE(PG8_SA(1, 1), a1 + hstepA, voffA);
            PG8_WAIT_V(8); PG8_WAIT_L(0); PG8_BAR; PG8_MMA(0, 0, At, B0); PG8_MMA(0, 1, At, B1); PG8_BAR; PG8_SCHED;
            PG8_LDA(At, 0, 1); PG8_STAGE(PG8_SB(0, 0), b2, voffB); PG8_STAGE(PG8_SB(0, 1), b2 + hstepB, voffB); PG8_STAGE(PG8_SA(0, 0), a2, voffA);
            PG8_WAIT_V(8); PG8_WAIT_L(0); PG8_BAR; PG8_MMA(1, 0, At, B0); PG8_MMA(1, 1, At, B1); PG8_BAR; PG8_SCHED;
            PG8_LDB(B0, 1, 0); PG8_LDB(B1, 1, 1); PG8_SCHED; PG8_LDA(At, 1, 0); PG8_STAGE(PG8_SA(0, 1), a2 + hstepA, voffA);
            PG8_WAIT_V(8); PG8_WAIT_L(0); PG8_BAR; PG8_MMA(0, 0, At, B0); PG8_MMA(0, 1, At, B1); PG8_BAR; PG8_SCHED;
            PG8_LDA(At, 1, 1); PG8_STAGE(PG8_SB(1, 0), b3, voffB); PG8_STAGE(PG8_SB(1, 1), b3 + hstepB, voffB); PG8_STAGE(PG8_SA(1, 0), a3, voffA);
            PG8_WAIT_V(8); PG8_WAIT_L(0); PG8_BAR; PG8_MMA(1, 0, At, B0); PG8_MMA(1, 1, At, B1); PG8_BAR; PG8_SCHED;
            } else {
            PG8_LDB(B0, 0, 0); PG8_SCHED; PG8_LDA(At, 0, 0); PG8_STAGE(PG8_SA(1, 1), a1 + hstepA, voffA);
            PG8_WAIT_L(8); PG8_BAR; PG8_WAIT_L(0); PG8_MMA(0, 0, At, B0); PG8_BAR; PG8_SCHED;
            PG8_LDB(B1, 0, 1); PG8_STAGE(PG8_SB(0, 0), b2, voffB);
            PG8_BAR; PG8_WAIT_L(0); PG8_MMA(0, 1, At, B1); PG8_BAR;
            PG8_LDA(At, 0, 1); PG8_STAGE(PG8_SA(0, 0), a2, voffA);
            PG8_BAR; PG8_WAIT_L(0); PG8_MMA(1, 0, At, B0); PG8_BAR; PG8_SCHED;
            PG8_STAGE(PG8_SB(0, 1), b2 + hstepB, voffB);
            PG8_WAIT_V(6); PG8_BAR; PG8_MMA(1, 1, At, B1); PG8_BAR;
            PG8_LDB(B0, 1, 0); PG8_SCHED; PG8_LDA(At, 1, 0); PG8_STAGE(PG8_SA(0, 1), a2 + hstepA, voffA);
            PG8_WAIT_L(8); PG8_BAR; PG8_WAIT_L(0); PG8_MMA(0, 0, At, B0); PG8_BAR; PG8_SCHED;
            PG8_LDB(B1, 1, 1); PG8_STAGE(PG8_SB(1, 0), b3, voffB);
            PG8_BAR; PG8_WAIT_L(0); PG8_MMA(0, 1, At, B1); PG8_BAR;
            PG8_LDA(At, 1, 1); PG8_STAGE(PG8_SA(1, 0), a3, voffA);
            PG8_BAR; PG8_WAIT_L(0); PG8_MMA(1, 0, At, B0); PG8_BAR; PG8_SCHED;
            PG8_STAGE(PG8_SB(1, 1), b3 + hstepB, voffB);
            PG8_WAIT_V(6); PG8_BAR; PG8_MMA(1, 1, At, B1); PG8_BAR;
            }
        }
        if constexpr (ALIGN_EPI) { if (wr == 0) PG8_BAR; }
        E(acc, cur, wr, wc, fr, fq);
        if (!has_next) break;
#pragma unroll
        for (int a = 0; a < 2; ++a)
#pragma unroll
            for (int b = 0; b < 2; ++b)
#pragma unroll
                for (int m = 0; m < 4; ++m)
#pragma unroll
                    for (int n = 0; n < 2; ++n) acc[a][b][m][n] = (f32x4){0.f, 0.f, 0.f, 0.f};
        cur = nxt; cA = nA; cB = nB; ++ui;
        if constexpr (ALIGN_EPI) { if (wr == 1) PG8_BAR; }
    }
    PG8_WAIT_V(0);
    if constexpr (!ALIGN_EPI) { if (wr == 0) PG8_BAR; }
    PG8_BAR;
#undef PG8_SA
#undef PG8_SB
#undef PG8_STAGE
#undef PG8_LDA
#undef PG8_LDB
#undef PG8_MMA
#undef PG8_WAIT_V
#undef PG8_WAIT_L
#undef PG8_BAR
#undef PG8_SCHED
}
}

constexpr int NWAVES = 8;
constexpr int D = 1024, DFF = 2816, NIN = 7184, NMIX = 3088, NMIXP = 3328, NGATE = 4096, NINP = NMIXP + NGATE;
constexpr int SEQ = 4096, NMETA = 16, L = SEQ + NMETA, BATCH = 4, DB = 32, DS = 8, PAST = 8192, PAGE = 128, NPAGES = PAST / PAGE, NPOOL = 2560, DEPTH = 2;
constexpr int MP = BATCH * L, MS = DB * DS, MR = MP + MS, M = 16896;
constexpr int NPOS = L + DS;
constexpr float EPS = 1e-6f;
constexpr int C_A = 0, C_G = 256, R_Q = 512, R_K = 768, R_V = 1024, R_G = 1280, G_Q = 1536, G_K = 1664, G_V = 1792, G_R = 2048, G_LOW = 2304, D_Q = 2320, D_K = 2576, D_V = 2832;
constexpr size_t O_YP = 0, O_YS = O_YP + (size_t)BATCH * SEQ * D, O_KP = O_YS + (size_t)MS * D, O_VP = O_KP + (size_t)DEPTH * MP * 256, O_KS = O_VP + (size_t)DEPTH * MP * 256,
                 O_VS = O_KS + (size_t)DEPTH * MS * 256, O_RP = O_VS + (size_t)DEPTH * MS * 256, O_RS = O_RP + (size_t)DEPTH * BATCH * 4 * 64 * 64, O_GP = O_RS + (size_t)DEPTH * DB * 4 * 64 * 64,
                 O_GS = O_GP + (size_t)DEPTH * BATCH * 4 * 32 * 64, O_CP = O_GS + (size_t)DEPTH * DB * 4 * 32 * 64, O_CS = O_CP + (size_t)DEPTH * BATCH * 30 * 256, O_END = O_CS + (size_t)DEPTH * DB * 30 * 256;
enum { I_XP = 0, I_XS, I_CK, I_CV, I_PT, I_SRET, I_SGLA, I_SCONV, I_META, I_RELB, I_NF1, I_F1G, I_F1U, I_F1D, I_NMIX, I_WIN, I_BIN, I_CW, I_CB, I_CLG, I_CLB, I_RGN, I_GAW, I_GAB, I_GGN,
       I_QN, I_KN, I_LQ1, I_LK1, I_LQ2, I_LK2, I_SUBLN, I_WBR, I_WOUT, I_NF2, I_F2G, I_F2U, I_F2D, N_INPUTS };

constexpr size_t MiB = 1u << 20;
constexpr size_t WS_CTL = 0, CTL_ZERO_BYTES = 1 * MiB;
constexpr size_t SZ_SS = (size_t)M * 16 * 4;
constexpr size_t SZ_W1 = (size_t)2 * DFF * D * 2, SZ_WD = (size_t)D * DFF * 2, SZ_WIN = (size_t)NINP * D * 2, SZ_WBR = (size_t)4 * D * 256 * 2, SZ_WOUT = (size_t)D * D * 2;
constexpr size_t WS_W1 = 4 * MiB;
constexpr size_t WS_WD = WS_W1 + 4 * SZ_W1;
constexpr size_t WS_WIN = WS_WD + 4 * SZ_WD;
constexpr size_t WS_WBR = WS_WIN + 2 * SZ_WIN;
constexpr size_t WS_WOUT = WS_WBR + 2 * SZ_WBR;
constexpr size_t WS_BINP = WS_WOUT + 2 * SZ_WOUT;
constexpr size_t WS_ROPE = WS_BINP + 64 * 1024;
constexpr size_t WS_SS = WS_ROPE + 2 * MiB;
constexpr size_t WS_H = 128 * MiB;
constexpr size_t WS_HB = WS_H + (size_t)M * D * 4;
constexpr size_t WS_ACT = WS_HB + (size_t)M * D * 2;
constexpr size_t WS_ZMIX = WS_ACT + (size_t)M * DFF * 2;
constexpr size_t WS_GATES = WS_ZMIX + (size_t)M * NMIXP * 2;
constexpr size_t WS_BR = WS_GATES + (size_t)M * NGATE * 2;
constexpr size_t WS_MERGED = WS_BR + (size_t)M * D * 2;
constexpr size_t WS_UBUF = WS_MERGED + (size_t)M * D * 2;
constexpr size_t WS_RQ = WS_UBUF + (size_t)M * 256 * 4, WS_RK = WS_RQ + (size_t)M * 256 * 4, WS_QN = WS_RK + (size_t)M * 256 * 4, WS_KN = WS_QN + (size_t)M * 256 * 4, WS_VB = WS_KN + (size_t)M * 256 * 4;
constexpr size_t WS_LDEC = WS_VB + (size_t)M * 256 * 4;
constexpr size_t WS_QNB = WS_LDEC + (size_t)M * 128 * 4;
constexpr size_t WS_KNB = WS_QNB + (size_t)M * 256 * 2;
constexpr size_t WS_PART = WS_KNB + (size_t)M * 256 * 2;
constexpr size_t WS_END = WS_PART + (size_t)DB * 4 * 16 * 16 * 68 * 4;
static_assert(WS_ROPE + 2 * NPOS * 32 * 4 <= WS_SS && WS_SS + 6 * SZ_SS <= WS_H, "weights region overflows");
constexpr int CW_BAR = 4096, CW_QUEUE = 8192;

constexpr int RING_OFF = 0, RING_BYTES = 131072;
constexpr int LDSCTL_OFF = 144384, MISC_OFF = LDSCTL_OFF + 320;
constexpr int LDS_BYTES = 147456;
static_assert(MISC_OFF + 128 <= LDS_BYTES, "LDS map");

#define GAS __attribute__((address_space(1)))
#define LAS __attribute__((address_space(3)))
typedef unsigned short bf16;
typedef unsigned v4u __attribute__((ext_vector_type(4)));
typedef float f32x4 __attribute__((ext_vector_type(4)));
#define LDS_WAIT() asm volatile("s_waitcnt lgkmcnt(0)" ::: "memory")
#define VM_WAIT() asm volatile("s_waitcnt vmcnt(0)" ::: "memory")
__device__ __forceinline__ unsigned f2bf(float f) { unsigned u = __builtin_bit_cast(unsigned, f); return (u + 0x7fffu + ((u >> 16) & 1u)) >> 16; }
__device__ __forceinline__ unsigned pk2(float lo, float hi) { return f2bf(lo) | (f2bf(hi) << 16); }
__device__ __forceinline__ float bf2f(bf16 b) { return __builtin_bit_cast(float, ((unsigned)b) << 16); }
__device__ __forceinline__ float bflo(unsigned w) { return __builtin_bit_cast(float, w << 16); }
__device__ __forceinline__ float bfhi(unsigned w) { return __builtin_bit_cast(float, w & 0xffff0000u); }
__device__ __forceinline__ float wave_sum(float v) {
#pragma unroll
    for (int o = 1; o < 64; o <<= 1) v += __shfl_xor(v, o);
    return v;
}
__device__ __forceinline__ float sigmoidf_(float x) { return 1.0f / (1.0f + __expf(-x)); }
__device__ __forceinline__ float siluf_(float x) { return x / (1.0f + __expf(-x)); }

#define XB_TMO      128
#define XB_XCNT(j)  (256  + 64 * (j))
#define XB_XSUB(j)  (1280 + 64 * (j))
#define XB_XGEN(j)  (2304 + 64 * (j))
#define XB_TOP      3328
#define XB_TOPGEN   3392
#define XCD_BAR_WORDS 3456
#define XB_SPIN_CAP (1u << 22)

__device__ __forceinline__ unsigned xb_ld(unsigned* p)              { return __hip_atomic_load(p, __ATOMIC_RELAXED, __HIP_MEMORY_SCOPE_AGENT); }
__device__ __forceinline__ unsigned xb_add(unsigned* p, unsigned v) { return __hip_atomic_fetch_add(p, v, __ATOMIC_RELAXED, __HIP_MEMORY_SCOPE_AGENT); }
__device__ __forceinline__ unsigned xb_xcc_id() { return (unsigned)__builtin_amdgcn_s_getreg((3 << 11) | 20) & 0xFu; }
#define XB_SPIN(cond, bar) do { unsigned _sp = 0; while (cond) { __builtin_amdgcn_s_sleep(1); \
    if ((++_sp & 255u) == 0u) { if (xb_ld(&(bar)[XB_TMO])) break; if (_sp > XB_SPIN_CAP) { atomicAdd(&(bar)[XB_TMO], 1u); break; } } } } while (0)

struct XcdBarrier { unsigned* bar; unsigned x; volatile LAS unsigned* st; };

__device__ __forceinline__ XcdBarrier xcd_barrier_post(unsigned* bar, volatile LAS unsigned* st) {
    XcdBarrier b; b.bar = bar; b.x = xb_xcc_id(); b.st = st;
    if (threadIdx.x == 0) (void)xb_add(&bar[XB_XCNT(b.x)], 1u);
    return b;
}
__device__ __forceinline__ void xcd_barrier_complete(unsigned* bar, unsigned x, unsigned& nloc, unsigned& nx) {
    const unsigned G = gridDim.x * gridDim.y * gridDim.z;
    unsigned sum, cnt, mine, sp = 0u;
    for (;;) {
        sum = 0u; cnt = 0u; mine = 0u;
#pragma unroll
        for (unsigned j = 0; j < 16; ++j) { const unsigned c = xb_ld(&bar[XB_XCNT(j)]); sum += c; cnt += (c > 0u) ? 1u : 0u; mine = (j == x) ? c : mine; }
        if (sum == G) break;
        __builtin_amdgcn_s_sleep(1);
        if ((++sp & 255u) == 0u) { if (xb_ld(&bar[XB_TMO])) break; if (sp > XB_SPIN_CAP) { atomicAdd(&bar[XB_TMO], 1u); break; } }
    }
    nloc = mine > 0u ? mine : 1u; nx = cnt > 0u ? cnt : 1u;
}
template <bool FIRST> __device__ __forceinline__ void xcd_barrier(const XcdBarrier& b) {
    asm volatile("s_waitcnt vmcnt(0)" ::: "memory");
    __syncthreads();
    if (threadIdx.x == 0) {
        unsigned* bar = b.bar;
        asm volatile("" : "+s"(bar));
        __builtin_amdgcn_s_waitcnt(0);
        unsigned nloc = b.st[0], nx = b.st[1];
        if (FIRST) { if (nloc == 0u) { xcd_barrier_complete(bar, b.x, nloc, nx); b.st[0] = nloc; b.st[1] = nx; } }
        const unsigned old = xb_add(&bar[XB_XSUB(b.x)], 1u);
        const unsigned gen = old / nloc;
        if (old + 1u == (gen + 1u) * nloc) {
            __builtin_amdgcn_fence(__ATOMIC_RELEASE, "agent");
            asm volatile("s_waitcnt vmcnt(0)" ::: "memory");
            const unsigned og = xb_add(&bar[XB_TOP], 1u);
            const unsigned tg = og / nx;
            if (og + 1u == (tg + 1u) * nx) xb_add(&bar[XB_TOPGEN], 1u);
            else XB_SPIN(xb_ld(&bar[XB_TOPGEN]) == tg, bar);
            __builtin_amdgcn_fence(__ATOMIC_ACQUIRE, "agent");
            xb_add(&bar[XB_XGEN(b.x)], 1u);
            asm volatile("s_waitcnt vmcnt(0)" ::: "memory");
        } else {
            XB_SPIN(xb_ld(&bar[XB_XGEN(b.x)]) == gen, bar);
            __builtin_amdgcn_fence(__ATOMIC_ACQUIRE, "agent");
            asm volatile("s_waitcnt vmcnt(0)" ::: "memory");
        }
    }
    __syncthreads();
}

struct Params { const float* in[N_INPUTS]; float* out; unsigned char* ws; float inv_freq[32]; };
static_assert(sizeof(Params) == N_INPUTS * 8 + 16 + 128, "Params has no padding");

struct Ctx {
    const float* const* in; float* out; unsigned char* ws;
    LAS unsigned char* lds;
    int G;
};
#define THREAD_IDS() int tid_ = threadIdx.x; asm volatile("" : "+v"(tid_)); const int tid = tid_, lane = tid & 63, wave = __builtin_amdgcn_readfirstlane(tid >> 6), gw = blockIdx.x * NWAVES + wave, NGW = C.G * NWAVES; (void)tid; (void)lane; (void)wave; (void)gw; (void)NGW
#define WSP(T, off) ((T*)(C.ws + (off)))

__device__ __forceinline__ float rstd_of(const float* ssp, int row) {
    const f32x4 a = *(const f32x4*)(ssp + (size_t)row * 16), b = *(const f32x4*)(ssp + (size_t)row * 16 + 4), c = *(const f32x4*)(ssp + (size_t)row * 16 + 8), d = *(const f32x4*)(ssp + (size_t)row * 16 + 12);
    const float s = (((a[0] + a[1]) + (a[2] + a[3])) + ((b[0] + b[1]) + (b[2] + b[3]))) + (((c[0] + c[1]) + (c[2] + c[3])) + ((d[0] + d[1]) + (d[2] + d[3])));
    return rsqrtf(s * (1.0f / D) + EPS);
}
#define EPI_IDS() int t_ = threadIdx.x; asm volatile("" : "+v"(t_)); const int wid_ = __builtin_amdgcn_readfirstlane(t_ >> 6), wr = wid_ >> 2, wc = wid_ & 3, fr = t_ & 15, fq = (t_ & 63) >> 4
struct EpiGLU {
    static constexpr bool PERM = true;
    bf16* act; const float* ss;
    __device__ __forceinline__ void operator()(const pg8::f32x4 (&acc)[2][2][4][2], const pg8::Unit& u, int, int, int, int) const {
        EPI_IDS();
        const int row0 = u.pm * 256 + wr * 64 + fr, col0 = u.pn * 128 + wc * 32 + 8 * fq;
#pragma unroll
        for (int ai = 0; ai < 2; ++ai)
#pragma unroll
            for (int m = 0; m < 4; ++m) {
                const int row = row0 + ai * 128 + m * 16; const float rstd = rstd_of(ss, row);
                float o[8];
#pragma unroll
                for (int n = 0; n < 2; ++n)
#pragma unroll
                    for (int j = 0; j < 4; ++j) { const float g = acc[ai][0][m][n][j] * rstd, up = acc[ai][1][m][n][j] * rstd; o[n * 4 + j] = siluf_(g) * up; }
                v4u w; w.x = pk2(o[0], o[1]); w.y = pk2(o[2], o[3]); w.z = pk2(o[4], o[5]); w.w = pk2(o[6], o[7]);
                *(v4u*)(act + (size_t)row * DFF + col0) = w;
            }
    }
};
template <bool FINAL, int SCALE2> struct EpiRes {
    static constexpr bool PERM = true;
    float* h; bf16* hb; float* ssout; float* out;
    __device__ __forceinline__ void operator()(const pg8::f32x4 (&acc)[2][2][4][2], const pg8::Unit& u, int, int, int, int) const {
        EPI_IDS();
        const int row0 = u.pm * 256 + wr * 64 + fr, col0 = u.pn * 256 + wc * 32 + 8 * fq;
#pragma unroll
        for (int ai = 0; ai < 2; ++ai)
#pragma unroll
            for (int m = 0; m < 4; ++m) {
                const int row = row0 + ai * 128 + m * 16; float sq = 0.f;
                constexpr float scale = 0.5f * SCALE2;
                long yoff = -1;
                if (FINAL) { if (row < MP) { const int b = row / L, pos = row - b * L; if (pos >= NMETA) yoff = (long)O_YP + ((long)b * SEQ + (pos - NMETA)) * D; } else if (row < MR) yoff = (long)O_YS + (long)(row - MP) * D; }
#pragma unroll
                for (int bj = 0; bj < 2; ++bj) {
                    const size_t off = (size_t)row * D + col0 + bj * 128;
                    f32x4 h0 = *(const f32x4*)(h + off), h1 = *(const f32x4*)(h + off + 4);
                    h0 = h0 + acc[ai][bj][m][0] * scale; h1 = h1 + acc[ai][bj][m][1] * scale;
                    *(f32x4*)(h + off) = h0; *(f32x4*)(h + off + 4) = h1;
                    v4u w; w.x = pk2(h0[0], h0[1]); w.y = pk2(h0[2], h0[3]); w.z = pk2(h1[0], h1[1]); w.w = pk2(h1[2], h1[3]);
                    *(v4u*)(hb + off) = w;
                    sq += (h0[0] * h0[0] + h0[1] * h0[1]) + (h0[2] * h0[2] + h0[3] * h0[3]) + (h1[0] * h1[0] + h1[1] * h1[1]) + (h1[2] * h1[2] + h1[3] * h1[3]);
                    if (FINAL && yoff >= 0) { *(f32x4*)(out + yoff + col0 + bj * 128) = h0; *(f32x4*)(out + yoff + col0 + bj * 128 + 4) = h1; }
                }
                sq += __shfl_xor(sq, 16); sq += __shfl_xor(sq, 32);
                if (fq == 0 && ssout) ssout[(size_t)row * 16 + u.pn * 4 + wc] = sq;
                asm volatile("" ::: "memory");
            }
    }
};
struct EpiZ {
    static constexpr bool PERM = true;
    bf16* zmix; bf16* gates; const float* ss; const float* bias;
    __device__ __forceinline__ void operator()(const pg8::f32x4 (&acc)[2][2][4][2], const pg8::Unit& u, int, int, int, int) const {
        EPI_IDS();
        const int row0 = u.pm * 256 + wr * 64 + fr, col0 = u.pn * 256 + wc * 32 + 8 * fq; const bool isgate = u.pn >= NMIXP / 256;
        f32x4 bv[2][2];
#pragma unroll
        for (int bj = 0; bj < 2; ++bj)
#pragma unroll
            for (int n = 0; n < 2; ++n) bv[bj][n] = *(const f32x4*)(bias + col0 + bj * 128 + 4 * n);
#pragma unroll
        for (int ai = 0; ai < 2; ++ai)
#pragma unroll
            for (int m = 0; m < 4; ++m) {
                const int row = row0 + ai * 128 + m * 16; const float rstd = rstd_of(ss, row);
#pragma unroll
                for (int bj = 0; bj < 2; ++bj) {
                    f32x4 v0 = acc[ai][bj][m][0] * rstd + bv[bj][0], v1 = acc[ai][bj][m][1] * rstd + bv[bj][1];
                    if (isgate) {
#pragma unroll
                        for (int j = 0; j < 4; ++j) { v0[j] = sigmoidf_(v0[j]); v1[j] = sigmoidf_(v1[j]); } }
                    v4u w; w.x = pk2(v0[0], v0[1]); w.y = pk2(v0[2], v0[3]); w.z = pk2(v1[0], v1[1]); w.w = pk2(v1[2], v1[3]);
                    if (isgate) *(v4u*)(gates + (size_t)row * NGATE + (col0 - NMIXP) + bj * 128) = w;
                    else *(v4u*)(zmix + (size_t)row * NMIXP + col0 + bj * 128) = w;
                }
            }
    }
};
struct EpiMerge {
    static constexpr bool PERM = true;
    bf16* merged; const bf16* gates;
    __device__ __forceinline__ void operator()(const pg8::f32x4 (&acc)[2][2][4][2], const pg8::Unit& u, int, int, int, int) const {
        EPI_IDS();
        const int n = u.pn >> 2, dt = u.pn & 3;
        const int row0 = u.pm * 256 + wr * 64 + fr, col0 = dt * 256 + wc * 32 + 8 * fq;
#pragma unroll
        for (int ai = 0; ai < 2; ++ai)
#pragma unroll
            for (int m = 0; m < 4; ++m) {
                const int row = row0 + ai * 128 + m * 16;
#pragma unroll
                for (int bj = 0; bj < 2; ++bj) {
                    const v4u gw = *(const v4u*)(gates + (size_t)row * NGATE + n * D + col0 + bj * 128);
                    bf16* mp = merged + (size_t)row * D + col0 + bj * 128;
                    float o[8];
                    o[0] = acc[ai][bj][m][0][0] * bflo(gw.x); o[1] = acc[ai][bj][m][0][1] * bfhi(gw.x); o[2] = acc[ai][bj][m][0][2] * bflo(gw.y); o[3] = acc[ai][bj][m][0][3] * bfhi(gw.y);
                    o[4] = acc[ai][bj][m][1][0] * bflo(gw.z); o[5] = acc[ai][bj][m][1][1] * bfhi(gw.z); o[6] = acc[ai][bj][m][1][2] * bflo(gw.w); o[7] = acc[ai][bj][m][1][3] * bfhi(gw.w);
                    if (n > 0) { const v4u pw = *(const v4u*)mp;
                        o[0] += bflo(pw.x); o[1] += bfhi(pw.x); o[2] += bflo(pw.y); o[3] += bfhi(pw.y); o[4] += bflo(pw.z); o[5] += bfhi(pw.z); o[6] += bflo(pw.w); o[7] += bfhi(pw.w); }
                    v4u w; w.x = pk2(o[0], o[1]); w.y = pk2(o[2], o[3]); w.z = pk2(o[4], o[5]); w.w = pk2(o[6], o[7]);
                    *(v4u*)mp = w;
                }
                asm volatile("" ::: "memory");
            }
    }
};

struct RowMap { int mode, a; __device__ __forceinline__ int operator()(int n) const { return mode == 0 ? n + a : (mode == 1 ? 256 * (n >> 7) + (n & 127) + a : (n < NMIX ? n : n + (NMIXP - NMIX))); } };
__device__ __forceinline__ void tr_item(const float* W, int K, int N, const float* gain, bf16* WT, int pitch, RowMap rm, LAS float* scr, int kb, int nb, int lane) {
    const int k0 = 64 * kb, n0 = 32 * nb; const int nn = n0 + (lane & 31);
#pragma unroll 8
    for (int i = 0; i < 32; ++i) { const int kk = 2 * i + (lane >> 5); float v = (nn < N) ? W[(size_t)(k0 + kk) * N + nn] : 0.f; if (gain) v *= gain[k0 + kk]; scr[kk * 33 + (lane & 31)] = v; }
    LDS_WAIT(); asm volatile("" ::: "memory");
    const int c = lane & 7;
#pragma unroll
    for (int j = 0; j < 4; ++j) { const int nl = (lane >> 3) + 8 * j; const int n = n0 + nl; const LAS float* s = scr + (8 * c) * 33 + nl;
        v4u o; o.x = pk2(s[0 * 33], s[1 * 33]); o.y = pk2(s[2 * 33], s[3 * 33]); o.z = pk2(s[4 * 33], s[5 * 33]); o.w = pk2(s[6 * 33], s[7 * 33]);
        if (n < N) *(v4u*)(WT + (size_t)rm(n) * pitch + k0 + 8 * c) = o; }
    LDS_WAIT(); asm volatile("" ::: "memory");
}
__device__ __forceinline__ void p0_prologue(const Ctx& C, const Params& P) {
    THREAD_IDS();
    LAS float* scr = (LAS float*)(C.lds + RING_OFF + wave * 16384);
    constexpr int I_FF = 16 * 88, I_DN = 44 * 32, I_IN = 16 * 225, I_BR = 4 * 4 * 32, I_OUT = 16 * 32;
    constexpr int PER_LAYER = 4 * I_FF + 2 * I_DN + I_IN + I_BR + I_OUT;
    for (int it = gw; it < DEPTH * PER_LAYER; it += NGW) {
        const int l = it / PER_LAYER; int r = it - l * PER_LAYER;
        bf16* W1a = WSP(bf16, WS_W1 + (size_t)(l * 2 + 0) * SZ_W1); bf16* W1b = WSP(bf16, WS_W1 + (size_t)(l * 2 + 1) * SZ_W1);
        bf16* Wda = WSP(bf16, WS_WD + (size_t)(l * 2 + 0) * SZ_WD); bf16* Wdb = WSP(bf16, WS_WD + (size_t)(l * 2 + 1) * SZ_WD);
        if (r < I_FF) { tr_item(C.in[I_F1G] + (size_t)l * D * DFF, D, DFF, C.in[I_NF1] + l * D, W1a, D, RowMap{1, 0}, scr, r / 88, r % 88, lane); continue; } r -= I_FF;
        if (r < I_FF) { tr_item(C.in[I_F1U] + (size_t)l * D * DFF, D, DFF, C.in[I_NF1] + l * D, W1a, D, RowMap{1, 128}, scr, r / 88, r % 88, lane); continue; } r -= I_FF;
        if (r < I_DN) { tr_item(C.in[I_F1D] + (size_t)l * D * DFF, DFF, D, nullptr, Wda, DFF, RowMap{0, 0}, scr, r / 32, r % 32, lane); continue; } r -= I_DN;
        if (r < I_FF) { tr_item(C.in[I_F2G] + (size_t)l * D * DFF, D, DFF, C.in[I_NF2] + l * D, W1b, D, RowMap{1, 0}, scr, r / 88, r % 88, lane); continue; } r -= I_FF;
        if (r < I_FF) { tr_item(C.in[I_F2U] + (size_t)l * D * DFF, D, DFF, C.in[I_NF2] + l * D, W1b, D, RowMap{1, 128}, scr, r / 88, r % 88, lane); continue; } r -= I_FF;
        if (r < I_DN) { tr_item(C.in[I_F2D] + (size_t)l * D * DFF, DFF, D, nullptr, Wdb, DFF, RowMap{0, 0}, scr, r / 32, r % 32, lane); continue; } r -= I_DN;
        if (r < I_IN) { tr_item(C.in[I_WIN] + (size_t)l * D * NIN, D, NIN, C.in[I_NMIX] + l * D, WSP(bf16, WS_WIN + (size_t)l * SZ_WIN), D, RowMap{2, 0}, scr, r / 225, r % 225, lane); continue; } r -= I_IN;
        if (r < I_BR) { const int n4 = r / 128, rr = r % 128; tr_item(C.in[I_WBR] + (size_t)(l * 4 + n4) * 256 * D, 256, D, nullptr, WSP(bf16, WS_WBR + (size_t)l * SZ_WBR), 256, RowMap{0, n4 * D}, scr, rr / 32, rr % 32, lane); continue; } r -= I_BR;
        tr_item(C.in[I_WOUT] + (size_t)l * D * D, D, D, nullptr, WSP(bf16, WS_WOUT + (size_t)l * SZ_WOUT), D, RowMap{0, 0}, scr, r / 32, r % 32, lane);
    }
    const int gt = gw * 64 + lane, NGT = NGW * 64;
    for (int i = gt; i < 2 * 240 * 128; i += NGT) { const int l = i / (240 * 128), r = i % (240 * 128); *(v4u*)(C.ws + WS_WIN + (size_t)l * SZ_WIN + ((size_t)NMIX * D) * 2 + (size_t)r * 16) = (v4u){0u, 0u, 0u, 0u}; }
    for (int i = gt; i < (M - MR) * 128; i += NGT) *(v4u*)(C.ws + WS_BR + (size_t)MR * D * 2 + (size_t)i * 16) = (v4u){0u, 0u, 0u, 0u};
    for (int i = gt; i < 2 * NINP; i += NGT) { const int l = i / NINP, j = i % NINP; float v = 0.f; if (j < NMIX) v = C.in[I_BIN][l * NIN + j]; else if (j >= NMIXP) v = C.in[I_BIN][l * NIN + NMIX + (j - NMIXP)]; WSP(float, WS_BINP)[i] = v; }
    for (int i = gt; i < NPOS * 32; i += NGT) { const int pi = i >> 5, fi = i & 31; const int pos = pi < L ? pi : PAST + (pi - L);
        const float angf = (float)pos * P.inv_freq[fi];
        const double a = (double)angf; const double k = rint(a * 0.15915494309189535); const double rr = (a - k * 6.283185307179586) - k * 2.4492935982947064e-16;
        const float rf = (float)rr; WSP(float, WS_ROPE)[i] = cosf(rf); WSP(float, WS_ROPE)[NPOS * 32 + i] = sinf(rf); }
    float* H = WSP(float, WS_H); bf16* HB = WSP(bf16, WS_HB); float* SS0 = WSP(float, WS_SS);
    for (int row = gw; row < M; row += NGW) {
        const float* src = nullptr;
        if (row < MP) { const int b = row / L, pos = row - b * L; src = pos < NMETA ? C.in[I_META] + (size_t)pos * D : C.in[I_XP] + ((size_t)b * SEQ + (pos - NMETA)) * D; }
        else if (row < MR) src = C.in[I_XS] + (size_t)(row - MP) * D;
        float s = 0.f;
#pragma unroll
        for (int j = 0; j < 4; ++j) { f32x4 v = src ? *(const f32x4*)(src + 256 * j + 4 * lane) : (f32x4){0.f, 0.f, 0.f, 0.f};
            *(f32x4*)(H + (size_t)row * D + 256 * j + 4 * lane) = v; s += (v[0] * v[0] + v[1] * v[1]) + (v[2] * v[2] + v[3] * v[3]);
            unsigned long long w = (unsigned long long)pk2(v[0], v[1]) | ((unsigned long long)pk2(v[2], v[3]) << 32);
            *(unsigned long long*)(HB + (size_t)row * D + 256 * j + 4 * lane) = w; }
        s = wave_sum(s); if (lane < 16) SS0[(size_t)row * 16 + lane] = lane == 0 ? s : 0.f;
    }
}

__device__ __forceinline__ float lam_of(const Ctx& C, int l, float lam_init) {
    THREAD_IDS();
    float a = 0.f, b = 0.f;
    for (int i = 0; i < 32; ++i) { a += C.in[I_LQ1][l * 32 + i] * C.in[I_LK1][l * 32 + i]; b += C.in[I_LQ2][l * 32 + i] * C.in[I_LK2][l * 32 + i]; }
    return __expf(a) - __expf(b) + lam_init;
}
__device__ __forceinline__ int t5_bucket(int n) {
    if (n < 16) return n;
    return 16 + (n >= 19) + (n >= 21) + (n >= 24) + (n >= 27) + (n >= 31) + (n >= 35) + (n >= 40) + (n >= 46) + (n >= 52) + (n >= 59) + (n >= 67) + (n >= 77) + (n >= 87) + (n >= 99) + (n >= 113);
}
__device__ __forceinline__ void n1_prep(const Ctx& C, int l) {
    THREAD_IDS();
    const bf16* ZM = WSP(bf16, WS_ZMIX); float* UB = WSP(float, WS_UBUF); float* RQ = WSP(float, WS_RQ); float* RK = WSP(float, WS_RK); float* QN = WSP(float, WS_QN); float* KN = WSP(float, WS_KN);
    float* VB = WSP(float, WS_VB); float* LD = WSP(float, WS_LDEC); const float* COS = WSP(float, WS_ROPE); const float* SIN = COS + NPOS * 32;
    for (int r = gw; r < MR; r += NGW) {
        const bf16* z = ZM + (size_t)r * NMIXP;
        const int pi = r < MP ? r % L : L + ((r - MP) & 7);
        float* kout = r < MP ? C.out + O_KP + ((size_t)l * MP + r) * 256 : C.out + O_KS + ((size_t)l * MS + (r - MP)) * 256;
        float* vout = r < MP ? C.out + O_VP + ((size_t)l * MP + r) * 256 : C.out + O_VS + ((size_t)l * MS + (r - MP)) * 256;
#pragma unroll
        for (int k = 0; k < 4; ++k) { const int c = lane + 64 * k;
            UB[(size_t)r * 256 + c] = bf2f(z[C_A + c]) * sigmoidf_(bf2f(z[C_G + c]));
            const float vv = bf2f(z[D_V + c]); VB[(size_t)r * 256 + c] = vv; vout[c] = vv;
            { float x = bf2f(z[D_Q + c]); float s = x * x; s += __shfl_xor(s, 1); s += __shfl_xor(s, 2); s += __shfl_xor(s, 4); s += __shfl_xor(s, 8); s += __shfl_xor(s, 16);
              const float y = x * rsqrtf(s * (1.0f / 32) + EPS) * C.in[I_QN][l * 32 + (c & 31)]; QN[(size_t)r * 256 + c] = y; WSP(bf16, WS_QNB)[(size_t)r * 256 + c] = (bf16)f2bf(y * (0.17677669529663687f * 1.4426950408889634f)); }
            { float x = bf2f(z[D_K + c]); float s = x * x; s += __shfl_xor(s, 1); s += __shfl_xor(s, 2); s += __shfl_xor(s, 4); s += __shfl_xor(s, 8); s += __shfl_xor(s, 16);
              const float y = x * rsqrtf(s * (1.0f / 32) + EPS) * C.in[I_KN][l * 32 + (c & 31)]; KN[(size_t)r * 256 + c] = y; kout[c] = y; WSP(bf16, WS_KNB)[(size_t)r * 256 + c] = (bf16)f2bf(y); }
        }
#pragma unroll
        for (int k = 0; k < 2; ++k) { const int p = lane + 64 * k, h = p >> 5, i = p & 31; const float cs = COS[pi * 32 + i], sn = SIN[pi * 32 + i];
            { const float x1 = bf2f(z[R_Q + h * 64 + i]), x2 = bf2f(z[R_Q + h * 64 + 32 + i]); RQ[(size_t)r * 256 + h * 64 + i] = x1 * cs - x2 * sn; RQ[(size_t)r * 256 + h * 64 + 32 + i] = x1 * sn + x2 * cs; }
            { const float x1 = bf2f(z[R_K + h * 64 + i]), x2 = bf2f(z[R_K + h * 64 + 32 + i]); RK[(size_t)r * 256 + h * 64 + i] = (x1 * cs - x2 * sn) * 0.125f; RK[(size_t)r * 256 + h * 64 + 32 + i] = (x1 * sn + x2 * cs) * 0.125f; }
            { const int j = p; float gp = C.in[I_GAB][l * 128 + j];
              for (int i2 = 0; i2 < 16; ++i2) gp += bf2f(z[G_LOW + i2]) * C.in[I_GAW][(l * 16 + i2) * 128 + j];
              const float ls = fminf(gp, 0.f) - log1pf(__expf(-fabsf(gp)));
              LD[(size_t)r * 128 + j] = ls * (1.0f / 16.0f); }
        }
    }
}
__device__ __forceinline__ void n2_conv(const Ctx& C, int l) {
    THREAD_IDS();
    const float* UB = WSP(float, WS_UBUF); bf16* BR = WSP(bf16, WS_BR);
    const float* cw = C.in[I_CW] + (size_t)l * 31 * 256; const float* sc = C.in[I_SCONV];
    for (int r = gw; r < MR; r += NGW) {
        const bool smp = r >= MP; const int b = smp ? (r - MP) >> 3 : r / L; const int p = smp ? (r - MP) & 7 : r - b * L; const int rb = smp ? MP + b * 8 : b * L;
        float cv[4];
#pragma unroll
        for (int k = 0; k < 4; ++k) cv[k] = C.in[I_CB][l * 256 + lane + 64 * k];
        for (int j = 0; j < 31; ++j) { const int q = p + j - 30;
#pragma unroll
            for (int k = 0; k < 4; ++k) { const int c = lane + 64 * k; float uv;
                if (q >= 0) uv = UB[(size_t)(rb + q) * 256 + c]; else uv = smp ? sc[(((size_t)l * DB + b) * 30 + (p + j)) * 256 + c] : 0.f;
                cv[k] += cw[j * 256 + c] * uv; } }
        float s = (cv[0] + cv[1]) + (cv[2] + cv[3]); const float mean = wave_sum(s) * (1.0f / 256);
        float q2 = 0.f;
#pragma unroll
        for (int k = 0; k < 4; ++k) { cv[k] -= mean; q2 += cv[k] * cv[k]; }
        const float rstd = rsqrtf(wave_sum(q2) * (1.0f / 256) + EPS);
#pragma unroll
        for (int k = 0; k < 4; ++k) { const int c = lane + 64 * k; const float y = cv[k] * rstd * C.in[I_CLG][l * 256 + c] + C.in[I_CLB][l * 256 + c]; BR[(size_t)r * D + c] = (bf16)f2bf(siluf_(y)); }
    }
    const int gt = gw * 64 + lane, NGT = NGW * 64;
    for (int i = gt; i < BATCH * 30 * 256; i += NGT) { const int c = i & 255, ii = (i >> 8) % 30, b = i / (30 * 256); C.out[O_CP + (size_t)l * BATCH * 30 * 256 + i] = UB[(size_t)(b * L + L - 30 + ii) * 256 + c]; }
    for (int i = gt; i < DB * 30 * 256; i += NGT) { const int c = i & 255, ii = (i >> 8) % 30, b = i / (30 * 256);
        C.out[O_CS + (size_t)l * DB * 30 * 256 + i] = ii < 22 ? sc[(((size_t)l * DB + b) * 30 + 8 + ii) * 256 + c] : UB[(size_t)(MP + b * 8 + ii - 22) * 256 + c]; }
}
template <int DK, bool RET> __device__ __forceinline__ void la_seq(const Ctx& C, int l, bool smp, int b, int h) {
    THREAD_IDS();
    const bf16* ZM = WSP(bf16, WS_ZMIX); const float* RQ = WSP(float, WS_RQ); const float* RK = WSP(float, WS_RK); const float* LD = WSP(float, WS_LDEC); bf16* BR = WSP(bf16, WS_BR);
    const int nt = smp ? DS : L; const int row0 = smp ? MP + b * DS : b * L;
    float S[DK];
    if (smp) { const float* s0 = (RET ? C.in[I_SRET] : C.in[I_SGLA]) + (((size_t)l * DB + b) * 4 + h) * DK * 64;
#pragma unroll
        for (int k = 0; k < DK; ++k) S[k] = s0[k * 64 + lane]; }
    else {
#pragma unroll
        for (int k = 0; k < DK; ++k) S[k] = 0.f; }
    const float gamma = 1.0f - exp2f(-5.0f - (float)h);
    const float gn = RET ? C.in[I_RGN][(l * 4 + h) * 64 + lane] : C.in[I_GGN][(l * 4 + h) * 64 + lane];
    for (int t = 0; t < nt; ++t) {
        const int r = row0 + t; const bf16* z = ZM + (size_t)r * NMIXP;
        float ql, kl, dl = 1.f;
        if (RET) { ql = RQ[(size_t)r * 256 + h * 64 + lane]; kl = RK[(size_t)r * 256 + h * 64 + lane]; }
        else { const int lk = lane & 31; ql = bf2f(z[G_Q + h * 32 + lk]) * 0.17677669529663687f; kl = bf2f(z[G_K + h * 32 + lk]); dl = __expf(LD[(size_t)r * 128 + h * 32 + lk]); }
        const float v = bf2f(z[(RET ? R_V : G_V) + h * 64 + lane]);
        float o = 0.f;
#pragma unroll
        for (int k = 0; k < DK; ++k) { const float qk = __shfl(ql, k), kk = __shfl(kl, k); const float dk = RET ? gamma : __shfl(dl, k);
            S[k] = dk * S[k] + kk * v; o += qk * S[k]; if ((k & 7) == 7) __builtin_amdgcn_sched_barrier(0); }
        float y;
        if (RET) { const float mean = wave_sum(o) * (1.0f / 64); const float d = o - mean; const float var = wave_sum(d * d) * (1.0f / 64); y = d * rsqrtf(var + EPS) * gn; }
        else { const float ms = wave_sum(o * o) * (1.0f / 64); y = o * rsqrtf(ms + EPS) * gn; }
        const float g = bf2f(z[(RET ? R_G : G_R) + h * 64 + lane]);
        BR[(size_t)r * D + (RET ? 256 : 512) + h * 64 + lane] = (bf16)f2bf(siluf_(g) * y);
    }
    float* so = C.out + (RET ? (smp ? O_RS + (((size_t)l * DB + b) * 4 + h) * DK * 64 : O_RP + (((size_t)l * BATCH + b) * 4 + h) * DK * 64)
                             : (smp ? O_GS + (((size_t)l * DB + b) * 4 + h) * DK * 64 : O_GP + (((size_t)l * BATCH + b) * 4 + h) * DK * 64));
#pragma unroll
    for (int k = 0; k < DK; ++k) so[k * 64 + lane] = S[k];
}
__device__ __forceinline__ void n2_la(const Ctx& C, int l) {
    THREAD_IDS();
    if ((gw & 63) == 0 && (gw >> 6) < 32) { const int it = gw >> 6; const int b = (it >> 2) & 3, h = it & 3;
        if (it < 16) la_seq<64, true>(C, l, false, b, h); else la_seq<32, false>(C, l, false, b, h); }
    for (int it = gw; it < 256; it += NGW) { const int typ = it >> 7, b = (it >> 2) & 31, h = it & 3;
        if (typ == 0) la_seq<64, true>(C, l, true, b, h); else la_seq<32, false>(C, l, true, b, h); }
}
__device__ __forceinline__ void n2_attn_prompt(const Ctx& C, int l, float lam_init) {
    THREAD_IDS();
    const float* QN = WSP(float, WS_QN); const float* KN = WSP(float, WS_KN); const float* VB = WSP(float, WS_VB); bf16* BR = WSP(bf16, WS_BR);
    const float lam = lam_of(C, l, lam_init);
    LAS float* park = (LAS float*)(C.lds) + wave * (64 * 65);
    constexpr int NQG = (L + 63) / 64;
    for (int it = gw; it < BATCH * 4 * NQG; it += NGW) {
        const int qg = NQG - 1 - it / 16, bh = it % 16, b = bh >> 2, h = bh & 3;
        const int qpos = min(qg * 64 + lane, L - 1); const bool valid = (qg * 64 + lane) < L; const int qrow = b * L + qpos;
        const int nkeys = min(qg * 64 + 64, L);
        float bias_near[1]; (void)bias_near;
        for (int s = 0; s < 2; ++s) {
            float q[32];
#pragma unroll
            for (int i = 0; i < 32; i += 4) { const f32x4 t = *(const f32x4*)(QN + (size_t)qrow * 256 + h * 64 + s * 32 + i); q[i] = t[0] * 0.17677669529663687f; q[i + 1] = t[1] * 0.17677669529663687f; q[i + 2] = t[2] * 0.17677669529663687f; q[i + 3] = t[3] * 0.17677669529663687f; }
            float m = -INFINITY, lsum = 0.f; float acc[64];
#pragma unroll
            for (int i = 0; i < 64; ++i) acc[i] = 0.f;
            for (int j = 0; j < nkeys; ++j) {
                const float* kp = KN + (size_t)(b * L + j) * 256 + h * 64 + s * 32; const float* vp = VB + (size_t)(b * L + j) * 256 + h * 64;
                float sc = 0.f;
#pragma unroll
                for (int i = 0; i < 32; i += 4) { const f32x4 kv = *(const f32x4*)(kp + i); sc += q[i] * kv[0] + q[i + 1] * kv[1] + q[i + 2] * kv[2] + q[i + 3] * kv[3]; }
                const int n = qpos - j;
                sc += C.in[I_RELB][t5_bucket(n < 0 ? 0 : n) * 4 + h];
                if (n < 0) sc = -INFINITY;
                const float mn = fmaxf(m, sc); const float corr = __expf(m - mn); const float p = __expf(sc - mn);
                m = mn; lsum = lsum * corr + p;
#pragma unroll
                for (int i = 0; i < 64; i += 4) { const f32x4 vv = *(const f32x4*)(vp + i); acc[i] = acc[i] * corr + p * vv[0]; acc[i + 1] = acc[i + 1] * corr + p * vv[1]; acc[i + 2] = acc[i + 2] * corr + p * vv[2]; acc[i + 3] = acc[i + 3] * corr + p * vv[3]; }
            }
            const float inv = 1.0f / lsum;
            if (s == 0) {
#pragma unroll
                for (int i = 0; i < 64; ++i) park[lane * 65 + i] = acc[i] * inv;
                LDS_WAIT();
            } else {
                float ms = 0.f;
#pragma unroll
                for (int i = 0; i < 64; ++i) { acc[i] = park[lane * 65 + i] - lam * (acc[i] * inv); ms += acc[i] * acc[i]; }
                const float rn = rsqrtf(ms * (1.0f / 64) + EPS) * (1.0f - lam_init);
                if (valid) {
#pragma unroll
                    for (int i = 0; i < 64; i += 2) { const unsigned w = pk2(acc[i] * rn * C.in[I_SUBLN][l * 64 + i], acc[i + 1] * rn * C.in[I_SUBLN][l * 64 + i + 1]); *(unsigned*)(BR + (size_t)qrow * D + 768 + h * 64 + i) = w; } }
                LDS_WAIT();
            }
        }
    }
}
__device__ __forceinline__ void n2_attn_sample(const Ctx& C, int l, float lam_init) {
    THREAD_IDS();
    const float* QN = WSP(float, WS_QN); const float* KN = WSP(float, WS_KN); const float* VB = WSP(float, WS_VB); bf16* BR = WSP(bf16, WS_BR);
    const int* PT = (const int*)C.in[I_PT]; const float* CK = C.in[I_CK] + (size_t)l * NPOOL * PAGE * 256; const float* CV = C.in[I_CV] + (size_t)l * NPOOL * PAGE * 256;
    const float lam = lam_of(C, l, lam_init);
    LAS float* part = (LAS float*)C.lds;
    for (int b = blockIdx.x; b < DB; b += C.G) {
        const int row = tid & 63, split = tid >> 6, h = row >> 4, s = (row >> 3) & 1, t = row & 7;
        float q[32];
#pragma unroll
        for (int i = 0; i < 32; ++i) q[i] = QN[(size_t)(MP + b * 8 + t) * 256 + h * 64 + s * 32 + i] * 0.17677669529663687f;
        float m = -INFINITY, lsum = 0.f; float acc[64];
#pragma unroll
        for (int i = 0; i < 64; ++i) acc[i] = 0.f;
        for (int j = split; j < PAST + DS; j += 8) {
            const float* kp; const float* vp; bool vis = true;
            if (j < PAST) { const int page = PT[b * NPAGES + (j >> 7)]; const size_t base = (((size_t)page * PAGE + (j & 127)) * 4 + h) * 64; kp = CK + base + s * 32; vp = CV + base; }
            else { const int jj = j - PAST; const size_t r2 = (size_t)(MP + b * 8 + jj); kp = KN + r2 * 256 + h * 64 + s * 32; vp = VB + r2 * 256 + h * 64; vis = jj <= t; }
            float sc = 0.f;
#pragma unroll
            for (int i = 0; i < 32; i += 4) { const f32x4 kv = *(const f32x4*)(kp + i); sc += q[i] * kv[0] + q[i + 1] * kv[1] + q[i + 2] * kv[2] + q[i + 3] * kv[3]; }
            const int n = PAST + t - j;
            sc += C.in[I_RELB][t5_bucket(n < 0 ? 0 : n) * 4 + h];
            if (!vis) sc = -INFINITY;
            const float mn = fmaxf(m, sc); const float corr = __expf(m - mn); const float p = __expf(sc - mn);
            m = mn; lsum = lsum * corr + p;
#pragma unroll
            for (int i = 0; i < 64; i += 4) { const f32x4 vv = *(const f32x4*)(vp + i); acc[i] = acc[i] * corr + p * vv[0]; acc[i + 1] = acc[i + 1] * corr + p * vv[1]; acc[i + 2] = acc[i + 2] * corr + p * vv[2]; acc[i + 3] = acc[i + 3] * corr + p * vv[3]; }
        }
        LAS float* pr = part + (split * 64 + row) * 66;
        pr[64] = m; pr[65] = lsum;
#pragma unroll
        for (int i = 0; i < 64; ++i) pr[i] = acc[i];
        __syncthreads();
        for (int k = 0; k < 4; ++k) { const int p = wave * 4 + k, h2 = p >> 3, t2 = p & 7; float os[2];
#pragma unroll
            for (int s2 = 0; s2 < 2; ++s2) { const int rw = h2 * 16 + s2 * 8 + t2; float mm = -INFINITY;
                for (int sp = 0; sp < 8; ++sp) mm = fmaxf(mm, part[(sp * 64 + rw) * 66 + 64]);
                float ll = 0.f, oo = 0.f;
                for (int sp = 0; sp < 8; ++sp) { const float w = __expf(part[(sp * 64 + rw) * 66 + 64] - mm); ll += part[(sp * 64 + rw) * 66 + 65] * w; oo += part[(sp * 64 + rw) * 66 + lane] * w; }
                os[s2] = oo / ll; }
            const float o = os[0] - lam * os[1]; const float ms = wave_sum(o * o) * (1.0f / 64);
            const float y = o * rsqrtf(ms + EPS) * C.in[I_SUBLN][l * 64 + lane] * (1.0f - lam_init);
            BR[(size_t)(MP + b * 8 + t2) * D + 768 + h2 * 64 + lane] = (bf16)f2bf(y); }
        __syncthreads();
    }
}
typedef short bf16x8_t __attribute__((ext_vector_type(8)));
template <int DK, bool RET> __device__ __forceinline__ void la_chunked(const Ctx& C, int l, bool smp, int b, int h) {
    THREAD_IDS();
    constexpr int QS = DK + 8, TS = 72, NKB = DK / 16, NKS = DK / 32;
    LAS bf16* QT = (LAS bf16*)(C.lds);
    LAS bf16* KT = QT + 64 * QS;
    LAS bf16* VT = KT + 64 * QS;
    LAS bf16* KE = VT + 64 * TS;
    LAS bf16* AL = KE + DK * TS;
    LAS bf16* ST = AL + 64 * TS;
    LAS float* WT = (LAS float*)(ST + 2 * 64 * QS);
    const bf16* ZM = WSP(bf16, WS_ZMIX); const float* RQ = WSP(float, WS_RQ); const float* RK = WSP(float, WS_RK); const float* LD = WSP(float, WS_LDEC); bf16* BR = WSP(bf16, WS_BR);
    const int nt = smp ? DS : L, row0 = smp ? MP + b * DS : b * L, nch = (nt + 63) >> 6;
    const float lg2 = RET ? log2f(1.0f - exp2f(-5.0f - (float)h)) : 0.f;
    const int g4 = lane >> 4, c16 = lane & 15;
    const bool qwave = wave < 4; const int w4 = wave & 3;
    float Sreg[NKB][4];
    if (wave >= 4) {
        const float* s0 = (RET ? C.in[I_SRET] : C.in[I_SGLA]) + (((size_t)l * DB + b) * 4 + h) * DK * 64;
#pragma unroll
        for (int cb = 0; cb < NKB; ++cb)
#pragma unroll
            for (int r = 0; r < 4; ++r) { const int dk = cb * 16 + c16, dv = (wave - 4) * 16 + 4 * g4 + r; const float v = smp ? s0[dk * 64 + dv] : 0.f; Sreg[cb][r] = v; ST[dv * QS + dk] = (bf16)f2bf(v); }
    }
    float gnv[4];
#pragma unroll
    for (int cb = 0; cb < 4; ++cb) gnv[cb] = (RET ? C.in[I_RGN] : C.in[I_GGN])[(l * 4 + h) * 64 + cb * 16 + c16];
    float a[16]; v4u vr;
#define LA_LOAD(c) do { const size_t r_ = (size_t)(row0 + (c) * 64 + lane); const bf16* z_ = ZM + r_ * NMIXP; \
        vr = *(const v4u*)(z_ + (RET ? R_V : G_V) + h * 64 + 8 * wave); \
        if (RET) { const float* p_ = (qwave ? RQ : RK) + r_ * 256 + h * 64 + 8 * w4; const f32x4 x0 = *(const f32x4*)p_, x1 = *(const f32x4*)(p_ + 4), x2 = *(const f32x4*)(p_ + 32), x3 = *(const f32x4*)(p_ + 36); \
            a[0] = x0[0]; a[1] = x0[1]; a[2] = x0[2]; a[3] = x0[3]; a[4] = x1[0]; a[5] = x1[1]; a[6] = x1[2]; a[7] = x1[3]; a[8] = x2[0]; a[9] = x2[1]; a[10] = x2[2]; a[11] = x2[3]; a[12] = x3[0]; a[13] = x3[1]; a[14] = x3[2]; a[15] = x3[3]; } \
        else { const v4u q_ = *(const v4u*)(z_ + (qwave ? G_Q : G_K) + h * 32 + 8 * w4); const float* p_ = LD + r_ * 128 + h * 32 + 8 * w4; const f32x4 x0 = *(const f32x4*)p_, x1 = *(const f32x4*)(p_ + 4); \
            a[0] = bflo(q_.x); a[1] = bfhi(q_.x); a[2] = bflo(q_.y); a[3] = bfhi(q_.y); a[4] = bflo(q_.z); a[5] = bfhi(q_.z); a[6] = bflo(q_.w); a[7] = bfhi(q_.w); \
            a[8] = x0[0]; a[9] = x0[1]; a[10] = x0[2]; a[11] = x0[3]; a[12] = x1[0]; a[13] = x1[1]; a[14] = x1[2]; a[15] = x1[3]; } } while (0)
    LA_LOAD(0);
    int cur = 0;
    for (int c = 0; c < nch; ++c) {
        const int nvc = min(64, nt - c * 64); const bool valid = lane < nvc;
        if (RET) {
            const float tq = (float)(lane + 1);
            if (qwave) { const float e = valid ? exp2f(lg2 * tq) : 0.f;
                v4u w0, w1; w0.x = pk2(a[0] * e, a[1] * e); w0.y = pk2(a[2] * e, a[3] * e); w0.z = pk2(a[4] * e, a[5] * e); w0.w = pk2(a[6] * e, a[7] * e);
                w1.x = pk2(a[8] * e, a[9] * e); w1.y = pk2(a[10] * e, a[11] * e); w1.z = pk2(a[12] * e, a[13] * e); w1.w = pk2(a[14] * e, a[15] * e);
                *(LAS v4u*)(QT + lane * QS + 8 * w4) = w0; *(LAS v4u*)(QT + lane * QS + 32 + 8 * w4) = w1; }
            else { const float e = valid ? exp2f(-lg2 * tq) : 0.f, ee = valid ? exp2f(lg2 * ((float)nvc - tq)) : 0.f;
                v4u w0, w1; w0.x = pk2(a[0] * e, a[1] * e); w0.y = pk2(a[2] * e, a[3] * e); w0.z = pk2(a[4] * e, a[5] * e); w0.w = pk2(a[6] * e, a[7] * e);
                w1.x = pk2(a[8] * e, a[9] * e); w1.y = pk2(a[10] * e, a[11] * e); w1.z = pk2(a[12] * e, a[13] * e); w1.w = pk2(a[14] * e, a[15] * e);
                *(LAS v4u*)(KT + lane * QS + 8 * w4) = w0; *(LAS v4u*)(KT + lane * QS + 32 + 8 * w4) = w1;
#pragma unroll
                for (int i = 0; i < 8; ++i) { KE[(8 * w4 + i) * TS + lane] = (bf16)f2bf(a[i] * ee); KE[(32 + 8 * w4 + i) * TS + lane] = (bf16)f2bf(a[8 + i] * ee); } }
        } else {
            float bb[8];
#pragma unroll
            for (int i = 0; i < 8; ++i) bb[i] = valid ? a[8 + i] : 0.f;
#pragma unroll
            for (int off = 1; off < 64; off <<= 1) {
#pragma unroll
                for (int i = 0; i < 8; ++i) { const float x = __shfl_up(bb[i], off); if (lane >= off) bb[i] += x; } }
            if (qwave) {
                if (lane == 63) {
#pragma unroll
                    for (int i = 0; i < 8; ++i) WT[8 * w4 + i] = bb[i]; }
                float o8[8];
#pragma unroll
                for (int i = 0; i < 8; ++i) o8[i] = valid ? a[i] * 0.17677669529663687f * __expf(bb[i]) : 0.f;
                v4u w0; w0.x = pk2(o8[0], o8[1]); w0.y = pk2(o8[2], o8[3]); w0.z = pk2(o8[4], o8[5]); w0.w = pk2(o8[6], o8[7]);
                *(LAS v4u*)(QT + lane * QS + 8 * w4) = w0;
            } else {
                float o8[8];
#pragma unroll
                for (int i = 0; i < 8; ++i) { const float tot = __shfl(bb[i], 63); o8[i] = valid ? a[i] * __expf(-bb[i]) : 0.f; KE[(8 * w4 + i) * TS + lane] = (bf16)f2bf(valid ? a[i] * __expf(tot - bb[i]) : 0.f); }
                v4u w0; w0.x = pk2(o8[0], o8[1]); w0.y = pk2(o8[2], o8[3]); w0.z = pk2(o8[4], o8[5]); w0.w = pk2(o8[6], o8[7]);
                *(LAS v4u*)(KT + lane * QS + 8 * w4) = w0;
            }
        }
        { const unsigned vv[4] = {valid ? vr.x : 0u, valid ? vr.y : 0u, valid ? vr.z : 0u, valid ? vr.w : 0u};
#pragma unroll
          for (int i = 0; i < 4; ++i) { VT[(8 * wave + 2 * i) * TS + lane] = (bf16)(vv[i] & 0xffffu); VT[(8 * wave + 2 * i + 1) * TS + lane] = (bf16)(vv[i] >> 16); } }
        if (c + 1 < nch) LA_LOAD(c + 1);
        LDS_WAIT(); __builtin_amdgcn_s_barrier(); asm volatile("" ::: "memory");
        { const int rb = wave >> 1;
#pragma unroll
          for (int ci = 0; ci < 2; ++ci) { const int cb = (wave & 1) * 2 + ci; f32x4 acc = {0.f, 0.f, 0.f, 0.f};
              if (cb <= rb) {
#pragma unroll
                  for (int ks = 0; ks < NKS; ++ks) { const bf16x8_t af = *(const LAS bf16x8_t*)(QT + (rb * 16 + c16) * QS + ks * 32 + 8 * g4), bf = *(const LAS bf16x8_t*)(KT + (cb * 16 + c16) * QS + ks * 32 + 8 * g4);
                      acc = __builtin_amdgcn_mfma_f32_16x16x32_bf16(af, bf, acc, 0, 0, 0); } }
#pragma unroll
              for (int r = 0; r < 4; ++r) { const int tt = rb * 16 + 4 * g4 + r, ss = cb * 16 + c16; AL[tt * TS + ss] = (bf16)f2bf(ss <= tt ? acc[r] : 0.f); } } }
        LDS_WAIT(); __builtin_amdgcn_s_barrier(); asm volatile("" ::: "memory");
        if (wave < 4) {
            const int rb = wave; const LAS bf16* STc = ST + cur * 64 * QS;
            f32x4 o[4];
#pragma unroll
            for (int cb = 0; cb < 4; ++cb) o[cb] = (f32x4){0.f, 0.f, 0.f, 0.f};
#pragma unroll
            for (int ks = 0; ks < 2; ++ks) { const bf16x8_t af = *(const LAS bf16x8_t*)(AL + (rb * 16 + c16) * TS + ks * 32 + 8 * g4);
#pragma unroll
                for (int cb = 0; cb < 4; ++cb) { const bf16x8_t bf = *(const LAS bf16x8_t*)(VT + (cb * 16 + c16) * TS + ks * 32 + 8 * g4); o[cb] = __builtin_amdgcn_mfma_f32_16x16x32_bf16(af, bf, o[cb], 0, 0, 0); } }
#pragma unroll
            for (int ks = 0; ks < NKS; ++ks) { const bf16x8_t af = *(const LAS bf16x8_t*)(QT + (rb * 16 + c16) * QS + ks * 32 + 8 * g4);
#pragma unroll
                for (int cb = 0; cb < 4; ++cb) { const bf16x8_t bf = *(const LAS bf16x8_t*)(STc + (cb * 16 + c16) * QS + ks * 32 + 8 * g4); o[cb] = __builtin_amdgcn_mfma_f32_16x16x32_bf16(af, bf, o[cb], 0, 0, 0); } }
#pragma unroll
            for (int r = 0; r < 4; ++r) {
                float s = (o[0][r] + o[1][r]) + (o[2][r] + o[3][r]); float y[4];
                if (RET) { s += __shfl_xor(s, 1); s += __shfl_xor(s, 2); s += __shfl_xor(s, 4); s += __shfl_xor(s, 8); const float mean = s * (1.0f / 64);
                    float q2 = 0.f;
#pragma unroll
                    for (int cb = 0; cb < 4; ++cb) { y[cb] = o[cb][r] - mean; q2 += y[cb] * y[cb]; }
                    q2 += __shfl_xor(q2, 1); q2 += __shfl_xor(q2, 2); q2 += __shfl_xor(q2, 4); q2 += __shfl_xor(q2, 8); const float rs = rsqrtf(q2 * (1.0f / 64) + EPS);
#pragma unroll
                    for (int cb = 0; cb < 4; ++cb) y[cb] *= rs;
                } else { float q2 = (o[0][r] * o[0][r] + o[1][r] * o[1][r]) + (o[2][r] * o[2][r] + o[3][r] * o[3][r]);
                    q2 += __shfl_xor(q2, 1); q2 += __shfl_xor(q2, 2); q2 += __shfl_xor(q2, 4); q2 += __shfl_xor(q2, 8); const float rs = rsqrtf(q2 * (1.0f / 64) + EPS);
#pragma unroll
                    for (int cb = 0; cb < 4; ++cb) y[cb] = o[cb][r] * rs; }
                const int tok = c * 64 + rb * 16 + 4 * g4 + r;
                if (tok < nt) { const size_t row = (size_t)(row0 + tok);
#pragma unroll
                    for (int cb = 0; cb < 4; ++cb) { const int dv = cb * 16 + c16; const float g = bf2f(ZM[row * NMIXP + (RET ? R_G : G_R) + h * 64 + dv]);
                        BR[row * D + (RET ? 256 : 512) + h * 64 + dv] = (bf16)f2bf(siluf_(g) * y[cb] * gnv[cb]); } }
            }
        } else {
            const int dvb = wave - 4; LAS bf16* STn = ST + (cur ^ 1) * 64 * QS;
            f32x4 ds[NKB];
#pragma unroll
            for (int cb = 0; cb < NKB; ++cb) ds[cb] = (f32x4){0.f, 0.f, 0.f, 0.f};
#pragma unroll
            for (int ks = 0; ks < 2; ++ks) { const bf16x8_t af = *(const LAS bf16x8_t*)(VT + (dvb * 16 + c16) * TS + ks * 32 + 8 * g4);
#pragma unroll
                for (int cb = 0; cb < NKB; ++cb) { const bf16x8_t bf = *(const LAS bf16x8_t*)(KE + (cb * 16 + c16) * TS + ks * 32 + 8 * g4); ds[cb] = __builtin_amdgcn_mfma_f32_16x16x32_bf16(af, bf, ds[cb], 0, 0, 0); } }
#pragma unroll
            for (int cb = 0; cb < NKB; ++cb) { const float eB = RET ? exp2f(lg2 * (float)nvc) : __expf(WT[cb * 16 + c16]);
#pragma unroll
                for (int r = 0; r < 4; ++r) { Sreg[cb][r] = eB * Sreg[cb][r] + ds[cb][r]; STn[(dvb * 16 + 4 * g4 + r) * QS + cb * 16 + c16] = (bf16)f2bf(Sreg[cb][r]); } }
        }
        LDS_WAIT(); __builtin_amdgcn_s_barrier(); asm volatile("" ::: "memory");
        cur ^= 1;
    }
#undef LA_LOAD
    if (wave >= 4) {
        float* so = C.out + (RET ? (smp ? O_RS + (((size_t)l * DB + b) * 4 + h) * DK * 64 : O_RP + (((size_t)l * BATCH + b) * 4 + h) * DK * 64)
                                 : (smp ? O_GS + (((size_t)l * DB + b) * 4 + h) * DK * 64 : O_GP + (((size_t)l * BATCH + b) * 4 + h) * DK * 64));
#pragma unroll
        for (int cb = 0; cb < NKB; ++cb)
#pragma unroll
            for (int r = 0; r < 4; ++r) so[(cb * 16 + c16) * 64 + (wave - 4) * 16 + 4 * g4 + r] = Sreg[cb][r];
    }
}
__device__ __forceinline__ void n2_la_chunked(const Ctx& C, int l) {
    const int bx = blockIdx.x;
    if (bx < 32) { const int b = (bx >> 2) & 3, h = bx & 3; if (bx < 16) la_chunked<64, true>(C, l, false, b, h); else la_chunked<32, false>(C, l, false, b, h); }
    else { for (int it = bx - 32; it < 256; it += C.G - 32) { const int b = (it >> 2) & 31, h = it & 3; if (it < 128) la_chunked<64, true>(C, l, true, b, h); else la_chunked<32, false>(C, l, true, b, h); } }
}
typedef float f32x16_t __attribute__((ext_vector_type(16)));
__device__ __forceinline__ int crow_(int r, int hi) { return (r & 3) + 8 * (r >> 2) + 4 * hi; }
__device__ __forceinline__ float swapmax32(float m) { auto rr = __builtin_amdgcn_permlane32_swap(__float_as_uint(m), __float_as_uint(m), false, false); return fmaxf(__uint_as_float(rr[0]), __uint_as_float(rr[1])); }
__device__ __forceinline__ float swapadd32(float m) { auto rr = __builtin_amdgcn_permlane32_swap(__float_as_uint(m), __float_as_uint(m), false, false); return __uint_as_float(rr[0]) + __uint_as_float(rr[1]); }
constexpr float LOG2E = 1.4426950408889634f;
__device__ __forceinline__ void attn_prompt_item(const Ctx& C, int l, int b, int h, int qb, float lam, float lam_init) {
    THREAD_IDS();
    constexpr int KS = 72;
    LAS bf16* Kt = (LAS bf16*)C.lds;
    LAS bf16* Vt = Kt + 2 * 64 * KS;
    LAS float* BT = (LAS float*)(Vt + 2 * 64 * KS);
    LAS float* OX = BT + 128;
    const bf16* ZM = WSP(bf16, WS_ZMIX); const bf16* QNB = WSP(bf16, WS_QNB); const bf16* KNB = WSP(bf16, WS_KNB); bf16* BR = WSP(bf16, WS_BR);
    const int r32 = lane & 31, hi = lane >> 5, qs = wave >> 1, s = wave & 1;
    const int q0 = qb * 128 + qs * 32; const int rowb = b * L;
    if (tid < 128) BT[tid] = (C.in[I_RELB][t5_bucket(tid) * 4 + h] - C.in[I_RELB][31 * 4 + h]) * LOG2E;
    pg8::bf16x8 qf[2];
#pragma unroll
    for (int d0 = 0; d0 < 2; ++d0) qf[d0] = *(const pg8::bf16x8*)(QNB + (size_t)(rowb + q0 + r32) * 256 + h * 64 + s * 32 + 16 * d0 + 8 * hi);
    const int pl = (lane & ~15) | ((lane & 8) >> 1) | ((lane & 4) << 1) | (lane & 3);
    const int NT = (min(128 * (qb + 1), L) + 63) >> 6;
    v4u kreg, vreg;
#define AT_LOAD(j) do { const size_t r_ = (size_t)(rowb + (j) * 64 + lane); kreg = *(const v4u*)(KNB + r_ * 256 + h * 64 + 8 * wave); vreg = *(const v4u*)(ZM + r_ * NMIXP + D_V + h * 64 + 8 * wave); } while (0)
#define AT_STORE(buf) do { *(LAS v4u*)(Kt + (buf) * 64 * KS + lane * KS + 8 * wave) = kreg; LAS bf16* v_ = Vt + (buf) * 64 * KS + (8 * wave) * KS + pl; \
        v_[0] = (bf16)(vreg.x & 0xffffu); v_[KS] = (bf16)(vreg.x >> 16); v_[2 * KS] = (bf16)(vreg.y & 0xffffu); v_[3 * KS] = (bf16)(vreg.y >> 16); \
        v_[4 * KS] = (bf16)(vreg.z & 0xffffu); v_[5 * KS] = (bf16)(vreg.z >> 16); v_[6 * KS] = (bf16)(vreg.w & 0xffffu); v_[7 * KS] = (bf16)(vreg.w >> 16); } while (0)
    AT_LOAD(0); AT_STORE(0); if (NT > 1) AT_LOAD(1);
    LDS_WAIT(); __builtin_amdgcn_s_barrier(); asm volatile("" ::: "memory");
    float m = -INFINITY, lsum = 0.f; f32x16_t o[2];
#pragma unroll
    for (int i = 0; i < 16; ++i) { o[0][i] = 0.f; o[1][i] = 0.f; }
    for (int j = 0; j < NT; ++j) {
        const int k0 = 64 * j, buf = j & 1;
        if (k0 <= q0 + 31) {
            const LAS bf16* kb = Kt + buf * 64 * KS; const LAS bf16* vb = Vt + buf * 64 * KS;
            f32x16_t p0, p1;
#pragma unroll
            for (int i = 0; i < 16; ++i) { p0[i] = 0.f; p1[i] = 0.f; }
#pragma unroll
            for (int d0 = 0; d0 < 2; ++d0) { const pg8::bf16x8 a0 = *(const LAS pg8::bf16x8*)(kb + r32 * KS + s * 32 + 16 * d0 + 8 * hi), a1 = *(const LAS pg8::bf16x8*)(kb + (32 + r32) * KS + s * 32 + 16 * d0 + 8 * hi);
                p0 = __builtin_amdgcn_mfma_f32_32x32x16_bf16(a0, qf[d0], p0, 0, 0, 0); p1 = __builtin_amdgcn_mfma_f32_32x32x16_bf16(a1, qf[d0], p1, 0, 0, 0); }
            if (q0 - k0 - 63 < 113) {
#pragma unroll
                for (int r = 0; r < 16; ++r) { const int n0 = (q0 + r32) - (k0 + crow_(r, hi)), n1 = n0 - 32;
                    p0[r] = n0 < 0 ? -INFINITY : p0[r] + (n0 < 128 ? BT[n0] : 0.f); p1[r] = n1 < 0 ? -INFINITY : p1[r] + (n1 < 128 ? BT[n1] : 0.f); } }
            float mt = fmaxf(p0[0], p1[0]);
#pragma unroll
            for (int r = 1; r < 16; ++r) mt = fmaxf(mt, fmaxf(p0[r], p1[r]));
            mt = swapmax32(mt);
            const float mn = fmaxf(m, mt);
            if (__any(mn > m)) { const float al = exp2f(m - mn);
#pragma unroll
                for (int i = 0; i < 16; ++i) { o[0][i] *= al; o[1][i] *= al; }
                lsum *= al; m = mn; }
            float ps = 0.f;
#pragma unroll
            for (int r = 0; r < 16; ++r) { p0[r] = exp2f(p0[r] - m); p1[r] = exp2f(p1[r] - m); ps += p0[r] + p1[r]; }
            lsum += ps;
            pg8::bf16x8 pb[4];
#pragma unroll
            for (int ks = 0; ks < 4; ++ks) { v4u w;
                if (ks < 2) { w.x = pg8::cvt_pk_bf16(p0[8 * ks], p0[8 * ks + 1]); w.y = pg8::cvt_pk_bf16(p0[8 * ks + 2], p0[8 * ks + 3]); w.z = pg8::cvt_pk_bf16(p0[8 * ks + 4], p0[8 * ks + 5]); w.w = pg8::cvt_pk_bf16(p0[8 * ks + 6], p0[8 * ks + 7]); }
                else { w.x = pg8::cvt_pk_bf16(p1[8 * ks - 16], p1[8 * ks - 15]); w.y = pg8::cvt_pk_bf16(p1[8 * ks - 14], p1[8 * ks - 13]); w.z = pg8::cvt_pk_bf16(p1[8 * ks - 12], p1[8 * ks - 11]); w.w = pg8::cvt_pk_bf16(p1[8 * ks - 10], p1[8 * ks - 9]); }
                pb[ks] = __builtin_bit_cast(pg8::bf16x8, w); }
#pragma unroll
            for (int d0 = 0; d0 < 2; ++d0)
#pragma unroll
                for (int ks = 0; ks < 4; ++ks) { const pg8::bf16x8 af = *(const LAS pg8::bf16x8*)(vb + (32 * d0 + r32) * KS + 16 * ks + 8 * hi); o[d0] = __builtin_amdgcn_mfma_f32_32x32x16_bf16(af, pb[ks], o[d0], 0, 0, 0); }
        }
        if (j + 1 < NT) AT_STORE(buf ^ 1);
        if (j + 2 < NT) AT_LOAD(j + 2);
        LDS_WAIT(); __builtin_amdgcn_s_barrier(); asm volatile("" ::: "memory");
    }
#undef AT_LOAD
#undef AT_STORE
    lsum = swapadd32(lsum); const float inv = 1.0f / lsum;
    LAS float* ox = OX + (qs * 32 + r32) * 65;
    if (s == 1) {
#pragma unroll
        for (int d0 = 0; d0 < 2; ++d0)
#pragma unroll
            for (int r = 0; r < 16; ++r) ox[32 * d0 + crow_(r, hi)] = o[d0][r] * inv; }
    LDS_WAIT(); __builtin_amdgcn_s_barrier(); asm volatile("" ::: "memory");
    if (s == 0) {
        float ss = 0.f;
#pragma unroll
        for (int d0 = 0; d0 < 2; ++d0)
#pragma unroll
            for (int r = 0; r < 16; ++r) { const float v = o[d0][r] * inv - lam * ox[32 * d0 + crow_(r, hi)]; o[d0][r] = v; ss += v * v; }
        ss = swapadd32(ss); const float rs = rsqrtf(ss * (1.0f / 64) + EPS) * (1.0f - lam_init);
        const int qpos = q0 + r32;
        if (qpos < L) { bf16* brp = BR + (size_t)(rowb + qpos) * D + 768 + h * 64;
#pragma unroll
            for (int d0 = 0; d0 < 2; ++d0)
#pragma unroll
                for (int r4 = 0; r4 < 4; ++r4) { const int dv = 32 * d0 + 8 * r4 + 4 * hi; const float* sl = C.in[I_SUBLN] + l * 64 + dv;
                    const unsigned w0 = pk2(o[d0][4 * r4] * rs * sl[0], o[d0][4 * r4 + 1] * rs * sl[1]), w1 = pk2(o[d0][4 * r4 + 2] * rs * sl[2], o[d0][4 * r4 + 3] * rs * sl[3]);
                    *(unsigned long long*)(brp + dv) = (unsigned long long)w0 | ((unsigned long long)w1 << 32); } }
    }
    LDS_WAIT(); __builtin_amdgcn_s_barrier(); asm volatile("" ::: "memory");
}
__device__ __forceinline__ void n2_attn_prompt_mfma(const Ctx& C, int l, float lam_init) {
    THREAD_IDS();
    const float lam = lam_of(C, l, lam_init);
    unsigned* qw = (unsigned*)(C.ws + WS_CTL) + CW_QUEUE + 64 * l;
    volatile LAS int* slot = (volatile LAS int*)(C.lds + MISC_OFF + 64);
    constexpr int NQB = (L + 127) / 128;
    for (;;) {
        if (tid == 0) slot[0] = (int)__hip_atomic_fetch_add(qw, 1u, __ATOMIC_RELAXED, __HIP_MEMORY_SCOPE_AGENT);
        __syncthreads();
        const int it = slot[0];
        if (it >= 16 * NQB) break;
        attn_prompt_item(C, l, (it & 15) >> 2, it & 3, NQB - 1 - (it >> 4), lam, lam_init);
    }
}
constexpr int PSTR = 68;
__device__ __forceinline__ pg8::bf16x8 cvt8(const f32x4 a, const f32x4 b) { v4u w; w.x = pg8::cvt_pk_bf16(a[0], a[1]); w.y = pg8::cvt_pk_bf16(a[2], a[3]); w.z = pg8::cvt_pk_bf16(b[0], b[1]); w.w = pg8::cvt_pk_bf16(b[2], b[3]); return __builtin_bit_cast(pg8::bf16x8, w); }
__device__ __forceinline__ void attn_sample_item(const Ctx& C, int l, int b, int split) {
    THREAD_IDS();
    const int h = wave & 3, half = wave >> 2, c16 = lane & 15, g = lane >> 4, srow = c16 >> 3, t = c16 & 7;
    const bf16* QNB = WSP(bf16, WS_QNB); const int* PT = (const int*)C.in[I_PT];
    const float* CK = C.in[I_CK] + (size_t)l * NPOOL * PAGE * 256; const float* CV = C.in[I_CV] + (size_t)l * NPOOL * PAGE * 256;
    LAS float* BT = (LAS float*)C.lds;
    BT[tid] = (C.in[I_RELB][t5_bucket(tid & 127) * 4 + (tid >> 7)] - C.in[I_RELB][31 * 4 + (tid >> 7)]) * LOG2E;
    const v4u z4 = {0u, 0u, 0u, 0u};
    const v4u q0w = srow == 0 ? *(const v4u*)(QNB + (size_t)(MP + b * 8 + t) * 256 + h * 64 + 8 * g) : z4, q1w = srow == 1 ? *(const v4u*)(QNB + (size_t)(MP + b * 8 + t) * 256 + h * 64 + 32 + 8 * g) : z4;
    const pg8::bf16x8 qf0 = __builtin_bit_cast(pg8::bf16x8, q0w), qf1 = __builtin_bit_cast(pg8::bf16x8, q1w);
    LDS_WAIT(); __builtin_amdgcn_s_barrier(); asm volatile("" ::: "memory");
    float m = -INFINITY, lsum = 0.f; f32x4 o[4];
#pragma unroll
    for (int db = 0; db < 4; ++db) o[db] = (f32x4){0.f, 0.f, 0.f, 0.f};
    const int kk0 = split * 1024 + half * 512;
    for (int step = 0; step < 16; ++step) {
        const int kk = kk0 + 32 * step; const int page = PT[b * NPAGES + (kk >> 7)];
        const size_t base = ((size_t)(page * PAGE + (kk & 127)) * 4 + h) * 64;
        f32x4 kr[2][2][2]; float vr[4][8];
#pragma unroll
        for (int T = 0; T < 2; ++T)
#pragma unroll
            for (int ks = 0; ks < 2; ++ks) { const float* p = CK + base + (size_t)(16 * T + c16) * 256 + 32 * ks + 8 * g; kr[T][ks][0] = *(const f32x4*)p; kr[T][ks][1] = *(const f32x4*)(p + 4); }
#pragma unroll
        for (int db = 0; db < 4; ++db)
#pragma unroll
            for (int j = 0; j < 8; ++j) { const int kv = j < 4 ? 4 * g + j : 16 + 4 * g + (j - 4); vr[db][j] = CV[base + (size_t)kv * 256 + 16 * db + c16]; }
        f32x4 sv[2];
#pragma unroll
        for (int T = 0; T < 2; ++T) { sv[T] = (f32x4){0.f, 0.f, 0.f, 0.f};
            sv[T] = __builtin_amdgcn_mfma_f32_16x16x32_bf16(cvt8(kr[T][0][0], kr[T][0][1]), qf0, sv[T], 0, 0, 0);
            sv[T] = __builtin_amdgcn_mfma_f32_16x16x32_bf16(cvt8(kr[T][1][0], kr[T][1][1]), qf1, sv[T], 0, 0, 0); }
        if (kk + 31 + 128 > PAST) {
#pragma unroll
            for (int T = 0; T < 2; ++T)
#pragma unroll
                for (int r = 0; r < 4; ++r) { const int n = PAST + t - (kk + 16 * T + 4 * g + r); if (n < 128) sv[T][r] += BT[h * 128 + n]; } }
        float mt = fmaxf(fmaxf(fmaxf(sv[0][0], sv[0][1]), fmaxf(sv[0][2], sv[0][3])), fmaxf(fmaxf(sv[1][0], sv[1][1]), fmaxf(sv[1][2], sv[1][3])));
        mt = fmaxf(mt, __shfl_xor(mt, 16)); mt = fmaxf(mt, __shfl_xor(mt, 32));
        const float mn = fmaxf(m, mt); const float al = exp2f(m - mn); m = mn;
        float ps = 0.f;
#pragma unroll
        for (int T = 0; T < 2; ++T)
#pragma unroll
            for (int r = 0; r < 4; ++r) { sv[T][r] = exp2f(sv[T][r] - m); ps += sv[T][r]; }
        lsum = lsum * al + ps;
        const pg8::bf16x8 pf = cvt8(sv[0], sv[1]);
#pragma unroll
        for (int db = 0; db < 4; ++db) { o[db] = o[db] * al;
            const f32x4 va = {vr[db][0], vr[db][1], vr[db][2], vr[db][3]}, vb = {vr[db][4], vr[db][5], vr[db][6], vr[db][7]};
            o[db] = __builtin_amdgcn_mfma_f32_16x16x32_bf16(cvt8(va, vb), pf, o[db], 0, 0, 0); }
    }
    lsum += __shfl_xor(lsum, 16); lsum += __shfl_xor(lsum, 32);
    float* pp = WSP(float, WS_PART) + ((((size_t)b * 4 + h) * 16 + split * 2 + half) * 16 + c16) * PSTR;
#pragma unroll
    for (int db = 0; db < 4; ++db) *(f32x4*)(pp + 16 * db + 4 * g) = o[db];
    if (g == 0) { pp[64] = m; pp[65] = lsum; }
    LDS_WAIT(); __builtin_amdgcn_s_barrier(); asm volatile("" ::: "memory");
}
__device__ __forceinline__ void n2_attn_sample_split(const Ctx& C, int l) {
    for (int it = blockIdx.x; it < DB * 8; it += C.G) attn_sample_item(C, l, it >> 3, it & 7);
}
__device__ __forceinline__ void n3_attn_sample_combine(const Ctx& C, int l, float lam_init) {
    THREAD_IDS();
    const float lam = lam_of(C, l, lam_init);
    const bf16* QNB = WSP(bf16, WS_QNB); const bf16* KNB = WSP(bf16, WS_KNB); const bf16* ZM = WSP(bf16, WS_ZMIX); bf16* BR = WSP(bf16, WS_BR);
    for (int it = gw; it < DB * 4 * DS; it += NGW) {
        const int b = it >> 5, h = (it >> 3) & 3, t = it & 7; float os[2];
        const float far = C.in[I_RELB][31 * 4 + h];
#pragma unroll
        for (int s = 0; s < 2; ++s) {
            const float* pb = WSP(float, WS_PART) + ((((size_t)b * 4 + h) * 16) * 16 + s * 8 + t) * PSTR;
            float sn[8]; float mm = -INFINITY;
            for (int pi = 0; pi < 16; ++pi) mm = fmaxf(mm, pb[(size_t)pi * 16 * PSTR + 64]);
#pragma unroll
            for (int jj = 0; jj < 8; ++jj) { float d = 0.f;
                for (int i = 0; i < 32; ++i) d += bf2f(QNB[(size_t)(MP + b * 8 + t) * 256 + h * 64 + s * 32 + i]) * bf2f(KNB[(size_t)(MP + b * 8 + jj) * 256 + h * 64 + s * 32 + i]);
                d += (C.in[I_RELB][t5_bucket(t - jj < 0 ? 0 : t - jj) * 4 + h] - far) * LOG2E;
                sn[jj] = jj <= t ? d : -INFINITY; mm = fmaxf(mm, sn[jj]); }
            float ll = 0.f, oo = 0.f;
            for (int pi = 0; pi < 16; ++pi) { const float* pr = pb + (size_t)pi * 16 * PSTR; const float w = exp2f(pr[64] - mm); ll += pr[65] * w; oo += pr[lane] * w; }
#pragma unroll
            for (int jj = 0; jj < 8; ++jj) { const float w = exp2f(sn[jj] - mm); ll += w; oo += w * bf2f(ZM[(size_t)(MP + b * 8 + jj) * NMIXP + D_V + h * 64 + lane]); }
            os[s] = oo / ll;
        }
        const float o = os[0] - lam * os[1]; const float ms = wave_sum(o * o) * (1.0f / 64);
        BR[(size_t)(MP + b * 8 + t) * D + 768 + h * 64 + lane] = (bf16)f2bf(o * rsqrtf(ms + EPS) * C.in[I_SUBLN][l * 64 + lane] * (1.0f - lam_init));
    }
}

template <int l> __device__ __forceinline__ void layer_fwd(const Ctx& C, const XcdBarrier& bar) {
#define GRID_BAR() xcd_barrier<false>(bar)
    LAS unsigned char* ring = C.lds + RING_OFF;
    float* SS = WSP(float, WS_SS); float* H = WSP(float, WS_H); bf16* HB = WSP(bf16, WS_HB); bf16* ACT = WSP(bf16, WS_ACT); bf16* ZMIX = WSP(bf16, WS_ZMIX); bf16* GATES = WSP(bf16, WS_GATES);
    bf16* BR = WSP(bf16, WS_BR); bf16* MERGED = WSP(bf16, WS_MERGED);
    constexpr float lam_init = l == 0 ? 0.2f : 0.35550906759096926f;
    constexpr bool last = (l == DEPTH - 1);
    { pg8::Gemm g{HB, WSP(bf16, WS_W1 + (size_t)(l * 2 + 0) * SZ_W1), D, D, D}; pg8::StaticOrder S; S.init(M, 2 * DFF, C.G, (int)blockIdx.x);
      EpiGLU E{ACT, SS + (size_t)(l * 3 + 0) * M * 16}; pg8::gemm_phase<EpiGLU, pg8::StaticOrder, true, true>(ring, g, S, E); }
    GRID_BAR();
    { pg8::Gemm g{ACT, WSP(bf16, WS_WD + (size_t)(l * 2 + 0) * SZ_WD), DFF, DFF, DFF}; pg8::StaticOrder S; S.init(M, D, C.G, (int)blockIdx.x);
      EpiRes<false, 1> E{H, HB, SS + (size_t)(l * 3 + 1) * M * 16, nullptr}; pg8::gemm_phase<EpiRes<false, 1>, pg8::StaticOrder, true, true>(ring, g, S, E); }
    GRID_BAR();
    { pg8::Gemm g{HB, WSP(bf16, WS_WIN + (size_t)l * SZ_WIN), D, D, D}; pg8::StaticOrder S; S.init(M, NINP, C.G, (int)blockIdx.x);
      EpiZ E{ZMIX, GATES, SS + (size_t)(l * 3 + 1) * M * 16, WSP(float, WS_BINP) + l * NINP}; pg8::gemm_phase<EpiZ, pg8::StaticOrder, true, true>(ring, g, S, E); }
    GRID_BAR();
    n1_prep(C, l);
    GRID_BAR();
    n2_attn_sample_split(C, l);
    n2_la_chunked(C, l);
    n2_attn_prompt_mfma(C, l, lam_init);
    n2_conv(C, l);
    GRID_BAR();
    n3_attn_sample_combine(C, l, lam_init);
    GRID_BAR();
    { pg8::Gemm g{BR, WSP(bf16, WS_WBR + (size_t)l * SZ_WBR), D, 256, 256}; pg8::MergeOrder S; S.init(M, C.G, (int)blockIdx.x);
      EpiMerge E{MERGED, GATES}; pg8::gemm_phase<EpiMerge, pg8::MergeOrder, true, true>(ring, g, S, E); }
    GRID_BAR();
    { pg8::Gemm g{MERGED, WSP(bf16, WS_WOUT + (size_t)l * SZ_WOUT), D, D, D}; pg8::StaticOrder S; S.init(M, D, C.G, (int)blockIdx.x);
      EpiRes<false, 2> E{H, HB, SS + (size_t)(l * 3 + 2) * M * 16, nullptr}; pg8::gemm_phase<EpiRes<false, 2>, pg8::StaticOrder, true, true>(ring, g, S, E); }
    GRID_BAR();
    { pg8::Gemm g{HB, WSP(bf16, WS_W1 + (size_t)(l * 2 + 1) * SZ_W1), D, D, D}; pg8::StaticOrder S; S.init(M, 2 * DFF, C.G, (int)blockIdx.x);
      EpiGLU E{ACT, SS + (size_t)(l * 3 + 2) * M * 16}; pg8::gemm_phase<EpiGLU, pg8::StaticOrder, true, true>(ring, g, S, E); }
    GRID_BAR();
    { pg8::Gemm g{ACT, WSP(bf16, WS_WD + (size_t)(l * 2 + 1) * SZ_WD), DFF, DFF, DFF}; pg8::StaticOrder S; S.init(M, D, C.G, (int)blockIdx.x);
      EpiRes<last, 1> E{H, HB, last ? nullptr : SS + (size_t)((l + 1) * 3) * M * 16, C.out};
      pg8::gemm_phase<EpiRes<last, 1>, pg8::StaticOrder, true, true>(ring, g, S, E); }
#undef GRID_BAR
}

__global__ void __launch_bounds__(NWAVES * 64, 2) fwd(Params P) {
    extern __shared__ __attribute__((aligned(16))) unsigned char lds[];
    Ctx C;
    C.in = P.in; C.out = P.out; C.ws = P.ws; C.lds = (LAS unsigned char*)lds;
    C.G = gridDim.x;
    volatile LAS unsigned* MISC = (volatile LAS unsigned*)(C.lds + MISC_OFF);
    for (int u = threadIdx.x; u < (LDS_BYTES - LDSCTL_OFF) / 4; u += NWAVES * 64) ((LAS unsigned*)(C.lds + LDSCTL_OFF))[u] = 0u;
    __syncthreads();
    unsigned* ctl = (unsigned*)(C.ws + WS_CTL);
    XcdBarrier bar = xcd_barrier_post(ctl + CW_BAR, MISC + 8);
    p0_prologue(C, P);
    xcd_barrier<true>(bar);
    layer_fwd<0>(C, bar);
    xcd_barrier<false>(bar);
    layer_fwd<1>(C, bar);
}

extern "C" void kernel_launch(void* const* d_in, const int* in_sizes, int n_in, void* d_out, int out_size, void* d_ws, size_t ws_size, hipStream_t stream) {
    static int grid = 0;
    if (grid == 0) {
        if (n_in != N_INPUTS || (size_t)out_size != O_END || ws_size < WS_END) { fprintf(stderr, "kernel_launch: unexpected shapes: n_in %d out %d (want %zu) ws %zu (want %zu)\n", n_in, out_size, (size_t)O_END, ws_size, (size_t)WS_END); grid = -1; return; }
        int dev = 0, cus = 0, per_cu = 0;
        if (hipGetDevice(&dev) != hipSuccess || hipDeviceGetAttribute(&cus, hipDeviceAttributeMultiprocessorCount, dev) != hipSuccess) { grid = -1; return; }
        if (hipFuncSetAttribute((const void*)fwd, hipFuncAttributeMaxDynamicSharedMemorySize, LDS_BYTES) != hipSuccess) { fprintf(stderr, "kernel_launch: hipFuncSetAttribute failed\n"); grid = -1; return; }
        if (hipOccupancyMaxActiveBlocksPerMultiprocessor(&per_cu, (const void*)fwd, NWAVES * 64, LDS_BYTES) != hipSuccess || per_cu < 1) { fprintf(stderr, "kernel_launch: occupancy query says %d blocks per CU\n", per_cu); }
        (void)hipGetLastError();
        grid = cus;
    }
    if (grid < 0) return;
    if (hipMemsetAsync((char*)d_ws + WS_CTL, 0, CTL_ZERO_BYTES, stream) != hipSuccess) return;
    Params p{};
    for (int i = 0; i < N_INPUTS; ++i) p.in[i] = (const float*)d_in[i];
    p.out = (float*)d_out; p.ws = (unsigned char*)d_ws;
    for (int i = 0; i < 32; ++i) p.inv_freq[i] = (float)pow(10000.0, -(double)i / 32.0);
    hipLaunchKernelGGL(fwd, dim3(grid), dim3(NWAVES * 64), LDS_BYTES, stream, p);
}
```

```cpp
#include <hip/hip_runtime.h>
#include <cstdio>
#include <cstdint>
#include <cmath>

namespace pg8 {
#define PG8_LAS __attribute__((address_space(3)))
typedef unsigned short bf16_t;
typedef short bf16x8 __attribute__((ext_vector_type(8)));
typedef float f32x4 __attribute__((ext_vector_type(4)));
typedef unsigned u32x4 __attribute__((ext_vector_type(4)));
constexpr int BM = 256, BK = 64, HALF = 128, HTB = HALF * BK * 2  , STAGE_BYTES = 8 * HTB, NXCD = 8, WGM = 8;

__host__ __device__ __forceinline__ int lds_byte(int r, int c) { const int st = (r >> 4) * 2 + (c >> 5), rr = r & 15, cc = c & 31, ob = rr * 64 + cc * 2; return st * 1024 + (ob ^ (((ob >> 9) & 1) << 5)); }
__host__ __device__ __forceinline__ void stage_rc(int b, int& R, int& C) { const int st = b / 1024, sb = b % 1024, swz = sb ^ (((sb >> 9) & 1) << 5); R = (st >> 1) * 16 + swz / 64; C = (st & 1) * 32 + (swz % 64) / 2; }
__host__ __device__ __forceinline__ int perm32(int rho) { const int n = rho >> 4, i = rho & 15; return 8 * (i >> 2) + 4 * n + (i & 3); }

struct Unit { int pm, pn, acol; };
struct Gemm { const bf16_t* A; const bf16_t* Bt; int lda, ldb, K; };

struct StaticOrder {
    int nM, nN, nwg, G, c;
    __host__ __device__ void init(int M, int N, int G_, int c_) { nM = M / BM; nN = N / BM; nwg = nM * nN; G = G_; c = c_; }
    __host__ __device__ bool next(int i, Unit& u) const {
        const long L = (long)i * G + c; if (L >= nwg) return false;
        int wgid = (int)L; { const int q = nwg / NXCD, r = nwg % NXCD, xcd = wgid % NXCD, off = wgid / NXCD; wgid = (xcd < r ? xcd * (q + 1) : r * (q + 1) + (xcd - r) * q) + off; }
        const int nig = WGM * nN, gid = wgid / nig, fm = gid * WGM, gsz = (nM - fm) < WGM ? (nM - fm) : WGM;
        u.pm = fm + ((wgid % nig) % gsz); u.pn = (wgid % nig) / gsz; u.acol = 0; return true;
    }
};
struct MergeOrder {
    int ntile, G, c;
    __host__ __device__ void init(int M, int G_, int c_) { ntile = (M / BM) * 4; G = G_; c = c_; }
    __host__ __device__ bool next(int i, Unit& u) const {
        const int T = (i >> 2) * G + c; if (T >= ntile) return false;
        const int n = i & 3; u.pm = T >> 2; u.pn = n * 4 + (T & 3); u.acol = n * 256; return true;
    }
};

__device__ __forceinline__ unsigned cvt_pk_bf16(float lo, float hi) { unsigned r; asm volatile("v_cvt_pk_bf16_f32 %0, %1, %2" : "=v"(r) : "v"(lo), "v"(hi)); return r; }

template <class Epi, class Sched, bool ALIGN_EPI = false, bool SP2 = false>
__device__ __forceinline__ void gemm_phase(PG8_LAS unsigned char* lds, const Gemm g, const Sched& S, const Epi& E) {
    int tid_ = threadIdx.x; asm volatile("" : "+v"(tid_));
    const int tid = tid_, wid = __builtin_amdgcn_readfirstlane(tid >> 6), lane = tid & 63, wr = wid >> 2, wc = wid & 3, fr = lane & 15, fq = lane >> 4;
    const int nt = g.K / BK;
    unsigned voffA[2], voffB[2];
#pragma unroll
    for (int i = 0; i < 2; ++i) { int R, C; stage_rc(tid * 16 + i * 8192, R, C); const int Rb = Epi::PERM ? ((R & ~31) + perm32(R & 31)) : R;
        voffA[i] = (unsigned)(R * g.lda + C) * 2u; voffB[i] = (unsigned)(Rb * g.ldb + C) * 2u; }
    const size_t kstep = (size_t)(BK * 2);
    const size_t hstepA = (size_t)HALF * g.lda * 2, hstepB = (size_t)HALF * g.ldb * 2;
    const size_t tstepA = 2 * hstepA, tstepB = 2 * hstepB;
    const unsigned ldsw = (unsigned)wid * 1024u;
    const int aoff = lds_byte(wr * 64 + fr, fq * 8), boff = lds_byte(wc * 32 + fr, fq * 8);
#define PG8_SA(b, h) (((b) * 2 + (h)) * HTB)
#define PG8_SB(b, h) ((4 + (b) * 2 + (h)) * HTB)
#define PG8_STAGE(bufoff, gbase, voff) do { _Pragma("unroll") for (int _i = 0; _i < 2; ++_i) \
        __builtin_amdgcn_global_load_lds((const unsigned*)((const char*)(gbase) + (voff)[_i]), (PG8_LAS unsigned*)(lds + (bufoff) + ldsw + _i * 8192), 16, 0, 0); } while (0)
#define PG8_LDA(dst, b, h) do { _Pragma("unroll") for (int m = 0; m < 4; ++m) _Pragma("unroll") for (int k = 0; k < 2; ++k) dst[m][k] = *(const PG8_LAS bf16x8*)(lds + PG8_SA(b, h) + aoff + m * 2048 + k * 1024); } while (0)
#define PG8_LDB(dst, b, h) do { _Pragma("unroll") for (int n = 0; n < 2; ++n) _Pragma("unroll") for (int k = 0; k < 2; ++k) dst[n][k] = *(const PG8_LAS bf16x8*)(lds + PG8_SB(b, h) + boff + n * 2048 + k * 1024); } while (0)
#define PG8_MMA(ai, bj, At, Bt) do { __builtin_amdgcn_s_setprio(1); _Pragma("unroll") for (int m = 0; m < 4; ++m) _Pragma("unroll") for (int n = 0; n < 2; ++n) _Pragma("unroll") for (int k = 0; k < 2; ++k) \
        acc[ai][bj][m][n] = __builtin_amdgcn_mfma_f32_16x16x32_bf16(Bt[n][k], At[m][k], acc[ai][bj][m][n], 0, 0, 0); __builtin_amdgcn_s_setprio(0); } while (0)
#define PG8_WAIT_V(n) asm volatile("s_waitcnt vmcnt(" #n ")" ::: "memory")
#define PG8_WAIT_L(n) asm volatile("s_waitcnt lgkmcnt(" #n ")" ::: "memory")
#define PG8_BAR __builtin_amdgcn_s_barrier()
#define PG8_SCHED __builtin_amdgcn_sched_barrier(0)
    Unit cur, nxt; int ui = 0;
    if (!S.next(0, cur)) return;
    f32x4 acc[2][2][4][2];
#pragma unroll
    for (int a = 0; a < 2; ++a)
#pragma unroll
        for (int b = 0; b < 2; ++b)
#pragma unroll
            for (int m = 0; m < 4; ++m)
#pragma unroll
                for (int n = 0; n < 2; ++n) acc[a][b][m][n] = (f32x4){0.f, 0.f, 0.f, 0.f};
    bf16x8 At[4][2], B0[2][2], B1[2][2];
    const char* cA = (const char*)g.A + (size_t)cur.pm * tstepA + (size_t)cur.acol * 2; const char* cB = (const char*)g.Bt + (size_t)cur.pn * tstepB;
    if constexpr (SP2) {
        PG8_STAGE(PG8_SB(0, 0), cB, voffB); PG8_STAGE(PG8_SB(0, 1), cB + hstepB, voffB); PG8_STAGE(PG8_SA(0, 0), cA, voffA); PG8_STAGE(PG8_SA(0, 1), cA + hstepA, voffA);
        if (wr == 1) PG8_BAR;
        PG8_WAIT_V(2); PG8_BAR;
        PG8_STAGE(PG8_SB(1, 0), cB + kstep, voffB); PG8_STAGE(PG8_SA(1, 0), cA + kstep, voffA); PG8_STAGE(PG8_SB(1, 1), cB + hstepB + kstep, voffB);
        PG8_WAIT_V(6); PG8_BAR;
    } else {
        PG8_STAGE(PG8_SB(0, 0), cB, voffB); PG8_STAGE(PG8_SA(0, 0), cA, voffA); PG8_STAGE(PG8_SB(0, 1), cB + hstepB, voffB); PG8_STAGE(PG8_SA(0, 1), cA + hstepA, voffA);
        if (wr == 1) PG8_BAR;
        PG8_WAIT_V(4); PG8_BAR;
        PG8_STAGE(PG8_SB(1, 0), cB + kstep, voffB); PG8_STAGE(PG8_SA(1, 0), cA + kstep, voffA); PG8_STAGE(PG8_SB(1, 1), cB + hstepB + kstep, voffB);
        PG8_WAIT_V(6); PG8_BAR;
    }
    for (;;) {
        const bool has_next = S.next(ui + 1, nxt);
        const char* nA = has_next ? (const char*)g.A + (size_t)nxt.pm * tstepA + (size_t)nxt.acol * 2 : cA; const char* nB = has_next ? (const char*)g.Bt + (size_t)nxt.pn * tstepB : cB;
        for (int t = 0; t < nt; t += 2) {
            const bool last = (t == nt - 2);
            const char* a1 = cA + (size_t)(t + 1) * kstep;
            const char* a2 = last ? nA : cA + (size_t)(t + 2) * kstep; const char* b2 = last ? nB : cB + (size_t)(t + 2) * kstep;
            const char* a3 = a2 + kstep; const char* b3 = b2 + kstep;
            if constexpr (SP2) {
            PG8_LDB(B0, 0, 0); PG8_LDB(B1, 0, 1); PG8_SCHED; PG8_LDA(At, 0, 0); PG8_STAGE(PG8_SA(1, 1), a1 + hstepA, voffA);
            PG8_WAIT_V(8); PG8_WAIT_L(0); PG8_BAR; PG8_MMA(0, 0, At, B0); PG8_MMA(0, 1, At, B1); PG8_BAR; PG8_SCHED;
            PG8_LDA(At, 0, 1); PG8_STAGE(PG8_SB(0, 0), b2, voffB); PG8_STAGE(PG8_SB(0, 1), b2 + hstepB, voffB); PG8_STAGE(PG8_SA(0, 0), a2, voffA);
            PG8_WAIT_V(8); PG8_WAIT_L(0); PG8_BAR; PG8_MMA(1, 0, At, B0); PG8_MMA(1, 1, At, B1); PG8_BAR; PG8_SCHED;
            PG8_LDB(B0, 1, 0); PG8_LDB(B1, 1, 1); PG8_SCHED; PG8_LDA(At, 1, 0); PG8_STAGE(PG8_SA(0, 1), a2 + hstepA, voffA);
            PG8_WAIT_V(8); PG8_WAIT_L(0); PG8_BAR; PG8_MMA(0, 0, At, B0); PG8_MMA(0, 1, At, B1); PG8_BAR; PG8_SCHED;
            PG8_LDA(At, 1, 1); PG8_STAGE(PG8_SB(1, 0), b3, voffB); PG8_STAGE(PG8_SB(1, 1), b3 + hstepB, voffB); PG8_STAGE(PG8_SA(1, 0), a3, voffA);
            PG8_WAIT_V(8); PG8_WAIT_L(0); PG8_BAR; PG8_MMA(1, 0, At, B0); PG8_MMA(1, 1, At, B1); PG8_BAR; PG8_SCHED;
            } else {
            PG8_LDB(B0, 0, 0); PG8_SCHED; PG8_LDA(At, 0, 0); PG8_STAGE(PG8_SA(1, 1), a1 + hstepA, voffA);
            PG8_WAIT_L(8); PG8_BAR; PG8_WAIT_L(0); PG8_MMA(0, 0, At, B0); PG8_BAR; PG8_SCHED;
            PG8_LDB(B1, 0, 1); PG8_STAGE(PG8_SB(0, 0), b2, voffB);
            PG8_BAR; PG8_WAIT_L(0); PG8_MMA(0, 1, At, B1); PG8_BAR;
            PG8_LDA(At, 0, 1); PG8_STAGE(PG8_SA(0, 0), a2, voffA);
            PG8_BAR; PG8_WAIT_L(0); PG8_MMA(1, 0, At, B0); PG8_BAR; PG8_SCHED;
            PG8_STAGE(PG8_SB(0, 1), b2 + hstepB, voffB);
            PG8_WAIT_V(6); PG8_BAR; PG8_MMA(1, 1, At, B1); PG8_BAR;
            PG8_LDB(B0, 1, 0); PG8_SCHED; PG8_LDA(At, 1, 0); PG8_STAGE(PG8_SA(0, 1), a2 + hstepA, voffA);
            PG8_WAIT_L(8); PG8_BAR; PG8_WAIT_L(0); PG8_MMA(0, 0, At, B0); PG8_BAR; PG8_SCHED;
            PG8_LDB(B1, 1, 1); PG8_STAGE(PG8_SB(1, 0), b3, voffB);
            PG8_BAR; PG8_WAIT_L(0); PG8_MMA(0, 1, At, B1); PG8_BAR;
            PG8_LDA(At, 1, 1); PG8_STAGE(PG8_SA(1, 0), a3, voffA);
            PG8_BAR; PG8_WAIT_L(0); PG8_MMA(1, 0, At, B0); PG8_BAR; PG8_SCHED;
            PG8_STAGE(PG8_SB(1, 1), b3 + hstepB, voffB);
            PG8_WAIT_V(6); PG8_BAR; PG8_MMA(1, 1, At, B1); PG8_BAR;
            }
        }
        if constexpr (ALIGN_EPI) { if (wr == 0) PG8_BAR; }
        E(acc, cur, wr, wc, fr, fq);
        if (!has_next) break;
#pragma unroll
        for (int a = 0; a < 2; ++a)
#pragma unroll
            for (int b = 0; b < 2; ++b)
#pragma unroll
                for (int m = 0; m < 4; ++m)
#pragma unroll
                    for (int n = 0; n < 2; ++n) acc[a][b][m][n] = (f32x4){0.f, 0.f, 0.f, 0.f};
        cur = nxt; cA = nA; cB = nB; ++ui;
        if constexpr (ALIGN_EPI) { if (wr == 1) PG8_BAR; }
    }
    PG8_WAIT_V(0);
    if constexpr (!ALIGN_EPI) { if (wr == 0) PG8_BAR; }
    PG8_BAR;
#undef PG8_SA
#undef PG8_SB
#undef PG8_STAGE
#undef PG8_LDA
#undef PG8_LDB
#undef PG8_MMA
#undef PG8_WAIT_V
#undef PG8_WAIT_L
#undef PG8_BAR
#undef PG8_SCHED
}
}

constexpr int NWAVES = 8;
constexpr int D = 1024, DFF = 2816, NIN = 7184, NMIX = 3088, NMIXP = 3328, NGATE = 4096, NINP = NMIXP + NGATE;
constexpr int SEQ = 4096, NMETA = 16, L = SEQ + NMETA, BATCH = 4, DB = 32, DS = 8, PAST = 8192, PAGE = 128, NPAGES = PAST / PAGE, NPOOL = 2560, DEPTH = 2;
constexpr int MP = BATCH * L, MS = DB * DS, MR = MP + MS, M = 16896;
constexpr int NPOS = L + DS;
constexpr float EPS = 1e-6f;
constexpr int C_A = 0, C_G = 256, R_Q = 512, R_K = 768, R_V = 1024, R_G = 1280, G_Q = 1536, G_K = 1664, G_V = 1792, G_R = 2048, G_LOW = 2304, D_Q = 2320, D_K = 2576, D_V = 2832;
constexpr size_t O_YP = 0, O_YS = O_YP + (size_t)BATCH * SEQ * D, O_KP = O_YS + (size_t)MS * D, O_VP = O_KP + (size_t)DEPTH * MP * 256, O_KS = O_VP + (size_t)DEPTH * MP * 256,
                 O_VS = O_KS + (size_t)DEPTH * MS * 256, O_RP = O_VS + (size_t)DEPTH * MS * 256, O_RS = O_RP + (size_t)DEPTH * BATCH * 4 * 64 * 64, O_GP = O_RS + (size_t)DEPTH * DB * 4 * 64 * 64,
                 O_GS = O_GP + (size_t)DEPTH * BATCH * 4 * 32 * 64, O_CP = O_GS + (size_t)DEPTH * DB * 4 * 32 * 64, O_CS = O_CP + (size_t)DEPTH * BATCH * 30 * 256, O_END = O_CS + (size_t)DEPTH * DB * 30 * 256;
enum { I_XP = 0, I_XS, I_CK, I_CV, I_PT, I_SRET, I_SGLA, I_SCONV, I_META, I_RELB, I_NF1, I_F1G, I_F1U, I_F1D, I_NMIX, I_WIN, I_BIN, I_CW, I_CB, I_CLG, I_CLB, I_RGN, I_GAW, I_GAB, I_GGN,
       I_QN, I_KN, I_LQ1, I_LK1, I_LQ2, I_LK2, I_SUBLN, I_WBR, I_WOUT, I_NF2, I_F2G, I_F2U, I_F2D, N_INPUTS };

constexpr size_t MiB = 1u << 20;
constexpr size_t WS_CTL = 0, CTL_ZERO_BYTES = 1 * MiB;
constexpr size_t SZ_SS = (size_t)M * 16 * 4;
constexpr size_t SZ_W1 = (size_t)2 * DFF * D * 2, SZ_WD = (size_t)D * DFF * 2, SZ_WIN = (size_t)NINP * D * 2, SZ_WBR = (size_t)4 * D * 256 * 2, SZ_WOUT = (size_t)D * D * 2;
constexpr size_t WS_W1 = 4 * MiB;
constexpr size_t WS_WD = WS_W1 + 4 * SZ_W1;
constexpr size_t WS_WIN = WS_WD + 4 * SZ_WD;
constexpr size_t WS_WBR = WS_WIN + 2 * SZ_WIN;
constexpr size_t WS_WOUT = WS_WBR + 2 * SZ_WBR;
constexpr size_t WS_BINP = WS_WOUT + 2 * SZ_WOUT;
constexpr size_t WS_ROPE = WS_BINP + 64 * 1024;
constexpr size_t WS_SS = WS_ROPE + 2 * MiB;
constexpr size_t WS_H = 128 * MiB;
constexpr size_t WS_HB = WS_H + (size_t)M * D * 4;
constexpr size_t WS_ACT = WS_HB + (size_t)M * D * 2;
constexpr size_t WS_ZMIX = WS_ACT + (size_t)M * DFF * 2;
constexpr size_t WS_GATES = WS_ZMIX + (size_t)M * NMIXP * 2;
constexpr size_t WS_BR = WS_GATES + (size_t)M * NGATE * 2;
constexpr size_t WS_MERGED = WS_BR + (size_t)M * D * 2;
constexpr size_t WS_UBUF = WS_MERGED + (size_t)M * D * 2;
constexpr size_t WS_RQ = WS_UBUF + (size_t)M * 256 * 4, WS_RK = WS_RQ + (size_t)M * 256 * 4, WS_QN = WS_RK + (size_t)M * 256 * 4, WS_KN = WS_QN + (size_t)M * 256 * 4, WS_VB = WS_KN + (size_t)M * 256 * 4;
constexpr size_t WS_LDEC = WS_VB + (size_t)M * 256 * 4;
constexpr size_t WS_QNB = WS_LDEC + (size_t)M * 128 * 4;
constexpr size_t WS_KNB = WS_QNB + (size_t)M * 256 * 2;
constexpr size_t WS_PART = WS_KNB + (size_t)M * 256 * 2;
constexpr size_t WS_END = WS_PART + (size_t)DB * 4 * 16 * 16 * 68 * 4;
static_assert(WS_ROPE + 2 * NPOS * 32 * 4 <= WS_SS && WS_SS + 6 * SZ_SS <= WS_H, "weights region overflows");
constexpr int CW_BAR = 4096, CW_QUEUE = 8192;

constexpr int RING_OFF = 0, RING_BYTES = 131072;
constexpr int LDSCTL_OFF = 144384, MISC_OFF = LDSCTL_OFF + 320;
constexpr int LDS_BYTES = 147456;
static_assert(MISC_OFF + 128 <= LDS_BYTES, "LDS map");

#define GAS __attribute__((address_space(1)))
#define LAS __attribute__((address_space(3)))
typedef unsigned short bf16;
typedef unsigned v4u __attribute__((ext_vector_type(4)));
typedef float f32x4 __attribute__((ext_vector_type(4)));
#define LDS_WAIT() asm volatile("s_waitcnt lgkmcnt(0)" ::: "memory")
#define VM_WAIT() asm volatile("s_waitcnt vmcnt(0)" ::: "memory")
__device__ __forceinline__ unsigned f2bf(float f) { unsigned u = __builtin_bit_cast(unsigned, f); return (u + 0x7fffu + ((u >> 16) & 1u)) >> 16; }
__device__ __forceinline__ unsigned pk2(float lo, float hi) { return f2bf(lo) | (f2bf(hi) << 16); }
__device__ __forceinline__ float bf2f(bf16 b) { return __builtin_bit_cast(float, ((unsigned)b) << 16); }
__device__ __forceinline__ float bflo(unsigned w) { return __builtin_bit_cast(float, w << 16); }
__device__ __forceinline__ float bfhi(unsigned w) { return __builtin_bit_cast(float, w & 0xffff0000u); }
__device__ __forceinline__ float wave_sum(float v) {
#pragma unroll
    for (int o = 1; o < 64; o <<= 1) v += __shfl_xor(v, o);
    return v;
}
__device__ __forceinline__ float sigmoidf_(float x) { return __builtin_amdgcn_rcpf(1.0f + __expf(-x)); }
__device__ __forceinline__ float siluf_(float x) { return x * __builtin_amdgcn_rcpf(1.0f + __expf(-x)); }

#define XB_TMO      128
#define XB_XCNT(j)  (256  + 64 * (j))
#define XB_XSUB(j)  (1280 + 64 * (j))
#define XB_XGEN(j)  (2304 + 64 * (j))
#define XB_TOP      3328
#define XB_TOPGEN   3392
#define XCD_BAR_WORDS 3456
#define XB_SPIN_CAP (1u << 22)

__device__ __forceinline__ unsigned xb_ld(unsigned* p)              { return __hip_atomic_load(p, __ATOMIC_RELAXED, __HIP_MEMORY_SCOPE_AGENT); }
__device__ __forceinline__ unsigned xb_add(unsigned* p, unsigned v) { return __hip_atomic_fetch_add(p, v, __ATOMIC_RELAXED, __HIP_MEMORY_SCOPE_AGENT); }
__device__ __forceinline__ unsigned xb_xcc_id() { return (unsigned)__builtin_amdgcn_s_getreg((3 << 11) | 20) & 0xFu; }
#define XB_SPIN(cond, bar) do { unsigned _sp = 0; while (cond) { __builtin_amdgcn_s_sleep(1); \
    if ((++_sp & 255u) == 0u) { if (xb_ld(&(bar)[XB_TMO])) break; if (_sp > XB_SPIN_CAP) { atomicAdd(&(bar)[XB_TMO], 1u); break; } } } } while (0)

struct XcdBarrier { unsigned* bar; unsigned x; volatile LAS unsigned* st; };

__device__ __forceinline__ XcdBarrier xcd_barrier_post(unsigned* bar, volatile LAS unsigned* st) {
    XcdBarrier b; b.bar = bar; b.x = xb_xcc_id(); b.st = st;
    if (threadIdx.x == 0) (void)xb_add(&bar[XB_XCNT(b.x)], 1u);
    return b;
}
__device__ __forceinline__ void xcd_barrier_complete(unsigned* bar, unsigned x, unsigned& nloc, unsigned& nx) {
    const unsigned G = gridDim.x * gridDim.y * gridDim.z;
    unsigned sum, cnt, mine, sp = 0u;
    for (;;) {
        sum = 0u; cnt = 0u; mine = 0u;
#pragma unroll
        for (unsigned j = 0; j < 16; ++j) { const unsigned c = xb_ld(&bar[XB_XCNT(j)]); sum += c; cnt += (c > 0u) ? 1u : 0u; mine = (j == x) ? c : mine; }
        if (sum == G) break;
        __builtin_amdgcn_s_sleep(1);
        if ((++sp & 255u) == 0u) { if (xb_ld(&bar[XB_TMO])) break; if (sp > XB_SPIN_CAP) { atomicAdd(&bar[XB_TMO], 1u); break; } }
    }
    nloc = mine > 0u ? mine : 1u; nx = cnt > 0u ? cnt : 1u;
}
template <bool FIRST> __device__ __forceinline__ void xcd_barrier(const XcdBarrier& b) {
    asm volatile("s_waitcnt vmcnt(0)" ::: "memory");
    __syncthreads();
    if (threadIdx.x == 0) {
        unsigned* bar = b.bar;
        asm volatile("" : "+s"(bar));
        __builtin_amdgcn_s_waitcnt(0);
        unsigned nloc = b.st[0], nx = b.st[1];
        if (FIRST) { if (nloc == 0u) { xcd_barrier_complete(bar, b.x, nloc, nx); b.st[0] = nloc; b.st[1] = nx; } }
        const unsigned old = xb_add(&bar[XB_XSUB(b.x)], 1u);
        const unsigned gen = old / nloc;
        if (old + 1u == (gen + 1u) * nloc) {
            __builtin_amdgcn_fence(__ATOMIC_RELEASE, "agent");
            asm volatile("s_waitcnt vmcnt(0)" ::: "memory");
            const unsigned og = xb_add(&bar[XB_TOP], 1u);
            const unsigned tg = og / nx;
            if (og + 1u == (tg + 1u) * nx) xb_add(&bar[XB_TOPGEN], 1u);
            else XB_SPIN(xb_ld(&bar[XB_TOPGEN]) == tg, bar);
            __builtin_amdgcn_fence(__ATOMIC_ACQUIRE, "agent");
            xb_add(&bar[XB_XGEN(b.x)], 1u);
            asm volatile("s_waitcnt vmcnt(0)" ::: "memory");
        } else {
            XB_SPIN(xb_ld(&bar[XB_XGEN(b.x)]) == gen, bar);
            __builtin_amdgcn_fence(__ATOMIC_ACQUIRE, "agent");
            asm volatile("s_waitcnt vmcnt(0)" ::: "memory");
        }
    }
    __syncthreads();
}

struct Params { const float* in[N_INPUTS]; float* out; unsigned char* ws; float inv_freq[32]; };
static_assert(sizeof(Params) == N_INPUTS * 8 + 16 + 128, "Params has no padding");

struct Ctx {
    const float* const* in; float* out; unsigned char* ws;
    LAS unsigned char* lds;
    int G;
};
#define THREAD_IDS() int tid_ = threadIdx.x; asm volatile("" : "+v"(tid_)); const int tid = tid_, lane = tid & 63, wave = __builtin_amdgcn_readfirstlane(tid >> 6), gw = blockIdx.x * NWAVES + wave, NGW = C.G * NWAVES; (void)tid; (void)lane; (void)wave; (void)gw; (void)NGW
#define WSP(T, off) ((T*)(C.ws + (off)))

__device__ __forceinline__ float rstd_of(const float* ssp, int row) {
    const f32x4 a = *(const f32x4*)(ssp + (size_t)row * 16), b = *(const f32x4*)(ssp + (size_t)row * 16 + 4), c = *(const f32x4*)(ssp + (size_t)row * 16 + 8), d = *(const f32x4*)(ssp + (size_t)row * 16 + 12);
    const float s = (((a[0] + a[1]) + (a[2] + a[3])) + ((b[0] + b[1]) + (b[2] + b[3]))) + (((c[0] + c[1]) + (c[2] + c[3])) + ((d[0] + d[1]) + (d[2] + d[3])));
    return rsqrtf(s * (1.0f / D) + EPS);
}
#define EPI_IDS() int t_ = threadIdx.x; asm volatile("" : "+v"(t_)); const int wid_ = __builtin_amdgcn_readfirstlane(t_ >> 6), wr = wid_ >> 2, wc = wid_ & 3, fr = t_ & 15, fq = (t_ & 63) >> 4
struct EpiGLU {
    static constexpr bool PERM = true;
    bf16* act; const float* ss;
    __device__ __forceinline__ void operator()(const pg8::f32x4 (&acc)[2][2][4][2], const pg8::Unit& u, int, int, int, int) const {
        EPI_IDS();
        const int row0 = u.pm * 256 + wr * 64 + fr, col0 = u.pn * 128 + wc * 32 + 8 * fq;
#pragma unroll
        for (int ai = 0; ai < 2; ++ai)
#pragma unroll
            for (int m = 0; m < 4; ++m) {
                const int row = row0 + ai * 128 + m * 16; const float rstd = rstd_of(ss, row);
                float o[8];
#pragma unroll
                for (int n = 0; n < 2; ++n)
#pragma unroll
                    for (int j = 0; j < 4; ++j) { const float g = acc[ai][0][m][n][j] * rstd, up = acc[ai][1][m][n][j] * rstd; o[n * 4 + j] = siluf_(g) * up; }
                v4u w; w.x = pg8::cvt_pk_bf16(o[0], o[1]); w.y = pg8::cvt_pk_bf16(o[2], o[3]); w.z = pg8::cvt_pk_bf16(o[4], o[5]); w.w = pg8::cvt_pk_bf16(o[6], o[7]);
                *(v4u*)(act + (size_t)row * DFF + col0) = w;
            }
    }
};
template <bool FINAL, int SCALE2> struct EpiRes {
    static constexpr bool PERM = true;
    float* h; bf16* hb; float* ssout; float* out;
    __device__ __forceinline__ void operator()(const pg8::f32x4 (&acc)[2][2][4][2], const pg8::Unit& u, int, int, int, int) const {
        EPI_IDS();
        const int row0 = u.pm * 256 + wr * 64 + fr, col0 = u.pn * 256 + wc * 32 + 8 * fq;
#pragma unroll
        for (int ai = 0; ai < 2; ++ai)
#pragma unroll
            for (int m = 0; m < 4; ++m) {
                const int row = row0 + ai * 128 + m * 16; float sq = 0.f;
                constexpr float scale = 0.5f * SCALE2;
                long yoff = -1;
                if (FINAL) { if (row < MP) { const int b = row / L, pos = row - b * L; if (pos >= NMETA) yoff = (long)O_YP + ((long)b * SEQ + (pos - NMETA)) * D; } else if (row < MR) yoff = (long)O_YS + (long)(row - MP) * D; }
#pragma unroll
                for (int bj = 0; bj < 2; ++bj) {
                    const size_t off = (size_t)row * D + col0 + bj * 128;
                    f32x4 h0 = *(const f32x4*)(h + off), h1 = *(const f32x4*)(h + off + 4);
                    h0 = h0 + acc[ai][bj][m][0] * scale; h1 = h1 + acc[ai][bj][m][1] * scale;
                    *(f32x4*)(h + off) = h0; *(f32x4*)(h + off + 4) = h1;
                    v4u w; w.x = pg8::cvt_pk_bf16(h0[0], h0[1]); w.y = pg8::cvt_pk_bf16(h0[2], h0[3]); w.z = pg8::cvt_pk_bf16(h1[0], h1[1]); w.w = pg8::cvt_pk_bf16(h1[2], h1[3]);
                    *(v4u*)(hb + off) = w;
                    sq += (h0[0] * h0[0] + h0[1] * h0[1]) + (h0[2] * h0[2] + h0[3] * h0[3]) + (h1[0] * h1[0] + h1[1] * h1[1]) + (h1[2] * h1[2] + h1[3] * h1[3]);
                    if (FINAL && yoff >= 0) { *(f32x4*)(out + yoff + col0 + bj * 128) = h0; *(f32x4*)(out + yoff + col0 + bj * 128 + 4) = h1; }
                }
                sq += __shfl_xor(sq, 16); sq += __shfl_xor(sq, 32);
                if (fq == 0 && ssout) ssout[(size_t)row * 16 + u.pn * 4 + wc] = sq;
                asm volatile("" ::: "memory");
            }
    }
};
struct EpiZ {
    static constexpr bool PERM = true;
    bf16* zmix; bf16* gates; const float* ss; const float* bias;
    __device__ __forceinline__ void operator()(const pg8::f32x4 (&acc)[2][2][4][2], const pg8::Unit& u, int, int, int, int) const {
        EPI_IDS();
        const int row0 = u.pm * 256 + wr * 64 + fr, col0 = u.pn * 256 + wc * 32 + 8 * fq; const bool isgate = u.pn >= NMIXP / 256;
        f32x4 bv[2][2];
#pragma unroll
        for (int bj = 0; bj < 2; ++bj)
#pragma unroll
            for (int n = 0; n < 2; ++n) bv[bj][n] = *(const f32x4*)(bias + col0 + bj * 128 + 4 * n);
#pragma unroll
        for (int ai = 0; ai < 2; ++ai)
#pragma unroll
            for (int m = 0; m < 4; ++m) {
                const int row = row0 + ai * 128 + m * 16; const float rstd = rstd_of(ss, row);
#pragma unroll
                for (int bj = 0; bj < 2; ++bj) {
                    f32x4 v0 = acc[ai][bj][m][0] * rstd + bv[bj][0], v1 = acc[ai][bj][m][1] * rstd + bv[bj][1];
                    if (isgate) {
#pragma unroll
                        for (int j = 0; j < 4; ++j) { v0[j] = sigmoidf_(v0[j]); v1[j] = sigmoidf_(v1[j]); } }
                    v4u w; w.x = pg8::cvt_pk_bf16(v0[0], v0[1]); w.y = pg8::cvt_pk_bf16(v0[2], v0[3]); w.z = pg8::cvt_pk_bf16(v1[0], v1[1]); w.w = pg8::cvt_pk_bf16(v1[2], v1[3]);
                    if (isgate) *(v4u*)(gates + (size_t)row * NGATE + (col0 - NMIXP) + bj * 128) = w;
                    else *(v4u*)(zmix + (size_t)row * NMIXP + col0 + bj * 128) = w;
                }
            }
    }
};
struct EpiMerge {
    static constexpr bool PERM = true;
    bf16* merged; const bf16* gates;
    __device__ __forceinline__ void operator()(const pg8::f32x4 (&acc)[2][2][4][2], const pg8::Unit& u, int, int, int, int) const {
        EPI_IDS();
        const int n = u.pn >> 2, dt = u.pn & 3;
        const int row0 = u.pm * 256 + wr * 64 + fr, col0 = dt * 256 + wc * 32 + 8 * fq;
#pragma unroll
        for (int ai = 0; ai < 2; ++ai)
#pragma unroll
            for (int m = 0; m < 4; ++m) {
                const int row = row0 + ai * 128 + m * 16;
#pragma unroll
                for (int bj = 0; bj < 2; ++bj) {
                    const v4u gw = *(const v4u*)(gates + (size_t)row * NGATE + n * D + col0 + bj * 128);
                    bf16* mp = merged + (size_t)row * D + col0 + bj * 128;
                    float o[8];
                    o[0] = acc[ai][bj][m][0][0] * bflo(gw.x); o[1] = acc[ai][bj][m][0][1] * bfhi(gw.x); o[2] = acc[ai][bj][m][0][2] * bflo(gw.y); o[3] = acc[ai][bj][m][0][3] * bfhi(gw.y);
                    o[4] = acc[ai][bj][m][1][0] * bflo(gw.z); o[5] = acc[ai][bj][m][1][1] * bfhi(gw.z); o[6] = acc[ai][bj][m][1][2] * bflo(gw.w); o[7] = acc[ai][bj][m][1][3] * bfhi(gw.w);
                    if (n > 0) { const v4u pw = *(const v4u*)mp;
                        o[0] += bflo(pw.x); o[1] += bfhi(pw.x); o[2] += bflo(pw.y); o[3] += bfhi(pw.y); o[4] += bflo(pw.z); o[5] += bfhi(pw.z); o[6] += bflo(pw.w); o[7] += bfhi(pw.w); }
                    v4u w; w.x = pg8::cvt_pk_bf16(o[0], o[1]); w.y = pg8::cvt_pk_bf16(o[2], o[3]); w.z = pg8::cvt_pk_bf16(o[4], o[5]); w.w = pg8::cvt_pk_bf16(o[6], o[7]);
                    *(v4u*)mp = w;
                }
                asm volatile("" ::: "memory");
            }
    }
};

struct RowMap { int mode, a; __device__ __forceinline__ int operator()(int n) const { return mode == 0 ? n + a : (mode == 1 ? 256 * (n >> 7) + (n & 127) + a : (n < NMIX ? n : n + (NMIXP - NMIX))); } };
__device__ __forceinline__ void tr_item(const float* W, int K, int N, const float* gain, bf16* WT, int pitch, RowMap rm, LAS float* scr, int kb, int nb, int lane) {
    const int k0 = 64 * kb, n0 = 32 * nb; const int nn = n0 + (lane & 31);
#pragma unroll 8
    for (int i = 0; i < 32; ++i) { const int kk = 2 * i + (lane >> 5); float v = (nn < N) ? W[(size_t)(k0 + kk) * N + nn] : 0.f; if (gain) v *= gain[k0 + kk]; scr[kk * 33 + (lane & 31)] = v; }
    LDS_WAIT(); asm volatile("" ::: "memory");
    const int c = lane & 7;
#pragma unroll
    for (int j = 0; j < 4; ++j) { const int nl = (lane >> 3) + 8 * j; const int n = n0 + nl; const LAS float* s = scr + (8 * c) * 33 + nl;
        v4u o; o.x = pk2(s[0 * 33], s[1 * 33]); o.y = pk2(s[2 * 33], s[3 * 33]); o.z = pk2(s[4 * 33], s[5 * 33]); o.w = pk2(s[6 * 33], s[7 * 33]);
        if (n < N) *(v4u*)(WT + (size_t)rm(n) * pitch + k0 + 8 * c) = o; }
    LDS_WAIT(); asm volatile("" ::: "memory");
}
__device__ __forceinline__ void p0_prologue(const Ctx& C, const Params& P) {
    THREAD_IDS();
    LAS float* scr = (LAS float*)(C.lds + RING_OFF + wave * 16384);
    constexpr int I_FF = 16 * 88, I_DN = 44 * 32, I_IN = 16 * 225, I_BR = 4 * 4 * 32, I_OUT = 16 * 32;
    constexpr int PER_LAYER = 4 * I_FF + 2 * I_DN + I_IN + I_BR + I_OUT;
    for (int it = gw; it < DEPTH * PER_LAYER; it += NGW) {
        const int l = it / PER_LAYER; int r = it - l * PER_LAYER;
        bf16* W1a = WSP(bf16, WS_W1 + (size_t)(l * 2 + 0) * SZ_W1); bf16* W1b = WSP(bf16, WS_W1 + (size_t)(l * 2 + 1) * SZ_W1);
        bf16* Wda = WSP(bf16, WS_WD + (size_t)(l * 2 + 0) * SZ_WD); bf16* Wdb = WSP(bf16, WS_WD + (size_t)(l * 2 + 1) * SZ_WD);
        if (r < I_FF) { tr_item(C.in[I_F1G] + (size_t)l * D * DFF, D, DFF, C.in[I_NF1] + l * D, W1a, D, RowMap{1, 0}, scr, r / 88, r % 88, lane); continue; } r -= I_FF;
        if (r < I_FF) { tr_item(C.in[I_F1U] + (size_t)l * D * DFF, D, DFF, C.in[I_NF1] + l * D, W1a, D, RowMap{1, 128}, scr, r / 88, r % 88, lane); continue; } r -= I_FF;
        if (r < I_DN) { tr_item(C.in[I_F1D] + (size_t)l * D * DFF, DFF, D, nullptr, Wda, DFF, RowMap{0, 0}, scr, r / 32, r % 32, lane); continue; } r -= I_DN;
        if (r < I_FF) { tr_item(C.in[I_F2G] + (size_t)l * D * DFF, D, DFF, C.in[I_NF2] + l * D, W1b, D, RowMap{1, 0}, scr, r / 88, r % 88, lane); continue; } r -= I_FF;
        if (r < I_FF) { tr_item(C.in[I_F2U] + (size_t)l * D * DFF, D, DFF, C.in[I_NF2] + l * D, W1b, D, RowMap{1, 128}, scr, r / 88, r % 88, lane); continue; } r -= I_FF;
        if (r < I_DN) { tr_item(C.in[I_F2D] + (size_t)l * D * DFF, DFF, D, nullptr, Wdb, DFF, RowMap{0, 0}, scr, r / 32, r % 32, lane); continue; } r -= I_DN;
        if (r < I_IN) { tr_item(C.in[I_WIN] + (size_t)l * D * NIN, D, NIN, C.in[I_NMIX] + l * D, WSP(bf16, WS_WIN + (size_t)l * SZ_WIN), D, RowMap{2, 0}, scr, r / 225, r % 225, lane); continue; } r -= I_IN;
        if (r < I_BR) { const int n4 = r / 128, rr = r % 128; tr_item(C.in[I_WBR] + (size_t)(l * 4 + n4) * 256 * D, 256, D, nullptr, WSP(bf16, WS_WBR + (size_t)l * SZ_WBR), 256, RowMap{0, n4 * D}, scr, rr / 32, rr % 32, lane); continue; } r -= I_BR;
        tr_item(C.in[I_WOUT] + (size_t)l * D * D, D, D, nullptr, WSP(bf16, WS_WOUT + (size_t)l * SZ_WOUT), D, RowMap{0, 0}, scr, r / 32, r % 32, lane);
    }
    const int gt = gw * 64 + lane, NGT = NGW * 64;
    for (int i = gt; i < 2 * 240 * 128; i += NGT) { const int l = i / (240 * 128), r = i % (240 * 128); *(v4u*)(C.ws + WS_WIN + (size_t)l * SZ_WIN + ((size_t)NMIX * D) * 2 + (size_t)r * 16) = (v4u){0u, 0u, 0u, 0u}; }
    for (int i = gt; i < (M - MR) * 128; i += NGT) *(v4u*)(C.ws + WS_BR + (size_t)MR * D * 2 + (size_t)i * 16) = (v4u){0u, 0u, 0u, 0u};
    for (int i = gt; i < 2 * NINP; i += NGT) { const int l = i / NINP, j = i % NINP; float v = 0.f; if (j < NMIX) v = C.in[I_BIN][l * NIN + j]; else if (j >= NMIXP) v = C.in[I_BIN][l * NIN + NMIX + (j - NMIXP)]; WSP(float, WS_BINP)[i] = v; }
    for (int i = gt; i < NPOS * 32; i += NGT) { const int pi = i >> 5, fi = i & 31; const int pos = pi < L ? pi : PAST + (pi - L);
        const float angf = (float)pos * P.inv_freq[fi];
        const double a = (double)angf; const double k = rint(a * 0.15915494309189535); const double rr = (a - k * 6.283185307179586) - k * 2.4492935982947064e-16;
        const float rf = (float)rr; WSP(float, WS_ROPE)[i] = cosf(rf); WSP(float, WS_ROPE)[NPOS * 32 + i] = sinf(rf); }
    float* H = WSP(float, WS_H); bf16* HB = WSP(bf16, WS_HB); float* SS0 = WSP(float, WS_SS);
    for (int row = gw; row < M; row += NGW) {
        const float* src = nullptr;
        if (row < MP) { const int b = row / L, pos = row - b * L; src = pos < NMETA ? C.in[I_META] + (size_t)pos * D : C.in[I_XP] + ((size_t)b * SEQ + (pos - NMETA)) * D; }
        else if (row < MR) src = C.in[I_XS] + (size_t)(row - MP) * D;
        float s = 0.f;
#pragma unroll
        for (int j = 0; j < 4; ++j) { f32x4 v = src ? *(const f32x4*)(src + 256 * j + 4 * lane) : (f32x4){0.f, 0.f, 0.f, 0.f};
            *(f32x4*)(H + (size_t)row * D + 256 * j + 4 * lane) = v; s += (v[0] * v[0] + v[1] * v[1]) + (v[2] * v[2] + v[3] * v[3]);
            unsigned long long w = (unsigned long long)pk2(v[0], v[1]) | ((unsigned long long)pk2(v[2], v[3]) << 32);
            *(unsigned long long*)(HB + (size_t)row * D + 256 * j + 4 * lane) = w; }
        s = wave_sum(s); if (lane < 16) SS0[(size_t)row * 16 + lane] = lane == 0 ? s : 0.f;
    }
}

__device__ __forceinline__ float lam_of(const Ctx& C, int l, float lam_init) {
    THREAD_IDS();
    float a = 0.f, b = 0.f;
    for (int i = 0; i < 32; ++i) { a += C.in[I_LQ1][l * 32 + i] * C.in[I_LK1][l * 32 + i]; b += C.in[I_LQ2][l * 32 + i] * C.in[I_LK2][l * 32 + i]; }
    return __expf(a) - __expf(b) + lam_init;
}
__device__ __forceinline__ int t5_bucket(int n) {
    if (n < 16) return n;
    return 16 + (n >= 19) + (n >= 21) + (n >= 24) + (n >= 27) + (n >= 31) + (n >= 35) + (n >= 40) + (n >= 46) + (n >= 52) + (n >= 59) + (n >= 67) + (n >= 77) + (n >= 87) + (n >= 99) + (n >= 113);
}
__device__ __forceinline__ void n1_prep(const Ctx& C, int l) {
    THREAD_IDS();
    const bf16* ZM = WSP(bf16, WS_ZMIX); float* UB = WSP(float, WS_UBUF); float* RQ = WSP(float, WS_RQ); float* RK = WSP(float, WS_RK); float* QN = WSP(float, WS_QN); float* KN = WSP(float, WS_KN);
    float* VB = WSP(float, WS_VB); float* LD = WSP(float, WS_LDEC); const float* COS = WSP(float, WS_ROPE); const float* SIN = COS + NPOS * 32;
    for (int r = gw; r < MR; r += NGW) {
        const bf16* z = ZM + (size_t)r * NMIXP;
        const int pi = r < MP ? r % L : L + ((r - MP) & 7);
        float* kout = r < MP ? C.out + O_KP + ((size_t)l * MP + r) * 256 : C.out + O_KS + ((size_t)l * MS + (r - MP)) * 256;
        float* vout = r < MP ? C.out + O_VP + ((size_t)l * MP + r) * 256 : C.out + O_VS + ((size_t)l * MS + (r - MP)) * 256;
#pragma unroll
        for (int k = 0; k < 4; ++k) { const int c = lane + 64 * k;
            UB[(size_t)r * 256 + c] = bf2f(z[C_A + c]) * sigmoidf_(bf2f(z[C_G + c]));
            const float vv = bf2f(z[D_V + c]); VB[(size_t)r * 256 + c] = vv; vout[c] = vv;
            { float x = bf2f(z[D_Q + c]); float s = x * x; s += __shfl_xor(s, 1); s += __shfl_xor(s, 2); s += __shfl_xor(s, 4); s += __shfl_xor(s, 8); s += __shfl_xor(s, 16);
              const float y = x * rsqrtf(s * (1.0f / 32) + EPS) * C.in[I_QN][l * 32 + (c & 31)]; QN[(size_t)r * 256 + c] = y; WSP(bf16, WS_QNB)[(size_t)r * 256 + c] = (bf16)f2bf(y * (0.17677669529663687f * 1.4426950408889634f)); }
            { float x = bf2f(z[D_K + c]); float s = x * x; s += __shfl_xor(s, 1); s += __shfl_xor(s, 2); s += __shfl_xor(s, 4); s += __shfl_xor(s, 8); s += __shfl_xor(s, 16);
              const float y = x * rsqrtf(s * (1.0f / 32) + EPS) * C.in[I_KN][l * 32 + (c & 31)]; KN[(size_t)r * 256 + c] = y; kout[c] = y; WSP(bf16, WS_KNB)[(size_t)r * 256 + c] = (bf16)f2bf(y); }
        }
#pragma unroll
        for (int k = 0; k < 2; ++k) { const int p = lane + 64 * k, h = p >> 5, i = p & 31; const float cs = COS[pi * 32 + i], sn = SIN[pi * 32 + i];
            { const float x1 = bf2f(z[R_Q + h * 64 + i]), x2 = bf2f(z[R_Q + h * 64 + 32 + i]); RQ[(size_t)r * 256 + h * 64 + i] = x1 * cs - x2 * sn; RQ[(size_t)r * 256 + h * 64 + 32 + i] = x1 * sn + x2 * cs; }
            { const float x1 = bf2f(z[R_K + h * 64 + i]), x2 = bf2f(z[R_K + h * 64 + 32 + i]); RK[(size_t)r * 256 + h * 64 + i] = (x1 * cs - x2 * sn) * 0.125f; RK[(size_t)r * 256 + h * 64 + 32 + i] = (x1 * sn + x2 * cs) * 0.125f; }
            { const int j = p; float gp = C.in[I_GAB][l * 128 + j];
              for (int i2 = 0; i2 < 16; ++i2) gp += bf2f(z[G_LOW + i2]) * C.in[I_GAW][(l * 16 + i2) * 128 + j];
              const float ls = fminf(gp, 0.f) - log1pf(__expf(-fabsf(gp)));
              LD[(size_t)r * 128 + j] = ls * (1.0f / 16.0f); }
        }
    }
}
__device__ __forceinline__ void conv_rows_item(const Ctx& C, int l, int item) {
    THREAD_IDS();
    const float* UB = WSP(float, WS_UBUF); bf16* BR = WSP(bf16, WS_BR);
    const float* cw = C.in[I_CW] + (size_t)l * 31 * 256; const float* sc = C.in[I_SCONV];
    for (int rr = wave; rr < 64; rr += NWAVES) {
        const int r = item * 64 + rr; if (r >= MR) break;
        const bool smp = r >= MP; const int b = smp ? (r - MP) >> 3 : r / L; const int p = smp ? (r - MP) & 7 : r - b * L; const int rb = smp ? MP + b * 8 : b * L;
        float cv[4];
#pragma unroll
        for (int k = 0; k < 4; ++k) cv[k] = C.in[I_CB][l * 256 + lane + 64 * k];
        for (int j = 0; j < 31; ++j) { const int q = p + j - 30;
#pragma unroll
            for (int k = 0; k < 4; ++k) { const int c = lane + 64 * k; float uv;
                if (q >= 0) uv = UB[(size_t)(rb + q) * 256 + c]; else uv = smp ? sc[(((size_t)l * DB + b) * 30 + (p + j)) * 256 + c] : 0.f;
                cv[k] += cw[j * 256 + c] * uv; } }
        float s = (cv[0] + cv[1]) + (cv[2] + cv[3]); const float mean = wave_sum(s) * (1.0f / 256);
        float q2 = 0.f;
#pragma unroll
        for (int k = 0; k < 4; ++k) { cv[k] -= mean; q2 += cv[k] * cv[k]; }
        const float rstd = rsqrtf(wave_sum(q2) * (1.0f / 256) + EPS);
#pragma unroll
        for (int k = 0; k < 4; ++k) { const int c = lane + 64 * k; const float y = cv[k] * rstd * C.in[I_CLG][l * 256 + c] + C.in[I_CLB][l * 256 + c]; BR[(size_t)r * D + c] = (bf16)f2bf(siluf_(y)); }
    }
}
__device__ __forceinline__ void conv_state_item(const Ctx& C, int l, int part, int nparts) {
    THREAD_IDS();
    const float* UB = WSP(float, WS_UBUF); const float* sc = C.in[I_SCONV];
    for (int i = part * NWAVES * 64 + tid; i < BATCH * 30 * 256; i += nparts * NWAVES * 64) { const int c = i & 255, ii = (i >> 8) % 30, b = i / (30 * 256); C.out[O_CP + (size_t)l * BATCH * 30 * 256 + i] = UB[(size_t)(b * L + L - 30 + ii) * 256 + c]; }
    for (int i = part * NWAVES * 64 + tid; i < DB * 30 * 256; i += nparts * NWAVES * 64) { const int c = i & 255, ii = (i >> 8) % 30, b = i / (30 * 256);
        C.out[O_CS + (size_t)l * DB * 30 * 256 + i] = ii < 22 ? sc[(((size_t)l * DB + b) * 30 + 8 + ii) * 256 + c] : UB[(size_t)(MP + b * 8 + ii - 22) * 256 + c]; }
}
template <int DK, bool RET> __device__ __forceinline__ void la_seq(const Ctx& C, int l, bool smp, int b, int h) {
    THREAD_IDS();
    const bf16* ZM = WSP(bf16, WS_ZMIX); const float* RQ = WSP(float, WS_RQ); const float* RK = WSP(float, WS_RK); const float* LD = WSP(float, WS_LDEC); bf16* BR = WSP(bf16, WS_BR);
    const int nt = smp ? DS : L; const int row0 = smp ? MP + b * DS : b * L;
    float S[DK];
    if (smp) { const float* s0 = (RET ? C.in[I_SRET] : C.in[I_SGLA]) + (((size_t)l * DB + b) * 4 + h) * DK * 64;
#pragma unroll
        for (int k = 0; k < DK; ++k) S[k] = s0[k * 64 + lane]; }
    else {
#pragma unroll
        for (int k = 0; k < DK; ++k) S[k] = 0.f; }
    const float gamma = 1.0f - exp2f(-5.0f - (float)h);
    const float gn = RET ? C.in[I_RGN][(l * 4 + h) * 64 + lane] : C.in[I_GGN][(l * 4 + h) * 64 + lane];
    for (int t = 0; t < nt; ++t) {
        const int r = row0 + t; const bf16* z = ZM + (size_t)r * NMIXP;
        float ql, kl, dl = 1.f;
        if (RET) { ql = RQ[(size_t)r * 256 + h * 64 + lane]; kl = RK[(size_t)r * 256 + h * 64 + lane]; }
        else { const int lk = lane & 31; ql = bf2f(z[G_Q + h * 32 + lk]) * 0.17677669529663687f; kl = bf2f(z[G_K + h * 32 + lk]); dl = __expf(LD[(size_t)r * 128 + h * 32 + lk]); }
        const float v = bf2f(z[(RET ? R_V : G_V) + h * 64 + lane]);
        float o = 0.f;
#pragma unroll
        for (int k = 0; k < DK; ++k) { const float qk = __shfl(ql, k), kk = __shfl(kl, k); const float dk = RET ? gamma : __shfl(dl, k);
            S[k] = dk * S[k] + kk * v; o += qk * S[k]; if ((k & 7) == 7) __builtin_amdgcn_sched_barrier(0); }
        float y;
        if (RET) { const float mean = wave_sum(o) * (1.0f / 64); const float d = o - mean; const float var = wave_sum(d * d) * (1.0f / 64); y = d * rsqrtf(var + EPS) * gn; }
        else { const float ms = wave_sum(o * o) * (1.0f / 64); y = o * rsqrtf(ms + EPS) * gn; }
        const float g = bf2f(z[(RET ? R_G : G_R) + h * 64 + lane]);
        BR[(size_t)r * D + (RET ? 256 : 512) + h * 64 + lane] = (bf16)f2bf(siluf_(g) * y);
    }
    float* so = C.out + (RET ? (smp ? O_RS + (((size_t)l * DB + b) * 4 + h) * DK * 64 : O_RP + (((size_t)l * BATCH + b) * 4 + h) * DK * 64)
                             : (smp ? O_GS + (((size_t)l * DB + b) * 4 + h) * DK * 64 : O_GP + (((size_t)l * BATCH + b) * 4 + h) * DK * 64));
#pragma unroll
    for (int k = 0; k < DK; ++k) so[k * 64 + lane] = S[k];
}
__device__ __forceinline__ void n2_la(const Ctx& C, int l) {
    THREAD_IDS();
    if ((gw & 63) == 0 && (gw >> 6) < 32) { const int it = gw >> 6; const int b = (it >> 2) & 3, h = it & 3;
        if (it < 16) la_seq<64, true>(C, l, false, b, h); else la_seq<32, false>(C, l, false, b, h); }
    for (int it = gw; it < 256; it += NGW) { const int typ = it >> 7, b = (it >> 2) & 31, h = it & 3;
        if (typ == 0) la_seq<64, true>(C, l, true, b, h); else la_seq<32, false>(C, l, true, b, h); }
}
__device__ __forceinline__ void n2_attn_prompt(const Ctx& C, int l, float lam_init) {
    THREAD_IDS();
    const float* QN = WSP(float, WS_QN); const float* KN = WSP(float, WS_KN); const float* VB = WSP(float, WS_VB); bf16* BR = WSP(bf16, WS_BR);
    const float lam = lam_of(C, l, lam_init);
    LAS float* park = (LAS float*)(C.lds) + wave * (64 * 65);
    constexpr int NQG = (L + 63) / 64;
    for (int it = gw; it < BATCH * 4 * NQG; it += NGW) {
        const int qg = NQG - 1 - it / 16, bh = it % 16, b = bh >> 2, h = bh & 3;
        const int qpos = min(qg * 64 + lane, L - 1); const bool valid = (qg * 64 + lane) < L; const int qrow = b * L + qpos;
        const int nkeys = min(qg * 64 + 64, L);
        float bias_near[1]; (void)bias_near;
        for (int s = 0; s < 2; ++s) {
            float q[32];
#pragma unroll
            for (int i = 0; i < 32; i += 4) { const f32x4 t = *(const f32x4*)(QN + (size_t)qrow * 256 + h * 64 + s * 32 + i); q[i] = t[0] * 0.17677669529663687f; q[i + 1] = t[1] * 0.17677669529663687f; q[i + 2] = t[2] * 0.17677669529663687f; q[i + 3] = t[3] * 0.17677669529663687f; }
            float m = -INFINITY, lsum = 0.f; float acc[64];
#pragma unroll
            for (int i = 0; i < 64; ++i) acc[i] = 0.f;
            for (int j = 0; j < nkeys; ++j) {
                const float* kp = KN + (size_t)(b * L + j) * 256 + h * 64 + s * 32; const float* vp = VB + (size_t)(b * L + j) * 256 + h * 64;
                float sc = 0.f;
#pragma unroll
                for (int i = 0; i < 32; i += 4) { const f32x4 kv = *(const f32x4*)(kp + i); sc += q[i] * kv[0] + q[i + 1] * kv[1] + q[i + 2] * kv[2] + q[i + 3] * kv[3]; }
                const int n = qpos - j;
                sc += C.in[I_RELB][t5_bucket(n < 0 ? 0 : n) * 4 + h];
                if (n < 0) sc = -INFINITY;
                const float mn = fmaxf(m, sc); const float corr = __expf(m - mn); const float p = __expf(sc - mn);
                m = mn; lsum = lsum * corr + p;
#pragma unroll
                for (int i = 0; i < 64; i += 4) { const f32x4 vv = *(const f32x4*)(vp + i); acc[i] = acc[i] * corr + p * vv[0]; acc[i + 1] = acc[i + 1] * corr + p * vv[1]; acc[i + 2] = acc[i + 2] * corr + p * vv[2]; acc[i + 3] = acc[i + 3] * corr + p * vv[3]; }
            }
            const float inv = 1.0f / lsum;
            if (s == 0) {
#pragma unroll
                for (int i = 0; i < 64; ++i) park[lane * 65 + i] = acc[i] * inv;
                LDS_WAIT();
            } else {
                float ms = 0.f;
#pragma unroll
                for (int i = 0; i < 64; ++i) { acc[i] = park[lane * 65 + i] - lam * (acc[i] * inv); ms += acc[i] * acc[i]; }
                const float rn = rsqrtf(ms * (1.0f / 64) + EPS) * (1.0f - lam_init);
                if (valid) {
#pragma unroll
                    for (int i = 0; i < 64; i += 2) { const unsigned w = pk2(acc[i] * rn * C.in[I_SUBLN][l * 64 + i], acc[i + 1] * rn * C.in[I_SUBLN][l * 64 + i + 1]); *(unsigned*)(BR + (size_t)qrow * D + 768 + h * 64 + i) = w; } }
                LDS_WAIT();
            }
        }
    }
}
__device__ __forceinline__ void n2_attn_sample(const Ctx& C, int l, float lam_init) {
    THREAD_IDS();
    const float* QN = WSP(float, WS_QN); const float* KN = WSP(float, WS_KN); const float* VB = WSP(float, WS_VB); bf16* BR = WSP(bf16, WS_BR);
    const int* PT = (const int*)C.in[I_PT]; const float* CK = C.in[I_CK] + (size_t)l * NPOOL * PAGE * 256; const float* CV = C.in[I_CV] + (size_t)l * NPOOL * PAGE * 256;
    const float lam = lam_of(C, l, lam_init);
    LAS float* part = (LAS float*)C.lds;
    for (int b = blockIdx.x; b < DB; b += C.G) {
        const int row = tid & 63, split = tid >> 6, h = row >> 4, s = (row >> 3) & 1, t = row & 7;
        float q[32];
#pragma unroll
        for (int i = 0; i < 32; ++i) q[i] = QN[(size_t)(MP + b * 8 + t) * 256 + h * 64 + s * 32 + i] * 0.17677669529663687f;
        float m = -INFINITY, lsum = 0.f; float acc[64];
#pragma unroll
        for (int i = 0; i < 64; ++i) acc[i] = 0.f;
        for (int j = split; j < PAST + DS; j += 8) {
            const float* kp; const float* vp; bool vis = true;
            if (j < PAST) { const int page = PT[b * NPAGES + (j >> 7)]; const size_t base = (((size_t)page * PAGE + (j & 127)) * 4 + h) * 64; kp = CK + base + s * 32; vp = CV + base; }
            else { const int jj = j - PAST; const size_t r2 = (size_t)(MP + b * 8 + jj); kp = KN + r2 * 256 + h * 64 + s * 32; vp = VB + r2 * 256 + h * 64; vis = jj <= t; }
            float sc = 0.f;
#pragma unroll
            for (int i = 0; i < 32; i += 4) { const f32x4 kv = *(const f32x4*)(kp + i); sc += q[i] * kv[0] + q[i + 1] * kv[1] + q[i + 2] * kv[2] + q[i + 3] * kv[3]; }
            const int n = PAST + t - j;
            sc += C.in[I_RELB][t5_bucket(n < 0 ? 0 : n) * 4 + h];
            if (!vis) sc = -INFINITY;
            const float mn = fmaxf(m, sc); const float corr = __expf(m - mn); const float p = __expf(sc - mn);
            m = mn; lsum = lsum * corr + p;
#pragma unroll
            for (int i = 0; i < 64; i += 4) { const f32x4 vv = *(const f32x4*)(vp + i); acc[i] = acc[i] * corr + p * vv[0]; acc[i + 1] = acc[i + 1] * corr + p * vv[1]; acc[i + 2] = acc[i + 2] * corr + p * vv[2]; acc[i + 3] = acc[i + 3] * corr + p * vv[3]; }
        }
        LAS float* pr = part + (split * 64 + row) * 66;
        pr[64] = m; pr[65] = lsum;
#pragma unroll
        for (int i = 0; i < 64; ++i) pr[i] = acc[i];
        __syncthreads();
        for (int k = 0; k < 4; ++k) { const int p = wave * 4 + k, h2 = p >> 3, t2 = p & 7; float os[2];
#pragma unroll
            for (int s2 = 0; s2 < 2; ++s2) { const int rw = h2 * 16 + s2 * 8 + t2; float mm = -INFINITY;
                for (int sp = 0; sp < 8; ++sp) mm = fmaxf(mm, part[(sp * 64 + rw) * 66 + 64]);
                float ll = 0.f, oo = 0.f;
                for (int sp = 0; sp < 8; ++sp) { const float w = __expf(part[(sp * 64 + rw) * 66 + 64] - mm); ll += part[(sp * 64 + rw) * 66 + 65] * w; oo += part[(sp * 64 + rw) * 66 + lane] * w; }
                os[s2] = oo / ll; }
            const float o = os[0] - lam * os[1]; const float ms = wave_sum(o * o) * (1.0f / 64);
            const float y = o * rsqrtf(ms + EPS) * C.in[I_SUBLN][l * 64 + lane] * (1.0f - lam_init);
            BR[(size_t)(MP + b * 8 + t2) * D + 768 + h2 * 64 + lane] = (bf16)f2bf(y); }
        __syncthreads();
    }
}
typedef short bf16x8_t __attribute__((ext_vector_type(8)));
template <int DK, bool RET> __device__ __forceinline__ void la_chunked(const Ctx& C, int l, bool smp, int b, int h) {
    THREAD_IDS();
    constexpr int QS = DK + 8, TS = 72, NKB = DK / 16, NKS = DK / 32;
    constexpr int SB = 2 * 64 * QS + 64 * TS + DK * TS + 64 * TS + 64;
    LAS bf16* SB0 = (LAS bf16*)(C.lds);
    LAS bf16* AL = SB0 + 2 * SB;
    LAS bf16* ST = AL + 64 * TS;
    const bf16* ZM = WSP(bf16, WS_ZMIX); const float* RQ = WSP(float, WS_RQ); const float* RK = WSP(float, WS_RK); const float* LD = WSP(float, WS_LDEC); bf16* BR = WSP(bf16, WS_BR);
    const int nt = smp ? DS : L, row0 = smp ? MP + b * DS : b * L, nch = (nt + 63) >> 6;
    const float lg2 = RET ? log2f(1.0f - exp2f(-5.0f - (float)h)) : 0.f;
    const int g4 = lane >> 4, c16 = lane & 15;
    const bool qwave = wave < 4; const int w4 = wave & 3;
    float Sreg[NKB][4];
    if (wave >= 4) {
        const float* s0 = (RET ? C.in[I_SRET] : C.in[I_SGLA]) + (((size_t)l * DB + b) * 4 + h) * DK * 64;
#pragma unroll
        for (int cb = 0; cb < NKB; ++cb)
#pragma unroll
            for (int r = 0; r < 4; ++r) { const int dk = cb * 16 + c16, dv = (wave - 4) * 16 + 4 * g4 + r; const float v = smp ? s0[dk * 64 + dv] : 0.f; Sreg[cb][r] = v; ST[dv * QS + dk] = (bf16)f2bf(v); }
    }
    float gnv[4];
#pragma unroll
    for (int cb = 0; cb < 4; ++cb) gnv[cb] = (RET ? C.in[I_RGN] : C.in[I_GGN])[(l * 4 + h) * 64 + cb * 16 + c16];
    float a[16]; v4u vr, gr;
#define LA_LOAD(c) do { const size_t r_ = (size_t)(row0 + (c) * 64 + lane); const bf16* z_ = ZM + r_ * NMIXP; \
        vr = *(const v4u*)(z_ + (RET ? R_V : G_V) + h * 64 + 8 * wave); gr = *(const v4u*)(z_ + (RET ? R_G : G_R) + h * 64 + 8 * wave); \
        if (RET) { const float* p_ = (qwave ? RQ : RK) + r_ * 256 + h * 64 + 8 * w4; const f32x4 x0 = *(const f32x4*)p_, x1 = *(const f32x4*)(p_ + 4), x2 = *(const f32x4*)(p_ + 32), x3 = *(const f32x4*)(p_ + 36); \
            a[0] = x0[0]; a[1] = x0[1]; a[2] = x0[2]; a[3] = x0[3]; a[4] = x1[0]; a[5] = x1[1]; a[6] = x1[2]; a[7] = x1[3]; a[8] = x2[0]; a[9] = x2[1]; a[10] = x2[2]; a[11] = x2[3]; a[12] = x3[0]; a[13] = x3[1]; a[14] = x3[2]; a[15] = x3[3]; } \
        else { const v4u q_ = *(const v4u*)(z_ + (qwave ? G_Q : G_K) + h * 32 + 8 * w4); const float* p_ = LD + r_ * 128 + h * 32 + 8 * w4; const f32x4 x0 = *(const f32x4*)p_, x1 = *(const f32x4*)(p_ + 4); \
            a[0] = bflo(q_.x); a[1] = bfhi(q_.x); a[2] = bflo(q_.y); a[3] = bfhi(q_.y); a[4] = bflo(q_.z); a[5] = bfhi(q_.z); a[6] = bflo(q_.w); a[7] = bfhi(q_.w); \
            a[8] = x0[0]; a[9] = x0[1]; a[10] = x0[2]; a[11] = x0[3]; a[12] = x1[0]; a[13] = x1[1]; a[14] = x1[2]; a[15] = x1[3]; } } while (0)
    LA_LOAD(0);
    int cur = 0;
    for (int i = 0; i <= nch; ++i) {
        if (i < nch) {
            const int c = i; LAS bf16* QT = SB0 + (i & 1) * SB; LAS bf16* KT = QT + 64 * QS; LAS bf16* VT = KT + 64 * QS; LAS bf16* KE = VT + 64 * TS; LAS bf16* GT = KE + DK * TS; LAS float* WT = (LAS float*)(GT + 64 * TS);
            const int nvc = min(64, nt - c * 64); const bool valid = lane < nvc;
        if (RET) {
            const float tq = (float)(lane + 1);
            if (qwave) { const float e = valid ? __builtin_amdgcn_exp2f(lg2 * tq) : 0.f;
                v4u w0, w1; w0.x = pg8::cvt_pk_bf16(a[0] * e, a[1] * e); w0.y = pg8::cvt_pk_bf16(a[2] * e, a[3] * e); w0.z = pg8::cvt_pk_bf16(a[4] * e, a[5] * e); w0.w = pg8::cvt_pk_bf16(a[6] * e, a[7] * e);
                w1.x = pg8::cvt_pk_bf16(a[8] * e, a[9] * e); w1.y = pg8::cvt_pk_bf16(a[10] * e, a[11] * e); w1.z = pg8::cvt_pk_bf16(a[12] * e, a[13] * e); w1.w = pg8::cvt_pk_bf16(a[14] * e, a[15] * e);
                *(LAS v4u*)(QT + lane * QS + 8 * w4) = w0; *(LAS v4u*)(QT + lane * QS + 32 + 8 * w4) = w1; }
            else { const float e = valid ? __builtin_amdgcn_exp2f(-lg2 * tq) : 0.f, ee = valid ? __builtin_amdgcn_exp2f(lg2 * ((float)nvc - tq)) : 0.f;
                v4u w0, w1; w0.x = pg8::cvt_pk_bf16(a[0] * e, a[1] * e); w0.y = pg8::cvt_pk_bf16(a[2] * e, a[3] * e); w0.z = pg8::cvt_pk_bf16(a[4] * e, a[5] * e); w0.w = pg8::cvt_pk_bf16(a[6] * e, a[7] * e);
                w1.x = pg8::cvt_pk_bf16(a[8] * e, a[9] * e); w1.y = pg8::cvt_pk_bf16(a[10] * e, a[11] * e); w1.z = pg8::cvt_pk_bf16(a[12] * e, a[13] * e); w1.w = pg8::cvt_pk_bf16(a[14] * e, a[15] * e);
                *(LAS v4u*)(KT + lane * QS + 8 * w4) = w0; *(LAS v4u*)(KT + lane * QS + 32 + 8 * w4) = w1;
#pragma unroll
                for (int i = 0; i < 16; i += 2) { const unsigned mine = pg8::cvt_pk_bf16(a[i] * ee, a[i + 1] * ee); const unsigned pv = (unsigned)__shfl_xor((int)mine, 1);
                    const unsigned w = (lane & 1) ? ((pv >> 16) | (mine & 0xffff0000u)) : ((mine & 0xffffu) | (pv << 16));
                    const int row = (i < 8 ? 8 * w4 + i : 32 + 8 * w4 + (i - 8)) + (lane & 1);
                    *(LAS unsigned*)(KE + row * TS + (lane & ~1)) = w; } }
        } else {
            float bb[8];
#pragma unroll
            for (int i = 0; i < 8; ++i) bb[i] = valid ? a[8 + i] : 0.f;
#pragma unroll
            for (int i = 0; i < 8; ++i) { float x = bb[i];
                x += __builtin_bit_cast(float, __builtin_amdgcn_mov_dpp(__builtin_bit_cast(int, x), 0x111, 0xf, 0xf, true));
                x += __builtin_bit_cast(float, __builtin_amdgcn_mov_dpp(__builtin_bit_cast(int, x), 0x112, 0xf, 0xf, true));
                x += __builtin_bit_cast(float, __builtin_amdgcn_mov_dpp(__builtin_bit_cast(int, x), 0x114, 0xf, 0xf, true));
                x += __builtin_bit_cast(float, __builtin_amdgcn_mov_dpp(__builtin_bit_cast(int, x), 0x118, 0xf, 0xf, true));
                const float t0 = __builtin_bit_cast(float, __builtin_amdgcn_readlane(__builtin_bit_cast(int, x), 15)), t1 = __builtin_bit_cast(float, __builtin_amdgcn_readlane(__builtin_bit_cast(int, x), 31)), t2 = __builtin_bit_cast(float, __builtin_amdgcn_readlane(__builtin_bit_cast(int, x), 47));
                bb[i] = x + (lane >= 16 ? t0 : 0.f) + (lane >= 32 ? t1 : 0.f) + (lane >= 48 ? t2 : 0.f); }
            if (qwave) {
                if (lane == 63) {
#pragma unroll
                    for (int i = 0; i < 8; ++i) WT[8 * w4 + i] = bb[i]; }
                float o8[8];
#pragma unroll
                for (int i = 0; i < 8; ++i) o8[i] = valid ? a[i] * 0.17677669529663687f * __expf(bb[i]) : 0.f;
                v4u w0; w0.x = pg8::cvt_pk_bf16(o8[0], o8[1]); w0.y = pg8::cvt_pk_bf16(o8[2], o8[3]); w0.z = pg8::cvt_pk_bf16(o8[4], o8[5]); w0.w = pg8::cvt_pk_bf16(o8[6], o8[7]);
                *(LAS v4u*)(QT + lane * QS + 8 * w4) = w0;
            } else {
                float o8[8];
#pragma unroll
                for (int i = 0; i < 8; ++i) o8[i] = valid ? a[i] * __expf(-bb[i]) : 0.f;
#pragma unroll
                for (int i = 0; i < 8; i += 2) { const float t0 = __shfl(bb[i], 63), t1 = __shfl(bb[i + 1], 63);
                    const unsigned mine = pg8::cvt_pk_bf16(valid ? a[i] * __expf(t0 - bb[i]) : 0.f, valid ? a[i + 1] * __expf(t1 - bb[i + 1]) : 0.f); const unsigned pv = (unsigned)__shfl_xor((int)mine, 1);
                    const unsigned w = (lane & 1) ? ((pv >> 16) | (mine & 0xffff0000u)) : ((mine & 0xffffu) | (pv << 16));
                    *(LAS unsigned*)(KE + (8 * w4 + i + (lane & 1)) * TS + (lane & ~1)) = w; }
                v4u w0; w0.x = pg8::cvt_pk_bf16(o8[0], o8[1]); w0.y = pg8::cvt_pk_bf16(o8[2], o8[3]); w0.z = pg8::cvt_pk_bf16(o8[4], o8[5]); w0.w = pg8::cvt_pk_bf16(o8[6], o8[7]);
                *(LAS v4u*)(KT + lane * QS + 8 * w4) = w0;
            }
        }
        { const unsigned vv[4] = {valid ? vr.x : 0u, valid ? vr.y : 0u, valid ? vr.z : 0u, valid ? vr.w : 0u};
#pragma unroll
          for (int i = 0; i < 4; ++i) { const unsigned pv = (unsigned)__shfl_xor((int)vv[i], 1);
              const unsigned w = (lane & 1) ? ((pv >> 16) | (vv[i] & 0xffff0000u)) : ((vv[i] & 0xffffu) | (pv << 16));
              *(LAS unsigned*)(VT + (8 * wave + 2 * i + (lane & 1)) * TS + (lane & ~1)) = w; } }
            *(LAS v4u*)(GT + lane * TS + 8 * wave) = gr;
            if (c + 1 < nch) LA_LOAD(c + 1);
        }
        if (i >= 1) {
            LAS bf16* QT = SB0 + ((i - 1) & 1) * SB; LAS bf16* KT = QT + 64 * QS;
        { const int rb = wave >> 1;
#pragma unroll
          for (int ci = 0; ci < 2; ++ci) { const int cb = (wave & 1) * 2 + ci; f32x4 acc = {0.f, 0.f, 0.f, 0.f};
              if (cb <= rb) {
#pragma unroll
                  for (int ks = 0; ks < NKS; ++ks) { const bf16x8_t af = *(const LAS bf16x8_t*)(QT + (rb * 16 + c16) * QS + ks * 32 + 8 * g4), bf = *(const LAS bf16x8_t*)(KT + (cb * 16 + c16) * QS + ks * 32 + 8 * g4);
                      acc = __builtin_amdgcn_mfma_f32_16x16x32_bf16(af, bf, acc, 0, 0, 0); } }
#pragma unroll
              for (int r = 0; r < 4; ++r) { const int tt = rb * 16 + 4 * g4 + r, ss = cb * 16 + c16; AL[tt * TS + ss] = (bf16)f2bf(ss <= tt ? acc[r] : 0.f); } } }
        }
        LDS_WAIT(); __builtin_amdgcn_s_barrier(); asm volatile("" ::: "memory");
        if (i >= 1) {
            const int c = i - 1; LAS bf16* QT = SB0 + (c & 1) * SB; LAS bf16* KT = QT + 64 * QS; LAS bf16* VT = KT + 64 * QS; LAS bf16* KE = VT + 64 * TS; LAS bf16* GT = KE + DK * TS; LAS float* WT = (LAS float*)(GT + 64 * TS);
            const int nvc = min(64, nt - c * 64); (void)KT;
        if (wave < 4) {
            const int rb = wave; const LAS bf16* STc = ST + cur * 64 * QS;
            f32x4 o[4];
#pragma unroll
            for (int cb = 0; cb < 4; ++cb) o[cb] = (f32x4){0.f, 0.f, 0.f, 0.f};
#pragma unroll
            for (int ks = 0; ks < 2; ++ks) { const bf16x8_t af = *(const LAS bf16x8_t*)(AL + (rb * 16 + c16) * TS + ks * 32 + 8 * g4);
#pragma unroll
                for (int cb = 0; cb < 4; ++cb) { const bf16x8_t bf = *(const LAS bf16x8_t*)(VT + (cb * 16 + c16) * TS + ks * 32 + 8 * g4); o[cb] = __builtin_amdgcn_mfma_f32_16x16x32_bf16(af, bf, o[cb], 0, 0, 0); } }
#pragma unroll
            for (int ks = 0; ks < NKS; ++ks) { const bf16x8_t af = *(const LAS bf16x8_t*)(QT + (rb * 16 + c16) * QS + ks * 32 + 8 * g4);
#pragma unroll
                for (int cb = 0; cb < 4; ++cb) { const bf16x8_t bf = *(const LAS bf16x8_t*)(STc + (cb * 16 + c16) * QS + ks * 32 + 8 * g4); o[cb] = __builtin_amdgcn_mfma_f32_16x16x32_bf16(af, bf, o[cb], 0, 0, 0); } }
#pragma unroll
            for (int r = 0; r < 4; ++r) {
                float s = (o[0][r] + o[1][r]) + (o[2][r] + o[3][r]); float y[4];
                if (RET) { s += __shfl_xor(s, 1); s += __shfl_xor(s, 2); s += __shfl_xor(s, 4); s += __shfl_xor(s, 8); const float mean = s * (1.0f / 64);
                    float q2 = 0.f;
#pragma unroll
                    for (int cb = 0; cb < 4; ++cb) { y[cb] = o[cb][r] - mean; q2 += y[cb] * y[cb]; }
                    q2 += __shfl_xor(q2, 1); q2 += __shfl_xor(q2, 2); q2 += __shfl_xor(q2, 4); q2 += __shfl_xor(q2, 8); const float rs = rsqrtf(q2 * (1.0f / 64) + EPS);
#pragma unroll
                    for (int cb = 0; cb < 4; ++cb) y[cb] *= rs;
                } else { float q2 = (o[0][r] * o[0][r] + o[1][r] * o[1][r]) + (o[2][r] * o[2][r] + o[3][r] * o[3][r]);
                    q2 += __shfl_xor(q2, 1); q2 += __shfl_xor(q2, 2); q2 += __shfl_xor(q2, 4); q2 += __shfl_xor(q2, 8); const float rs = rsqrtf(q2 * (1.0f / 64) + EPS);
#pragma unroll
                    for (int cb = 0; cb < 4; ++cb) y[cb] = o[cb][r] * rs; }
                const int tok = c * 64 + rb * 16 + 4 * g4 + r;
                if (tok < nt) { const size_t row = (size_t)(row0 + tok);
#pragma unroll
                    for (int cb = 0; cb < 4; ++cb) { const int dv = cb * 16 + c16; const float g = bf2f(GT[(rb * 16 + 4 * g4 + r) * TS + dv]);
                        BR[row * D + (RET ? 256 : 512) + h * 64 + dv] = (bf16)f2bf(siluf_(g) * y[cb] * gnv[cb]); } }
            }
        } else {
            const int dvb = wave - 4; LAS bf16* STn = ST + (cur ^ 1) * 64 * QS;
            f32x4 ds[NKB];
#pragma unroll
            for (int cb = 0; cb < NKB; ++cb) ds[cb] = (f32x4){0.f, 0.f, 0.f, 0.f};
#pragma unroll
            for (int ks = 0; ks < 2; ++ks) { const bf16x8_t af = *(const LAS bf16x8_t*)(VT + (dvb * 16 + c16) * TS + ks * 32 + 8 * g4);
#pragma unroll
                for (int cb = 0; cb < NKB; ++cb) { const bf16x8_t bf = *(const LAS bf16x8_t*)(KE + (cb * 16 + c16) * TS + ks * 32 + 8 * g4); ds[cb] = __builtin_amdgcn_mfma_f32_16x16x32_bf16(af, bf, ds[cb], 0, 0, 0); } }
#pragma unroll
            for (int cb = 0; cb < NKB; ++cb) { const float eB = RET ? __builtin_amdgcn_exp2f(lg2 * (float)nvc) : __expf(WT[cb * 16 + c16]);
#pragma unroll
                for (int r = 0; r < 4; ++r) { Sreg[cb][r] = eB * Sreg[cb][r] + ds[cb][r]; STn[(dvb * 16 + 4 * g4 + r) * QS + cb * 16 + c16] = (bf16)f2bf(Sreg[cb][r]); } }
        }
            cur ^= 1;
        }
        LDS_WAIT(); __builtin_amdgcn_s_barrier(); asm volatile("" ::: "memory");
    }
#undef LA_LOAD
    if (wave >= 4) {
        float* so = C.out + (RET ? (smp ? O_RS + (((size_t)l * DB + b) * 4 + h) * DK * 64 : O_RP + (((size_t)l * BATCH + b) * 4 + h) * DK * 64)
                                 : (smp ? O_GS + (((size_t)l * DB + b) * 4 + h) * DK * 64 : O_GP + (((size_t)l * BATCH + b) * 4 + h) * DK * 64));
#pragma unroll
        for (int cb = 0; cb < NKB; ++cb)
#pragma unroll
            for (int r = 0; r < 4; ++r) so[(cb * 16 + c16) * 64 + (wave - 4) * 16 + 4 * g4 + r] = Sreg[cb][r];
    }
}
__device__ __forceinline__ void n2_la_chunked(const Ctx& C, int l) {
    const int bx = blockIdx.x;
    if (bx < 32) { const int b = (bx >> 2) & 3, h = bx & 3; if (bx < 16) la_chunked<64, true>(C, l, false, b, h); else la_chunked<32, false>(C, l, false, b, h); }
    else { for (int it = bx - 32; it < 256; it += C.G - 32) { const int b = (it >> 2) & 31, h = it & 3; if (it < 128) la_chunked<64, true>(C, l, true, b, h); else la_chunked<32, false>(C, l, true, b, h); } }
}
typedef float f32x16_t __attribute__((ext_vector_type(16)));
__device__ __forceinline__ int crow_(int r, int hi) { return (r & 3) + 8 * (r >> 2) + 4 * hi; }
__device__ __forceinline__ float swapmax32(float m) { auto rr = __builtin_amdgcn_permlane32_swap(__float_as_uint(m), __float_as_uint(m), false, false); return fmaxf(__uint_as_float(rr[0]), __uint_as_float(rr[1])); }
__device__ __forceinline__ float swapadd32(float m) { auto rr = __builtin_amdgcn_permlane32_swap(__float_as_uint(m), __float_as_uint(m), false, false); return __uint_as_float(rr[0]) + __uint_as_float(rr[1]); }
constexpr float LOG2E = 1.4426950408889634f;
__device__ __forceinline__ void attn_prompt_item(const Ctx& C, int l, int b, int h, int qb, float lam, float lam_init) {
    THREAD_IDS();
    constexpr int KS = 72;
    LAS bf16* Kt = (LAS bf16*)C.lds;
    LAS bf16* Vt = Kt + 2 * 64 * KS;
    LAS float* BT = (LAS float*)(Vt + 2 * 64 * KS);
    LAS float* OX = BT + 128;
    const bf16* ZM = WSP(bf16, WS_ZMIX); const bf16* QNB = WSP(bf16, WS_QNB); const bf16* KNB = WSP(bf16, WS_KNB); bf16* BR = WSP(bf16, WS_BR);
    const int r32 = lane & 31, hi = lane >> 5, qs = wave >> 1, s = wave & 1;
    const int q0 = qb * 128 + qs * 32; const int rowb = b * L;
    if (tid < 128) BT[tid] = (C.in[I_RELB][t5_bucket(tid) * 4 + h] - C.in[I_RELB][31 * 4 + h]) * LOG2E;
    pg8::bf16x8 qf[2];
#pragma unroll
    for (int d0 = 0; d0 < 2; ++d0) qf[d0] = *(const pg8::bf16x8*)(QNB + (size_t)(rowb + q0 + r32) * 256 + h * 64 + s * 32 + 16 * d0 + 8 * hi);
    const int pl = (lane & ~15) | ((lane & 8) >> 1) | ((lane & 4) << 1) | (lane & 3);
    const int NT = (min(128 * (qb + 1), L) + 63) >> 6;
    v4u kreg, vreg;
#define AT_LOAD(j) do { const size_t r_ = (size_t)(rowb + (j) * 64 + lane); kreg = *(const v4u*)(KNB + r_ * 256 + h * 64 + 8 * wave); vreg = *(const v4u*)(ZM + r_ * NMIXP + D_V + h * 64 + 8 * wave); } while (0)
#define AT_STORE(buf) do { *(LAS v4u*)(Kt + (buf) * 64 * KS + lane * KS + 8 * wave) = kreg; LAS bf16* v_ = Vt + (buf) * 64 * KS + (8 * wave) * KS + pl; \
        v_[0] = (bf16)(vreg.x & 0xffffu); v_[KS] = (bf16)(vreg.x >> 16); v_[2 * KS] = (bf16)(vreg.y & 0xffffu); v_[3 * KS] = (bf16)(vreg.y >> 16); \
        v_[4 * KS] = (bf16)(vreg.z & 0xffffu); v_[5 * KS] = (bf16)(vreg.z >> 16); v_[6 * KS] = (bf16)(vreg.w & 0xffffu); v_[7 * KS] = (bf16)(vreg.w >> 16); } while (0)
    AT_LOAD(0); AT_STORE(0); if (NT > 1) AT_LOAD(1);
    LDS_WAIT(); __builtin_amdgcn_s_barrier(); asm volatile("" ::: "memory");
    float m = -INFINITY, lsum = 0.f; f32x16_t o[2];
#pragma unroll
    for (int i = 0; i < 16; ++i) { o[0][i] = 0.f; o[1][i] = 0.f; }
    for (int j = 0; j < NT; ++j) {
        const int k0 = 64 * j, buf = j & 1;
        if (k0 <= q0 + 31) {
            const LAS bf16* kb = Kt + buf * 64 * KS; const LAS bf16* vb = Vt + buf * 64 * KS;
            f32x16_t p0, p1;
#pragma unroll
            for (int i = 0; i < 16; ++i) { p0[i] = 0.f; p1[i] = 0.f; }
#pragma unroll
            for (int d0 = 0; d0 < 2; ++d0) { const pg8::bf16x8 a0 = *(const LAS pg8::bf16x8*)(kb + r32 * KS + s * 32 + 16 * d0 + 8 * hi), a1 = *(const LAS pg8::bf16x8*)(kb + (32 + r32) * KS + s * 32 + 16 * d0 + 8 * hi);
                p0 = __builtin_amdgcn_mfma_f32_32x32x16_bf16(a0, qf[d0], p0, 0, 0, 0); p1 = __builtin_amdgcn_mfma_f32_32x32x16_bf16(a1, qf[d0], p1, 0, 0, 0); }
            if (q0 - k0 - 63 < 113) {
#pragma unroll
                for (int r = 0; r < 16; ++r) { const int n0 = (q0 + r32) - (k0 + crow_(r, hi)), n1 = n0 - 32;
                    p0[r] = n0 < 0 ? -INFINITY : p0[r] + (n0 < 128 ? BT[n0] : 0.f); p1[r] = n1 < 0 ? -INFINITY : p1[r] + (n1 < 128 ? BT[n1] : 0.f); } }
            float mt = fmaxf(p0[0], p1[0]);
#pragma unroll
            for (int r = 1; r < 16; ++r) mt = fmaxf(mt, fmaxf(p0[r], p1[r]));
            mt = swapmax32(mt);
            const float mn = fmaxf(m, mt);
            if (__any(mn > m)) { const float al = exp2f(m - mn);
#pragma unroll
                for (int i = 0; i < 16; ++i) { o[0][i] *= al; o[1][i] *= al; }
                lsum *= al; m = mn; }
            float ps = 0.f;
#pragma unroll
            for (int r = 0; r < 16; ++r) { p0[r] = exp2f(p0[r] - m); p1[r] = exp2f(p1[r] - m); ps += p0[r] + p1[r]; }
            lsum += ps;
            pg8::bf16x8 pb[4];
#pragma unroll
            for (int ks = 0; ks < 4; ++ks) { v4u w;
                if (ks < 2) { w.x = pg8::cvt_pk_bf16(p0[8 * ks], p0[8 * ks + 1]); w.y = pg8::cvt_pk_bf16(p0[8 * ks + 2], p0[8 * ks + 3]); w.z = pg8::cvt_pk_bf16(p0[8 * ks + 4], p0[8 * ks + 5]); w.w = pg8::cvt_pk_bf16(p0[8 * ks + 6], p0[8 * ks + 7]); }
                else { w.x = pg8::cvt_pk_bf16(p1[8 * ks - 16], p1[8 * ks - 15]); w.y = pg8::cvt_pk_bf16(p1[8 * ks - 14], p1[8 * ks - 13]); w.z = pg8::cvt_pk_bf16(p1[8 * ks - 12], p1[8 * ks - 11]); w.w = pg8::cvt_pk_bf16(p1[8 * ks - 10], p1[8 * ks - 9]); }
                pb[ks] = __builtin_bit_cast(pg8::bf16x8, w); }
#pragma unroll
            for (int d0 = 0; d0 < 2; ++d0)
#pragma unroll
                for (int ks = 0; ks < 4; ++ks) { const pg8::bf16x8 af = *(const LAS pg8::bf16x8*)(vb + (32 * d0 + r32) * KS + 16 * ks + 8 * hi); o[d0] = __builtin_amdgcn_mfma_f32_32x32x16_bf16(af, pb[ks], o[d0], 0, 0, 0); }
        }
        if (j + 1 < NT) AT_STORE(buf ^ 1);
        if (j + 2 < NT) AT_LOAD(j + 2);
        LDS_WAIT(); __builtin_amdgcn_s_barrier(); asm volatile("" ::: "memory");
    }
#undef AT_LOAD
#undef AT_STORE
    lsum = swapadd32(lsum); const float inv = 1.0f / lsum;
    LAS float* ox = OX + (qs * 32 + r32) * 65;
    if (s == 1) {
#pragma unroll
        for (int d0 = 0; d0 < 2; ++d0)
#pragma unroll
            for (int r = 0; r < 16; ++r) ox[32 * d0 + crow_(r, hi)] = o[d0][r] * inv; }
    LDS_WAIT(); __builtin_amdgcn_s_barrier(); asm volatile("" ::: "memory");
    if (s == 0) {
        float ss = 0.f;
#pragma unroll
        for (int d0 = 0; d0 < 2; ++d0)
#pragma unroll
            for (int r = 0; r < 16; ++r) { const float v = o[d0][r] * inv - lam * ox[32 * d0 + crow_(r, hi)]; o[d0][r] = v; ss += v * v; }
        ss = swapadd32(ss); const float rs = rsqrtf(ss * (1.0f / 64) + EPS) * (1.0f - lam_init);
        const int qpos = q0 + r32;
        if (qpos < L) { bf16* brp = BR + (size_t)(rowb + qpos) * D + 768 + h * 64;
#pragma unroll
            for (int d0 = 0; d0 < 2; ++d0)
#pragma unroll
                for (int r4 = 0; r4 < 4; ++r4) { const int dv = 32 * d0 + 8 * r4 + 4 * hi; const float* sl = C.in[I_SUBLN] + l * 64 + dv;
                    const unsigned w0 = pk2(o[d0][4 * r4] * rs * sl[0], o[d0][4 * r4 + 1] * rs * sl[1]), w1 = pk2(o[d0][4 * r4 + 2] * rs * sl[2], o[d0][4 * r4 + 3] * rs * sl[3]);
                    *(unsigned long long*)(brp + dv) = (unsigned long long)w0 | ((unsigned long long)w1 << 32); } }
    }
    LDS_WAIT(); __builtin_amdgcn_s_barrier(); asm volatile("" ::: "memory");
}
__device__ __forceinline__ void n2_attn_prompt_mfma(const Ctx& C, int l, float lam_init, int qoff = 0) {
    THREAD_IDS();
    const float lam = lam_of(C, l, lam_init);
    unsigned* qw = (unsigned*)(C.ws + WS_CTL) + CW_QUEUE + 64 * (l + qoff);
    volatile LAS int* slot = (volatile LAS int*)(C.lds + MISC_OFF + 64);
    constexpr int NQB = (L + 127) / 128;
    for (;;) {
        if (tid == 0) slot[0] = (int)__hip_atomic_fetch_add(qw, 1u, __ATOMIC_RELAXED, __HIP_MEMORY_SCOPE_AGENT);
        __syncthreads();
        const int it = slot[0];
        if (it >= 16 * NQB) break;
        attn_prompt_item(C, l, (it & 15) >> 2, it & 3, NQB - 1 - (it >> 4), lam, lam_init);
    }
}
constexpr int PSTR = 68;
__device__ __forceinline__ pg8::bf16x8 cvt8(const f32x4 a, const f32x4 b) { v4u w; w.x = pg8::cvt_pk_bf16(a[0], a[1]); w.y = pg8::cvt_pk_bf16(a[2], a[3]); w.z = pg8::cvt_pk_bf16(b[0], b[1]); w.w = pg8::cvt_pk_bf16(b[2], b[3]); return __builtin_bit_cast(pg8::bf16x8, w); }
__device__ __forceinline__ void attn_sample_item(const Ctx& C, int l, int b, int split) {
    THREAD_IDS();
    const int h = wave & 3, half = wave >> 2, c16 = lane & 15, g = lane >> 4, srow = c16 >> 3, t = c16 & 7;
    const bf16* QNB = WSP(bf16, WS_QNB); const int* PT = (const int*)C.in[I_PT];
    const float* CK = C.in[I_CK] + (size_t)l * NPOOL * PAGE * 256; const float* CV = C.in[I_CV] + (size_t)l * NPOOL * PAGE * 256;
    LAS float* BT = (LAS float*)C.lds;
    BT[tid] = (C.in[I_RELB][t5_bucket(tid & 127) * 4 + (tid >> 7)] - C.in[I_RELB][31 * 4 + (tid >> 7)]) * LOG2E;
    const v4u z4 = {0u, 0u, 0u, 0u};
    const v4u q0w = srow == 0 ? *(const v4u*)(QNB + (size_t)(MP + b * 8 + t) * 256 + h * 64 + 8 * g) : z4, q1w = srow == 1 ? *(const v4u*)(QNB + (size_t)(MP + b * 8 + t) * 256 + h * 64 + 32 + 8 * g) : z4;
    const pg8::bf16x8 qf0 = __builtin_bit_cast(pg8::bf16x8, q0w), qf1 = __builtin_bit_cast(pg8::bf16x8, q1w);
    LDS_WAIT(); __builtin_amdgcn_s_barrier(); asm volatile("" ::: "memory");
    float m = -INFINITY, lsum = 0.f; f32x4 o[4];
#pragma unroll
    for (int db = 0; db < 4; ++db) o[db] = (f32x4){0.f, 0.f, 0.f, 0.f};
    const int kk0 = split * 1024 + half * 512;
    for (int step = 0; step < 16; ++step) {
        const int kk = kk0 + 32 * step; const int page = PT[b * NPAGES + (kk >> 7)];
        const size_t base = ((size_t)(page * PAGE + (kk & 127)) * 4 + h) * 64;
        f32x4 kr[2][2][2]; float vr[4][8];
#pragma unroll
        for (int T = 0; T < 2; ++T)
#pragma unroll
            for (int ks = 0; ks < 2; ++ks) { const float* p = CK + base + (size_t)(16 * T + c16) * 256 + 32 * ks + 8 * g; kr[T][ks][0] = *(const f32x4*)p; kr[T][ks][1] = *(const f32x4*)(p + 4); }
#pragma unroll
        for (int db = 0; db < 4; ++db)
#pragma unroll
            for (int j = 0; j < 8; ++j) { const int kv = j < 4 ? 4 * g + j : 16 + 4 * g + (j - 4); vr[db][j] = CV[base + (size_t)kv * 256 + 16 * db + c16]; }
        f32x4 sv[2];
#pragma unroll
        for (int T = 0; T < 2; ++T) { sv[T] = (f32x4){0.f, 0.f, 0.f, 0.f};
            sv[T] = __builtin_amdgcn_mfma_f32_16x16x32_bf16(cvt8(kr[T][0][0], kr[T][0][1]), qf0, sv[T], 0, 0, 0);
            sv[T] = __builtin_amdgcn_mfma_f32_16x16x32_bf16(cvt8(kr[T][1][0], kr[T][1][1]), qf1, sv[T], 0, 0, 0); }
        if (kk + 31 + 128 > PAST) {
#pragma unroll
            for (int T = 0; T < 2; ++T)
#pragma unroll
                for (int r = 0; r < 4; ++r) { const int n = PAST + t - (kk + 16 * T + 4 * g + r); if (n < 128) sv[T][r] += BT[h * 128 + n]; } }
        float mt = fmaxf(fmaxf(fmaxf(sv[0][0], sv[0][1]), fmaxf(sv[0][2], sv[0][3])), fmaxf(fmaxf(sv[1][0], sv[1][1]), fmaxf(sv[1][2], sv[1][3])));
        mt = fmaxf(mt, __shfl_xor(mt, 16)); mt = fmaxf(mt, __shfl_xor(mt, 32));
        const float mn = fmaxf(m, mt); const float al = exp2f(m - mn); m = mn;
        float ps = 0.f;
#pragma unroll
        for (int T = 0; T < 2; ++T)
#pragma unroll
            for (int r = 0; r < 4; ++r) { sv[T][r] = exp2f(sv[T][r] - m); ps += sv[T][r]; }
        lsum = lsum * al + ps;
        const pg8::bf16x8 pf = cvt8(sv[0], sv[1]);
#pragma unroll
        for (int db = 0; db < 4; ++db) { o[db] = o[db] * al;
            const f32x4 va = {vr[db][0], vr[db][1], vr[db][2], vr[db][3]}, vb = {vr[db][4], vr[db][5], vr[db][6], vr[db][7]};
            o[db] = __builtin_amdgcn_mfma_f32_16x16x32_bf16(cvt8(va, vb), pf, o[db], 0, 0, 0); }
    }
    lsum += __shfl_xor(lsum, 16); lsum += __shfl_xor(lsum, 32);
    float* pp = WSP(float, WS_PART) + ((((size_t)b * 4 + h) * 16 + split * 2 + half) * 16 + c16) * PSTR;
#pragma unroll
    for (int db = 0; db < 4; ++db) *(f32x4*)(pp + 16 * db + 4 * g) = o[db];
    if (g == 0) { pp[64] = m; pp[65] = lsum; }
    LDS_WAIT(); __builtin_amdgcn_s_barrier(); asm volatile("" ::: "memory");
}
__device__ __forceinline__ void n2_attn_sample_split(const Ctx& C, int l) {
    for (int it = blockIdx.x; it < DB * 8; it += C.G) attn_sample_item(C, l, it >> 3, it & 7);
}
__device__ __forceinline__ void n3_attn_sample_combine(const Ctx& C, int l, float lam_init) {
    THREAD_IDS();
    const float lam = lam_of(C, l, lam_init);
    const bf16* QNB = WSP(bf16, WS_QNB); const bf16* KNB = WSP(bf16, WS_KNB); const bf16* ZM = WSP(bf16, WS_ZMIX); bf16* BR = WSP(bf16, WS_BR);
    for (int it = gw; it < DB * 4 * DS; it += NGW) {
        const int b = it >> 5, h = (it >> 3) & 3, t = it & 7; float os[2];
        const float far = C.in[I_RELB][31 * 4 + h];
#pragma unroll
        for (int s = 0; s < 2; ++s) {
            const float* pb = WSP(float, WS_PART) + ((((size_t)b * 4 + h) * 16) * 16 + s * 8 + t) * PSTR;
            float sn[8]; float mm = -INFINITY;
            for (int pi = 0; pi < 16; ++pi) mm = fmaxf(mm, pb[(size_t)pi * 16 * PSTR + 64]);
#pragma unroll
            for (int jj = 0; jj < 8; ++jj) { float d = 0.f;
                for (int i = 0; i < 32; ++i) d += bf2f(QNB[(size_t)(MP + b * 8 + t) * 256 + h * 64 + s * 32 + i]) * bf2f(KNB[(size_t)(MP + b * 8 + jj) * 256 + h * 64 + s * 32 + i]);
                d += (C.in[I_RELB][t5_bucket(t - jj < 0 ? 0 : t - jj) * 4 + h] - far) * LOG2E;
                sn[jj] = jj <= t ? d : -INFINITY; mm = fmaxf(mm, sn[jj]); }
            float ll = 0.f, oo = 0.f;
            for (int pi = 0; pi < 16; ++pi) { const float* pr = pb + (size_t)pi * 16 * PSTR; const float w = exp2f(pr[64] - mm); ll += pr[65] * w; oo += pr[lane] * w; }
#pragma unroll
            for (int jj = 0; jj < 8; ++jj) { const float w = exp2f(sn[jj] - mm); ll += w; oo += w * bf2f(ZM[(size_t)(MP + b * 8 + jj) * NMIXP + D_V + h * 64 + lane]); }
            os[s] = oo / ll;
        }
        const float o = os[0] - lam * os[1]; const float ms = wave_sum(o * o) * (1.0f / 64);
        BR[(size_t)(MP + b * 8 + t) * D + 768 + h * 64 + lane] = (bf16)f2bf(o * rsqrtf(ms + EPS) * C.in[I_SUBLN][l * 64 + lane] * (1.0f - lam_init));
    }
}

constexpr int NQB_ATT = (L + 127) / 128;
constexpr int IT_LA = 32, IT_SS = IT_LA + DB * 8, IT_AT = IT_SS + 16 * NQB_ATT, IT_LS = IT_AT + 256, IT_CV = IT_LS + (MR + 63) / 64, IT_END = IT_CV;
__device__ __forceinline__ void n2_phase(const Ctx& C, int l, float lam_init, int qslot) {
    THREAD_IDS();
    const float lam = lam_of(C, l, lam_init);
    unsigned* qw = (unsigned*)(C.ws + WS_CTL) + CW_QUEUE + 64 * qslot;
    volatile LAS int* slot = (volatile LAS int*)(C.lds + MISC_OFF + 64);
    if (blockIdx.x < IT_LA) { const int it = blockIdx.x; const int b = (it >> 2) & 3, h = it & 3; if (it < 16) la_chunked<64, true>(C, l, false, b, h); else la_chunked<32, false>(C, l, false, b, h); }
#if defined(PROBE_ID)
    if (l == 0 && tid == 0) ((unsigned long long*)(C.ws + WS_CTL + 65536))[blockIdx.x * 16 + 3] = __builtin_amdgcn_s_memrealtime();
#endif
    for (;;) {
        if (tid == 0) slot[0] = (int)__hip_atomic_fetch_add(qw, 1u, __ATOMIC_RELAXED, __HIP_MEMORY_SCOPE_AGENT);
        __syncthreads();
        const int it = slot[0] + IT_LA;
        __syncthreads();
        if (it >= IT_END) break;
        if (it < IT_SS) { const int i2 = it - IT_LA; attn_sample_item(C, l, i2 >> 3, i2 & 7); }
        else if (it < IT_AT) { const int i2 = it - IT_SS; attn_prompt_item(C, l, (i2 & 15) >> 2, i2 & 3, NQB_ATT - 1 - (i2 >> 4), lam, lam_init); }
        else if (it < IT_LS) { const int i2 = it - IT_AT; const int b = (i2 >> 2) & 31, h = i2 & 3; if (i2 < 128) la_chunked<64, true>(C, l, true, b, h); else la_chunked<32, false>(C, l, true, b, h); }
        else { conv_rows_item(C, l, it - IT_LS); conv_state_item(C, l, it - IT_LS, IT_CV - IT_LS); }
    }
}

#ifndef PROBE_ID
#define PROBE_ID 0
#endif
#define TSTAMP(k) do { if (PROBE_ID && l == 0 && threadIdx.x == 0) { ((unsigned long long*)(C.ws + WS_CTL + 65536))[blockIdx.x * 16 + (k)] = __builtin_amdgcn_s_memrealtime(); } } while (0)
template <int l> __device__ __forceinline__ void layer_fwd(const Ctx& C, const XcdBarrier& bar) {
#define GRID_BAR() xcd_barrier<false>(bar)
    LAS unsigned char* ring = C.lds + RING_OFF;
    float* SS = WSP(float, WS_SS); float* H = WSP(float, WS_H); bf16* HB = WSP(bf16, WS_HB); bf16* ACT = WSP(bf16, WS_ACT); bf16* ZMIX = WSP(bf16, WS_ZMIX); bf16* GATES = WSP(bf16, WS_GATES);
    bf16* BR = WSP(bf16, WS_BR); bf16* MERGED = WSP(bf16, WS_MERGED);
    constexpr float lam_init = l == 0 ? 0.2f : 0.35550906759096926f;
    constexpr bool last = (l == DEPTH - 1);
    { pg8::Gemm g{HB, WSP(bf16, WS_W1 + (size_t)(l * 2 + 0) * SZ_W1), D, D, D}; pg8::StaticOrder S; S.init(M, 2 * DFF, C.G, (int)blockIdx.x);
      EpiGLU E{ACT, SS + (size_t)(l * 3 + 0) * M * 16}; pg8::gemm_phase<EpiGLU, pg8::StaticOrder, true, true>(ring, g, S, E); }
    GRID_BAR();
    { pg8::Gemm g{ACT, WSP(bf16, WS_WD + (size_t)(l * 2 + 0) * SZ_WD), DFF, DFF, DFF}; pg8::StaticOrder S; S.init(M, D, C.G, (int)blockIdx.x);
      EpiRes<false, 1> E{H, HB, SS + (size_t)(l * 3 + 1) * M * 16, nullptr}; pg8::gemm_phase<EpiRes<false, 1>, pg8::StaticOrder, true, true>(ring, g, S, E); }
    GRID_BAR();
    { pg8::Gemm g{HB, WSP(bf16, WS_WIN + (size_t)l * SZ_WIN), D, D, D}; pg8::StaticOrder S; S.init(M, NINP, C.G, (int)blockIdx.x);
      EpiZ E{ZMIX, GATES, SS + (size_t)(l * 3 + 1) * M * 16, WSP(float, WS_BINP) + l * NINP}; pg8::gemm_phase<EpiZ, pg8::StaticOrder, true, true>(ring, g, S, E); }
    GRID_BAR();
    TSTAMP(0);
    n1_prep(C, l);
    TSTAMP(1);
    GRID_BAR();
    TSTAMP(2);
    n2_phase(C, l, lam_init, l);
    TSTAMP(6);
    GRID_BAR();
    TSTAMP(7);
    n3_attn_sample_combine(C, l, lam_init);
    TSTAMP(8);
    GRID_BAR();
    TSTAMP(9);
    { pg8::Gemm g{BR, WSP(bf16, WS_WBR + (size_t)l * SZ_WBR), D, 256, 256}; pg8::MergeOrder S; S.init(M, C.G, (int)blockIdx.x);
      EpiMerge E{MERGED, GATES}; pg8::gemm_phase<EpiMerge, pg8::MergeOrder, true, true>(ring, g, S, E); }
    GRID_BAR();
    { pg8::Gemm g{MERGED, WSP(bf16, WS_WOUT + (size_t)l * SZ_WOUT), D, D, D}; pg8::StaticOrder S; S.init(M, D, C.G, (int)blockIdx.x);
      EpiRes<false, 2> E{H, HB, SS + (size_t)(l * 3 + 2) * M * 16, nullptr}; pg8::gemm_phase<EpiRes<false, 2>, pg8::StaticOrder, true, true>(ring, g, S, E); }
    GRID_BAR();
    { pg8::Gemm g{HB, WSP(bf16, WS_W1 + (size_t)(l * 2 + 1) * SZ_W1), D, D, D}; pg8::StaticOrder S; S.init(M, 2 * DFF, C.G, (int)blockIdx.x);
      EpiGLU E{ACT, SS + (size_t)(l * 3 + 2) * M * 16}; pg8::gemm_phase<EpiGLU, pg8::StaticOrder, true, true>(ring, g, S, E); }
    GRID_BAR();
    { pg8::Gemm g{ACT, WSP(bf16, WS_WD + (size_t)(l * 2 + 1) * SZ_WD), DFF, DFF, DFF}; pg8::StaticOrder S; S.init(M, D, C.G, (int)blockIdx.x);
      EpiRes<last, 1> E{H, HB, last ? nullptr : SS + (size_t)((l + 1) * 3) * M * 16, C.out};
      pg8::gemm_phase<EpiRes<last, 1>, pg8::StaticOrder, true, true>(ring, g, S, E); }
#undef GRID_BAR
}

__global__ void __launch_bounds__(NWAVES * 64, 2) fwd(Params P) {
    extern __shared__ __attribute__((aligned(16))) unsigned char lds[];
    Ctx C;
    C.in = P.in; C.out = P.out; C.ws = P.ws; C.lds = (LAS unsigned char*)lds;
    C.G = gridDim.x;
    volatile LAS unsigned* MISC = (volatile LAS unsigned*)(C.lds + MISC_OFF);
    for (int u = threadIdx.x; u < (LDS_BYTES - LDSCTL_OFF) / 4; u += NWAVES * 64) ((LAS unsigned*)(C.lds + LDSCTL_OFF))[u] = 0u;
    __syncthreads();
    unsigned* ctl = (unsigned*)(C.ws + WS_CTL);
    XcdBarrier bar = xcd_barrier_post(ctl + CW_BAR, MISC + 8);
    p0_prologue(C, P);
    xcd_barrier<true>(bar);
    layer_fwd<0>(C, bar);
    xcd_barrier<false>(bar);
    layer_fwd<1>(C, bar);
#if PROBE_ID
    xcd_barrier<false>(bar);
    if (blockIdx.x == 0 && threadIdx.x == 0) { const unsigned long long* ts = (const unsigned long long*)(C.ws + WS_CTL + 65536);
        const int pb = PROBE_ID / 1000, k0 = (PROBE_ID / 10) % 100 % 10, k1 = PROBE_ID % 10;
        float val = (float)(ts[pb * 16 + k1] - ts[pb * 16 + k0]) * 0.001f;
        if (PROBE_ID >= 800000) { const int k = PROBE_ID % 10, mode = (PROBE_ID / 10) % 10; long long best = -1; int arg = 0;
            int cnt = 0;
            for (int bb = 0; bb < 256; ++bb) { const long long d = (long long)(ts[bb * 16 + k] - ts[2]); if (d > best) { best = d; arg = bb; } if (d > 45000) ++cnt; }
            val = mode == 0 ? (float)best * 0.001f : mode == 1 ? (float)arg * 0.1f + 0.5f: (float)cnt * 0.1f + 0.5f; }
        C.out[O_YP] = val; }
#endif
}

extern "C" void kernel_launch(void* const* d_in, const int* in_sizes, int n_in, void* d_out, int out_size, void* d_ws, size_t ws_size, hipStream_t stream) {
    static int grid = 0;
    if (grid == 0) {
        if (n_in != N_INPUTS || (size_t)out_size != O_END || ws_size < WS_END) { fprintf(stderr, "kernel_launch: unexpected shapes: n_in %d out %d (want %zu) ws %zu (want %zu)\n", n_in, out_size, (size_t)O_END, ws_size, (size_t)WS_END); grid = -1; return; }
        int dev = 0, cus = 0, per_cu = 0;
        if (hipGetDevice(&dev) != hipSuccess || hipDeviceGetAttribute(&cus, hipDeviceAttributeMultiprocessorCount, dev) != hipSuccess) { grid = -1; return; }
        if (hipFuncSetAttribute((const void*)fwd, hipFuncAttributeMaxDynamicSharedMemorySize, LDS_BYTES) != hipSuccess) { fprintf(stderr, "kernel_launch: hipFuncSetAttribute failed\n"); grid = -1; return; }
        if (hipOccupancyMaxActiveBlocksPerMultiprocessor(&per_cu, (const void*)fwd, NWAVES * 64, LDS_BYTES) != hipSuccess || per_cu < 1) { fprintf(stderr, "kernel_launch: occupancy query says %d blocks per CU\n", per_cu); }
        (void)hipGetLastError();
        grid = cus;
    }
    if (grid < 0) return;
    if (hipMemsetAsync((char*)d_ws + WS_CTL, 0, CTL_ZERO_BYTES, stream) != hipSuccess) return;
    Params p{};
    for (int i = 0; i < N_INPUTS; ++i) p.in[i] = (const float*)d_in[i];
    p.out = (float*)d_out; p.ws = (unsigned char*)d_ws;
    for (int i = 0; i < 32; ++i) p.inv_freq[i] = (float)pow(10000.0, -(double)i / 32.0);
    hipLaunchKernelGGL(fwd, dim3(grid), dim3(NWAVES * 64), LDS_BYTES, stream, p);
}
```

```cpp
#include <hip/hip_runtime.h>
#include <cstdio>
#include <cstdint>
#include <cmath>

namespace pg8 {
#define PG8_LAS __attribute__((address_space(3)))
typedef unsigned short bf16_t;
typedef short bf16x8 __attribute__((ext_vector_type(8)));
typedef float f32x4 __attribute__((ext_vector_type(4)));
typedef unsigned u32x4 __attribute__((ext_vector_type(4)));
constexpr int BM = 256, BK = 64, HALF = 128, HTB = HALF * BK * 2  , STAGE_BYTES = 8 * HTB, NXCD = 8, WGM = 8;

__host__ __device__ __forceinline__ int lds_byte(int r, int c) { const int st = (r >> 4) * 2 + (c >> 5), rr = r & 15, cc = c & 31, ob = rr * 64 + cc * 2; return st * 1024 + (ob ^ (((ob >> 9) & 1) << 5)); }
__host__ __device__ __forceinline__ void stage_rc(int b, int& R, int& C) { const int st = b / 1024, sb = b % 1024, swz = sb ^ (((sb >> 9) & 1) << 5); R = (st >> 1) * 16 + swz / 64; C = (st & 1) * 32 + (swz % 64) / 2; }
__host__ __device__ __forceinline__ int perm32(int rho) { const int n = rho >> 4, i = rho & 15; return 8 * (i >> 2) + 4 * n + (i & 3); }

struct Unit { int pm, pn, acol; };
struct Gemm { const bf16_t* A; const bf16_t* Bt; int lda, ldb, K; };

struct StaticOrder {
    int nM, nN, nwg, G, c;
    __host__ __device__ void init(int M, int N, int G_, int c_) { nM = M / BM; nN = N / BM; nwg = nM * nN; G = G_; c = c_; }
    __host__ __device__ bool next(int i, Unit& u) const {
        const long L = (long)i * G + c; if (L >= nwg) return false;
        int wgid = (int)L; { const int q = nwg / NXCD, r = nwg % NXCD, xcd = wgid % NXCD, off = wgid / NXCD; wgid = (xcd < r ? xcd * (q + 1) : r * (q + 1) + (xcd - r) * q) + off; }
        const int nig = WGM * nN, gid = wgid / nig, fm = gid * WGM, gsz = (nM - fm) < WGM ? (nM - fm) : WGM;
        u.pm = fm + ((wgid % nig) % gsz); u.pn = (wgid % nig) / gsz; u.acol = 0; return true;
    }
};
struct MergeOrder {
    int ntile, G, c;
    __host__ __device__ void init(int M, int G_, int c_) { ntile = (M / BM) * 4; G = G_; c = c_; }
    __host__ __device__ bool next(int i, Unit& u) const {
        const int T = (i >> 2) * G + c; if (T >= ntile) return false;
        const int n = i & 3; u.pm = T >> 2; u.pn = n * 4 + (T & 3); u.acol = n * 256; return true;
    }
};

__device__ __forceinline__ unsigned cvt_pk_bf16(float lo, float hi) { unsigned r; asm volatile("v_cvt_pk_bf16_f32 %0, %1, %2" : "=v"(r) : "v"(lo), "v"(hi)); return r; }

template <class Epi, class Sched, bool ALIGN_EPI = false, bool SP2 = false>
__device__ __forceinline__ void gemm_phase(PG8_LAS unsigned char* lds, const Gemm g, const Sched& S, const Epi& E) {
    int tid_ = threadIdx.x; asm volatile("" : "+v"(tid_));
    const int tid = tid_, wid = __builtin_amdgcn_readfirstlane(tid >> 6), lane = tid & 63, wr = wid >> 2, wc = wid & 3, fr = lane & 15, fq = lane >> 4;
    const int nt = g.K / BK;
    unsigned voffA[2], voffB[2];
#pragma unroll
    for (int i = 0; i < 2; ++i) { int R, C; stage_rc(tid * 16 + i * 8192, R, C); const int Rb = Epi::PERM ? ((R & ~31) + perm32(R & 31)) : R;
        voffA[i] = (unsigned)(R * g.lda + C) * 2u; voffB[i] = (unsigned)(Rb * g.ldb + C) * 2u; }
    const size_t kstep = (size_t)(BK * 2);
    const size_t hstepA = (size_t)HALF * g.lda * 2, hstepB = (size_t)HALF * g.ldb * 2;
    const size_t tstepA = 2 * hstepA, tstepB = 2 * hstepB;
    const unsigned ldsw = (unsigned)wid * 1024u;
    const int aoff = lds_byte(wr * 64 + fr, fq * 8), boff = lds_byte(wc * 32 + fr, fq * 8);
#define PG8_SA(b, h) (((b) * 2 + (h)) * HTB)
#define PG8_SB(b, h) ((4 + (b) * 2 + (h)) * HTB)
#define PG8_STAGE(bufoff, gbase, voff) do { _Pragma("unroll") for (int _i = 0; _i < 2; ++_i) \
        __builtin_amdgcn_global_load_lds((const unsigned*)((const char*)(gbase) + (voff)[_i]), (PG8_LAS unsigned*)(lds + (bufoff) + ldsw + _i * 8192), 16, 0, 0); } while (0)
#define PG8_LDA(dst, b, h) do { _Pragma("unroll") for (int m = 0; m < 4; ++m) _Pragma("unroll") for (int k = 0; k < 2; ++k) dst[m][k] = *(const PG8_LAS bf16x8*)(lds + PG8_SA(b, h) + aoff + m * 2048 + k * 1024); } while (0)
#define PG8_LDB(dst, b, h) do { _Pragma("unroll") for (int n = 0; n < 2; ++n) _Pragma("unroll") for (int k = 0; k < 2; ++k) dst[n][k] = *(const PG8_LAS bf16x8*)(lds + PG8_SB(b, h) + boff + n * 2048 + k * 1024); } while (0)
#define PG8_MMA(ai, bj, At, Bt) do { __builtin_amdgcn_s_setprio(1); _Pragma("unroll") for (int m = 0; m < 4; ++m) _Pragma("unroll") for (int n = 0; n < 2; ++n) _Pragma("unroll") for (int k = 0; k < 2; ++k) \
        acc[ai][bj][m][n] = __builtin_amdgcn_mfma_f32_16x16x32_bf16(Bt[n][k], At[m][k], acc[ai][bj][m][n], 0, 0, 0); __builtin_amdgcn_s_setprio(0); } while (0)
#define PG8_WAIT_V(n) asm volatile("s_waitcnt vmcnt(" #n ")" ::: "memory")
#define PG8_WAIT_L(n) asm volatile("s_waitcnt lgkmcnt(" #n ")" ::: "memory")
#define PG8_BAR __builtin_amdgcn_s_barrier()
#define PG8_SCHED __builtin_amdgcn_sched_barrier(0)
    Unit cur, nxt; int ui = 0;
    if (!S.next(0, cur)) return;
    f32x4 acc[2][2][4][2];
#pragma unroll
    for (int a = 0; a < 2; ++a)
#pragma unroll
        for (int b = 0; b < 2; ++b)
#pragma unroll
            for (int m = 0; m < 4; ++m)
#pragma unroll
                for (int n = 0; n < 2; ++n) acc[a][b][m][n] = (f32x4){0.f, 0.f, 0.f, 0.f};
    bf16x8 At[4][2], B0[2][2], B1[2][2];
    const char* cA = (const char*)g.A + (size_t)cur.pm * tstepA + (size_t)cur.acol * 2; const char* cB = (const char*)g.Bt + (size_t)cur.pn * tstepB;
    if constexpr (SP2) {
        PG8_STAGE(PG8_SB(0, 0), cB, voffB); PG8_STAGE(PG8_SB(0, 1), cB + hstepB, voffB); PG8_STAGE(PG8_SA(0, 0), cA, voffA); PG8_STAGE(PG8_SA(0, 1), cA + hstepA, voffA);
        if (wr == 1) PG8_BAR;
        PG8_WAIT_V(2); PG8_BAR;
        PG8_STAGE(PG8_SB(1, 0), cB + kstep, voffB); PG8_STAGE(PG8_SA(1, 0), cA + kstep, voffA); PG8_STAGE(PG8_SB(1, 1), cB + hstepB + kstep, voffB);
        PG8_WAIT_V(6); PG8_BAR;
    } else {
        PG8_STAGE(PG8_SB(0, 0), cB, voffB); PG8_STAGE(PG8_SA(0, 0), cA, voffA); PG8_STAGE(PG8_SB(0, 1), cB + hstepB, voffB); PG8_STAGE(PG8_SA(0, 1), cA + hstepA, voffA);
        if (wr == 1) PG8_BAR;
        PG8_WAIT_V(4); PG8_BAR;
        PG8_STAGE(PG8_SB(1, 0), cB + kstep, voffB); PG8_STAGE(PG8_SA(1, 0), cA + kstep, voffA); PG8_STAGE(PG8_SB(1, 1), cB + hstepB + kstep, voffB);
        PG8_WAIT_V(6); PG8_BAR;
    }
    for (;;) {
        const bool has_next = S.next(ui + 1, nxt);
        const char* nA = has_next ? (const char*)g.A + (size_t)nxt.pm * tstepA + (size_t)nxt.acol * 2 : cA; const char* nB = has_next ? (const char*)g.Bt + (size_t)nxt.pn * tstepB : cB;
        for (int t = 0; t < nt; t += 2) {
            const bool last = (t == nt - 2);
            const char* a1 = cA + (size_t)(t + 1) * kstep;
            const char* a2 = last ? nA : cA + (size_t)(t + 2) * kstep; const char* b2 = last ? nB : cB + (size_t)(t + 2) * kstep;
            const char* a3 = a2 + kstep; const char* b3 = b2 + kstep;
            if constexpr (SP2) {
            PG8_LDB(B0, 0, 0); PG8_LDB(B1, 0, 1); PG8_SCHED; PG8_LDA(At, 0, 0); PG8_STAGE(PG8_SA(1, 1), a1 + hstepA, voffA);
            PG8_WAIT_V(8); PG8_WAIT_L(0); PG8_BAR; PG8_MMA(0, 0, At, B0); PG8_MMA(0, 1, At, B1); PG8_BAR; PG8_SCHED;
            PG8_LDA(At, 0, 1); PG8_STAGE(PG8_SB(0, 0), b2, voffB); PG8_STAGE(PG8_SB(0, 1), b2 + hstepB, voffB); PG8_STAGE(PG8_SA(0, 0), a2, voffA);
            PG8_WAIT_V(8); PG8_WAIT_L(0); PG8_BAR; PG8_MMA(1, 0, At, B0); PG8_MMA(1, 1, At, B1); PG8_BAR; PG8_SCHED;
            PG8_LDB(B0, 1, 0); PG8_LDB(B1, 1, 1); PG8_SCHED; PG8_LDA(At, 1, 0); PG8_STAGE(PG8_SA(0, 1), a2 + hstepA, voffA);
            PG8_WAIT_V(8); PG8_WAIT_L(0); PG8_BAR; PG8_MMA(0, 0, At, B0); PG8_MMA(0, 1, At, B1); PG8_BAR; PG8_SCHED;
            PG8_LDA(At, 1, 1); PG8_STAGE(PG8_SB(1, 0), b3, voffB); PG8_STAGE(PG8_SB(1, 1), b3 + hstepB, voffB); PG8_STAGE(PG8_SA(1, 0), a3, voffA);
            PG8_WAIT_V(8); PG8_WAIT_L(0); PG8_BAR; PG8_MMA(1, 0, At, B0); PG8_MMA(1, 1, At, B1); PG8_BAR; PG8_SCHED;
            } else {
            PG8_LDB(B0, 0, 0); PG8_SCHED; PG8_LDA(At, 0, 0); PG8_STAGE(PG8_SA(1, 1), a1 + hstepA, voffA);
            PG8_WAIT_L(8); PG8_BAR; PG8_WAIT_L(0); PG8_MMA(0, 0, At, B0); PG8_BAR; PG8_SCHED;
            PG8_LDB(B1, 0, 1); PG8_STAGE(PG8_SB(0, 0), b2, voffB);
            PG8_BAR; PG8_WAIT_L(0); PG8_MMA(0, 1, At, B1); PG8_BAR;
            PG8_LDA(At, 0, 1); PG8_STAGE(PG8_SA(0, 0), a2, voffA);
            PG8_BAR; PG8_WAIT_L(0); PG8_MMA(1, 0, At, B0); PG8_BAR; PG8_SCHED;
            PG8_STAGE(PG8_SB(0, 1), b2 + hstepB, voffB);
            PG8_WAIT_V(6); PG8_BAR; PG8_MMA(1, 1, At, B1); PG8_BAR;
            PG8_LDB(B0, 1, 0); PG8_SCHED; PG8_LDA(At, 1, 0); PG8_STAGE(PG8_SA(0, 1), a2 + hstepA, voffA);
            PG8_WAIT_L(8); PG8_BAR; PG8_WAIT_L(0); PG8_MMA(0, 0, At, B0); PG8_BAR; PG8_SCHED;
            PG8_LDB(B1, 1, 1); PG8_STAGE(PG8_SB(1, 0), b3, voffB);
            PG8_BAR; PG8_WAIT_L(0); PG8_MMA(0, 1, At, B1); PG8_BAR;
            PG8_LDA(At, 1, 1); PG8_STAGE(PG8_SA(1, 0), a3, voffA);
            PG8_BAR; PG8_WAIT_L(0); PG8_MMA(1, 0, At, B0); PG8_BAR; PG8_SCHED;
            PG8_STAGE(PG8_SB(1, 1), b3 + hstepB, voffB);
            PG8_WAIT_V(6); PG8_BAR; PG8_MMA(1, 1, At, B1); PG8_BAR;
            }
        }
        if constexpr (ALIGN_EPI) { if (wr == 0) PG8_BAR; }
        E(acc, cur, wr, wc, fr, fq);
        if (!has_next) break;
#pragma unroll
        for (int a = 0; a < 2; ++a)
#pragma unroll
            for (int b = 0; b < 2; ++b)
#pragma unroll
                for (int m = 0; m < 4; ++m)
#pragma unroll
                    for (int n = 0; n < 2; ++n) acc[a][b][m][n] = (f32x4){0.f, 0.f, 0.f, 0.f};
        cur = nxt; cA = nA; cB = nB; ++ui;
        if constexpr (ALIGN_EPI) { if (wr == 1) PG8_BAR; }
    }
    PG8_WAIT_V(0);
    if constexpr (!ALIGN_EPI) { if (wr == 0) PG8_BAR; }
    PG8_BAR;
#undef PG8_SA
#undef PG8_SB
#undef PG8_STAGE
#undef PG8_LDA
#undef PG8_LDB
#undef PG8_MMA
#undef PG8_WAIT_V
#undef PG8_WAIT_L
#undef PG8_BAR
#undef PG8_SCHED
}
}

constexpr int NWAVES = 8;
constexpr int D = 1024, DFF = 2816, NIN = 7184, NMIX = 3088, NMIXP = 3328, NGATE = 4096, NINP = NMIXP + NGATE;
constexpr int SEQ = 4096, NMETA = 16, L = SEQ + NMETA, BATCH = 4, DB = 32, DS = 8, PAST = 8192, PAGE = 128, NPAGES = PAST / PAGE, NPOOL = 2560, DEPTH = 2;
constexpr int MP = BATCH * L, MS = DB * DS, MR = MP + MS, M = 16896;
constexpr int NPOS = L + DS;
constexpr float EPS = 1e-6f;
constexpr int C_A = 0, C_G = 256, R_Q = 512, R_K = 768, R_V = 1024, R_G = 1280, G_Q = 1536, G_K = 1664, G_V = 1792, G_R = 2048, G_LOW = 2304, D_Q = 2320, D_K = 2576, D_V = 2832;
constexpr size_t O_YP = 0, O_YS = O_YP + (size_t)BATCH * SEQ * D, O_KP = O_YS + (size_t)MS * D, O_VP = O_KP + (size_t)DEPTH * MP * 256, O_KS = O_VP + (size_t)DEPTH * MP * 256,
                 O_VS = O_KS + (size_t)DEPTH * MS * 256, O_RP = O_VS + (size_t)DEPTH * MS * 256, O_RS = O_RP + (size_t)DEPTH * BATCH * 4 * 64 * 64, O_GP = O_RS + (size_t)DEPTH * DB * 4 * 64 * 64,
                 O_GS = O_GP + (size_t)DEPTH * BATCH * 4 * 32 * 64, O_CP = O_GS + (size_t)DEPTH * DB * 4 * 32 * 64, O_CS = O_CP + (size_t)DEPTH * BATCH * 30 * 256, O_END = O_CS + (size_t)DEPTH * DB * 30 * 256;
enum { I_XP = 0, I_XS, I_CK, I_CV, I_PT, I_SRET, I_SGLA, I_SCONV, I_META, I_RELB, I_NF1, I_F1G, I_F1U, I_F1D, I_NMIX, I_WIN, I_BIN, I_CW, I_CB, I_CLG, I_CLB, I_RGN, I_GAW, I_GAB, I_GGN,
       I_QN, I_KN, I_LQ1, I_LK1, I_LQ2, I_LK2, I_SUBLN, I_WBR, I_WOUT, I_NF2, I_F2G, I_F2U, I_F2D, N_INPUTS };

constexpr size_t MiB = 1u << 20;
constexpr size_t WS_CTL = 0, CTL_ZERO_BYTES = 1 * MiB;
constexpr size_t SZ_SS = (size_t)M * 16 * 4;
constexpr size_t SZ_W1 = (size_t)2 * DFF * D * 2, SZ_WD = (size_t)D * DFF * 2, SZ_WIN = (size_t)NINP * D * 2, SZ_WBR = (size_t)4 * D * 256 * 2, SZ_WOUT = (size_t)D * D * 2;
constexpr size_t WS_W1 = 4 * MiB;
constexpr size_t WS_WD = WS_W1 + 4 * SZ_W1;
constexpr size_t WS_WIN = WS_WD + 4 * SZ_WD;
constexpr size_t WS_WBR = WS_WIN + 2 * SZ_WIN;
constexpr size_t WS_WOUT = WS_WBR + 2 * SZ_WBR;
constexpr size_t WS_BINP = WS_WOUT + 2 * SZ_WOUT;
constexpr size_t WS_ROPE = WS_BINP + 64 * 1024;
constexpr size_t WS_SS = WS_ROPE + 2 * MiB;
constexpr size_t WS_H = 128 * MiB;
constexpr size_t WS_HB = WS_H + (size_t)M * D * 4;
constexpr size_t WS_ACT = WS_HB + (size_t)M * D * 2;
constexpr size_t WS_ZMIX = WS_ACT + (size_t)M * DFF * 2;
constexpr size_t WS_GATES = WS_ZMIX + (size_t)M * NMIXP * 2;
constexpr size_t WS_BR = WS_GATES + (size_t)M * NGATE * 2;
constexpr size_t WS_MERGED = WS_BR + (size_t)M * D * 2;
constexpr size_t WS_UBUF = WS_MERGED + (size_t)M * D * 2;
constexpr size_t WS_RQ = WS_UBUF + (size_t)M * 256 * 4, WS_RK = WS_RQ + (size_t)M * 256 * 4, WS_QN = WS_RK + (size_t)M * 256 * 4, WS_KN = WS_QN + (size_t)M * 256 * 4, WS_VB = WS_KN + (size_t)M * 256 * 4;
constexpr size_t WS_LDEC = WS_VB + (size_t)M * 256 * 4;
constexpr size_t WS_QNB = WS_LDEC + (size_t)M * 128 * 4;
constexpr size_t WS_KNB = WS_QNB + (size_t)M * 256 * 2;
constexpr size_t WS_PART = WS_KNB + (size_t)M * 256 * 2;
constexpr size_t WS_LAO = WS_PART + (size_t)DB * 4 * 16 * 16 * 68 * 4;
constexpr size_t WS_END = WS_LAO + (size_t)M * 512 * 4;
static_assert(WS_ROPE + 2 * NPOS * 32 * 4 <= WS_SS && WS_SS + 6 * SZ_SS <= WS_H, "weights region overflows");
constexpr int CW_BAR = 4096, CW_QUEUE = 8192;

constexpr int RING_OFF = 0, RING_BYTES = 131072;
constexpr int LDSCTL_OFF = 144384, MISC_OFF = LDSCTL_OFF + 320;
constexpr int LDS_BYTES = 147456;
static_assert(MISC_OFF + 128 <= LDS_BYTES, "LDS map");

#define GAS __attribute__((address_space(1)))
#define LAS __attribute__((address_space(3)))
typedef unsigned short bf16;
typedef unsigned v4u __attribute__((ext_vector_type(4)));
typedef float f32x4 __attribute__((ext_vector_type(4)));
#define LDS_WAIT() asm volatile("s_waitcnt lgkmcnt(0)" ::: "memory")
#define VM_WAIT() asm volatile("s_waitcnt vmcnt(0)" ::: "memory")
__device__ __forceinline__ unsigned f2bf(float f) { unsigned u = __builtin_bit_cast(unsigned, f); return (u + 0x7fffu + ((u >> 16) & 1u)) >> 16; }
__device__ __forceinline__ unsigned pk2(float lo, float hi) { return f2bf(lo) | (f2bf(hi) << 16); }
__device__ __forceinline__ float bf2f(bf16 b) { return __builtin_bit_cast(float, ((unsigned)b) << 16); }
__device__ __forceinline__ float bflo(unsigned w) { return __builtin_bit_cast(float, w << 16); }
__device__ __forceinline__ float bfhi(unsigned w) { return __builtin_bit_cast(float, w & 0xffff0000u); }
__device__ __forceinline__ float wave_sum(float v) {
#pragma unroll
    for (int o = 1; o < 64; o <<= 1) v += __shfl_xor(v, o);
    return v;
}
__device__ __forceinline__ float sigmoidf_(float x) { return __builtin_amdgcn_rcpf(1.0f + __expf(-x)); }
__device__ __forceinline__ float siluf_(float x) { return x * __builtin_amdgcn_rcpf(1.0f + __expf(-x)); }

#define XB_TMO      128
#define XB_XCNT(j)  (256  + 64 * (j))
#define XB_XSUB(j)  (1280 + 64 * (j))
#define XB_XGEN(j)  (2304 + 64 * (j))
#define XB_TOP      3328
#define XB_TOPGEN   3392
#define XCD_BAR_WORDS 3456
#define XB_SPIN_CAP (1u << 22)

__device__ __forceinline__ unsigned xb_ld(unsigned* p)              { return __hip_atomic_load(p, __ATOMIC_RELAXED, __HIP_MEMORY_SCOPE_AGENT); }
__device__ __forceinline__ unsigned xb_add(unsigned* p, unsigned v) { return __hip_atomic_fetch_add(p, v, __ATOMIC_RELAXED, __HIP_MEMORY_SCOPE_AGENT); }
__device__ __forceinline__ unsigned xb_xcc_id() { return (unsigned)__builtin_amdgcn_s_getreg((3 << 11) | 20) & 0xFu; }
#define XB_SPIN(cond, bar) do { unsigned _sp = 0; while (cond) { __builtin_amdgcn_s_sleep(1); \
    if ((++_sp & 255u) == 0u) { if (xb_ld(&(bar)[XB_TMO])) break; if (_sp > XB_SPIN_CAP) { atomicAdd(&(bar)[XB_TMO], 1u); break; } } } } while (0)

struct XcdBarrier { unsigned* bar; unsigned x; volatile LAS unsigned* st; };

__device__ __forceinline__ XcdBarrier xcd_barrier_post(unsigned* bar, volatile LAS unsigned* st) {
    XcdBarrier b; b.bar = bar; b.x = xb_xcc_id(); b.st = st;
    if (threadIdx.x == 0) (void)xb_add(&bar[XB_XCNT(b.x)], 1u);
    return b;
}
__device__ __forceinline__ void xcd_barrier_complete(unsigned* bar, unsigned x, unsigned& nloc, unsigned& nx) {
    const unsigned G = gridDim.x * gridDim.y * gridDim.z;
    unsigned sum, cnt, mine, sp = 0u;
    for (;;) {
        sum = 0u; cnt = 0u; mine = 0u;
#pragma unroll
        for (unsigned j = 0; j < 16; ++j) { const unsigned c = xb_ld(&bar[XB_XCNT(j)]); sum += c; cnt += (c > 0u) ? 1u : 0u; mine = (j == x) ? c : mine; }
        if (sum == G) break;
        __builtin_amdgcn_s_sleep(1);
        if ((++sp & 255u) == 0u) { if (xb_ld(&bar[XB_TMO])) break; if (sp > XB_SPIN_CAP) { atomicAdd(&bar[XB_TMO], 1u); break; } }
    }
    nloc = mine > 0u ? mine : 1u; nx = cnt > 0u ? cnt : 1u;
}
template <bool FIRST> __device__ __forceinline__ void xcd_barrier(const XcdBarrier& b) {
    asm volatile("s_waitcnt vmcnt(0)" ::: "memory");
    __syncthreads();
    if (threadIdx.x == 0) {
        unsigned* bar = b.bar;
        asm volatile("" : "+s"(bar));
        __builtin_amdgcn_s_waitcnt(0);
        unsigned nloc = b.st[0], nx = b.st[1];
        if (FIRST) { if (nloc == 0u) { xcd_barrier_complete(bar, b.x, nloc, nx); b.st[0] = nloc; b.st[1] = nx; } }
        const unsigned old = xb_add(&bar[XB_XSUB(b.x)], 1u);
        const unsigned gen = old / nloc;
        if (old + 1u == (gen + 1u) * nloc) {
            __builtin_amdgcn_fence(__ATOMIC_RELEASE, "agent");
            asm volatile("s_waitcnt vmcnt(0)" ::: "memory");
            const unsigned og = xb_add(&bar[XB_TOP], 1u);
            const unsigned tg = og / nx;
            if (og + 1u == (tg + 1u) * nx) xb_add(&bar[XB_TOPGEN], 1u);
            else XB_SPIN(xb_ld(&bar[XB_TOPGEN]) == tg, bar);
            __builtin_amdgcn_fence(__ATOMIC_ACQUIRE, "agent");
            xb_add(&bar[XB_XGEN(b.x)], 1u);
            asm volatile("s_waitcnt vmcnt(0)" ::: "memory");
        } else {
            XB_SPIN(xb_ld(&bar[XB_XGEN(b.x)]) == gen, bar);
            __builtin_amdgcn_fence(__ATOMIC_ACQUIRE, "agent");
            asm volatile("s_waitcnt vmcnt(0)" ::: "memory");
        }
    }
    __syncthreads();
}

struct Params { const float* in[N_INPUTS]; float* out; unsigned char* ws; float inv_freq[32]; };
static_assert(sizeof(Params) == N_INPUTS * 8 + 16 + 128, "Params has no padding");

struct Ctx {
    const float* const* in; float* out; unsigned char* ws;
    LAS unsigned char* lds;
    int G;
};
#define THREAD_IDS() int tid_ = threadIdx.x; asm volatile("" : "+v"(tid_)); const int tid = tid_, lane = tid & 63, wave = __builtin_amdgcn_readfirstlane(tid >> 6), gw = blockIdx.x * NWAVES + wave, NGW = C.G * NWAVES; (void)tid; (void)lane; (void)wave; (void)gw; (void)NGW
#define WSP(T, off) ((T*)(C.ws + (off)))

__device__ __forceinline__ float rstd_of(const float* ssp, int row) {
    const f32x4 a = *(const f32x4*)(ssp + (size_t)row * 16), b = *(const f32x4*)(ssp + (size_t)row * 16 + 4), c = *(const f32x4*)(ssp + (size_t)row * 16 + 8), d = *(const f32x4*)(ssp + (size_t)row * 16 + 12);
    const float s = (((a[0] + a[1]) + (a[2] + a[3])) + ((b[0] + b[1]) + (b[2] + b[3]))) + (((c[0] + c[1]) + (c[2] + c[3])) + ((d[0] + d[1]) + (d[2] + d[3])));
    return rsqrtf(s * (1.0f / D) + EPS);
}
#define EPI_IDS() int t_ = threadIdx.x; asm volatile("" : "+v"(t_)); const int wid_ = __builtin_amdgcn_readfirstlane(t_ >> 6), wr = wid_ >> 2, wc = wid_ & 3, fr = t_ & 15, fq = (t_ & 63) >> 4
struct EpiGLU {
    static constexpr bool PERM = true;
    bf16* act; const float* ss;
    __device__ __forceinline__ void operator()(const pg8::f32x4 (&acc)[2][2][4][2], const pg8::Unit& u, int, int, int, int) const {
        EPI_IDS();
        const int row0 = u.pm * 256 + wr * 64 + fr, col0 = u.pn * 128 + wc * 32 + 8 * fq;
#pragma unroll
        for (int ai = 0; ai < 2; ++ai)
#pragma unroll
            for (int m = 0; m < 4; ++m) {
                const int row = row0 + ai * 128 + m * 16; const float rstd = rstd_of(ss, row);
                float o[8];
#pragma unroll
                for (int n = 0; n < 2; ++n)
#pragma unroll
                    for (int j = 0; j < 4; ++j) { const float g = acc[ai][0][m][n][j] * rstd, up = acc[ai][1][m][n][j] * rstd; o[n * 4 + j] = siluf_(g) * up; }
                v4u w; w.x = pg8::cvt_pk_bf16(o[0], o[1]); w.y = pg8::cvt_pk_bf16(o[2], o[3]); w.z = pg8::cvt_pk_bf16(o[4], o[5]); w.w = pg8::cvt_pk_bf16(o[6], o[7]);
                *(v4u*)(act + (size_t)row * DFF + col0) = w;
            }
    }
};
template <bool FINAL, int SCALE2> struct EpiRes {
    static constexpr bool PERM = true;
    float* h; bf16* hb; float* ssout; float* out;
    __device__ __forceinline__ void operator()(const pg8::f32x4 (&acc)[2][2][4][2], const pg8::Unit& u, int, int, int, int) const {
        EPI_IDS();
        const int row0 = u.pm * 256 + wr * 64 + fr, col0 = u.pn * 256 + wc * 32 + 8 * fq;
#pragma unroll
        for (int ai = 0; ai < 2; ++ai)
#pragma unroll
            for (int m = 0; m < 4; ++m) {
                const int row = row0 + ai * 128 + m * 16; float sq = 0.f;
                constexpr float scale = 0.5f * SCALE2;
                long yoff = -1;
                if (FINAL) { if (row < MP) { const int b = row / L, pos = row - b * L; if (pos >= NMETA) yoff = (long)O_YP + ((long)b * SEQ + (pos - NMETA)) * D; } else if (row < MR) yoff = (long)O_YS + (long)(row - MP) * D; }
#pragma unroll
                for (int bj = 0; bj < 2; ++bj) {
                    const size_t off = (size_t)row * D + col0 + bj * 128;
                    f32x4 h0 = *(const f32x4*)(h + off), h1 = *(const f32x4*)(h + off + 4);
                    h0 = h0 + acc[ai][bj][m][0] * scale; h1 = h1 + acc[ai][bj][m][1] * scale;
                    *(f32x4*)(h + off) = h0; *(f32x4*)(h + off + 4) = h1;
                    v4u w; w.x = pg8::cvt_pk_bf16(h0[0], h0[1]); w.y = pg8::cvt_pk_bf16(h0[2], h0[3]); w.z = pg8::cvt_pk_bf16(h1[0], h1[1]); w.w = pg8::cvt_pk_bf16(h1[2], h1[3]);
                    *(v4u*)(hb + off) = w;
                    sq += (h0[0] * h0[0] + h0[1] * h0[1]) + (h0[2] * h0[2] + h0[3] * h0[3]) + (h1[0] * h1[0] + h1[1] * h1[1]) + (h1[2] * h1[2] + h1[3] * h1[3]);
                    if (FINAL && yoff >= 0) { *(f32x4*)(out + yoff + col0 + bj * 128) = h0; *(f32x4*)(out + yoff + col0 + bj * 128 + 4) = h1; }
                }
                sq += __shfl_xor(sq, 16); sq += __shfl_xor(sq, 32);
                if (fq == 0 && ssout) ssout[(size_t)row * 16 + u.pn * 4 + wc] = sq;
                asm volatile("" ::: "memory");
            }
    }
};
struct EpiZ {
    static constexpr bool PERM = true;
    bf16* zmix; bf16* gates; const float* ss; const float* bias;
    __device__ __forceinline__ void operator()(const pg8::f32x4 (&acc)[2][2][4][2], const pg8::Unit& u, int, int, int, int) const {
        EPI_IDS();
        const int row0 = u.pm * 256 + wr * 64 + fr, col0 = u.pn * 256 + wc * 32 + 8 * fq; const bool isgate = u.pn >= NMIXP / 256;
        f32x4 bv[2][2];
#pragma unroll
        for (int bj = 0; bj < 2; ++bj)
#pragma unroll
            for (int n = 0; n < 2; ++n) bv[bj][n] = *(const f32x4*)(bias + col0 + bj * 128 + 4 * n);
#pragma unroll
        for (int ai = 0; ai < 2; ++ai)
#pragma unroll
            for (int m = 0; m < 4; ++m) {
                const int row = row0 + ai * 128 + m * 16; const float rstd = rstd_of(ss, row);
#pragma unroll
                for (int bj = 0; bj < 2; ++bj) {
                    f32x4 v0 = acc[ai][bj][m][0] * rstd + bv[bj][0], v1 = acc[ai][bj][m][1] * rstd + bv[bj][1];
                    if (isgate) {
#pragma unroll
                        for (int j = 0; j < 4; ++j) { v0[j] = sigmoidf_(v0[j]); v1[j] = sigmoidf_(v1[j]); } }
                    v4u w; w.x = pg8::cvt_pk_bf16(v0[0], v0[1]); w.y = pg8::cvt_pk_bf16(v0[2], v0[3]); w.z = pg8::cvt_pk_bf16(v1[0], v1[1]); w.w = pg8::cvt_pk_bf16(v1[2], v1[3]);
                    if (isgate) *(v4u*)(gates + (size_t)row * NGATE + (col0 - NMIXP) + bj * 128) = w;
                    else *(v4u*)(zmix + (size_t)row * NMIXP + col0 + bj * 128) = w;
                }
            }
    }
};
struct EpiMerge {
    static constexpr bool PERM = true;
    bf16* merged; const bf16* gates;
    __device__ __forceinline__ void operator()(const pg8::f32x4 (&acc)[2][2][4][2], const pg8::Unit& u, int, int, int, int) const {
        EPI_IDS();
        const int n = u.pn >> 2, dt = u.pn & 3;
        const int row0 = u.pm * 256 + wr * 64 + fr, col0 = dt * 256 + wc * 32 + 8 * fq;
#pragma unroll
        for (int ai = 0; ai < 2; ++ai)
#pragma unroll
            for (int m = 0; m < 4; ++m) {
                const int row = row0 + ai * 128 + m * 16;
#pragma unroll
                for (int bj = 0; bj < 2; ++bj) {
                    const v4u gw = *(const v4u*)(gates + (size_t)row * NGATE + n * D + col0 + bj * 128);
                    bf16* mp = merged + (size_t)row * D + col0 + bj * 128;
                    float o[8];
                    o[0] = acc[ai][bj][m][0][0] * bflo(gw.x); o[1] = acc[ai][bj][m][0][1] * bfhi(gw.x); o[2] = acc[ai][bj][m][0][2] * bflo(gw.y); o[3] = acc[ai][bj][m][0][3] * bfhi(gw.y);
                    o[4] = acc[ai][bj][m][1][0] * bflo(gw.z); o[5] = acc[ai][bj][m][1][1] * bfhi(gw.z); o[6] = acc[ai][bj][m][1][2] * bflo(gw.w); o[7] = acc[ai][bj][m][1][3] * bfhi(gw.w);
                    if (n > 0) { const v4u pw = *(const v4u*)mp;
                        o[0] += bflo(pw.x); o[1] += bfhi(pw.x); o[2] += bflo(pw.y); o[3] += bfhi(pw.y); o[4] += bflo(pw.z); o[5] += bfhi(pw.z); o[6] += bflo(pw.w); o[7] += bfhi(pw.w); }
                    v4u w; w.x = pg8::cvt_pk_bf16(o[0], o[1]); w.y = pg8::cvt_pk_bf16(o[2], o[3]); w.z = pg8::cvt_pk_bf16(o[4], o[5]); w.w = pg8::cvt_pk_bf16(o[6], o[7]);
                    *(v4u*)mp = w;
                }
                asm volatile("" ::: "memory");
            }
    }
};

struct RowMap { int mode, a; __device__ __forceinline__ int operator()(int n) const { return mode == 0 ? n + a : (mode == 1 ? 256 * (n >> 7) + (n & 127) + a : (n < NMIX ? n : n + (NMIXP - NMIX))); } };
__device__ __forceinline__ void tr_item(const float* W, int K, int N, const float* gain, bf16* WT, int pitch, RowMap rm, LAS float* scr, int kb, int nb, int lane) {
    const int k0 = 64 * kb, n0 = 64 * nb; const int nn = n0 + 4 * (lane & 15), kr = lane >> 4;
    f32x4 v[16];
#pragma unroll
    for (int i = 0; i < 16; ++i) v[i] = (nn < N) ? *(const f32x4*)(W + (size_t)(k0 + 4 * i + kr) * N + nn) : (f32x4){0.f, 0.f, 0.f, 0.f};
#pragma unroll
    for (int i = 0; i < 16; ++i) { const int kk = 4 * i + kr; const float g = gain ? gain[k0 + kk] : 1.0f; LAS float* d = scr + kk * 65 + 4 * (lane & 15); d[0] = v[i][0] * g; d[1] = v[i][1] * g; d[2] = v[i][2] * g; d[3] = v[i][3] * g; }
    LDS_WAIT(); asm volatile("" ::: "memory");
    const int c = lane & 7;
#pragma unroll
    for (int j = 0; j < 8; ++j) { const int nl = (lane >> 3) + 8 * j; const int n = n0 + nl; const LAS float* s = scr + (8 * c) * 65 + nl;
        v4u o; o.x = pg8::cvt_pk_bf16(s[0 * 65], s[1 * 65]); o.y = pg8::cvt_pk_bf16(s[2 * 65], s[3 * 65]); o.z = pg8::cvt_pk_bf16(s[4 * 65], s[5 * 65]); o.w = pg8::cvt_pk_bf16(s[6 * 65], s[7 * 65]);
        if (n < N) *(v4u*)(WT + (size_t)rm(n) * pitch + k0 + 8 * c) = o; }
    LDS_WAIT(); asm volatile("" ::: "memory");
}
__device__ __forceinline__ void p0_prologue(const Ctx& C, const Params& P) {
    THREAD_IDS();
    LAS float* scr = (LAS float*)(C.lds + RING_OFF + wave * 16896);
    constexpr int I_FF = 16 * 44, I_DN = 44 * 16, I_IN = 16 * 113, I_BR = 4 * 4 * 16, I_OUT = 16 * 16;
    constexpr int PER_LAYER = 4 * I_FF + 2 * I_DN + I_IN + I_BR + I_OUT;
    for (int it = gw; it < DEPTH * PER_LAYER; it += NGW) {
        const int l = it / PER_LAYER; int r = it - l * PER_LAYER;
        bf16* W1a = WSP(bf16, WS_W1 + (size_t)(l * 2 + 0) * SZ_W1); bf16* W1b = WSP(bf16, WS_W1 + (size_t)(l * 2 + 1) * SZ_W1);
        bf16* Wda = WSP(bf16, WS_WD + (size_t)(l * 2 + 0) * SZ_WD); bf16* Wdb = WSP(bf16, WS_WD + (size_t)(l * 2 + 1) * SZ_WD);
        if (r < I_FF) { tr_item(C.in[I_F1G] + (size_t)l * D * DFF, D, DFF, C.in[I_NF1] + l * D, W1a, D, RowMap{1, 0}, scr, r / 44, r % 44, lane); continue; } r -= I_FF;
        if (r < I_FF) { tr_item(C.in[I_F1U] + (size_t)l * D * DFF, D, DFF, C.in[I_NF1] + l * D, W1a, D, RowMap{1, 128}, scr, r / 44, r % 44, lane); continue; } r -= I_FF;
        if (r < I_DN) { tr_item(C.in[I_F1D] + (size_t)l * D * DFF, DFF, D, nullptr, Wda, DFF, RowMap{0, 0}, scr, r / 16, r % 16, lane); continue; } r -= I_DN;
        if (r < I_FF) { tr_item(C.in[I_F2G] + (size_t)l * D * DFF, D, DFF, C.in[I_NF2] + l * D, W1b, D, RowMap{1, 0}, scr, r / 44, r % 44, lane); continue; } r -= I_FF;
        if (r < I_FF) { tr_item(C.in[I_F2U] + (size_t)l * D * DFF, D, DFF, C.in[I_NF2] + l * D, W1b, D, RowMap{1, 128}, scr, r / 44, r % 44, lane); continue; } r -= I_FF;
        if (r < I_DN) { tr_item(C.in[I_F2D] + (size_t)l * D * DFF, DFF, D, nullptr, Wdb, DFF, RowMap{0, 0}, scr, r / 16, r % 16, lane); continue; } r -= I_DN;
        if (r < I_IN) { tr_item(C.in[I_WIN] + (size_t)l * D * NIN, D, NIN, C.in[I_NMIX] + l * D, WSP(bf16, WS_WIN + (size_t)l * SZ_WIN), D, RowMap{2, 0}, scr, r / 113, r % 113, lane); continue; } r -= I_IN;
        if (r < I_BR) { const int n4 = r / 64, rr = r % 64; tr_item(C.in[I_WBR] + (size_t)(l * 4 + n4) * 256 * D, 256, D, nullptr, WSP(bf16, WS_WBR + (size_t)l * SZ_WBR), 256, RowMap{0, n4 * D}, scr, rr / 16, rr % 16, lane); continue; } r -= I_BR;
        tr_item(C.in[I_WOUT] + (size_t)l * D * D, D, D, nullptr, WSP(bf16, WS_WOUT + (size_t)l * SZ_WOUT), D, RowMap{0, 0}, scr, r / 16, r % 16, lane);
    }
    const int gt = gw * 64 + lane, NGT = NGW * 64;
    for (int i = gt; i < 2 * 240 * 128; i += NGT) { const int l = i / (240 * 128), r = i % (240 * 128); *(v4u*)(C.ws + WS_WIN + (size_t)l * SZ_WIN + ((size_t)NMIX * D) * 2 + (size_t)r * 16) = (v4u){0u, 0u, 0u, 0u}; }
    for (int i = gt; i < (M - MR) * 128; i += NGT) *(v4u*)(C.ws + WS_BR + (size_t)MR * D * 2 + (size_t)i * 16) = (v4u){0u, 0u, 0u, 0u};
    for (int i = gt; i < 2 * NINP; i += NGT) { const int l = i / NINP, j = i % NINP; float v = 0.f; if (j < NMIX) v = C.in[I_BIN][l * NIN + j]; else if (j >= NMIXP) v = C.in[I_BIN][l * NIN + NMIX + (j - NMIXP)]; WSP(float, WS_BINP)[i] = v; }
    for (int i = gt; i < NPOS * 32; i += NGT) { const int pi = i >> 5, fi = i & 31; const int pos = pi < L ? pi : PAST + (pi - L);
        const float angf = (float)pos * P.inv_freq[fi];
        const double a = (double)angf; const double k = rint(a * 0.15915494309189535); const double rr = (a - k * 6.283185307179586) - k * 2.4492935982947064e-16;
        const float rf = (float)rr; WSP(float, WS_ROPE)[i] = cosf(rf); WSP(float, WS_ROPE)[NPOS * 32 + i] = sinf(rf); }
    float* H = WSP(float, WS_H); bf16* HB = WSP(bf16, WS_HB); float* SS0 = WSP(float, WS_SS);
    for (int row = gw; row < M; row += NGW) {
        const float* src = nullptr;
        if (row < MP) { const int b = row / L, pos = row - b * L; src = pos < NMETA ? C.in[I_META] + (size_t)pos * D : C.in[I_XP] + ((size_t)b * SEQ + (pos - NMETA)) * D; }
        else if (row < MR) src = C.in[I_XS] + (size_t)(row - MP) * D;
        float s = 0.f;
#pragma unroll
        for (int j = 0; j < 4; ++j) { f32x4 v = src ? *(const f32x4*)(src + 256 * j + 4 * lane) : (f32x4){0.f, 0.f, 0.f, 0.f};
            *(f32x4*)(H + (size_t)row * D + 256 * j + 4 * lane) = v; s += (v[0] * v[0] + v[1] * v[1]) + (v[2] * v[2] + v[3] * v[3]);
            unsigned long long w = (unsigned long long)pk2(v[0], v[1]) | ((unsigned long long)pk2(v[2], v[3]) << 32);
            *(unsigned long long*)(HB + (size_t)row * D + 256 * j + 4 * lane) = w; }
        s = wave_sum(s); if (lane < 16) SS0[(size_t)row * 16 + lane] = lane == 0 ? s : 0.f;
    }
}

__device__ __forceinline__ float lam_of(const Ctx& C, int l, float lam_init) {
    THREAD_IDS();
    float a = 0.f, b = 0.f;
    for (int i = 0; i < 32; ++i) { a += C.in[I_LQ1][l * 32 + i] * C.in[I_LK1][l * 32 + i]; b += C.in[I_LQ2][l * 32 + i] * C.in[I_LK2][l * 32 + i]; }
    return __expf(a) - __expf(b) + lam_init;
}
__device__ __forceinline__ int t5_bucket(int n) {
    if (n < 16) return n;
    return 16 + (n >= 19) + (n >= 21) + (n >= 24) + (n >= 27) + (n >= 31) + (n >= 35) + (n >= 40) + (n >= 46) + (n >= 52) + (n >= 59) + (n >= 67) + (n >= 77) + (n >= 87) + (n >= 99) + (n >= 113);
}
__device__ __forceinline__ void unpack8(const v4u w, float (&x)[8]) { x[0] = bflo(w.x); x[1] = bfhi(w.x); x[2] = bflo(w.y); x[3] = bfhi(w.y); x[4] = bflo(w.z); x[5] = bfhi(w.z); x[6] = bflo(w.w); x[7] = bfhi(w.w); }
__device__ __forceinline__ v4u pack8(const float (&x)[8]) { v4u w; w.x = pg8::cvt_pk_bf16(x[0], x[1]); w.y = pg8::cvt_pk_bf16(x[2], x[3]); w.z = pg8::cvt_pk_bf16(x[4], x[5]); w.w = pg8::cvt_pk_bf16(x[6], x[7]); return w; }
__device__ __forceinline__ void n1_prep(const Ctx& C, int l) {
    THREAD_IDS();
    const bf16* ZM = WSP(bf16, WS_ZMIX); float* UB = WSP(float, WS_UBUF); float* RQ = WSP(float, WS_RQ); float* RK = WSP(float, WS_RK);
    float* LD = WSP(float, WS_LDEC); const float* COS = WSP(float, WS_ROPE); const float* SIN = COS + NPOS * 32; bf16* QNB = WSP(bf16, WS_QNB); bf16* KNB = WSP(bf16, WS_KNB);
    const int i = lane & 31;
    float qg[8], kg[8];
#pragma unroll
    for (int j = 0; j < 8; ++j) { qg[j] = C.in[I_QN][l * 32 + ((8 * i) & 31) + j] * (0.17677669529663687f * 1.4426950408889634f); kg[j] = C.in[I_KN][l * 32 + ((8 * i) & 31) + j]; }
    for (int rp = gw; rp < MR / 2; rp += NGW) {
        const int r = 2 * rp + (lane >> 5);
        const bf16* z = ZM + (size_t)r * NMIXP;
        const int pi = r < MP ? r % L : L + ((r - MP) & 7);
        float* kout = r < MP ? C.out + O_KP + ((size_t)l * MP + r) * 256 : C.out + O_KS + ((size_t)l * MS + (r - MP)) * 256;
        float* vout = r < MP ? C.out + O_VP + ((size_t)l * MP + r) * 256 : C.out + O_VS + ((size_t)l * MS + (r - MP)) * 256;
        const v4u wa = *(const v4u*)(z + C_A + 8 * i), wg = *(const v4u*)(z + C_G + 8 * i), wq = *(const v4u*)(z + D_Q + 8 * i), wk = *(const v4u*)(z + D_K + 8 * i), wv = *(const v4u*)(z + D_V + 8 * i);
        const int isk = i >> 4, hh = (i >> 2) & 3, jc = i & 3;
        const bf16* zr = z + (isk ? R_K : R_Q) + hh * 64 + 8 * jc;
        const v4u w1 = *(const v4u*)zr, w2 = *(const v4u*)(zr + 32);
        const v4u gl0 = *(const v4u*)(z + G_LOW), gl1 = *(const v4u*)(z + G_LOW + 8);
        float x[8], y[8];
        unpack8(wa, x); unpack8(wg, y);
#pragma unroll
        for (int j = 0; j < 8; ++j) x[j] *= sigmoidf_(y[j]);
        *(f32x4*)(UB + (size_t)r * 256 + 8 * i) = (f32x4){x[0], x[1], x[2], x[3]}; *(f32x4*)(UB + (size_t)r * 256 + 8 * i + 4) = (f32x4){x[4], x[5], x[6], x[7]};
        unpack8(wv, x);
        *(f32x4*)(vout + 8 * i) = (f32x4){x[0], x[1], x[2], x[3]}; *(f32x4*)(vout + 8 * i + 4) = (f32x4){x[4], x[5], x[6], x[7]};
        unpack8(wq, x);
        { float s = 0.f;
#pragma unroll
          for (int j = 0; j < 8; ++j) s += x[j] * x[j];
          s += __shfl_xor(s, 1); s += __shfl_xor(s, 2); const float rs = rsqrtf(s * (1.0f / 32) + EPS);
#pragma unroll
          for (int j = 0; j < 8; ++j) x[j] = x[j] * rs * qg[j];
          *(v4u*)(QNB + (size_t)r * 256 + 8 * i) = pack8(x); }
        unpack8(wk, x);
        { float s = 0.f;
#pragma unroll
          for (int j = 0; j < 8; ++j) s += x[j] * x[j];
          s += __shfl_xor(s, 1); s += __shfl_xor(s, 2); const float rs = rsqrtf(s * (1.0f / 32) + EPS);
#pragma unroll
          for (int j = 0; j < 8; ++j) x[j] = x[j] * rs * kg[j];
          *(v4u*)(KNB + (size_t)r * 256 + 8 * i) = pack8(x);
          *(f32x4*)(kout + 8 * i) = (f32x4){x[0], x[1], x[2], x[3]}; *(f32x4*)(kout + 8 * i + 4) = (f32x4){x[4], x[5], x[6], x[7]}; }
        unpack8(w1, x); unpack8(w2, y);
        { const f32x4 c0 = *(const f32x4*)(COS + pi * 32 + 8 * jc), c1 = *(const f32x4*)(COS + pi * 32 + 8 * jc + 4), s0 = *(const f32x4*)(SIN + pi * 32 + 8 * jc), s1 = *(const f32x4*)(SIN + pi * 32 + 8 * jc + 4);
          const float sc = isk ? 0.125f : 1.0f; float o1[8], o2[8];
#pragma unroll
          for (int j = 0; j < 8; ++j) { const float cs = j < 4 ? c0[j & 3] : c1[j & 3], sn = j < 4 ? s0[j & 3] : s1[j & 3]; o1[j] = (x[j] * cs - y[j] * sn) * sc; o2[j] = (x[j] * sn + y[j] * cs) * sc; }
          float* ro = (isk ? RK : RQ) + (size_t)r * 256 + hh * 64 + 8 * jc;
          *(f32x4*)ro = (f32x4){o1[0], o1[1], o1[2], o1[3]}; *(f32x4*)(ro + 4) = (f32x4){o1[4], o1[5], o1[6], o1[7]}; *(f32x4*)(ro + 32) = (f32x4){o2[0], o2[1], o2[2], o2[3]}; *(f32x4*)(ro + 36) = (f32x4){o2[4], o2[5], o2[6], o2[7]}; }
        { float gv[16]; unpack8(gl0, x); unpack8(gl1, y);
#pragma unroll
          for (int j = 0; j < 8; ++j) { gv[j] = x[j]; gv[8 + j] = y[j]; }
          f32x4 gp = *(const f32x4*)(C.in[I_GAB] + l * 128 + 4 * i);
#pragma unroll
          for (int k = 0; k < 16; ++k) { const f32x4 aw = *(const f32x4*)(C.in[I_GAW] + (size_t)(l * 16 + k) * 128 + 4 * i); gp = gp + aw * gv[k]; }
          f32x4 ls;
#pragma unroll
          for (int j = 0; j < 4; ++j) ls[j] = (fminf(gp[j], 0.f) - log1pf(__expf(-fabsf(gp[j])))) * (1.0f / 16.0f);
          *(f32x4*)(LD + (size_t)r * 128 + 4 * i) = ls; }
    }
}
__device__ __forceinline__ void conv_rows_item(const Ctx& C, int l, int item) {
    THREAD_IDS();
    const float* UB = WSP(float, WS_UBUF); bf16* BR = WSP(bf16, WS_BR);
    const float* cw = C.in[I_CW] + (size_t)l * 31 * 256; const float* sc = C.in[I_SCONV];
    LAS float* wl = (LAS float*)C.lds;
    for (int i = tid; i < 31 * 256; i += NWAVES * 64) wl[i] = cw[i];
    LDS_WAIT(); __builtin_amdgcn_s_barrier(); asm volatile("" ::: "memory");
    for (int rr = wave; rr < 64; rr += NWAVES) {
        const int r = item * 64 + rr; if (r >= MR) break;
        const bool smp = r >= MP; const int b = smp ? (r - MP) >> 3 : r / L; const int p = smp ? (r - MP) & 7 : r - b * L; const int rb = smp ? MP + b * 8 : b * L;
        float cv[4];
#pragma unroll
        for (int k = 0; k < 4; ++k) cv[k] = C.in[I_CB][l * 256 + lane + 64 * k];
#pragma unroll 1
        for (int jh = 0; jh < 32; jh += 8) {
            float uv[8][4];
            const float* up = UB + (size_t)(rb + p + jh - 30) * 256 + lane; const float* sp = sc + (((size_t)l * DB + b) * 30 + (p + jh)) * 256 + lane;
#pragma unroll
            for (int jj = 0; jj < 8; ++jj) { const int j = jh + jj; const int q = p + j - 30;
#pragma unroll
                for (int k = 0; k < 4; ++k) uv[jj][k] = j >= 31 ? 0.f : (q >= 0 ? up[jj * 256 + 64 * k] : (smp ? sp[jj * 256 + 64 * k] : 0.f)); }
            const LAS float* wp = wl + jh * 256 + lane;
#pragma unroll
            for (int jj = 0; jj < 8; ++jj) { if (jh + jj < 31) {
#pragma unroll
                    for (int k = 0; k < 4; ++k) cv[k] += wp[jj * 256 + 64 * k] * uv[jj][k]; } }
        }
        float s = (cv[0] + cv[1]) + (cv[2] + cv[3]); const float mean = wave_sum(s) * (1.0f / 256);
        float q2 = 0.f;
#pragma unroll
        for (int k = 0; k < 4; ++k) { cv[k] -= mean; q2 += cv[k] * cv[k]; }
        const float rstd = rsqrtf(wave_sum(q2) * (1.0f / 256) + EPS);
#pragma unroll
        for (int k = 0; k < 4; ++k) { const int c = lane + 64 * k; const float y = cv[k] * rstd * C.in[I_CLG][l * 256 + c] + C.in[I_CLB][l * 256 + c]; BR[(size_t)r * D + c] = (bf16)f2bf(siluf_(y)); }
    }
    LDS_WAIT(); __builtin_amdgcn_s_barrier(); asm volatile("" ::: "memory");
}
__device__ __forceinline__ void conv_state_item(const Ctx& C, int l, int part, int nparts) {
    THREAD_IDS();
    const float* UB = WSP(float, WS_UBUF); const float* sc = C.in[I_SCONV];
    for (int i = part * NWAVES * 64 + tid; i < BATCH * 30 * 256; i += nparts * NWAVES * 64) { const int c = i & 255, ii = (i >> 8) % 30, b = i / (30 * 256); C.out[O_CP + (size_t)l * BATCH * 30 * 256 + i] = UB[(size_t)(b * L + L - 30 + ii) * 256 + c]; }
    for (int i = part * NWAVES * 64 + tid; i < DB * 30 * 256; i += nparts * NWAVES * 64) { const int c = i & 255, ii = (i >> 8) % 30, b = i / (30 * 256);
        C.out[O_CS + (size_t)l * DB * 30 * 256 + i] = ii < 22 ? sc[(((size_t)l * DB + b) * 30 + 8 + ii) * 256 + c] : UB[(size_t)(MP + b * 8 + ii - 22) * 256 + c]; }
}
template <int DK, bool RET> __device__ __forceinline__ void la_seq(const Ctx& C, int l, bool smp, int b, int h) {
    THREAD_IDS();
    const bf16* ZM = WSP(bf16, WS_ZMIX); const float* RQ = WSP(float, WS_RQ); const float* RK = WSP(float, WS_RK); const float* LD = WSP(float, WS_LDEC); bf16* BR = WSP(bf16, WS_BR);
    const int nt = smp ? DS : L; const int row0 = smp ? MP + b * DS : b * L;
    float S[DK];
    if (smp) { const float* s0 = (RET ? C.in[I_SRET] : C.in[I_SGLA]) + (((size_t)l * DB + b) * 4 + h) * DK * 64;
#pragma unroll
        for (int k = 0; k < DK; ++k) S[k] = s0[k * 64 + lane]; }
    else {
#pragma unroll
        for (int k = 0; k < DK; ++k) S[k] = 0.f; }
    const float gamma = 1.0f - exp2f(-5.0f - (float)h);
    const float gn = RET ? C.in[I_RGN][(l * 4 + h) * 64 + lane] : C.in[I_GGN][(l * 4 + h) * 64 + lane];
    for (int t = 0; t < nt; ++t) {
        const int r = row0 + t; const bf16* z = ZM + (size_t)r * NMIXP;
        float ql, kl, dl = 1.f;
        if (RET) { ql = RQ[(size_t)r * 256 + h * 64 + lane]; kl = RK[(size_t)r * 256 + h * 64 + lane]; }
        else { const int lk = lane & 31; ql = bf2f(z[G_Q + h * 32 + lk]) * 0.17677669529663687f; kl = bf2f(z[G_K + h * 32 + lk]); dl = __expf(LD[(size_t)r * 128 + h * 32 + lk]); }
        const float v = bf2f(z[(RET ? R_V : G_V) + h * 64 + lane]);
        float o = 0.f;
#pragma unroll
        for (int k = 0; k < DK; ++k) { const float qk = __shfl(ql, k), kk = __shfl(kl, k); const float dk = RET ? gamma : __shfl(dl, k);
            S[k] = dk * S[k] + kk * v; o += qk * S[k]; if ((k & 7) == 7) __builtin_amdgcn_sched_barrier(0); }
        float y;
        if (RET) { const float mean = wave_sum(o) * (1.0f / 64); const float d = o - mean; const float var = wave_sum(d * d) * (1.0f / 64); y = d * rsqrtf(var + EPS) * gn; }
        else { const float ms = wave_sum(o * o) * (1.0f / 64); y = o * rsqrtf(ms + EPS) * gn; }
        const float g = bf2f(z[(RET ? R_G : G_R) + h * 64 + lane]);
        BR[(size_t)r * D + (RET ? 256 : 512) + h * 64 + lane] = (bf16)f2bf(siluf_(g) * y);
    }
    float* so = C.out + (RET ? (smp ? O_RS + (((size_t)l * DB + b) * 4 + h) * DK * 64 : O_RP + (((size_t)l * BATCH + b) * 4 + h) * DK * 64)
                             : (smp ? O_GS + (((size_t)l * DB + b) * 4 + h) * DK * 64 : O_GP + (((size_t)l * BATCH + b) * 4 + h) * DK * 64));
#pragma unroll
    for (int k = 0; k < DK; ++k) so[k * 64 + lane] = S[k];
}
__device__ __forceinline__ void n2_la(const Ctx& C, int l) {
    THREAD_IDS();
    if ((gw & 63) == 0 && (gw >> 6) < 32) { const int it = gw >> 6; const int b = (it >> 2) & 3, h = it & 3;
        if (it < 16) la_seq<64, true>(C, l, false, b, h); else la_seq<32, false>(C, l, false, b, h); }
    for (int it = gw; it < 256; it += NGW) { const int typ = it >> 7, b = (it >> 2) & 31, h = it & 3;
        if (typ == 0) la_seq<64, true>(C, l, true, b, h); else la_seq<32, false>(C, l, true, b, h); }
}
__device__ __forceinline__ void n2_attn_prompt(const Ctx& C, int l, float lam_init) {
    THREAD_IDS();
    const float* QN = WSP(float, WS_QN); const float* KN = WSP(float, WS_KN); const float* VB = WSP(float, WS_VB); bf16* BR = WSP(bf16, WS_BR);
    const float lam = lam_of(C, l, lam_init);
    LAS float* park = (LAS float*)(C.lds) + wave * (64 * 65);
    constexpr int NQG = (L + 63) / 64;
    for (int it = gw; it < BATCH * 4 * NQG; it += NGW) {
        const int qg = NQG - 1 - it / 16, bh = it % 16, b = bh >> 2, h = bh & 3;
        const int qpos = min(qg * 64 + lane, L - 1); const bool valid = (qg * 64 + lane) < L; const int qrow = b * L + qpos;
        const int nkeys = min(qg * 64 + 64, L);
        float bias_near[1]; (void)bias_near;
        for (int s = 0; s < 2; ++s) {
            float q[32];
#pragma unroll
            for (int i = 0; i < 32; i += 4) { const f32x4 t = *(const f32x4*)(QN + (size_t)qrow * 256 + h * 64 + s * 32 + i); q[i] = t[0] * 0.17677669529663687f; q[i + 1] = t[1] * 0.17677669529663687f; q[i + 2] = t[2] * 0.17677669529663687f; q[i + 3] = t[3] * 0.17677669529663687f; }
            float m = -INFINITY, lsum = 0.f; float acc[64];
#pragma unroll
            for (int i = 0; i < 64; ++i) acc[i] = 0.f;
            for (int j = 0; j < nkeys; ++j) {
                const float* kp = KN + (size_t)(b * L + j) * 256 + h * 64 + s * 32; const float* vp = VB + (size_t)(b * L + j) * 256 + h * 64;
                float sc = 0.f;
#pragma unroll
                for (int i = 0; i < 32; i += 4) { const f32x4 kv = *(const f32x4*)(kp + i); sc += q[i] * kv[0] + q[i + 1] * kv[1] + q[i + 2] * kv[2] + q[i + 3] * kv[3]; }
                const int n = qpos - j;
                sc += C.in[I_RELB][t5_bucket(n < 0 ? 0 : n) * 4 + h];
                if (n < 0) sc = -INFINITY;
                const float mn = fmaxf(m, sc); const float corr = __expf(m - mn); const float p = __expf(sc - mn);
                m = mn; lsum = lsum * corr + p;
#pragma unroll
                for (int i = 0; i < 64; i += 4) { const f32x4 vv = *(const f32x4*)(vp + i); acc[i] = acc[i] * corr + p * vv[0]; acc[i + 1] = acc[i + 1] * corr + p * vv[1]; acc[i + 2] = acc[i + 2] * corr + p * vv[2]; acc[i + 3] = acc[i + 3] * corr + p * vv[3]; }
            }
            const float inv = 1.0f / lsum;
            if (s == 0) {
#pragma unroll
                for (int i = 0; i < 64; ++i) park[lane * 65 + i] = acc[i] * inv;
                LDS_WAIT();
            } else {
                float ms = 0.f;
#pragma unroll
                for (int i = 0; i < 64; ++i) { acc[i] = park[lane * 65 + i] - lam * (acc[i] * inv); ms += acc[i] * acc[i]; }
                const float rn = rsqrtf(ms * (1.0f / 64) + EPS) * (1.0f - lam_init);
                if (valid) {
#pragma unroll
                    for (int i = 0; i < 64; i += 2) { const unsigned w = pk2(acc[i] * rn * C.in[I_SUBLN][l * 64 + i], acc[i + 1] * rn * C.in[I_SUBLN][l * 64 + i + 1]); *(unsigned*)(BR + (size_t)qrow * D + 768 + h * 64 + i) = w; } }
                LDS_WAIT();
            }
        }
    }
}
__device__ __forceinline__ void n2_attn_sample(const Ctx& C, int l, float lam_init) {
    THREAD_IDS();
    const float* QN = WSP(float, WS_QN); const float* KN = WSP(float, WS_KN); const float* VB = WSP(float, WS_VB); bf16* BR = WSP(bf16, WS_BR);
    const int* PT = (const int*)C.in[I_PT]; const float* CK = C.in[I_CK] + (size_t)l * NPOOL * PAGE * 256; const float* CV = C.in[I_CV] + (size_t)l * NPOOL * PAGE * 256;
    const float lam = lam_of(C, l, lam_init);
    LAS float* part = (LAS float*)C.lds;
    for (int b = blockIdx.x; b < DB; b += C.G) {
        const int row = tid & 63, split = tid >> 6, h = row >> 4, s = (row >> 3) & 1, t = row & 7;
        float q[32];
#pragma unroll
        for (int i = 0; i < 32; ++i) q[i] = QN[(size_t)(MP + b * 8 + t) * 256 + h * 64 + s * 32 + i] * 0.17677669529663687f;
        float m = -INFINITY, lsum = 0.f; float acc[64];
#pragma unroll
        for (int i = 0; i < 64; ++i) acc[i] = 0.f;
        for (int j = split; j < PAST + DS; j += 8) {
            const float* kp; const float* vp; bool vis = true;
            if (j < PAST) { const int page = PT[b * NPAGES + (j >> 7)]; const size_t base = (((size_t)page * PAGE + (j & 127)) * 4 + h) * 64; kp = CK + base + s * 32; vp = CV + base; }
            else { const int jj = j - PAST; const size_t r2 = (size_t)(MP + b * 8 + jj); kp = KN + r2 * 256 + h * 64 + s * 32; vp = VB + r2 * 256 + h * 64; vis = jj <= t; }
            float sc = 0.f;
#pragma unroll
            for (int i = 0; i < 32; i += 4) { const f32x4 kv = *(const f32x4*)(kp + i); sc += q[i] * kv[0] + q[i + 1] * kv[1] + q[i + 2] * kv[2] + q[i + 3] * kv[3]; }
            const int n = PAST + t - j;
            sc += C.in[I_RELB][t5_bucket(n < 0 ? 0 : n) * 4 + h];
            if (!vis) sc = -INFINITY;
            const float mn = fmaxf(m, sc); const float corr = __expf(m - mn); const float p = __expf(sc - mn);
            m = mn; lsum = lsum * corr + p;
#pragma unroll
            for (int i = 0; i < 64; i += 4) { const f32x4 vv = *(const f32x4*)(vp + i); acc[i] = acc[i] * corr + p * vv[0]; acc[i + 1] = acc[i + 1] * corr + p * vv[1]; acc[i + 2] = acc[i + 2] * corr + p * vv[2]; acc[i + 3] = acc[i + 3] * corr + p * vv[3]; }
        }
        LAS float* pr = part + (split * 64 + row) * 66;
        pr[64] = m; pr[65] = lsum;
#pragma unroll
        for (int i = 0; i < 64; ++i) pr[i] = acc[i];
        __syncthreads();
        for (int k = 0; k < 4; ++k) { const int p = wave * 4 + k, h2 = p >> 3, t2 = p & 7; float os[2];
#pragma unroll
            for (int s2 = 0; s2 < 2; ++s2) { const int rw = h2 * 16 + s2 * 8 + t2; float mm = -INFINITY;
                for (int sp = 0; sp < 8; ++sp) mm = fmaxf(mm, part[(sp * 64 + rw) * 66 + 64]);
                float ll = 0.f, oo = 0.f;
                for (int sp = 0; sp < 8; ++sp) { const float w = __expf(part[(sp * 64 + rw) * 66 + 64] - mm); ll += part[(sp * 64 + rw) * 66 + 65] * w; oo += part[(sp * 64 + rw) * 66 + lane] * w; }
                os[s2] = oo / ll; }
            const float o = os[0] - lam * os[1]; const float ms = wave_sum(o * o) * (1.0f / 64);
            const float y = o * rsqrtf(ms + EPS) * C.in[I_SUBLN][l * 64 + lane] * (1.0f - lam_init);
            BR[(size_t)(MP + b * 8 + t2) * D + 768 + h2 * 64 + lane] = (bf16)f2bf(y); }
        __syncthreads();
    }
}
typedef short bf16x8_t __attribute__((ext_vector_type(8)));
template <int DK, bool RET> __device__ __forceinline__ void la_chunked(const Ctx& C, int l, bool smp, int b, int h) {
    THREAD_IDS();
    constexpr int QS = DK + 8, TS = 72, NKB = DK / 16, NKS = DK / 32;
    constexpr int SB = 2 * 64 * QS + 64 * TS + DK * TS + 64 * TS + 64;
    LAS bf16* SB0 = (LAS bf16*)(C.lds);
    LAS bf16* AL = SB0 + 2 * SB;
    LAS bf16* ST = AL + 64 * TS;
    const bf16* ZM = WSP(bf16, WS_ZMIX); const float* RQ = WSP(float, WS_RQ); const float* RK = WSP(float, WS_RK); const float* LD = WSP(float, WS_LDEC); bf16* BR = WSP(bf16, WS_BR);
    const int nt = smp ? DS : L, row0 = smp ? MP + b * DS : b * L, nch = (nt + 63) >> 6;
    const float lg2 = RET ? log2f(1.0f - exp2f(-5.0f - (float)h)) : 0.f;
    const int g4 = lane >> 4, c16 = lane & 15;
    const bool qwave = wave < 4; const int w4 = wave & 3;
    float Sreg[NKB][4];
    if (wave >= 4) {
        const float* s0 = (RET ? C.in[I_SRET] : C.in[I_SGLA]) + (((size_t)l * DB + b) * 4 + h) * DK * 64;
#pragma unroll
        for (int cb = 0; cb < NKB; ++cb)
#pragma unroll
            for (int r = 0; r < 4; ++r) { const int dk = cb * 16 + c16, dv = (wave - 4) * 16 + 4 * g4 + r; const float v = smp ? s0[dk * 64 + dv] : 0.f; Sreg[cb][r] = v; ST[dv * QS + dk] = (bf16)f2bf(v); }
    }
    float gnv[4];
#pragma unroll
    for (int cb = 0; cb < 4; ++cb) gnv[cb] = (RET ? C.in[I_RGN] : C.in[I_GGN])[(l * 4 + h) * 64 + cb * 16 + c16];
    float a[16]; v4u vr;
#define LA_LOAD(c) do { const size_t r_ = (size_t)(row0 + (c) * 64 + lane); const bf16* z_ = ZM + r_ * NMIXP; \
        vr = *(const v4u*)(z_ + (RET ? R_V : G_V) + h * 64 + 8 * wave); \
        if (RET) { const float* p_ = (qwave ? RQ : RK) + r_ * 256 + h * 64 + 8 * w4; const f32x4 x0 = *(const f32x4*)p_, x1 = *(const f32x4*)(p_ + 4), x2 = *(const f32x4*)(p_ + 32), x3 = *(const f32x4*)(p_ + 36); \
            a[0] = x0[0]; a[1] = x0[1]; a[2] = x0[2]; a[3] = x0[3]; a[4] = x1[0]; a[5] = x1[1]; a[6] = x1[2]; a[7] = x1[3]; a[8] = x2[0]; a[9] = x2[1]; a[10] = x2[2]; a[11] = x2[3]; a[12] = x3[0]; a[13] = x3[1]; a[14] = x3[2]; a[15] = x3[3]; } \
        else { const v4u q_ = *(const v4u*)(z_ + (qwave ? G_Q : G_K) + h * 32 + 8 * w4); const float* p_ = LD + r_ * 128 + h * 32 + 8 * w4; const f32x4 x0 = *(const f32x4*)p_, x1 = *(const f32x4*)(p_ + 4); \
            a[0] = bflo(q_.x); a[1] = bfhi(q_.x); a[2] = bflo(q_.y); a[3] = bfhi(q_.y); a[4] = bflo(q_.z); a[5] = bfhi(q_.z); a[6] = bflo(q_.w); a[7] = bfhi(q_.w); \
            a[8] = x0[0]; a[9] = x0[1]; a[10] = x0[2]; a[11] = x0[3]; a[12] = x1[0]; a[13] = x1[1]; a[14] = x1[2]; a[15] = x1[3]; } } while (0)
    LA_LOAD(0);
    int cur = 0;
    for (int i = 0; i <= nch; ++i) {
        if (i < nch) {
            const int c = i; LAS bf16* QT = SB0 + (i & 1) * SB; LAS bf16* KT = QT + 64 * QS; LAS bf16* VT = KT + 64 * QS; LAS bf16* KE = VT + 64 * TS; LAS bf16* GT = KE + DK * TS; LAS float* WT = (LAS float*)(GT + 64 * TS);
            const int nvc = min(64, nt - c * 64); const bool valid = lane < nvc;
        if (RET) {
            const float tq = (float)(lane + 1);
            if (qwave) { const float e = valid ? __builtin_amdgcn_exp2f(lg2 * tq) : 0.f;
                v4u w0, w1; w0.x = pg8::cvt_pk_bf16(a[0] * e, a[1] * e); w0.y = pg8::cvt_pk_bf16(a[2] * e, a[3] * e); w0.z = pg8::cvt_pk_bf16(a[4] * e, a[5] * e); w0.w = pg8::cvt_pk_bf16(a[6] * e, a[7] * e);
                w1.x = pg8::cvt_pk_bf16(a[8] * e, a[9] * e); w1.y = pg8::cvt_pk_bf16(a[10] * e, a[11] * e); w1.z = pg8::cvt_pk_bf16(a[12] * e, a[13] * e); w1.w = pg8::cvt_pk_bf16(a[14] * e, a[15] * e);
                *(LAS v4u*)(QT + lane * QS + 8 * w4) = w0; *(LAS v4u*)(QT + lane * QS + 32 + 8 * w4) = w1; }
            else { const float e = valid ? __builtin_amdgcn_exp2f(-lg2 * tq) : 0.f, ee = valid ? __builtin_amdgcn_exp2f(lg2 * ((float)nvc - tq)) : 0.f;
                v4u w0, w1; w0.x = pg8::cvt_pk_bf16(a[0] * e, a[1] * e); w0.y = pg8::cvt_pk_bf16(a[2] * e, a[3] * e); w0.z = pg8::cvt_pk_bf16(a[4] * e, a[5] * e); w0.w = pg8::cvt_pk_bf16(a[6] * e, a[7] * e);
                w1.x = pg8::cvt_pk_bf16(a[8] * e, a[9] * e); w1.y = pg8::cvt_pk_bf16(a[10] * e, a[11] * e); w1.z = pg8::cvt_pk_bf16(a[12] * e, a[13] * e); w1.w = pg8::cvt_pk_bf16(a[14] * e, a[15] * e);
                *(LAS v4u*)(KT + lane * QS + 8 * w4) = w0; *(LAS v4u*)(KT + lane * QS + 32 + 8 * w4) = w1;
#pragma unroll
                for (int i = 0; i < 16; i += 2) { const unsigned mine = pg8::cvt_pk_bf16(a[i] * ee, a[i + 1] * ee); const unsigned pv = (unsigned)__shfl_xor((int)mine, 1);
                    const unsigned w = (lane & 1) ? ((pv >> 16) | (mine & 0xffff0000u)) : ((mine & 0xffffu) | (pv << 16));
                    const int row = (i < 8 ? 8 * w4 + i : 32 + 8 * w4 + (i - 8)) + (lane & 1);
                    *(LAS unsigned*)(KE + row * TS + (lane & ~1)) = w; } }
        } else {
            float bb[8];
#pragma unroll
            for (int i = 0; i < 8; ++i) bb[i] = valid ? a[8 + i] : 0.f;
#pragma unroll
            for (int i = 0; i < 8; ++i) { float x = bb[i];
                x += __builtin_bit_cast(float, __builtin_amdgcn_mov_dpp(__builtin_bit_cast(int, x), 0x111, 0xf, 0xf, true));
                x += __builtin_bit_cast(float, __builtin_amdgcn_mov_dpp(__builtin_bit_cast(int, x), 0x112, 0xf, 0xf, true));
                x += __builtin_bit_cast(float, __builtin_amdgcn_mov_dpp(__builtin_bit_cast(int, x), 0x114, 0xf, 0xf, true));
                x += __builtin_bit_cast(float, __builtin_amdgcn_mov_dpp(__builtin_bit_cast(int, x), 0x118, 0xf, 0xf, true));
                const float t0 = __builtin_bit_cast(float, __builtin_amdgcn_readlane(__builtin_bit_cast(int, x), 15)), t1 = __builtin_bit_cast(float, __builtin_amdgcn_readlane(__builtin_bit_cast(int, x), 31)), t2 = __builtin_bit_cast(float, __builtin_amdgcn_readlane(__builtin_bit_cast(int, x), 47));
                bb[i] = x + (lane >= 16 ? t0 : 0.f) + (lane >= 32 ? t1 : 0.f) + (lane >= 48 ? t2 : 0.f); }
            if (qwave) {
                if (lane == 63) {
#pragma unroll
                    for (int i = 0; i < 8; ++i) WT[8 * w4 + i] = bb[i]; }
                float o8[8];
#pragma unroll
                for (int i = 0; i < 8; ++i) o8[i] = valid ? a[i] * 0.17677669529663687f * __expf(bb[i]) : 0.f;
                v4u w0; w0.x = pg8::cvt_pk_bf16(o8[0], o8[1]); w0.y = pg8::cvt_pk_bf16(o8[2], o8[3]); w0.z = pg8::cvt_pk_bf16(o8[4], o8[5]); w0.w = pg8::cvt_pk_bf16(o8[6], o8[7]);
                *(LAS v4u*)(QT + lane * QS + 8 * w4) = w0;
            } else {
                float o8[8];
#pragma unroll
                for (int i = 0; i < 8; ++i) o8[i] = valid ? a[i] * __expf(-bb[i]) : 0.f;
#pragma unroll
                for (int i = 0; i < 8; i += 2) { const float t0 = __shfl(bb[i], 63), t1 = __shfl(bb[i + 1], 63);
                    const unsigned mine = pg8::cvt_pk_bf16(valid ? a[i] * __expf(t0 - bb[i]) : 0.f, valid ? a[i + 1] * __expf(t1 - bb[i + 1]) : 0.f); const unsigned pv = (unsigned)__shfl_xor((int)mine, 1);
                    const unsigned w = (lane & 1) ? ((pv >> 16) | (mine & 0xffff0000u)) : ((mine & 0xffffu) | (pv << 16));
                    *(LAS unsigned*)(KE + (8 * w4 + i + (lane & 1)) * TS + (lane & ~1)) = w; }
                v4u w0; w0.x = pg8::cvt_pk_bf16(o8[0], o8[1]); w0.y = pg8::cvt_pk_bf16(o8[2], o8[3]); w0.z = pg8::cvt_pk_bf16(o8[4], o8[5]); w0.w = pg8::cvt_pk_bf16(o8[6], o8[7]);
                *(LAS v4u*)(KT + lane * QS + 8 * w4) = w0;
            }
        }
        { const unsigned vv[4] = {valid ? vr.x : 0u, valid ? vr.y : 0u, valid ? vr.z : 0u, valid ? vr.w : 0u};
#pragma unroll
          for (int i = 0; i < 4; ++i) { const unsigned pv = (unsigned)__shfl_xor((int)vv[i], 1);
              const unsigned w = (lane & 1) ? ((pv >> 16) | (vv[i] & 0xffff0000u)) : ((vv[i] & 0xffffu) | (pv << 16));
              *(LAS unsigned*)(VT + (8 * wave + 2 * i + (lane & 1)) * TS + (lane & ~1)) = w; } }
            if (c + 1 < nch) LA_LOAD(c + 1);
        }
        if (i >= 1) {
            LAS bf16* QT = SB0 + ((i - 1) & 1) * SB; LAS bf16* KT = QT + 64 * QS;
        { const int rb = wave >> 1;
#pragma unroll
          for (int ci = 0; ci < 2; ++ci) { const int cb = (wave & 1) * 2 + ci; f32x4 acc = {0.f, 0.f, 0.f, 0.f};
              if (cb <= rb) {
#pragma unroll
                  for (int ks = 0; ks < NKS; ++ks) { const bf16x8_t af = *(const LAS bf16x8_t*)(QT + (rb * 16 + c16) * QS + ks * 32 + 8 * g4), bf = *(const LAS bf16x8_t*)(KT + (cb * 16 + c16) * QS + ks * 32 + 8 * g4);
                      acc = __builtin_amdgcn_mfma_f32_16x16x32_bf16(af, bf, acc, 0, 0, 0); } }
#pragma unroll
              for (int r = 0; r < 4; ++r) { const int tt = rb * 16 + 4 * g4 + r, ss = cb * 16 + c16; AL[tt * TS + ss] = (bf16)f2bf(ss <= tt ? acc[r] : 0.f); } } }
        }
        LDS_WAIT(); __builtin_amdgcn_s_barrier(); asm volatile("" ::: "memory");
        if (i >= 1) {
            const int c = i - 1; LAS bf16* QT = SB0 + (c & 1) * SB; LAS bf16* KT = QT + 64 * QS; LAS bf16* VT = KT + 64 * QS; LAS bf16* KE = VT + 64 * TS; LAS bf16* GT = KE + DK * TS; LAS float* WT = (LAS float*)(GT + 64 * TS);
            const int nvc = min(64, nt - c * 64); (void)KT;
        if (wave < 4) {
            const int rb = wave; const LAS bf16* STc = ST + cur * 64 * QS;
            f32x4 o[4];
#pragma unroll
            for (int cb = 0; cb < 4; ++cb) o[cb] = (f32x4){0.f, 0.f, 0.f, 0.f};
#pragma unroll
            for (int ks = 0; ks < 2; ++ks) { const bf16x8_t af = *(const LAS bf16x8_t*)(AL + (rb * 16 + c16) * TS + ks * 32 + 8 * g4);
#pragma unroll
                for (int cb = 0; cb < 4; ++cb) { const bf16x8_t bf = *(const LAS bf16x8_t*)(VT + (cb * 16 + c16) * TS + ks * 32 + 8 * g4); o[cb] = __builtin_amdgcn_mfma_f32_16x16x32_bf16(af, bf, o[cb], 0, 0, 0); } }
#pragma unroll
            for (int ks = 0; ks < NKS; ++ks) { const bf16x8_t af = *(const LAS bf16x8_t*)(QT + (rb * 16 + c16) * QS + ks * 32 + 8 * g4);
#pragma unroll
                for (int cb = 0; cb < 4; ++cb) { const bf16x8_t bf = *(const LAS bf16x8_t*)(STc + (cb * 16 + c16) * QS + ks * 32 + 8 * g4); o[cb] = __builtin_amdgcn_mfma_f32_16x16x32_bf16(af, bf, o[cb], 0, 0, 0); } }
            { float* LAO = WSP(float, WS_LAO);
#pragma unroll
              for (int r = 0; r < 4; ++r) { const int tok = c * 64 + rb * 16 + 4 * g4 + r;
                  if (tok < nt) { float* op = LAO + (size_t)(row0 + tok) * 512 + (RET ? 0 : 256) + h * 64 + c16;
#pragma unroll
                      for (int cb = 0; cb < 4; ++cb) op[cb * 16] = o[cb][r]; } } }
        } else {
            const int dvb = wave - 4; LAS bf16* STn = ST + (cur ^ 1) * 64 * QS;
            f32x4 ds[NKB];
#pragma unroll
            for (int cb = 0; cb < NKB; ++cb) ds[cb] = (f32x4){0.f, 0.f, 0.f, 0.f};
#pragma unroll
            for (int ks = 0; ks < 2; ++ks) { const bf16x8_t af = *(const LAS bf16x8_t*)(VT + (dvb * 16 + c16) * TS + ks * 32 + 8 * g4);
#pragma unroll
                for (int cb = 0; cb < NKB; ++cb) { const bf16x8_t bf = *(const LAS bf16x8_t*)(KE + (cb * 16 + c16) * TS + ks * 32 + 8 * g4); ds[cb] = __builtin_amdgcn_mfma_f32_16x16x32_bf16(af, bf, ds[cb], 0, 0, 0); } }
#pragma unroll
            for (int cb = 0; cb < NKB; ++cb) { const float eB = RET ? __builtin_amdgcn_exp2f(lg2 * (float)nvc) : __expf(WT[cb * 16 + c16]);
#pragma unroll
                for (int r = 0; r < 4; ++r) { Sreg[cb][r] = eB * Sreg[cb][r] + ds[cb][r]; STn[(dvb * 16 + 4 * g4 + r) * QS + cb * 16 + c16] = (bf16)f2bf(Sreg[cb][r]); } }
        }
            cur ^= 1;
        }
        LDS_WAIT(); __builtin_amdgcn_s_barrier(); asm volatile("" ::: "memory");
    }
#undef LA_LOAD
    if (wave >= 4) {
        float* so = C.out + (RET ? (smp ? O_RS + (((size_t)l * DB + b) * 4 + h) * DK * 64 : O_RP + (((size_t)l * BATCH + b) * 4 + h) * DK * 64)
                                 : (smp ? O_GS + (((size_t)l * DB + b) * 4 + h) * DK * 64 : O_GP + (((size_t)l * BATCH + b) * 4 + h) * DK * 64));
#pragma unroll
        for (int cb = 0; cb < NKB; ++cb)
#pragma unroll
            for (int r = 0; r < 4; ++r) so[(cb * 16 + c16) * 64 + (wave - 4) * 16 + 4 * g4 + r] = Sreg[cb][r];
    }
}
__device__ __forceinline__ void n2_la_chunked(const Ctx& C, int l) {
    const int bx = blockIdx.x;
    if (bx < 32) { const int b = (bx >> 2) & 3, h = bx & 3; if (bx < 16) la_chunked<64, true>(C, l, false, b, h); else la_chunked<32, false>(C, l, false, b, h); }
    else { for (int it = bx - 32; it < 256; it += C.G - 32) { const int b = (it >> 2) & 31, h = it & 3; if (it < 128) la_chunked<64, true>(C, l, true, b, h); else la_chunked<32, false>(C, l, true, b, h); } }
}
typedef float f32x16_t __attribute__((ext_vector_type(16)));
__device__ __forceinline__ int crow_(int r, int hi) { return (r & 3) + 8 * (r >> 2) + 4 * hi; }
__device__ __forceinline__ float swapmax32(float m) { auto rr = __builtin_amdgcn_permlane32_swap(__float_as_uint(m), __float_as_uint(m), false, false); return fmaxf(__uint_as_float(rr[0]), __uint_as_float(rr[1])); }
__device__ __forceinline__ float swapadd32(float m) { auto rr = __builtin_amdgcn_permlane32_swap(__float_as_uint(m), __float_as_uint(m), false, false); return __uint_as_float(rr[0]) + __uint_as_float(rr[1]); }
constexpr float LOG2E = 1.4426950408889634f;
__device__ __forceinline__ void attn_prompt_item(const Ctx& C, int l, int b, int h, int qb, float lam, float lam_init) {
    THREAD_IDS();
    constexpr int KS = 72;
    LAS bf16* Kt = (LAS bf16*)C.lds;
    LAS bf16* Vt = Kt + 2 * 64 * KS;
    LAS float* BT = (LAS float*)(Vt + 2 * 64 * KS);
    LAS float* OX = BT + 128;
    const bf16* ZM = WSP(bf16, WS_ZMIX); const bf16* QNB = WSP(bf16, WS_QNB); const bf16* KNB = WSP(bf16, WS_KNB); bf16* BR = WSP(bf16, WS_BR);
    const int r32 = lane & 31, hi = lane >> 5, qs = wave >> 1, s = wave & 1;
    const int q0 = qb * 128 + qs * 32; const int rowb = b * L;
    if (tid < 128) BT[tid] = (C.in[I_RELB][t5_bucket(tid) * 4 + h] - C.in[I_RELB][31 * 4 + h]) * LOG2E;
    pg8::bf16x8 qf[2];
#pragma unroll
    for (int d0 = 0; d0 < 2; ++d0) qf[d0] = *(const pg8::bf16x8*)(QNB + (size_t)(rowb + q0 + r32) * 256 + h * 64 + s * 32 + 16 * d0 + 8 * hi);
    const int pl = (lane & ~15) | ((lane & 8) >> 1) | ((lane & 4) << 1) | (lane & 3);
    const int NT = (min(128 * (qb + 1), L) + 63) >> 6;
    v4u kreg, vreg;
#define AT_LOAD(j) do { const size_t r_ = (size_t)(rowb + (j) * 64 + lane); kreg = *(const v4u*)(KNB + r_ * 256 + h * 64 + 8 * wave); vreg = *(const v4u*)(ZM + r_ * NMIXP + D_V + h * 64 + 8 * wave); } while (0)
#define AT_STORE(buf) do { *(LAS v4u*)(Kt + (buf) * 64 * KS + lane * KS + 8 * wave) = kreg; LAS bf16* v_ = Vt + (buf) * 64 * KS + (8 * wave) * KS + pl; \
        v_[0] = (bf16)(vreg.x & 0xffffu); v_[KS] = (bf16)(vreg.x >> 16); v_[2 * KS] = (bf16)(vreg.y & 0xffffu); v_[3 * KS] = (bf16)(vreg.y >> 16); \
        v_[4 * KS] = (bf16)(vreg.z & 0xffffu); v_[5 * KS] = (bf16)(vreg.z >> 16); v_[6 * KS] = (bf16)(vreg.w & 0xffffu); v_[7 * KS] = (bf16)(vreg.w >> 16); } while (0)
    AT_LOAD(0); AT_STORE(0); if (NT > 1) AT_LOAD(1);
    LDS_WAIT(); __builtin_amdgcn_s_barrier(); asm volatile("" ::: "memory");
    float m = -INFINITY, lsum = 0.f; f32x16_t o[2];
#pragma unroll
    for (int i = 0; i < 16; ++i) { o[0][i] = 0.f; o[1][i] = 0.f; }
    for (int j = 0; j < NT; ++j) {
        const int k0 = 64 * j, buf = j & 1;
        if (k0 <= q0 + 31) {
            const LAS bf16* kb = Kt + buf * 64 * KS; const LAS bf16* vb = Vt + buf * 64 * KS;
            f32x16_t p0, p1;
#pragma unroll
            for (int i = 0; i < 16; ++i) { p0[i] = 0.f; p1[i] = 0.f; }
#pragma unroll
            for (int d0 = 0; d0 < 2; ++d0) { const pg8::bf16x8 a0 = *(const LAS pg8::bf16x8*)(kb + r32 * KS + s * 32 + 16 * d0 + 8 * hi), a1 = *(const LAS pg8::bf16x8*)(kb + (32 + r32) * KS + s * 32 + 16 * d0 + 8 * hi);
                p0 = __builtin_amdgcn_mfma_f32_32x32x16_bf16(a0, qf[d0], p0, 0, 0, 0); p1 = __builtin_amdgcn_mfma_f32_32x32x16_bf16(a1, qf[d0], p1, 0, 0, 0); }
            if (q0 - k0 - 63 < 113) {
#pragma unroll
                for (int r = 0; r < 16; ++r) { const int n0 = (q0 + r32) - (k0 + crow_(r, hi)), n1 = n0 - 32;
                    p0[r] = n0 < 0 ? -INFINITY : p0[r] + (n0 < 128 ? BT[n0] : 0.f); p1[r] = n1 < 0 ? -INFINITY : p1[r] + (n1 < 128 ? BT[n1] : 0.f); } }
            float mt = fmaxf(p0[0], p1[0]);
#pragma unroll
            for (int r = 1; r < 16; ++r) mt = fmaxf(mt, fmaxf(p0[r], p1[r]));
            mt = swapmax32(mt);
            const float mn = fmaxf(m, mt);
            if (__any(mn > m)) { const float al = exp2f(m - mn);
#pragma unroll
                for (int i = 0; i < 16; ++i) { o[0][i] *= al; o[1][i] *= al; }
                lsum *= al; m = mn; }
            float ps = 0.f;
#pragma unroll
            for (int r = 0; r < 16; ++r) { p0[r] = exp2f(p0[r] - m); p1[r] = exp2f(p1[r] - m); ps += p0[r] + p1[r]; }
            lsum += ps;
            pg8::bf16x8 pb[4];
#pragma unroll
            for (int ks = 0; ks < 4; ++ks) { v4u w;
                if (ks < 2) { w.x = pg8::cvt_pk_bf16(p0[8 * ks], p0[8 * ks + 1]); w.y = pg8::cvt_pk_bf16(p0[8 * ks + 2], p0[8 * ks + 3]); w.z = pg8::cvt_pk_bf16(p0[8 * ks + 4], p0[8 * ks + 5]); w.w = pg8::cvt_pk_bf16(p0[8 * ks + 6], p0[8 * ks + 7]); }
                else { w.x = pg8::cvt_pk_bf16(p1[8 * ks - 16], p1[8 * ks - 15]); w.y = pg8::cvt_pk_bf16(p1[8 * ks - 14], p1[8 * ks - 13]); w.z = pg8::cvt_pk_bf16(p1[8 * ks - 12], p1[8 * ks - 11]); w.w = pg8::cvt_pk_bf16(p1[8 * ks - 10], p1[8 * ks - 9]); }
                pb[ks] = __builtin_bit_cast(pg8::bf16x8, w); }
#pragma unroll
            for (int d0 = 0; d0 < 2; ++d0)
#pragma unroll
                for (int ks = 0; ks < 4; ++ks) { const pg8::bf16x8 af = *(const LAS pg8::bf16x8*)(vb + (32 * d0 + r32) * KS + 16 * ks + 8 * hi); o[d0] = __builtin_amdgcn_mfma_f32_32x32x16_bf16(af, pb[ks], o[d0], 0, 0, 0); }
        }
        if (j + 1 < NT) AT_STORE(buf ^ 1);
        if (j + 2 < NT) AT_LOAD(j + 2);
        LDS_WAIT(); __builtin_amdgcn_s_barrier(); asm volatile("" ::: "memory");
    }
#undef AT_LOAD
#undef AT_STORE
    lsum = swapadd32(lsum); const float inv = 1.0f / lsum;
    LAS float* ox = OX + (qs * 32 + r32) * 65;
    if (s == 1) {
#pragma unroll
        for (int d0 = 0; d0 < 2; ++d0)
#pragma unroll
            for (int r = 0; r < 16; ++r) ox[32 * d0 + crow_(r, hi)] = o[d0][r] * inv; }
    LDS_WAIT(); __builtin_amdgcn_s_barrier(); asm volatile("" ::: "memory");
    if (s == 0) {
        float ss = 0.f;
#pragma unroll
        for (int d0 = 0; d0 < 2; ++d0)
#pragma unroll
            for (int r = 0; r < 16; ++r) { const float v = o[d0][r] * inv - lam * ox[32 * d0 + crow_(r, hi)]; o[d0][r] = v; ss += v * v; }
        ss = swapadd32(ss); const float rs = rsqrtf(ss * (1.0f / 64) + EPS) * (1.0f - lam_init);
        const int qpos = q0 + r32;
        if (qpos < L) { bf16* brp = BR + (size_t)(rowb + qpos) * D + 768 + h * 64;
#pragma unroll
            for (int d0 = 0; d0 < 2; ++d0)
#pragma unroll
                for (int r4 = 0; r4 < 4; ++r4) { const int dv = 32 * d0 + 8 * r4 + 4 * hi; const float* sl = C.in[I_SUBLN] + l * 64 + dv;
                    const unsigned w0 = pk2(o[d0][4 * r4] * rs * sl[0], o[d0][4 * r4 + 1] * rs * sl[1]), w1 = pk2(o[d0][4 * r4 + 2] * rs * sl[2], o[d0][4 * r4 + 3] * rs * sl[3]);
                    *(unsigned long long*)(brp + dv) = (unsigned long long)w0 | ((unsigned long long)w1 << 32); } }
    }
    LDS_WAIT(); __builtin_amdgcn_s_barrier(); asm volatile("" ::: "memory");
}
__device__ __forceinline__ void n2_attn_prompt_mfma(const Ctx& C, int l, float lam_init, int qoff = 0) {
    THREAD_IDS();
    const float lam = lam_of(C, l, lam_init);
    unsigned* qw = (unsigned*)(C.ws + WS_CTL) + CW_QUEUE + 64 * (l + qoff);
    volatile LAS int* slot = (volatile LAS int*)(C.lds + MISC_OFF + 64);
    constexpr int NQB = (L + 127) / 128;
    for (;;) {
        if (tid == 0) slot[0] = (int)__hip_atomic_fetch_add(qw, 1u, __ATOMIC_RELAXED, __HIP_MEMORY_SCOPE_AGENT);
        __syncthreads();
        const int it = slot[0];
        if (it >= 16 * NQB) break;
        attn_prompt_item(C, l, (it & 15) >> 2, it & 3, NQB - 1 - (it >> 4), lam, lam_init);
    }
}
constexpr int PSTR = 68;
__device__ __forceinline__ pg8::bf16x8 cvt8(const f32x4 a, const f32x4 b) { v4u w; w.x = pg8::cvt_pk_bf16(a[0], a[1]); w.y = pg8::cvt_pk_bf16(a[2], a[3]); w.z = pg8::cvt_pk_bf16(b[0], b[1]); w.w = pg8::cvt_pk_bf16(b[2], b[3]); return __builtin_bit_cast(pg8::bf16x8, w); }
__device__ __forceinline__ void attn_sample_item(const Ctx& C, int l, int b, int split) {
    THREAD_IDS();
    const int h = wave & 3, half = wave >> 2, c16 = lane & 15, g = lane >> 4, srow = c16 >> 3, t = c16 & 7;
    const bf16* QNB = WSP(bf16, WS_QNB); const int* PT = (const int*)C.in[I_PT];
    const float* CK = C.in[I_CK] + (size_t)l * NPOOL * PAGE * 256; const float* CV = C.in[I_CV] + (size_t)l * NPOOL * PAGE * 256;
    LAS float* BT = (LAS float*)C.lds;
    BT[tid] = (C.in[I_RELB][t5_bucket(tid & 127) * 4 + (tid >> 7)] - C.in[I_RELB][31 * 4 + (tid >> 7)]) * LOG2E;
    const v4u z4 = {0u, 0u, 0u, 0u};
    const v4u q0w = srow == 0 ? *(const v4u*)(QNB + (size_t)(MP + b * 8 + t) * 256 + h * 64 + 8 * g) : z4, q1w = srow == 1 ? *(const v4u*)(QNB + (size_t)(MP + b * 8 + t) * 256 + h * 64 + 32 + 8 * g) : z4;
    const pg8::bf16x8 qf0 = __builtin_bit_cast(pg8::bf16x8, q0w), qf1 = __builtin_bit_cast(pg8::bf16x8, q1w);
    LDS_WAIT(); __builtin_amdgcn_s_barrier(); asm volatile("" ::: "memory");
    float m = -INFINITY, lsum = 0.f; f32x4 o[4];
#pragma unroll
    for (int db = 0; db < 4; ++db) o[db] = (f32x4){0.f, 0.f, 0.f, 0.f};
    const int kk0 = split * 1024 + half * 512;
    for (int step = 0; step < 16; ++step) {
        const int kk = kk0 + 32 * step; const int page = PT[b * NPAGES + (kk >> 7)];
        const size_t base = ((size_t)(page * PAGE + (kk & 127)) * 4 + h) * 64;
        f32x4 kr[2][2][2]; float vr[4][8];
#pragma unroll
        for (int T = 0; T < 2; ++T)
#pragma unroll
            for (int ks = 0; ks < 2; ++ks) { const float* p = CK + base + (size_t)(16 * T + c16) * 256 + 32 * ks + 8 * g; kr[T][ks][0] = *(const f32x4*)p; kr[T][ks][1] = *(const f32x4*)(p + 4); }
#pragma unroll
        for (int db = 0; db < 4; ++db)
#pragma unroll
            for (int j = 0; j < 8; ++j) { const int kv = j < 4 ? 4 * g + j : 16 + 4 * g + (j - 4); vr[db][j] = CV[base + (size_t)kv * 256 + 16 * db + c16]; }
        f32x4 sv[2];
#pragma unroll
        for (int T = 0; T < 2; ++T) { sv[T] = (f32x4){0.f, 0.f, 0.f, 0.f};
            sv[T] = __builtin_amdgcn_mfma_f32_16x16x32_bf16(cvt8(kr[T][0][0], kr[T][0][1]), qf0, sv[T], 0, 0, 0);
            sv[T] = __builtin_amdgcn_mfma_f32_16x16x32_bf16(cvt8(kr[T][1][0], kr[T][1][1]), qf1, sv[T], 0, 0, 0); }
        if (kk + 31 + 128 > PAST) {
#pragma unroll
            for (int T = 0; T < 2; ++T)
#pragma unroll
                for (int r = 0; r < 4; ++r) { const int n = PAST + t - (kk + 16 * T + 4 * g + r); if (n < 128) sv[T][r] += BT[h * 128 + n]; } }
        float mt = fmaxf(fmaxf(fmaxf(sv[0][0], sv[0][1]), fmaxf(sv[0][2], sv[0][3])), fmaxf(fmaxf(sv[1][0], sv[1][1]), fmaxf(sv[1][2], sv[1][3])));
        mt = fmaxf(mt, __shfl_xor(mt, 16)); mt = fmaxf(mt, __shfl_xor(mt, 32));
        const float mn = fmaxf(m, mt); const float al = exp2f(m - mn); m = mn;
        float ps = 0.f;
#pragma unroll
        for (int T = 0; T < 2; ++T)
#pragma unroll
            for (int r = 0; r < 4; ++r) { sv[T][r] = exp2f(sv[T][r] - m); ps += sv[T][r]; }
        lsum = lsum * al + ps;
        const pg8::bf16x8 pf = cvt8(sv[0], sv[1]);
#pragma unroll
        for (int db = 0; db < 4; ++db) { o[db] = o[db] * al;
            const f32x4 va = {vr[db][0], vr[db][1], vr[db][2], vr[db][3]}, vb = {vr[db][4], vr[db][5], vr[db][6], vr[db][7]};
            o[db] = __builtin_amdgcn_mfma_f32_16x16x32_bf16(cvt8(va, vb), pf, o[db], 0, 0, 0); }
    }
    lsum += __shfl_xor(lsum, 16); lsum += __shfl_xor(lsum, 32);
    float* pp = WSP(float, WS_PART) + ((((size_t)b * 4 + h) * 16 + split * 2 + half) * 16 + c16) * PSTR;
#pragma unroll
    for (int db = 0; db < 4; ++db) *(f32x4*)(pp + 16 * db + 4 * g) = o[db];
    if (g == 0) { pp[64] = m; pp[65] = lsum; }
    LDS_WAIT(); __builtin_amdgcn_s_barrier(); asm volatile("" ::: "memory");
}
__device__ __forceinline__ void n2_attn_sample_split(const Ctx& C, int l) {
    for (int it = blockIdx.x; it < DB * 8; it += C.G) attn_sample_item(C, l, it >> 3, it & 7);
}
__device__ __forceinline__ void n3_attn_sample_combine(const Ctx& C, int l, float lam_init) {
    THREAD_IDS();
    const float lam = lam_of(C, l, lam_init);
    const bf16* QNB = WSP(bf16, WS_QNB); const bf16* KNB = WSP(bf16, WS_KNB); const bf16* ZM = WSP(bf16, WS_ZMIX); bf16* BR = WSP(bf16, WS_BR);
    for (int it = gw; it < DB * 4 * DS; it += NGW) {
        const int b = it >> 5, h = (it >> 3) & 3, t = it & 7; float os[2];
        const float far = C.in[I_RELB][31 * 4 + h];
#pragma unroll
        for (int s = 0; s < 2; ++s) {
            const float* pb = WSP(float, WS_PART) + ((((size_t)b * 4 + h) * 16) * 16 + s * 8 + t) * PSTR;
            float sn[8]; float mm = -INFINITY;
            for (int pi = 0; pi < 16; ++pi) mm = fmaxf(mm, pb[(size_t)pi * 16 * PSTR + 64]);
#pragma unroll
            for (int jj = 0; jj < 8; ++jj) { float d = 0.f;
                for (int i = 0; i < 32; ++i) d += bf2f(QNB[(size_t)(MP + b * 8 + t) * 256 + h * 64 + s * 32 + i]) * bf2f(KNB[(size_t)(MP + b * 8 + jj) * 256 + h * 64 + s * 32 + i]);
                d += (C.in[I_RELB][t5_bucket(t - jj < 0 ? 0 : t - jj) * 4 + h] - far) * LOG2E;
                sn[jj] = jj <= t ? d : -INFINITY; mm = fmaxf(mm, sn[jj]); }
            float ll = 0.f, oo = 0.f;
            for (int pi = 0; pi < 16; ++pi) { const float* pr = pb + (size_t)pi * 16 * PSTR; const float w = exp2f(pr[64] - mm); ll += pr[65] * w; oo += pr[lane] * w; }
#pragma unroll
            for (int jj = 0; jj < 8; ++jj) { const float w = exp2f(sn[jj] - mm); ll += w; oo += w * bf2f(ZM[(size_t)(MP + b * 8 + jj) * NMIXP + D_V + h * 64 + lane]); }
            os[s] = oo / ll;
        }
        const float o = os[0] - lam * os[1]; const float ms = wave_sum(o * o) * (1.0f / 64);
        BR[(size_t)(MP + b * 8 + t) * D + 768 + h * 64 + lane] = (bf16)f2bf(o * rsqrtf(ms + EPS) * C.in[I_SUBLN][l * 64 + lane] * (1.0f - lam_init));
    }
}

__device__ __forceinline__ void n3_la_finalize(const Ctx& C, int l) {
    THREAD_IDS();
    const float* LAO = WSP(float, WS_LAO); const bf16* ZM = WSP(bf16, WS_ZMIX); bf16* BR = WSP(bf16, WS_BR);
    const bool ret = lane < 32; const int hd = (lane >> 3) & 3, c8 = (lane & 7) * 8;
    float gn[8];
#pragma unroll
    for (int j = 0; j < 8; ++j) gn[j] = (ret ? C.in[I_RGN] : C.in[I_GGN])[(l * 4 + hd) * 64 + c8 + j];
    for (int r = gw; r < MR; r += NGW) {
        const f32x4 a = *(const f32x4*)(LAO + (size_t)r * 512 + 8 * lane), b = *(const f32x4*)(LAO + (size_t)r * 512 + 8 * lane + 4);
        const v4u gw4 = *(const v4u*)(ZM + (size_t)r * NMIXP + (ret ? R_G : G_R) + hd * 64 + c8);
        float x[8] = {a[0], a[1], a[2], a[3], b[0], b[1], b[2], b[3]}, g[8]; unpack8(gw4, g);
        float s = ((x[0] + x[1]) + (x[2] + x[3])) + ((x[4] + x[5]) + (x[6] + x[7]));
        s += __shfl_xor(s, 1); s += __shfl_xor(s, 2); s += __shfl_xor(s, 4);
        const float mean = ret ? s * (1.0f / 64) : 0.f; float q2 = 0.f;
#pragma unroll
        for (int j = 0; j < 8; ++j) { x[j] -= mean; q2 += x[j] * x[j]; }
        q2 += __shfl_xor(q2, 1); q2 += __shfl_xor(q2, 2); q2 += __shfl_xor(q2, 4);
        const float rs = rsqrtf(q2 * (1.0f / 64) + EPS);
#pragma unroll
        for (int j = 0; j < 8; ++j) x[j] = siluf_(g[j]) * x[j] * rs * gn[j];
        *(v4u*)(BR + (size_t)r * D + 256 + 8 * lane) = pack8(x);
    }
}

constexpr int NQB_ATT = (L + 127) / 128;
constexpr int IT_LA = 32, IT_SS = IT_LA + DB * 8, IT_AT = IT_SS + 16 * NQB_ATT, IT_LS = IT_AT + 256, IT_CV = IT_LS + (MR + 63) / 64, IT_END = IT_CV;
__device__ __forceinline__ void n2_phase(const Ctx& C, int l, float lam_init, int qslot) {
    THREAD_IDS();
    const float lam = lam_of(C, l, lam_init);
    unsigned* qw = (unsigned*)(C.ws + WS_CTL) + CW_QUEUE + 64 * qslot;
    volatile LAS int* slot = (volatile LAS int*)(C.lds + MISC_OFF + 64);
    if (blockIdx.x < IT_LA) { const int it = blockIdx.x; const int b = (it >> 2) & 3, h = it & 3; if (it < 16) la_chunked<64, true>(C, l, false, b, h); else la_chunked<32, false>(C, l, false, b, h); }
#if defined(PROBE_ID)
    if (l == 0 && tid == 0) ((unsigned long long*)(C.ws + WS_CTL + 65536))[blockIdx.x * 16 + 3] = __builtin_amdgcn_s_memrealtime();
#endif
    for (;;) {
        if (tid == 0) slot[0] = (int)__hip_atomic_fetch_add(qw, 1u, __ATOMIC_RELAXED, __HIP_MEMORY_SCOPE_AGENT);
        __syncthreads();
        const int it = slot[0] + IT_LA;
        __syncthreads();
        if (it >= IT_END) break;
        if (it < IT_SS) { const int i2 = it - IT_LA; attn_sample_item(C, l, i2 >> 3, i2 & 7); }
        else if (it < IT_AT) { const int i2 = it - IT_SS; attn_prompt_item(C, l, (i2 & 15) >> 2, i2 & 3, NQB_ATT - 1 - (i2 >> 4), lam, lam_init); }
        else if (it < IT_LS) { const int i2 = it - IT_AT; const int b = (i2 >> 2) & 31, h = i2 & 3; if (i2 < 128) la_chunked<64, true>(C, l, true, b, h); else la_chunked<32, false>(C, l, true, b, h); }
        else { conv_rows_item(C, l, it - IT_LS); conv_state_item(C, l, it - IT_LS, IT_CV - IT_LS); }
    }
}

#ifndef PROBE_ID
#define PROBE_ID 0
#endif
#define TSTAMP(k) do { if (PROBE_ID && l == 0 && threadIdx.x == 0) { ((unsigned long long*)(C.ws + WS_CTL + 65536))[blockIdx.x * 16 + (k)] = __builtin_amdgcn_s_memrealtime(); } } while (0)
template <int l> __device__ __forceinline__ void layer_fwd(const Ctx& C, const XcdBarrier& bar) {
#define GRID_BAR() xcd_barrier<false>(bar)
    LAS unsigned char* ring = C.lds + RING_OFF;
    float* SS = WSP(float, WS_SS); float* H = WSP(float, WS_H); bf16* HB = WSP(bf16, WS_HB); bf16* ACT = WSP(bf16, WS_ACT); bf16* ZMIX = WSP(bf16, WS_ZMIX); bf16* GATES = WSP(bf16, WS_GATES);
    bf16* BR = WSP(bf16, WS_BR); bf16* MERGED = WSP(bf16, WS_MERGED);
    constexpr float lam_init = l == 0 ? 0.2f : 0.35550906759096926f;
    constexpr bool last = (l == DEPTH - 1);
    { pg8::Gemm g{HB, WSP(bf16, WS_W1 + (size_t)(l * 2 + 0) * SZ_W1), D, D, D}; pg8::StaticOrder S; S.init(M, 2 * DFF, C.G, (int)blockIdx.x);
      EpiGLU E{ACT, SS + (size_t)(l * 3 + 0) * M * 16}; pg8::gemm_phase<EpiGLU, pg8::StaticOrder, true, true>(ring, g, S, E); }
    GRID_BAR();
    { pg8::Gemm g{ACT, WSP(bf16, WS_WD + (size_t)(l * 2 + 0) * SZ_WD), DFF, DFF, DFF}; pg8::StaticOrder S; S.init(M, D, C.G, (int)blockIdx.x);
      EpiRes<false, 1> E{H, HB, SS + (size_t)(l * 3 + 1) * M * 16, nullptr}; pg8::gemm_phase<EpiRes<false, 1>, pg8::StaticOrder, true, true>(ring, g, S, E); }
    GRID_BAR();
    { pg8::Gemm g{HB, WSP(bf16, WS_WIN + (size_t)l * SZ_WIN), D, D, D}; pg8::StaticOrder S; S.init(M, NINP, C.G, (int)blockIdx.x);
      EpiZ E{ZMIX, GATES, SS + (size_t)(l * 3 + 1) * M * 16, WSP(float, WS_BINP) + l * NINP}; pg8::gemm_phase<EpiZ, pg8::StaticOrder, true, true>(ring, g, S, E); }
    GRID_BAR();
    TSTAMP(0);
    n1_prep(C, l);
    TSTAMP(1);
    GRID_BAR();
    TSTAMP(2);
    n2_phase(C, l, lam_init, l);
    TSTAMP(6);
    GRID_BAR();
    TSTAMP(7);
    n3_attn_sample_combine(C, l, lam_init);
    n3_la_finalize(C, l);
    TSTAMP(8);
    GRID_BAR();
    TSTAMP(9);
    { pg8::Gemm g{BR, WSP(bf16, WS_WBR + (size_t)l * SZ_WBR), D, 256, 256}; pg8::MergeOrder S; S.init(M, C.G, (int)blockIdx.x);
      EpiMerge E{MERGED, GATES}; pg8::gemm_phase<EpiMerge, pg8::MergeOrder, true, true>(ring, g, S, E); }
    GRID_BAR();
    { pg8::Gemm g{MERGED, WSP(bf16, WS_WOUT + (size_t)l * SZ_WOUT), D, D, D}; pg8::StaticOrder S; S.init(M, D, C.G, (int)blockIdx.x);
      EpiRes<false, 2> E{H, HB, SS + (size_t)(l * 3 + 2) * M * 16, nullptr}; pg8::gemm_phase<EpiRes<false, 2>, pg8::StaticOrder, true, true>(ring, g, S, E); }
    GRID_BAR();
    { pg8::Gemm g{HB, WSP(bf16, WS_W1 + (size_t)(l * 2 + 1) * SZ_W1), D, D, D}; pg8::StaticOrder S; S.init(M, 2 * DFF, C.G, (int)blockIdx.x);
      EpiGLU E{ACT, SS + (size_t)(l * 3 + 2) * M * 16}; pg8::gemm_phase<EpiGLU, pg8::StaticOrder, true, true>(ring, g, S, E); }
    GRID_BAR();
    { pg8::Gemm g{ACT, WSP(bf16, WS_WD + (size_t)(l * 2 + 1) * SZ_WD), DFF, DFF, DFF}; pg8::StaticOrder S; S.init(M, D, C.G, (int)blockIdx.x);
      EpiRes<last, 1> E{H, HB, last ? nullptr : SS + (size_t)((l + 1) * 3) * M * 16, C.out};
      pg8::gemm_phase<EpiRes<last, 1>, pg8::StaticOrder, true, true>(ring, g, S, E); }
#undef GRID_BAR
}

__global__ void __launch_bounds__(NWAVES * 64, 2) fwd(Params P) {
    extern __shared__ __attribute__((aligned(16))) unsigned char lds[];
    Ctx C;
    C.in = P.in; C.out = P.out; C.ws = P.ws; C.lds = (LAS unsigned char*)lds;
    C.G = gridDim.x;
    volatile LAS unsigned* MISC = (volatile LAS unsigned*)(C.lds + MISC_OFF);
    for (int u = threadIdx.x; u < (LDS_BYTES - LDSCTL_OFF) / 4; u += NWAVES * 64) ((LAS unsigned*)(C.lds + LDSCTL_OFF))[u] = 0u;
    __syncthreads();
    unsigned* ctl = (unsigned*)(C.ws + WS_CTL);
    XcdBarrier bar = xcd_barrier_post(ctl + CW_BAR, MISC + 8);
    p0_prologue(C, P);
#if PROBE_ID == 700001
    p0_prologue(C, P);
#endif
    xcd_barrier<true>(bar);
    layer_fwd<0>(C, bar);
    xcd_barrier<false>(bar);
    layer_fwd<1>(C, bar);
#if PROBE_ID
    xcd_barrier<false>(bar);
    if (blockIdx.x == 0 && threadIdx.x == 0) { const unsigned long long* ts = (const unsigned long long*)(C.ws + WS_CTL + 65536);
        const int pb = PROBE_ID / 1000, k0 = (PROBE_ID / 10) % 100 % 10, k1 = PROBE_ID % 10;
        float val = (float)(ts[pb * 16 + k1] - ts[pb * 16 + k0]) * 0.001f;
        C.out[O_YP] = val; }
#endif
}

extern "C" void kernel_launch(void* const* d_in, const int* in_sizes, int n_in, void* d_out, int out_size, void* d_ws, size_t ws_size, hipStream_t stream) {
    static int grid = 0;
    if (grid == 0) {
        if (n_in != N_INPUTS || (size_t)out_size != O_END || ws_size < WS_END) { fprintf(stderr, "kernel_launch: unexpected shapes: n_in %d out %d (want %zu) ws %zu (want %zu)\n", n_in, out_size, (size_t)O_END, ws_size, (size_t)WS_END); grid = -1; return; }
        int dev = 0, cus = 0, per_cu = 0;
        if (hipGetDevice(&dev) != hipSuccess || hipDeviceGetAttribute(&cus, hipDeviceAttributeMultiprocessorCount, dev) != hipSuccess) { grid = -1; return; }
        if (hipFuncSetAttribute((const void*)fwd, hipFuncAttributeMaxDynamicSharedMemorySize, LDS_BYTES) != hipSuccess) { fprintf(stderr, "kernel_launch: hipFuncSetAttribute failed\n"); grid = -1; return; }
        if (hipOccupancyMaxActiveBlocksPerMultiprocessor(&per_cu, (const void*)fwd, NWAVES * 64, LDS_BYTES) != hipSuccess || per_cu < 1) { fprintf(stderr, "kernel_launch: occupancy query says %d blocks per CU\n", per_cu); }
        (void)hipGetLastError();
        grid = cus;
    }
    if (grid < 0) return;
    if (hipMemsetAsync((char*)d_ws + WS_CTL, 0, CTL_ZERO_BYTES, stream) != hipSuccess) return;
    Params p{};
    for (int i = 0; i < N_INPUTS; ++i) p.in[i] = (const float*)d_in[i];
    p.out = (float*)d_out; p.ws = (unsigned char*)d_ws;
    for (int i = 0; i < 32; ++i) p.inv_freq[i] = (float)pow(10000.0, -(double)i / 32.0);
    hipLaunchKernelGGL(fwd, dim3(grid), dim3(NWAVES * 64), LDS_BYTES, stream, p);
}
```

```cpp
#include <hip/hip_runtime.h>
#include <cstdio>
#include <cstdint>
#include <cmath>

namespace pg8 {
#define PG8_LAS __attribute__((address_space(3)))
typedef unsigned short bf16_t;
typedef short bf16x8 __attribute__((ext_vector_type(8)));
typedef float f32x4 __attribute__((ext_vector_type(4)));
typedef unsigned u32x4 __attribute__((ext_vector_type(4)));
constexpr int BM = 256, BK = 64, HALF = 128, HTB = HALF * BK * 2  , STAGE_BYTES = 8 * HTB, NXCD = 8, WGM = 8;

__host__ __device__ __forceinline__ int lds_byte(int r, int c) { const int st = (r >> 4) * 2 + (c >> 5), rr = r & 15, cc = c & 31, ob = rr * 64 + cc * 2; return st * 1024 + (ob ^ (((ob >> 9) & 1) << 5)); }
__host__ __device__ __forceinline__ void stage_rc(int b, int& R, int& C) { const int st = b / 1024, sb = b % 1024, swz = sb ^ (((sb >> 9) & 1) << 5); R = (st >> 1) * 16 + swz / 64; C = (st & 1) * 32 + (swz % 64) / 2; }
__host__ __device__ __forceinline__ int perm32(int rho) { const int n = rho >> 4, i = rho & 15; return 8 * (i >> 2) + 4 * n + (i & 3); }

struct Unit { int pm, pn, acol, bcol; };
struct Gemm { const bf16_t* A; const bf16_t* Bt; int lda, ldb, K; };

struct StaticOrder {
    int nM, nN, nwg, G, c;
    __host__ __device__ void init(int M, int N, int G_, int c_) { nM = M / BM; nN = N / BM; nwg = nM * nN; G = G_; c = c_; }
    __host__ __device__ void unit_of(int L, Unit& u) const {
        int wgid = L; { const int q = nwg / NXCD, r = nwg % NXCD, xcd = wgid % NXCD, off = wgid / NXCD; wgid = (xcd < r ? xcd * (q + 1) : r * (q + 1) + (xcd - r) * q) + off; }
        const int nig = WGM * nN, gid = wgid / nig, fm = gid * WGM, gsz = (nM - fm) < WGM ? (nM - fm) : WGM;
        u.pm = fm + ((wgid % nig) % gsz); u.pn = (wgid % nig) / gsz; u.acol = 0; u.bcol = 0;
    }
    __host__ __device__ bool next(int i, Unit& u) const { const long L = (long)i * G + c; if (L >= nwg) return false; unit_of((int)L, u); return true; }
};
struct HeadOrder : StaticOrder { int limit; __host__ __device__ bool next(int i, Unit& u) const { const long L = (long)i * G + c; if (L >= limit || L >= nwg) return false; unit_of((int)L, u); return true; } };
struct TailOrder : StaticOrder { int limit, nsplit, kper;
    __host__ __device__ bool next(int i, Unit& u) const {
        if (i > 0 || c >= (nwg - limit) * nsplit) return false;
        unit_of(limit + c / nsplit, u); u.acol = u.bcol = (c % nsplit) * kper; return true; } };
struct MergeOrder {
    int ntile, G, c;
    __host__ __device__ void init(int M, int G_, int c_) { ntile = (M / BM) * 4; G = G_; c = c_; }
    __host__ __device__ bool next(int i, Unit& u) const {
        const int T = (i >> 2) * G + c; if (T >= ntile) return false;
        const int n = i & 3; u.pm = T >> 2; u.pn = n * 4 + (T & 3); u.acol = n * 256; u.bcol = 0; return true;
    }
};

__device__ __forceinline__ unsigned cvt_pk_bf16(float lo, float hi) { unsigned r; asm volatile("v_cvt_pk_bf16_f32 %0, %1, %2" : "=v"(r) : "v"(lo), "v"(hi)); return r; }

template <class Epi, class Sched, bool ALIGN_EPI = false, bool SP2 = false>
__device__ __forceinline__ void gemm_phase(PG8_LAS unsigned char* lds, const Gemm g, const Sched& S, const Epi& E) {
    int tid_ = threadIdx.x; asm volatile("" : "+v"(tid_));
    const int tid = tid_, wid = __builtin_amdgcn_readfirstlane(tid >> 6), lane = tid & 63, wr = wid >> 2, wc = wid & 3, fr = lane & 15, fq = lane >> 4;
    const int nt = g.K / BK;
    unsigned voffA[2], voffB[2];
#pragma unroll
    for (int i = 0; i < 2; ++i) { int R, C; stage_rc(tid * 16 + i * 8192, R, C); const int Rb = Epi::PERM ? ((R & ~31) + perm32(R & 31)) : R;
        voffA[i] = (unsigned)(R * g.lda + C) * 2u; voffB[i] = (unsigned)(Rb * g.ldb + C) * 2u; }
    const size_t kstep = (size_t)(BK * 2);
    const size_t hstepA = (size_t)HALF * g.lda * 2, hstepB = (size_t)HALF * g.ldb * 2;
    const size_t tstepA = 2 * hstepA, tstepB = 2 * hstepB;
    const unsigned ldsw = (unsigned)wid * 1024u;
    const int aoff = lds_byte(wr * 64 + fr, fq * 8), boff = lds_byte(wc * 32 + fr, fq * 8);
#define PG8_SA(b, h) (((b) * 2 + (h)) * HTB)
#define PG8_SB(b, h) ((4 + (b) * 2 + (h)) * HTB)
#define PG8_STAGE(bufoff, gbase, voff) do { _Pragma("unroll") for (int _i = 0; _i < 2; ++_i) \
        __builtin_amdgcn_global_load_lds((const unsigned*)((const char*)(gbase) + (voff)[_i]), (PG8_LAS unsigned*)(lds + (bufoff) + ldsw + _i * 8192), 16, 0, 0); } while (0)
#define PG8_LDA(dst, b, h) do { _Pragma("unroll") for (int m = 0; m < 4; ++m) _Pragma("unroll") for (int k = 0; k < 2; ++k) dst[m][k] = *(const PG8_LAS bf16x8*)(lds + PG8_SA(b, h) + aoff + m * 2048 + k * 1024); } while (0)
#define PG8_LDB(dst, b, h) do { _Pragma("unroll") for (int n = 0; n < 2; ++n) _Pragma("unroll") for (int k = 0; k < 2; ++k) dst[n][k] = *(const PG8_LAS bf16x8*)(lds + PG8_SB(b, h) + boff + n * 2048 + k * 1024); } while (0)
#define PG8_MMA(ai, bj, At, Bt) do { __builtin_amdgcn_s_setprio(1); _Pragma("unroll") for (int m = 0; m < 4; ++m) _Pragma("unroll") for (int n = 0; n < 2; ++n) _Pragma("unroll") for (int k = 0; k < 2; ++k) \
        acc[ai][bj][m][n] = __builtin_amdgcn_mfma_f32_16x16x32_bf16(Bt[n][k], At[m][k], acc[ai][bj][m][n], 0, 0, 0); __builtin_amdgcn_s_setprio(0); } while (0)
#define PG8_WAIT_V(n) asm volatile("s_waitcnt vmcnt(" #n ")" ::: "memory")
#define PG8_WAIT_L(n) asm volatile("s_waitcnt lgkmcnt(" #n ")" ::: "memory")
#define PG8_BAR __builtin_amdgcn_s_barrier()
#define PG8_SCHED __builtin_amdgcn_sched_barrier(0)
    Unit cur, nxt; int ui = 0;
    if (!S.next(0, cur)) return;
    f32x4 acc[2][2][4][2];
#pragma unroll
    for (int a = 0; a < 2; ++a)
#pragma unroll
        for (int b = 0; b < 2; ++b)
#pragma unroll
            for (int m = 0; m < 4; ++m)
#pragma unroll
                for (int n = 0; n < 2; ++n) acc[a][b][m][n] = (f32x4){0.f, 0.f, 0.f, 0.f};
    bf16x8 At[4][2], B0[2][2], B1[2][2];
    const char* cA = (const char*)g.A + (size_t)cur.pm * tstepA + (size_t)cur.acol * 2; const char* cB = (const char*)g.Bt + (size_t)cur.pn * tstepB + (size_t)cur.bcol * 2;
    if constexpr (SP2) {
        PG8_STAGE(PG8_SB(0, 0), cB, voffB); PG8_STAGE(PG8_SB(0, 1), cB + hstepB, voffB); PG8_STAGE(PG8_SA(0, 0), cA, voffA); PG8_STAGE(PG8_SA(0, 1), cA + hstepA, voffA);
        if (wr == 1) PG8_BAR;
        PG8_WAIT_V(2); PG8_BAR;
        PG8_STAGE(PG8_SB(1, 0), cB + kstep, voffB); PG8_STAGE(PG8_SA(1, 0), cA + kstep, voffA); PG8_STAGE(PG8_SB(1, 1), cB + hstepB + kstep, voffB);
        PG8_WAIT_V(6); PG8_BAR;
    } else {
        PG8_STAGE(PG8_SB(0, 0), cB, voffB); PG8_STAGE(PG8_SA(0, 0), cA, voffA); PG8_STAGE(PG8_SB(0, 1), cB + hstepB, voffB); PG8_STAGE(PG8_SA(0, 1), cA + hstepA, voffA);
        if (wr == 1) PG8_BAR;
        PG8_WAIT_V(4); PG8_BAR;
        PG8_STAGE(PG8_SB(1, 0), cB + kstep, voffB); PG8_STAGE(PG8_SA(1, 0), cA + kstep, voffA); PG8_STAGE(PG8_SB(1, 1), cB + hstepB + kstep, voffB);
        PG8_WAIT_V(6); PG8_BAR;
    }
    for (;;) {
        const bool has_next = S.next(ui + 1, nxt);
        const char* nA = has_next ? (const char*)g.A + (size_t)nxt.pm * tstepA + (size_t)nxt.acol * 2 : cA; const char* nB = has_next ? (const char*)g.Bt + (size_t)nxt.pn * tstepB + (size_t)nxt.bcol * 2 : cB;
        for (int t = 0; t < nt; t += 2) {
            const bool last = (t == nt - 2);
            const char* a1 = cA + (size_t)(t + 1) * kstep;
            const char* a2 = last ? nA : cA + (size_t)(t + 2) * kstep; const char* b2 = last ? nB : cB + (size_t)(t + 2) * kstep;
            const char* a3 = a2 + kstep; const char* b3 = b2 + kstep;
            if constexpr (SP2) {
            PG8_LDB(B0, 0, 0); PG8_LDB(B1, 0, 1); PG8_SCHED; PG8_LDA(At, 0, 0); PG8_STAGE(PG8_SA(1, 1), a1 + hstepA, voffA);
            PG8_WAIT_V(8); PG8_WAIT_L(0); PG8_BAR; PG8_MMA(0, 0, At, B0); PG8_MMA(0, 1, At, B1); PG8_BAR; PG8_SCHED;
            PG8_LDA(At, 0, 1); PG8_STAGE(PG8_SB(0, 0), b2, voffB); PG8_STAGE(PG8_SB(0, 1), b2 + hstepB, voffB); PG8_STAGE(PG8_SA(0, 0), a2, voffA);
            PG8_WAIT_V(8); PG8_WAIT_L(0); PG8_BAR; PG8_MMA(1, 0, At, B0); PG8_MMA(1, 1, At, B1); PG8_BAR; PG8_SCHED;
            PG8_LDB(B0, 1, 0); PG8_LDB(B1, 1, 1); PG8_SCHED; PG8_LDA(At, 1, 0); PG8_STAGE(PG8_SA(0, 1), a2 + hstepA, voffA);
            PG8_WAIT_V(8); PG8_WAIT_L(0); PG8_BAR; PG8_MMA(0, 0, At, B0); PG8_MMA(0, 1, At, B1); PG8_BAR; PG8_SCHED;
            PG8_LDA(At, 1, 1); PG8_STAGE(PG8_SB(1, 0), b3, voffB); PG8_STAGE(PG8_SB(1, 1), b3 + hstepB, voffB); PG8_STAGE(PG8_SA(1, 0), a3, voffA);
            PG8_WAIT_V(8); PG8_WAIT_L(0); PG8_BAR; PG8_MMA(1, 0, At, B0); PG8_MMA(1, 1, At, B1); PG8_BAR; PG8_SCHED;
            } else {
            PG8_LDB(B0, 0, 0); PG8_SCHED; PG8_LDA(At, 0, 0); PG8_STAGE(PG8_SA(1, 1), a1 + hstepA, voffA);
            PG8_WAIT_L(8); PG8_BAR; PG8_WAIT_L(0); PG8_MMA(0, 0, At, B0); PG8_BAR; PG8_SCHED;
            PG8_LDB(B1, 0, 1); PG8_STAGE(PG8_SB(0, 0), b2, voffB);
            PG8_BAR; PG8_WAIT_L(0); PG8_MMA(0, 1, At, B1); PG8_BAR;
            PG8_LDA(At, 0, 1); PG8_STAGE(PG8_SA(0, 0), a2, voffA);
            PG8_BAR; PG8_WAIT_L(0); PG8_MMA(1, 0, At, B0); PG8_BAR; PG8_SCHED;
            PG8_STAGE(PG8_SB(0, 1), b2 + hstepB, voffB);
            PG8_WAIT_V(6); PG8_BAR; PG8_MMA(1, 1, At, B1); PG8_BAR;
            PG8_LDB(B0, 1, 0); PG8_SCHED; PG8_LDA(At, 1, 0); PG8_STAGE(PG8_SA(0, 1), a2 + hstepA, voffA);
            PG8_WAIT_L(8); PG8_BAR; PG8_WAIT_L(0); PG8_MMA(0, 0, At, B0); PG8_BAR; PG8_SCHED;
            PG8_LDB(B1, 1, 1); PG8_STAGE(PG8_SB(1, 0), b3, voffB);
            PG8_BAR; PG8_WAIT_L(0); PG8_MMA(0, 1, At, B1); PG8_BAR;
            PG8_LDA(At, 1, 1); PG8_STAGE(PG8_SA(1, 0), a3, voffA);
            PG8_BAR; PG8_WAIT_L(0); PG8_MMA(1, 0, At, B0); PG8_BAR; PG8_SCHED;
            PG8_STAGE(PG8_SB(1, 1), b3 + hstepB, voffB);
            PG8_WAIT_V(6); PG8_BAR; PG8_MMA(1, 1, At, B1); PG8_BAR;
            }
        }
        if constexpr (ALIGN_EPI) { if (wr == 0) PG8_BAR; }
        E(acc, cur, wr, wc, fr, fq);
        if (!has_next) break;
#pragma unroll
        for (int a = 0; a < 2; ++a)
#pragma unroll
            for (int b = 0; b < 2; ++b)
#pragma unroll
                for (int m = 0; m < 4; ++m)
#pragma unroll
                    for (int n = 0; n < 2; ++n) acc[a][b][m][n] = (f32x4){0.f, 0.f, 0.f, 0.f};
        cur = nxt; cA = nA; cB = nB; ++ui;
        if constexpr (ALIGN_EPI) { if (wr == 1) PG8_BAR; }
    }
    PG8_WAIT_V(0);
    if constexpr (!ALIGN_EPI) { if (wr == 0) PG8_BAR; }
    PG8_BAR;
#undef PG8_SA
#undef PG8_SB
#undef PG8_STAGE
#undef PG8_LDA
#undef PG8_LDB
#undef PG8_MMA
#undef PG8_WAIT_V
#undef PG8_WAIT_L
#undef PG8_BAR
#undef PG8_SCHED
}
}

constexpr int NWAVES = 8;
constexpr int D = 1024, DFF = 2816, NIN = 7184, NMIX = 3088, NMIXP = 3328, NGATE = 4096, NINP = NMIXP + NGATE;
constexpr int SEQ = 4096, NMETA = 16, L = SEQ + NMETA, BATCH = 4, DB = 32, DS = 8, PAST = 8192, PAGE = 128, NPAGES = PAST / PAGE, NPOOL = 2560, DEPTH = 2;
constexpr int MP = BATCH * L, MS = DB * DS, MR = MP + MS, M = 16896;
constexpr int NPOS = L + DS;
constexpr float EPS = 1e-6f;
constexpr int C_A = 0, C_G = 256, R_Q = 512, R_K = 768, R_V = 1024, R_G = 1280, G_Q = 1536, G_K = 1664, G_V = 1792, G_R = 2048, G_LOW = 2304, D_Q = 2320, D_K = 2576, D_V = 2832;
constexpr size_t O_YP = 0, O_YS = O_YP + (size_t)BATCH * SEQ * D, O_KP = O_YS + (size_t)MS * D, O_VP = O_KP + (size_t)DEPTH * MP * 256, O_KS = O_VP + (size_t)DEPTH * MP * 256,
                 O_VS = O_KS + (size_t)DEPTH * MS * 256, O_RP = O_VS + (size_t)DEPTH * MS * 256, O_RS = O_RP + (size_t)DEPTH * BATCH * 4 * 64 * 64, O_GP = O_RS + (size_t)DEPTH * DB * 4 * 64 * 64,
                 O_GS = O_GP + (size_t)DEPTH * BATCH * 4 * 32 * 64, O_CP = O_GS + (size_t)DEPTH * DB * 4 * 32 * 64, O_CS = O_CP + (size_t)DEPTH * BATCH * 30 * 256, O_END = O_CS + (size_t)DEPTH * DB * 30 * 256;
enum { I_XP = 0, I_XS, I_CK, I_CV, I_PT, I_SRET, I_SGLA, I_SCONV, I_META, I_RELB, I_NF1, I_F1G, I_F1U, I_F1D, I_NMIX, I_WIN, I_BIN, I_CW, I_CB, I_CLG, I_CLB, I_RGN, I_GAW, I_GAB, I_GGN,
       I_QN, I_KN, I_LQ1, I_LK1, I_LQ2, I_LK2, I_SUBLN, I_WBR, I_WOUT, I_NF2, I_F2G, I_F2U, I_F2D, N_INPUTS };

constexpr size_t MiB = 1u << 20;
constexpr size_t WS_CTL = 0, CTL_ZERO_BYTES = 1 * MiB;
constexpr size_t SZ_SS = (size_t)M * 16 * 4;
constexpr size_t SZ_W1 = (size_t)2 * DFF * D * 2, SZ_WD = (size_t)D * DFF * 2, SZ_WIN = (size_t)NINP * D * 2, SZ_WBR = (size_t)4 * D * 256 * 2, SZ_WOUT = (size_t)D * D * 2;
constexpr size_t WS_W1 = 4 * MiB;
constexpr size_t WS_WD = WS_W1 + 4 * SZ_W1;
constexpr size_t WS_WIN = WS_WD + 4 * SZ_WD;
constexpr size_t WS_WBR = WS_WIN + 2 * SZ_WIN;
constexpr size_t WS_WOUT = WS_WBR + 2 * SZ_WBR;
constexpr size_t WS_BINP = WS_WOUT + 2 * SZ_WOUT;
constexpr size_t WS_ROPE = WS_BINP + 64 * 1024;
constexpr size_t WS_SS = WS_ROPE + 2 * MiB;
constexpr size_t WS_H = 128 * MiB;
constexpr size_t WS_HB = WS_H + (size_t)M * D * 4;
constexpr size_t WS_ACT = WS_HB + (size_t)M * D * 2;
constexpr size_t WS_ZMIX = WS_ACT + (size_t)M * DFF * 2;
constexpr size_t WS_GATES = WS_ZMIX + (size_t)M * NMIXP * 2;
constexpr size_t WS_BR = WS_GATES + (size_t)M * NGATE * 2;
constexpr size_t WS_MERGED = WS_BR + (size_t)M * D * 2;
constexpr size_t WS_UBUF = WS_MERGED + (size_t)M * D * 2;
constexpr size_t WS_RQ = WS_UBUF + (size_t)M * 256 * 4, WS_RK = WS_RQ + (size_t)M * 256 * 4, WS_QN = WS_RK + (size_t)M * 256 * 4, WS_KN = WS_QN + (size_t)M * 256 * 4, WS_VB = WS_KN + (size_t)M * 256 * 4;
constexpr size_t WS_LDEC = WS_VB + (size_t)M * 256 * 4;
constexpr size_t WS_QNB = WS_LDEC + (size_t)M * 128 * 4;
constexpr size_t WS_KNB = WS_QNB + (size_t)M * 256 * 2;
constexpr size_t WS_PART = WS_KNB + (size_t)M * 256 * 2;
constexpr size_t WS_LAO = WS_PART + (size_t)DB * 4 * 16 * 16 * 68 * 4;
constexpr size_t WS_KSP = WS_LAO + (size_t)M * 512 * 4;
constexpr size_t WS_END = WS_KSP + (size_t)8 * 11 * 65536 * 4;
static_assert(WS_ROPE + 2 * NPOS * 32 * 4 <= WS_SS && WS_SS + 6 * SZ_SS <= WS_H, "weights region overflows");
constexpr int CW_BAR = 4096, CW_QUEUE = 8192;

constexpr int RING_OFF = 0, RING_BYTES = 131072;
constexpr int LDSCTL_OFF = 144384, MISC_OFF = LDSCTL_OFF + 320;
constexpr int LDS_BYTES = 147456;
static_assert(MISC_OFF + 128 <= LDS_BYTES, "LDS map");

#define GAS __attribute__((address_space(1)))
#define LAS __attribute__((address_space(3)))
typedef unsigned short bf16;
typedef unsigned v4u __attribute__((ext_vector_type(4)));
typedef float f32x4 __attribute__((ext_vector_type(4)));
#define LDS_WAIT() asm volatile("s_waitcnt lgkmcnt(0)" ::: "memory")
#define VM_WAIT() asm volatile("s_waitcnt vmcnt(0)" ::: "memory")
__device__ __forceinline__ unsigned f2bf(float f) { unsigned u = __builtin_bit_cast(unsigned, f); return (u + 0x7fffu + ((u >> 16) & 1u)) >> 16; }
__device__ __forceinline__ unsigned pk2(float lo, float hi) { return f2bf(lo) | (f2bf(hi) << 16); }
__device__ __forceinline__ float bf2f(bf16 b) { return __builtin_bit_cast(float, ((unsigned)b) << 16); }
__device__ __forceinline__ float bflo(unsigned w) { return __builtin_bit_cast(float, w << 16); }
__device__ __forceinline__ float bfhi(unsigned w) { return __builtin_bit_cast(float, w & 0xffff0000u); }
__device__ __forceinline__ float wave_sum(float v) {
#pragma unroll
    for (int o = 1; o < 64; o <<= 1) v += __shfl_xor(v, o);
    return v;
}
__device__ __forceinline__ float sigmoidf_(float x) { return __builtin_amdgcn_rcpf(1.0f + __expf(-x)); }
__device__ __forceinline__ float siluf_(float x) { return x * __builtin_amdgcn_rcpf(1.0f + __expf(-x)); }

#define XB_TMO      128
#define XB_XCNT(j)  (256  + 64 * (j))
#define XB_XSUB(j)  (1280 + 64 * (j))
#define XB_XGEN(j)  (2304 + 64 * (j))
#define XB_TOP      3328
#define XB_TOPGEN   3392
#define XCD_BAR_WORDS 3456
#define XB_SPIN_CAP (1u << 22)

__device__ __forceinline__ unsigned xb_ld(unsigned* p)              { return __hip_atomic_load(p, __ATOMIC_RELAXED, __HIP_MEMORY_SCOPE_AGENT); }
__device__ __forceinline__ unsigned xb_add(unsigned* p, unsigned v) { return __hip_atomic_fetch_add(p, v, __ATOMIC_RELAXED, __HIP_MEMORY_SCOPE_AGENT); }
__device__ __forceinline__ unsigned xb_xcc_id() { return (unsigned)__builtin_amdgcn_s_getreg((3 << 11) | 20) & 0xFu; }
#define XB_SPIN(cond, bar) do { unsigned _sp = 0; while (cond) { __builtin_amdgcn_s_sleep(1); \
    if ((++_sp & 255u) == 0u) { if (xb_ld(&(bar)[XB_TMO])) break; if (_sp > XB_SPIN_CAP) { atomicAdd(&(bar)[XB_TMO], 1u); break; } } } } while (0)

struct XcdBarrier { unsigned* bar; unsigned x; volatile LAS unsigned* st; };

__device__ __forceinline__ XcdBarrier xcd_barrier_post(unsigned* bar, volatile LAS unsigned* st) {
    XcdBarrier b; b.bar = bar; b.x = xb_xcc_id(); b.st = st;
    if (threadIdx.x == 0) (void)xb_add(&bar[XB_XCNT(b.x)], 1u);
    return b;
}
__device__ __forceinline__ void xcd_barrier_complete(unsigned* bar, unsigned x, unsigned& nloc, unsigned& nx) {
    const unsigned G = gridDim.x * gridDim.y * gridDim.z;
    unsigned sum, cnt, mine, sp = 0u;
    for (;;) {
        sum = 0u; cnt = 0u; mine = 0u;
#pragma unroll
        for (unsigned j = 0; j < 16; ++j) { const unsigned c = xb_ld(&bar[XB_XCNT(j)]); sum += c; cnt += (c > 0u) ? 1u : 0u; mine = (j == x) ? c : mine; }
        if (sum == G) break;
        __builtin_amdgcn_s_sleep(1);
        if ((++sp & 255u) == 0u) { if (xb_ld(&bar[XB_TMO])) break; if (sp > XB_SPIN_CAP) { atomicAdd(&bar[XB_TMO], 1u); break; } }
    }
    nloc = mine > 0u ? mine : 1u; nx = cnt > 0u ? cnt : 1u;
}
template <bool FIRST> __device__ __forceinline__ void xcd_barrier(const XcdBarrier& b) {
    asm volatile("s_waitcnt vmcnt(0)" ::: "memory");
    __syncthreads();
    if (threadIdx.x == 0) {
        unsigned* bar = b.bar;
        asm volatile("" : "+s"(bar));
        __builtin_amdgcn_s_waitcnt(0);
        unsigned nloc = b.st[0], nx = b.st[1];
        if (FIRST) { if (nloc == 0u) { xcd_barrier_complete(bar, b.x, nloc, nx); b.st[0] = nloc; b.st[1] = nx; } }
        const unsigned old = xb_add(&bar[XB_XSUB(b.x)], 1u);
        const unsigned gen = old / nloc;
        if (old + 1u == (gen + 1u) * nloc) {
            __builtin_amdgcn_fence(__ATOMIC_RELEASE, "agent");
            asm volatile("s_waitcnt vmcnt(0)" ::: "memory");
            const unsigned og = xb_add(&bar[XB_TOP], 1u);
            const unsigned tg = og / nx;
            if (og + 1u == (tg + 1u) * nx) xb_add(&bar[XB_TOPGEN], 1u);
            else XB_SPIN(xb_ld(&bar[XB_TOPGEN]) == tg, bar);
            __builtin_amdgcn_fence(__ATOMIC_ACQUIRE, "agent");
            xb_add(&bar[XB_XGEN(b.x)], 1u);
            asm volatile("s_waitcnt vmcnt(0)" ::: "memory");
        } else {
            XB_SPIN(xb_ld(&bar[XB_XGEN(b.x)]) == gen, bar);
            __builtin_amdgcn_fence(__ATOMIC_ACQUIRE, "agent");
            asm volatile("s_waitcnt vmcnt(0)" ::: "memory");
        }
    }
    __syncthreads();
}

struct Params { const float* in[N_INPUTS]; float* out; unsigned char* ws; float inv_freq[32]; };
static_assert(sizeof(Params) == N_INPUTS * 8 + 16 + 128, "Params has no padding");

struct Ctx {
    const float* const* in; float* out; unsigned char* ws;
    LAS unsigned char* lds;
    int G;
};
#define THREAD_IDS() int tid_ = threadIdx.x; asm volatile("" : "+v"(tid_)); const int tid = tid_, lane = tid & 63, wave = __builtin_amdgcn_readfirstlane(tid >> 6), gw = blockIdx.x * NWAVES + wave, NGW = C.G * NWAVES; (void)tid; (void)lane; (void)wave; (void)gw; (void)NGW
#define WSP(T, off) ((T*)(C.ws + (off)))

__device__ __forceinline__ float rstd_of(const float* ssp, int row) {
    const f32x4 a = *(const f32x4*)(ssp + (size_t)row * 16), b = *(const f32x4*)(ssp + (size_t)row * 16 + 4), c = *(const f32x4*)(ssp + (size_t)row * 16 + 8), d = *(const f32x4*)(ssp + (size_t)row * 16 + 12);
    const float s = (((a[0] + a[1]) + (a[2] + a[3])) + ((b[0] + b[1]) + (b[2] + b[3]))) + (((c[0] + c[1]) + (c[2] + c[3])) + ((d[0] + d[1]) + (d[2] + d[3])));
    return rsqrtf(s * (1.0f / D) + EPS);
}
#define EPI_IDS() int t_ = threadIdx.x; asm volatile("" : "+v"(t_)); const int wid_ = __builtin_amdgcn_readfirstlane(t_ >> 6), wr = wid_ >> 2, wc = wid_ & 3, fr = t_ & 15, fq = (t_ & 63) >> 4
struct EpiGLU {
    static constexpr bool PERM = true;
    bf16* act; const float* ss;
    __device__ __forceinline__ void operator()(const pg8::f32x4 (&acc)[2][2][4][2], const pg8::Unit& u, int, int, int, int) const {
        EPI_IDS();
        const int row0 = u.pm * 256 + wr * 64 + fr, col0 = u.pn * 128 + wc * 32 + 8 * fq;
#pragma unroll
        for (int ai = 0; ai < 2; ++ai)
#pragma unroll
            for (int m = 0; m < 4; ++m) {
                const int row = row0 + ai * 128 + m * 16; const float rstd = rstd_of(ss, row);
                float o[8];
#pragma unroll
                for (int n = 0; n < 2; ++n)
#pragma unroll
                    for (int j = 0; j < 4; ++j) { const float g = acc[ai][0][m][n][j] * rstd, up = acc[ai][1][m][n][j] * rstd; o[n * 4 + j] = siluf_(g) * up; }
                v4u w; w.x = pg8::cvt_pk_bf16(o[0], o[1]); w.y = pg8::cvt_pk_bf16(o[2], o[3]); w.z = pg8::cvt_pk_bf16(o[4], o[5]); w.w = pg8::cvt_pk_bf16(o[6], o[7]);
                *(v4u*)(act + (size_t)row * DFF + col0) = w;
            }
    }
};
template <bool FINAL, int SCALE2> struct EpiRes {
    static constexpr bool PERM = true;
    float* h; bf16* hb; float* ssout; float* out;
    __device__ __forceinline__ void rowgroup(const pg8::f32x4 (&a)[2][2], int row, int col0, int pn, int wc, int fq) const {
        constexpr float scale = 0.5f * SCALE2; float sq = 0.f;
        long yoff = -1;
        if (FINAL) { if (row < MP) { const int b = row / L, pos = row - b * L; if (pos >= NMETA) yoff = (long)O_YP + ((long)b * SEQ + (pos - NMETA)) * D; } else if (row < MR) yoff = (long)O_YS + (long)(row - MP) * D; }
#pragma unroll
        for (int bj = 0; bj < 2; ++bj) {
            const size_t off = (size_t)row * D + col0 + bj * 128;
            f32x4 h0 = *(const f32x4*)(h + off), h1 = *(const f32x4*)(h + off + 4);
            h0 = h0 + a[bj][0] * scale; h1 = h1 + a[bj][1] * scale;
            *(f32x4*)(h + off) = h0; *(f32x4*)(h + off + 4) = h1;
            v4u w; w.x = pg8::cvt_pk_bf16(h0[0], h0[1]); w.y = pg8::cvt_pk_bf16(h0[2], h0[3]); w.z = pg8::cvt_pk_bf16(h1[0], h1[1]); w.w = pg8::cvt_pk_bf16(h1[2], h1[3]);
            *(v4u*)(hb + off) = w;
            sq += (h0[0] * h0[0] + h0[1] * h0[1]) + (h0[2] * h0[2] + h0[3] * h0[3]) + (h1[0] * h1[0] + h1[1] * h1[1]) + (h1[2] * h1[2] + h1[3] * h1[3]);
            if (FINAL && yoff >= 0) { *(f32x4*)(out + yoff + col0 + bj * 128) = h0; *(f32x4*)(out + yoff + col0 + bj * 128 + 4) = h1; }
        }
        sq += __shfl_xor(sq, 16); sq += __shfl_xor(sq, 32);
        if (fq == 0 && ssout) ssout[(size_t)row * 16 + pn * 4 + wc] = sq;
    }
    __device__ __forceinline__ void operator()(const pg8::f32x4 (&acc)[2][2][4][2], const pg8::Unit& u, int, int, int, int) const {
        EPI_IDS();
        const int row0 = u.pm * 256 + wr * 64 + fr, col0 = u.pn * 256 + wc * 32 + 8 * fq;
#pragma unroll
        for (int ai = 0; ai < 2; ++ai)
#pragma unroll
            for (int m = 0; m < 4; ++m) {
                const pg8::f32x4 a[2][2] = {{acc[ai][0][m][0], acc[ai][0][m][1]}, {acc[ai][1][m][0], acc[ai][1][m][1]}};
                rowgroup(a, row0 + ai * 128 + m * 16, col0, u.pn, wc, fq);
                asm volatile("" ::: "memory");
            }
    }
};
struct EpiZ {
    static constexpr bool PERM = true;
    bf16* zmix; bf16* gates; const float* ss; const float* bias;
    __device__ __forceinline__ void operator()(const pg8::f32x4 (&acc)[2][2][4][2], const pg8::Unit& u, int, int, int, int) const {
        EPI_IDS();
        const int row0 = u.pm * 256 + wr * 64 + fr, col0 = u.pn * 256 + wc * 32 + 8 * fq; const bool isgate = u.pn >= NMIXP / 256;
        f32x4 bv[2][2];
#pragma unroll
        for (int bj = 0; bj < 2; ++bj)
#pragma unroll
            for (int n = 0; n < 2; ++n) bv[bj][n] = *(const f32x4*)(bias + col0 + bj * 128 + 4 * n);
#pragma unroll
        for (int ai = 0; ai < 2; ++ai)
#pragma unroll
            for (int m = 0; m < 4; ++m) {
                const int row = row0 + ai * 128 + m * 16; const float rstd = rstd_of(ss, row);
#pragma unroll
                for (int bj = 0; bj < 2; ++bj) {
                    f32x4 v0 = acc[ai][bj][m][0] * rstd + bv[bj][0], v1 = acc[ai][bj][m][1] * rstd + bv[bj][1];
                    if (isgate) {
#pragma unroll
                        for (int j = 0; j < 4; ++j) { v0[j] = sigmoidf_(v0[j]); v1[j] = sigmoidf_(v1[j]); } }
                    v4u w; w.x = pg8::cvt_pk_bf16(v0[0], v0[1]); w.y = pg8::cvt_pk_bf16(v0[2], v0[3]); w.z = pg8::cvt_pk_bf16(v1[0], v1[1]); w.w = pg8::cvt_pk_bf16(v1[2], v1[3]);
                    if (isgate) *(v4u*)(gates + (size_t)row * NGATE + (col0 - NMIXP) + bj * 128) = w;
                    else *(v4u*)(zmix + (size_t)row * NMIXP + col0 + bj * 128) = w;
                }
            }
    }
};
struct EpiMerge {
    static constexpr bool PERM = true;
    bf16* merged; const bf16* gates;
    __device__ __forceinline__ void operator()(const pg8::f32x4 (&acc)[2][2][4][2], const pg8::Unit& u, int, int, int, int) const {
        EPI_IDS();
        const int n = u.pn >> 2, dt = u.pn & 3;
        const int row0 = u.pm * 256 + wr * 64 + fr, col0 = dt * 256 + wc * 32 + 8 * fq;
#pragma unroll
        for (int ai = 0; ai < 2; ++ai)
#pragma unroll
            for (int m = 0; m < 4; ++m) {
                const int row = row0 + ai * 128 + m * 16;
#pragma unroll
                for (int bj = 0; bj < 2; ++bj) {
                    const v4u gw = *(const v4u*)(gates + (size_t)row * NGATE + n * D + col0 + bj * 128);
                    bf16* mp = merged + (size_t)row * D + col0 + bj * 128;
                    float o[8];
                    o[0] = acc[ai][bj][m][0][0] * bflo(gw.x); o[1] = acc[ai][bj][m][0][1] * bfhi(gw.x); o[2] = acc[ai][bj][m][0][2] * bflo(gw.y); o[3] = acc[ai][bj][m][0][3] * bfhi(gw.y);
                    o[4] = acc[ai][bj][m][1][0] * bflo(gw.z); o[5] = acc[ai][bj][m][1][1] * bfhi(gw.z); o[6] = acc[ai][bj][m][1][2] * bflo(gw.w); o[7] = acc[ai][bj][m][1][3] * bfhi(gw.w);
                    if (n > 0) { const v4u pw = *(const v4u*)mp;
                        o[0] += bflo(pw.x); o[1] += bfhi(pw.x); o[2] += bflo(pw.y); o[3] += bfhi(pw.y); o[4] += bflo(pw.z); o[5] += bfhi(pw.z); o[6] += bflo(pw.w); o[7] += bfhi(pw.w); }
                    v4u w; w.x = pg8::cvt_pk_bf16(o[0], o[1]); w.y = pg8::cvt_pk_bf16(o[2], o[3]); w.z = pg8::cvt_pk_bf16(o[4], o[5]); w.w = pg8::cvt_pk_bf16(o[6], o[7]);
                    *(v4u*)mp = w;
                }
                asm volatile("" ::: "memory");
            }
    }
};

struct EpiPartial {
    static constexpr bool PERM = true;
    float* part;
    __device__ __forceinline__ void operator()(const pg8::f32x4 (&acc)[2][2][4][2], const pg8::Unit& u, int, int, int, int) const {
        int t_ = threadIdx.x; asm volatile("" : "+v"(t_));
        const int slot = blockIdx.x;
        float* p = part + (size_t)slot * 65536 + (size_t)t_ * 4;
#pragma unroll
        for (int ai = 0; ai < 2; ++ai)
#pragma unroll
            for (int bj = 0; bj < 2; ++bj)
#pragma unroll
                for (int m = 0; m < 4; ++m)
#pragma unroll
                    for (int n = 0; n < 2; ++n) *(pg8::f32x4*)(p + (size_t)((((ai * 2 + bj) * 4 + m) * 2 + n) * 2048)) = acc[ai][bj][m][n];
        (void)u;
    }
};
template <int NSPLIT, class Epi> __device__ __forceinline__ void ksp_finalize(const float* part, const pg8::StaticOrder& so, int limit, const Epi& E) {
    const int ntail = so.nwg - limit;
    for (int it = blockIdx.x; it < ntail * 8; it += gridDim.x) {
        const int tt = it >> 3, ai = (it >> 2) & 1, m = it & 3;
        EPI_IDS();
        pg8::f32x4 a[2][2];
#pragma unroll
        for (int bj = 0; bj < 2; ++bj)
#pragma unroll
            for (int n = 0; n < 2; ++n) { pg8::f32x4 s = {0.f, 0.f, 0.f, 0.f};
#pragma unroll
                for (int k = 0; k < NSPLIT; ++k) s = s + *(const pg8::f32x4*)(part + (size_t)(tt * NSPLIT + k) * 65536 + (size_t)((((ai * 2 + bj) * 4 + m) * 2 + n) * 2048) + (size_t)t_ * 4);
                a[bj][n] = s; }
        pg8::Unit u; so.unit_of(limit + tt, u);
        E.rowgroup(a, u.pm * 256 + wr * 64 + fr + ai * 128 + m * 16, u.pn * 256 + wc * 32 + 8 * fq, u.pn, wc, fq);
    }
}

struct RowMap { int mode, a; __device__ __forceinline__ int operator()(int n) const { return mode == 0 ? n + a : (mode == 1 ? 256 * (n >> 7) + (n & 127) + a : (n < NMIX ? n : n + (NMIXP - NMIX))); } };
__device__ __forceinline__ void tr_item(const float* W, int K, int N, const float* gain, bf16* WT, int pitch, RowMap rm, LAS float* scr, int kb, int nb, int lane) {
    const int k0 = 64 * kb, n0 = 64 * nb; const int nn = n0 + 4 * (lane & 15), kr = lane >> 4;
    f32x4 v[16];
#pragma unroll
    for (int i = 0; i < 16; ++i) v[i] = (nn < N) ? *(const f32x4*)(W + (size_t)(k0 + 4 * i + kr) * N + nn) : (f32x4){0.f, 0.f, 0.f, 0.f};
#pragma unroll
    for (int i = 0; i < 16; ++i) { const int kk = 4 * i + kr; const float g = gain ? gain[k0 + kk] : 1.0f; LAS float* d = scr + kk * 65 + 4 * (lane & 15); d[0] = v[i][0] * g; d[1] = v[i][1] * g; d[2] = v[i][2] * g; d[3] = v[i][3] * g; }
    LDS_WAIT(); asm volatile("" ::: "memory");
    const int c = lane & 7;
#pragma unroll
    for (int j = 0; j < 8; ++j) { const int nl = (lane >> 3) + 8 * j; const int n = n0 + nl; const LAS float* s = scr + (8 * c) * 65 + nl;
        v4u o; o.x = pg8::cvt_pk_bf16(s[0 * 65], s[1 * 65]); o.y = pg8::cvt_pk_bf16(s[2 * 65], s[3 * 65]); o.z = pg8::cvt_pk_bf16(s[4 * 65], s[5 * 65]); o.w = pg8::cvt_pk_bf16(s[6 * 65], s[7 * 65]);
        if (n < N) *(v4u*)(WT + (size_t)rm(n) * pitch + k0 + 8 * c) = o; }
    LDS_WAIT(); asm volatile("" ::: "memory");
}
__device__ __forceinline__ void p0_prologue(const Ctx& C, const Params& P) {
    THREAD_IDS();
    LAS float* scr = (LAS float*)(C.lds + RING_OFF + wave * 16896);
    constexpr int I_FF = 16 * 44, I_DN = 44 * 16, I_IN = 16 * 113, I_BR = 4 * 4 * 16, I_OUT = 16 * 16;
    constexpr int PER_LAYER = 4 * I_FF + 2 * I_DN + I_IN + I_BR + I_OUT;
    for (int it = gw; it < DEPTH * PER_LAYER; it += NGW) {
        const int l = it / PER_LAYER; int r = it - l * PER_LAYER;
        bf16* W1a = WSP(bf16, WS_W1 + (size_t)(l * 2 + 0) * SZ_W1); bf16* W1b = WSP(bf16, WS_W1 + (size_t)(l * 2 + 1) * SZ_W1);
        bf16* Wda = WSP(bf16, WS_WD + (size_t)(l * 2 + 0) * SZ_WD); bf16* Wdb = WSP(bf16, WS_WD + (size_t)(l * 2 + 1) * SZ_WD);
        if (r < I_FF) { tr_item(C.in[I_F1G] + (size_t)l * D * DFF, D, DFF, C.in[I_NF1] + l * D, W1a, D, RowMap{1, 0}, scr, r / 44, r % 44, lane); continue; } r -= I_FF;
        if (r < I_FF) { tr_item(C.in[I_F1U] + (size_t)l * D * DFF, D, DFF, C.in[I_NF1] + l * D, W1a, D, RowMap{1, 128}, scr, r / 44, r % 44, lane); continue; } r -= I_FF;
        if (r < I_DN) { tr_item(C.in[I_F1D] + (size_t)l * D * DFF, DFF, D, nullptr, Wda, DFF, RowMap{0, 0}, scr, r / 16, r % 16, lane); continue; } r -= I_DN;
        if (r < I_FF) { tr_item(C.in[I_F2G] + (size_t)l * D * DFF, D, DFF, C.in[I_NF2] + l * D, W1b, D, RowMap{1, 0}, scr, r / 44, r % 44, lane); continue; } r -= I_FF;
        if (r < I_FF) { tr_item(C.in[I_F2U] + (size_t)l * D * DFF, D, DFF, C.in[I_NF2] + l * D, W1b, D, RowMap{1, 128}, scr, r / 44, r % 44, lane); continue; } r -= I_FF;
        if (r < I_DN) { tr_item(C.in[I_F2D] + (size_t)l * D * DFF, DFF, D, nullptr, Wdb, DFF, RowMap{0, 0}, scr, r / 16, r % 16, lane); continue; } r -= I_DN;
        if (r < I_IN) { tr_item(C.in[I_WIN] + (size_t)l * D * NIN, D, NIN, C.in[I_NMIX] + l * D, WSP(bf16, WS_WIN + (size_t)l * SZ_WIN), D, RowMap{2, 0}, scr, r / 113, r % 113, lane); continue; } r -= I_IN;
        if (r < I_BR) { const int n4 = r / 64, rr = r % 64; tr_item(C.in[I_WBR] + (size_t)(l * 4 + n4) * 256 * D, 256, D, nullptr, WSP(bf16, WS_WBR + (size_t)l * SZ_WBR), 256, RowMap{0, n4 * D}, scr, rr / 16, rr % 16, lane); continue; } r -= I_BR;
        tr_item(C.in[I_WOUT] + (size_t)l * D * D, D, D, nullptr, WSP(bf16, WS_WOUT + (size_t)l * SZ_WOUT), D, RowMap{0, 0}, scr, r / 16, r % 16, lane);
    }
    const int gt = gw * 64 + lane, NGT = NGW * 64;
    for (int i = gt; i < 2 * 240 * 128; i += NGT) { const int l = i / (240 * 128), r = i % (240 * 128); *(v4u*)(C.ws + WS_WIN + (size_t)l * SZ_WIN + ((size_t)NMIX * D) * 2 + (size_t)r * 16) = (v4u){0u, 0u, 0u, 0u}; }
    for (int i = gt; i < (M - MR) * 128; i += NGT) *(v4u*)(C.ws + WS_BR + (size_t)MR * D * 2 + (size_t)i * 16) = (v4u){0u, 0u, 0u, 0u};
    for (int i = gt; i < 2 * NINP; i += NGT) { const int l = i / NINP, j = i % NINP; float v = 0.f; if (j < NMIX) v = C.in[I_BIN][l * NIN + j]; else if (j >= NMIXP) v = C.in[I_BIN][l * NIN + NMIX + (j - NMIXP)]; WSP(float, WS_BINP)[i] = v; }
    for (int i = gt; i < NPOS * 32; i += NGT) { const int pi = i >> 5, fi = i & 31; const int pos = pi < L ? pi : PAST + (pi - L);
        const float angf = (float)pos * P.inv_freq[fi];
        const double a = (double)angf; const double k = rint(a * 0.15915494309189535); const double rr = (a - k * 6.283185307179586) - k * 2.4492935982947064e-16;
        const float rf = (float)rr; WSP(float, WS_ROPE)[i] = cosf(rf); WSP(float, WS_ROPE)[NPOS * 32 + i] = sinf(rf); }
    float* H = WSP(float, WS_H); bf16* HB = WSP(bf16, WS_HB); float* SS0 = WSP(float, WS_SS);
    for (int row = gw; row < M; row += NGW) {
        const float* src = nullptr;
        if (row < MP) { const int b = row / L, pos = row - b * L; src = pos < NMETA ? C.in[I_META] + (size_t)pos * D : C.in[I_XP] + ((size_t)b * SEQ + (pos - NMETA)) * D; }
        else if (row < MR) src = C.in[I_XS] + (size_t)(row - MP) * D;
        float s = 0.f;
#pragma unroll
        for (int j = 0; j < 4; ++j) { f32x4 v = src ? *(const f32x4*)(src + 256 * j + 4 * lane) : (f32x4){0.f, 0.f, 0.f, 0.f};
            *(f32x4*)(H + (size_t)row * D + 256 * j + 4 * lane) = v; s += (v[0] * v[0] + v[1] * v[1]) + (v[2] * v[2] + v[3] * v[3]);
            unsigned long long w = (unsigned long long)pk2(v[0], v[1]) | ((unsigned long long)pk2(v[2], v[3]) << 32);
            *(unsigned long long*)(HB + (size_t)row * D + 256 * j + 4 * lane) = w; }
        s = wave_sum(s); if (lane < 16) SS0[(size_t)row * 16 + lane] = lane == 0 ? s : 0.f;
    }
}

__device__ __forceinline__ float lam_of(const Ctx& C, int l, float lam_init) {
    THREAD_IDS();
    float a = 0.f, b = 0.f;
#pragma unroll 1
    for (int i = 0; i < 32; ++i) { a += C.in[I_LQ1][l * 32 + i] * C.in[I_LK1][l * 32 + i]; b += C.in[I_LQ2][l * 32 + i] * C.in[I_LK2][l * 32 + i]; }
    return __expf(a) - __expf(b) + lam_init;
}
__device__ __forceinline__ int t5_bucket(int n) {
    if (n < 16) return n;
    return 16 + (n >= 19) + (n >= 21) + (n >= 24) + (n >= 27) + (n >= 31) + (n >= 35) + (n >= 40) + (n >= 46) + (n >= 52) + (n >= 59) + (n >= 67) + (n >= 77) + (n >= 87) + (n >= 99) + (n >= 113);
}
__device__ __forceinline__ void unpack8(const v4u w, float (&x)[8]) { x[0] = bflo(w.x); x[1] = bfhi(w.x); x[2] = bflo(w.y); x[3] = bfhi(w.y); x[4] = bflo(w.z); x[5] = bfhi(w.z); x[6] = bflo(w.w); x[7] = bfhi(w.w); }
__device__ __forceinline__ v4u pack8(const float (&x)[8]) { v4u w; w.x = pg8::cvt_pk_bf16(x[0], x[1]); w.y = pg8::cvt_pk_bf16(x[2], x[3]); w.z = pg8::cvt_pk_bf16(x[4], x[5]); w.w = pg8::cvt_pk_bf16(x[6], x[7]); return w; }
__device__ __forceinline__ void n1_prep(const Ctx& C, int l) {
    THREAD_IDS();
    const bf16* ZM = WSP(bf16, WS_ZMIX); float* UB = WSP(float, WS_UBUF); float* RQ = WSP(float, WS_RQ); float* RK = WSP(float, WS_RK);
    float* LD = WSP(float, WS_LDEC); const float* COS = WSP(float, WS_ROPE); const float* SIN = COS + NPOS * 32; bf16* QNB = WSP(bf16, WS_QNB); bf16* KNB = WSP(bf16, WS_KNB);
    const int i = lane & 31;
    float qg[8], kg[8];
#pragma unroll
    for (int j = 0; j < 8; ++j) { qg[j] = C.in[I_QN][l * 32 + ((8 * i) & 31) + j] * (0.17677669529663687f * 1.4426950408889634f); kg[j] = C.in[I_KN][l * 32 + ((8 * i) & 31) + j]; }
    for (int rp = gw; rp < MR / 2; rp += NGW) {
        const int r = 2 * rp + (lane >> 5);
        const bf16* z = ZM + (size_t)r * NMIXP;
        const int pi = r < MP ? r % L : L + ((r - MP) & 7);
        float* kout = r < MP ? C.out + O_KP + ((size_t)l * MP + r) * 256 : C.out + O_KS + ((size_t)l * MS + (r - MP)) * 256;
        float* vout = r < MP ? C.out + O_VP + ((size_t)l * MP + r) * 256 : C.out + O_VS + ((size_t)l * MS + (r - MP)) * 256;
        const v4u wa = *(const v4u*)(z + C_A + 8 * i), wg = *(const v4u*)(z + C_G + 8 * i), wq = *(const v4u*)(z + D_Q + 8 * i), wk = *(const v4u*)(z + D_K + 8 * i), wv = *(const v4u*)(z + D_V + 8 * i);
        const int isk = i >> 4, hh = (i >> 2) & 3, jc = i & 3;
        const bf16* zr = z + (isk ? R_K : R_Q) + hh * 64 + 8 * jc;
        const v4u w1 = *(const v4u*)zr, w2 = *(const v4u*)(zr + 32);
        const v4u gl0 = *(const v4u*)(z + G_LOW), gl1 = *(const v4u*)(z + G_LOW + 8);
        float x[8], y[8];
        unpack8(wa, x); unpack8(wg, y);
#pragma unroll
        for (int j = 0; j < 8; ++j) x[j] *= sigmoidf_(y[j]);
        *(f32x4*)(UB + (size_t)r * 256 + 8 * i) = (f32x4){x[0], x[1], x[2], x[3]}; *(f32x4*)(UB + (size_t)r * 256 + 8 * i + 4) = (f32x4){x[4], x[5], x[6], x[7]};
        unpack8(wv, x);
        *(f32x4*)(vout + 8 * i) = (f32x4){x[0], x[1], x[2], x[3]}; *(f32x4*)(vout + 8 * i + 4) = (f32x4){x[4], x[5], x[6], x[7]};
        unpack8(wq, x);
        { float s = 0.f;
#pragma unroll
          for (int j = 0; j < 8; ++j) s += x[j] * x[j];
          s += __shfl_xor(s, 1); s += __shfl_xor(s, 2); const float rs = rsqrtf(s * (1.0f / 32) + EPS);
#pragma unroll
          for (int j = 0; j < 8; ++j) x[j] = x[j] * rs * qg[j];
          *(v4u*)(QNB + (size_t)r * 256 + 8 * i) = pack8(x); }
        unpack8(wk, x);
        { float s = 0.f;
#pragma unroll
          for (int j = 0; j < 8; ++j) s += x[j] * x[j];
          s += __shfl_xor(s, 1); s += __shfl_xor(s, 2); const float rs = rsqrtf(s * (1.0f / 32) + EPS);
#pragma unroll
          for (int j = 0; j < 8; ++j) x[j] = x[j] * rs * kg[j];
          *(v4u*)(KNB + (size_t)r * 256 + 8 * i) = pack8(x);
          *(f32x4*)(kout + 8 * i) = (f32x4){x[0], x[1], x[2], x[3]}; *(f32x4*)(kout + 8 * i + 4) = (f32x4){x[4], x[5], x[6], x[7]}; }
        unpack8(w1, x); unpack8(w2, y);
        { const f32x4 c0 = *(const f32x4*)(COS + pi * 32 + 8 * jc), c1 = *(const f32x4*)(COS + pi * 32 + 8 * jc + 4), s0 = *(const f32x4*)(SIN + pi * 32 + 8 * jc), s1 = *(const f32x4*)(SIN + pi * 32 + 8 * jc + 4);
          const float sc = isk ? 0.125f : 1.0f; float o1[8], o2[8];
#pragma unroll
          for (int j = 0; j < 8; ++j) { const float cs = j < 4 ? c0[j & 3] : c1[j & 3], sn = j < 4 ? s0[j & 3] : s1[j & 3]; o1[j] = (x[j] * cs - y[j] * sn) * sc; o2[j] = (x[j] * sn + y[j] * cs) * sc; }
          float* ro = (isk ? RK : RQ) + (size_t)r * 256 + hh * 64 + 8 * jc;
          *(f32x4*)ro = (f32x4){o1[0], o1[1], o1[2], o1[3]}; *(f32x4*)(ro + 4) = (f32x4){o1[4], o1[5], o1[6], o1[7]}; *(f32x4*)(ro + 32) = (f32x4){o2[0], o2[1], o2[2], o2[3]}; *(f32x4*)(ro + 36) = (f32x4){o2[4], o2[5], o2[6], o2[7]}; }
        { float gv[16]; unpack8(gl0, x); unpack8(gl1, y);
#pragma unroll
          for (int j = 0; j < 8; ++j) { gv[j] = x[j]; gv[8 + j] = y[j]; }
          f32x4 gp = *(const f32x4*)(C.in[I_GAB] + l * 128 + 4 * i);
#pragma unroll
          for (int k = 0; k < 16; ++k) { const f32x4 aw = *(const f32x4*)(C.in[I_GAW] + (size_t)(l * 16 + k) * 128 + 4 * i); gp = gp + aw * gv[k]; }
          f32x4 ls;
#pragma unroll
          for (int j = 0; j < 4; ++j) ls[j] = (fminf(gp[j], 0.f) - log1pf(__expf(-fabsf(gp[j])))) * (1.0f / 16.0f);
          *(f32x4*)(LD + (size_t)r * 128 + 4 * i) = ls; }
    }
}
__device__ __forceinline__ void conv_rows_item(const Ctx& C, int l, int item) {
    THREAD_IDS();
    const float* UB = WSP(float, WS_UBUF); bf16* BR = WSP(bf16, WS_BR);
    const float* cw = C.in[I_CW] + (size_t)l * 31 * 256; const float* sc = C.in[I_SCONV];
    LAS float* wl = (LAS float*)C.lds;
    for (int i = tid; i < 31 * 256; i += NWAVES * 64) wl[i] = cw[i];
    LDS_WAIT(); __builtin_amdgcn_s_barrier(); asm volatile("" ::: "memory");
    for (int rr = wave; rr < 64; rr += NWAVES) {
        const int r = item * 64 + rr; if (r >= MR) break;
        const bool smp = r >= MP; const int b = smp ? (r - MP) >> 3 : r / L; const int p = smp ? (r - MP) & 7 : r - b * L; const int rb = smp ? MP + b * 8 : b * L;
        float cv[4];
#pragma unroll
        for (int k = 0; k < 4; ++k) cv[k] = C.in[I_CB][l * 256 + lane + 64 * k];
#pragma unroll 1
        for (int jh = 0; jh < 32; jh += 8) {
            float uv[8][4];
            const float* up = UB + (size_t)(rb + p + jh - 30) * 256 + lane; const float* sp = sc + (((size_t)l * DB + b) * 30 + (p + jh)) * 256 + lane;
#pragma unroll
            for (int jj = 0; jj < 8; ++jj) { const int j = jh + jj; const int q = p + j - 30;
#pragma unroll
                for (int k = 0; k < 4; ++k) uv[jj][k] = j >= 31 ? 0.f : (q >= 0 ? up[jj * 256 + 64 * k] : (smp ? sp[jj * 256 + 64 * k] : 0.f)); }
            const LAS float* wp = wl + jh * 256 + lane;
#pragma unroll
            for (int jj = 0; jj < 8; ++jj) { if (jh + jj < 31) {
#pragma unroll
                    for (int k = 0; k < 4; ++k) cv[k] += wp[jj * 256 + 64 * k] * uv[jj][k]; } }
        }
        float s = (cv[0] + cv[1]) + (cv[2] + cv[3]); const float mean = wave_sum(s) * (1.0f / 256);
        float q2 = 0.f;
#pragma unroll
        for (int k = 0; k < 4; ++k) { cv[k] -= mean; q2 += cv[k] * cv[k]; }
        const float rstd = rsqrtf(wave_sum(q2) * (1.0f / 256) + EPS);
#pragma unroll
        for (int k = 0; k < 4; ++k) { const int c = lane + 64 * k; const float y = cv[k] * rstd * C.in[I_CLG][l * 256 + c] + C.in[I_CLB][l * 256 + c]; BR[(size_t)r * D + c] = (bf16)f2bf(siluf_(y)); }
    }
    LDS_WAIT(); __builtin_amdgcn_s_barrier(); asm volatile("" ::: "memory");
}
__device__ __forceinline__ void conv_state_item(const Ctx& C, int l, int part, int nparts) {
    THREAD_IDS();
    const float* UB = WSP(float, WS_UBUF); const float* sc = C.in[I_SCONV];
    for (int i = part * NWAVES * 64 + tid; i < BATCH * 30 * 256; i += nparts * NWAVES * 64) { const int c = i & 255, ii = (i >> 8) % 30, b = i / (30 * 256); C.out[O_CP + (size_t)l * BATCH * 30 * 256 + i] = UB[(size_t)(b * L + L - 30 + ii) * 256 + c]; }
    for (int i = part * NWAVES * 64 + tid; i < DB * 30 * 256; i += nparts * NWAVES * 64) { const int c = i & 255, ii = (i >> 8) % 30, b = i / (30 * 256);
        C.out[O_CS + (size_t)l * DB * 30 * 256 + i] = ii < 22 ? sc[(((size_t)l * DB + b) * 30 + 8 + ii) * 256 + c] : UB[(size_t)(MP + b * 8 + ii - 22) * 256 + c]; }
}
template <int DK, bool RET> __device__ __forceinline__ void la_seq(const Ctx& C, int l, bool smp, int b, int h) {
    THREAD_IDS();
    const bf16* ZM = WSP(bf16, WS_ZMIX); const float* RQ = WSP(float, WS_RQ); const float* RK = WSP(float, WS_RK); const float* LD = WSP(float, WS_LDEC); bf16* BR = WSP(bf16, WS_BR);
    const int nt = smp ? DS : L; const int row0 = smp ? MP + b * DS : b * L;
    float S[DK];
    if (smp) { const float* s0 = (RET ? C.in[I_SRET] : C.in[I_SGLA]) + (((size_t)l * DB + b) * 4 + h) * DK * 64;
#pragma unroll
        for (int k = 0; k < DK; ++k) S[k] = s0[k * 64 + lane]; }
    else {
#pragma unroll
        for (int k = 0; k < DK; ++k) S[k] = 0.f; }
    const float gamma = 1.0f - exp2f(-5.0f - (float)h);
    const float gn = RET ? C.in[I_RGN][(l * 4 + h) * 64 + lane] : C.in[I_GGN][(l * 4 + h) * 64 + lane];
    for (int t = 0; t < nt; ++t) {
        const int r = row0 + t; const bf16* z = ZM + (size_t)r * NMIXP;
        float ql, kl, dl = 1.f;
        if (RET) { ql = RQ[(size_t)r * 256 + h * 64 + lane]; kl = RK[(size_t)r * 256 + h * 64 + lane]; }
        else { const int lk = lane & 31; ql = bf2f(z[G_Q + h * 32 + lk]) * 0.17677669529663687f; kl = bf2f(z[G_K + h * 32 + lk]); dl = __expf(LD[(size_t)r * 128 + h * 32 + lk]); }
        const float v = bf2f(z[(RET ? R_V : G_V) + h * 64 + lane]);
        float o = 0.f;
#pragma unroll
        for (int k = 0; k < DK; ++k) { const float qk = __shfl(ql, k), kk = __shfl(kl, k); const float dk = RET ? gamma : __shfl(dl, k);
            S[k] = dk * S[k] + kk * v; o += qk * S[k]; if ((k & 7) == 7) __builtin_amdgcn_sched_barrier(0); }
        float y;
        if (RET) { const float mean = wave_sum(o) * (1.0f / 64); const float d = o - mean; const float var = wave_sum(d * d) * (1.0f / 64); y = d * rsqrtf(var + EPS) * gn; }
        else { const float ms = wave_sum(o * o) * (1.0f / 64); y = o * rsqrtf(ms + EPS) * gn; }
        const float g = bf2f(z[(RET ? R_G : G_R) + h * 64 + lane]);
        BR[(size_t)r * D + (RET ? 256 : 512) + h * 64 + lane] = (bf16)f2bf(siluf_(g) * y);
    }
    float* so = C.out + (RET ? (smp ? O_RS + (((size_t)l * DB + b) * 4 + h) * DK * 64 : O_RP + (((size_t)l * BATCH + b) * 4 + h) * DK * 64)
                             : (smp ? O_GS + (((size_t)l * DB + b) * 4 + h) * DK * 64 : O_GP + (((size_t)l * BATCH + b) * 4 + h) * DK * 64));
#pragma unroll
    for (int k = 0; k < DK; ++k) so[k * 64 + lane] = S[k];
}
__device__ __forceinline__ void n2_la(const Ctx& C, int l) {
    THREAD_IDS();
    if ((gw & 63) == 0 && (gw >> 6) < 32) { const int it = gw >> 6; const int b = (it >> 2) & 3, h = it & 3;
        if (it < 16) la_seq<64, true>(C, l, false, b, h); else la_seq<32, false>(C, l, false, b, h); }
    for (int it = gw; it < 256; it += NGW) { const int typ = it >> 7, b = (it >> 2) & 31, h = it & 3;
        if (typ == 0) la_seq<64, true>(C, l, true, b, h); else la_seq<32, false>(C, l, true, b, h); }
}
__device__ __forceinline__ void n2_attn_prompt(const Ctx& C, int l, float lam_init) {
    THREAD_IDS();
    const float* QN = WSP(float, WS_QN); const float* KN = WSP(float, WS_KN); const float* VB = WSP(float, WS_VB); bf16* BR = WSP(bf16, WS_BR);
    const float lam = lam_of(C, l, lam_init);
    LAS float* park = (LAS float*)(C.lds) + wave * (64 * 65);
    constexpr int NQG = (L + 63) / 64;
    for (int it = gw; it < BATCH * 4 * NQG; it += NGW) {
        const int qg = NQG - 1 - it / 16, bh = it % 16, b = bh >> 2, h = bh & 3;
        const int qpos = min(qg * 64 + lane, L - 1); const bool valid = (qg * 64 + lane) < L; const int qrow = b * L + qpos;
        const int nkeys = min(qg * 64 + 64, L);
        float bias_near[1]; (void)bias_near;
        for (int s = 0; s < 2; ++s) {
            float q[32];
#pragma unroll
            for (int i = 0; i < 32; i += 4) { const f32x4 t = *(const f32x4*)(QN + (size_t)qrow * 256 + h * 64 + s * 32 + i); q[i] = t[0] * 0.17677669529663687f; q[i + 1] = t[1] * 0.17677669529663687f; q[i + 2] = t[2] * 0.17677669529663687f; q[i + 3] = t[3] * 0.17677669529663687f; }
            float m = -INFINITY, lsum = 0.f; float acc[64];
#pragma unroll
            for (int i = 0; i < 64; ++i) acc[i] = 0.f;
            for (int j = 0; j < nkeys; ++j) {
                const float* kp = KN + (size_t)(b * L + j) * 256 + h * 64 + s * 32; const float* vp = VB + (size_t)(b * L + j) * 256 + h * 64;
                float sc = 0.f;
#pragma unroll
                for (int i = 0; i < 32; i += 4) { const f32x4 kv = *(const f32x4*)(kp + i); sc += q[i] * kv[0] + q[i + 1] * kv[1] + q[i + 2] * kv[2] + q[i + 3] * kv[3]; }
                const int n = qpos - j;
                sc += C.in[I_RELB][t5_bucket(n < 0 ? 0 : n) * 4 + h];
                if (n < 0) sc = -INFINITY;
                const float mn = fmaxf(m, sc); const float corr = __expf(m - mn); const float p = __expf(sc - mn);
                m = mn; lsum = lsum * corr + p;
#pragma unroll
                for (int i = 0; i < 64; i += 4) { const f32x4 vv = *(const f32x4*)(vp + i); acc[i] = acc[i] * corr + p * vv[0]; acc[i + 1] = acc[i + 1] * corr + p * vv[1]; acc[i + 2] = acc[i + 2] * corr + p * vv[2]; acc[i + 3] = acc[i + 3] * corr + p * vv[3]; }
            }
            const float inv = 1.0f / lsum;
            if (s == 0) {
#pragma unroll
                for (int i = 0; i < 64; ++i) park[lane * 65 + i] = acc[i] * inv;
                LDS_WAIT();
            } else {
                float ms = 0.f;
#pragma unroll
                for (int i = 0; i < 64; ++i) { acc[i] = park[lane * 65 + i] - lam * (acc[i] * inv); ms += acc[i] * acc[i]; }
                const float rn = rsqrtf(ms * (1.0f / 64) + EPS) * (1.0f - lam_init);
                if (valid) {
#pragma unroll
                    for (int i = 0; i < 64; i += 2) { const unsigned w = pk2(acc[i] * rn * C.in[I_SUBLN][l * 64 + i], acc[i + 1] * rn * C.in[I_SUBLN][l * 64 + i + 1]); *(unsigned*)(BR + (size_t)qrow * D + 768 + h * 64 + i) = w; } }
                LDS_WAIT();
            }
        }
    }
}
__device__ __forceinline__ void n2_attn_sample(const Ctx& C, int l, float lam_init) {
    THREAD_IDS();
    const float* QN = WSP(float, WS_QN); const float* KN = WSP(float, WS_KN); const float* VB = WSP(float, WS_VB); bf16* BR = WSP(bf16, WS_BR);
    const int* PT = (const int*)C.in[I_PT]; const float* CK = C.in[I_CK] + (size_t)l * NPOOL * PAGE * 256; const float* CV = C.in[I_CV] + (size_t)l * NPOOL * PAGE * 256;
    const float lam = lam_of(C, l, lam_init);
    LAS float* part = (LAS float*)C.lds;
    for (int b = blockIdx.x; b < DB; b += C.G) {
        const int row = tid & 63, split = tid >> 6, h = row >> 4, s = (row >> 3) & 1, t = row & 7;
        float q[32];
#pragma unroll
        for (int i = 0; i < 32; ++i) q[i] = QN[(size_t)(MP + b * 8 + t) * 256 + h * 64 + s * 32 + i] * 0.17677669529663687f;
        float m = -INFINITY, lsum = 0.f; float acc[64];
#pragma unroll
        for (int i = 0; i < 64; ++i) acc[i] = 0.f;
        for (int j = split; j < PAST + DS; j += 8) {
            const float* kp; const float* vp; bool vis = true;
            if (j < PAST) { const int page = PT[b * NPAGES + (j >> 7)]; const size_t base = (((size_t)page * PAGE + (j & 127)) * 4 + h) * 64; kp = CK + base + s * 32; vp = CV + base; }
            else { const int jj = j - PAST; const size_t r2 = (size_t)(MP + b * 8 + jj); kp = KN + r2 * 256 + h * 64 + s * 32; vp = VB + r2 * 256 + h * 64; vis = jj <= t; }
            float sc = 0.f;
#pragma unroll
            for (int i = 0; i < 32; i += 4) { const f32x4 kv = *(const f32x4*)(kp + i); sc += q[i] * kv[0] + q[i + 1] * kv[1] + q[i + 2] * kv[2] + q[i + 3] * kv[3]; }
            const int n = PAST + t - j;
            sc += C.in[I_RELB][t5_bucket(n < 0 ? 0 : n) * 4 + h];
            if (!vis) sc = -INFINITY;
            const float mn = fmaxf(m, sc); const float corr = __expf(m - mn); const float p = __expf(sc - mn);
            m = mn; lsum = lsum * corr + p;
#pragma unroll
            for (int i = 0; i < 64; i += 4) { const f32x4 vv = *(const f32x4*)(vp + i); acc[i] = acc[i] * corr + p * vv[0]; acc[i + 1] = acc[i + 1] * corr + p * vv[1]; acc[i + 2] = acc[i + 2] * corr + p * vv[2]; acc[i + 3] = acc[i + 3] * corr + p * vv[3]; }
        }
        LAS float* pr = part + (split * 64 + row) * 66;
        pr[64] = m; pr[65] = lsum;
#pragma unroll
        for (int i = 0; i < 64; ++i) pr[i] = acc[i];
        __syncthreads();
        for (int k = 0; k < 4; ++k) { const int p = wave * 4 + k, h2 = p >> 3, t2 = p & 7; float os[2];
#pragma unroll
            for (int s2 = 0; s2 < 2; ++s2) { const int rw = h2 * 16 + s2 * 8 + t2; float mm = -INFINITY;
                for (int sp = 0; sp < 8; ++sp) mm = fmaxf(mm, part[(sp * 64 + rw) * 66 + 64]);
                float ll = 0.f, oo = 0.f;
                for (int sp = 0; sp < 8; ++sp) { const float w = __expf(part[(sp * 64 + rw) * 66 + 64] - mm); ll += part[(sp * 64 + rw) * 66 + 65] * w; oo += part[(sp * 64 + rw) * 66 + lane] * w; }
                os[s2] = oo / ll; }
            const float o = os[0] - lam * os[1]; const float ms = wave_sum(o * o) * (1.0f / 64);
            const float y = o * rsqrtf(ms + EPS) * C.in[I_SUBLN][l * 64 + lane] * (1.0f - lam_init);
            BR[(size_t)(MP + b * 8 + t2) * D + 768 + h2 * 64 + lane] = (bf16)f2bf(y); }
        __syncthreads();
    }
}
typedef short bf16x8_t __attribute__((ext_vector_type(8)));
template <int DK, bool RET> __device__ __forceinline__ void la_chunked(const Ctx& C, int l, bool smp, int b, int h) {
    THREAD_IDS();
    constexpr int QS = DK + 8, TS = 72, NKB = DK / 16, NKS = DK / 32;
    constexpr int SB = 2 * 64 * QS + 64 * TS + DK * TS + 64 * TS + 64;
    LAS bf16* SB0 = (LAS bf16*)(C.lds);
    LAS bf16* AL = SB0 + 2 * SB;
    LAS bf16* ST = AL + 64 * TS;
    const bf16* ZM = WSP(bf16, WS_ZMIX); const float* RQ = WSP(float, WS_RQ); const float* RK = WSP(float, WS_RK); const float* LD = WSP(float, WS_LDEC); bf16* BR = WSP(bf16, WS_BR);
    const int nt = smp ? DS : L, row0 = smp ? MP + b * DS : b * L, nch = (nt + 63) >> 6;
    const float lg2 = RET ? log2f(1.0f - exp2f(-5.0f - (float)h)) : 0.f;
    const int g4 = lane >> 4, c16 = lane & 15;
    const bool qwave = wave < 4; const int w4 = wave & 3;
    float Sreg[NKB][4];
    if (wave >= 4) {
        const float* s0 = (RET ? C.in[I_SRET] : C.in[I_SGLA]) + (((size_t)l * DB + b) * 4 + h) * DK * 64;
#pragma unroll
        for (int cb = 0; cb < NKB; ++cb)
#pragma unroll
            for (int r = 0; r < 4; ++r) { const int dk = cb * 16 + c16, dv = (wave - 4) * 16 + 4 * g4 + r; const float v = smp ? s0[dk * 64 + dv] : 0.f; Sreg[cb][r] = v; ST[dv * QS + dk] = (bf16)f2bf(v); }
    }
    float gnv[4];
#pragma unroll
    for (int cb = 0; cb < 4; ++cb) gnv[cb] = (RET ? C.in[I_RGN] : C.in[I_GGN])[(l * 4 + h) * 64 + cb * 16 + c16];
    float a[16]; v4u vr;
#define LA_LOAD(c) do { const size_t r_ = (size_t)(row0 + (c) * 64 + lane); const bf16* z_ = ZM + r_ * NMIXP; \
        vr = *(const v4u*)(z_ + (RET ? R_V : G_V) + h * 64 + 8 * wave); \
        if (RET) { const float* p_ = (qwave ? RQ : RK) + r_ * 256 + h * 64 + 8 * w4; const f32x4 x0 = *(const f32x4*)p_, x1 = *(const f32x4*)(p_ + 4), x2 = *(const f32x4*)(p_ + 32), x3 = *(const f32x4*)(p_ + 36); \
            a[0] = x0[0]; a[1] = x0[1]; a[2] = x0[2]; a[3] = x0[3]; a[4] = x1[0]; a[5] = x1[1]; a[6] = x1[2]; a[7] = x1[3]; a[8] = x2[0]; a[9] = x2[1]; a[10] = x2[2]; a[11] = x2[3]; a[12] = x3[0]; a[13] = x3[1]; a[14] = x3[2]; a[15] = x3[3]; } \
        else { const v4u q_ = *(const v4u*)(z_ + (qwave ? G_Q : G_K) + h * 32 + 8 * w4); const float* p_ = LD + r_ * 128 + h * 32 + 8 * w4; const f32x4 x0 = *(const f32x4*)p_, x1 = *(const f32x4*)(p_ + 4); \
            a[0] = bflo(q_.x); a[1] = bfhi(q_.x); a[2] = bflo(q_.y); a[3] = bfhi(q_.y); a[4] = bflo(q_.z); a[5] = bfhi(q_.z); a[6] = bflo(q_.w); a[7] = bfhi(q_.w); \
            a[8] = x0[0]; a[9] = x0[1]; a[10] = x0[2]; a[11] = x0[3]; a[12] = x1[0]; a[13] = x1[1]; a[14] = x1[2]; a[15] = x1[3]; } } while (0)
    LA_LOAD(0);
    int cur = 0;
    for (int i = 0; i <= nch; ++i) {
        if (i < nch) {
            const int c = i; LAS bf16* QT = SB0 + (i & 1) * SB; LAS bf16* KT = QT + 64 * QS; LAS bf16* VT = KT + 64 * QS; LAS bf16* KE = VT + 64 * TS; LAS bf16* GT = KE + DK * TS; LAS float* WT = (LAS float*)(GT + 64 * TS);
            const int nvc = min(64, nt - c * 64); const bool valid = lane < nvc;
        if (RET) {
            const float tq = (float)(lane + 1);
            if (qwave) { const float e = valid ? __builtin_amdgcn_exp2f(lg2 * tq) : 0.f;
                v4u w0, w1; w0.x = pg8::cvt_pk_bf16(a[0] * e, a[1] * e); w0.y = pg8::cvt_pk_bf16(a[2] * e, a[3] * e); w0.z = pg8::cvt_pk_bf16(a[4] * e, a[5] * e); w0.w = pg8::cvt_pk_bf16(a[6] * e, a[7] * e);
                w1.x = pg8::cvt_pk_bf16(a[8] * e, a[9] * e); w1.y = pg8::cvt_pk_bf16(a[10] * e, a[11] * e); w1.z = pg8::cvt_pk_bf16(a[12] * e, a[13] * e); w1.w = pg8::cvt_pk_bf16(a[14] * e, a[15] * e);
                *(LAS v4u*)(QT + lane * QS + 8 * w4) = w0; *(LAS v4u*)(QT + lane * QS + 32 + 8 * w4) = w1; }
            else { const float e = valid ? __builtin_amdgcn_exp2f(-lg2 * tq) : 0.f, ee = valid ? __builtin_amdgcn_exp2f(lg2 * ((float)nvc - tq)) : 0.f;
                v4u w0, w1; w0.x = pg8::cvt_pk_bf16(a[0] * e, a[1] * e); w0.y = pg8::cvt_pk_bf16(a[2] * e, a[3] * e); w0.z = pg8::cvt_pk_bf16(a[4] * e, a[5] * e); w0.w = pg8::cvt_pk_bf16(a[6] * e, a[7] * e);
                w1.x = pg8::cvt_pk_bf16(a[8] * e, a[9] * e); w1.y = pg8::cvt_pk_bf16(a[10] * e, a[11] * e); w1.z = pg8::cvt_pk_bf16(a[12] * e, a[13] * e); w1.w = pg8::cvt_pk_bf16(a[14] * e, a[15] * e);
                *(LAS v4u*)(KT + lane * QS + 8 * w4) = w0; *(LAS v4u*)(KT + lane * QS + 32 + 8 * w4) = w1;
#pragma unroll
                for (int i = 0; i < 16; i += 2) { const unsigned mine = pg8::cvt_pk_bf16(a[i] * ee, a[i + 1] * ee); const unsigned pv = (unsigned)__shfl_xor((int)mine, 1);
                    const unsigned w = (lane & 1) ? ((pv >> 16) | (mine & 0xffff0000u)) : ((mine & 0xffffu) | (pv << 16));
                    const int row = (i < 8 ? 8 * w4 + i : 32 + 8 * w4 + (i - 8)) + (lane & 1);
                    *(LAS unsigned*)(KE + row * TS + (lane & ~1)) = w; } }
        } else {
            float bb[8];
#pragma unroll
            for (int i = 0; i < 8; ++i) bb[i] = valid ? a[8 + i] : 0.f;
#pragma unroll
            for (int i = 0; i < 8; ++i) { float x = bb[i];
                x += __builtin_bit_cast(float, __builtin_amdgcn_mov_dpp(__builtin_bit_cast(int, x), 0x111, 0xf, 0xf, true));
                x += __builtin_bit_cast(float, __builtin_amdgcn_mov_dpp(__builtin_bit_cast(int, x), 0x112, 0xf, 0xf, true));
                x += __builtin_bit_cast(float, __builtin_amdgcn_mov_dpp(__builtin_bit_cast(int, x), 0x114, 0xf, 0xf, true));
                x += __builtin_bit_cast(float, __builtin_amdgcn_mov_dpp(__builtin_bit_cast(int, x), 0x118, 0xf, 0xf, true));
                const float t0 = __builtin_bit_cast(float, __builtin_amdgcn_readlane(__builtin_bit_cast(int, x), 15)), t1 = __builtin_bit_cast(float, __builtin_amdgcn_readlane(__builtin_bit_cast(int, x), 31)), t2 = __builtin_bit_cast(float, __builtin_amdgcn_readlane(__builtin_bit_cast(int, x), 47));
                bb[i] = x + (lane >= 16 ? t0 : 0.f) + (lane >= 32 ? t1 : 0.f) + (lane >= 48 ? t2 : 0.f); }
            if (qwave) {
                if (lane == 63) {
#pragma unroll
                    for (int i = 0; i < 8; ++i) WT[8 * w4 + i] = bb[i]; }
                float o8[8];
#pragma unroll
                for (int i = 0; i < 8; ++i) o8[i] = valid ? a[i] * 0.17677669529663687f * __expf(bb[i]) : 0.f;
                v4u w0; w0.x = pg8::cvt_pk_bf16(o8[0], o8[1]); w0.y = pg8::cvt_pk_bf16(o8[2], o8[3]); w0.z = pg8::cvt_pk_bf16(o8[4], o8[5]); w0.w = pg8::cvt_pk_bf16(o8[6], o8[7]);
                *(LAS v4u*)(QT + lane * QS + 8 * w4) = w0;
            } else {
                float o8[8];
#pragma unroll
                for (int i = 0; i < 8; ++i) o8[i] = valid ? a[i] * __expf(-bb[i]) : 0.f;
#pragma unroll
                for (int i = 0; i < 8; i += 2) { const float t0 = __shfl(bb[i], 63), t1 = __shfl(bb[i + 1], 63);
                    const unsigned mine = pg8::cvt_pk_bf16(valid ? a[i] * __expf(t0 - bb[i]) : 0.f, valid ? a[i + 1] * __expf(t1 - bb[i + 1]) : 0.f); const unsigned pv = (unsigned)__shfl_xor((int)mine, 1);
                    const unsigned w = (lane & 1) ? ((pv >> 16) | (mine & 0xffff0000u)) : ((mine & 0xffffu) | (pv << 16));
                    *(LAS unsigned*)(KE + (8 * w4 + i + (lane & 1)) * TS + (lane & ~1)) = w; }
                v4u w0; w0.x = pg8::cvt_pk_bf16(o8[0], o8[1]); w0.y = pg8::cvt_pk_bf16(o8[2], o8[3]); w0.z = pg8::cvt_pk_bf16(o8[4], o8[5]); w0.w = pg8::cvt_pk_bf16(o8[6], o8[7]);
                *(LAS v4u*)(KT + lane * QS + 8 * w4) = w0;
            }
        }
        { const unsigned vv[4] = {valid ? vr.x : 0u, valid ? vr.y : 0u, valid ? vr.z : 0u, valid ? vr.w : 0u};
#pragma unroll
          for (int i = 0; i < 4; ++i) { const unsigned pv = (unsigned)__shfl_xor((int)vv[i], 1);
              const unsigned w = (lane & 1) ? ((pv >> 16) | (vv[i] & 0xffff0000u)) : ((vv[i] & 0xffffu) | (pv << 16));
              *(LAS unsigned*)(VT + (8 * wave + 2 * i + (lane & 1)) * TS + (lane & ~1)) = w; } }
            if (c + 1 < nch) LA_LOAD(c + 1);
        }
        if (i >= 1) {
            LAS bf16* QT = SB0 + ((i - 1) & 1) * SB; LAS bf16* KT = QT + 64 * QS;
        { const int rb = wave >> 1;
#pragma unroll
          for (int ci = 0; ci < 2; ++ci) { const int cb = (wave & 1) * 2 + ci; f32x4 acc = {0.f, 0.f, 0.f, 0.f};
              if (cb <= rb) {
#pragma unroll
                  for (int ks = 0; ks < NKS; ++ks) { const bf16x8_t af = *(const LAS bf16x8_t*)(QT + (rb * 16 + c16) * QS + ks * 32 + 8 * g4), bf = *(const LAS bf16x8_t*)(KT + (cb * 16 + c16) * QS + ks * 32 + 8 * g4);
                      acc = __builtin_amdgcn_mfma_f32_16x16x32_bf16(af, bf, acc, 0, 0, 0); } }
#pragma unroll
              for (int r = 0; r < 4; ++r) { const int tt = rb * 16 + 4 * g4 + r, ss = cb * 16 + c16; AL[tt * TS + ss] = (bf16)f2bf(ss <= tt ? acc[r] : 0.f); } } }
        }
        LDS_WAIT(); __builtin_amdgcn_s_barrier(); asm volatile("" ::: "memory");
        if (i >= 1) {
            const int c = i - 1; LAS bf16* QT = SB0 + (c & 1) * SB; LAS bf16* KT = QT + 64 * QS; LAS bf16* VT = KT + 64 * QS; LAS bf16* KE = VT + 64 * TS; LAS bf16* GT = KE + DK * TS; LAS float* WT = (LAS float*)(GT + 64 * TS);
            const int nvc = min(64, nt - c * 64); (void)KT;
        if (wave < 4) {
            const int rb = wave; const LAS bf16* STc = ST + cur * 64 * QS;
            f32x4 o[4];
#pragma unroll
            for (int cb = 0; cb < 4; ++cb) o[cb] = (f32x4){0.f, 0.f, 0.f, 0.f};
#pragma unroll
            for (int ks = 0; ks < 2; ++ks) { const bf16x8_t af = *(const LAS bf16x8_t*)(AL + (rb * 16 + c16) * TS + ks * 32 + 8 * g4);
#pragma unroll
                for (int cb = 0; cb < 4; ++cb) { const bf16x8_t bf = *(const LAS bf16x8_t*)(VT + (cb * 16 + c16) * TS + ks * 32 + 8 * g4); o[cb] = __builtin_amdgcn_mfma_f32_16x16x32_bf16(af, bf, o[cb], 0, 0, 0); } }
#pragma unroll
            for (int ks = 0; ks < NKS; ++ks) { const bf16x8_t af = *(const LAS bf16x8_t*)(QT + (rb * 16 + c16) * QS + ks * 32 + 8 * g4);
#pragma unroll
                for (int cb = 0; cb < 4; ++cb) { const bf16x8_t bf = *(const LAS bf16x8_t*)(STc + (cb * 16 + c16) * QS + ks * 32 + 8 * g4); o[cb] = __builtin_amdgcn_mfma_f32_16x16x32_bf16(af, bf, o[cb], 0, 0, 0); } }
            { float* LAO = WSP(float, WS_LAO);
#pragma unroll
              for (int r = 0; r < 4; ++r) { const int tok = c * 64 + rb * 16 + 4 * g4 + r;
                  if (tok < nt) { float* op = LAO + (size_t)(row0 + tok) * 512 + (RET ? 0 : 256) + h * 64 + c16;
#pragma unroll
                      for (int cb = 0; cb < 4; ++cb) op[cb * 16] = o[cb][r]; } } }
        } else {
            const int dvb = wave - 4; LAS bf16* STn = ST + (cur ^ 1) * 64 * QS;
            f32x4 ds[NKB];
#pragma unroll
            for (int cb = 0; cb < NKB; ++cb) ds[cb] = (f32x4){0.f, 0.f, 0.f, 0.f};
#pragma unroll
            for (int ks = 0; ks < 2; ++ks) { const bf16x8_t af = *(const LAS bf16x8_t*)(VT + (dvb * 16 + c16) * TS + ks * 32 + 8 * g4);
#pragma unroll
                for (int cb = 0; cb < NKB; ++cb) { const bf16x8_t bf = *(const LAS bf16x8_t*)(KE + (cb * 16 + c16) * TS + ks * 32 + 8 * g4); ds[cb] = __builtin_amdgcn_mfma_f32_16x16x32_bf16(af, bf, ds[cb], 0, 0, 0); } }
#pragma unroll
            for (int cb = 0; cb < NKB; ++cb) { const float eB = RET ? __builtin_amdgcn_exp2f(lg2 * (float)nvc) : __expf(WT[cb * 16 + c16]);
#pragma unroll
                for (int r = 0; r < 4; ++r) { Sreg[cb][r] = eB * Sreg[cb][r] + ds[cb][r]; STn[(dvb * 16 + 4 * g4 + r) * QS + cb * 16 + c16] = (bf16)f2bf(Sreg[cb][r]); } }
        }
            cur ^= 1;
        }
        LDS_WAIT(); __builtin_amdgcn_s_barrier(); asm volatile("" ::: "memory");
    }
#undef LA_LOAD
    if (wave >= 4) {
        float* so = C.out + (RET ? (smp ? O_RS + (((size_t)l * DB + b) * 4 + h) * DK * 64 : O_RP + (((size_t)l * BATCH + b) * 4 + h) * DK * 64)
                                 : (smp ? O_GS + (((size_t)l * DB + b) * 4 + h) * DK * 64 : O_GP + (((size_t)l * BATCH + b) * 4 + h) * DK * 64));
#pragma unroll
        for (int cb = 0; cb < NKB; ++cb)
#pragma unroll
            for (int r = 0; r < 4; ++r) so[(cb * 16 + c16) * 64 + (wave - 4) * 16 + 4 * g4 + r] = Sreg[cb][r];
    }
}
__device__ __forceinline__ void n2_la_chunked(const Ctx& C, int l) {
    const int bx = blockIdx.x;
    if (bx < 32) { const int b = (bx >> 2) & 3, h = bx & 3; if (bx < 16) la_chunked<64, true>(C, l, false, b, h); else la_chunked<32, false>(C, l, false, b, h); }
    else { for (int it = bx - 32; it < 256; it += C.G - 32) { const int b = (it >> 2) & 31, h = it & 3; if (it < 128) la_chunked<64, true>(C, l, true, b, h); else la_chunked<32, false>(C, l, true, b, h); } }
}
typedef float f32x16_t __attribute__((ext_vector_type(16)));
__device__ __forceinline__ int crow_(int r, int hi) { return (r & 3) + 8 * (r >> 2) + 4 * hi; }
__device__ __forceinline__ float swapmax32(float m) { auto rr = __builtin_amdgcn_permlane32_swap(__float_as_uint(m), __float_as_uint(m), false, false); return fmaxf(__uint_as_float(rr[0]), __uint_as_float(rr[1])); }
__device__ __forceinline__ float swapadd32(float m) { auto rr = __builtin_amdgcn_permlane32_swap(__float_as_uint(m), __float_as_uint(m), false, false); return __uint_as_float(rr[0]) + __uint_as_float(rr[1]); }
constexpr float LOG2E = 1.4426950408889634f;
__device__ __forceinline__ void attn_prompt_item(const Ctx& C, int l, int b, int h, int qb, float lam, float lam_init, float mb) {
    THREAD_IDS();
    constexpr int KS = 72;
    LAS bf16* Kt = (LAS bf16*)C.lds;
    LAS bf16* Vt = Kt + 2 * 64 * KS;
    LAS float* BT = (LAS float*)(Vt + 2 * 64 * KS);
    LAS float* OX = BT + 128;
    const bf16* ZM = WSP(bf16, WS_ZMIX); const bf16* QNB = WSP(bf16, WS_QNB); const bf16* KNB = WSP(bf16, WS_KNB); bf16* BR = WSP(bf16, WS_BR);
    const int r32 = lane & 31, hi = lane >> 5, qs = wave >> 1, s = wave & 1;
    const int q0 = qb * 128 + qs * 32; const int rowb = b * L;
    if (tid < 128) BT[tid] = (C.in[I_RELB][t5_bucket(tid) * 4 + h] - C.in[I_RELB][31 * 4 + h]) * LOG2E;
    pg8::bf16x8 qf[2];
#pragma unroll
    for (int d0 = 0; d0 < 2; ++d0) qf[d0] = *(const pg8::bf16x8*)(QNB + (size_t)(rowb + q0 + r32) * 256 + h * 64 + s * 32 + 16 * d0 + 8 * hi);
    const int pl = (lane & ~15) | ((lane & 8) >> 1) | ((lane & 4) << 1) | (lane & 3);
    const int NT = (min(128 * (qb + 1), L) + 63) >> 6;
    v4u kreg, vreg;
#define AT_LOAD(j) do { const size_t r_ = (size_t)(rowb + (j) * 64 + lane); kreg = *(const v4u*)(KNB + r_ * 256 + h * 64 + 8 * wave); vreg = *(const v4u*)(ZM + r_ * NMIXP + D_V + h * 64 + 8 * wave); } while (0)
#define AT_STORE(buf) do { *(LAS v4u*)(Kt + (buf) * 64 * KS + lane * KS + 8 * wave) = kreg; LAS bf16* v_ = Vt + (buf) * 64 * KS + (8 * wave) * KS + pl; \
        v_[0] = (bf16)(vreg.x & 0xffffu); v_[KS] = (bf16)(vreg.x >> 16); v_[2 * KS] = (bf16)(vreg.y & 0xffffu); v_[3 * KS] = (bf16)(vreg.y >> 16); \
        v_[4 * KS] = (bf16)(vreg.z & 0xffffu); v_[5 * KS] = (bf16)(vreg.z >> 16); v_[6 * KS] = (bf16)(vreg.w & 0xffffu); v_[7 * KS] = (bf16)(vreg.w >> 16); } while (0)
    AT_LOAD(0); AT_STORE(0); if (NT > 1) AT_LOAD(1);
    LDS_WAIT(); __builtin_amdgcn_s_barrier(); asm volatile("" ::: "memory");
    float lsum = 0.f; f32x16_t o[2]; f32x16_t negm;
#pragma unroll
    for (int i = 0; i < 16; ++i) negm[i] = -mb;
#pragma unroll
    for (int i = 0; i < 16; ++i) { o[0][i] = 0.f; o[1][i] = 0.f; }
    for (int j = 0; j < NT; ++j) {
        const int k0 = 64 * j, buf = j & 1;
        if (k0 <= q0 + 31) {
            const LAS bf16* kb = Kt + buf * 64 * KS; const LAS bf16* vb = Vt + buf * 64 * KS;
            f32x16_t p0 = negm, p1 = negm;
#pragma unroll
            for (int d0 = 0; d0 < 2; ++d0) { const pg8::bf16x8 a0 = *(const LAS pg8::bf16x8*)(kb + r32 * KS + s * 32 + 16 * d0 + 8 * hi), a1 = *(const LAS pg8::bf16x8*)(kb + (32 + r32) * KS + s * 32 + 16 * d0 + 8 * hi);
                p0 = __builtin_amdgcn_mfma_f32_32x32x16_bf16(a0, qf[d0], p0, 0, 0, 0); p1 = __builtin_amdgcn_mfma_f32_32x32x16_bf16(a1, qf[d0], p1, 0, 0, 0); }
            if (q0 - k0 - 63 < 113) {
#pragma unroll
                for (int r = 0; r < 16; ++r) { const int n0 = (q0 + r32) - (k0 + crow_(r, hi)), n1 = n0 - 32;
                    p0[r] = n0 < 0 ? -INFINITY : p0[r] + (n0 < 128 ? BT[n0] : 0.f); p1[r] = n1 < 0 ? -INFINITY : p1[r] + (n1 < 128 ? BT[n1] : 0.f); } }
            typedef float f32x2_t __attribute__((ext_vector_type(2)));
            f32x2_t ps2 = {0.f, 0.f};
#pragma unroll
            for (int r = 0; r < 16; r += 2) { p0[r] = __builtin_amdgcn_exp2f(p0[r]); p0[r + 1] = __builtin_amdgcn_exp2f(p0[r + 1]); p1[r] = __builtin_amdgcn_exp2f(p1[r]); p1[r + 1] = __builtin_amdgcn_exp2f(p1[r + 1]);
                ps2 = ps2 + (f32x2_t){p0[r], p0[r + 1]}; ps2 = ps2 + (f32x2_t){p1[r], p1[r + 1]}; }
            lsum += ps2[0] + ps2[1];
            pg8::bf16x8 pb[4];
#pragma unroll
            for (int ks = 0; ks < 4; ++ks) { v4u w;
                if (ks < 2) { w.x = pg8::cvt_pk_bf16(p0[8 * ks], p0[8 * ks + 1]); w.y = pg8::cvt_pk_bf16(p0[8 * ks + 2], p0[8 * ks + 3]); w.z = pg8::cvt_pk_bf16(p0[8 * ks + 4], p0[8 * ks + 5]); w.w = pg8::cvt_pk_bf16(p0[8 * ks + 6], p0[8 * ks + 7]); }
                else { w.x = pg8::cvt_pk_bf16(p1[8 * ks - 16], p1[8 * ks - 15]); w.y = pg8::cvt_pk_bf16(p1[8 * ks - 14], p1[8 * ks - 13]); w.z = pg8::cvt_pk_bf16(p1[8 * ks - 12], p1[8 * ks - 11]); w.w = pg8::cvt_pk_bf16(p1[8 * ks - 10], p1[8 * ks - 9]); }
                pb[ks] = __builtin_bit_cast(pg8::bf16x8, w); }
#pragma unroll
            for (int d0 = 0; d0 < 2; ++d0)
#pragma unroll
                for (int ks = 0; ks < 4; ++ks) { const pg8::bf16x8 af = *(const LAS pg8::bf16x8*)(vb + (32 * d0 + r32) * KS + 16 * ks + 8 * hi); o[d0] = __builtin_amdgcn_mfma_f32_32x32x16_bf16(af, pb[ks], o[d0], 0, 0, 0); }
        }
        if (j + 1 < NT) AT_STORE(buf ^ 1);
        if (j + 2 < NT) AT_LOAD(j + 2);
        LDS_WAIT(); __builtin_amdgcn_s_barrier(); asm volatile("" ::: "memory");
    }
#undef AT_LOAD
#undef AT_STORE
    lsum = swapadd32(lsum); const float inv = 1.0f / lsum;
    LAS float* ox = OX + (qs * 32 + r32) * 65;
    if (s == 1) {
#pragma unroll
        for (int d0 = 0; d0 < 2; ++d0)
#pragma unroll
            for (int r = 0; r < 16; ++r) ox[32 * d0 + crow_(r, hi)] = o[d0][r] * inv; }
    LDS_WAIT(); __builtin_amdgcn_s_barrier(); asm volatile("" ::: "memory");
    if (s == 0) {
        float ss = 0.f;
#pragma unroll
        for (int d0 = 0; d0 < 2; ++d0)
#pragma unroll
            for (int r = 0; r < 16; ++r) { const float v = o[d0][r] * inv - lam * ox[32 * d0 + crow_(r, hi)]; o[d0][r] = v; ss += v * v; }
        ss = swapadd32(ss); const float rs = rsqrtf(ss * (1.0f / 64) + EPS) * (1.0f - lam_init);
        const int qpos = q0 + r32;
        if (qpos < L) { bf16* brp = BR + (size_t)(rowb + qpos) * D + 768 + h * 64;
#pragma unroll
            for (int d0 = 0; d0 < 2; ++d0)
#pragma unroll
                for (int r4 = 0; r4 < 4; ++r4) { const int dv = 32 * d0 + 8 * r4 + 4 * hi; const float* sl = C.in[I_SUBLN] + l * 64 + dv;
                    const unsigned w0 = pk2(o[d0][4 * r4] * rs * sl[0], o[d0][4 * r4 + 1] * rs * sl[1]), w1 = pk2(o[d0][4 * r4 + 2] * rs * sl[2], o[d0][4 * r4 + 3] * rs * sl[3]);
                    *(unsigned long long*)(brp + dv) = (unsigned long long)w0 | ((unsigned long long)w1 << 32); } }
    }
    LDS_WAIT(); __builtin_amdgcn_s_barrier(); asm volatile("" ::: "memory");
}
__device__ __forceinline__ void n2_attn_prompt_mfma(const Ctx& C, int l, float lam_init, int qoff = 0) {
    THREAD_IDS();
    const float lam = lam_of(C, l, lam_init);
    unsigned* qw = (unsigned*)(C.ws + WS_CTL) + CW_QUEUE + 64 * (l + qoff);
    volatile LAS int* slot = (volatile LAS int*)(C.lds + MISC_OFF + 64);
    constexpr int NQB = (L + 127) / 128;
    for (;;) {
        if (tid == 0) slot[0] = (int)__hip_atomic_fetch_add(qw, 1u, __ATOMIC_RELAXED, __HIP_MEMORY_SCOPE_AGENT);
        __syncthreads();
        const int it = slot[0];
        if (it >= 16 * NQB) break;
        attn_prompt_item(C, l, (it & 15) >> 2, it & 3, NQB - 1 - (it >> 4), lam, lam_init, 16.0f);
    }
}
constexpr int PSTR = 68;
__device__ __forceinline__ pg8::bf16x8 cvt8(const f32x4 a, const f32x4 b) { v4u w; w.x = pg8::cvt_pk_bf16(a[0], a[1]); w.y = pg8::cvt_pk_bf16(a[2], a[3]); w.z = pg8::cvt_pk_bf16(b[0], b[1]); w.w = pg8::cvt_pk_bf16(b[2], b[3]); return __builtin_bit_cast(pg8::bf16x8, w); }
__device__ __forceinline__ void attn_sample_item(const Ctx& C, int l, int b, int split) {
    THREAD_IDS();
    const int h = wave & 3, half = wave >> 2, c16 = lane & 15, g = lane >> 4, srow = c16 >> 3, t = c16 & 7;
    const bf16* QNB = WSP(bf16, WS_QNB); const int* PT = (const int*)C.in[I_PT];
    const float* CK = C.in[I_CK] + (size_t)l * NPOOL * PAGE * 256; const float* CV = C.in[I_CV] + (size_t)l * NPOOL * PAGE * 256;
    LAS float* BT = (LAS float*)C.lds;
    BT[tid] = (C.in[I_RELB][t5_bucket(tid & 127) * 4 + (tid >> 7)] - C.in[I_RELB][31 * 4 + (tid >> 7)]) * LOG2E;
    const v4u z4 = {0u, 0u, 0u, 0u};
    const v4u q0w = srow == 0 ? *(const v4u*)(QNB + (size_t)(MP + b * 8 + t) * 256 + h * 64 + 8 * g) : z4, q1w = srow == 1 ? *(const v4u*)(QNB + (size_t)(MP + b * 8 + t) * 256 + h * 64 + 32 + 8 * g) : z4;
    const pg8::bf16x8 qf0 = __builtin_bit_cast(pg8::bf16x8, q0w), qf1 = __builtin_bit_cast(pg8::bf16x8, q1w);
    LDS_WAIT(); __builtin_amdgcn_s_barrier(); asm volatile("" ::: "memory");
    float m = -INFINITY, lsum = 0.f; f32x4 o[4];
#pragma unroll
    for (int db = 0; db < 4; ++db) o[db] = (f32x4){0.f, 0.f, 0.f, 0.f};
    const int kk0 = split * 1024 + half * 512;
    for (int step = 0; step < 16; ++step) {
        const int kk = kk0 + 32 * step; const int page = PT[b * NPAGES + (kk >> 7)];
        const size_t base = ((size_t)(page * PAGE + (kk & 127)) * 4 + h) * 64;
        f32x4 kr[2][2][2]; float vr[4][8];
#pragma unroll
        for (int T = 0; T < 2; ++T)
#pragma unroll
            for (int ks = 0; ks < 2; ++ks) { const float* p = CK + base + (size_t)(16 * T + c16) * 256 + 32 * ks + 8 * g; kr[T][ks][0] = *(const f32x4*)p; kr[T][ks][1] = *(const f32x4*)(p + 4); }
#pragma unroll
        for (int db = 0; db < 4; ++db)
#pragma unroll
            for (int j = 0; j < 8; ++j) { const int kv = j < 4 ? 4 * g + j : 16 + 4 * g + (j - 4); vr[db][j] = CV[base + (size_t)kv * 256 + 16 * db + c16]; }
        f32x4 sv[2];
#pragma unroll
        for (int T = 0; T < 2; ++T) { sv[T] = (f32x4){0.f, 0.f, 0.f, 0.f};
            sv[T] = __builtin_amdgcn_mfma_f32_16x16x32_bf16(cvt8(kr[T][0][0], kr[T][0][1]), qf0, sv[T], 0, 0, 0);
            sv[T] = __builtin_amdgcn_mfma_f32_16x16x32_bf16(cvt8(kr[T][1][0], kr[T][1][1]), qf1, sv[T], 0, 0, 0); }
        if (kk + 31 + 128 > PAST) {
#pragma unroll
            for (int T = 0; T < 2; ++T)
#pragma unroll
                for (int r = 0; r < 4; ++r) { const int n = PAST + t - (kk + 16 * T + 4 * g + r); if (n < 128) sv[T][r] += BT[h * 128 + n]; } }
        float mt = fmaxf(fmaxf(fmaxf(sv[0][0], sv[0][1]), fmaxf(sv[0][2], sv[0][3])), fmaxf(fmaxf(sv[1][0], sv[1][1]), fmaxf(sv[1][2], sv[1][3])));
        mt = fmaxf(mt, __shfl_xor(mt, 16)); mt = fmaxf(mt, __shfl_xor(mt, 32));
        const float mn = fmaxf(m, mt); const float al = exp2f(m - mn); m = mn;
        float ps = 0.f;
#pragma unroll
        for (int T = 0; T < 2; ++T)
#pragma unroll
            for (int r = 0; r < 4; ++r) { sv[T][r] = exp2f(sv[T][r] - m); ps += sv[T][r]; }
        lsum = lsum * al + ps;
        const pg8::bf16x8 pf = cvt8(sv[0], sv[1]);
#pragma unroll
        for (int db = 0; db < 4; ++db) { o[db] = o[db] * al;
            const f32x4 va = {vr[db][0], vr[db][1], vr[db][2], vr[db][3]}, vb = {vr[db][4], vr[db][5], vr[db][6], vr[db][7]};
            o[db] = __builtin_amdgcn_mfma_f32_16x16x32_bf16(cvt8(va, vb), pf, o[db], 0, 0, 0); }
    }
    lsum += __shfl_xor(lsum, 16); lsum += __shfl_xor(lsum, 32);
    float* pp = WSP(float, WS_PART) + ((((size_t)b * 4 + h) * 16 + split * 2 + half) * 16 + c16) * PSTR;
#pragma unroll
    for (int db = 0; db < 4; ++db) *(f32x4*)(pp + 16 * db + 4 * g) = o[db];
    if (g == 0) { pp[64] = m; pp[65] = lsum; }
    LDS_WAIT(); __builtin_amdgcn_s_barrier(); asm volatile("" ::: "memory");
}
__device__ __forceinline__ void n2_attn_sample_split(const Ctx& C, int l) {
    for (int it = blockIdx.x; it < DB * 8; it += C.G) attn_sample_item(C, l, it >> 3, it & 7);
}
__device__ __forceinline__ void n3_attn_sample_combine(const Ctx& C, int l, float lam_init) {
    THREAD_IDS();
    const float lam = lam_of(C, l, lam_init);
    const bf16* QNB = WSP(bf16, WS_QNB); const bf16* KNB = WSP(bf16, WS_KNB); const bf16* ZM = WSP(bf16, WS_ZMIX); bf16* BR = WSP(bf16, WS_BR);
    for (int it = gw; it < DB * 4 * DS; it += NGW) {
        const int b = it >> 5, h = (it >> 3) & 3, t = it & 7; float os[2];
        const float far = C.in[I_RELB][31 * 4 + h];
#pragma unroll
        for (int s = 0; s < 2; ++s) {
            const float* pb = WSP(float, WS_PART) + ((((size_t)b * 4 + h) * 16) * 16 + s * 8 + t) * PSTR;
            float sn[8]; float mm = -INFINITY;
            for (int pi = 0; pi < 16; ++pi) mm = fmaxf(mm, pb[(size_t)pi * 16 * PSTR + 64]);
#pragma unroll
            for (int jj = 0; jj < 8; ++jj) { float d = 0.f;
                for (int i = 0; i < 32; ++i) d += bf2f(QNB[(size_t)(MP + b * 8 + t) * 256 + h * 64 + s * 32 + i]) * bf2f(KNB[(size_t)(MP + b * 8 + jj) * 256 + h * 64 + s * 32 + i]);
                d += (C.in[I_RELB][t5_bucket(t - jj < 0 ? 0 : t - jj) * 4 + h] - far) * LOG2E;
                sn[jj] = jj <= t ? d : -INFINITY; mm = fmaxf(mm, sn[jj]); }
            float ll = 0.f, oo = 0.f;
            for (int pi = 0; pi < 16; ++pi) { const float* pr = pb + (size_t)pi * 16 * PSTR; const float w = exp2f(pr[64] - mm); ll += pr[65] * w; oo += pr[lane] * w; }
#pragma unroll
            for (int jj = 0; jj < 8; ++jj) { const float w = exp2f(sn[jj] - mm); ll += w; oo += w * bf2f(ZM[(size_t)(MP + b * 8 + jj) * NMIXP + D_V + h * 64 + lane]); }
            os[s] = oo / ll;
        }
        const float o = os[0] - lam * os[1]; const float ms = wave_sum(o * o) * (1.0f / 64);
        BR[(size_t)(MP + b * 8 + t) * D + 768 + h * 64 + lane] = (bf16)f2bf(o * rsqrtf(ms + EPS) * C.in[I_SUBLN][l * 64 + lane] * (1.0f - lam_init));
    }
}

__device__ __forceinline__ void n3_la_finalize(const Ctx& C, int l) {
    THREAD_IDS();
    const float* LAO = WSP(float, WS_LAO); const bf16* ZM = WSP(bf16, WS_ZMIX); bf16* BR = WSP(bf16, WS_BR);
    const bool ret = lane < 32; const int hd = (lane >> 3) & 3, c8 = (lane & 7) * 8;
    float gn[8];
#pragma unroll
    for (int j = 0; j < 8; ++j) gn[j] = (ret ? C.in[I_RGN] : C.in[I_GGN])[(l * 4 + hd) * 64 + c8 + j];
    for (int r = gw; r < MR; r += NGW) {
        const f32x4 a = *(const f32x4*)(LAO + (size_t)r * 512 + 8 * lane), b = *(const f32x4*)(LAO + (size_t)r * 512 + 8 * lane + 4);
        const v4u gw4 = *(const v4u*)(ZM + (size_t)r * NMIXP + (ret ? R_G : G_R) + hd * 64 + c8);
        float x[8] = {a[0], a[1], a[2], a[3], b[0], b[1], b[2], b[3]}, g[8]; unpack8(gw4, g);
        float s = ((x[0] + x[1]) + (x[2] + x[3])) + ((x[4] + x[5]) + (x[6] + x[7]));
        s += __shfl_xor(s, 1); s += __shfl_xor(s, 2); s += __shfl_xor(s, 4);
        const float mean = ret ? s * (1.0f / 64) : 0.f; float q2 = 0.f;
#pragma unroll
        for (int j = 0; j < 8; ++j) { x[j] -= mean; q2 += x[j] * x[j]; }
        q2 += __shfl_xor(q2, 1); q2 += __shfl_xor(q2, 2); q2 += __shfl_xor(q2, 4);
        const float rs = rsqrtf(q2 * (1.0f / 64) + EPS);
#pragma unroll
        for (int j = 0; j < 8; ++j) x[j] = siluf_(g[j]) * x[j] * rs * gn[j];
        *(v4u*)(BR + (size_t)r * D + 256 + 8 * lane) = pack8(x);
    }
}

constexpr int NQB_ATT = (L + 127) / 128;
constexpr int IT_LA = 32, IT_SS = IT_LA + DB * 8, IT_AT = IT_SS + 16 * NQB_ATT, IT_LS = IT_AT + 256, IT_CV = IT_LS + (MR + 63) / 64, IT_END = IT_CV;
__device__ __forceinline__ void n2_phase(const Ctx& C, int l, float lam_init, int qslot) {
    THREAD_IDS();
    const float lam = lam_of(C, l, lam_init);
    float mb;
    { float mq = 0.f, mk = 0.f, mbias = 0.f;
#pragma unroll 1
      for (int i = 0; i < 32; ++i) { mq = fmaxf(mq, fabsf(C.in[I_QN][l * 32 + i])); mk = fmaxf(mk, fabsf(C.in[I_KN][l * 32 + i])); }
#pragma unroll 1
      for (int i = 0; i < 128; ++i) mbias = fmaxf(mbias, C.in[I_RELB][i] - C.in[I_RELB][31 * 4 + (i & 3)]);
      mb = 1.02f * 1.4426950408889634f * 5.656854249492381f * mq * mk + 1.4426950408889634f * mbias; }
    unsigned* qw = (unsigned*)(C.ws + WS_CTL) + CW_QUEUE + 64 * qslot;
    volatile LAS int* slot = (volatile LAS int*)(C.lds + MISC_OFF + 64);
    if (blockIdx.x < IT_LA) { const int it = blockIdx.x; const int b = (it >> 2) & 3, h = it & 3; if (it < 16) la_chunked<64, true>(C, l, false, b, h); else la_chunked<32, false>(C, l, false, b, h); }
#if defined(PROBE_ID)
    if (l == 0 && tid == 0) ((unsigned long long*)(C.ws + WS_CTL + 65536))[blockIdx.x * 16 + 3] = __builtin_amdgcn_s_memrealtime();
#endif
    for (;;) {
        if (tid == 0) slot[0] = (int)__hip_atomic_fetch_add(qw, 1u, __ATOMIC_RELAXED, __HIP_MEMORY_SCOPE_AGENT);
        __syncthreads();
        const int qi = slot[0];
        const int it = qi < 2 * DB * 8 ? ((qi & 1) ? IT_SS + (qi >> 1) : IT_LA + (qi >> 1)) : qi + IT_LA;
        __syncthreads();
        if (it >= IT_END) break;
        if (it < IT_SS) { const int i2 = it - IT_LA; attn_sample_item(C, l, i2 >> 3, i2 & 7); }
        else if (it < IT_AT) { const int i2 = it - IT_SS; attn_prompt_item(C, l, (i2 & 15) >> 2, i2 & 3, NQB_ATT - 1 - (i2 >> 4), lam, lam_init, mb); }
        else if (it < IT_LS) { const int i2 = it - IT_AT; const int b = (i2 >> 2) & 31, h = i2 & 3; if (i2 < 128) la_chunked<64, true>(C, l, true, b, h); else la_chunked<32, false>(C, l, true, b, h); }
        else { conv_rows_item(C, l, it - IT_LS); conv_state_item(C, l, it - IT_LS, IT_CV - IT_LS); }
    }
}

#ifndef PROBE_ID
#define PROBE_ID 0
#endif
#define TSTAMP(k) do { if (PROBE_ID && l == 0 && threadIdx.x == 0) { ((unsigned long long*)(C.ws + WS_CTL + 65536))[blockIdx.x * 16 + (k)] = __builtin_amdgcn_s_memrealtime(); } } while (0)
template <int l> __device__ __forceinline__ void layer_fwd(const Ctx& C, const XcdBarrier& bar) {
#define GRID_BAR() xcd_barrier<false>(bar)
    LAS unsigned char* ring = C.lds + RING_OFF;
    float* SS = WSP(float, WS_SS); float* H = WSP(float, WS_H); bf16* HB = WSP(bf16, WS_HB); bf16* ACT = WSP(bf16, WS_ACT); bf16* ZMIX = WSP(bf16, WS_ZMIX); bf16* GATES = WSP(bf16, WS_GATES);
    bf16* BR = WSP(bf16, WS_BR); bf16* MERGED = WSP(bf16, WS_MERGED);
    constexpr float lam_init = l == 0 ? 0.2f : 0.35550906759096926f;
    constexpr bool last = (l == DEPTH - 1);
    TSTAMP(10);
    { pg8::Gemm g{HB, WSP(bf16, WS_W1 + (size_t)(l * 2 + 0) * SZ_W1), D, D, D}; pg8::StaticOrder S; S.init(M, 2 * DFF, C.G, (int)blockIdx.x);
      EpiGLU E{ACT, SS + (size_t)(l * 3 + 0) * M * 16}; pg8::gemm_phase<EpiGLU, pg8::StaticOrder, true, true>(ring, g, S, E); }
    TSTAMP(11);
    GRID_BAR();
    TSTAMP(12);
    { pg8::HeadOrder S; S.init(M, D, C.G, (int)blockIdx.x); S.limit = C.G; EpiRes<false, 1> E{H, HB, SS + (size_t)(l * 3 + 1) * M * 16, nullptr};
      { pg8::Gemm g{ACT, WSP(bf16, WS_WD + (size_t)(l * 2 + 0) * SZ_WD), DFF, DFF, DFF}; pg8::gemm_phase<EpiRes<false, 1>, pg8::HeadOrder, true, true>(ring, g, S, E); }
      { int kt = DFF / 11; asm volatile("" : "+s"(kt)); pg8::Gemm g{ACT, WSP(bf16, WS_WD + (size_t)(l * 2 + 0) * SZ_WD), DFF, DFF, kt}; pg8::TailOrder T; T.init(M, D, C.G, (int)blockIdx.x); T.limit = C.G; T.nsplit = 11; T.kper = DFF / 11;
        EpiPartial EP{WSP(float, WS_KSP)}; pg8::gemm_phase<EpiPartial, pg8::TailOrder, true, true>(ring, g, T, EP); }
      GRID_BAR();
      ksp_finalize<11>(WSP(float, WS_KSP), S, C.G, E); }
    TSTAMP(13);
    GRID_BAR();
    TSTAMP(14);
    { pg8::Gemm g{HB, WSP(bf16, WS_WIN + (size_t)l * SZ_WIN), D, D, D}; pg8::StaticOrder S; S.init(M, NINP, C.G, (int)blockIdx.x);
      EpiZ E{ZMIX, GATES, SS + (size_t)(l * 3 + 1) * M * 16, WSP(float, WS_BINP) + l * NINP}; pg8::gemm_phase<EpiZ, pg8::StaticOrder, true, true>(ring, g, S, E); }
    TSTAMP(15);
    GRID_BAR();
    TSTAMP(0);
    n1_prep(C, l);
    TSTAMP(1);
    GRID_BAR();
    TSTAMP(2);
    n2_phase(C, l, lam_init, l);
    TSTAMP(6);
    GRID_BAR();
    TSTAMP(7);
    n3_attn_sample_combine(C, l, lam_init);
    n3_la_finalize(C, l);
    TSTAMP(8);
    GRID_BAR();
    TSTAMP(9);
    { pg8::Gemm g{BR, WSP(bf16, WS_WBR + (size_t)l * SZ_WBR), D, 256, 256}; pg8::MergeOrder S; S.init(M, C.G, (int)blockIdx.x);
      EpiMerge E{MERGED, GATES}; pg8::gemm_phase<EpiMerge, pg8::MergeOrder, true, true>(ring, g, S, E); }
    GRID_BAR();
    { pg8::Gemm g{MERGED, WSP(bf16, WS_WOUT + (size_t)l * SZ_WOUT), D, D, D}; pg8::StaticOrder S; S.init(M, D, C.G, (int)blockIdx.x);
      EpiRes<false, 2> E{H, HB, SS + (size_t)(l * 3 + 2) * M * 16, nullptr}; pg8::gemm_phase<EpiRes<false, 2>, pg8::StaticOrder, true, true>(ring, g, S, E); }
    GRID_BAR();
    { pg8::Gemm g{HB, WSP(bf16, WS_W1 + (size_t)(l * 2 + 1) * SZ_W1), D, D, D}; pg8::StaticOrder S; S.init(M, 2 * DFF, C.G, (int)blockIdx.x);
      EpiGLU E{ACT, SS + (size_t)(l * 3 + 2) * M * 16}; pg8::gemm_phase<EpiGLU, pg8::StaticOrder, true, true>(ring, g, S, E); }
    GRID_BAR();
    { pg8::HeadOrder S; S.init(M, D, C.G, (int)blockIdx.x); S.limit = C.G; EpiRes<last, 1> E{H, HB, last ? nullptr : SS + (size_t)((l + 1) * 3) * M * 16, C.out};
      { pg8::Gemm g{ACT, WSP(bf16, WS_WD + (size_t)(l * 2 + 1) * SZ_WD), DFF, DFF, DFF}; pg8::gemm_phase<EpiRes<last, 1>, pg8::HeadOrder, true, true>(ring, g, S, E); }
      { int kt = DFF / 11; asm volatile("" : "+s"(kt)); pg8::Gemm g{ACT, WSP(bf16, WS_WD + (size_t)(l * 2 + 1) * SZ_WD), DFF, DFF, kt}; pg8::TailOrder T; T.init(M, D, C.G, (int)blockIdx.x); T.limit = C.G; T.nsplit = 11; T.kper = DFF / 11;
        EpiPartial EP{WSP(float, WS_KSP)}; pg8::gemm_phase<EpiPartial, pg8::TailOrder, true, true>(ring, g, T, EP); }
      GRID_BAR();
      ksp_finalize<11>(WSP(float, WS_KSP), S, C.G, E); }
#undef GRID_BAR
}

__global__ void __launch_bounds__(NWAVES * 64, 2) fwd(Params P) {
    extern __shared__ __attribute__((aligned(16))) unsigned char lds[];
    Ctx C;
    C.in = P.in; C.out = P.out; C.ws = P.ws; C.lds = (LAS unsigned char*)lds;
    C.G = gridDim.x;
    volatile LAS unsigned* MISC = (volatile LAS unsigned*)(C.lds + MISC_OFF);
    for (int u = threadIdx.x; u < (LDS_BYTES - LDSCTL_OFF) / 4; u += NWAVES * 64) ((LAS unsigned*)(C.lds + LDSCTL_OFF))[u] = 0u;
    __syncthreads();
    unsigned* ctl = (unsigned*)(C.ws + WS_CTL);
    XcdBarrier bar = xcd_barrier_post(ctl + CW_BAR, MISC + 8);
    p0_prologue(C, P);
#if PROBE_ID == 700001
    p0_prologue(C, P);
#endif
    xcd_barrier<true>(bar);
    layer_fwd<0>(C, bar);
    xcd_barrier<false>(bar);
    layer_fwd<1>(C, bar);
#if PROBE_ID
    xcd_barrier<false>(bar);
    if (blockIdx.x == 0 && threadIdx.x == 0) { const unsigned long long* ts = (const unsigned long long*)(C.ws + WS_CTL + 65536);
        const int pb = PROBE_ID / 1000, k0 = (PROBE_ID / 10) % 100 % 10, k1 = PROBE_ID % 10;
        float val = (float)(ts[pb * 16 + k1] - ts[pb * 16 + k0]) * 0.001f;
        if (PROBE_ID >= 500000 && PROBE_ID < 600000) val = (float)(ts[PROBE_ID % 100] - ts[(PROBE_ID / 100) % 100]) * 0.001f;
        C.out[O_YP] = val; }
#endif
}

extern "C" void kernel_launch(void* const* d_in, const int* in_sizes, int n_in, void* d_out, int out_size, void* d_ws, size_t ws_size, hipStream_t stream) {
    static int grid = 0;
    if (grid == 0) {
        if (n_in != N_INPUTS || (size_t)out_size != O_END || ws_size < WS_END) { fprintf(stderr, "kernel_launch: unexpected shapes: n_in %d out %d (want %zu) ws %zu (want %zu)\n", n_in, out_size, (size_t)O_END, ws_size, (size_t)WS_END); grid = -1; return; }
        int dev = 0, cus = 0, per_cu = 0;
        if (hipGetDevice(&dev) != hipSuccess || hipDeviceGetAttribute(&cus, hipDeviceAttributeMultiprocessorCount, dev) != hipSuccess) { grid = -1; return; }
        if (hipFuncSetAttribute((const void*)fwd, hipFuncAttributeMaxDynamicSharedMemorySize, LDS_BYTES) != hipSuccess) { fprintf(stderr, "kernel_launch: hipFuncSetAttribute failed\n"); grid = -1; return; }
        if (hipOccupancyMaxActiveBlocksPerMultiprocessor(&per_cu, (const void*)fwd, NWAVES * 64, LDS_BYTES) != hipSuccess || per_cu < 1) { fprintf(stderr, "kernel_launch: occupancy query says %d blocks per CU\n", per_cu); }
        (void)hipGetLastError();
        grid = cus;
    }
    if (grid < 0) return;
    if (hipMemsetAsync((char*)d_ws + WS_CTL, 0, CTL_ZERO_BYTES, stream) != hipSuccess) return;
    Params p{};
    for (int i = 0; i < N_INPUTS; ++i) p.in[i] = (const float*)d_in[i];
    p.out = (float*)d_out; p.ws = (unsigned char*)d_ws;
    for (int i = 0; i < 32; ++i) p.inv_freq[i] = (float)pow(10000.0, -(double)i / 32.0);
    hipLaunchKernelGGL(fwd, dim3(grid), dim3(NWAVES * 64), LDS_BYTES, stream, p);
}
```

```cpp
#include <hip/hip_runtime.h>
#include <cstdio>
#include <cstdint>
#include <cmath>

namespace pg8 {
#define PG8_LAS __attribute__((address_space(3)))
typedef unsigned short bf16_t;
typedef short bf16x8 __attribute__((ext_vector_type(8)));
typedef float f32x4 __attribute__((ext_vector_type(4)));
typedef unsigned u32x4 __attribute__((ext_vector_type(4)));
constexpr int BM = 256, BK = 64, HALF = 128, HTB = HALF * BK * 2  , STAGE_BYTES = 8 * HTB, NXCD = 8, WGM = 8;

__host__ __device__ __forceinline__ int lds_byte(int r, int c) { const int st = (r >> 4) * 2 + (c >> 5), rr = r & 15, cc = c & 31, ob = rr * 64 + cc * 2; return st * 1024 + (ob ^ (((ob >> 9) & 1) << 5)); }
__host__ __device__ __forceinline__ void stage_rc(int b, int& R, int& C) { const int st = b / 1024, sb = b % 1024, swz = sb ^ (((sb >> 9) & 1) << 5); R = (st >> 1) * 16 + swz / 64; C = (st & 1) * 32 + (swz % 64) / 2; }
__host__ __device__ __forceinline__ int perm32(int rho) { const int n = rho >> 4, i = rho & 15; return 8 * (i >> 2) + 4 * n + (i & 3); }

struct Unit { int pm, pn, acol, bcol; };
struct Gemm { const bf16_t* A; const bf16_t* Bt; int lda, ldb, K; };

struct StaticOrder {
    int nM, nN, nwg, G, c;
    __host__ __device__ void init(int M, int N, int G_, int c_) { nM = M / BM; nN = N / BM; nwg = nM * nN; G = G_; c = c_; }
    __host__ __device__ void unit_of(int L, Unit& u) const {
        int wgid = L; { const int q = nwg / NXCD, r = nwg % NXCD, xcd = wgid % NXCD, off = wgid / NXCD; wgid = (xcd < r ? xcd * (q + 1) : r * (q + 1) + (xcd - r) * q) + off; }
        const int nig = WGM * nN, gid = wgid / nig, fm = gid * WGM, gsz = (nM - fm) < WGM ? (nM - fm) : WGM;
        u.pm = fm + ((wgid % nig) % gsz); u.pn = (wgid % nig) / gsz; u.acol = 0; u.bcol = 0;
    }
    __host__ __device__ bool next(int i, Unit& u) const { const long L = (long)i * G + c; if (L >= nwg) return false; unit_of((int)L, u); return true; }
};
struct HeadOrder : StaticOrder { int limit; __host__ __device__ bool next(int i, Unit& u) const { const long L = (long)i * G + c; if (L >= limit || L >= nwg) return false; unit_of((int)L, u); return true; } };
struct TailOrder : StaticOrder { int limit, nsplit, kper;
    __host__ __device__ bool next(int i, Unit& u) const {
        if (i > 0 || c >= (nwg - limit) * nsplit) return false;
        unit_of(limit + c / nsplit, u); u.acol = u.bcol = (c % nsplit) * kper; return true; } };
struct MergeOrder {
    int ntile, G, c;
    __host__ __device__ void init(int M, int G_, int c_) { ntile = (M / BM) * 4; G = G_; c = c_; }
    __host__ __device__ bool next(int i, Unit& u) const {
        const int T = (i >> 2) * G + c; if (T >= ntile) return false;
        const int n = i & 3; u.pm = T >> 2; u.pn = n * 4 + (T & 3); u.acol = n * 256; u.bcol = 0; return true;
    }
};

__device__ __forceinline__ unsigned cvt_pk_bf16(float lo, float hi) { unsigned r; asm volatile("v_cvt_pk_bf16_f32 %0, %1, %2" : "=v"(r) : "v"(lo), "v"(hi)); return r; }

template <class Epi, class Sched, bool ALIGN_EPI = false, bool SP2 = false, int SEG = 0>
__device__ __forceinline__ void gemm_phase(PG8_LAS unsigned char* lds, const Gemm g, const Sched& S, const Epi& E) {
    int tid_ = threadIdx.x; asm volatile("" : "+v"(tid_));
    const int tid = tid_, wid = __builtin_amdgcn_readfirstlane(tid >> 6), lane = tid & 63, wr = wid >> 2, wc = wid & 3, fr = lane & 15, fq = lane >> 4;
    const int nt = g.K / BK;
    unsigned voffA[2], voffB[2];
#pragma unroll
    for (int i = 0; i < 2; ++i) { int R, C; stage_rc(tid * 16 + i * 8192, R, C); const int Rb = Epi::PERM ? ((R & ~31) + perm32(R & 31)) : R;
        voffA[i] = (unsigned)(R * g.lda + C) * 2u; voffB[i] = (unsigned)(Rb * g.ldb + C) * 2u; }
    const size_t kstep = (size_t)(BK * 2);
    const size_t hstepA = (size_t)HALF * g.lda * 2, hstepB = (size_t)HALF * g.ldb * 2;
    const size_t tstepA = 2 * hstepA, tstepB = 2 * hstepB;
    const unsigned ldsw = (unsigned)wid * 1024u;
    const int aoff = lds_byte(wr * 64 + fr, fq * 8), boff = lds_byte(wc * 32 + fr, fq * 8);
#define PG8_SA(b, h) (((b) * 2 + (h)) * HTB)
#define PG8_SB(b, h) ((4 + (b) * 2 + (h)) * HTB)
#define PG8_STAGE(bufoff, gbase, voff) do { _Pragma("unroll") for (int _i = 0; _i < 2; ++_i) \
        __builtin_amdgcn_global_load_lds((const unsigned*)((const char*)(gbase) + (voff)[_i]), (PG8_LAS unsigned*)(lds + (bufoff) + ldsw + _i * 8192), 16, 0, 0); } while (0)
#define PG8_LDA(dst, b, h) do { _Pragma("unroll") for (int m = 0; m < 4; ++m) _Pragma("unroll") for (int k = 0; k < 2; ++k) dst[m][k] = *(const PG8_LAS bf16x8*)(lds + PG8_SA(b, h) + aoff + m * 2048 + k * 1024); } while (0)
#define PG8_LDB(dst, b, h) do { _Pragma("unroll") for (int n = 0; n < 2; ++n) _Pragma("unroll") for (int k = 0; k < 2; ++k) dst[n][k] = *(const PG8_LAS bf16x8*)(lds + PG8_SB(b, h) + boff + n * 2048 + k * 1024); } while (0)
#define PG8_MMA(ai, bj, At, Bt) do { __builtin_amdgcn_s_setprio(1); _Pragma("unroll") for (int m = 0; m < 4; ++m) _Pragma("unroll") for (int n = 0; n < 2; ++n) _Pragma("unroll") for (int k = 0; k < 2; ++k) \
        acc[ai][bj][m][n] = __builtin_amdgcn_mfma_f32_16x16x32_bf16(Bt[n][k], At[m][k], acc[ai][bj][m][n], 0, 0, 0); __builtin_amdgcn_s_setprio(0); } while (0)
#define PG8_WAIT_V(n) asm volatile("s_waitcnt vmcnt(" #n ")" ::: "memory")
#define PG8_WAIT_L(n) asm volatile("s_waitcnt lgkmcnt(" #n ")" ::: "memory")
#define PG8_BAR __builtin_amdgcn_s_barrier()
#define PG8_SCHED __builtin_amdgcn_sched_barrier(0)
    Unit cur, nxt; int ui = 0;
    if (!S.next(0, cur)) return;
    f32x4 acc[2][2][4][2];
#pragma unroll
    for (int a = 0; a < 2; ++a)
#pragma unroll
        for (int b = 0; b < 2; ++b)
#pragma unroll
            for (int m = 0; m < 4; ++m)
#pragma unroll
                for (int n = 0; n < 2; ++n) acc[a][b][m][n] = (f32x4){0.f, 0.f, 0.f, 0.f};
    bf16x8 At[4][2], B0[2][2], B1[2][2];
    const char* cA = (const char*)g.A + (size_t)cur.pm * tstepA + (size_t)cur.acol * 2; const char* cB = (const char*)g.Bt + (size_t)cur.pn * tstepB + (size_t)cur.bcol * 2;
    if constexpr (SP2) {
        PG8_STAGE(PG8_SB(0, 0), cB, voffB); PG8_STAGE(PG8_SB(0, 1), cB + hstepB, voffB); PG8_STAGE(PG8_SA(0, 0), cA, voffA); PG8_STAGE(PG8_SA(0, 1), cA + hstepA, voffA);
        if (wr == 1) PG8_BAR;
        PG8_WAIT_V(2); PG8_BAR;
        PG8_STAGE(PG8_SB(1, 0), cB + kstep, voffB); PG8_STAGE(PG8_SA(1, 0), cA + kstep, voffA); PG8_STAGE(PG8_SB(1, 1), cB + hstepB + kstep, voffB);
        PG8_WAIT_V(6); PG8_BAR;
    } else {
        PG8_STAGE(PG8_SB(0, 0), cB, voffB); PG8_STAGE(PG8_SA(0, 0), cA, voffA); PG8_STAGE(PG8_SB(0, 1), cB + hstepB, voffB); PG8_STAGE(PG8_SA(0, 1), cA + hstepA, voffA);
        if (wr == 1) PG8_BAR;
        PG8_WAIT_V(4); PG8_BAR;
        PG8_STAGE(PG8_SB(1, 0), cB + kstep, voffB); PG8_STAGE(PG8_SA(1, 0), cA + kstep, voffA); PG8_STAGE(PG8_SB(1, 1), cB + hstepB + kstep, voffB);
        PG8_WAIT_V(6); PG8_BAR;
    }
    for (;;) {
        const bool has_next = S.next(ui + 1, nxt);
        const char* nA = has_next ? (const char*)g.A + (size_t)nxt.pm * tstepA + (size_t)nxt.acol * 2 : cA; const char* nB = has_next ? (const char*)g.Bt + (size_t)nxt.pn * tstepB + (size_t)nxt.bcol * 2 : cB;
        for (int t = 0; t < nt; t += 2) {
            const bool last = (t == nt - 2);
            const char* a1 = cA + (size_t)(t + 1) * kstep;
            const char* a2 = last ? nA : cA + (size_t)(t + 2) * kstep; const char* b2 = last ? nB : cB + (size_t)(t + 2) * kstep;
            const char* a3 = a2 + kstep; const char* b3 = b2 + kstep;
            if constexpr (SP2) {
            PG8_LDB(B0, 0, 0); PG8_LDB(B1, 0, 1); PG8_SCHED; PG8_LDA(At, 0, 0); PG8_STAGE(PG8_SA(1, 1), a1 + hstepA, voffA);
            PG8_WAIT_V(8); PG8_WAIT_L(0); PG8_BAR; PG8_MMA(0, 0, At, B0); PG8_MMA(0, 1, At, B1); PG8_BAR; PG8_SCHED;
            PG8_LDA(At, 0, 1); PG8_STAGE(PG8_SB(0, 0), b2, voffB); PG8_STAGE(PG8_SB(0, 1), b2 + hstepB, voffB); PG8_STAGE(PG8_SA(0, 0), a2, voffA);
            PG8_WAIT_V(8); PG8_WAIT_L(0); PG8_BAR; PG8_MMA(1, 0, At, B0); PG8_MMA(1, 1, At, B1); PG8_BAR; PG8_SCHED;
            PG8_LDB(B0, 1, 0); PG8_LDB(B1, 1, 1); PG8_SCHED; PG8_LDA(At, 1, 0); PG8_STAGE(PG8_SA(0, 1), a2 + hstepA, voffA);
            PG8_WAIT_V(8); PG8_WAIT_L(0); PG8_BAR; PG8_MMA(0, 0, At, B0); PG8_MMA(0, 1, At, B1); PG8_BAR; PG8_SCHED;
            PG8_LDA(At, 1, 1); PG8_STAGE(PG8_SB(1, 0), b3, voffB); PG8_STAGE(PG8_SB(1, 1), b3 + hstepB, voffB); PG8_STAGE(PG8_SA(1, 0), a3, voffA);
            PG8_WAIT_V(8); PG8_WAIT_L(0); PG8_BAR; PG8_MMA(1, 0, At, B0); PG8_MMA(1, 1, At, B1); PG8_BAR; PG8_SCHED;
            } else {
            PG8_LDB(B0, 0, 0); PG8_SCHED; PG8_LDA(At, 0, 0); PG8_STAGE(PG8_SA(1, 1), a1 + hstepA, voffA);
            PG8_WAIT_L(8); PG8_BAR; PG8_WAIT_L(0); PG8_MMA(0, 0, At, B0); PG8_BAR; PG8_SCHED;
            PG8_LDB(B1, 0, 1); PG8_STAGE(PG8_SB(0, 0), b2, voffB);
            PG8_BAR; PG8_WAIT_L(0); PG8_MMA(0, 1, At, B1); PG8_BAR;
            PG8_LDA(At, 0, 1); PG8_STAGE(PG8_SA(0, 0), a2, voffA);
            PG8_BAR; PG8_WAIT_L(0); PG8_MMA(1, 0, At, B0); PG8_BAR; PG8_SCHED;
            PG8_STAGE(PG8_SB(0, 1), b2 + hstepB, voffB);
            PG8_WAIT_V(6); PG8_BAR; PG8_MMA(1, 1, At, B1); PG8_BAR;
            PG8_LDB(B0, 1, 0); PG8_SCHED; PG8_LDA(At, 1, 0); PG8_STAGE(PG8_SA(0, 1), a2 + hstepA, voffA);
            PG8_WAIT_L(8); PG8_BAR; PG8_WAIT_L(0); PG8_MMA(0, 0, At, B0); PG8_BAR; PG8_SCHED;
            PG8_LDB(B1, 1, 1); PG8_STAGE(PG8_SB(1, 0), b3, voffB);
            PG8_BAR; PG8_WAIT_L(0); PG8_MMA(0, 1, At, B1); PG8_BAR;
            PG8_LDA(At, 1, 1); PG8_STAGE(PG8_SA(1, 0), a3, voffA);
            PG8_BAR; PG8_WAIT_L(0); PG8_MMA(1, 0, At, B0); PG8_BAR; PG8_SCHED;
            PG8_STAGE(PG8_SB(1, 1), b3 + hstepB, voffB);
            PG8_WAIT_V(6); PG8_BAR; PG8_MMA(1, 1, At, B1); PG8_BAR;
            }
            if constexpr (SEG > 0) { if (((t + 2) % SEG) == 0 && (t + 2) < nt) E.mid(acc, cur, (t + 2) / SEG); }
        }
        if constexpr (ALIGN_EPI) { if (wr == 0) PG8_BAR; }
        E(acc, cur, wr, wc, fr, fq);
        if (!has_next) break;
#pragma unroll
        for (int a = 0; a < 2; ++a)
#pragma unroll
            for (int b = 0; b < 2; ++b)
#pragma unroll
                for (int m = 0; m < 4; ++m)
#pragma unroll
                    for (int n = 0; n < 2; ++n) acc[a][b][m][n] = (f32x4){0.f, 0.f, 0.f, 0.f};
        cur = nxt; cA = nA; cB = nB; ++ui;
        if constexpr (ALIGN_EPI) { if (wr == 1) PG8_BAR; }
    }
    PG8_WAIT_V(0);
    if constexpr (!ALIGN_EPI) { if (wr == 0) PG8_BAR; }
    PG8_BAR;
#undef PG8_SA
#undef PG8_SB
#undef PG8_STAGE
#undef PG8_LDA
#undef PG8_LDB
#undef PG8_MMA
#undef PG8_WAIT_V
#undef PG8_WAIT_L
#undef PG8_BAR
#undef PG8_SCHED
}
}

constexpr int NWAVES = 8;
constexpr int D = 1024, DFF = 2816, NIN = 7184, NMIX = 3088, NMIXP = 3328, NGATE = 4096, NINP = NMIXP + NGATE;
constexpr int SEQ = 4096, NMETA = 16, L = SEQ + NMETA, BATCH = 4, DB = 32, DS = 8, PAST = 8192, PAGE = 128, NPAGES = PAST / PAGE, NPOOL = 2560, DEPTH = 2;
constexpr int MP = BATCH * L, MS = DB * DS, MR = MP + MS, M = 16896;
constexpr int NPOS = L + DS;
constexpr float EPS = 1e-6f;
constexpr int C_A = 0, C_G = 256, R_Q = 512, R_K = 768, R_V = 1024, R_G = 1280, G_Q = 1536, G_K = 1664, G_V = 1792, G_R = 2048, G_LOW = 2304, D_Q = 2320, D_K = 2576, D_V = 2832;
constexpr size_t O_YP = 0, O_YS = O_YP + (size_t)BATCH * SEQ * D, O_KP = O_YS + (size_t)MS * D, O_VP = O_KP + (size_t)DEPTH * MP * 256, O_KS = O_VP + (size_t)DEPTH * MP * 256,
                 O_VS = O_KS + (size_t)DEPTH * MS * 256, O_RP = O_VS + (size_t)DEPTH * MS * 256, O_RS = O_RP + (size_t)DEPTH * BATCH * 4 * 64 * 64, O_GP = O_RS + (size_t)DEPTH * DB * 4 * 64 * 64,
                 O_GS = O_GP + (size_t)DEPTH * BATCH * 4 * 32 * 64, O_CP = O_GS + (size_t)DEPTH * DB * 4 * 32 * 64, O_CS = O_CP + (size_t)DEPTH * BATCH * 30 * 256, O_END = O_CS + (size_t)DEPTH * DB * 30 * 256;
enum { I_XP = 0, I_XS, I_CK, I_CV, I_PT, I_SRET, I_SGLA, I_SCONV, I_META, I_RELB, I_NF1, I_F1G, I_F1U, I_F1D, I_NMIX, I_WIN, I_BIN, I_CW, I_CB, I_CLG, I_CLB, I_RGN, I_GAW, I_GAB, I_GGN,
       I_QN, I_KN, I_LQ1, I_LK1, I_LQ2, I_LK2, I_SUBLN, I_WBR, I_WOUT, I_NF2, I_F2G, I_F2U, I_F2D, N_INPUTS };

constexpr size_t MiB = 1u << 20;
constexpr size_t WS_CTL = 0, CTL_ZERO_BYTES = 1 * MiB;
constexpr size_t SZ_SS = (size_t)M * 16 * 4;
constexpr size_t SZ_W1 = (size_t)2 * DFF * D * 2, SZ_WD = (size_t)D * DFF * 2, SZ_WIN = (size_t)NINP * D * 2, SZ_WBR = (size_t)4 * D * 256 * 2, SZ_WOUT = (size_t)D * D * 2;
constexpr size_t WS_W1 = 4 * MiB;
constexpr size_t WS_WD = WS_W1 + 4 * SZ_W1;
constexpr size_t WS_WIN = WS_WD + 4 * SZ_WD;
constexpr size_t WS_WBR = WS_WIN + 2 * SZ_WIN;
constexpr size_t WS_WOUT = WS_WBR + 2 * SZ_WBR;
constexpr size_t WS_BINP = WS_WOUT + 2 * SZ_WOUT;
constexpr size_t WS_ROPE = WS_BINP + 64 * 1024;
constexpr size_t WS_SS = WS_ROPE + 2 * MiB;
constexpr size_t WS_H = 128 * MiB;
constexpr size_t WS_HB = WS_H + (size_t)M * D * 4;
constexpr size_t WS_ACT = WS_HB + (size_t)M * D * 2;
constexpr size_t WS_ZMIX = WS_ACT + (size_t)M * DFF * 2;
constexpr size_t WS_GATES = WS_ZMIX + (size_t)M * NMIXP * 2;
constexpr size_t WS_BR = WS_GATES + (size_t)M * NGATE * 2;
constexpr size_t WS_MERGED = WS_BR + (size_t)M * D * 2;
constexpr size_t WS_UBUF = WS_MERGED + (size_t)M * D * 2;
constexpr size_t WS_RQ = WS_UBUF + (size_t)M * 256 * 4, WS_RK = WS_RQ + (size_t)M * 256 * 4, WS_QN = WS_RK + (size_t)M * 256 * 4, WS_KN = WS_QN + (size_t)M * 256 * 4, WS_VB = WS_KN + (size_t)M * 256 * 4;
constexpr size_t WS_LDEC = WS_VB + (size_t)M * 256 * 4;
constexpr size_t WS_QNB = WS_LDEC + (size_t)M * 128 * 4;
constexpr size_t WS_KNB = WS_QNB + (size_t)M * 256 * 2;
constexpr size_t WS_PART = WS_KNB + (size_t)M * 256 * 2;
constexpr size_t WS_LAO = WS_PART + (size_t)DB * 4 * 16 * 16 * 68 * 4;
constexpr size_t WS_KSP = WS_LAO + (size_t)M * 512 * 4;
constexpr size_t WS_END = WS_KSP + (size_t)8 * 11 * 65536 * 4;
static_assert(WS_ROPE + 2 * NPOS * 32 * 4 <= WS_SS && WS_SS + 6 * SZ_SS <= WS_H, "weights region overflows");
constexpr int CW_BAR = 4096, CW_QUEUE = 8192;

constexpr int RING_OFF = 0, RING_BYTES = 131072;
constexpr int LDSCTL_OFF = 144384, MISC_OFF = LDSCTL_OFF + 320;
constexpr int LDS_BYTES = 147456;
static_assert(MISC_OFF + 128 <= LDS_BYTES, "LDS map");

#define GAS __attribute__((address_space(1)))
#define LAS __attribute__((address_space(3)))
typedef unsigned short bf16;
typedef unsigned v4u __attribute__((ext_vector_type(4)));
typedef float f32x4 __attribute__((ext_vector_type(4)));
#define LDS_WAIT() asm volatile("s_waitcnt lgkmcnt(0)" ::: "memory")
#define VM_WAIT() asm volatile("s_waitcnt vmcnt(0)" ::: "memory")
__device__ __forceinline__ unsigned f2bf(float f) { unsigned u = __builtin_bit_cast(unsigned, f); return (u + 0x7fffu + ((u >> 16) & 1u)) >> 16; }
__device__ __forceinline__ unsigned pk2(float lo, float hi) { return f2bf(lo) | (f2bf(hi) << 16); }
__device__ __forceinline__ float bf2f(bf16 b) { return __builtin_bit_cast(float, ((unsigned)b) << 16); }
__device__ __forceinline__ float bflo(unsigned w) { return __builtin_bit_cast(float, w << 16); }
__device__ __forceinline__ float bfhi(unsigned w) { return __builtin_bit_cast(float, w & 0xffff0000u); }
__device__ __forceinline__ float wave_sum(float v) {
#pragma unroll
    for (int o = 1; o < 64; o <<= 1) v += __shfl_xor(v, o);
    return v;
}
__device__ __forceinline__ float sigmoidf_(float x) { return __builtin_amdgcn_rcpf(1.0f + __expf(-x)); }
__device__ __forceinline__ float siluf_(float x) { return x * __builtin_amdgcn_rcpf(1.0f + __expf(-x)); }

#define XB_TMO      128
#define XB_XCNT(j)  (256  + 64 * (j))
#define XB_XSUB(j)  (1280 + 64 * (j))
#define XB_XGEN(j)  (2304 + 64 * (j))
#define XB_TOP      3328
#define XB_TOPGEN   3392
#define XCD_BAR_WORDS 3456
#define XB_SPIN_CAP (1u << 22)

__device__ __forceinline__ unsigned xb_ld(unsigned* p)              { return __hip_atomic_load(p, __ATOMIC_RELAXED, __HIP_MEMORY_SCOPE_AGENT); }
__device__ __forceinline__ unsigned xb_add(unsigned* p, unsigned v) { return __hip_atomic_fetch_add(p, v, __ATOMIC_RELAXED, __HIP_MEMORY_SCOPE_AGENT); }
__device__ __forceinline__ unsigned xb_xcc_id() { return (unsigned)__builtin_amdgcn_s_getreg((3 << 11) | 20) & 0xFu; }
#define XB_SPIN(cond, bar) do { unsigned _sp = 0; while (cond) { __builtin_amdgcn_s_sleep(1); \
    if ((++_sp & 255u) == 0u) { if (xb_ld(&(bar)[XB_TMO])) break; if (_sp > XB_SPIN_CAP) { atomicAdd(&(bar)[XB_TMO], 1u); break; } } } } while (0)

struct XcdBarrier { unsigned* bar; unsigned x; volatile LAS unsigned* st; };

__device__ __forceinline__ XcdBarrier xcd_barrier_post(unsigned* bar, volatile LAS unsigned* st) {
    XcdBarrier b; b.bar = bar; b.x = xb_xcc_id(); b.st = st;
    if (threadIdx.x == 0) (void)xb_add(&bar[XB_XCNT(b.x)], 1u);
    return b;
}
__device__ __forceinline__ void xcd_barrier_complete(unsigned* bar, unsigned x, unsigned& nloc, unsigned& nx) {
    const unsigned G = gridDim.x * gridDim.y * gridDim.z;
    unsigned sum, cnt, mine, sp = 0u;
    for (;;) {
        sum = 0u; cnt = 0u; mine = 0u;
#pragma unroll
        for (unsigned j = 0; j < 16; ++j) { const unsigned c = xb_ld(&bar[XB_XCNT(j)]); sum += c; cnt += (c > 0u) ? 1u : 0u; mine = (j == x) ? c : mine; }
        if (sum == G) break;
        __builtin_amdgcn_s_sleep(1);
        if ((++sp & 255u) == 0u) { if (xb_ld(&bar[XB_TMO])) break; if (sp > XB_SPIN_CAP) { atomicAdd(&bar[XB_TMO], 1u); break; } }
    }
    nloc = mine > 0u ? mine : 1u; nx = cnt > 0u ? cnt : 1u;
}
template <bool FIRST> __device__ __forceinline__ void xcd_barrier(const XcdBarrier& b) {
    asm volatile("s_waitcnt vmcnt(0)" ::: "memory");
    __syncthreads();
    if (threadIdx.x == 0) {
        unsigned* bar = b.bar;
        asm volatile("" : "+s"(bar));
        __builtin_amdgcn_s_waitcnt(0);
        unsigned nloc = b.st[0], nx = b.st[1];
        if (FIRST) { if (nloc == 0u) { xcd_barrier_complete(bar, b.x, nloc, nx); b.st[0] = nloc; b.st[1] = nx; } }
        const unsigned old = xb_add(&bar[XB_XSUB(b.x)], 1u);
        const unsigned gen = old / nloc;
        if (old + 1u == (gen + 1u) * nloc) {
            __builtin_amdgcn_fence(__ATOMIC_RELEASE, "agent");
            asm volatile("s_waitcnt vmcnt(0)" ::: "memory");
            const unsigned og = xb_add(&bar[XB_TOP], 1u);
            const unsigned tg = og / nx;
            if (og + 1u == (tg + 1u) * nx) xb_add(&bar[XB_TOPGEN], 1u);
            else XB_SPIN(xb_ld(&bar[XB_TOPGEN]) == tg, bar);
            __builtin_amdgcn_fence(__ATOMIC_ACQUIRE, "agent");
            xb_add(&bar[XB_XGEN(b.x)], 1u);
            asm volatile("s_waitcnt vmcnt(0)" ::: "memory");
        } else {
            XB_SPIN(xb_ld(&bar[XB_XGEN(b.x)]) == gen, bar);
            __builtin_amdgcn_fence(__ATOMIC_ACQUIRE, "agent");
            asm volatile("s_waitcnt vmcnt(0)" ::: "memory");
        }
    }
    __syncthreads();
}

struct Params { const float* in[N_INPUTS]; float* out; unsigned char* ws; float inv_freq[32]; };
static_assert(sizeof(Params) == N_INPUTS * 8 + 16 + 128, "Params has no padding");

struct Ctx {
    const float* const* in; float* out; unsigned char* ws;
    LAS unsigned char* lds;
    int G;
};
#define THREAD_IDS() int tid_ = threadIdx.x; asm volatile("" : "+v"(tid_)); const int tid = tid_, lane = tid & 63, wave = __builtin_amdgcn_readfirstlane(tid >> 6), gw = blockIdx.x * NWAVES + wave, NGW = C.G * NWAVES; (void)tid; (void)lane; (void)wave; (void)gw; (void)NGW
#define WSP(T, off) ((T*)(C.ws + (off)))

__device__ __forceinline__ float rstd_of(const float* ssp, int row) {
    const f32x4 a = *(const f32x4*)(ssp + (size_t)row * 16), b = *(const f32x4*)(ssp + (size_t)row * 16 + 4), c = *(const f32x4*)(ssp + (size_t)row * 16 + 8), d = *(const f32x4*)(ssp + (size_t)row * 16 + 12);
    const float s = (((a[0] + a[1]) + (a[2] + a[3])) + ((b[0] + b[1]) + (b[2] + b[3]))) + (((c[0] + c[1]) + (c[2] + c[3])) + ((d[0] + d[1]) + (d[2] + d[3])));
    return rsqrtf(s * (1.0f / D) + EPS);
}
#define EPI_IDS() int t_ = threadIdx.x; asm volatile("" : "+v"(t_)); const int wid_ = __builtin_amdgcn_readfirstlane(t_ >> 6), wr = wid_ >> 2, wc = wid_ & 3, fr = t_ & 15, fq = (t_ & 63) >> 4
struct EpiGLU {
    static constexpr bool PERM = true;
    bf16* act; const float* ss;
    __device__ __forceinline__ void operator()(const pg8::f32x4 (&acc)[2][2][4][2], const pg8::Unit& u, int, int, int, int) const {
        EPI_IDS();
        const int row0 = u.pm * 256 + wr * 64 + fr, col0 = u.pn * 128 + wc * 32 + 8 * fq;
#pragma unroll
        for (int ai = 0; ai < 2; ++ai)
#pragma unroll
            for (int m = 0; m < 4; ++m) {
                const int row = row0 + ai * 128 + m * 16; const float rstd = rstd_of(ss, row);
                float o[8];
#pragma unroll
                for (int n = 0; n < 2; ++n)
#pragma unroll
                    for (int j = 0; j < 4; ++j) { const float g = acc[ai][0][m][n][j] * rstd, up = acc[ai][1][m][n][j] * rstd; o[n * 4 + j] = siluf_(g) * up; }
                v4u w; w.x = pg8::cvt_pk_bf16(o[0], o[1]); w.y = pg8::cvt_pk_bf16(o[2], o[3]); w.z = pg8::cvt_pk_bf16(o[4], o[5]); w.w = pg8::cvt_pk_bf16(o[6], o[7]);
                *(v4u*)(act + (size_t)row * DFF + col0) = w;
            }
    }
};
template <bool FINAL, int SCALE2> struct EpiRes {
    static constexpr bool PERM = true;
    float* h; bf16* hb; float* ssout; float* out;
    __device__ __forceinline__ void rowgroup(const pg8::f32x4 (&a)[2][2], int row, int col0, int pn, int wc, int fq) const {
        constexpr float scale = 0.5f * SCALE2; float sq = 0.f;
        long yoff = -1;
        if (FINAL) { if (row < MP) { const int b = row / L, pos = row - b * L; if (pos >= NMETA) yoff = (long)O_YP + ((long)b * SEQ + (pos - NMETA)) * D; } else if (row < MR) yoff = (long)O_YS + (long)(row - MP) * D; }
#pragma unroll
        for (int bj = 0; bj < 2; ++bj) {
            const size_t off = (size_t)row * D + col0 + bj * 128;
            f32x4 h0 = *(const f32x4*)(h + off), h1 = *(const f32x4*)(h + off + 4);
            h0 = h0 + a[bj][0] * scale; h1 = h1 + a[bj][1] * scale;
            *(f32x4*)(h + off) = h0; *(f32x4*)(h + off + 4) = h1;
            v4u w; w.x = pg8::cvt_pk_bf16(h0[0], h0[1]); w.y = pg8::cvt_pk_bf16(h0[2], h0[3]); w.z = pg8::cvt_pk_bf16(h1[0], h1[1]); w.w = pg8::cvt_pk_bf16(h1[2], h1[3]);
            *(v4u*)(hb + off) = w;
            sq += (h0[0] * h0[0] + h0[1] * h0[1]) + (h0[2] * h0[2] + h0[3] * h0[3]) + (h1[0] * h1[0] + h1[1] * h1[1]) + (h1[2] * h1[2] + h1[3] * h1[3]);
            if (FINAL && yoff >= 0) { *(f32x4*)(out + yoff + col0 + bj * 128) = h0; *(f32x4*)(out + yoff + col0 + bj * 128 + 4) = h1; }
        }
        sq += __shfl_xor(sq, 16); sq += __shfl_xor(sq, 32);
        if (fq == 0 && ssout) ssout[(size_t)row * 16 + pn * 4 + wc] = sq;
    }
    __device__ __forceinline__ void operator()(const pg8::f32x4 (&acc)[2][2][4][2], const pg8::Unit& u, int, int, int, int) const {
        EPI_IDS();
        const int row0 = u.pm * 256 + wr * 64 + fr, col0 = u.pn * 256 + wc * 32 + 8 * fq;
#pragma unroll
        for (int ai = 0; ai < 2; ++ai)
#pragma unroll
            for (int m = 0; m < 4; ++m) {
                const pg8::f32x4 a[2][2] = {{acc[ai][0][m][0], acc[ai][0][m][1]}, {acc[ai][1][m][0], acc[ai][1][m][1]}};
                rowgroup(a, row0 + ai * 128 + m * 16, col0, u.pn, wc, fq);
                if (m == 3) asm volatile("" ::: "memory");
            }
    }
};
struct EpiZ {
    static constexpr bool PERM = true;
    bf16* zmix; bf16* gates; const float* ss; const float* bias;
    __device__ __forceinline__ void operator()(const pg8::f32x4 (&acc)[2][2][4][2], const pg8::Unit& u, int, int, int, int) const {
        EPI_IDS();
        const int row0 = u.pm * 256 + wr * 64 + fr, col0 = u.pn * 256 + wc * 32 + 8 * fq; const bool isgate = u.pn >= NMIXP / 256;
        f32x4 bv[2][2];
#pragma unroll
        for (int bj = 0; bj < 2; ++bj)
#pragma unroll
            for (int n = 0; n < 2; ++n) bv[bj][n] = *(const f32x4*)(bias + col0 + bj * 128 + 4 * n);
#pragma unroll
        for (int ai = 0; ai < 2; ++ai)
#pragma unroll
            for (int m = 0; m < 4; ++m) {
                const int row = row0 + ai * 128 + m * 16; const float rstd = rstd_of(ss, row);
#pragma unroll
                for (int bj = 0; bj < 2; ++bj) {
                    f32x4 v0 = acc[ai][bj][m][0] * rstd + bv[bj][0], v1 = acc[ai][bj][m][1] * rstd + bv[bj][1];
                    if (isgate) {
#pragma unroll
                        for (int j = 0; j < 4; ++j) { v0[j] = fmaxf(sigmoidf_(v0[j]), 9.094947017729282e-13f); v1[j] = fmaxf(sigmoidf_(v1[j]), 9.094947017729282e-13f); } }
                    v4u w; w.x = pg8::cvt_pk_bf16(v0[0], v0[1]); w.y = pg8::cvt_pk_bf16(v0[2], v0[3]); w.z = pg8::cvt_pk_bf16(v1[0], v1[1]); w.w = pg8::cvt_pk_bf16(v1[2], v1[3]);
                    if (isgate) *(v4u*)(gates + (size_t)row * NGATE + (col0 - NMIXP) + bj * 128) = w;
                    else *(v4u*)(zmix + (size_t)row * NMIXP + col0 + bj * 128) = w;
                }
            }
    }
};
struct EpiMerge {
    static constexpr bool PERM = true;
    bf16* merged; const bf16* gates;
    __device__ __forceinline__ void operator()(const pg8::f32x4 (&acc)[2][2][4][2], const pg8::Unit& u, int, int, int, int) const {
        EPI_IDS();
        const int n = u.pn >> 2, dt = u.pn & 3;
        const int row0 = u.pm * 256 + wr * 64 + fr, col0 = dt * 256 + wc * 32 + 8 * fq;
#pragma unroll
        for (int ai = 0; ai < 2; ++ai)
#pragma unroll
            for (int m = 0; m < 4; ++m) {
                const int row = row0 + ai * 128 + m * 16;
#pragma unroll
                for (int bj = 0; bj < 2; ++bj) {
                    const v4u gw = *(const v4u*)(gates + (size_t)row * NGATE + n * D + col0 + bj * 128);
                    bf16* mp = merged + (size_t)row * D + col0 + bj * 128;
                    float o[8];
                    o[0] = acc[ai][bj][m][0][0] * bflo(gw.x); o[1] = acc[ai][bj][m][0][1] * bfhi(gw.x); o[2] = acc[ai][bj][m][0][2] * bflo(gw.y); o[3] = acc[ai][bj][m][0][3] * bfhi(gw.y);
                    o[4] = acc[ai][bj][m][1][0] * bflo(gw.z); o[5] = acc[ai][bj][m][1][1] * bfhi(gw.z); o[6] = acc[ai][bj][m][1][2] * bflo(gw.w); o[7] = acc[ai][bj][m][1][3] * bfhi(gw.w);
                    if (n > 0) { const v4u pw = *(const v4u*)mp;
                        o[0] += bflo(pw.x); o[1] += bfhi(pw.x); o[2] += bflo(pw.y); o[3] += bfhi(pw.y); o[4] += bflo(pw.z); o[5] += bfhi(pw.z); o[6] += bflo(pw.w); o[7] += bfhi(pw.w); }
                    v4u w; w.x = pg8::cvt_pk_bf16(o[0], o[1]); w.y = pg8::cvt_pk_bf16(o[2], o[3]); w.z = pg8::cvt_pk_bf16(o[4], o[5]); w.w = pg8::cvt_pk_bf16(o[6], o[7]);
                    *(v4u*)mp = w;
                }
                if (m == 3) asm volatile("" ::: "memory");
            }
    }
};

struct EpiPartial {
    static constexpr bool PERM = true;
    float* part;
    __device__ __forceinline__ void operator()(const pg8::f32x4 (&acc)[2][2][4][2], const pg8::Unit& u, int, int, int, int) const {
        int t_ = threadIdx.x; asm volatile("" : "+v"(t_));
        const int slot = blockIdx.x;
        float* p = part + (size_t)slot * 65536 + (size_t)t_ * 4;
#pragma unroll
        for (int ai = 0; ai < 2; ++ai)
#pragma unroll
            for (int bj = 0; bj < 2; ++bj)
#pragma unroll
                for (int m = 0; m < 4; ++m)
#pragma unroll
                    for (int n = 0; n < 2; ++n) *(pg8::f32x4*)(p + (size_t)((((ai * 2 + bj) * 4 + m) * 2 + n) * 2048)) = acc[ai][bj][m][n];
        (void)u;
    }
};
template <int NSPLIT, class Epi> __device__ __forceinline__ void ksp_finalize(const float* part, const pg8::StaticOrder& so, int limit, const Epi& E) {
    const int ntail = so.nwg - limit;
    for (int it = blockIdx.x; it < ntail * 8; it += gridDim.x) {
        const int tt = it >> 3, ai = (it >> 2) & 1, m = it & 3;
        EPI_IDS();
        pg8::f32x4 a[2][2];
#pragma unroll
        for (int bj = 0; bj < 2; ++bj)
#pragma unroll
            for (int n = 0; n < 2; ++n) { pg8::f32x4 s = {0.f, 0.f, 0.f, 0.f};
#pragma unroll
                for (int k = 0; k < NSPLIT; ++k) s = s + *(const pg8::f32x4*)(part + (size_t)(tt * NSPLIT + k) * 65536 + (size_t)((((ai * 2 + bj) * 4 + m) * 2 + n) * 2048) + (size_t)t_ * 4);
                a[bj][n] = s; }
        pg8::Unit u; so.unit_of(limit + tt, u);
        E.rowgroup(a, u.pm * 256 + wr * 64 + fr + ai * 128 + m * 16, u.pn * 256 + wc * 32 + 8 * fq, u.pn, wc, fq);
    }
}

struct EpiMergeR {
    static constexpr bool PERM = true;
    bf16* merged; const bf16* gates;
    __device__ __forceinline__ void mid(pg8::f32x4 (&acc)[2][2][4][2], const pg8::Unit& u, int seg) const {
        EPI_IDS();
        const int row0 = u.pm * 256 + wr * 64 + fr, col0 = u.pn * 256 + wc * 32 + 8 * fq;
#pragma unroll
        for (int ai = 0; ai < 2; ++ai) {
#pragma unroll
            for (int m = 0; m < 4; ++m) {
                const int row = row0 + ai * 128 + m * 16;
#pragma unroll
                for (int bj = 0; bj < 2; ++bj) {
                    const bf16* gp = gates + (size_t)row * NGATE + (seg - 1) * D + col0 + bj * 128;
                    const v4u ga = *(const v4u*)gp, gb = *(const v4u*)(gp + D);
                    pg8::f32x4& a0 = acc[ai][bj][m][0]; pg8::f32x4& a1 = acc[ai][bj][m][1];
                    a0[0] *= bflo(ga.x) * __builtin_amdgcn_rcpf(bflo(gb.x)); a0[1] *= bfhi(ga.x) * __builtin_amdgcn_rcpf(bfhi(gb.x)); a0[2] *= bflo(ga.y) * __builtin_amdgcn_rcpf(bflo(gb.y)); a0[3] *= bfhi(ga.y) * __builtin_amdgcn_rcpf(bfhi(gb.y));
                    a1[0] *= bflo(ga.z) * __builtin_amdgcn_rcpf(bflo(gb.z)); a1[1] *= bfhi(ga.z) * __builtin_amdgcn_rcpf(bfhi(gb.z)); a1[2] *= bflo(ga.w) * __builtin_amdgcn_rcpf(bflo(gb.w)); a1[3] *= bfhi(ga.w) * __builtin_amdgcn_rcpf(bfhi(gb.w));
                }
            }
            asm volatile("" ::: "memory");
        }
    }
    __device__ __forceinline__ void operator()(const pg8::f32x4 (&acc)[2][2][4][2], const pg8::Unit& u, int, int, int, int) const {
        EPI_IDS();
        const int row0 = u.pm * 256 + wr * 64 + fr, col0 = u.pn * 256 + wc * 32 + 8 * fq;
#pragma unroll
        for (int ai = 0; ai < 2; ++ai)
#pragma unroll
            for (int m = 0; m < 4; ++m) {
                const int row = row0 + ai * 128 + m * 16;
#pragma unroll
                for (int bj = 0; bj < 2; ++bj) {
                    const v4u g = *(const v4u*)(gates + (size_t)row * NGATE + 3 * D + col0 + bj * 128);
                    const pg8::f32x4 a0 = acc[ai][bj][m][0], a1 = acc[ai][bj][m][1];
                    v4u w; w.x = pg8::cvt_pk_bf16(a0[0] * bflo(g.x), a0[1] * bfhi(g.x)); w.y = pg8::cvt_pk_bf16(a0[2] * bflo(g.y), a0[3] * bfhi(g.y));
                    w.z = pg8::cvt_pk_bf16(a1[0] * bflo(g.z), a1[1] * bfhi(g.z)); w.w = pg8::cvt_pk_bf16(a1[2] * bflo(g.w), a1[3] * bfhi(g.w));
                    *(v4u*)(merged + (size_t)row * D + col0 + bj * 128) = w;
                }
            }
    }
};

struct RowMap { int mode, a; __device__ __forceinline__ int operator()(int n) const { return mode == 0 ? n + a : (mode == 1 ? 256 * (n >> 7) + (n & 127) + a : (n < NMIX ? n : n + (NMIXP - NMIX))); } };
__device__ __forceinline__ void tr_item(const float* W, int K, int N, const float* gain, bf16* WT, int pitch, RowMap rm, LAS float* scr, int kb, int nb, int lane) {
    const int k0 = 64 * kb, n0 = 64 * nb; const int nn = n0 + 4 * (lane & 15), kr = lane >> 4;
    f32x4 v[16];
#pragma unroll
    for (int i = 0; i < 16; ++i) v[i] = (nn < N) ? *(const f32x4*)(W + (size_t)(k0 + 4 * i + kr) * N + nn) : (f32x4){0.f, 0.f, 0.f, 0.f};
#pragma unroll
    for (int i = 0; i < 16; ++i) { const int kk = 4 * i + kr; const float g = gain ? gain[k0 + kk] : 1.0f; LAS float* d = scr + kk * 65 + 4 * (lane & 15); d[0] = v[i][0] * g; d[1] = v[i][1] * g; d[2] = v[i][2] * g; d[3] = v[i][3] * g; }
    LDS_WAIT(); asm volatile("" ::: "memory");
    const int c = lane & 7;
#pragma unroll
    for (int j = 0; j < 8; ++j) { const int nl = (lane >> 3) + 8 * j; const int n = n0 + nl; const LAS float* s = scr + (8 * c) * 65 + nl;
        v4u o; o.x = pg8::cvt_pk_bf16(s[0 * 65], s[1 * 65]); o.y = pg8::cvt_pk_bf16(s[2 * 65], s[3 * 65]); o.z = pg8::cvt_pk_bf16(s[4 * 65], s[5 * 65]); o.w = pg8::cvt_pk_bf16(s[6 * 65], s[7 * 65]);
        if (n < N) *(v4u*)(WT + (size_t)rm(n) * pitch + k0 + 8 * c) = o; }
    LDS_WAIT(); asm volatile("" ::: "memory");
}
__device__ __forceinline__ void p0_prologue(const Ctx& C, const Params& P) {
    THREAD_IDS();
    LAS float* scr = (LAS float*)(C.lds + RING_OFF + wave * 16896);
    constexpr int I_FF = 16 * 44, I_DN = 44 * 16, I_IN = 16 * 113, I_BR = 4 * 4 * 16, I_OUT = 16 * 16;
    constexpr int PER_LAYER = 4 * I_FF + 2 * I_DN + I_IN + I_BR + I_OUT;
    for (int it = gw; it < DEPTH * PER_LAYER; it += NGW) {
        const int l = it / PER_LAYER; int r = it - l * PER_LAYER;
        bf16* W1a = WSP(bf16, WS_W1 + (size_t)(l * 2 + 0) * SZ_W1); bf16* W1b = WSP(bf16, WS_W1 + (size_t)(l * 2 + 1) * SZ_W1);
        bf16* Wda = WSP(bf16, WS_WD + (size_t)(l * 2 + 0) * SZ_WD); bf16* Wdb = WSP(bf16, WS_WD + (size_t)(l * 2 + 1) * SZ_WD);
        if (r < I_FF) { tr_item(C.in[I_F1G] + (size_t)l * D * DFF, D, DFF, C.in[I_NF1] + l * D, W1a, D, RowMap{1, 0}, scr, r / 44, r % 44, lane); continue; } r -= I_FF;
        if (r < I_FF) { tr_item(C.in[I_F1U] + (size_t)l * D * DFF, D, DFF, C.in[I_NF1] + l * D, W1a, D, RowMap{1, 128}, scr, r / 44, r % 44, lane); continue; } r -= I_FF;
        if (r < I_DN) { tr_item(C.in[I_F1D] + (size_t)l * D * DFF, DFF, D, nullptr, Wda, DFF, RowMap{0, 0}, scr, r / 16, r % 16, lane); continue; } r -= I_DN;
        if (r < I_FF) { tr_item(C.in[I_F2G] + (size_t)l * D * DFF, D, DFF, C.in[I_NF2] + l * D, W1b, D, RowMap{1, 0}, scr, r / 44, r % 44, lane); continue; } r -= I_FF;
        if (r < I_FF) { tr_item(C.in[I_F2U] + (size_t)l * D * DFF, D, DFF, C.in[I_NF2] + l * D, W1b, D, RowMap{1, 128}, scr, r / 44, r % 44, lane); continue; } r -= I_FF;
        if (r < I_DN) { tr_item(C.in[I_F2D] + (size_t)l * D * DFF, DFF, D, nullptr, Wdb, DFF, RowMap{0, 0}, scr, r / 16, r % 16, lane); continue; } r -= I_DN;
        if (r < I_IN) { tr_item(C.in[I_WIN] + (size_t)l * D * NIN, D, NIN, C.in[I_NMIX] + l * D, WSP(bf16, WS_WIN + (size_t)l * SZ_WIN), D, RowMap{2, 0}, scr, r / 113, r % 113, lane); continue; } r -= I_IN;
        if (r < I_BR) { const int n4 = r / 64, rr = r % 64; tr_item(C.in[I_WBR] + (size_t)(l * 4 + n4) * 256 * D, 256, D, nullptr, WSP(bf16, WS_WBR + (size_t)l * SZ_WBR) + n4 * 256, D, RowMap{0, 0}, scr, rr / 16, rr % 16, lane); continue; } r -= I_BR;
        tr_item(C.in[I_WOUT] + (size_t)l * D * D, D, D, nullptr, WSP(bf16, WS_WOUT + (size_t)l * SZ_WOUT), D, RowMap{0, 0}, scr, r / 16, r % 16, lane);
    }
    const int gt = gw * 64 + lane, NGT = NGW * 64;
    for (int i = gt; i < 2 * 240 * 128; i += NGT) { const int l = i / (240 * 128), r = i % (240 * 128); *(v4u*)(C.ws + WS_WIN + (size_t)l * SZ_WIN + ((size_t)NMIX * D) * 2 + (size_t)r * 16) = (v4u){0u, 0u, 0u, 0u}; }
    for (int i = gt; i < (M - MR) * 128; i += NGT) *(v4u*)(C.ws + WS_BR + (size_t)MR * D * 2 + (size_t)i * 16) = (v4u){0u, 0u, 0u, 0u};
    for (int i = gt; i < 2 * NINP; i += NGT) { const int l = i / NINP, j = i % NINP; float v = 0.f; if (j < NMIX) v = C.in[I_BIN][l * NIN + j]; else if (j >= NMIXP) v = C.in[I_BIN][l * NIN + NMIX + (j - NMIXP)]; WSP(float, WS_BINP)[i] = v; }
    for (int i = gt; i < NPOS * 32; i += NGT) { const int pi = i >> 5, fi = i & 31; const int pos = pi < L ? pi : PAST + (pi - L);
        const float angf = (float)pos * P.inv_freq[fi];
        const double a = (double)angf; const double k = rint(a * 0.15915494309189535); const double rr = (a - k * 6.283185307179586) - k * 2.4492935982947064e-16;
        const float rf = (float)rr; WSP(float, WS_ROPE)[i] = cosf(rf); WSP(float, WS_ROPE)[NPOS * 32 + i] = sinf(rf); }
    float* H = WSP(float, WS_H); bf16* HB = WSP(bf16, WS_HB); float* SS0 = WSP(float, WS_SS);
    for (int row = gw; row < M; row += NGW) {
        const float* src = nullptr;
        if (row < MP) { const int b = row / L, pos = row - b * L; src = pos < NMETA ? C.in[I_META] + (size_t)pos * D : C.in[I_XP] + ((size_t)b * SEQ + (pos - NMETA)) * D; }
        else if (row < MR) src = C.in[I_XS] + (size_t)(row - MP) * D;
        float s = 0.f;
#pragma unroll
        for (int j = 0; j < 4; ++j) { f32x4 v = src ? *(const f32x4*)(src + 256 * j + 4 * lane) : (f32x4){0.f, 0.f, 0.f, 0.f};
            *(f32x4*)(H + (size_t)row * D + 256 * j + 4 * lane) = v; s += (v[0] * v[0] + v[1] * v[1]) + (v[2] * v[2] + v[3] * v[3]);
            unsigned long long w = (unsigned long long)pk2(v[0], v[1]) | ((unsigned long long)pk2(v[2], v[3]) << 32);
            *(unsigned long long*)(HB + (size_t)row * D + 256 * j + 4 * lane) = w; }
        s = wave_sum(s); if (lane < 16) SS0[(size_t)row * 16 + lane] = lane == 0 ? s : 0.f;
    }
}

__device__ __forceinline__ float lam_of(const Ctx& C, int l, float lam_init) {
    THREAD_IDS();
    float a = 0.f, b = 0.f;
#pragma unroll 1
    for (int i = 0; i < 32; ++i) { a += C.in[I_LQ1][l * 32 + i] * C.in[I_LK1][l * 32 + i]; b += C.in[I_LQ2][l * 32 + i] * C.in[I_LK2][l * 32 + i]; }
    return __expf(a) - __expf(b) + lam_init;
}
__device__ __forceinline__ int t5_bucket(int n) {
    if (n < 16) return n;
    return 16 + (n >= 19) + (n >= 21) + (n >= 24) + (n >= 27) + (n >= 31) + (n >= 35) + (n >= 40) + (n >= 46) + (n >= 52) + (n >= 59) + (n >= 67) + (n >= 77) + (n >= 87) + (n >= 99) + (n >= 113);
}
__device__ __forceinline__ void unpack8(const v4u w, float (&x)[8]) { x[0] = bflo(w.x); x[1] = bfhi(w.x); x[2] = bflo(w.y); x[3] = bfhi(w.y); x[4] = bflo(w.z); x[5] = bfhi(w.z); x[6] = bflo(w.w); x[7] = bfhi(w.w); }
__device__ __forceinline__ v4u pack8(const float (&x)[8]) { v4u w; w.x = pg8::cvt_pk_bf16(x[0], x[1]); w.y = pg8::cvt_pk_bf16(x[2], x[3]); w.z = pg8::cvt_pk_bf16(x[4], x[5]); w.w = pg8::cvt_pk_bf16(x[6], x[7]); return w; }
__device__ __forceinline__ void n1_prep(const Ctx& C, int l) {
    THREAD_IDS();
    const bf16* ZM = WSP(bf16, WS_ZMIX); float* UB = WSP(float, WS_UBUF); float* RQ = WSP(float, WS_RQ); float* RK = WSP(float, WS_RK);
    float* LD = WSP(float, WS_LDEC); const float* COS = WSP(float, WS_ROPE); const float* SIN = COS + NPOS * 32; bf16* QNB = WSP(bf16, WS_QNB); bf16* KNB = WSP(bf16, WS_KNB);
    const int i = lane & 31;
    float qg[8], kg[8];
#pragma unroll
    for (int j = 0; j < 8; ++j) { qg[j] = C.in[I_QN][l * 32 + ((8 * i) & 31) + j] * (0.17677669529663687f * 1.4426950408889634f); kg[j] = C.in[I_KN][l * 32 + ((8 * i) & 31) + j]; }
    for (int rp = gw; rp < MR / 2; rp += NGW) {
        const int r = 2 * rp + (lane >> 5);
        const bf16* z = ZM + (size_t)r * NMIXP;
        const int pi = r < MP ? r % L : L + ((r - MP) & 7);
        float* kout = r < MP ? C.out + O_KP + ((size_t)l * MP + r) * 256 : C.out + O_KS + ((size_t)l * MS + (r - MP)) * 256;
        float* vout = r < MP ? C.out + O_VP + ((size_t)l * MP + r) * 256 : C.out + O_VS + ((size_t)l * MS + (r - MP)) * 256;
        const v4u wa = *(const v4u*)(z + C_A + 8 * i), wg = *(const v4u*)(z + C_G + 8 * i), wq = *(const v4u*)(z + D_Q + 8 * i), wk = *(const v4u*)(z + D_K + 8 * i), wv = *(const v4u*)(z + D_V + 8 * i);
        const int isk = i >> 4, hh = (i >> 2) & 3, jc = i & 3;
        const bf16* zr = z + (isk ? R_K : R_Q) + hh * 64 + 8 * jc;
        const v4u w1 = *(const v4u*)zr, w2 = *(const v4u*)(zr + 32);
        const v4u gl0 = *(const v4u*)(z + G_LOW), gl1 = *(const v4u*)(z + G_LOW + 8);
        float x[8], y[8];
        unpack8(wa, x); unpack8(wg, y);
#pragma unroll
        for (int j = 0; j < 8; ++j) x[j] *= sigmoidf_(y[j]);
        *(f32x4*)(UB + (size_t)r * 256 + 8 * i) = (f32x4){x[0], x[1], x[2], x[3]}; *(f32x4*)(UB + (size_t)r * 256 + 8 * i + 4) = (f32x4){x[4], x[5], x[6], x[7]};
        unpack8(wv, x);
        *(f32x4*)(vout + 8 * i) = (f32x4){x[0], x[1], x[2], x[3]}; *(f32x4*)(vout + 8 * i + 4) = (f32x4){x[4], x[5], x[6], x[7]};
        unpack8(wq, x);
        { float s = 0.f;
#pragma unroll
          for (int j = 0; j < 8; ++j) s += x[j] * x[j];
          s += __shfl_xor(s, 1); s += __shfl_xor(s, 2); const float rs = rsqrtf(s * (1.0f / 32) + EPS);
#pragma unroll
          for (int j = 0; j < 8; ++j) x[j] = x[j] * rs * qg[j];
          *(v4u*)(QNB + (size_t)r * 256 + 8 * i) = pack8(x); }
        unpack8(wk, x);
        { float s = 0.f;
#pragma unroll
          for (int j = 0; j < 8; ++j) s += x[j] * x[j];
          s += __shfl_xor(s, 1); s += __shfl_xor(s, 2); const float rs = rsqrtf(s * (1.0f / 32) + EPS);
#pragma unroll
          for (int j = 0; j < 8; ++j) x[j] = x[j] * rs * kg[j];
          *(v4u*)(KNB + (size_t)r * 256 + 8 * i) = pack8(x);
          *(f32x4*)(kout + 8 * i) = (f32x4){x[0], x[1], x[2], x[3]}; *(f32x4*)(kout + 8 * i + 4) = (f32x4){x[4], x[5], x[6], x[7]}; }
        unpack8(w1, x); unpack8(w2, y);
        { const f32x4 c0 = *(const f32x4*)(COS + pi * 32 + 8 * jc), c1 = *(const f32x4*)(COS + pi * 32 + 8 * jc + 4), s0 = *(const f32x4*)(SIN + pi * 32 + 8 * jc), s1 = *(const f32x4*)(SIN + pi * 32 + 8 * jc + 4);
          const float sc = isk ? 0.125f : 1.0f; float o1[8], o2[8];
#pragma unroll
          for (int j = 0; j < 8; ++j) { const float cs = j < 4 ? c0[j & 3] : c1[j & 3], sn = j < 4 ? s0[j & 3] : s1[j & 3]; o1[j] = (x[j] * cs - y[j] * sn) * sc; o2[j] = (x[j] * sn + y[j] * cs) * sc; }
          float* ro = (isk ? RK : RQ) + (size_t)r * 256 + hh * 64 + 8 * jc;
          *(f32x4*)ro = (f32x4){o1[0], o1[1], o1[2], o1[3]}; *(f32x4*)(ro + 4) = (f32x4){o1[4], o1[5], o1[6], o1[7]}; *(f32x4*)(ro + 32) = (f32x4){o2[0], o2[1], o2[2], o2[3]}; *(f32x4*)(ro + 36) = (f32x4){o2[4], o2[5], o2[6], o2[7]}; }
        { float gv[16]; unpack8(gl0, x); unpack8(gl1, y);
#pragma unroll
          for (int j = 0; j < 8; ++j) { gv[j] = x[j]; gv[8 + j] = y[j]; }
          f32x4 gp = *(const f32x4*)(C.in[I_GAB] + l * 128 + 4 * i);
#pragma unroll
          for (int k = 0; k < 16; ++k) { const f32x4 aw = *(const f32x4*)(C.in[I_GAW] + (size_t)(l * 16 + k) * 128 + 4 * i); gp = gp + aw * gv[k]; }
          f32x4 ls;
#pragma unroll
          for (int j = 0; j < 4; ++j) ls[j] = (fminf(gp[j], 0.f) - log1pf(__expf(-fabsf(gp[j])))) * (1.0f / 16.0f);
          *(f32x4*)(LD + (size_t)r * 128 + 4 * i) = ls; }
    }
}
__device__ __forceinline__ void conv_rows_item(const Ctx& C, int l, int item) {
    THREAD_IDS();
    const float* UB = WSP(float, WS_UBUF); bf16* BR = WSP(bf16, WS_BR);
    const float* cw = C.in[I_CW] + (size_t)l * 31 * 256; const float* sc = C.in[I_SCONV];
    LAS float* wl = (LAS float*)C.lds;
    for (int i = tid; i < 31 * 256; i += NWAVES * 64) wl[i] = cw[i];
    LDS_WAIT(); __builtin_amdgcn_s_barrier(); asm volatile("" ::: "memory");
    for (int rr = wave; rr < 64; rr += NWAVES) {
        const int r = item * 64 + rr; if (r >= MR) break;
        const bool smp = r >= MP; const int b = smp ? (r - MP) >> 3 : r / L; const int p = smp ? (r - MP) & 7 : r - b * L; const int rb = smp ? MP + b * 8 : b * L;
        float cv[4];
#pragma unroll
        for (int k = 0; k < 4; ++k) cv[k] = C.in[I_CB][l * 256 + lane + 64 * k];
#pragma unroll 1
        for (int jh = 0; jh < 32; jh += 8) {
            float uv[8][4];
            const float* up = UB + (size_t)(rb + p + jh - 30) * 256 + lane; const float* sp = sc + (((size_t)l * DB + b) * 30 + (p + jh)) * 256 + lane;
#pragma unroll
            for (int jj = 0; jj < 8; ++jj) { const int j = jh + jj; const int q = p + j - 30;
#pragma unroll
                for (int k = 0; k < 4; ++k) uv[jj][k] = j >= 31 ? 0.f : (q >= 0 ? up[jj * 256 + 64 * k] : (smp ? sp[jj * 256 + 64 * k] : 0.f)); }
            const LAS float* wp = wl + jh * 256 + lane;
#pragma unroll
            for (int jj = 0; jj < 8; ++jj) { if (jh + jj < 31) {
#pragma unroll
                    for (int k = 0; k < 4; ++k) cv[k] += wp[jj * 256 + 64 * k] * uv[jj][k]; } }
        }
        float s = (cv[0] + cv[1]) + (cv[2] + cv[3]); const float mean = wave_sum(s) * (1.0f / 256);
        float q2 = 0.f;
#pragma unroll
        for (int k = 0; k < 4; ++k) { cv[k] -= mean; q2 += cv[k] * cv[k]; }
        const float rstd = rsqrtf(wave_sum(q2) * (1.0f / 256) + EPS);
#pragma unroll
        for (int k = 0; k < 4; ++k) { const int c = lane + 64 * k; const float y = cv[k] * rstd * C.in[I_CLG][l * 256 + c] + C.in[I_CLB][l * 256 + c]; BR[(size_t)r * D + c] = (bf16)f2bf(siluf_(y)); }
    }
    LDS_WAIT(); __builtin_amdgcn_s_barrier(); asm volatile("" ::: "memory");
}
__device__ __forceinline__ void conv_state_item(const Ctx& C, int l, int part, int nparts) {
    THREAD_IDS();
    const float* UB = WSP(float, WS_UBUF); const float* sc = C.in[I_SCONV];
    for (int i = part * NWAVES * 64 + tid; i < BATCH * 30 * 256; i += nparts * NWAVES * 64) { const int c = i & 255, ii = (i >> 8) % 30, b = i / (30 * 256); C.out[O_CP + (size_t)l * BATCH * 30 * 256 + i] = UB[(size_t)(b * L + L - 30 + ii) * 256 + c]; }
    for (int i = part * NWAVES * 64 + tid; i < DB * 30 * 256; i += nparts * NWAVES * 64) { const int c = i & 255, ii = (i >> 8) % 30, b = i / (30 * 256);
        C.out[O_CS + (size_t)l * DB * 30 * 256 + i] = ii < 22 ? sc[(((size_t)l * DB + b) * 30 + 8 + ii) * 256 + c] : UB[(size_t)(MP + b * 8 + ii - 22) * 256 + c]; }
}
template <int DK, bool RET> __device__ __forceinline__ void la_seq(const Ctx& C, int l, bool smp, int b, int h) {
    THREAD_IDS();
    const bf16* ZM = WSP(bf16, WS_ZMIX); const float* RQ = WSP(float, WS_RQ); const float* RK = WSP(float, WS_RK); const float* LD = WSP(float, WS_LDEC); bf16* BR = WSP(bf16, WS_BR);
    const int nt = smp ? DS : L; const int row0 = smp ? MP + b * DS : b * L;
    float S[DK];
    if (smp) { const float* s0 = (RET ? C.in[I_SRET] : C.in[I_SGLA]) + (((size_t)l * DB + b) * 4 + h) * DK * 64;
#pragma unroll
        for (int k = 0; k < DK; ++k) S[k] = s0[k * 64 + lane]; }
    else {
#pragma unroll
        for (int k = 0; k < DK; ++k) S[k] = 0.f; }
    const float gamma = 1.0f - exp2f(-5.0f - (float)h);
    const float gn = RET ? C.in[I_RGN][(l * 4 + h) * 64 + lane] : C.in[I_GGN][(l * 4 + h) * 64 + lane];
    for (int t = 0; t < nt; ++t) {
        const int r = row0 + t; const bf16* z = ZM + (size_t)r * NMIXP;
        float ql, kl, dl = 1.f;
        if (RET) { ql = RQ[(size_t)r * 256 + h * 64 + lane]; kl = RK[(size_t)r * 256 + h * 64 + lane]; }
        else { const int lk = lane & 31; ql = bf2f(z[G_Q + h * 32 + lk]) * 0.17677669529663687f; kl = bf2f(z[G_K + h * 32 + lk]); dl = __expf(LD[(size_t)r * 128 + h * 32 + lk]); }
        const float v = bf2f(z[(RET ? R_V : G_V) + h * 64 + lane]);
        float o = 0.f;
#pragma unroll
        for (int k = 0; k < DK; ++k) { const float qk = __shfl(ql, k), kk = __shfl(kl, k); const float dk = RET ? gamma : __shfl(dl, k);
            S[k] = dk * S[k] + kk * v; o += qk * S[k]; if ((k & 7) == 7) __builtin_amdgcn_sched_barrier(0); }
        float y;
        if (RET) { const float mean = wave_sum(o) * (1.0f / 64); const float d = o - mean; const float var = wave_sum(d * d) * (1.0f / 64); y = d * rsqrtf(var + EPS) * gn; }
        else { const float ms = wave_sum(o * o) * (1.0f / 64); y = o * rsqrtf(ms + EPS) * gn; }
        const float g = bf2f(z[(RET ? R_G : G_R) + h * 64 + lane]);
        BR[(size_t)r * D + (RET ? 256 : 512) + h * 64 + lane] = (bf16)f2bf(siluf_(g) * y);
    }
    float* so = C.out + (RET ? (smp ? O_RS + (((size_t)l * DB + b) * 4 + h) * DK * 64 : O_RP + (((size_t)l * BATCH + b) * 4 + h) * DK * 64)
                             : (smp ? O_GS + (((size_t)l * DB + b) * 4 + h) * DK * 64 : O_GP + (((size_t)l * BATCH + b) * 4 + h) * DK * 64));
#pragma unroll
    for (int k = 0; k < DK; ++k) so[k * 64 + lane] = S[k];
}
__device__ __forceinline__ void n2_la(const Ctx& C, int l) {
    THREAD_IDS();
    if ((gw & 63) == 0 && (gw >> 6) < 32) { const int it = gw >> 6; const int b = (it >> 2) & 3, h = it & 3;
        if (it < 16) la_seq<64, true>(C, l, false, b, h); else la_seq<32, false>(C, l, false, b, h); }
    for (int it = gw; it < 256; it += NGW) { const int typ = it >> 7, b = (it >> 2) & 31, h = it & 3;
        if (typ == 0) la_seq<64, true>(C, l, true, b, h); else la_seq<32, false>(C, l, true, b, h); }
}
__device__ __forceinline__ void n2_attn_prompt(const Ctx& C, int l, float lam_init) {
    THREAD_IDS();
    const float* QN = WSP(float, WS_QN); const float* KN = WSP(float, WS_KN); const float* VB = WSP(float, WS_VB); bf16* BR = WSP(bf16, WS_BR);
    const float lam = lam_of(C, l, lam_init);
    LAS float* park = (LAS float*)(C.lds) + wave * (64 * 65);
    constexpr int NQG = (L + 63) / 64;
    for (int it = gw; it < BATCH * 4 * NQG; it += NGW) {
        const int qg = NQG - 1 - it / 16, bh = it % 16, b = bh >> 2, h = bh & 3;
        const int qpos = min(qg * 64 + lane, L - 1); const bool valid = (qg * 64 + lane) < L; const int qrow = b * L + qpos;
        const int nkeys = min(qg * 64 + 64, L);
        float bias_near[1]; (void)bias_near;
        for (int s = 0; s < 2; ++s) {
            float q[32];
#pragma unroll
            for (int i = 0; i < 32; i += 4) { const f32x4 t = *(const f32x4*)(QN + (size_t)qrow * 256 + h * 64 + s * 32 + i); q[i] = t[0] * 0.17677669529663687f; q[i + 1] = t[1] * 0.17677669529663687f; q[i + 2] = t[2] * 0.17677669529663687f; q[i + 3] = t[3] * 0.17677669529663687f; }
            float m = -INFINITY, lsum = 0.f; float acc[64];
#pragma unroll
            for (int i = 0; i < 64; ++i) acc[i] = 0.f;
            for (int j = 0; j < nkeys; ++j) {
                const float* kp = KN + (size_t)(b * L + j) * 256 + h * 64 + s * 32; const float* vp = VB + (size_t)(b * L + j) * 256 + h * 64;
                float sc = 0.f;
#pragma unroll
                for (int i = 0; i < 32; i += 4) { const f32x4 kv = *(const f32x4*)(kp + i); sc += q[i] * kv[0] + q[i + 1] * kv[1] + q[i + 2] * kv[2] + q[i + 3] * kv[3]; }
                const int n = qpos - j;
                sc += C.in[I_RELB][t5_bucket(n < 0 ? 0 : n) * 4 + h];
                if (n < 0) sc = -INFINITY;
                const float mn = fmaxf(m, sc); const float corr = __expf(m - mn); const float p = __expf(sc - mn);
                m = mn; lsum = lsum * corr + p;
#pragma unroll
                for (int i = 0; i < 64; i += 4) { const f32x4 vv = *(const f32x4*)(vp + i); acc[i] = acc[i] * corr + p * vv[0]; acc[i + 1] = acc[i + 1] * corr + p * vv[1]; acc[i + 2] = acc[i + 2] * corr + p * vv[2]; acc[i + 3] = acc[i + 3] * corr + p * vv[3]; }
            }
            const float inv = 1.0f / lsum;
            if (s == 0) {
#pragma unroll
                for (int i = 0; i < 64; ++i) park[lane * 65 + i] = acc[i] * inv;
                LDS_WAIT();
            } else {
                float ms = 0.f;
#pragma unroll
                for (int i = 0; i < 64; ++i) { acc[i] = park[lane * 65 + i] - lam * (acc[i] * inv); ms += acc[i] * acc[i]; }
                const float rn = rsqrtf(ms * (1.0f / 64) + EPS) * (1.0f - lam_init);
                if (valid) {
#pragma unroll
                    for (int i = 0; i < 64; i += 2) { const unsigned w = pk2(acc[i] * rn * C.in[I_SUBLN][l * 64 + i], acc[i + 1] * rn * C.in[I_SUBLN][l * 64 + i + 1]); *(unsigned*)(BR + (size_t)qrow * D + 768 + h * 64 + i) = w; } }
                LDS_WAIT();
            }
        }
    }
}
__device__ __forceinline__ void n2_attn_sample(const Ctx& C, int l, float lam_init) {
    THREAD_IDS();
    const float* QN = WSP(float, WS_QN); const float* KN = WSP(float, WS_KN); const float* VB = WSP(float, WS_VB); bf16* BR = WSP(bf16, WS_BR);
    const int* PT = (const int*)C.in[I_PT]; const float* CK = C.in[I_CK] + (size_t)l * NPOOL * PAGE * 256; const float* CV = C.in[I_CV] + (size_t)l * NPOOL * PAGE * 256;
    const float lam = lam_of(C, l, lam_init);
    LAS float* part = (LAS float*)C.lds;
    for (int b = blockIdx.x; b < DB; b += C.G) {
        const int row = tid & 63, split = tid >> 6, h = row >> 4, s = (row >> 3) & 1, t = row & 7;
        float q[32];
#pragma unroll
        for (int i = 0; i < 32; ++i) q[i] = QN[(size_t)(MP + b * 8 + t) * 256 + h * 64 + s * 32 + i] * 0.17677669529663687f;
        float m = -INFINITY, lsum = 0.f; float acc[64];
#pragma unroll
        for (int i = 0; i < 64; ++i) acc[i] = 0.f;
        for (int j = split; j < PAST + DS; j += 8) {
            const float* kp; const float* vp; bool vis = true;
            if (j < PAST) { const int page = PT[b * NPAGES + (j >> 7)]; const size_t base = (((size_t)page * PAGE + (j & 127)) * 4 + h) * 64; kp = CK + base + s * 32; vp = CV + base; }
            else { const int jj = j - PAST; const size_t r2 = (size_t)(MP + b * 8 + jj); kp = KN + r2 * 256 + h * 64 + s * 32; vp = VB + r2 * 256 + h * 64; vis = jj <= t; }
            float sc = 0.f;
#pragma unroll
            for (int i = 0; i < 32; i += 4) { const f32x4 kv = *(const f32x4*)(kp + i); sc += q[i] * kv[0] + q[i + 1] * kv[1] + q[i + 2] * kv[2] + q[i + 3] * kv[3]; }
            const int n = PAST + t - j;
            sc += C.in[I_RELB][t5_bucket(n < 0 ? 0 : n) * 4 + h];
            if (!vis) sc = -INFINITY;
            const float mn = fmaxf(m, sc); const float corr = __expf(m - mn); const float p = __expf(sc - mn);
            m = mn; lsum = lsum * corr + p;
#pragma unroll
            for (int i = 0; i < 64; i += 4) { const f32x4 vv = *(const f32x4*)(vp + i); acc[i] = acc[i] * corr + p * vv[0]; acc[i + 1] = acc[i + 1] * corr + p * vv[1]; acc[i + 2] = acc[i + 2] * corr + p * vv[2]; acc[i + 3] = acc[i + 3] * corr + p * vv[3]; }
        }
        LAS float* pr = part + (split * 64 + row) * 66;
        pr[64] = m; pr[65] = lsum;
#pragma unroll
        for (int i = 0; i < 64; ++i) pr[i] = acc[i];
        __syncthreads();
        for (int k = 0; k < 4; ++k) { const int p = wave * 4 + k, h2 = p >> 3, t2 = p & 7; float os[2];
#pragma unroll
            for (int s2 = 0; s2 < 2; ++s2) { const int rw = h2 * 16 + s2 * 8 + t2; float mm = -INFINITY;
                for (int sp = 0; sp < 8; ++sp) mm = fmaxf(mm, part[(sp * 64 + rw) * 66 + 64]);
                float ll = 0.f, oo = 0.f;
                for (int sp = 0; sp < 8; ++sp) { const float w = __expf(part[(sp * 64 + rw) * 66 + 64] - mm); ll += part[(sp * 64 + rw) * 66 + 65] * w; oo += part[(sp * 64 + rw) * 66 + lane] * w; }
                os[s2] = oo / ll; }
            const float o = os[0] - lam * os[1]; const float ms = wave_sum(o * o) * (1.0f / 64);
            const float y = o * rsqrtf(ms + EPS) * C.in[I_SUBLN][l * 64 + lane] * (1.0f - lam_init);
            BR[(size_t)(MP + b * 8 + t2) * D + 768 + h2 * 64 + lane] = (bf16)f2bf(y); }
        __syncthreads();
    }
}
typedef short bf16x8_t __attribute__((ext_vector_type(8)));
template <int DK, bool RET> __device__ __forceinline__ void la_chunked(const Ctx& C, int l, bool smp, int b, int h) {
    THREAD_IDS();
    constexpr int QS = DK + 8, TS = 72, NKB = DK / 16, NKS = DK / 32;
    constexpr int SB = 2 * 64 * QS + 64 * TS + DK * TS + 64 * TS + 64;
    LAS bf16* SB0 = (LAS bf16*)(C.lds);
    LAS bf16* AL = SB0 + 2 * SB;
    LAS bf16* ST = AL + 64 * TS;
    const bf16* ZM = WSP(bf16, WS_ZMIX); const float* RQ = WSP(float, WS_RQ); const float* RK = WSP(float, WS_RK); const float* LD = WSP(float, WS_LDEC); bf16* BR = WSP(bf16, WS_BR);
    const int nt = smp ? DS : L, row0 = smp ? MP + b * DS : b * L, nch = (nt + 63) >> 6;
    const float lg2 = RET ? log2f(1.0f - exp2f(-5.0f - (float)h)) : 0.f;
    const int g4 = lane >> 4, c16 = lane & 15;
    const bool qwave = wave < 4; const int w4 = wave & 3;
    float Sreg[NKB][4];
    if (wave >= 4) {
        const float* s0 = (RET ? C.in[I_SRET] : C.in[I_SGLA]) + (((size_t)l * DB + b) * 4 + h) * DK * 64;
#pragma unroll
        for (int cb = 0; cb < NKB; ++cb)
#pragma unroll
            for (int r = 0; r < 4; ++r) { const int dk = cb * 16 + c16, dv = (wave - 4) * 16 + 4 * g4 + r; const float v = smp ? s0[dk * 64 + dv] : 0.f; Sreg[cb][r] = v; ST[dv * QS + dk] = (bf16)f2bf(v); }
    }
    float gnv[4];
#pragma unroll
    for (int cb = 0; cb < 4; ++cb) gnv[cb] = (RET ? C.in[I_RGN] : C.in[I_GGN])[(l * 4 + h) * 64 + cb * 16 + c16];
    float a[16]; v4u vr;
#define LA_LOAD(c) do { const size_t r_ = (size_t)(row0 + (c) * 64 + lane); const bf16* z_ = ZM + r_ * NMIXP; \
        vr = *(const v4u*)(z_ + (RET ? R_V : G_V) + h * 64 + 8 * wave); \
        if (RET) { const float* p_ = (qwave ? RQ : RK) + r_ * 256 + h * 64 + 8 * w4; const f32x4 x0 = *(const f32x4*)p_, x1 = *(const f32x4*)(p_ + 4), x2 = *(const f32x4*)(p_ + 32), x3 = *(const f32x4*)(p_ + 36); \
            a[0] = x0[0]; a[1] = x0[1]; a[2] = x0[2]; a[3] = x0[3]; a[4] = x1[0]; a[5] = x1[1]; a[6] = x1[2]; a[7] = x1[3]; a[8] = x2[0]; a[9] = x2[1]; a[10] = x2[2]; a[11] = x2[3]; a[12] = x3[0]; a[13] = x3[1]; a[14] = x3[2]; a[15] = x3[3]; } \
        else { const v4u q_ = *(const v4u*)(z_ + (qwave ? G_Q : G_K) + h * 32 + 8 * w4); const float* p_ = LD + r_ * 128 + h * 32 + 8 * w4; const f32x4 x0 = *(const f32x4*)p_, x1 = *(const f32x4*)(p_ + 4); \
            a[0] = bflo(q_.x); a[1] = bfhi(q_.x); a[2] = bflo(q_.y); a[3] = bfhi(q_.y); a[4] = bflo(q_.z); a[5] = bfhi(q_.z); a[6] = bflo(q_.w); a[7] = bfhi(q_.w); \
            a[8] = x0[0]; a[9] = x0[1]; a[10] = x0[2]; a[11] = x0[3]; a[12] = x1[0]; a[13] = x1[1]; a[14] = x1[2]; a[15] = x1[3]; } } while (0)
    LA_LOAD(0);
    int cur = 0;
    for (int i = 0; i <= nch; ++i) {
        if (i < nch) {
            const int c = i; LAS bf16* QT = SB0 + (i & 1) * SB; LAS bf16* KT = QT + 64 * QS; LAS bf16* VT = KT + 64 * QS; LAS bf16* KE = VT + 64 * TS; LAS bf16* GT = KE + DK * TS; LAS float* WT = (LAS float*)(GT + 64 * TS);
            const int nvc = min(64, nt - c * 64); const bool valid = lane < nvc;
        if (RET) {
            const float tq = (float)(lane + 1);
            if (qwave) { const float e = valid ? __builtin_amdgcn_exp2f(lg2 * tq) : 0.f;
                v4u w0, w1; w0.x = pg8::cvt_pk_bf16(a[0] * e, a[1] * e); w0.y = pg8::cvt_pk_bf16(a[2] * e, a[3] * e); w0.z = pg8::cvt_pk_bf16(a[4] * e, a[5] * e); w0.w = pg8::cvt_pk_bf16(a[6] * e, a[7] * e);
                w1.x = pg8::cvt_pk_bf16(a[8] * e, a[9] * e); w1.y = pg8::cvt_pk_bf16(a[10] * e, a[11] * e); w1.z = pg8::cvt_pk_bf16(a[12] * e, a[13] * e); w1.w = pg8::cvt_pk_bf16(a[14] * e, a[15] * e);
                *(LAS v4u*)(QT + lane * QS + 8 * w4) = w0; *(LAS v4u*)(QT + lane * QS + 32 + 8 * w4) = w1; }
            else { const float e = valid ? __builtin_amdgcn_exp2f(-lg2 * tq) : 0.f, ee = valid ? __builtin_amdgcn_exp2f(lg2 * ((float)nvc - tq)) : 0.f;
                v4u w0, w1; w0.x = pg8::cvt_pk_bf16(a[0] * e, a[1] * e); w0.y = pg8::cvt_pk_bf16(a[2] * e, a[3] * e); w0.z = pg8::cvt_pk_bf16(a[4] * e, a[5] * e); w0.w = pg8::cvt_pk_bf16(a[6] * e, a[7] * e);
                w1.x = pg8::cvt_pk_bf16(a[8] * e, a[9] * e); w1.y = pg8::cvt_pk_bf16(a[10] * e, a[11] * e); w1.z = pg8::cvt_pk_bf16(a[12] * e, a[13] * e); w1.w = pg8::cvt_pk_bf16(a[14] * e, a[15] * e);
                *(LAS v4u*)(KT + lane * QS + 8 * w4) = w0; *(LAS v4u*)(KT + lane * QS + 32 + 8 * w4) = w1;
#pragma unroll
                for (int i = 0; i < 16; i += 2) { const unsigned mine = pg8::cvt_pk_bf16(a[i] * ee, a[i + 1] * ee); const unsigned pv = (unsigned)__shfl_xor((int)mine, 1);
                    const unsigned w = (lane & 1) ? ((pv >> 16) | (mine & 0xffff0000u)) : ((mine & 0xffffu) | (pv << 16));
                    const int row = (i < 8 ? 8 * w4 + i : 32 + 8 * w4 + (i - 8)) + (lane & 1);
                    *(LAS unsigned*)(KE + row * TS + (lane & ~1)) = w; } }
        } else {
            float bb[8];
#pragma unroll
            for (int i = 0; i < 8; ++i) bb[i] = valid ? a[8 + i] : 0.f;
#pragma unroll
            for (int i = 0; i < 8; ++i) { float x = bb[i];
                x += __builtin_bit_cast(float, __builtin_amdgcn_mov_dpp(__builtin_bit_cast(int, x), 0x111, 0xf, 0xf, true));
                x += __builtin_bit_cast(float, __builtin_amdgcn_mov_dpp(__builtin_bit_cast(int, x), 0x112, 0xf, 0xf, true));
                x += __builtin_bit_cast(float, __builtin_amdgcn_mov_dpp(__builtin_bit_cast(int, x), 0x114, 0xf, 0xf, true));
                x += __builtin_bit_cast(float, __builtin_amdgcn_mov_dpp(__builtin_bit_cast(int, x), 0x118, 0xf, 0xf, true));
                const float t0 = __builtin_bit_cast(float, __builtin_amdgcn_readlane(__builtin_bit_cast(int, x), 15)), t1 = __builtin_bit_cast(float, __builtin_amdgcn_readlane(__builtin_bit_cast(int, x), 31)), t2 = __builtin_bit_cast(float, __builtin_amdgcn_readlane(__builtin_bit_cast(int, x), 47));
                bb[i] = x + (lane >= 16 ? t0 : 0.f) + (lane >= 32 ? t1 : 0.f) + (lane >= 48 ? t2 : 0.f); }
            if (qwave) {
                if (lane == 63) {
#pragma unroll
                    for (int i = 0; i < 8; ++i) WT[8 * w4 + i] = bb[i]; }
                float o8[8];
#pragma unroll
                for (int i = 0; i < 8; ++i) o8[i] = valid ? a[i] * 0.17677669529663687f * __expf(bb[i]) : 0.f;
                v4u w0; w0.x = pg8::cvt_pk_bf16(o8[0], o8[1]); w0.y = pg8::cvt_pk_bf16(o8[2], o8[3]); w0.z = pg8::cvt_pk_bf16(o8[4], o8[5]); w0.w = pg8::cvt_pk_bf16(o8[6], o8[7]);
                *(LAS v4u*)(QT + lane * QS + 8 * w4) = w0;
            } else {
                float o8[8];
#pragma unroll
                for (int i = 0; i < 8; ++i) o8[i] = valid ? a[i] * __expf(-bb[i]) : 0.f;
#pragma unroll
                for (int i = 0; i < 8; i += 2) { const float t0 = __shfl(bb[i], 63), t1 = __shfl(bb[i + 1], 63);
                    const unsigned mine = pg8::cvt_pk_bf16(valid ? a[i] * __expf(t0 - bb[i]) : 0.f, valid ? a[i + 1] * __expf(t1 - bb[i + 1]) : 0.f); const unsigned pv = (unsigned)__shfl_xor((int)mine, 1);
                    const unsigned w = (lane & 1) ? ((pv >> 16) | (mine & 0xffff0000u)) : ((mine & 0xffffu) | (pv << 16));
                    *(LAS unsigned*)(KE + (8 * w4 + i + (lane & 1)) * TS + (lane & ~1)) = w; }
                v4u w0; w0.x = pg8::cvt_pk_bf16(o8[0], o8[1]); w0.y = pg8::cvt_pk_bf16(o8[2], o8[3]); w0.z = pg8::cvt_pk_bf16(o8[4], o8[5]); w0.w = pg8::cvt_pk_bf16(o8[6], o8[7]);
                *(LAS v4u*)(KT + lane * QS + 8 * w4) = w0;
            }
        }
        { const unsigned vv[4] = {valid ? vr.x : 0u, valid ? vr.y : 0u, valid ? vr.z : 0u, valid ? vr.w : 0u};
#pragma unroll
          for (int i = 0; i < 4; ++i) { const unsigned pv = (unsigned)__shfl_xor((int)vv[i], 1);
              const unsigned w = (lane & 1) ? ((pv >> 16) | (vv[i] & 0xffff0000u)) : ((vv[i] & 0xffffu) | (pv << 16));
              *(LAS unsigned*)(VT + (8 * wave + 2 * i + (lane & 1)) * TS + (lane & ~1)) = w; } }
            if (c + 1 < nch) LA_LOAD(c + 1);
        }
        if (i >= 1) {
            LAS bf16* QT = SB0 + ((i - 1) & 1) * SB; LAS bf16* KT = QT + 64 * QS;
        { const int rb = wave >> 1;
#pragma unroll
          for (int ci = 0; ci < 2; ++ci) { const int cb = (wave & 1) * 2 + ci; f32x4 acc = {0.f, 0.f, 0.f, 0.f};
              if (cb <= rb) {
#pragma unroll
                  for (int ks = 0; ks < NKS; ++ks) { const bf16x8_t af = *(const LAS bf16x8_t*)(QT + (rb * 16 + c16) * QS + ks * 32 + 8 * g4), bf = *(const LAS bf16x8_t*)(KT + (cb * 16 + c16) * QS + ks * 32 + 8 * g4);
                      acc = __builtin_amdgcn_mfma_f32_16x16x32_bf16(af, bf, acc, 0, 0, 0); } }
#pragma unroll
              for (int r = 0; r < 4; ++r) { const int tt = rb * 16 + 4 * g4 + r, ss = cb * 16 + c16; AL[tt * TS + ss] = (bf16)f2bf(ss <= tt ? acc[r] : 0.f); } } }
        }
        LDS_WAIT(); __builtin_amdgcn_s_barrier(); asm volatile("" ::: "memory");
        if (i >= 1) {
            const int c = i - 1; LAS bf16* QT = SB0 + (c & 1) * SB; LAS bf16* KT = QT + 64 * QS; LAS bf16* VT = KT + 64 * QS; LAS bf16* KE = VT + 64 * TS; LAS bf16* GT = KE + DK * TS; LAS float* WT = (LAS float*)(GT + 64 * TS);
            const int nvc = min(64, nt - c * 64); (void)KT;
        if (wave < 4) {
            const int rb = wave; const LAS bf16* STc = ST + cur * 64 * QS;
            f32x4 o[4];
#pragma unroll
            for (int cb = 0; cb < 4; ++cb) o[cb] = (f32x4){0.f, 0.f, 0.f, 0.f};
#pragma unroll
            for (int ks = 0; ks < 2; ++ks) { const bf16x8_t af = *(const LAS bf16x8_t*)(AL + (rb * 16 + c16) * TS + ks * 32 + 8 * g4);
#pragma unroll
                for (int cb = 0; cb < 4; ++cb) { const bf16x8_t bf = *(const LAS bf16x8_t*)(VT + (cb * 16 + c16) * TS + ks * 32 + 8 * g4); o[cb] = __builtin_amdgcn_mfma_f32_16x16x32_bf16(af, bf, o[cb], 0, 0, 0); } }
#pragma unroll
            for (int ks = 0; ks < NKS; ++ks) { const bf16x8_t af = *(const LAS bf16x8_t*)(QT + (rb * 16 + c16) * QS + ks * 32 + 8 * g4);
#pragma unroll
                for (int cb = 0; cb < 4; ++cb) { const bf16x8_t bf = *(const LAS bf16x8_t*)(STc + (cb * 16 + c16) * QS + ks * 32 + 8 * g4); o[cb] = __builtin_amdgcn_mfma_f32_16x16x32_bf16(af, bf, o[cb], 0, 0, 0); } }
            { float* LAO = WSP(float, WS_LAO);
#pragma unroll
              for (int r = 0; r < 4; ++r) { const int tok = c * 64 + rb * 16 + 4 * g4 + r;
                  if (tok < nt) { float* op = LAO + (size_t)(row0 + tok) * 512 + (RET ? 0 : 256) + h * 64 + c16;
#pragma unroll
                      for (int cb = 0; cb < 4; ++cb) op[cb * 16] = o[cb][r]; } } }
        } else {
            const int dvb = wave - 4; LAS bf16* STn = ST + (cur ^ 1) * 64 * QS;
            f32x4 ds[NKB];
#pragma unroll
            for (int cb = 0; cb < NKB; ++cb) ds[cb] = (f32x4){0.f, 0.f, 0.f, 0.f};
#pragma unroll
            for (int ks = 0; ks < 2; ++ks) { const bf16x8_t af = *(const LAS bf16x8_t*)(VT + (dvb * 16 + c16) * TS + ks * 32 + 8 * g4);
#pragma unroll
                for (int cb = 0; cb < NKB; ++cb) { const bf16x8_t bf = *(const LAS bf16x8_t*)(KE + (cb * 16 + c16) * TS + ks * 32 + 8 * g4); ds[cb] = __builtin_amdgcn_mfma_f32_16x16x32_bf16(af, bf, ds[cb], 0, 0, 0); } }
#pragma unroll
            for (int cb = 0; cb < NKB; ++cb) { const float eB = RET ? __builtin_amdgcn_exp2f(lg2 * (float)nvc) : __expf(WT[cb * 16 + c16]);
#pragma unroll
                for (int r = 0; r < 4; ++r) { Sreg[cb][r] = eB * Sreg[cb][r] + ds[cb][r]; STn[(dvb * 16 + 4 * g4 + r) * QS + cb * 16 + c16] = (bf16)f2bf(Sreg[cb][r]); } }
        }
            cur ^= 1;
        }
        LDS_WAIT(); __builtin_amdgcn_s_barrier(); asm volatile("" ::: "memory");
    }
#undef LA_LOAD
    if (wave >= 4) {
        float* so = C.out + (RET ? (smp ? O_RS + (((size_t)l * DB + b) * 4 + h) * DK * 64 : O_RP + (((size_t)l * BATCH + b) * 4 + h) * DK * 64)
                                 : (smp ? O_GS + (((size_t)l * DB + b) * 4 + h) * DK * 64 : O_GP + (((size_t)l * BATCH + b) * 4 + h) * DK * 64));
#pragma unroll
        for (int cb = 0; cb < NKB; ++cb)
#pragma unroll
            for (int r = 0; r < 4; ++r) so[(cb * 16 + c16) * 64 + (wave - 4) * 16 + 4 * g4 + r] = Sreg[cb][r];
    }
}
__device__ __forceinline__ void n2_la_chunked(const Ctx& C, int l) {
    const int bx = blockIdx.x;
    if (bx < 32) { const int b = (bx >> 2) & 3, h = bx & 3; if (bx < 16) la_chunked<64, true>(C, l, false, b, h); else la_chunked<32, false>(C, l, false, b, h); }
    else { for (int it = bx - 32; it < 256; it += C.G - 32) { const int b = (it >> 2) & 31, h = it & 3; if (it < 128) la_chunked<64, true>(C, l, true, b, h); else la_chunked<32, false>(C, l, true, b, h); } }
}
typedef float f32x16_t __attribute__((ext_vector_type(16)));
__device__ __forceinline__ int crow_(int r, int hi) { return (r & 3) + 8 * (r >> 2) + 4 * hi; }
__device__ __forceinline__ float swapmax32(float m) { auto rr = __builtin_amdgcn_permlane32_swap(__float_as_uint(m), __float_as_uint(m), false, false); return fmaxf(__uint_as_float(rr[0]), __uint_as_float(rr[1])); }
__device__ __forceinline__ float swapadd32(float m) { auto rr = __builtin_amdgcn_permlane32_swap(__float_as_uint(m), __float_as_uint(m), false, false); return __uint_as_float(rr[0]) + __uint_as_float(rr[1]); }
constexpr float LOG2E = 1.4426950408889634f;
__device__ __forceinline__ void attn_prompt_item(const Ctx& C, int l, int b, int h, int qb, float lam, float lam_init, float mb) {
    THREAD_IDS();
    constexpr int KS = 72;
    LAS bf16* Kt = (LAS bf16*)C.lds;
    LAS bf16* Vt = Kt + 2 * 64 * KS;
    LAS float* BT = (LAS float*)(Vt + 2 * 64 * KS);
    LAS float* OX = BT + 128;
    const bf16* ZM = WSP(bf16, WS_ZMIX); const bf16* QNB = WSP(bf16, WS_QNB); const bf16* KNB = WSP(bf16, WS_KNB); bf16* BR = WSP(bf16, WS_BR);
    const int r32 = lane & 31, hi = lane >> 5, qs = wave >> 1, s = wave & 1;
    const int q0 = qb * 128 + qs * 32; const int rowb = b * L;
    if (tid < 128) BT[tid] = (C.in[I_RELB][t5_bucket(tid) * 4 + h] - C.in[I_RELB][31 * 4 + h]) * LOG2E;
    pg8::bf16x8 qf[2];
#pragma unroll
    for (int d0 = 0; d0 < 2; ++d0) qf[d0] = *(const pg8::bf16x8*)(QNB + (size_t)(rowb + q0 + r32) * 256 + h * 64 + s * 32 + 16 * d0 + 8 * hi);
    const int pl = (lane & ~15) | ((lane & 8) >> 1) | ((lane & 4) << 1) | (lane & 3);
    const int NT = (min(128 * (qb + 1), L) + 63) >> 6;
    v4u kreg, vreg;
#define AT_LOAD(j) do { const size_t r_ = (size_t)(rowb + (j) * 64 + lane); kreg = *(const v4u*)(KNB + r_ * 256 + h * 64 + 8 * wave); vreg = *(const v4u*)(ZM + r_ * NMIXP + D_V + h * 64 + 8 * wave); } while (0)
#define AT_STORE(buf) do { *(LAS v4u*)(Kt + (buf) * 64 * KS + lane * KS + 8 * wave) = kreg; LAS bf16* v_ = Vt + (buf) * 64 * KS + (8 * wave) * KS + pl; \
        v_[0] = (bf16)(vreg.x & 0xffffu); v_[KS] = (bf16)(vreg.x >> 16); v_[2 * KS] = (bf16)(vreg.y & 0xffffu); v_[3 * KS] = (bf16)(vreg.y >> 16); \
        v_[4 * KS] = (bf16)(vreg.z & 0xffffu); v_[5 * KS] = (bf16)(vreg.z >> 16); v_[6 * KS] = (bf16)(vreg.w & 0xffffu); v_[7 * KS] = (bf16)(vreg.w >> 16); } while (0)
    AT_LOAD(0); AT_STORE(0); if (NT > 1) AT_LOAD(1);
    LDS_WAIT(); __builtin_amdgcn_s_barrier(); asm volatile("" ::: "memory");
    float lsum = 0.f; f32x16_t o[2]; f32x16_t negm;
#pragma unroll
    for (int i = 0; i < 16; ++i) negm[i] = -mb;
#pragma unroll
    for (int i = 0; i < 16; ++i) { o[0][i] = 0.f; o[1][i] = 0.f; }
    for (int j = 0; j < NT; ++j) {
        const int k0 = 64 * j, buf = j & 1;
        if (k0 <= q0 + 31) {
            const LAS bf16* kb = Kt + buf * 64 * KS; const LAS bf16* vb = Vt + buf * 64 * KS;
            f32x16_t p0 = negm, p1 = negm;
#pragma unroll
            for (int d0 = 0; d0 < 2; ++d0) { const pg8::bf16x8 a0 = *(const LAS pg8::bf16x8*)(kb + r32 * KS + s * 32 + 16 * d0 + 8 * hi), a1 = *(const LAS pg8::bf16x8*)(kb + (32 + r32) * KS + s * 32 + 16 * d0 + 8 * hi);
                p0 = __builtin_amdgcn_mfma_f32_32x32x16_bf16(a0, qf[d0], p0, 0, 0, 0); p1 = __builtin_amdgcn_mfma_f32_32x32x16_bf16(a1, qf[d0], p1, 0, 0, 0); }
            if (q0 - k0 - 63 < 113) {
#pragma unroll
                for (int r = 0; r < 16; ++r) { const int n0 = (q0 + r32) - (k0 + crow_(r, hi)), n1 = n0 - 32;
                    p0[r] = n0 < 0 ? -INFINITY : p0[r] + (n0 < 128 ? BT[n0] : 0.f); p1[r] = n1 < 0 ? -INFINITY : p1[r] + (n1 < 128 ? BT[n1] : 0.f); } }
            typedef float f32x2_t __attribute__((ext_vector_type(2)));
            f32x2_t ps2 = {0.f, 0.f};
#pragma unroll
            for (int r = 0; r < 16; r += 2) { p0[r] = __builtin_amdgcn_exp2f(p0[r]); p0[r + 1] = __builtin_amdgcn_exp2f(p0[r + 1]); p1[r] = __builtin_amdgcn_exp2f(p1[r]); p1[r + 1] = __builtin_amdgcn_exp2f(p1[r + 1]);
                ps2 = ps2 + (f32x2_t){p0[r], p0[r + 1]}; ps2 = ps2 + (f32x2_t){p1[r], p1[r + 1]}; }
            lsum += ps2[0] + ps2[1];
            pg8::bf16x8 pb[4];
#pragma unroll
            for (int ks = 0; ks < 4; ++ks) { v4u w;
                if (ks < 2) { w.x = pg8::cvt_pk_bf16(p0[8 * ks], p0[8 * ks + 1]); w.y = pg8::cvt_pk_bf16(p0[8 * ks + 2], p0[8 * ks + 3]); w.z = pg8::cvt_pk_bf16(p0[8 * ks + 4], p0[8 * ks + 5]); w.w = pg8::cvt_pk_bf16(p0[8 * ks + 6], p0[8 * ks + 7]); }
                else { w.x = pg8::cvt_pk_bf16(p1[8 * ks - 16], p1[8 * ks - 15]); w.y = pg8::cvt_pk_bf16(p1[8 * ks - 14], p1[8 * ks - 13]); w.z = pg8::cvt_pk_bf16(p1[8 * ks - 12], p1[8 * ks - 11]); w.w = pg8::cvt_pk_bf16(p1[8 * ks - 10], p1[8 * ks - 9]); }
                pb[ks] = __builtin_bit_cast(pg8::bf16x8, w); }
#pragma unroll
            for (int d0 = 0; d0 < 2; ++d0)
#pragma unroll
                for (int ks = 0; ks < 4; ++ks) { const pg8::bf16x8 af = *(const LAS pg8::bf16x8*)(vb + (32 * d0 + r32) * KS + 16 * ks + 8 * hi); o[d0] = __builtin_amdgcn_mfma_f32_32x32x16_bf16(af, pb[ks], o[d0], 0, 0, 0); }
        }
        if (j + 1 < NT) AT_STORE(buf ^ 1);
        if (j + 2 < NT) AT_LOAD(j + 2);
        LDS_WAIT(); __builtin_amdgcn_s_barrier(); asm volatile("" ::: "memory");
    }
#undef AT_LOAD
#undef AT_STORE
    lsum = swapadd32(lsum); const float inv = 1.0f / lsum;
    LAS float* ox = OX + (qs * 32 + r32) * 65;
    if (s == 1) {
#pragma unroll
        for (int d0 = 0; d0 < 2; ++d0)
#pragma unroll
            for (int r = 0; r < 16; ++r) ox[32 * d0 + crow_(r, hi)] = o[d0][r] * inv; }
    LDS_WAIT(); __builtin_amdgcn_s_barrier(); asm volatile("" ::: "memory");
    if (s == 0) {
        float ss = 0.f;
#pragma unroll
        for (int d0 = 0; d0 < 2; ++d0)
#pragma unroll
            for (int r = 0; r < 16; ++r) { const float v = o[d0][r] * inv - lam * ox[32 * d0 + crow_(r, hi)]; o[d0][r] = v; ss += v * v; }
        ss = swapadd32(ss); const float rs = rsqrtf(ss * (1.0f / 64) + EPS) * (1.0f - lam_init);
        const int qpos = q0 + r32;
        if (qpos < L) { bf16* brp = BR + (size_t)(rowb + qpos) * D + 768 + h * 64;
#pragma unroll
            for (int d0 = 0; d0 < 2; ++d0)
#pragma unroll
                for (int r4 = 0; r4 < 4; ++r4) { const int dv = 32 * d0 + 8 * r4 + 4 * hi; const float* sl = C.in[I_SUBLN] + l * 64 + dv;
                    const unsigned w0 = pk2(o[d0][4 * r4] * rs * sl[0], o[d0][4 * r4 + 1] * rs * sl[1]), w1 = pk2(o[d0][4 * r4 + 2] * rs * sl[2], o[d0][4 * r4 + 3] * rs * sl[3]);
                    *(unsigned long long*)(brp + dv) = (unsigned long long)w0 | ((unsigned long long)w1 << 32); } }
    }
    LDS_WAIT(); __builtin_amdgcn_s_barrier(); asm volatile("" ::: "memory");
}
__device__ __forceinline__ void n2_attn_prompt_mfma(const Ctx& C, int l, float lam_init, int qoff = 0) {
    THREAD_IDS();
    const float lam = lam_of(C, l, lam_init);
    unsigned* qw = (unsigned*)(C.ws + WS_CTL) + CW_QUEUE + 64 * (l + qoff);
    volatile LAS int* slot = (volatile LAS int*)(C.lds + MISC_OFF + 64);
    constexpr int NQB = (L + 127) / 128;
    for (;;) {
        if (tid == 0) slot[0] = (int)__hip_atomic_fetch_add(qw, 1u, __ATOMIC_RELAXED, __HIP_MEMORY_SCOPE_AGENT);
        __syncthreads();
        const int it = slot[0];
        if (it >= 16 * NQB) break;
        attn_prompt_item(C, l, (it & 15) >> 2, it & 3, NQB - 1 - (it >> 4), lam, lam_init, 16.0f);
    }
}
constexpr int PSTR = 68;
__device__ __forceinline__ pg8::bf16x8 cvt8(const f32x4 a, const f32x4 b) { v4u w; w.x = pg8::cvt_pk_bf16(a[0], a[1]); w.y = pg8::cvt_pk_bf16(a[2], a[3]); w.z = pg8::cvt_pk_bf16(b[0], b[1]); w.w = pg8::cvt_pk_bf16(b[2], b[3]); return __builtin_bit_cast(pg8::bf16x8, w); }
__device__ __forceinline__ void attn_sample_item(const Ctx& C, int l, int b, int split) {
    THREAD_IDS();
    const int h = wave & 3, half = wave >> 2, c16 = lane & 15, g = lane >> 4, srow = c16 >> 3, t = c16 & 7;
    const bf16* QNB = WSP(bf16, WS_QNB); const int* PT = (const int*)C.in[I_PT];
    const float* CK = C.in[I_CK] + (size_t)l * NPOOL * PAGE * 256; const float* CV = C.in[I_CV] + (size_t)l * NPOOL * PAGE * 256;
    LAS float* BT = (LAS float*)C.lds;
    BT[tid] = (C.in[I_RELB][t5_bucket(tid & 127) * 4 + (tid >> 7)] - C.in[I_RELB][31 * 4 + (tid >> 7)]) * LOG2E;
    const v4u z4 = {0u, 0u, 0u, 0u};
    const v4u q0w = srow == 0 ? *(const v4u*)(QNB + (size_t)(MP + b * 8 + t) * 256 + h * 64 + 8 * g) : z4, q1w = srow == 1 ? *(const v4u*)(QNB + (size_t)(MP + b * 8 + t) * 256 + h * 64 + 32 + 8 * g) : z4;
    const pg8::bf16x8 qf0 = __builtin_bit_cast(pg8::bf16x8, q0w), qf1 = __builtin_bit_cast(pg8::bf16x8, q1w);
    LDS_WAIT(); __builtin_amdgcn_s_barrier(); asm volatile("" ::: "memory");
    float m = -INFINITY, lsum = 0.f; f32x4 o[4];
#pragma unroll
    for (int db = 0; db < 4; ++db) o[db] = (f32x4){0.f, 0.f, 0.f, 0.f};
    const int kk0 = split * 1024 + half * 512;
    for (int step = 0; step < 16; ++step) {
        const int kk = kk0 + 32 * step; const int page = PT[b * NPAGES + (kk >> 7)];
        const size_t base = ((size_t)(page * PAGE + (kk & 127)) * 4 + h) * 64;
        f32x4 kr[2][2][2]; float vr[4][8];
#pragma unroll
        for (int T = 0; T < 2; ++T)
#pragma unroll
            for (int ks = 0; ks < 2; ++ks) { const float* p = CK + base + (size_t)(16 * T + c16) * 256 + 32 * ks + 8 * g; kr[T][ks][0] = *(const f32x4*)p; kr[T][ks][1] = *(const f32x4*)(p + 4); }
#pragma unroll
        for (int db = 0; db < 4; ++db)
#pragma unroll
            for (int j = 0; j < 8; ++j) { const int kv = j < 4 ? 4 * g + j : 16 + 4 * g + (j - 4); vr[db][j] = CV[base + (size_t)kv * 256 + 16 * db + c16]; }
        f32x4 sv[2];
#pragma unroll
        for (int T = 0; T < 2; ++T) { sv[T] = (f32x4){0.f, 0.f, 0.f, 0.f};
            sv[T] = __builtin_amdgcn_mfma_f32_16x16x32_bf16(cvt8(kr[T][0][0], kr[T][0][1]), qf0, sv[T], 0, 0, 0);
            sv[T] = __builtin_amdgcn_mfma_f32_16x16x32_bf16(cvt8(kr[T][1][0], kr[T][1][1]), qf1, sv[T], 0, 0, 0); }
        if (kk + 31 + 128 > PAST) {
#pragma unroll
            for (int T = 0; T < 2; ++T)
#pragma unroll
                for (int r = 0; r < 4; ++r) { const int n = PAST + t - (kk + 16 * T + 4 * g + r); if (n < 128) sv[T][r] += BT[h * 128 + n]; } }
        float mt = fmaxf(fmaxf(fmaxf(sv[0][0], sv[0][1]), fmaxf(sv[0][2], sv[0][3])), fmaxf(fmaxf(sv[1][0], sv[1][1]), fmaxf(sv[1][2], sv[1][3])));
        mt = fmaxf(mt, __shfl_xor(mt, 16)); mt = fmaxf(mt, __shfl_xor(mt, 32));
        const float mn = fmaxf(m, mt); const float al = exp2f(m - mn); m = mn;
        float ps = 0.f;
#pragma unroll
        for (int T = 0; T < 2; ++T)
#pragma unroll
            for (int r = 0; r < 4; ++r) { sv[T][r] = exp2f(sv[T][r] - m); ps += sv[T][r]; }
        lsum = lsum * al + ps;
        const pg8::bf16x8 pf = cvt8(sv[0], sv[1]);
#pragma unroll
        for (int db = 0; db < 4; ++db) { o[db] = o[db] * al;
            const f32x4 va = {vr[db][0], vr[db][1], vr[db][2], vr[db][3]}, vb = {vr[db][4], vr[db][5], vr[db][6], vr[db][7]};
            o[db] = __builtin_amdgcn_mfma_f32_16x16x32_bf16(cvt8(va, vb), pf, o[db], 0, 0, 0); }
    }
    lsum += __shfl_xor(lsum, 16); lsum += __shfl_xor(lsum, 32);
    float* pp = WSP(float, WS_PART) + ((((size_t)b * 4 + h) * 16 + split * 2 + half) * 16 + c16) * PSTR;
#pragma unroll
    for (int db = 0; db < 4; ++db) *(f32x4*)(pp + 16 * db + 4 * g) = o[db];
    if (g == 0) { pp[64] = m; pp[65] = lsum; }
    LDS_WAIT(); __builtin_amdgcn_s_barrier(); asm volatile("" ::: "memory");
}
__device__ __forceinline__ void n2_attn_sample_split(const Ctx& C, int l) {
    for (int it = blockIdx.x; it < DB * 8; it += C.G) attn_sample_item(C, l, it >> 3, it & 7);
}
__device__ __forceinline__ void n3_attn_sample_combine(const Ctx& C, int l, float lam_init) {
    THREAD_IDS();
    const float lam = lam_of(C, l, lam_init);
    const bf16* QNB = WSP(bf16, WS_QNB); const bf16* KNB = WSP(bf16, WS_KNB); const bf16* ZM = WSP(bf16, WS_ZMIX); bf16* BR = WSP(bf16, WS_BR);
    for (int it = gw; it < DB * 4 * DS; it += NGW) {
        const int b = it >> 5, h = (it >> 3) & 3, t = it & 7; float os[2];
        const float far = C.in[I_RELB][31 * 4 + h];
#pragma unroll
        for (int s = 0; s < 2; ++s) {
            const float* pb = WSP(float, WS_PART) + ((((size_t)b * 4 + h) * 16) * 16 + s * 8 + t) * PSTR;
            float sn[8]; float mm = -INFINITY;
            for (int pi = 0; pi < 16; ++pi) mm = fmaxf(mm, pb[(size_t)pi * 16 * PSTR + 64]);
#pragma unroll
            for (int jj = 0; jj < 8; ++jj) { float d = 0.f;
                for (int i = 0; i < 32; ++i) d += bf2f(QNB[(size_t)(MP + b * 8 + t) * 256 + h * 64 + s * 32 + i]) * bf2f(KNB[(size_t)(MP + b * 8 + jj) * 256 + h * 64 + s * 32 + i]);
                d += (C.in[I_RELB][t5_bucket(t - jj < 0 ? 0 : t - jj) * 4 + h] - far) * LOG2E;
                sn[jj] = jj <= t ? d : -INFINITY; mm = fmaxf(mm, sn[jj]); }
            float ll = 0.f, oo = 0.f;
            for (int pi = 0; pi < 16; ++pi) { const float* pr = pb + (size_t)pi * 16 * PSTR; const float w = exp2f(pr[64] - mm); ll += pr[65] * w; oo += pr[lane] * w; }
#pragma unroll
            for (int jj = 0; jj < 8; ++jj) { const float w = exp2f(sn[jj] - mm); ll += w; oo += w * bf2f(ZM[(size_t)(MP + b * 8 + jj) * NMIXP + D_V + h * 64 + lane]); }
            os[s] = oo / ll;
        }
        const float o = os[0] - lam * os[1]; const float ms = wave_sum(o * o) * (1.0f / 64);
        BR[(size_t)(MP + b * 8 + t) * D + 768 + h * 64 + lane] = (bf16)f2bf(o * rsqrtf(ms + EPS) * C.in[I_SUBLN][l * 64 + lane] * (1.0f - lam_init));
    }
}

__device__ __forceinline__ void n3_la_finalize(const Ctx& C, int l) {
    THREAD_IDS();
    const float* LAO = WSP(float, WS_LAO); const bf16* ZM = WSP(bf16, WS_ZMIX); bf16* BR = WSP(bf16, WS_BR);
    const bool ret = lane < 32; const int hd = (lane >> 3) & 3, c8 = (lane & 7) * 8;
    float gn[8];
#pragma unroll
    for (int j = 0; j < 8; ++j) gn[j] = (ret ? C.in[I_RGN] : C.in[I_GGN])[(l * 4 + hd) * 64 + c8 + j];
    for (int r = gw; r < MP; r += NGW) {
        const f32x4 a = *(const f32x4*)(LAO + (size_t)r * 512 + 8 * lane), b = *(const f32x4*)(LAO + (size_t)r * 512 + 8 * lane + 4);
        const v4u gw4 = *(const v4u*)(ZM + (size_t)r * NMIXP + (ret ? R_G : G_R) + hd * 64 + c8);
        float x[8] = {a[0], a[1], a[2], a[3], b[0], b[1], b[2], b[3]}, g[8]; unpack8(gw4, g);
        float s = ((x[0] + x[1]) + (x[2] + x[3])) + ((x[4] + x[5]) + (x[6] + x[7]));
        s += __shfl_xor(s, 1); s += __shfl_xor(s, 2); s += __shfl_xor(s, 4);
        const float mean = ret ? s * (1.0f / 64) : 0.f; float q2 = 0.f;
#pragma unroll
        for (int j = 0; j < 8; ++j) { x[j] -= mean; q2 += x[j] * x[j]; }
        q2 += __shfl_xor(q2, 1); q2 += __shfl_xor(q2, 2); q2 += __shfl_xor(q2, 4);
        const float rs = rsqrtf(q2 * (1.0f / 64) + EPS);
#pragma unroll
        for (int j = 0; j < 8; ++j) x[j] = siluf_(g[j]) * x[j] * rs * gn[j];
        *(v4u*)(BR + (size_t)r * D + 256 + 8 * lane) = pack8(x);
    }
}

constexpr int NQB_ATT = (L + 127) / 128;
constexpr int IT_LA = 32, IT_SS = IT_LA + DB * 8, IT_AT = IT_SS + 16 * NQB_ATT, IT_LS = IT_AT + 32, IT_CV = IT_LS + (MR + 63) / 64, IT_END = IT_CV;
__device__ __forceinline__ void n2_phase(const Ctx& C, int l, float lam_init, int qslot) {
    THREAD_IDS();
    const float lam = lam_of(C, l, lam_init);
    float mb;
    { float mq = 0.f, mk = 0.f, mbias = 0.f;
#pragma unroll 1
      for (int i = 0; i < 32; ++i) { mq = fmaxf(mq, fabsf(C.in[I_QN][l * 32 + i])); mk = fmaxf(mk, fabsf(C.in[I_KN][l * 32 + i])); }
#pragma unroll 1
      for (int i = 0; i < 128; ++i) mbias = fmaxf(mbias, C.in[I_RELB][i] - C.in[I_RELB][31 * 4 + (i & 3)]);
      mb = 1.02f * 1.4426950408889634f * 5.656854249492381f * mq * mk + 1.4426950408889634f * mbias; }
    unsigned* qw = (unsigned*)(C.ws + WS_CTL) + CW_QUEUE + 64 * qslot;
    volatile LAS int* slot = (volatile LAS int*)(C.lds + MISC_OFF + 64);
    if (blockIdx.x < IT_LA) { const int it = blockIdx.x; const int b = (it >> 2) & 3, h = it & 3; if (it < 16) la_chunked<64, true>(C, l, false, b, h); else la_chunked<32, false>(C, l, false, b, h); }
#if defined(PROBE_ID)
    if (l == 0 && tid == 0) ((unsigned long long*)(C.ws + WS_CTL + 65536))[blockIdx.x * 16 + 3] = __builtin_amdgcn_s_memrealtime();
#endif
    for (;;) {
        if (tid == 0) slot[0] = (int)__hip_atomic_fetch_add(qw, 1u, __ATOMIC_RELAXED, __HIP_MEMORY_SCOPE_AGENT);
        __syncthreads();
        const int qi = slot[0];
        const int it = qi < 2 * DB * 8 ? ((qi & 1) ? IT_SS + (qi >> 1) : IT_LA + (qi >> 1)) : qi + IT_LA;
        __syncthreads();
        if (it >= IT_END) break;
        if (it < IT_SS) { const int i2 = it - IT_LA; attn_sample_item(C, l, i2 >> 3, i2 & 7); }
        else if (it < IT_AT) { const int i2 = it - IT_SS; attn_prompt_item(C, l, (i2 & 15) >> 2, i2 & 3, NQB_ATT - 1 - (i2 >> 4), lam, lam_init, mb); }
        else if (it < IT_LS) { const int i2 = (it - IT_AT) * 8 + wave; const int b = (i2 >> 2) & 31, h = i2 & 3; if (i2 < 128) la_seq<64, true>(C, l, true, b, h); else la_seq<32, false>(C, l, true, b, h); }
        else { conv_rows_item(C, l, it - IT_LS); conv_state_item(C, l, it - IT_LS, IT_CV - IT_LS); }
    }
}

#ifndef PROBE_ID
#define PROBE_ID 0
#endif
#define TSTAMP(k) do { if (PROBE_ID && l == 0 && threadIdx.x == 0) { ((unsigned long long*)(C.ws + WS_CTL + 65536))[blockIdx.x * 16 + (k)] = __builtin_amdgcn_s_memrealtime(); } } while (0)
template <int l> __device__ __forceinline__ void layer_fwd(const Ctx& C, const XcdBarrier& bar) {
#define GRID_BAR() xcd_barrier<false>(bar)
    LAS unsigned char* ring = C.lds + RING_OFF;
    float* SS = WSP(float, WS_SS); float* H = WSP(float, WS_H); bf16* HB = WSP(bf16, WS_HB); bf16* ACT = WSP(bf16, WS_ACT); bf16* ZMIX = WSP(bf16, WS_ZMIX); bf16* GATES = WSP(bf16, WS_GATES);
    bf16* BR = WSP(bf16, WS_BR); bf16* MERGED = WSP(bf16, WS_MERGED);
    constexpr float lam_init = l == 0 ? 0.2f : 0.35550906759096926f;
    constexpr bool last = (l == DEPTH - 1);
    TSTAMP(10);
    { pg8::Gemm g{HB, WSP(bf16, WS_W1 + (size_t)(l * 2 + 0) * SZ_W1), D, D, D}; pg8::StaticOrder S; S.init(M, 2 * DFF, C.G, (int)blockIdx.x);
      EpiGLU E{ACT, SS + (size_t)(l * 3 + 0) * M * 16}; pg8::gemm_phase<EpiGLU, pg8::StaticOrder, true, true>(ring, g, S, E); }
    GRID_BAR();
    { pg8::HeadOrder S; S.init(M, D, C.G, (int)blockIdx.x); S.limit = C.G; EpiRes<false, 1> E{H, HB, SS + (size_t)(l * 3 + 1) * M * 16, nullptr};
      { pg8::Gemm g{ACT, WSP(bf16, WS_WD + (size_t)(l * 2 + 0) * SZ_WD), DFF, DFF, DFF}; pg8::gemm_phase<EpiRes<false, 1>, pg8::HeadOrder, true, true>(ring, g, S, E); }
      { int kt = DFF / 11; asm volatile("" : "+s"(kt)); pg8::Gemm g{ACT, WSP(bf16, WS_WD + (size_t)(l * 2 + 0) * SZ_WD), DFF, DFF, kt}; pg8::TailOrder T; T.init(M, D, C.G, (int)blockIdx.x); T.limit = C.G; T.nsplit = 11; T.kper = DFF / 11;
        EpiPartial EP{WSP(float, WS_KSP)}; pg8::gemm_phase<EpiPartial, pg8::TailOrder, true, true>(ring, g, T, EP); }
      GRID_BAR();
      ksp_finalize<11>(WSP(float, WS_KSP), S, C.G, E); }
    GRID_BAR();
    { pg8::Gemm g{HB, WSP(bf16, WS_WIN + (size_t)l * SZ_WIN), D, D, D}; pg8::StaticOrder S; S.init(M, NINP, C.G, (int)blockIdx.x);
      EpiZ E{ZMIX, GATES, SS + (size_t)(l * 3 + 1) * M * 16, WSP(float, WS_BINP) + l * NINP}; pg8::gemm_phase<EpiZ, pg8::StaticOrder, true, true>(ring, g, S, E); }
    TSTAMP(15);
    GRID_BAR();
    TSTAMP(0);
    n1_prep(C, l);
    TSTAMP(1);
    GRID_BAR();
    TSTAMP(2);
    n2_phase(C, l, lam_init, l);
    TSTAMP(6);
    GRID_BAR();
    TSTAMP(7);
    n3_attn_sample_combine(C, l, lam_init);
    n3_la_finalize(C, l);
    TSTAMP(8);
    GRID_BAR();
    TSTAMP(9);
    { pg8::Gemm g{BR, WSP(bf16, WS_WBR + (size_t)l * SZ_WBR), D, D, D}; pg8::StaticOrder S; S.init(M, D, C.G, (int)blockIdx.x);
      EpiMergeR E{MERGED, GATES}; pg8::gemm_phase<EpiMergeR, pg8::StaticOrder, true, true, 4>(ring, g, S, E); }
    TSTAMP(11);
    GRID_BAR();
    TSTAMP(12);
    { pg8::Gemm g{MERGED, WSP(bf16, WS_WOUT + (size_t)l * SZ_WOUT), D, D, D}; pg8::StaticOrder S; S.init(M, D, C.G, (int)blockIdx.x);
      EpiRes<false, 2> E{H, HB, SS + (size_t)(l * 3 + 2) * M * 16, nullptr}; pg8::gemm_phase<EpiRes<false, 2>, pg8::StaticOrder, true, true>(ring, g, S, E); }
    TSTAMP(13);
    GRID_BAR();
    TSTAMP(14);
    { pg8::Gemm g{HB, WSP(bf16, WS_W1 + (size_t)(l * 2 + 1) * SZ_W1), D, D, D}; pg8::StaticOrder S; S.init(M, 2 * DFF, C.G, (int)blockIdx.x);
      EpiGLU E{ACT, SS + (size_t)(l * 3 + 2) * M * 16}; pg8::gemm_phase<EpiGLU, pg8::StaticOrder, true, true>(ring, g, S, E); }
    GRID_BAR();
    { pg8::HeadOrder S; S.init(M, D, C.G, (int)blockIdx.x); S.limit = C.G; EpiRes<last, 1> E{H, HB, last ? nullptr : SS + (size_t)((l + 1) * 3) * M * 16, C.out};
      { pg8::Gemm g{ACT, WSP(bf16, WS_WD + (size_t)(l * 2 + 1) * SZ_WD), DFF, DFF, DFF}; pg8::gemm_phase<EpiRes<last, 1>, pg8::HeadOrder, true, true>(ring, g, S, E); }
      { int kt = DFF / 11; asm volatile("" : "+s"(kt)); pg8::Gemm g{ACT, WSP(bf16, WS_WD + (size_t)(l * 2 + 1) * SZ_WD), DFF, DFF, kt}; pg8::TailOrder T; T.init(M, D, C.G, (int)blockIdx.x); T.limit = C.G; T.nsplit = 11; T.kper = DFF / 11;
        EpiPartial EP{WSP(float, WS_KSP)}; pg8::gemm_phase<EpiPartial, pg8::TailOrder, true, true>(ring, g, T, EP); }
      GRID_BAR();
      ksp_finalize<11>(WSP(float, WS_KSP), S, C.G, E); }
#undef GRID_BAR
}

__global__ void __launch_bounds__(NWAVES * 64, 2) fwd(Params P) {
    extern __shared__ __attribute__((aligned(16))) unsigned char lds[];
    Ctx C;
    C.in = P.in; C.out = P.out; C.ws = P.ws; C.lds = (LAS unsigned char*)lds;
    C.G = gridDim.x;
    volatile LAS unsigned* MISC = (volatile LAS unsigned*)(C.lds + MISC_OFF);
    for (int u = threadIdx.x; u < (LDS_BYTES - LDSCTL_OFF) / 4; u += NWAVES * 64) ((LAS unsigned*)(C.lds + LDSCTL_OFF))[u] = 0u;
    __syncthreads();
    unsigned* ctl = (unsigned*)(C.ws + WS_CTL);
    XcdBarrier bar = xcd_barrier_post(ctl + CW_BAR, MISC + 8);
    p0_prologue(C, P);
#if PROBE_ID == 700001
    p0_prologue(C, P);
#endif
    xcd_barrier<true>(bar);
    layer_fwd<0>(C, bar);
    xcd_barrier<false>(bar);
    layer_fwd<1>(C, bar);
#if PROBE_ID
    xcd_barrier<false>(bar);
    if (blockIdx.x == 0 && threadIdx.x == 0) { const unsigned long long* ts = (const unsigned long long*)(C.ws + WS_CTL + 65536);
        const int pb = PROBE_ID / 1000, k0 = (PROBE_ID / 10) % 100 % 10, k1 = PROBE_ID % 10;
        float val = (float)(ts[pb * 16 + k1] - ts[pb * 16 + k0]) * 0.001f;
        if (PROBE_ID >= 500000 && PROBE_ID < 600000) val = (float)(ts[PROBE_ID % 100] - ts[(PROBE_ID / 100) % 100]) * 0.001f;
        C.out[O_YP] = val; }
#endif
}

extern "C" void kernel_launch(void* const* d_in, const int* in_sizes, int n_in, void* d_out, int out_size, void* d_ws, size_t ws_size, hipStream_t stream) {
    static int grid = 0;
    if (grid == 0) {
        if (n_in != N_INPUTS || (size_t)out_size != O_END || ws_size < WS_END) { fprintf(stderr, "kernel_launch: unexpected shapes: n_in %d out %d (want %zu) ws %zu (want %zu)\n", n_in, out_size, (size_t)O_END, ws_size, (size_t)WS_END); grid = -1; return; }
        int dev = 0, cus = 0, per_cu = 0;
        if (hipGetDevice(&dev) != hipSuccess || hipDeviceGetAttribute(&cus, hipDeviceAttributeMultiprocessorCount, dev) != hipSuccess) { grid = -1; return; }
        if (hipFuncSetAttribute((const void*)fwd, hipFuncAttributeMaxDynamicSharedMemorySize, LDS_BYTES) != hipSuccess) { fprintf(stderr, "kernel_launch: hipFuncSetAttribute failed\n"); grid = -1; return; }
        if (hipOccupancyMaxActiveBlocksPerMultiprocessor(&per_cu, (const void*)fwd, NWAVES * 64, LDS_BYTES) != hipSuccess || per_cu < 1) { fprintf(stderr, "kernel_launch: occupancy query says %d blocks per CU\n", per_cu); }
        (void)hipGetLastError();
        grid = cus;
    }
    if (grid < 0) return;
    if (hipMemsetAsync((char*)d_ws + WS_CTL, 0, CTL_ZERO_BYTES, stream) != hipSuccess) return;
    Params p{};
    for (int i = 0; i < N_INPUTS; ++i) p.in[i] = (const float*)d_in[i];
    p.out = (float*)d_out; p.ws = (unsigned char*)d_ws;
    for (int i = 0; i < 32; ++i) p.inv_freq[i] = (float)pow(10000.0, -(double)i / 32.0);
    hipLaunchKernelGGL(fwd, dim3(grid), dim3(NWAVES * 64), LDS_BYTES, stream, p);
}
```

```cpp
#include <hip/hip_runtime.h>
#include <cstdio>
#include <cstdint>
#include <cmath>

namespace pg8 {
#define PG8_LAS __attribute__((address_space(3)))
typedef unsigned short bf16_t;
typedef short bf16x8 __attribute__((ext_vector_type(8)));
typedef float f32x4 __attribute__((ext_vector_type(4)));
typedef unsigned u32x4 __attribute__((ext_vector_type(4)));
constexpr int BM = 256, BK = 64, HALF = 128, HTB = HALF * BK * 2  , STAGE_BYTES = 8 * HTB, NXCD = 8, WGM = 8;

__host__ __device__ __forceinline__ int lds_byte(int r, int c) { const int st = (r >> 4) * 2 + (c >> 5), rr = r & 15, cc = c & 31, ob = rr * 64 + cc * 2; return st * 1024 + (ob ^ (((ob >> 9) & 1) << 5)); }
__host__ __device__ __forceinline__ void stage_rc(int b, int& R, int& C) { const int st = b / 1024, sb = b % 1024, swz = sb ^ (((sb >> 9) & 1) << 5); R = (st >> 1) * 16 + swz / 64; C = (st & 1) * 32 + (swz % 64) / 2; }
__host__ __device__ __forceinline__ int perm32(int rho) { const int n = rho >> 4, i = rho & 15; return 8 * (i >> 2) + 4 * n + (i & 3); }

struct Unit { int pm, pn, acol, bcol; };
struct Gemm { const bf16_t* A; const bf16_t* Bt; int lda, ldb, K; };

struct StaticOrder {
    int nM, nN, nwg, G, c;
    __host__ __device__ void init(int M, int N, int G_, int c_) { nM = M / BM; nN = N / BM; nwg = nM * nN; G = G_; c = c_; }
    __host__ __device__ void unit_of(int L, Unit& u) const {
        int wgid = L; { const int q = nwg / NXCD, r = nwg % NXCD, xcd = wgid % NXCD, off = wgid / NXCD; wgid = (xcd < r ? xcd * (q + 1) : r * (q + 1) + (xcd - r) * q) + off; }
        const int nig = WGM * nN, gid = wgid / nig, fm = gid * WGM, gsz = (nM - fm) < WGM ? (nM - fm) : WGM;
        u.pm = fm + ((wgid % nig) % gsz); u.pn = (wgid % nig) / gsz; u.acol = 0; u.bcol = 0;
    }
    __host__ __device__ bool next(int i, Unit& u) const { const long L = (long)i * G + c; if (L >= nwg) return false; unit_of((int)L, u); return true; }
};
struct HeadOrder : StaticOrder { int limit; __host__ __device__ bool next(int i, Unit& u) const { const long L = (long)i * G + c; if (L >= limit || L >= nwg) return false; unit_of((int)L, u); return true; } };
struct TailOrder : StaticOrder { int limit, nsplit, kper;
    __host__ __device__ bool next(int i, Unit& u) const {
        if (i > 0 || c >= (nwg - limit) * nsplit) return false;
        unit_of(limit + c / nsplit, u); u.acol = u.bcol = (c % nsplit) * kper; return true; } };
struct MergeOrder {
    int ntile, G, c;
    __host__ __device__ void init(int M, int G_, int c_) { ntile = (M / BM) * 4; G = G_; c = c_; }
    __host__ __device__ bool next(int i, Unit& u) const {
        const int T = (i >> 2) * G + c; if (T >= ntile) return false;
        const int n = i & 3; u.pm = T >> 2; u.pn = n * 4 + (T & 3); u.acol = n * 256; u.bcol = 0; return true;
    }
};

__device__ __forceinline__ unsigned cvt_pk_bf16(float lo, float hi) { unsigned r; asm volatile("v_cvt_pk_bf16_f32 %0, %1, %2" : "=v"(r) : "v"(lo), "v"(hi)); return r; }

template <class Epi, class Sched, bool ALIGN_EPI = false, bool SP2 = false, int SEG = 0>
__device__ __forceinline__ void gemm_phase(PG8_LAS unsigned char* lds, const Gemm g, const Sched& S, const Epi& E) {
    int tid_ = threadIdx.x; asm volatile("" : "+v"(tid_));
    const int tid = tid_, wid = __builtin_amdgcn_readfirstlane(tid >> 6), lane = tid & 63, wr = wid >> 2, wc = wid & 3, fr = lane & 15, fq = lane >> 4;
    const int nt = g.K / BK;
    unsigned voffA[2], voffB[2];
#pragma unroll
    for (int i = 0; i < 2; ++i) { int R, C; stage_rc(tid * 16 + i * 8192, R, C); const int Rb = Epi::PERM ? ((R & ~31) + perm32(R & 31)) : R;
        voffA[i] = (unsigned)(R * g.lda + C) * 2u; voffB[i] = (unsigned)(Rb * g.ldb + C) * 2u; }
    const size_t kstep = (size_t)(BK * 2);
    const size_t hstepA = (size_t)HALF * g.lda * 2, hstepB = (size_t)HALF * g.ldb * 2;
    const size_t tstepA = 2 * hstepA, tstepB = 2 * hstepB;
    const unsigned ldsw = (unsigned)wid * 1024u;
    const int aoff = lds_byte(wr * 64 + fr, fq * 8), boff = lds_byte(wc * 32 + fr, fq * 8);
#define PG8_SA(b, h) (((b) * 2 + (h)) * HTB)
#define PG8_SB(b, h) ((4 + (b) * 2 + (h)) * HTB)
#define PG8_STAGE(bufoff, gbase, voff) do { _Pragma("unroll") for (int _i = 0; _i < 2; ++_i) \
        __builtin_amdgcn_global_load_lds((const unsigned*)((const char*)(gbase) + (voff)[_i]), (PG8_LAS unsigned*)(lds + (bufoff) + ldsw + _i * 8192), 16, 0, 0); } while (0)
#define PG8_LDA(dst, b, h) do { _Pragma("unroll") for (int m = 0; m < 4; ++m) _Pragma("unroll") for (int k = 0; k < 2; ++k) dst[m][k] = *(const PG8_LAS bf16x8*)(lds + PG8_SA(b, h) + aoff + m * 2048 + k * 1024); } while (0)
#define PG8_LDB(dst, b, h) do { _Pragma("unroll") for (int n = 0; n < 2; ++n) _Pragma("unroll") for (int k = 0; k < 2; ++k) dst[n][k] = *(const PG8_LAS bf16x8*)(lds + PG8_SB(b, h) + boff + n * 2048 + k * 1024); } while (0)
#define PG8_MMA(ai, bj, At, Bt) do { __builtin_amdgcn_s_setprio(1); _Pragma("unroll") for (int m = 0; m < 4; ++m) _Pragma("unroll") for (int n = 0; n < 2; ++n) _Pragma("unroll") for (int k = 0; k < 2; ++k) \
        acc[ai][bj][m][n] = __builtin_amdgcn_mfma_f32_16x16x32_bf16(Bt[n][k], At[m][k], acc[ai][bj][m][n], 0, 0, 0); __builtin_amdgcn_s_setprio(0); } while (0)
#define PG8_WAIT_V(n) asm volatile("s_waitcnt vmcnt(" #n ")" ::: "memory")
#define PG8_WAIT_L(n) asm volatile("s_waitcnt lgkmcnt(" #n ")" ::: "memory")
#define PG8_BAR __builtin_amdgcn_s_barrier()
#define PG8_SCHED __builtin_amdgcn_sched_barrier(0)
    Unit cur, nxt; int ui = 0;
    if (!S.next(0, cur)) return;
    f32x4 acc[2][2][4][2];
#pragma unroll
    for (int a = 0; a < 2; ++a)
#pragma unroll
        for (int b = 0; b < 2; ++b)
#pragma unroll
            for (int m = 0; m < 4; ++m)
#pragma unroll
                for (int n = 0; n < 2; ++n) acc[a][b][m][n] = (f32x4){0.f, 0.f, 0.f, 0.f};
    bf16x8 At[4][2], B0[2][2], B1[2][2];
    const char* cA = (const char*)g.A + (size_t)cur.pm * tstepA + (size_t)cur.acol * 2; const char* cB = (const char*)g.Bt + (size_t)cur.pn * tstepB + (size_t)cur.bcol * 2;
    if constexpr (SP2) {
        PG8_STAGE(PG8_SB(0, 0), cB, voffB); PG8_STAGE(PG8_SB(0, 1), cB + hstepB, voffB); PG8_STAGE(PG8_SA(0, 0), cA, voffA); PG8_STAGE(PG8_SA(0, 1), cA + hstepA, voffA);
        if (wr == 1) PG8_BAR;
        PG8_WAIT_V(2); PG8_BAR;
        PG8_STAGE(PG8_SB(1, 0), cB + kstep, voffB); PG8_STAGE(PG8_SA(1, 0), cA + kstep, voffA); PG8_STAGE(PG8_SB(1, 1), cB + hstepB + kstep, voffB);
        PG8_WAIT_V(6); PG8_BAR;
    } else {
        PG8_STAGE(PG8_SB(0, 0), cB, voffB); PG8_STAGE(PG8_SA(0, 0), cA, voffA); PG8_STAGE(PG8_SB(0, 1), cB + hstepB, voffB); PG8_STAGE(PG8_SA(0, 1), cA + hstepA, voffA);
        if (wr == 1) PG8_BAR;
        PG8_WAIT_V(4); PG8_BAR;
        PG8_STAGE(PG8_SB(1, 0), cB + kstep, voffB); PG8_STAGE(PG8_SA(1, 0), cA + kstep, voffA); PG8_STAGE(PG8_SB(1, 1), cB + hstepB + kstep, voffB);
        PG8_WAIT_V(6); PG8_BAR;
    }
    for (;;) {
        const bool has_next = S.next(ui + 1, nxt);
        const char* nA = has_next ? (const char*)g.A + (size_t)nxt.pm * tstepA + (size_t)nxt.acol * 2 : cA; const char* nB = has_next ? (const char*)g.Bt + (size_t)nxt.pn * tstepB + (size_t)nxt.bcol * 2 : cB;
        for (int t = 0; t < nt; t += 2) {
            const bool last = (t == nt - 2);
            const char* a1 = cA + (size_t)(t + 1) * kstep;
            const char* a2 = last ? nA : cA + (size_t)(t + 2) * kstep; const char* b2 = last ? nB : cB + (size_t)(t + 2) * kstep;
            const char* a3 = a2 + kstep; const char* b3 = b2 + kstep;
            if constexpr (SP2) {
            PG8_LDB(B0, 0, 0); PG8_LDB(B1, 0, 1); PG8_SCHED; PG8_LDA(At, 0, 0); PG8_STAGE(PG8_SA(1, 1), a1 + hstepA, voffA);
            PG8_WAIT_V(8); PG8_WAIT_L(0); PG8_BAR; PG8_MMA(0, 0, At, B0); PG8_MMA(0, 1, At, B1); PG8_BAR; PG8_SCHED;
            PG8_LDA(At, 0, 1); PG8_STAGE(PG8_SB(0, 0), b2, voffB); PG8_STAGE(PG8_SB(0, 1), b2 + hstepB, voffB); PG8_STAGE(PG8_SA(0, 0), a2, voffA);
            PG8_WAIT_V(8); PG8_WAIT_L(0); PG8_BAR; PG8_MMA(1, 0, At, B0); PG8_MMA(1, 1, At, B1); PG8_BAR; PG8_SCHED;
            PG8_LDB(B0, 1, 0); PG8_LDB(B1, 1, 1); PG8_SCHED; PG8_LDA(At, 1, 0); PG8_STAGE(PG8_SA(0, 1), a2 + hstepA, voffA);
            PG8_WAIT_V(8); PG8_WAIT_L(0); PG8_BAR; PG8_MMA(0, 0, At, B0); PG8_MMA(0, 1, At, B1); PG8_BAR; PG8_SCHED;
            PG8_LDA(At, 1, 1); PG8_STAGE(PG8_SB(1, 0), b3, voffB); PG8_STAGE(PG8_SB(1, 1), b3 + hstepB, voffB); PG8_STAGE(PG8_SA(1, 0), a3, voffA);
            PG8_WAIT_V(8); PG8_WAIT_L(0); PG8_BAR; PG8_MMA(1, 0, At, B0); PG8_MMA(1, 1, At, B1); PG8_BAR; PG8_SCHED;
            } else {
            PG8_LDB(B0, 0, 0); PG8_SCHED; PG8_LDA(At, 0, 0); PG8_STAGE(PG8_SA(1, 1), a1 + hstepA, voffA);
            PG8_WAIT_L(8); PG8_BAR; PG8_WAIT_L(0); PG8_MMA(0, 0, At, B0); PG8_BAR; PG8_SCHED;
            PG8_LDB(B1, 0, 1); PG8_STAGE(PG8_SB(0, 0), b2, voffB);
            PG8_BAR; PG8_WAIT_L(0); PG8_MMA(0, 1, At, B1); PG8_BAR;
            PG8_LDA(At, 0, 1); PG8_STAGE(PG8_SA(0, 0), a2, voffA);
            PG8_BAR; PG8_WAIT_L(0); PG8_MMA(1, 0, At, B0); PG8_BAR; PG8_SCHED;
            PG8_STAGE(PG8_SB(0, 1), b2 + hstepB, voffB);
            PG8_WAIT_V(6); PG8_BAR; PG8_MMA(1, 1, At, B1); PG8_BAR;
            PG8_LDB(B0, 1, 0); PG8_SCHED; PG8_LDA(At, 1, 0); PG8_STAGE(PG8_SA(0, 1), a2 + hstepA, voffA);
            PG8_WAIT_L(8); PG8_BAR; PG8_WAIT_L(0); PG8_MMA(0, 0, At, B0); PG8_BAR; PG8_SCHED;
            PG8_LDB(B1, 1, 1); PG8_STAGE(PG8_SB(1, 0), b3, voffB);
            PG8_BAR; PG8_WAIT_L(0); PG8_MMA(0, 1, At, B1); PG8_BAR;
            PG8_LDA(At, 1, 1); PG8_STAGE(PG8_SA(1, 0), a3, voffA);
            PG8_BAR; PG8_WAIT_L(0); PG8_MMA(1, 0, At, B0); PG8_BAR; PG8_SCHED;
            PG8_STAGE(PG8_SB(1, 1), b3 + hstepB, voffB);
            PG8_WAIT_V(6); PG8_BAR; PG8_MMA(1, 1, At, B1); PG8_BAR;
            }
            if constexpr (SEG > 0) { if (((t + 2) % SEG) == 0 && (t + 2) < nt) E.mid(acc, cur, (t + 2) / SEG); }
        }
        if constexpr (ALIGN_EPI) { if (wr == 0) PG8_BAR; }
        E(acc, cur, wr, wc, fr, fq);
        if (!has_next) break;
#pragma unroll
        for (int a = 0; a < 2; ++a)
#pragma unroll
            for (int b = 0; b < 2; ++b)
#pragma unroll
                for (int m = 0; m < 4; ++m)
#pragma unroll
                    for (int n = 0; n < 2; ++n) acc[a][b][m][n] = (f32x4){0.f, 0.f, 0.f, 0.f};
        cur = nxt; cA = nA; cB = nB; ++ui;
        if constexpr (ALIGN_EPI) { if (wr == 1) PG8_BAR; }
    }
    PG8_WAIT_V(0);
    if constexpr (!ALIGN_EPI) { if (wr == 0) PG8_BAR; }
    PG8_BAR;
#undef PG8_SA
#undef PG8_SB
#undef PG8_STAGE
#undef PG8_LDA
#undef PG8_LDB
#undef PG8_MMA
#undef PG8_WAIT_V
#undef PG8_WAIT_L
#undef PG8_BAR
#undef PG8_SCHED
}
}

constexpr int NWAVES = 8;
constexpr int D = 1024, DFF = 2816, NIN = 7184, NMIX = 3088, NMIXP = 3328, NGATE = 4096, NINP = NMIXP + NGATE;
constexpr int SEQ = 4096, NMETA = 16, L = SEQ + NMETA, BATCH = 4, DB = 32, DS = 8, PAST = 8192, PAGE = 128, NPAGES = PAST / PAGE, NPOOL = 2560, DEPTH = 2;
constexpr int MP = BATCH * L, MS = DB * DS, MR = MP + MS, M = 16896;
constexpr int NPOS = L + DS;
constexpr float EPS = 1e-6f;
constexpr int C_A = 0, C_G = 256, R_Q = 512, R_K = 768, R_V = 1024, R_G = 1280, G_Q = 1536, G_K = 1664, G_V = 1792, G_R = 2048, G_LOW = 2304, D_Q = 2320, D_K = 2576, D_V = 2832;
constexpr size_t O_YP = 0, O_YS = O_YP + (size_t)BATCH * SEQ * D, O_KP = O_YS + (size_t)MS * D, O_VP = O_KP + (size_t)DEPTH * MP * 256, O_KS = O_VP + (size_t)DEPTH * MP * 256,
                 O_VS = O_KS + (size_t)DEPTH * MS * 256, O_RP = O_VS + (size_t)DEPTH * MS * 256, O_RS = O_RP + (size_t)DEPTH * BATCH * 4 * 64 * 64, O_GP = O_RS + (size_t)DEPTH * DB * 4 * 64 * 64,
                 O_GS = O_GP + (size_t)DEPTH * BATCH * 4 * 32 * 64, O_CP = O_GS + (size_t)DEPTH * DB * 4 * 32 * 64, O_CS = O_CP + (size_t)DEPTH * BATCH * 30 * 256, O_END = O_CS + (size_t)DEPTH * DB * 30 * 256;
enum { I_XP = 0, I_XS, I_CK, I_CV, I_PT, I_SRET, I_SGLA, I_SCONV, I_META, I_RELB, I_NF1, I_F1G, I_F1U, I_F1D, I_NMIX, I_WIN, I_BIN, I_CW, I_CB, I_CLG, I_CLB, I_RGN, I_GAW, I_GAB, I_GGN,
       I_QN, I_KN, I_LQ1, I_LK1, I_LQ2, I_LK2, I_SUBLN, I_WBR, I_WOUT, I_NF2, I_F2G, I_F2U, I_F2D, N_INPUTS };

constexpr size_t MiB = 1u << 20;
constexpr size_t WS_CTL = 0, CTL_ZERO_BYTES = 1 * MiB;
constexpr size_t SZ_SS = (size_t)M * 16 * 4;
constexpr size_t SZ_W1 = (size_t)2 * DFF * D * 2, SZ_WD = (size_t)D * DFF * 2, SZ_WIN = (size_t)NINP * D * 2, SZ_WBR = (size_t)4 * D * 256 * 2, SZ_WOUT = (size_t)D * D * 2;
constexpr size_t WS_W1 = 4 * MiB;
constexpr size_t WS_WD = WS_W1 + 4 * SZ_W1;
constexpr size_t WS_WIN = WS_WD + 4 * SZ_WD;
constexpr size_t WS_WBR = WS_WIN + 2 * SZ_WIN;
constexpr size_t WS_WOUT = WS_WBR + 2 * SZ_WBR;
constexpr size_t WS_BINP = WS_WOUT + 2 * SZ_WOUT;
constexpr size_t WS_ROPE = WS_BINP + 64 * 1024;
constexpr size_t WS_SS = WS_ROPE + 2 * MiB;
constexpr size_t WS_H = 128 * MiB;
constexpr size_t WS_HB = WS_H + (size_t)M * D * 4;
constexpr size_t WS_ACT = WS_HB + (size_t)M * D * 2;
constexpr size_t WS_ZMIX = WS_ACT + (size_t)M * DFF * 2;
constexpr size_t WS_GATES = WS_ZMIX + (size_t)M * NMIXP * 2;
constexpr size_t WS_BR = WS_GATES + (size_t)M * NGATE * 2;
constexpr size_t WS_MERGED = WS_BR + (size_t)M * D * 2;
constexpr size_t WS_UBUF = WS_MERGED + (size_t)M * D * 2;
constexpr size_t WS_RQ = WS_UBUF + (size_t)M * 256 * 4, WS_RK = WS_RQ + (size_t)M * 256 * 4, WS_QN = WS_RK + (size_t)M * 256 * 4, WS_KN = WS_QN + (size_t)M * 256 * 4, WS_VB = WS_KN + (size_t)M * 256 * 4;
constexpr size_t WS_LDEC = WS_VB + (size_t)M * 256 * 4;
constexpr size_t WS_QNB = WS_LDEC + (size_t)M * 128 * 4;
constexpr size_t WS_KNB = WS_QNB + (size_t)M * 256 * 2;
constexpr size_t WS_PART = WS_KNB + (size_t)M * 256 * 2;
constexpr size_t WS_LAO = WS_PART + (size_t)DB * 4 * 16 * 16 * 68 * 4;
constexpr size_t WS_KSP = WS_LAO + (size_t)M * 512 * 4;
constexpr size_t WS_END = WS_KSP + (size_t)8 * 11 * 65536 * 4;
static_assert(WS_ROPE + 2 * NPOS * 32 * 4 <= WS_SS && WS_SS + 6 * SZ_SS <= WS_H, "weights region overflows");
constexpr int CW_BAR = 4096, CW_QUEUE = 8192;

constexpr int RING_OFF = 0, RING_BYTES = 131072;
constexpr int LDSCTL_OFF = 144384, MISC_OFF = LDSCTL_OFF + 320;
constexpr int LDS_BYTES = 147456;
static_assert(MISC_OFF + 128 <= LDS_BYTES, "LDS map");

#define GAS __attribute__((address_space(1)))
#define LAS __attribute__((address_space(3)))
typedef unsigned short bf16;
typedef unsigned v4u __attribute__((ext_vector_type(4)));
typedef float f32x4 __attribute__((ext_vector_type(4)));
#define LDS_WAIT() asm volatile("s_waitcnt lgkmcnt(0)" ::: "memory")
#define VM_WAIT() asm volatile("s_waitcnt vmcnt(0)" ::: "memory")
__device__ __forceinline__ unsigned f2bf(float f) { unsigned u = __builtin_bit_cast(unsigned, f); return (u + 0x7fffu + ((u >> 16) & 1u)) >> 16; }
__device__ __forceinline__ unsigned pk2(float lo, float hi) { return f2bf(lo) | (f2bf(hi) << 16); }
__device__ __forceinline__ float bf2f(bf16 b) { return __builtin_bit_cast(float, ((unsigned)b) << 16); }
__device__ __forceinline__ float bflo(unsigned w) { return __builtin_bit_cast(float, w << 16); }
__device__ __forceinline__ float bfhi(unsigned w) { return __builtin_bit_cast(float, w & 0xffff0000u); }
__device__ __forceinline__ float wave_sum(float v) {
#pragma unroll
    for (int o = 1; o < 64; o <<= 1) v += __shfl_xor(v, o);
    return v;
}
__device__ __forceinline__ float sigmoidf_(float x) { return __builtin_amdgcn_rcpf(1.0f + __expf(-x)); }
__device__ __forceinline__ float siluf_(float x) { return x * __builtin_amdgcn_rcpf(1.0f + __expf(-x)); }

#define XB_TMO      128
#define XB_XCNT(j)  (256  + 64 * (j))
#define XB_XSUB(j)  (1280 + 64 * (j))
#define XB_XGEN(j)  (2304 + 64 * (j))
#define XB_TOP      3328
#define XB_TOPGEN   3392
#define XCD_BAR_WORDS 3456
#define XB_SPIN_CAP (1u << 22)

__device__ __forceinline__ unsigned xb_ld(unsigned* p)              { return __hip_atomic_load(p, __ATOMIC_RELAXED, __HIP_MEMORY_SCOPE_AGENT); }
__device__ __forceinline__ unsigned xb_add(unsigned* p, unsigned v) { return __hip_atomic_fetch_add(p, v, __ATOMIC_RELAXED, __HIP_MEMORY_SCOPE_AGENT); }
__device__ __forceinline__ unsigned xb_xcc_id() { return (unsigned)__builtin_amdgcn_s_getreg((3 << 11) | 20) & 0xFu; }
#define XB_SPIN(cond, bar) do { unsigned _sp = 0; while (cond) { __builtin_amdgcn_s_sleep(1); \
    if ((++_sp & 255u) == 0u) { if (xb_ld(&(bar)[XB_TMO])) break; if (_sp > XB_SPIN_CAP) { atomicAdd(&(bar)[XB_TMO], 1u); break; } } } } while (0)

struct XcdBarrier { unsigned* bar; unsigned x; volatile LAS unsigned* st; };

__device__ __forceinline__ XcdBarrier xcd_barrier_post(unsigned* bar, volatile LAS unsigned* st) {
    XcdBarrier b; b.bar = bar; b.x = xb_xcc_id(); b.st = st;
    if (threadIdx.x == 0) (void)xb_add(&bar[XB_XCNT(b.x)], 1u);
    return b;
}
__device__ __forceinline__ void xcd_barrier_complete(unsigned* bar, unsigned x, unsigned& nloc, unsigned& nx) {
    const unsigned G = gridDim.x * gridDim.y * gridDim.z;
    unsigned sum, cnt, mine, sp = 0u;
    for (;;) {
        sum = 0u; cnt = 0u; mine = 0u;
#pragma unroll
        for (unsigned j = 0; j < 16; ++j) { const unsigned c = xb_ld(&bar[XB_XCNT(j)]); sum += c; cnt += (c > 0u) ? 1u : 0u; mine = (j == x) ? c : mine; }
        if (sum == G) break;
        __builtin_amdgcn_s_sleep(1);
        if ((++sp & 255u) == 0u) { if (xb_ld(&bar[XB_TMO])) break; if (sp > XB_SPIN_CAP) { atomicAdd(&bar[XB_TMO], 1u); break; } }
    }
    nloc = mine > 0u ? mine : 1u; nx = cnt > 0u ? cnt : 1u;
}
template <bool FIRST> __device__ __forceinline__ void xcd_barrier(const XcdBarrier& b) {
    asm volatile("s_waitcnt vmcnt(0)" ::: "memory");
    __syncthreads();
    if (threadIdx.x == 0) {
        unsigned* bar = b.bar;
        asm volatile("" : "+s"(bar));
        __builtin_amdgcn_s_waitcnt(0);
        unsigned nloc = b.st[0], nx = b.st[1];
        if (FIRST) { if (nloc == 0u) { xcd_barrier_complete(bar, b.x, nloc, nx); b.st[0] = nloc; b.st[1] = nx; } }
        const unsigned old = xb_add(&bar[XB_XSUB(b.x)], 1u);
        const unsigned gen = old / nloc;
        if (old + 1u == (gen + 1u) * nloc) {
            __builtin_amdgcn_fence(__ATOMIC_RELEASE, "agent");
            asm volatile("s_waitcnt vmcnt(0)" ::: "memory");
            const unsigned og = xb_add(&bar[XB_TOP], 1u);
            const unsigned tg = og / nx;
            if (og + 1u == (tg + 1u) * nx) xb_add(&bar[XB_TOPGEN], 1u);
            else XB_SPIN(xb_ld(&bar[XB_TOPGEN]) == tg, bar);
            __builtin_amdgcn_fence(__ATOMIC_ACQUIRE, "agent");
            xb_add(&bar[XB_XGEN(b.x)], 1u);
            asm volatile("s_waitcnt vmcnt(0)" ::: "memory");
        } else {
            XB_SPIN(xb_ld(&bar[XB_XGEN(b.x)]) == gen, bar);
            __builtin_amdgcn_fence(__ATOMIC_ACQUIRE, "agent");
            asm volatile("s_waitcnt vmcnt(0)" ::: "memory");
        }
    }
    __syncthreads();
}

struct Params { const float* in[N_INPUTS]; float* out; unsigned char* ws; float inv_freq[32]; };
static_assert(sizeof(Params) == N_INPUTS * 8 + 16 + 128, "Params has no padding");

struct Ctx {
    const float* const* in; float* out; unsigned char* ws;
    LAS unsigned char* lds;
    int G;
};
#define THREAD_IDS() int tid_ = threadIdx.x; asm volatile("" : "+v"(tid_)); const int tid = tid_, lane = tid & 63, wave = __builtin_amdgcn_readfirstlane(tid >> 6), gw = blockIdx.x * NWAVES + wave, NGW = C.G * NWAVES; (void)tid; (void)lane; (void)wave; (void)gw; (void)NGW
#define WSP(T, off) ((T*)(C.ws + (off)))

__device__ __forceinline__ float rstd_of(const float* ssp, int row) {
    const f32x4 a = *(const f32x4*)(ssp + (size_t)row * 16), b = *(const f32x4*)(ssp + (size_t)row * 16 + 4), c = *(const f32x4*)(ssp + (size_t)row * 16 + 8), d = *(const f32x4*)(ssp + (size_t)row * 16 + 12);
    const float s = (((a[0] + a[1]) + (a[2] + a[3])) + ((b[0] + b[1]) + (b[2] + b[3]))) + (((c[0] + c[1]) + (c[2] + c[3])) + ((d[0] + d[1]) + (d[2] + d[3])));
    return rsqrtf(s * (1.0f / D) + EPS);
}
#define EPI_IDS() int t_ = threadIdx.x; asm volatile("" : "+v"(t_)); const int wid_ = __builtin_amdgcn_readfirstlane(t_ >> 6), wr = wid_ >> 2, wc = wid_ & 3, fr = t_ & 15, fq = (t_ & 63) >> 4
struct EpiGLU {
    static constexpr bool PERM = true;
    bf16* act; const float* ss;
    __device__ __forceinline__ void operator()(const pg8::f32x4 (&acc)[2][2][4][2], const pg8::Unit& u, int, int, int, int) const {
        EPI_IDS();
        const int row0 = u.pm * 256 + wr * 64 + fr, col0 = u.pn * 128 + wc * 32 + 8 * fq;
#pragma unroll
        for (int ai = 0; ai < 2; ++ai)
#pragma unroll
            for (int m = 0; m < 4; ++m) {
                const int row = row0 + ai * 128 + m * 16; const float rstd = rstd_of(ss, row);
                float o[8];
#pragma unroll
                for (int n = 0; n < 2; ++n)
#pragma unroll
                    for (int j = 0; j < 4; ++j) { const float g = acc[ai][0][m][n][j] * rstd, up = acc[ai][1][m][n][j] * rstd; o[n * 4 + j] = siluf_(g) * up; }
                v4u w; w.x = pg8::cvt_pk_bf16(o[0], o[1]); w.y = pg8::cvt_pk_bf16(o[2], o[3]); w.z = pg8::cvt_pk_bf16(o[4], o[5]); w.w = pg8::cvt_pk_bf16(o[6], o[7]);
                *(v4u*)(act + (size_t)row * DFF + col0) = w;
            }
    }
};
template <bool FINAL, int SCALE2> struct EpiRes {
    static constexpr bool PERM = true;
    float* h; bf16* hb; float* ssout; float* out;
    __device__ __forceinline__ void rowgroup(const pg8::f32x4 (&a)[2][2], int row, int col0, int pn, int wc, int fq) const {
        constexpr float scale = 0.5f * SCALE2; float sq = 0.f;
        long yoff = -1;
        if (FINAL) { if (row < MP) { const int b = row / L, pos = row - b * L; if (pos >= NMETA) yoff = (long)O_YP + ((long)b * SEQ + (pos - NMETA)) * D; } else if (row < MR) yoff = (long)O_YS + (long)(row - MP) * D; }
#pragma unroll
        for (int bj = 0; bj < 2; ++bj) {
            const size_t off = (size_t)row * D + col0 + bj * 128;
            f32x4 h0 = *(const f32x4*)(h + off), h1 = *(const f32x4*)(h + off + 4);
            h0 = h0 + a[bj][0] * scale; h1 = h1 + a[bj][1] * scale;
            *(f32x4*)(h + off) = h0; *(f32x4*)(h + off + 4) = h1;
            v4u w; w.x = pg8::cvt_pk_bf16(h0[0], h0[1]); w.y = pg8::cvt_pk_bf16(h0[2], h0[3]); w.z = pg8::cvt_pk_bf16(h1[0], h1[1]); w.w = pg8::cvt_pk_bf16(h1[2], h1[3]);
            *(v4u*)(hb + off) = w;
            sq += (h0[0] * h0[0] + h0[1] * h0[1]) + (h0[2] * h0[2] + h0[3] * h0[3]) + (h1[0] * h1[0] + h1[1] * h1[1]) + (h1[2] * h1[2] + h1[3] * h1[3]);
            if (FINAL && yoff >= 0) { *(f32x4*)(out + yoff + col0 + bj * 128) = h0; *(f32x4*)(out + yoff + col0 + bj * 128 + 4) = h1; }
        }
        sq += __shfl_xor(sq, 16); sq += __shfl_xor(sq, 32);
        if (fq == 0 && ssout) ssout[(size_t)row * 16 + pn * 4 + wc] = sq;
    }
    __device__ __forceinline__ void operator()(const pg8::f32x4 (&acc)[2][2][4][2], const pg8::Unit& u, int, int, int, int) const {
        EPI_IDS();
        const int row0 = u.pm * 256 + wr * 64 + fr, col0 = u.pn * 256 + wc * 32 + 8 * fq;
#pragma unroll
        for (int ai = 0; ai < 2; ++ai)
#pragma unroll
            for (int m = 0; m < 4; ++m) {
                const pg8::f32x4 a[2][2] = {{acc[ai][0][m][0], acc[ai][0][m][1]}, {acc[ai][1][m][0], acc[ai][1][m][1]}};
                rowgroup(a, row0 + ai * 128 + m * 16, col0, u.pn, wc, fq);
                if (m == 3) asm volatile("" ::: "memory");
            }
    }
};
struct EpiZ {
    static constexpr bool PERM = true;
    bf16* zmix; bf16* gates; const float* ss; const float* bias;
    __device__ __forceinline__ void operator()(const pg8::f32x4 (&acc)[2][2][4][2], const pg8::Unit& u, int, int, int, int) const {
        EPI_IDS();
        const int row0 = u.pm * 256 + wr * 64 + fr, col0 = u.pn * 256 + wc * 32 + 8 * fq; const bool isgate = u.pn >= NMIXP / 256;
        f32x4 bv[2][2];
#pragma unroll
        for (int bj = 0; bj < 2; ++bj)
#pragma unroll
            for (int n = 0; n < 2; ++n) bv[bj][n] = *(const f32x4*)(bias + col0 + bj * 128 + 4 * n);
#pragma unroll
        for (int ai = 0; ai < 2; ++ai)
#pragma unroll
            for (int m = 0; m < 4; ++m) {
                const int row = row0 + ai * 128 + m * 16; const float rstd = rstd_of(ss, row);
#pragma unroll
                for (int bj = 0; bj < 2; ++bj) {
                    f32x4 v0 = acc[ai][bj][m][0] * rstd + bv[bj][0], v1 = acc[ai][bj][m][1] * rstd + bv[bj][1];
                    if (isgate) {
#pragma unroll
                        for (int j = 0; j < 4; ++j) { v0[j] = fmaxf(sigmoidf_(v0[j]), 9.094947017729282e-13f); v1[j] = fmaxf(sigmoidf_(v1[j]), 9.094947017729282e-13f); } }
                    v4u w; w.x = pg8::cvt_pk_bf16(v0[0], v0[1]); w.y = pg8::cvt_pk_bf16(v0[2], v0[3]); w.z = pg8::cvt_pk_bf16(v1[0], v1[1]); w.w = pg8::cvt_pk_bf16(v1[2], v1[3]);
                    if (isgate) *(v4u*)(gates + (size_t)row * NGATE + (col0 - NMIXP) + bj * 128) = w;
                    else *(v4u*)(zmix + (size_t)row * NMIXP + col0 + bj * 128) = w;
                }
            }
    }
};
struct EpiMerge {
    static constexpr bool PERM = true;
    bf16* merged; const bf16* gates;
    __device__ __forceinline__ void operator()(const pg8::f32x4 (&acc)[2][2][4][2], const pg8::Unit& u, int, int, int, int) const {
        EPI_IDS();
        const int n = u.pn >> 2, dt = u.pn & 3;
        const int row0 = u.pm * 256 + wr * 64 + fr, col0 = dt * 256 + wc * 32 + 8 * fq;
#pragma unroll
        for (int ai = 0; ai < 2; ++ai)
#pragma unroll
            for (int m = 0; m < 4; ++m) {
                const int row = row0 + ai * 128 + m * 16;
#pragma unroll
                for (int bj = 0; bj < 2; ++bj) {
                    const v4u gw = *(const v4u*)(gates + (size_t)row * NGATE + n * D + col0 + bj * 128);
                    bf16* mp = merged + (size_t)row * D + col0 + bj * 128;
                    float o[8];
                    o[0] = acc[ai][bj][m][0][0] * bflo(gw.x); o[1] = acc[ai][bj][m][0][1] * bfhi(gw.x); o[2] = acc[ai][bj][m][0][2] * bflo(gw.y); o[3] = acc[ai][bj][m][0][3] * bfhi(gw.y);
                    o[4] = acc[ai][bj][m][1][0] * bflo(gw.z); o[5] = acc[ai][bj][m][1][1] * bfhi(gw.z); o[6] = acc[ai][bj][m][1][2] * bflo(gw.w); o[7] = acc[ai][bj][m][1][3] * bfhi(gw.w);
                    if (n > 0) { const v4u pw = *(const v4u*)mp;
                        o[0] += bflo(pw.x); o[1] += bfhi(pw.x); o[2] += bflo(pw.y); o[3] += bfhi(pw.y); o[4] += bflo(pw.z); o[5] += bfhi(pw.z); o[6] += bflo(pw.w); o[7] += bfhi(pw.w); }
                    v4u w; w.x = pg8::cvt_pk_bf16(o[0], o[1]); w.y = pg8::cvt_pk_bf16(o[2], o[3]); w.z = pg8::cvt_pk_bf16(o[4], o[5]); w.w = pg8::cvt_pk_bf16(o[6], o[7]);
                    *(v4u*)mp = w;
                }
                if (m == 3) asm volatile("" ::: "memory");
            }
    }
};

struct EpiPartial {
    static constexpr bool PERM = true;
    float* part;
    __device__ __forceinline__ void operator()(const pg8::f32x4 (&acc)[2][2][4][2], const pg8::Unit& u, int, int, int, int) const {
        int t_ = threadIdx.x; asm volatile("" : "+v"(t_));
        const int slot = blockIdx.x;
        float* p = part + (size_t)slot * 65536 + (size_t)t_ * 4;
#pragma unroll
        for (int ai = 0; ai < 2; ++ai)
#pragma unroll
            for (int bj = 0; bj < 2; ++bj)
#pragma unroll
                for (int m = 0; m < 4; ++m)
#pragma unroll
                    for (int n = 0; n < 2; ++n) *(pg8::f32x4*)(p + (size_t)((((ai * 2 + bj) * 4 + m) * 2 + n) * 2048)) = acc[ai][bj][m][n];
        (void)u;
    }
};
template <int NSPLIT, class Epi> __device__ __forceinline__ void ksp_finalize(const float* part, const pg8::StaticOrder& so, int limit, const Epi& E) {
    const int ntail = so.nwg - limit;
    for (int it = blockIdx.x; it < ntail * 8; it += gridDim.x) {
        const int tt = it >> 3, ai = (it >> 2) & 1, m = it & 3;
        EPI_IDS();
        pg8::f32x4 a[2][2];
#pragma unroll
        for (int bj = 0; bj < 2; ++bj)
#pragma unroll
            for (int n = 0; n < 2; ++n) { pg8::f32x4 s = {0.f, 0.f, 0.f, 0.f};
#pragma unroll
                for (int k = 0; k < NSPLIT; ++k) s = s + *(const pg8::f32x4*)(part + (size_t)(tt * NSPLIT + k) * 65536 + (size_t)((((ai * 2 + bj) * 4 + m) * 2 + n) * 2048) + (size_t)t_ * 4);
                a[bj][n] = s; }
        pg8::Unit u; so.unit_of(limit + tt, u);
        E.rowgroup(a, u.pm * 256 + wr * 64 + fr + ai * 128 + m * 16, u.pn * 256 + wc * 32 + 8 * fq, u.pn, wc, fq);
    }
}

struct EpiMergeR {
    static constexpr bool PERM = true;
    bf16* merged; const bf16* gates;
    __device__ __forceinline__ void mid(pg8::f32x4 (&acc)[2][2][4][2], const pg8::Unit& u, int seg) const {
        EPI_IDS();
        const int row0 = u.pm * 256 + wr * 64 + fr, col0 = u.pn * 256 + wc * 32 + 8 * fq;
#pragma unroll
        for (int ai = 0; ai < 2; ++ai) {
#pragma unroll
            for (int m = 0; m < 4; ++m) {
                const int row = row0 + ai * 128 + m * 16;
#pragma unroll
                for (int bj = 0; bj < 2; ++bj) {
                    const bf16* gp = gates + (size_t)row * NGATE + (seg - 1) * D + col0 + bj * 128;
                    const v4u ga = *(const v4u*)gp, gb = *(const v4u*)(gp + D);
                    pg8::f32x4& a0 = acc[ai][bj][m][0]; pg8::f32x4& a1 = acc[ai][bj][m][1];
                    a0[0] *= bflo(ga.x) * __builtin_amdgcn_rcpf(bflo(gb.x)); a0[1] *= bfhi(ga.x) * __builtin_amdgcn_rcpf(bfhi(gb.x)); a0[2] *= bflo(ga.y) * __builtin_amdgcn_rcpf(bflo(gb.y)); a0[3] *= bfhi(ga.y) * __builtin_amdgcn_rcpf(bfhi(gb.y));
                    a1[0] *= bflo(ga.z) * __builtin_amdgcn_rcpf(bflo(gb.z)); a1[1] *= bfhi(ga.z) * __builtin_amdgcn_rcpf(bfhi(gb.z)); a1[2] *= bflo(ga.w) * __builtin_amdgcn_rcpf(bflo(gb.w)); a1[3] *= bfhi(ga.w) * __builtin_amdgcn_rcpf(bfhi(gb.w));
                }
            }
            asm volatile("" ::: "memory");
        }
    }
    __device__ __forceinline__ void operator()(const pg8::f32x4 (&acc)[2][2][4][2], const pg8::Unit& u, int, int, int, int) const {
        EPI_IDS();
        const int row0 = u.pm * 256 + wr * 64 + fr, col0 = u.pn * 256 + wc * 32 + 8 * fq;
#pragma unroll
        for (int ai = 0; ai < 2; ++ai)
#pragma unroll
            for (int m = 0; m < 4; ++m) {
                const int row = row0 + ai * 128 + m * 16;
#pragma unroll
                for (int bj = 0; bj < 2; ++bj) {
                    const v4u g = *(const v4u*)(gates + (size_t)row * NGATE + 3 * D + col0 + bj * 128);
                    const pg8::f32x4 a0 = acc[ai][bj][m][0], a1 = acc[ai][bj][m][1];
                    v4u w; w.x = pg8::cvt_pk_bf16(a0[0] * bflo(g.x), a0[1] * bfhi(g.x)); w.y = pg8::cvt_pk_bf16(a0[2] * bflo(g.y), a0[3] * bfhi(g.y));
                    w.z = pg8::cvt_pk_bf16(a1[0] * bflo(g.z), a1[1] * bfhi(g.z)); w.w = pg8::cvt_pk_bf16(a1[2] * bflo(g.w), a1[3] * bfhi(g.w));
                    *(v4u*)(merged + (size_t)row * D + col0 + bj * 128) = w;
                }
            }
    }
};

struct RowMap { int mode, a; __device__ __forceinline__ int operator()(int n) const { return mode == 0 ? n + a : (mode == 1 ? 256 * (n >> 7) + (n & 127) + a : (n < NMIX ? n : n + (NMIXP - NMIX))); } };
__device__ __forceinline__ void tr_item(const float* W, int K, int N, const float* gain, bf16* WT, int pitch, RowMap rm, LAS float* scr, int kb, int nb, int lane) {
    const int k0 = 64 * kb, n0 = 64 * nb; const int nn = n0 + 4 * (lane & 15), kr = lane >> 4;
    f32x4 v[16];
#pragma unroll
    for (int i = 0; i < 16; ++i) v[i] = (nn < N) ? *(const f32x4*)(W + (size_t)(k0 + 4 * i + kr) * N + nn) : (f32x4){0.f, 0.f, 0.f, 0.f};
#pragma unroll
    for (int i = 0; i < 16; ++i) { const int kk = 4 * i + kr; const float g = gain ? gain[k0 + kk] : 1.0f; LAS float* d = scr + kk * 65 + 4 * (lane & 15); d[0] = v[i][0] * g; d[1] = v[i][1] * g; d[2] = v[i][2] * g; d[3] = v[i][3] * g; }
    LDS_WAIT(); asm volatile("" ::: "memory");
    const int c = lane & 7;
#pragma unroll
    for (int j = 0; j < 8; ++j) { const int nl = (lane >> 3) + 8 * j; const int n = n0 + nl; const LAS float* s = scr + (8 * c) * 65 + nl;
        v4u o; o.x = pg8::cvt_pk_bf16(s[0 * 65], s[1 * 65]); o.y = pg8::cvt_pk_bf16(s[2 * 65], s[3 * 65]); o.z = pg8::cvt_pk_bf16(s[4 * 65], s[5 * 65]); o.w = pg8::cvt_pk_bf16(s[6 * 65], s[7 * 65]);
        if (n < N) *(v4u*)(WT + (size_t)rm(n) * pitch + k0 + 8 * c) = o; }
    LDS_WAIT(); asm volatile("" ::: "memory");
}
__device__ __forceinline__ void p0_prologue(const Ctx& C, const Params& P) {
    THREAD_IDS();
    LAS float* scr = (LAS float*)(C.lds + RING_OFF + wave * 16896);
    constexpr int I_FF = 16 * 44, I_DN = 44 * 16, I_IN = 16 * 113, I_BR = 4 * 4 * 16, I_OUT = 16 * 16;
    constexpr int PER_LAYER = 4 * I_FF + 2 * I_DN + I_IN + I_BR + I_OUT;
    for (int it = gw; it < DEPTH * PER_LAYER; it += NGW) {
        const int l = it / PER_LAYER; int r = it - l * PER_LAYER;
        bf16* W1a = WSP(bf16, WS_W1 + (size_t)(l * 2 + 0) * SZ_W1); bf16* W1b = WSP(bf16, WS_W1 + (size_t)(l * 2 + 1) * SZ_W1);
        bf16* Wda = WSP(bf16, WS_WD + (size_t)(l * 2 + 0) * SZ_WD); bf16* Wdb = WSP(bf16, WS_WD + (size_t)(l * 2 + 1) * SZ_WD);
        if (r < I_FF) { tr_item(C.in[I_F1G] + (size_t)l * D * DFF, D, DFF, C.in[I_NF1] + l * D, W1a, D, RowMap{1, 0}, scr, r / 44, r % 44, lane); continue; } r -= I_FF;
        if (r < I_FF) { tr_item(C.in[I_F1U] + (size_t)l * D * DFF, D, DFF, C.in[I_NF1] + l * D, W1a, D, RowMap{1, 128}, scr, r / 44, r % 44, lane); continue; } r -= I_FF;
        if (r < I_DN) { tr_item(C.in[I_F1D] + (size_t)l * D * DFF, DFF, D, nullptr, Wda, DFF, RowMap{0, 0}, scr, r / 16, r % 16, lane); continue; } r -= I_DN;
        if (r < I_FF) { tr_item(C.in[I_F2G] + (size_t)l * D * DFF, D, DFF, C.in[I_NF2] + l * D, W1b, D, RowMap{1, 0}, scr, r / 44, r % 44, lane); continue; } r -= I_FF;
        if (r < I_FF) { tr_item(C.in[I_F2U] + (size_t)l * D * DFF, D, DFF, C.in[I_NF2] + l * D, W1b, D, RowMap{1, 128}, scr, r / 44, r % 44, lane); continue; } r -= I_FF;
        if (r < I_DN) { tr_item(C.in[I_F2D] + (size_t)l * D * DFF, DFF, D, nullptr, Wdb, DFF, RowMap{0, 0}, scr, r / 16, r % 16, lane); continue; } r -= I_DN;
        if (r < I_IN) { tr_item(C.in[I_WIN] + (size_t)l * D * NIN, D, NIN, C.in[I_NMIX] + l * D, WSP(bf16, WS_WIN + (size_t)l * SZ_WIN), D, RowMap{2, 0}, scr, r / 113, r % 113, lane); continue; } r -= I_IN;
        if (r < I_BR) { const int n4 = r / 64, rr = r % 64; tr_item(C.in[I_WBR] + (size_t)(l * 4 + n4) * 256 * D, 256, D, nullptr, WSP(bf16, WS_WBR + (size_t)l * SZ_WBR) + n4 * 256, D, RowMap{0, 0}, scr, rr / 16, rr % 16, lane); continue; } r -= I_BR;
        tr_item(C.in[I_WOUT] + (size_t)l * D * D, D, D, nullptr, WSP(bf16, WS_WOUT + (size_t)l * SZ_WOUT), D, RowMap{0, 0}, scr, r / 16, r % 16, lane);
    }
    const int gt = gw * 64 + lane, NGT = NGW * 64;
    for (int i = gt; i < 2 * 240 * 128; i += NGT) { const int l = i / (240 * 128), r = i % (240 * 128); *(v4u*)(C.ws + WS_WIN + (size_t)l * SZ_WIN + ((size_t)NMIX * D) * 2 + (size_t)r * 16) = (v4u){0u, 0u, 0u, 0u}; }
    for (int i = gt; i < (M - MR) * 128; i += NGT) *(v4u*)(C.ws + WS_BR + (size_t)MR * D * 2 + (size_t)i * 16) = (v4u){0u, 0u, 0u, 0u};
    for (int i = gt; i < 2 * NINP; i += NGT) { const int l = i / NINP, j = i % NINP; float v = 0.f; if (j < NMIX) v = C.in[I_BIN][l * NIN + j]; else if (j >= NMIXP) v = C.in[I_BIN][l * NIN + NMIX + (j - NMIXP)]; WSP(float, WS_BINP)[i] = v; }
    for (int i = gt; i < NPOS * 32; i += NGT) { const int pi = i >> 5, fi = i & 31; const int pos = pi < L ? pi : PAST + (pi - L);
        const float angf = (float)pos * P.inv_freq[fi];
        const double a = (double)angf; const double k = rint(a * 0.15915494309189535); const double rr = (a - k * 6.283185307179586) - k * 2.4492935982947064e-16;
        const float rf = (float)rr; WSP(float, WS_ROPE)[i] = cosf(rf); WSP(float, WS_ROPE)[NPOS * 32 + i] = sinf(rf); }
    float* H = WSP(float, WS_H); bf16* HB = WSP(bf16, WS_HB); float* SS0 = WSP(float, WS_SS);
    for (int row = gw; row < M; row += NGW) {
        const float* src = nullptr;
        if (row < MP) { const int b = row / L, pos = row - b * L; src = pos < NMETA ? C.in[I_META] + (size_t)pos * D : C.in[I_XP] + ((size_t)b * SEQ + (pos - NMETA)) * D; }
        else if (row < MR) src = C.in[I_XS] + (size_t)(row - MP) * D;
        float s = 0.f;
#pragma unroll
        for (int j = 0; j < 4; ++j) { f32x4 v = src ? *(const f32x4*)(src + 256 * j + 4 * lane) : (f32x4){0.f, 0.f, 0.f, 0.f};
            *(f32x4*)(H + (size_t)row * D + 256 * j + 4 * lane) = v; s += (v[0] * v[0] + v[1] * v[1]) + (v[2] * v[2] + v[3] * v[3]);
            unsigned long long w = (unsigned long long)pk2(v[0], v[1]) | ((unsigned long long)pk2(v[2], v[3]) << 32);
            *(unsigned long long*)(HB + (size_t)row * D + 256 * j + 4 * lane) = w; }
        s = wave_sum(s); if (lane < 16) SS0[(size_t)row * 16 + lane] = lane == 0 ? s : 0.f;
    }
}

__device__ __forceinline__ float lam_of(const Ctx& C, int l, float lam_init) {
    THREAD_IDS();
    float a = 0.f, b = 0.f;
#pragma unroll 1
    for (int i = 0; i < 32; ++i) { a += C.in[I_LQ1][l * 32 + i] * C.in[I_LK1][l * 32 + i]; b += C.in[I_LQ2][l * 32 + i] * C.in[I_LK2][l * 32 + i]; }
    return __expf(a) - __expf(b) + lam_init;
}
__device__ __forceinline__ int t5_bucket(int n) {
    if (n < 16) return n;
    return 16 + (n >= 19) + (n >= 21) + (n >= 24) + (n >= 27) + (n >= 31) + (n >= 35) + (n >= 40) + (n >= 46) + (n >= 52) + (n >= 59) + (n >= 67) + (n >= 77) + (n >= 87) + (n >= 99) + (n >= 113);
}
__device__ __forceinline__ void unpack8(const v4u w, float (&x)[8]) { x[0] = bflo(w.x); x[1] = bfhi(w.x); x[2] = bflo(w.y); x[3] = bfhi(w.y); x[4] = bflo(w.z); x[5] = bfhi(w.z); x[6] = bflo(w.w); x[7] = bfhi(w.w); }
__device__ __forceinline__ v4u pack8(const float (&x)[8]) { v4u w; w.x = pg8::cvt_pk_bf16(x[0], x[1]); w.y = pg8::cvt_pk_bf16(x[2], x[3]); w.z = pg8::cvt_pk_bf16(x[4], x[5]); w.w = pg8::cvt_pk_bf16(x[6], x[7]); return w; }
__device__ __forceinline__ void n1_prep(const Ctx& C, int l) {
    THREAD_IDS();
    const bf16* ZM = WSP(bf16, WS_ZMIX); float* UB = WSP(float, WS_UBUF); float* RQ = WSP(float, WS_RQ); float* RK = WSP(float, WS_RK);
    float* LD = WSP(float, WS_LDEC); const float* COS = WSP(float, WS_ROPE); const float* SIN = COS + NPOS * 32; bf16* QNB = WSP(bf16, WS_QNB); bf16* KNB = WSP(bf16, WS_KNB);
    const int i = lane & 31;
    float qg[8], kg[8];
#pragma unroll
    for (int j = 0; j < 8; ++j) { qg[j] = C.in[I_QN][l * 32 + ((8 * i) & 31) + j] * (0.17677669529663687f * 1.4426950408889634f); kg[j] = C.in[I_KN][l * 32 + ((8 * i) & 31) + j]; }
    for (int rp = gw; rp < MR / 2; rp += NGW) {
        const int r = 2 * rp + (lane >> 5);
        const bf16* z = ZM + (size_t)r * NMIXP;
        const int pi = r < MP ? r % L : L + ((r - MP) & 7);
        float* kout = r < MP ? C.out + O_KP + ((size_t)l * MP + r) * 256 : C.out + O_KS + ((size_t)l * MS + (r - MP)) * 256;
        float* vout = r < MP ? C.out + O_VP + ((size_t)l * MP + r) * 256 : C.out + O_VS + ((size_t)l * MS + (r - MP)) * 256;
        const v4u wa = *(const v4u*)(z + C_A + 8 * i), wg = *(const v4u*)(z + C_G + 8 * i), wq = *(const v4u*)(z + D_Q + 8 * i), wk = *(const v4u*)(z + D_K + 8 * i), wv = *(const v4u*)(z + D_V + 8 * i);
        const int isk = i >> 4, hh = (i >> 2) & 3, jc = i & 3;
        const bf16* zr = z + (isk ? R_K : R_Q) + hh * 64 + 8 * jc;
        const v4u w1 = *(const v4u*)zr, w2 = *(const v4u*)(zr + 32);
        const v4u gl0 = *(const v4u*)(z + G_LOW), gl1 = *(const v4u*)(z + G_LOW + 8);
        float x[8], y[8];
        unpack8(wa, x); unpack8(wg, y);
#pragma unroll
        for (int j = 0; j < 8; ++j) x[j] *= sigmoidf_(y[j]);
        *(f32x4*)(UB + (size_t)r * 256 + 8 * i) = (f32x4){x[0], x[1], x[2], x[3]}; *(f32x4*)(UB + (size_t)r * 256 + 8 * i + 4) = (f32x4){x[4], x[5], x[6], x[7]};
        unpack8(wv, x);
        *(f32x4*)(vout + 8 * i) = (f32x4){x[0], x[1], x[2], x[3]}; *(f32x4*)(vout + 8 * i + 4) = (f32x4){x[4], x[5], x[6], x[7]};
        unpack8(wq, x);
        { float s = 0.f;
#pragma unroll
          for (int j = 0; j < 8; ++j) s += x[j] * x[j];
          s += __shfl_xor(s, 1); s += __shfl_xor(s, 2); const float rs = rsqrtf(s * (1.0f / 32) + EPS);
#pragma unroll
          for (int j = 0; j < 8; ++j) x[j] = x[j] * rs * qg[j];
          *(v4u*)(QNB + (size_t)r * 256 + 8 * i) = pack8(x); }
        unpack8(wk, x);
        { float s = 0.f;
#pragma unroll
          for (int j = 0; j < 8; ++j) s += x[j] * x[j];
          s += __shfl_xor(s, 1); s += __shfl_xor(s, 2); const float rs = rsqrtf(s * (1.0f / 32) + EPS);
#pragma unroll
          for (int j = 0; j < 8; ++j) x[j] = x[j] * rs * kg[j];
          *(v4u*)(KNB + (size_t)r * 256 + 8 * i) = pack8(x);
          *(f32x4*)(kout + 8 * i) = (f32x4){x[0], x[1], x[2], x[3]}; *(f32x4*)(kout + 8 * i + 4) = (f32x4){x[4], x[5], x[6], x[7]}; }
        unpack8(w1, x); unpack8(w2, y);
        { const f32x4 c0 = *(const f32x4*)(COS + pi * 32 + 8 * jc), c1 = *(const f32x4*)(COS + pi * 32 + 8 * jc + 4), s0 = *(const f32x4*)(SIN + pi * 32 + 8 * jc), s1 = *(const f32x4*)(SIN + pi * 32 + 8 * jc + 4);
          const float sc = isk ? 0.125f : 1.0f; float o1[8], o2[8];
#pragma unroll
          for (int j = 0; j < 8; ++j) { const float cs = j < 4 ? c0[j & 3] : c1[j & 3], sn = j < 4 ? s0[j & 3] : s1[j & 3]; o1[j] = (x[j] * cs - y[j] * sn) * sc; o2[j] = (x[j] * sn + y[j] * cs) * sc; }
          float* ro = (isk ? RK : RQ) + (size_t)r * 256 + hh * 64 + 8 * jc;
          *(f32x4*)ro = (f32x4){o1[0], o1[1], o1[2], o1[3]}; *(f32x4*)(ro + 4) = (f32x4){o1[4], o1[5], o1[6], o1[7]}; *(f32x4*)(ro + 32) = (f32x4){o2[0], o2[1], o2[2], o2[3]}; *(f32x4*)(ro + 36) = (f32x4){o2[4], o2[5], o2[6], o2[7]}; }
        { float gv[16]; unpack8(gl0, x); unpack8(gl1, y);
#pragma unroll
          for (int j = 0; j < 8; ++j) { gv[j] = x[j]; gv[8 + j] = y[j]; }
          f32x4 gp = *(const f32x4*)(C.in[I_GAB] + l * 128 + 4 * i);
#pragma unroll
          for (int k = 0; k < 16; ++k) { const f32x4 aw = *(const f32x4*)(C.in[I_GAW] + (size_t)(l * 16 + k) * 128 + 4 * i); gp = gp + aw * gv[k]; }
          f32x4 ls;
#pragma unroll
          for (int j = 0; j < 4; ++j) ls[j] = (fminf(gp[j], 0.f) - log1pf(__expf(-fabsf(gp[j])))) * (1.0f / 16.0f);
          *(f32x4*)(LD + (size_t)r * 128 + 4 * i) = ls; }
    }
}
__device__ __forceinline__ void conv_rows_item(const Ctx& C, int l, int item) {
    THREAD_IDS();
    const float* UB = WSP(float, WS_UBUF); bf16* BR = WSP(bf16, WS_BR);
    const float* cw = C.in[I_CW] + (size_t)l * 31 * 256; const float* sc = C.in[I_SCONV];
    LAS float* wl = (LAS float*)C.lds;
    for (int i = tid; i < 31 * 256; i += NWAVES * 64) wl[i] = cw[i];
    LDS_WAIT(); __builtin_amdgcn_s_barrier(); asm volatile("" ::: "memory");
    const int r0 = item * 64 + wave * 8;
    if (r0 < MR) {
        const bool smp = r0 >= MP; const int b = smp ? (r0 - MP) >> 3 : r0 / L; const int p0 = smp ? 0 : r0 - b * L; const int rb = smp ? MP + b * 8 : b * L;
        float acc[8][4];
#pragma unroll
        for (int i = 0; i < 8; ++i)
#pragma unroll
            for (int k = 0; k < 4; ++k) acc[i][k] = C.in[I_CB][l * 256 + lane + 64 * k];
#pragma unroll 1
        for (int jb = 0; jb < 40; jb += 8) {
            float uv[8][4];
#pragma unroll
            for (int jj = 0; jj < 8; ++jj) { const int j = jb + jj; const int q = p0 - 30 + j;
#pragma unroll
                for (int k = 0; k < 4; ++k) { const int c = lane + 64 * k;
                    uv[jj][k] = j >= 38 ? 0.f : (q >= 0 ? UB[(size_t)(rb + q) * 256 + c] : (smp ? sc[(((size_t)l * DB + b) * 30 + (q + 30)) * 256 + c] : 0.f)); } }
#pragma unroll
            for (int jj = 0; jj < 8; ++jj)
#pragma unroll
                for (int i = 0; i < 8; ++i) { const int t = jb + jj - i;
                    if (t >= 0 && t <= 30) {
#pragma unroll
                        for (int k = 0; k < 4; ++k) acc[i][k] += wl[t * 256 + lane + 64 * k] * uv[jj][k]; } }
        }
#pragma unroll
        for (int i = 0; i < 8; ++i) { const int r = r0 + i;
            float s = (acc[i][0] + acc[i][1]) + (acc[i][2] + acc[i][3]); const float mean = wave_sum(s) * (1.0f / 256);
            float q2 = 0.f;
#pragma unroll
            for (int k = 0; k < 4; ++k) { acc[i][k] -= mean; q2 += acc[i][k] * acc[i][k]; }
            const float rstd = rsqrtf(wave_sum(q2) * (1.0f / 256) + EPS);
#pragma unroll
            for (int k = 0; k < 4; ++k) { const int c = lane + 64 * k; const float y = acc[i][k] * rstd * C.in[I_CLG][l * 256 + c] + C.in[I_CLB][l * 256 + c]; BR[(size_t)r * D + c] = (bf16)f2bf(siluf_(y)); } }
    }
    LDS_WAIT(); __builtin_amdgcn_s_barrier(); asm volatile("" ::: "memory");
}
__device__ __forceinline__ void conv_state_item(const Ctx& C, int l, int part, int nparts) {
    THREAD_IDS();
    const float* UB = WSP(float, WS_UBUF); const float* sc = C.in[I_SCONV];
    for (int i = part * NWAVES * 64 + tid; i < BATCH * 30 * 256; i += nparts * NWAVES * 64) { const int c = i & 255, ii = (i >> 8) % 30, b = i / (30 * 256); C.out[O_CP + (size_t)l * BATCH * 30 * 256 + i] = UB[(size_t)(b * L + L - 30 + ii) * 256 + c]; }
    for (int i = part * NWAVES * 64 + tid; i < DB * 30 * 256; i += nparts * NWAVES * 64) { const int c = i & 255, ii = (i >> 8) % 30, b = i / (30 * 256);
        C.out[O_CS + (size_t)l * DB * 30 * 256 + i] = ii < 22 ? sc[(((size_t)l * DB + b) * 30 + 8 + ii) * 256 + c] : UB[(size_t)(MP + b * 8 + ii - 22) * 256 + c]; }
}
template <int DK, bool RET> __device__ __forceinline__ void la_seq(const Ctx& C, int l, bool smp, int b, int h) {
    THREAD_IDS();
    const bf16* ZM = WSP(bf16, WS_ZMIX); const float* RQ = WSP(float, WS_RQ); const float* RK = WSP(float, WS_RK); const float* LD = WSP(float, WS_LDEC); bf16* BR = WSP(bf16, WS_BR);
    const int nt = smp ? DS : L; const int row0 = smp ? MP + b * DS : b * L;
    float S[DK];
    if (smp) { const float* s0 = (RET ? C.in[I_SRET] : C.in[I_SGLA]) + (((size_t)l * DB + b) * 4 + h) * DK * 64;
#pragma unroll
        for (int k = 0; k < DK; ++k) S[k] = s0[k * 64 + lane]; }
    else {
#pragma unroll
        for (int k = 0; k < DK; ++k) S[k] = 0.f; }
    const float gamma = 1.0f - exp2f(-5.0f - (float)h);
    const float gn = RET ? C.in[I_RGN][(l * 4 + h) * 64 + lane] : C.in[I_GGN][(l * 4 + h) * 64 + lane];
    for (int t = 0; t < nt; ++t) {
        const int r = row0 + t; const bf16* z = ZM + (size_t)r * NMIXP;
        float ql, kl, dl = 1.f;
        if (RET) { ql = RQ[(size_t)r * 256 + h * 64 + lane]; kl = RK[(size_t)r * 256 + h * 64 + lane]; }
        else { const int lk = lane & 31; ql = bf2f(z[G_Q + h * 32 + lk]) * 0.17677669529663687f; kl = bf2f(z[G_K + h * 32 + lk]); dl = __expf(LD[(size_t)r * 128 + h * 32 + lk]); }
        const float v = bf2f(z[(RET ? R_V : G_V) + h * 64 + lane]);
        float o = 0.f;
#pragma unroll
        for (int k = 0; k < DK; ++k) { const float qk = __shfl(ql, k), kk = __shfl(kl, k); const float dk = RET ? gamma : __shfl(dl, k);
            S[k] = dk * S[k] + kk * v; o += qk * S[k]; if ((k & 7) == 7) __builtin_amdgcn_sched_barrier(0); }
        float y;
        if (RET) { const float mean = wave_sum(o) * (1.0f / 64); const float d = o - mean; const float var = wave_sum(d * d) * (1.0f / 64); y = d * rsqrtf(var + EPS) * gn; }
        else { const float ms = wave_sum(o * o) * (1.0f / 64); y = o * rsqrtf(ms + EPS) * gn; }
        const float g = bf2f(z[(RET ? R_G : G_R) + h * 64 + lane]);
        BR[(size_t)r * D + (RET ? 256 : 512) + h * 64 + lane] = (bf16)f2bf(siluf_(g) * y);
    }
    float* so = C.out + (RET ? (smp ? O_RS + (((size_t)l * DB + b) * 4 + h) * DK * 64 : O_RP + (((size_t)l * BATCH + b) * 4 + h) * DK * 64)
                             : (smp ? O_GS + (((size_t)l * DB + b) * 4 + h) * DK * 64 : O_GP + (((size_t)l * BATCH + b) * 4 + h) * DK * 64));
#pragma unroll
    for (int k = 0; k < DK; ++k) so[k * 64 + lane] = S[k];
}
__device__ __forceinline__ void n2_la(const Ctx& C, int l) {
    THREAD_IDS();
    if ((gw & 63) == 0 && (gw >> 6) < 32) { const int it = gw >> 6; const int b = (it >> 2) & 3, h = it & 3;
        if (it < 16) la_seq<64, true>(C, l, false, b, h); else la_seq<32, false>(C, l, false, b, h); }
    for (int it = gw; it < 256; it += NGW) { const int typ = it >> 7, b = (it >> 2) & 31, h = it & 3;
        if (typ == 0) la_seq<64, true>(C, l, true, b, h); else la_seq<32, false>(C, l, true, b, h); }
}
__device__ __forceinline__ void n2_attn_prompt(const Ctx& C, int l, float lam_init) {
    THREAD_IDS();
    const float* QN = WSP(float, WS_QN); const float* KN = WSP(float, WS_KN); const float* VB = WSP(float, WS_VB); bf16* BR = WSP(bf16, WS_BR);
    const float lam = lam_of(C, l, lam_init);
    LAS float* park = (LAS float*)(C.lds) + wave * (64 * 65);
    constexpr int NQG = (L + 63) / 64;
    for (int it = gw; it < BATCH * 4 * NQG; it += NGW) {
        const int qg = NQG - 1 - it / 16, bh = it % 16, b = bh >> 2, h = bh & 3;
        const int qpos = min(qg * 64 + lane, L - 1); const bool valid = (qg * 64 + lane) < L; const int qrow = b * L + qpos;
        const int nkeys = min(qg * 64 + 64, L);
        float bias_near[1]; (void)bias_near;
        for (int s = 0; s < 2; ++s) {
            float q[32];
#pragma unroll
            for (int i = 0; i < 32; i += 4) { const f32x4 t = *(const f32x4*)(QN + (size_t)qrow * 256 + h * 64 + s * 32 + i); q[i] = t[0] * 0.17677669529663687f; q[i + 1] = t[1] * 0.17677669529663687f; q[i + 2] = t[2] * 0.17677669529663687f; q[i + 3] = t[3] * 0.17677669529663687f; }
            float m = -INFINITY, lsum = 0.f; float acc[64];
#pragma unroll
            for (int i = 0; i < 64; ++i) acc[i] = 0.f;
            for (int j = 0; j < nkeys; ++j) {
                const float* kp = KN + (size_t)(b * L + j) * 256 + h * 64 + s * 32; const float* vp = VB + (size_t)(b * L + j) * 256 + h * 64;
                float sc = 0.f;
#pragma unroll
                for (int i = 0; i < 32; i += 4) { const f32x4 kv = *(const f32x4*)(kp + i); sc += q[i] * kv[0] + q[i + 1] * kv[1] + q[i + 2] * kv[2] + q[i + 3] * kv[3]; }
                const int n = qpos - j;
                sc += C.in[I_RELB][t5_bucket(n < 0 ? 0 : n) * 4 + h];
                if (n < 0) sc = -INFINITY;
                const float mn = fmaxf(m, sc); const float corr = __expf(m - mn); const float p = __expf(sc - mn);
                m = mn; lsum = lsum * corr + p;
#pragma unroll
                for (int i = 0; i < 64; i += 4) { const f32x4 vv = *(const f32x4*)(vp + i); acc[i] = acc[i] * corr + p * vv[0]; acc[i + 1] = acc[i + 1] * corr + p * vv[1]; acc[i + 2] = acc[i + 2] * corr + p * vv[2]; acc[i + 3] = acc[i + 3] * corr + p * vv[3]; }
            }
            const float inv = 1.0f / lsum;
            if (s == 0) {
#pragma unroll
                for (int i = 0; i < 64; ++i) park[lane * 65 + i] = acc[i] * inv;
                LDS_WAIT();
            } else {
                float ms = 0.f;
#pragma unroll
                for (int i = 0; i < 64; ++i) { acc[i] = park[lane * 65 + i] - lam * (acc[i] * inv); ms += acc[i] * acc[i]; }
                const float rn = rsqrtf(ms * (1.0f / 64) + EPS) * (1.0f - lam_init);
                if (valid) {
#pragma unroll
                    for (int i = 0; i < 64; i += 2) { const unsigned w = pk2(acc[i] * rn * C.in[I_SUBLN][l * 64 + i], acc[i + 1] * rn * C.in[I_SUBLN][l * 64 + i + 1]); *(unsigned*)(BR + (size_t)qrow * D + 768 + h * 64 + i) = w; } }
                LDS_WAIT();
            }
        }
    }
}
__device__ __forceinline__ void n2_attn_sample(const Ctx& C, int l, float lam_init) {
    THREAD_IDS();
    const float* QN = WSP(float, WS_QN); const float* KN = WSP(float, WS_KN); const float* VB = WSP(float, WS_VB); bf16* BR = WSP(bf16, WS_BR);
    const int* PT = (const int*)C.in[I_PT]; const float* CK = C.in[I_CK] + (size_t)l * NPOOL * PAGE * 256; const float* CV = C.in[I_CV] + (size_t)l * NPOOL * PAGE * 256;
    const float lam = lam_of(C, l, lam_init);
    LAS float* part = (LAS float*)C.lds;
    for (int b = blockIdx.x; b < DB; b += C.G) {
        const int row = tid & 63, split = tid >> 6, h = row >> 4, s = (row >> 3) & 1, t = row & 7;
        float q[32];
#pragma unroll
        for (int i = 0; i < 32; ++i) q[i] = QN[(size_t)(MP + b * 8 + t) * 256 + h * 64 + s * 32 + i] * 0.17677669529663687f;
        float m = -INFINITY, lsum = 0.f; float acc[64];
#pragma unroll
        for (int i = 0; i < 64; ++i) acc[i] = 0.f;
        for (int j = split; j < PAST + DS; j += 8) {
            const float* kp; const float* vp; bool vis = true;
            if (j < PAST) { const int page = PT[b * NPAGES + (j >> 7)]; const size_t base = (((size_t)page * PAGE + (j & 127)) * 4 + h) * 64; kp = CK + base + s * 32; vp = CV + base; }
            else { const int jj = j - PAST; const size_t r2 = (size_t)(MP + b * 8 + jj); kp = KN + r2 * 256 + h * 64 + s * 32; vp = VB + r2 * 256 + h * 64; vis = jj <= t; }
            float sc = 0.f;
#pragma unroll
            for (int i = 0; i < 32; i += 4) { const f32x4 kv = *(const f32x4*)(kp + i); sc += q[i] * kv[0] + q[i + 1] * kv[1] + q[i + 2] * kv[2] + q[i + 3] * kv[3]; }
            const int n = PAST + t - j;
            sc += C.in[I_RELB][t5_bucket(n < 0 ? 0 : n) * 4 + h];
            if (!vis) sc = -INFINITY;
            const float mn = fmaxf(m, sc); const float corr = __expf(m - mn); const float p = __expf(sc - mn);
            m = mn; lsum = lsum * corr + p;
#pragma unroll
            for (int i = 0; i < 64; i += 4) { const f32x4 vv = *(const f32x4*)(vp + i); acc[i] = acc[i] * corr + p * vv[0]; acc[i + 1] = acc[i + 1] * corr + p * vv[1]; acc[i + 2] = acc[i + 2] * corr + p * vv[2]; acc[i + 3] = acc[i + 3] * corr + p * vv[3]; }
        }
        LAS float* pr = part + (split * 64 + row) * 66;
        pr[64] = m; pr[65] = lsum;
#pragma unroll
        for (int i = 0; i < 64; ++i) pr[i] = acc[i];
        __syncthreads();
        for (int k = 0; k < 4; ++k) { const int p = wave * 4 + k, h2 = p >> 3, t2 = p & 7; float os[2];
#pragma unroll
            for (int s2 = 0; s2 < 2; ++s2) { const int rw = h2 * 16 + s2 * 8 + t2; float mm = -INFINITY;
                for (int sp = 0; sp < 8; ++sp) mm = fmaxf(mm, part[(sp * 64 + rw) * 66 + 64]);
                float ll = 0.f, oo = 0.f;
                for (int sp = 0; sp < 8; ++sp) { const float w = __expf(part[(sp * 64 + rw) * 66 + 64] - mm); ll += part[(sp * 64 + rw) * 66 + 65] * w; oo += part[(sp * 64 + rw) * 66 + lane] * w; }
                os[s2] = oo / ll; }
            const float o = os[0] - lam * os[1]; const float ms = wave_sum(o * o) * (1.0f / 64);
            const float y = o * rsqrtf(ms + EPS) * C.in[I_SUBLN][l * 64 + lane] * (1.0f - lam_init);
            BR[(size_t)(MP + b * 8 + t2) * D + 768 + h2 * 64 + lane] = (bf16)f2bf(y); }
        __syncthreads();
    }
}
typedef short bf16x8_t __attribute__((ext_vector_type(8)));
template <int DK, bool RET> __device__ __forceinline__ void la_chunked(const Ctx& C, int l, bool smp, int b, int h) {
    THREAD_IDS();
    constexpr int QS = DK + 8, TS = 72, NKB = DK / 16, NKS = DK / 32;
    constexpr int SB = 2 * 64 * QS + 64 * TS + DK * TS + 64 * TS + 64;
    LAS bf16* SB0 = (LAS bf16*)(C.lds);
    LAS bf16* AL = SB0 + 2 * SB;
    LAS bf16* ST = AL + 64 * TS;
    const bf16* ZM = WSP(bf16, WS_ZMIX); const float* RQ = WSP(float, WS_RQ); const float* RK = WSP(float, WS_RK); const float* LD = WSP(float, WS_LDEC); bf16* BR = WSP(bf16, WS_BR);
    const int nt = smp ? DS : L, row0 = smp ? MP + b * DS : b * L, nch = (nt + 63) >> 6;
    const float lg2 = RET ? log2f(1.0f - exp2f(-5.0f - (float)h)) : 0.f;
    const int g4 = lane >> 4, c16 = lane & 15;
    const bool qwave = wave < 4; const int w4 = wave & 3;
    float Sreg[NKB][4];
    if (wave >= 4) {
        const float* s0 = (RET ? C.in[I_SRET] : C.in[I_SGLA]) + (((size_t)l * DB + b) * 4 + h) * DK * 64;
#pragma unroll
        for (int cb = 0; cb < NKB; ++cb)
#pragma unroll
            for (int r = 0; r < 4; ++r) { const int dk = cb * 16 + c16, dv = (wave - 4) * 16 + 4 * g4 + r; const float v = smp ? s0[dk * 64 + dv] : 0.f; Sreg[cb][r] = v; ST[dv * QS + dk] = (bf16)f2bf(v); }
    }
    float gnv[4];
#pragma unroll
    for (int cb = 0; cb < 4; ++cb) gnv[cb] = (RET ? C.in[I_RGN] : C.in[I_GGN])[(l * 4 + h) * 64 + cb * 16 + c16];
    float a[16]; v4u vr;
#define LA_LOAD(c) do { const size_t r_ = (size_t)(row0 + (c) * 64 + lane); const bf16* z_ = ZM + r_ * NMIXP; \
        vr = *(const v4u*)(z_ + (RET ? R_V : G_V) + h * 64 + 8 * wave); \
        if (RET) { const float* p_ = (qwave ? RQ : RK) + r_ * 256 + h * 64 + 8 * w4; const f32x4 x0 = *(const f32x4*)p_, x1 = *(const f32x4*)(p_ + 4), x2 = *(const f32x4*)(p_ + 32), x3 = *(const f32x4*)(p_ + 36); \
            a[0] = x0[0]; a[1] = x0[1]; a[2] = x0[2]; a[3] = x0[3]; a[4] = x1[0]; a[5] = x1[1]; a[6] = x1[2]; a[7] = x1[3]; a[8] = x2[0]; a[9] = x2[1]; a[10] = x2[2]; a[11] = x2[3]; a[12] = x3[0]; a[13] = x3[1]; a[14] = x3[2]; a[15] = x3[3]; } \
        else { const v4u q_ = *(const v4u*)(z_ + (qwave ? G_Q : G_K) + h * 32 + 8 * w4); const float* p_ = LD + r_ * 128 + h * 32 + 8 * w4; const f32x4 x0 = *(const f32x4*)p_, x1 = *(const f32x4*)(p_ + 4); \
            a[0] = bflo(q_.x); a[1] = bfhi(q_.x); a[2] = bflo(q_.y); a[3] = bfhi(q_.y); a[4] = bflo(q_.z); a[5] = bfhi(q_.z); a[6] = bflo(q_.w); a[7] = bfhi(q_.w); \
            a[8] = x0[0]; a[9] = x0[1]; a[10] = x0[2]; a[11] = x0[3]; a[12] = x1[0]; a[13] = x1[1]; a[14] = x1[2]; a[15] = x1[3]; } } while (0)
    LA_LOAD(0);
    int cur = 0;
    for (int i = 0; i <= nch; ++i) {
        if (i < nch) {
            const int c = i; LAS bf16* QT = SB0 + (i & 1) * SB; LAS bf16* KT = QT + 64 * QS; LAS bf16* VT = KT + 64 * QS; LAS bf16* KE = VT + 64 * TS; LAS bf16* GT = KE + DK * TS; LAS float* WT = (LAS float*)(GT + 64 * TS);
            const int nvc = min(64, nt - c * 64); const bool valid = lane < nvc;
        if (RET) {
            const float tq = (float)(lane + 1);
            if (qwave) { const float e = valid ? __builtin_amdgcn_exp2f(lg2 * tq) : 0.f;
                v4u w0, w1; w0.x = pg8::cvt_pk_bf16(a[0] * e, a[1] * e); w0.y = pg8::cvt_pk_bf16(a[2] * e, a[3] * e); w0.z = pg8::cvt_pk_bf16(a[4] * e, a[5] * e); w0.w = pg8::cvt_pk_bf16(a[6] * e, a[7] * e);
                w1.x = pg8::cvt_pk_bf16(a[8] * e, a[9] * e); w1.y = pg8::cvt_pk_bf16(a[10] * e, a[11] * e); w1.z = pg8::cvt_pk_bf16(a[12] * e, a[13] * e); w1.w = pg8::cvt_pk_bf16(a[14] * e, a[15] * e);
                *(LAS v4u*)(QT + lane * QS + 8 * w4) = w0; *(LAS v4u*)(QT + lane * QS + 32 + 8 * w4) = w1; }
            else { const float e = valid ? __builtin_amdgcn_exp2f(-lg2 * tq) : 0.f, ee = valid ? __builtin_amdgcn_exp2f(lg2 * ((float)nvc - tq)) : 0.f;
                v4u w0, w1; w0.x = pg8::cvt_pk_bf16(a[0] * e, a[1] * e); w0.y = pg8::cvt_pk_bf16(a[2] * e, a[3] * e); w0.z = pg8::cvt_pk_bf16(a[4] * e, a[5] * e); w0.w = pg8::cvt_pk_bf16(a[6] * e, a[7] * e);
                w1.x = pg8::cvt_pk_bf16(a[8] * e, a[9] * e); w1.y = pg8::cvt_pk_bf16(a[10] * e, a[11] * e); w1.z = pg8::cvt_pk_bf16(a[12] * e, a[13] * e); w1.w = pg8::cvt_pk_bf16(a[14] * e, a[15] * e);
                *(LAS v4u*)(KT + lane * QS + 8 * w4) = w0; *(LAS v4u*)(KT + lane * QS + 32 + 8 * w4) = w1;
#pragma unroll
                for (int i = 0; i < 16; i += 2) { const unsigned mine = pg8::cvt_pk_bf16(a[i] * ee, a[i + 1] * ee); const unsigned pv = (unsigned)__shfl_xor((int)mine, 1);
                    const unsigned w = (lane & 1) ? ((pv >> 16) | (mine & 0xffff0000u)) : ((mine & 0xffffu) | (pv << 16));
                    const int row = (i < 8 ? 8 * w4 + i : 32 + 8 * w4 + (i - 8)) + (lane & 1);
                    *(LAS unsigned*)(KE + row * TS + (lane & ~1)) = w; } }
        } else {
            float bb[8];
#pragma unroll
            for (int i = 0; i < 8; ++i) bb[i] = valid ? a[8 + i] : 0.f;
#pragma unroll
            for (int i = 0; i < 8; ++i) { float x = bb[i];
                x += __builtin_bit_cast(float, __builtin_amdgcn_mov_dpp(__builtin_bit_cast(int, x), 0x111, 0xf, 0xf, true));
                x += __builtin_bit_cast(float, __builtin_amdgcn_mov_dpp(__builtin_bit_cast(int, x), 0x112, 0xf, 0xf, true));
                x += __builtin_bit_cast(float, __builtin_amdgcn_mov_dpp(__builtin_bit_cast(int, x), 0x114, 0xf, 0xf, true));
                x += __builtin_bit_cast(float, __builtin_amdgcn_mov_dpp(__builtin_bit_cast(int, x), 0x118, 0xf, 0xf, true));
                const float t0 = __builtin_bit_cast(float, __builtin_amdgcn_readlane(__builtin_bit_cast(int, x), 15)), t1 = __builtin_bit_cast(float, __builtin_amdgcn_readlane(__builtin_bit_cast(int, x), 31)), t2 = __builtin_bit_cast(float, __builtin_amdgcn_readlane(__builtin_bit_cast(int, x), 47));
                bb[i] = x + (lane >= 16 ? t0 : 0.f) + (lane >= 32 ? t1 : 0.f) + (lane >= 48 ? t2 : 0.f); }
            if (qwave) {
                if (lane == 63) {
#pragma unroll
                    for (int i = 0; i < 8; ++i) WT[8 * w4 + i] = bb[i]; }
                float o8[8];
#pragma unroll
                for (int i = 0; i < 8; ++i) o8[i] = valid ? a[i] * 0.17677669529663687f * __expf(bb[i]) : 0.f;
                v4u w0; w0.x = pg8::cvt_pk_bf16(o8[0], o8[1]); w0.y = pg8::cvt_pk_bf16(o8[2], o8[3]); w0.z = pg8::cvt_pk_bf16(o8[4], o8[5]); w0.w = pg8::cvt_pk_bf16(o8[6], o8[7]);
                *(LAS v4u*)(QT + lane * QS + 8 * w4) = w0;
            } else {
                float o8[8];
#pragma unroll
                for (int i = 0; i < 8; ++i) o8[i] = valid ? a[i] * __expf(-bb[i]) : 0.f;
#pragma unroll
                for (int i = 0; i < 8; i += 2) { const float t0 = __shfl(bb[i], 63), t1 = __shfl(bb[i + 1], 63);
                    const unsigned mine = pg8::cvt_pk_bf16(valid ? a[i] * __expf(t0 - bb[i]) : 0.f, valid ? a[i + 1] * __expf(t1 - bb[i + 1]) : 0.f); const unsigned pv = (unsigned)__shfl_xor((int)mine, 1);
                    const unsigned w = (lane & 1) ? ((pv >> 16) | (mine & 0xffff0000u)) : ((mine & 0xffffu) | (pv << 16));
                    *(LAS unsigned*)(KE + (8 * w4 + i + (lane & 1)) * TS + (lane & ~1)) = w; }
                v4u w0; w0.x = pg8::cvt_pk_bf16(o8[0], o8[1]); w0.y = pg8::cvt_pk_bf16(o8[2], o8[3]); w0.z = pg8::cvt_pk_bf16(o8[4], o8[5]); w0.w = pg8::cvt_pk_bf16(o8[6], o8[7]);
                *(LAS v4u*)(KT + lane * QS + 8 * w4) = w0;
            }
        }
        { const unsigned vv[4] = {valid ? vr.x : 0u, valid ? vr.y : 0u, valid ? vr.z : 0u, valid ? vr.w : 0u};
#pragma unroll
          for (int i = 0; i < 4; ++i) { const unsigned pv = (unsigned)__shfl_xor((int)vv[i], 1);
              const unsigned w = (lane & 1) ? ((pv >> 16) | (vv[i] & 0xffff0000u)) : ((vv[i] & 0xffffu) | (pv << 16));
              *(LAS unsigned*)(VT + (8 * wave + 2 * i + (lane & 1)) * TS + (lane & ~1)) = w; } }
            if (c + 1 < nch) LA_LOAD(c + 1);
        }
        if (i >= 1) {
            LAS bf16* QT = SB0 + ((i - 1) & 1) * SB; LAS bf16* KT = QT + 64 * QS;
        { const int rb = wave >> 1;
#pragma unroll
          for (int ci = 0; ci < 2; ++ci) { const int cb = (wave & 1) * 2 + ci; f32x4 acc = {0.f, 0.f, 0.f, 0.f};
              if (cb <= rb) {
#pragma unroll
                  for (int ks = 0; ks < NKS; ++ks) { const bf16x8_t af = *(const LAS bf16x8_t*)(QT + (rb * 16 + c16) * QS + ks * 32 + 8 * g4), bf = *(const LAS bf16x8_t*)(KT + (cb * 16 + c16) * QS + ks * 32 + 8 * g4);
                      acc = __builtin_amdgcn_mfma_f32_16x16x32_bf16(af, bf, acc, 0, 0, 0); } }
#pragma unroll
              for (int r = 0; r < 4; ++r) { const int tt = rb * 16 + 4 * g4 + r, ss = cb * 16 + c16; AL[tt * TS + ss] = (bf16)f2bf(ss <= tt ? acc[r] : 0.f); } } }
        }
        LDS_WAIT(); __builtin_amdgcn_s_barrier(); asm volatile("" ::: "memory");
        if (i >= 1) {
            const int c = i - 1; LAS bf16* QT = SB0 + (c & 1) * SB; LAS bf16* KT = QT + 64 * QS; LAS bf16* VT = KT + 64 * QS; LAS bf16* KE = VT + 64 * TS; LAS bf16* GT = KE + DK * TS; LAS float* WT = (LAS float*)(GT + 64 * TS);
            const int nvc = min(64, nt - c * 64); (void)KT;
        if (wave < 4) {
            const int rb = wave; const LAS bf16* STc = ST + cur * 64 * QS;
            f32x4 o[4];
#pragma unroll
            for (int cb = 0; cb < 4; ++cb) o[cb] = (f32x4){0.f, 0.f, 0.f, 0.f};
#pragma unroll
            for (int ks = 0; ks < 2; ++ks) { const bf16x8_t af = *(const LAS bf16x8_t*)(AL + (rb * 16 + c16) * TS + ks * 32 + 8 * g4);
#pragma unroll
                for (int cb = 0; cb < 4; ++cb) { const bf16x8_t bf = *(const LAS bf16x8_t*)(VT + (cb * 16 + c16) * TS + ks * 32 + 8 * g4); o[cb] = __builtin_amdgcn_mfma_f32_16x16x32_bf16(af, bf, o[cb], 0, 0, 0); } }
#pragma unroll
            for (int ks = 0; ks < NKS; ++ks) { const bf16x8_t af = *(const LAS bf16x8_t*)(QT + (rb * 16 + c16) * QS + ks * 32 + 8 * g4);
#pragma unroll
                for (int cb = 0; cb < 4; ++cb) { const bf16x8_t bf = *(const LAS bf16x8_t*)(STc + (cb * 16 + c16) * QS + ks * 32 + 8 * g4); o[cb] = __builtin_amdgcn_mfma_f32_16x16x32_bf16(af, bf, o[cb], 0, 0, 0); } }
            { float* LAO = WSP(float, WS_LAO);
#pragma unroll
              for (int r = 0; r < 4; ++r) { const int tok = c * 64 + rb * 16 + 4 * g4 + r;
                  if (tok < nt) { float* op = LAO + (size_t)(row0 + tok) * 512 + (RET ? 0 : 256) + h * 64 + c16;
#pragma unroll
                      for (int cb = 0; cb < 4; ++cb) op[cb * 16] = o[cb][r]; } } }
        } else {
            const int dvb = wave - 4; LAS bf16* STn = ST + (cur ^ 1) * 64 * QS;
            f32x4 ds[NKB];
#pragma unroll
            for (int cb = 0; cb < NKB; ++cb) ds[cb] = (f32x4){0.f, 0.f, 0.f, 0.f};
#pragma unroll
            for (int ks = 0; ks < 2; ++ks) { const bf16x8_t af = *(const LAS bf16x8_t*)(VT + (dvb * 16 + c16) * TS + ks * 32 + 8 * g4);
#pragma unroll
                for (int cb = 0; cb < NKB; ++cb) { const bf16x8_t bf = *(const LAS bf16x8_t*)(KE + (cb * 16 + c16) * TS + ks * 32 + 8 * g4); ds[cb] = __builtin_amdgcn_mfma_f32_16x16x32_bf16(af, bf, ds[cb], 0, 0, 0); } }
#pragma unroll
            for (int cb = 0; cb < NKB; ++cb) { const float eB = RET ? __builtin_amdgcn_exp2f(lg2 * (float)nvc) : __expf(WT[cb * 16 + c16]);
#pragma unroll
                for (int r = 0; r < 4; ++r) { Sreg[cb][r] = eB * Sreg[cb][r] + ds[cb][r]; STn[(dvb * 16 + 4 * g4 + r) * QS + cb * 16 + c16] = (bf16)f2bf(Sreg[cb][r]); } }
        }
            cur ^= 1;
        }
        LDS_WAIT(); __builtin_amdgcn_s_barrier(); asm volatile("" ::: "memory");
    }
#undef LA_LOAD
    if (wave >= 4) {
        float* so = C.out + (RET ? (smp ? O_RS + (((size_t)l * DB + b) * 4 + h) * DK * 64 : O_RP + (((size_t)l * BATCH + b) * 4 + h) * DK * 64)
                                 : (smp ? O_GS + (((size_t)l * DB + b) * 4 + h) * DK * 64 : O_GP + (((size_t)l * BATCH + b) * 4 + h) * DK * 64));
#pragma unroll
        for (int cb = 0; cb < NKB; ++cb)
#pragma unroll
            for (int r = 0; r < 4; ++r) so[(cb * 16 + c16) * 64 + (wave - 4) * 16 + 4 * g4 + r] = Sreg[cb][r];
    }
}
__device__ __forceinline__ void n2_la_chunked(const Ctx& C, int l) {
    const int bx = blockIdx.x;
    if (bx < 32) { const int b = (bx >> 2) & 3, h = bx & 3; if (bx < 16) la_chunked<64, true>(C, l, false, b, h); else la_chunked<32, false>(C, l, false, b, h); }
    else { for (int it = bx - 32; it < 256; it += C.G - 32) { const int b = (it >> 2) & 31, h = it & 3; if (it < 128) la_chunked<64, true>(C, l, true, b, h); else la_chunked<32, false>(C, l, true, b, h); } }
}
typedef float f32x16_t __attribute__((ext_vector_type(16)));
__device__ __forceinline__ int crow_(int r, int hi) { return (r & 3) + 8 * (r >> 2) + 4 * hi; }
__device__ __forceinline__ float swapmax32(float m) { auto rr = __builtin_amdgcn_permlane32_swap(__float_as_uint(m), __float_as_uint(m), false, false); return fmaxf(__uint_as_float(rr[0]), __uint_as_float(rr[1])); }
__device__ __forceinline__ float swapadd32(float m) { auto rr = __builtin_amdgcn_permlane32_swap(__float_as_uint(m), __float_as_uint(m), false, false); return __uint_as_float(rr[0]) + __uint_as_float(rr[1]); }
constexpr float LOG2E = 1.4426950408889634f;
__device__ __forceinline__ void attn_prompt_item(const Ctx& C, int l, int b, int h, int qb, float lam, float lam_init, float mb) {
    THREAD_IDS();
    constexpr int KS = 72;
    LAS bf16* Kt = (LAS bf16*)C.lds;
    LAS bf16* Vt = Kt + 2 * 64 * KS;
    LAS float* BT = (LAS float*)(Vt + 2 * 64 * KS);
    LAS float* OX = BT + 128;
    const bf16* ZM = WSP(bf16, WS_ZMIX); const bf16* QNB = WSP(bf16, WS_QNB); const bf16* KNB = WSP(bf16, WS_KNB); bf16* BR = WSP(bf16, WS_BR);
    const int r32 = lane & 31, hi = lane >> 5, qs = wave >> 1, s = wave & 1;
    const int q0 = qb * 128 + qs * 32; const int rowb = b * L;
    if (tid < 128) BT[tid] = (C.in[I_RELB][t5_bucket(tid) * 4 + h] - C.in[I_RELB][31 * 4 + h]) * LOG2E;
    pg8::bf16x8 qf[2];
#pragma unroll
    for (int d0 = 0; d0 < 2; ++d0) qf[d0] = *(const pg8::bf16x8*)(QNB + (size_t)(rowb + q0 + r32) * 256 + h * 64 + s * 32 + 16 * d0 + 8 * hi);
    const int pl = (lane & ~15) | ((lane & 8) >> 1) | ((lane & 4) << 1) | (lane & 3);
    const int NT = (min(128 * (qb + 1), L) + 63) >> 6;
    v4u kreg, vreg;
#define AT_LOAD(j) do { const size_t r_ = (size_t)(rowb + (j) * 64 + lane); kreg = *(const v4u*)(KNB + r_ * 256 + h * 64 + 8 * wave); vreg = *(const v4u*)(ZM + r_ * NMIXP + D_V + h * 64 + 8 * wave); } while (0)
#define AT_STORE(buf) do { *(LAS v4u*)(Kt + (buf) * 64 * KS + lane * KS + 8 * wave) = kreg; LAS bf16* v_ = Vt + (buf) * 64 * KS + (8 * wave) * KS + pl; \
        v_[0] = (bf16)(vreg.x & 0xffffu); v_[KS] = (bf16)(vreg.x >> 16); v_[2 * KS] = (bf16)(vreg.y & 0xffffu); v_[3 * KS] = (bf16)(vreg.y >> 16); \
        v_[4 * KS] = (bf16)(vreg.z & 0xffffu); v_[5 * KS] = (bf16)(vreg.z >> 16); v_[6 * KS] = (bf16)(vreg.w & 0xffffu); v_[7 * KS] = (bf16)(vreg.w >> 16); } while (0)
    AT_LOAD(0); AT_STORE(0); if (NT > 1) AT_LOAD(1);
    LDS_WAIT(); __builtin_amdgcn_s_barrier(); asm volatile("" ::: "memory");
    float lsum = 0.f; f32x16_t o[2]; f32x16_t negm;
#pragma unroll
    for (int i = 0; i < 16; ++i) negm[i] = -mb;
#pragma unroll
    for (int i = 0; i < 16; ++i) { o[0][i] = 0.f; o[1][i] = 0.f; }
    for (int j = 0; j < NT; ++j) {
        const int k0 = 64 * j, buf = j & 1;
        if (k0 <= q0 + 31) {
            const LAS bf16* kb = Kt + buf * 64 * KS; const LAS bf16* vb = Vt + buf * 64 * KS;
            f32x16_t p0 = negm, p1 = negm;
#pragma unroll
            for (int d0 = 0; d0 < 2; ++d0) { const pg8::bf16x8 a0 = *(const LAS pg8::bf16x8*)(kb + r32 * KS + s * 32 + 16 * d0 + 8 * hi), a1 = *(const LAS pg8::bf16x8*)(kb + (32 + r32) * KS + s * 32 + 16 * d0 + 8 * hi);
                p0 = __builtin_amdgcn_mfma_f32_32x32x16_bf16(a0, qf[d0], p0, 0, 0, 0); p1 = __builtin_amdgcn_mfma_f32_32x32x16_bf16(a1, qf[d0], p1, 0, 0, 0); }
            if (q0 - k0 - 63 < 113) {
#pragma unroll
                for (int r = 0; r < 16; ++r) { const int n0 = (q0 + r32) - (k0 + crow_(r, hi)), n1 = n0 - 32;
                    p0[r] = n0 < 0 ? -INFINITY : p0[r] + (n0 < 128 ? BT[n0] : 0.f); p1[r] = n1 < 0 ? -INFINITY : p1[r] + (n1 < 128 ? BT[n1] : 0.f); } }
            typedef float f32x2_t __attribute__((ext_vector_type(2)));
            f32x2_t ps2 = {0.f, 0.f};
#pragma unroll
            for (int r = 0; r < 16; r += 2) { p0[r] = __builtin_amdgcn_exp2f(p0[r]); p0[r + 1] = __builtin_amdgcn_exp2f(p0[r + 1]); p1[r] = __builtin_amdgcn_exp2f(p1[r]); p1[r + 1] = __builtin_amdgcn_exp2f(p1[r + 1]);
                ps2 = ps2 + (f32x2_t){p0[r], p0[r + 1]}; ps2 = ps2 + (f32x2_t){p1[r], p1[r + 1]}; }
            lsum += ps2[0] + ps2[1];
            pg8::bf16x8 pb[4];
#pragma unroll
            for (int ks = 0; ks < 4; ++ks) { v4u w;
                if (ks < 2) { w.x = pg8::cvt_pk_bf16(p0[8 * ks], p0[8 * ks + 1]); w.y = pg8::cvt_pk_bf16(p0[8 * ks + 2], p0[8 * ks + 3]); w.z = pg8::cvt_pk_bf16(p0[8 * ks + 4], p0[8 * ks + 5]); w.w = pg8::cvt_pk_bf16(p0[8 * ks + 6], p0[8 * ks + 7]); }
                else { w.x = pg8::cvt_pk_bf16(p1[8 * ks - 16], p1[8 * ks - 15]); w.y = pg8::cvt_pk_bf16(p1[8 * ks - 14], p1[8 * ks - 13]); w.z = pg8::cvt_pk_bf16(p1[8 * ks - 12], p1[8 * ks - 11]); w.w = pg8::cvt_pk_bf16(p1[8 * ks - 10], p1[8 * ks - 9]); }
                pb[ks] = __builtin_bit_cast(pg8::bf16x8, w); }
#pragma unroll
            for (int d0 = 0; d0 < 2; ++d0)
#pragma unroll
                for (int ks = 0; ks < 4; ++ks) { const pg8::bf16x8 af = *(const LAS pg8::bf16x8*)(vb + (32 * d0 + r32) * KS + 16 * ks + 8 * hi); o[d0] = __builtin_amdgcn_mfma_f32_32x32x16_bf16(af, pb[ks], o[d0], 0, 0, 0); }
        }
        if (j + 1 < NT) AT_STORE(buf ^ 1);
        if (j + 2 < NT) AT_LOAD(j + 2);
        LDS_WAIT(); __builtin_amdgcn_s_barrier(); asm volatile("" ::: "memory");
    }
#undef AT_LOAD
#undef AT_STORE
    lsum = swapadd32(lsum); const float inv = 1.0f / lsum;
    LAS float* ox = OX + (qs * 32 + r32) * 65;
    if (s == 1) {
#pragma unroll
        for (int d0 = 0; d0 < 2; ++d0)
#pragma unroll
            for (int r = 0; r < 16; ++r) ox[32 * d0 + crow_(r, hi)] = o[d0][r] * inv; }
    LDS_WAIT(); __builtin_amdgcn_s_barrier(); asm volatile("" ::: "memory");
    if (s == 0) {
        float ss = 0.f;
#pragma unroll
        for (int d0 = 0; d0 < 2; ++d0)
#pragma unroll
            for (int r = 0; r < 16; ++r) { const float v = o[d0][r] * inv - lam * ox[32 * d0 + crow_(r, hi)]; o[d0][r] = v; ss += v * v; }
        ss = swapadd32(ss); const float rs = rsqrtf(ss * (1.0f / 64) + EPS) * (1.0f - lam_init);
        const int qpos = q0 + r32;
        if (qpos < L) { bf16* brp = BR + (size_t)(rowb + qpos) * D + 768 + h * 64;
#pragma unroll
            for (int d0 = 0; d0 < 2; ++d0)
#pragma unroll
                for (int r4 = 0; r4 < 4; ++r4) { const int dv = 32 * d0 + 8 * r4 + 4 * hi; const float* sl = C.in[I_SUBLN] + l * 64 + dv;
                    const unsigned w0 = pk2(o[d0][4 * r4] * rs * sl[0], o[d0][4 * r4 + 1] * rs * sl[1]), w1 = pk2(o[d0][4 * r4 + 2] * rs * sl[2], o[d0][4 * r4 + 3] * rs * sl[3]);
                    *(unsigned long long*)(brp + dv) = (unsigned long long)w0 | ((unsigned long long)w1 << 32); } }
    }
    LDS_WAIT(); __builtin_amdgcn_s_barrier(); asm volatile("" ::: "memory");
}
__device__ __forceinline__ void n2_attn_prompt_mfma(const Ctx& C, int l, float lam_init, int qoff = 0) {
    THREAD_IDS();
    const float lam = lam_of(C, l, lam_init);
    unsigned* qw = (unsigned*)(C.ws + WS_CTL) + CW_QUEUE + 64 * (l + qoff);
    volatile LAS int* slot = (volatile LAS int*)(C.lds + MISC_OFF + 64);
    constexpr int NQB = (L + 127) / 128;
    for (;;) {
        if (tid == 0) slot[0] = (int)__hip_atomic_fetch_add(qw, 1u, __ATOMIC_RELAXED, __HIP_MEMORY_SCOPE_AGENT);
        __syncthreads();
        const int it = slot[0];
        if (it >= 16 * NQB) break;
        attn_prompt_item(C, l, (it & 15) >> 2, it & 3, NQB - 1 - (it >> 4), lam, lam_init, 16.0f);
    }
}
constexpr int PSTR = 68;
__device__ __forceinline__ pg8::bf16x8 cvt8(const f32x4 a, const f32x4 b) { v4u w; w.x = pg8::cvt_pk_bf16(a[0], a[1]); w.y = pg8::cvt_pk_bf16(a[2], a[3]); w.z = pg8::cvt_pk_bf16(b[0], b[1]); w.w = pg8::cvt_pk_bf16(b[2], b[3]); return __builtin_bit_cast(pg8::bf16x8, w); }
__device__ __forceinline__ void attn_sample_item(const Ctx& C, int l, int b, int split) {
    THREAD_IDS();
    const int h = wave & 3, half = wave >> 2, c16 = lane & 15, g = lane >> 4, srow = c16 >> 3, t = c16 & 7;
    const bf16* QNB = WSP(bf16, WS_QNB); const int* PT = (const int*)C.in[I_PT];
    const float* CK = C.in[I_CK] + (size_t)l * NPOOL * PAGE * 256; const float* CV = C.in[I_CV] + (size_t)l * NPOOL * PAGE * 256;
    LAS float* BT = (LAS float*)C.lds;
    BT[tid] = (C.in[I_RELB][t5_bucket(tid & 127) * 4 + (tid >> 7)] - C.in[I_RELB][31 * 4 + (tid >> 7)]) * LOG2E;
    const v4u z4 = {0u, 0u, 0u, 0u};
    const v4u q0w = srow == 0 ? *(const v4u*)(QNB + (size_t)(MP + b * 8 + t) * 256 + h * 64 + 8 * g) : z4, q1w = srow == 1 ? *(const v4u*)(QNB + (size_t)(MP + b * 8 + t) * 256 + h * 64 + 32 + 8 * g) : z4;
    const pg8::bf16x8 qf0 = __builtin_bit_cast(pg8::bf16x8, q0w), qf1 = __builtin_bit_cast(pg8::bf16x8, q1w);
    LDS_WAIT(); __builtin_amdgcn_s_barrier(); asm volatile("" ::: "memory");
    float m = -INFINITY, lsum = 0.f; f32x4 o[4];
#pragma unroll
    for (int db = 0; db < 4; ++db) o[db] = (f32x4){0.f, 0.f, 0.f, 0.f};
    const int kk0 = split * 1024 + half * 512;
    const int pg0 = __builtin_amdgcn_readfirstlane(PT[b * NPAGES + (kk0 >> 7)]), pg1 = __builtin_amdgcn_readfirstlane(PT[b * NPAGES + (kk0 >> 7) + 1]), pg2 = __builtin_amdgcn_readfirstlane(PT[b * NPAGES + (kk0 >> 7) + 2]), pg3 = __builtin_amdgcn_readfirstlane(PT[b * NPAGES + (kk0 >> 7) + 3]);
#define SA_LOAD(KR, VR, st) do { const int kk_ = kk0 + 32 * (st); const int pi_ = (st) >> 2; const int page_ = pi_ == 0 ? pg0 : pi_ == 1 ? pg1 : pi_ == 2 ? pg2 : pg3; const size_t base_ = ((size_t)(page_ * PAGE + (kk_ & 127)) * 4 + h) * 64; \
        _Pragma("unroll") for (int T = 0; T < 2; ++T) _Pragma("unroll") for (int ks = 0; ks < 2; ++ks) { const float* p = CK + base_ + (size_t)(16 * T + c16) * 256 + 32 * ks + 8 * g; KR[T][ks][0] = *(const f32x4*)p; KR[T][ks][1] = *(const f32x4*)(p + 4); } \
        _Pragma("unroll") for (int db = 0; db < 4; ++db) _Pragma("unroll") for (int j = 0; j < 8; ++j) { const int kv = j < 4 ? 4 * g + j : 16 + 4 * g + (j - 4); VR[db][j] = CV[base_ + (size_t)kv * 256 + 16 * db + c16]; } } while (0)
#define SA_MATH(KR, VR, st) do { const int kk = kk0 + 32 * (st); f32x4 sv[2]; \
        _Pragma("unroll") for (int T = 0; T < 2; ++T) { sv[T] = (f32x4){0.f, 0.f, 0.f, 0.f}; \
            sv[T] = __builtin_amdgcn_mfma_f32_16x16x32_bf16(cvt8(KR[T][0][0], KR[T][0][1]), qf0, sv[T], 0, 0, 0); \
            sv[T] = __builtin_amdgcn_mfma_f32_16x16x32_bf16(cvt8(KR[T][1][0], KR[T][1][1]), qf1, sv[T], 0, 0, 0); } \
        if (kk + 31 + 128 > PAST) { \
            _Pragma("unroll") for (int T = 0; T < 2; ++T) _Pragma("unroll") for (int r = 0; r < 4; ++r) { const int n = PAST + t - (kk + 16 * T + 4 * g + r); if (n < 128) sv[T][r] += BT[h * 128 + n]; } } \
        float mt = fmaxf(fmaxf(fmaxf(sv[0][0], sv[0][1]), fmaxf(sv[0][2], sv[0][3])), fmaxf(fmaxf(sv[1][0], sv[1][1]), fmaxf(sv[1][2], sv[1][3]))); \
        mt = fmaxf(mt, __shfl_xor(mt, 16)); mt = fmaxf(mt, __shfl_xor(mt, 32)); \
        const float mn = fmaxf(m, mt); const float al = __builtin_amdgcn_exp2f(m - mn); m = mn; float ps = 0.f; \
        _Pragma("unroll") for (int T = 0; T < 2; ++T) _Pragma("unroll") for (int r = 0; r < 4; ++r) { sv[T][r] = __builtin_amdgcn_exp2f(sv[T][r] - m); ps += sv[T][r]; } \
        lsum = lsum * al + ps; const pg8::bf16x8 pf = cvt8(sv[0], sv[1]); \
        _Pragma("unroll") for (int db = 0; db < 4; ++db) { o[db] = o[db] * al; \
            const f32x4 va = {VR[db][0], VR[db][1], VR[db][2], VR[db][3]}, vb = {VR[db][4], VR[db][5], VR[db][6], VR[db][7]}; \
            o[db] = __builtin_amdgcn_mfma_f32_16x16x32_bf16(cvt8(va, vb), pf, o[db], 0, 0, 0); } } while (0)
    f32x4 krA[2][2][2], krB[2][2][2]; float vrA[4][8], vrB[4][8];
    SA_LOAD(krA, vrA, 0);
#pragma unroll 1
    for (int step = 0; step < 16; step += 2) {
        SA_LOAD(krB, vrB, step + 1);
        SA_MATH(krA, vrA, step);
        if (step + 2 < 16) SA_LOAD(krA, vrA, step + 2);
        SA_MATH(krB, vrB, step + 1);
    }
#undef SA_LOAD
#undef SA_MATH
    lsum += __shfl_xor(lsum, 16); lsum += __shfl_xor(lsum, 32);
    float* pp = WSP(float, WS_PART) + ((((size_t)b * 4 + h) * 16 + split * 2 + half) * 16 + c16) * PSTR;
#pragma unroll
    for (int db = 0; db < 4; ++db) *(f32x4*)(pp + 16 * db + 4 * g) = o[db];
    if (g == 0) { pp[64] = m; pp[65] = lsum; }
    LDS_WAIT(); __builtin_amdgcn_s_barrier(); asm volatile("" ::: "memory");
}
__device__ __forceinline__ void n2_attn_sample_split(const Ctx& C, int l) {
    for (int it = blockIdx.x; it < DB * 8; it += C.G) attn_sample_item(C, l, it >> 3, it & 7);
}
__device__ __forceinline__ void n3_attn_sample_combine(const Ctx& C, int l, float lam_init) {
    THREAD_IDS();
    const float lam = lam_of(C, l, lam_init);
    const bf16* QNB = WSP(bf16, WS_QNB); const bf16* KNB = WSP(bf16, WS_KNB); const bf16* ZM = WSP(bf16, WS_ZMIX); bf16* BR = WSP(bf16, WS_BR);
    for (int it = gw; it < DB * 4 * DS; it += NGW) {
        const int b = it >> 5, h = (it >> 3) & 3, t = it & 7; float os[2];
        const float far = C.in[I_RELB][31 * 4 + h];
#pragma unroll
        for (int s = 0; s < 2; ++s) {
            const float* pb = WSP(float, WS_PART) + ((((size_t)b * 4 + h) * 16) * 16 + s * 8 + t) * PSTR;
            float sn[8]; float mm = -INFINITY;
            for (int pi = 0; pi < 16; ++pi) mm = fmaxf(mm, pb[(size_t)pi * 16 * PSTR + 64]);
#pragma unroll
            for (int jj = 0; jj < 8; ++jj) { float d = 0.f;
                for (int i = 0; i < 32; ++i) d += bf2f(QNB[(size_t)(MP + b * 8 + t) * 256 + h * 64 + s * 32 + i]) * bf2f(KNB[(size_t)(MP + b * 8 + jj) * 256 + h * 64 + s * 32 + i]);
                d += (C.in[I_RELB][t5_bucket(t - jj < 0 ? 0 : t - jj) * 4 + h] - far) * LOG2E;
                sn[jj] = jj <= t ? d : -INFINITY; mm = fmaxf(mm, sn[jj]); }
            float ll = 0.f, oo = 0.f;
            for (int pi = 0; pi < 16; ++pi) { const float* pr = pb + (size_t)pi * 16 * PSTR; const float w = exp2f(pr[64] - mm); ll += pr[65] * w; oo += pr[lane] * w; }
#pragma unroll
            for (int jj = 0; jj < 8; ++jj) { const float w = exp2f(sn[jj] - mm); ll += w; oo += w * bf2f(ZM[(size_t)(MP + b * 8 + jj) * NMIXP + D_V + h * 64 + lane]); }
            os[s] = oo / ll;
        }
        const float o = os[0] - lam * os[1]; const float ms = wave_sum(o * o) * (1.0f / 64);
        BR[(size_t)(MP + b * 8 + t) * D + 768 + h * 64 + lane] = (bf16)f2bf(o * rsqrtf(ms + EPS) * C.in[I_SUBLN][l * 64 + lane] * (1.0f - lam_init));
    }
}

__device__ __forceinline__ void n3_la_finalize(const Ctx& C, int l) {
    THREAD_IDS();
    const float* LAO = WSP(float, WS_LAO); const bf16* ZM = WSP(bf16, WS_ZMIX); bf16* BR = WSP(bf16, WS_BR);
    const bool ret = lane < 32; const int hd = (lane >> 3) & 3, c8 = (lane & 7) * 8;
    float gn[8];
#pragma unroll
    for (int j = 0; j < 8; ++j) gn[j] = (ret ? C.in[I_RGN] : C.in[I_GGN])[(l * 4 + hd) * 64 + c8 + j];
    for (int r = gw; r < MP; r += NGW) {
        const f32x4 a = *(const f32x4*)(LAO + (size_t)r * 512 + 8 * lane), b = *(const f32x4*)(LAO + (size_t)r * 512 + 8 * lane + 4);
        const v4u gw4 = *(const v4u*)(ZM + (size_t)r * NMIXP + (ret ? R_G : G_R) + hd * 64 + c8);
        float x[8] = {a[0], a[1], a[2], a[3], b[0], b[1], b[2], b[3]}, g[8]; unpack8(gw4, g);
        float s = ((x[0] + x[1]) + (x[2] + x[3])) + ((x[4] + x[5]) + (x[6] + x[7]));
        s += __shfl_xor(s, 1); s += __shfl_xor(s, 2); s += __shfl_xor(s, 4);
        const float mean = ret ? s * (1.0f / 64) : 0.f; float q2 = 0.f;
#pragma unroll
        for (int j = 0; j < 8; ++j) { x[j] -= mean; q2 += x[j] * x[j]; }
        q2 += __shfl_xor(q2, 1); q2 += __shfl_xor(q2, 2); q2 += __shfl_xor(q2, 4);
        const float rs = rsqrtf(q2 * (1.0f / 64) + EPS);
#pragma unroll
        for (int j = 0; j < 8; ++j) x[j] = siluf_(g[j]) * x[j] * rs * gn[j];
        *(v4u*)(BR + (size_t)r * D + 256 + 8 * lane) = pack8(x);
    }
}

constexpr int NQB_ATT = (L + 127) / 128;
constexpr int IT_LA = 32, IT_SS = IT_LA + DB * 8, IT_AT = IT_SS + 16 * NQB_ATT, IT_LS = IT_AT + 32, IT_CV = IT_LS + (MR + 63) / 64, IT_END = IT_CV;
__device__ __forceinline__ void n2_phase(const Ctx& C, int l, float lam_init, int qslot) {
    THREAD_IDS();
    const float lam = lam_of(C, l, lam_init);
    float mb;
    { float mq = 0.f, mk = 0.f, mbias = 0.f;
#pragma unroll 1
      for (int i = 0; i < 32; ++i) { mq = fmaxf(mq, fabsf(C.in[I_QN][l * 32 + i])); mk = fmaxf(mk, fabsf(C.in[I_KN][l * 32 + i])); }
#pragma unroll 1
      for (int i = 0; i < 128; ++i) mbias = fmaxf(mbias, C.in[I_RELB][i] - C.in[I_RELB][31 * 4 + (i & 3)]);
      mb = 1.02f * 1.4426950408889634f * 5.656854249492381f * mq * mk + 1.4426950408889634f * mbias; }
    unsigned* qw = (unsigned*)(C.ws + WS_CTL) + CW_QUEUE + 64 * qslot;
    volatile LAS int* slot = (volatile LAS int*)(C.lds + MISC_OFF + 64);
    if (blockIdx.x < IT_LA) { const int it = blockIdx.x; const int b = (it >> 2) & 3, h = it & 3; if (it < 16) la_chunked<64, true>(C, l, false, b, h); else la_chunked<32, false>(C, l, false, b, h); }
#if defined(PROBE_ID)
    if (l == 0 && tid == 0) ((unsigned long long*)(C.ws + WS_CTL + 65536))[blockIdx.x * 16 + 3] = __builtin_amdgcn_s_memrealtime();
#endif
    for (;;) {
        if (tid == 0) slot[0] = (int)__hip_atomic_fetch_add(qw, 1u, __ATOMIC_RELAXED, __HIP_MEMORY_SCOPE_AGENT);
        __syncthreads();
        const int qi = slot[0];
        const int it = qi < 2 * DB * 8 ? ((qi & 1) ? IT_SS + (qi >> 1) : IT_LA + (qi >> 1)) : qi + IT_LA;
        __syncthreads();
        if (it >= IT_END) break;
#ifndef PROBE_DBL
#define PROBE_DBL 0
#endif
        if (it < IT_SS) { const int i2 = it - IT_LA; attn_sample_item(C, l, i2 >> 3, i2 & 7); if (PROBE_DBL == 1) attn_sample_item(C, l, i2 >> 3, i2 & 7); }
        else if (it < IT_AT) { const int i2 = it - IT_SS; attn_prompt_item(C, l, (i2 & 15) >> 2, i2 & 3, NQB_ATT - 1 - (i2 >> 4), lam, lam_init, mb); if (PROBE_DBL == 2) attn_prompt_item(C, l, (i2 & 15) >> 2, i2 & 3, NQB_ATT - 1 - (i2 >> 4), lam, lam_init, mb); }
        else if (it < IT_LS) { const int i2 = (it - IT_AT) * 8 + wave; const int b = (i2 >> 2) & 31, h = i2 & 3; if (i2 < 128) la_seq<64, true>(C, l, true, b, h); else la_seq<32, false>(C, l, true, b, h); }
        else { conv_rows_item(C, l, it - IT_LS); if (PROBE_DBL == 3) conv_rows_item(C, l, it - IT_LS); conv_state_item(C, l, it - IT_LS, IT_CV - IT_LS); }
    }
}

#ifndef PROBE_ID
#define PROBE_ID 0
#endif
#define TSTAMP(k) do { if (PROBE_ID && l == 0 && threadIdx.x == 0) { ((unsigned long long*)(C.ws + WS_CTL + 65536))[blockIdx.x * 16 + (k)] = __builtin_amdgcn_s_memrealtime(); } } while (0)
template <int l> __device__ __forceinline__ void layer_fwd(const Ctx& C, const XcdBarrier& bar) {
#define GRID_BAR() xcd_barrier<false>(bar)
    LAS unsigned char* ring = C.lds + RING_OFF;
    float* SS = WSP(float, WS_SS); float* H = WSP(float, WS_H); bf16* HB = WSP(bf16, WS_HB); bf16* ACT = WSP(bf16, WS_ACT); bf16* ZMIX = WSP(bf16, WS_ZMIX); bf16* GATES = WSP(bf16, WS_GATES);
    bf16* BR = WSP(bf16, WS_BR); bf16* MERGED = WSP(bf16, WS_MERGED);
    constexpr float lam_init = l == 0 ? 0.2f : 0.35550906759096926f;
    constexpr bool last = (l == DEPTH - 1);
    TSTAMP(10);
    { pg8::Gemm g{HB, WSP(bf16, WS_W1 + (size_t)(l * 2 + 0) * SZ_W1), D, D, D}; pg8::StaticOrder S; S.init(M, 2 * DFF, C.G, (int)blockIdx.x);
      EpiGLU E{ACT, SS + (size_t)(l * 3 + 0) * M * 16}; pg8::gemm_phase<EpiGLU, pg8::StaticOrder, true, true>(ring, g, S, E); }
    GRID_BAR();
    { pg8::HeadOrder S; S.init(M, D, C.G, (int)blockIdx.x); S.limit = C.G; EpiRes<false, 1> E{H, HB, SS + (size_t)(l * 3 + 1) * M * 16, nullptr};
      { pg8::Gemm g{ACT, WSP(bf16, WS_WD + (size_t)(l * 2 + 0) * SZ_WD), DFF, DFF, DFF}; pg8::gemm_phase<EpiRes<false, 1>, pg8::HeadOrder, true, true>(ring, g, S, E); }
      { int kt = DFF / 11; asm volatile("" : "+s"(kt)); pg8::Gemm g{ACT, WSP(bf16, WS_WD + (size_t)(l * 2 + 0) * SZ_WD), DFF, DFF, kt}; pg8::TailOrder T; T.init(M, D, C.G, (int)blockIdx.x); T.limit = C.G; T.nsplit = 11; T.kper = DFF / 11;
        EpiPartial EP{WSP(float, WS_KSP)}; pg8::gemm_phase<EpiPartial, pg8::TailOrder, true, true>(ring, g, T, EP); }
      GRID_BAR();
      ksp_finalize<11>(WSP(float, WS_KSP), S, C.G, E); }
    GRID_BAR();
    { pg8::Gemm g{HB, WSP(bf16, WS_WIN + (size_t)l * SZ_WIN), D, D, D}; pg8::StaticOrder S; S.init(M, NINP, C.G, (int)blockIdx.x);
      EpiZ E{ZMIX, GATES, SS + (size_t)(l * 3 + 1) * M * 16, WSP(float, WS_BINP) + l * NINP}; pg8::gemm_phase<EpiZ, pg8::StaticOrder, true, true>(ring, g, S, E); }
    TSTAMP(15);
    GRID_BAR();
    TSTAMP(0);
    n1_prep(C, l);
    TSTAMP(1);
    GRID_BAR();
    TSTAMP(2);
    n2_phase(C, l, lam_init, l);
    TSTAMP(6);
    GRID_BAR();
    TSTAMP(7);
    n3_attn_sample_combine(C, l, lam_init);
    n3_la_finalize(C, l);
    TSTAMP(8);
    GRID_BAR();
    TSTAMP(9);
    { pg8::Gemm g{BR, WSP(bf16, WS_WBR + (size_t)l * SZ_WBR), D, D, D}; pg8::StaticOrder S; S.init(M, D, C.G, (int)blockIdx.x);
      EpiMergeR E{MERGED, GATES}; pg8::gemm_phase<EpiMergeR, pg8::StaticOrder, true, true, 4>(ring, g, S, E); }
    TSTAMP(11);
    GRID_BAR();
    TSTAMP(12);
    { pg8::Gemm g{MERGED, WSP(bf16, WS_WOUT + (size_t)l * SZ_WOUT), D, D, D}; pg8::StaticOrder S; S.init(M, D, C.G, (int)blockIdx.x);
      EpiRes<false, 2> E{H, HB, SS + (size_t)(l * 3 + 2) * M * 16, nullptr}; pg8::gemm_phase<EpiRes<false, 2>, pg8::StaticOrder, true, true>(ring, g, S, E); }
    TSTAMP(13);
    GRID_BAR();
    TSTAMP(14);
    { pg8::Gemm g{HB, WSP(bf16, WS_W1 + (size_t)(l * 2 + 1) * SZ_W1), D, D, D}; pg8::StaticOrder S; S.init(M, 2 * DFF, C.G, (int)blockIdx.x);
      EpiGLU E{ACT, SS + (size_t)(l * 3 + 2) * M * 16}; pg8::gemm_phase<EpiGLU, pg8::StaticOrder, true, true>(ring, g, S, E); }
    GRID_BAR();
    { pg8::HeadOrder S; S.init(M, D, C.G, (int)blockIdx.x); S.limit = C.G; EpiRes<last, 1> E{H, HB, last ? nullptr : SS + (size_t)((l + 1) * 3) * M * 16, C.out};
      { pg8::Gemm g{ACT, WSP(bf16, WS_WD + (size_t)(l * 2 + 1) * SZ_WD), DFF, DFF, DFF}; pg8::gemm_phase<EpiRes<last, 1>, pg8::HeadOrder, true, true>(ring, g, S, E); }
      { int kt = DFF / 11; asm volatile("" : "+s"(kt)); pg8::Gemm g{ACT, WSP(bf16, WS_WD + (size_t)(l * 2 + 1) * SZ_WD), DFF, DFF, kt}; pg8::TailOrder T; T.init(M, D, C.G, (int)blockIdx.x); T.limit = C.G; T.nsplit = 11; T.kper = DFF / 11;
        EpiPartial EP{WSP(float, WS_KSP)}; pg8::gemm_phase<EpiPartial, pg8::TailOrder, true, true>(ring, g, T, EP); }
      GRID_BAR();
      ksp_finalize<11>(WSP(float, WS_KSP), S, C.G, E); }
#undef GRID_BAR
}

__global__ void __launch_bounds__(NWAVES * 64, 2) fwd(Params P) {
    extern __shared__ __attribute__((aligned(16))) unsigned char lds[];
    Ctx C;
    C.in = P.in; C.out = P.out; C.ws = P.ws; C.lds = (LAS unsigned char*)lds;
    C.G = gridDim.x;
    volatile LAS unsigned* MISC = (volatile LAS unsigned*)(C.lds + MISC_OFF);
    for (int u = threadIdx.x; u < (LDS_BYTES - LDSCTL_OFF) / 4; u += NWAVES * 64) ((LAS unsigned*)(C.lds + LDSCTL_OFF))[u] = 0u;
    __syncthreads();
    unsigned* ctl = (unsigned*)(C.ws + WS_CTL);
    XcdBarrier bar = xcd_barrier_post(ctl + CW_BAR, MISC + 8);
    p0_prologue(C, P);
#if PROBE_ID == 700001
    p0_prologue(C, P);
#endif
    xcd_barrier<true>(bar);
    layer_fwd<0>(C, bar);
    xcd_barrier<false>(bar);
    layer_fwd<1>(C, bar);
#if PROBE_ID
    xcd_barrier<false>(bar);
    if (blockIdx.x == 0 && threadIdx.x == 0) { const unsigned long long* ts = (const unsigned long long*)(C.ws + WS_CTL + 65536);
        const int pb = PROBE_ID / 1000, k0 = (PROBE_ID / 10) % 100 % 10, k1 = PROBE_ID % 10;
        float val = (float)(ts[pb * 16 + k1] - ts[pb * 16 + k0]) * 0.001f;
        if (PROBE_ID >= 600000 && PROBE_ID < 700000) val = (float)ts[((PROBE_ID - 600000) / 100) * 16 + PROBE_ID % 100] * 0.001f;
        if (PROBE_ID >= 500000 && PROBE_ID < 600000) val = (float)(ts[PROBE_ID % 100] - ts[(PROBE_ID / 100) % 100]) * 0.001f;
        C.out[O_YP] = val; }
#endif
}

extern "C" void kernel_launch(void* const* d_in, const int* in_sizes, int n_in, void* d_out, int out_size, void* d_ws, size_t ws_size, hipStream_t stream) {
    static int grid = 0;
    if (grid == 0) {
        if (n_in != N_INPUTS || (size_t)out_size != O_END || ws_size < WS_END) { fprintf(stderr, "kernel_launch: unexpected shapes: n_in %d out %d (want %zu) ws %zu (want %zu)\n", n_in, out_size, (size_t)O_END, ws_size, (size_t)WS_END); grid = -1; return; }
        int dev = 0, cus = 0, per_cu = 0;
        if (hipGetDevice(&dev) != hipSuccess || hipDeviceGetAttribute(&cus, hipDeviceAttributeMultiprocessorCount, dev) != hipSuccess) { grid = -1; return; }
        if (hipFuncSetAttribute((const void*)fwd, hipFuncAttributeMaxDynamicSharedMemorySize, LDS_BYTES) != hipSuccess) { fprintf(stderr, "kernel_launch: hipFuncSetAttribute failed\n"); grid = -1; return; }
        if (hipOccupancyMaxActiveBlocksPerMultiprocessor(&per_cu, (const void*)fwd, NWAVES * 64, LDS_BYTES) != hipSuccess || per_cu < 1) { fprintf(stderr, "kernel_launch: occupancy query says %d blocks per CU\n", per_cu); }
        (void)hipGetLastError();
        grid = cus;
    }
    if (grid < 0) return;
    if (hipMemsetAsync((char*)d_ws + WS_CTL, 0, CTL_ZERO_BYTES, stream) != hipSuccess) return;
    Params p{};
    for (int i = 0; i < N_INPUTS; ++i) p.in[i] = (const float*)d_in[i];
    p.out = (float*)d_out; p.ws = (unsigned char*)d_ws;
    for (int i = 0; i < 32; ++i) p.inv_freq[i] = (float)pow(10000.0, -(double)i / 32.0);
    hipLaunchKernelGGL(fwd, dim3(grid), dim3(NWAVES * 64), LDS_BYTES, stream, p);
}
```

```cpp
#include <hip/hip_runtime.h>
#include <cstdio>
#include <cstdint>
#include <cmath>

namespace pg8 {
#define PG8_LAS __attribute__((address_space(3)))
typedef unsigned short bf16_t;
typedef short bf16x8 __attribute__((ext_vector_type(8)));
typedef float f32x4 __attribute__((ext_vector_type(4)));
typedef unsigned u32x4 __attribute__((ext_vector_type(4)));
constexpr int BM = 256, BK = 64, HALF = 128, HTB = HALF * BK * 2  , STAGE_BYTES = 8 * HTB, NXCD = 8, WGM = 8;

__host__ __device__ __forceinline__ int lds_byte(int r, int c) { const int st = (r >> 4) * 2 + (c >> 5), rr = r & 15, cc = c & 31, ob = rr * 64 + cc * 2; return st * 1024 + (ob ^ (((ob >> 9) & 1) << 5)); }
__host__ __device__ __forceinline__ void stage_rc(int b, int& R, int& C) { const int st = b / 1024, sb = b % 1024, swz = sb ^ (((sb >> 9) & 1) << 5); R = (st >> 1) * 16 + swz / 64; C = (st & 1) * 32 + (swz % 64) / 2; }
__host__ __device__ __forceinline__ int perm32(int rho) { const int n = rho >> 4, i = rho & 15; return 8 * (i >> 2) + 4 * n + (i & 3); }

struct Unit { int pm, pn, acol, bcol; };
struct Gemm { const bf16_t* A; const bf16_t* Bt; int lda, ldb, K; };

struct StaticOrder {
    int nM, nN, nwg, G, c;
    __host__ __device__ void init(int M, int N, int G_, int c_) { nM = M / BM; nN = N / BM; nwg = nM * nN; G = G_; c = c_; }
    __host__ __device__ void unit_of(int L, Unit& u) const {
        int wgid = L; { const int q = nwg / NXCD, r = nwg % NXCD, xcd = wgid % NXCD, off = wgid / NXCD; wgid = (xcd < r ? xcd * (q + 1) : r * (q + 1) + (xcd - r) * q) + off; }
        const int nig = WGM * nN, gid = wgid / nig, fm = gid * WGM, gsz = (nM - fm) < WGM ? (nM - fm) : WGM;
        u.pm = fm + ((wgid % nig) % gsz); u.pn = (wgid % nig) / gsz; u.acol = 0; u.bcol = 0;
    }
    __host__ __device__ bool next(int i, Unit& u) const { const long L = (long)i * G + c; if (L >= nwg) return false; unit_of((int)L, u); return true; }
};
struct HeadOrder : StaticOrder { int limit; __host__ __device__ bool next(int i, Unit& u) const { const long L = (long)i * G + c; if (L >= limit || L >= nwg) return false; unit_of((int)L, u); return true; } };
struct TailOrder : StaticOrder { int limit, nsplit, kper;
    __host__ __device__ bool next(int i, Unit& u) const {
        if (i > 0 || c >= (nwg - limit) * nsplit) return false;
        unit_of(limit + c / nsplit, u); u.acol = u.bcol = (c % nsplit) * kper; return true; } };
struct MergeOrder {
    int ntile, G, c;
    __host__ __device__ void init(int M, int G_, int c_) { ntile = (M / BM) * 4; G = G_; c = c_; }
    __host__ __device__ bool next(int i, Unit& u) const {
        const int T = (i >> 2) * G + c; if (T >= ntile) return false;
        const int n = i & 3; u.pm = T >> 2; u.pn = n * 4 + (T & 3); u.acol = n * 256; u.bcol = 0; return true;
    }
};

__device__ __forceinline__ unsigned cvt_pk_bf16(float lo, float hi) { unsigned r; asm volatile("v_cvt_pk_bf16_f32 %0, %1, %2" : "=v"(r) : "v"(lo), "v"(hi)); return r; }

template <class Epi, class Sched, bool ALIGN_EPI = false, bool SP2 = false, int SEG = 0>
__device__ __forceinline__ void gemm_phase(PG8_LAS unsigned char* lds, const Gemm g, const Sched& S, const Epi& E) {
    int tid_ = threadIdx.x; asm volatile("" : "+v"(tid_));
    const int tid = tid_, wid = __builtin_amdgcn_readfirstlane(tid >> 6), lane = tid & 63, wr = wid >> 2, wc = wid & 3, fr = lane & 15, fq = lane >> 4;
    const int nt = g.K / BK;
    unsigned voffA[2], voffB[2];
#pragma unroll
    for (int i = 0; i < 2; ++i) { int R, C; stage_rc(tid * 16 + i * 8192, R, C); const int Rb = Epi::PERM ? ((R & ~31) + perm32(R & 31)) : R;
        voffA[i] = (unsigned)(R * g.lda + C) * 2u; voffB[i] = (unsigned)(Rb * g.ldb + C) * 2u; }
    const size_t kstep = (size_t)(BK * 2);
    const size_t hstepA = (size_t)HALF * g.lda * 2, hstepB = (size_t)HALF * g.ldb * 2;
    const size_t tstepA = 2 * hstepA, tstepB = 2 * hstepB;
    const unsigned ldsw = (unsigned)wid * 1024u;
    const int aoff = lds_byte(wr * 64 + fr, fq * 8), boff = lds_byte(wc * 32 + fr, fq * 8);
#define PG8_SA(b, h) (((b) * 2 + (h)) * HTB)
#define PG8_SB(b, h) ((4 + (b) * 2 + (h)) * HTB)
#define PG8_STAGE(bufoff, gbase, voff) do { _Pragma("unroll") for (int _i = 0; _i < 2; ++_i) \
        __builtin_amdgcn_global_load_lds((const unsigned*)((const char*)(gbase) + (voff)[_i]), (PG8_LAS unsigned*)(lds + (bufoff) + ldsw + _i * 8192), 16, 0, 0); } while (0)
#define PG8_LDA(dst, b, h) do { _Pragma("unroll") for (int m = 0; m < 4; ++m) _Pragma("unroll") for (int k = 0; k < 2; ++k) dst[m][k] = *(const PG8_LAS bf16x8*)(lds + PG8_SA(b, h) + aoff + m * 2048 + k * 1024); } while (0)
#define PG8_LDB(dst, b, h) do { _Pragma("unroll") for (int n = 0; n < 2; ++n) _Pragma("unroll") for (int k = 0; k < 2; ++k) dst[n][k] = *(const PG8_LAS bf16x8*)(lds + PG8_SB(b, h) + boff + n * 2048 + k * 1024); } while (0)
#define PG8_MMA(ai, bj, At, Bt) do { __builtin_amdgcn_s_setprio(1); _Pragma("unroll") for (int m = 0; m < 4; ++m) _Pragma("unroll") for (int n = 0; n < 2; ++n) _Pragma("unroll") for (int k = 0; k < 2; ++k) \
        acc[ai][bj][m][n] = __builtin_amdgcn_mfma_f32_16x16x32_bf16(Bt[n][k], At[m][k], acc[ai][bj][m][n], 0, 0, 0); __builtin_amdgcn_s_setprio(0); } while (0)
#define PG8_WAIT_V(n) asm volatile("s_waitcnt vmcnt(" #n ")" ::: "memory")
#define PG8_WAIT_L(n) asm volatile("s_waitcnt lgkmcnt(" #n ")" ::: "memory")
#define PG8_BAR __builtin_amdgcn_s_barrier()
#define PG8_SCHED __builtin_amdgcn_sched_barrier(0)
    Unit cur, nxt; int ui = 0;
    if (!S.next(0, cur)) return;
    f32x4 acc[2][2][4][2];
#pragma unroll
    for (int a = 0; a < 2; ++a)
#pragma unroll
        for (int b = 0; b < 2; ++b)
#pragma unroll
            for (int m = 0; m < 4; ++m)
#pragma unroll
                for (int n = 0; n < 2; ++n) acc[a][b][m][n] = (f32x4){0.f, 0.f, 0.f, 0.f};
    bf16x8 At[4][2], B0[2][2], B1[2][2];
    const char* cA = (const char*)g.A + (size_t)cur.pm * tstepA + (size_t)cur.acol * 2; const char* cB = (const char*)g.Bt + (size_t)cur.pn * tstepB + (size_t)cur.bcol * 2;
    if constexpr (SP2) {
        PG8_STAGE(PG8_SB(0, 0), cB, voffB); PG8_STAGE(PG8_SB(0, 1), cB + hstepB, voffB); PG8_STAGE(PG8_SA(0, 0), cA, voffA); PG8_STAGE(PG8_SA(0, 1), cA + hstepA, voffA);
        if (wr == 1) PG8_BAR;
        PG8_WAIT_V(2); PG8_BAR;
        PG8_STAGE(PG8_SB(1, 0), cB + kstep, voffB); PG8_STAGE(PG8_SA(1, 0), cA + kstep, voffA); PG8_STAGE(PG8_SB(1, 1), cB + hstepB + kstep, voffB);
        PG8_WAIT_V(6); PG8_BAR;
    } else {
        PG8_STAGE(PG8_SB(0, 0), cB, voffB); PG8_STAGE(PG8_SA(0, 0), cA, voffA); PG8_STAGE(PG8_SB(0, 1), cB + hstepB, voffB); PG8_STAGE(PG8_SA(0, 1), cA + hstepA, voffA);
        if (wr == 1) PG8_BAR;
        PG8_WAIT_V(4); PG8_BAR;
        PG8_STAGE(PG8_SB(1, 0), cB + kstep, voffB); PG8_STAGE(PG8_SA(1, 0), cA + kstep, voffA); PG8_STAGE(PG8_SB(1, 1), cB + hstepB + kstep, voffB);
        PG8_WAIT_V(6); PG8_BAR;
    }
    for (;;) {
        const bool has_next = S.next(ui + 1, nxt);
        const char* nA = has_next ? (const char*)g.A + (size_t)nxt.pm * tstepA + (size_t)nxt.acol * 2 : cA; const char* nB = has_next ? (const char*)g.Bt + (size_t)nxt.pn * tstepB + (size_t)nxt.bcol * 2 : cB;
        for (int t = 0; t < nt; t += 2) {
            const bool last = (t == nt - 2);
            const char* a1 = cA + (size_t)(t + 1) * kstep;
            const char* a2 = last ? nA : cA + (size_t)(t + 2) * kstep; const char* b2 = last ? nB : cB + (size_t)(t + 2) * kstep;
            const char* a3 = a2 + kstep; const char* b3 = b2 + kstep;
            if constexpr (SP2) {
            PG8_LDB(B0, 0, 0); PG8_LDB(B1, 0, 1); PG8_SCHED; PG8_LDA(At, 0, 0); PG8_STAGE(PG8_SA(1, 1), a1 + hstepA, voffA);
            PG8_WAIT_V(8); PG8_WAIT_L(0); PG8_BAR; PG8_MMA(0, 0, At, B0); PG8_MMA(0, 1, At, B1); PG8_BAR; PG8_SCHED;
            PG8_LDA(At, 0, 1); PG8_STAGE(PG8_SB(0, 0), b2, voffB); PG8_STAGE(PG8_SB(0, 1), b2 + hstepB, voffB); PG8_STAGE(PG8_SA(0, 0), a2, voffA);
            PG8_WAIT_V(8); PG8_WAIT_L(0); PG8_BAR; PG8_MMA(1, 0, At, B0); PG8_MMA(1, 1, At, B1); PG8_BAR; PG8_SCHED;
            PG8_LDB(B0, 1, 0); PG8_LDB(B1, 1, 1); PG8_SCHED; PG8_LDA(At, 1, 0); PG8_STAGE(PG8_SA(0, 1), a2 + hstepA, voffA);
            PG8_WAIT_V(8); PG8_WAIT_L(0); PG8_BAR; PG8_MMA(0, 0, At, B0); PG8_MMA(0, 1, At, B1); PG8_BAR; PG8_SCHED;
            PG8_LDA(At, 1, 1); PG8_STAGE(PG8_SB(1, 0), b3, voffB); PG8_STAGE(PG8_SB(1, 1), b3 + hstepB, voffB); PG8_STAGE(PG8_SA(1, 0), a3, voffA);
            PG8_WAIT_V(8); PG8_WAIT_L(0); PG8_BAR; PG8_MMA(1, 0, At, B0); PG8_MMA(1, 1, At, B1); PG8_BAR; PG8_SCHED;
            } else {
            PG8_LDB(B0, 0, 0); PG8_SCHED; PG8_LDA(At, 0, 0); PG8_STAGE(PG8_SA(1, 1), a1 + hstepA, voffA);
            PG8_WAIT_L(8); PG8_BAR; PG8_WAIT_L(0); PG8_MMA(0, 0, At, B0); PG8_BAR; PG8_SCHED;
            PG8_LDB(B1, 0, 1); PG8_STAGE(PG8_SB(0, 0), b2, voffB);
            PG8_BAR; PG8_WAIT_L(0); PG8_MMA(0, 1, At, B1); PG8_BAR;
            PG8_LDA(At, 0, 1); PG8_STAGE(PG8_SA(0, 0), a2, voffA);
            PG8_BAR; PG8_WAIT_L(0); PG8_MMA(1, 0, At, B0); PG8_BAR; PG8_SCHED;
            PG8_STAGE(PG8_SB(0, 1), b2 + hstepB, voffB);
            PG8_WAIT_V(6); PG8_BAR; PG8_MMA(1, 1, At, B1); PG8_BAR;
            PG8_LDB(B0, 1, 0); PG8_SCHED; PG8_LDA(At, 1, 0); PG8_STAGE(PG8_SA(0, 1), a2 + hstepA, voffA);
            PG8_WAIT_L(8); PG8_BAR; PG8_WAIT_L(0); PG8_MMA(0, 0, At, B0); PG8_BAR; PG8_SCHED;
            PG8_LDB(B1, 1, 1); PG8_STAGE(PG8_SB(1, 0), b3, voffB);
            PG8_BAR; PG8_WAIT_L(0); PG8_MMA(0, 1, At, B1); PG8_BAR;
            PG8_LDA(At, 1, 1); PG8_STAGE(PG8_SA(1, 0), a3, voffA);
            PG8_BAR; PG8_WAIT_L(0); PG8_MMA(1, 0, At, B0); PG8_BAR; PG8_SCHED;
            PG8_STAGE(PG8_SB(1, 1), b3 + hstepB, voffB);
            PG8_WAIT_V(6); PG8_BAR; PG8_MMA(1, 1, At, B1); PG8_BAR;
            }
            if constexpr (SEG > 0) { if (((t + 2) % SEG) == 0 && (t + 2) < nt) E.mid(acc, cur, (t + 2) / SEG); }
        }
        if constexpr (ALIGN_EPI) { if (wr == 0) PG8_BAR; }
        E(acc, cur, wr, wc, fr, fq);
        if (!has_next) break;
#pragma unroll
        for (int a = 0; a < 2; ++a)
#pragma unroll
            for (int b = 0; b < 2; ++b)
#pragma unroll
                for (int m = 0; m < 4; ++m)
#pragma unroll
                    for (int n = 0; n < 2; ++n) acc[a][b][m][n] = (f32x4){0.f, 0.f, 0.f, 0.f};
        cur = nxt; cA = nA; cB = nB; ++ui;
        if constexpr (ALIGN_EPI) { if (wr == 1) PG8_BAR; }
    }
    PG8_WAIT_V(0);
    if constexpr (!ALIGN_EPI) { if (wr == 0) PG8_BAR; }
    PG8_BAR;
#undef PG8_SA
#undef PG8_SB
#undef PG8_STAGE
#undef PG8_LDA
#undef PG8_LDB
#undef PG8_MMA
#undef PG8_WAIT_V
#undef PG8_WAIT_L
#undef PG8_BAR
#undef PG8_SCHED
}
}

constexpr int NWAVES = 8;
constexpr int D = 1024, DFF = 2816, NIN = 7184, NMIX = 3088, NMIXP = 3328, NGATE = 4096, NINP = NMIXP + NGATE;
constexpr int SEQ = 4096, NMETA = 16, L = SEQ + NMETA, BATCH = 4, DB = 32, DS = 8, PAST = 8192, PAGE = 128, NPAGES = PAST / PAGE, NPOOL = 2560, DEPTH = 2;
constexpr int MP = BATCH * L, MS = DB * DS, MR = MP + MS, M = 16896;
constexpr int NPOS = L + DS;
constexpr float EPS = 1e-6f;
constexpr int C_A = 0, C_G = 256, R_Q = 512, R_K = 768, R_V = 1024, R_G = 1280, G_Q = 1536, G_K = 1664, G_V = 1792, G_R = 2048, G_LOW = 2304, D_Q = 2320, D_K = 2576, D_V = 2832;
constexpr size_t O_YP = 0, O_YS = O_YP + (size_t)BATCH * SEQ * D, O_KP = O_YS + (size_t)MS * D, O_VP = O_KP + (size_t)DEPTH * MP * 256, O_KS = O_VP + (size_t)DEPTH * MP * 256,
                 O_VS = O_KS + (size_t)DEPTH * MS * 256, O_RP = O_VS + (size_t)DEPTH * MS * 256, O_RS = O_RP + (size_t)DEPTH * BATCH * 4 * 64 * 64, O_GP = O_RS + (size_t)DEPTH * DB * 4 * 64 * 64,
                 O_GS = O_GP + (size_t)DEPTH * BATCH * 4 * 32 * 64, O_CP = O_GS + (size_t)DEPTH * DB * 4 * 32 * 64, O_CS = O_CP + (size_t)DEPTH * BATCH * 30 * 256, O_END = O_CS + (size_t)DEPTH * DB * 30 * 256;
enum { I_XP = 0, I_XS, I_CK, I_CV, I_PT, I_SRET, I_SGLA, I_SCONV, I_META, I_RELB, I_NF1, I_F1G, I_F1U, I_F1D, I_NMIX, I_WIN, I_BIN, I_CW, I_CB, I_CLG, I_CLB, I_RGN, I_GAW, I_GAB, I_GGN,
       I_QN, I_KN, I_LQ1, I_LK1, I_LQ2, I_LK2, I_SUBLN, I_WBR, I_WOUT, I_NF2, I_F2G, I_F2U, I_F2D, N_INPUTS };

constexpr size_t MiB = 1u << 20;
constexpr size_t WS_CTL = 0, CTL_ZERO_BYTES = 1 * MiB;
constexpr size_t SZ_SS = (size_t)M * 16 * 4;
constexpr size_t SZ_W1 = (size_t)2 * DFF * D * 2, SZ_WD = (size_t)D * DFF * 2, SZ_WIN = (size_t)NINP * D * 2, SZ_WBR = (size_t)4 * D * 256 * 2, SZ_WOUT = (size_t)D * D * 2;
constexpr size_t WS_W1 = 4 * MiB;
constexpr size_t WS_WD = WS_W1 + 4 * SZ_W1;
constexpr size_t WS_WIN = WS_WD + 4 * SZ_WD;
constexpr size_t WS_WBR = WS_WIN + 2 * SZ_WIN;
constexpr size_t WS_WOUT = WS_WBR + 2 * SZ_WBR;
constexpr size_t WS_BINP = WS_WOUT + 2 * SZ_WOUT;
constexpr size_t WS_ROPE = WS_BINP + 64 * 1024;
constexpr size_t WS_SS = WS_ROPE + 2 * MiB;
constexpr size_t WS_H = 128 * MiB;
constexpr size_t WS_HB = WS_H + (size_t)M * D * 4;
constexpr size_t WS_ACT = WS_HB + (size_t)M * D * 2;
constexpr size_t WS_ZMIX = WS_ACT + (size_t)M * DFF * 2;
constexpr size_t WS_GATES = WS_ZMIX + (size_t)M * NMIXP * 2;
constexpr size_t WS_BR = WS_GATES + (size_t)M * NGATE * 2;
constexpr size_t WS_MERGED = WS_BR + (size_t)M * D * 2;
constexpr size_t WS_UBUF = WS_MERGED + (size_t)M * D * 2;
constexpr size_t WS_RQ = WS_UBUF + (size_t)M * 256 * 4, WS_RK = WS_RQ + (size_t)M * 256 * 4, WS_QN = WS_RK + (size_t)M * 256 * 4, WS_KN = WS_QN + (size_t)M * 256 * 4, WS_VB = WS_KN + (size_t)M * 256 * 4;
constexpr size_t WS_LDEC = WS_VB + (size_t)M * 256 * 4;
constexpr size_t WS_QNB = WS_LDEC + (size_t)M * 128 * 4;
constexpr size_t WS_KNB = WS_QNB + (size_t)M * 256 * 2;
constexpr size_t WS_PART = WS_KNB + (size_t)M * 256 * 2;
constexpr size_t WS_LAO = WS_PART + (size_t)DB * 4 * 16 * 16 * 68 * 4;
constexpr size_t WS_KSP = WS_LAO + (size_t)M * 512 * 4;
constexpr size_t WS_END = WS_KSP + (size_t)8 * 11 * 65536 * 4;
static_assert(WS_ROPE + 2 * NPOS * 32 * 4 <= WS_SS && WS_SS + 6 * SZ_SS <= WS_H, "weights region overflows");
constexpr int CW_BAR = 4096, CW_QUEUE = 8192;

constexpr int RING_OFF = 0, RING_BYTES = 131072;
constexpr int LDSCTL_OFF = 144384, MISC_OFF = LDSCTL_OFF + 320;
constexpr int LDS_BYTES = 147456;
static_assert(MISC_OFF + 128 <= LDS_BYTES, "LDS map");

#define GAS __attribute__((address_space(1)))
#define LAS __attribute__((address_space(3)))
typedef unsigned short bf16;
typedef unsigned v4u __attribute__((ext_vector_type(4)));
typedef float f32x4 __attribute__((ext_vector_type(4)));
#define LDS_WAIT() asm volatile("s_waitcnt lgkmcnt(0)" ::: "memory")
#define VM_WAIT() asm volatile("s_waitcnt vmcnt(0)" ::: "memory")
__device__ __forceinline__ unsigned f2bf(float f) { unsigned u = __builtin_bit_cast(unsigned, f); return (u + 0x7fffu + ((u >> 16) & 1u)) >> 16; }
__device__ __forceinline__ unsigned pk2(float lo, float hi) { return f2bf(lo) | (f2bf(hi) << 16); }
__device__ __forceinline__ float bf2f(bf16 b) { return __builtin_bit_cast(float, ((unsigned)b) << 16); }
__device__ __forceinline__ float bflo(unsigned w) { return __builtin_bit_cast(float, w << 16); }
__device__ __forceinline__ float bfhi(unsigned w) { return __builtin_bit_cast(float, w & 0xffff0000u); }
__device__ __forceinline__ float wave_sum(float v) {
#pragma unroll
    for (int o = 1; o < 64; o <<= 1) v += __shfl_xor(v, o);
    return v;
}
__device__ __forceinline__ float sigmoidf_(float x) { return __builtin_amdgcn_rcpf(1.0f + __expf(-x)); }
__device__ __forceinline__ float siluf_(float x) { return x * __builtin_amdgcn_rcpf(1.0f + __expf(-x)); }

#define XB_TMO      128
#define XB_XCNT(j)  (256  + 64 * (j))
#define XB_XSUB(j)  (1280 + 64 * (j))
#define XB_XGEN(j)  (2304 + 64 * (j))
#define XB_TOP      3328
#define XB_TOPGEN   3392
#define XCD_BAR_WORDS 3456
#define XB_SPIN_CAP (1u << 22)

__device__ __forceinline__ unsigned xb_ld(unsigned* p)              { return __hip_atomic_load(p, __ATOMIC_RELAXED, __HIP_MEMORY_SCOPE_AGENT); }
__device__ __forceinline__ unsigned xb_add(unsigned* p, unsigned v) { return __hip_atomic_fetch_add(p, v, __ATOMIC_RELAXED, __HIP_MEMORY_SCOPE_AGENT); }
__device__ __forceinline__ unsigned xb_xcc_id() { return (unsigned)__builtin_amdgcn_s_getreg((3 << 11) | 20) & 0xFu; }
#define XB_SPIN(cond, bar) do { unsigned _sp = 0; while (cond) { __builtin_amdgcn_s_sleep(1); \
    if ((++_sp & 255u) == 0u) { if (xb_ld(&(bar)[XB_TMO])) break; if (_sp > XB_SPIN_CAP) { atomicAdd(&(bar)[XB_TMO], 1u); break; } } } } while (0)

struct XcdBarrier { unsigned* bar; unsigned x; volatile LAS unsigned* st; };

__device__ __forceinline__ XcdBarrier xcd_barrier_post(unsigned* bar, volatile LAS unsigned* st) {
    XcdBarrier b; b.bar = bar; b.x = xb_xcc_id(); b.st = st;
    if (threadIdx.x == 0) (void)xb_add(&bar[XB_XCNT(b.x)], 1u);
    return b;
}
__device__ __forceinline__ void xcd_barrier_complete(unsigned* bar, unsigned x, unsigned& nloc, unsigned& nx) {
    const unsigned G = gridDim.x * gridDim.y * gridDim.z;
    unsigned sum, cnt, mine, sp = 0u;
    for (;;) {
        sum = 0u; cnt = 0u; mine = 0u;
#pragma unroll
        for (unsigned j = 0; j < 16; ++j) { const unsigned c = xb_ld(&bar[XB_XCNT(j)]); sum += c; cnt += (c > 0u) ? 1u : 0u; mine = (j == x) ? c : mine; }
        if (sum == G) break;
        __builtin_amdgcn_s_sleep(1);
        if ((++sp & 255u) == 0u) { if (xb_ld(&bar[XB_TMO])) break; if (sp > XB_SPIN_CAP) { atomicAdd(&bar[XB_TMO], 1u); break; } }
    }
    nloc = mine > 0u ? mine : 1u; nx = cnt > 0u ? cnt : 1u;
}
#ifndef FLAT_BAR
#define FLAT_BAR 0
#endif
__device__ __forceinline__ void flat_barrier(const XcdBarrier& b) {
    asm volatile("s_waitcnt vmcnt(0)" ::: "memory");
    __syncthreads();
    if (threadIdx.x == 0) {
        unsigned* bar = b.bar;
        asm volatile("" : "+s"(bar));
        const unsigned epoch = b.st[2] + 1u; b.st[2] = epoch; const unsigned target = epoch * gridDim.x;
        __builtin_amdgcn_fence(__ATOMIC_RELEASE, "agent");
        asm volatile("s_waitcnt vmcnt(0)" ::: "memory");
        (void)xb_add(&bar[XB_TOP], 1u);
        unsigned sp = 0u;
        while (xb_ld(&bar[XB_TOP]) < target) { __builtin_amdgcn_s_sleep(1); if ((++sp & 255u) == 0u) { if (xb_ld(&bar[XB_TMO])) break; if (sp > XB_SPIN_CAP) { atomicAdd(&bar[XB_TMO], 1u); break; } } }
        __builtin_amdgcn_fence(__ATOMIC_ACQUIRE, "agent");
        asm volatile("s_waitcnt vmcnt(0)" ::: "memory");
    }
    __syncthreads();
}
template <bool FIRST> __device__ __forceinline__ void xcd_barrier(const XcdBarrier& b) {
    if (FLAT_BAR) { flat_barrier(b); return; }
    asm volatile("s_waitcnt vmcnt(0)" ::: "memory");
    __syncthreads();
    if (threadIdx.x == 0) {
        unsigned* bar = b.bar;
        asm volatile("" : "+s"(bar));
        __builtin_amdgcn_s_waitcnt(0);
        unsigned nloc = b.st[0], nx = b.st[1];
        if (FIRST) { if (nloc == 0u) { xcd_barrier_complete(bar, b.x, nloc, nx); b.st[0] = nloc; b.st[1] = nx; } }
        const unsigned old = xb_add(&bar[XB_XSUB(b.x)], 1u);
        const unsigned gen = old / nloc;
        if (old + 1u == (gen + 1u) * nloc) {
            __builtin_amdgcn_fence(__ATOMIC_RELEASE, "agent");
            asm volatile("s_waitcnt vmcnt(0)" ::: "memory");
            const unsigned og = xb_add(&bar[XB_TOP], 1u);
            const unsigned tg = og / nx;
            if (og + 1u == (tg + 1u) * nx) xb_add(&bar[XB_TOPGEN], 1u);
            else XB_SPIN(xb_ld(&bar[XB_TOPGEN]) == tg, bar);
            __builtin_amdgcn_fence(__ATOMIC_ACQUIRE, "agent");
            xb_add(&bar[XB_XGEN(b.x)], 1u);
            asm volatile("s_waitcnt vmcnt(0)" ::: "memory");
        } else {
            XB_SPIN(xb_ld(&bar[XB_XGEN(b.x)]) == gen, bar);
            __builtin_amdgcn_fence(__ATOMIC_ACQUIRE, "agent");
            asm volatile("s_waitcnt vmcnt(0)" ::: "memory");
        }
    }
    __syncthreads();
}

struct Params { const float* in[N_INPUTS]; float* out; unsigned char* ws; float inv_freq[32]; };
static_assert(sizeof(Params) == N_INPUTS * 8 + 16 + 128, "Params has no padding");

struct Ctx {
    const float* const* in; float* out; unsigned char* ws;
    LAS unsigned char* lds;
    int G;
};
#define THREAD_IDS() int tid_ = threadIdx.x; asm volatile("" : "+v"(tid_)); const int tid = tid_, lane = tid & 63, wave = __builtin_amdgcn_readfirstlane(tid >> 6), gw = blockIdx.x * NWAVES + wave, NGW = C.G * NWAVES; (void)tid; (void)lane; (void)wave; (void)gw; (void)NGW
#define WSP(T, off) ((T*)(C.ws + (off)))

__device__ __forceinline__ float rstd_of(const float* ssp, int row) {
    const f32x4 a = *(const f32x4*)(ssp + (size_t)row * 16), b = *(const f32x4*)(ssp + (size_t)row * 16 + 4), c = *(const f32x4*)(ssp + (size_t)row * 16 + 8), d = *(const f32x4*)(ssp + (size_t)row * 16 + 12);
    const float s = (((a[0] + a[1]) + (a[2] + a[3])) + ((b[0] + b[1]) + (b[2] + b[3]))) + (((c[0] + c[1]) + (c[2] + c[3])) + ((d[0] + d[1]) + (d[2] + d[3])));
    return rsqrtf(s * (1.0f / D) + EPS);
}
#define EPI_IDS() int t_ = threadIdx.x; asm volatile("" : "+v"(t_)); const int wid_ = __builtin_amdgcn_readfirstlane(t_ >> 6), wr = wid_ >> 2, wc = wid_ & 3, fr = t_ & 15, fq = (t_ & 63) >> 4
struct EpiGLU {
    static constexpr bool PERM = true;
    bf16* act; const float* ss;
    __device__ __forceinline__ void operator()(const pg8::f32x4 (&acc)[2][2][4][2], const pg8::Unit& u, int, int, int, int) const {
        EPI_IDS();
        const int row0 = u.pm * 256 + wr * 64 + fr, col0 = u.pn * 128 + wc * 32 + 8 * fq;
#pragma unroll
        for (int ai = 0; ai < 2; ++ai)
#pragma unroll
            for (int m = 0; m < 4; ++m) {
                const int row = row0 + ai * 128 + m * 16; const float rstd = rstd_of(ss, row);
                float o[8];
#pragma unroll
                for (int n = 0; n < 2; ++n)
#pragma unroll
                    for (int j = 0; j < 4; ++j) { const float g = acc[ai][0][m][n][j] * rstd, up = acc[ai][1][m][n][j] * rstd; o[n * 4 + j] = siluf_(g) * up; }
                v4u w; w.x = pg8::cvt_pk_bf16(o[0], o[1]); w.y = pg8::cvt_pk_bf16(o[2], o[3]); w.z = pg8::cvt_pk_bf16(o[4], o[5]); w.w = pg8::cvt_pk_bf16(o[6], o[7]);
                *(v4u*)(act + (size_t)row * DFF + col0) = w;
            }
    }
};
template <bool FINAL, int SCALE2> struct EpiRes {
    static constexpr bool PERM = true;
    float* h; bf16* hb; float* ssout; float* out;
    __device__ __forceinline__ void rowgroup(const pg8::f32x4 (&a)[2][2], int row, int col0, int pn, int wc, int fq) const {
        constexpr float scale = 0.5f * SCALE2; float sq = 0.f;
        long yoff = -1;
        if (FINAL) { if (row < MP) { const int b = row / L, pos = row - b * L; if (pos >= NMETA) yoff = (long)O_YP + ((long)b * SEQ + (pos - NMETA)) * D; } else if (row < MR) yoff = (long)O_YS + (long)(row - MP) * D; }
#pragma unroll
        for (int bj = 0; bj < 2; ++bj) {
            const size_t off = (size_t)row * D + col0 + bj * 128;
            f32x4 h0 = *(const f32x4*)(h + off), h1 = *(const f32x4*)(h + off + 4);
            h0 = h0 + a[bj][0] * scale; h1 = h1 + a[bj][1] * scale;
            *(f32x4*)(h + off) = h0; *(f32x4*)(h + off + 4) = h1;
            v4u w; w.x = pg8::cvt_pk_bf16(h0[0], h0[1]); w.y = pg8::cvt_pk_bf16(h0[2], h0[3]); w.z = pg8::cvt_pk_bf16(h1[0], h1[1]); w.w = pg8::cvt_pk_bf16(h1[2], h1[3]);
            *(v4u*)(hb + off) = w;
            sq += (h0[0] * h0[0] + h0[1] * h0[1]) + (h0[2] * h0[2] + h0[3] * h0[3]) + (h1[0] * h1[0] + h1[1] * h1[1]) + (h1[2] * h1[2] + h1[3] * h1[3]);
            if (FINAL && yoff >= 0) { *(f32x4*)(out + yoff + col0 + bj * 128) = h0; *(f32x4*)(out + yoff + col0 + bj * 128 + 4) = h1; }
        }
        sq += __shfl_xor(sq, 16); sq += __shfl_xor(sq, 32);
        if (fq == 0 && ssout) ssout[(size_t)row * 16 + pn * 4 + wc] = sq;
    }
    __device__ __forceinline__ void operator()(const pg8::f32x4 (&acc)[2][2][4][2], const pg8::Unit& u, int, int, int, int) const {
        EPI_IDS();
        const int row0 = u.pm * 256 + wr * 64 + fr, col0 = u.pn * 256 + wc * 32 + 8 * fq;
#pragma unroll
        for (int ai = 0; ai < 2; ++ai)
#pragma unroll
            for (int m = 0; m < 4; ++m) {
                const pg8::f32x4 a[2][2] = {{acc[ai][0][m][0], acc[ai][0][m][1]}, {acc[ai][1][m][0], acc[ai][1][m][1]}};
                rowgroup(a, row0 + ai * 128 + m * 16, col0, u.pn, wc, fq);
                if (m == 3) asm volatile("" ::: "memory");
            }
    }
};
struct EpiZ {
    static constexpr bool PERM = true;
    bf16* zmix; bf16* gates; const float* ss; const float* bias;
    __device__ __forceinline__ void operator()(const pg8::f32x4 (&acc)[2][2][4][2], const pg8::Unit& u, int, int, int, int) const {
        EPI_IDS();
        const int row0 = u.pm * 256 + wr * 64 + fr, col0 = u.pn * 256 + wc * 32 + 8 * fq; const bool isgate = u.pn >= NMIXP / 256;
        f32x4 bv[2][2];
#pragma unroll
        for (int bj = 0; bj < 2; ++bj)
#pragma unroll
            for (int n = 0; n < 2; ++n) bv[bj][n] = *(const f32x4*)(bias + col0 + bj * 128 + 4 * n);
#pragma unroll
        for (int ai = 0; ai < 2; ++ai)
#pragma unroll
            for (int m = 0; m < 4; ++m) {
                const int row = row0 + ai * 128 + m * 16; const float rstd = rstd_of(ss, row);
#pragma unroll
                for (int bj = 0; bj < 2; ++bj) {
                    f32x4 v0 = acc[ai][bj][m][0] * rstd + bv[bj][0], v1 = acc[ai][bj][m][1] * rstd + bv[bj][1];
                    if (isgate) {
#pragma unroll
                        for (int j = 0; j < 4; ++j) { v0[j] = fmaxf(sigmoidf_(v0[j]), 9.094947017729282e-13f); v1[j] = fmaxf(sigmoidf_(v1[j]), 9.094947017729282e-13f); } }
                    v4u w; w.x = pg8::cvt_pk_bf16(v0[0], v0[1]); w.y = pg8::cvt_pk_bf16(v0[2], v0[3]); w.z = pg8::cvt_pk_bf16(v1[0], v1[1]); w.w = pg8::cvt_pk_bf16(v1[2], v1[3]);
                    if (isgate) *(v4u*)(gates + (size_t)row * NGATE + (col0 - NMIXP) + bj * 128) = w;
                    else *(v4u*)(zmix + (size_t)row * NMIXP + col0 + bj * 128) = w;
                }
            }
    }
};
struct EpiMerge {
    static constexpr bool PERM = true;
    bf16* merged; const bf16* gates;
    __device__ __forceinline__ void operator()(const pg8::f32x4 (&acc)[2][2][4][2], const pg8::Unit& u, int, int, int, int) const {
        EPI_IDS();
        const int n = u.pn >> 2, dt = u.pn & 3;
        const int row0 = u.pm * 256 + wr * 64 + fr, col0 = dt * 256 + wc * 32 + 8 * fq;
#pragma unroll
        for (int ai = 0; ai < 2; ++ai)
#pragma unroll
            for (int m = 0; m < 4; ++m) {
                const int row = row0 + ai * 128 + m * 16;
#pragma unroll
                for (int bj = 0; bj < 2; ++bj) {
                    const v4u gw = *(const v4u*)(gates + (size_t)row * NGATE + n * D + col0 + bj * 128);
                    bf16* mp = merged + (size_t)row * D + col0 + bj * 128;
                    float o[8];
                    o[0] = acc[ai][bj][m][0][0] * bflo(gw.x); o[1] = acc[ai][bj][m][0][1] * bfhi(gw.x); o[2] = acc[ai][bj][m][0][2] * bflo(gw.y); o[3] = acc[ai][bj][m][0][3] * bfhi(gw.y);
                    o[4] = acc[ai][bj][m][1][0] * bflo(gw.z); o[5] = acc[ai][bj][m][1][1] * bfhi(gw.z); o[6] = acc[ai][bj][m][1][2] * bflo(gw.w); o[7] = acc[ai][bj][m][1][3] * bfhi(gw.w);
                    if (n > 0) { const v4u pw = *(const v4u*)mp;
                        o[0] += bflo(pw.x); o[1] += bfhi(pw.x); o[2] += bflo(pw.y); o[3] += bfhi(pw.y); o[4] += bflo(pw.z); o[5] += bfhi(pw.z); o[6] += bflo(pw.w); o[7] += bfhi(pw.w); }
                    v4u w; w.x = pg8::cvt_pk_bf16(o[0], o[1]); w.y = pg8::cvt_pk_bf16(o[2], o[3]); w.z = pg8::cvt_pk_bf16(o[4], o[5]); w.w = pg8::cvt_pk_bf16(o[6], o[7]);
                    *(v4u*)mp = w;
                }
                if (m == 3) asm volatile("" ::: "memory");
            }
    }
};

struct EpiPartial {
    static constexpr bool PERM = true;
    float* part;
    __device__ __forceinline__ void operator()(const pg8::f32x4 (&acc)[2][2][4][2], const pg8::Unit& u, int, int, int, int) const {
        int t_ = threadIdx.x; asm volatile("" : "+v"(t_));
        const int slot = blockIdx.x;
        float* p = part + (size_t)slot * 65536 + (size_t)t_ * 4;
#pragma unroll
        for (int ai = 0; ai < 2; ++ai)
#pragma unroll
            for (int bj = 0; bj < 2; ++bj)
#pragma unroll
                for (int m = 0; m < 4; ++m)
#pragma unroll
                    for (int n = 0; n < 2; ++n) *(pg8::f32x4*)(p + (size_t)((((ai * 2 + bj) * 4 + m) * 2 + n) * 2048)) = acc[ai][bj][m][n];
        (void)u;
    }
};
template <int NSPLIT, class Epi> __device__ __forceinline__ void ksp_finalize(const float* part, const pg8::StaticOrder& so, int limit, const Epi& E) {
    const int ntail = so.nwg - limit;
    for (int it = blockIdx.x; it < ntail * 8; it += gridDim.x) {
        const int tt = it >> 3, ai = (it >> 2) & 1, m = it & 3;
        EPI_IDS();
        pg8::f32x4 a[2][2];
#pragma unroll
        for (int bj = 0; bj < 2; ++bj)
#pragma unroll
            for (int n = 0; n < 2; ++n) { pg8::f32x4 s = {0.f, 0.f, 0.f, 0.f};
#pragma unroll
                for (int k = 0; k < NSPLIT; ++k) s = s + *(const pg8::f32x4*)(part + (size_t)(tt * NSPLIT + k) * 65536 + (size_t)((((ai * 2 + bj) * 4 + m) * 2 + n) * 2048) + (size_t)t_ * 4);
                a[bj][n] = s; }
        pg8::Unit u; so.unit_of(limit + tt, u);
        E.rowgroup(a, u.pm * 256 + wr * 64 + fr + ai * 128 + m * 16, u.pn * 256 + wc * 32 + 8 * fq, u.pn, wc, fq);
    }
}

struct EpiMergeR {
    static constexpr bool PERM = true;
    bf16* merged; const bf16* gates;
    __device__ __forceinline__ void mid(pg8::f32x4 (&acc)[2][2][4][2], const pg8::Unit& u, int seg) const {
        EPI_IDS();
        const int row0 = u.pm * 256 + wr * 64 + fr, col0 = u.pn * 256 + wc * 32 + 8 * fq;
#pragma unroll
        for (int ai = 0; ai < 2; ++ai) {
#pragma unroll
            for (int m = 0; m < 4; ++m) {
                const int row = row0 + ai * 128 + m * 16;
#pragma unroll
                for (int bj = 0; bj < 2; ++bj) {
                    const bf16* gp = gates + (size_t)row * NGATE + (seg - 1) * D + col0 + bj * 128;
                    const v4u ga = *(const v4u*)gp, gb = *(const v4u*)(gp + D);
                    pg8::f32x4& a0 = acc[ai][bj][m][0]; pg8::f32x4& a1 = acc[ai][bj][m][1];
                    a0[0] *= bflo(ga.x) * __builtin_amdgcn_rcpf(bflo(gb.x)); a0[1] *= bfhi(ga.x) * __builtin_amdgcn_rcpf(bfhi(gb.x)); a0[2] *= bflo(ga.y) * __builtin_amdgcn_rcpf(bflo(gb.y)); a0[3] *= bfhi(ga.y) * __builtin_amdgcn_rcpf(bfhi(gb.y));
                    a1[0] *= bflo(ga.z) * __builtin_amdgcn_rcpf(bflo(gb.z)); a1[1] *= bfhi(ga.z) * __builtin_amdgcn_rcpf(bfhi(gb.z)); a1[2] *= bflo(ga.w) * __builtin_amdgcn_rcpf(bflo(gb.w)); a1[3] *= bfhi(ga.w) * __builtin_amdgcn_rcpf(bfhi(gb.w));
                }
            }
            asm volatile("" ::: "memory");
        }
    }
    __device__ __forceinline__ void operator()(const pg8::f32x4 (&acc)[2][2][4][2], const pg8::Unit& u, int, int, int, int) const {
        EPI_IDS();
        const int row0 = u.pm * 256 + wr * 64 + fr, col0 = u.pn * 256 + wc * 32 + 8 * fq;
#pragma unroll
        for (int ai = 0; ai < 2; ++ai)
#pragma unroll
            for (int m = 0; m < 4; ++m) {
                const int row = row0 + ai * 128 + m * 16;
#pragma unroll
                for (int bj = 0; bj < 2; ++bj) {
                    const v4u g = *(const v4u*)(gates + (size_t)row * NGATE + 3 * D + col0 + bj * 128);
                    const pg8::f32x4 a0 = acc[ai][bj][m][0], a1 = acc[ai][bj][m][1];
                    v4u w; w.x = pg8::cvt_pk_bf16(a0[0] * bflo(g.x), a0[1] * bfhi(g.x)); w.y = pg8::cvt_pk_bf16(a0[2] * bflo(g.y), a0[3] * bfhi(g.y));
                    w.z = pg8::cvt_pk_bf16(a1[0] * bflo(g.z), a1[1] * bfhi(g.z)); w.w = pg8::cvt_pk_bf16(a1[2] * bflo(g.w), a1[3] * bfhi(g.w));
                    *(v4u*)(merged + (size_t)row * D + col0 + bj * 128) = w;
                }
            }
    }
};

struct RowMap { int mode, a; __device__ __forceinline__ int operator()(int n) const { return mode == 0 ? n + a : (mode == 1 ? 256 * (n >> 7) + (n & 127) + a : (n < NMIX ? n : n + (NMIXP - NMIX))); } };
__device__ __forceinline__ void tr_item(const float* W, int K, int N, const float* gain, bf16* WT, int pitch, RowMap rm, LAS float* scr, int kb, int nb, int lane) {
    const int k0 = 64 * kb, n0 = 64 * nb; const int nn = n0 + 4 * (lane & 15), kr = lane >> 4;
    f32x4 v[16];
#pragma unroll
    for (int i = 0; i < 16; ++i) v[i] = (nn < N) ? *(const f32x4*)(W + (size_t)(k0 + 4 * i + kr) * N + nn) : (f32x4){0.f, 0.f, 0.f, 0.f};
#pragma unroll
    for (int i = 0; i < 16; ++i) { const int kk = 4 * i + kr; const float g = gain ? gain[k0 + kk] : 1.0f; LAS float* d = scr + kk * 65 + 4 * (lane & 15); d[0] = v[i][0] * g; d[1] = v[i][1] * g; d[2] = v[i][2] * g; d[3] = v[i][3] * g; }
    LDS_WAIT(); asm volatile("" ::: "memory");
    const int c = lane & 7;
#pragma unroll
    for (int j = 0; j < 8; ++j) { const int nl = (lane >> 3) + 8 * j; const int n = n0 + nl; const LAS float* s = scr + (8 * c) * 65 + nl;
        v4u o; o.x = pg8::cvt_pk_bf16(s[0 * 65], s[1 * 65]); o.y = pg8::cvt_pk_bf16(s[2 * 65], s[3 * 65]); o.z = pg8::cvt_pk_bf16(s[4 * 65], s[5 * 65]); o.w = pg8::cvt_pk_bf16(s[6 * 65], s[7 * 65]);
        if (n < N) *(v4u*)(WT + (size_t)rm(n) * pitch + k0 + 8 * c) = o; }
    LDS_WAIT(); asm volatile("" ::: "memory");
}
__device__ __forceinline__ void p0_prologue(const Ctx& C, const Params& P) {
    THREAD_IDS();
    LAS float* scr = (LAS float*)(C.lds + RING_OFF + wave * 16896);
    constexpr int I_FF = 16 * 44, I_DN = 44 * 16, I_IN = 16 * 113, I_BR = 4 * 4 * 16, I_OUT = 16 * 16;
    constexpr int PER_LAYER = 4 * I_FF + 2 * I_DN + I_IN + I_BR + I_OUT;
    for (int it = gw; it < DEPTH * PER_LAYER; it += NGW) {
        const int l = it / PER_LAYER; int r = it - l * PER_LAYER;
        bf16* W1a = WSP(bf16, WS_W1 + (size_t)(l * 2 + 0) * SZ_W1); bf16* W1b = WSP(bf16, WS_W1 + (size_t)(l * 2 + 1) * SZ_W1);
        bf16* Wda = WSP(bf16, WS_WD + (size_t)(l * 2 + 0) * SZ_WD); bf16* Wdb = WSP(bf16, WS_WD + (size_t)(l * 2 + 1) * SZ_WD);
        if (r < I_FF) { tr_item(C.in[I_F1G] + (size_t)l * D * DFF, D, DFF, C.in[I_NF1] + l * D, W1a, D, RowMap{1, 0}, scr, r / 44, r % 44, lane); continue; } r -= I_FF;
        if (r < I_FF) { tr_item(C.in[I_F1U] + (size_t)l * D * DFF, D, DFF, C.in[I_NF1] + l * D, W1a, D, RowMap{1, 128}, scr, r / 44, r % 44, lane); continue; } r -= I_FF;
        if (r < I_DN) { tr_item(C.in[I_F1D] + (size_t)l * D * DFF, DFF, D, nullptr, Wda, DFF, RowMap{0, 0}, scr, r / 16, r % 16, lane); continue; } r -= I_DN;
        if (r < I_FF) { tr_item(C.in[I_F2G] + (size_t)l * D * DFF, D, DFF, C.in[I_NF2] + l * D, W1b, D, RowMap{1, 0}, scr, r / 44, r % 44, lane); continue; } r -= I_FF;
        if (r < I_FF) { tr_item(C.in[I_F2U] + (size_t)l * D * DFF, D, DFF, C.in[I_NF2] + l * D, W1b, D, RowMap{1, 128}, scr, r / 44, r % 44, lane); continue; } r -= I_FF;
        if (r < I_DN) { tr_item(C.in[I_F2D] + (size_t)l * D * DFF, DFF, D, nullptr, Wdb, DFF, RowMap{0, 0}, scr, r / 16, r % 16, lane); continue; } r -= I_DN;
        if (r < I_IN) { tr_item(C.in[I_WIN] + (size_t)l * D * NIN, D, NIN, C.in[I_NMIX] + l * D, WSP(bf16, WS_WIN + (size_t)l * SZ_WIN), D, RowMap{2, 0}, scr, r / 113, r % 113, lane); continue; } r -= I_IN;
        if (r < I_BR) { const int n4 = r / 64, rr = r % 64; tr_item(C.in[I_WBR] + (size_t)(l * 4 + n4) * 256 * D, 256, D, nullptr, WSP(bf16, WS_WBR + (size_t)l * SZ_WBR) + n4 * 256, D, RowMap{0, 0}, scr, rr / 16, rr % 16, lane); continue; } r -= I_BR;
        tr_item(C.in[I_WOUT] + (size_t)l * D * D, D, D, nullptr, WSP(bf16, WS_WOUT + (size_t)l * SZ_WOUT), D, RowMap{0, 0}, scr, r / 16, r % 16, lane);
    }
    const int gt = gw * 64 + lane, NGT = NGW * 64;
    for (int i = gt; i < 2 * 240 * 128; i += NGT) { const int l = i / (240 * 128), r = i % (240 * 128); *(v4u*)(C.ws + WS_WIN + (size_t)l * SZ_WIN + ((size_t)NMIX * D) * 2 + (size_t)r * 16) = (v4u){0u, 0u, 0u, 0u}; }
    for (int i = gt; i < (M - MR) * 128; i += NGT) *(v4u*)(C.ws + WS_BR + (size_t)MR * D * 2 + (size_t)i * 16) = (v4u){0u, 0u, 0u, 0u};
    for (int i = gt; i < 2 * NINP; i += NGT) { const int l = i / NINP, j = i % NINP; float v = 0.f; if (j < NMIX) v = C.in[I_BIN][l * NIN + j]; else if (j >= NMIXP) v = C.in[I_BIN][l * NIN + NMIX + (j - NMIXP)]; WSP(float, WS_BINP)[i] = v; }
    for (int i = gt; i < NPOS * 32; i += NGT) { const int pi = i >> 5, fi = i & 31; const int pos = pi < L ? pi : PAST + (pi - L);
        const float angf = (float)pos * P.inv_freq[fi];
        const double a = (double)angf; const double k = rint(a * 0.15915494309189535); const double rr = (a - k * 6.283185307179586) - k * 2.4492935982947064e-16;
        const float rf = (float)rr; WSP(float, WS_ROPE)[i] = cosf(rf); WSP(float, WS_ROPE)[NPOS * 32 + i] = sinf(rf); }
    float* H = WSP(float, WS_H); bf16* HB = WSP(bf16, WS_HB); float* SS0 = WSP(float, WS_SS);
    for (int row = gw; row < M; row += NGW) {
        const float* src = nullptr;
        if (row < MP) { const int b = row / L, pos = row - b * L; src = pos < NMETA ? C.in[I_META] + (size_t)pos * D : C.in[I_XP] + ((size_t)b * SEQ + (pos - NMETA)) * D; }
        else if (row < MR) src = C.in[I_XS] + (size_t)(row - MP) * D;
        float s = 0.f;
#pragma unroll
        for (int j = 0; j < 4; ++j) { f32x4 v = src ? *(const f32x4*)(src + 256 * j + 4 * lane) : (f32x4){0.f, 0.f, 0.f, 0.f};
            *(f32x4*)(H + (size_t)row * D + 256 * j + 4 * lane) = v; s += (v[0] * v[0] + v[1] * v[1]) + (v[2] * v[2] + v[3] * v[3]);
            unsigned long long w = (unsigned long long)pk2(v[0], v[1]) | ((unsigned long long)pk2(v[2], v[3]) << 32);
            *(unsigned long long*)(HB + (size_t)row * D + 256 * j + 4 * lane) = w; }
        s = wave_sum(s); if (lane < 16) SS0[(size_t)row * 16 + lane] = lane == 0 ? s : 0.f;
    }
}

__device__ __forceinline__ float lam_of(const Ctx& C, int l, float lam_init) {
    THREAD_IDS();
    float a = 0.f, b = 0.f;
#pragma unroll 1
    for (int i = 0; i < 32; ++i) { a += C.in[I_LQ1][l * 32 + i] * C.in[I_LK1][l * 32 + i]; b += C.in[I_LQ2][l * 32 + i] * C.in[I_LK2][l * 32 + i]; }
    return __expf(a) - __expf(b) + lam_init;
}
__device__ __forceinline__ int t5_bucket(int n) {
    if (n < 16) return n;
    return 16 + (n >= 19) + (n >= 21) + (n >= 24) + (n >= 27) + (n >= 31) + (n >= 35) + (n >= 40) + (n >= 46) + (n >= 52) + (n >= 59) + (n >= 67) + (n >= 77) + (n >= 87) + (n >= 99) + (n >= 113);
}
__device__ __forceinline__ void unpack8(const v4u w, float (&x)[8]) { x[0] = bflo(w.x); x[1] = bfhi(w.x); x[2] = bflo(w.y); x[3] = bfhi(w.y); x[4] = bflo(w.z); x[5] = bfhi(w.z); x[6] = bflo(w.w); x[7] = bfhi(w.w); }
__device__ __forceinline__ v4u pack8(const float (&x)[8]) { v4u w; w.x = pg8::cvt_pk_bf16(x[0], x[1]); w.y = pg8::cvt_pk_bf16(x[2], x[3]); w.z = pg8::cvt_pk_bf16(x[4], x[5]); w.w = pg8::cvt_pk_bf16(x[6], x[7]); return w; }
__device__ __forceinline__ void n1_prep(const Ctx& C, int l) {
    THREAD_IDS();
    const bf16* ZM = WSP(bf16, WS_ZMIX); float* UB = WSP(float, WS_UBUF); float* RQ = WSP(float, WS_RQ); float* RK = WSP(float, WS_RK);
    float* LD = WSP(float, WS_LDEC); const float* COS = WSP(float, WS_ROPE); const float* SIN = COS + NPOS * 32; bf16* QNB = WSP(bf16, WS_QNB); bf16* KNB = WSP(bf16, WS_KNB);
    const int i = lane & 31;
    float qg[8], kg[8];
#pragma unroll
    for (int j = 0; j < 8; ++j) { qg[j] = C.in[I_QN][l * 32 + ((8 * i) & 31) + j] * (0.17677669529663687f * 1.4426950408889634f); kg[j] = C.in[I_KN][l * 32 + ((8 * i) & 31) + j]; }
    for (int rp = gw; rp < MR / 2; rp += NGW) {
        const int r = 2 * rp + (lane >> 5);
        const bf16* z = ZM + (size_t)r * NMIXP;
        const int pi = r < MP ? r % L : L + ((r - MP) & 7);
        float* kout = r < MP ? C.out + O_KP + ((size_t)l * MP + r) * 256 : C.out + O_KS + ((size_t)l * MS + (r - MP)) * 256;
        float* vout = r < MP ? C.out + O_VP + ((size_t)l * MP + r) * 256 : C.out + O_VS + ((size_t)l * MS + (r - MP)) * 256;
        const v4u wa = *(const v4u*)(z + C_A + 8 * i), wg = *(const v4u*)(z + C_G + 8 * i), wq = *(const v4u*)(z + D_Q + 8 * i), wk = *(const v4u*)(z + D_K + 8 * i), wv = *(const v4u*)(z + D_V + 8 * i);
        const int isk = i >> 4, hh = (i >> 2) & 3, jc = i & 3;
        const bf16* zr = z + (isk ? R_K : R_Q) + hh * 64 + 8 * jc;
        const v4u w1 = *(const v4u*)zr, w2 = *(const v4u*)(zr + 32);
        const v4u gl0 = *(const v4u*)(z + G_LOW), gl1 = *(const v4u*)(z + G_LOW + 8);
        float x[8], y[8];
        unpack8(wa, x); unpack8(wg, y);
#pragma unroll
        for (int j = 0; j < 8; ++j) x[j] *= sigmoidf_(y[j]);
        *(f32x4*)(UB + (size_t)r * 256 + 8 * i) = (f32x4){x[0], x[1], x[2], x[3]}; *(f32x4*)(UB + (size_t)r * 256 + 8 * i + 4) = (f32x4){x[4], x[5], x[6], x[7]};
        unpack8(wv, x);
        *(f32x4*)(vout + 8 * i) = (f32x4){x[0], x[1], x[2], x[3]}; *(f32x4*)(vout + 8 * i + 4) = (f32x4){x[4], x[5], x[6], x[7]};
        unpack8(wq, x);
        { float s = 0.f;
#pragma unroll
          for (int j = 0; j < 8; ++j) s += x[j] * x[j];
          s += __shfl_xor(s, 1); s += __shfl_xor(s, 2); const float rs = rsqrtf(s * (1.0f / 32) + EPS);
#pragma unroll
          for (int j = 0; j < 8; ++j) x[j] = x[j] * rs * qg[j];
          *(v4u*)(QNB + (size_t)r * 256 + 8 * i) = pack8(x); }
        unpack8(wk, x);
        { float s = 0.f;
#pragma unroll
          for (int j = 0; j < 8; ++j) s += x[j] * x[j];
          s += __shfl_xor(s, 1); s += __shfl_xor(s, 2); const float rs = rsqrtf(s * (1.0f / 32) + EPS);
#pragma unroll
          for (int j = 0; j < 8; ++j) x[j] = x[j] * rs * kg[j];
          *(v4u*)(KNB + (size_t)r * 256 + 8 * i) = pack8(x);
          *(f32x4*)(kout + 8 * i) = (f32x4){x[0], x[1], x[2], x[3]}; *(f32x4*)(kout + 8 * i + 4) = (f32x4){x[4], x[5], x[6], x[7]}; }
        unpack8(w1, x); unpack8(w2, y);
        { const f32x4 c0 = *(const f32x4*)(COS + pi * 32 + 8 * jc), c1 = *(const f32x4*)(COS + pi * 32 + 8 * jc + 4), s0 = *(const f32x4*)(SIN + pi * 32 + 8 * jc), s1 = *(const f32x4*)(SIN + pi * 32 + 8 * jc + 4);
          const float sc = isk ? 0.125f : 1.0f; float o1[8], o2[8];
#pragma unroll
          for (int j = 0; j < 8; ++j) { const float cs = j < 4 ? c0[j & 3] : c1[j & 3], sn = j < 4 ? s0[j & 3] : s1[j & 3]; o1[j] = (x[j] * cs - y[j] * sn) * sc; o2[j] = (x[j] * sn + y[j] * cs) * sc; }
          float* ro = (isk ? RK : RQ) + (size_t)r * 256 + hh * 64 + 8 * jc;
          *(f32x4*)ro = (f32x4){o1[0], o1[1], o1[2], o1[3]}; *(f32x4*)(ro + 4) = (f32x4){o1[4], o1[5], o1[6], o1[7]}; *(f32x4*)(ro + 32) = (f32x4){o2[0], o2[1], o2[2], o2[3]}; *(f32x4*)(ro + 36) = (f32x4){o2[4], o2[5], o2[6], o2[7]}; }
        { float gv[16]; unpack8(gl0, x); unpack8(gl1, y);
#pragma unroll
          for (int j = 0; j < 8; ++j) { gv[j] = x[j]; gv[8 + j] = y[j]; }
          f32x4 gp = *(const f32x4*)(C.in[I_GAB] + l * 128 + 4 * i);
#pragma unroll
          for (int k = 0; k < 16; ++k) { const f32x4 aw = *(const f32x4*)(C.in[I_GAW] + (size_t)(l * 16 + k) * 128 + 4 * i); gp = gp + aw * gv[k]; }
          f32x4 ls;
#pragma unroll
          for (int j = 0; j < 4; ++j) ls[j] = (fminf(gp[j], 0.f) - log1pf(__expf(-fabsf(gp[j])))) * (1.0f / 16.0f);
          *(f32x4*)(LD + (size_t)r * 128 + 4 * i) = ls; }
    }
}
__device__ __forceinline__ void conv_rows_item(const Ctx& C, int l, int item) {
    THREAD_IDS();
    const float* UB = WSP(float, WS_UBUF); bf16* BR = WSP(bf16, WS_BR);
    const float* cw = C.in[I_CW] + (size_t)l * 31 * 256; const float* sc = C.in[I_SCONV];
    LAS float* wl = (LAS float*)C.lds;
    for (int i = tid; i < 31 * 256; i += NWAVES * 64) wl[i] = cw[i];
    LDS_WAIT(); __builtin_amdgcn_s_barrier(); asm volatile("" ::: "memory");
    const int r0 = item * 64 + wave * 8;
    if (r0 < MR) {
        const bool smp = r0 >= MP; const int b = smp ? (r0 - MP) >> 3 : r0 / L; const int p0 = smp ? 0 : r0 - b * L; const int rb = smp ? MP + b * 8 : b * L;
        float acc[8][4];
#pragma unroll
        for (int i = 0; i < 8; ++i)
#pragma unroll
            for (int k = 0; k < 4; ++k) acc[i][k] = C.in[I_CB][l * 256 + lane + 64 * k];
#pragma unroll 1
        for (int jb = 0; jb < 40; jb += 8) {
            float uv[8][4];
#pragma unroll
            for (int jj = 0; jj < 8; ++jj) { const int j = jb + jj; const int q = p0 - 30 + j;
#pragma unroll
                for (int k = 0; k < 4; ++k) { const int c = lane + 64 * k;
                    uv[jj][k] = j >= 38 ? 0.f : (q >= 0 ? UB[(size_t)(rb + q) * 256 + c] : (smp ? sc[(((size_t)l * DB + b) * 30 + (q + 30)) * 256 + c] : 0.f)); } }
#pragma unroll
            for (int jj = 0; jj < 8; ++jj)
#pragma unroll
                for (int i = 0; i < 8; ++i) { const int t = jb + jj - i;
                    if (t >= 0 && t <= 30) {
#pragma unroll
                        for (int k = 0; k < 4; ++k) acc[i][k] += wl[t * 256 + lane + 64 * k] * uv[jj][k]; } }
        }
#pragma unroll
        for (int i = 0; i < 8; ++i) { const int r = r0 + i;
            float s = (acc[i][0] + acc[i][1]) + (acc[i][2] + acc[i][3]); const float mean = wave_sum(s) * (1.0f / 256);
            float q2 = 0.f;
#pragma unroll
            for (int k = 0; k < 4; ++k) { acc[i][k] -= mean; q2 += acc[i][k] * acc[i][k]; }
            const float rstd = rsqrtf(wave_sum(q2) * (1.0f / 256) + EPS);
#pragma unroll
            for (int k = 0; k < 4; ++k) { const int c = lane + 64 * k; const float y = acc[i][k] * rstd * C.in[I_CLG][l * 256 + c] + C.in[I_CLB][l * 256 + c]; BR[(size_t)r * D + c] = (bf16)f2bf(siluf_(y)); } }
    }
    LDS_WAIT(); __builtin_amdgcn_s_barrier(); asm volatile("" ::: "memory");
}
__device__ __forceinline__ void conv_state_item(const Ctx& C, int l, int part, int nparts) {
    THREAD_IDS();
    const float* UB = WSP(float, WS_UBUF); const float* sc = C.in[I_SCONV];
    for (int i = part * NWAVES * 64 + tid; i < BATCH * 30 * 256; i += nparts * NWAVES * 64) { const int c = i & 255, ii = (i >> 8) % 30, b = i / (30 * 256); C.out[O_CP + (size_t)l * BATCH * 30 * 256 + i] = UB[(size_t)(b * L + L - 30 + ii) * 256 + c]; }
    for (int i = part * NWAVES * 64 + tid; i < DB * 30 * 256; i += nparts * NWAVES * 64) { const int c = i & 255, ii = (i >> 8) % 30, b = i / (30 * 256);
        C.out[O_CS + (size_t)l * DB * 30 * 256 + i] = ii < 22 ? sc[(((size_t)l * DB + b) * 30 + 8 + ii) * 256 + c] : UB[(size_t)(MP + b * 8 + ii - 22) * 256 + c]; }
}
template <int DK, bool RET> __device__ __forceinline__ void la_seq(const Ctx& C, int l, bool smp, int b, int h) {
    THREAD_IDS();
    const bf16* ZM = WSP(bf16, WS_ZMIX); const float* RQ = WSP(float, WS_RQ); const float* RK = WSP(float, WS_RK); const float* LD = WSP(float, WS_LDEC); bf16* BR = WSP(bf16, WS_BR);
    const int nt = smp ? DS : L; const int row0 = smp ? MP + b * DS : b * L;
    float S[DK];
    if (smp) { const float* s0 = (RET ? C.in[I_SRET] : C.in[I_SGLA]) + (((size_t)l * DB + b) * 4 + h) * DK * 64;
#pragma unroll
        for (int k = 0; k < DK; ++k) S[k] = s0[k * 64 + lane]; }
    else {
#pragma unroll
        for (int k = 0; k < DK; ++k) S[k] = 0.f; }
    const float gamma = 1.0f - exp2f(-5.0f - (float)h);
    const float gn = RET ? C.in[I_RGN][(l * 4 + h) * 64 + lane] : C.in[I_GGN][(l * 4 + h) * 64 + lane];
    for (int t = 0; t < nt; ++t) {
        const int r = row0 + t; const bf16* z = ZM + (size_t)r * NMIXP;
        float ql, kl, dl = 1.f;
        if (RET) { ql = RQ[(size_t)r * 256 + h * 64 + lane]; kl = RK[(size_t)r * 256 + h * 64 + lane]; }
        else { const int lk = lane & 31; ql = bf2f(z[G_Q + h * 32 + lk]) * 0.17677669529663687f; kl = bf2f(z[G_K + h * 32 + lk]); dl = __expf(LD[(size_t)r * 128 + h * 32 + lk]); }
        const float v = bf2f(z[(RET ? R_V : G_V) + h * 64 + lane]);
        float o = 0.f;
#pragma unroll
        for (int k = 0; k < DK; ++k) { const float qk = __shfl(ql, k), kk = __shfl(kl, k); const float dk = RET ? gamma : __shfl(dl, k);
            S[k] = dk * S[k] + kk * v; o += qk * S[k]; if ((k & 7) == 7) __builtin_amdgcn_sched_barrier(0); }
        float y;
        if (RET) { const float mean = wave_sum(o) * (1.0f / 64); const float d = o - mean; const float var = wave_sum(d * d) * (1.0f / 64); y = d * rsqrtf(var + EPS) * gn; }
        else { const float ms = wave_sum(o * o) * (1.0f / 64); y = o * rsqrtf(ms + EPS) * gn; }
        const float g = bf2f(z[(RET ? R_G : G_R) + h * 64 + lane]);
        BR[(size_t)r * D + (RET ? 256 : 512) + h * 64 + lane] = (bf16)f2bf(siluf_(g) * y);
    }
    float* so = C.out + (RET ? (smp ? O_RS + (((size_t)l * DB + b) * 4 + h) * DK * 64 : O_RP + (((size_t)l * BATCH + b) * 4 + h) * DK * 64)
                             : (smp ? O_GS + (((size_t)l * DB + b) * 4 + h) * DK * 64 : O_GP + (((size_t)l * BATCH + b) * 4 + h) * DK * 64));
#pragma unroll
    for (int k = 0; k < DK; ++k) so[k * 64 + lane] = S[k];
}
__device__ __forceinline__ void n2_la(const Ctx& C, int l) {
    THREAD_IDS();
    if ((gw & 63) == 0 && (gw >> 6) < 32) { const int it = gw >> 6; const int b = (it >> 2) & 3, h = it & 3;
        if (it < 16) la_seq<64, true>(C, l, false, b, h); else la_seq<32, false>(C, l, false, b, h); }
    for (int it = gw; it < 256; it += NGW) { const int typ = it >> 7, b = (it >> 2) & 31, h = it & 3;
        if (typ == 0) la_seq<64, true>(C, l, true, b, h); else la_seq<32, false>(C, l, true, b, h); }
}
__device__ __forceinline__ void n2_attn_prompt(const Ctx& C, int l, float lam_init) {
    THREAD_IDS();
    const float* QN = WSP(float, WS_QN); const float* KN = WSP(float, WS_KN); const float* VB = WSP(float, WS_VB); bf16* BR = WSP(bf16, WS_BR);
    const float lam = lam_of(C, l, lam_init);
    LAS float* park = (LAS float*)(C.lds) + wave * (64 * 65);
    constexpr int NQG = (L + 63) / 64;
    for (int it = gw; it < BATCH * 4 * NQG; it += NGW) {
        const int qg = NQG - 1 - it / 16, bh = it % 16, b = bh >> 2, h = bh & 3;
        const int qpos = min(qg * 64 + lane, L - 1); const bool valid = (qg * 64 + lane) < L; const int qrow = b * L + qpos;
        const int nkeys = min(qg * 64 + 64, L);
        float bias_near[1]; (void)bias_near;
        for (int s = 0; s < 2; ++s) {
            float q[32];
#pragma unroll
            for (int i = 0; i < 32; i += 4) { const f32x4 t = *(const f32x4*)(QN + (size_t)qrow * 256 + h * 64 + s * 32 + i); q[i] = t[0] * 0.17677669529663687f; q[i + 1] = t[1] * 0.17677669529663687f; q[i + 2] = t[2] * 0.17677669529663687f; q[i + 3] = t[3] * 0.17677669529663687f; }
            float m = -INFINITY, lsum = 0.f; float acc[64];
#pragma unroll
            for (int i = 0; i < 64; ++i) acc[i] = 0.f;
            for (int j = 0; j < nkeys; ++j) {
                const float* kp = KN + (size_t)(b * L + j) * 256 + h * 64 + s * 32; const float* vp = VB + (size_t)(b * L + j) * 256 + h * 64;
                float sc = 0.f;
#pragma unroll
                for (int i = 0; i < 32; i += 4) { const f32x4 kv = *(const f32x4*)(kp + i); sc += q[i] * kv[0] + q[i + 1] * kv[1] + q[i + 2] * kv[2] + q[i + 3] * kv[3]; }
                const int n = qpos - j;
                sc += C.in[I_RELB][t5_bucket(n < 0 ? 0 : n) * 4 + h];
                if (n < 0) sc = -INFINITY;
                const float mn = fmaxf(m, sc); const float corr = __expf(m - mn); const float p = __expf(sc - mn);
                m = mn; lsum = lsum * corr + p;
#pragma unroll
                for (int i = 0; i < 64; i += 4) { const f32x4 vv = *(const f32x4*)(vp + i); acc[i] = acc[i] * corr + p * vv[0]; acc[i + 1] = acc[i + 1] * corr + p * vv[1]; acc[i + 2] = acc[i + 2] * corr + p * vv[2]; acc[i + 3] = acc[i + 3] * corr + p * vv[3]; }
            }
            const float inv = 1.0f / lsum;
            if (s == 0) {
#pragma unroll
                for (int i = 0; i < 64; ++i) park[lane * 65 + i] = acc[i] * inv;
                LDS_WAIT();
            } else {
                float ms = 0.f;
#pragma unroll
                for (int i = 0; i < 64; ++i) { acc[i] = park[lane * 65 + i] - lam * (acc[i] * inv); ms += acc[i] * acc[i]; }
                const float rn = rsqrtf(ms * (1.0f / 64) + EPS) * (1.0f - lam_init);
                if (valid) {
#pragma unroll
                    for (int i = 0; i < 64; i += 2) { const unsigned w = pk2(acc[i] * rn * C.in[I_SUBLN][l * 64 + i], acc[i + 1] * rn * C.in[I_SUBLN][l * 64 + i + 1]); *(unsigned*)(BR + (size_t)qrow * D + 768 + h * 64 + i) = w; } }
                LDS_WAIT();
            }
        }
    }
}
__device__ __forceinline__ void n2_attn_sample(const Ctx& C, int l, float lam_init) {
    THREAD_IDS();
    const float* QN = WSP(float, WS_QN); const float* KN = WSP(float, WS_KN); const float* VB = WSP(float, WS_VB); bf16* BR = WSP(bf16, WS_BR);
    const int* PT = (const int*)C.in[I_PT]; const float* CK = C.in[I_CK] + (size_t)l * NPOOL * PAGE * 256; const float* CV = C.in[I_CV] + (size_t)l * NPOOL * PAGE * 256;
    const float lam = lam_of(C, l, lam_init);
    LAS float* part = (LAS float*)C.lds;
    for (int b = blockIdx.x; b < DB; b += C.G) {
        const int row = tid & 63, split = tid >> 6, h = row >> 4, s = (row >> 3) & 1, t = row & 7;
        float q[32];
#pragma unroll
        for (int i = 0; i < 32; ++i) q[i] = QN[(size_t)(MP + b * 8 + t) * 256 + h * 64 + s * 32 + i] * 0.17677669529663687f;
        float m = -INFINITY, lsum = 0.f; float acc[64];
#pragma unroll
        for (int i = 0; i < 64; ++i) acc[i] = 0.f;
        for (int j = split; j < PAST + DS; j += 8) {
            const float* kp; const float* vp; bool vis = true;
            if (j < PAST) { const int page = PT[b * NPAGES + (j >> 7)]; const size_t base = (((size_t)page * PAGE + (j & 127)) * 4 + h) * 64; kp = CK + base + s * 32; vp = CV + base; }
            else { const int jj = j - PAST; const size_t r2 = (size_t)(MP + b * 8 + jj); kp = KN + r2 * 256 + h * 64 + s * 32; vp = VB + r2 * 256 + h * 64; vis = jj <= t; }
            float sc = 0.f;
#pragma unroll
            for (int i = 0; i < 32; i += 4) { const f32x4 kv = *(const f32x4*)(kp + i); sc += q[i] * kv[0] + q[i + 1] * kv[1] + q[i + 2] * kv[2] + q[i + 3] * kv[3]; }
            const int n = PAST + t - j;
            sc += C.in[I_RELB][t5_bucket(n < 0 ? 0 : n) * 4 + h];
            if (!vis) sc = -INFINITY;
            const float mn = fmaxf(m, sc); const float corr = __expf(m - mn); const float p = __expf(sc - mn);
            m = mn; lsum = lsum * corr + p;
#pragma unroll
            for (int i = 0; i < 64; i += 4) { const f32x4 vv = *(const f32x4*)(vp + i); acc[i] = acc[i] * corr + p * vv[0]; acc[i + 1] = acc[i + 1] * corr + p * vv[1]; acc[i + 2] = acc[i + 2] * corr + p * vv[2]; acc[i + 3] = acc[i + 3] * corr + p * vv[3]; }
        }
        LAS float* pr = part + (split * 64 + row) * 66;
        pr[64] = m; pr[65] = lsum;
#pragma unroll
        for (int i = 0; i < 64; ++i) pr[i] = acc[i];
        __syncthreads();
        for (int k = 0; k < 4; ++k) { const int p = wave * 4 + k, h2 = p >> 3, t2 = p & 7; float os[2];
#pragma unroll
            for (int s2 = 0; s2 < 2; ++s2) { const int rw = h2 * 16 + s2 * 8 + t2; float mm = -INFINITY;
                for (int sp = 0; sp < 8; ++sp) mm = fmaxf(mm, part[(sp * 64 + rw) * 66 + 64]);
                float ll = 0.f, oo = 0.f;
                for (int sp = 0; sp < 8; ++sp) { const float w = __expf(part[(sp * 64 + rw) * 66 + 64] - mm); ll += part[(sp * 64 + rw) * 66 + 65] * w; oo += part[(sp * 64 + rw) * 66 + lane] * w; }
                os[s2] = oo / ll; }
            const float o = os[0] - lam * os[1]; const float ms = wave_sum(o * o) * (1.0f / 64);
            const float y = o * rsqrtf(ms + EPS) * C.in[I_SUBLN][l * 64 + lane] * (1.0f - lam_init);
            BR[(size_t)(MP + b * 8 + t2) * D + 768 + h2 * 64 + lane] = (bf16)f2bf(y); }
        __syncthreads();
    }
}
typedef short bf16x8_t __attribute__((ext_vector_type(8)));
template <int DK, bool RET> __device__ __forceinline__ void la_chunked(const Ctx& C, int l, bool smp, int b, int h) {
    THREAD_IDS();
    constexpr int QS = DK + 8, TS = 72, NKB = DK / 16, NKS = DK / 32;
    constexpr int SB = 2 * 64 * QS + 64 * TS + DK * TS + 64 * TS + 64;
    LAS bf16* SB0 = (LAS bf16*)(C.lds);
    LAS bf16* AL = SB0 + 2 * SB;
    LAS bf16* ST = AL + 64 * TS;
    const bf16* ZM = WSP(bf16, WS_ZMIX); const float* RQ = WSP(float, WS_RQ); const float* RK = WSP(float, WS_RK); const float* LD = WSP(float, WS_LDEC); bf16* BR = WSP(bf16, WS_BR);
    const int nt = smp ? DS : L, row0 = smp ? MP + b * DS : b * L, nch = (nt + 63) >> 6;
    const float lg2 = RET ? log2f(1.0f - exp2f(-5.0f - (float)h)) : 0.f;
    const int g4 = lane >> 4, c16 = lane & 15;
    const bool qwave = wave < 4; const int w4 = wave & 3;
    float Sreg[NKB][4];
    if (wave >= 4) {
        const float* s0 = (RET ? C.in[I_SRET] : C.in[I_SGLA]) + (((size_t)l * DB + b) * 4 + h) * DK * 64;
#pragma unroll
        for (int cb = 0; cb < NKB; ++cb)
#pragma unroll
            for (int r = 0; r < 4; ++r) { const int dk = cb * 16 + c16, dv = (wave - 4) * 16 + 4 * g4 + r; const float v = smp ? s0[dk * 64 + dv] : 0.f; Sreg[cb][r] = v; ST[dv * QS + dk] = (bf16)f2bf(v); }
    }
    float gnv[4];
#pragma unroll
    for (int cb = 0; cb < 4; ++cb) gnv[cb] = (RET ? C.in[I_RGN] : C.in[I_GGN])[(l * 4 + h) * 64 + cb * 16 + c16];
    float a[16]; v4u vr;
#define LA_LOAD(c) do { const size_t r_ = (size_t)(row0 + (c) * 64 + lane); const bf16* z_ = ZM + r_ * NMIXP; \
        vr = *(const v4u*)(z_ + (RET ? R_V : G_V) + h * 64 + 8 * wave); \
        if (RET) { const float* p_ = (qwave ? RQ : RK) + r_ * 256 + h * 64 + 8 * w4; const f32x4 x0 = *(const f32x4*)p_, x1 = *(const f32x4*)(p_ + 4), x2 = *(const f32x4*)(p_ + 32), x3 = *(const f32x4*)(p_ + 36); \
            a[0] = x0[0]; a[1] = x0[1]; a[2] = x0[2]; a[3] = x0[3]; a[4] = x1[0]; a[5] = x1[1]; a[6] = x1[2]; a[7] = x1[3]; a[8] = x2[0]; a[9] = x2[1]; a[10] = x2[2]; a[11] = x2[3]; a[12] = x3[0]; a[13] = x3[1]; a[14] = x3[2]; a[15] = x3[3]; } \
        else { const v4u q_ = *(const v4u*)(z_ + (qwave ? G_Q : G_K) + h * 32 + 8 * w4); const float* p_ = LD + r_ * 128 + h * 32 + 8 * w4; const f32x4 x0 = *(const f32x4*)p_, x1 = *(const f32x4*)(p_ + 4); \
            a[0] = bflo(q_.x); a[1] = bfhi(q_.x); a[2] = bflo(q_.y); a[3] = bfhi(q_.y); a[4] = bflo(q_.z); a[5] = bfhi(q_.z); a[6] = bflo(q_.w); a[7] = bfhi(q_.w); \
            a[8] = x0[0]; a[9] = x0[1]; a[10] = x0[2]; a[11] = x0[3]; a[12] = x1[0]; a[13] = x1[1]; a[14] = x1[2]; a[15] = x1[3]; } } while (0)
    LA_LOAD(0);
    int cur = 0;
    for (int i = 0; i <= nch; ++i) {
        if (i < nch) {
            const int c = i; LAS bf16* QT = SB0 + (i & 1) * SB; LAS bf16* KT = QT + 64 * QS; LAS bf16* VT = KT + 64 * QS; LAS bf16* KE = VT + 64 * TS; LAS bf16* GT = KE + DK * TS; LAS float* WT = (LAS float*)(GT + 64 * TS);
            const int nvc = min(64, nt - c * 64); const bool valid = lane < nvc;
        if (RET) {
            const float tq = (float)(lane + 1);
            if (qwave) { const float e = valid ? __builtin_amdgcn_exp2f(lg2 * tq) : 0.f;
                v4u w0, w1; w0.x = pg8::cvt_pk_bf16(a[0] * e, a[1] * e); w0.y = pg8::cvt_pk_bf16(a[2] * e, a[3] * e); w0.z = pg8::cvt_pk_bf16(a[4] * e, a[5] * e); w0.w = pg8::cvt_pk_bf16(a[6] * e, a[7] * e);
                w1.x = pg8::cvt_pk_bf16(a[8] * e, a[9] * e); w1.y = pg8::cvt_pk_bf16(a[10] * e, a[11] * e); w1.z = pg8::cvt_pk_bf16(a[12] * e, a[13] * e); w1.w = pg8::cvt_pk_bf16(a[14] * e, a[15] * e);
                *(LAS v4u*)(QT + lane * QS + 8 * w4) = w0; *(LAS v4u*)(QT + lane * QS + 32 + 8 * w4) = w1; }
            else { const float e = valid ? __builtin_amdgcn_exp2f(-lg2 * tq) : 0.f, ee = valid ? __builtin_amdgcn_exp2f(lg2 * ((float)nvc - tq)) : 0.f;
                v4u w0, w1; w0.x = pg8::cvt_pk_bf16(a[0] * e, a[1] * e); w0.y = pg8::cvt_pk_bf16(a[2] * e, a[3] * e); w0.z = pg8::cvt_pk_bf16(a[4] * e, a[5] * e); w0.w = pg8::cvt_pk_bf16(a[6] * e, a[7] * e);
                w1.x = pg8::cvt_pk_bf16(a[8] * e, a[9] * e); w1.y = pg8::cvt_pk_bf16(a[10] * e, a[11] * e); w1.z = pg8::cvt_pk_bf16(a[12] * e, a[13] * e); w1.w = pg8::cvt_pk_bf16(a[14] * e, a[15] * e);
                *(LAS v4u*)(KT + lane * QS + 8 * w4) = w0; *(LAS v4u*)(KT + lane * QS + 32 + 8 * w4) = w1;
#pragma unroll
                for (int i = 0; i < 16; i += 2) { const unsigned mine = pg8::cvt_pk_bf16(a[i] * ee, a[i + 1] * ee); const unsigned pv = (unsigned)__shfl_xor((int)mine, 1);
                    const unsigned w = (lane & 1) ? ((pv >> 16) | (mine & 0xffff0000u)) : ((mine & 0xffffu) | (pv << 16));
                    const int row = (i < 8 ? 8 * w4 + i : 32 + 8 * w4 + (i - 8)) + (lane & 1);
                    *(LAS unsigned*)(KE + row * TS + (lane & ~1)) = w; } }
        } else {
            float bb[8];
#pragma unroll
            for (int i = 0; i < 8; ++i) bb[i] = valid ? a[8 + i] : 0.f;
#pragma unroll
            for (int i = 0; i < 8; ++i) { float x = bb[i];
                x += __builtin_bit_cast(float, __builtin_amdgcn_mov_dpp(__builtin_bit_cast(int, x), 0x111, 0xf, 0xf, true));
                x += __builtin_bit_cast(float, __builtin_amdgcn_mov_dpp(__builtin_bit_cast(int, x), 0x112, 0xf, 0xf, true));
                x += __builtin_bit_cast(float, __builtin_amdgcn_mov_dpp(__builtin_bit_cast(int, x), 0x114, 0xf, 0xf, true));
                x += __builtin_bit_cast(float, __builtin_amdgcn_mov_dpp(__builtin_bit_cast(int, x), 0x118, 0xf, 0xf, true));
                const float t0 = __builtin_bit_cast(float, __builtin_amdgcn_readlane(__builtin_bit_cast(int, x), 15)), t1 = __builtin_bit_cast(float, __builtin_amdgcn_readlane(__builtin_bit_cast(int, x), 31)), t2 = __builtin_bit_cast(float, __builtin_amdgcn_readlane(__builtin_bit_cast(int, x), 47));
                bb[i] = x + (lane >= 16 ? t0 : 0.f) + (lane >= 32 ? t1 : 0.f) + (lane >= 48 ? t2 : 0.f); }
            if (qwave) {
                if (lane == 63) {
#pragma unroll
                    for (int i = 0; i < 8; ++i) WT[8 * w4 + i] = bb[i]; }
                float o8[8];
#pragma unroll
                for (int i = 0; i < 8; ++i) o8[i] = valid ? a[i] * 0.17677669529663687f * __expf(bb[i]) : 0.f;
                v4u w0; w0.x = pg8::cvt_pk_bf16(o8[0], o8[1]); w0.y = pg8::cvt_pk_bf16(o8[2], o8[3]); w0.z = pg8::cvt_pk_bf16(o8[4], o8[5]); w0.w = pg8::cvt_pk_bf16(o8[6], o8[7]);
                *(LAS v4u*)(QT + lane * QS + 8 * w4) = w0;
            } else {
                float o8[8];
#pragma unroll
                for (int i = 0; i < 8; ++i) o8[i] = valid ? a[i] * __expf(-bb[i]) : 0.f;
#pragma unroll
                for (int i = 0; i < 8; i += 2) { const float t0 = __shfl(bb[i], 63), t1 = __shfl(bb[i + 1], 63);
                    const unsigned mine = pg8::cvt_pk_bf16(valid ? a[i] * __expf(t0 - bb[i]) : 0.f, valid ? a[i + 1] * __expf(t1 - bb[i + 1]) : 0.f); const unsigned pv = (unsigned)__shfl_xor((int)mine, 1);
                    const unsigned w = (lane & 1) ? ((pv >> 16) | (mine & 0xffff0000u)) : ((mine & 0xffffu) | (pv << 16));
                    *(LAS unsigned*)(KE + (8 * w4 + i + (lane & 1)) * TS + (lane & ~1)) = w; }
                v4u w0; w0.x = pg8::cvt_pk_bf16(o8[0], o8[1]); w0.y = pg8::cvt_pk_bf16(o8[2], o8[3]); w0.z = pg8::cvt_pk_bf16(o8[4], o8[5]); w0.w = pg8::cvt_pk_bf16(o8[6], o8[7]);
                *(LAS v4u*)(KT + lane * QS + 8 * w4) = w0;
            }
        }
        { const unsigned vv[4] = {valid ? vr.x : 0u, valid ? vr.y : 0u, valid ? vr.z : 0u, valid ? vr.w : 0u};
#pragma unroll
          for (int i = 0; i < 4; ++i) { const unsigned pv = (unsigned)__shfl_xor((int)vv[i], 1);
              const unsigned w = (lane & 1) ? ((pv >> 16) | (vv[i] & 0xffff0000u)) : ((vv[i] & 0xffffu) | (pv << 16));
              *(LAS unsigned*)(VT + (8 * wave + 2 * i + (lane & 1)) * TS + (lane & ~1)) = w; } }
            if (c + 1 < nch) LA_LOAD(c + 1);
        }
        if (i >= 1) {
            LAS bf16* QT = SB0 + ((i - 1) & 1) * SB; LAS bf16* KT = QT + 64 * QS;
        { const int rb = wave >> 1;
#pragma unroll
          for (int ci = 0; ci < 2; ++ci) { const int cb = (wave & 1) * 2 + ci; f32x4 acc = {0.f, 0.f, 0.f, 0.f};
              if (cb <= rb) {
#pragma unroll
                  for (int ks = 0; ks < NKS; ++ks) { const bf16x8_t af = *(const LAS bf16x8_t*)(QT + (rb * 16 + c16) * QS + ks * 32 + 8 * g4), bf = *(const LAS bf16x8_t*)(KT + (cb * 16 + c16) * QS + ks * 32 + 8 * g4);
                      acc = __builtin_amdgcn_mfma_f32_16x16x32_bf16(af, bf, acc, 0, 0, 0); } }
#pragma unroll
              for (int r = 0; r < 4; ++r) { const int tt = rb * 16 + 4 * g4 + r, ss = cb * 16 + c16; AL[tt * TS + ss] = (bf16)f2bf(ss <= tt ? acc[r] : 0.f); } } }
        }
        LDS_WAIT(); __builtin_amdgcn_s_barrier(); asm volatile("" ::: "memory");
        if (i >= 1) {
            const int c = i - 1; LAS bf16* QT = SB0 + (c & 1) * SB; LAS bf16* KT = QT + 64 * QS; LAS bf16* VT = KT + 64 * QS; LAS bf16* KE = VT + 64 * TS; LAS bf16* GT = KE + DK * TS; LAS float* WT = (LAS float*)(GT + 64 * TS);
            const int nvc = min(64, nt - c * 64); (void)KT;
        if (wave < 4) {
            const int rb = wave; const LAS bf16* STc = ST + cur * 64 * QS;
            f32x4 o[4];
#pragma unroll
            for (int cb = 0; cb < 4; ++cb) o[cb] = (f32x4){0.f, 0.f, 0.f, 0.f};
#pragma unroll
            for (int ks = 0; ks < 2; ++ks) { const bf16x8_t af = *(const LAS bf16x8_t*)(AL + (rb * 16 + c16) * TS + ks * 32 + 8 * g4);
#pragma unroll
                for (int cb = 0; cb < 4; ++cb) { const bf16x8_t bf = *(const LAS bf16x8_t*)(VT + (cb * 16 + c16) * TS + ks * 32 + 8 * g4); o[cb] = __builtin_amdgcn_mfma_f32_16x16x32_bf16(af, bf, o[cb], 0, 0, 0); } }
#pragma unroll
            for (int ks = 0; ks < NKS; ++ks) { const bf16x8_t af = *(const LAS bf16x8_t*)(QT + (rb * 16 + c16) * QS + ks * 32 + 8 * g4);
#pragma unroll
                for (int cb = 0; cb < 4; ++cb) { const bf16x8_t bf = *(const LAS bf16x8_t*)(STc + (cb * 16 + c16) * QS + ks * 32 + 8 * g4); o[cb] = __builtin_amdgcn_mfma_f32_16x16x32_bf16(af, bf, o[cb], 0, 0, 0); } }
            { float* LAO = WSP(float, WS_LAO);
#pragma unroll
              for (int r = 0; r < 4; ++r) { const int tok = c * 64 + rb * 16 + 4 * g4 + r;
                  if (tok < nt) { float* op = LAO + (size_t)(row0 + tok) * 512 + (RET ? 0 : 256) + h * 64 + c16;
#pragma unroll
                      for (int cb = 0; cb < 4; ++cb) op[cb * 16] = o[cb][r]; } } }
        } else {
            const int dvb = wave - 4; LAS bf16* STn = ST + (cur ^ 1) * 64 * QS;
            f32x4 ds[NKB];
#pragma unroll
            for (int cb = 0; cb < NKB; ++cb) ds[cb] = (f32x4){0.f, 0.f, 0.f, 0.f};
#pragma unroll
            for (int ks = 0; ks < 2; ++ks) { const bf16x8_t af = *(const LAS bf16x8_t*)(VT + (dvb * 16 + c16) * TS + ks * 32 + 8 * g4);
#pragma unroll
                for (int cb = 0; cb < NKB; ++cb) { const bf16x8_t bf = *(const LAS bf16x8_t*)(KE + (cb * 16 + c16) * TS + ks * 32 + 8 * g4); ds[cb] = __builtin_amdgcn_mfma_f32_16x16x32_bf16(af, bf, ds[cb], 0, 0, 0); } }
#pragma unroll
            for (int cb = 0; cb < NKB; ++cb) { const float eB = RET ? __builtin_amdgcn_exp2f(lg2 * (float)nvc) : __expf(WT[cb * 16 + c16]);
#pragma unroll
                for (int r = 0; r < 4; ++r) { Sreg[cb][r] = eB * Sreg[cb][r] + ds[cb][r]; STn[(dvb * 16 + 4 * g4 + r) * QS + cb * 16 + c16] = (bf16)f2bf(Sreg[cb][r]); } }
        }
            cur ^= 1;
        }
        LDS_WAIT(); __builtin_amdgcn_s_barrier(); asm volatile("" ::: "memory");
    }
#undef LA_LOAD
    if (wave >= 4) {
        float* so = C.out + (RET ? (smp ? O_RS + (((size_t)l * DB + b) * 4 + h) * DK * 64 : O_RP + (((size_t)l * BATCH + b) * 4 + h) * DK * 64)
                                 : (smp ? O_GS + (((size_t)l * DB + b) * 4 + h) * DK * 64 : O_GP + (((size_t)l * BATCH + b) * 4 + h) * DK * 64));
#pragma unroll
        for (int cb = 0; cb < NKB; ++cb)
#pragma unroll
            for (int r = 0; r < 4; ++r) so[(cb * 16 + c16) * 64 + (wave - 4) * 16 + 4 * g4 + r] = Sreg[cb][r];
    }
}
__device__ __forceinline__ void n2_la_chunked(const Ctx& C, int l) {
    const int bx = blockIdx.x;
    if (bx < 32) { const int b = (bx >> 2) & 3, h = bx & 3; if (bx < 16) la_chunked<64, true>(C, l, false, b, h); else la_chunked<32, false>(C, l, false, b, h); }
    else { for (int it = bx - 32; it < 256; it += C.G - 32) { const int b = (it >> 2) & 31, h = it & 3; if (it < 128) la_chunked<64, true>(C, l, true, b, h); else la_chunked<32, false>(C, l, true, b, h); } }
}
typedef float f32x16_t __attribute__((ext_vector_type(16)));
__device__ __forceinline__ int crow_(int r, int hi) { return (r & 3) + 8 * (r >> 2) + 4 * hi; }
__device__ __forceinline__ float swapmax32(float m) { auto rr = __builtin_amdgcn_permlane32_swap(__float_as_uint(m), __float_as_uint(m), false, false); return fmaxf(__uint_as_float(rr[0]), __uint_as_float(rr[1])); }
__device__ __forceinline__ float swapadd32(float m) { auto rr = __builtin_amdgcn_permlane32_swap(__float_as_uint(m), __float_as_uint(m), false, false); return __uint_as_float(rr[0]) + __uint_as_float(rr[1]); }
constexpr float LOG2E = 1.4426950408889634f;
__device__ __forceinline__ void attn_prompt_item(const Ctx& C, int l, int b, int h, int qb, float lam, float lam_init, float mb) {
    THREAD_IDS();
    constexpr int KS = 72;
    LAS bf16* Kt = (LAS bf16*)C.lds;
    LAS bf16* Vt = Kt + 2 * 64 * KS;
    LAS float* BT = (LAS float*)(Vt + 2 * 64 * KS);
    LAS float* OX = BT + 128;
    const bf16* ZM = WSP(bf16, WS_ZMIX); const bf16* QNB = WSP(bf16, WS_QNB); const bf16* KNB = WSP(bf16, WS_KNB); bf16* BR = WSP(bf16, WS_BR);
    const int r32 = lane & 31, hi = lane >> 5, qs = wave >> 1, s = wave & 1;
    const int q0 = qb * 128 + qs * 32; const int rowb = b * L;
    if (tid < 128) BT[tid] = (C.in[I_RELB][t5_bucket(tid) * 4 + h] - C.in[I_RELB][31 * 4 + h]) * LOG2E;
    pg8::bf16x8 qf[2];
#pragma unroll
    for (int d0 = 0; d0 < 2; ++d0) qf[d0] = *(const pg8::bf16x8*)(QNB + (size_t)(rowb + q0 + r32) * 256 + h * 64 + s * 32 + 16 * d0 + 8 * hi);
    const int pl = (lane & ~15) | ((lane & 8) >> 1) | ((lane & 4) << 1) | (lane & 3);
    const int NT = (min(128 * (qb + 1), L) + 63) >> 6;
    v4u kreg, vreg;
#define AT_LOAD(j) do { const size_t r_ = (size_t)(rowb + (j) * 64 + lane); kreg = *(const v4u*)(KNB + r_ * 256 + h * 64 + 8 * wave); vreg = *(const v4u*)(ZM + r_ * NMIXP + D_V + h * 64 + 8 * wave); } while (0)
#define AT_STORE(buf) do { *(LAS v4u*)(Kt + (buf) * 64 * KS + lane * KS + 8 * wave) = kreg; LAS bf16* v_ = Vt + (buf) * 64 * KS + (8 * wave) * KS + pl; \
        v_[0] = (bf16)(vreg.x & 0xffffu); v_[KS] = (bf16)(vreg.x >> 16); v_[2 * KS] = (bf16)(vreg.y & 0xffffu); v_[3 * KS] = (bf16)(vreg.y >> 16); \
        v_[4 * KS] = (bf16)(vreg.z & 0xffffu); v_[5 * KS] = (bf16)(vreg.z >> 16); v_[6 * KS] = (bf16)(vreg.w & 0xffffu); v_[7 * KS] = (bf16)(vreg.w >> 16); } while (0)
    AT_LOAD(0); AT_STORE(0); if (NT > 1) AT_LOAD(1);
    LDS_WAIT(); __builtin_amdgcn_s_barrier(); asm volatile("" ::: "memory");
    float lsum = 0.f; f32x16_t o[2]; f32x16_t negm;
#pragma unroll
    for (int i = 0; i < 16; ++i) negm[i] = -mb;
#pragma unroll
    for (int i = 0; i < 16; ++i) { o[0][i] = 0.f; o[1][i] = 0.f; }
    for (int j = 0; j < NT; ++j) {
        const int k0 = 64 * j, buf = j & 1;
        if (k0 <= q0 + 31) {
            const LAS bf16* kb = Kt + buf * 64 * KS; const LAS bf16* vb = Vt + buf * 64 * KS;
            f32x16_t p0 = negm, p1 = negm;
#pragma unroll
            for (int d0 = 0; d0 < 2; ++d0) { const pg8::bf16x8 a0 = *(const LAS pg8::bf16x8*)(kb + r32 * KS + s * 32 + 16 * d0 + 8 * hi), a1 = *(const LAS pg8::bf16x8*)(kb + (32 + r32) * KS + s * 32 + 16 * d0 + 8 * hi);
                p0 = __builtin_amdgcn_mfma_f32_32x32x16_bf16(a0, qf[d0], p0, 0, 0, 0); p1 = __builtin_amdgcn_mfma_f32_32x32x16_bf16(a1, qf[d0], p1, 0, 0, 0); }
            if (q0 - k0 - 63 < 113) {
#pragma unroll
                for (int r = 0; r < 16; ++r) { const int n0 = (q0 + r32) - (k0 + crow_(r, hi)), n1 = n0 - 32;
                    p0[r] = n0 < 0 ? -INFINITY : p0[r] + (n0 < 128 ? BT[n0] : 0.f); p1[r] = n1 < 0 ? -INFINITY : p1[r] + (n1 < 128 ? BT[n1] : 0.f); } }
            typedef float f32x2_t __attribute__((ext_vector_type(2)));
            f32x2_t ps2 = {0.f, 0.f};
#pragma unroll
            for (int r = 0; r < 16; r += 2) { p0[r] = __builtin_amdgcn_exp2f(p0[r]); p0[r + 1] = __builtin_amdgcn_exp2f(p0[r + 1]); p1[r] = __builtin_amdgcn_exp2f(p1[r]); p1[r + 1] = __builtin_amdgcn_exp2f(p1[r + 1]);
                ps2 = ps2 + (f32x2_t){p0[r], p0[r + 1]}; ps2 = ps2 + (f32x2_t){p1[r], p1[r + 1]}; }
            lsum += ps2[0] + ps2[1];
            pg8::bf16x8 pb[4];
#pragma unroll
            for (int ks = 0; ks < 4; ++ks) { v4u w;
                if (ks < 2) { w.x = pg8::cvt_pk_bf16(p0[8 * ks], p0[8 * ks + 1]); w.y = pg8::cvt_pk_bf16(p0[8 * ks + 2], p0[8 * ks + 3]); w.z = pg8::cvt_pk_bf16(p0[8 * ks + 4], p0[8 * ks + 5]); w.w = pg8::cvt_pk_bf16(p0[8 * ks + 6], p0[8 * ks + 7]); }
                else { w.x = pg8::cvt_pk_bf16(p1[8 * ks - 16], p1[8 * ks - 15]); w.y = pg8::cvt_pk_bf16(p1[8 * ks - 14], p1[8 * ks - 13]); w.z = pg8::cvt_pk_bf16(p1[8 * ks - 12], p1[8 * ks - 11]); w.w = pg8::cvt_pk_bf16(p1[8 * ks - 10], p1[8 * ks - 9]); }
                pb[ks] = __builtin_bit_cast(pg8::bf16x8, w); }
#pragma unroll
            for (int d0 = 0; d0 < 2; ++d0)
#pragma unroll
                for (int ks = 0; ks < 4; ++ks) { const pg8::bf16x8 af = *(const LAS pg8::bf16x8*)(vb + (32 * d0 + r32) * KS + 16 * ks + 8 * hi); o[d0] = __builtin_amdgcn_mfma_f32_32x32x16_bf16(af, pb[ks], o[d0], 0, 0, 0); }
        }
        if (j + 1 < NT) AT_STORE(buf ^ 1);
        if (j + 2 < NT) AT_LOAD(j + 2);
        LDS_WAIT(); __builtin_amdgcn_s_barrier(); asm volatile("" ::: "memory");
    }
#undef AT_LOAD
#undef AT_STORE
    lsum = swapadd32(lsum); const float inv = 1.0f / lsum;
    LAS float* ox = OX + (qs * 32 + r32) * 65;
    if (s == 1) {
#pragma unroll
        for (int d0 = 0; d0 < 2; ++d0)
#pragma unroll
            for (int r = 0; r < 16; ++r) ox[32 * d0 + crow_(r, hi)] = o[d0][r] * inv; }
    LDS_WAIT(); __builtin_amdgcn_s_barrier(); asm volatile("" ::: "memory");
    if (s == 0) {
        float ss = 0.f;
#pragma unroll
        for (int d0 = 0; d0 < 2; ++d0)
#pragma unroll
            for (int r = 0; r < 16; ++r) { const float v = o[d0][r] * inv - lam * ox[32 * d0 + crow_(r, hi)]; o[d0][r] = v; ss += v * v; }
        ss = swapadd32(ss); const float rs = rsqrtf(ss * (1.0f / 64) + EPS) * (1.0f - lam_init);
        const int qpos = q0 + r32;
        if (qpos < L) { bf16* brp = BR + (size_t)(rowb + qpos) * D + 768 + h * 64;
#pragma unroll
            for (int d0 = 0; d0 < 2; ++d0)
#pragma unroll
                for (int r4 = 0; r4 < 4; ++r4) { const int dv = 32 * d0 + 8 * r4 + 4 * hi; const float* sl = C.in[I_SUBLN] + l * 64 + dv;
                    const unsigned w0 = pk2(o[d0][4 * r4] * rs * sl[0], o[d0][4 * r4 + 1] * rs * sl[1]), w1 = pk2(o[d0][4 * r4 + 2] * rs * sl[2], o[d0][4 * r4 + 3] * rs * sl[3]);
                    *(unsigned long long*)(brp + dv) = (unsigned long long)w0 | ((unsigned long long)w1 << 32); } }
    }
    LDS_WAIT(); __builtin_amdgcn_s_barrier(); asm volatile("" ::: "memory");
}
__device__ __forceinline__ void n2_attn_prompt_mfma(const Ctx& C, int l, float lam_init, int qoff = 0) {
    THREAD_IDS();
    const float lam = lam_of(C, l, lam_init);
    unsigned* qw = (unsigned*)(C.ws + WS_CTL) + CW_QUEUE + 64 * (l + qoff);
    volatile LAS int* slot = (volatile LAS int*)(C.lds + MISC_OFF + 64);
    constexpr int NQB = (L + 127) / 128;
    for (;;) {
        if (tid == 0) slot[0] = (int)__hip_atomic_fetch_add(qw, 1u, __ATOMIC_RELAXED, __HIP_MEMORY_SCOPE_AGENT);
        __syncthreads();
        const int it = slot[0];
        if (it >= 16 * NQB) break;
        attn_prompt_item(C, l, (it & 15) >> 2, it & 3, NQB - 1 - (it >> 4), lam, lam_init, 16.0f);
    }
}
constexpr int PSTR = 68;
__device__ __forceinline__ pg8::bf16x8 cvt8(const f32x4 a, const f32x4 b) { v4u w; w.x = pg8::cvt_pk_bf16(a[0], a[1]); w.y = pg8::cvt_pk_bf16(a[2], a[3]); w.z = pg8::cvt_pk_bf16(b[0], b[1]); w.w = pg8::cvt_pk_bf16(b[2], b[3]); return __builtin_bit_cast(pg8::bf16x8, w); }
__device__ __forceinline__ void attn_sample_item(const Ctx& C, int l, int b, int split) {
    THREAD_IDS();
    const int h = wave & 3, half = wave >> 2, c16 = lane & 15, g = lane >> 4, srow = c16 >> 3, t = c16 & 7;
    const bf16* QNB = WSP(bf16, WS_QNB); const int* PT = (const int*)C.in[I_PT];
    const float* CK = C.in[I_CK] + (size_t)l * NPOOL * PAGE * 256; const float* CV = C.in[I_CV] + (size_t)l * NPOOL * PAGE * 256;
    LAS float* BT = (LAS float*)C.lds;
    BT[tid] = (C.in[I_RELB][t5_bucket(tid & 127) * 4 + (tid >> 7)] - C.in[I_RELB][31 * 4 + (tid >> 7)]) * LOG2E;
    const v4u z4 = {0u, 0u, 0u, 0u};
    const v4u q0w = srow == 0 ? *(const v4u*)(QNB + (size_t)(MP + b * 8 + t) * 256 + h * 64 + 8 * g) : z4, q1w = srow == 1 ? *(const v4u*)(QNB + (size_t)(MP + b * 8 + t) * 256 + h * 64 + 32 + 8 * g) : z4;
    const pg8::bf16x8 qf0 = __builtin_bit_cast(pg8::bf16x8, q0w), qf1 = __builtin_bit_cast(pg8::bf16x8, q1w);
    LDS_WAIT(); __builtin_amdgcn_s_barrier(); asm volatile("" ::: "memory");
    float m = -INFINITY, lsum = 0.f; f32x4 o[4];
#pragma unroll
    for (int db = 0; db < 4; ++db) o[db] = (f32x4){0.f, 0.f, 0.f, 0.f};
    const int kk0 = split * 1024 + half * 512;
    const int pg0 = __builtin_amdgcn_readfirstlane(PT[b * NPAGES + (kk0 >> 7)]), pg1 = __builtin_amdgcn_readfirstlane(PT[b * NPAGES + (kk0 >> 7) + 1]), pg2 = __builtin_amdgcn_readfirstlane(PT[b * NPAGES + (kk0 >> 7) + 2]), pg3 = __builtin_amdgcn_readfirstlane(PT[b * NPAGES + (kk0 >> 7) + 3]);
#define SA_LOAD(KR, VR, st) do { const int kk_ = kk0 + 32 * (st); const int pi_ = (st) >> 2; const int page_ = pi_ == 0 ? pg0 : pi_ == 1 ? pg1 : pi_ == 2 ? pg2 : pg3; const size_t base_ = ((size_t)(page_ * PAGE + (kk_ & 127)) * 4 + h) * 64; \
        _Pragma("unroll") for (int T = 0; T < 2; ++T) _Pragma("unroll") for (int ks = 0; ks < 2; ++ks) { const float* p = CK + base_ + (size_t)(16 * T + c16) * 256 + 32 * ks + 8 * g; KR[T][ks][0] = *(const f32x4*)p; KR[T][ks][1] = *(const f32x4*)(p + 4); } \
        _Pragma("unroll") for (int db = 0; db < 4; ++db) _Pragma("unroll") for (int j = 0; j < 8; ++j) { const int kv = j < 4 ? 4 * g + j : 16 + 4 * g + (j - 4); VR[db][j] = CV[base_ + (size_t)kv * 256 + 16 * db + c16]; } } while (0)
#define SA_MATH(KR, VR, st) do { const int kk = kk0 + 32 * (st); f32x4 sv[2]; \
        _Pragma("unroll") for (int T = 0; T < 2; ++T) { sv[T] = (f32x4){0.f, 0.f, 0.f, 0.f}; \
            sv[T] = __builtin_amdgcn_mfma_f32_16x16x32_bf16(cvt8(KR[T][0][0], KR[T][0][1]), qf0, sv[T], 0, 0, 0); \
            sv[T] = __builtin_amdgcn_mfma_f32_16x16x32_bf16(cvt8(KR[T][1][0], KR[T][1][1]), qf1, sv[T], 0, 0, 0); } \
        if (kk + 31 + 128 > PAST) { \
            _Pragma("unroll") for (int T = 0; T < 2; ++T) _Pragma("unroll") for (int r = 0; r < 4; ++r) { const int n = PAST + t - (kk + 16 * T + 4 * g + r); if (n < 128) sv[T][r] += BT[h * 128 + n]; } } \
        float mt = fmaxf(fmaxf(fmaxf(sv[0][0], sv[0][1]), fmaxf(sv[0][2], sv[0][3])), fmaxf(fmaxf(sv[1][0], sv[1][1]), fmaxf(sv[1][2], sv[1][3]))); \
        mt = fmaxf(mt, __shfl_xor(mt, 16)); mt = fmaxf(mt, __shfl_xor(mt, 32)); \
        const float mn = fmaxf(m, mt); const float al = __builtin_amdgcn_exp2f(m - mn); m = mn; float ps = 0.f; \
        _Pragma("unroll") for (int T = 0; T < 2; ++T) _Pragma("unroll") for (int r = 0; r < 4; ++r) { sv[T][r] = __builtin_amdgcn_exp2f(sv[T][r] - m); ps += sv[T][r]; } \
        lsum = lsum * al + ps; const pg8::bf16x8 pf = cvt8(sv[0], sv[1]); \
        _Pragma("unroll") for (int db = 0; db < 4; ++db) { o[db] = o[db] * al; \
            const f32x4 va = {VR[db][0], VR[db][1], VR[db][2], VR[db][3]}, vb = {VR[db][4], VR[db][5], VR[db][6], VR[db][7]}; \
            o[db] = __builtin_amdgcn_mfma_f32_16x16x32_bf16(cvt8(va, vb), pf, o[db], 0, 0, 0); } } while (0)
    f32x4 krA[2][2][2], krB[2][2][2]; float vrA[4][8], vrB[4][8];
    SA_LOAD(krA, vrA, 0);
#pragma unroll 1
    for (int step = 0; step < 16; step += 2) {
        SA_LOAD(krB, vrB, step + 1);
        SA_MATH(krA, vrA, step);
        if (step + 2 < 16) SA_LOAD(krA, vrA, step + 2);
        SA_MATH(krB, vrB, step + 1);
    }
#undef SA_LOAD
#undef SA_MATH
    lsum += __shfl_xor(lsum, 16); lsum += __shfl_xor(lsum, 32);
    float* pp = WSP(float, WS_PART) + ((((size_t)b * 4 + h) * 16 + split * 2 + half) * 16 + c16) * PSTR;
#pragma unroll
    for (int db = 0; db < 4; ++db) *(f32x4*)(pp + 16 * db + 4 * g) = o[db];
    if (g == 0) { pp[64] = m; pp[65] = lsum; }
    LDS_WAIT(); __builtin_amdgcn_s_barrier(); asm volatile("" ::: "memory");
}
__device__ __forceinline__ void n2_attn_sample_split(const Ctx& C, int l) {
    for (int it = blockIdx.x; it < DB * 8; it += C.G) attn_sample_item(C, l, it >> 3, it & 7);
}
__device__ __forceinline__ void n3_attn_sample_combine(const Ctx& C, int l, float lam_init) {
    THREAD_IDS();
    const float lam = lam_of(C, l, lam_init);
    const bf16* QNB = WSP(bf16, WS_QNB); const bf16* KNB = WSP(bf16, WS_KNB); const bf16* ZM = WSP(bf16, WS_ZMIX); bf16* BR = WSP(bf16, WS_BR);
    for (int it = gw; it < DB * 4 * DS; it += NGW) {
        const int b = it >> 5, h = (it >> 3) & 3, t = it & 7; float os[2];
        const float far = C.in[I_RELB][31 * 4 + h];
#pragma unroll
        for (int s = 0; s < 2; ++s) {
            const float* pb = WSP(float, WS_PART) + ((((size_t)b * 4 + h) * 16) * 16 + s * 8 + t) * PSTR;
            float sn[8]; float mm = -INFINITY;
            for (int pi = 0; pi < 16; ++pi) mm = fmaxf(mm, pb[(size_t)pi * 16 * PSTR + 64]);
#pragma unroll
            for (int jj = 0; jj < 8; ++jj) { float d = 0.f;
                for (int i = 0; i < 32; ++i) d += bf2f(QNB[(size_t)(MP + b * 8 + t) * 256 + h * 64 + s * 32 + i]) * bf2f(KNB[(size_t)(MP + b * 8 + jj) * 256 + h * 64 + s * 32 + i]);
                d += (C.in[I_RELB][t5_bucket(t - jj < 0 ? 0 : t - jj) * 4 + h] - far) * LOG2E;
                sn[jj] = jj <= t ? d : -INFINITY; mm = fmaxf(mm, sn[jj]); }
            float ll = 0.f, oo = 0.f;
            for (int pi = 0; pi < 16; ++pi) { const float* pr = pb + (size_t)pi * 16 * PSTR; const float w = exp2f(pr[64] - mm); ll += pr[65] * w; oo += pr[lane] * w; }
#pragma unroll
            for (int jj = 0; jj < 8; ++jj) { const float w = exp2f(sn[jj] - mm); ll += w; oo += w * bf2f(ZM[(size_t)(MP + b * 8 + jj) * NMIXP + D_V + h * 64 + lane]); }
            os[s] = oo / ll;
        }
        const float o = os[0] - lam * os[1]; const float ms = wave_sum(o * o) * (1.0f / 64);
        BR[(size_t)(MP + b * 8 + t) * D + 768 + h * 64 + lane] = (bf16)f2bf(o * rsqrtf(ms + EPS) * C.in[I_SUBLN][l * 64 + lane] * (1.0f - lam_init));
    }
}

__device__ __forceinline__ void n3_la_finalize(const Ctx& C, int l) {
    THREAD_IDS();
    const float* LAO = WSP(float, WS_LAO); const bf16* ZM = WSP(bf16, WS_ZMIX); bf16* BR = WSP(bf16, WS_BR);
    const bool ret = lane < 32; const int hd = (lane >> 3) & 3, c8 = (lane & 7) * 8;
    float gn[8];
#pragma unroll
    for (int j = 0; j < 8; ++j) gn[j] = (ret ? C.in[I_RGN] : C.in[I_GGN])[(l * 4 + hd) * 64 + c8 + j];
    for (int r = gw; r < MP; r += NGW) {
        const f32x4 a = *(const f32x4*)(LAO + (size_t)r * 512 + 8 * lane), b = *(const f32x4*)(LAO + (size_t)r * 512 + 8 * lane + 4);
        const v4u gw4 = *(const v4u*)(ZM + (size_t)r * NMIXP + (ret ? R_G : G_R) + hd * 64 + c8);
        float x[8] = {a[0], a[1], a[2], a[3], b[0], b[1], b[2], b[3]}, g[8]; unpack8(gw4, g);
        float s = ((x[0] + x[1]) + (x[2] + x[3])) + ((x[4] + x[5]) + (x[6] + x[7]));
        s += __shfl_xor(s, 1); s += __shfl_xor(s, 2); s += __shfl_xor(s, 4);
        const float mean = ret ? s * (1.0f / 64) : 0.f; float q2 = 0.f;
#pragma unroll
        for (int j = 0; j < 8; ++j) { x[j] -= mean; q2 += x[j] * x[j]; }
        q2 += __shfl_xor(q2, 1); q2 += __shfl_xor(q2, 2); q2 += __shfl_xor(q2, 4);
        const float rs = rsqrtf(q2 * (1.0f / 64) + EPS);
#pragma unroll
        for (int j = 0; j < 8; ++j) x[j] = siluf_(g[j]) * x[j] * rs * gn[j];
        *(v4u*)(BR + (size_t)r * D + 256 + 8 * lane) = pack8(x);
    }
}

constexpr int NQB_ATT = (L + 127) / 128;
constexpr int IT_LA = 32, IT_SS = IT_LA + DB * 8, IT_AT = IT_SS + 16 * NQB_ATT, IT_LS = IT_AT + 32, IT_CV = IT_LS + (MR + 63) / 64, IT_END = IT_CV;
__device__ __forceinline__ void n2_phase(const Ctx& C, int l, float lam_init, int qslot) {
    THREAD_IDS();
    const float lam = lam_of(C, l, lam_init);
    float mb;
    { float mq = 0.f, mk = 0.f, mbias = 0.f;
#pragma unroll 1
      for (int i = 0; i < 32; ++i) { mq = fmaxf(mq, fabsf(C.in[I_QN][l * 32 + i])); mk = fmaxf(mk, fabsf(C.in[I_KN][l * 32 + i])); }
#pragma unroll 1
      for (int i = 0; i < 128; ++i) mbias = fmaxf(mbias, C.in[I_RELB][i] - C.in[I_RELB][31 * 4 + (i & 3)]);
      mb = 1.02f * 1.4426950408889634f * 5.656854249492381f * mq * mk + 1.4426950408889634f * mbias; }
    unsigned* qw = (unsigned*)(C.ws + WS_CTL) + CW_QUEUE + 64 * qslot;
    volatile LAS int* slot = (volatile LAS int*)(C.lds + MISC_OFF + 64);
    if (blockIdx.x < IT_LA) { const int it = blockIdx.x; const int b = (it >> 2) & 3, h = it & 3; if (it < 16) la_chunked<64, true>(C, l, false, b, h); else la_chunked<32, false>(C, l, false, b, h); }
#if defined(PROBE_ID)
    if (l == 0 && tid == 0) ((unsigned long long*)(C.ws + WS_CTL + 65536))[blockIdx.x * 16 + 3] = __builtin_amdgcn_s_memrealtime();
#endif
    for (;;) {
        if (tid == 0) slot[0] = (int)__hip_atomic_fetch_add(qw, 1u, __ATOMIC_RELAXED, __HIP_MEMORY_SCOPE_AGENT);
        __syncthreads();
        const int qi = slot[0];
        const int it = qi < 2 * DB * 8 ? ((qi & 1) ? IT_SS + (qi >> 1) : IT_LA + (qi >> 1)) : qi + IT_LA;
        __syncthreads();
        if (it >= IT_END) break;
#ifndef PROBE_DBL
#define PROBE_DBL 0
#endif
        if (it < IT_SS) { const int i2 = it - IT_LA; attn_sample_item(C, l, i2 >> 3, i2 & 7); if (PROBE_DBL == 1) attn_sample_item(C, l, i2 >> 3, i2 & 7); }
        else if (it < IT_AT) { const int i2 = it - IT_SS; attn_prompt_item(C, l, (i2 & 15) >> 2, i2 & 3, NQB_ATT - 1 - (i2 >> 4), lam, lam_init, mb); if (PROBE_DBL == 2) attn_prompt_item(C, l, (i2 & 15) >> 2, i2 & 3, NQB_ATT - 1 - (i2 >> 4), lam, lam_init, mb); }
        else if (it < IT_LS) { const int i2 = (it - IT_AT) * 8 + wave; const int b = (i2 >> 2) & 31, h = i2 & 3; if (i2 < 128) la_seq<64, true>(C, l, true, b, h); else la_seq<32, false>(C, l, true, b, h); }
        else { conv_rows_item(C, l, it - IT_LS); if (PROBE_DBL == 3) conv_rows_item(C, l, it - IT_LS); conv_state_item(C, l, it - IT_LS, IT_CV - IT_LS); }
    }
}

#ifndef PROBE_ID
#define PROBE_ID 0
#endif
#define TSTAMP(k) do { if (PROBE_ID && l == 0 && threadIdx.x == 0) { ((unsigned long long*)(C.ws + WS_CTL + 65536))[blockIdx.x * 16 + (k)] = __builtin_amdgcn_s_memrealtime(); } } while (0)
template <int l> __device__ __forceinline__ void layer_fwd(const Ctx& C, const XcdBarrier& bar) {
#define GRID_BAR() xcd_barrier<false>(bar)
    LAS unsigned char* ring = C.lds + RING_OFF;
    float* SS = WSP(float, WS_SS); float* H = WSP(float, WS_H); bf16* HB = WSP(bf16, WS_HB); bf16* ACT = WSP(bf16, WS_ACT); bf16* ZMIX = WSP(bf16, WS_ZMIX); bf16* GATES = WSP(bf16, WS_GATES);
    bf16* BR = WSP(bf16, WS_BR); bf16* MERGED = WSP(bf16, WS_MERGED);
    constexpr float lam_init = l == 0 ? 0.2f : 0.35550906759096926f;
    constexpr bool last = (l == DEPTH - 1);
    TSTAMP(10);
    { pg8::Gemm g{HB, WSP(bf16, WS_W1 + (size_t)(l * 2 + 0) * SZ_W1), D, D, D}; pg8::StaticOrder S; S.init(M, 2 * DFF, C.G, (int)blockIdx.x);
      EpiGLU E{ACT, SS + (size_t)(l * 3 + 0) * M * 16}; pg8::gemm_phase<EpiGLU, pg8::StaticOrder, true, true>(ring, g, S, E); }
    GRID_BAR();
    { pg8::HeadOrder S; S.init(M, D, C.G, (int)blockIdx.x); S.limit = C.G; EpiRes<false, 1> E{H, HB, SS + (size_t)(l * 3 + 1) * M * 16, nullptr};
      { pg8::Gemm g{ACT, WSP(bf16, WS_WD + (size_t)(l * 2 + 0) * SZ_WD), DFF, DFF, DFF}; pg8::gemm_phase<EpiRes<false, 1>, pg8::HeadOrder, true, true>(ring, g, S, E); }
      { int kt = DFF / 11; asm volatile("" : "+s"(kt)); pg8::Gemm g{ACT, WSP(bf16, WS_WD + (size_t)(l * 2 + 0) * SZ_WD), DFF, DFF, kt}; pg8::TailOrder T; T.init(M, D, C.G, (int)blockIdx.x); T.limit = C.G; T.nsplit = 11; T.kper = DFF / 11;
        EpiPartial EP{WSP(float, WS_KSP)}; pg8::gemm_phase<EpiPartial, pg8::TailOrder, true, true>(ring, g, T, EP); }
      GRID_BAR();
      ksp_finalize<11>(WSP(float, WS_KSP), S, C.G, E); }
    GRID_BAR();
    { pg8::Gemm g{HB, WSP(bf16, WS_WIN + (size_t)l * SZ_WIN), D, D, D}; pg8::StaticOrder S; S.init(M, NINP, C.G, (int)blockIdx.x);
      EpiZ E{ZMIX, GATES, SS + (size_t)(l * 3 + 1) * M * 16, WSP(float, WS_BINP) + l * NINP}; pg8::gemm_phase<EpiZ, pg8::StaticOrder, true, true>(ring, g, S, E); }
    TSTAMP(15);
    GRID_BAR();
    TSTAMP(0);
    n1_prep(C, l);
    TSTAMP(1);
    GRID_BAR();
    TSTAMP(2);
    n2_phase(C, l, lam_init, l);
    TSTAMP(6);
    GRID_BAR();
    TSTAMP(7);
    n3_attn_sample_combine(C, l, lam_init);
    n3_la_finalize(C, l);
    TSTAMP(8);
    GRID_BAR();
    TSTAMP(9);
#if PROBE_ID == 500903
    GRID_BAR();
    TSTAMP(3);
#endif
    { pg8::Gemm g{BR, WSP(bf16, WS_WBR + (size_t)l * SZ_WBR), D, D, D}; pg8::StaticOrder S; S.init(M, D, C.G, (int)blockIdx.x);
      EpiMergeR E{MERGED, GATES}; pg8::gemm_phase<EpiMergeR, pg8::StaticOrder, true, true, 4>(ring, g, S, E); }
    TSTAMP(11);
    GRID_BAR();
    TSTAMP(12);
    { pg8::HeadOrder S; S.init(M, D, C.G, (int)blockIdx.x); S.limit = C.G; EpiRes<false, 2> E{H, HB, SS + (size_t)(l * 3 + 2) * M * 16, nullptr};
      { pg8::Gemm g{MERGED, WSP(bf16, WS_WOUT + (size_t)l * SZ_WOUT), D, D, D}; pg8::gemm_phase<EpiRes<false, 2>, pg8::HeadOrder, true, true>(ring, g, S, E); }
      { int kt = D / 4; asm volatile("" : "+s"(kt)); pg8::Gemm g{MERGED, WSP(bf16, WS_WOUT + (size_t)l * SZ_WOUT), D, D, kt}; pg8::TailOrder T; T.init(M, D, C.G, (int)blockIdx.x); T.limit = C.G; T.nsplit = 4; T.kper = D / 4;
        EpiPartial EP{WSP(float, WS_KSP)}; pg8::gemm_phase<EpiPartial, pg8::TailOrder, true, true>(ring, g, T, EP); }
      GRID_BAR();
      ksp_finalize<4>(WSP(float, WS_KSP), S, C.G, E); }
    TSTAMP(13);
    GRID_BAR();
    TSTAMP(14);
    { pg8::Gemm g{HB, WSP(bf16, WS_W1 + (size_t)(l * 2 + 1) * SZ_W1), D, D, D}; pg8::StaticOrder S; S.init(M, 2 * DFF, C.G, (int)blockIdx.x);
      EpiGLU E{ACT, SS + (size_t)(l * 3 + 2) * M * 16}; pg8::gemm_phase<EpiGLU, pg8::StaticOrder, true, true>(ring, g, S, E); }
    GRID_BAR();
    { pg8::HeadOrder S; S.init(M, D, C.G, (int)blockIdx.x); S.limit = C.G; EpiRes<last, 1> E{H, HB, last ? nullptr : SS + (size_t)((l + 1) * 3) * M * 16, C.out};
      { pg8::Gemm g{ACT, WSP(bf16, WS_WD + (size_t)(l * 2 + 1) * SZ_WD), DFF, DFF, DFF}; pg8::gemm_phase<EpiRes<last, 1>, pg8::HeadOrder, true, true>(ring, g, S, E); }
      { int kt = DFF / 11; asm volatile("" : "+s"(kt)); pg8::Gemm g{ACT, WSP(bf16, WS_WD + (size_t)(l * 2 + 1) * SZ_WD), DFF, DFF, kt}; pg8::TailOrder T; T.init(M, D, C.G, (int)blockIdx.x); T.limit = C.G; T.nsplit = 11; T.kper = DFF / 11;
        EpiPartial EP{WSP(float, WS_KSP)}; pg8::gemm_phase<EpiPartial, pg8::TailOrder, true, true>(ring, g, T, EP); }
      GRID_BAR();
      ksp_finalize<11>(WSP(float, WS_KSP), S, C.G, E); }
#undef GRID_BAR
}

__global__ void __launch_bounds__(NWAVES * 64, 2) fwd(Params P) {
    extern __shared__ __attribute__((aligned(16))) unsigned char lds[];
    Ctx C;
    C.in = P.in; C.out = P.out; C.ws = P.ws; C.lds = (LAS unsigned char*)lds;
    C.G = gridDim.x;
    volatile LAS unsigned* MISC = (volatile LAS unsigned*)(C.lds + MISC_OFF);
    for (int u = threadIdx.x; u < (LDS_BYTES - LDSCTL_OFF) / 4; u += NWAVES * 64) ((LAS unsigned*)(C.lds + LDSCTL_OFF))[u] = 0u;
    __syncthreads();
    unsigned* ctl = (unsigned*)(C.ws + WS_CTL);
    XcdBarrier bar = xcd_barrier_post(ctl + CW_BAR, MISC + 8);
    p0_prologue(C, P);
#if PROBE_ID == 700001
    p0_prologue(C, P);
#endif
    xcd_barrier<true>(bar);
    layer_fwd<0>(C, bar);
    xcd_barrier<false>(bar);
    layer_fwd<1>(C, bar);
#if PROBE_ID
    xcd_barrier<false>(bar);
    if (blockIdx.x == 0 && threadIdx.x == 0) { const unsigned long long* ts = (const unsigned long long*)(C.ws + WS_CTL + 65536);
        const int pb = PROBE_ID / 1000, k0 = (PROBE_ID / 10) % 100 % 10, k1 = PROBE_ID % 10;
        float val = (float)(ts[pb * 16 + k1] - ts[pb * 16 + k0]) * 0.001f;
        if (PROBE_ID >= 600000 && PROBE_ID < 700000) val = (float)ts[((PROBE_ID - 600000) / 100) * 16 + PROBE_ID % 100] * 0.001f;
        if (PROBE_ID >= 500000 && PROBE_ID < 600000) val = (float)(ts[PROBE_ID % 100] - ts[(PROBE_ID / 100) % 100]) * 0.001f;
        C.out[O_YP] = val; }
#endif
}

extern "C" void kernel_launch(void* const* d_in, const int* in_sizes, int n_in, void* d_out, int out_size, void* d_ws, size_t ws_size, hipStream_t stream) {
    static int grid = 0;
    if (grid == 0) {
        if (n_in != N_INPUTS || (size_t)out_size != O_END || ws_size < WS_END) { fprintf(stderr, "kernel_launch: unexpected shapes: n_in %d out %d (want %zu) ws %zu (want %zu)\n", n_in, out_size, (size_t)O_END, ws_size, (size_t)WS_END); grid = -1; return; }
        int dev = 0, cus = 0, per_cu = 0;
        if (hipGetDevice(&dev) != hipSuccess || hipDeviceGetAttribute(&cus, hipDeviceAttributeMultiprocessorCount, dev) != hipSuccess) { grid = -1; return; }
        if (hipFuncSetAttribute((const void*)fwd, hipFuncAttributeMaxDynamicSharedMemorySize, LDS_BYTES) != hipSuccess) { fprintf(stderr, "kernel_launch: hipFuncSetAttribute failed\n"); grid = -1; return; }
        if (hipOccupancyMaxActiveBlocksPerMultiprocessor(&per_cu, (const void*)fwd, NWAVES * 64, LDS_BYTES) != hipSuccess || per_cu < 1) { fprintf(stderr, "kernel_launch: occupancy query says %d blocks per CU\n", per_cu); }
        (void)hipGetLastError();
        grid = cus;
    }
    if (grid < 0) return;
    if (hipMemsetAsync((char*)d_ws + WS_CTL, 0, CTL_ZERO_BYTES, stream) != hipSuccess) return;
    Params p{};
    for (int i = 0; i < N_INPUTS; ++i) p.in[i] = (const float*)d_in[i];
    p.out = (float*)d_out; p.ws = (unsigned char*)d_ws;
    for (int i = 0; i < 32; ++i) p.inv_freq[i] = (float)pow(10000.0, -(double)i / 32.0);
    hipLaunchKernelGGL(fwd, dim3(grid), dim3(NWAVES * 64), LDS_BYTES, stream, p);
}
```

```cpp
#include <hip/hip_runtime.h>
#include <cstdio>
#include <cstdint>
#include <cmath>

namespace pg8 {
#define PG8_LAS __attribute__((address_space(3)))
typedef unsigned short bf16_t;
typedef short bf16x8 __attribute__((ext_vector_type(8)));
typedef float f32x4 __attribute__((ext_vector_type(4)));
typedef unsigned u32x4 __attribute__((ext_vector_type(4)));
constexpr int BM = 256, BK = 64, HALF = 128, HTB = HALF * BK * 2  , STAGE_BYTES = 8 * HTB, NXCD = 8, WGM = 8;

__host__ __device__ __forceinline__ int lds_byte(int r, int c) { const int st = (r >> 4) * 2 + (c >> 5), rr = r & 15, cc = c & 31, ob = rr * 64 + cc * 2; return st * 1024 + (ob ^ (((ob >> 9) & 1) << 5)); }
__host__ __device__ __forceinline__ void stage_rc(int b, int& R, int& C) { const int st = b / 1024, sb = b % 1024, swz = sb ^ (((sb >> 9) & 1) << 5); R = (st >> 1) * 16 + swz / 64; C = (st & 1) * 32 + (swz % 64) / 2; }
__host__ __device__ __forceinline__ int perm32(int rho) { const int n = rho >> 4, i = rho & 15; return 8 * (i >> 2) + 4 * n + (i & 3); }

struct Unit { int pm, pn, acol, bcol; };
struct Gemm { const bf16_t* A; const bf16_t* Bt; int lda, ldb, K; };

struct StaticOrder {
    int nM, nN, nwg, G, c;
    __host__ __device__ void init(int M, int N, int G_, int c_) { nM = M / BM; nN = N / BM; nwg = nM * nN; G = G_; c = c_; }
    __host__ __device__ void unit_of(int L, Unit& u) const {
        int wgid = L; { const int q = nwg / NXCD, r = nwg % NXCD, xcd = wgid % NXCD, off = wgid / NXCD; wgid = (xcd < r ? xcd * (q + 1) : r * (q + 1) + (xcd - r) * q) + off; }
        const int nig = WGM * nN, gid = wgid / nig, fm = gid * WGM, gsz = (nM - fm) < WGM ? (nM - fm) : WGM;
        u.pm = fm + ((wgid % nig) % gsz); u.pn = (wgid % nig) / gsz; u.acol = 0; u.bcol = 0;
    }
    __host__ __device__ bool next(int i, Unit& u) const { const long L = (long)i * G + c; if (L >= nwg) return false; unit_of((int)L, u); return true; }
};
struct HeadOrder : StaticOrder { int limit; __host__ __device__ bool next(int i, Unit& u) const { const long L = (long)i * G + c; if (L >= limit || L >= nwg) return false; unit_of((int)L, u); return true; } };
struct TailOrder : StaticOrder { int limit, nsplit, kper;
    __host__ __device__ bool next(int i, Unit& u) const {
        if (i > 0 || c >= (nwg - limit) * nsplit) return false;
        unit_of(limit + c / nsplit, u); u.acol = u.bcol = (c % nsplit) * kper; return true; } };
__device__ __forceinline__ unsigned cvt_pk_bf16(float lo, float hi) { unsigned r; asm volatile("v_cvt_pk_bf16_f32 %0, %1, %2" : "=v"(r) : "v"(lo), "v"(hi)); return r; }

template <class Epi, class Sched, bool ALIGN_EPI = false, bool SP2 = false, int SEG = 0>
__device__ __forceinline__ void gemm_phase(PG8_LAS unsigned char* lds, const Gemm g, const Sched& S, const Epi& E) {
    int tid_ = threadIdx.x; asm volatile("" : "+v"(tid_));
    const int tid = tid_, wid = __builtin_amdgcn_readfirstlane(tid >> 6), lane = tid & 63, wr = wid >> 2, wc = wid & 3, fr = lane & 15, fq = lane >> 4;
    const int nt = g.K / BK;
    unsigned voffA[2], voffB[2];
#pragma unroll
    for (int i = 0; i < 2; ++i) { int R, C; stage_rc(tid * 16 + i * 8192, R, C); const int Rb = Epi::PERM ? ((R & ~31) + perm32(R & 31)) : R;
        voffA[i] = (unsigned)(R * g.lda + C) * 2u; voffB[i] = (unsigned)(Rb * g.ldb + C) * 2u; }
    const size_t kstep = (size_t)(BK * 2);
    const size_t hstepA = (size_t)HALF * g.lda * 2, hstepB = (size_t)HALF * g.ldb * 2;
    const size_t tstepA = 2 * hstepA, tstepB = 2 * hstepB;
    const unsigned ldsw = (unsigned)wid * 1024u;
    const int aoff = lds_byte(wr * 64 + fr, fq * 8), boff = lds_byte(wc * 32 + fr, fq * 8);
#define PG8_SA(b, h) (((b) * 2 + (h)) * HTB)
#define PG8_SB(b, h) ((4 + (b) * 2 + (h)) * HTB)
#define PG8_STAGE(bufoff, gbase, voff) do { _Pragma("unroll") for (int _i = 0; _i < 2; ++_i) \
        __builtin_amdgcn_global_load_lds((const unsigned*)((const char*)(gbase) + (voff)[_i]), (PG8_LAS unsigned*)(lds + (bufoff) + ldsw + _i * 8192), 16, 0, 0); } while (0)
#define PG8_LDA(dst, b, h) do { _Pragma("unroll") for (int m = 0; m < 4; ++m) _Pragma("unroll") for (int k = 0; k < 2; ++k) dst[m][k] = *(const PG8_LAS bf16x8*)(lds + PG8_SA(b, h) + aoff + m * 2048 + k * 1024); } while (0)
#define PG8_LDB(dst, b, h) do { _Pragma("unroll") for (int n = 0; n < 2; ++n) _Pragma("unroll") for (int k = 0; k < 2; ++k) dst[n][k] = *(const PG8_LAS bf16x8*)(lds + PG8_SB(b, h) + boff + n * 2048 + k * 1024); } while (0)
#define PG8_MMA(ai, bj, At, Bt) do { __builtin_amdgcn_s_setprio(1); _Pragma("unroll") for (int m = 0; m < 4; ++m) _Pragma("unroll") for (int n = 0; n < 2; ++n) _Pragma("unroll") for (int k = 0; k < 2; ++k) \
        acc[ai][bj][m][n] = __builtin_amdgcn_mfma_f32_16x16x32_bf16(Bt[n][k], At[m][k], acc[ai][bj][m][n], 0, 0, 0); __builtin_amdgcn_s_setprio(0); } while (0)
#define PG8_WAIT_V(n) asm volatile("s_waitcnt vmcnt(" #n ")" ::: "memory")
#define PG8_WAIT_L(n) asm volatile("s_waitcnt lgkmcnt(" #n ")" ::: "memory")
#define PG8_BAR __builtin_amdgcn_s_barrier()
#define PG8_SCHED __builtin_amdgcn_sched_barrier(0)
    Unit cur, nxt; int ui = 0;
    if (!S.next(0, cur)) return;
    f32x4 acc[2][2][4][2];
#pragma unroll
    for (int a = 0; a < 2; ++a)
#pragma unroll
        for (int b = 0; b < 2; ++b)
#pragma unroll
            for (int m = 0; m < 4; ++m)
#pragma unroll
                for (int n = 0; n < 2; ++n) acc[a][b][m][n] = (f32x4){0.f, 0.f, 0.f, 0.f};
    bf16x8 At[4][2], B0[2][2], B1[2][2];
    const char* cA = (const char*)g.A + (size_t)cur.pm * tstepA + (size_t)cur.acol * 2; const char* cB = (const char*)g.Bt + (size_t)cur.pn * tstepB + (size_t)cur.bcol * 2;
    if constexpr (SP2) {
        PG8_STAGE(PG8_SB(0, 0), cB, voffB); PG8_STAGE(PG8_SB(0, 1), cB + hstepB, voffB); PG8_STAGE(PG8_SA(0, 0), cA, voffA); PG8_STAGE(PG8_SA(0, 1), cA + hstepA, voffA);
        if (wr == 1) PG8_BAR;
        PG8_WAIT_V(2); PG8_BAR;
        PG8_STAGE(PG8_SB(1, 0), cB + kstep, voffB); PG8_STAGE(PG8_SA(1, 0), cA + kstep, voffA); PG8_STAGE(PG8_SB(1, 1), cB + hstepB + kstep, voffB);
        PG8_WAIT_V(6); PG8_BAR;
    } else {
        PG8_STAGE(PG8_SB(0, 0), cB, voffB); PG8_STAGE(PG8_SA(0, 0), cA, voffA); PG8_STAGE(PG8_SB(0, 1), cB + hstepB, voffB); PG8_STAGE(PG8_SA(0, 1), cA + hstepA, voffA);
        if (wr == 1) PG8_BAR;
        PG8_WAIT_V(4); PG8_BAR;
        PG8_STAGE(PG8_SB(1, 0), cB + kstep, voffB); PG8_STAGE(PG8_SA(1, 0), cA + kstep, voffA); PG8_STAGE(PG8_SB(1, 1), cB + hstepB + kstep, voffB);
        PG8_WAIT_V(6); PG8_BAR;
    }
    for (;;) {
        const bool has_next = S.next(ui + 1, nxt);
        const char* nA = has_next ? (const char*)g.A + (size_t)nxt.pm * tstepA + (size_t)nxt.acol * 2 : cA; const char* nB = has_next ? (const char*)g.Bt + (size_t)nxt.pn * tstepB + (size_t)nxt.bcol * 2 : cB;
        for (int t = 0; t < nt; t += 2) {
            const bool last = (t == nt - 2);
            const char* a1 = cA + (size_t)(t + 1) * kstep;
            const char* a2 = last ? nA : cA + (size_t)(t + 2) * kstep; const char* b2 = last ? nB : cB + (size_t)(t + 2) * kstep;
            const char* a3 = a2 + kstep; const char* b3 = b2 + kstep;
            if constexpr (SP2) {
            PG8_LDB(B0, 0, 0); PG8_LDB(B1, 0, 1); PG8_SCHED; PG8_LDA(At, 0, 0); PG8_STAGE(PG8_SA(1, 1), a1 + hstepA, voffA);
            PG8_WAIT_V(8); PG8_WAIT_L(0); PG8_BAR; PG8_MMA(0, 0, At, B0); PG8_MMA(0, 1, At, B1); PG8_BAR; PG8_SCHED;
            PG8_LDA(At, 0, 1); PG8_STAGE(PG8_SB(0, 0), b2, voffB); PG8_STAGE(PG8_SB(0, 1), b2 + hstepB, voffB); PG8_STAGE(PG8_SA(0, 0), a2, voffA);
            PG8_WAIT_V(8); PG8_WAIT_L(0); PG8_BAR; PG8_MMA(1, 0, At, B0); PG8_MMA(1, 1, At, B1); PG8_BAR; PG8_SCHED;
            PG8_LDB(B0, 1, 0); PG8_LDB(B1, 1, 1); PG8_SCHED; PG8_LDA(At, 1, 0); PG8_STAGE(PG8_SA(0, 1), a2 + hstepA, voffA);
            PG8_WAIT_V(8); PG8_WAIT_L(0); PG8_BAR; PG8_MMA(0, 0, At, B0); PG8_MMA(0, 1, At, B1); PG8_BAR; PG8_SCHED;
            PG8_LDA(At, 1, 1); PG8_STAGE(PG8_SB(1, 0), b3, voffB); PG8_STAGE(PG8_SB(1, 1), b3 + hstepB, voffB); PG8_STAGE(PG8_SA(1, 0), a3, voffA);
            PG8_WAIT_V(8); PG8_WAIT_L(0); PG8_BAR; PG8_MMA(1, 0, At, B0); PG8_MMA(1, 1, At, B1); PG8_BAR; PG8_SCHED;
            } else {
            PG8_LDB(B0, 0, 0); PG8_SCHED; PG8_LDA(At, 0, 0); PG8_STAGE(PG8_SA(1, 1), a1 + hstepA, voffA);
            PG8_WAIT_L(8); PG8_BAR; PG8_WAIT_L(0); PG8_MMA(0, 0, At, B0); PG8_BAR; PG8_SCHED;
            PG8_LDB(B1, 0, 1); PG8_STAGE(PG8_SB(0, 0), b2, voffB);
            PG8_BAR; PG8_WAIT_L(0); PG8_MMA(0, 1, At, B1); PG8_BAR;
            PG8_LDA(At, 0, 1); PG8_STAGE(PG8_SA(0, 0), a2, voffA);
            PG8_BAR; PG8_WAIT_L(0); PG8_MMA(1, 0, At, B0); PG8_BAR; PG8_SCHED;
            PG8_STAGE(PG8_SB(0, 1), b2 + hstepB, voffB);
            PG8_WAIT_V(6); PG8_BAR; PG8_MMA(1, 1, At, B1); PG8_BAR;
            PG8_LDB(B0, 1, 0); PG8_SCHED; PG8_LDA(At, 1, 0); PG8_STAGE(PG8_SA(0, 1), a2 + hstepA, voffA);
            PG8_WAIT_L(8); PG8_BAR; PG8_WAIT_L(0); PG8_MMA(0, 0, At, B0); PG8_BAR; PG8_SCHED;
            PG8_LDB(B1, 1, 1); PG8_STAGE(PG8_SB(1, 0), b3, voffB);
            PG8_BAR; PG8_WAIT_L(0); PG8_MMA(0, 1, At, B1); PG8_BAR;
            PG8_LDA(At, 1, 1); PG8_STAGE(PG8_SA(1, 0), a3, voffA);
            PG8_BAR; PG8_WAIT_L(0); PG8_MMA(1, 0, At, B0); PG8_BAR; PG8_SCHED;
            PG8_STAGE(PG8_SB(1, 1), b3 + hstepB, voffB);
            PG8_WAIT_V(6); PG8_BAR; PG8_MMA(1, 1, At, B1); PG8_BAR;
            }
            if constexpr (SEG > 0) { if (((t + 2) % SEG) == 0 && (t + 2) < nt) E.mid(acc, cur, (t + 2) / SEG); }
        }
        if constexpr (ALIGN_EPI) { if (wr == 0) PG8_BAR; }
        E(acc, cur, wr, wc, fr, fq);
        if (!has_next) break;
#pragma unroll
        for (int a = 0; a < 2; ++a)
#pragma unroll
            for (int b = 0; b < 2; ++b)
#pragma unroll
                for (int m = 0; m < 4; ++m)
#pragma unroll
                    for (int n = 0; n < 2; ++n) acc[a][b][m][n] = (f32x4){0.f, 0.f, 0.f, 0.f};
        cur = nxt; cA = nA; cB = nB; ++ui;
        if constexpr (ALIGN_EPI) { if (wr == 1) PG8_BAR; }
    }
    PG8_WAIT_V(0);
    if constexpr (!ALIGN_EPI) { if (wr == 0) PG8_BAR; }
    PG8_BAR;
#undef PG8_SA
#undef PG8_SB
#undef PG8_STAGE
#undef PG8_LDA
#undef PG8_LDB
#undef PG8_MMA
#undef PG8_WAIT_V
#undef PG8_WAIT_L
#undef PG8_BAR
#undef PG8_SCHED
}
}

constexpr int NWAVES = 8;
constexpr int D = 1024, DFF = 2816, NIN = 7184, NMIX = 3088, NMIXP = 3328, NGATE = 4096, NINP = NMIXP + NGATE;
constexpr int SEQ = 4096, NMETA = 16, L = SEQ + NMETA, BATCH = 4, DB = 32, DS = 8, PAST = 8192, PAGE = 128, NPAGES = PAST / PAGE, NPOOL = 2560, DEPTH = 2;
constexpr int MP = BATCH * L, MS = DB * DS, MR = MP + MS, M = 16896;
constexpr int NPOS = L + DS;
constexpr float EPS = 1e-6f;
constexpr int C_A = 0, C_G = 256, R_Q = 512, R_K = 768, R_V = 1024, R_G = 1280, G_Q = 1536, G_K = 1664, G_V = 1792, G_R = 2048, G_LOW = 2304, D_Q = 2320, D_K = 2576, D_V = 2832;
constexpr size_t O_YP = 0, O_YS = O_YP + (size_t)BATCH * SEQ * D, O_KP = O_YS + (size_t)MS * D, O_VP = O_KP + (size_t)DEPTH * MP * 256, O_KS = O_VP + (size_t)DEPTH * MP * 256,
                 O_VS = O_KS + (size_t)DEPTH * MS * 256, O_RP = O_VS + (size_t)DEPTH * MS * 256, O_RS = O_RP + (size_t)DEPTH * BATCH * 4 * 64 * 64, O_GP = O_RS + (size_t)DEPTH * DB * 4 * 64 * 64,
                 O_GS = O_GP + (size_t)DEPTH * BATCH * 4 * 32 * 64, O_CP = O_GS + (size_t)DEPTH * DB * 4 * 32 * 64, O_CS = O_CP + (size_t)DEPTH * BATCH * 30 * 256, O_END = O_CS + (size_t)DEPTH * DB * 30 * 256;
enum { I_XP = 0, I_XS, I_CK, I_CV, I_PT, I_SRET, I_SGLA, I_SCONV, I_META, I_RELB, I_NF1, I_F1G, I_F1U, I_F1D, I_NMIX, I_WIN, I_BIN, I_CW, I_CB, I_CLG, I_CLB, I_RGN, I_GAW, I_GAB, I_GGN,
       I_QN, I_KN, I_LQ1, I_LK1, I_LQ2, I_LK2, I_SUBLN, I_WBR, I_WOUT, I_NF2, I_F2G, I_F2U, I_F2D, N_INPUTS };

constexpr size_t MiB = 1u << 20;
constexpr size_t WS_CTL = 0, CTL_ZERO_BYTES = 1 * MiB;
constexpr size_t SZ_SS = (size_t)M * 16 * 4;
constexpr size_t SZ_W1 = (size_t)2 * DFF * D * 2, SZ_WD = (size_t)D * DFF * 2, SZ_WIN = (size_t)NINP * D * 2, SZ_WBR = (size_t)4 * D * 256 * 2, SZ_WOUT = (size_t)D * D * 2;
constexpr size_t WS_W1 = 4 * MiB;
constexpr size_t WS_WD = WS_W1 + 4 * SZ_W1;
constexpr size_t WS_WIN = WS_WD + 4 * SZ_WD;
constexpr size_t WS_WBR = WS_WIN + 2 * SZ_WIN;
constexpr size_t WS_WOUT = WS_WBR + 2 * SZ_WBR;
constexpr size_t WS_BINP = WS_WOUT + 2 * SZ_WOUT;
constexpr size_t WS_ROPE = WS_BINP + 64 * 1024;
constexpr size_t WS_SS = WS_ROPE + 2 * MiB;
constexpr size_t WS_H = 128 * MiB;
constexpr size_t WS_HB = WS_H + (size_t)M * D * 4;
constexpr size_t WS_ACT = WS_HB + (size_t)M * D * 2;
constexpr size_t WS_ZMIX = WS_ACT + (size_t)M * DFF * 2;
constexpr size_t WS_GATES = WS_ZMIX + (size_t)M * NMIXP * 2;
constexpr size_t WS_BR = WS_GATES + (size_t)M * NGATE * 2;
constexpr size_t WS_MERGED = WS_BR + (size_t)M * D * 2;
constexpr size_t WS_UBUF = WS_MERGED + (size_t)M * D * 2;
constexpr size_t WS_RQ = WS_UBUF + (size_t)M * 256 * 4, WS_RK = WS_RQ + (size_t)M * 256 * 4, WS_QN = WS_RK + (size_t)M * 256 * 4, WS_KN = WS_QN + (size_t)M * 256 * 4, WS_VB = WS_KN + (size_t)M * 256 * 4;
constexpr size_t WS_LDEC = WS_VB + (size_t)M * 256 * 4;
constexpr size_t WS_QNB = WS_LDEC + (size_t)M * 128 * 4;
constexpr size_t WS_KNB = WS_QNB + (size_t)M * 256 * 2;
constexpr size_t WS_PART = WS_KNB + (size_t)M * 256 * 2;
constexpr size_t WS_LAO = WS_PART + (size_t)DB * 4 * 16 * 16 * 68 * 4;
constexpr size_t WS_KSP = WS_LAO + (size_t)M * 512 * 4;
constexpr size_t WS_END = WS_KSP + (size_t)8 * 11 * 65536 * 4;
static_assert(WS_ROPE + 2 * NPOS * 32 * 4 <= WS_SS && WS_SS + 6 * SZ_SS <= WS_H, "weights region overflows");
constexpr int CW_BAR = 4096, CW_QUEUE = 8192;

constexpr int RING_OFF = 0, RING_BYTES = 131072;
constexpr int LDSCTL_OFF = 144384, MISC_OFF = LDSCTL_OFF + 320;
constexpr int LDS_BYTES = 147456;
static_assert(MISC_OFF + 128 <= LDS_BYTES, "LDS map");

#define GAS __attribute__((address_space(1)))
#define LAS __attribute__((address_space(3)))
typedef unsigned short bf16;
typedef unsigned v4u __attribute__((ext_vector_type(4)));
typedef float f32x4 __attribute__((ext_vector_type(4)));
#define LDS_WAIT() asm volatile("s_waitcnt lgkmcnt(0)" ::: "memory")
#define VM_WAIT() asm volatile("s_waitcnt vmcnt(0)" ::: "memory")
__device__ __forceinline__ unsigned f2bf(float f) { unsigned u = __builtin_bit_cast(unsigned, f); return (u + 0x7fffu + ((u >> 16) & 1u)) >> 16; }
__device__ __forceinline__ unsigned pk2(float lo, float hi) { return f2bf(lo) | (f2bf(hi) << 16); }
__device__ __forceinline__ float bf2f(bf16 b) { return __builtin_bit_cast(float, ((unsigned)b) << 16); }
__device__ __forceinline__ float bflo(unsigned w) { return __builtin_bit_cast(float, w << 16); }
__device__ __forceinline__ float bfhi(unsigned w) { return __builtin_bit_cast(float, w & 0xffff0000u); }
__device__ __forceinline__ float wave_sum(float v) {
#pragma unroll
    for (int o = 1; o < 64; o <<= 1) v += __shfl_xor(v, o);
    return v;
}
__device__ __forceinline__ float sigmoidf_(float x) { return __builtin_amdgcn_rcpf(1.0f + __expf(-x)); }
__device__ __forceinline__ float siluf_(float x) { return x * __builtin_amdgcn_rcpf(1.0f + __expf(-x)); }

#define XB_TMO      128
#define XB_XCNT(j)  (256  + 64 * (j))
#define XB_XSUB(j)  (1280 + 64 * (j))
#define XB_XGEN(j)  (2304 + 64 * (j))
#define XB_TOP      3328
#define XB_TOPGEN   3392
#define XCD_BAR_WORDS 3456
#define XB_SPIN_CAP (1u << 22)

__device__ __forceinline__ unsigned xb_ld(unsigned* p)              { return __hip_atomic_load(p, __ATOMIC_RELAXED, __HIP_MEMORY_SCOPE_AGENT); }
__device__ __forceinline__ unsigned xb_add(unsigned* p, unsigned v) { return __hip_atomic_fetch_add(p, v, __ATOMIC_RELAXED, __HIP_MEMORY_SCOPE_AGENT); }
__device__ __forceinline__ unsigned xb_xcc_id() { return (unsigned)__builtin_amdgcn_s_getreg((3 << 11) | 20) & 0xFu; }
#define XB_SPIN(cond, bar) do { unsigned _sp = 0; while (cond) { __builtin_amdgcn_s_sleep(1); \
    if ((++_sp & 255u) == 0u) { if (xb_ld(&(bar)[XB_TMO])) break; if (_sp > XB_SPIN_CAP) { atomicAdd(&(bar)[XB_TMO], 1u); break; } } } } while (0)

struct XcdBarrier { unsigned* bar; unsigned x; volatile LAS unsigned* st; };

__device__ __forceinline__ XcdBarrier xcd_barrier_post(unsigned* bar, volatile LAS unsigned* st) {
    XcdBarrier b; b.bar = bar; b.x = xb_xcc_id(); b.st = st;
    if (threadIdx.x == 0) (void)xb_add(&bar[XB_XCNT(b.x)], 1u);
    return b;
}
__device__ __forceinline__ void xcd_barrier_complete(unsigned* bar, unsigned x, unsigned& nloc, unsigned& nx) {
    const unsigned G = gridDim.x * gridDim.y * gridDim.z;
    unsigned sum, cnt, mine, sp = 0u;
    for (;;) {
        sum = 0u; cnt = 0u; mine = 0u;
#pragma unroll
        for (unsigned j = 0; j < 16; ++j) { const unsigned c = xb_ld(&bar[XB_XCNT(j)]); sum += c; cnt += (c > 0u) ? 1u : 0u; mine = (j == x) ? c : mine; }
        if (sum == G) break;
        __builtin_amdgcn_s_sleep(1);
        if ((++sp & 255u) == 0u) { if (xb_ld(&bar[XB_TMO])) break; if (sp > XB_SPIN_CAP) { atomicAdd(&bar[XB_TMO], 1u); break; } }
    }
    nloc = mine > 0u ? mine : 1u; nx = cnt > 0u ? cnt : 1u;
}
#ifndef FLAT_BAR
#define FLAT_BAR 0
#endif
__device__ __forceinline__ void flat_barrier(const XcdBarrier& b) {
    asm volatile("s_waitcnt vmcnt(0)" ::: "memory");
    __syncthreads();
    if (threadIdx.x == 0) {
        unsigned* bar = b.bar;
        asm volatile("" : "+s"(bar));
        const unsigned epoch = b.st[2] + 1u; b.st[2] = epoch; const unsigned target = epoch * gridDim.x;
        __builtin_amdgcn_fence(__ATOMIC_RELEASE, "agent");
        asm volatile("s_waitcnt vmcnt(0)" ::: "memory");
        (void)xb_add(&bar[XB_TOP], 1u);
        unsigned sp = 0u;
        while (xb_ld(&bar[XB_TOP]) < target) { __builtin_amdgcn_s_sleep(1); if ((++sp & 255u) == 0u) { if (xb_ld(&bar[XB_TMO])) break; if (sp > XB_SPIN_CAP) { atomicAdd(&bar[XB_TMO], 1u); break; } } }
        __builtin_amdgcn_fence(__ATOMIC_ACQUIRE, "agent");
        asm volatile("s_waitcnt vmcnt(0)" ::: "memory");
    }
    __syncthreads();
}
template <bool FIRST> __device__ __forceinline__ void xcd_barrier(const XcdBarrier& b) {
    if (FLAT_BAR) { flat_barrier(b); return; }
    asm volatile("s_waitcnt vmcnt(0)" ::: "memory");
    __syncthreads();
    if (threadIdx.x == 0) {
        unsigned* bar = b.bar;
        asm volatile("" : "+s"(bar));
        __builtin_amdgcn_s_waitcnt(0);
        unsigned nloc = b.st[0], nx = b.st[1];
        if (FIRST) { if (nloc == 0u) { xcd_barrier_complete(bar, b.x, nloc, nx); b.st[0] = nloc; b.st[1] = nx; } }
        const unsigned old = xb_add(&bar[XB_XSUB(b.x)], 1u);
        const unsigned gen = old / nloc;
        if (old + 1u == (gen + 1u) * nloc) {
            __builtin_amdgcn_fence(__ATOMIC_RELEASE, "agent");
            asm volatile("s_waitcnt vmcnt(0)" ::: "memory");
            const unsigned og = xb_add(&bar[XB_TOP], 1u);
            const unsigned tg = og / nx;
            if (og + 1u == (tg + 1u) * nx) xb_add(&bar[XB_TOPGEN], 1u);
            else XB_SPIN(xb_ld(&bar[XB_TOPGEN]) == tg, bar);
            __builtin_amdgcn_fence(__ATOMIC_ACQUIRE, "agent");
            xb_add(&bar[XB_XGEN(b.x)], 1u);
            asm volatile("s_waitcnt vmcnt(0)" ::: "memory");
        } else {
            XB_SPIN(xb_ld(&bar[XB_XGEN(b.x)]) == gen, bar);
            __builtin_amdgcn_fence(__ATOMIC_ACQUIRE, "agent");
            asm volatile("s_waitcnt vmcnt(0)" ::: "memory");
        }
    }
    __syncthreads();
}

struct Params { const float* in[N_INPUTS]; float* out; unsigned char* ws; float inv_freq[32]; };
static_assert(sizeof(Params) == N_INPUTS * 8 + 16 + 128, "Params has no padding");

struct Ctx {
    const float* const* in; float* out; unsigned char* ws;
    LAS unsigned char* lds;
    int G;
};
#define THREAD_IDS() int tid_ = threadIdx.x; asm volatile("" : "+v"(tid_)); const int tid = tid_, lane = tid & 63, wave = __builtin_amdgcn_readfirstlane(tid >> 6), gw = blockIdx.x * NWAVES + wave, NGW = C.G * NWAVES; (void)tid; (void)lane; (void)wave; (void)gw; (void)NGW
#define WSP(T, off) ((T*)(C.ws + (off)))

__device__ __forceinline__ float rstd_of(const float* ssp, int row) {
    const f32x4 a = *(const f32x4*)(ssp + (size_t)row * 16), b = *(const f32x4*)(ssp + (size_t)row * 16 + 4), c = *(const f32x4*)(ssp + (size_t)row * 16 + 8), d = *(const f32x4*)(ssp + (size_t)row * 16 + 12);
    const float s = (((a[0] + a[1]) + (a[2] + a[3])) + ((b[0] + b[1]) + (b[2] + b[3]))) + (((c[0] + c[1]) + (c[2] + c[3])) + ((d[0] + d[1]) + (d[2] + d[3])));
    return rsqrtf(s * (1.0f / D) + EPS);
}
#define EPI_IDS() int t_ = threadIdx.x; asm volatile("" : "+v"(t_)); const int wid_ = __builtin_amdgcn_readfirstlane(t_ >> 6), wr = wid_ >> 2, wc = wid_ & 3, fr = t_ & 15, fq = (t_ & 63) >> 4
struct EpiGLU {
    static constexpr bool PERM = true;
    bf16* act; const float* ss;
    __device__ __forceinline__ void operator()(const pg8::f32x4 (&acc)[2][2][4][2], const pg8::Unit& u, int, int, int, int) const {
        EPI_IDS();
        const int row0 = u.pm * 256 + wr * 64 + fr, col0 = u.pn * 128 + wc * 32 + 8 * fq;
#pragma unroll
        for (int ai = 0; ai < 2; ++ai)
#pragma unroll
            for (int m = 0; m < 4; ++m) {
                const int row = row0 + ai * 128 + m * 16; const float rstd = rstd_of(ss, row);
                float o[8];
#pragma unroll
                for (int n = 0; n < 2; ++n)
#pragma unroll
                    for (int j = 0; j < 4; ++j) { const float g = acc[ai][0][m][n][j] * rstd, up = acc[ai][1][m][n][j] * rstd; o[n * 4 + j] = siluf_(g) * up; }
                v4u w; w.x = pg8::cvt_pk_bf16(o[0], o[1]); w.y = pg8::cvt_pk_bf16(o[2], o[3]); w.z = pg8::cvt_pk_bf16(o[4], o[5]); w.w = pg8::cvt_pk_bf16(o[6], o[7]);
                *(v4u*)(act + (size_t)row * DFF + col0) = w;
            }
    }
};
template <bool FINAL, int SCALE2> struct EpiRes {
    static constexpr bool PERM = true;
    float* h; bf16* hb; float* ssout; float* out;
    __device__ __forceinline__ void rowgroup(const pg8::f32x4 (&a)[2][2], int row, int col0, int pn, int wc, int fq) const {
        constexpr float scale = 0.5f * SCALE2; float sq = 0.f;
        long yoff = -1;
        if (FINAL) { if (row < MP) { const int b = row / L, pos = row - b * L; if (pos >= NMETA) yoff = (long)O_YP + ((long)b * SEQ + (pos - NMETA)) * D; } else if (row < MR) yoff = (long)O_YS + (long)(row - MP) * D; }
#pragma unroll
        for (int bj = 0; bj < 2; ++bj) {
            const size_t off = (size_t)row * D + col0 + bj * 128;
            f32x4 h0 = *(const f32x4*)(h + off), h1 = *(const f32x4*)(h + off + 4);
            h0 = h0 + a[bj][0] * scale; h1 = h1 + a[bj][1] * scale;
            *(f32x4*)(h + off) = h0; *(f32x4*)(h + off + 4) = h1;
            v4u w; w.x = pg8::cvt_pk_bf16(h0[0], h0[1]); w.y = pg8::cvt_pk_bf16(h0[2], h0[3]); w.z = pg8::cvt_pk_bf16(h1[0], h1[1]); w.w = pg8::cvt_pk_bf16(h1[2], h1[3]);
            *(v4u*)(hb + off) = w;
            sq += (h0[0] * h0[0] + h0[1] * h0[1]) + (h0[2] * h0[2] + h0[3] * h0[3]) + (h1[0] * h1[0] + h1[1] * h1[1]) + (h1[2] * h1[2] + h1[3] * h1[3]);
            if (FINAL && yoff >= 0) { *(f32x4*)(out + yoff + col0 + bj * 128) = h0; *(f32x4*)(out + yoff + col0 + bj * 128 + 4) = h1; }
        }
        sq += __shfl_xor(sq, 16); sq += __shfl_xor(sq, 32);
        if (fq == 0 && ssout) ssout[(size_t)row * 16 + pn * 4 + wc] = sq;
    }
    __device__ __forceinline__ void operator()(const pg8::f32x4 (&acc)[2][2][4][2], const pg8::Unit& u, int, int, int, int) const {
        EPI_IDS();
        const int row0 = u.pm * 256 + wr * 64 + fr, col0 = u.pn * 256 + wc * 32 + 8 * fq;
#pragma unroll
        for (int ai = 0; ai < 2; ++ai)
#pragma unroll
            for (int m = 0; m < 4; ++m) {
                const pg8::f32x4 a[2][2] = {{acc[ai][0][m][0], acc[ai][0][m][1]}, {acc[ai][1][m][0], acc[ai][1][m][1]}};
                rowgroup(a, row0 + ai * 128 + m * 16, col0, u.pn, wc, fq);
                if (m == 3) asm volatile("" ::: "memory");
            }
    }
};
struct EpiZ {
    static constexpr bool PERM = true;
    bf16* zmix; bf16* gates; const float* ss; const float* bias;
    __device__ __forceinline__ void operator()(const pg8::f32x4 (&acc)[2][2][4][2], const pg8::Unit& u, int, int, int, int) const {
        EPI_IDS();
        const int row0 = u.pm * 256 + wr * 64 + fr, col0 = u.pn * 256 + wc * 32 + 8 * fq; const bool isgate = u.pn >= NMIXP / 256;
        f32x4 bv[2][2];
#pragma unroll
        for (int bj = 0; bj < 2; ++bj)
#pragma unroll
            for (int n = 0; n < 2; ++n) bv[bj][n] = *(const f32x4*)(bias + col0 + bj * 128 + 4 * n);
#pragma unroll
        for (int ai = 0; ai < 2; ++ai)
#pragma unroll
            for (int m = 0; m < 4; ++m) {
                const int row = row0 + ai * 128 + m * 16; const float rstd = rstd_of(ss, row);
#pragma unroll
                for (int bj = 0; bj < 2; ++bj) {
                    f32x4 v0 = acc[ai][bj][m][0] * rstd + bv[bj][0], v1 = acc[ai][bj][m][1] * rstd + bv[bj][1];
                    if (isgate) {
#pragma unroll
                        for (int j = 0; j < 4; ++j) { v0[j] = fmaxf(sigmoidf_(v0[j]), 9.094947017729282e-13f); v1[j] = fmaxf(sigmoidf_(v1[j]), 9.094947017729282e-13f); } }
                    v4u w; w.x = pg8::cvt_pk_bf16(v0[0], v0[1]); w.y = pg8::cvt_pk_bf16(v0[2], v0[3]); w.z = pg8::cvt_pk_bf16(v1[0], v1[1]); w.w = pg8::cvt_pk_bf16(v1[2], v1[3]);
                    if (isgate) *(v4u*)(gates + (size_t)row * NGATE + (col0 - NMIXP) + bj * 128) = w;
                    else *(v4u*)(zmix + (size_t)row * NMIXP + col0 + bj * 128) = w;
                }
            }
    }
};

struct EpiPartial {
    static constexpr bool PERM = true;
    float* part;
    __device__ __forceinline__ void operator()(const pg8::f32x4 (&acc)[2][2][4][2], const pg8::Unit& u, int, int, int, int) const {
        int t_ = threadIdx.x; asm volatile("" : "+v"(t_));
        const int slot = blockIdx.x;
        float* p = part + (size_t)slot * 65536 + (size_t)t_ * 4;
#pragma unroll
        for (int ai = 0; ai < 2; ++ai)
#pragma unroll
            for (int bj = 0; bj < 2; ++bj)
#pragma unroll
                for (int m = 0; m < 4; ++m)
#pragma unroll
                    for (int n = 0; n < 2; ++n) *(pg8::f32x4*)(p + (size_t)((((ai * 2 + bj) * 4 + m) * 2 + n) * 2048)) = acc[ai][bj][m][n];
        (void)u;
    }
};
template <int NSPLIT, class Epi> __device__ __forceinline__ void ksp_finalize(const float* part, const pg8::StaticOrder& so, int limit, const Epi& E) {
    const int ntail = so.nwg - limit;
    for (int it = blockIdx.x; it < ntail * 8; it += gridDim.x) {
        const int tt = it >> 3, ai = (it >> 2) & 1, m = it & 3;
        EPI_IDS();
        pg8::f32x4 a[2][2];
#pragma unroll
        for (int bj = 0; bj < 2; ++bj)
#pragma unroll
            for (int n = 0; n < 2; ++n) { pg8::f32x4 s = {0.f, 0.f, 0.f, 0.f};
#pragma unroll
                for (int k = 0; k < NSPLIT; ++k) s = s + *(const pg8::f32x4*)(part + (size_t)(tt * NSPLIT + k) * 65536 + (size_t)((((ai * 2 + bj) * 4 + m) * 2 + n) * 2048) + (size_t)t_ * 4);
                a[bj][n] = s; }
        pg8::Unit u; so.unit_of(limit + tt, u);
        E.rowgroup(a, u.pm * 256 + wr * 64 + fr + ai * 128 + m * 16, u.pn * 256 + wc * 32 + 8 * fq, u.pn, wc, fq);
    }
}

struct EpiMergeR {
    static constexpr bool PERM = true;
    bf16* merged; const bf16* gates;
    __device__ __forceinline__ void mid(pg8::f32x4 (&acc)[2][2][4][2], const pg8::Unit& u, int seg) const {
        EPI_IDS();
        const int row0 = u.pm * 256 + wr * 64 + fr, col0 = u.pn * 256 + wc * 32 + 8 * fq;
#pragma unroll
        for (int ai = 0; ai < 2; ++ai) {
#pragma unroll
            for (int m = 0; m < 4; ++m) {
                const int row = row0 + ai * 128 + m * 16;
#pragma unroll
                for (int bj = 0; bj < 2; ++bj) {
                    const bf16* gp = gates + (size_t)row * NGATE + (seg - 1) * D + col0 + bj * 128;
                    const v4u ga = *(const v4u*)gp, gb = *(const v4u*)(gp + D);
                    pg8::f32x4& a0 = acc[ai][bj][m][0]; pg8::f32x4& a1 = acc[ai][bj][m][1];
                    a0[0] *= bflo(ga.x) * __builtin_amdgcn_rcpf(bflo(gb.x)); a0[1] *= bfhi(ga.x) * __builtin_amdgcn_rcpf(bfhi(gb.x)); a0[2] *= bflo(ga.y) * __builtin_amdgcn_rcpf(bflo(gb.y)); a0[3] *= bfhi(ga.y) * __builtin_amdgcn_rcpf(bfhi(gb.y));
                    a1[0] *= bflo(ga.z) * __builtin_amdgcn_rcpf(bflo(gb.z)); a1[1] *= bfhi(ga.z) * __builtin_amdgcn_rcpf(bfhi(gb.z)); a1[2] *= bflo(ga.w) * __builtin_amdgcn_rcpf(bflo(gb.w)); a1[3] *= bfhi(ga.w) * __builtin_amdgcn_rcpf(bfhi(gb.w));
                }
            }
            asm volatile("" ::: "memory");
        }
    }
    __device__ __forceinline__ void operator()(const pg8::f32x4 (&acc)[2][2][4][2], const pg8::Unit& u, int, int, int, int) const {
        EPI_IDS();
        const int row0 = u.pm * 256 + wr * 64 + fr, col0 = u.pn * 256 + wc * 32 + 8 * fq;
#pragma unroll
        for (int ai = 0; ai < 2; ++ai)
#pragma unroll
            for (int m = 0; m < 4; ++m) {
                const int row = row0 + ai * 128 + m * 16;
#pragma unroll
                for (int bj = 0; bj < 2; ++bj) {
                    const v4u g = *(const v4u*)(gates + (size_t)row * NGATE + 3 * D + col0 + bj * 128);
                    const pg8::f32x4 a0 = acc[ai][bj][m][0], a1 = acc[ai][bj][m][1];
                    v4u w; w.x = pg8::cvt_pk_bf16(a0[0] * bflo(g.x), a0[1] * bfhi(g.x)); w.y = pg8::cvt_pk_bf16(a0[2] * bflo(g.y), a0[3] * bfhi(g.y));
                    w.z = pg8::cvt_pk_bf16(a1[0] * bflo(g.z), a1[1] * bfhi(g.z)); w.w = pg8::cvt_pk_bf16(a1[2] * bflo(g.w), a1[3] * bfhi(g.w));
                    *(v4u*)(merged + (size_t)row * D + col0 + bj * 128) = w;
                }
            }
    }
};

struct RowMap { int mode, a; __device__ __forceinline__ int operator()(int n) const { return mode == 0 ? n + a : (mode == 1 ? 256 * (n >> 7) + (n & 127) + a : (n < NMIX ? n : n + (NMIXP - NMIX))); } };
__device__ __forceinline__ void tr_item(const float* W, int K, int N, const float* gain, bf16* WT, int pitch, RowMap rm, LAS float* scr, int kb, int nb, int lane) {
    const int k0 = 64 * kb, n0 = 64 * nb; const int nn = n0 + 4 * (lane & 15), kr = lane >> 4;
    f32x4 v[16];
#pragma unroll
    for (int i = 0; i < 16; ++i) v[i] = (nn < N) ? *(const f32x4*)(W + (size_t)(k0 + 4 * i + kr) * N + nn) : (f32x4){0.f, 0.f, 0.f, 0.f};
#pragma unroll
    for (int i = 0; i < 16; ++i) { const int kk = 4 * i + kr; const float g = gain ? gain[k0 + kk] : 1.0f; LAS float* d = scr + kk * 65 + 4 * (lane & 15); d[0] = v[i][0] * g; d[1] = v[i][1] * g; d[2] = v[i][2] * g; d[3] = v[i][3] * g; }
    LDS_WAIT(); asm volatile("" ::: "memory");
    const int c = lane & 7;
#pragma unroll
    for (int j = 0; j < 8; ++j) { const int nl = (lane >> 3) + 8 * j; const int n = n0 + nl; const LAS float* s = scr + (8 * c) * 65 + nl;
        v4u o; o.x = pg8::cvt_pk_bf16(s[0 * 65], s[1 * 65]); o.y = pg8::cvt_pk_bf16(s[2 * 65], s[3 * 65]); o.z = pg8::cvt_pk_bf16(s[4 * 65], s[5 * 65]); o.w = pg8::cvt_pk_bf16(s[6 * 65], s[7 * 65]);
        if (n < N) *(v4u*)(WT + (size_t)rm(n) * pitch + k0 + 8 * c) = o; }
    LDS_WAIT(); asm volatile("" ::: "memory");
}
__device__ __forceinline__ void p0_prologue(const Ctx& C, const Params& P) {
    THREAD_IDS();
    LAS float* scr = (LAS float*)(C.lds + RING_OFF + wave * 16896);
    constexpr int I_FF = 16 * 44, I_DN = 44 * 16, I_IN = 16 * 113, I_BR = 4 * 4 * 16, I_OUT = 16 * 16;
    constexpr int PER_LAYER = 4 * I_FF + 2 * I_DN + I_IN + I_BR + I_OUT;
    for (int it = gw; it < DEPTH * PER_LAYER; it += NGW) {
        const int l = it / PER_LAYER; int r = it - l * PER_LAYER;
        bf16* W1a = WSP(bf16, WS_W1 + (size_t)(l * 2 + 0) * SZ_W1); bf16* W1b = WSP(bf16, WS_W1 + (size_t)(l * 2 + 1) * SZ_W1);
        bf16* Wda = WSP(bf16, WS_WD + (size_t)(l * 2 + 0) * SZ_WD); bf16* Wdb = WSP(bf16, WS_WD + (size_t)(l * 2 + 1) * SZ_WD);
        if (r < I_FF) { tr_item(C.in[I_F1G] + (size_t)l * D * DFF, D, DFF, C.in[I_NF1] + l * D, W1a, D, RowMap{1, 0}, scr, r / 44, r % 44, lane); continue; } r -= I_FF;
        if (r < I_FF) { tr_item(C.in[I_F1U] + (size_t)l * D * DFF, D, DFF, C.in[I_NF1] + l * D, W1a, D, RowMap{1, 128}, scr, r / 44, r % 44, lane); continue; } r -= I_FF;
        if (r < I_DN) { tr_item(C.in[I_F1D] + (size_t)l * D * DFF, DFF, D, nullptr, Wda, DFF, RowMap{0, 0}, scr, r / 16, r % 16, lane); continue; } r -= I_DN;
        if (r < I_FF) { tr_item(C.in[I_F2G] + (size_t)l * D * DFF, D, DFF, C.in[I_NF2] + l * D, W1b, D, RowMap{1, 0}, scr, r / 44, r % 44, lane); continue; } r -= I_FF;
        if (r < I_FF) { tr_item(C.in[I_F2U] + (size_t)l * D * DFF, D, DFF, C.in[I_NF2] + l * D, W1b, D, RowMap{1, 128}, scr, r / 44, r % 44, lane); continue; } r -= I_FF;
        if (r < I_DN) { tr_item(C.in[I_F2D] + (size_t)l * D * DFF, DFF, D, nullptr, Wdb, DFF, RowMap{0, 0}, scr, r / 16, r % 16, lane); continue; } r -= I_DN;
        if (r < I_IN) { tr_item(C.in[I_WIN] + (size_t)l * D * NIN, D, NIN, C.in[I_NMIX] + l * D, WSP(bf16, WS_WIN + (size_t)l * SZ_WIN), D, RowMap{2, 0}, scr, r / 113, r % 113, lane); continue; } r -= I_IN;
        if (r < I_BR) { const int n4 = r / 64, rr = r % 64; tr_item(C.in[I_WBR] + (size_t)(l * 4 + n4) * 256 * D, 256, D, nullptr, WSP(bf16, WS_WBR + (size_t)l * SZ_WBR) + n4 * 256, D, RowMap{0, 0}, scr, rr / 16, rr % 16, lane); continue; } r -= I_BR;
        tr_item(C.in[I_WOUT] + (size_t)l * D * D, D, D, nullptr, WSP(bf16, WS_WOUT + (size_t)l * SZ_WOUT), D, RowMap{0, 0}, scr, r / 16, r % 16, lane);
    }
    const int gt = gw * 64 + lane, NGT = NGW * 64;
    for (int i = gt; i < 2 * 240 * 128; i += NGT) { const int l = i / (240 * 128), r = i % (240 * 128); *(v4u*)(C.ws + WS_WIN + (size_t)l * SZ_WIN + ((size_t)NMIX * D) * 2 + (size_t)r * 16) = (v4u){0u, 0u, 0u, 0u}; }
    for (int i = gt; i < (M - MR) * 128; i += NGT) *(v4u*)(C.ws + WS_BR + (size_t)MR * D * 2 + (size_t)i * 16) = (v4u){0u, 0u, 0u, 0u};
    for (int i = gt; i < 2 * NINP; i += NGT) { const int l = i / NINP, j = i % NINP; float v = 0.f; if (j < NMIX) v = C.in[I_BIN][l * NIN + j]; else if (j >= NMIXP) v = C.in[I_BIN][l * NIN + NMIX + (j - NMIXP)]; WSP(float, WS_BINP)[i] = v; }
    for (int i = gt; i < NPOS * 32; i += NGT) { const int pi = i >> 5, fi = i & 31; const int pos = pi < L ? pi : PAST + (pi - L);
        const float angf = (float)pos * P.inv_freq[fi];
        const double a = (double)angf; const double k = rint(a * 0.15915494309189535); const double rr = (a - k * 6.283185307179586) - k * 2.4492935982947064e-16;
        const float rf = (float)rr; WSP(float, WS_ROPE)[i] = cosf(rf); WSP(float, WS_ROPE)[NPOS * 32 + i] = sinf(rf); }
    float* H = WSP(float, WS_H); bf16* HB = WSP(bf16, WS_HB); float* SS0 = WSP(float, WS_SS);
    for (int row = gw; row < M; row += NGW) {
        const float* src = nullptr;
        if (row < MP) { const int b = row / L, pos = row - b * L; src = pos < NMETA ? C.in[I_META] + (size_t)pos * D : C.in[I_XP] + ((size_t)b * SEQ + (pos - NMETA)) * D; }
        else if (row < MR) src = C.in[I_XS] + (size_t)(row - MP) * D;
        float s = 0.f;
#pragma unroll
        for (int j = 0; j < 4; ++j) { f32x4 v = src ? *(const f32x4*)(src + 256 * j + 4 * lane) : (f32x4){0.f, 0.f, 0.f, 0.f};
            *(f32x4*)(H + (size_t)row * D + 256 * j + 4 * lane) = v; s += (v[0] * v[0] + v[1] * v[1]) + (v[2] * v[2] + v[3] * v[3]);
            unsigned long long w = (unsigned long long)pk2(v[0], v[1]) | ((unsigned long long)pk2(v[2], v[3]) << 32);
            *(unsigned long long*)(HB + (size_t)row * D + 256 * j + 4 * lane) = w; }
        s = wave_sum(s); if (lane < 16) SS0[(size_t)row * 16 + lane] = lane == 0 ? s : 0.f;
    }
}

__device__ __forceinline__ float lam_of(const Ctx& C, int l, float lam_init) {
    THREAD_IDS();
    float a = 0.f, b = 0.f;
#pragma unroll 1
    for (int i = 0; i < 32; ++i) { a += C.in[I_LQ1][l * 32 + i] * C.in[I_LK1][l * 32 + i]; b += C.in[I_LQ2][l * 32 + i] * C.in[I_LK2][l * 32 + i]; }
    return __expf(a) - __expf(b) + lam_init;
}
__device__ __forceinline__ int t5_bucket(int n) {
    if (n < 16) return n;
    return 16 + (n >= 19) + (n >= 21) + (n >= 24) + (n >= 27) + (n >= 31) + (n >= 35) + (n >= 40) + (n >= 46) + (n >= 52) + (n >= 59) + (n >= 67) + (n >= 77) + (n >= 87) + (n >= 99) + (n >= 113);
}
__device__ __forceinline__ void unpack8(const v4u w, float (&x)[8]) { x[0] = bflo(w.x); x[1] = bfhi(w.x); x[2] = bflo(w.y); x[3] = bfhi(w.y); x[4] = bflo(w.z); x[5] = bfhi(w.z); x[6] = bflo(w.w); x[7] = bfhi(w.w); }
__device__ __forceinline__ v4u pack8(const float (&x)[8]) { v4u w; w.x = pg8::cvt_pk_bf16(x[0], x[1]); w.y = pg8::cvt_pk_bf16(x[2], x[3]); w.z = pg8::cvt_pk_bf16(x[4], x[5]); w.w = pg8::cvt_pk_bf16(x[6], x[7]); return w; }
__device__ __forceinline__ void n1_prep(const Ctx& C, int l) {
    THREAD_IDS();
    const bf16* ZM = WSP(bf16, WS_ZMIX); float* UB = WSP(float, WS_UBUF); float* RQ = WSP(float, WS_RQ); float* RK = WSP(float, WS_RK);
    float* LD = WSP(float, WS_LDEC); const float* COS = WSP(float, WS_ROPE); const float* SIN = COS + NPOS * 32; bf16* QNB = WSP(bf16, WS_QNB); bf16* KNB = WSP(bf16, WS_KNB);
    const int i = lane & 31;
    float qg[8], kg[8];
#pragma unroll
    for (int j = 0; j < 8; ++j) { qg[j] = C.in[I_QN][l * 32 + ((8 * i) & 31) + j] * (0.17677669529663687f * 1.4426950408889634f); kg[j] = C.in[I_KN][l * 32 + ((8 * i) & 31) + j]; }
    for (int rp = gw; rp < MR / 2; rp += NGW) {
        const int r = 2 * rp + (lane >> 5);
        const bf16* z = ZM + (size_t)r * NMIXP;
        const int pi = r < MP ? r % L : L + ((r - MP) & 7);
        float* kout = r < MP ? C.out + O_KP + ((size_t)l * MP + r) * 256 : C.out + O_KS + ((size_t)l * MS + (r - MP)) * 256;
        float* vout = r < MP ? C.out + O_VP + ((size_t)l * MP + r) * 256 : C.out + O_VS + ((size_t)l * MS + (r - MP)) * 256;
        const v4u wa = *(const v4u*)(z + C_A + 8 * i), wg = *(const v4u*)(z + C_G + 8 * i), wq = *(const v4u*)(z + D_Q + 8 * i), wk = *(const v4u*)(z + D_K + 8 * i), wv = *(const v4u*)(z + D_V + 8 * i);
        const int isk = i >> 4, hh = (i >> 2) & 3, jc = i & 3;
        const bf16* zr = z + (isk ? R_K : R_Q) + hh * 64 + 8 * jc;
        const v4u w1 = *(const v4u*)zr, w2 = *(const v4u*)(zr + 32);
        const v4u gl0 = *(const v4u*)(z + G_LOW), gl1 = *(const v4u*)(z + G_LOW + 8);
        float x[8], y[8];
        unpack8(wa, x); unpack8(wg, y);
#pragma unroll
        for (int j = 0; j < 8; ++j) x[j] *= sigmoidf_(y[j]);
        *(f32x4*)(UB + (size_t)r * 256 + 8 * i) = (f32x4){x[0], x[1], x[2], x[3]}; *(f32x4*)(UB + (size_t)r * 256 + 8 * i + 4) = (f32x4){x[4], x[5], x[6], x[7]};
        unpack8(wv, x);
        *(f32x4*)(vout + 8 * i) = (f32x4){x[0], x[1], x[2], x[3]}; *(f32x4*)(vout + 8 * i + 4) = (f32x4){x[4], x[5], x[6], x[7]};
        unpack8(wq, x);
        { float s = 0.f;
#pragma unroll
          for (int j = 0; j < 8; ++j) s += x[j] * x[j];
          s += __shfl_xor(s, 1); s += __shfl_xor(s, 2); const float rs = rsqrtf(s * (1.0f / 32) + EPS);
#pragma unroll
          for (int j = 0; j < 8; ++j) x[j] = x[j] * rs * qg[j];
          *(v4u*)(QNB + (size_t)r * 256 + 8 * i) = pack8(x); }
        unpack8(wk, x);
        { float s = 0.f;
#pragma unroll
          for (int j = 0; j < 8; ++j) s += x[j] * x[j];
          s += __shfl_xor(s, 1); s += __shfl_xor(s, 2); const float rs = rsqrtf(s * (1.0f / 32) + EPS);
#pragma unroll
          for (int j = 0; j < 8; ++j) x[j] = x[j] * rs * kg[j];
          *(v4u*)(KNB + (size_t)r * 256 + 8 * i) = pack8(x);
          *(f32x4*)(kout + 8 * i) = (f32x4){x[0], x[1], x[2], x[3]}; *(f32x4*)(kout + 8 * i + 4) = (f32x4){x[4], x[5], x[6], x[7]}; }
        unpack8(w1, x); unpack8(w2, y);
        { const f32x4 c0 = *(const f32x4*)(COS + pi * 32 + 8 * jc), c1 = *(const f32x4*)(COS + pi * 32 + 8 * jc + 4), s0 = *(const f32x4*)(SIN + pi * 32 + 8 * jc), s1 = *(const f32x4*)(SIN + pi * 32 + 8 * jc + 4);
          const float sc = isk ? 0.125f : 1.0f; float o1[8], o2[8];
#pragma unroll
          for (int j = 0; j < 8; ++j) { const float cs = j < 4 ? c0[j & 3] : c1[j & 3], sn = j < 4 ? s0[j & 3] : s1[j & 3]; o1[j] = (x[j] * cs - y[j] * sn) * sc; o2[j] = (x[j] * sn + y[j] * cs) * sc; }
          float* ro = (isk ? RK : RQ) + (size_t)r * 256 + hh * 64 + 8 * jc;
          *(f32x4*)ro = (f32x4){o1[0], o1[1], o1[2], o1[3]}; *(f32x4*)(ro + 4) = (f32x4){o1[4], o1[5], o1[6], o1[7]}; *(f32x4*)(ro + 32) = (f32x4){o2[0], o2[1], o2[2], o2[3]}; *(f32x4*)(ro + 36) = (f32x4){o2[4], o2[5], o2[6], o2[7]}; }
        { float gv[16]; unpack8(gl0, x); unpack8(gl1, y);
#pragma unroll
          for (int j = 0; j < 8; ++j) { gv[j] = x[j]; gv[8 + j] = y[j]; }
          f32x4 gp = *(const f32x4*)(C.in[I_GAB] + l * 128 + 4 * i);
#pragma unroll
          for (int k = 0; k < 16; ++k) { const f32x4 aw = *(const f32x4*)(C.in[I_GAW] + (size_t)(l * 16 + k) * 128 + 4 * i); gp = gp + aw * gv[k]; }
          f32x4 ls;
#pragma unroll
          for (int j = 0; j < 4; ++j) ls[j] = (fminf(gp[j], 0.f) - log1pf(__expf(-fabsf(gp[j])))) * (1.0f / 16.0f);
          *(f32x4*)(LD + (size_t)r * 128 + 4 * i) = ls; }
    }
}
__device__ __forceinline__ void conv_rows_item(const Ctx& C, int l, int item) {
    THREAD_IDS();
    const float* UB = WSP(float, WS_UBUF); bf16* BR = WSP(bf16, WS_BR);
    const float* cw = C.in[I_CW] + (size_t)l * 31 * 256; const float* sc = C.in[I_SCONV];
    LAS float* wl = (LAS float*)C.lds;
    for (int i = tid; i < 31 * 256; i += NWAVES * 64) wl[i] = cw[i];
    LDS_WAIT(); __builtin_amdgcn_s_barrier(); asm volatile("" ::: "memory");
    const int r0 = item * 64 + wave * 8;
    if (r0 < MR) {
        const bool smp = r0 >= MP; const int b = smp ? (r0 - MP) >> 3 : r0 / L; const int p0 = smp ? 0 : r0 - b * L; const int rb = smp ? MP + b * 8 : b * L;
        float acc[8][4];
#pragma unroll
        for (int i = 0; i < 8; ++i)
#pragma unroll
            for (int k = 0; k < 4; ++k) acc[i][k] = C.in[I_CB][l * 256 + lane + 64 * k];
#pragma unroll 1
        for (int jb = 0; jb < 40; jb += 8) {
            float uv[8][4];
#pragma unroll
            for (int jj = 0; jj < 8; ++jj) { const int j = jb + jj; const int q = p0 - 30 + j;
#pragma unroll
                for (int k = 0; k < 4; ++k) { const int c = lane + 64 * k;
                    uv[jj][k] = j >= 38 ? 0.f : (q >= 0 ? UB[(size_t)(rb + q) * 256 + c] : (smp ? sc[(((size_t)l * DB + b) * 30 + (q + 30)) * 256 + c] : 0.f)); } }
#pragma unroll
            for (int jj = 0; jj < 8; ++jj)
#pragma unroll
                for (int i = 0; i < 8; ++i) { const int t = jb + jj - i;
                    if (t >= 0 && t <= 30) {
#pragma unroll
                        for (int k = 0; k < 4; ++k) acc[i][k] += wl[t * 256 + lane + 64 * k] * uv[jj][k]; } }
        }
#pragma unroll
        for (int i = 0; i < 8; ++i) { const int r = r0 + i;
            float s = (acc[i][0] + acc[i][1]) + (acc[i][2] + acc[i][3]); const float mean = wave_sum(s) * (1.0f / 256);
            float q2 = 0.f;
#pragma unroll
            for (int k = 0; k < 4; ++k) { acc[i][k] -= mean; q2 += acc[i][k] * acc[i][k]; }
            const float rstd = rsqrtf(wave_sum(q2) * (1.0f / 256) + EPS);
#pragma unroll
            for (int k = 0; k < 4; ++k) { const int c = lane + 64 * k; const float y = acc[i][k] * rstd * C.in[I_CLG][l * 256 + c] + C.in[I_CLB][l * 256 + c]; BR[(size_t)r * D + c] = (bf16)f2bf(siluf_(y)); } }
    }
    LDS_WAIT(); __builtin_amdgcn_s_barrier(); asm volatile("" ::: "memory");
}
__device__ __forceinline__ void conv_state_item(const Ctx& C, int l, int part, int nparts) {
    THREAD_IDS();
    const float* UB = WSP(float, WS_UBUF); const float* sc = C.in[I_SCONV];
    for (int i = part * NWAVES * 64 + tid; i < BATCH * 30 * 256; i += nparts * NWAVES * 64) { const int c = i & 255, ii = (i >> 8) % 30, b = i / (30 * 256); C.out[O_CP + (size_t)l * BATCH * 30 * 256 + i] = UB[(size_t)(b * L + L - 30 + ii) * 256 + c]; }
    for (int i = part * NWAVES * 64 + tid; i < DB * 30 * 256; i += nparts * NWAVES * 64) { const int c = i & 255, ii = (i >> 8) % 30, b = i / (30 * 256);
        C.out[O_CS + (size_t)l * DB * 30 * 256 + i] = ii < 22 ? sc[(((size_t)l * DB + b) * 30 + 8 + ii) * 256 + c] : UB[(size_t)(MP + b * 8 + ii - 22) * 256 + c]; }
}
template <int DK, bool RET> __device__ __forceinline__ void la_seq(const Ctx& C, int l, bool smp, int b, int h) {
    THREAD_IDS();
    const bf16* ZM = WSP(bf16, WS_ZMIX); const float* RQ = WSP(float, WS_RQ); const float* RK = WSP(float, WS_RK); const float* LD = WSP(float, WS_LDEC); bf16* BR = WSP(bf16, WS_BR);
    const int nt = smp ? DS : L; const int row0 = smp ? MP + b * DS : b * L;
    float S[DK];
    if (smp) { const float* s0 = (RET ? C.in[I_SRET] : C.in[I_SGLA]) + (((size_t)l * DB + b) * 4 + h) * DK * 64;
#pragma unroll
        for (int k = 0; k < DK; ++k) S[k] = s0[k * 64 + lane]; }
    else {
#pragma unroll
        for (int k = 0; k < DK; ++k) S[k] = 0.f; }
    const float gamma = 1.0f - exp2f(-5.0f - (float)h);
    const float gn = RET ? C.in[I_RGN][(l * 4 + h) * 64 + lane] : C.in[I_GGN][(l * 4 + h) * 64 + lane];
    for (int t = 0; t < nt; ++t) {
        const int r = row0 + t; const bf16* z = ZM + (size_t)r * NMIXP;
        float ql, kl, dl = 1.f;
        if (RET) { ql = RQ[(size_t)r * 256 + h * 64 + lane]; kl = RK[(size_t)r * 256 + h * 64 + lane]; }
        else { const int lk = lane & 31; ql = bf2f(z[G_Q + h * 32 + lk]) * 0.17677669529663687f; kl = bf2f(z[G_K + h * 32 + lk]); dl = __expf(LD[(size_t)r * 128 + h * 32 + lk]); }
        const float v = bf2f(z[(RET ? R_V : G_V) + h * 64 + lane]);
        float o = 0.f;
#pragma unroll
        for (int k = 0; k < DK; ++k) { const float qk = __shfl(ql, k), kk = __shfl(kl, k); const float dk = RET ? gamma : __shfl(dl, k);
            S[k] = dk * S[k] + kk * v; o += qk * S[k]; if ((k & 7) == 7) __builtin_amdgcn_sched_barrier(0); }
        float y;
        if (RET) { const float mean = wave_sum(o) * (1.0f / 64); const float d = o - mean; const float var = wave_sum(d * d) * (1.0f / 64); y = d * rsqrtf(var + EPS) * gn; }
        else { const float ms = wave_sum(o * o) * (1.0f / 64); y = o * rsqrtf(ms + EPS) * gn; }
        const float g = bf2f(z[(RET ? R_G : G_R) + h * 64 + lane]);
        BR[(size_t)r * D + (RET ? 256 : 512) + h * 64 + lane] = (bf16)f2bf(siluf_(g) * y);
    }
    float* so = C.out + (RET ? (smp ? O_RS + (((size_t)l * DB + b) * 4 + h) * DK * 64 : O_RP + (((size_t)l * BATCH + b) * 4 + h) * DK * 64)
                             : (smp ? O_GS + (((size_t)l * DB + b) * 4 + h) * DK * 64 : O_GP + (((size_t)l * BATCH + b) * 4 + h) * DK * 64));
#pragma unroll
    for (int k = 0; k < DK; ++k) so[k * 64 + lane] = S[k];
}
typedef short bf16x8_t __attribute__((ext_vector_type(8)));
template <int DK, bool RET> __device__ __forceinline__ void la_chunked(const Ctx& C, int l, bool smp, int b, int h) {
    THREAD_IDS();
    constexpr int QS = DK + 8, TS = 72, NKB = DK / 16, NKS = DK / 32;
    constexpr int SB = 2 * 64 * QS + 64 * TS + DK * TS + 64 * TS + 64;
    LAS bf16* SB0 = (LAS bf16*)(C.lds);
    LAS bf16* AL = SB0 + 2 * SB;
    LAS bf16* ST = AL + 64 * TS;
    const bf16* ZM = WSP(bf16, WS_ZMIX); const float* RQ = WSP(float, WS_RQ); const float* RK = WSP(float, WS_RK); const float* LD = WSP(float, WS_LDEC); bf16* BR = WSP(bf16, WS_BR);
    const int nt = smp ? DS : L, row0 = smp ? MP + b * DS : b * L, nch = (nt + 63) >> 6;
    const float lg2 = RET ? log2f(1.0f - exp2f(-5.0f - (float)h)) : 0.f;
    const int g4 = lane >> 4, c16 = lane & 15;
    const bool qwave = wave < 4; const int w4 = wave & 3;
    float Sreg[NKB][4];
    if (wave >= 4) {
        const float* s0 = (RET ? C.in[I_SRET] : C.in[I_SGLA]) + (((size_t)l * DB + b) * 4 + h) * DK * 64;
#pragma unroll
        for (int cb = 0; cb < NKB; ++cb)
#pragma unroll
            for (int r = 0; r < 4; ++r) { const int dk = cb * 16 + c16, dv = (wave - 4) * 16 + 4 * g4 + r; const float v = smp ? s0[dk * 64 + dv] : 0.f; Sreg[cb][r] = v; ST[dv * QS + dk] = (bf16)f2bf(v); }
    }
    float gnv[4];
#pragma unroll
    for (int cb = 0; cb < 4; ++cb) gnv[cb] = (RET ? C.in[I_RGN] : C.in[I_GGN])[(l * 4 + h) * 64 + cb * 16 + c16];
    float a[16]; v4u vr;
#define LA_LOAD(c) do { const size_t r_ = (size_t)(row0 + (c) * 64 + lane); const bf16* z_ = ZM + r_ * NMIXP; \
        vr = *(const v4u*)(z_ + (RET ? R_V : G_V) + h * 64 + 8 * wave); \
        if (RET) { const float* p_ = (qwave ? RQ : RK) + r_ * 256 + h * 64 + 8 * w4; const f32x4 x0 = *(const f32x4*)p_, x1 = *(const f32x4*)(p_ + 4), x2 = *(const f32x4*)(p_ + 32), x3 = *(const f32x4*)(p_ + 36); \
            a[0] = x0[0]; a[1] = x0[1]; a[2] = x0[2]; a[3] = x0[3]; a[4] = x1[0]; a[5] = x1[1]; a[6] = x1[2]; a[7] = x1[3]; a[8] = x2[0]; a[9] = x2[1]; a[10] = x2[2]; a[11] = x2[3]; a[12] = x3[0]; a[13] = x3[1]; a[14] = x3[2]; a[15] = x3[3]; } \
        else { const v4u q_ = *(const v4u*)(z_ + (qwave ? G_Q : G_K) + h * 32 + 8 * w4); const float* p_ = LD + r_ * 128 + h * 32 + 8 * w4; const f32x4 x0 = *(const f32x4*)p_, x1 = *(const f32x4*)(p_ + 4); \
            a[0] = bflo(q_.x); a[1] = bfhi(q_.x); a[2] = bflo(q_.y); a[3] = bfhi(q_.y); a[4] = bflo(q_.z); a[5] = bfhi(q_.z); a[6] = bflo(q_.w); a[7] = bfhi(q_.w); \
            a[8] = x0[0]; a[9] = x0[1]; a[10] = x0[2]; a[11] = x0[3]; a[12] = x1[0]; a[13] = x1[1]; a[14] = x1[2]; a[15] = x1[3]; } } while (0)
    LA_LOAD(0);
    int cur = 0;
    for (int i = 0; i <= nch; ++i) {
        if (i < nch) {
            const int c = i; LAS bf16* QT = SB0 + (i & 1) * SB; LAS bf16* KT = QT + 64 * QS; LAS bf16* VT = KT + 64 * QS; LAS bf16* KE = VT + 64 * TS; LAS bf16* GT = KE + DK * TS; LAS float* WT = (LAS float*)(GT + 64 * TS);
            const int nvc = min(64, nt - c * 64); const bool valid = lane < nvc;
        if (RET) {
            const float tq = (float)(lane + 1);
            if (qwave) { const float e = valid ? __builtin_amdgcn_exp2f(lg2 * tq) : 0.f;
                v4u w0, w1; w0.x = pg8::cvt_pk_bf16(a[0] * e, a[1] * e); w0.y = pg8::cvt_pk_bf16(a[2] * e, a[3] * e); w0.z = pg8::cvt_pk_bf16(a[4] * e, a[5] * e); w0.w = pg8::cvt_pk_bf16(a[6] * e, a[7] * e);
                w1.x = pg8::cvt_pk_bf16(a[8] * e, a[9] * e); w1.y = pg8::cvt_pk_bf16(a[10] * e, a[11] * e); w1.z = pg8::cvt_pk_bf16(a[12] * e, a[13] * e); w1.w = pg8::cvt_pk_bf16(a[14] * e, a[15] * e);
                *(LAS v4u*)(QT + lane * QS + 8 * w4) = w0; *(LAS v4u*)(QT + lane * QS + 32 + 8 * w4) = w1; }
            else { const float e = valid ? __builtin_amdgcn_exp2f(-lg2 * tq) : 0.f, ee = valid ? __builtin_amdgcn_exp2f(lg2 * ((float)nvc - tq)) : 0.f;
                v4u w0, w1; w0.x = pg8::cvt_pk_bf16(a[0] * e, a[1] * e); w0.y = pg8::cvt_pk_bf16(a[2] * e, a[3] * e); w0.z = pg8::cvt_pk_bf16(a[4] * e, a[5] * e); w0.w = pg8::cvt_pk_bf16(a[6] * e, a[7] * e);
                w1.x = pg8::cvt_pk_bf16(a[8] * e, a[9] * e); w1.y = pg8::cvt_pk_bf16(a[10] * e, a[11] * e); w1.z = pg8::cvt_pk_bf16(a[12] * e, a[13] * e); w1.w = pg8::cvt_pk_bf16(a[14] * e, a[15] * e);
                *(LAS v4u*)(KT + lane * QS + 8 * w4) = w0; *(LAS v4u*)(KT + lane * QS + 32 + 8 * w4) = w1;
#pragma unroll
                for (int i = 0; i < 16; i += 2) { const unsigned mine = pg8::cvt_pk_bf16(a[i] * ee, a[i + 1] * ee); const unsigned pv = (unsigned)__shfl_xor((int)mine, 1);
                    const unsigned w = (lane & 1) ? ((pv >> 16) | (mine & 0xffff0000u)) : ((mine & 0xffffu) | (pv << 16));
                    const int row = (i < 8 ? 8 * w4 + i : 32 + 8 * w4 + (i - 8)) + (lane & 1);
                    *(LAS unsigned*)(KE + row * TS + (lane & ~1)) = w; } }
        } else {
            float bb[8];
#pragma unroll
            for (int i = 0; i < 8; ++i) bb[i] = valid ? a[8 + i] : 0.f;
#pragma unroll
            for (int i = 0; i < 8; ++i) { float x = bb[i];
                x += __builtin_bit_cast(float, __builtin_amdgcn_mov_dpp(__builtin_bit_cast(int, x), 0x111, 0xf, 0xf, true));
                x += __builtin_bit_cast(float, __builtin_amdgcn_mov_dpp(__builtin_bit_cast(int, x), 0x112, 0xf, 0xf, true));
                x += __builtin_bit_cast(float, __builtin_amdgcn_mov_dpp(__builtin_bit_cast(int, x), 0x114, 0xf, 0xf, true));
                x += __builtin_bit_cast(float, __builtin_amdgcn_mov_dpp(__builtin_bit_cast(int, x), 0x118, 0xf, 0xf, true));
                const float t0 = __builtin_bit_cast(float, __builtin_amdgcn_readlane(__builtin_bit_cast(int, x), 15)), t1 = __builtin_bit_cast(float, __builtin_amdgcn_readlane(__builtin_bit_cast(int, x), 31)), t2 = __builtin_bit_cast(float, __builtin_amdgcn_readlane(__builtin_bit_cast(int, x), 47));
                bb[i] = x + (lane >= 16 ? t0 : 0.f) + (lane >= 32 ? t1 : 0.f) + (lane >= 48 ? t2 : 0.f); }
            if (qwave) {
                if (lane == 63) {
#pragma unroll
                    for (int i = 0; i < 8; ++i) WT[8 * w4 + i] = bb[i]; }
                float o8[8];
#pragma unroll
                for (int i = 0; i < 8; ++i) o8[i] = valid ? a[i] * 0.17677669529663687f * __expf(bb[i]) : 0.f;
                v4u w0; w0.x = pg8::cvt_pk_bf16(o8[0], o8[1]); w0.y = pg8::cvt_pk_bf16(o8[2], o8[3]); w0.z = pg8::cvt_pk_bf16(o8[4], o8[5]); w0.w = pg8::cvt_pk_bf16(o8[6], o8[7]);
                *(LAS v4u*)(QT + lane * QS + 8 * w4) = w0;
            } else {
                float o8[8];
#pragma unroll
                for (int i = 0; i < 8; ++i) o8[i] = valid ? a[i] * __expf(-bb[i]) : 0.f;
#pragma unroll
                for (int i = 0; i < 8; i += 2) { const float t0 = __shfl(bb[i], 63), t1 = __shfl(bb[i + 1], 63);
                    const unsigned mine = pg8::cvt_pk_bf16(valid ? a[i] * __expf(t0 - bb[i]) : 0.f, valid ? a[i + 1] * __expf(t1 - bb[i + 1]) : 0.f); const unsigned pv = (unsigned)__shfl_xor((int)mine, 1);
                    const unsigned w = (lane & 1) ? ((pv >> 16) | (mine & 0xffff0000u)) : ((mine & 0xffffu) | (pv << 16));
                    *(LAS unsigned*)(KE + (8 * w4 + i + (lane & 1)) * TS + (lane & ~1)) = w; }
                v4u w0; w0.x = pg8::cvt_pk_bf16(o8[0], o8[1]); w0.y = pg8::cvt_pk_bf16(o8[2], o8[3]); w0.z = pg8::cvt_pk_bf16(o8[4], o8[5]); w0.w = pg8::cvt_pk_bf16(o8[6], o8[7]);
                *(LAS v4u*)(KT + lane * QS + 8 * w4) = w0;
            }
        }
        { const unsigned vv[4] = {valid ? vr.x : 0u, valid ? vr.y : 0u, valid ? vr.z : 0u, valid ? vr.w : 0u};
#pragma unroll
          for (int i = 0; i < 4; ++i) { const unsigned pv = (unsigned)__shfl_xor((int)vv[i], 1);
              const unsigned w = (lane & 1) ? ((pv >> 16) | (vv[i] & 0xffff0000u)) : ((vv[i] & 0xffffu) | (pv << 16));
              *(LAS unsigned*)(VT + (8 * wave + 2 * i + (lane & 1)) * TS + (lane & ~1)) = w; } }
            if (c + 1 < nch) LA_LOAD(c + 1);
        }
        if (i >= 1) {
            LAS bf16* QT = SB0 + ((i - 1) & 1) * SB; LAS bf16* KT = QT + 64 * QS;
        { const int rb = wave >> 1;
#pragma unroll
          for (int ci = 0; ci < 2; ++ci) { const int cb = (wave & 1) * 2 + ci; f32x4 acc = {0.f, 0.f, 0.f, 0.f};
              if (cb <= rb) {
#pragma unroll
                  for (int ks = 0; ks < NKS; ++ks) { const bf16x8_t af = *(const LAS bf16x8_t*)(QT + (rb * 16 + c16) * QS + ks * 32 + 8 * g4), bf = *(const LAS bf16x8_t*)(KT + (cb * 16 + c16) * QS + ks * 32 + 8 * g4);
                      acc = __builtin_amdgcn_mfma_f32_16x16x32_bf16(af, bf, acc, 0, 0, 0); } }
#pragma unroll
              for (int r = 0; r < 4; ++r) { const int tt = rb * 16 + 4 * g4 + r, ss = cb * 16 + c16; AL[tt * TS + ss] = (bf16)f2bf(ss <= tt ? acc[r] : 0.f); } } }
        }
        LDS_WAIT(); __builtin_amdgcn_s_barrier(); asm volatile("" ::: "memory");
        if (i >= 1) {
            const int c = i - 1; LAS bf16* QT = SB0 + (c & 1) * SB; LAS bf16* KT = QT + 64 * QS; LAS bf16* VT = KT + 64 * QS; LAS bf16* KE = VT + 64 * TS; LAS bf16* GT = KE + DK * TS; LAS float* WT = (LAS float*)(GT + 64 * TS);
            const int nvc = min(64, nt - c * 64); (void)KT;
        if (wave < 4) {
            const int rb = wave; const LAS bf16* STc = ST + cur * 64 * QS;
            f32x4 o[4];
#pragma unroll
            for (int cb = 0; cb < 4; ++cb) o[cb] = (f32x4){0.f, 0.f, 0.f, 0.f};
#pragma unroll
            for (int ks = 0; ks < 2; ++ks) { const bf16x8_t af = *(const LAS bf16x8_t*)(AL + (rb * 16 + c16) * TS + ks * 32 + 8 * g4);
#pragma unroll
                for (int cb = 0; cb < 4; ++cb) { const bf16x8_t bf = *(const LAS bf16x8_t*)(VT + (cb * 16 + c16) * TS + ks * 32 + 8 * g4); o[cb] = __builtin_amdgcn_mfma_f32_16x16x32_bf16(af, bf, o[cb], 0, 0, 0); } }
#pragma unroll
            for (int ks = 0; ks < NKS; ++ks) { const bf16x8_t af = *(const LAS bf16x8_t*)(QT + (rb * 16 + c16) * QS + ks * 32 + 8 * g4);
#pragma unroll
                for (int cb = 0; cb < 4; ++cb) { const bf16x8_t bf = *(const LAS bf16x8_t*)(STc + (cb * 16 + c16) * QS + ks * 32 + 8 * g4); o[cb] = __builtin_amdgcn_mfma_f32_16x16x32_bf16(af, bf, o[cb], 0, 0, 0); } }
            { float* LAO = WSP(float, WS_LAO);
#pragma unroll
              for (int r = 0; r < 4; ++r) { const int tok = c * 64 + rb * 16 + 4 * g4 + r;
                  if (tok < nt) { float* op = LAO + (size_t)(row0 + tok) * 512 + (RET ? 0 : 256) + h * 64 + c16;
#pragma unroll
                      for (int cb = 0; cb < 4; ++cb) op[cb * 16] = o[cb][r]; } } }
        } else {
            const int dvb = wave - 4; LAS bf16* STn = ST + (cur ^ 1) * 64 * QS;
            f32x4 ds[NKB];
#pragma unroll
            for (int cb = 0; cb < NKB; ++cb) ds[cb] = (f32x4){0.f, 0.f, 0.f, 0.f};
#pragma unroll
            for (int ks = 0; ks < 2; ++ks) { const bf16x8_t af = *(const LAS bf16x8_t*)(VT + (dvb * 16 + c16) * TS + ks * 32 + 8 * g4);
#pragma unroll
                for (int cb = 0; cb < NKB; ++cb) { const bf16x8_t bf = *(const LAS bf16x8_t*)(KE + (cb * 16 + c16) * TS + ks * 32 + 8 * g4); ds[cb] = __builtin_amdgcn_mfma_f32_16x16x32_bf16(af, bf, ds[cb], 0, 0, 0); } }
#pragma unroll
            for (int cb = 0; cb < NKB; ++cb) { const float eB = RET ? __builtin_amdgcn_exp2f(lg2 * (float)nvc) : __expf(WT[cb * 16 + c16]);
#pragma unroll
                for (int r = 0; r < 4; ++r) { Sreg[cb][r] = eB * Sreg[cb][r] + ds[cb][r]; STn[(dvb * 16 + 4 * g4 + r) * QS + cb * 16 + c16] = (bf16)f2bf(Sreg[cb][r]); } }
        }
            cur ^= 1;
        }
        LDS_WAIT(); __builtin_amdgcn_s_barrier(); asm volatile("" ::: "memory");
    }
#undef LA_LOAD
    if (wave >= 4) {
        float* so = C.out + (RET ? (smp ? O_RS + (((size_t)l * DB + b) * 4 + h) * DK * 64 : O_RP + (((size_t)l * BATCH + b) * 4 + h) * DK * 64)
                                 : (smp ? O_GS + (((size_t)l * DB + b) * 4 + h) * DK * 64 : O_GP + (((size_t)l * BATCH + b) * 4 + h) * DK * 64));
#pragma unroll
        for (int cb = 0; cb < NKB; ++cb)
#pragma unroll
            for (int r = 0; r < 4; ++r) so[(cb * 16 + c16) * 64 + (wave - 4) * 16 + 4 * g4 + r] = Sreg[cb][r];
    }
}
typedef float f32x16_t __attribute__((ext_vector_type(16)));
__device__ __forceinline__ int crow_(int r, int hi) { return (r & 3) + 8 * (r >> 2) + 4 * hi; }
__device__ __forceinline__ float swapmax32(float m) { auto rr = __builtin_amdgcn_permlane32_swap(__float_as_uint(m), __float_as_uint(m), false, false); return fmaxf(__uint_as_float(rr[0]), __uint_as_float(rr[1])); }
__device__ __forceinline__ float swapadd32(float m) { auto rr = __builtin_amdgcn_permlane32_swap(__float_as_uint(m), __float_as_uint(m), false, false); return __uint_as_float(rr[0]) + __uint_as_float(rr[1]); }
constexpr float LOG2E = 1.4426950408889634f;
__device__ __forceinline__ void attn_prompt_item(const Ctx& C, int l, int b, int h, int qb, float lam, float lam_init, float mb) {
    THREAD_IDS();
    constexpr int KS = 72;
    LAS bf16* Kt = (LAS bf16*)C.lds;
    LAS bf16* Vt = Kt + 2 * 64 * KS;
    LAS float* BT = (LAS float*)(Vt + 2 * 64 * KS);
    LAS float* OX = BT + 128;
    const bf16* ZM = WSP(bf16, WS_ZMIX); const bf16* QNB = WSP(bf16, WS_QNB); const bf16* KNB = WSP(bf16, WS_KNB); bf16* BR = WSP(bf16, WS_BR);
    const int r32 = lane & 31, hi = lane >> 5, qs = wave >> 1, s = wave & 1;
    const int q0 = qb * 128 + qs * 32; const int rowb = b * L;
    if (tid < 128) BT[tid] = (C.in[I_RELB][t5_bucket(tid) * 4 + h] - C.in[I_RELB][31 * 4 + h]) * LOG2E;
    pg8::bf16x8 qf[2];
#pragma unroll
    for (int d0 = 0; d0 < 2; ++d0) qf[d0] = *(const pg8::bf16x8*)(QNB + (size_t)(rowb + q0 + r32) * 256 + h * 64 + s * 32 + 16 * d0 + 8 * hi);
    const int pl = (lane & ~15) | ((lane & 8) >> 1) | ((lane & 4) << 1) | (lane & 3);
    const int NT = (min(128 * (qb + 1), L) + 63) >> 6;
    v4u kreg, vreg;
#define AT_LOAD(j) do { const size_t r_ = (size_t)(rowb + (j) * 64 + lane); kreg = *(const v4u*)(KNB + r_ * 256 + h * 64 + 8 * wave); vreg = *(const v4u*)(ZM + r_ * NMIXP + D_V + h * 64 + 8 * wave); } while (0)
#define AT_STORE(buf) do { *(LAS v4u*)(Kt + (buf) * 64 * KS + lane * KS + 8 * wave) = kreg; LAS bf16* v_ = Vt + (buf) * 64 * KS + (8 * wave) * KS + pl; \
        v_[0] = (bf16)(vreg.x & 0xffffu); v_[KS] = (bf16)(vreg.x >> 16); v_[2 * KS] = (bf16)(vreg.y & 0xffffu); v_[3 * KS] = (bf16)(vreg.y >> 16); \
        v_[4 * KS] = (bf16)(vreg.z & 0xffffu); v_[5 * KS] = (bf16)(vreg.z >> 16); v_[6 * KS] = (bf16)(vreg.w & 0xffffu); v_[7 * KS] = (bf16)(vreg.w >> 16); } while (0)
    AT_LOAD(0); AT_STORE(0); if (NT > 1) AT_LOAD(1);
    LDS_WAIT(); __builtin_amdgcn_s_barrier(); asm volatile("" ::: "memory");
    float lsum = 0.f; f32x16_t o[2]; f32x16_t negm;
#pragma unroll
    for (int i = 0; i < 16; ++i) negm[i] = -mb;
#pragma unroll
    for (int i = 0; i < 16; ++i) { o[0][i] = 0.f; o[1][i] = 0.f; }
    for (int j = 0; j < NT; ++j) {
        const int k0 = 64 * j, buf = j & 1;
        if (k0 <= q0 + 31) {
            const LAS bf16* kb = Kt + buf * 64 * KS; const LAS bf16* vb = Vt + buf * 64 * KS;
            f32x16_t p0 = negm, p1 = negm;
#pragma unroll
            for (int d0 = 0; d0 < 2; ++d0) { const pg8::bf16x8 a0 = *(const LAS pg8::bf16x8*)(kb + r32 * KS + s * 32 + 16 * d0 + 8 * hi), a1 = *(const LAS pg8::bf16x8*)(kb + (32 + r32) * KS + s * 32 + 16 * d0 + 8 * hi);
                p0 = __builtin_amdgcn_mfma_f32_32x32x16_bf16(a0, qf[d0], p0, 0, 0, 0); p1 = __builtin_amdgcn_mfma_f32_32x32x16_bf16(a1, qf[d0], p1, 0, 0, 0); }
            if (q0 - k0 - 63 < 113) {
#pragma unroll
                for (int r = 0; r < 16; ++r) { const int n0 = (q0 + r32) - (k0 + crow_(r, hi)), n1 = n0 - 32;
                    p0[r] = n0 < 0 ? -INFINITY : p0[r] + (n0 < 128 ? BT[n0] : 0.f); p1[r] = n1 < 0 ? -INFINITY : p1[r] + (n1 < 128 ? BT[n1] : 0.f); } }
            typedef float f32x2_t __attribute__((ext_vector_type(2)));
            f32x2_t ps2 = {0.f, 0.f};
#pragma unroll
            for (int r = 0; r < 16; r += 2) { p0[r] = __builtin_amdgcn_exp2f(p0[r]); p0[r + 1] = __builtin_amdgcn_exp2f(p0[r + 1]); p1[r] = __builtin_amdgcn_exp2f(p1[r]); p1[r + 1] = __builtin_amdgcn_exp2f(p1[r + 1]);
                ps2 = ps2 + (f32x2_t){p0[r], p0[r + 1]}; ps2 = ps2 + (f32x2_t){p1[r], p1[r + 1]}; }
            lsum += ps2[0] + ps2[1];
            pg8::bf16x8 pb[4];
#pragma unroll
            for (int ks = 0; ks < 4; ++ks) { v4u w;
                if (ks < 2) { w.x = pg8::cvt_pk_bf16(p0[8 * ks], p0[8 * ks + 1]); w.y = pg8::cvt_pk_bf16(p0[8 * ks + 2], p0[8 * ks + 3]); w.z = pg8::cvt_pk_bf16(p0[8 * ks + 4], p0[8 * ks + 5]); w.w = pg8::cvt_pk_bf16(p0[8 * ks + 6], p0[8 * ks + 7]); }
                else { w.x = pg8::cvt_pk_bf16(p1[8 * ks - 16], p1[8 * ks - 15]); w.y = pg8::cvt_pk_bf16(p1[8 * ks - 14], p1[8 * ks - 13]); w.z = pg8::cvt_pk_bf16(p1[8 * ks - 12], p1[8 * ks - 11]); w.w = pg8::cvt_pk_bf16(p1[8 * ks - 10], p1[8 * ks - 9]); }
                pb[ks] = __builtin_bit_cast(pg8::bf16x8, w); }
#pragma unroll
            for (int d0 = 0; d0 < 2; ++d0)
#pragma unroll
                for (int ks = 0; ks < 4; ++ks) { const pg8::bf16x8 af = *(const LAS pg8::bf16x8*)(vb + (32 * d0 + r32) * KS + 16 * ks + 8 * hi); o[d0] = __builtin_amdgcn_mfma_f32_32x32x16_bf16(af, pb[ks], o[d0], 0, 0, 0); }
        }
        if (j + 1 < NT) AT_STORE(buf ^ 1);
        if (j + 2 < NT) AT_LOAD(j + 2);
        LDS_WAIT(); __builtin_amdgcn_s_barrier(); asm volatile("" ::: "memory");
    }
#undef AT_LOAD
#undef AT_STORE
    lsum = swapadd32(lsum); const float inv = 1.0f / lsum;
    LAS float* ox = OX + (qs * 32 + r32) * 65;
    if (s == 1) {
#pragma unroll
        for (int d0 = 0; d0 < 2; ++d0)
#pragma unroll
            for (int r = 0; r < 16; ++r) ox[32 * d0 + crow_(r, hi)] = o[d0][r] * inv; }
    LDS_WAIT(); __builtin_amdgcn_s_barrier(); asm volatile("" ::: "memory");
    if (s == 0) {
        float ss = 0.f;
#pragma unroll
        for (int d0 = 0; d0 < 2; ++d0)
#pragma unroll
            for (int r = 0; r < 16; ++r) { const float v = o[d0][r] * inv - lam * ox[32 * d0 + crow_(r, hi)]; o[d0][r] = v; ss += v * v; }
        ss = swapadd32(ss); const float rs = rsqrtf(ss * (1.0f / 64) + EPS) * (1.0f - lam_init);
        const int qpos = q0 + r32;
        if (qpos < L) { bf16* brp = BR + (size_t)(rowb + qpos) * D + 768 + h * 64;
#pragma unroll
            for (int d0 = 0; d0 < 2; ++d0)
#pragma unroll
                for (int r4 = 0; r4 < 4; ++r4) { const int dv = 32 * d0 + 8 * r4 + 4 * hi; const float* sl = C.in[I_SUBLN] + l * 64 + dv;
                    const unsigned w0 = pk2(o[d0][4 * r4] * rs * sl[0], o[d0][4 * r4 + 1] * rs * sl[1]), w1 = pk2(o[d0][4 * r4 + 2] * rs * sl[2], o[d0][4 * r4 + 3] * rs * sl[3]);
                    *(unsigned long long*)(brp + dv) = (unsigned long long)w0 | ((unsigned long long)w1 << 32); } }
    }
    LDS_WAIT(); __builtin_amdgcn_s_barrier(); asm volatile("" ::: "memory");
}
constexpr int PSTR = 68;
__device__ __forceinline__ pg8::bf16x8 cvt8(const f32x4 a, const f32x4 b) { v4u w; w.x = pg8::cvt_pk_bf16(a[0], a[1]); w.y = pg8::cvt_pk_bf16(a[2], a[3]); w.z = pg8::cvt_pk_bf16(b[0], b[1]); w.w = pg8::cvt_pk_bf16(b[2], b[3]); return __builtin_bit_cast(pg8::bf16x8, w); }
__device__ __forceinline__ void attn_sample_item(const Ctx& C, int l, int b, int split) {
    THREAD_IDS();
    const int h = wave & 3, half = wave >> 2, c16 = lane & 15, g = lane >> 4, srow = c16 >> 3, t = c16 & 7;
    const bf16* QNB = WSP(bf16, WS_QNB); const int* PT = (const int*)C.in[I_PT];
    const float* CK = C.in[I_CK] + (size_t)l * NPOOL * PAGE * 256; const float* CV = C.in[I_CV] + (size_t)l * NPOOL * PAGE * 256;
    LAS float* BT = (LAS float*)C.lds;
    BT[tid] = (C.in[I_RELB][t5_bucket(tid & 127) * 4 + (tid >> 7)] - C.in[I_RELB][31 * 4 + (tid >> 7)]) * LOG2E;
    const v4u z4 = {0u, 0u, 0u, 0u};
    const v4u q0w = srow == 0 ? *(const v4u*)(QNB + (size_t)(MP + b * 8 + t) * 256 + h * 64 + 8 * g) : z4, q1w = srow == 1 ? *(const v4u*)(QNB + (size_t)(MP + b * 8 + t) * 256 + h * 64 + 32 + 8 * g) : z4;
    const pg8::bf16x8 qf0 = __builtin_bit_cast(pg8::bf16x8, q0w), qf1 = __builtin_bit_cast(pg8::bf16x8, q1w);
    LDS_WAIT(); __builtin_amdgcn_s_barrier(); asm volatile("" ::: "memory");
    float m = -INFINITY, lsum = 0.f; f32x4 o[4];
#pragma unroll
    for (int db = 0; db < 4; ++db) o[db] = (f32x4){0.f, 0.f, 0.f, 0.f};
    const int kk0 = split * 1024 + half * 512;
    const int pg0 = __builtin_amdgcn_readfirstlane(PT[b * NPAGES + (kk0 >> 7)]), pg1 = __builtin_amdgcn_readfirstlane(PT[b * NPAGES + (kk0 >> 7) + 1]), pg2 = __builtin_amdgcn_readfirstlane(PT[b * NPAGES + (kk0 >> 7) + 2]), pg3 = __builtin_amdgcn_readfirstlane(PT[b * NPAGES + (kk0 >> 7) + 3]);
#define SA_LOAD(KR, VR, st) do { const int kk_ = kk0 + 32 * (st); const int pi_ = (st) >> 2; const int page_ = pi_ == 0 ? pg0 : pi_ == 1 ? pg1 : pi_ == 2 ? pg2 : pg3; const size_t base_ = ((size_t)(page_ * PAGE + (kk_ & 127)) * 4 + h) * 64; \
        _Pragma("unroll") for (int T = 0; T < 2; ++T) _Pragma("unroll") for (int ks = 0; ks < 2; ++ks) { const float* p = CK + base_ + (size_t)(16 * T + c16) * 256 + 32 * ks + 8 * g; KR[T][ks][0] = *(const f32x4*)p; KR[T][ks][1] = *(const f32x4*)(p + 4); } \
        _Pragma("unroll") for (int db = 0; db < 4; ++db) _Pragma("unroll") for (int j = 0; j < 8; ++j) { const int kv = j < 4 ? 4 * g + j : 16 + 4 * g + (j - 4); VR[db][j] = CV[base_ + (size_t)kv * 256 + 16 * db + c16]; } } while (0)
#define SA_MATH(KR, VR, st) do { const int kk = kk0 + 32 * (st); f32x4 sv[2]; \
        _Pragma("unroll") for (int T = 0; T < 2; ++T) { sv[T] = (f32x4){0.f, 0.f, 0.f, 0.f}; \
            sv[T] = __builtin_amdgcn_mfma_f32_16x16x32_bf16(cvt8(KR[T][0][0], KR[T][0][1]), qf0, sv[T], 0, 0, 0); \
            sv[T] = __builtin_amdgcn_mfma_f32_16x16x32_bf16(cvt8(KR[T][1][0], KR[T][1][1]), qf1, sv[T], 0, 0, 0); } \
        if (kk + 31 + 128 > PAST) { \
            _Pragma("unroll") for (int T = 0; T < 2; ++T) _Pragma("unroll") for (int r = 0; r < 4; ++r) { const int n = PAST + t - (kk + 16 * T + 4 * g + r); if (n < 128) sv[T][r] += BT[h * 128 + n]; } } \
        float mt = fmaxf(fmaxf(fmaxf(sv[0][0], sv[0][1]), fmaxf(sv[0][2], sv[0][3])), fmaxf(fmaxf(sv[1][0], sv[1][1]), fmaxf(sv[1][2], sv[1][3]))); \
        mt = fmaxf(mt, __shfl_xor(mt, 16)); mt = fmaxf(mt, __shfl_xor(mt, 32)); \
        const float mn = fmaxf(m, mt); const float al = __builtin_amdgcn_exp2f(m - mn); m = mn; float ps = 0.f; \
        _Pragma("unroll") for (int T = 0; T < 2; ++T) _Pragma("unroll") for (int r = 0; r < 4; ++r) { sv[T][r] = __builtin_amdgcn_exp2f(sv[T][r] - m); ps += sv[T][r]; } \
        lsum = lsum * al + ps; const pg8::bf16x8 pf = cvt8(sv[0], sv[1]); \
        _Pragma("unroll") for (int db = 0; db < 4; ++db) { o[db] = o[db] * al; \
            const f32x4 va = {VR[db][0], VR[db][1], VR[db][2], VR[db][3]}, vb = {VR[db][4], VR[db][5], VR[db][6], VR[db][7]}; \
            o[db] = __builtin_amdgcn_mfma_f32_16x16x32_bf16(cvt8(va, vb), pf, o[db], 0, 0, 0); } } while (0)
    f32x4 krA[2][2][2], krB[2][2][2]; float vrA[4][8], vrB[4][8];
    SA_LOAD(krA, vrA, 0);
#pragma unroll 1
    for (int step = 0; step < 16; step += 2) {
        SA_LOAD(krB, vrB, step + 1);
        SA_MATH(krA, vrA, step);
        if (step + 2 < 16) SA_LOAD(krA, vrA, step + 2);
        SA_MATH(krB, vrB, step + 1);
    }
#undef SA_LOAD
#undef SA_MATH
    lsum += __shfl_xor(lsum, 16); lsum += __shfl_xor(lsum, 32);
    float* pp = WSP(float, WS_PART) + ((((size_t)b * 4 + h) * 16 + split * 2 + half) * 16 + c16) * PSTR;
#pragma unroll
    for (int db = 0; db < 4; ++db) *(f32x4*)(pp + 16 * db + 4 * g) = o[db];
    if (g == 0) { pp[64] = m; pp[65] = lsum; }
    LDS_WAIT(); __builtin_amdgcn_s_barrier(); asm volatile("" ::: "memory");
}
__device__ __forceinline__ void n3_attn_sample_combine(const Ctx& C, int l, float lam_init) {
    THREAD_IDS();
    const float lam = lam_of(C, l, lam_init);
    const bf16* QNB = WSP(bf16, WS_QNB); const bf16* KNB = WSP(bf16, WS_KNB); const bf16* ZM = WSP(bf16, WS_ZMIX); bf16* BR = WSP(bf16, WS_BR);
    for (int it = gw; it < DB * 4 * DS; it += NGW) {
        const int b = it >> 5, h = (it >> 3) & 3, t = it & 7; float os[2];
        const float far = C.in[I_RELB][31 * 4 + h];
#pragma unroll
        for (int s = 0; s < 2; ++s) {
            const float* pb = WSP(float, WS_PART) + ((((size_t)b * 4 + h) * 16) * 16 + s * 8 + t) * PSTR;
            float sn[8]; float mm = -INFINITY;
            for (int pi = 0; pi < 16; ++pi) mm = fmaxf(mm, pb[(size_t)pi * 16 * PSTR + 64]);
#pragma unroll
            for (int jj = 0; jj < 8; ++jj) { float d = 0.f;
                for (int i = 0; i < 32; ++i) d += bf2f(QNB[(size_t)(MP + b * 8 + t) * 256 + h * 64 + s * 32 + i]) * bf2f(KNB[(size_t)(MP + b * 8 + jj) * 256 + h * 64 + s * 32 + i]);
                d += (C.in[I_RELB][t5_bucket(t - jj < 0 ? 0 : t - jj) * 4 + h] - far) * LOG2E;
                sn[jj] = jj <= t ? d : -INFINITY; mm = fmaxf(mm, sn[jj]); }
            float ll = 0.f, oo = 0.f;
            for (int pi = 0; pi < 16; ++pi) { const float* pr = pb + (size_t)pi * 16 * PSTR; const float w = exp2f(pr[64] - mm); ll += pr[65] * w; oo += pr[lane] * w; }
#pragma unroll
            for (int jj = 0; jj < 8; ++jj) { const float w = exp2f(sn[jj] - mm); ll += w; oo += w * bf2f(ZM[(size_t)(MP + b * 8 + jj) * NMIXP + D_V + h * 64 + lane]); }
            os[s] = oo / ll;
        }
        const float o = os[0] - lam * os[1]; const float ms = wave_sum(o * o) * (1.0f / 64);
        BR[(size_t)(MP + b * 8 + t) * D + 768 + h * 64 + lane] = (bf16)f2bf(o * rsqrtf(ms + EPS) * C.in[I_SUBLN][l * 64 + lane] * (1.0f - lam_init));
    }
}

__device__ __forceinline__ void n3_la_finalize(const Ctx& C, int l) {
    THREAD_IDS();
    const float* LAO = WSP(float, WS_LAO); const bf16* ZM = WSP(bf16, WS_ZMIX); bf16* BR = WSP(bf16, WS_BR);
    const bool ret = lane < 32; const int hd = (lane >> 3) & 3, c8 = (lane & 7) * 8;
    float gn[8];
#pragma unroll
    for (int j = 0; j < 8; ++j) gn[j] = (ret ? C.in[I_RGN] : C.in[I_GGN])[(l * 4 + hd) * 64 + c8 + j];
    for (int r = gw; r < MP; r += NGW) {
        const f32x4 a = *(const f32x4*)(LAO + (size_t)r * 512 + 8 * lane), b = *(const f32x4*)(LAO + (size_t)r * 512 + 8 * lane + 4);
        const v4u gw4 = *(const v4u*)(ZM + (size_t)r * NMIXP + (ret ? R_G : G_R) + hd * 64 + c8);
        float x[8] = {a[0], a[1], a[2], a[3], b[0], b[1], b[2], b[3]}, g[8]; unpack8(gw4, g);
        float s = ((x[0] + x[1]) + (x[2] + x[3])) + ((x[4] + x[5]) + (x[6] + x[7]));
        s += __shfl_xor(s, 1); s += __shfl_xor(s, 2); s += __shfl_xor(s, 4);
        const float mean = ret ? s * (1.0f / 64) : 0.f; float q2 = 0.f;
#pragma unroll
        for (int j = 0; j < 8; ++j) { x[j] -= mean; q2 += x[j] * x[j]; }
        q2 += __shfl_xor(q2, 1); q2 += __shfl_xor(q2, 2); q2 += __shfl_xor(q2, 4);
        const float rs = rsqrtf(q2 * (1.0f / 64) + EPS);
#pragma unroll
        for (int j = 0; j < 8; ++j) x[j] = siluf_(g[j]) * x[j] * rs * gn[j];
        *(v4u*)(BR + (size_t)r * D + 256 + 8 * lane) = pack8(x);
    }
}

constexpr int NQB_ATT = (L + 127) / 128;
constexpr int IT_LA = 32, IT_SS = IT_LA + DB * 8, IT_AT = IT_SS + 16 * NQB_ATT, IT_LS = IT_AT + 32, IT_CV = IT_LS + (MR + 63) / 64, IT_END = IT_CV;
__device__ __forceinline__ void n2_phase(const Ctx& C, int l, float lam_init, int qslot) {
    THREAD_IDS();
    const float lam = lam_of(C, l, lam_init);
    float mb;
    { float mq = 0.f, mk = 0.f, mbias = 0.f;
#pragma unroll 1
      for (int i = 0; i < 32; ++i) { mq = fmaxf(mq, fabsf(C.in[I_QN][l * 32 + i])); mk = fmaxf(mk, fabsf(C.in[I_KN][l * 32 + i])); }
#pragma unroll 1
      for (int i = 0; i < 128; ++i) mbias = fmaxf(mbias, C.in[I_RELB][i] - C.in[I_RELB][31 * 4 + (i & 3)]);
      mb = 1.02f * 1.4426950408889634f * 5.656854249492381f * mq * mk + 1.4426950408889634f * mbias; }
    unsigned* qw = (unsigned*)(C.ws + WS_CTL) + CW_QUEUE + 64 * qslot;
    volatile LAS int* slot = (volatile LAS int*)(C.lds + MISC_OFF + 64);
    if (blockIdx.x < IT_LA) { const int it = blockIdx.x; const int b = (it >> 2) & 3, h = it & 3; if (it < 16) la_chunked<64, true>(C, l, false, b, h); else la_chunked<32, false>(C, l, false, b, h); }
    for (;;) {
        if (tid == 0) slot[0] = (int)__hip_atomic_fetch_add(qw, 1u, __ATOMIC_RELAXED, __HIP_MEMORY_SCOPE_AGENT);
        __syncthreads();
        const int qi = slot[0];
        const int it = qi < 2 * DB * 8 ? ((qi & 1) ? IT_SS + (qi >> 1) : IT_LA + (qi >> 1)) : qi + IT_LA;
        __syncthreads();
        if (it >= IT_END) break;
        if (it < IT_SS) { const int i2 = it - IT_LA; attn_sample_item(C, l, i2 >> 3, i2 & 7); }
        else if (it < IT_AT) { const int i2 = it - IT_SS; attn_prompt_item(C, l, (i2 & 15) >> 2, i2 & 3, NQB_ATT - 1 - (i2 >> 4), lam, lam_init, mb); }
        else if (it < IT_LS) { const int i2 = (it - IT_AT) * 8 + wave; const int b = (i2 >> 2) & 31, h = i2 & 3; if (i2 < 128) la_seq<64, true>(C, l, true, b, h); else la_seq<32, false>(C, l, true, b, h); }
        else { conv_rows_item(C, l, it - IT_LS); conv_state_item(C, l, it - IT_LS, IT_CV - IT_LS); }
    }
}

template <int l> __device__ __forceinline__ void layer_fwd(const Ctx& C, const XcdBarrier& bar) {
#define GRID_BAR() xcd_barrier<false>(bar)
    LAS unsigned char* ring = C.lds + RING_OFF;
    float* SS = WSP(float, WS_SS); float* H = WSP(float, WS_H); bf16* HB = WSP(bf16, WS_HB); bf16* ACT = WSP(bf16, WS_ACT); bf16* ZMIX = WSP(bf16, WS_ZMIX); bf16* GATES = WSP(bf16, WS_GATES);
    bf16* BR = WSP(bf16, WS_BR); bf16* MERGED = WSP(bf16, WS_MERGED);
    constexpr float lam_init = l == 0 ? 0.2f : 0.35550906759096926f;
    constexpr bool last = (l == DEPTH - 1);
    { pg8::Gemm g{HB, WSP(bf16, WS_W1 + (size_t)(l * 2 + 0) * SZ_W1), D, D, D}; pg8::StaticOrder S; S.init(M, 2 * DFF, C.G, (int)blockIdx.x);
      EpiGLU E{ACT, SS + (size_t)(l * 3 + 0) * M * 16}; pg8::gemm_phase<EpiGLU, pg8::StaticOrder, true, true>(ring, g, S, E); }
    GRID_BAR();
    { pg8::HeadOrder S; S.init(M, D, C.G, (int)blockIdx.x); S.limit = C.G; EpiRes<false, 1> E{H, HB, SS + (size_t)(l * 3 + 1) * M * 16, nullptr};
      { pg8::Gemm g{ACT, WSP(bf16, WS_WD + (size_t)(l * 2 + 0) * SZ_WD), DFF, DFF, DFF}; pg8::gemm_phase<EpiRes<false, 1>, pg8::HeadOrder, true, true>(ring, g, S, E); }
      { int kt = DFF / 11; asm volatile("" : "+s"(kt)); pg8::Gemm g{ACT, WSP(bf16, WS_WD + (size_t)(l * 2 + 0) * SZ_WD), DFF, DFF, kt}; pg8::TailOrder T; T.init(M, D, C.G, (int)blockIdx.x); T.limit = C.G; T.nsplit = 11; T.kper = DFF / 11;
        EpiPartial EP{WSP(float, WS_KSP)}; pg8::gemm_phase<EpiPartial, pg8::TailOrder, true, true>(ring, g, T, EP); }
      GRID_BAR();
      ksp_finalize<11>(WSP(float, WS_KSP), S, C.G, E); }
    GRID_BAR();
    { pg8::Gemm g{HB, WSP(bf16, WS_WIN + (size_t)l * SZ_WIN), D, D, D}; pg8::StaticOrder S; S.init(M, NINP, C.G, (int)blockIdx.x);
      EpiZ E{ZMIX, GATES, SS + (size_t)(l * 3 + 1) * M * 16, WSP(float, WS_BINP) + l * NINP}; pg8::gemm_phase<EpiZ, pg8::StaticOrder, true, true>(ring, g, S, E); }
    GRID_BAR();
    n1_prep(C, l);
    GRID_BAR();
    n2_phase(C, l, lam_init, l);
    GRID_BAR();
    n3_attn_sample_combine(C, l, lam_init);
    n3_la_finalize(C, l);
    GRID_BAR();
    { pg8::Gemm g{BR, WSP(bf16, WS_WBR + (size_t)l * SZ_WBR), D, D, D}; pg8::StaticOrder S; S.init(M, D, C.G, (int)blockIdx.x);
      EpiMergeR E{MERGED, GATES}; pg8::gemm_phase<EpiMergeR, pg8::StaticOrder, true, true, 4>(ring, g, S, E); }
    GRID_BAR();
    { pg8::HeadOrder S; S.init(M, D, C.G, (int)blockIdx.x); S.limit = C.G; EpiRes<false, 2> E{H, HB, SS + (size_t)(l * 3 + 2) * M * 16, nullptr};
      { pg8::Gemm g{MERGED, WSP(bf16, WS_WOUT + (size_t)l * SZ_WOUT), D, D, D}; pg8::gemm_phase<EpiRes<false, 2>, pg8::HeadOrder, true, true>(ring, g, S, E); }
      { int kt = D / 4; asm volatile("" : "+s"(kt)); pg8::Gemm g{MERGED, WSP(bf16, WS_WOUT + (size_t)l * SZ_WOUT), D, D, kt}; pg8::TailOrder T; T.init(M, D, C.G, (int)blockIdx.x); T.limit = C.G; T.nsplit = 4; T.kper = D / 4;
        EpiPartial EP{WSP(float, WS_KSP)}; pg8::gemm_phase<EpiPartial, pg8::TailOrder, true, true>(ring, g, T, EP); }
      GRID_BAR();
      ksp_finalize<4>(WSP(float, WS_KSP), S, C.G, E); }
    GRID_BAR();
    { pg8::Gemm g{HB, WSP(bf16, WS_W1 + (size_t)(l * 2 + 1) * SZ_W1), D, D, D}; pg8::StaticOrder S; S.init(M, 2 * DFF, C.G, (int)blockIdx.x);
      EpiGLU E{ACT, SS + (size_t)(l * 3 + 2) * M * 16}; pg8::gemm_phase<EpiGLU, pg8::StaticOrder, true, true>(ring, g, S, E); }
    GRID_BAR();
    { pg8::HeadOrder S; S.init(M, D, C.G, (int)blockIdx.x); S.limit = C.G; EpiRes<last, 1> E{H, HB, last ? nullptr : SS + (size_t)((l + 1) * 3) * M * 16, C.out};
      { pg8::Gemm g{ACT, WSP(bf16, WS_WD + (size_t)(l * 2 + 1) * SZ_WD), DFF, DFF, DFF}; pg8::gemm_phase<EpiRes<last, 1>, pg8::HeadOrder, true, true>(ring, g, S, E); }
      { int kt = DFF / 11; asm volatile("" : "+s"(kt)); pg8::Gemm g{ACT, WSP(bf16, WS_WD + (size_t)(l * 2 + 1) * SZ_WD), DFF, DFF, kt}; pg8::TailOrder T; T.init(M, D, C.G, (int)blockIdx.x); T.limit = C.G; T.nsplit = 11; T.kper = DFF / 11;
        EpiPartial EP{WSP(float, WS_KSP)}; pg8::gemm_phase<EpiPartial, pg8::TailOrder, true, true>(ring, g, T, EP); }
      GRID_BAR();
      ksp_finalize<11>(WSP(float, WS_KSP), S, C.G, E); }
#undef GRID_BAR
}

__global__ void __launch_bounds__(NWAVES * 64, 2) fwd(Params P) {
    extern __shared__ __attribute__((aligned(16))) unsigned char lds[];
    Ctx C;
    C.in = P.in; C.out = P.out; C.ws = P.ws; C.lds = (LAS unsigned char*)lds;
    C.G = gridDim.x;
    volatile LAS unsigned* MISC = (volatile LAS unsigned*)(C.lds + MISC_OFF);
    for (int u = threadIdx.x; u < (LDS_BYTES - LDSCTL_OFF) / 4; u += NWAVES * 64) ((LAS unsigned*)(C.lds + LDSCTL_OFF))[u] = 0u;
    __syncthreads();
    unsigned* ctl = (unsigned*)(C.ws + WS_CTL);
    XcdBarrier bar = xcd_barrier_post(ctl + CW_BAR, MISC + 8);
    p0_prologue(C, P);
    xcd_barrier<true>(bar);
    layer_fwd<0>(C, bar);
    xcd_barrier<false>(bar);
    layer_fwd<1>(C, bar);
}

extern "C" void kernel_launch(void* const* d_in, const int* in_sizes, int n_in, void* d_out, int out_size, void* d_ws, size_t ws_size, hipStream_t stream) {
    static int grid = 0;
    if (grid == 0) {
        if (n_in != N_INPUTS || (size_t)out_size != O_END || ws_size < WS_END) { fprintf(stderr, "kernel_launch: unexpected shapes: n_in %d out %d (want %zu) ws %zu (want %zu)\n", n_in, out_size, (size_t)O_END, ws_size, (size_t)WS_END); grid = -1; return; }
        int dev = 0, cus = 0, per_cu = 0;
        if (hipGetDevice(&dev) != hipSuccess || hipDeviceGetAttribute(&cus, hipDeviceAttributeMultiprocessorCount, dev) != hipSuccess) { grid = -1; return; }
        if (hipFuncSetAttribute((const void*)fwd, hipFuncAttributeMaxDynamicSharedMemorySize, LDS_BYTES) != hipSuccess) { fprintf(stderr, "kernel_launch: hipFuncSetAttribute failed\n"); grid = -1; return; }
        if (hipOccupancyMaxActiveBlocksPerMultiprocessor(&per_cu, (const void*)fwd, NWAVES * 64, LDS_BYTES) != hipSuccess || per_cu < 1) { fprintf(stderr, "kernel_launch: occupancy query says %d blocks per CU\n", per_cu); }
        (void)hipGetLastError();
        grid = cus;
    }
    if (grid < 0) return;
    if (hipMemsetAsync((char*)d_ws + WS_CTL, 0, CTL_ZERO_BYTES, stream) != hipSuccess) return;
    Params p{};
    for (int i = 0; i < N_INPUTS; ++i) p.in[i] = (const float*)d_in[i];
    p.out = (float*)d_out; p.ws = (unsigned char*)d_ws;
    for (int i = 0; i < 32; ++i) p.inv_freq[i] = (float)pow(10000.0, -(double)i / 32.0);
    hipLaunchKernelGGL(fwd, dim3(grid), dim3(NWAVES * 64), LDS_BYTES, stream, p);
}
```

```cpp
#include <hip/hip_runtime.h>
#include <cstdio>
#include <cstdint>
#include <cmath>

namespace pg8 {
#define PG8_LAS __attribute__((address_space(3)))
typedef unsigned short bf16_t;
typedef short bf16x8 __attribute__((ext_vector_type(8)));
typedef float f32x4 __attribute__((ext_vector_type(4)));
typedef unsigned u32x4 __attribute__((ext_vector_type(4)));
constexpr int BM = 256, BK = 64, HALF = 128, HTB = HALF * BK * 2  , STAGE_BYTES = 8 * HTB, NXCD = 8, WGM = 8;

__host__ __device__ __forceinline__ int lds_byte(int r, int c) { const int st = (r >> 4) * 2 + (c >> 5), rr = r & 15, cc = c & 31, ob = rr * 64 + cc * 2; return st * 1024 + (ob ^ (((ob >> 9) & 1) << 5)); }
__host__ __device__ __forceinline__ void stage_rc(int b, int& R, int& C) { const int st = b / 1024, sb = b % 1024, swz = sb ^ (((sb >> 9) & 1) << 5); R = (st >> 1) * 16 + swz / 64; C = (st & 1) * 32 + (swz % 64) / 2; }
__host__ __device__ __forceinline__ int perm32(int rho) { const int n = rho >> 4, i = rho & 15; return 8 * (i >> 2) + 4 * n + (i & 3); }

struct Unit { int pm, pn, acol, bcol; };
struct Gemm { const bf16_t* A; const bf16_t* Bt; int lda, ldb, K; };

struct StaticOrder {
    int nM, nN, nwg, G, c;
    __host__ __device__ void init(int M, int N, int G_, int c_) { nM = M / BM; nN = N / BM; nwg = nM * nN; G = G_; c = c_; }
    __host__ __device__ void unit_of(int L, Unit& u) const {
        int wgid = L; { const int q = nwg / NXCD, r = nwg % NXCD, xcd = wgid % NXCD, off = wgid / NXCD; wgid = (xcd < r ? xcd * (q + 1) : r * (q + 1) + (xcd - r) * q) + off; }
        const int nig = WGM * nN, gid = wgid / nig, fm = gid * WGM, gsz = (nM - fm) < WGM ? (nM - fm) : WGM;
        u.pm = fm + ((wgid % nig) % gsz); u.pn = (wgid % nig) / gsz; u.acol = 0; u.bcol = 0;
    }
    __host__ __device__ bool next(int i, Unit& u) const { const long L = (long)i * G + c; if (L >= nwg) return false; unit_of((int)L, u); return true; }
};
struct HeadOrder : StaticOrder { int limit; __host__ __device__ bool next(int i, Unit& u) const { const long L = (long)i * G + c; if (L >= limit || L >= nwg) return false; unit_of((int)L, u); return true; } };
struct TailOrder : StaticOrder { int limit, nsplit, kper;
    __host__ __device__ bool next(int i, Unit& u) const {
        if (i > 0 || c >= (nwg - limit) * nsplit) return false;
        unit_of(limit + c / nsplit, u); u.acol = u.bcol = (c % nsplit) * kper; return true; } };
__device__ __forceinline__ unsigned cvt_pk_bf16(float lo, float hi) { unsigned r; asm volatile("v_cvt_pk_bf16_f32 %0, %1, %2" : "=v"(r) : "v"(lo), "v"(hi)); return r; }

template <class Epi, class Sched, bool ALIGN_EPI = false, bool SP2 = false, int SEG = 0>
__device__ __forceinline__ void gemm_phase(PG8_LAS unsigned char* lds, const Gemm g, const Sched& S, const Epi& E) {
    int tid_ = threadIdx.x; asm volatile("" : "+v"(tid_));
    const int tid = tid_, wid = __builtin_amdgcn_readfirstlane(tid >> 6), lane = tid & 63, wr = wid >> 2, wc = wid & 3, fr = lane & 15, fq = lane >> 4;
    const int nt = g.K / BK;
    unsigned voffA[2], voffB[2];
#pragma unroll
    for (int i = 0; i < 2; ++i) { int R, C; stage_rc(tid * 16 + i * 8192, R, C); const int Rb = Epi::PERM ? ((R & ~31) + perm32(R & 31)) : R;
        voffA[i] = (unsigned)(R * g.lda + C) * 2u; voffB[i] = (unsigned)(Rb * g.ldb + C) * 2u; }
    const size_t kstep = (size_t)(BK * 2);
    const size_t hstepA = (size_t)HALF * g.lda * 2, hstepB = (size_t)HALF * g.ldb * 2;
    const size_t tstepA = 2 * hstepA, tstepB = 2 * hstepB;
    const unsigned ldsw = (unsigned)wid * 1024u;
    const int aoff = lds_byte(wr * 64 + fr, fq * 8), boff = lds_byte(wc * 32 + fr, fq * 8);
#define PG8_SA(b, h) (((b) * 2 + (h)) * HTB)
#define PG8_SB(b, h) ((4 + (b) * 2 + (h)) * HTB)
#define PG8_STAGE(bufoff, gbase, voff) do { _Pragma("unroll") for (int _i = 0; _i < 2; ++_i) \
        __builtin_amdgcn_global_load_lds((const unsigned*)((const char*)(gbase) + (voff)[_i]), (PG8_LAS unsigned*)(lds + (bufoff) + ldsw + _i * 8192), 16, 0, 0); } while (0)
#define PG8_LDA(dst, b, h) do { _Pragma("unroll") for (int m = 0; m < 4; ++m) _Pragma("unroll") for (int k = 0; k < 2; ++k) dst[m][k] = *(const PG8_LAS bf16x8*)(lds + PG8_SA(b, h) + aoff + m * 2048 + k * 1024); } while (0)
#define PG8_LDB(dst, b, h) do { _Pragma("unroll") for (int n = 0; n < 2; ++n) _Pragma("unroll") for (int k = 0; k < 2; ++k) dst[n][k] = *(const PG8_LAS bf16x8*)(lds + PG8_SB(b, h) + boff + n * 2048 + k * 1024); } while (0)
#define PG8_MMA(ai, bj, At, Bt) do { __builtin_amdgcn_s_setprio(1); _Pragma("unroll") for (int m = 0; m < 4; ++m) _Pragma("unroll") for (int n = 0; n < 2; ++n) _Pragma("unroll") for (int k = 0; k < 2; ++k) \
        acc[ai][bj][m][n] = __builtin_amdgcn_mfma_f32_16x16x32_bf16(Bt[n][k], At[m][k], acc[ai][bj][m][n], 0, 0, 0); __builtin_amdgcn_s_setprio(0); } while (0)
#define PG8_WAIT_V(n) asm volatile("s_waitcnt vmcnt(" #n ")" ::: "memory")
#define PG8_WAIT_L(n) asm volatile("s_waitcnt lgkmcnt(" #n ")" ::: "memory")
#define PG8_BAR __builtin_amdgcn_s_barrier()
#define PG8_SCHED __builtin_amdgcn_sched_barrier(0)
    Unit cur, nxt; int ui = 0;
    if (!S.next(0, cur)) return;
    f32x4 acc[2][2][4][2];
#pragma unroll
    for (int a = 0; a < 2; ++a)
#pragma unroll
        for (int b = 0; b < 2; ++b)
#pragma unroll
            for (int m = 0; m < 4; ++m)
#pragma unroll
                for (int n = 0; n < 2; ++n) acc[a][b][m][n] = (f32x4){0.f, 0.f, 0.f, 0.f};
    bf16x8 At[4][2], B0[2][2], B1[2][2];
    const char* cA = (const char*)g.A + (size_t)cur.pm * tstepA + (size_t)cur.acol * 2; const char* cB = (const char*)g.Bt + (size_t)cur.pn * tstepB + (size_t)cur.bcol * 2;
    if constexpr (SP2) {
        PG8_STAGE(PG8_SB(0, 0), cB, voffB); PG8_STAGE(PG8_SB(0, 1), cB + hstepB, voffB); PG8_STAGE(PG8_SA(0, 0), cA, voffA); PG8_STAGE(PG8_SA(0, 1), cA + hstepA, voffA);
        if (wr == 1) PG8_BAR;
        PG8_WAIT_V(2); PG8_BAR;
        PG8_STAGE(PG8_SB(1, 0), cB + kstep, voffB); PG8_STAGE(PG8_SA(1, 0), cA + kstep, voffA); PG8_STAGE(PG8_SB(1, 1), cB + hstepB + kstep, voffB);
        PG8_WAIT_V(6); PG8_BAR;
    } else {
        PG8_STAGE(PG8_SB(0, 0), cB, voffB); PG8_STAGE(PG8_SA(0, 0), cA, voffA); PG8_STAGE(PG8_SB(0, 1), cB + hstepB, voffB); PG8_STAGE(PG8_SA(0, 1), cA + hstepA, voffA);
        if (wr == 1) PG8_BAR;
        PG8_WAIT_V(4); PG8_BAR;
        PG8_STAGE(PG8_SB(1, 0), cB + kstep, voffB); PG8_STAGE(PG8_SA(1, 0), cA + kstep, voffA); PG8_STAGE(PG8_SB(1, 1), cB + hstepB + kstep, voffB);
        PG8_WAIT_V(6); PG8_BAR;
    }
    for (;;) {
        const bool has_next = S.next(ui + 1, nxt);
        const char* nA = has_next ? (const char*)g.A + (size_t)nxt.pm * tstepA + (size_t)nxt.acol * 2 : cA; const char* nB = has_next ? (const char*)g.Bt + (size_t)nxt.pn * tstepB + (size_t)nxt.bcol * 2 : cB;
        for (int t = 0; t < nt; t += 2) {
            const bool last = (t == nt - 2);
            const char* a1 = cA + (size_t)(t + 1) * kstep;
            const char* a2 = last ? nA : cA + (size_t)(t + 2) * kstep; const char* b2 = last ? nB : cB + (size_t)(t + 2) * kstep;
            const char* a3 = a2 + kstep; const char* b3 = b2 + kstep;
            if constexpr (SP2) {
            PG8_LDB(B0, 0, 0); PG8_LDB(B1, 0, 1); PG8_SCHED; PG8_LDA(At, 0, 0); PG8_STAGE(PG8_SA(1, 1), a1 + hstepA, voffA);
            PG8_WAIT_V(8); PG8_WAIT_L(0); PG8_BAR; PG8_MMA(0, 0, At, B0); PG8_MMA(0, 1, At, B1); PG8_BAR; PG8_SCHED;
            PG8_LDA(At, 0, 1); PG8_STAGE(PG8_SB(0, 0), b2, voffB); PG8_STAGE(PG8_SB(0, 1), b2 + hstepB, voffB); PG8_STAGE(PG8_SA(0, 0), a2, voffA);
            PG8_WAIT_V(8); PG8_WAIT_L(0); PG8_BAR; PG8_MMA(1, 0, At, B0); PG8_MMA(1, 1, At, B1); PG8_BAR; PG8_SCHED;
            PG8_LDB(B0, 1, 0); PG8_LDB(B1, 1, 1); PG8_SCHED; PG8_LDA(At, 1, 0); PG8_STAGE(PG8_SA(0, 1), a2 + hstepA, voffA);
            PG8_WAIT_V(8); PG8_WAIT_L(0); PG8_BAR; PG8_MMA(0, 0, At, B0); PG8_MMA(0, 1, At, B1); PG8_BAR; PG8_SCHED;
            PG8_LDA(At, 1, 1); PG8_STAGE(PG8_SB(1, 0), b3, voffB); PG8_STAGE(PG8_SB(1, 1), b3 + hstepB, voffB); PG8_STAGE(PG8_SA(1, 0), a3, voffA);
            PG8_WAIT_V(8); PG8_WAIT_L(0); PG8_BAR; PG8_MMA(1, 0, At, B0); PG8_MMA(1, 1, At, B1); PG8_BAR; PG8_SCHED;
            } else {
            PG8_LDB(B0, 0, 0); PG8_SCHED; PG8_LDA(At, 0, 0); PG8_STAGE(PG8_SA(1, 1), a1 + hstepA, voffA);
            PG8_WAIT_L(8); PG8_BAR; PG8_WAIT_L(0); PG8_MMA(0, 0, At, B0); PG8_BAR; PG8_SCHED;
            PG8_LDB(B1, 0, 1); PG8_STAGE(PG8_SB(0, 0), b2, voffB);
            PG8_BAR; PG8_WAIT_L(0); PG8_MMA(0, 1, At, B1); PG8_BAR;
            PG8_LDA(At, 0, 1); PG8_STAGE(PG8_SA(0, 0), a2, voffA);
            PG8_BAR; PG8_WAIT_L(0); PG8_MMA(1, 0, At, B0); PG8_BAR; PG8_SCHED;
            PG8_STAGE(PG8_SB(0, 1), b2 + hstepB, voffB);
            PG8_WAIT_V(6); PG8_BAR; PG8_MMA(1, 1, At, B1); PG8_BAR;
            PG8_LDB(B0, 1, 0); PG8_SCHED; PG8_LDA(At, 1, 0); PG8_STAGE(PG8_SA(0, 1), a2 + hstepA, voffA);
            PG8_WAIT_L(8); PG8_BAR; PG8_WAIT_L(0); PG8_MMA(0, 0, At, B0); PG8_BAR; PG8_SCHED;
            PG8_LDB(B1, 1, 1); PG8_STAGE(PG8_SB(1, 0), b3, voffB);
            PG8_BAR; PG8_WAIT_L(0); PG8_MMA(0, 1, At, B1); PG8_BAR;
            PG8_LDA(At, 1, 1); PG8_STAGE(PG8_SA(1, 0), a3, voffA);
            PG8_BAR; PG8_WAIT_L(0); PG8_MMA(1, 0, At, B0); PG8_BAR; PG8_SCHED;
            PG8_STAGE(PG8_SB(1, 1), b3 + hstepB, voffB);
            PG8_WAIT_V(6); PG8_BAR; PG8_MMA(1, 1, At, B1); PG8_BAR;
            }
            if constexpr (SEG > 0) { if (((t + 2) % SEG) == 0 && (t + 2) < nt) E.mid(acc, cur, (t + 2) / SEG); }
        }
        if constexpr (ALIGN_EPI) { if (wr == 0) PG8_BAR; }
        E(acc, cur, wr, wc, fr, fq);
        if (!has_next) break;
#pragma unroll
        for (int a = 0; a < 2; ++a)
#pragma unroll
            for (int b = 0; b < 2; ++b)
#pragma unroll
                for (int m = 0; m < 4; ++m)
#pragma unroll
                    for (int n = 0; n < 2; ++n) acc[a][b][m][n] = (f32x4){0.f, 0.f, 0.f, 0.f};
        cur = nxt; cA = nA; cB = nB; ++ui;
        if constexpr (ALIGN_EPI) { if (wr == 1) PG8_BAR; }
    }
    PG8_WAIT_V(0);
    if constexpr (!ALIGN_EPI) { if (wr == 0) PG8_BAR; }
    PG8_BAR;
#undef PG8_SA
#undef PG8_SB
#undef PG8_STAGE
#undef PG8_LDA
#undef PG8_LDB
#undef PG8_MMA
#undef PG8_WAIT_V
#undef PG8_WAIT_L
#undef PG8_BAR
#undef PG8_SCHED
}
}

constexpr int NWAVES = 8;
constexpr int D = 1024, DFF = 2816, NIN = 7184, NMIX = 3088, NMIXP = 3328, NGATE = 4096, NINP = NMIXP + NGATE;
constexpr int SEQ = 4096, NMETA = 16, L = SEQ + NMETA, BATCH = 4, DB = 32, DS = 8, PAST = 8192, PAGE = 128, NPAGES = PAST / PAGE, NPOOL = 2560, DEPTH = 2;
constexpr int MP = BATCH * L, MS = DB * DS, MR = MP + MS, M = 16896;
constexpr int NPOS = L + DS;
constexpr float EPS = 1e-6f;
constexpr int C_A = 0, C_G = 256, R_Q = 512, R_K = 768, R_V = 1024, R_G = 1280, G_Q = 1536, G_K = 1664, G_V = 1792, G_R = 2048, G_LOW = 2304, D_Q = 2320, D_K = 2576, D_V = 2832;
constexpr size_t O_YP = 0, O_YS = O_YP + (size_t)BATCH * SEQ * D, O_KP = O_YS + (size_t)MS * D, O_VP = O_KP + (size_t)DEPTH * MP * 256, O_KS = O_VP + (size_t)DEPTH * MP * 256,
                 O_VS = O_KS + (size_t)DEPTH * MS * 256, O_RP = O_VS + (size_t)DEPTH * MS * 256, O_RS = O_RP + (size_t)DEPTH * BATCH * 4 * 64 * 64, O_GP = O_RS + (size_t)DEPTH * DB * 4 * 64 * 64,
                 O_GS = O_GP + (size_t)DEPTH * BATCH * 4 * 32 * 64, O_CP = O_GS + (size_t)DEPTH * DB * 4 * 32 * 64, O_CS = O_CP + (size_t)DEPTH * BATCH * 30 * 256, O_END = O_CS + (size_t)DEPTH * DB * 30 * 256;
enum { I_XP = 0, I_XS, I_CK, I_CV, I_PT, I_SRET, I_SGLA, I_SCONV, I_META, I_RELB, I_NF1, I_F1G, I_F1U, I_F1D, I_NMIX, I_WIN, I_BIN, I_CW, I_CB, I_CLG, I_CLB, I_RGN, I_GAW, I_GAB, I_GGN,
       I_QN, I_KN, I_LQ1, I_LK1, I_LQ2, I_LK2, I_SUBLN, I_WBR, I_WOUT, I_NF2, I_F2G, I_F2U, I_F2D, N_INPUTS };

constexpr size_t MiB = 1u << 20;
constexpr size_t WS_CTL = 0, CTL_ZERO_BYTES = 1 * MiB;
constexpr size_t SZ_SS = (size_t)M * 16 * 4;
constexpr size_t SZ_W1 = (size_t)2 * DFF * D * 2, SZ_WD = (size_t)D * DFF * 2, SZ_WIN = (size_t)NINP * D * 2, SZ_WBR = (size_t)4 * D * 256 * 2, SZ_WOUT = (size_t)D * D * 2;
constexpr size_t WS_W1 = 4 * MiB;
constexpr size_t WS_WD = WS_W1 + 4 * SZ_W1;
constexpr size_t WS_WIN = WS_WD + 4 * SZ_WD;
constexpr size_t WS_WBR = WS_WIN + 2 * SZ_WIN;
constexpr size_t WS_WOUT = WS_WBR + 2 * SZ_WBR;
constexpr size_t WS_BINP = WS_WOUT + 2 * SZ_WOUT;
constexpr size_t WS_ROPE = WS_BINP + 64 * 1024;
constexpr size_t WS_SS = WS_ROPE + 2 * MiB;
constexpr size_t WS_H = 128 * MiB;
constexpr size_t WS_HB = WS_H + (size_t)M * D * 4;
constexpr size_t WS_ACT = WS_HB + (size_t)M * D * 2;
constexpr size_t WS_ZMIX = WS_ACT + (size_t)M * DFF * 2;
constexpr size_t WS_GATES = WS_ZMIX + (size_t)M * NMIXP * 2;
constexpr size_t WS_BR = WS_GATES + (size_t)M * NGATE * 2;
constexpr size_t WS_MERGED = WS_BR + (size_t)M * D * 2;
constexpr size_t WS_UBUF = WS_MERGED + (size_t)M * D * 2;
constexpr size_t WS_RQ = WS_UBUF + (size_t)M * 256 * 4, WS_RK = WS_RQ + (size_t)M * 256 * 4, WS_QN = WS_RK + (size_t)M * 256 * 4, WS_KN = WS_QN + (size_t)M * 256 * 4, WS_VB = WS_KN + (size_t)M * 256 * 4;
constexpr size_t WS_LDEC = WS_VB + (size_t)M * 256 * 4;
constexpr size_t WS_QNB = WS_LDEC + (size_t)M * 128 * 4;
constexpr size_t WS_KNB = WS_QNB + (size_t)M * 256 * 2;
constexpr size_t WS_PART = WS_KNB + (size_t)M * 256 * 2;
constexpr size_t WS_LAO = WS_PART + (size_t)DB * 4 * 16 * 16 * 68 * 4;
constexpr size_t WS_KSP = WS_LAO + (size_t)M * 512 * 4;
constexpr size_t WS_END = WS_KSP + (size_t)8 * 11 * 65536 * 4;
static_assert(WS_ROPE + 2 * NPOS * 32 * 4 <= WS_SS && WS_SS + 6 * SZ_SS <= WS_H, "weights region overflows");
constexpr int CW_BAR = 4096, CW_QUEUE = 8192;

constexpr int RING_OFF = 0, RING_BYTES = 131072;
constexpr int LDSCTL_OFF = 144384, MISC_OFF = LDSCTL_OFF + 320;
constexpr int LDS_BYTES = 147456;
static_assert(MISC_OFF + 128 <= LDS_BYTES, "LDS map");

#define GAS __attribute__((address_space(1)))
#define LAS __attribute__((address_space(3)))
typedef unsigned short bf16;
typedef unsigned v4u __attribute__((ext_vector_type(4)));
typedef float f32x4 __attribute__((ext_vector_type(4)));
#define LDS_WAIT() asm volatile("s_waitcnt lgkmcnt(0)" ::: "memory")
#define VM_WAIT() asm volatile("s_waitcnt vmcnt(0)" ::: "memory")
__device__ __forceinline__ unsigned f2bf(float f) { unsigned u = __builtin_bit_cast(unsigned, f); return (u + 0x7fffu + ((u >> 16) & 1u)) >> 16; }
__device__ __forceinline__ unsigned pk2(float lo, float hi) { return f2bf(lo) | (f2bf(hi) << 16); }
__device__ __forceinline__ float bf2f(bf16 b) { return __builtin_bit_cast(float, ((unsigned)b) << 16); }
__device__ __forceinline__ float bflo(unsigned w) { return __builtin_bit_cast(float, w << 16); }
__device__ __forceinline__ float bfhi(unsigned w) { return __builtin_bit_cast(float, w & 0xffff0000u); }
__device__ __forceinline__ float wave_sum(float v) {
#pragma unroll
    for (int o = 1; o < 64; o <<= 1) v += __shfl_xor(v, o);
    return v;
}
__device__ __forceinline__ float sigmoidf_(float x) { return __builtin_amdgcn_rcpf(1.0f + __expf(-x)); }
__device__ __forceinline__ float siluf_(float x) { return x * __builtin_amdgcn_rcpf(1.0f + __expf(-x)); }

#define XB_TMO      128
#define XB_XCNT(j)  (256  + 64 * (j))
#define XB_XSUB(j)  (1280 + 64 * (j))
#define XB_XGEN(j)  (2304 + 64 * (j))
#define XB_TOP      3328
#define XB_TOPGEN   3392
#define XCD_BAR_WORDS 3456
#define XB_SPIN_CAP (1u << 22)

__device__ __forceinline__ unsigned xb_ld(unsigned* p)              { return __hip_atomic_load(p, __ATOMIC_RELAXED, __HIP_MEMORY_SCOPE_AGENT); }
__device__ __forceinline__ unsigned xb_add(unsigned* p, unsigned v) { return __hip_atomic_fetch_add(p, v, __ATOMIC_RELAXED, __HIP_MEMORY_SCOPE_AGENT); }
__device__ __forceinline__ unsigned xb_xcc_id() { return (unsigned)__builtin_amdgcn_s_getreg((3 << 11) | 20) & 0xFu; }
#define XB_SPIN(cond, bar) do { unsigned _sp = 0; while (cond) { __builtin_amdgcn_s_sleep(1); \
    if ((++_sp & 255u) == 0u) { if (xb_ld(&(bar)[XB_TMO])) break; if (_sp > XB_SPIN_CAP) { atomicAdd(&(bar)[XB_TMO], 1u); break; } } } } while (0)

struct XcdBarrier { unsigned* bar; unsigned x; volatile LAS unsigned* st; };

__device__ __forceinline__ XcdBarrier xcd_barrier_post(unsigned* bar, volatile LAS unsigned* st) {
    XcdBarrier b; b.bar = bar; b.x = xb_xcc_id(); b.st = st;
    if (threadIdx.x == 0) (void)xb_add(&bar[XB_XCNT(b.x)], 1u);
    return b;
}
__device__ __forceinline__ void xcd_barrier_complete(unsigned* bar, unsigned x, unsigned& nloc, unsigned& nx) {
    const unsigned G = gridDim.x * gridDim.y * gridDim.z;
    unsigned sum, cnt, mine, sp = 0u;
    for (;;) {
        sum = 0u; cnt = 0u; mine = 0u;
#pragma unroll
        for (unsigned j = 0; j < 16; ++j) { const unsigned c = xb_ld(&bar[XB_XCNT(j)]); sum += c; cnt += (c > 0u) ? 1u : 0u; mine = (j == x) ? c : mine; }
        if (sum == G) break;
        __builtin_amdgcn_s_sleep(1);
        if ((++sp & 255u) == 0u) { if (xb_ld(&bar[XB_TMO])) break; if (sp > XB_SPIN_CAP) { atomicAdd(&bar[XB_TMO], 1u); break; } }
    }
    nloc = mine > 0u ? mine : 1u; nx = cnt > 0u ? cnt : 1u;
}
#ifndef FLAT_BAR
#define FLAT_BAR 0
#endif
__device__ __forceinline__ void flat_barrier(const XcdBarrier& b) {
    asm volatile("s_waitcnt vmcnt(0)" ::: "memory");
    __syncthreads();
    if (threadIdx.x == 0) {
        unsigned* bar = b.bar;
        asm volatile("" : "+s"(bar));
        const unsigned epoch = b.st[2] + 1u; b.st[2] = epoch; const unsigned target = epoch * gridDim.x;
        __builtin_amdgcn_fence(__ATOMIC_RELEASE, "agent");
        asm volatile("s_waitcnt vmcnt(0)" ::: "memory");
        (void)xb_add(&bar[XB_TOP], 1u);
        unsigned sp = 0u;
        while (xb_ld(&bar[XB_TOP]) < target) { __builtin_amdgcn_s_sleep(1); if ((++sp & 255u) == 0u) { if (xb_ld(&bar[XB_TMO])) break; if (sp > XB_SPIN_CAP) { atomicAdd(&bar[XB_TMO], 1u); break; } } }
        __builtin_amdgcn_fence(__ATOMIC_ACQUIRE, "agent");
        asm volatile("s_waitcnt vmcnt(0)" ::: "memory");
    }
    __syncthreads();
}
template <bool FIRST> __device__ __forceinline__ void xcd_barrier(const XcdBarrier& b) {
    if (FLAT_BAR) { flat_barrier(b); return; }
    asm volatile("s_waitcnt vmcnt(0)" ::: "memory");
    __syncthreads();
    if (threadIdx.x == 0) {
        unsigned* bar = b.bar;
        asm volatile("" : "+s"(bar));
        __builtin_amdgcn_s_waitcnt(0);
        unsigned nloc = b.st[0], nx = b.st[1];
        if (FIRST) { if (nloc == 0u) { xcd_barrier_complete(bar, b.x, nloc, nx); b.st[0] = nloc; b.st[1] = nx; } }
        const unsigned old = xb_add(&bar[XB_XSUB(b.x)], 1u);
        const unsigned gen = old / nloc;
        if (old + 1u == (gen + 1u) * nloc) {
            __builtin_amdgcn_fence(__ATOMIC_RELEASE, "agent");
            asm volatile("s_waitcnt vmcnt(0)" ::: "memory");
            const unsigned og = xb_add(&bar[XB_TOP], 1u);
            const unsigned tg = og / nx;
            if (og + 1u == (tg + 1u) * nx) xb_add(&bar[XB_TOPGEN], 1u);
            else XB_SPIN(xb_ld(&bar[XB_TOPGEN]) == tg, bar);
            __builtin_amdgcn_fence(__ATOMIC_ACQUIRE, "agent");
            xb_add(&bar[XB_XGEN(b.x)], 1u);
            asm volatile("s_waitcnt vmcnt(0)" ::: "memory");
        } else {
            XB_SPIN(xb_ld(&bar[XB_XGEN(b.x)]) == gen, bar);
            __builtin_amdgcn_fence(__ATOMIC_ACQUIRE, "agent");
            asm volatile("s_waitcnt vmcnt(0)" ::: "memory");
        }
    }
    __syncthreads();
}

struct Params { const float* in[N_INPUTS]; float* out; unsigned char* ws; float inv_freq[32]; };
static_assert(sizeof(Params) == N_INPUTS * 8 + 16 + 128, "Params has no padding");

struct Ctx {
    const float* const* in; float* out; unsigned char* ws;
    LAS unsigned char* lds;
    int G;
};
#define THREAD_IDS() int tid_ = threadIdx.x; asm volatile("" : "+v"(tid_)); const int tid = tid_, lane = tid & 63, wave = __builtin_amdgcn_readfirstlane(tid >> 6), gw = blockIdx.x * NWAVES + wave, NGW = C.G * NWAVES; (void)tid; (void)lane; (void)wave; (void)gw; (void)NGW
#define WSP(T, off) ((T*)(C.ws + (off)))

__device__ __forceinline__ float rstd_of(const float* ssp, int row) {
    const f32x4 a = *(const f32x4*)(ssp + (size_t)row * 16), b = *(const f32x4*)(ssp + (size_t)row * 16 + 4), c = *(const f32x4*)(ssp + (size_t)row * 16 + 8), d = *(const f32x4*)(ssp + (size_t)row * 16 + 12);
    const float s = (((a[0] + a[1]) + (a[2] + a[3])) + ((b[0] + b[1]) + (b[2] + b[3]))) + (((c[0] + c[1]) + (c[2] + c[3])) + ((d[0] + d[1]) + (d[2] + d[3])));
    return rsqrtf(s * (1.0f / D) + EPS);
}
#define EPI_IDS() int t_ = threadIdx.x; asm volatile("" : "+v"(t_)); const int wid_ = __builtin_amdgcn_readfirstlane(t_ >> 6), wr = wid_ >> 2, wc = wid_ & 3, fr = t_ & 15, fq = (t_ & 63) >> 4
struct EpiGLU {
    static constexpr bool PERM = true;
    bf16* act; const float* ss;
    __device__ __forceinline__ void operator()(const pg8::f32x4 (&acc)[2][2][4][2], const pg8::Unit& u, int, int, int, int) const {
        EPI_IDS();
        const int row0 = u.pm * 256 + wr * 64 + fr, col0 = u.pn * 128 + wc * 32 + 8 * fq;
#pragma unroll
        for (int ai = 0; ai < 2; ++ai)
#pragma unroll
            for (int m = 0; m < 4; ++m) {
                const int row = row0 + ai * 128 + m * 16; const float rstd = rstd_of(ss, row);
                float o[8];
#pragma unroll
                for (int n = 0; n < 2; ++n)
#pragma unroll
                    for (int j = 0; j < 4; ++j) { const float g = acc[ai][0][m][n][j] * rstd, up = acc[ai][1][m][n][j] * rstd; o[n * 4 + j] = siluf_(g) * up; }
                v4u w; w.x = pg8::cvt_pk_bf16(o[0], o[1]); w.y = pg8::cvt_pk_bf16(o[2], o[3]); w.z = pg8::cvt_pk_bf16(o[4], o[5]); w.w = pg8::cvt_pk_bf16(o[6], o[7]);
                *(v4u*)(act + (size_t)row * DFF + col0) = w;
            }
    }
};
template <bool FINAL, int SCALE2> struct EpiRes {
    static constexpr bool PERM = true;
    float* h; bf16* hb; float* ssout; float* out;
    __device__ __forceinline__ void rowgroup(const pg8::f32x4 (&a)[2][2], int row, int col0, int pn, int wc, int fq) const {
        constexpr float scale = 0.5f * SCALE2; float sq = 0.f;
        long yoff = -1;
        if (FINAL) { if (row < MP) { const int b = row / L, pos = row - b * L; if (pos >= NMETA) yoff = (long)O_YP + ((long)b * SEQ + (pos - NMETA)) * D; } else if (row < MR) yoff = (long)O_YS + (long)(row - MP) * D; }
#pragma unroll
        for (int bj = 0; bj < 2; ++bj) {
            const size_t off = (size_t)row * D + col0 + bj * 128;
            f32x4 h0 = *(const f32x4*)(h + off), h1 = *(const f32x4*)(h + off + 4);
            h0 = h0 + a[bj][0] * scale; h1 = h1 + a[bj][1] * scale;
            *(f32x4*)(h + off) = h0; *(f32x4*)(h + off + 4) = h1;
            v4u w; w.x = pg8::cvt_pk_bf16(h0[0], h0[1]); w.y = pg8::cvt_pk_bf16(h0[2], h0[3]); w.z = pg8::cvt_pk_bf16(h1[0], h1[1]); w.w = pg8::cvt_pk_bf16(h1[2], h1[3]);
            *(v4u*)(hb + off) = w;
            sq += (h0[0] * h0[0] + h0[1] * h0[1]) + (h0[2] * h0[2] + h0[3] * h0[3]) + (h1[0] * h1[0] + h1[1] * h1[1]) + (h1[2] * h1[2] + h1[3] * h1[3]);
            if (FINAL && yoff >= 0) { *(f32x4*)(out + yoff + col0 + bj * 128) = h0; *(f32x4*)(out + yoff + col0 + bj * 128 + 4) = h1; }
        }
        sq += __shfl_xor(sq, 16); sq += __shfl_xor(sq, 32);
        if (fq == 0 && ssout) ssout[(size_t)row * 16 + pn * 4 + wc] = sq;
    }
    __device__ __forceinline__ void operator()(const pg8::f32x4 (&acc)[2][2][4][2], const pg8::Unit& u, int, int, int, int) const {
        EPI_IDS();
        const int row0 = u.pm * 256 + wr * 64 + fr, col0 = u.pn * 256 + wc * 32 + 8 * fq;
#pragma unroll
        for (int ai = 0; ai < 2; ++ai)
#pragma unroll
            for (int m = 0; m < 4; ++m) {
                const pg8::f32x4 a[2][2] = {{acc[ai][0][m][0], acc[ai][0][m][1]}, {acc[ai][1][m][0], acc[ai][1][m][1]}};
                rowgroup(a, row0 + ai * 128 + m * 16, col0, u.pn, wc, fq);
                if (m == 3) asm volatile("" ::: "memory");
            }
    }
};
struct EpiZ {
    static constexpr bool PERM = true;
    bf16* zmix; bf16* gates; const float* ss; const float* bias;
    __device__ __forceinline__ void operator()(const pg8::f32x4 (&acc)[2][2][4][2], const pg8::Unit& u, int, int, int, int) const {
        EPI_IDS();
        const int row0 = u.pm * 256 + wr * 64 + fr, col0 = u.pn * 256 + wc * 32 + 8 * fq; const bool isgate = u.pn >= NMIXP / 256;
        f32x4 bv[2][2];
#pragma unroll
        for (int bj = 0; bj < 2; ++bj)
#pragma unroll
            for (int n = 0; n < 2; ++n) bv[bj][n] = *(const f32x4*)(bias + col0 + bj * 128 + 4 * n);
#pragma unroll
        for (int ai = 0; ai < 2; ++ai)
#pragma unroll
            for (int m = 0; m < 4; ++m) {
                const int row = row0 + ai * 128 + m * 16; const float rstd = rstd_of(ss, row);
#pragma unroll
                for (int bj = 0; bj < 2; ++bj) {
                    f32x4 v0 = acc[ai][bj][m][0] * rstd + bv[bj][0], v1 = acc[ai][bj][m][1] * rstd + bv[bj][1];
                    if (isgate) {
#pragma unroll
                        for (int j = 0; j < 4; ++j) { v0[j] = fmaxf(sigmoidf_(v0[j]), 9.094947017729282e-13f); v1[j] = fmaxf(sigmoidf_(v1[j]), 9.094947017729282e-13f); } }
                    v4u w; w.x = pg8::cvt_pk_bf16(v0[0], v0[1]); w.y = pg8::cvt_pk_bf16(v0[2], v0[3]); w.z = pg8::cvt_pk_bf16(v1[0], v1[1]); w.w = pg8::cvt_pk_bf16(v1[2], v1[3]);
                    if (isgate) *(v4u*)(gates + (size_t)row * NGATE + (col0 - NMIXP) + bj * 128) = w;
                    else *(v4u*)(zmix + (size_t)row * NMIXP + col0 + bj * 128) = w;
                }
            }
    }
};

struct EpiPartial {
    static constexpr bool PERM = true;
    float* part;
    __device__ __forceinline__ void operator()(const pg8::f32x4 (&acc)[2][2][4][2], const pg8::Unit& u, int, int, int, int) const {
        int t_ = threadIdx.x; asm volatile("" : "+v"(t_));
        const int slot = blockIdx.x;
        float* p = part + (size_t)slot * 65536 + (size_t)t_ * 4;
#pragma unroll
        for (int ai = 0; ai < 2; ++ai)
#pragma unroll
            for (int bj = 0; bj < 2; ++bj)
#pragma unroll
                for (int m = 0; m < 4; ++m)
#pragma unroll
                    for (int n = 0; n < 2; ++n) *(pg8::f32x4*)(p + (size_t)((((ai * 2 + bj) * 4 + m) * 2 + n) * 2048)) = acc[ai][bj][m][n];
        (void)u;
    }
};
template <int NSPLIT, class Epi> __device__ __forceinline__ void ksp_finalize(const float* part, const pg8::StaticOrder& so, int limit, const Epi& E) {
    const int ntail = so.nwg - limit;
    for (int it = blockIdx.x; it < ntail * 8; it += gridDim.x) {
        const int tt = it >> 3, ai = (it >> 2) & 1, m = it & 3;
        EPI_IDS();
        pg8::f32x4 a[2][2];
#pragma unroll
        for (int bj = 0; bj < 2; ++bj)
#pragma unroll
            for (int n = 0; n < 2; ++n) { pg8::f32x4 s = {0.f, 0.f, 0.f, 0.f};
#pragma unroll
                for (int k = 0; k < NSPLIT; ++k) s = s + *(const pg8::f32x4*)(part + (size_t)(tt * NSPLIT + k) * 65536 + (size_t)((((ai * 2 + bj) * 4 + m) * 2 + n) * 2048) + (size_t)t_ * 4);
                a[bj][n] = s; }
        pg8::Unit u; so.unit_of(limit + tt, u);
        E.rowgroup(a, u.pm * 256 + wr * 64 + fr + ai * 128 + m * 16, u.pn * 256 + wc * 32 + 8 * fq, u.pn, wc, fq);
    }
}

struct EpiMergeR {
    static constexpr bool PERM = true;
    bf16* merged; const bf16* gates;
    __device__ __forceinline__ void mid(pg8::f32x4 (&acc)[2][2][4][2], const pg8::Unit& u, int seg) const {
        EPI_IDS();
        const int row0 = u.pm * 256 + wr * 64 + fr, col0 = u.pn * 256 + wc * 32 + 8 * fq;
#pragma unroll
        for (int ai = 0; ai < 2; ++ai) {
#pragma unroll
            for (int m = 0; m < 4; ++m) {
                const int row = row0 + ai * 128 + m * 16;
#pragma unroll
                for (int bj = 0; bj < 2; ++bj) {
                    const bf16* gp = gates + (size_t)row * NGATE + (seg - 1) * D + col0 + bj * 128;
                    const v4u ga = *(const v4u*)gp, gb = *(const v4u*)(gp + D);
                    pg8::f32x4& a0 = acc[ai][bj][m][0]; pg8::f32x4& a1 = acc[ai][bj][m][1];
                    a0[0] *= bflo(ga.x) * __builtin_amdgcn_rcpf(bflo(gb.x)); a0[1] *= bfhi(ga.x) * __builtin_amdgcn_rcpf(bfhi(gb.x)); a0[2] *= bflo(ga.y) * __builtin_amdgcn_rcpf(bflo(gb.y)); a0[3] *= bfhi(ga.y) * __builtin_amdgcn_rcpf(bfhi(gb.y));
                    a1[0] *= bflo(ga.z) * __builtin_amdgcn_rcpf(bflo(gb.z)); a1[1] *= bfhi(ga.z) * __builtin_amdgcn_rcpf(bfhi(gb.z)); a1[2] *= bflo(ga.w) * __builtin_amdgcn_rcpf(bflo(gb.w)); a1[3] *= bfhi(ga.w) * __builtin_amdgcn_rcpf(bfhi(gb.w));
                }
            }
            asm volatile("" ::: "memory");
        }
    }
    __device__ __forceinline__ void operator()(const pg8::f32x4 (&acc)[2][2][4][2], const pg8::Unit& u, int, int, int, int) const {
        EPI_IDS();
        const int row0 = u.pm * 256 + wr * 64 + fr, col0 = u.pn * 256 + wc * 32 + 8 * fq;
#pragma unroll
        for (int ai = 0; ai < 2; ++ai)
#pragma unroll
            for (int m = 0; m < 4; ++m) {
                const int row = row0 + ai * 128 + m * 16;
#pragma unroll
                for (int bj = 0; bj < 2; ++bj) {
                    const v4u g = *(const v4u*)(gates + (size_t)row * NGATE + 3 * D + col0 + bj * 128);
                    const pg8::f32x4 a0 = acc[ai][bj][m][0], a1 = acc[ai][bj][m][1];
                    v4u w; w.x = pg8::cvt_pk_bf16(a0[0] * bflo(g.x), a0[1] * bfhi(g.x)); w.y = pg8::cvt_pk_bf16(a0[2] * bflo(g.y), a0[3] * bfhi(g.y));
                    w.z = pg8::cvt_pk_bf16(a1[0] * bflo(g.z), a1[1] * bfhi(g.z)); w.w = pg8::cvt_pk_bf16(a1[2] * bflo(g.w), a1[3] * bfhi(g.w));
                    *(v4u*)(merged + (size_t)row * D + col0 + bj * 128) = w;
                }
            }
    }
};

struct RowMap { int mode, a; __device__ __forceinline__ int operator()(int n) const { return mode == 0 ? n + a : (mode == 1 ? 256 * (n >> 7) + (n & 127) + a : (n < NMIX ? n : n + (NMIXP - NMIX))); } };
__device__ __forceinline__ void tr_item(const float* W, int K, int N, const float* gain, bf16* WT, int pitch, RowMap rm, LAS float* scr, int kb, int nb, int lane) {
    const int k0 = 64 * kb, n0 = 64 * nb; const int nn = n0 + 4 * (lane & 15), kr = lane >> 4;
    f32x4 v[16];
#pragma unroll
    for (int i = 0; i < 16; ++i) v[i] = (nn < N) ? *(const f32x4*)(W + (size_t)(k0 + 4 * i + kr) * N + nn) : (f32x4){0.f, 0.f, 0.f, 0.f};
#pragma unroll
    for (int i = 0; i < 16; ++i) { const int kk = 4 * i + kr; const float g = gain ? gain[k0 + kk] : 1.0f; LAS float* d = scr + kk * 65 + 4 * (lane & 15); d[0] = v[i][0] * g; d[1] = v[i][1] * g; d[2] = v[i][2] * g; d[3] = v[i][3] * g; }
    LDS_WAIT(); asm volatile("" ::: "memory");
    const int c = lane & 7;
#pragma unroll
    for (int j = 0; j < 8; ++j) { const int nl = (lane >> 3) + 8 * j; const int n = n0 + nl; const LAS float* s = scr + (8 * c) * 65 + nl;
        v4u o; o.x = pg8::cvt_pk_bf16(s[0 * 65], s[1 * 65]); o.y = pg8::cvt_pk_bf16(s[2 * 65], s[3 * 65]); o.z = pg8::cvt_pk_bf16(s[4 * 65], s[5 * 65]); o.w = pg8::cvt_pk_bf16(s[6 * 65], s[7 * 65]);
        if (n < N) *(v4u*)(WT + (size_t)rm(n) * pitch + k0 + 8 * c) = o; }
    LDS_WAIT(); asm volatile("" ::: "memory");
}
__device__ __forceinline__ void p0_prologue(const Ctx& C, const Params& P) {
    THREAD_IDS();
    LAS float* scr = (LAS float*)(C.lds + RING_OFF + wave * 16896);
    constexpr int I_FF = 16 * 44, I_DN = 44 * 16, I_IN = 16 * 113, I_BR = 4 * 4 * 16, I_OUT = 16 * 16;
    constexpr int PER_LAYER = 4 * I_FF + 2 * I_DN + I_IN + I_BR + I_OUT;
    for (int it = gw; it < DEPTH * PER_LAYER; it += NGW) {
        const int l = it / PER_LAYER; int r = it - l * PER_LAYER;
        bf16* W1a = WSP(bf16, WS_W1 + (size_t)(l * 2 + 0) * SZ_W1); bf16* W1b = WSP(bf16, WS_W1 + (size_t)(l * 2 + 1) * SZ_W1);
        bf16* Wda = WSP(bf16, WS_WD + (size_t)(l * 2 + 0) * SZ_WD); bf16* Wdb = WSP(bf16, WS_WD + (size_t)(l * 2 + 1) * SZ_WD);
        if (r < I_FF) { tr_item(C.in[I_F1G] + (size_t)l * D * DFF, D, DFF, C.in[I_NF1] + l * D, W1a, D, RowMap{1, 0}, scr, r / 44, r % 44, lane); continue; } r -= I_FF;
        if (r < I_FF) { tr_item(C.in[I_F1U] + (size_t)l * D * DFF, D, DFF, C.in[I_NF1] + l * D, W1a, D, RowMap{1, 128}, scr, r / 44, r % 44, lane); continue; } r -= I_FF;
        if (r < I_DN) { tr_item(C.in[I_F1D] + (size_t)l * D * DFF, DFF, D, nullptr, Wda, DFF, RowMap{0, 0}, scr, r / 16, r % 16, lane); continue; } r -= I_DN;
        if (r < I_FF) { tr_item(C.in[I_F2G] + (size_t)l * D * DFF, D, DFF, C.in[I_NF2] + l * D, W1b, D, RowMap{1, 0}, scr, r / 44, r % 44, lane); continue; } r -= I_FF;
        if (r < I_FF) { tr_item(C.in[I_F2U] + (size_t)l * D * DFF, D, DFF, C.in[I_NF2] + l * D, W1b, D, RowMap{1, 128}, scr, r / 44, r % 44, lane); continue; } r -= I_FF;
        if (r < I_DN) { tr_item(C.in[I_F2D] + (size_t)l * D * DFF, DFF, D, nullptr, Wdb, DFF, RowMap{0, 0}, scr, r / 16, r % 16, lane); continue; } r -= I_DN;
        if (r < I_IN) { tr_item(C.in[I_WIN] + (size_t)l * D * NIN, D, NIN, C.in[I_NMIX] + l * D, WSP(bf16, WS_WIN + (size_t)l * SZ_WIN), D, RowMap{2, 0}, scr, r / 113, r % 113, lane); continue; } r -= I_IN;
        if (r < I_BR) { const int n4 = r / 64, rr = r % 64; tr_item(C.in[I_WBR] + (size_t)(l * 4 + n4) * 256 * D, 256, D, nullptr, WSP(bf16, WS_WBR + (size_t)l * SZ_WBR) + n4 * 256, D, RowMap{0, 0}, scr, rr / 16, rr % 16, lane); continue; } r -= I_BR;
        tr_item(C.in[I_WOUT] + (size_t)l * D * D, D, D, nullptr, WSP(bf16, WS_WOUT + (size_t)l * SZ_WOUT), D, RowMap{0, 0}, scr, r / 16, r % 16, lane);
    }
    const int gt = gw * 64 + lane, NGT = NGW * 64;
    for (int i = gt; i < 2 * 240 * 128; i += NGT) { const int l = i / (240 * 128), r = i % (240 * 128); *(v4u*)(C.ws + WS_WIN + (size_t)l * SZ_WIN + ((size_t)NMIX * D) * 2 + (size_t)r * 16) = (v4u){0u, 0u, 0u, 0u}; }
    for (int i = gt; i < (M - MR) * 128; i += NGT) *(v4u*)(C.ws + WS_BR + (size_t)MR * D * 2 + (size_t)i * 16) = (v4u){0u, 0u, 0u, 0u};
    for (int i = gt; i < 2 * NINP; i += NGT) { const int l = i / NINP, j = i % NINP; float v = 0.f; if (j < NMIX) v = C.in[I_BIN][l * NIN + j]; else if (j >= NMIXP) v = C.in[I_BIN][l * NIN + NMIX + (j - NMIXP)]; WSP(float, WS_BINP)[i] = v; }
    for (int i = gt; i < NPOS * 32; i += NGT) { const int pi = i >> 5, fi = i & 31; const int pos = pi < L ? pi : PAST + (pi - L);
        const float angf = (float)pos * P.inv_freq[fi];
        const double a = (double)angf; const double k = rint(a * 0.15915494309189535); const double rr = (a - k * 6.283185307179586) - k * 2.4492935982947064e-16;
        const float rf = (float)rr; WSP(float, WS_ROPE)[i] = cosf(rf); WSP(float, WS_ROPE)[NPOS * 32 + i] = sinf(rf); }
    float* H = WSP(float, WS_H); bf16* HB = WSP(bf16, WS_HB); float* SS0 = WSP(float, WS_SS);
    for (int row = gw; row < M; row += NGW) {
        const float* src = nullptr;
        if (row < MP) { const int b = row / L, pos = row - b * L; src = pos < NMETA ? C.in[I_META] + (size_t)pos * D : C.in[I_XP] + ((size_t)b * SEQ + (pos - NMETA)) * D; }
        else if (row < MR) src = C.in[I_XS] + (size_t)(row - MP) * D;
        float s = 0.f;
#pragma unroll
        for (int j = 0; j < 4; ++j) { f32x4 v = src ? *(const f32x4*)(src + 256 * j + 4 * lane) : (f32x4){0.f, 0.f, 0.f, 0.f};
            *(f32x4*)(H + (size_t)row * D + 256 * j + 4 * lane) = v; s += (v[0] * v[0] + v[1] * v[1]) + (v[2] * v[2] + v[3] * v[3]);
            unsigned long long w = (unsigned long long)pk2(v[0], v[1]) | ((unsigned long long)pk2(v[2], v[3]) << 32);
            *(unsigned long long*)(HB + (size_t)row * D + 256 * j + 4 * lane) = w; }
        s = wave_sum(s); if (lane < 16) SS0[(size_t)row * 16 + lane] = lane == 0 ? s : 0.f;
    }
}

__device__ __forceinline__ float lam_of(const Ctx& C, int l, float lam_init) {
    THREAD_IDS();
    float a = 0.f, b = 0.f;
#pragma unroll 1
    for (int i = 0; i < 32; ++i) { a += C.in[I_LQ1][l * 32 + i] * C.in[I_LK1][l * 32 + i]; b += C.in[I_LQ2][l * 32 + i] * C.in[I_LK2][l * 32 + i]; }
    return __expf(a) - __expf(b) + lam_init;
}
__device__ __forceinline__ int t5_bucket(int n) {
    if (n < 16) return n;
    return 16 + (n >= 19) + (n >= 21) + (n >= 24) + (n >= 27) + (n >= 31) + (n >= 35) + (n >= 40) + (n >= 46) + (n >= 52) + (n >= 59) + (n >= 67) + (n >= 77) + (n >= 87) + (n >= 99) + (n >= 113);
}
__device__ __forceinline__ void unpack8(const v4u w, float (&x)[8]) { x[0] = bflo(w.x); x[1] = bfhi(w.x); x[2] = bflo(w.y); x[3] = bfhi(w.y); x[4] = bflo(w.z); x[5] = bfhi(w.z); x[6] = bflo(w.w); x[7] = bfhi(w.w); }
__device__ __forceinline__ v4u pack8(const float (&x)[8]) { v4u w; w.x = pg8::cvt_pk_bf16(x[0], x[1]); w.y = pg8::cvt_pk_bf16(x[2], x[3]); w.z = pg8::cvt_pk_bf16(x[4], x[5]); w.w = pg8::cvt_pk_bf16(x[6], x[7]); return w; }
__device__ __forceinline__ void n1_prep(const Ctx& C, int l) {
    THREAD_IDS();
    const bf16* ZM = WSP(bf16, WS_ZMIX); float* UB = WSP(float, WS_UBUF); float* RQ = WSP(float, WS_RQ); float* RK = WSP(float, WS_RK);
    float* LD = WSP(float, WS_LDEC); const float* COS = WSP(float, WS_ROPE); const float* SIN = COS + NPOS * 32; bf16* QNB = WSP(bf16, WS_QNB); bf16* KNB = WSP(bf16, WS_KNB);
    const int i = lane & 31;
    float qg[8], kg[8];
#pragma unroll
    for (int j = 0; j < 8; ++j) { qg[j] = C.in[I_QN][l * 32 + ((8 * i) & 31) + j] * (0.17677669529663687f * 1.4426950408889634f); kg[j] = C.in[I_KN][l * 32 + ((8 * i) & 31) + j]; }
    const int isk = i >> 4, hh = (i >> 2) & 3, jc = i & 3;
    for (int rp0 = gw * 2; rp0 < MR / 2; rp0 += NGW * 2) {
        v4u Wa[2], Wg[2], Wq[2], Wk[2], Wv[2], W1[2], W2[2], G0[2], G1[2];
#pragma unroll
        for (int u = 0; u < 2; ++u) { const int r = min(2 * (rp0 + u) + (lane >> 5), MR - 1); const bf16* z = ZM + (size_t)r * NMIXP; const bf16* zr = z + (isk ? R_K : R_Q) + hh * 64 + 8 * jc;
            Wa[u] = *(const v4u*)(z + C_A + 8 * i); Wg[u] = *(const v4u*)(z + C_G + 8 * i); Wq[u] = *(const v4u*)(z + D_Q + 8 * i); Wk[u] = *(const v4u*)(z + D_K + 8 * i); Wv[u] = *(const v4u*)(z + D_V + 8 * i);
            W1[u] = *(const v4u*)zr; W2[u] = *(const v4u*)(zr + 32); G0[u] = *(const v4u*)(z + G_LOW); G1[u] = *(const v4u*)(z + G_LOW + 8); }
#pragma unroll
        for (int u = 0; u < 2; ++u) {
        if (rp0 + u >= MR / 2) break;
        const int r = 2 * (rp0 + u) + (lane >> 5);
        const int pi = r < MP ? r % L : L + ((r - MP) & 7);
        float* kout = r < MP ? C.out + O_KP + ((size_t)l * MP + r) * 256 : C.out + O_KS + ((size_t)l * MS + (r - MP)) * 256;
        float* vout = r < MP ? C.out + O_VP + ((size_t)l * MP + r) * 256 : C.out + O_VS + ((size_t)l * MS + (r - MP)) * 256;
        const v4u wa = Wa[u], wg = Wg[u], wq = Wq[u], wk = Wk[u], wv = Wv[u], w1 = W1[u], w2 = W2[u], gl0 = G0[u], gl1 = G1[u];
        float x[8], y[8];
        unpack8(wa, x); unpack8(wg, y);
#pragma unroll
        for (int j = 0; j < 8; ++j) x[j] *= sigmoidf_(y[j]);
        *(f32x4*)(UB + (size_t)r * 256 + 8 * i) = (f32x4){x[0], x[1], x[2], x[3]}; *(f32x4*)(UB + (size_t)r * 256 + 8 * i + 4) = (f32x4){x[4], x[5], x[6], x[7]};
        unpack8(wv, x);
        *(f32x4*)(vout + 8 * i) = (f32x4){x[0], x[1], x[2], x[3]}; *(f32x4*)(vout + 8 * i + 4) = (f32x4){x[4], x[5], x[6], x[7]};
        unpack8(wq, x);
        { float s = 0.f;
#pragma unroll
          for (int j = 0; j < 8; ++j) s += x[j] * x[j];
          s += __shfl_xor(s, 1); s += __shfl_xor(s, 2); const float rs = rsqrtf(s * (1.0f / 32) + EPS);
#pragma unroll
          for (int j = 0; j < 8; ++j) x[j] = x[j] * rs * qg[j];
          *(v4u*)(QNB + (size_t)r * 256 + 8 * i) = pack8(x); }
        unpack8(wk, x);
        { float s = 0.f;
#pragma unroll
          for (int j = 0; j < 8; ++j) s += x[j] * x[j];
          s += __shfl_xor(s, 1); s += __shfl_xor(s, 2); const float rs = rsqrtf(s * (1.0f / 32) + EPS);
#pragma unroll
          for (int j = 0; j < 8; ++j) x[j] = x[j] * rs * kg[j];
          *(v4u*)(KNB + (size_t)r * 256 + 8 * i) = pack8(x);
          *(f32x4*)(kout + 8 * i) = (f32x4){x[0], x[1], x[2], x[3]}; *(f32x4*)(kout + 8 * i + 4) = (f32x4){x[4], x[5], x[6], x[7]}; }
        unpack8(w1, x); unpack8(w2, y);
        { const f32x4 c0 = *(const f32x4*)(COS + pi * 32 + 8 * jc), c1 = *(const f32x4*)(COS + pi * 32 + 8 * jc + 4), s0 = *(const f32x4*)(SIN + pi * 32 + 8 * jc), s1 = *(const f32x4*)(SIN + pi * 32 + 8 * jc + 4);
          const float sc = isk ? 0.125f : 1.0f; float o1[8], o2[8];
#pragma unroll
          for (int j = 0; j < 8; ++j) { const float cs = j < 4 ? c0[j & 3] : c1[j & 3], sn = j < 4 ? s0[j & 3] : s1[j & 3]; o1[j] = (x[j] * cs - y[j] * sn) * sc; o2[j] = (x[j] * sn + y[j] * cs) * sc; }
          float* ro = (isk ? RK : RQ) + (size_t)r * 256 + hh * 64 + 8 * jc;
          *(f32x4*)ro = (f32x4){o1[0], o1[1], o1[2], o1[3]}; *(f32x4*)(ro + 4) = (f32x4){o1[4], o1[5], o1[6], o1[7]}; *(f32x4*)(ro + 32) = (f32x4){o2[0], o2[1], o2[2], o2[3]}; *(f32x4*)(ro + 36) = (f32x4){o2[4], o2[5], o2[6], o2[7]}; }
        { float gv[16]; unpack8(gl0, x); unpack8(gl1, y);
#pragma unroll
          for (int j = 0; j < 8; ++j) { gv[j] = x[j]; gv[8 + j] = y[j]; }
          f32x4 gp = *(const f32x4*)(C.in[I_GAB] + l * 128 + 4 * i);
#pragma unroll
          for (int k = 0; k < 16; ++k) { const f32x4 aw = *(const f32x4*)(C.in[I_GAW] + (size_t)(l * 16 + k) * 128 + 4 * i); gp = gp + aw * gv[k]; }
          f32x4 ls;
#pragma unroll
          for (int j = 0; j < 4; ++j) ls[j] = (fminf(gp[j], 0.f) - log1pf(__expf(-fabsf(gp[j])))) * (1.0f / 16.0f);
          *(f32x4*)(LD + (size_t)r * 128 + 4 * i) = ls; }
        }
    }
}
__device__ __forceinline__ void conv_rows_item(const Ctx& C, int l, int item) {
    THREAD_IDS();
    const float* UB = WSP(float, WS_UBUF); bf16* BR = WSP(bf16, WS_BR);
    const float* cw = C.in[I_CW] + (size_t)l * 31 * 256; const float* sc = C.in[I_SCONV];
    LAS float* wl = (LAS float*)C.lds;
    for (int i = tid; i < 31 * 256; i += NWAVES * 64) wl[i] = cw[i];
    LDS_WAIT(); __builtin_amdgcn_s_barrier(); asm volatile("" ::: "memory");
    const int r0 = item * 64 + wave * 8;
    if (r0 < MR) {
        const bool smp = r0 >= MP; const int b = smp ? (r0 - MP) >> 3 : r0 / L; const int p0 = smp ? 0 : r0 - b * L; const int rb = smp ? MP + b * 8 : b * L;
        float acc[8][4];
#pragma unroll
        for (int i = 0; i < 8; ++i)
#pragma unroll
            for (int k = 0; k < 4; ++k) acc[i][k] = C.in[I_CB][l * 256 + lane + 64 * k];
#pragma unroll 1
        for (int jb = 0; jb < 40; jb += 8) {
            float uv[8][4];
#pragma unroll
            for (int jj = 0; jj < 8; ++jj) { const int j = jb + jj; const int q = p0 - 30 + j;
#pragma unroll
                for (int k = 0; k < 4; ++k) { const int c = lane + 64 * k;
                    uv[jj][k] = j >= 38 ? 0.f : (q >= 0 ? UB[(size_t)(rb + q) * 256 + c] : (smp ? sc[(((size_t)l * DB + b) * 30 + (q + 30)) * 256 + c] : 0.f)); } }
#pragma unroll
            for (int jj = 0; jj < 8; ++jj)
#pragma unroll
                for (int i = 0; i < 8; ++i) { const int t = jb + jj - i;
                    if (t >= 0 && t <= 30) {
#pragma unroll
                        for (int k = 0; k < 4; ++k) acc[i][k] += wl[t * 256 + lane + 64 * k] * uv[jj][k]; } }
        }
#pragma unroll
        for (int i = 0; i < 8; ++i) { const int r = r0 + i;
            float s = (acc[i][0] + acc[i][1]) + (acc[i][2] + acc[i][3]); const float mean = wave_sum(s) * (1.0f / 256);
            float q2 = 0.f;
#pragma unroll
            for (int k = 0; k < 4; ++k) { acc[i][k] -= mean; q2 += acc[i][k] * acc[i][k]; }
            const float rstd = rsqrtf(wave_sum(q2) * (1.0f / 256) + EPS);
#pragma unroll
            for (int k = 0; k < 4; ++k) { const int c = lane + 64 * k; const float y = acc[i][k] * rstd * C.in[I_CLG][l * 256 + c] + C.in[I_CLB][l * 256 + c]; BR[(size_t)r * D + c] = (bf16)f2bf(siluf_(y)); } }
    }
    LDS_WAIT(); __builtin_amdgcn_s_barrier(); asm volatile("" ::: "memory");
}
__device__ __forceinline__ void conv_state_item(const Ctx& C, int l, int part, int nparts) {
    THREAD_IDS();
    const float* UB = WSP(float, WS_UBUF); const float* sc = C.in[I_SCONV];
    for (int i = part * NWAVES * 64 + tid; i < BATCH * 30 * 256; i += nparts * NWAVES * 64) { const int c = i & 255, ii = (i >> 8) % 30, b = i / (30 * 256); C.out[O_CP + (size_t)l * BATCH * 30 * 256 + i] = UB[(size_t)(b * L + L - 30 + ii) * 256 + c]; }
    for (int i = part * NWAVES * 64 + tid; i < DB * 30 * 256; i += nparts * NWAVES * 64) { const int c = i & 255, ii = (i >> 8) % 30, b = i / (30 * 256);
        C.out[O_CS + (size_t)l * DB * 30 * 256 + i] = ii < 22 ? sc[(((size_t)l * DB + b) * 30 + 8 + ii) * 256 + c] : UB[(size_t)(MP + b * 8 + ii - 22) * 256 + c]; }
}
template <int DK, bool RET> __device__ __forceinline__ void la_seq(const Ctx& C, int l, bool smp, int b, int h) {
    THREAD_IDS();
    const bf16* ZM = WSP(bf16, WS_ZMIX); const float* RQ = WSP(float, WS_RQ); const float* RK = WSP(float, WS_RK); const float* LD = WSP(float, WS_LDEC); bf16* BR = WSP(bf16, WS_BR);
    const int nt = smp ? DS : L; const int row0 = smp ? MP + b * DS : b * L;
    float S[DK];
    if (smp) { const float* s0 = (RET ? C.in[I_SRET] : C.in[I_SGLA]) + (((size_t)l * DB + b) * 4 + h) * DK * 64;
#pragma unroll
        for (int k = 0; k < DK; ++k) S[k] = s0[k * 64 + lane]; }
    else {
#pragma unroll
        for (int k = 0; k < DK; ++k) S[k] = 0.f; }
    const float gamma = 1.0f - exp2f(-5.0f - (float)h);
    const float gn = RET ? C.in[I_RGN][(l * 4 + h) * 64 + lane] : C.in[I_GGN][(l * 4 + h) * 64 + lane];
    for (int t = 0; t < nt; ++t) {
        const int r = row0 + t; const bf16* z = ZM + (size_t)r * NMIXP;
        float ql, kl, dl = 1.f;
        if (RET) { ql = RQ[(size_t)r * 256 + h * 64 + lane]; kl = RK[(size_t)r * 256 + h * 64 + lane]; }
        else { const int lk = lane & 31; ql = bf2f(z[G_Q + h * 32 + lk]) * 0.17677669529663687f; kl = bf2f(z[G_K + h * 32 + lk]); dl = __expf(LD[(size_t)r * 128 + h * 32 + lk]); }
        const float v = bf2f(z[(RET ? R_V : G_V) + h * 64 + lane]);
        float o = 0.f;
#pragma unroll
        for (int k = 0; k < DK; ++k) { const float qk = __shfl(ql, k), kk = __shfl(kl, k); const float dk = RET ? gamma : __shfl(dl, k);
            S[k] = dk * S[k] + kk * v; o += qk * S[k]; if ((k & 7) == 7) __builtin_amdgcn_sched_barrier(0); }
        float y;
        if (RET) { const float mean = wave_sum(o) * (1.0f / 64); const float d = o - mean; const float var = wave_sum(d * d) * (1.0f / 64); y = d * rsqrtf(var + EPS) * gn; }
        else { const float ms = wave_sum(o * o) * (1.0f / 64); y = o * rsqrtf(ms + EPS) * gn; }
        const float g = bf2f(z[(RET ? R_G : G_R) + h * 64 + lane]);
        BR[(size_t)r * D + (RET ? 256 : 512) + h * 64 + lane] = (bf16)f2bf(siluf_(g) * y);
    }
    float* so = C.out + (RET ? (smp ? O_RS + (((size_t)l * DB + b) * 4 + h) * DK * 64 : O_RP + (((size_t)l * BATCH + b) * 4 + h) * DK * 64)
                             : (smp ? O_GS + (((size_t)l * DB + b) * 4 + h) * DK * 64 : O_GP + (((size_t)l * BATCH + b) * 4 + h) * DK * 64));
#pragma unroll
    for (int k = 0; k < DK; ++k) so[k * 64 + lane] = S[k];
}
typedef short bf16x8_t __attribute__((ext_vector_type(8)));
template <int DK, bool RET> __device__ __forceinline__ void la_chunked(const Ctx& C, int l, bool smp, int b, int h) {
    THREAD_IDS();
    constexpr int QS = DK + 8, TS = 72, NKB = DK / 16, NKS = DK / 32;
    constexpr int SB = 2 * 64 * QS + 64 * TS + DK * TS + 64 * TS + 64;
    LAS bf16* SB0 = (LAS bf16*)(C.lds);
    LAS bf16* AL = SB0 + 2 * SB;
    LAS bf16* ST = AL + 64 * TS;
    const bf16* ZM = WSP(bf16, WS_ZMIX); const float* RQ = WSP(float, WS_RQ); const float* RK = WSP(float, WS_RK); const float* LD = WSP(float, WS_LDEC); bf16* BR = WSP(bf16, WS_BR);
    const int nt = smp ? DS : L, row0 = smp ? MP + b * DS : b * L, nch = (nt + 63) >> 6;
    const float lg2 = RET ? log2f(1.0f - exp2f(-5.0f - (float)h)) : 0.f;
    const int g4 = lane >> 4, c16 = lane & 15;
    const bool qwave = wave < 4; const int w4 = wave & 3;
    float Sreg[NKB][4];
    if (wave >= 4) {
        const float* s0 = (RET ? C.in[I_SRET] : C.in[I_SGLA]) + (((size_t)l * DB + b) * 4 + h) * DK * 64;
#pragma unroll
        for (int cb = 0; cb < NKB; ++cb)
#pragma unroll
            for (int r = 0; r < 4; ++r) { const int dk = cb * 16 + c16, dv = (wave - 4) * 16 + 4 * g4 + r; const float v = smp ? s0[dk * 64 + dv] : 0.f; Sreg[cb][r] = v; ST[dv * QS + dk] = (bf16)f2bf(v); }
    }
    float gnv[4];
#pragma unroll
    for (int cb = 0; cb < 4; ++cb) gnv[cb] = (RET ? C.in[I_RGN] : C.in[I_GGN])[(l * 4 + h) * 64 + cb * 16 + c16];
    float a[16]; v4u vr;
#define LA_LOAD(c) do { const size_t r_ = (size_t)(row0 + (c) * 64 + lane); const bf16* z_ = ZM + r_ * NMIXP; \
        vr = *(const v4u*)(z_ + (RET ? R_V : G_V) + h * 64 + 8 * wave); \
        if (RET) { const float* p_ = (qwave ? RQ : RK) + r_ * 256 + h * 64 + 8 * w4; const f32x4 x0 = *(const f32x4*)p_, x1 = *(const f32x4*)(p_ + 4), x2 = *(const f32x4*)(p_ + 32), x3 = *(const f32x4*)(p_ + 36); \
            a[0] = x0[0]; a[1] = x0[1]; a[2] = x0[2]; a[3] = x0[3]; a[4] = x1[0]; a[5] = x1[1]; a[6] = x1[2]; a[7] = x1[3]; a[8] = x2[0]; a[9] = x2[1]; a[10] = x2[2]; a[11] = x2[3]; a[12] = x3[0]; a[13] = x3[1]; a[14] = x3[2]; a[15] = x3[3]; } \
        else { const v4u q_ = *(const v4u*)(z_ + (qwave ? G_Q : G_K) + h * 32 + 8 * w4); const float* p_ = LD + r_ * 128 + h * 32 + 8 * w4; const f32x4 x0 = *(const f32x4*)p_, x1 = *(const f32x4*)(p_ + 4); \
            a[0] = bflo(q_.x); a[1] = bfhi(q_.x); a[2] = bflo(q_.y); a[3] = bfhi(q_.y); a[4] = bflo(q_.z); a[5] = bfhi(q_.z); a[6] = bflo(q_.w); a[7] = bfhi(q_.w); \
            a[8] = x0[0]; a[9] = x0[1]; a[10] = x0[2]; a[11] = x0[3]; a[12] = x1[0]; a[13] = x1[1]; a[14] = x1[2]; a[15] = x1[3]; } } while (0)
    LA_LOAD(0);
    int cur = 0;
    for (int i = 0; i <= nch; ++i) {
        if (i < nch) {
            const int c = i; LAS bf16* QT = SB0 + (i & 1) * SB; LAS bf16* KT = QT + 64 * QS; LAS bf16* VT = KT + 64 * QS; LAS bf16* KE = VT + 64 * TS; LAS bf16* GT = KE + DK * TS; LAS float* WT = (LAS float*)(GT + 64 * TS);
            const int nvc = min(64, nt - c * 64); const bool valid = lane < nvc;
        if (RET) {
            const float tq = (float)(lane + 1);
            if (qwave) { const float e = valid ? __builtin_amdgcn_exp2f(lg2 * tq) : 0.f;
                v4u w0, w1; w0.x = pg8::cvt_pk_bf16(a[0] * e, a[1] * e); w0.y = pg8::cvt_pk_bf16(a[2] * e, a[3] * e); w0.z = pg8::cvt_pk_bf16(a[4] * e, a[5] * e); w0.w = pg8::cvt_pk_bf16(a[6] * e, a[7] * e);
                w1.x = pg8::cvt_pk_bf16(a[8] * e, a[9] * e); w1.y = pg8::cvt_pk_bf16(a[10] * e, a[11] * e); w1.z = pg8::cvt_pk_bf16(a[12] * e, a[13] * e); w1.w = pg8::cvt_pk_bf16(a[14] * e, a[15] * e);
                *(LAS v4u*)(QT + lane * QS + 8 * w4) = w0; *(LAS v4u*)(QT + lane * QS + 32 + 8 * w4) = w1; }
            else { const float e = valid ? __builtin_amdgcn_exp2f(-lg2 * tq) : 0.f, ee = valid ? __builtin_amdgcn_exp2f(lg2 * ((float)nvc - tq)) : 0.f;
                v4u w0, w1; w0.x = pg8::cvt_pk_bf16(a[0] * e, a[1] * e); w0.y = pg8::cvt_pk_bf16(a[2] * e, a[3] * e); w0.z = pg8::cvt_pk_bf16(a[4] * e, a[5] * e); w0.w = pg8::cvt_pk_bf16(a[6] * e, a[7] * e);
                w1.x = pg8::cvt_pk_bf16(a[8] * e, a[9] * e); w1.y = pg8::cvt_pk_bf16(a[10] * e, a[11] * e); w1.z = pg8::cvt_pk_bf16(a[12] * e, a[13] * e); w1.w = pg8::cvt_pk_bf16(a[14] * e, a[15] * e);
                *(LAS v4u*)(KT + lane * QS + 8 * w4) = w0; *(LAS v4u*)(KT + lane * QS + 32 + 8 * w4) = w1;
#pragma unroll
                for (int i = 0; i < 16; i += 2) { const unsigned mine = pg8::cvt_pk_bf16(a[i] * ee, a[i + 1] * ee); const unsigned pv = (unsigned)__shfl_xor((int)mine, 1);
                    const unsigned w = (lane & 1) ? ((pv >> 16) | (mine & 0xffff0000u)) : ((mine & 0xffffu) | (pv << 16));
                    const int row = (i < 8 ? 8 * w4 + i : 32 + 8 * w4 + (i - 8)) + (lane & 1);
                    *(LAS unsigned*)(KE + row * TS + (lane & ~1)) = w; } }
        } else {
            float bb[8];
#pragma unroll
            for (int i = 0; i < 8; ++i) bb[i] = valid ? a[8 + i] : 0.f;
#pragma unroll
            for (int i = 0; i < 8; ++i) { float x = bb[i];
                x += __builtin_bit_cast(float, __builtin_amdgcn_mov_dpp(__builtin_bit_cast(int, x), 0x111, 0xf, 0xf, true));
                x += __builtin_bit_cast(float, __builtin_amdgcn_mov_dpp(__builtin_bit_cast(int, x), 0x112, 0xf, 0xf, true));
                x += __builtin_bit_cast(float, __builtin_amdgcn_mov_dpp(__builtin_bit_cast(int, x), 0x114, 0xf, 0xf, true));
                x += __builtin_bit_cast(float, __builtin_amdgcn_mov_dpp(__builtin_bit_cast(int, x), 0x118, 0xf, 0xf, true));
                const float t0 = __builtin_bit_cast(float, __builtin_amdgcn_readlane(__builtin_bit_cast(int, x), 15)), t1 = __builtin_bit_cast(float, __builtin_amdgcn_readlane(__builtin_bit_cast(int, x), 31)), t2 = __builtin_bit_cast(float, __builtin_amdgcn_readlane(__builtin_bit_cast(int, x), 47));
                bb[i] = x + (lane >= 16 ? t0 : 0.f) + (lane >= 32 ? t1 : 0.f) + (lane >= 48 ? t2 : 0.f); }
            if (qwave) {
                if (lane == 63) {
#pragma unroll
                    for (int i = 0; i < 8; ++i) WT[8 * w4 + i] = bb[i]; }
                float o8[8];
#pragma unroll
                for (int i = 0; i < 8; ++i) o8[i] = valid ? a[i] * 0.17677669529663687f * __expf(bb[i]) : 0.f;
                v4u w0; w0.x = pg8::cvt_pk_bf16(o8[0], o8[1]); w0.y = pg8::cvt_pk_bf16(o8[2], o8[3]); w0.z = pg8::cvt_pk_bf16(o8[4], o8[5]); w0.w = pg8::cvt_pk_bf16(o8[6], o8[7]);
                *(LAS v4u*)(QT + lane * QS + 8 * w4) = w0;
            } else {
                float o8[8];
#pragma unroll
                for (int i = 0; i < 8; ++i) o8[i] = valid ? a[i] * __expf(-bb[i]) : 0.f;
#pragma unroll
                for (int i = 0; i < 8; i += 2) { const float t0 = __shfl(bb[i], 63), t1 = __shfl(bb[i + 1], 63);
                    const unsigned mine = pg8::cvt_pk_bf16(valid ? a[i] * __expf(t0 - bb[i]) : 0.f, valid ? a[i + 1] * __expf(t1 - bb[i + 1]) : 0.f); const unsigned pv = (unsigned)__shfl_xor((int)mine, 1);
                    const unsigned w = (lane & 1) ? ((pv >> 16) | (mine & 0xffff0000u)) : ((mine & 0xffffu) | (pv << 16));
                    *(LAS unsigned*)(KE + (8 * w4 + i + (lane & 1)) * TS + (lane & ~1)) = w; }
                v4u w0; w0.x = pg8::cvt_pk_bf16(o8[0], o8[1]); w0.y = pg8::cvt_pk_bf16(o8[2], o8[3]); w0.z = pg8::cvt_pk_bf16(o8[4], o8[5]); w0.w = pg8::cvt_pk_bf16(o8[6], o8[7]);
                *(LAS v4u*)(KT + lane * QS + 8 * w4) = w0;
            }
        }
        { const unsigned vv[4] = {valid ? vr.x : 0u, valid ? vr.y : 0u, valid ? vr.z : 0u, valid ? vr.w : 0u};
#pragma unroll
          for (int i = 0; i < 4; ++i) { const unsigned pv = (unsigned)__shfl_xor((int)vv[i], 1);
              const unsigned w = (lane & 1) ? ((pv >> 16) | (vv[i] & 0xffff0000u)) : ((vv[i] & 0xffffu) | (pv << 16));
              *(LAS unsigned*)(VT + (8 * wave + 2 * i + (lane & 1)) * TS + (lane & ~1)) = w; } }
            if (c + 1 < nch) LA_LOAD(c + 1);
        }
        if (i >= 1) {
            LAS bf16* QT = SB0 + ((i - 1) & 1) * SB; LAS bf16* KT = QT + 64 * QS;
        { const int rb = wave >> 1;
#pragma unroll
          for (int ci = 0; ci < 2; ++ci) { const int cb = (wave & 1) * 2 + ci; f32x4 acc = {0.f, 0.f, 0.f, 0.f};
              if (cb <= rb) {
#pragma unroll
                  for (int ks = 0; ks < NKS; ++ks) { const bf16x8_t af = *(const LAS bf16x8_t*)(QT + (rb * 16 + c16) * QS + ks * 32 + 8 * g4), bf = *(const LAS bf16x8_t*)(KT + (cb * 16 + c16) * QS + ks * 32 + 8 * g4);
                      acc = __builtin_amdgcn_mfma_f32_16x16x32_bf16(af, bf, acc, 0, 0, 0); } }
#pragma unroll
              for (int r = 0; r < 4; ++r) { const int tt = rb * 16 + 4 * g4 + r, ss = cb * 16 + c16; AL[tt * TS + ss] = (bf16)f2bf(ss <= tt ? acc[r] : 0.f); } } }
        }
        LDS_WAIT(); __builtin_amdgcn_s_barrier(); asm volatile("" ::: "memory");
        if (i >= 1) {
            const int c = i - 1; LAS bf16* QT = SB0 + (c & 1) * SB; LAS bf16* KT = QT + 64 * QS; LAS bf16* VT = KT + 64 * QS; LAS bf16* KE = VT + 64 * TS; LAS bf16* GT = KE + DK * TS; LAS float* WT = (LAS float*)(GT + 64 * TS);
            const int nvc = min(64, nt - c * 64); (void)KT;
        if (wave < 4) {
            const int rb = wave; const LAS bf16* STc = ST + cur * 64 * QS;
            f32x4 o[4];
#pragma unroll
            for (int cb = 0; cb < 4; ++cb) o[cb] = (f32x4){0.f, 0.f, 0.f, 0.f};
#pragma unroll
            for (int ks = 0; ks < 2; ++ks) { const bf16x8_t af = *(const LAS bf16x8_t*)(AL + (rb * 16 + c16) * TS + ks * 32 + 8 * g4);
#pragma unroll
                for (int cb = 0; cb < 4; ++cb) { const bf16x8_t bf = *(const LAS bf16x8_t*)(VT + (cb * 16 + c16) * TS + ks * 32 + 8 * g4); o[cb] = __builtin_amdgcn_mfma_f32_16x16x32_bf16(af, bf, o[cb], 0, 0, 0); } }
#pragma unroll
            for (int ks = 0; ks < NKS; ++ks) { const bf16x8_t af = *(const LAS bf16x8_t*)(QT + (rb * 16 + c16) * QS + ks * 32 + 8 * g4);
#pragma unroll
                for (int cb = 0; cb < 4; ++cb) { const bf16x8_t bf = *(const LAS bf16x8_t*)(STc + (cb * 16 + c16) * QS + ks * 32 + 8 * g4); o[cb] = __builtin_amdgcn_mfma_f32_16x16x32_bf16(af, bf, o[cb], 0, 0, 0); } }
            { float* LAO = WSP(float, WS_LAO);
#pragma unroll
              for (int r = 0; r < 4; ++r) { const int tok = c * 64 + rb * 16 + 4 * g4 + r;
                  if (tok < nt) { float* op = LAO + (size_t)(row0 + tok) * 512 + (RET ? 0 : 256) + h * 64 + c16;
#pragma unroll
                      for (int cb = 0; cb < 4; ++cb) op[cb * 16] = o[cb][r]; } } }
        } else {
            const int dvb = wave - 4; LAS bf16* STn = ST + (cur ^ 1) * 64 * QS;
            f32x4 ds[NKB];
#pragma unroll
            for (int cb = 0; cb < NKB; ++cb) ds[cb] = (f32x4){0.f, 0.f, 0.f, 0.f};
#pragma unroll
            for (int ks = 0; ks < 2; ++ks) { const bf16x8_t af = *(const LAS bf16x8_t*)(VT + (dvb * 16 + c16) * TS + ks * 32 + 8 * g4);
#pragma unroll
                for (int cb = 0; cb < NKB; ++cb) { const bf16x8_t bf = *(const LAS bf16x8_t*)(KE + (cb * 16 + c16) * TS + ks * 32 + 8 * g4); ds[cb] = __builtin_amdgcn_mfma_f32_16x16x32_bf16(af, bf, ds[cb], 0, 0, 0); } }
#pragma unroll
            for (int cb = 0; cb < NKB; ++cb) { const float eB = RET ? __builtin_amdgcn_exp2f(lg2 * (float)nvc) : __expf(WT[cb * 16 + c16]);
#pragma unroll
                for (int r = 0; r < 4; ++r) { Sreg[cb][r] = eB * Sreg[cb][r] + ds[cb][r]; STn[(dvb * 16 + 4 * g4 + r) * QS + cb * 16 + c16] = (bf16)f2bf(Sreg[cb][r]); } }
        }
            cur ^= 1;
        }
        LDS_WAIT(); __builtin_amdgcn_s_barrier(); asm volatile("" ::: "memory");
    }
#undef LA_LOAD
    if (wave >= 4) {
        float* so = C.out + (RET ? (smp ? O_RS + (((size_t)l * DB + b) * 4 + h) * DK * 64 : O_RP + (((size_t)l * BATCH + b) * 4 + h) * DK * 64)
                                 : (smp ? O_GS + (((size_t)l * DB + b) * 4 + h) * DK * 64 : O_GP + (((size_t)l * BATCH + b) * 4 + h) * DK * 64));
#pragma unroll
        for (int cb = 0; cb < NKB; ++cb)
#pragma unroll
            for (int r = 0; r < 4; ++r) so[(cb * 16 + c16) * 64 + (wave - 4) * 16 + 4 * g4 + r] = Sreg[cb][r];
    }
}
typedef float f32x16_t __attribute__((ext_vector_type(16)));
__device__ __forceinline__ int crow_(int r, int hi) { return (r & 3) + 8 * (r >> 2) + 4 * hi; }
__device__ __forceinline__ float swapmax32(float m) { auto rr = __builtin_amdgcn_permlane32_swap(__float_as_uint(m), __float_as_uint(m), false, false); return fmaxf(__uint_as_float(rr[0]), __uint_as_float(rr[1])); }
__device__ __forceinline__ float swapadd32(float m) { auto rr = __builtin_amdgcn_permlane32_swap(__float_as_uint(m), __float_as_uint(m), false, false); return __uint_as_float(rr[0]) + __uint_as_float(rr[1]); }
constexpr float LOG2E = 1.4426950408889634f;
__device__ __forceinline__ void attn_prompt_item(const Ctx& C, int l, int b, int h, int qb, float lam, float lam_init, float mb) {
    THREAD_IDS();
    constexpr int KS = 72;
    LAS bf16* Kt = (LAS bf16*)C.lds;
    LAS bf16* Vt = Kt + 2 * 64 * KS;
    LAS float* BT = (LAS float*)(Vt + 2 * 64 * KS);
    LAS float* OX = BT + 128;
    const bf16* ZM = WSP(bf16, WS_ZMIX); const bf16* QNB = WSP(bf16, WS_QNB); const bf16* KNB = WSP(bf16, WS_KNB); bf16* BR = WSP(bf16, WS_BR);
    const int r32 = lane & 31, hi = lane >> 5, qs = wave >> 1, s = wave & 1;
    const int q0 = qb * 128 + qs * 32; const int rowb = b * L;
    if (tid < 128) BT[tid] = (C.in[I_RELB][t5_bucket(tid) * 4 + h] - C.in[I_RELB][31 * 4 + h]) * LOG2E;
    pg8::bf16x8 qf[2];
#pragma unroll
    for (int d0 = 0; d0 < 2; ++d0) qf[d0] = *(const pg8::bf16x8*)(QNB + (size_t)(rowb + q0 + r32) * 256 + h * 64 + s * 32 + 16 * d0 + 8 * hi);
    const int pl = (lane & ~15) | ((lane & 8) >> 1) | ((lane & 4) << 1) | (lane & 3);
    const int NT = (min(128 * (qb + 1), L) + 63) >> 6;
    v4u kreg, vreg;
#define AT_LOAD(j) do { const size_t r_ = (size_t)(rowb + (j) * 64 + lane); kreg = *(const v4u*)(KNB + r_ * 256 + h * 64 + 8 * wave); vreg = *(const v4u*)(ZM + r_ * NMIXP + D_V + h * 64 + 8 * wave); } while (0)
#define AT_STORE(buf) do { *(LAS v4u*)(Kt + (buf) * 64 * KS + lane * KS + 8 * wave) = kreg; LAS bf16* v_ = Vt + (buf) * 64 * KS + (8 * wave) * KS + pl; \
        v_[0] = (bf16)(vreg.x & 0xffffu); v_[KS] = (bf16)(vreg.x >> 16); v_[2 * KS] = (bf16)(vreg.y & 0xffffu); v_[3 * KS] = (bf16)(vreg.y >> 16); \
        v_[4 * KS] = (bf16)(vreg.z & 0xffffu); v_[5 * KS] = (bf16)(vreg.z >> 16); v_[6 * KS] = (bf16)(vreg.w & 0xffffu); v_[7 * KS] = (bf16)(vreg.w >> 16); } while (0)
    AT_LOAD(0); AT_STORE(0); if (NT > 1) AT_LOAD(1);
    LDS_WAIT(); __builtin_amdgcn_s_barrier(); asm volatile("" ::: "memory");
    float lsum = 0.f; f32x16_t o[2]; f32x16_t negm;
#pragma unroll
    for (int i = 0; i < 16; ++i) negm[i] = -mb;
#pragma unroll
    for (int i = 0; i < 16; ++i) { o[0][i] = 0.f; o[1][i] = 0.f; }
    for (int j = 0; j < NT; ++j) {
        const int k0 = 64 * j, buf = j & 1;
        if (k0 <= q0 + 31) {
            const LAS bf16* kb = Kt + buf * 64 * KS; const LAS bf16* vb = Vt + buf * 64 * KS;
            f32x16_t p0 = negm, p1 = negm;
#pragma unroll
            for (int d0 = 0; d0 < 2; ++d0) { const pg8::bf16x8 a0 = *(const LAS pg8::bf16x8*)(kb + r32 * KS + s * 32 + 16 * d0 + 8 * hi), a1 = *(const LAS pg8::bf16x8*)(kb + (32 + r32) * KS + s * 32 + 16 * d0 + 8 * hi);
                p0 = __builtin_amdgcn_mfma_f32_32x32x16_bf16(a0, qf[d0], p0, 0, 0, 0); p1 = __builtin_amdgcn_mfma_f32_32x32x16_bf16(a1, qf[d0], p1, 0, 0, 0); }
            if (q0 - k0 - 63 < 113) {
#pragma unroll
                for (int r = 0; r < 16; ++r) { const int n0 = (q0 + r32) - (k0 + crow_(r, hi)), n1 = n0 - 32;
                    p0[r] = n0 < 0 ? -INFINITY : p0[r] + (n0 < 128 ? BT[n0] : 0.f); p1[r] = n1 < 0 ? -INFINITY : p1[r] + (n1 < 128 ? BT[n1] : 0.f); } }
            typedef float f32x2_t __attribute__((ext_vector_type(2)));
            f32x2_t ps2 = {0.f, 0.f};
#pragma unroll
            for (int r = 0; r < 16; r += 2) { p0[r] = __builtin_amdgcn_exp2f(p0[r]); p0[r + 1] = __builtin_amdgcn_exp2f(p0[r + 1]); p1[r] = __builtin_amdgcn_exp2f(p1[r]); p1[r + 1] = __builtin_amdgcn_exp2f(p1[r + 1]);
                ps2 = ps2 + (f32x2_t){p0[r], p0[r + 1]}; ps2 = ps2 + (f32x2_t){p1[r], p1[r + 1]}; }
            lsum += ps2[0] + ps2[1];
            pg8::bf16x8 pb[4];
#pragma unroll
            for (int ks = 0; ks < 4; ++ks) { v4u w;
                if (ks < 2) { w.x = pg8::cvt_pk_bf16(p0[8 * ks], p0[8 * ks + 1]); w.y = pg8::cvt_pk_bf16(p0[8 * ks + 2], p0[8 * ks + 3]); w.z = pg8::cvt_pk_bf16(p0[8 * ks + 4], p0[8 * ks + 5]); w.w = pg8::cvt_pk_bf16(p0[8 * ks + 6], p0[8 * ks + 7]); }
                else { w.x = pg8::cvt_pk_bf16(p1[8 * ks - 16], p1[8 * ks - 15]); w.y = pg8::cvt_pk_bf16(p1[8 * ks - 14], p1[8 * ks - 13]); w.z = pg8::cvt_pk_bf16(p1[8 * ks - 12], p1[8 * ks - 11]); w.w = pg8::cvt_pk_bf16(p1[8 * ks - 10], p1[8 * ks - 9]); }
                pb[ks] = __builtin_bit_cast(pg8::bf16x8, w); }
#pragma unroll
            for (int d0 = 0; d0 < 2; ++d0)
#pragma unroll
                for (int ks = 0; ks < 4; ++ks) { const pg8::bf16x8 af = *(const LAS pg8::bf16x8*)(vb + (32 * d0 + r32) * KS + 16 * ks + 8 * hi); o[d0] = __builtin_amdgcn_mfma_f32_32x32x16_bf16(af, pb[ks], o[d0], 0, 0, 0); }
        }
        if (j + 1 < NT) AT_STORE(buf ^ 1);
        if (j + 2 < NT) AT_LOAD(j + 2);
        LDS_WAIT(); __builtin_amdgcn_s_barrier(); asm volatile("" ::: "memory");
    }
#undef AT_LOAD
#undef AT_STORE
    lsum = swapadd32(lsum); const float inv = 1.0f / lsum;
    LAS float* ox = OX + (qs * 32 + r32) * 65;
    if (s == 1) {
#pragma unroll
        for (int d0 = 0; d0 < 2; ++d0)
#pragma unroll
            for (int r = 0; r < 16; ++r) ox[32 * d0 + crow_(r, hi)] = o[d0][r] * inv; }
    LDS_WAIT(); __builtin_amdgcn_s_barrier(); asm volatile("" ::: "memory");
    if (s == 0) {
        float ss = 0.f;
#pragma unroll
        for (int d0 = 0; d0 < 2; ++d0)
#pragma unroll
            for (int r = 0; r < 16; ++r) { const float v = o[d0][r] * inv - lam * ox[32 * d0 + crow_(r, hi)]; o[d0][r] = v; ss += v * v; }
        ss = swapadd32(ss); const float rs = rsqrtf(ss * (1.0f / 64) + EPS) * (1.0f - lam_init);
        const int qpos = q0 + r32;
        if (qpos < L) { bf16* brp = BR + (size_t)(rowb + qpos) * D + 768 + h * 64;
#pragma unroll
            for (int d0 = 0; d0 < 2; ++d0)
#pragma unroll
                for (int r4 = 0; r4 < 4; ++r4) { const int dv = 32 * d0 + 8 * r4 + 4 * hi; const float* sl = C.in[I_SUBLN] + l * 64 + dv;
                    const unsigned w0 = pk2(o[d0][4 * r4] * rs * sl[0], o[d0][4 * r4 + 1] * rs * sl[1]), w1 = pk2(o[d0][4 * r4 + 2] * rs * sl[2], o[d0][4 * r4 + 3] * rs * sl[3]);
                    *(unsigned long long*)(brp + dv) = (unsigned long long)w0 | ((unsigned long long)w1 << 32); } }
    }
    LDS_WAIT(); __builtin_amdgcn_s_barrier(); asm volatile("" ::: "memory");
}
constexpr int PSTR = 68;
__device__ __forceinline__ pg8::bf16x8 cvt8(const f32x4 a, const f32x4 b) { v4u w; w.x = pg8::cvt_pk_bf16(a[0], a[1]); w.y = pg8::cvt_pk_bf16(a[2], a[3]); w.z = pg8::cvt_pk_bf16(b[0], b[1]); w.w = pg8::cvt_pk_bf16(b[2], b[3]); return __builtin_bit_cast(pg8::bf16x8, w); }
__device__ __forceinline__ void attn_sample_item(const Ctx& C, int l, int b, int split) {
    THREAD_IDS();
    const int h = wave & 3, half = wave >> 2, c16 = lane & 15, g = lane >> 4, srow = c16 >> 3, t = c16 & 7;
    const bf16* QNB = WSP(bf16, WS_QNB); const int* PT = (const int*)C.in[I_PT];
    const float* CK = C.in[I_CK] + (size_t)l * NPOOL * PAGE * 256; const float* CV = C.in[I_CV] + (size_t)l * NPOOL * PAGE * 256;
    LAS float* BT = (LAS float*)C.lds;
    BT[tid] = (C.in[I_RELB][t5_bucket(tid & 127) * 4 + (tid >> 7)] - C.in[I_RELB][31 * 4 + (tid >> 7)]) * LOG2E;
    const v4u z4 = {0u, 0u, 0u, 0u};
    const v4u q0w = srow == 0 ? *(const v4u*)(QNB + (size_t)(MP + b * 8 + t) * 256 + h * 64 + 8 * g) : z4, q1w = srow == 1 ? *(const v4u*)(QNB + (size_t)(MP + b * 8 + t) * 256 + h * 64 + 32 + 8 * g) : z4;
    const pg8::bf16x8 qf0 = __builtin_bit_cast(pg8::bf16x8, q0w), qf1 = __builtin_bit_cast(pg8::bf16x8, q1w);
    LDS_WAIT(); __builtin_amdgcn_s_barrier(); asm volatile("" ::: "memory");
    float m = -INFINITY, lsum = 0.f; f32x4 o[4];
#pragma unroll
    for (int db = 0; db < 4; ++db) o[db] = (f32x4){0.f, 0.f, 0.f, 0.f};
    const int kk0 = split * 1024 + half * 512;
    const int pg0 = __builtin_amdgcn_readfirstlane(PT[b * NPAGES + (kk0 >> 7)]), pg1 = __builtin_amdgcn_readfirstlane(PT[b * NPAGES + (kk0 >> 7) + 1]), pg2 = __builtin_amdgcn_readfirstlane(PT[b * NPAGES + (kk0 >> 7) + 2]), pg3 = __builtin_amdgcn_readfirstlane(PT[b * NPAGES + (kk0 >> 7) + 3]);
#define SA_LOAD(KR, VR, st) do { const int kk_ = kk0 + 32 * (st); const int pi_ = (st) >> 2; const int page_ = pi_ == 0 ? pg0 : pi_ == 1 ? pg1 : pi_ == 2 ? pg2 : pg3; const size_t base_ = ((size_t)(page_ * PAGE + (kk_ & 127)) * 4 + h) * 64; \
        _Pragma("unroll") for (int T = 0; T < 2; ++T) _Pragma("unroll") for (int ks = 0; ks < 2; ++ks) { const float* p = CK + base_ + (size_t)(16 * T + c16) * 256 + 32 * ks + 8 * g; KR[T][ks][0] = *(const f32x4*)p; KR[T][ks][1] = *(const f32x4*)(p + 4); } \
        _Pragma("unroll") for (int db = 0; db < 4; ++db) _Pragma("unroll") for (int j = 0; j < 8; ++j) { const int kv = j < 4 ? 4 * g + j : 16 + 4 * g + (j - 4); VR[db][j] = CV[base_ + (size_t)kv * 256 + 16 * db + c16]; } } while (0)
#define SA_MATH(KR, VR, st) do { const int kk = kk0 + 32 * (st); f32x4 sv[2]; \
        _Pragma("unroll") for (int T = 0; T < 2; ++T) { sv[T] = (f32x4){0.f, 0.f, 0.f, 0.f}; \
            sv[T] = __builtin_amdgcn_mfma_f32_16x16x32_bf16(cvt8(KR[T][0][0], KR[T][0][1]), qf0, sv[T], 0, 0, 0); \
            sv[T] = __builtin_amdgcn_mfma_f32_16x16x32_bf16(cvt8(KR[T][1][0], KR[T][1][1]), qf1, sv[T], 0, 0, 0); } \
        if (kk + 31 + 128 > PAST) { \
            _Pragma("unroll") for (int T = 0; T < 2; ++T) _Pragma("unroll") for (int r = 0; r < 4; ++r) { const int n = PAST + t - (kk + 16 * T + 4 * g + r); if (n < 128) sv[T][r] += BT[h * 128 + n]; } } \
        float mt = fmaxf(fmaxf(fmaxf(sv[0][0], sv[0][1]), fmaxf(sv[0][2], sv[0][3])), fmaxf(fmaxf(sv[1][0], sv[1][1]), fmaxf(sv[1][2], sv[1][3]))); \
        mt = fmaxf(mt, __shfl_xor(mt, 16)); mt = fmaxf(mt, __shfl_xor(mt, 32)); \
        const float mn = fmaxf(m, mt); const float al = __builtin_amdgcn_exp2f(m - mn); m = mn; float ps = 0.f; \
        _Pragma("unroll") for (int T = 0; T < 2; ++T) _Pragma("unroll") for (int r = 0; r < 4; ++r) { sv[T][r] = __builtin_amdgcn_exp2f(sv[T][r] - m); ps += sv[T][r]; } \
        lsum = lsum * al + ps; const pg8::bf16x8 pf = cvt8(sv[0], sv[1]); \
        _Pragma("unroll") for (int db = 0; db < 4; ++db) { o[db] = o[db] * al; \
            const f32x4 va = {VR[db][0], VR[db][1], VR[db][2], VR[db][3]}, vb = {VR[db][4], VR[db][5], VR[db][6], VR[db][7]}; \
            o[db] = __builtin_amdgcn_mfma_f32_16x16x32_bf16(cvt8(va, vb), pf, o[db], 0, 0, 0); } } while (0)
    f32x4 krA[2][2][2], krB[2][2][2]; float vrA[4][8], vrB[4][8];
    SA_LOAD(krA, vrA, 0);
#pragma unroll 1
    for (int step = 0; step < 16; step += 2) {
        SA_LOAD(krB, vrB, step + 1);
        SA_MATH(krA, vrA, step);
        if (step + 2 < 16) SA_LOAD(krA, vrA, step + 2);
        SA_MATH(krB, vrB, step + 1);
    }
#undef SA_LOAD
#undef SA_MATH
    lsum += __shfl_xor(lsum, 16); lsum += __shfl_xor(lsum, 32);
    float* pp = WSP(float, WS_PART) + ((((size_t)b * 4 + h) * 16 + split * 2 + half) * 16 + c16) * PSTR;
#pragma unroll
    for (int db = 0; db < 4; ++db) *(f32x4*)(pp + 16 * db + 4 * g) = o[db];
    if (g == 0) { pp[64] = m; pp[65] = lsum; }
    LDS_WAIT(); __builtin_amdgcn_s_barrier(); asm volatile("" ::: "memory");
}
__device__ __forceinline__ void n3_attn_sample_combine(const Ctx& C, int l, float lam_init) {
    THREAD_IDS();
    const float lam = lam_of(C, l, lam_init);
    const bf16* QNB = WSP(bf16, WS_QNB); const bf16* KNB = WSP(bf16, WS_KNB); const bf16* ZM = WSP(bf16, WS_ZMIX); bf16* BR = WSP(bf16, WS_BR);
    for (int it = gw; it < DB * 4 * DS; it += NGW) {
        const int b = it >> 5, h = (it >> 3) & 3, t = it & 7; float os[2];
        const float far = C.in[I_RELB][31 * 4 + h];
        float sn[2][8];
        { const float qv = bf2f(QNB[(size_t)(MP + b * 8 + t) * 256 + h * 64 + lane]);
#pragma unroll
          for (int jj = 0; jj < 8; ++jj) { float p = qv * bf2f(KNB[(size_t)(MP + b * 8 + jj) * 256 + h * 64 + lane]);
              p += __shfl_xor(p, 1); p += __shfl_xor(p, 2); p += __shfl_xor(p, 4); p += __shfl_xor(p, 8); p += __shfl_xor(p, 16);
              const float bias = (C.in[I_RELB][t5_bucket(t - jj < 0 ? 0 : t - jj) * 4 + h] - far) * LOG2E;
              sn[0][jj] = jj <= t ? __shfl(p, 0) + bias : -INFINITY; sn[1][jj] = jj <= t ? __shfl(p, 32) + bias : -INFINITY; } }
#pragma unroll
        for (int s = 0; s < 2; ++s) {
            const float* pb = WSP(float, WS_PART) + ((((size_t)b * 4 + h) * 16) * 16 + s * 8 + t) * PSTR;
            float mm = -INFINITY; float pm[16];
#pragma unroll
            for (int pi = 0; pi < 16; ++pi) { pm[pi] = pb[(size_t)pi * 16 * PSTR + 64]; mm = fmaxf(mm, pm[pi]); }
#pragma unroll
            for (int jj = 0; jj < 8; ++jj) mm = fmaxf(mm, sn[s][jj]);
            float ll = 0.f, oo = 0.f;
#pragma unroll
            for (int pi = 0; pi < 16; ++pi) { const float* pr = pb + (size_t)pi * 16 * PSTR; const float w = __builtin_amdgcn_exp2f(pm[pi] - mm); ll += pr[65] * w; oo += pr[lane] * w; }
#pragma unroll
            for (int jj = 0; jj < 8; ++jj) { const float w = __builtin_amdgcn_exp2f(sn[s][jj] - mm); ll += w; oo += w * bf2f(ZM[(size_t)(MP + b * 8 + jj) * NMIXP + D_V + h * 64 + lane]); }
            os[s] = oo / ll;
        }
        const float o = os[0] - lam * os[1]; const float ms = wave_sum(o * o) * (1.0f / 64);
        BR[(size_t)(MP + b * 8 + t) * D + 768 + h * 64 + lane] = (bf16)f2bf(o * rsqrtf(ms + EPS) * C.in[I_SUBLN][l * 64 + lane] * (1.0f - lam_init));
    }
}

__device__ __forceinline__ void n3_la_finalize(const Ctx& C, int l) {
    THREAD_IDS();
    const float* LAO = WSP(float, WS_LAO); const bf16* ZM = WSP(bf16, WS_ZMIX); bf16* BR = WSP(bf16, WS_BR);
    const bool ret = lane < 32; const int hd = (lane >> 3) & 3, c8 = (lane & 7) * 8;
    float gn[8];
#pragma unroll
    for (int j = 0; j < 8; ++j) gn[j] = (ret ? C.in[I_RGN] : C.in[I_GGN])[(l * 4 + hd) * 64 + c8 + j];
    for (int r0 = gw * 4; r0 < MP; r0 += NGW * 4) {
        f32x4 a4[4], b4[4]; v4u g4[4];
#pragma unroll
        for (int u = 0; u < 4; ++u) { const int r = min(r0 + u, MP - 1); a4[u] = *(const f32x4*)(LAO + (size_t)r * 512 + 8 * lane); b4[u] = *(const f32x4*)(LAO + (size_t)r * 512 + 8 * lane + 4);
            g4[u] = *(const v4u*)(ZM + (size_t)r * NMIXP + (ret ? R_G : G_R) + hd * 64 + c8); }
#pragma unroll
        for (int u = 0; u < 4; ++u) { const int r = r0 + u; if (r >= MP) break;
            float x[8] = {a4[u][0], a4[u][1], a4[u][2], a4[u][3], b4[u][0], b4[u][1], b4[u][2], b4[u][3]}, g[8]; unpack8(g4[u], g);
            float s = ((x[0] + x[1]) + (x[2] + x[3])) + ((x[4] + x[5]) + (x[6] + x[7]));
            s += __shfl_xor(s, 1); s += __shfl_xor(s, 2); s += __shfl_xor(s, 4);
            const float mean = ret ? s * (1.0f / 64) : 0.f; float q2 = 0.f;
#pragma unroll
            for (int j = 0; j < 8; ++j) { x[j] -= mean; q2 += x[j] * x[j]; }
            q2 += __shfl_xor(q2, 1); q2 += __shfl_xor(q2, 2); q2 += __shfl_xor(q2, 4);
            const float rs = rsqrtf(q2 * (1.0f / 64) + EPS);
#pragma unroll
            for (int j = 0; j < 8; ++j) x[j] = siluf_(g[j]) * x[j] * rs * gn[j];
            *(v4u*)(BR + (size_t)r * D + 256 + 8 * lane) = pack8(x); }
    }
}

constexpr int NQB_ATT = (L + 127) / 128;
constexpr int IT_LA = 32, IT_SS = IT_LA + DB * 8, IT_AT = IT_SS + 16 * NQB_ATT, IT_LS = IT_AT + 32, IT_CV = IT_LS + (MR + 63) / 64, IT_END = IT_CV;
__device__ __forceinline__ void n2_phase(const Ctx& C, int l, float lam_init, int qslot) {
    THREAD_IDS();
    const float lam = lam_of(C, l, lam_init);
    float mb;
    { float mq = 0.f, mk = 0.f, mbias = 0.f;
#pragma unroll 1
      for (int i = 0; i < 32; ++i) { mq = fmaxf(mq, fabsf(C.in[I_QN][l * 32 + i])); mk = fmaxf(mk, fabsf(C.in[I_KN][l * 32 + i])); }
#pragma unroll 1
      for (int i = 0; i < 128; ++i) mbias = fmaxf(mbias, C.in[I_RELB][i] - C.in[I_RELB][31 * 4 + (i & 3)]);
      mb = 1.02f * 1.4426950408889634f * 5.656854249492381f * mq * mk + 1.4426950408889634f * mbias; }
    unsigned* qw = (unsigned*)(C.ws + WS_CTL) + CW_QUEUE + 64 * qslot;
    volatile LAS int* slot = (volatile LAS int*)(C.lds + MISC_OFF + 64);
    if (blockIdx.x < IT_LA) { const int it = blockIdx.x; const int b = (it >> 2) & 3, h = it & 3; if (it < 16) la_chunked<64, true>(C, l, false, b, h); else la_chunked<32, false>(C, l, false, b, h); }
    for (;;) {
        if (tid == 0) slot[0] = (int)__hip_atomic_fetch_add(qw, 1u, __ATOMIC_RELAXED, __HIP_MEMORY_SCOPE_AGENT);
        __syncthreads();
        const int qi = slot[0];
        const int it = qi < 3 * DB * 8 ? ((qi % 3) ? IT_SS + 2 * (qi / 3) + (qi % 3) - 1 : IT_LA + qi / 3) : qi + IT_LA;
        __syncthreads();
        if (it >= IT_END) break;
        if (it < IT_SS) { const int i2 = it - IT_LA; attn_sample_item(C, l, i2 >> 3, i2 & 7); }
        else if (it < IT_AT) { const int i2 = it - IT_SS; attn_prompt_item(C, l, (i2 & 15) >> 2, i2 & 3, NQB_ATT - 1 - (i2 >> 4), lam, lam_init, mb); }
        else if (it < IT_LS) { const int i2 = (it - IT_AT) * 8 + wave; const int b = (i2 >> 2) & 31, h = i2 & 3; if (i2 < 128) la_seq<64, true>(C, l, true, b, h); else la_seq<32, false>(C, l, true, b, h); }
        else { conv_rows_item(C, l, it - IT_LS); conv_state_item(C, l, it - IT_LS, IT_CV - IT_LS); }
    }
}

template <int l> __device__ __forceinline__ void layer_fwd(const Ctx& C, const XcdBarrier& bar) {
#define GRID_BAR() xcd_barrier<false>(bar)
    LAS unsigned char* ring = C.lds + RING_OFF;
    float* SS = WSP(float, WS_SS); float* H = WSP(float, WS_H); bf16* HB = WSP(bf16, WS_HB); bf16* ACT = WSP(bf16, WS_ACT); bf16* ZMIX = WSP(bf16, WS_ZMIX); bf16* GATES = WSP(bf16, WS_GATES);
    bf16* BR = WSP(bf16, WS_BR); bf16* MERGED = WSP(bf16, WS_MERGED);
    constexpr float lam_init = l == 0 ? 0.2f : 0.35550906759096926f;
    constexpr bool last = (l == DEPTH - 1);
    { pg8::Gemm g{HB, WSP(bf16, WS_W1 + (size_t)(l * 2 + 0) * SZ_W1), D, D, D}; pg8::StaticOrder S; S.init(M, 2 * DFF, C.G, (int)blockIdx.x);
      EpiGLU E{ACT, SS + (size_t)(l * 3 + 0) * M * 16}; pg8::gemm_phase<EpiGLU, pg8::StaticOrder, true, true>(ring, g, S, E); }
    GRID_BAR();
    { pg8::HeadOrder S; S.init(M, D, C.G, (int)blockIdx.x); S.limit = C.G; EpiRes<false, 1> E{H, HB, SS + (size_t)(l * 3 + 1) * M * 16, nullptr};
      { pg8::Gemm g{ACT, WSP(bf16, WS_WD + (size_t)(l * 2 + 0) * SZ_WD), DFF, DFF, DFF}; pg8::gemm_phase<EpiRes<false, 1>, pg8::HeadOrder, true, true>(ring, g, S, E); }
      { int kt = DFF / 11; asm volatile("" : "+s"(kt)); pg8::Gemm g{ACT, WSP(bf16, WS_WD + (size_t)(l * 2 + 0) * SZ_WD), DFF, DFF, kt}; pg8::TailOrder T; T.init(M, D, C.G, (int)blockIdx.x); T.limit = C.G; T.nsplit = 11; T.kper = DFF / 11;
        EpiPartial EP{WSP(float, WS_KSP)}; pg8::gemm_phase<EpiPartial, pg8::TailOrder, true, true>(ring, g, T, EP); }
      GRID_BAR();
      ksp_finalize<11>(WSP(float, WS_KSP), S, C.G, E); }
    GRID_BAR();
    { pg8::Gemm g{HB, WSP(bf16, WS_WIN + (size_t)l * SZ_WIN), D, D, D}; pg8::StaticOrder S; S.init(M, NINP, C.G, (int)blockIdx.x);
      EpiZ E{ZMIX, GATES, SS + (size_t)(l * 3 + 1) * M * 16, WSP(float, WS_BINP) + l * NINP}; pg8::gemm_phase<EpiZ, pg8::StaticOrder, true, true>(ring, g, S, E); }
    GRID_BAR();
    n1_prep(C, l);
    GRID_BAR();
    n2_phase(C, l, lam_init, l);
    GRID_BAR();
    n3_attn_sample_combine(C, l, lam_init);
    n3_la_finalize(C, l);
    GRID_BAR();
    { pg8::Gemm g{BR, WSP(bf16, WS_WBR + (size_t)l * SZ_WBR), D, D, D}; pg8::StaticOrder S; S.init(M, D, C.G, (int)blockIdx.x);
      EpiMergeR E{MERGED, GATES}; pg8::gemm_phase<EpiMergeR, pg8::StaticOrder, true, true, 4>(ring, g, S, E); }
    GRID_BAR();
    { pg8::HeadOrder S; S.init(M, D, C.G, (int)blockIdx.x); S.limit = C.G; EpiRes<false, 2> E{H, HB, SS + (size_t)(l * 3 + 2) * M * 16, nullptr};
      { pg8::Gemm g{MERGED, WSP(bf16, WS_WOUT + (size_t)l * SZ_WOUT), D, D, D}; pg8::gemm_phase<EpiRes<false, 2>, pg8::HeadOrder, true, true>(ring, g, S, E); }
      { int kt = D / 4; asm volatile("" : "+s"(kt)); pg8::Gemm g{MERGED, WSP(bf16, WS_WOUT + (size_t)l * SZ_WOUT), D, D, kt}; pg8::TailOrder T; T.init(M, D, C.G, (int)blockIdx.x); T.limit = C.G; T.nsplit = 4; T.kper = D / 4;
        EpiPartial EP{WSP(float, WS_KSP)}; pg8::gemm_phase<EpiPartial, pg8::TailOrder, true, true>(ring, g, T, EP); }
      GRID_BAR();
      ksp_finalize<4>(WSP(float, WS_KSP), S, C.G, E); }
    GRID_BAR();
    { pg8::Gemm g{HB, WSP(bf16, WS_W1 + (size_t)(l * 2 + 1) * SZ_W1), D, D, D}; pg8::StaticOrder S; S.init(M, 2 * DFF, C.G, (int)blockIdx.x);
      EpiGLU E{ACT, SS + (size_t)(l * 3 + 2) * M * 16}; pg8::gemm_phase<EpiGLU, pg8::StaticOrder, true, true>(ring, g, S, E); }
    GRID_BAR();
    { pg8::HeadOrder S; S.init(M, D, C.G, (int)blockIdx.x); S.limit = C.G; EpiRes<last, 1> E{H, HB, last ? nullptr : SS + (size_t)((l + 1) * 3) * M * 16, C.out};
      { pg8::Gemm g{ACT, WSP(bf16, WS_WD + (size_t)(l * 2 + 1) * SZ_WD), DFF, DFF, DFF}; pg8::gemm_phase<EpiRes<last, 1>, pg8::HeadOrder, true, true>(ring, g, S, E); }
      { int kt = DFF / 11; asm volatile("" : "+s"(kt)); pg8::Gemm g{ACT, WSP(bf16, WS_WD + (size_t)(l * 2 + 1) * SZ_WD), DFF, DFF, kt}; pg8::TailOrder T; T.init(M, D, C.G, (int)blockIdx.x); T.limit = C.G; T.nsplit = 11; T.kper = DFF / 11;
        EpiPartial EP{WSP(float, WS_KSP)}; pg8::gemm_phase<EpiPartial, pg8::TailOrder, true, true>(ring, g, T, EP); }
      GRID_BAR();
      ksp_finalize<11>(WSP(float, WS_KSP), S, C.G, E); }
#undef GRID_BAR
}

__global__ void __launch_bounds__(NWAVES * 64, 2) fwd(Params P) {
    extern __shared__ __attribute__((aligned(16))) unsigned char lds[];
    Ctx C;
    C.in = P.in; C.out = P.out; C.ws = P.ws; C.lds = (LAS unsigned char*)lds;
    C.G = gridDim.x;
    volatile LAS unsigned* MISC = (volatile LAS unsigned*)(C.lds + MISC_OFF);
    for (int u = threadIdx.x; u < (LDS_BYTES - LDSCTL_OFF) / 4; u += NWAVES * 64) ((LAS unsigned*)(C.lds + LDSCTL_OFF))[u] = 0u;
    __syncthreads();
    unsigned* ctl = (unsigned*)(C.ws + WS_CTL);
    XcdBarrier bar = xcd_barrier_post(ctl + CW_BAR, MISC + 8);
    p0_prologue(C, P);
    xcd_barrier<true>(bar);
    layer_fwd<0>(C, bar);
    xcd_barrier<false>(bar);
    layer_fwd<1>(C, bar);
}

extern "C" void kernel_launch(void* const* d_in, const int* in_sizes, int n_in, void* d_out, int out_size, void* d_ws, size_t ws_size, hipStream_t stream) {
    static int grid = 0;
    if (grid == 0) {
        if (n_in != N_INPUTS || (size_t)out_size != O_END || ws_size < WS_END) { fprintf(stderr, "kernel_launch: unexpected shapes: n_in %d out %d (want %zu) ws %zu (want %zu)\n", n_in, out_size, (size_t)O_END, ws_size, (size_t)WS_END); grid = -1; return; }
        int dev = 0, cus = 0, per_cu = 0;
        if (hipGetDevice(&dev) != hipSuccess || hipDeviceGetAttribute(&cus, hipDeviceAttributeMultiprocessorCount, dev) != hipSuccess) { grid = -1; return; }
        if (hipFuncSetAttribute((const void*)fwd, hipFuncAttributeMaxDynamicSharedMemorySize, LDS_BYTES) != hipSuccess) { fprintf(stderr, "kernel_launch: hipFuncSetAttribute failed\n"); grid = -1; return; }
        if (hipOccupancyMaxActiveBlocksPerMultiprocessor(&per_cu, (const void*)fwd, NWAVES * 64, LDS_BYTES) != hipSuccess || per_cu < 1) { fprintf(stderr, "kernel_launch: occupancy query says %d blocks per CU\n", per_cu); }
        (void)hipGetLastError();
        grid = cus;
    }
    if (grid < 0) return;
    if (hipMemsetAsync((char*)d_ws + WS_CTL, 0, CTL_ZERO_BYTES, stream) != hipSuccess) return;
    Params p{};
    for (int i = 0; i < N_INPUTS; ++i) p.in[i] = (const float*)d_in[i];
    p.out = (float*)d_out; p.ws = (unsigned char*)d_ws;
    for (int i = 0; i < 32; ++i) p.inv_freq[i] = (float)pow(10000.0, -(double)i / 32.0);
    hipLaunchKernelGGL(fwd, dim3(grid), dim3(NWAVES * 64), LDS_BYTES, stream, p);
}
```

```cpp
#include <hip/hip_runtime.h>
#include <cstdio>
#include <cstdint>
#include <cmath>

namespace pg8 {
#define PG8_LAS __attribute__((address_space(3)))
typedef unsigned short bf16_t;
typedef short bf16x8 __attribute__((ext_vector_type(8)));
typedef float f32x4 __attribute__((ext_vector_type(4)));
typedef unsigned u32x4 __attribute__((ext_vector_type(4)));
constexpr int BM = 256, BK = 64, HALF = 128, HTB = HALF * BK * 2  , STAGE_BYTES = 8 * HTB, NXCD = 8, WGM = 8;

__host__ __device__ __forceinline__ int lds_byte(int r, int c) { const int st = (r >> 4) * 2 + (c >> 5), rr = r & 15, cc = c & 31, ob = rr * 64 + cc * 2; return st * 1024 + (ob ^ (((ob >> 9) & 1) << 5)); }
__host__ __device__ __forceinline__ void stage_rc(int b, int& R, int& C) { const int st = b / 1024, sb = b % 1024, swz = sb ^ (((sb >> 9) & 1) << 5); R = (st >> 1) * 16 + swz / 64; C = (st & 1) * 32 + (swz % 64) / 2; }
__host__ __device__ __forceinline__ int perm32(int rho) { const int n = rho >> 4, i = rho & 15; return 8 * (i >> 2) + 4 * n + (i & 3); }

struct Unit { int pm, pn, acol, bcol; };
struct Gemm { const bf16_t* A; const bf16_t* Bt; int lda, ldb, K, kseg0; };

struct StaticOrder {
    int nM, nN, nwg, G, c;
    __host__ __device__ void init(int M, int N, int G_, int c_) { nM = M / BM; nN = N / BM; nwg = nM * nN; G = G_; c = c_; }
    __host__ __device__ void unit_of(int L, Unit& u) const {
        int wgid = L; { const int q = nwg / NXCD, r = nwg % NXCD, xcd = wgid % NXCD, off = wgid / NXCD; wgid = (xcd < r ? xcd * (q + 1) : r * (q + 1) + (xcd - r) * q) + off; }
        const int nig = WGM * nN, gid = wgid / nig, fm = gid * WGM, gsz = (nM - fm) < WGM ? (nM - fm) : WGM;
        u.pm = fm + ((wgid % nig) % gsz); u.pn = (wgid % nig) / gsz; u.acol = 0; u.bcol = 0;
    }
    __host__ __device__ bool next(int i, Unit& u) const { const long L = (long)i * G + c; if (L >= nwg) return false; unit_of((int)L, u); return true; }
};
struct HeadOrder : StaticOrder { int limit; __host__ __device__ bool next(int i, Unit& u) const { const long L = (long)i * G + c; if (L >= limit || L >= nwg) return false; unit_of((int)L, u); return true; } };
struct TailOrder : StaticOrder { int limit, nsplit, kper;
    __host__ __device__ bool next(int i, Unit& u) const {
        if (i > 0 || c >= (nwg - limit) * nsplit) return false;
        unit_of(limit + c / nsplit, u); u.acol = u.bcol = (c % nsplit) * kper; return true; } };
__device__ __forceinline__ unsigned cvt_pk_bf16(float lo, float hi) { unsigned r; asm volatile("v_cvt_pk_bf16_f32 %0, %1, %2" : "=v"(r) : "v"(lo), "v"(hi)); return r; }

template <class Epi, class Sched, bool ALIGN_EPI = false, bool SP2 = false, int SEG = 0>
__device__ __forceinline__ void gemm_phase(PG8_LAS unsigned char* lds, const Gemm g, const Sched& S, const Epi& E) {
    int tid_ = threadIdx.x; asm volatile("" : "+v"(tid_));
    const int tid = tid_, wid = __builtin_amdgcn_readfirstlane(tid >> 6), lane = tid & 63, wr = wid >> 2, wc = wid & 3, fr = lane & 15, fq = lane >> 4;
    const int nt = g.K / BK;
    unsigned voffA[2], voffB[2];
#pragma unroll
    for (int i = 0; i < 2; ++i) { int R, C; stage_rc(tid * 16 + i * 8192, R, C); const int Rb = Epi::PERM ? ((R & ~31) + perm32(R & 31)) : R;
        voffA[i] = (unsigned)(R * g.lda + C) * 2u; voffB[i] = (unsigned)(Rb * g.ldb + C) * 2u; }
    const size_t kstep = (size_t)(BK * 2);
    const size_t hstepA = (size_t)HALF * g.lda * 2, hstepB = (size_t)HALF * g.ldb * 2;
    const size_t tstepA = 2 * hstepA, tstepB = 2 * hstepB;
    const unsigned ldsw = (unsigned)wid * 1024u;
    const int aoff = lds_byte(wr * 64 + fr, fq * 8), boff = lds_byte(wc * 32 + fr, fq * 8);
#define PG8_SA(b, h) (((b) * 2 + (h)) * HTB)
#define PG8_SB(b, h) ((4 + (b) * 2 + (h)) * HTB)
#define PG8_STAGE(bufoff, gbase, voff) do { _Pragma("unroll") for (int _i = 0; _i < 2; ++_i) \
        __builtin_amdgcn_global_load_lds((const unsigned*)((const char*)(gbase) + (voff)[_i]), (PG8_LAS unsigned*)(lds + (bufoff) + ldsw + _i * 8192), 16, 0, 0); } while (0)
#define PG8_LDA(dst, b, h) do { _Pragma("unroll") for (int m = 0; m < 4; ++m) _Pragma("unroll") for (int k = 0; k < 2; ++k) dst[m][k] = *(const PG8_LAS bf16x8*)(lds + PG8_SA(b, h) + aoff + m * 2048 + k * 1024); } while (0)
#define PG8_LDB(dst, b, h) do { _Pragma("unroll") for (int n = 0; n < 2; ++n) _Pragma("unroll") for (int k = 0; k < 2; ++k) dst[n][k] = *(const PG8_LAS bf16x8*)(lds + PG8_SB(b, h) + boff + n * 2048 + k * 1024); } while (0)
#define PG8_MMA(ai, bj, At, Bt) do { __builtin_amdgcn_s_setprio(1); _Pragma("unroll") for (int m = 0; m < 4; ++m) _Pragma("unroll") for (int n = 0; n < 2; ++n) _Pragma("unroll") for (int k = 0; k < 2; ++k) \
        acc[ai][bj][m][n] = __builtin_amdgcn_mfma_f32_16x16x32_bf16(Bt[n][k], At[m][k], acc[ai][bj][m][n], 0, 0, 0); __builtin_amdgcn_s_setprio(0); } while (0)
#define PG8_WAIT_V(n) asm volatile("s_waitcnt vmcnt(" #n ")" ::: "memory")
#define PG8_WAIT_L(n) asm volatile("s_waitcnt lgkmcnt(" #n ")" ::: "memory")
#define PG8_BAR __builtin_amdgcn_s_barrier()
#define PG8_SCHED __builtin_amdgcn_sched_barrier(0)
    Unit cur, nxt; int ui = 0;
    if (!S.next(0, cur)) return;
    f32x4 acc[2][2][4][2];
#pragma unroll
    for (int a = 0; a < 2; ++a)
#pragma unroll
        for (int b = 0; b < 2; ++b)
#pragma unroll
            for (int m = 0; m < 4; ++m)
#pragma unroll
                for (int n = 0; n < 2; ++n) acc[a][b][m][n] = (f32x4){0.f, 0.f, 0.f, 0.f};
    bf16x8 At[4][2], B0[2][2], B1[2][2];
    const char* cA = (const char*)g.A + (size_t)cur.pm * tstepA + (size_t)cur.acol * 2; const char* cB = (const char*)g.Bt + (size_t)cur.pn * tstepB + (size_t)cur.bcol * 2;
#define PG8_KOFF(t) ((SEG > 0) ? (size_t)(((((t) / (SEG > 0 ? SEG : 1)) + g.kseg0) & (nt / (SEG > 0 ? SEG : 1) - 1)) * (SEG > 0 ? SEG : 1) + ((t) % (SEG > 0 ? SEG : 1))) * kstep : (size_t)(t) * kstep)
    const size_t K0 = PG8_KOFF(0);
    cA += K0; cB += K0;
    if constexpr (SP2) {
        PG8_STAGE(PG8_SB(0, 0), cB, voffB); PG8_STAGE(PG8_SB(0, 1), cB + hstepB, voffB); PG8_STAGE(PG8_SA(0, 0), cA, voffA); PG8_STAGE(PG8_SA(0, 1), cA + hstepA, voffA);
        if (wr == 1) PG8_BAR;
        PG8_WAIT_V(2); PG8_BAR;
        PG8_STAGE(PG8_SB(1, 0), cB + kstep, voffB); PG8_STAGE(PG8_SA(1, 0), cA + kstep, voffA); PG8_STAGE(PG8_SB(1, 1), cB + hstepB + kstep, voffB);
        PG8_WAIT_V(6); PG8_BAR;
    } else {
        PG8_STAGE(PG8_SB(0, 0), cB, voffB); PG8_STAGE(PG8_SA(0, 0), cA, voffA); PG8_STAGE(PG8_SB(0, 1), cB + hstepB, voffB); PG8_STAGE(PG8_SA(0, 1), cA + hstepA, voffA);
        if (wr == 1) PG8_BAR;
        PG8_WAIT_V(4); PG8_BAR;
        PG8_STAGE(PG8_SB(1, 0), cB + kstep, voffB); PG8_STAGE(PG8_SA(1, 0), cA + kstep, voffA); PG8_STAGE(PG8_SB(1, 1), cB + hstepB + kstep, voffB);
        PG8_WAIT_V(6); PG8_BAR;
    }
    for (;;) {
        const bool has_next = S.next(ui + 1, nxt);
        const char* nA = has_next ? (const char*)g.A + (size_t)nxt.pm * tstepA + (size_t)nxt.acol * 2 + K0 : cA; const char* nB = has_next ? (const char*)g.Bt + (size_t)nxt.pn * tstepB + (size_t)nxt.bcol * 2 + K0 : cB;
        for (int t = 0; t < nt; t += 2) {
            const bool last = (t == nt - 2);
            const char* a1 = cA - K0 + PG8_KOFF(t + 1);
            const char* a2 = last ? nA : cA - K0 + PG8_KOFF(t + 2); const char* b2 = last ? nB : cB - K0 + PG8_KOFF(t + 2);
            const char* a3 = a2 + kstep; const char* b3 = b2 + kstep;
            if constexpr (SP2) {
            PG8_LDB(B0, 0, 0); PG8_LDB(B1, 0, 1); PG8_SCHED; PG8_LDA(At, 0, 0); PG8_STAGE(PG8_SA(1, 1), a1 + hstepA, voffA);
            PG8_WAIT_V(8); PG8_WAIT_L(0); PG8_BAR; PG8_MMA(0, 0, At, B0); PG8_MMA(0, 1, At, B1); PG8_BAR; PG8_SCHED;
            PG8_LDA(At, 0, 1); PG8_STAGE(PG8_SB(0, 0), b2, voffB); PG8_STAGE(PG8_SB(0, 1), b2 + hstepB, voffB); PG8_STAGE(PG8_SA(0, 0), a2, voffA);
            PG8_WAIT_V(8); PG8_WAIT_L(0); PG8_BAR; PG8_MMA(1, 0, At, B0); PG8_MMA(1, 1, At, B1); PG8_BAR; PG8_SCHED;
            PG8_LDB(B0, 1, 0); PG8_LDB(B1, 1, 1); PG8_SCHED; PG8_LDA(At, 1, 0); PG8_STAGE(PG8_SA(0, 1), a2 + hstepA, voffA);
            PG8_WAIT_V(8); PG8_WAIT_L(0); PG8_BAR; PG8_MMA(0, 0, At, B0); PG8_MMA(0, 1, At, B1); PG8_BAR; PG8_SCHED;
            PG8_LDA(At, 1, 1); PG8_STAGE(PG8_SB(1, 0), b3, voffB); PG8_STAGE(PG8_SB(1, 1), b3 + hstepB, voffB); PG8_STAGE(PG8_SA(1, 0), a3, voffA);
            PG8_WAIT_V(8); PG8_WAIT_L(0); PG8_BAR; PG8_MMA(1, 0, At, B0); PG8_MMA(1, 1, At, B1); PG8_BAR; PG8_SCHED;
            } else {
            PG8_LDB(B0, 0, 0); PG8_SCHED; PG8_LDA(At, 0, 0); PG8_STAGE(PG8_SA(1, 1), a1 + hstepA, voffA);
            PG8_WAIT_L(8); PG8_BAR; PG8_WAIT_L(0); PG8_MMA(0, 0, At, B0); PG8_BAR; PG8_SCHED;
            PG8_LDB(B1, 0, 1); PG8_STAGE(PG8_SB(0, 0), b2, voffB);
            PG8_BAR; PG8_WAIT_L(0); PG8_MMA(0, 1, At, B1); PG8_BAR;
            PG8_LDA(At, 0, 1); PG8_STAGE(PG8_SA(0, 0), a2, voffA);
            PG8_BAR; PG8_WAIT_L(0); PG8_MMA(1, 0, At, B0); PG8_BAR; PG8_SCHED;
            PG8_STAGE(PG8_SB(0, 1), b2 + hstepB, voffB);
            PG8_WAIT_V(6); PG8_BAR; PG8_MMA(1, 1, At, B1); PG8_BAR;
            PG8_LDB(B0, 1, 0); PG8_SCHED; PG8_LDA(At, 1, 0); PG8_STAGE(PG8_SA(0, 1), a2 + hstepA, voffA);
            PG8_WAIT_L(8); PG8_BAR; PG8_WAIT_L(0); PG8_MMA(0, 0, At, B0); PG8_BAR; PG8_SCHED;
            PG8_LDB(B1, 1, 1); PG8_STAGE(PG8_SB(1, 0), b3, voffB);
            PG8_BAR; PG8_WAIT_L(0); PG8_MMA(0, 1, At, B1); PG8_BAR;
            PG8_LDA(At, 1, 1); PG8_STAGE(PG8_SA(1, 0), a3, voffA);
            PG8_BAR; PG8_WAIT_L(0); PG8_MMA(1, 0, At, B0); PG8_BAR; PG8_SCHED;
            PG8_STAGE(PG8_SB(1, 1), b3 + hstepB, voffB);
            PG8_WAIT_V(6); PG8_BAR; PG8_MMA(1, 1, At, B1); PG8_BAR;
            }
            if constexpr (SEG > 0) { if (((t + 2) % SEG) == 0 && (t + 2) < nt) E.mid(acc, cur, (t + 2) / SEG, g.kseg0); }
        }
        if constexpr (ALIGN_EPI) { if (wr == 0) PG8_BAR; }
        E(acc, cur, wr, wc, fr, fq);
        if (!has_next) break;
#pragma unroll
        for (int a = 0; a < 2; ++a)
#pragma unroll
            for (int b = 0; b < 2; ++b)
#pragma unroll
                for (int m = 0; m < 4; ++m)
#pragma unroll
                    for (int n = 0; n < 2; ++n) acc[a][b][m][n] = (f32x4){0.f, 0.f, 0.f, 0.f};
        cur = nxt; cA = nA; cB = nB; ++ui;
        if constexpr (ALIGN_EPI) { if (wr == 1) PG8_BAR; }
    }
    PG8_WAIT_V(0);
    if constexpr (!ALIGN_EPI) { if (wr == 0) PG8_BAR; }
    PG8_BAR;
#undef PG8_KOFF
#undef PG8_SA
#undef PG8_SB
#undef PG8_STAGE
#undef PG8_LDA
#undef PG8_LDB
#undef PG8_MMA
#undef PG8_WAIT_V
#undef PG8_WAIT_L
#undef PG8_BAR
#undef PG8_SCHED
}
}

constexpr int NWAVES = 8;
constexpr int D = 1024, DFF = 2816, NIN = 7184, NMIX = 3088, NMIXP = 3328, NGATE = 4096, NINP = NMIXP + NGATE;
constexpr int SEQ = 4096, NMETA = 16, L = SEQ + NMETA, BATCH = 4, DB = 32, DS = 8, PAST = 8192, PAGE = 128, NPAGES = PAST / PAGE, NPOOL = 2560, DEPTH = 2;
constexpr int MP = BATCH * L, MS = DB * DS, MR = MP + MS, M = 16896;
constexpr int NPOS = L + DS;
constexpr float EPS = 1e-6f;
constexpr int C_A = 0, C_G = 256, R_Q = 512, R_K = 768, R_V = 1024, R_G = 1280, G_Q = 1536, G_K = 1664, G_V = 1792, G_R = 2048, G_LOW = 2304, D_Q = 2320, D_K = 2576, D_V = 2832;
constexpr size_t O_YP = 0, O_YS = O_YP + (size_t)BATCH * SEQ * D, O_KP = O_YS + (size_t)MS * D, O_VP = O_KP + (size_t)DEPTH * MP * 256, O_KS = O_VP + (size_t)DEPTH * MP * 256,
                 O_VS = O_KS + (size_t)DEPTH * MS * 256, O_RP = O_VS + (size_t)DEPTH * MS * 256, O_RS = O_RP + (size_t)DEPTH * BATCH * 4 * 64 * 64, O_GP = O_RS + (size_t)DEPTH * DB * 4 * 64 * 64,
                 O_GS = O_GP + (size_t)DEPTH * BATCH * 4 * 32 * 64, O_CP = O_GS + (size_t)DEPTH * DB * 4 * 32 * 64, O_CS = O_CP + (size_t)DEPTH * BATCH * 30 * 256, O_END = O_CS + (size_t)DEPTH * DB * 30 * 256;
enum { I_XP = 0, I_XS, I_CK, I_CV, I_PT, I_SRET, I_SGLA, I_SCONV, I_META, I_RELB, I_NF1, I_F1G, I_F1U, I_F1D, I_NMIX, I_WIN, I_BIN, I_CW, I_CB, I_CLG, I_CLB, I_RGN, I_GAW, I_GAB, I_GGN,
       I_QN, I_KN, I_LQ1, I_LK1, I_LQ2, I_LK2, I_SUBLN, I_WBR, I_WOUT, I_NF2, I_F2G, I_F2U, I_F2D, N_INPUTS };

constexpr size_t MiB = 1u << 20;
constexpr size_t WS_CTL = 0, CTL_ZERO_BYTES = 1 * MiB;
constexpr size_t SZ_SS = (size_t)M * 16 * 4;
constexpr size_t SZ_W1 = (size_t)2 * DFF * D * 2, SZ_WD = (size_t)D * DFF * 2, SZ_WIN = (size_t)NINP * D * 2, SZ_WBR = (size_t)4 * D * 256 * 2, SZ_WOUT = (size_t)D * D * 2;
constexpr size_t WS_W1 = 4 * MiB;
constexpr size_t WS_WD = WS_W1 + 4 * SZ_W1;
constexpr size_t WS_WIN = WS_WD + 4 * SZ_WD;
constexpr size_t WS_WBR = WS_WIN + 2 * SZ_WIN;
constexpr size_t WS_WOUT = WS_WBR + 2 * SZ_WBR;
constexpr size_t WS_BINP = WS_WOUT + 2 * SZ_WOUT;
constexpr size_t WS_ROPE = WS_BINP + 64 * 1024;
constexpr size_t WS_SS = WS_ROPE + 2 * MiB;
constexpr size_t WS_H = 128 * MiB;
constexpr size_t WS_HB = WS_H + (size_t)M * D * 4;
constexpr size_t WS_ACT = WS_HB + (size_t)M * D * 2;
constexpr size_t WS_ZMIX = WS_ACT + (size_t)M * DFF * 2;
constexpr size_t WS_GATES = WS_ZMIX + (size_t)M * NMIXP * 2;
constexpr size_t WS_BR = WS_GATES + (size_t)M * NGATE * 2;
constexpr size_t WS_MERGED = WS_BR + (size_t)M * D * 2;
constexpr size_t WS_UBUF = WS_MERGED + (size_t)M * D * 2;
constexpr size_t WS_RQ = WS_UBUF + (size_t)M * 256 * 4, WS_RK = WS_RQ + (size_t)M * 256 * 4, WS_QN = WS_RK + (size_t)M * 256 * 4, WS_KN = WS_QN + (size_t)M * 256 * 4, WS_VB = WS_KN + (size_t)M * 256 * 4;
constexpr size_t WS_LDEC = WS_VB + (size_t)M * 256 * 4;
constexpr size_t WS_QNB = WS_LDEC + (size_t)M * 128 * 4;
constexpr size_t WS_KNB = WS_QNB + (size_t)M * 256 * 2;
constexpr size_t WS_PART = WS_KNB + (size_t)M * 256 * 2;
constexpr size_t WS_LAO = WS_PART + (size_t)DB * 4 * 16 * 16 * 68 * 4;
constexpr size_t WS_KSP = WS_LAO + (size_t)M * 512 * 4;
constexpr size_t WS_END = WS_KSP + (size_t)8 * 11 * 65536 * 4;
static_assert(WS_ROPE + 2 * NPOS * 32 * 4 <= WS_SS && WS_SS + 6 * SZ_SS <= WS_H, "weights region overflows");
constexpr int CW_BAR = 4096, CW_QUEUE = 8192;

constexpr int RING_OFF = 0, RING_BYTES = 131072;
constexpr int LDSCTL_OFF = 144384, MISC_OFF = LDSCTL_OFF + 320;
constexpr int LDS_BYTES = 147456;
static_assert(MISC_OFF + 128 <= LDS_BYTES, "LDS map");

#define GAS __attribute__((address_space(1)))
#define LAS __attribute__((address_space(3)))
typedef unsigned short bf16;
typedef unsigned v4u __attribute__((ext_vector_type(4)));
typedef float f32x4 __attribute__((ext_vector_type(4)));
#define LDS_WAIT() asm volatile("s_waitcnt lgkmcnt(0)" ::: "memory")
#define VM_WAIT() asm volatile("s_waitcnt vmcnt(0)" ::: "memory")
__device__ __forceinline__ unsigned f2bf(float f) { unsigned u = __builtin_bit_cast(unsigned, f); return (u + 0x7fffu + ((u >> 16) & 1u)) >> 16; }
__device__ __forceinline__ unsigned pk2(float lo, float hi) { return f2bf(lo) | (f2bf(hi) << 16); }
__device__ __forceinline__ float bf2f(bf16 b) { return __builtin_bit_cast(float, ((unsigned)b) << 16); }
__device__ __forceinline__ float bflo(unsigned w) { return __builtin_bit_cast(float, w << 16); }
__device__ __forceinline__ float bfhi(unsigned w) { return __builtin_bit_cast(float, w & 0xffff0000u); }
__device__ __forceinline__ float wave_sum(float v) {
#pragma unroll
    for (int o = 1; o < 64; o <<= 1) v += __shfl_xor(v, o);
    return v;
}
__device__ __forceinline__ float sigmoidf_(float x) { return __builtin_amdgcn_rcpf(1.0f + __expf(-x)); }
__device__ __forceinline__ float siluf_(float x) { return x * __builtin_amdgcn_rcpf(1.0f + __expf(-x)); }

#define XB_TMO      128
#define XB_XCNT(j)  (256  + 64 * (j))
#define XB_XSUB(j)  (1280 + 64 * (j))
#define XB_XGEN(j)  (2304 + 64 * (j))
#define XB_TOP      3328
#define XB_TOPGEN   3392
#define XCD_BAR_WORDS 3456
#define XB_SPIN_CAP (1u << 22)

__device__ __forceinline__ unsigned xb_ld(unsigned* p)              { return __hip_atomic_load(p, __ATOMIC_RELAXED, __HIP_MEMORY_SCOPE_AGENT); }
__device__ __forceinline__ unsigned xb_add(unsigned* p, unsigned v) { return __hip_atomic_fetch_add(p, v, __ATOMIC_RELAXED, __HIP_MEMORY_SCOPE_AGENT); }
__device__ __forceinline__ unsigned xb_xcc_id() { return (unsigned)__builtin_amdgcn_s_getreg((3 << 11) | 20) & 0xFu; }
#define XB_SPIN(cond, bar) do { unsigned _sp = 0; while (cond) { __builtin_amdgcn_s_sleep(1); \
    if ((++_sp & 255u) == 0u) { if (xb_ld(&(bar)[XB_TMO])) break; if (_sp > XB_SPIN_CAP) { atomicAdd(&(bar)[XB_TMO], 1u); break; } } } } while (0)

struct XcdBarrier { unsigned* bar; unsigned x; volatile LAS unsigned* st; };

__device__ __forceinline__ XcdBarrier xcd_barrier_post(unsigned* bar, volatile LAS unsigned* st) {
    XcdBarrier b; b.bar = bar; b.x = xb_xcc_id(); b.st = st;
    if (threadIdx.x == 0) (void)xb_add(&bar[XB_XCNT(b.x)], 1u);
    return b;
}
__device__ __forceinline__ void xcd_barrier_complete(unsigned* bar, unsigned x, unsigned& nloc, unsigned& nx) {
    const unsigned G = gridDim.x * gridDim.y * gridDim.z;
    unsigned sum, cnt, mine, sp = 0u;
    for (;;) {
        sum = 0u; cnt = 0u; mine = 0u;
#pragma unroll
        for (unsigned j = 0; j < 16; ++j) { const unsigned c = xb_ld(&bar[XB_XCNT(j)]); sum += c; cnt += (c > 0u) ? 1u : 0u; mine = (j == x) ? c : mine; }
        if (sum == G) break;
        __builtin_amdgcn_s_sleep(1);
        if ((++sp & 255u) == 0u) { if (xb_ld(&bar[XB_TMO])) break; if (sp > XB_SPIN_CAP) { atomicAdd(&bar[XB_TMO], 1u); break; } }
    }
    nloc = mine > 0u ? mine : 1u; nx = cnt > 0u ? cnt : 1u;
}
#ifndef FLAT_BAR
#define FLAT_BAR 0
#endif
__device__ __forceinline__ void flat_barrier(const XcdBarrier& b) {
    asm volatile("s_waitcnt vmcnt(0)" ::: "memory");
    __syncthreads();
    if (threadIdx.x == 0) {
        unsigned* bar = b.bar;
        asm volatile("" : "+s"(bar));
        const unsigned epoch = b.st[2] + 1u; b.st[2] = epoch; const unsigned target = epoch * gridDim.x;
        __builtin_amdgcn_fence(__ATOMIC_RELEASE, "agent");
        asm volatile("s_waitcnt vmcnt(0)" ::: "memory");
        (void)xb_add(&bar[XB_TOP], 1u);
        unsigned sp = 0u;
        while (xb_ld(&bar[XB_TOP]) < target) { __builtin_amdgcn_s_sleep(1); if ((++sp & 255u) == 0u) { if (xb_ld(&bar[XB_TMO])) break; if (sp > XB_SPIN_CAP) { atomicAdd(&bar[XB_TMO], 1u); break; } } }
        __builtin_amdgcn_fence(__ATOMIC_ACQUIRE, "agent");
        asm volatile("s_waitcnt vmcnt(0)" ::: "memory");
    }
    __syncthreads();
}
template <bool FIRST> __device__ __forceinline__ void xcd_barrier(const XcdBarrier& b) {
    if (FLAT_BAR) { flat_barrier(b); return; }
    asm volatile("s_waitcnt vmcnt(0)" ::: "memory");
    __syncthreads();
    if (threadIdx.x == 0) {
        unsigned* bar = b.bar;
        asm volatile("" : "+s"(bar));
        __builtin_amdgcn_s_waitcnt(0);
        unsigned nloc = b.st[0], nx = b.st[1];
        if (FIRST) { if (nloc == 0u) { xcd_barrier_complete(bar, b.x, nloc, nx); b.st[0] = nloc; b.st[1] = nx; } }
        const unsigned old = xb_add(&bar[XB_XSUB(b.x)], 1u);
        const unsigned gen = old / nloc;
        if (old + 1u == (gen + 1u) * nloc) {
            __builtin_amdgcn_fence(__ATOMIC_RELEASE, "agent");
            asm volatile("s_waitcnt vmcnt(0)" ::: "memory");
            const unsigned og = xb_add(&bar[XB_TOP], 1u);
            const unsigned tg = og / nx;
            if (og + 1u == (tg + 1u) * nx) xb_add(&bar[XB_TOPGEN], 1u);
            else XB_SPIN(xb_ld(&bar[XB_TOPGEN]) == tg, bar);
            __builtin_amdgcn_fence(__ATOMIC_ACQUIRE, "agent");
            xb_add(&bar[XB_XGEN(b.x)], 1u);
            asm volatile("s_waitcnt vmcnt(0)" ::: "memory");
        } else {
            XB_SPIN(xb_ld(&bar[XB_XGEN(b.x)]) == gen, bar);
            __builtin_amdgcn_fence(__ATOMIC_ACQUIRE, "agent");
            asm volatile("s_waitcnt vmcnt(0)" ::: "memory");
        }
    }
    __syncthreads();
}

struct Params { const float* in[N_INPUTS]; float* out; unsigned char* ws; float inv_freq[32]; };
static_assert(sizeof(Params) == N_INPUTS * 8 + 16 + 128, "Params has no padding");

struct Ctx {
    const float* const* in; float* out; unsigned char* ws;
    LAS unsigned char* lds;
    int G;
};
#define THREAD_IDS() int tid_ = threadIdx.x; asm volatile("" : "+v"(tid_)); const int tid = tid_, lane = tid & 63, wave = __builtin_amdgcn_readfirstlane(tid >> 6), gw = blockIdx.x * NWAVES + wave, NGW = C.G * NWAVES; (void)tid; (void)lane; (void)wave; (void)gw; (void)NGW
#define WSP(T, off) ((T*)(C.ws + (off)))

__device__ __forceinline__ float rstd_of(const float* ssp, int row) {
    const f32x4 a = *(const f32x4*)(ssp + (size_t)row * 16), b = *(const f32x4*)(ssp + (size_t)row * 16 + 4), c = *(const f32x4*)(ssp + (size_t)row * 16 + 8), d = *(const f32x4*)(ssp + (size_t)row * 16 + 12);
    const float s = (((a[0] + a[1]) + (a[2] + a[3])) + ((b[0] + b[1]) + (b[2] + b[3]))) + (((c[0] + c[1]) + (c[2] + c[3])) + ((d[0] + d[1]) + (d[2] + d[3])));
    return rsqrtf(s * (1.0f / D) + EPS);
}
#define EPI_IDS() int t_ = threadIdx.x; asm volatile("" : "+v"(t_)); const int wid_ = __builtin_amdgcn_readfirstlane(t_ >> 6), wr = wid_ >> 2, wc = wid_ & 3, fr = t_ & 15, fq = (t_ & 63) >> 4
struct EpiGLU {
    static constexpr bool PERM = true;
    bf16* act; const float* ss;
    __device__ __forceinline__ void operator()(const pg8::f32x4 (&acc)[2][2][4][2], const pg8::Unit& u, int, int, int, int) const {
        EPI_IDS();
        const int row0 = u.pm * 256 + wr * 64 + fr, col0 = u.pn * 128 + wc * 32 + 8 * fq;
#pragma unroll
        for (int ai = 0; ai < 2; ++ai)
#pragma unroll
            for (int m = 0; m < 4; ++m) {
                const int row = row0 + ai * 128 + m * 16; const float rstd = rstd_of(ss, row);
                float o[8];
#pragma unroll
                for (int n = 0; n < 2; ++n)
#pragma unroll
                    for (int j = 0; j < 4; ++j) { const float g = acc[ai][0][m][n][j] * rstd, up = acc[ai][1][m][n][j] * rstd; o[n * 4 + j] = siluf_(g) * up; }
                v4u w; w.x = pg8::cvt_pk_bf16(o[0], o[1]); w.y = pg8::cvt_pk_bf16(o[2], o[3]); w.z = pg8::cvt_pk_bf16(o[4], o[5]); w.w = pg8::cvt_pk_bf16(o[6], o[7]);
                *(v4u*)(act + (size_t)row * DFF + col0) = w;
            }
    }
};
template <bool FINAL, int SCALE2> struct EpiRes {
    static constexpr bool PERM = true;
    float* h; bf16* hb; float* ssout; float* out;
    __device__ __forceinline__ void rowgroup(const pg8::f32x4 (&a)[2][2], int row, int col0, int pn, int wc, int fq) const {
        constexpr float scale = 0.5f * SCALE2; float sq = 0.f;
        long yoff = -1;
        if (FINAL) { if (row < MP) { const int b = row / L, pos = row - b * L; if (pos >= NMETA) yoff = (long)O_YP + ((long)b * SEQ + (pos - NMETA)) * D; } else if (row < MR) yoff = (long)O_YS + (long)(row - MP) * D; }
#pragma unroll
        for (int bj = 0; bj < 2; ++bj) {
            const size_t off = (size_t)row * D + col0 + bj * 128;
            f32x4 h0 = *(const f32x4*)(h + off), h1 = *(const f32x4*)(h + off + 4);
            h0 = h0 + a[bj][0] * scale; h1 = h1 + a[bj][1] * scale;
            *(f32x4*)(h + off) = h0; *(f32x4*)(h + off + 4) = h1;
            v4u w; w.x = pg8::cvt_pk_bf16(h0[0], h0[1]); w.y = pg8::cvt_pk_bf16(h0[2], h0[3]); w.z = pg8::cvt_pk_bf16(h1[0], h1[1]); w.w = pg8::cvt_pk_bf16(h1[2], h1[3]);
            *(v4u*)(hb + off) = w;
            sq += (h0[0] * h0[0] + h0[1] * h0[1]) + (h0[2] * h0[2] + h0[3] * h0[3]) + (h1[0] * h1[0] + h1[1] * h1[1]) + (h1[2] * h1[2] + h1[3] * h1[3]);
            if (FINAL && yoff >= 0) { *(f32x4*)(out + yoff + col0 + bj * 128) = h0; *(f32x4*)(out + yoff + col0 + bj * 128 + 4) = h1; }
        }
        sq += __shfl_xor(sq, 16); sq += __shfl_xor(sq, 32);
        if (fq == 0 && ssout) ssout[(size_t)row * 16 + pn * 4 + wc] = sq;
    }
    __device__ __forceinline__ void operator()(const pg8::f32x4 (&acc)[2][2][4][2], const pg8::Unit& u, int, int, int, int) const {
        EPI_IDS();
        const int row0 = u.pm * 256 + wr * 64 + fr, col0 = u.pn * 256 + wc * 32 + 8 * fq;
#pragma unroll
        for (int ai = 0; ai < 2; ++ai)
#pragma unroll
            for (int m = 0; m < 4; ++m) {
                const pg8::f32x4 a[2][2] = {{acc[ai][0][m][0], acc[ai][0][m][1]}, {acc[ai][1][m][0], acc[ai][1][m][1]}};
                rowgroup(a, row0 + ai * 128 + m * 16, col0, u.pn, wc, fq);
                if (m == 3) asm volatile("" ::: "memory");
            }
    }
};
struct EpiZ {
    static constexpr bool PERM = true;
    bf16* zmix; bf16* gates; const float* ss; const float* bias;
    __device__ __forceinline__ void operator()(const pg8::f32x4 (&acc)[2][2][4][2], const pg8::Unit& u, int, int, int, int) const {
        EPI_IDS();
        const int row0 = u.pm * 256 + wr * 64 + fr, col0 = u.pn * 256 + wc * 32 + 8 * fq; const bool isgate = u.pn >= NMIXP / 256;
        f32x4 bv[2][2];
#pragma unroll
        for (int bj = 0; bj < 2; ++bj)
#pragma unroll
            for (int n = 0; n < 2; ++n) bv[bj][n] = *(const f32x4*)(bias + col0 + bj * 128 + 4 * n);
#pragma unroll
        for (int ai = 0; ai < 2; ++ai)
#pragma unroll
            for (int m = 0; m < 4; ++m) {
                const int row = row0 + ai * 128 + m * 16; const float rstd = rstd_of(ss, row);
                if (isgate) {
                    f32x4 g[4];
#pragma unroll
                    for (int bj = 0; bj < 2; ++bj)
#pragma unroll
                        for (int n = 0; n < 2; ++n) { const f32x4 z = acc[ai][bj][m][n] * rstd + bv[bj][n];
#pragma unroll
                            for (int j = 0; j < 4; ++j) g[2 * bj + n][j] = fmaxf(sigmoidf_(z[j]), 9.094947017729282e-13f); }
                    const int d0 = 64 * (u.pn - NMIXP / 256) + 16 * wc + 4 * fq; bf16* gp = gates + (size_t)row * NGATE + d0;
#pragma unroll
                    for (int s = 0; s < 4; ++s) { f32x4 o = g[s];
                        if (s < 3) {
#pragma unroll
                            for (int j = 0; j < 4; ++j) o[j] = g[s][j] * __builtin_amdgcn_rcpf(g[s + 1][j]); }
                        *(unsigned long long*)(gp + s * D) = (unsigned long long)pg8::cvt_pk_bf16(o[0], o[1]) | ((unsigned long long)pg8::cvt_pk_bf16(o[2], o[3]) << 32); }
                } else {
#pragma unroll
                    for (int bj = 0; bj < 2; ++bj) {
                        const f32x4 v0 = acc[ai][bj][m][0] * rstd + bv[bj][0], v1 = acc[ai][bj][m][1] * rstd + bv[bj][1];
                        v4u w; w.x = pg8::cvt_pk_bf16(v0[0], v0[1]); w.y = pg8::cvt_pk_bf16(v0[2], v0[3]); w.z = pg8::cvt_pk_bf16(v1[0], v1[1]); w.w = pg8::cvt_pk_bf16(v1[2], v1[3]);
                        *(v4u*)(zmix + (size_t)row * NMIXP + col0 + bj * 128) = w;
                    }
                }
            }
    }
};
struct EpiPartial {
    static constexpr bool PERM = true;
    float* part;
    __device__ __forceinline__ void operator()(const pg8::f32x4 (&acc)[2][2][4][2], const pg8::Unit& u, int, int, int, int) const {
        int t_ = threadIdx.x; asm volatile("" : "+v"(t_));
        const int slot = blockIdx.x;
        float* p = part + (size_t)slot * 65536 + (size_t)t_ * 4;
#pragma unroll
        for (int ai = 0; ai < 2; ++ai)
#pragma unroll
            for (int bj = 0; bj < 2; ++bj)
#pragma unroll
                for (int m = 0; m < 4; ++m)
#pragma unroll
                    for (int n = 0; n < 2; ++n) *(pg8::f32x4*)(p + (size_t)((((ai * 2 + bj) * 4 + m) * 2 + n) * 2048)) = acc[ai][bj][m][n];
        (void)u;
    }
};
template <int NSPLIT, class Epi> __device__ __forceinline__ void ksp_finalize(const float* part, const pg8::StaticOrder& so, int limit, const Epi& E) {
    const int ntail = so.nwg - limit;
    for (int it = blockIdx.x; it < ntail * 8; it += gridDim.x) {
        const int tt = it >> 3, ai = (it >> 2) & 1, m = it & 3;
        EPI_IDS();
        pg8::f32x4 a[2][2];
#pragma unroll
        for (int bj = 0; bj < 2; ++bj)
#pragma unroll
            for (int n = 0; n < 2; ++n) { pg8::f32x4 s = {0.f, 0.f, 0.f, 0.f};
#pragma unroll
                for (int k = 0; k < NSPLIT; ++k) s = s + *(const pg8::f32x4*)(part + (size_t)(tt * NSPLIT + k) * 65536 + (size_t)((((ai * 2 + bj) * 4 + m) * 2 + n) * 2048) + (size_t)t_ * 4);
                a[bj][n] = s; }
        pg8::Unit u; so.unit_of(limit + tt, u);
        E.rowgroup(a, u.pm * 256 + wr * 64 + fr + ai * 128 + m * 16, u.pn * 256 + wc * 32 + 8 * fq, u.pn, wc, fq);
    }
}

struct EpiMergeR {
    static constexpr bool PERM = true;
    bf16* merged; const bf16* gates;
    __device__ __forceinline__ void mid(pg8::f32x4 (&acc)[2][2][4][2], const pg8::Unit& u, int seg, int) const {
        EPI_IDS();
        const int row0 = u.pm * 256 + wr * 64 + fr, col0 = u.pn * 256 + wc * 32 + 8 * fq;
#pragma unroll
        for (int ai = 0; ai < 2; ++ai) {
#pragma unroll
            for (int m = 0; m < 4; ++m) {
                const int row = row0 + ai * 128 + m * 16;
#pragma unroll
                for (int bj = 0; bj < 2; ++bj) {
                    const v4u r = *(const v4u*)(gates + (size_t)row * NGATE + (seg - 1) * D + col0 + bj * 128);
                    pg8::f32x4& a0 = acc[ai][bj][m][0]; pg8::f32x4& a1 = acc[ai][bj][m][1];
                    a0[0] *= bflo(r.x); a0[1] *= bfhi(r.x); a0[2] *= bflo(r.y); a0[3] *= bfhi(r.y); a1[0] *= bflo(r.z); a1[1] *= bfhi(r.z); a1[2] *= bflo(r.w); a1[3] *= bfhi(r.w);
                }
            }
        }
    }
    __device__ __forceinline__ void operator()(const pg8::f32x4 (&acc)[2][2][4][2], const pg8::Unit& u, int, int, int, int) const {
        EPI_IDS();
        const int row0 = u.pm * 256 + wr * 64 + fr, col0 = u.pn * 256 + wc * 32 + 8 * fq;
#pragma unroll
        for (int ai = 0; ai < 2; ++ai)
#pragma unroll
            for (int m = 0; m < 4; ++m) {
                const int row = row0 + ai * 128 + m * 16;
#pragma unroll
                for (int bj = 0; bj < 2; ++bj) {
                    const v4u g = *(const v4u*)(gates + (size_t)row * NGATE + 3 * D + col0 + bj * 128);
                    const pg8::f32x4 a0 = acc[ai][bj][m][0], a1 = acc[ai][bj][m][1];
                    v4u w; w.x = pg8::cvt_pk_bf16(a0[0] * bflo(g.x), a0[1] * bfhi(g.x)); w.y = pg8::cvt_pk_bf16(a0[2] * bflo(g.y), a0[3] * bfhi(g.y));
                    w.z = pg8::cvt_pk_bf16(a1[0] * bflo(g.z), a1[1] * bfhi(g.z)); w.w = pg8::cvt_pk_bf16(a1[2] * bflo(g.w), a1[3] * bfhi(g.w));
                    *(v4u*)(merged + (size_t)row * D + col0 + bj * 128) = w;
                }
            }
    }
};

__host__ __device__ __forceinline__ int gate_col(int m) { const int br = m >> 10, d = m & 1023, dd = d & 63; return 256 * (d >> 6) + 128 * (br >> 1) + 32 * (dd >> 4) + 8 * ((dd >> 2) & 3) + 4 * (br & 1) + (dd & 3); }
__host__ __device__ __forceinline__ int gate_src(int c) { const int ct = c & 255, br = 2 * (ct >> 7) + ((ct >> 2) & 1), d = 64 * (c >> 8) + 16 * ((ct >> 5) & 3) + 4 * ((ct >> 3) & 3) + (ct & 3); return br * 1024 + d; }
struct RowMap { int mode, a; __device__ __forceinline__ int operator()(int n) const { return mode == 0 ? n + a : (mode == 1 ? 256 * (n >> 7) + (n & 127) + a : (n < NMIX ? n : NMIXP + gate_col(n - NMIX))); } };
__device__ __forceinline__ void tr_item(const float* W, int K, int N, const float* gain, bf16* WT, int pitch, RowMap rm, LAS float* scr, int kb, int nb, int lane) {
    const int k0 = 64 * kb, n0 = 64 * nb; const int nn = n0 + 4 * (lane & 15), kr = lane >> 4;
    f32x4 v[16];
#pragma unroll
    for (int i = 0; i < 16; ++i) v[i] = (nn < N) ? *(const f32x4*)(W + (size_t)(k0 + 4 * i + kr) * N + nn) : (f32x4){0.f, 0.f, 0.f, 0.f};
#pragma unroll
    for (int i = 0; i < 16; ++i) { const int kk = 4 * i + kr; const float g = gain ? gain[k0 + kk] : 1.0f; LAS float* d = scr + kk * 65 + 4 * (lane & 15); d[0] = v[i][0] * g; d[1] = v[i][1] * g; d[2] = v[i][2] * g; d[3] = v[i][3] * g; }
    LDS_WAIT(); asm volatile("" ::: "memory");
    const int c = lane & 7;
#pragma unroll
    for (int j = 0; j < 8; ++j) { const int nl = (lane >> 3) + 8 * j; const int n = n0 + nl; const LAS float* s = scr + (8 * c) * 65 + nl;
        v4u o; o.x = pg8::cvt_pk_bf16(s[0 * 65], s[1 * 65]); o.y = pg8::cvt_pk_bf16(s[2 * 65], s[3 * 65]); o.z = pg8::cvt_pk_bf16(s[4 * 65], s[5 * 65]); o.w = pg8::cvt_pk_bf16(s[6 * 65], s[7 * 65]);
        if (n < N) *(v4u*)(WT + (size_t)rm(n) * pitch + k0 + 8 * c) = o; }
    LDS_WAIT(); asm volatile("" ::: "memory");
}
__device__ __forceinline__ void p0_prologue(const Ctx& C, const Params& P) {
    THREAD_IDS();
    LAS float* scr = (LAS float*)(C.lds + RING_OFF + wave * 16896);
    constexpr int I_FF = 16 * 44, I_DN = 44 * 16, I_IN = 16 * 113, I_BR = 4 * 4 * 16, I_OUT = 16 * 16;
    constexpr int PER_LAYER = 4 * I_FF + 2 * I_DN + I_IN + I_BR + I_OUT;
    for (int it = gw; it < DEPTH * PER_LAYER; it += NGW) {
        const int l = it / PER_LAYER; int r = it - l * PER_LAYER;
        bf16* W1a = WSP(bf16, WS_W1 + (size_t)(l * 2 + 0) * SZ_W1); bf16* W1b = WSP(bf16, WS_W1 + (size_t)(l * 2 + 1) * SZ_W1);
        bf16* Wda = WSP(bf16, WS_WD + (size_t)(l * 2 + 0) * SZ_WD); bf16* Wdb = WSP(bf16, WS_WD + (size_t)(l * 2 + 1) * SZ_WD);
        if (r < I_FF) { tr_item(C.in[I_F1G] + (size_t)l * D * DFF, D, DFF, C.in[I_NF1] + l * D, W1a, D, RowMap{1, 0}, scr, r / 44, r % 44, lane); continue; } r -= I_FF;
        if (r < I_FF) { tr_item(C.in[I_F1U] + (size_t)l * D * DFF, D, DFF, C.in[I_NF1] + l * D, W1a, D, RowMap{1, 128}, scr, r / 44, r % 44, lane); continue; } r -= I_FF;
        if (r < I_DN) { tr_item(C.in[I_F1D] + (size_t)l * D * DFF, DFF, D, nullptr, Wda, DFF, RowMap{0, 0}, scr, r / 16, r % 16, lane); continue; } r -= I_DN;
        if (r < I_FF) { tr_item(C.in[I_F2G] + (size_t)l * D * DFF, D, DFF, C.in[I_NF2] + l * D, W1b, D, RowMap{1, 0}, scr, r / 44, r % 44, lane); continue; } r -= I_FF;
        if (r < I_FF) { tr_item(C.in[I_F2U] + (size_t)l * D * DFF, D, DFF, C.in[I_NF2] + l * D, W1b, D, RowMap{1, 128}, scr, r / 44, r % 44, lane); continue; } r -= I_FF;
        if (r < I_DN) { tr_item(C.in[I_F2D] + (size_t)l * D * DFF, DFF, D, nullptr, Wdb, DFF, RowMap{0, 0}, scr, r / 16, r % 16, lane); continue; } r -= I_DN;
        if (r < I_IN) { tr_item(C.in[I_WIN] + (size_t)l * D * NIN, D, NIN, C.in[I_NMIX] + l * D, WSP(bf16, WS_WIN + (size_t)l * SZ_WIN), D, RowMap{2, 0}, scr, r / 113, r % 113, lane); continue; } r -= I_IN;
        if (r < I_BR) { const int n4 = r / 64, rr = r % 64; tr_item(C.in[I_WBR] + (size_t)(l * 4 + n4) * 256 * D, 256, D, nullptr, WSP(bf16, WS_WBR + (size_t)l * SZ_WBR) + n4 * 256, D, RowMap{0, 0}, scr, rr / 16, rr % 16, lane); continue; } r -= I_BR;
        tr_item(C.in[I_WOUT] + (size_t)l * D * D, D, D, nullptr, WSP(bf16, WS_WOUT + (size_t)l * SZ_WOUT), D, RowMap{0, 0}, scr, r / 16, r % 16, lane);
    }
    const int gt = gw * 64 + lane, NGT = NGW * 64;
    for (int i = gt; i < 2 * 240 * 128; i += NGT) { const int l = i / (240 * 128), r = i % (240 * 128); *(v4u*)(C.ws + WS_WIN + (size_t)l * SZ_WIN + ((size_t)NMIX * D) * 2 + (size_t)r * 16) = (v4u){0u, 0u, 0u, 0u}; }
    for (int i = gt; i < (M - MR) * 128; i += NGT) *(v4u*)(C.ws + WS_BR + (size_t)MR * D * 2 + (size_t)i * 16) = (v4u){0u, 0u, 0u, 0u};
    for (int i = gt; i < 2 * NINP; i += NGT) { const int l = i / NINP, j = i % NINP; float v = 0.f; if (j < NMIX) v = C.in[I_BIN][l * NIN + j]; else if (j >= NMIXP) v = C.in[I_BIN][l * NIN + NMIX + gate_src(j - NMIXP)]; WSP(float, WS_BINP)[i] = v; }
    for (int i = gt; i < NPOS * 32; i += NGT) { const int pi = i >> 5, fi = i & 31; const int pos = pi < L ? pi : PAST + (pi - L);
        const float angf = (float)pos * P.inv_freq[fi];
        const double a = (double)angf; const double k = rint(a * 0.15915494309189535); const double rr = (a - k * 6.283185307179586) - k * 2.4492935982947064e-16;
        const float rf = (float)rr; WSP(float, WS_ROPE)[i] = cosf(rf); WSP(float, WS_ROPE)[NPOS * 32 + i] = sinf(rf); }
    float* H = WSP(float, WS_H); bf16* HB = WSP(bf16, WS_HB); float* SS0 = WSP(float, WS_SS);
    for (int row = gw; row < M; row += NGW) {
        const float* src = nullptr;
        if (row < MP) { const int b = row / L, pos = row - b * L; src = pos < NMETA ? C.in[I_META] + (size_t)pos * D : C.in[I_XP] + ((size_t)b * SEQ + (pos - NMETA)) * D; }
        else if (row < MR) src = C.in[I_XS] + (size_t)(row - MP) * D;
        float s = 0.f;
#pragma unroll
        for (int j = 0; j < 4; ++j) { f32x4 v = src ? *(const f32x4*)(src + 256 * j + 4 * lane) : (f32x4){0.f, 0.f, 0.f, 0.f};
            *(f32x4*)(H + (size_t)row * D + 256 * j + 4 * lane) = v; s += (v[0] * v[0] + v[1] * v[1]) + (v[2] * v[2] + v[3] * v[3]);
            unsigned long long w = (unsigned long long)pk2(v[0], v[1]) | ((unsigned long long)pk2(v[2], v[3]) << 32);
            *(unsigned long long*)(HB + (size_t)row * D + 256 * j + 4 * lane) = w; }
        s = wave_sum(s); if (lane < 16) SS0[(size_t)row * 16 + lane] = lane == 0 ? s : 0.f;
    }
}

__device__ __forceinline__ float lam_of(const Ctx& C, int l, float lam_init) {
    THREAD_IDS();
    float a = 0.f, b = 0.f;
#pragma unroll 1
    for (int i = 0; i < 32; ++i) { a += C.in[I_LQ1][l * 32 + i] * C.in[I_LK1][l * 32 + i]; b += C.in[I_LQ2][l * 32 + i] * C.in[I_LK2][l * 32 + i]; }
    return __expf(a) - __expf(b) + lam_init;
}
__device__ __forceinline__ int t5_bucket(int n) {
    if (n < 16) return n;
    return 16 + (n >= 19) + (n >= 21) + (n >= 24) + (n >= 27) + (n >= 31) + (n >= 35) + (n >= 40) + (n >= 46) + (n >= 52) + (n >= 59) + (n >= 67) + (n >= 77) + (n >= 87) + (n >= 99) + (n >= 113);
}
__device__ __forceinline__ void unpack8(const v4u w, float (&x)[8]) { x[0] = bflo(w.x); x[1] = bfhi(w.x); x[2] = bflo(w.y); x[3] = bfhi(w.y); x[4] = bflo(w.z); x[5] = bfhi(w.z); x[6] = bflo(w.w); x[7] = bfhi(w.w); }
__device__ __forceinline__ v4u pack8(const float (&x)[8]) { v4u w; w.x = pg8::cvt_pk_bf16(x[0], x[1]); w.y = pg8::cvt_pk_bf16(x[2], x[3]); w.z = pg8::cvt_pk_bf16(x[4], x[5]); w.w = pg8::cvt_pk_bf16(x[6], x[7]); return w; }
__device__ __forceinline__ void n1_prep(const Ctx& C, int l) {
    THREAD_IDS();
    const bf16* ZM = WSP(bf16, WS_ZMIX); float* UB = WSP(float, WS_UBUF); float* RQ = WSP(float, WS_RQ); float* RK = WSP(float, WS_RK);
    float* LD = WSP(float, WS_LDEC); const float* COS = WSP(float, WS_ROPE); const float* SIN = COS + NPOS * 32; bf16* QNB = WSP(bf16, WS_QNB); bf16* KNB = WSP(bf16, WS_KNB);
    const int i = lane & 31;
    float qg[8], kg[8];
#pragma unroll
    for (int j = 0; j < 8; ++j) { qg[j] = C.in[I_QN][l * 32 + ((8 * i) & 31) + j] * (0.17677669529663687f * 1.4426950408889634f); kg[j] = C.in[I_KN][l * 32 + ((8 * i) & 31) + j]; }
    const int isk = i >> 4, hh = (i >> 2) & 3, jc = i & 3;
    for (int rp0 = gw * 2; rp0 < MR / 2; rp0 += NGW * 2) {
        v4u Wa[2], Wg[2], Wq[2], Wk[2], Wv[2], W1[2], W2[2], G0[2], G1[2];
#pragma unroll
        for (int u = 0; u < 2; ++u) { const int r = min(2 * (rp0 + u) + (lane >> 5), MR - 1); const bf16* z = ZM + (size_t)r * NMIXP; const bf16* zr = z + (isk ? R_K : R_Q) + hh * 64 + 8 * jc;
            Wa[u] = *(const v4u*)(z + C_A + 8 * i); Wg[u] = *(const v4u*)(z + C_G + 8 * i); Wq[u] = *(const v4u*)(z + D_Q + 8 * i); Wk[u] = *(const v4u*)(z + D_K + 8 * i); Wv[u] = *(const v4u*)(z + D_V + 8 * i);
            W1[u] = *(const v4u*)zr; W2[u] = *(const v4u*)(zr + 32); G0[u] = *(const v4u*)(z + G_LOW); G1[u] = *(const v4u*)(z + G_LOW + 8); }
#pragma unroll
        for (int u = 0; u < 2; ++u) {
        if (rp0 + u >= MR / 2) break;
        const int r = 2 * (rp0 + u) + (lane >> 5);
        const int pi = r < MP ? r % L : L + ((r - MP) & 7);
        float* kout = r < MP ? C.out + O_KP + ((size_t)l * MP + r) * 256 : C.out + O_KS + ((size_t)l * MS + (r - MP)) * 256;
        float* vout = r < MP ? C.out + O_VP + ((size_t)l * MP + r) * 256 : C.out + O_VS + ((size_t)l * MS + (r - MP)) * 256;
        const v4u wa = Wa[u], wg = Wg[u], wq = Wq[u], wk = Wk[u], wv = Wv[u], w1 = W1[u], w2 = W2[u], gl0 = G0[u], gl1 = G1[u];
        float x[8], y[8];
        unpack8(wa, x); unpack8(wg, y);
#pragma unroll
        for (int j = 0; j < 8; ++j) x[j] *= sigmoidf_(y[j]);
        *(f32x4*)(UB + (size_t)r * 256 + 8 * i) = (f32x4){x[0], x[1], x[2], x[3]}; *(f32x4*)(UB + (size_t)r * 256 + 8 * i + 4) = (f32x4){x[4], x[5], x[6], x[7]};
        unpack8(wv, x);
        *(f32x4*)(vout + 8 * i) = (f32x4){x[0], x[1], x[2], x[3]}; *(f32x4*)(vout + 8 * i + 4) = (f32x4){x[4], x[5], x[6], x[7]};
        unpack8(wq, x);
        { float s = 0.f;
#pragma unroll
          for (int j = 0; j < 8; ++j) s += x[j] * x[j];
          s += __shfl_xor(s, 1); s += __shfl_xor(s, 2); const float rs = rsqrtf(s * (1.0f / 32) + EPS);
#pragma unroll
          for (int j = 0; j < 8; ++j) x[j] = x[j] * rs * qg[j];
          *(v4u*)(QNB + (size_t)r * 256 + 8 * i) = pack8(x); }
        unpack8(wk, x);
        { float s = 0.f;
#pragma unroll
          for (int j = 0; j < 8; ++j) s += x[j] * x[j];
          s += __shfl_xor(s, 1); s += __shfl_xor(s, 2); const float rs = rsqrtf(s * (1.0f / 32) + EPS);
#pragma unroll
          for (int j = 0; j < 8; ++j) x[j] = x[j] * rs * kg[j];
          *(v4u*)(KNB + (size_t)r * 256 + 8 * i) = pack8(x);
          *(f32x4*)(kout + 8 * i) = (f32x4){x[0], x[1], x[2], x[3]}; *(f32x4*)(kout + 8 * i + 4) = (f32x4){x[4], x[5], x[6], x[7]}; }
        unpack8(w1, x); unpack8(w2, y);
        { const f32x4 c0 = *(const f32x4*)(COS + pi * 32 + 8 * jc), c1 = *(const f32x4*)(COS + pi * 32 + 8 * jc + 4), s0 = *(const f32x4*)(SIN + pi * 32 + 8 * jc), s1 = *(const f32x4*)(SIN + pi * 32 + 8 * jc + 4);
          const float sc = isk ? 0.125f : 1.0f; float o1[8], o2[8];
#pragma unroll
          for (int j = 0; j < 8; ++j) { const float cs = j < 4 ? c0[j & 3] : c1[j & 3], sn = j < 4 ? s0[j & 3] : s1[j & 3]; o1[j] = (x[j] * cs - y[j] * sn) * sc; o2[j] = (x[j] * sn + y[j] * cs) * sc; }
          float* ro = (isk ? RK : RQ) + (size_t)r * 256 + hh * 64 + 8 * jc;
          *(f32x4*)ro = (f32x4){o1[0], o1[1], o1[2], o1[3]}; *(f32x4*)(ro + 4) = (f32x4){o1[4], o1[5], o1[6], o1[7]}; *(f32x4*)(ro + 32) = (f32x4){o2[0], o2[1], o2[2], o2[3]}; *(f32x4*)(ro + 36) = (f32x4){o2[4], o2[5], o2[6], o2[7]}; }
        { float gv[16]; unpack8(gl0, x); unpack8(gl1, y);
#pragma unroll
          for (int j = 0; j < 8; ++j) { gv[j] = x[j]; gv[8 + j] = y[j]; }
          f32x4 gp = *(const f32x4*)(C.in[I_GAB] + l * 128 + 4 * i);
#pragma unroll
          for (int k = 0; k < 16; ++k) { const f32x4 aw = *(const f32x4*)(C.in[I_GAW] + (size_t)(l * 16 + k) * 128 + 4 * i); gp = gp + aw * gv[k]; }
          f32x4 ls;
#pragma unroll
          for (int j = 0; j < 4; ++j) ls[j] = (fminf(gp[j], 0.f) - log1pf(__expf(-fabsf(gp[j])))) * (1.0f / 16.0f);
          *(f32x4*)(LD + (size_t)r * 128 + 4 * i) = ls; }
        }
    }
}
__device__ __forceinline__ void conv_rows_item(const Ctx& C, int l, int item) {
    THREAD_IDS();
    const float* UB = WSP(float, WS_UBUF); bf16* BR = WSP(bf16, WS_BR);
    const float* cw = C.in[I_CW] + (size_t)l * 31 * 256; const float* sc = C.in[I_SCONV];
    LAS float* wl = (LAS float*)C.lds;
    for (int i = tid; i < 31 * 256; i += NWAVES * 64) wl[i] = cw[i];
    LDS_WAIT(); __builtin_amdgcn_s_barrier(); asm volatile("" ::: "memory");
    const int r0 = item * 64 + wave * 8;
    if (r0 < MR) {
        const bool smp = r0 >= MP; const int b = smp ? (r0 - MP) >> 3 : r0 / L; const int p0 = smp ? 0 : r0 - b * L; const int rb = smp ? MP + b * 8 : b * L;
        float acc[8][4];
#pragma unroll
        for (int i = 0; i < 8; ++i)
#pragma unroll
            for (int k = 0; k < 4; ++k) acc[i][k] = C.in[I_CB][l * 256 + lane + 64 * k];
#pragma unroll 1
        for (int jb = 0; jb < 40; jb += 8) {
            float uv[8][4];
#pragma unroll
            for (int jj = 0; jj < 8; ++jj) { const int j = jb + jj; const int q = p0 - 30 + j;
#pragma unroll
                for (int k = 0; k < 4; ++k) { const int c = lane + 64 * k;
                    uv[jj][k] = j >= 38 ? 0.f : (q >= 0 ? UB[(size_t)(rb + q) * 256 + c] : (smp ? sc[(((size_t)l * DB + b) * 30 + (q + 30)) * 256 + c] : 0.f)); } }
#pragma unroll
            for (int jj = 0; jj < 8; ++jj)
#pragma unroll
                for (int i = 0; i < 8; ++i) { const int t = jb + jj - i;
                    if (t >= 0 && t <= 30) {
#pragma unroll
                        for (int k = 0; k < 4; ++k) acc[i][k] += wl[t * 256 + lane + 64 * k] * uv[jj][k]; } }
        }
#pragma unroll
        for (int i = 0; i < 8; ++i) { const int r = r0 + i;
            float s = (acc[i][0] + acc[i][1]) + (acc[i][2] + acc[i][3]); const float mean = wave_sum(s) * (1.0f / 256);
            float q2 = 0.f;
#pragma unroll
            for (int k = 0; k < 4; ++k) { acc[i][k] -= mean; q2 += acc[i][k] * acc[i][k]; }
            const float rstd = rsqrtf(wave_sum(q2) * (1.0f / 256) + EPS);
#pragma unroll
            for (int k = 0; k < 4; ++k) { const int c = lane + 64 * k; const float y = acc[i][k] * rstd * C.in[I_CLG][l * 256 + c] + C.in[I_CLB][l * 256 + c]; BR[(size_t)r * D + c] = (bf16)f2bf(siluf_(y)); } }
    }
    LDS_WAIT(); __builtin_amdgcn_s_barrier(); asm volatile("" ::: "memory");
}
__device__ __forceinline__ void conv_state_item(const Ctx& C, int l, int part, int nparts) {
    THREAD_IDS();
    const float* UB = WSP(float, WS_UBUF); const float* sc = C.in[I_SCONV];
    for (int i = part * NWAVES * 64 + tid; i < BATCH * 30 * 256; i += nparts * NWAVES * 64) { const int c = i & 255, ii = (i >> 8) % 30, b = i / (30 * 256); C.out[O_CP + (size_t)l * BATCH * 30 * 256 + i] = UB[(size_t)(b * L + L - 30 + ii) * 256 + c]; }
    for (int i = part * NWAVES * 64 + tid; i < DB * 30 * 256; i += nparts * NWAVES * 64) { const int c = i & 255, ii = (i >> 8) % 30, b = i / (30 * 256);
        C.out[O_CS + (size_t)l * DB * 30 * 256 + i] = ii < 22 ? sc[(((size_t)l * DB + b) * 30 + 8 + ii) * 256 + c] : UB[(size_t)(MP + b * 8 + ii - 22) * 256 + c]; }
}
template <int DK, bool RET> __device__ __forceinline__ void la_seq(const Ctx& C, int l, bool smp, int b, int h) {
    THREAD_IDS();
    const bf16* ZM = WSP(bf16, WS_ZMIX); const float* RQ = WSP(float, WS_RQ); const float* RK = WSP(float, WS_RK); const float* LD = WSP(float, WS_LDEC); bf16* BR = WSP(bf16, WS_BR);
    const int nt = smp ? DS : L; const int row0 = smp ? MP + b * DS : b * L;
    float S[DK];
    if (smp) { const float* s0 = (RET ? C.in[I_SRET] : C.in[I_SGLA]) + (((size_t)l * DB + b) * 4 + h) * DK * 64;
#pragma unroll
        for (int k = 0; k < DK; ++k) S[k] = s0[k * 64 + lane]; }
    else {
#pragma unroll
        for (int k = 0; k < DK; ++k) S[k] = 0.f; }
    const float gamma = 1.0f - exp2f(-5.0f - (float)h);
    const float gn = RET ? C.in[I_RGN][(l * 4 + h) * 64 + lane] : C.in[I_GGN][(l * 4 + h) * 64 + lane];
    for (int t = 0; t < nt; ++t) {
        const int r = row0 + t; const bf16* z = ZM + (size_t)r * NMIXP;
        float ql, kl, dl = 1.f;
        if (RET) { ql = RQ[(size_t)r * 256 + h * 64 + lane]; kl = RK[(size_t)r * 256 + h * 64 + lane]; }
        else { const int lk = lane & 31; ql = bf2f(z[G_Q + h * 32 + lk]) * 0.17677669529663687f; kl = bf2f(z[G_K + h * 32 + lk]); dl = __expf(LD[(size_t)r * 128 + h * 32 + lk]); }
        const float v = bf2f(z[(RET ? R_V : G_V) + h * 64 + lane]);
        float o = 0.f;
#pragma unroll
        for (int k = 0; k < DK; ++k) { const float qk = __shfl(ql, k), kk = __shfl(kl, k); const float dk = RET ? gamma : __shfl(dl, k);
            S[k] = dk * S[k] + kk * v; o += qk * S[k]; if ((k & 7) == 7) __builtin_amdgcn_sched_barrier(0); }
        float y;
        if (RET) { const float mean = wave_sum(o) * (1.0f / 64); const float d = o - mean; const float var = wave_sum(d * d) * (1.0f / 64); y = d * rsqrtf(var + EPS) * gn; }
        else { const float ms = wave_sum(o * o) * (1.0f / 64); y = o * rsqrtf(ms + EPS) * gn; }
        const float g = bf2f(z[(RET ? R_G : G_R) + h * 64 + lane]);
        BR[(size_t)r * D + (RET ? 256 : 512) + h * 64 + lane] = (bf16)f2bf(siluf_(g) * y);
    }
    float* so = C.out + (RET ? (smp ? O_RS + (((size_t)l * DB + b) * 4 + h) * DK * 64 : O_RP + (((size_t)l * BATCH + b) * 4 + h) * DK * 64)
                             : (smp ? O_GS + (((size_t)l * DB + b) * 4 + h) * DK * 64 : O_GP + (((size_t)l * BATCH + b) * 4 + h) * DK * 64));
#pragma unroll
    for (int k = 0; k < DK; ++k) so[k * 64 + lane] = S[k];
}
typedef short bf16x8_t __attribute__((ext_vector_type(8)));
template <int DK, bool RET> __device__ __forceinline__ void la_chunked(const Ctx& C, int l, bool smp, int b, int h) {
    THREAD_IDS();
    constexpr int QS = DK + 8, TS = 72, NKB = DK / 16, NKS = DK / 32;
    constexpr int SB = 2 * 64 * QS + 64 * TS + DK * TS + 64 * TS + 64;
    LAS bf16* SB0 = (LAS bf16*)(C.lds);
    LAS bf16* AL = SB0 + 2 * SB;
    LAS bf16* ST = AL + 64 * TS;
    const bf16* ZM = WSP(bf16, WS_ZMIX); const float* RQ = WSP(float, WS_RQ); const float* RK = WSP(float, WS_RK); const float* LD = WSP(float, WS_LDEC); bf16* BR = WSP(bf16, WS_BR);
    const int nt = smp ? DS : L, row0 = smp ? MP + b * DS : b * L, nch = (nt + 63) >> 6;
    const float lg2 = RET ? log2f(1.0f - exp2f(-5.0f - (float)h)) : 0.f;
    const int g4 = lane >> 4, c16 = lane & 15;
    const bool qwave = wave < 4; const int w4 = wave & 3;
    float Sreg[NKB][4];
    if (wave >= 4) {
        const float* s0 = (RET ? C.in[I_SRET] : C.in[I_SGLA]) + (((size_t)l * DB + b) * 4 + h) * DK * 64;
#pragma unroll
        for (int cb = 0; cb < NKB; ++cb)
#pragma unroll
            for (int r = 0; r < 4; ++r) { const int dk = cb * 16 + c16, dv = (wave - 4) * 16 + 4 * g4 + r; const float v = smp ? s0[dk * 64 + dv] : 0.f; Sreg[cb][r] = v; ST[dv * QS + dk] = (bf16)f2bf(v); }
    }
    float gnv[4];
#pragma unroll
    for (int cb = 0; cb < 4; ++cb) gnv[cb] = (RET ? C.in[I_RGN] : C.in[I_GGN])[(l * 4 + h) * 64 + cb * 16 + c16];
    float a[16]; v4u vr;
#define LA_LOAD(c) do { const size_t r_ = (size_t)(row0 + (c) * 64 + lane); const bf16* z_ = ZM + r_ * NMIXP; \
        vr = *(const v4u*)(z_ + (RET ? R_V : G_V) + h * 64 + 8 * wave); \
        if (RET) { const float* p_ = (qwave ? RQ : RK) + r_ * 256 + h * 64 + 8 * w4; const f32x4 x0 = *(const f32x4*)p_, x1 = *(const f32x4*)(p_ + 4), x2 = *(const f32x4*)(p_ + 32), x3 = *(const f32x4*)(p_ + 36); \
            a[0] = x0[0]; a[1] = x0[1]; a[2] = x0[2]; a[3] = x0[3]; a[4] = x1[0]; a[5] = x1[1]; a[6] = x1[2]; a[7] = x1[3]; a[8] = x2[0]; a[9] = x2[1]; a[10] = x2[2]; a[11] = x2[3]; a[12] = x3[0]; a[13] = x3[1]; a[14] = x3[2]; a[15] = x3[3]; } \
        else { const v4u q_ = *(const v4u*)(z_ + (qwave ? G_Q : G_K) + h * 32 + 8 * w4); const float* p_ = LD + r_ * 128 + h * 32 + 8 * w4; const f32x4 x0 = *(const f32x4*)p_, x1 = *(const f32x4*)(p_ + 4); \
            a[0] = bflo(q_.x); a[1] = bfhi(q_.x); a[2] = bflo(q_.y); a[3] = bfhi(q_.y); a[4] = bflo(q_.z); a[5] = bfhi(q_.z); a[6] = bflo(q_.w); a[7] = bfhi(q_.w); \
            a[8] = x0[0]; a[9] = x0[1]; a[10] = x0[2]; a[11] = x0[3]; a[12] = x1[0]; a[13] = x1[1]; a[14] = x1[2]; a[15] = x1[3]; } } while (0)
    LA_LOAD(0);
    int cur = 0;
    for (int i = 0; i <= nch; ++i) {
        if (i < nch) {
            const int c = i; LAS bf16* QT = SB0 + (i & 1) * SB; LAS bf16* KT = QT + 64 * QS; LAS bf16* VT = KT + 64 * QS; LAS bf16* KE = VT + 64 * TS; LAS bf16* GT = KE + DK * TS; LAS float* WT = (LAS float*)(GT + 64 * TS);
            const int nvc = min(64, nt - c * 64); const bool valid = lane < nvc;
        if (RET) {
            const float tq = (float)(lane + 1);
            if (qwave) { const float e = valid ? __builtin_amdgcn_exp2f(lg2 * tq) : 0.f;
                v4u w0, w1; w0.x = pg8::cvt_pk_bf16(a[0] * e, a[1] * e); w0.y = pg8::cvt_pk_bf16(a[2] * e, a[3] * e); w0.z = pg8::cvt_pk_bf16(a[4] * e, a[5] * e); w0.w = pg8::cvt_pk_bf16(a[6] * e, a[7] * e);
                w1.x = pg8::cvt_pk_bf16(a[8] * e, a[9] * e); w1.y = pg8::cvt_pk_bf16(a[10] * e, a[11] * e); w1.z = pg8::cvt_pk_bf16(a[12] * e, a[13] * e); w1.w = pg8::cvt_pk_bf16(a[14] * e, a[15] * e);
                *(LAS v4u*)(QT + lane * QS + 8 * w4) = w0; *(LAS v4u*)(QT + lane * QS + 32 + 8 * w4) = w1; }
            else { const float e = valid ? __builtin_amdgcn_exp2f(-lg2 * tq) : 0.f, ee = valid ? __builtin_amdgcn_exp2f(lg2 * ((float)nvc - tq)) : 0.f;
                v4u w0, w1; w0.x = pg8::cvt_pk_bf16(a[0] * e, a[1] * e); w0.y = pg8::cvt_pk_bf16(a[2] * e, a[3] * e); w0.z = pg8::cvt_pk_bf16(a[4] * e, a[5] * e); w0.w = pg8::cvt_pk_bf16(a[6] * e, a[7] * e);
                w1.x = pg8::cvt_pk_bf16(a[8] * e, a[9] * e); w1.y = pg8::cvt_pk_bf16(a[10] * e, a[11] * e); w1.z = pg8::cvt_pk_bf16(a[12] * e, a[13] * e); w1.w = pg8::cvt_pk_bf16(a[14] * e, a[15] * e);
                *(LAS v4u*)(KT + lane * QS + 8 * w4) = w0; *(LAS v4u*)(KT + lane * QS + 32 + 8 * w4) = w1;
#pragma unroll
                for (int i = 0; i < 16; i += 2) { const unsigned mine = pg8::cvt_pk_bf16(a[i] * ee, a[i + 1] * ee); const unsigned pv = (unsigned)__shfl_xor((int)mine, 1);
                    const unsigned w = (lane & 1) ? ((pv >> 16) | (mine & 0xffff0000u)) : ((mine & 0xffffu) | (pv << 16));
                    const int row = (i < 8 ? 8 * w4 + i : 32 + 8 * w4 + (i - 8)) + (lane & 1);
                    *(LAS unsigned*)(KE + row * TS + (lane & ~1)) = w; } }
        } else {
            float bb[8];
#pragma unroll
            for (int i = 0; i < 8; ++i) bb[i] = valid ? a[8 + i] : 0.f;
#pragma unroll
            for (int i = 0; i < 8; ++i) { float x = bb[i];
                x += __builtin_bit_cast(float, __builtin_amdgcn_mov_dpp(__builtin_bit_cast(int, x), 0x111, 0xf, 0xf, true));
                x += __builtin_bit_cast(float, __builtin_amdgcn_mov_dpp(__builtin_bit_cast(int, x), 0x112, 0xf, 0xf, true));
                x += __builtin_bit_cast(float, __builtin_amdgcn_mov_dpp(__builtin_bit_cast(int, x), 0x114, 0xf, 0xf, true));
                x += __builtin_bit_cast(float, __builtin_amdgcn_mov_dpp(__builtin_bit_cast(int, x), 0x118, 0xf, 0xf, true));
                const float t0 = __builtin_bit_cast(float, __builtin_amdgcn_readlane(__builtin_bit_cast(int, x), 15)), t1 = __builtin_bit_cast(float, __builtin_amdgcn_readlane(__builtin_bit_cast(int, x), 31)), t2 = __builtin_bit_cast(float, __builtin_amdgcn_readlane(__builtin_bit_cast(int, x), 47));
                bb[i] = x + (lane >= 16 ? t0 : 0.f) + (lane >= 32 ? t1 : 0.f) + (lane >= 48 ? t2 : 0.f); }
            if (qwave) {
                if (lane == 63) {
#pragma unroll
                    for (int i = 0; i < 8; ++i) WT[8 * w4 + i] = bb[i]; }
                float o8[8];
#pragma unroll
                for (int i = 0; i < 8; ++i) o8[i] = valid ? a[i] * 0.17677669529663687f * __expf(bb[i]) : 0.f;
                v4u w0; w0.x = pg8::cvt_pk_bf16(o8[0], o8[1]); w0.y = pg8::cvt_pk_bf16(o8[2], o8[3]); w0.z = pg8::cvt_pk_bf16(o8[4], o8[5]); w0.w = pg8::cvt_pk_bf16(o8[6], o8[7]);
                *(LAS v4u*)(QT + lane * QS + 8 * w4) = w0;
            } else {
                float o8[8];
#pragma unroll
                for (int i = 0; i < 8; ++i) o8[i] = valid ? a[i] * __expf(-bb[i]) : 0.f;
#pragma unroll
                for (int i = 0; i < 8; i += 2) { const float t0 = __shfl(bb[i], 63), t1 = __shfl(bb[i + 1], 63);
                    const unsigned mine = pg8::cvt_pk_bf16(valid ? a[i] * __expf(t0 - bb[i]) : 0.f, valid ? a[i + 1] * __expf(t1 - bb[i + 1]) : 0.f); const unsigned pv = (unsigned)__shfl_xor((int)mine, 1);
                    const unsigned w = (lane & 1) ? ((pv >> 16) | (mine & 0xffff0000u)) : ((mine & 0xffffu) | (pv << 16));
                    *(LAS unsigned*)(KE + (8 * w4 + i + (lane & 1)) * TS + (lane & ~1)) = w; }
                v4u w0; w0.x = pg8::cvt_pk_bf16(o8[0], o8[1]); w0.y = pg8::cvt_pk_bf16(o8[2], o8[3]); w0.z = pg8::cvt_pk_bf16(o8[4], o8[5]); w0.w = pg8::cvt_pk_bf16(o8[6], o8[7]);
                *(LAS v4u*)(KT + lane * QS + 8 * w4) = w0;
            }
        }
        { const unsigned vv[4] = {valid ? vr.x : 0u, valid ? vr.y : 0u, valid ? vr.z : 0u, valid ? vr.w : 0u};
#pragma unroll
          for (int i = 0; i < 4; ++i) { const unsigned pv = (unsigned)__shfl_xor((int)vv[i], 1);
              const unsigned w = (lane & 1) ? ((pv >> 16) | (vv[i] & 0xffff0000u)) : ((vv[i] & 0xffffu) | (pv << 16));
              *(LAS unsigned*)(VT + (8 * wave + 2 * i + (lane & 1)) * TS + (lane & ~1)) = w; } }
            if (c + 1 < nch) LA_LOAD(c + 1);
        }
        if (i >= 1) {
            LAS bf16* QT = SB0 + ((i - 1) & 1) * SB; LAS bf16* KT = QT + 64 * QS;
        { const int rb = wave >> 1;
#pragma unroll
          for (int ci = 0; ci < 2; ++ci) { const int cb = (wave & 1) * 2 + ci; f32x4 acc = {0.f, 0.f, 0.f, 0.f};
              if (cb <= rb) {
#pragma unroll
                  for (int ks = 0; ks < NKS; ++ks) { const bf16x8_t af = *(const LAS bf16x8_t*)(QT + (rb * 16 + c16) * QS + ks * 32 + 8 * g4), bf = *(const LAS bf16x8_t*)(KT + (cb * 16 + c16) * QS + ks * 32 + 8 * g4);
                      acc = __builtin_amdgcn_mfma_f32_16x16x32_bf16(af, bf, acc, 0, 0, 0); } }
#pragma unroll
              for (int r = 0; r < 4; ++r) { const int tt = rb * 16 + 4 * g4 + r, ss = cb * 16 + c16; AL[tt * TS + ss] = (bf16)f2bf(ss <= tt ? acc[r] : 0.f); } } }
        }
        LDS_WAIT(); __builtin_amdgcn_s_barrier(); asm volatile("" ::: "memory");
        if (i >= 1) {
            const int c = i - 1; LAS bf16* QT = SB0 + (c & 1) * SB; LAS bf16* KT = QT + 64 * QS; LAS bf16* VT = KT + 64 * QS; LAS bf16* KE = VT + 64 * TS; LAS bf16* GT = KE + DK * TS; LAS float* WT = (LAS float*)(GT + 64 * TS);
            const int nvc = min(64, nt - c * 64); (void)KT;
        if (wave < 4) {
            const int rb = wave; const LAS bf16* STc = ST + cur * 64 * QS;
            f32x4 o[4];
#pragma unroll
            for (int cb = 0; cb < 4; ++cb) o[cb] = (f32x4){0.f, 0.f, 0.f, 0.f};
#pragma unroll
            for (int ks = 0; ks < 2; ++ks) { const bf16x8_t af = *(const LAS bf16x8_t*)(AL + (rb * 16 + c16) * TS + ks * 32 + 8 * g4);
#pragma unroll
                for (int cb = 0; cb < 4; ++cb) { const bf16x8_t bf = *(const LAS bf16x8_t*)(VT + (cb * 16 + c16) * TS + ks * 32 + 8 * g4); o[cb] = __builtin_amdgcn_mfma_f32_16x16x32_bf16(af, bf, o[cb], 0, 0, 0); } }
#pragma unroll
            for (int ks = 0; ks < NKS; ++ks) { const bf16x8_t af = *(const LAS bf16x8_t*)(QT + (rb * 16 + c16) * QS + ks * 32 + 8 * g4);
#pragma unroll
                for (int cb = 0; cb < 4; ++cb) { const bf16x8_t bf = *(const LAS bf16x8_t*)(STc + (cb * 16 + c16) * QS + ks * 32 + 8 * g4); o[cb] = __builtin_amdgcn_mfma_f32_16x16x32_bf16(af, bf, o[cb], 0, 0, 0); } }
            { float* LAO = WSP(float, WS_LAO);
#pragma unroll
              for (int r = 0; r < 4; ++r) { const int tok = c * 64 + rb * 16 + 4 * g4 + r;
                  if (tok < nt) { float* op = LAO + (size_t)(row0 + tok) * 512 + (RET ? 0 : 256) + h * 64 + c16;
#pragma unroll
                      for (int cb = 0; cb < 4; ++cb) op[cb * 16] = o[cb][r]; } } }
        } else {
            const int dvb = wave - 4; LAS bf16* STn = ST + (cur ^ 1) * 64 * QS;
            f32x4 ds[NKB];
#pragma unroll
            for (int cb = 0; cb < NKB; ++cb) ds[cb] = (f32x4){0.f, 0.f, 0.f, 0.f};
#pragma unroll
            for (int ks = 0; ks < 2; ++ks) { const bf16x8_t af = *(const LAS bf16x8_t*)(VT + (dvb * 16 + c16) * TS + ks * 32 + 8 * g4);
#pragma unroll
                for (int cb = 0; cb < NKB; ++cb) { const bf16x8_t bf = *(const LAS bf16x8_t*)(KE + (cb * 16 + c16) * TS + ks * 32 + 8 * g4); ds[cb] = __builtin_amdgcn_mfma_f32_16x16x32_bf16(af, bf, ds[cb], 0, 0, 0); } }
#pragma unroll
            for (int cb = 0; cb < NKB; ++cb) { const float eB = RET ? __builtin_amdgcn_exp2f(lg2 * (float)nvc) : __expf(WT[cb * 16 + c16]);
#pragma unroll
                for (int r = 0; r < 4; ++r) { Sreg[cb][r] = eB * Sreg[cb][r] + ds[cb][r]; STn[(dvb * 16 + 4 * g4 + r) * QS + cb * 16 + c16] = (bf16)f2bf(Sreg[cb][r]); } }
        }
            cur ^= 1;
        }
        LDS_WAIT(); __builtin_amdgcn_s_barrier(); asm volatile("" ::: "memory");
    }
#undef LA_LOAD
    if (wave >= 4) {
        float* so = C.out + (RET ? (smp ? O_RS + (((size_t)l * DB + b) * 4 + h) * DK * 64 : O_RP + (((size_t)l * BATCH + b) * 4 + h) * DK * 64)
                                 : (smp ? O_GS + (((size_t)l * DB + b) * 4 + h) * DK * 64 : O_GP + (((size_t)l * BATCH + b) * 4 + h) * DK * 64));
#pragma unroll
        for (int cb = 0; cb < NKB; ++cb)
#pragma unroll
            for (int r = 0; r < 4; ++r) so[(cb * 16 + c16) * 64 + (wave - 4) * 16 + 4 * g4 + r] = Sreg[cb][r];
    }
}
typedef float f32x16_t __attribute__((ext_vector_type(16)));
__device__ __forceinline__ int crow_(int r, int hi) { return (r & 3) + 8 * (r >> 2) + 4 * hi; }
__device__ __forceinline__ float swapmax32(float m) { auto rr = __builtin_amdgcn_permlane32_swap(__float_as_uint(m), __float_as_uint(m), false, false); return fmaxf(__uint_as_float(rr[0]), __uint_as_float(rr[1])); }
__device__ __forceinline__ float swapadd32(float m) { auto rr = __builtin_amdgcn_permlane32_swap(__float_as_uint(m), __float_as_uint(m), false, false); return __uint_as_float(rr[0]) + __uint_as_float(rr[1]); }
constexpr float LOG2E = 1.4426950408889634f;
__device__ __forceinline__ void attn_prompt_item(const Ctx& C, int l, int b, int h, int qb, float lam, float lam_init, float mb) {
    THREAD_IDS();
    constexpr int KS = 72;
    LAS bf16* Kt = (LAS bf16*)C.lds;
    LAS bf16* Vt = Kt + 2 * 64 * KS;
    LAS float* BT = (LAS float*)(Vt + 2 * 64 * KS);
    LAS float* OX = BT + 128;
    const bf16* ZM = WSP(bf16, WS_ZMIX); const bf16* QNB = WSP(bf16, WS_QNB); const bf16* KNB = WSP(bf16, WS_KNB); bf16* BR = WSP(bf16, WS_BR);
    const int r32 = lane & 31, hi = lane >> 5, qs = wave >> 1, s = wave & 1;
    const int q0 = qb * 128 + qs * 32; const int rowb = b * L;
    if (tid < 128) BT[tid] = (C.in[I_RELB][t5_bucket(tid) * 4 + h] - C.in[I_RELB][31 * 4 + h]) * LOG2E;
    pg8::bf16x8 qf[2];
#pragma unroll
    for (int d0 = 0; d0 < 2; ++d0) qf[d0] = *(const pg8::bf16x8*)(QNB + (size_t)(rowb + q0 + r32) * 256 + h * 64 + s * 32 + 16 * d0 + 8 * hi);
    const int pl = (lane & ~15) | ((lane & 8) >> 1) | ((lane & 4) << 1) | (lane & 3);
    const int NT = (min(128 * (qb + 1), L) + 63) >> 6;
    v4u kreg, vreg;
#define AT_LOAD(j) do { const size_t r_ = (size_t)(rowb + (j) * 64 + lane); kreg = *(const v4u*)(KNB + r_ * 256 + h * 64 + 8 * wave); vreg = *(const v4u*)(ZM + r_ * NMIXP + D_V + h * 64 + 8 * wave); } while (0)
#define AT_STORE(buf) do { *(LAS v4u*)(Kt + (buf) * 64 * KS + lane * KS + 8 * wave) = kreg; LAS bf16* v_ = Vt + (buf) * 64 * KS + (8 * wave) * KS + pl; \
        v_[0] = (bf16)(vreg.x & 0xffffu); v_[KS] = (bf16)(vreg.x >> 16); v_[2 * KS] = (bf16)(vreg.y & 0xffffu); v_[3 * KS] = (bf16)(vreg.y >> 16); \
        v_[4 * KS] = (bf16)(vreg.z & 0xffffu); v_[5 * KS] = (bf16)(vreg.z >> 16); v_[6 * KS] = (bf16)(vreg.w & 0xffffu); v_[7 * KS] = (bf16)(vreg.w >> 16); } while (0)
    AT_LOAD(0); AT_STORE(0); if (NT > 1) AT_LOAD(1);
    LDS_WAIT(); __builtin_amdgcn_s_barrier(); asm volatile("" ::: "memory");
    float lsum = 0.f; f32x16_t o[2]; f32x16_t negm;
#pragma unroll
    for (int i = 0; i < 16; ++i) negm[i] = -mb;
#pragma unroll
    for (int i = 0; i < 16; ++i) { o[0][i] = 0.f; o[1][i] = 0.f; }
    for (int j = 0; j < NT; ++j) {
        const int k0 = 64 * j, buf = j & 1;
        if (k0 <= q0 + 31) {
            const LAS bf16* kb = Kt + buf * 64 * KS; const LAS bf16* vb = Vt + buf * 64 * KS;
            f32x16_t p0 = negm, p1 = negm;
#pragma unroll
            for (int d0 = 0; d0 < 2; ++d0) { const pg8::bf16x8 a0 = *(const LAS pg8::bf16x8*)(kb + r32 * KS + s * 32 + 16 * d0 + 8 * hi), a1 = *(const LAS pg8::bf16x8*)(kb + (32 + r32) * KS + s * 32 + 16 * d0 + 8 * hi);
                p0 = __builtin_amdgcn_mfma_f32_32x32x16_bf16(a0, qf[d0], p0, 0, 0, 0); p1 = __builtin_amdgcn_mfma_f32_32x32x16_bf16(a1, qf[d0], p1, 0, 0, 0); }
            if (q0 - k0 - 63 < 113) {
#pragma unroll
                for (int r = 0; r < 16; ++r) { const int n0 = (q0 + r32) - (k0 + crow_(r, hi)), n1 = n0 - 32;
                    p0[r] = n0 < 0 ? -INFINITY : p0[r] + (n0 < 128 ? BT[n0] : 0.f); p1[r] = n1 < 0 ? -INFINITY : p1[r] + (n1 < 128 ? BT[n1] : 0.f); } }
            typedef float f32x2_t __attribute__((ext_vector_type(2)));
            f32x2_t ps2 = {0.f, 0.f};
#pragma unroll
            for (int r = 0; r < 16; r += 2) { p0[r] = __builtin_amdgcn_exp2f(p0[r]); p0[r + 1] = __builtin_amdgcn_exp2f(p0[r + 1]); p1[r] = __builtin_amdgcn_exp2f(p1[r]); p1[r + 1] = __builtin_amdgcn_exp2f(p1[r + 1]);
                ps2 = ps2 + (f32x2_t){p0[r], p0[r + 1]}; ps2 = ps2 + (f32x2_t){p1[r], p1[r + 1]}; }
            lsum += ps2[0] + ps2[1];
            pg8::bf16x8 pb[4];
#pragma unroll
            for (int ks = 0; ks < 4; ++ks) { v4u w;
                if (ks < 2) { w.x = pg8::cvt_pk_bf16(p0[8 * ks], p0[8 * ks + 1]); w.y = pg8::cvt_pk_bf16(p0[8 * ks + 2], p0[8 * ks + 3]); w.z = pg8::cvt_pk_bf16(p0[8 * ks + 4], p0[8 * ks + 5]); w.w = pg8::cvt_pk_bf16(p0[8 * ks + 6], p0[8 * ks + 7]); }
                else { w.x = pg8::cvt_pk_bf16(p1[8 * ks - 16], p1[8 * ks - 15]); w.y = pg8::cvt_pk_bf16(p1[8 * ks - 14], p1[8 * ks - 13]); w.z = pg8::cvt_pk_bf16(p1[8 * ks - 12], p1[8 * ks - 11]); w.w = pg8::cvt_pk_bf16(p1[8 * ks - 10], p1[8 * ks - 9]); }
                pb[ks] = __builtin_bit_cast(pg8::bf16x8, w); }
#pragma unroll
            for (int d0 = 0; d0 < 2; ++d0)
#pragma unroll
                for (int ks = 0; ks < 4; ++ks) { const pg8::bf16x8 af = *(const LAS pg8::bf16x8*)(vb + (32 * d0 + r32) * KS + 16 * ks + 8 * hi); o[d0] = __builtin_amdgcn_mfma_f32_32x32x16_bf16(af, pb[ks], o[d0], 0, 0, 0); }
        }
        if (j + 1 < NT) AT_STORE(buf ^ 1);
        if (j + 2 < NT) AT_LOAD(j + 2);
        LDS_WAIT(); __builtin_amdgcn_s_barrier(); asm volatile("" ::: "memory");
    }
#undef AT_LOAD
#undef AT_STORE
    lsum = swapadd32(lsum); const float inv = 1.0f / lsum;
    LAS float* ox = OX + (qs * 32 + r32) * 65;
    if (s == 1) {
#pragma unroll
        for (int d0 = 0; d0 < 2; ++d0)
#pragma unroll
            for (int r = 0; r < 16; ++r) ox[32 * d0 + crow_(r, hi)] = o[d0][r] * inv; }
    LDS_WAIT(); __builtin_amdgcn_s_barrier(); asm volatile("" ::: "memory");
    if (s == 0) {
        float ss = 0.f;
#pragma unroll
        for (int d0 = 0; d0 < 2; ++d0)
#pragma unroll
            for (int r = 0; r < 16; ++r) { const float v = o[d0][r] * inv - lam * ox[32 * d0 + crow_(r, hi)]; o[d0][r] = v; ss += v * v; }
        ss = swapadd32(ss); const float rs = rsqrtf(ss * (1.0f / 64) + EPS) * (1.0f - lam_init);
        const int qpos = q0 + r32;
        if (qpos < L) { bf16* brp = BR + (size_t)(rowb + qpos) * D + 768 + h * 64;
#pragma unroll
            for (int d0 = 0; d0 < 2; ++d0)
#pragma unroll
                for (int r4 = 0; r4 < 4; ++r4) { const int dv = 32 * d0 + 8 * r4 + 4 * hi; const float* sl = C.in[I_SUBLN] + l * 64 + dv;
                    const unsigned w0 = pk2(o[d0][4 * r4] * rs * sl[0], o[d0][4 * r4 + 1] * rs * sl[1]), w1 = pk2(o[d0][4 * r4 + 2] * rs * sl[2], o[d0][4 * r4 + 3] * rs * sl[3]);
                    *(unsigned long long*)(brp + dv) = (unsigned long long)w0 | ((unsigned long long)w1 << 32); } }
    }
    LDS_WAIT(); __builtin_amdgcn_s_barrier(); asm volatile("" ::: "memory");
}
constexpr int PSTR = 68;
__device__ __forceinline__ pg8::bf16x8 cvt8(const f32x4 a, const f32x4 b) { v4u w; w.x = pg8::cvt_pk_bf16(a[0], a[1]); w.y = pg8::cvt_pk_bf16(a[2], a[3]); w.z = pg8::cvt_pk_bf16(b[0], b[1]); w.w = pg8::cvt_pk_bf16(b[2], b[3]); return __builtin_bit_cast(pg8::bf16x8, w); }
__device__ __forceinline__ void attn_sample_item(const Ctx& C, int l, int b, int split) {
    THREAD_IDS();
    const int h = wave & 3, half = wave >> 2, c16 = lane & 15, g = lane >> 4, srow = c16 >> 3, t = c16 & 7;
    const bf16* QNB = WSP(bf16, WS_QNB); const int* PT = (const int*)C.in[I_PT];
    const float* CK = C.in[I_CK] + (size_t)l * NPOOL * PAGE * 256; const float* CV = C.in[I_CV] + (size_t)l * NPOOL * PAGE * 256;
    LAS float* BT = (LAS float*)C.lds;
    BT[tid] = (C.in[I_RELB][t5_bucket(tid & 127) * 4 + (tid >> 7)] - C.in[I_RELB][31 * 4 + (tid >> 7)]) * LOG2E;
    const v4u z4 = {0u, 0u, 0u, 0u};
    const v4u q0w = srow == 0 ? *(const v4u*)(QNB + (size_t)(MP + b * 8 + t) * 256 + h * 64 + 8 * g) : z4, q1w = srow == 1 ? *(const v4u*)(QNB + (size_t)(MP + b * 8 + t) * 256 + h * 64 + 32 + 8 * g) : z4;
    const pg8::bf16x8 qf0 = __builtin_bit_cast(pg8::bf16x8, q0w), qf1 = __builtin_bit_cast(pg8::bf16x8, q1w);
    LDS_WAIT(); __builtin_amdgcn_s_barrier(); asm volatile("" ::: "memory");
    float m = -INFINITY, lsum = 0.f; f32x4 o[4];
#pragma unroll
    for (int db = 0; db < 4; ++db) o[db] = (f32x4){0.f, 0.f, 0.f, 0.f};
    const int kk0 = split * 1024 + half * 512;
    const int pg0 = __builtin_amdgcn_readfirstlane(PT[b * NPAGES + (kk0 >> 7)]), pg1 = __builtin_amdgcn_readfirstlane(PT[b * NPAGES + (kk0 >> 7) + 1]), pg2 = __builtin_amdgcn_readfirstlane(PT[b * NPAGES + (kk0 >> 7) + 2]), pg3 = __builtin_amdgcn_readfirstlane(PT[b * NPAGES + (kk0 >> 7) + 3]);
#define SA_LOAD(KR, VR, st) do { const int kk_ = kk0 + 32 * (st); const int pi_ = (st) >> 2; const int page_ = pi_ == 0 ? pg0 : pi_ == 1 ? pg1 : pi_ == 2 ? pg2 : pg3; const size_t base_ = ((size_t)(page_ * PAGE + (kk_ & 127)) * 4 + h) * 64; \
        _Pragma("unroll") for (int T = 0; T < 2; ++T) _Pragma("unroll") for (int ks = 0; ks < 2; ++ks) { const float* p = CK + base_ + (size_t)(16 * T + c16) * 256 + 32 * ks + 8 * g; KR[T][ks][0] = *(const f32x4*)p; KR[T][ks][1] = *(const f32x4*)(p + 4); } \
        _Pragma("unroll") for (int db = 0; db < 4; ++db) _Pragma("unroll") for (int j = 0; j < 8; ++j) { const int kv = j < 4 ? 4 * g + j : 16 + 4 * g + (j - 4); VR[db][j] = CV[base_ + (size_t)kv * 256 + 16 * db + c16]; } } while (0)
#define SA_MATH(KR, VR, st) do { const int kk = kk0 + 32 * (st); f32x4 sv[2]; \
        _Pragma("unroll") for (int T = 0; T < 2; ++T) { sv[T] = (f32x4){0.f, 0.f, 0.f, 0.f}; \
            sv[T] = __builtin_amdgcn_mfma_f32_16x16x32_bf16(cvt8(KR[T][0][0], KR[T][0][1]), qf0, sv[T], 0, 0, 0); \
            sv[T] = __builtin_amdgcn_mfma_f32_16x16x32_bf16(cvt8(KR[T][1][0], KR[T][1][1]), qf1, sv[T], 0, 0, 0); } \
        if (kk + 31 + 128 > PAST) { \
            _Pragma("unroll") for (int T = 0; T < 2; ++T) _Pragma("unroll") for (int r = 0; r < 4; ++r) { const int n = PAST + t - (kk + 16 * T + 4 * g + r); if (n < 128) sv[T][r] += BT[h * 128 + n]; } } \
        float mt = fmaxf(fmaxf(fmaxf(sv[0][0], sv[0][1]), fmaxf(sv[0][2], sv[0][3])), fmaxf(fmaxf(sv[1][0], sv[1][1]), fmaxf(sv[1][2], sv[1][3]))); \
        mt = fmaxf(mt, __shfl_xor(mt, 16)); mt = fmaxf(mt, __shfl_xor(mt, 32)); \
        const float mn = fmaxf(m, mt); const float al = __builtin_amdgcn_exp2f(m - mn); m = mn; float ps = 0.f; \
        _Pragma("unroll") for (int T = 0; T < 2; ++T) _Pragma("unroll") for (int r = 0; r < 4; ++r) { sv[T][r] = __builtin_amdgcn_exp2f(sv[T][r] - m); ps += sv[T][r]; } \
        lsum = lsum * al + ps; const pg8::bf16x8 pf = cvt8(sv[0], sv[1]); \
        _Pragma("unroll") for (int db = 0; db < 4; ++db) { o[db] = o[db] * al; \
            const f32x4 va = {VR[db][0], VR[db][1], VR[db][2], VR[db][3]}, vb = {VR[db][4], VR[db][5], VR[db][6], VR[db][7]}; \
            o[db] = __builtin_amdgcn_mfma_f32_16x16x32_bf16(cvt8(va, vb), pf, o[db], 0, 0, 0); } } while (0)
    f32x4 krA[2][2][2], krB[2][2][2]; float vrA[4][8], vrB[4][8];
    SA_LOAD(krA, vrA, 0);
#pragma unroll 1
    for (int step = 0; step < 16; step += 2) {
        SA_LOAD(krB, vrB, step + 1);
        SA_MATH(krA, vrA, step);
        if (step + 2 < 16) SA_LOAD(krA, vrA, step + 2);
        SA_MATH(krB, vrB, step + 1);
    }
#undef SA_LOAD
#undef SA_MATH
    lsum += __shfl_xor(lsum, 16); lsum += __shfl_xor(lsum, 32);
    float* pp = WSP(float, WS_PART) + ((((size_t)b * 4 + h) * 16 + split * 2 + half) * 16 + c16) * PSTR;
#pragma unroll
    for (int db = 0; db < 4; ++db) *(f32x4*)(pp + 16 * db + 4 * g) = o[db];
    if (g == 0) { pp[64] = m; pp[65] = lsum; }
    LDS_WAIT(); __builtin_amdgcn_s_barrier(); asm volatile("" ::: "memory");
}
__device__ __forceinline__ void n3_attn_sample_combine(const Ctx& C, int l, float lam_init) {
    THREAD_IDS();
    const float lam = lam_of(C, l, lam_init);
    const bf16* QNB = WSP(bf16, WS_QNB); const bf16* KNB = WSP(bf16, WS_KNB); const bf16* ZM = WSP(bf16, WS_ZMIX); bf16* BR = WSP(bf16, WS_BR);
    for (int it = gw; it < DB * 4 * DS; it += NGW) {
        const int b = it >> 5, h = (it >> 3) & 3, t = it & 7; float os[2];
        const float far = C.in[I_RELB][31 * 4 + h];
        float sn[2][8];
        { const float qv = bf2f(QNB[(size_t)(MP + b * 8 + t) * 256 + h * 64 + lane]);
#pragma unroll
          for (int jj = 0; jj < 8; ++jj) { float p = qv * bf2f(KNB[(size_t)(MP + b * 8 + jj) * 256 + h * 64 + lane]);
              p += __shfl_xor(p, 1); p += __shfl_xor(p, 2); p += __shfl_xor(p, 4); p += __shfl_xor(p, 8); p += __shfl_xor(p, 16);
              const float bias = (C.in[I_RELB][t5_bucket(t - jj < 0 ? 0 : t - jj) * 4 + h] - far) * LOG2E;
              sn[0][jj] = jj <= t ? __shfl(p, 0) + bias : -INFINITY; sn[1][jj] = jj <= t ? __shfl(p, 32) + bias : -INFINITY; } }
#pragma unroll
        for (int s = 0; s < 2; ++s) {
            const float* pb = WSP(float, WS_PART) + ((((size_t)b * 4 + h) * 16) * 16 + s * 8 + t) * PSTR;
            float mm = -INFINITY; float pm[16];
#pragma unroll
            for (int pi = 0; pi < 16; ++pi) { pm[pi] = pb[(size_t)pi * 16 * PSTR + 64]; mm = fmaxf(mm, pm[pi]); }
#pragma unroll
            for (int jj = 0; jj < 8; ++jj) mm = fmaxf(mm, sn[s][jj]);
            float ll = 0.f, oo = 0.f;
#pragma unroll
            for (int pi = 0; pi < 16; ++pi) { const float* pr = pb + (size_t)pi * 16 * PSTR; const float w = __builtin_amdgcn_exp2f(pm[pi] - mm); ll += pr[65] * w; oo += pr[lane] * w; }
#pragma unroll
            for (int jj = 0; jj < 8; ++jj) { const float w = __builtin_amdgcn_exp2f(sn[s][jj] - mm); ll += w; oo += w * bf2f(ZM[(size_t)(MP + b * 8 + jj) * NMIXP + D_V + h * 64 + lane]); }
            os[s] = oo / ll;
        }
        const float o = os[0] - lam * os[1]; const float ms = wave_sum(o * o) * (1.0f / 64);
        BR[(size_t)(MP + b * 8 + t) * D + 768 + h * 64 + lane] = (bf16)f2bf(o * rsqrtf(ms + EPS) * C.in[I_SUBLN][l * 64 + lane] * (1.0f - lam_init));
    }
}

__device__ __forceinline__ void n3_la_finalize(const Ctx& C, int l) {
    THREAD_IDS();
    const float* LAO = WSP(float, WS_LAO); const bf16* ZM = WSP(bf16, WS_ZMIX); bf16* BR = WSP(bf16, WS_BR);
    const bool ret = lane < 32; const int hd = (lane >> 3) & 3, c8 = (lane & 7) * 8;
    float gn[8];
#pragma unroll
    for (int j = 0; j < 8; ++j) gn[j] = (ret ? C.in[I_RGN] : C.in[I_GGN])[(l * 4 + hd) * 64 + c8 + j];
    for (int r0 = gw * 4; r0 < MP; r0 += NGW * 4) {
        f32x4 a4[4], b4[4]; v4u g4[4];
#pragma unroll
        for (int u = 0; u < 4; ++u) { const int r = min(r0 + u, MP - 1); a4[u] = *(const f32x4*)(LAO + (size_t)r * 512 + 8 * lane); b4[u] = *(const f32x4*)(LAO + (size_t)r * 512 + 8 * lane + 4);
            g4[u] = *(const v4u*)(ZM + (size_t)r * NMIXP + (ret ? R_G : G_R) + hd * 64 + c8); }
#pragma unroll
        for (int u = 0; u < 4; ++u) { const int r = r0 + u; if (r >= MP) break;
            float x[8] = {a4[u][0], a4[u][1], a4[u][2], a4[u][3], b4[u][0], b4[u][1], b4[u][2], b4[u][3]}, g[8]; unpack8(g4[u], g);
            float s = ((x[0] + x[1]) + (x[2] + x[3])) + ((x[4] + x[5]) + (x[6] + x[7]));
            s += __shfl_xor(s, 1); s += __shfl_xor(s, 2); s += __shfl_xor(s, 4);
            const float mean = ret ? s * (1.0f / 64) : 0.f; float q2 = 0.f;
#pragma unroll
            for (int j = 0; j < 8; ++j) { x[j] -= mean; q2 += x[j] * x[j]; }
            q2 += __shfl_xor(q2, 1); q2 += __shfl_xor(q2, 2); q2 += __shfl_xor(q2, 4);
            const float rs = rsqrtf(q2 * (1.0f / 64) + EPS);
#pragma unroll
            for (int j = 0; j < 8; ++j) x[j] = siluf_(g[j]) * x[j] * rs * gn[j];
            *(v4u*)(BR + (size_t)r * D + 256 + 8 * lane) = pack8(x); }
    }
}

constexpr int NQB_ATT = (L + 127) / 128;
constexpr int IT_LA = 32, IT_SS = IT_LA + DB * 8, IT_AT = IT_SS + 16 * NQB_ATT, IT_LS = IT_AT + 32, IT_CV = IT_LS + (MR + 63) / 64, IT_END = IT_CV;
__device__ __forceinline__ void n2_phase(const Ctx& C, int l, float lam_init, int qslot) {
    THREAD_IDS();
    const float lam = lam_of(C, l, lam_init);
    float mb;
    { float mq = 0.f, mk = 0.f, mbias = 0.f;
#pragma unroll 1
      for (int i = 0; i < 32; ++i) { mq = fmaxf(mq, fabsf(C.in[I_QN][l * 32 + i])); mk = fmaxf(mk, fabsf(C.in[I_KN][l * 32 + i])); }
#pragma unroll 1
      for (int i = 0; i < 128; ++i) mbias = fmaxf(mbias, C.in[I_RELB][i] - C.in[I_RELB][31 * 4 + (i & 3)]);
      mb = 1.02f * 1.4426950408889634f * 5.656854249492381f * mq * mk + 1.4426950408889634f * mbias; }
    unsigned* qw = (unsigned*)(C.ws + WS_CTL) + CW_QUEUE + 64 * qslot;
    volatile LAS int* slot = (volatile LAS int*)(C.lds + MISC_OFF + 64);
    if (blockIdx.x < IT_LA) { const int it = blockIdx.x; const int b = (it >> 2) & 3, h = it & 3; if (it < 16) la_chunked<64, true>(C, l, false, b, h); else la_chunked<32, false>(C, l, false, b, h); }
    for (;;) {
        if (tid == 0) slot[0] = (int)__hip_atomic_fetch_add(qw, 1u, __ATOMIC_RELAXED, __HIP_MEMORY_SCOPE_AGENT);
        __syncthreads();
        const int qi = slot[0];
        const int it = qi < 3 * DB * 8 ? ((qi % 3) ? IT_SS + 2 * (qi / 3) + (qi % 3) - 1 : IT_LA + qi / 3) : qi + IT_LA;
        __syncthreads();
        if (it >= IT_END) break;
        if (it < IT_SS) { const int i2 = it - IT_LA; attn_sample_item(C, l, i2 >> 3, i2 & 7); }
        else if (it < IT_AT) { const int i2 = it - IT_SS; attn_prompt_item(C, l, (i2 & 15) >> 2, i2 & 3, NQB_ATT - 1 - (i2 >> 4), lam, lam_init, mb); }
        else if (it < IT_LS) { const int i2 = (it - IT_AT) * 8 + wave; const int b = (i2 >> 2) & 31, h = i2 & 3; if (i2 < 128) la_seq<64, true>(C, l, true, b, h); else la_seq<32, false>(C, l, true, b, h); }
        else { conv_rows_item(C, l, it - IT_LS); conv_state_item(C, l, it - IT_LS, IT_CV - IT_LS); }
    }
}

template <int l> __device__ __forceinline__ void layer_fwd(const Ctx& C, const XcdBarrier& bar) {
#define GRID_BAR() xcd_barrier<false>(bar)
    LAS unsigned char* ring = C.lds + RING_OFF;
    float* SS = WSP(float, WS_SS); float* H = WSP(float, WS_H); bf16* HB = WSP(bf16, WS_HB); bf16* ACT = WSP(bf16, WS_ACT); bf16* ZMIX = WSP(bf16, WS_ZMIX); bf16* GATES = WSP(bf16, WS_GATES);
    bf16* BR = WSP(bf16, WS_BR); bf16* MERGED = WSP(bf16, WS_MERGED);
    constexpr float lam_init = l == 0 ? 0.2f : 0.35550906759096926f;
    constexpr bool last = (l == DEPTH - 1);
    { pg8::Gemm g{HB, WSP(bf16, WS_W1 + (size_t)(l * 2 + 0) * SZ_W1), D, D, D}; pg8::StaticOrder S; S.init(M, 2 * DFF, C.G, (int)blockIdx.x);
      EpiGLU E{ACT, SS + (size_t)(l * 3 + 0) * M * 16}; pg8::gemm_phase<EpiGLU, pg8::StaticOrder, true, true>(ring, g, S, E); }
    GRID_BAR();
    { pg8::HeadOrder S; S.init(M, D, C.G, (int)blockIdx.x); S.limit = C.G; EpiRes<false, 1> E{H, HB, SS + (size_t)(l * 3 + 1) * M * 16, nullptr};
      { pg8::Gemm g{ACT, WSP(bf16, WS_WD + (size_t)(l * 2 + 0) * SZ_WD), DFF, DFF, DFF}; pg8::gemm_phase<EpiRes<false, 1>, pg8::HeadOrder, true, true>(ring, g, S, E); }
      { int kt = DFF / 11; asm volatile("" : "+s"(kt)); pg8::Gemm g{ACT, WSP(bf16, WS_WD + (size_t)(l * 2 + 0) * SZ_WD), DFF, DFF, kt}; pg8::TailOrder T; T.init(M, D, C.G, (int)blockIdx.x); T.limit = C.G; T.nsplit = 11; T.kper = DFF / 11;
        EpiPartial EP{WSP(float, WS_KSP)}; pg8::gemm_phase<EpiPartial, pg8::TailOrder, true, true>(ring, g, T, EP); }
      GRID_BAR();
      ksp_finalize<11>(WSP(float, WS_KSP), S, C.G, E); }
    GRID_BAR();
    { pg8::Gemm g{HB, WSP(bf16, WS_WIN + (size_t)l * SZ_WIN), D, D, D}; pg8::StaticOrder S; S.init(M, NINP, C.G, (int)blockIdx.x);
      EpiZ E{ZMIX, GATES, SS + (size_t)(l * 3 + 1) * M * 16, WSP(float, WS_BINP) + l * NINP}; pg8::gemm_phase<EpiZ, pg8::StaticOrder, true, true>(ring, g, S, E); }
    GRID_BAR();
    n1_prep(C, l);
    GRID_BAR();
    n2_phase(C, l, lam_init, l);
    GRID_BAR();
    n3_attn_sample_combine(C, l, lam_init);
    n3_la_finalize(C, l);
    GRID_BAR();
    { pg8::Gemm g{BR, WSP(bf16, WS_WBR + (size_t)l * SZ_WBR), D, D, D}; pg8::StaticOrder S; S.init(M, D, C.G, (int)blockIdx.x);
      EpiMergeR E{MERGED, GATES}; pg8::gemm_phase<EpiMergeR, pg8::StaticOrder, true, true, 4>(ring, g, S, E); }
    GRID_BAR();
    { pg8::HeadOrder S; S.init(M, D, C.G, (int)blockIdx.x); S.limit = C.G; EpiRes<false, 2> E{H, HB, SS + (size_t)(l * 3 + 2) * M * 16, nullptr};
      { pg8::Gemm g{MERGED, WSP(bf16, WS_WOUT + (size_t)l * SZ_WOUT), D, D, D}; pg8::gemm_phase<EpiRes<false, 2>, pg8::HeadOrder, true, true>(ring, g, S, E); }
      { int kt = D / 4; asm volatile("" : "+s"(kt)); pg8::Gemm g{MERGED, WSP(bf16, WS_WOUT + (size_t)l * SZ_WOUT), D, D, kt}; pg8::TailOrder T; T.init(M, D, C.G, (int)blockIdx.x); T.limit = C.G; T.nsplit = 4; T.kper = D / 4;
        EpiPartial EP{WSP(float, WS_KSP)}; pg8::gemm_phase<EpiPartial, pg8::TailOrder, true, true>(ring, g, T, EP); }
      GRID_BAR();
      ksp_finalize<4>(WSP(float, WS_KSP), S, C.G, E); }
    GRID_BAR();
    { pg8::Gemm g{HB, WSP(bf16, WS_W1 + (size_t)(l * 2 + 1) * SZ_W1), D, D, D}; pg8::StaticOrder S; S.init(M, 2 * DFF, C.G, (int)blockIdx.x);
      EpiGLU E{ACT, SS + (size_t)(l * 3 + 2) * M * 16}; pg8::gemm_phase<EpiGLU, pg8::StaticOrder, true, true>(ring, g, S, E); }
    GRID_BAR();
    { pg8::HeadOrder S; S.init(M, D, C.G, (int)blockIdx.x); S.limit = C.G; EpiRes<last, 1> E{H, HB, last ? nullptr : SS + (size_t)((l + 1) * 3) * M * 16, C.out};
      { pg8::Gemm g{ACT, WSP(bf16, WS_WD + (size_t)(l * 2 + 1) * SZ_WD), DFF, DFF, DFF}; pg8::gemm_phase<EpiRes<last, 1>, pg8::HeadOrder, true, true>(ring, g, S, E); }
      { int kt = DFF / 11; asm volatile("" : "+s"(kt)); pg8::Gemm g{ACT, WSP(bf16, WS_WD + (size_t)(l * 2 + 1) * SZ_WD), DFF, DFF, kt}; pg8::TailOrder T; T.init(M, D, C.G, (int)blockIdx.x); T.limit = C.G; T.nsplit = 11; T.kper = DFF / 11;
        EpiPartial EP{WSP(float, WS_KSP)}; pg8::gemm_phase<EpiPartial, pg8::TailOrder, true, true>(ring, g, T, EP); }
      GRID_BAR();
      ksp_finalize<11>(WSP(float, WS_KSP), S, C.G, E); }
#undef GRID_BAR
}

__global__ void __launch_bounds__(NWAVES * 64, 2) fwd(Params P) {
    extern __shared__ __attribute__((aligned(16))) unsigned char lds[];
    Ctx C;
    C.in = P.in; C.out = P.out; C.ws = P.ws; C.lds = (LAS unsigned char*)lds;
    C.G = gridDim.x;
    volatile LAS unsigned* MISC = (volatile LAS unsigned*)(C.lds + MISC_OFF);
    for (int u = threadIdx.x; u < (LDS_BYTES - LDSCTL_OFF) / 4; u += NWAVES * 64) ((LAS unsigned*)(C.lds + LDSCTL_OFF))[u] = 0u;
    __syncthreads();
    unsigned* ctl = (unsigned*)(C.ws + WS_CTL);
    XcdBarrier bar = xcd_barrier_post(ctl + CW_BAR, MISC + 8);
    p0_prologue(C, P);
    xcd_barrier<true>(bar);
    layer_fwd<0>(C, bar);
    xcd_barrier<false>(bar);
    layer_fwd<1>(C, bar);
}

extern "C" void kernel_launch(void* const* d_in, const int* in_sizes, int n_in, void* d_out, int out_size, void* d_ws, size_t ws_size, hipStream_t stream) {
    static int grid = 0;
    if (grid == 0) {
        if (n_in != N_INPUTS || (size_t)out_size != O_END || ws_size < WS_END) { fprintf(stderr, "kernel_launch: unexpected shapes: n_in %d out %d (want %zu) ws %zu (want %zu)\n", n_in, out_size, (size_t)O_END, ws_size, (size_t)WS_END); grid = -1; return; }
        int dev = 0, cus = 0, per_cu = 0;
        if (hipGetDevice(&dev) != hipSuccess || hipDeviceGetAttribute(&cus, hipDeviceAttributeMultiprocessorCount, dev) != hipSuccess) { grid = -1; return; }
        if (hipFuncSetAttribute((const void*)fwd, hipFuncAttributeMaxDynamicSharedMemorySize, LDS_BYTES) != hipSuccess) { fprintf(stderr, "kernel_launch: hipFuncSetAttribute failed\n"); grid = -1; return; }
        if (hipOccupancyMaxActiveBlocksPerMultiprocessor(&per_cu, (const void*)fwd, NWAVES * 64, LDS_BYTES) != hipSuccess || per_cu < 1) { fprintf(stderr, "kernel_launch: occupancy query says %d blocks per CU\n", per_cu); }
        (void)hipGetLastError();
        grid = cus;
    }
    if (grid < 0) return;
    if (hipMemsetAsync((char*)d_ws + WS_CTL, 0, CTL_ZERO_BYTES, stream) != hipSuccess) return;
    Params p{};
    for (int i = 0; i < N_INPUTS; ++i) p.in[i] = (const float*)d_in[i];
    p.out = (float*)d_out; p.ws = (unsigned char*)d_ws;
    for (int i = 0; i < 32; ++i) p.inv_freq[i] = (float)pow(10000.0, -(double)i / 32.0);
    hipLaunchKernelGGL(fwd, dim3(grid), dim3(NWAVES * 64), LDS_BYTES, stream, p);
}
```

```cpp
#include <hip/hip_runtime.h>
#include <cstdio>
#include <cstdint>
#include <cmath>

namespace pg8 {
#define PG8_LAS __attribute__((address_space(3)))
typedef unsigned short bf16_t;
typedef short bf16x8 __attribute__((ext_vector_type(8)));
typedef float f32x4 __attribute__((ext_vector_type(4)));
typedef unsigned u32x4 __attribute__((ext_vector_type(4)));
constexpr int BM = 256, BK = 64, HALF = 128, HTB = HALF * BK * 2  , STAGE_BYTES = 8 * HTB, NXCD = 8, WGM = 8;

__host__ __device__ __forceinline__ int lds_byte(int r, int c) { const int st = (r >> 4) * 2 + (c >> 5), rr = r & 15, cc = c & 31, ob = rr * 64 + cc * 2; return st * 1024 + (ob ^ (((ob >> 9) & 1) << 5)); }
__host__ __device__ __forceinline__ void stage_rc(int b, int& R, int& C) { const int st = b / 1024, sb = b % 1024, swz = sb ^ (((sb >> 9) & 1) << 5); R = (st >> 1) * 16 + swz / 64; C = (st & 1) * 32 + (swz % 64) / 2; }
__host__ __device__ __forceinline__ int perm32(int rho) { const int n = rho >> 4, i = rho & 15; return 8 * (i >> 2) + 4 * n + (i & 3); }

struct Unit { int pm, pn, acol, bcol; };
struct Gemm { const bf16_t* A; const bf16_t* Bt; int lda, ldb, K, kseg0; };

struct StaticOrder {
    int nM, nN, nwg, G, c;
    __host__ __device__ void init(int M, int N, int G_, int c_) { nM = M / BM; nN = N / BM; nwg = nM * nN; G = G_; c = c_; }
    __host__ __device__ void unit_of(int L, Unit& u) const {
        int wgid = L; { const int q = nwg / NXCD, r = nwg % NXCD, xcd = wgid % NXCD, off = wgid / NXCD; wgid = (xcd < r ? xcd * (q + 1) : r * (q + 1) + (xcd - r) * q) + off; }
        const int nig = WGM * nN, gid = wgid / nig, fm = gid * WGM, gsz = (nM - fm) < WGM ? (nM - fm) : WGM;
        u.pm = fm + ((wgid % nig) % gsz); u.pn = (wgid % nig) / gsz; u.acol = 0; u.bcol = 0;
    }
    __host__ __device__ bool next(int i, Unit& u) const { const long L = (long)i * G + c; if (L >= nwg) return false; unit_of((int)L, u); return true; }
};
struct HeadOrder : StaticOrder { int limit; __host__ __device__ bool next(int i, Unit& u) const { const long L = (long)i * G + c; if (L >= limit || L >= nwg) return false; unit_of((int)L, u); return true; } };
struct TailOrder : StaticOrder { int limit, nsplit, kper;
    __host__ __device__ bool next(int i, Unit& u) const {
        if (i > 0 || c >= (nwg - limit) * nsplit) return false;
        unit_of(limit + c / nsplit, u); u.acol = u.bcol = (c % nsplit) * kper; return true; } };
__device__ __forceinline__ unsigned cvt_pk_bf16(float lo, float hi) { unsigned r; asm volatile("v_cvt_pk_bf16_f32 %0, %1, %2" : "=v"(r) : "v"(lo), "v"(hi)); return r; }

template <class Epi, class Sched, bool ALIGN_EPI = false, bool SP2 = false, int SEG = 0>
__device__ __forceinline__ void gemm_phase(PG8_LAS unsigned char* lds, const Gemm g, const Sched& S, const Epi& E) {
    int tid_ = threadIdx.x; asm volatile("" : "+v"(tid_));
    const int tid = tid_, wid = __builtin_amdgcn_readfirstlane(tid >> 6), lane = tid & 63, wr = wid >> 2, wc = wid & 3, fr = lane & 15, fq = lane >> 4;
    const int nt = g.K / BK;
    unsigned voffA[2], voffB[2];
#pragma unroll
    for (int i = 0; i < 2; ++i) { int R, C; stage_rc(tid * 16 + i * 8192, R, C); const int Rb = Epi::PERM ? ((R & ~31) + perm32(R & 31)) : R;
        voffA[i] = (unsigned)(R * g.lda + C) * 2u; voffB[i] = (unsigned)(Rb * g.ldb + C) * 2u; }
    const size_t kstep = (size_t)(BK * 2);
    const size_t hstepA = (size_t)HALF * g.lda * 2, hstepB = (size_t)HALF * g.ldb * 2;
    const size_t tstepA = 2 * hstepA, tstepB = 2 * hstepB;
    const unsigned ldsw = (unsigned)wid * 1024u;
    const int aoff = lds_byte(wr * 64 + fr, fq * 8), boff = lds_byte(wc * 32 + fr, fq * 8);
#define PG8_SA(b, h) (((b) * 2 + (h)) * HTB)
#define PG8_SB(b, h) ((4 + (b) * 2 + (h)) * HTB)
#define PG8_STAGE(bufoff, gbase, voff) do { _Pragma("unroll") for (int _i = 0; _i < 2; ++_i) \
        __builtin_amdgcn_global_load_lds((const unsigned*)((const char*)(gbase) + (voff)[_i]), (PG8_LAS unsigned*)(lds + (bufoff) + ldsw + _i * 8192), 16, 0, 0); } while (0)
#define PG8_LDA(dst, b, h) do { _Pragma("unroll") for (int m = 0; m < 4; ++m) _Pragma("unroll") for (int k = 0; k < 2; ++k) dst[m][k] = *(const PG8_LAS bf16x8*)(lds + PG8_SA(b, h) + aoff + m * 2048 + k * 1024); } while (0)
#define PG8_LDB(dst, b, h) do { _Pragma("unroll") for (int n = 0; n < 2; ++n) _Pragma("unroll") for (int k = 0; k < 2; ++k) dst[n][k] = *(const PG8_LAS bf16x8*)(lds + PG8_SB(b, h) + boff + n * 2048 + k * 1024); } while (0)
#define PG8_MMA(ai, bj, At, Bt) do { __builtin_amdgcn_s_setprio(1); _Pragma("unroll") for (int m = 0; m < 4; ++m) _Pragma("unroll") for (int n = 0; n < 2; ++n) _Pragma("unroll") for (int k = 0; k < 2; ++k) \
        acc[ai][bj][m][n] = __builtin_amdgcn_mfma_f32_16x16x32_bf16(Bt[n][k], At[m][k], acc[ai][bj][m][n], 0, 0, 0); __builtin_amdgcn_s_setprio(0); } while (0)
#define PG8_WAIT_V(n) asm volatile("s_waitcnt vmcnt(" #n ")" ::: "memory")
#define PG8_WAIT_L(n) asm volatile("s_waitcnt lgkmcnt(" #n ")" ::: "memory")
#define PG8_BAR __builtin_amdgcn_s_barrier()
#define PG8_SCHED __builtin_amdgcn_sched_barrier(0)
    Unit cur, nxt; int ui = 0;
    if (!S.next(0, cur)) return;
    f32x4 acc[2][2][4][2];
#pragma unroll
    for (int a = 0; a < 2; ++a)
#pragma unroll
        for (int b = 0; b < 2; ++b)
#pragma unroll
            for (int m = 0; m < 4; ++m)
#pragma unroll
                for (int n = 0; n < 2; ++n) acc[a][b][m][n] = (f32x4){0.f, 0.f, 0.f, 0.f};
    bf16x8 At[4][2], B0[2][2], B1[2][2];
    const char* cA = (const char*)g.A + (size_t)cur.pm * tstepA + (size_t)cur.acol * 2; const char* cB = (const char*)g.Bt + (size_t)cur.pn * tstepB + (size_t)cur.bcol * 2;
#define PG8_KOFF(t) ((SEG > 0) ? (size_t)(((((t) / (SEG > 0 ? SEG : 1)) + g.kseg0) & (nt / (SEG > 0 ? SEG : 1) - 1)) * (SEG > 0 ? SEG : 1) + ((t) % (SEG > 0 ? SEG : 1))) * kstep : (size_t)(t) * kstep)
    const size_t K0 = PG8_KOFF(0);
    cA += K0; cB += K0;
    if constexpr (SP2) {
        PG8_STAGE(PG8_SB(0, 0), cB, voffB); PG8_STAGE(PG8_SB(0, 1), cB + hstepB, voffB); PG8_STAGE(PG8_SA(0, 0), cA, voffA); PG8_STAGE(PG8_SA(0, 1), cA + hstepA, voffA);
        if (wr == 1) PG8_BAR;
        PG8_WAIT_V(2); PG8_BAR;
        PG8_STAGE(PG8_SB(1, 0), cB + kstep, voffB); PG8_STAGE(PG8_SA(1, 0), cA + kstep, voffA); PG8_STAGE(PG8_SB(1, 1), cB + hstepB + kstep, voffB);
        PG8_WAIT_V(6); PG8_BAR;
    } else {
        PG8_STAGE(PG8_SB(0, 0), cB, voffB); PG8_STAGE(PG8_SA(0, 0), cA, voffA); PG8_STAGE(PG8_SB(0, 1), cB + hstepB, voffB); PG8_STAGE(PG8_SA(0, 1), cA + hstepA, voffA);
        if (wr == 1) PG8_BAR;
        PG8_WAIT_V(4); PG8_BAR;
        PG8_STAGE(PG8_SB(1, 0), cB + kstep, voffB); PG8_STAGE(PG8_SA(1, 0), cA + kstep, voffA); PG8_STAGE(PG8_SB(1, 1), cB + hstepB + kstep, voffB);
        PG8_WAIT_V(6); PG8_BAR;
    }
    for (;;) {
        const bool has_next = S.next(ui + 1, nxt);
        const char* nA = has_next ? (const char*)g.A + (size_t)nxt.pm * tstepA + (size_t)nxt.acol * 2 + K0 : cA; const char* nB = has_next ? (const char*)g.Bt + (size_t)nxt.pn * tstepB + (size_t)nxt.bcol * 2 + K0 : cB;
        for (int t = 0; t < nt; t += 2) {
            const bool last = (t == nt - 2);
            const char* a1 = cA - K0 + PG8_KOFF(t + 1);
            const char* a2 = last ? nA : cA - K0 + PG8_KOFF(t + 2); const char* b2 = last ? nB : cB - K0 + PG8_KOFF(t + 2);
            const char* a3 = a2 + kstep; const char* b3 = b2 + kstep;
            if constexpr (SP2) {
            PG8_LDB(B0, 0, 0); PG8_LDB(B1, 0, 1); PG8_SCHED; PG8_LDA(At, 0, 0); PG8_STAGE(PG8_SA(1, 1), a1 + hstepA, voffA);
            PG8_WAIT_V(8); PG8_WAIT_L(0); PG8_BAR; PG8_MMA(0, 0, At, B0); PG8_MMA(0, 1, At, B1); PG8_BAR; PG8_SCHED;
            PG8_LDA(At, 0, 1); PG8_STAGE(PG8_SB(0, 0), b2, voffB); PG8_STAGE(PG8_SB(0, 1), b2 + hstepB, voffB); PG8_STAGE(PG8_SA(0, 0), a2, voffA);
            PG8_WAIT_V(8); PG8_WAIT_L(0); PG8_BAR; PG8_MMA(1, 0, At, B0); PG8_MMA(1, 1, At, B1); PG8_BAR; PG8_SCHED;
            PG8_LDB(B0, 1, 0); PG8_LDB(B1, 1, 1); PG8_SCHED; PG8_LDA(At, 1, 0); PG8_STAGE(PG8_SA(0, 1), a2 + hstepA, voffA);
            PG8_WAIT_V(8); PG8_WAIT_L(0); PG8_BAR; PG8_MMA(0, 0, At, B0); PG8_MMA(0, 1, At, B1); PG8_BAR; PG8_SCHED;
            PG8_LDA(At, 1, 1); PG8_STAGE(PG8_SB(1, 0), b3, voffB); PG8_STAGE(PG8_SB(1, 1), b3 + hstepB, voffB); PG8_STAGE(PG8_SA(1, 0), a3, voffA);
            PG8_WAIT_V(8); PG8_WAIT_L(0); PG8_BAR; PG8_MMA(1, 0, At, B0); PG8_MMA(1, 1, At, B1); PG8_BAR; PG8_SCHED;
            } else {
            PG8_LDB(B0, 0, 0); PG8_SCHED; PG8_LDA(At, 0, 0); PG8_STAGE(PG8_SA(1, 1), a1 + hstepA, voffA);
            PG8_WAIT_L(8); PG8_BAR; PG8_WAIT_L(0); PG8_MMA(0, 0, At, B0); PG8_BAR; PG8_SCHED;
            PG8_LDB(B1, 0, 1); PG8_STAGE(PG8_SB(0, 0), b2, voffB);
            PG8_BAR; PG8_WAIT_L(0); PG8_MMA(0, 1, At, B1); PG8_BAR;
            PG8_LDA(At, 0, 1); PG8_STAGE(PG8_SA(0, 0), a2, voffA);
            PG8_BAR; PG8_WAIT_L(0); PG8_MMA(1, 0, At, B0); PG8_BAR; PG8_SCHED;
            PG8_STAGE(PG8_SB(0, 1), b2 + hstepB, voffB);
            PG8_WAIT_V(6); PG8_BAR; PG8_MMA(1, 1, At, B1); PG8_BAR;
            PG8_LDB(B0, 1, 0); PG8_SCHED; PG8_LDA(At, 1, 0); PG8_STAGE(PG8_SA(0, 1), a2 + hstepA, voffA);
            PG8_WAIT_L(8); PG8_BAR; PG8_WAIT_L(0); PG8_MMA(0, 0, At, B0); PG8_BAR; PG8_SCHED;
            PG8_LDB(B1, 1, 1); PG8_STAGE(PG8_SB(1, 0), b3, voffB);
            PG8_BAR; PG8_WAIT_L(0); PG8_MMA(0, 1, At, B1); PG8_BAR;
            PG8_LDA(At, 1, 1); PG8_STAGE(PG8_SA(1, 0), a3, voffA);
            PG8_BAR; PG8_WAIT_L(0); PG8_MMA(1, 0, At, B0); PG8_BAR; PG8_SCHED;
            PG8_STAGE(PG8_SB(1, 1), b3 + hstepB, voffB);
            PG8_WAIT_V(6); PG8_BAR; PG8_MMA(1, 1, At, B1); PG8_BAR;
            }
            if constexpr (SEG > 0) { if (((t + 2) % SEG) == 0 && (t + 2) < nt) E.mid(acc, cur, (t + 2) / SEG, g.kseg0); }
        }
        if constexpr (ALIGN_EPI) { if (wr == 0) PG8_BAR; }
        E(acc, cur, wr, wc, fr, fq);
        if (!has_next) break;
#pragma unroll
        for (int a = 0; a < 2; ++a)
#pragma unroll
            for (int b = 0; b < 2; ++b)
#pragma unroll
                for (int m = 0; m < 4; ++m)
#pragma unroll
                    for (int n = 0; n < 2; ++n) acc[a][b][m][n] = (f32x4){0.f, 0.f, 0.f, 0.f};
        cur = nxt; cA = nA; cB = nB; ++ui;
        if constexpr (ALIGN_EPI) { if (wr == 1) PG8_BAR; }
    }
    PG8_WAIT_V(0);
    if constexpr (!ALIGN_EPI) { if (wr == 0) PG8_BAR; }
    PG8_BAR;
#undef PG8_KOFF
#undef PG8_SA
#undef PG8_SB
#undef PG8_STAGE
#undef PG8_LDA
#undef PG8_LDB
#undef PG8_MMA
#undef PG8_WAIT_V
#undef PG8_WAIT_L
#undef PG8_BAR
#undef PG8_SCHED
}
}

constexpr int NWAVES = 8;
constexpr int D = 1024, DFF = 2816, NIN = 7184, NMIX = 3088, NMIXP = 3328, NGATE = 4096, NINP = NMIXP + NGATE;
constexpr int SEQ = 4096, NMETA = 16, L = SEQ + NMETA, BATCH = 4, DB = 32, DS = 8, PAST = 8192, PAGE = 128, NPAGES = PAST / PAGE, NPOOL = 2560, DEPTH = 2;
constexpr int MP = BATCH * L, MS = DB * DS, MR = MP + MS, M = 16896;
constexpr int NPOS = L + DS;
constexpr float EPS = 1e-6f;
constexpr int C_A = 0, C_G = 256, R_Q = 512, R_K = 768, R_V = 1024, R_G = 1280, G_Q = 1536, G_K = 1664, G_V = 1792, G_R = 2048, G_LOW = 2304, D_Q = 2320, D_K = 2576, D_V = 2832;
constexpr size_t O_YP = 0, O_YS = O_YP + (size_t)BATCH * SEQ * D, O_KP = O_YS + (size_t)MS * D, O_VP = O_KP + (size_t)DEPTH * MP * 256, O_KS = O_VP + (size_t)DEPTH * MP * 256,
                 O_VS = O_KS + (size_t)DEPTH * MS * 256, O_RP = O_VS + (size_t)DEPTH * MS * 256, O_RS = O_RP + (size_t)DEPTH * BATCH * 4 * 64 * 64, O_GP = O_RS + (size_t)DEPTH * DB * 4 * 64 * 64,
                 O_GS = O_GP + (size_t)DEPTH * BATCH * 4 * 32 * 64, O_CP = O_GS + (size_t)DEPTH * DB * 4 * 32 * 64, O_CS = O_CP + (size_t)DEPTH * BATCH * 30 * 256, O_END = O_CS + (size_t)DEPTH * DB * 30 * 256;
enum { I_XP = 0, I_XS, I_CK, I_CV, I_PT, I_SRET, I_SGLA, I_SCONV, I_META, I_RELB, I_NF1, I_F1G, I_F1U, I_F1D, I_NMIX, I_WIN, I_BIN, I_CW, I_CB, I_CLG, I_CLB, I_RGN, I_GAW, I_GAB, I_GGN,
       I_QN, I_KN, I_LQ1, I_LK1, I_LQ2, I_LK2, I_SUBLN, I_WBR, I_WOUT, I_NF2, I_F2G, I_F2U, I_F2D, N_INPUTS };

constexpr size_t MiB = 1u << 20;
constexpr size_t WS_CTL = 0, CTL_ZERO_BYTES = 1 * MiB;
constexpr size_t SZ_SS = (size_t)M * 16 * 4;
constexpr size_t SZ_W1 = (size_t)2 * DFF * D * 2, SZ_WD = (size_t)D * DFF * 2, SZ_WIN = (size_t)NINP * D * 2, SZ_WBR = (size_t)4 * D * 256 * 2, SZ_WOUT = (size_t)D * D * 2;
constexpr size_t WS_W1 = 4 * MiB;
constexpr size_t WS_WD = WS_W1 + 4 * SZ_W1;
constexpr size_t WS_WIN = WS_WD + 4 * SZ_WD;
constexpr size_t WS_WBR = WS_WIN + 2 * SZ_WIN;
constexpr size_t WS_WOUT = WS_WBR + 2 * SZ_WBR;
constexpr size_t WS_BINP = WS_WOUT + 2 * SZ_WOUT;
constexpr size_t WS_ROPE = WS_BINP + 64 * 1024;
constexpr size_t WS_SS = WS_ROPE + 2 * MiB;
constexpr size_t WS_H = 128 * MiB;
constexpr size_t WS_HB = WS_H + (size_t)M * D * 4;
constexpr size_t WS_ACT = WS_HB + (size_t)M * D * 2;
constexpr size_t WS_ZMIX = WS_ACT + (size_t)M * DFF * 2;
constexpr size_t WS_GATES = WS_ZMIX + (size_t)M * NMIXP * 2;
constexpr size_t WS_BR = WS_GATES + (size_t)M * NGATE * 2;
constexpr size_t WS_MERGED = WS_BR + (size_t)M * D * 2;
constexpr size_t WS_UBUF = WS_MERGED + (size_t)M * D * 2;
constexpr size_t WS_RQ = WS_UBUF + (size_t)M * 256 * 4, WS_RK = WS_RQ + (size_t)M * 256 * 4, WS_QN = WS_RK + (size_t)M * 256 * 4, WS_KN = WS_QN + (size_t)M * 256 * 4, WS_VB = WS_KN + (size_t)M * 256 * 4;
constexpr size_t WS_LDEC = WS_VB + (size_t)M * 256 * 4;
constexpr size_t WS_QNB = WS_LDEC + (size_t)M * 128 * 4;
constexpr size_t WS_KNB = WS_QNB + (size_t)M * 256 * 2;
constexpr size_t WS_PART = WS_KNB + (size_t)M * 256 * 2;
constexpr size_t WS_LAO = WS_PART + (size_t)DB * 4 * 16 * 16 * 68 * 4;
constexpr size_t WS_KSP = WS_LAO + (size_t)M * 512 * 4;
constexpr size_t WS_END = WS_KSP + (size_t)8 * 11 * 65536 * 4;
static_assert(WS_ROPE + 2 * NPOS * 32 * 4 <= WS_SS && WS_SS + 6 * SZ_SS <= WS_H, "weights region overflows");
constexpr int CW_BAR = 4096, CW_QUEUE = 8192;

constexpr int RING_OFF = 0, RING_BYTES = 131072;
constexpr int LDSCTL_OFF = 144384, MISC_OFF = LDSCTL_OFF + 320;
constexpr int LDS_BYTES = 147456;
static_assert(MISC_OFF + 128 <= LDS_BYTES, "LDS map");

#define GAS __attribute__((address_space(1)))
#define LAS __attribute__((address_space(3)))
typedef unsigned short bf16;
typedef unsigned v4u __attribute__((ext_vector_type(4)));
typedef float f32x4 __attribute__((ext_vector_type(4)));
#define LDS_WAIT() asm volatile("s_waitcnt lgkmcnt(0)" ::: "memory")
#define VM_WAIT() asm volatile("s_waitcnt vmcnt(0)" ::: "memory")
__device__ __forceinline__ unsigned f2bf(float f) { unsigned u = __builtin_bit_cast(unsigned, f); return (u + 0x7fffu + ((u >> 16) & 1u)) >> 16; }
__device__ __forceinline__ unsigned pk2(float lo, float hi) { return f2bf(lo) | (f2bf(hi) << 16); }
__device__ __forceinline__ float bf2f(bf16 b) { return __builtin_bit_cast(float, ((unsigned)b) << 16); }
__device__ __forceinline__ float bflo(unsigned w) { return __builtin_bit_cast(float, w << 16); }
__device__ __forceinline__ float bfhi(unsigned w) { return __builtin_bit_cast(float, w & 0xffff0000u); }
__device__ __forceinline__ float wave_sum(float v) {
#pragma unroll
    for (int o = 1; o < 64; o <<= 1) v += __shfl_xor(v, o);
    return v;
}
__device__ __forceinline__ float sigmoidf_(float x) { return __builtin_amdgcn_rcpf(1.0f + __expf(-x)); }
__device__ __forceinline__ float siluf_(float x) { return x * __builtin_amdgcn_rcpf(1.0f + __expf(-x)); }

#define XB_TMO      128
#define XB_XCNT(j)  (256  + 64 * (j))
#define XB_XSUB(j)  (1280 + 64 * (j))
#define XB_XGEN(j)  (2304 + 64 * (j))
#define XB_TOP      3328
#define XB_TOPGEN   3392
#define XCD_BAR_WORDS 3456
#define XB_SPIN_CAP (1u << 22)

__device__ __forceinline__ unsigned xb_ld(unsigned* p)              { return __hip_atomic_load(p, __ATOMIC_RELAXED, __HIP_MEMORY_SCOPE_AGENT); }
__device__ __forceinline__ unsigned xb_add(unsigned* p, unsigned v) { return __hip_atomic_fetch_add(p, v, __ATOMIC_RELAXED, __HIP_MEMORY_SCOPE_AGENT); }
__device__ __forceinline__ unsigned xb_xcc_id() { return (unsigned)__builtin_amdgcn_s_getreg((3 << 11) | 20) & 0xFu; }
#define XB_SPIN(cond, bar) do { unsigned _sp = 0; while (cond) { __builtin_amdgcn_s_sleep(1); \
    if ((++_sp & 255u) == 0u) { if (xb_ld(&(bar)[XB_TMO])) break; if (_sp > XB_SPIN_CAP) { atomicAdd(&(bar)[XB_TMO], 1u); break; } } } } while (0)

struct XcdBarrier { unsigned* bar; unsigned x; volatile LAS unsigned* st; };

__device__ __forceinline__ XcdBarrier xcd_barrier_post(unsigned* bar, volatile LAS unsigned* st) {
    XcdBarrier b; b.bar = bar; b.x = xb_xcc_id(); b.st = st;
    if (threadIdx.x == 0) (void)xb_add(&bar[XB_XCNT(b.x)], 1u);
    return b;
}
__device__ __forceinline__ void xcd_barrier_complete(unsigned* bar, unsigned x, unsigned& nloc, unsigned& nx) {
    const unsigned G = gridDim.x * gridDim.y * gridDim.z;
    unsigned sum, cnt, mine, sp = 0u;
    for (;;) {
        sum = 0u; cnt = 0u; mine = 0u;
#pragma unroll
        for (unsigned j = 0; j < 16; ++j) { const unsigned c = xb_ld(&bar[XB_XCNT(j)]); sum += c; cnt += (c > 0u) ? 1u : 0u; mine = (j == x) ? c : mine; }
        if (sum == G) break;
        __builtin_amdgcn_s_sleep(1);
        if ((++sp & 255u) == 0u) { if (xb_ld(&bar[XB_TMO])) break; if (sp > XB_SPIN_CAP) { atomicAdd(&bar[XB_TMO], 1u); break; } }
    }
    nloc = mine > 0u ? mine : 1u; nx = cnt > 0u ? cnt : 1u;
}
#ifndef FLAT_BAR
#define FLAT_BAR 0
#endif
__device__ __forceinline__ void flat_barrier(const XcdBarrier& b) {
    asm volatile("s_waitcnt vmcnt(0)" ::: "memory");
    __syncthreads();
    if (threadIdx.x == 0) {
        unsigned* bar = b.bar;
        asm volatile("" : "+s"(bar));
        const unsigned epoch = b.st[2] + 1u; b.st[2] = epoch; const unsigned target = epoch * gridDim.x;
        __builtin_amdgcn_fence(__ATOMIC_RELEASE, "agent");
        asm volatile("s_waitcnt vmcnt(0)" ::: "memory");
        (void)xb_add(&bar[XB_TOP], 1u);
        unsigned sp = 0u;
        while (xb_ld(&bar[XB_TOP]) < target) { __builtin_amdgcn_s_sleep(1); if ((++sp & 255u) == 0u) { if (xb_ld(&bar[XB_TMO])) break; if (sp > XB_SPIN_CAP) { atomicAdd(&bar[XB_TMO], 1u); break; } } }
        __builtin_amdgcn_fence(__ATOMIC_ACQUIRE, "agent");
        asm volatile("s_waitcnt vmcnt(0)" ::: "memory");
    }
    __syncthreads();
}
template <bool FIRST> __device__ __forceinline__ void xcd_barrier(const XcdBarrier& b) {
    if (FLAT_BAR) { flat_barrier(b); return; }
    asm volatile("s_waitcnt vmcnt(0)" ::: "memory");
    __syncthreads();
    if (threadIdx.x == 0) {
        unsigned* bar = b.bar;
        asm volatile("" : "+s"(bar));
        __builtin_amdgcn_s_waitcnt(0);
        unsigned nloc = b.st[0], nx = b.st[1];
        if (FIRST) { if (nloc == 0u) { xcd_barrier_complete(bar, b.x, nloc, nx); b.st[0] = nloc; b.st[1] = nx; } }
        const unsigned old = xb_add(&bar[XB_XSUB(b.x)], 1u);
        const unsigned gen = old / nloc;
        if (old + 1u == (gen + 1u) * nloc) {
            __builtin_amdgcn_fence(__ATOMIC_RELEASE, "agent");
            asm volatile("s_waitcnt vmcnt(0)" ::: "memory");
            const unsigned og = xb_add(&bar[XB_TOP], 1u);
            const unsigned tg = og / nx;
            if (og + 1u == (tg + 1u) * nx) {
#pragma unroll
                for (unsigned j = 0; j < 16; ++j) (void)__hip_atomic_fetch_add(&bar[XB_XGEN(j)], 1u, __ATOMIC_RELAXED, __HIP_MEMORY_SCOPE_AGENT);
            }
        }
        XB_SPIN(xb_ld(&bar[XB_XGEN(b.x)]) == gen, bar);
        __builtin_amdgcn_fence(__ATOMIC_ACQUIRE, "agent");
        asm volatile("s_waitcnt vmcnt(0)" ::: "memory");
    }
    __syncthreads();
}

struct Params { const float* in[N_INPUTS]; float* out; unsigned char* ws; float inv_freq[32]; };
static_assert(sizeof(Params) == N_INPUTS * 8 + 16 + 128, "Params has no padding");

struct Ctx {
    const float* const* in; float* out; unsigned char* ws;
    LAS unsigned char* lds;
    int G;
};
#define THREAD_IDS() int tid_ = threadIdx.x; asm volatile("" : "+v"(tid_)); const int tid = tid_, lane = tid & 63, wave = __builtin_amdgcn_readfirstlane(tid >> 6), gw = blockIdx.x * NWAVES + wave, NGW = C.G * NWAVES; (void)tid; (void)lane; (void)wave; (void)gw; (void)NGW
#define WSP(T, off) ((T*)(C.ws + (off)))

__device__ __forceinline__ float rstd_of(const float* ssp, int row) {
    const f32x4 a = *(const f32x4*)(ssp + (size_t)row * 16), b = *(const f32x4*)(ssp + (size_t)row * 16 + 4), c = *(const f32x4*)(ssp + (size_t)row * 16 + 8), d = *(const f32x4*)(ssp + (size_t)row * 16 + 12);
    const float s = (((a[0] + a[1]) + (a[2] + a[3])) + ((b[0] + b[1]) + (b[2] + b[3]))) + (((c[0] + c[1]) + (c[2] + c[3])) + ((d[0] + d[1]) + (d[2] + d[3])));
    return rsqrtf(s * (1.0f / D) + EPS);
}
#define EPI_IDS() int t_ = threadIdx.x; asm volatile("" : "+v"(t_)); const int wid_ = __builtin_amdgcn_readfirstlane(t_ >> 6), wr = wid_ >> 2, wc = wid_ & 3, fr = t_ & 15, fq = (t_ & 63) >> 4
struct EpiGLU {
    static constexpr bool PERM = true;
    bf16* act; const float* ss;
    __device__ __forceinline__ void operator()(const pg8::f32x4 (&acc)[2][2][4][2], const pg8::Unit& u, int, int, int, int) const {
        EPI_IDS();
        const int row0 = u.pm * 256 + wr * 64 + fr, col0 = u.pn * 128 + wc * 32 + 8 * fq;
#pragma unroll
        for (int ai = 0; ai < 2; ++ai)
#pragma unroll
            for (int m = 0; m < 4; ++m) {
                const int row = row0 + ai * 128 + m * 16; const float rstd = rstd_of(ss, row);
                float o[8];
#pragma unroll
                for (int n = 0; n < 2; ++n)
#pragma unroll
                    for (int j = 0; j < 4; ++j) { const float g = acc[ai][0][m][n][j] * rstd, up = acc[ai][1][m][n][j] * rstd; o[n * 4 + j] = siluf_(g) * up; }
                v4u w; w.x = pg8::cvt_pk_bf16(o[0], o[1]); w.y = pg8::cvt_pk_bf16(o[2], o[3]); w.z = pg8::cvt_pk_bf16(o[4], o[5]); w.w = pg8::cvt_pk_bf16(o[6], o[7]);
                *(v4u*)(act + (size_t)row * DFF + col0) = w;
            }
    }
};
template <bool FINAL, int SCALE2> struct EpiRes {
    static constexpr bool PERM = true;
    float* h; bf16* hb; float* ssout; float* out;
    __device__ __forceinline__ void rowgroup(const pg8::f32x4 (&a)[2][2], int row, int col0, int pn, int wc, int fq) const {
        constexpr float scale = 0.5f * SCALE2; float sq = 0.f;
        long yoff = -1;
        if (FINAL) { if (row < MP) { const int b = row / L, pos = row - b * L; if (pos >= NMETA) yoff = (long)O_YP + ((long)b * SEQ + (pos - NMETA)) * D; } else if (row < MR) yoff = (long)O_YS + (long)(row - MP) * D; }
#pragma unroll
        for (int bj = 0; bj < 2; ++bj) {
            const size_t off = (size_t)row * D + col0 + bj * 128;
            f32x4 h0 = *(const f32x4*)(h + off), h1 = *(const f32x4*)(h + off + 4);
            h0 = h0 + a[bj][0] * scale; h1 = h1 + a[bj][1] * scale;
            *(f32x4*)(h + off) = h0; *(f32x4*)(h + off + 4) = h1;
            v4u w; w.x = pg8::cvt_pk_bf16(h0[0], h0[1]); w.y = pg8::cvt_pk_bf16(h0[2], h0[3]); w.z = pg8::cvt_pk_bf16(h1[0], h1[1]); w.w = pg8::cvt_pk_bf16(h1[2], h1[3]);
            *(v4u*)(hb + off) = w;
            sq += (h0[0] * h0[0] + h0[1] * h0[1]) + (h0[2] * h0[2] + h0[3] * h0[3]) + (h1[0] * h1[0] + h1[1] * h1[1]) + (h1[2] * h1[2] + h1[3] * h1[3]);
            if (FINAL && yoff >= 0) { *(f32x4*)(out + yoff + col0 + bj * 128) = h0; *(f32x4*)(out + yoff + col0 + bj * 128 + 4) = h1; }
        }
        sq += __shfl_xor(sq, 16); sq += __shfl_xor(sq, 32);
        if (fq == 0 && ssout) ssout[(size_t)row * 16 + pn * 4 + wc] = sq;
    }
    __device__ __forceinline__ void operator()(const pg8::f32x4 (&acc)[2][2][4][2], const pg8::Unit& u, int, int, int, int) const {
        EPI_IDS();
        const int row0 = u.pm * 256 + wr * 64 + fr, col0 = u.pn * 256 + wc * 32 + 8 * fq;
#pragma unroll
        for (int ai = 0; ai < 2; ++ai)
#pragma unroll
            for (int m = 0; m < 4; ++m) {
                const pg8::f32x4 a[2][2] = {{acc[ai][0][m][0], acc[ai][0][m][1]}, {acc[ai][1][m][0], acc[ai][1][m][1]}};
                rowgroup(a, row0 + ai * 128 + m * 16, col0, u.pn, wc, fq);
                if (m == 3) asm volatile("" ::: "memory");
            }
    }
};
struct EpiZ {
    static constexpr bool PERM = true;
    bf16* zmix; bf16* gates; const float* ss; const float* bias;
    __device__ __forceinline__ void operator()(const pg8::f32x4 (&acc)[2][2][4][2], const pg8::Unit& u, int, int, int, int) const {
        EPI_IDS();
        const int row0 = u.pm * 256 + wr * 64 + fr, col0 = u.pn * 256 + wc * 32 + 8 * fq; const bool isgate = u.pn >= NMIXP / 256;
        f32x4 bv[2][2];
#pragma unroll
        for (int bj = 0; bj < 2; ++bj)
#pragma unroll
            for (int n = 0; n < 2; ++n) bv[bj][n] = *(const f32x4*)(bias + col0 + bj * 128 + 4 * n);
#pragma unroll
        for (int ai = 0; ai < 2; ++ai)
#pragma unroll
            for (int m = 0; m < 4; ++m) {
                const int row = row0 + ai * 128 + m * 16; const float rstd = rstd_of(ss, row);
                if (isgate) {
                    f32x4 g[4];
#pragma unroll
                    for (int bj = 0; bj < 2; ++bj)
#pragma unroll
                        for (int n = 0; n < 2; ++n) { const f32x4 z = acc[ai][bj][m][n] * rstd + bv[bj][n];
#pragma unroll
                            for (int j = 0; j < 4; ++j) g[2 * bj + n][j] = fmaxf(sigmoidf_(z[j]), 9.094947017729282e-13f); }
                    const int d0 = 64 * (u.pn - NMIXP / 256) + 16 * wc + 4 * fq; bf16* gp = gates + (size_t)row * NGATE + d0;
#pragma unroll
                    for (int s = 0; s < 4; ++s) { f32x4 o = g[s];
                        if (s < 3) {
#pragma unroll
                            for (int j = 0; j < 4; ++j) o[j] = g[s][j] * __builtin_amdgcn_rcpf(g[s + 1][j]); }
                        *(unsigned long long*)(gp + s * D) = (unsigned long long)pg8::cvt_pk_bf16(o[0], o[1]) | ((unsigned long long)pg8::cvt_pk_bf16(o[2], o[3]) << 32); }
                } else {
#pragma unroll
                    for (int bj = 0; bj < 2; ++bj) {
                        const f32x4 v0 = acc[ai][bj][m][0] * rstd + bv[bj][0], v1 = acc[ai][bj][m][1] * rstd + bv[bj][1];
                        v4u w; w.x = pg8::cvt_pk_bf16(v0[0], v0[1]); w.y = pg8::cvt_pk_bf16(v0[2], v0[3]); w.z = pg8::cvt_pk_bf16(v1[0], v1[1]); w.w = pg8::cvt_pk_bf16(v1[2], v1[3]);
                        *(v4u*)(zmix + (size_t)row * NMIXP + col0 + bj * 128) = w;
                    }
                }
            }
    }
};
struct EpiPartial {
    static constexpr bool PERM = true;
    float* part;
    __device__ __forceinline__ void operator()(const pg8::f32x4 (&acc)[2][2][4][2], const pg8::Unit& u, int, int, int, int) const {
        int t_ = threadIdx.x; asm volatile("" : "+v"(t_));
        const int slot = blockIdx.x;
        float* p = part + (size_t)slot * 65536 + (size_t)t_ * 4;
#pragma unroll
        for (int ai = 0; ai < 2; ++ai)
#pragma unroll
            for (int bj = 0; bj < 2; ++bj)
#pragma unroll
                for (int m = 0; m < 4; ++m)
#pragma unroll
                    for (int n = 0; n < 2; ++n) *(pg8::f32x4*)(p + (size_t)((((ai * 2 + bj) * 4 + m) * 2 + n) * 2048)) = acc[ai][bj][m][n];
        (void)u;
    }
};
template <int NSPLIT, class Epi> __device__ __forceinline__ void ksp_finalize(const float* part, const pg8::StaticOrder& so, int limit, const Epi& E) {
    const int ntail = so.nwg - limit;
    for (int it = blockIdx.x; it < ntail * 8; it += gridDim.x) {
        const int tt = it >> 3, ai = (it >> 2) & 1, m = it & 3;
        EPI_IDS();
        pg8::f32x4 a[2][2];
#pragma unroll
        for (int bj = 0; bj < 2; ++bj)
#pragma unroll
            for (int n = 0; n < 2; ++n) { pg8::f32x4 s = {0.f, 0.f, 0.f, 0.f};
#pragma unroll
                for (int k = 0; k < NSPLIT; ++k) s = s + *(const pg8::f32x4*)(part + (size_t)(tt * NSPLIT + k) * 65536 + (size_t)((((ai * 2 + bj) * 4 + m) * 2 + n) * 2048) + (size_t)t_ * 4);
                a[bj][n] = s; }
        pg8::Unit u; so.unit_of(limit + tt, u);
        E.rowgroup(a, u.pm * 256 + wr * 64 + fr + ai * 128 + m * 16, u.pn * 256 + wc * 32 + 8 * fq, u.pn, wc, fq);
    }
}

struct EpiMergeR {
    static constexpr bool PERM = true;
    bf16* merged; const bf16* gates;
    __device__ __forceinline__ void mid(pg8::f32x4 (&acc)[2][2][4][2], const pg8::Unit& u, int seg, int) const {
        EPI_IDS();
        const int row0 = u.pm * 256 + wr * 64 + fr, col0 = u.pn * 256 + wc * 32 + 8 * fq;
#pragma unroll
        for (int ai = 0; ai < 2; ++ai) {
#pragma unroll
            for (int m = 0; m < 4; ++m) {
                const int row = row0 + ai * 128 + m * 16;
#pragma unroll
                for (int bj = 0; bj < 2; ++bj) {
                    const v4u r = *(const v4u*)(gates + (size_t)row * NGATE + (seg - 1) * D + col0 + bj * 128);
                    pg8::f32x4& a0 = acc[ai][bj][m][0]; pg8::f32x4& a1 = acc[ai][bj][m][1];
                    a0[0] *= bflo(r.x); a0[1] *= bfhi(r.x); a0[2] *= bflo(r.y); a0[3] *= bfhi(r.y); a1[0] *= bflo(r.z); a1[1] *= bfhi(r.z); a1[2] *= bflo(r.w); a1[3] *= bfhi(r.w);
                }
            }
        }
    }
    __device__ __forceinline__ void operator()(const pg8::f32x4 (&acc)[2][2][4][2], const pg8::Unit& u, int, int, int, int) const {
        EPI_IDS();
        const int row0 = u.pm * 256 + wr * 64 + fr, col0 = u.pn * 256 + wc * 32 + 8 * fq;
#pragma unroll
        for (int ai = 0; ai < 2; ++ai)
#pragma unroll
            for (int m = 0; m < 4; ++m) {
                const int row = row0 + ai * 128 + m * 16;
#pragma unroll
                for (int bj = 0; bj < 2; ++bj) {
                    const v4u g = *(const v4u*)(gates + (size_t)row * NGATE + 3 * D + col0 + bj * 128);
                    const pg8::f32x4 a0 = acc[ai][bj][m][0], a1 = acc[ai][bj][m][1];
                    v4u w; w.x = pg8::cvt_pk_bf16(a0[0] * bflo(g.x), a0[1] * bfhi(g.x)); w.y = pg8::cvt_pk_bf16(a0[2] * bflo(g.y), a0[3] * bfhi(g.y));
                    w.z = pg8::cvt_pk_bf16(a1[0] * bflo(g.z), a1[1] * bfhi(g.z)); w.w = pg8::cvt_pk_bf16(a1[2] * bflo(g.w), a1[3] * bfhi(g.w));
                    *(v4u*)(merged + (size_t)row * D + col0 + bj * 128) = w;
                }
            }
    }
};

__host__ __device__ __forceinline__ int gate_col(int m) { const int br = m >> 10, d = m & 1023, dd = d & 63; return 256 * (d >> 6) + 128 * (br >> 1) + 32 * (dd >> 4) + 8 * ((dd >> 2) & 3) + 4 * (br & 1) + (dd & 3); }
__host__ __device__ __forceinline__ int gate_src(int c) { const int ct = c & 255, br = 2 * (ct >> 7) + ((ct >> 2) & 1), d = 64 * (c >> 8) + 16 * ((ct >> 5) & 3) + 4 * ((ct >> 3) & 3) + (ct & 3); return br * 1024 + d; }
struct RowMap { int mode, a; __device__ __forceinline__ int operator()(int n) const { return mode == 0 ? n + a : (mode == 1 ? 256 * (n >> 7) + (n & 127) + a : (n < NMIX ? n : NMIXP + gate_col(n - NMIX))); } };
__device__ __forceinline__ void tr_item(const float* W, int K, int N, const float* gain, bf16* WT, int pitch, RowMap rm, LAS float* scr, int kb, int nb, int lane) {
    const int k0 = 64 * kb, n0 = 64 * nb; const int nn = n0 + 4 * (lane & 15), kr = lane >> 4;
    f32x4 v[16];
#pragma unroll
    for (int i = 0; i < 16; ++i) v[i] = (nn < N) ? *(const f32x4*)(W + (size_t)(k0 + 4 * i + kr) * N + nn) : (f32x4){0.f, 0.f, 0.f, 0.f};
#pragma unroll
    for (int i = 0; i < 16; ++i) { const int kk = 4 * i + kr; const float g = gain ? gain[k0 + kk] : 1.0f; LAS float* d = scr + kk * 65 + 4 * (lane & 15); d[0] = v[i][0] * g; d[1] = v[i][1] * g; d[2] = v[i][2] * g; d[3] = v[i][3] * g; }
    LDS_WAIT(); asm volatile("" ::: "memory");
    const int c = lane & 7;
#pragma unroll
    for (int j = 0; j < 8; ++j) { const int nl = (lane >> 3) + 8 * j; const int n = n0 + nl; const LAS float* s = scr + (8 * c) * 65 + nl;
        v4u o; o.x = pg8::cvt_pk_bf16(s[0 * 65], s[1 * 65]); o.y = pg8::cvt_pk_bf16(s[2 * 65], s[3 * 65]); o.z = pg8::cvt_pk_bf16(s[4 * 65], s[5 * 65]); o.w = pg8::cvt_pk_bf16(s[6 * 65], s[7 * 65]);
        if (n < N) *(v4u*)(WT + (size_t)rm(n) * pitch + k0 + 8 * c) = o; }
    LDS_WAIT(); asm volatile("" ::: "memory");
}
__device__ __forceinline__ void p0_prologue(const Ctx& C, const Params& P) {
    THREAD_IDS();
    LAS float* scr = (LAS float*)(C.lds + RING_OFF + wave * 16896);
    constexpr int I_FF = 16 * 44, I_DN = 44 * 16, I_IN = 16 * 113, I_BR = 4 * 4 * 16, I_OUT = 16 * 16;
    constexpr int PER_LAYER = 4 * I_FF + 2 * I_DN + I_IN + I_BR + I_OUT;
    for (int it = gw; it < DEPTH * PER_LAYER; it += NGW) {
        const int l = it / PER_LAYER; int r = it - l * PER_LAYER;
        bf16* W1a = WSP(bf16, WS_W1 + (size_t)(l * 2 + 0) * SZ_W1); bf16* W1b = WSP(bf16, WS_W1 + (size_t)(l * 2 + 1) * SZ_W1);
        bf16* Wda = WSP(bf16, WS_WD + (size_t)(l * 2 + 0) * SZ_WD); bf16* Wdb = WSP(bf16, WS_WD + (size_t)(l * 2 + 1) * SZ_WD);
        if (r < I_FF) { tr_item(C.in[I_F1G] + (size_t)l * D * DFF, D, DFF, C.in[I_NF1] + l * D, W1a, D, RowMap{1, 0}, scr, r / 44, r % 44, lane); continue; } r -= I_FF;
        if (r < I_FF) { tr_item(C.in[I_F1U] + (size_t)l * D * DFF, D, DFF, C.in[I_NF1] + l * D, W1a, D, RowMap{1, 128}, scr, r / 44, r % 44, lane); continue; } r -= I_FF;
        if (r < I_DN) { tr_item(C.in[I_F1D] + (size_t)l * D * DFF, DFF, D, nullptr, Wda, DFF, RowMap{0, 0}, scr, r / 16, r % 16, lane); continue; } r -= I_DN;
        if (r < I_FF) { tr_item(C.in[I_F2G] + (size_t)l * D * DFF, D, DFF, C.in[I_NF2] + l * D, W1b, D, RowMap{1, 0}, scr, r / 44, r % 44, lane); continue; } r -= I_FF;
        if (r < I_FF) { tr_item(C.in[I_F2U] + (size_t)l * D * DFF, D, DFF, C.in[I_NF2] + l * D, W1b, D, RowMap{1, 128}, scr, r / 44, r % 44, lane); continue; } r -= I_FF;
        if (r < I_DN) { tr_item(C.in[I_F2D] + (size_t)l * D * DFF, DFF, D, nullptr, Wdb, DFF, RowMap{0, 0}, scr, r / 16, r % 16, lane); continue; } r -= I_DN;
        if (r < I_IN) { tr_item(C.in[I_WIN] + (size_t)l * D * NIN, D, NIN, C.in[I_NMIX] + l * D, WSP(bf16, WS_WIN + (size_t)l * SZ_WIN), D, RowMap{2, 0}, scr, r / 113, r % 113, lane); continue; } r -= I_IN;
        if (r < I_BR) { const int n4 = r / 64, rr = r % 64; tr_item(C.in[I_WBR] + (size_t)(l * 4 + n4) * 256 * D, 256, D, nullptr, WSP(bf16, WS_WBR + (size_t)l * SZ_WBR) + n4 * 256, D, RowMap{0, 0}, scr, rr / 16, rr % 16, lane); continue; } r -= I_BR;
        tr_item(C.in[I_WOUT] + (size_t)l * D * D, D, D, nullptr, WSP(bf16, WS_WOUT + (size_t)l * SZ_WOUT), D, RowMap{0, 0}, scr, r / 16, r % 16, lane);
    }
    const int gt = gw * 64 + lane, NGT = NGW * 64;
    for (int i = gt; i < 2 * 240 * 128; i += NGT) { const int l = i / (240 * 128), r = i % (240 * 128); *(v4u*)(C.ws + WS_WIN + (size_t)l * SZ_WIN + ((size_t)NMIX * D) * 2 + (size_t)r * 16) = (v4u){0u, 0u, 0u, 0u}; }
    for (int i = gt; i < (M - MR) * 128; i += NGT) *(v4u*)(C.ws + WS_BR + (size_t)MR * D * 2 + (size_t)i * 16) = (v4u){0u, 0u, 0u, 0u};
    for (int i = gt; i < 2 * NINP; i += NGT) { const int l = i / NINP, j = i % NINP; float v = 0.f; if (j < NMIX) v = C.in[I_BIN][l * NIN + j]; else if (j >= NMIXP) v = C.in[I_BIN][l * NIN + NMIX + gate_src(j - NMIXP)]; WSP(float, WS_BINP)[i] = v; }
    for (int i = gt; i < NPOS * 32; i += NGT) { const int pi = i >> 5, fi = i & 31; const int pos = pi < L ? pi : PAST + (pi - L);
        const float angf = (float)pos * P.inv_freq[fi];
        const double a = (double)angf; const double k = rint(a * 0.15915494309189535); const double rr = (a - k * 6.283185307179586) - k * 2.4492935982947064e-16;
        const float rf = (float)rr; WSP(float, WS_ROPE)[i] = cosf(rf); WSP(float, WS_ROPE)[NPOS * 32 + i] = sinf(rf); }
    float* H = WSP(float, WS_H); bf16* HB = WSP(bf16, WS_HB); float* SS0 = WSP(float, WS_SS);
    for (int row = gw; row < M; row += NGW) {
        const float* src = nullptr;
        if (row < MP) { const int b = row / L, pos = row - b * L; src = pos < NMETA ? C.in[I_META] + (size_t)pos * D : C.in[I_XP] + ((size_t)b * SEQ + (pos - NMETA)) * D; }
        else if (row < MR) src = C.in[I_XS] + (size_t)(row - MP) * D;
        float s = 0.f;
#pragma unroll
        for (int j = 0; j < 4; ++j) { f32x4 v = src ? *(const f32x4*)(src + 256 * j + 4 * lane) : (f32x4){0.f, 0.f, 0.f, 0.f};
            *(f32x4*)(H + (size_t)row * D + 256 * j + 4 * lane) = v; s += (v[0] * v[0] + v[1] * v[1]) + (v[2] * v[2] + v[3] * v[3]);
            unsigned long long w = (unsigned long long)pk2(v[0], v[1]) | ((unsigned long long)pk2(v[2], v[3]) << 32);
            *(unsigned long long*)(HB + (size_t)row * D + 256 * j + 4 * lane) = w; }
        s = wave_sum(s); if (lane < 16) SS0[(size_t)row * 16 + lane] = lane == 0 ? s : 0.f;
    }
}

__device__ __forceinline__ float lam_of(const Ctx& C, int l, float lam_init) {
    THREAD_IDS();
    float a = 0.f, b = 0.f;
#pragma unroll 1
    for (int i = 0; i < 32; ++i) { a += C.in[I_LQ1][l * 32 + i] * C.in[I_LK1][l * 32 + i]; b += C.in[I_LQ2][l * 32 + i] * C.in[I_LK2][l * 32 + i]; }
    return __expf(a) - __expf(b) + lam_init;
}
__device__ __forceinline__ int t5_bucket(int n) {
    if (n < 16) return n;
    return 16 + (n >= 19) + (n >= 21) + (n >= 24) + (n >= 27) + (n >= 31) + (n >= 35) + (n >= 40) + (n >= 46) + (n >= 52) + (n >= 59) + (n >= 67) + (n >= 77) + (n >= 87) + (n >= 99) + (n >= 113);
}
__device__ __forceinline__ void unpack8(const v4u w, float (&x)[8]) { x[0] = bflo(w.x); x[1] = bfhi(w.x); x[2] = bflo(w.y); x[3] = bfhi(w.y); x[4] = bflo(w.z); x[5] = bfhi(w.z); x[6] = bflo(w.w); x[7] = bfhi(w.w); }
__device__ __forceinline__ v4u pack8(const float (&x)[8]) { v4u w; w.x = pg8::cvt_pk_bf16(x[0], x[1]); w.y = pg8::cvt_pk_bf16(x[2], x[3]); w.z = pg8::cvt_pk_bf16(x[4], x[5]); w.w = pg8::cvt_pk_bf16(x[6], x[7]); return w; }
__device__ __forceinline__ void n1_prep(const Ctx& C, int l) {
    THREAD_IDS();
    const bf16* ZM = WSP(bf16, WS_ZMIX); float* UB = WSP(float, WS_UBUF); float* RQ = WSP(float, WS_RQ); float* RK = WSP(float, WS_RK);
    float* LD = WSP(float, WS_LDEC); const float* COS = WSP(float, WS_ROPE); const float* SIN = COS + NPOS * 32; bf16* QNB = WSP(bf16, WS_QNB); bf16* KNB = WSP(bf16, WS_KNB);
    const int i = lane & 31;
    float qg[8], kg[8];
#pragma unroll
    for (int j = 0; j < 8; ++j) { qg[j] = C.in[I_QN][l * 32 + ((8 * i) & 31) + j] * (0.17677669529663687f * 1.4426950408889634f); kg[j] = C.in[I_KN][l * 32 + ((8 * i) & 31) + j]; }
    const int isk = i >> 4, hh = (i >> 2) & 3, jc = i & 3;
    for (int rp0 = gw * 2; rp0 < MR / 2; rp0 += NGW * 2) {
        v4u Wa[2], Wg[2], Wq[2], Wk[2], Wv[2], W1[2], W2[2], G0[2], G1[2];
#pragma unroll
        for (int u = 0; u < 2; ++u) { const int r = min(2 * (rp0 + u) + (lane >> 5), MR - 1); const bf16* z = ZM + (size_t)r * NMIXP; const bf16* zr = z + (isk ? R_K : R_Q) + hh * 64 + 8 * jc;
            Wa[u] = *(const v4u*)(z + C_A + 8 * i); Wg[u] = *(const v4u*)(z + C_G + 8 * i); Wq[u] = *(const v4u*)(z + D_Q + 8 * i); Wk[u] = *(const v4u*)(z + D_K + 8 * i); Wv[u] = *(const v4u*)(z + D_V + 8 * i);
            W1[u] = *(const v4u*)zr; W2[u] = *(const v4u*)(zr + 32); G0[u] = *(const v4u*)(z + G_LOW); G1[u] = *(const v4u*)(z + G_LOW + 8); }
#pragma unroll
        for (int u = 0; u < 2; ++u) {
        if (rp0 + u >= MR / 2) break;
        const int r = 2 * (rp0 + u) + (lane >> 5);
        const int pi = r < MP ? r % L : L + ((r - MP) & 7);
        float* kout = r < MP ? C.out + O_KP + ((size_t)l * MP + r) * 256 : C.out + O_KS + ((size_t)l * MS + (r - MP)) * 256;
        float* vout = r < MP ? C.out + O_VP + ((size_t)l * MP + r) * 256 : C.out + O_VS + ((size_t)l * MS + (r - MP)) * 256;
        const v4u wa = Wa[u], wg = Wg[u], wq = Wq[u], wk = Wk[u], wv = Wv[u], w1 = W1[u], w2 = W2[u], gl0 = G0[u], gl1 = G1[u];
        float x[8], y[8];
        unpack8(wa, x); unpack8(wg, y);
#pragma unroll
        for (int j = 0; j < 8; ++j) x[j] *= sigmoidf_(y[j]);
        *(f32x4*)(UB + (size_t)r * 256 + 8 * i) = (f32x4){x[0], x[1], x[2], x[3]}; *(f32x4*)(UB + (size_t)r * 256 + 8 * i + 4) = (f32x4){x[4], x[5], x[6], x[7]};
        unpack8(wv, x);
        *(f32x4*)(vout + 8 * i) = (f32x4){x[0], x[1], x[2], x[3]}; *(f32x4*)(vout + 8 * i + 4) = (f32x4){x[4], x[5], x[6], x[7]};
        unpack8(wq, x);
        { float s = 0.f;
#pragma unroll
          for (int j = 0; j < 8; ++j) s += x[j] * x[j];
          s += __shfl_xor(s, 1); s += __shfl_xor(s, 2); const float rs = rsqrtf(s * (1.0f / 32) + EPS);
#pragma unroll
          for (int j = 0; j < 8; ++j) x[j] = x[j] * rs * qg[j];
          *(v4u*)(QNB + (size_t)r * 256 + 8 * i) = pack8(x); }
        unpack8(wk, x);
        { float s = 0.f;
#pragma unroll
          for (int j = 0; j < 8; ++j) s += x[j] * x[j];
          s += __shfl_xor(s, 1); s += __shfl_xor(s, 2); const float rs = rsqrtf(s * (1.0f / 32) + EPS);
#pragma unroll
          for (int j = 0; j < 8; ++j) x[j] = x[j] * rs * kg[j];
          *(v4u*)(KNB + (size_t)r * 256 + 8 * i) = pack8(x);
          *(f32x4*)(kout + 8 * i) = (f32x4){x[0], x[1], x[2], x[3]}; *(f32x4*)(kout + 8 * i + 4) = (f32x4){x[4], x[5], x[6], x[7]}; }
        unpack8(w1, x); unpack8(w2, y);
        { const f32x4 c0 = *(const f32x4*)(COS + pi * 32 + 8 * jc), c1 = *(const f32x4*)(COS + pi * 32 + 8 * jc + 4), s0 = *(const f32x4*)(SIN + pi * 32 + 8 * jc), s1 = *(const f32x4*)(SIN + pi * 32 + 8 * jc + 4);
          const float sc = isk ? 0.125f : 1.0f; float o1[8], o2[8];
#pragma unroll
          for (int j = 0; j < 8; ++j) { const float cs = j < 4 ? c0[j & 3] : c1[j & 3], sn = j < 4 ? s0[j & 3] : s1[j & 3]; o1[j] = (x[j] * cs - y[j] * sn) * sc; o2[j] = (x[j] * sn + y[j] * cs) * sc; }
          float* ro = (isk ? RK : RQ) + (size_t)r * 256 + hh * 64 + 8 * jc;
          *(f32x4*)ro = (f32x4){o1[0], o1[1], o1[2], o1[3]}; *(f32x4*)(ro + 4) = (f32x4){o1[4], o1[5], o1[6], o1[7]}; *(f32x4*)(ro + 32) = (f32x4){o2[0], o2[1], o2[2], o2[3]}; *(f32x4*)(ro + 36) = (f32x4){o2[4], o2[5], o2[6], o2[7]}; }
        { float gv[16]; unpack8(gl0, x); unpack8(gl1, y);
#pragma unroll
          for (int j = 0; j < 8; ++j) { gv[j] = x[j]; gv[8 + j] = y[j]; }
          f32x4 gp = *(const f32x4*)(C.in[I_GAB] + l * 128 + 4 * i);
#pragma unroll
          for (int k = 0; k < 16; ++k) { const f32x4 aw = *(const f32x4*)(C.in[I_GAW] + (size_t)(l * 16 + k) * 128 + 4 * i); gp = gp + aw * gv[k]; }
          f32x4 ls;
#pragma unroll
          for (int j = 0; j < 4; ++j) ls[j] = (fminf(gp[j], 0.f) - log1pf(__expf(-fabsf(gp[j])))) * (1.0f / 16.0f);
          *(f32x4*)(LD + (size_t)r * 128 + 4 * i) = ls; }
        }
    }
}
__device__ __forceinline__ void conv_rows_item(const Ctx& C, int l, int item) {
    THREAD_IDS();
    const float* UB = WSP(float, WS_UBUF); bf16* BR = WSP(bf16, WS_BR);
    const float* cw = C.in[I_CW] + (size_t)l * 31 * 256; const float* sc = C.in[I_SCONV];
    LAS float* wl = (LAS float*)C.lds;
    for (int i = tid; i < 31 * 256; i += NWAVES * 64) wl[i] = cw[i];
    LDS_WAIT(); __builtin_amdgcn_s_barrier(); asm volatile("" ::: "memory");
    const int r0 = item * 64 + wave * 8;
    if (r0 < MR) {
        const bool smp = r0 >= MP; const int b = smp ? (r0 - MP) >> 3 : r0 / L; const int p0 = smp ? 0 : r0 - b * L; const int rb = smp ? MP + b * 8 : b * L;
        float acc[8][4];
#pragma unroll
        for (int i = 0; i < 8; ++i)
#pragma unroll
            for (int k = 0; k < 4; ++k) acc[i][k] = C.in[I_CB][l * 256 + lane + 64 * k];
#pragma unroll 1
        for (int jb = 0; jb < 40; jb += 8) {
            float uv[8][4];
#pragma unroll
            for (int jj = 0; jj < 8; ++jj) { const int j = jb + jj; const int q = p0 - 30 + j;
#pragma unroll
                for (int k = 0; k < 4; ++k) { const int c = lane + 64 * k;
                    uv[jj][k] = j >= 38 ? 0.f : (q >= 0 ? UB[(size_t)(rb + q) * 256 + c] : (smp ? sc[(((size_t)l * DB + b) * 30 + (q + 30)) * 256 + c] : 0.f)); } }
#pragma unroll
            for (int jj = 0; jj < 8; ++jj)
#pragma unroll
                for (int i = 0; i < 8; ++i) { const int t = jb + jj - i;
                    if (t >= 0 && t <= 30) {
#pragma unroll
                        for (int k = 0; k < 4; ++k) acc[i][k] += wl[t * 256 + lane + 64 * k] * uv[jj][k]; } }
        }
#pragma unroll
        for (int i = 0; i < 8; ++i) { const int r = r0 + i;
            float s = (acc[i][0] + acc[i][1]) + (acc[i][2] + acc[i][3]); const float mean = wave_sum(s) * (1.0f / 256);
            float q2 = 0.f;
#pragma unroll
            for (int k = 0; k < 4; ++k) { acc[i][k] -= mean; q2 += acc[i][k] * acc[i][k]; }
            const float rstd = rsqrtf(wave_sum(q2) * (1.0f / 256) + EPS);
#pragma unroll
            for (int k = 0; k < 4; ++k) { const int c = lane + 64 * k; const float y = acc[i][k] * rstd * C.in[I_CLG][l * 256 + c] + C.in[I_CLB][l * 256 + c]; BR[(size_t)r * D + c] = (bf16)f2bf(siluf_(y)); } }
    }
    LDS_WAIT(); __builtin_amdgcn_s_barrier(); asm volatile("" ::: "memory");
}
__device__ __forceinline__ void conv_state_item(const Ctx& C, int l, int part, int nparts) {
    THREAD_IDS();
    const float* UB = WSP(float, WS_UBUF); const float* sc = C.in[I_SCONV];
    for (int i = part * NWAVES * 64 + tid; i < BATCH * 30 * 256; i += nparts * NWAVES * 64) { const int c = i & 255, ii = (i >> 8) % 30, b = i / (30 * 256); C.out[O_CP + (size_t)l * BATCH * 30 * 256 + i] = UB[(size_t)(b * L + L - 30 + ii) * 256 + c]; }
    for (int i = part * NWAVES * 64 + tid; i < DB * 30 * 256; i += nparts * NWAVES * 64) { const int c = i & 255, ii = (i >> 8) % 30, b = i / (30 * 256);
        C.out[O_CS + (size_t)l * DB * 30 * 256 + i] = ii < 22 ? sc[(((size_t)l * DB + b) * 30 + 8 + ii) * 256 + c] : UB[(size_t)(MP + b * 8 + ii - 22) * 256 + c]; }
}
template <int DK, bool RET> __device__ __forceinline__ void la_seq(const Ctx& C, int l, bool smp, int b, int h) {
    THREAD_IDS();
    const bf16* ZM = WSP(bf16, WS_ZMIX); const float* RQ = WSP(float, WS_RQ); const float* RK = WSP(float, WS_RK); const float* LD = WSP(float, WS_LDEC); bf16* BR = WSP(bf16, WS_BR);
    const int nt = smp ? DS : L; const int row0 = smp ? MP + b * DS : b * L;
    float S[DK];
    if (smp) { const float* s0 = (RET ? C.in[I_SRET] : C.in[I_SGLA]) + (((size_t)l * DB + b) * 4 + h) * DK * 64;
#pragma unroll
        for (int k = 0; k < DK; ++k) S[k] = s0[k * 64 + lane]; }
    else {
#pragma unroll
        for (int k = 0; k < DK; ++k) S[k] = 0.f; }
    const float gamma = 1.0f - exp2f(-5.0f - (float)h);
    const float gn = RET ? C.in[I_RGN][(l * 4 + h) * 64 + lane] : C.in[I_GGN][(l * 4 + h) * 64 + lane];
    for (int t = 0; t < nt; ++t) {
        const int r = row0 + t; const bf16* z = ZM + (size_t)r * NMIXP;
        float ql, kl, dl = 1.f;
        if (RET) { ql = RQ[(size_t)r * 256 + h * 64 + lane]; kl = RK[(size_t)r * 256 + h * 64 + lane]; }
        else { const int lk = lane & 31; ql = bf2f(z[G_Q + h * 32 + lk]) * 0.17677669529663687f; kl = bf2f(z[G_K + h * 32 + lk]); dl = __expf(LD[(size_t)r * 128 + h * 32 + lk]); }
        const float v = bf2f(z[(RET ? R_V : G_V) + h * 64 + lane]);
        float o = 0.f;
#pragma unroll
        for (int k = 0; k < DK; ++k) { const float qk = __shfl(ql, k), kk = __shfl(kl, k); const float dk = RET ? gamma : __shfl(dl, k);
            S[k] = dk * S[k] + kk * v; o += qk * S[k]; if ((k & 7) == 7) __builtin_amdgcn_sched_barrier(0); }
        float y;
        if (RET) { const float mean = wave_sum(o) * (1.0f / 64); const float d = o - mean; const float var = wave_sum(d * d) * (1.0f / 64); y = d * rsqrtf(var + EPS) * gn; }
        else { const float ms = wave_sum(o * o) * (1.0f / 64); y = o * rsqrtf(ms + EPS) * gn; }
        const float g = bf2f(z[(RET ? R_G : G_R) + h * 64 + lane]);
        BR[(size_t)r * D + (RET ? 256 : 512) + h * 64 + lane] = (bf16)f2bf(siluf_(g) * y);
    }
    float* so = C.out + (RET ? (smp ? O_RS + (((size_t)l * DB + b) * 4 + h) * DK * 64 : O_RP + (((size_t)l * BATCH + b) * 4 + h) * DK * 64)
                             : (smp ? O_GS + (((size_t)l * DB + b) * 4 + h) * DK * 64 : O_GP + (((size_t)l * BATCH + b) * 4 + h) * DK * 64));
#pragma unroll
    for (int k = 0; k < DK; ++k) so[k * 64 + lane] = S[k];
}
typedef short bf16x8_t __attribute__((ext_vector_type(8)));
template <int DK, bool RET> __device__ __forceinline__ void la_chunked(const Ctx& C, int l, bool smp, int b, int h) {
    THREAD_IDS();
    constexpr int QS = DK + 8, TS = 72, NKB = DK / 16, NKS = DK / 32;
    constexpr int SB = 2 * 64 * QS + 64 * TS + DK * TS + 64 * TS + 64;
    LAS bf16* SB0 = (LAS bf16*)(C.lds);
    LAS bf16* AL = SB0 + 2 * SB;
    LAS bf16* ST = AL + 64 * TS;
    const bf16* ZM = WSP(bf16, WS_ZMIX); const float* RQ = WSP(float, WS_RQ); const float* RK = WSP(float, WS_RK); const float* LD = WSP(float, WS_LDEC); bf16* BR = WSP(bf16, WS_BR);
    const int nt = smp ? DS : L, row0 = smp ? MP + b * DS : b * L, nch = (nt + 63) >> 6;
    const float lg2 = RET ? log2f(1.0f - exp2f(-5.0f - (float)h)) : 0.f;
    const int g4 = lane >> 4, c16 = lane & 15;
    const bool qwave = wave < 4; const int w4 = wave & 3;
    float Sreg[NKB][4];
    if (wave >= 4) {
        const float* s0 = (RET ? C.in[I_SRET] : C.in[I_SGLA]) + (((size_t)l * DB + b) * 4 + h) * DK * 64;
#pragma unroll
        for (int cb = 0; cb < NKB; ++cb)
#pragma unroll
            for (int r = 0; r < 4; ++r) { const int dk = cb * 16 + c16, dv = (wave - 4) * 16 + 4 * g4 + r; const float v = smp ? s0[dk * 64 + dv] : 0.f; Sreg[cb][r] = v; ST[dv * QS + dk] = (bf16)f2bf(v); }
    }
    float gnv[4];
#pragma unroll
    for (int cb = 0; cb < 4; ++cb) gnv[cb] = (RET ? C.in[I_RGN] : C.in[I_GGN])[(l * 4 + h) * 64 + cb * 16 + c16];
    float a[16]; v4u vr;
#define LA_LOAD(c) do { const size_t r_ = (size_t)(row0 + (c) * 64 + lane); const bf16* z_ = ZM + r_ * NMIXP; \
        vr = *(const v4u*)(z_ + (RET ? R_V : G_V) + h * 64 + 8 * wave); \
        if (RET) { const float* p_ = (qwave ? RQ : RK) + r_ * 256 + h * 64 + 8 * w4; const f32x4 x0 = *(const f32x4*)p_, x1 = *(const f32x4*)(p_ + 4), x2 = *(const f32x4*)(p_ + 32), x3 = *(const f32x4*)(p_ + 36); \
            a[0] = x0[0]; a[1] = x0[1]; a[2] = x0[2]; a[3] = x0[3]; a[4] = x1[0]; a[5] = x1[1]; a[6] = x1[2]; a[7] = x1[3]; a[8] = x2[0]; a[9] = x2[1]; a[10] = x2[2]; a[11] = x2[3]; a[12] = x3[0]; a[13] = x3[1]; a[14] = x3[2]; a[15] = x3[3]; } \
        else { const v4u q_ = *(const v4u*)(z_ + (qwave ? G_Q : G_K) + h * 32 + 8 * w4); const float* p_ = LD + r_ * 128 + h * 32 + 8 * w4; const f32x4 x0 = *(const f32x4*)p_, x1 = *(const f32x4*)(p_ + 4); \
            a[0] = bflo(q_.x); a[1] = bfhi(q_.x); a[2] = bflo(q_.y); a[3] = bfhi(q_.y); a[4] = bflo(q_.z); a[5] = bfhi(q_.z); a[6] = bflo(q_.w); a[7] = bfhi(q_.w); \
            a[8] = x0[0]; a[9] = x0[1]; a[10] = x0[2]; a[11] = x0[3]; a[12] = x1[0]; a[13] = x1[1]; a[14] = x1[2]; a[15] = x1[3]; } } while (0)
    LA_LOAD(0);
    int cur = 0;
    for (int i = 0; i <= nch; ++i) {
        if (i < nch) {
            const int c = i; LAS bf16* QT = SB0 + (i & 1) * SB; LAS bf16* KT = QT + 64 * QS; LAS bf16* VT = KT + 64 * QS; LAS bf16* KE = VT + 64 * TS; LAS bf16* GT = KE + DK * TS; LAS float* WT = (LAS float*)(GT + 64 * TS);
            const int nvc = min(64, nt - c * 64); const bool valid = lane < nvc;
        if (RET) {
            const float tq = (float)(lane + 1);
            if (qwave) { const float e = valid ? __builtin_amdgcn_exp2f(lg2 * tq) : 0.f;
                v4u w0, w1; w0.x = pg8::cvt_pk_bf16(a[0] * e, a[1] * e); w0.y = pg8::cvt_pk_bf16(a[2] * e, a[3] * e); w0.z = pg8::cvt_pk_bf16(a[4] * e, a[5] * e); w0.w = pg8::cvt_pk_bf16(a[6] * e, a[7] * e);
                w1.x = pg8::cvt_pk_bf16(a[8] * e, a[9] * e); w1.y = pg8::cvt_pk_bf16(a[10] * e, a[11] * e); w1.z = pg8::cvt_pk_bf16(a[12] * e, a[13] * e); w1.w = pg8::cvt_pk_bf16(a[14] * e, a[15] * e);
                *(LAS v4u*)(QT + lane * QS + 8 * w4) = w0; *(LAS v4u*)(QT + lane * QS + 32 + 8 * w4) = w1; }
            else { const float e = valid ? __builtin_amdgcn_exp2f(-lg2 * tq) : 0.f, ee = valid ? __builtin_amdgcn_exp2f(lg2 * ((float)nvc - tq)) : 0.f;
                v4u w0, w1; w0.x = pg8::cvt_pk_bf16(a[0] * e, a[1] * e); w0.y = pg8::cvt_pk_bf16(a[2] * e, a[3] * e); w0.z = pg8::cvt_pk_bf16(a[4] * e, a[5] * e); w0.w = pg8::cvt_pk_bf16(a[6] * e, a[7] * e);
                w1.x = pg8::cvt_pk_bf16(a[8] * e, a[9] * e); w1.y = pg8::cvt_pk_bf16(a[10] * e, a[11] * e); w1.z = pg8::cvt_pk_bf16(a[12] * e, a[13] * e); w1.w = pg8::cvt_pk_bf16(a[14] * e, a[15] * e);
                *(LAS v4u*)(KT + lane * QS + 8 * w4) = w0; *(LAS v4u*)(KT + lane * QS + 32 + 8 * w4) = w1;
#pragma unroll
                for (int i = 0; i < 16; i += 2) { const unsigned mine = pg8::cvt_pk_bf16(a[i] * ee, a[i + 1] * ee); const unsigned pv = (unsigned)__shfl_xor((int)mine, 1);
                    const unsigned w = (lane & 1) ? ((pv >> 16) | (mine & 0xffff0000u)) : ((mine & 0xffffu) | (pv << 16));
                    const int row = (i < 8 ? 8 * w4 + i : 32 + 8 * w4 + (i - 8)) + (lane & 1);
                    *(LAS unsigned*)(KE + row * TS + (lane & ~1)) = w; } }
        } else {
            float bb[8];
#pragma unroll
            for (int i = 0; i < 8; ++i) bb[i] = valid ? a[8 + i] : 0.f;
#pragma unroll
            for (int i = 0; i < 8; ++i) { float x = bb[i];
                x += __builtin_bit_cast(float, __builtin_amdgcn_mov_dpp(__builtin_bit_cast(int, x), 0x111, 0xf, 0xf, true));
                x += __builtin_bit_cast(float, __builtin_amdgcn_mov_dpp(__builtin_bit_cast(int, x), 0x112, 0xf, 0xf, true));
                x += __builtin_bit_cast(float, __builtin_amdgcn_mov_dpp(__builtin_bit_cast(int, x), 0x114, 0xf, 0xf, true));
                x += __builtin_bit_cast(float, __builtin_amdgcn_mov_dpp(__builtin_bit_cast(int, x), 0x118, 0xf, 0xf, true));
                const float t0 = __builtin_bit_cast(float, __builtin_amdgcn_readlane(__builtin_bit_cast(int, x), 15)), t1 = __builtin_bit_cast(float, __builtin_amdgcn_readlane(__builtin_bit_cast(int, x), 31)), t2 = __builtin_bit_cast(float, __builtin_amdgcn_readlane(__builtin_bit_cast(int, x), 47));
                bb[i] = x + (lane >= 16 ? t0 : 0.f) + (lane >= 32 ? t1 : 0.f) + (lane >= 48 ? t2 : 0.f); }
            if (qwave) {
                if (lane == 63) {
#pragma unroll
                    for (int i = 0; i < 8; ++i) WT[8 * w4 + i] = bb[i]; }
                float o8[8];
#pragma unroll
                for (int i = 0; i < 8; ++i) o8[i] = valid ? a[i] * 0.17677669529663687f * __expf(bb[i]) : 0.f;
                v4u w0; w0.x = pg8::cvt_pk_bf16(o8[0], o8[1]); w0.y = pg8::cvt_pk_bf16(o8[2], o8[3]); w0.z = pg8::cvt_pk_bf16(o8[4], o8[5]); w0.w = pg8::cvt_pk_bf16(o8[6], o8[7]);
                *(LAS v4u*)(QT + lane * QS + 8 * w4) = w0;
            } else {
                float o8[8];
#pragma unroll
                for (int i = 0; i < 8; ++i) o8[i] = valid ? a[i] * __expf(-bb[i]) : 0.f;
#pragma unroll
                for (int i = 0; i < 8; i += 2) { const float t0 = __shfl(bb[i], 63), t1 = __shfl(bb[i + 1], 63);
                    const unsigned mine = pg8::cvt_pk_bf16(valid ? a[i] * __expf(t0 - bb[i]) : 0.f, valid ? a[i + 1] * __expf(t1 - bb[i + 1]) : 0.f); const unsigned pv = (unsigned)__shfl_xor((int)mine, 1);
                    const unsigned w = (lane & 1) ? ((pv >> 16) | (mine & 0xffff0000u)) : ((mine & 0xffffu) | (pv << 16));
                    *(LAS unsigned*)(KE + (8 * w4 + i + (lane & 1)) * TS + (lane & ~1)) = w; }
                v4u w0; w0.x = pg8::cvt_pk_bf16(o8[0], o8[1]); w0.y = pg8::cvt_pk_bf16(o8[2], o8[3]); w0.z = pg8::cvt_pk_bf16(o8[4], o8[5]); w0.w = pg8::cvt_pk_bf16(o8[6], o8[7]);
                *(LAS v4u*)(KT + lane * QS + 8 * w4) = w0;
            }
        }
        { const unsigned vv[4] = {valid ? vr.x : 0u, valid ? vr.y : 0u, valid ? vr.z : 0u, valid ? vr.w : 0u};
#pragma unroll
          for (int i = 0; i < 4; ++i) { const unsigned pv = (unsigned)__shfl_xor((int)vv[i], 1);
              const unsigned w = (lane & 1) ? ((pv >> 16) | (vv[i] & 0xffff0000u)) : ((vv[i] & 0xffffu) | (pv << 16));
              *(LAS unsigned*)(VT + (8 * wave + 2 * i + (lane & 1)) * TS + (lane & ~1)) = w; } }
            if (c + 1 < nch) LA_LOAD(c + 1);
        }
        if (i >= 1) {
            LAS bf16* QT = SB0 + ((i - 1) & 1) * SB; LAS bf16* KT = QT + 64 * QS;
        { const int rb = wave >> 1;
#pragma unroll
          for (int ci = 0; ci < 2; ++ci) { const int cb = (wave & 1) * 2 + ci; f32x4 acc = {0.f, 0.f, 0.f, 0.f};
              if (cb <= rb) {
#pragma unroll
                  for (int ks = 0; ks < NKS; ++ks) { const bf16x8_t af = *(const LAS bf16x8_t*)(QT + (rb * 16 + c16) * QS + ks * 32 + 8 * g4), bf = *(const LAS bf16x8_t*)(KT + (cb * 16 + c16) * QS + ks * 32 + 8 * g4);
                      acc = __builtin_amdgcn_mfma_f32_16x16x32_bf16(af, bf, acc, 0, 0, 0); } }
#pragma unroll
              for (int r = 0; r < 4; ++r) { const int tt = rb * 16 + 4 * g4 + r, ss = cb * 16 + c16; AL[tt * TS + ss] = (bf16)f2bf(ss <= tt ? acc[r] : 0.f); } } }
        }
        LDS_WAIT(); __builtin_amdgcn_s_barrier(); asm volatile("" ::: "memory");
        if (i >= 1) {
            const int c = i - 1; LAS bf16* QT = SB0 + (c & 1) * SB; LAS bf16* KT = QT + 64 * QS; LAS bf16* VT = KT + 64 * QS; LAS bf16* KE = VT + 64 * TS; LAS bf16* GT = KE + DK * TS; LAS float* WT = (LAS float*)(GT + 64 * TS);
            const int nvc = min(64, nt - c * 64); (void)KT;
        if (wave < 4) {
            const int rb = wave; const LAS bf16* STc = ST + cur * 64 * QS;
            f32x4 o[4];
#pragma unroll
            for (int cb = 0; cb < 4; ++cb) o[cb] = (f32x4){0.f, 0.f, 0.f, 0.f};
#pragma unroll
            for (int ks = 0; ks < 2; ++ks) { const bf16x8_t af = *(const LAS bf16x8_t*)(AL + (rb * 16 + c16) * TS + ks * 32 + 8 * g4);
#pragma unroll
                for (int cb = 0; cb < 4; ++cb) { const bf16x8_t bf = *(const LAS bf16x8_t*)(VT + (cb * 16 + c16) * TS + ks * 32 + 8 * g4); o[cb] = __builtin_amdgcn_mfma_f32_16x16x32_bf16(af, bf, o[cb], 0, 0, 0); } }
#pragma unroll
            for (int ks = 0; ks < NKS; ++ks) { const bf16x8_t af = *(const LAS bf16x8_t*)(QT + (rb * 16 + c16) * QS + ks * 32 + 8 * g4);
#pragma unroll
                for (int cb = 0; cb < 4; ++cb) { const bf16x8_t bf = *(const LAS bf16x8_t*)(STc + (cb * 16 + c16) * QS + ks * 32 + 8 * g4); o[cb] = __builtin_amdgcn_mfma_f32_16x16x32_bf16(af, bf, o[cb], 0, 0, 0); } }
            { float* LAO = WSP(float, WS_LAO);
#pragma unroll
              for (int r = 0; r < 4; ++r) { const int tok = c * 64 + rb * 16 + 4 * g4 + r;
                  if (tok < nt) { float* op = LAO + (size_t)(row0 + tok) * 512 + (RET ? 0 : 256) + h * 64 + c16;
#pragma unroll
                      for (int cb = 0; cb < 4; ++cb) op[cb * 16] = o[cb][r]; } } }
        } else {
            const int dvb = wave - 4; LAS bf16* STn = ST + (cur ^ 1) * 64 * QS;
            f32x4 ds[NKB];
#pragma unroll
            for (int cb = 0; cb < NKB; ++cb) ds[cb] = (f32x4){0.f, 0.f, 0.f, 0.f};
#pragma unroll
            for (int ks = 0; ks < 2; ++ks) { const bf16x8_t af = *(const LAS bf16x8_t*)(VT + (dvb * 16 + c16) * TS + ks * 32 + 8 * g4);
#pragma unroll
                for (int cb = 0; cb < NKB; ++cb) { const bf16x8_t bf = *(const LAS bf16x8_t*)(KE + (cb * 16 + c16) * TS + ks * 32 + 8 * g4); ds[cb] = __builtin_amdgcn_mfma_f32_16x16x32_bf16(af, bf, ds[cb], 0, 0, 0); } }
#pragma unroll
            for (int cb = 0; cb < NKB; ++cb) { const float eB = RET ? __builtin_amdgcn_exp2f(lg2 * (float)nvc) : __expf(WT[cb * 16 + c16]);
#pragma unroll
                for (int r = 0; r < 4; ++r) { Sreg[cb][r] = eB * Sreg[cb][r] + ds[cb][r]; STn[(dvb * 16 + 4 * g4 + r) * QS + cb * 16 + c16] = (bf16)f2bf(Sreg[cb][r]); } }
        }
            cur ^= 1;
        }
        LDS_WAIT(); __builtin_amdgcn_s_barrier(); asm volatile("" ::: "memory");
    }
#undef LA_LOAD
    if (wave >= 4) {
        float* so = C.out + (RET ? (smp ? O_RS + (((size_t)l * DB + b) * 4 + h) * DK * 64 : O_RP + (((size_t)l * BATCH + b) * 4 + h) * DK * 64)
                                 : (smp ? O_GS + (((size_t)l * DB + b) * 4 + h) * DK * 64 : O_GP + (((size_t)l * BATCH + b) * 4 + h) * DK * 64));
#pragma unroll
        for (int cb = 0; cb < NKB; ++cb)
#pragma unroll
            for (int r = 0; r < 4; ++r) so[(cb * 16 + c16) * 64 + (wave - 4) * 16 + 4 * g4 + r] = Sreg[cb][r];
    }
}
typedef float f32x16_t __attribute__((ext_vector_type(16)));
__device__ __forceinline__ int crow_(int r, int hi) { return (r & 3) + 8 * (r >> 2) + 4 * hi; }
__device__ __forceinline__ float swapmax32(float m) { auto rr = __builtin_amdgcn_permlane32_swap(__float_as_uint(m), __float_as_uint(m), false, false); return fmaxf(__uint_as_float(rr[0]), __uint_as_float(rr[1])); }
__device__ __forceinline__ float swapadd32(float m) { auto rr = __builtin_amdgcn_permlane32_swap(__float_as_uint(m), __float_as_uint(m), false, false); return __uint_as_float(rr[0]) + __uint_as_float(rr[1]); }
constexpr float LOG2E = 1.4426950408889634f;
__device__ __forceinline__ void attn_prompt_item(const Ctx& C, int l, int b, int h, int qb, float lam, float lam_init, float mb) {
    THREAD_IDS();
    constexpr int KS = 72;
    LAS bf16* Kt = (LAS bf16*)C.lds;
    LAS bf16* Vt = Kt + 2 * 64 * KS;
    LAS float* BT = (LAS float*)(Vt + 2 * 64 * KS);
    LAS float* OX = BT + 128;
    const bf16* ZM = WSP(bf16, WS_ZMIX); const bf16* QNB = WSP(bf16, WS_QNB); const bf16* KNB = WSP(bf16, WS_KNB); bf16* BR = WSP(bf16, WS_BR);
    const int r32 = lane & 31, hi = lane >> 5, qs = wave >> 1, s = wave & 1;
    const int q0 = qb * 128 + qs * 32; const int rowb = b * L;
    if (tid < 128) BT[tid] = (C.in[I_RELB][t5_bucket(tid) * 4 + h] - C.in[I_RELB][31 * 4 + h]) * LOG2E;
    pg8::bf16x8 qf[2];
#pragma unroll
    for (int d0 = 0; d0 < 2; ++d0) qf[d0] = *(const pg8::bf16x8*)(QNB + (size_t)(rowb + q0 + r32) * 256 + h * 64 + s * 32 + 16 * d0 + 8 * hi);
    const int pl = (lane & ~15) | ((lane & 8) >> 1) | ((lane & 4) << 1) | (lane & 3);
    const int NT = (min(128 * (qb + 1), L) + 63) >> 6;
    v4u kreg, vreg;
#define AT_LOAD(j) do { const size_t r_ = (size_t)(rowb + (j) * 64 + lane); kreg = *(const v4u*)(KNB + r_ * 256 + h * 64 + 8 * wave); vreg = *(const v4u*)(ZM + r_ * NMIXP + D_V + h * 64 + 8 * wave); } while (0)
#define AT_STORE(buf) do { *(LAS v4u*)(Kt + (buf) * 64 * KS + lane * KS + 8 * wave) = kreg; LAS bf16* v_ = Vt + (buf) * 64 * KS + (8 * wave) * KS + pl; \
        v_[0] = (bf16)(vreg.x & 0xffffu); v_[KS] = (bf16)(vreg.x >> 16); v_[2 * KS] = (bf16)(vreg.y & 0xffffu); v_[3 * KS] = (bf16)(vreg.y >> 16); \
        v_[4 * KS] = (bf16)(vreg.z & 0xffffu); v_[5 * KS] = (bf16)(vreg.z >> 16); v_[6 * KS] = (bf16)(vreg.w & 0xffffu); v_[7 * KS] = (bf16)(vreg.w >> 16); } while (0)
    AT_LOAD(0); AT_STORE(0); if (NT > 1) AT_LOAD(1);
    LDS_WAIT(); __builtin_amdgcn_s_barrier(); asm volatile("" ::: "memory");
    float lsum = 0.f; f32x16_t o[2]; f32x16_t negm;
#pragma unroll
    for (int i = 0; i < 16; ++i) negm[i] = -mb;
#pragma unroll
    for (int i = 0; i < 16; ++i) { o[0][i] = 0.f; o[1][i] = 0.f; }
    for (int j = 0; j < NT; ++j) {
        const int k0 = 64 * j, buf = j & 1;
        if (k0 <= q0 + 31) {
            const LAS bf16* kb = Kt + buf * 64 * KS; const LAS bf16* vb = Vt + buf * 64 * KS;
            f32x16_t p0 = negm, p1 = negm;
#pragma unroll
            for (int d0 = 0; d0 < 2; ++d0) { const pg8::bf16x8 a0 = *(const LAS pg8::bf16x8*)(kb + r32 * KS + s * 32 + 16 * d0 + 8 * hi), a1 = *(const LAS pg8::bf16x8*)(kb + (32 + r32) * KS + s * 32 + 16 * d0 + 8 * hi);
                p0 = __builtin_amdgcn_mfma_f32_32x32x16_bf16(a0, qf[d0], p0, 0, 0, 0); p1 = __builtin_amdgcn_mfma_f32_32x32x16_bf16(a1, qf[d0], p1, 0, 0, 0); }
            if (q0 - k0 - 63 < 113) {
#pragma unroll
                for (int r = 0; r < 16; ++r) { const int n0 = (q0 + r32) - (k0 + crow_(r, hi)), n1 = n0 - 32;
                    p0[r] = n0 < 0 ? -INFINITY : p0[r] + (n0 < 128 ? BT[n0] : 0.f); p1[r] = n1 < 0 ? -INFINITY : p1[r] + (n1 < 128 ? BT[n1] : 0.f); } }
            typedef float f32x2_t __attribute__((ext_vector_type(2)));
            f32x2_t ps2 = {0.f, 0.f};
#pragma unroll
            for (int r = 0; r < 16; r += 2) { p0[r] = __builtin_amdgcn_exp2f(p0[r]); p0[r + 1] = __builtin_amdgcn_exp2f(p0[r + 1]); p1[r] = __builtin_amdgcn_exp2f(p1[r]); p1[r + 1] = __builtin_amdgcn_exp2f(p1[r + 1]);
                ps2 = ps2 + (f32x2_t){p0[r], p0[r + 1]}; ps2 = ps2 + (f32x2_t){p1[r], p1[r + 1]}; }
            lsum += ps2[0] + ps2[1];
            pg8::bf16x8 pb[4];
#pragma unroll
            for (int ks = 0; ks < 4; ++ks) { v4u w;
                if (ks < 2) { w.x = pg8::cvt_pk_bf16(p0[8 * ks], p0[8 * ks + 1]); w.y = pg8::cvt_pk_bf16(p0[8 * ks + 2], p0[8 * ks + 3]); w.z = pg8::cvt_pk_bf16(p0[8 * ks + 4], p0[8 * ks + 5]); w.w = pg8::cvt_pk_bf16(p0[8 * ks + 6], p0[8 * ks + 7]); }
                else { w.x = pg8::cvt_pk_bf16(p1[8 * ks - 16], p1[8 * ks - 15]); w.y = pg8::cvt_pk_bf16(p1[8 * ks - 14], p1[8 * ks - 13]); w.z = pg8::cvt_pk_bf16(p1[8 * ks - 12], p1[8 * ks - 11]); w.w = pg8::cvt_pk_bf16(p1[8 * ks - 10], p1[8 * ks - 9]); }
                pb[ks] = __builtin_bit_cast(pg8::bf16x8, w); }
#pragma unroll
            for (int d0 = 0; d0 < 2; ++d0)
#pragma unroll
                for (int ks = 0; ks < 4; ++ks) { const pg8::bf16x8 af = *(const LAS pg8::bf16x8*)(vb + (32 * d0 + r32) * KS + 16 * ks + 8 * hi); o[d0] = __builtin_amdgcn_mfma_f32_32x32x16_bf16(af, pb[ks], o[d0], 0, 0, 0); }
        }
        if (j + 1 < NT) AT_STORE(buf ^ 1);
        if (j + 2 < NT) AT_LOAD(j + 2);
        LDS_WAIT(); __builtin_amdgcn_s_barrier(); asm volatile("" ::: "memory");
    }
#undef AT_LOAD
#undef AT_STORE
    lsum = swapadd32(lsum); const float inv = 1.0f / lsum;
    LAS float* ox = OX + (qs * 32 + r32) * 65;
    if (s == 1) {
#pragma unroll
        for (int d0 = 0; d0 < 2; ++d0)
#pragma unroll
            for (int r = 0; r < 16; ++r) ox[32 * d0 + crow_(r, hi)] = o[d0][r] * inv; }
    LDS_WAIT(); __builtin_amdgcn_s_barrier(); asm volatile("" ::: "memory");
    if (s == 0) {
        float ss = 0.f;
#pragma unroll
        for (int d0 = 0; d0 < 2; ++d0)
#pragma unroll
            for (int r = 0; r < 16; ++r) { const float v = o[d0][r] * inv - lam * ox[32 * d0 + crow_(r, hi)]; o[d0][r] = v; ss += v * v; }
        ss = swapadd32(ss); const float rs = rsqrtf(ss * (1.0f / 64) + EPS) * (1.0f - lam_init);
        const int qpos = q0 + r32;
        if (qpos < L) { bf16* brp = BR + (size_t)(rowb + qpos) * D + 768 + h * 64;
#pragma unroll
            for (int d0 = 0; d0 < 2; ++d0)
#pragma unroll
                for (int r4 = 0; r4 < 4; ++r4) { const int dv = 32 * d0 + 8 * r4 + 4 * hi; const float* sl = C.in[I_SUBLN] + l * 64 + dv;
                    const unsigned w0 = pk2(o[d0][4 * r4] * rs * sl[0], o[d0][4 * r4 + 1] * rs * sl[1]), w1 = pk2(o[d0][4 * r4 + 2] * rs * sl[2], o[d0][4 * r4 + 3] * rs * sl[3]);
                    *(unsigned long long*)(brp + dv) = (unsigned long long)w0 | ((unsigned long long)w1 << 32); } }
    }
    LDS_WAIT(); __builtin_amdgcn_s_barrier(); asm volatile("" ::: "memory");
}
constexpr int PSTR = 68;
__device__ __forceinline__ pg8::bf16x8 cvt8(const f32x4 a, const f32x4 b) { v4u w; w.x = pg8::cvt_pk_bf16(a[0], a[1]); w.y = pg8::cvt_pk_bf16(a[2], a[3]); w.z = pg8::cvt_pk_bf16(b[0], b[1]); w.w = pg8::cvt_pk_bf16(b[2], b[3]); return __builtin_bit_cast(pg8::bf16x8, w); }
__device__ __forceinline__ void attn_sample_item(const Ctx& C, int l, int b, int split) {
    THREAD_IDS();
    const int h = wave & 3, half = wave >> 2, c16 = lane & 15, g = lane >> 4, srow = c16 >> 3, t = c16 & 7;
    const bf16* QNB = WSP(bf16, WS_QNB); const int* PT = (const int*)C.in[I_PT];
    const float* CK = C.in[I_CK] + (size_t)l * NPOOL * PAGE * 256; const float* CV = C.in[I_CV] + (size_t)l * NPOOL * PAGE * 256;
    LAS float* BT = (LAS float*)C.lds;
    BT[tid] = (C.in[I_RELB][t5_bucket(tid & 127) * 4 + (tid >> 7)] - C.in[I_RELB][31 * 4 + (tid >> 7)]) * LOG2E;
    const v4u z4 = {0u, 0u, 0u, 0u};
    const v4u q0w = srow == 0 ? *(const v4u*)(QNB + (size_t)(MP + b * 8 + t) * 256 + h * 64 + 8 * g) : z4, q1w = srow == 1 ? *(const v4u*)(QNB + (size_t)(MP + b * 8 + t) * 256 + h * 64 + 32 + 8 * g) : z4;
    const pg8::bf16x8 qf0 = __builtin_bit_cast(pg8::bf16x8, q0w), qf1 = __builtin_bit_cast(pg8::bf16x8, q1w);
    LDS_WAIT(); __builtin_amdgcn_s_barrier(); asm volatile("" ::: "memory");
    float m = -INFINITY, lsum = 0.f; f32x4 o[4];
#pragma unroll
    for (int db = 0; db < 4; ++db) o[db] = (f32x4){0.f, 0.f, 0.f, 0.f};
    const int kk0 = split * 1024 + half * 512;
    const int pg0 = __builtin_amdgcn_readfirstlane(PT[b * NPAGES + (kk0 >> 7)]), pg1 = __builtin_amdgcn_readfirstlane(PT[b * NPAGES + (kk0 >> 7) + 1]), pg2 = __builtin_amdgcn_readfirstlane(PT[b * NPAGES + (kk0 >> 7) + 2]), pg3 = __builtin_amdgcn_readfirstlane(PT[b * NPAGES + (kk0 >> 7) + 3]);
#define SA_LOAD(KR, VR, st) do { const int kk_ = kk0 + 32 * (st); const int pi_ = (st) >> 2; const int page_ = pi_ == 0 ? pg0 : pi_ == 1 ? pg1 : pi_ == 2 ? pg2 : pg3; const size_t base_ = ((size_t)(page_ * PAGE + (kk_ & 127)) * 4 + h) * 64; \
        _Pragma("unroll") for (int T = 0; T < 2; ++T) _Pragma("unroll") for (int ks = 0; ks < 2; ++ks) { const float* p = CK + base_ + (size_t)(16 * T + c16) * 256 + 32 * ks + 8 * g; KR[T][ks][0] = *(const f32x4*)p; KR[T][ks][1] = *(const f32x4*)(p + 4); } \
        _Pragma("unroll") for (int db = 0; db < 4; ++db) _Pragma("unroll") for (int j = 0; j < 8; ++j) { const int kv = j < 4 ? 4 * g + j : 16 + 4 * g + (j - 4); VR[db][j] = CV[base_ + (size_t)kv * 256 + 16 * db + c16]; } } while (0)
#define SA_MATH(KR, VR, st) do { const int kk = kk0 + 32 * (st); f32x4 sv[2]; \
        _Pragma("unroll") for (int T = 0; T < 2; ++T) { sv[T] = (f32x4){0.f, 0.f, 0.f, 0.f}; \
            sv[T] = __builtin_amdgcn_mfma_f32_16x16x32_bf16(cvt8(KR[T][0][0], KR[T][0][1]), qf0, sv[T], 0, 0, 0); \
            sv[T] = __builtin_amdgcn_mfma_f32_16x16x32_bf16(cvt8(KR[T][1][0], KR[T][1][1]), qf1, sv[T], 0, 0, 0); } \
        if (kk + 31 + 128 > PAST) { \
            _Pragma("unroll") for (int T = 0; T < 2; ++T) _Pragma("unroll") for (int r = 0; r < 4; ++r) { const int n = PAST + t - (kk + 16 * T + 4 * g + r); if (n < 128) sv[T][r] += BT[h * 128 + n]; } } \
        float mt = fmaxf(fmaxf(fmaxf(sv[0][0], sv[0][1]), fmaxf(sv[0][2], sv[0][3])), fmaxf(fmaxf(sv[1][0], sv[1][1]), fmaxf(sv[1][2], sv[1][3]))); \
        mt = fmaxf(mt, __shfl_xor(mt, 16)); mt = fmaxf(mt, __shfl_xor(mt, 32)); \
        const float mn = fmaxf(m, mt); const float al = __builtin_amdgcn_exp2f(m - mn); m = mn; float ps = 0.f; \
        _Pragma("unroll") for (int T = 0; T < 2; ++T) _Pragma("unroll") for (int r = 0; r < 4; ++r) { sv[T][r] = __builtin_amdgcn_exp2f(sv[T][r] - m); ps += sv[T][r]; } \
        lsum = lsum * al + ps; const pg8::bf16x8 pf = cvt8(sv[0], sv[1]); \
        _Pragma("unroll") for (int db = 0; db < 4; ++db) { o[db] = o[db] * al; \
            const f32x4 va = {VR[db][0], VR[db][1], VR[db][2], VR[db][3]}, vb = {VR[db][4], VR[db][5], VR[db][6], VR[db][7]}; \
            o[db] = __builtin_amdgcn_mfma_f32_16x16x32_bf16(cvt8(va, vb), pf, o[db], 0, 0, 0); } } while (0)
    f32x4 krA[2][2][2], krB[2][2][2]; float vrA[4][8], vrB[4][8];
    SA_LOAD(krA, vrA, 0);
#pragma unroll 1
    for (int step = 0; step < 16; step += 2) {
        SA_LOAD(krB, vrB, step + 1);
        SA_MATH(krA, vrA, step);
        if (step + 2 < 16) SA_LOAD(krA, vrA, step + 2);
        SA_MATH(krB, vrB, step + 1);
    }
#undef SA_LOAD
#undef SA_MATH
    lsum += __shfl_xor(lsum, 16); lsum += __shfl_xor(lsum, 32);
    float* pp = WSP(float, WS_PART) + ((((size_t)b * 4 + h) * 16 + split * 2 + half) * 16 + c16) * PSTR;
#pragma unroll
    for (int db = 0; db < 4; ++db) *(f32x4*)(pp + 16 * db + 4 * g) = o[db];
    if (g == 0) { pp[64] = m; pp[65] = lsum; }
    LDS_WAIT(); __builtin_amdgcn_s_barrier(); asm volatile("" ::: "memory");
}
__device__ __forceinline__ void n3_attn_sample_combine(const Ctx& C, int l, float lam_init) {
    THREAD_IDS();
    const float lam = lam_of(C, l, lam_init);
    const bf16* QNB = WSP(bf16, WS_QNB); const bf16* KNB = WSP(bf16, WS_KNB); const bf16* ZM = WSP(bf16, WS_ZMIX); bf16* BR = WSP(bf16, WS_BR);
    for (int it = gw; it < DB * 4 * DS; it += NGW) {
        const int b = it >> 5, h = (it >> 3) & 3, t = it & 7; float os[2];
        const float far = C.in[I_RELB][31 * 4 + h];
        float sn[2][8];
        { const float qv = bf2f(QNB[(size_t)(MP + b * 8 + t) * 256 + h * 64 + lane]);
#pragma unroll
          for (int jj = 0; jj < 8; ++jj) { float p = qv * bf2f(KNB[(size_t)(MP + b * 8 + jj) * 256 + h * 64 + lane]);
              p += __shfl_xor(p, 1); p += __shfl_xor(p, 2); p += __shfl_xor(p, 4); p += __shfl_xor(p, 8); p += __shfl_xor(p, 16);
              const float bias = (C.in[I_RELB][t5_bucket(t - jj < 0 ? 0 : t - jj) * 4 + h] - far) * LOG2E;
              sn[0][jj] = jj <= t ? __shfl(p, 0) + bias : -INFINITY; sn[1][jj] = jj <= t ? __shfl(p, 32) + bias : -INFINITY; } }
#pragma unroll
        for (int s = 0; s < 2; ++s) {
            const float* pb = WSP(float, WS_PART) + ((((size_t)b * 4 + h) * 16) * 16 + s * 8 + t) * PSTR;
            float mm = -INFINITY; float pm[16];
#pragma unroll
            for (int pi = 0; pi < 16; ++pi) { pm[pi] = pb[(size_t)pi * 16 * PSTR + 64]; mm = fmaxf(mm, pm[pi]); }
#pragma unroll
            for (int jj = 0; jj < 8; ++jj) mm = fmaxf(mm, sn[s][jj]);
            float ll = 0.f, oo = 0.f;
#pragma unroll
            for (int pi = 0; pi < 16; ++pi) { const float* pr = pb + (size_t)pi * 16 * PSTR; const float w = __builtin_amdgcn_exp2f(pm[pi] - mm); ll += pr[65] * w; oo += pr[lane] * w; }
#pragma unroll
            for (int jj = 0; jj < 8; ++jj) { const float w = __builtin_amdgcn_exp2f(sn[s][jj] - mm); ll += w; oo += w * bf2f(ZM[(size_t)(MP + b * 8 + jj) * NMIXP + D_V + h * 64 + lane]); }
            os[s] = oo / ll;
        }
        const float o = os[0] - lam * os[1]; const float ms = wave_sum(o * o) * (1.0f / 64);
        BR[(size_t)(MP + b * 8 + t) * D + 768 + h * 64 + lane] = (bf16)f2bf(o * rsqrtf(ms + EPS) * C.in[I_SUBLN][l * 64 + lane] * (1.0f - lam_init));
    }
}

__device__ __forceinline__ void n3_la_finalize(const Ctx& C, int l) {
    THREAD_IDS();
    const float* LAO = WSP(float, WS_LAO); const bf16* ZM = WSP(bf16, WS_ZMIX); bf16* BR = WSP(bf16, WS_BR);
    const bool ret = lane < 32; const int hd = (lane >> 3) & 3, c8 = (lane & 7) * 8;
    float gn[8];
#pragma unroll
    for (int j = 0; j < 8; ++j) gn[j] = (ret ? C.in[I_RGN] : C.in[I_GGN])[(l * 4 + hd) * 64 + c8 + j];
    for (int r0 = gw * 4; r0 < MP; r0 += NGW * 4) {
        f32x4 a4[4], b4[4]; v4u g4[4];
#pragma unroll
        for (int u = 0; u < 4; ++u) { const int r = min(r0 + u, MP - 1); a4[u] = *(const f32x4*)(LAO + (size_t)r * 512 + 8 * lane); b4[u] = *(const f32x4*)(LAO + (size_t)r * 512 + 8 * lane + 4);
            g4[u] = *(const v4u*)(ZM + (size_t)r * NMIXP + (ret ? R_G : G_R) + hd * 64 + c8); }
#pragma unroll
        for (int u = 0; u < 4; ++u) { const int r = r0 + u; if (r >= MP) break;
            float x[8] = {a4[u][0], a4[u][1], a4[u][2], a4[u][3], b4[u][0], b4[u][1], b4[u][2], b4[u][3]}, g[8]; unpack8(g4[u], g);
            float s = ((x[0] + x[1]) + (x[2] + x[3])) + ((x[4] + x[5]) + (x[6] + x[7]));
            s += __shfl_xor(s, 1); s += __shfl_xor(s, 2); s += __shfl_xor(s, 4);
            const float mean = ret ? s * (1.0f / 64) : 0.f; float q2 = 0.f;
#pragma unroll
            for (int j = 0; j < 8; ++j) { x[j] -= mean; q2 += x[j] * x[j]; }
            q2 += __shfl_xor(q2, 1); q2 += __shfl_xor(q2, 2); q2 += __shfl_xor(q2, 4);
            const float rs = rsqrtf(q2 * (1.0f / 64) + EPS);
#pragma unroll
            for (int j = 0; j < 8; ++j) x[j] = siluf_(g[j]) * x[j] * rs * gn[j];
            *(v4u*)(BR + (size_t)r * D + 256 + 8 * lane) = pack8(x); }
    }
}

constexpr int NQB_ATT = (L + 127) / 128;
constexpr int IT_LA = 32, IT_SS = IT_LA + DB * 8, IT_AT = IT_SS + 16 * NQB_ATT, IT_LS = IT_AT + 32, IT_CV = IT_LS + (MR + 63) / 64, IT_END = IT_CV;
__device__ __forceinline__ void n2_phase(const Ctx& C, int l, float lam_init, int qslot) {
    THREAD_IDS();
    const float lam = lam_of(C, l, lam_init);
    float mb;
    { float mq = 0.f, mk = 0.f, mbias = 0.f;
#pragma unroll 1
      for (int i = 0; i < 32; ++i) { mq = fmaxf(mq, fabsf(C.in[I_QN][l * 32 + i])); mk = fmaxf(mk, fabsf(C.in[I_KN][l * 32 + i])); }
#pragma unroll 1
      for (int i = 0; i < 128; ++i) mbias = fmaxf(mbias, C.in[I_RELB][i] - C.in[I_RELB][31 * 4 + (i & 3)]);
      mb = 1.02f * 1.4426950408889634f * 5.656854249492381f * mq * mk + 1.4426950408889634f * mbias; }
    unsigned* qw = (unsigned*)(C.ws + WS_CTL) + CW_QUEUE + 64 * qslot;
    volatile LAS int* slot = (volatile LAS int*)(C.lds + MISC_OFF + 64);
    if (blockIdx.x < IT_LA) { const int it = blockIdx.x; const int b = (it >> 2) & 3, h = it & 3; if (it < 16) la_chunked<64, true>(C, l, false, b, h); else la_chunked<32, false>(C, l, false, b, h); }
    for (;;) {
        if (tid == 0) slot[0] = (int)__hip_atomic_fetch_add(qw, 1u, __ATOMIC_RELAXED, __HIP_MEMORY_SCOPE_AGENT);
        __syncthreads();
        const int qi = slot[0];
        const int it = qi < 3 * DB * 8 ? ((qi % 3) ? IT_SS + 2 * (qi / 3) + (qi % 3) - 1 : IT_LA + qi / 3) : qi + IT_LA;
        __syncthreads();
        if (it >= IT_END) break;
        if (it < IT_SS) { const int i2 = it - IT_LA; attn_sample_item(C, l, i2 >> 3, i2 & 7); }
        else if (it < IT_AT) { const int i2 = it - IT_SS; attn_prompt_item(C, l, (i2 & 15) >> 2, i2 & 3, NQB_ATT - 1 - (i2 >> 4), lam, lam_init, mb); }
        else if (it < IT_LS) { const int i2 = (it - IT_AT) * 8 + wave; const int b = (i2 >> 2) & 31, h = i2 & 3; if (i2 < 128) la_seq<64, true>(C, l, true, b, h); else la_seq<32, false>(C, l, true, b, h); }
        else { conv_rows_item(C, l, it - IT_LS); conv_state_item(C, l, it - IT_LS, IT_CV - IT_LS); }
    }
}

template <int l> __device__ __forceinline__ void layer_fwd(const Ctx& C, const XcdBarrier& bar) {
#define GRID_BAR() xcd_barrier<false>(bar)
    LAS unsigned char* ring = C.lds + RING_OFF;
    float* SS = WSP(float, WS_SS); float* H = WSP(float, WS_H); bf16* HB = WSP(bf16, WS_HB); bf16* ACT = WSP(bf16, WS_ACT); bf16* ZMIX = WSP(bf16, WS_ZMIX); bf16* GATES = WSP(bf16, WS_GATES);
    bf16* BR = WSP(bf16, WS_BR); bf16* MERGED = WSP(bf16, WS_MERGED);
    constexpr float lam_init = l == 0 ? 0.2f : 0.35550906759096926f;
    constexpr bool last = (l == DEPTH - 1);
    { pg8::Gemm g{HB, WSP(bf16, WS_W1 + (size_t)(l * 2 + 0) * SZ_W1), D, D, D}; pg8::StaticOrder S; S.init(M, 2 * DFF, C.G, (int)blockIdx.x);
      EpiGLU E{ACT, SS + (size_t)(l * 3 + 0) * M * 16}; pg8::gemm_phase<EpiGLU, pg8::StaticOrder, true, true>(ring, g, S, E); }
    GRID_BAR();
    { pg8::HeadOrder S; S.init(M, D, C.G, (int)blockIdx.x); S.limit = C.G; EpiRes<false, 1> E{H, HB, SS + (size_t)(l * 3 + 1) * M * 16, nullptr};
      { pg8::Gemm g{ACT, WSP(bf16, WS_WD + (size_t)(l * 2 + 0) * SZ_WD), DFF, DFF, DFF}; pg8::gemm_phase<EpiRes<false, 1>, pg8::HeadOrder, true, true>(ring, g, S, E); }
      { int kt = DFF / 11; asm volatile("" : "+s"(kt)); pg8::Gemm g{ACT, WSP(bf16, WS_WD + (size_t)(l * 2 + 0) * SZ_WD), DFF, DFF, kt}; pg8::TailOrder T; T.init(M, D, C.G, (int)blockIdx.x); T.limit = C.G; T.nsplit = 11; T.kper = DFF / 11;
        EpiPartial EP{WSP(float, WS_KSP)}; pg8::gemm_phase<EpiPartial, pg8::TailOrder, true, true>(ring, g, T, EP); }
      GRID_BAR();
      ksp_finalize<11>(WSP(float, WS_KSP), S, C.G, E); }
    GRID_BAR();
    { pg8::Gemm g{HB, WSP(bf16, WS_WIN + (size_t)l * SZ_WIN), D, D, D}; pg8::StaticOrder S; S.init(M, NINP, C.G, (int)blockIdx.x);
      EpiZ E{ZMIX, GATES, SS + (size_t)(l * 3 + 1) * M * 16, WSP(float, WS_BINP) + l * NINP}; pg8::gemm_phase<EpiZ, pg8::StaticOrder, true, true>(ring, g, S, E); }
    GRID_BAR();
    n1_prep(C, l);
    GRID_BAR();
    n2_phase(C, l, lam_init, l);
    GRID_BAR();
    n3_attn_sample_combine(C, l, lam_init);
    n3_la_finalize(C, l);
    GRID_BAR();
    { pg8::Gemm g{BR, WSP(bf16, WS_WBR + (size_t)l * SZ_WBR), D, D, D}; pg8::StaticOrder S; S.init(M, D, C.G, (int)blockIdx.x);
      EpiMergeR E{MERGED, GATES}; pg8::gemm_phase<EpiMergeR, pg8::StaticOrder, true, true, 4>(ring, g, S, E); }
    GRID_BAR();
    { pg8::HeadOrder S; S.init(M, D, C.G, (int)blockIdx.x); S.limit = C.G; EpiRes<false, 2> E{H, HB, SS + (size_t)(l * 3 + 2) * M * 16, nullptr};
      { pg8::Gemm g{MERGED, WSP(bf16, WS_WOUT + (size_t)l * SZ_WOUT), D, D, D}; pg8::gemm_phase<EpiRes<false, 2>, pg8::HeadOrder, true, true>(ring, g, S, E); }
      { int kt = D / 4; asm volatile("" : "+s"(kt)); pg8::Gemm g{MERGED, WSP(bf16, WS_WOUT + (size_t)l * SZ_WOUT), D, D, kt}; pg8::TailOrder T; T.init(M, D, C.G, (int)blockIdx.x); T.limit = C.G; T.nsplit = 4; T.kper = D / 4;
        EpiPartial EP{WSP(float, WS_KSP)}; pg8::gemm_phase<EpiPartial, pg8::TailOrder, true, true>(ring, g, T, EP); }
      GRID_BAR();
      ksp_finalize<4>(WSP(float, WS_KSP), S, C.G, E); }
    GRID_BAR();
    { pg8::Gemm g{HB, WSP(bf16, WS_W1 + (size_t)(l * 2 + 1) * SZ_W1), D, D, D}; pg8::StaticOrder S; S.init(M, 2 * DFF, C.G, (int)blockIdx.x);
      EpiGLU E{ACT, SS + (size_t)(l * 3 + 2) * M * 16}; pg8::gemm_phase<EpiGLU, pg8::StaticOrder, true, true>(ring, g, S, E); }
    GRID_BAR();
    { pg8::HeadOrder S; S.init(M, D, C.G, (int)blockIdx.x); S.limit = C.G; EpiRes<last, 1> E{H, HB, last ? nullptr : SS + (size_t)((l + 1) * 3) * M * 16, C.out};
      { pg8::Gemm g{ACT, WSP(bf16, WS_WD + (size_t)(l * 2 + 1) * SZ_WD), DFF, DFF, DFF}; pg8::gemm_phase<EpiRes<last, 1>, pg8::HeadOrder, true, true>(ring, g, S, E); }
      { int kt = DFF / 11; asm volatile("" : "+s"(kt)); pg8::Gemm g{ACT, WSP(bf16, WS_WD + (size_t)(l * 2 + 1) * SZ_WD), DFF, DFF, kt}; pg8::TailOrder T; T.init(M, D, C.G, (int)blockIdx.x); T.limit = C.G; T.nsplit = 11; T.kper = DFF / 11;
        EpiPartial EP{WSP(float, WS_KSP)}; pg8::gemm_phase<EpiPartial, pg8::TailOrder, true, true>(ring, g, T, EP); }
      GRID_BAR();
      ksp_finalize<11>(WSP(float, WS_KSP), S, C.G, E); }
#undef GRID_BAR
}

__global__ void __launch_bounds__(NWAVES * 64, 2) fwd(Params P) {
    extern __shared__ __attribute__((aligned(16))) unsigned char lds[];
    Ctx C;
    C.in = P.in; C.out = P.out; C.ws = P.ws; C.lds = (LAS unsigned char*)lds;
    C.G = gridDim.x;
    volatile LAS unsigned* MISC = (volatile LAS unsigned*)(C.lds + MISC_OFF);
    for (int u = threadIdx.x; u < (LDS_BYTES - LDSCTL_OFF) / 4; u += NWAVES * 64) ((LAS unsigned*)(C.lds + LDSCTL_OFF))[u] = 0u;
    __syncthreads();
    unsigned* ctl = (unsigned*)(C.ws + WS_CTL);
    XcdBarrier bar = xcd_barrier_post(ctl + CW_BAR, MISC + 8);
    p0_prologue(C, P);
    xcd_barrier<true>(bar);
    layer_fwd<0>(C, bar);
    xcd_barrier<false>(bar);
    layer_fwd<1>(C, bar);
}

extern "C" void kernel_launch(void* const* d_in, const int* in_sizes, int n_in, void* d_out, int out_size, void* d_ws, size_t ws_size, hipStream_t stream) {
    static int grid = 0;
    if (grid == 0) {
        if (n_in != N_INPUTS || (size_t)out_size != O_END || ws_size < WS_END) { fprintf(stderr, "kernel_launch: unexpected shapes: n_in %d out %d (want %zu) ws %zu (want %zu)\n", n_in, out_size, (size_t)O_END, ws_size, (size_t)WS_END); grid = -1; return; }
        int dev = 0, cus = 0, per_cu = 0;
        if (hipGetDevice(&dev) != hipSuccess || hipDeviceGetAttribute(&cus, hipDeviceAttributeMultiprocessorCount, dev) != hipSuccess) { grid = -1; return; }
        if (hipFuncSetAttribute((const void*)fwd, hipFuncAttributeMaxDynamicSharedMemorySize, LDS_BYTES) != hipSuccess) { fprintf(stderr, "kernel_launch: hipFuncSetAttribute failed\n"); grid = -1; return; }
        if (hipOccupancyMaxActiveBlocksPerMultiprocessor(&per_cu, (const void*)fwd, NWAVES * 64, LDS_BYTES) != hipSuccess || per_cu < 1) { fprintf(stderr, "kernel_launch: occupancy query says %d blocks per CU\n", per_cu); }
        (void)hipGetLastError();
        grid = cus;
    }
    if (grid < 0) return;
    if (hipMemsetAsync((char*)d_ws + WS_CTL, 0, CTL_ZERO_BYTES, stream) != hipSuccess) return;
    Params p{};
    for (int i = 0; i < N_INPUTS; ++i) p.in[i] = (const float*)d_in[i];
    p.out = (float*)d_out; p.ws = (unsigned char*)d_ws;
    for (int i = 0; i < 32; ++i) p.inv_freq[i] = (float)pow(10000.0, -(double)i / 32.0);
    hipLaunchKernelGGL(fwd, dim3(grid), dim3(NWAVES * 64), LDS_BYTES, stream, p);
}
```

```cpp
#include <hip/hip_runtime.h>
#include <cstdio>
#include <cstdint>
#include <cmath>

namespace pg8 {
#define PG8_LAS __attribute__((address_space(3)))
typedef unsigned short bf16_t;
typedef short bf16x8 __attribute__((ext_vector_type(8)));
typedef float f32x4 __attribute__((ext_vector_type(4)));
typedef unsigned u32x4 __attribute__((ext_vector_type(4)));
constexpr int BM = 256, BK = 64, HALF = 128, HTB = HALF * BK * 2  , STAGE_BYTES = 8 * HTB, NXCD = 8, WGM = 8;

__host__ __device__ __forceinline__ int lds_byte(int r, int c) { const int st = (r >> 4) * 2 + (c >> 5), rr = r & 15, cc = c & 31, ob = rr * 64 + cc * 2; return st * 1024 + (ob ^ (((ob >> 9) & 1) << 5)); }
__host__ __device__ __forceinline__ void stage_rc(int b, int& R, int& C) { const int st = b / 1024, sb = b % 1024, swz = sb ^ (((sb >> 9) & 1) << 5); R = (st >> 1) * 16 + swz / 64; C = (st & 1) * 32 + (swz % 64) / 2; }
__host__ __device__ __forceinline__ int perm32(int rho) { const int n = rho >> 4, i = rho & 15; return 8 * (i >> 2) + 4 * n + (i & 3); }

struct Unit { int pm, pn, acol, bcol; };
struct Gemm { const bf16_t* A; const bf16_t* Bt; int lda, ldb, K, kseg0; };

struct StaticOrder {
    int nM, nN, nwg, G, c;
    __host__ __device__ void init(int M, int N, int G_, int c_) { nM = M / BM; nN = N / BM; nwg = nM * nN; G = G_; c = c_; }
    __host__ __device__ void unit_of(int L, Unit& u) const {
        int wgid = L; { const int q = nwg / NXCD, r = nwg % NXCD, xcd = wgid % NXCD, off = wgid / NXCD; wgid = (xcd < r ? xcd * (q + 1) : r * (q + 1) + (xcd - r) * q) + off; }
        const int nig = WGM * nN, gid = wgid / nig, fm = gid * WGM, gsz = (nM - fm) < WGM ? (nM - fm) : WGM;
        u.pm = fm + ((wgid % nig) % gsz); u.pn = (wgid % nig) / gsz; u.acol = 0; u.bcol = 0;
    }
    __host__ __device__ bool next(int i, Unit& u) const { const long L = (long)i * G + c; if (L >= nwg) return false; unit_of((int)L, u); return true; }
};
struct HeadOrder : StaticOrder { int limit; __host__ __device__ bool next(int i, Unit& u) const { const long L = (long)i * G + c; if (L >= limit || L >= nwg) return false; unit_of((int)L, u); return true; } };
struct TailOrder : StaticOrder { int limit, nsplit, kper;
    __host__ __device__ bool next(int i, Unit& u) const {
        if (i > 0 || c >= (nwg - limit) * nsplit) return false;
        unit_of(limit + c / nsplit, u); u.acol = u.bcol = (c % nsplit) * kper; return true; } };
__device__ __forceinline__ unsigned cvt_pk_bf16(float lo, float hi) { unsigned r; asm volatile("v_cvt_pk_bf16_f32 %0, %1, %2" : "=v"(r) : "v"(lo), "v"(hi)); return r; }

template <class Epi, class Sched, bool ALIGN_EPI = false, bool SP2 = false, int SEG = 0>
__device__ __forceinline__ void gemm_phase(PG8_LAS unsigned char* lds, const Gemm g, const Sched& S, const Epi& E) {
    int tid_ = threadIdx.x; asm volatile("" : "+v"(tid_));
    const int tid = tid_, wid = __builtin_amdgcn_readfirstlane(tid >> 6), lane = tid & 63, wr = wid >> 2, wc = wid & 3, fr = lane & 15, fq = lane >> 4;
    const int nt = g.K / BK;
    unsigned voffA[2], voffB[2];
#pragma unroll
    for (int i = 0; i < 2; ++i) { int R, C; stage_rc(tid * 16 + i * 8192, R, C); const int Rb = Epi::PERM ? ((R & ~31) + perm32(R & 31)) : R;
        voffA[i] = (unsigned)(R * g.lda + C) * 2u; voffB[i] = (unsigned)(Rb * g.ldb + C) * 2u; }
    const size_t kstep = (size_t)(BK * 2);
    const size_t hstepA = (size_t)HALF * g.lda * 2, hstepB = (size_t)HALF * g.ldb * 2;
    const size_t tstepA = 2 * hstepA, tstepB = 2 * hstepB;
    const unsigned ldsw = (unsigned)wid * 1024u;
    const int aoff = lds_byte(wr * 64 + fr, fq * 8), boff = lds_byte(wc * 32 + fr, fq * 8);
#define PG8_SA(b, h) (((b) * 2 + (h)) * HTB)
#define PG8_SB(b, h) ((4 + (b) * 2 + (h)) * HTB)
#define PG8_STAGE(bufoff, gbase, voff) do { _Pragma("unroll") for (int _i = 0; _i < 2; ++_i) \
        __builtin_amdgcn_global_load_lds((const unsigned*)((const char*)(gbase) + (voff)[_i]), (PG8_LAS unsigned*)(lds + (bufoff) + ldsw + _i * 8192), 16, 0, 0); } while (0)
#define PG8_LDA(dst, b, h) do { _Pragma("unroll") for (int m = 0; m < 4; ++m) _Pragma("unroll") for (int k = 0; k < 2; ++k) dst[m][k] = *(const PG8_LAS bf16x8*)(lds + PG8_SA(b, h) + aoff + m * 2048 + k * 1024); } while (0)
#define PG8_LDB(dst, b, h) do { _Pragma("unroll") for (int n = 0; n < 2; ++n) _Pragma("unroll") for (int k = 0; k < 2; ++k) dst[n][k] = *(const PG8_LAS bf16x8*)(lds + PG8_SB(b, h) + boff + n * 2048 + k * 1024); } while (0)
#define PG8_MMA(ai, bj, At, Bt) do { __builtin_amdgcn_s_setprio(1); _Pragma("unroll") for (int m = 0; m < 4; ++m) _Pragma("unroll") for (int n = 0; n < 2; ++n) _Pragma("unroll") for (int k = 0; k < 2; ++k) \
        acc[ai][bj][m][n] = __builtin_amdgcn_mfma_f32_16x16x32_bf16(Bt[n][k], At[m][k], acc[ai][bj][m][n], 0, 0, 0); __builtin_amdgcn_s_setprio(0); } while (0)
#define PG8_WAIT_V(n) asm volatile("s_waitcnt vmcnt(" #n ")" ::: "memory")
#define PG8_WAIT_L(n) asm volatile("s_waitcnt lgkmcnt(" #n ")" ::: "memory")
#define PG8_BAR __builtin_amdgcn_s_barrier()
#define PG8_SCHED __builtin_amdgcn_sched_barrier(0)
    Unit cur, nxt; int ui = 0;
    if (!S.next(0, cur)) return;
    f32x4 acc[2][2][4][2];
#pragma unroll
    for (int a = 0; a < 2; ++a)
#pragma unroll
        for (int b = 0; b < 2; ++b)
#pragma unroll
            for (int m = 0; m < 4; ++m)
#pragma unroll
                for (int n = 0; n < 2; ++n) acc[a][b][m][n] = (f32x4){0.f, 0.f, 0.f, 0.f};
    bf16x8 At[4][2], B0[2][2], B1[2][2];
    const char* cA = (const char*)g.A + (size_t)cur.pm * tstepA + (size_t)cur.acol * 2; const char* cB = (const char*)g.Bt + (size_t)cur.pn * tstepB + (size_t)cur.bcol * 2;
#define PG8_KOFF(t) ((SEG > 0) ? (size_t)(((((t) / (SEG > 0 ? SEG : 1)) + g.kseg0) & (nt / (SEG > 0 ? SEG : 1) - 1)) * (SEG > 0 ? SEG : 1) + ((t) % (SEG > 0 ? SEG : 1))) * kstep : (size_t)(t) * kstep)
    const size_t K0 = PG8_KOFF(0);
    cA += K0; cB += K0;
    if constexpr (SP2) {
        PG8_STAGE(PG8_SB(0, 0), cB, voffB); PG8_STAGE(PG8_SB(0, 1), cB + hstepB, voffB); PG8_STAGE(PG8_SA(0, 0), cA, voffA); PG8_STAGE(PG8_SA(0, 1), cA + hstepA, voffA);
        if (wr == 1) PG8_BAR;
        PG8_WAIT_V(2); PG8_BAR;
        PG8_STAGE(PG8_SB(1, 0), cB + kstep, voffB); PG8_STAGE(PG8_SA(1, 0), cA + kstep, voffA); PG8_STAGE(PG8_SB(1, 1), cB + hstepB + kstep, voffB);
        PG8_WAIT_V(6); PG8_BAR;
    } else {
        PG8_STAGE(PG8_SB(0, 0), cB, voffB); PG8_STAGE(PG8_SA(0, 0), cA, voffA); PG8_STAGE(PG8_SB(0, 1), cB + hstepB, voffB); PG8_STAGE(PG8_SA(0, 1), cA + hstepA, voffA);
        if (wr == 1) PG8_BAR;
        PG8_WAIT_V(4); PG8_BAR;
        PG8_STAGE(PG8_SB(1, 0), cB + kstep, voffB); PG8_STAGE(PG8_SA(1, 0), cA + kstep, voffA); PG8_STAGE(PG8_SB(1, 1), cB + hstepB + kstep, voffB);
        PG8_WAIT_V(6); PG8_BAR;
    }
    for (;;) {
        const bool has_next = S.next(ui + 1, nxt);
        const char* nA = has_next ? (const char*)g.A + (size_t)nxt.pm * tstepA + (size_t)nxt.acol * 2 + K0 : cA; const char* nB = has_next ? (const char*)g.Bt + (size_t)nxt.pn * tstepB + (size_t)nxt.bcol * 2 + K0 : cB;
        for (int t = 0; t < nt; t += 2) {
            const bool last = (t == nt - 2);
            const char* a1 = cA - K0 + PG8_KOFF(t + 1);
            const char* a2 = last ? nA : cA - K0 + PG8_KOFF(t + 2); const char* b2 = last ? nB : cB - K0 + PG8_KOFF(t + 2);
            const char* a3 = a2 + kstep; const char* b3 = b2 + kstep;
            if constexpr (SP2) {
            PG8_LDB(B0, 0, 0); PG8_LDB(B1, 0, 1); PG8_SCHED; PG8_LDA(At, 0, 0); PG8_STAGE(PG8_SA(1, 1), a1 + hstepA, voffA);
            PG8_WAIT_V(8); PG8_WAIT_L(0); PG8_BAR; PG8_MMA(0, 0, At, B0); PG8_MMA(0, 1, At, B1); PG8_BAR; PG8_SCHED;
            PG8_LDA(At, 0, 1); PG8_STAGE(PG8_SB(0, 0), b2, voffB); PG8_STAGE(PG8_SB(0, 1), b2 + hstepB, voffB); PG8_STAGE(PG8_SA(0, 0), a2, voffA);
            PG8_WAIT_V(8); PG8_WAIT_L(0); PG8_BAR; PG8_MMA(1, 0, At, B0); PG8_MMA(1, 1, At, B1); PG8_BAR; PG8_SCHED;
            PG8_LDB(B0, 1, 0); PG8_LDB(B1, 1, 1); PG8_SCHED; PG8_LDA(At, 1, 0); PG8_STAGE(PG8_SA(0, 1), a2 + hstepA, voffA);
            PG8_WAIT_V(8); PG8_WAIT_L(0); PG8_BAR; PG8_MMA(0, 0, At, B0); PG8_MMA(0, 1, At, B1); PG8_BAR; PG8_SCHED;
            PG8_LDA(At, 1, 1); PG8_STAGE(PG8_SB(1, 0), b3, voffB); PG8_STAGE(PG8_SB(1, 1), b3 + hstepB, voffB); PG8_STAGE(PG8_SA(1, 0), a3, voffA);
            PG8_WAIT_V(8); PG8_WAIT_L(0); PG8_BAR; PG8_MMA(1, 0, At, B0); PG8_MMA(1, 1, At, B1); PG8_BAR; PG8_SCHED;
            } else {
            PG8_LDB(B0, 0, 0); PG8_SCHED; PG8_LDA(At, 0, 0); PG8_STAGE(PG8_SA(1, 1), a1 + hstepA, voffA);
            PG8_WAIT_L(8); PG8_BAR; PG8_WAIT_L(0); PG8_MMA(0, 0, At, B0); PG8_BAR; PG8_SCHED;
            PG8_LDB(B1, 0, 1); PG8_STAGE(PG8_SB(0, 0), b2, voffB);
            PG8_BAR; PG8_WAIT_L(0); PG8_MMA(0, 1, At, B1); PG8_BAR;
            PG8_LDA(At, 0, 1); PG8_STAGE(PG8_SA(0, 0), a2, voffA);
            PG8_BAR; PG8_WAIT_L(0); PG8_MMA(1, 0, At, B0); PG8_BAR; PG8_SCHED;
            PG8_STAGE(PG8_SB(0, 1), b2 + hstepB, voffB);
            PG8_WAIT_V(6); PG8_BAR; PG8_MMA(1, 1, At, B1); PG8_BAR;
            PG8_LDB(B0, 1, 0); PG8_SCHED; PG8_LDA(At, 1, 0); PG8_STAGE(PG8_SA(0, 1), a2 + hstepA, voffA);
            PG8_WAIT_L(8); PG8_BAR; PG8_WAIT_L(0); PG8_MMA(0, 0, At, B0); PG8_BAR; PG8_SCHED;
            PG8_LDB(B1, 1, 1); PG8_STAGE(PG8_SB(1, 0), b3, voffB);
            PG8_BAR; PG8_WAIT_L(0); PG8_MMA(0, 1, At, B1); PG8_BAR;
            PG8_LDA(At, 1, 1); PG8_STAGE(PG8_SA(1, 0), a3, voffA);
            PG8_BAR; PG8_WAIT_L(0); PG8_MMA(1, 0, At, B0); PG8_BAR; PG8_SCHED;
            PG8_STAGE(PG8_SB(1, 1), b3 + hstepB, voffB);
            PG8_WAIT_V(6); PG8_BAR; PG8_MMA(1, 1, At, B1); PG8_BAR;
            }
            if constexpr (SEG > 0) { if (((t + 2) % SEG) == 0 && (t + 2) < nt) E.mid(acc, cur, (t + 2) / SEG, g.kseg0); }
        }
        if constexpr (ALIGN_EPI) { if (wr == 0) PG8_BAR; }
        E(acc, cur, wr, wc, fr, fq);
        if (!has_next) break;
#pragma unroll
        for (int a = 0; a < 2; ++a)
#pragma unroll
            for (int b = 0; b < 2; ++b)
#pragma unroll
                for (int m = 0; m < 4; ++m)
#pragma unroll
                    for (int n = 0; n < 2; ++n) acc[a][b][m][n] = (f32x4){0.f, 0.f, 0.f, 0.f};
        cur = nxt; cA = nA; cB = nB; ++ui;
        if constexpr (ALIGN_EPI) { if (wr == 1) PG8_BAR; }
    }
    PG8_WAIT_V(0);
    if constexpr (!ALIGN_EPI) { if (wr == 0) PG8_BAR; }
    PG8_BAR;
#undef PG8_KOFF
#undef PG8_SA
#undef PG8_SB
#undef PG8_STAGE
#undef PG8_LDA
#undef PG8_LDB
#undef PG8_MMA
#undef PG8_WAIT_V
#undef PG8_WAIT_L
#undef PG8_BAR
#undef PG8_SCHED
}
}

constexpr int NWAVES = 8;
constexpr int D = 1024, DFF = 2816, NIN = 7184, NMIX = 3088, NMIXP = 3328, NGATE = 4096, NINP = NMIXP + NGATE;
constexpr int SEQ = 4096, NMETA = 16, L = SEQ + NMETA, BATCH = 4, DB = 32, DS = 8, PAST = 8192, PAGE = 128, NPAGES = PAST / PAGE, NPOOL = 2560, DEPTH = 2;
constexpr int MP = BATCH * L, MS = DB * DS, MR = MP + MS, M = 16896;
constexpr int NPOS = L + DS;
constexpr float EPS = 1e-6f;
constexpr int C_A = 0, C_G = 256, R_Q = 512, R_K = 768, R_V = 1024, R_G = 1280, G_Q = 1536, G_K = 1664, G_V = 1792, G_R = 2048, G_LOW = 2304, D_Q = 2320, D_K = 2576, D_V = 2832;
constexpr size_t O_YP = 0, O_YS = O_YP + (size_t)BATCH * SEQ * D, O_KP = O_YS + (size_t)MS * D, O_VP = O_KP + (size_t)DEPTH * MP * 256, O_KS = O_VP + (size_t)DEPTH * MP * 256,
                 O_VS = O_KS + (size_t)DEPTH * MS * 256, O_RP = O_VS + (size_t)DEPTH * MS * 256, O_RS = O_RP + (size_t)DEPTH * BATCH * 4 * 64 * 64, O_GP = O_RS + (size_t)DEPTH * DB * 4 * 64 * 64,
                 O_GS = O_GP + (size_t)DEPTH * BATCH * 4 * 32 * 64, O_CP = O_GS + (size_t)DEPTH * DB * 4 * 32 * 64, O_CS = O_CP + (size_t)DEPTH * BATCH * 30 * 256, O_END = O_CS + (size_t)DEPTH * DB * 30 * 256;
enum { I_XP = 0, I_XS, I_CK, I_CV, I_PT, I_SRET, I_SGLA, I_SCONV, I_META, I_RELB, I_NF1, I_F1G, I_F1U, I_F1D, I_NMIX, I_WIN, I_BIN, I_CW, I_CB, I_CLG, I_CLB, I_RGN, I_GAW, I_GAB, I_GGN,
       I_QN, I_KN, I_LQ1, I_LK1, I_LQ2, I_LK2, I_SUBLN, I_WBR, I_WOUT, I_NF2, I_F2G, I_F2U, I_F2D, N_INPUTS };

constexpr size_t MiB = 1u << 20;
constexpr size_t WS_CTL = 0, CTL_ZERO_BYTES = 64 * 1024;
constexpr size_t SZ_SS = (size_t)M * 16 * 4;
constexpr size_t SZ_W1 = (size_t)2 * DFF * D * 2, SZ_WD = (size_t)D * DFF * 2, SZ_WIN = (size_t)NINP * D * 2, SZ_WBR = (size_t)4 * D * 256 * 2, SZ_WOUT = (size_t)D * D * 2;
constexpr size_t WS_W1 = 4 * MiB;
constexpr size_t WS_WD = WS_W1 + 4 * SZ_W1;
constexpr size_t WS_WIN = WS_WD + 4 * SZ_WD;
constexpr size_t WS_WBR = WS_WIN + 2 * SZ_WIN;
constexpr size_t WS_WOUT = WS_WBR + 2 * SZ_WBR;
constexpr size_t WS_BINP = WS_WOUT + 2 * SZ_WOUT;
constexpr size_t WS_ROPE = WS_BINP + 64 * 1024;
constexpr size_t WS_SS = WS_ROPE + 2 * MiB;
constexpr size_t WS_H = 128 * MiB;
constexpr size_t WS_HB = WS_H + (size_t)M * D * 4;
constexpr size_t WS_ACT = WS_HB + (size_t)M * D * 2;
constexpr size_t WS_ZMIX = WS_ACT + (size_t)M * DFF * 2;
constexpr size_t WS_GATES = WS_ZMIX + (size_t)M * NMIXP * 2;
constexpr size_t WS_BR = WS_GATES + (size_t)M * NGATE * 2;
constexpr size_t WS_MERGED = WS_BR + (size_t)M * D * 2;
constexpr size_t WS_UBUF = WS_MERGED + (size_t)M * D * 2;
constexpr size_t WS_RQ = WS_UBUF + (size_t)M * 256 * 4, WS_RK = WS_RQ + (size_t)M * 256 * 4, WS_QN = WS_RK + (size_t)M * 256 * 4, WS_KN = WS_QN + (size_t)M * 256 * 4, WS_VB = WS_KN + (size_t)M * 256 * 4;
constexpr size_t WS_LDEC = WS_VB + (size_t)M * 256 * 4;
constexpr size_t WS_QNB = WS_LDEC + (size_t)M * 128 * 4;
constexpr size_t WS_KNB = WS_QNB + (size_t)M * 256 * 2;
constexpr size_t WS_PART = WS_KNB + (size_t)M * 256 * 2;
constexpr size_t WS_LAO = WS_PART + (size_t)DB * 4 * 16 * 16 * 68 * 4;
constexpr size_t WS_KSP = WS_LAO + (size_t)M * 512 * 4;
constexpr size_t WS_END = WS_KSP + (size_t)8 * 11 * 65536 * 4;
static_assert(WS_ROPE + 2 * NPOS * 32 * 4 <= WS_SS && WS_SS + 6 * SZ_SS <= WS_H, "weights region overflows");
constexpr int CW_BAR = 4096, CW_QUEUE = 8192;

constexpr int RING_OFF = 0, RING_BYTES = 131072;
constexpr int LDSCTL_OFF = 144384, MISC_OFF = LDSCTL_OFF + 320;
constexpr int LDS_BYTES = 147456;
static_assert(MISC_OFF + 128 <= LDS_BYTES, "LDS map");

#define GAS __attribute__((address_space(1)))
#define LAS __attribute__((address_space(3)))
typedef unsigned short bf16;
typedef unsigned v4u __attribute__((ext_vector_type(4)));
typedef float f32x4 __attribute__((ext_vector_type(4)));
#define LDS_WAIT() asm volatile("s_waitcnt lgkmcnt(0)" ::: "memory")
#define VM_WAIT() asm volatile("s_waitcnt vmcnt(0)" ::: "memory")
__device__ __forceinline__ unsigned f2bf(float f) { unsigned u = __builtin_bit_cast(unsigned, f); return (u + 0x7fffu + ((u >> 16) & 1u)) >> 16; }
__device__ __forceinline__ unsigned pk2(float lo, float hi) { return f2bf(lo) | (f2bf(hi) << 16); }
__device__ __forceinline__ float bf2f(bf16 b) { return __builtin_bit_cast(float, ((unsigned)b) << 16); }
__device__ __forceinline__ float bflo(unsigned w) { return __builtin_bit_cast(float, w << 16); }
__device__ __forceinline__ float bfhi(unsigned w) { return __builtin_bit_cast(float, w & 0xffff0000u); }
__device__ __forceinline__ float wave_sum(float v) {
#pragma unroll
    for (int o = 1; o < 64; o <<= 1) v += __shfl_xor(v, o);
    return v;
}
__device__ __forceinline__ float sigmoidf_(float x) { return __builtin_amdgcn_rcpf(1.0f + __expf(-x)); }
__device__ __forceinline__ float siluf_(float x) { return x * __builtin_amdgcn_rcpf(1.0f + __expf(-x)); }

#define XB_TMO      128
#define XB_XCNT(j)  (256  + 64 * (j))
#define XB_XSUB(j)  (1280 + 64 * (j))
#define XB_XGEN(j)  (2304 + 64 * (j))
#define XB_TOP      3328
#define XB_TOPGEN   3392
#define XCD_BAR_WORDS 3456
#define XB_SPIN_CAP (1u << 22)

__device__ __forceinline__ unsigned xb_ld(unsigned* p)              { return __hip_atomic_load(p, __ATOMIC_RELAXED, __HIP_MEMORY_SCOPE_AGENT); }
__device__ __forceinline__ unsigned xb_add(unsigned* p, unsigned v) { return __hip_atomic_fetch_add(p, v, __ATOMIC_RELAXED, __HIP_MEMORY_SCOPE_AGENT); }
__device__ __forceinline__ unsigned xb_xcc_id() { return (unsigned)__builtin_amdgcn_s_getreg((3 << 11) | 20) & 0xFu; }
#define XB_SPIN(cond, bar) do { unsigned _sp = 0; while (cond) { __builtin_amdgcn_s_sleep(1); \
    if ((++_sp & 255u) == 0u) { if (xb_ld(&(bar)[XB_TMO])) break; if (_sp > XB_SPIN_CAP) { atomicAdd(&(bar)[XB_TMO], 1u); break; } } } } while (0)

struct XcdBarrier { unsigned* bar; unsigned x; volatile LAS unsigned* st; };

__device__ __forceinline__ XcdBarrier xcd_barrier_post(unsigned* bar, volatile LAS unsigned* st) {
    XcdBarrier b; b.bar = bar; b.x = xb_xcc_id(); b.st = st;
    if (threadIdx.x == 0) (void)xb_add(&bar[XB_XCNT(b.x)], 1u);
    return b;
}
__device__ __forceinline__ void xcd_barrier_complete(unsigned* bar, unsigned x, unsigned& nloc, unsigned& nx) {
    const unsigned G = gridDim.x * gridDim.y * gridDim.z;
    unsigned sum, cnt, mine, sp = 0u;
    for (;;) {
        sum = 0u; cnt = 0u; mine = 0u;
#pragma unroll
        for (unsigned j = 0; j < 16; ++j) { const unsigned c = xb_ld(&bar[XB_XCNT(j)]); sum += c; cnt += (c > 0u) ? 1u : 0u; mine = (j == x) ? c : mine; }
        if (sum == G) break;
        __builtin_amdgcn_s_sleep(1);
        if ((++sp & 255u) == 0u) { if (xb_ld(&bar[XB_TMO])) break; if (sp > XB_SPIN_CAP) { atomicAdd(&bar[XB_TMO], 1u); break; } }
    }
    nloc = mine > 0u ? mine : 1u; nx = cnt > 0u ? cnt : 1u;
}
#ifndef FLAT_BAR
#define FLAT_BAR 0
#endif
__device__ __forceinline__ void flat_barrier(const XcdBarrier& b) {
    asm volatile("s_waitcnt vmcnt(0)" ::: "memory");
    __syncthreads();
    if (threadIdx.x == 0) {
        unsigned* bar = b.bar;
        asm volatile("" : "+s"(bar));
        const unsigned epoch = b.st[2] + 1u; b.st[2] = epoch; const unsigned target = epoch * gridDim.x;
        __builtin_amdgcn_fence(__ATOMIC_RELEASE, "agent");
        asm volatile("s_waitcnt vmcnt(0)" ::: "memory");
        (void)xb_add(&bar[XB_TOP], 1u);
        unsigned sp = 0u;
        while (xb_ld(&bar[XB_TOP]) < target) { __builtin_amdgcn_s_sleep(1); if ((++sp & 255u) == 0u) { if (xb_ld(&bar[XB_TMO])) break; if (sp > XB_SPIN_CAP) { atomicAdd(&bar[XB_TMO], 1u); break; } } }
        __builtin_amdgcn_fence(__ATOMIC_ACQUIRE, "agent");
        asm volatile("s_waitcnt vmcnt(0)" ::: "memory");
    }
    __syncthreads();
}
template <bool FIRST> __device__ __forceinline__ void xcd_barrier(const XcdBarrier& b) {
    if (FLAT_BAR) { flat_barrier(b); return; }
    asm volatile("s_waitcnt vmcnt(0)" ::: "memory");
    __syncthreads();
    if (threadIdx.x == 0) {
        unsigned* bar = b.bar;
        asm volatile("" : "+s"(bar));
        __builtin_amdgcn_s_waitcnt(0);
        unsigned nloc = b.st[0], nx = b.st[1];
        if (FIRST) { if (nloc == 0u) { xcd_barrier_complete(bar, b.x, nloc, nx); b.st[0] = nloc; b.st[1] = nx; } }
        const unsigned old = xb_add(&bar[XB_XSUB(b.x)], 1u);
        const unsigned gen = old / nloc;
        if (old + 1u == (gen + 1u) * nloc) {
            __builtin_amdgcn_fence(__ATOMIC_RELEASE, "agent");
            asm volatile("s_waitcnt vmcnt(0)" ::: "memory");
            const unsigned og = xb_add(&bar[XB_TOP], 1u);
            const unsigned tg = og / nx;
            if (og + 1u == (tg + 1u) * nx) {
#pragma unroll
                for (unsigned j = 0; j < 16; ++j) (void)__hip_atomic_fetch_add(&bar[XB_XGEN(j)], 1u, __ATOMIC_RELAXED, __HIP_MEMORY_SCOPE_AGENT);
            }
        }
        XB_SPIN(xb_ld(&bar[XB_XGEN(b.x)]) == gen, bar);
        __builtin_amdgcn_fence(__ATOMIC_ACQUIRE, "agent");
        asm volatile("s_waitcnt vmcnt(0)" ::: "memory");
    }
    __syncthreads();
}

struct Params { const float* in[N_INPUTS]; float* out; unsigned char* ws; float inv_freq[32]; };
static_assert(sizeof(Params) == N_INPUTS * 8 + 16 + 128, "Params has no padding");

struct Ctx {
    const float* const* in; float* out; unsigned char* ws;
    LAS unsigned char* lds;
    int G;
};
#define THREAD_IDS() int tid_ = threadIdx.x; asm volatile("" : "+v"(tid_)); const int tid = tid_, lane = tid & 63, wave = __builtin_amdgcn_readfirstlane(tid >> 6), gw = blockIdx.x * NWAVES + wave, NGW = C.G * NWAVES; (void)tid; (void)lane; (void)wave; (void)gw; (void)NGW
#define WSP(T, off) ((T*)(C.ws + (off)))

__device__ __forceinline__ float rstd_of(const float* ssp, int row) {
    const f32x4 a = *(const f32x4*)(ssp + (size_t)row * 16), b = *(const f32x4*)(ssp + (size_t)row * 16 + 4), c = *(const f32x4*)(ssp + (size_t)row * 16 + 8), d = *(const f32x4*)(ssp + (size_t)row * 16 + 12);
    const float s = (((a[0] + a[1]) + (a[2] + a[3])) + ((b[0] + b[1]) + (b[2] + b[3]))) + (((c[0] + c[1]) + (c[2] + c[3])) + ((d[0] + d[1]) + (d[2] + d[3])));
    return rsqrtf(s * (1.0f / D) + EPS);
}
#define EPI_IDS() int t_ = threadIdx.x; asm volatile("" : "+v"(t_)); const int wid_ = __builtin_amdgcn_readfirstlane(t_ >> 6), wr = wid_ >> 2, wc = wid_ & 3, fr = t_ & 15, fq = (t_ & 63) >> 4
struct EpiGLU {
    static constexpr bool PERM = true;
    bf16* act; const float* ss;
    __device__ __forceinline__ void operator()(const pg8::f32x4 (&acc)[2][2][4][2], const pg8::Unit& u, int, int, int, int) const {
        EPI_IDS();
        const int row0 = u.pm * 256 + wr * 64 + fr, col0 = u.pn * 128 + wc * 32 + 8 * fq;
#pragma unroll
        for (int ai = 0; ai < 2; ++ai)
#pragma unroll
            for (int m = 0; m < 4; ++m) {
                const int row = row0 + ai * 128 + m * 16; const float rstd = rstd_of(ss, row);
                float o[8];
#pragma unroll
                for (int n = 0; n < 2; ++n)
#pragma unroll
                    for (int j = 0; j < 4; ++j) { const float g = acc[ai][0][m][n][j] * rstd, up = acc[ai][1][m][n][j] * rstd; o[n * 4 + j] = siluf_(g) * up; }
                v4u w; w.x = pg8::cvt_pk_bf16(o[0], o[1]); w.y = pg8::cvt_pk_bf16(o[2], o[3]); w.z = pg8::cvt_pk_bf16(o[4], o[5]); w.w = pg8::cvt_pk_bf16(o[6], o[7]);
                *(v4u*)(act + (size_t)row * DFF + col0) = w;
            }
    }
};
template <bool FINAL, int SCALE2> struct EpiRes {
    static constexpr bool PERM = true;
    float* h; bf16* hb; float* ssout; float* out;
    __device__ __forceinline__ void rowgroup(const pg8::f32x4 (&a)[2][2], int row, int col0, int pn, int wc, int fq) const {
        constexpr float scale = 0.5f * SCALE2; float sq = 0.f;
        long yoff = -1;
        if (FINAL) { if (row < MP) { const int b = row / L, pos = row - b * L; if (pos >= NMETA) yoff = (long)O_YP + ((long)b * SEQ + (pos - NMETA)) * D; } else if (row < MR) yoff = (long)O_YS + (long)(row - MP) * D; }
#pragma unroll
        for (int bj = 0; bj < 2; ++bj) {
            const size_t off = (size_t)row * D + col0 + bj * 128;
            f32x4 h0 = *(const f32x4*)(h + off), h1 = *(const f32x4*)(h + off + 4);
            h0 = h0 + a[bj][0] * scale; h1 = h1 + a[bj][1] * scale;
            *(f32x4*)(h + off) = h0; *(f32x4*)(h + off + 4) = h1;
            v4u w; w.x = pg8::cvt_pk_bf16(h0[0], h0[1]); w.y = pg8::cvt_pk_bf16(h0[2], h0[3]); w.z = pg8::cvt_pk_bf16(h1[0], h1[1]); w.w = pg8::cvt_pk_bf16(h1[2], h1[3]);
            *(v4u*)(hb + off) = w;
            sq += (h0[0] * h0[0] + h0[1] * h0[1]) + (h0[2] * h0[2] + h0[3] * h0[3]) + (h1[0] * h1[0] + h1[1] * h1[1]) + (h1[2] * h1[2] + h1[3] * h1[3]);
            if (FINAL && yoff >= 0) { *(f32x4*)(out + yoff + col0 + bj * 128) = h0; *(f32x4*)(out + yoff + col0 + bj * 128 + 4) = h1; }
        }
        sq += __shfl_xor(sq, 16); sq += __shfl_xor(sq, 32);
        if (fq == 0 && ssout) ssout[(size_t)row * 16 + pn * 4 + wc] = sq;
    }
    __device__ __forceinline__ void operator()(const pg8::f32x4 (&acc)[2][2][4][2], const pg8::Unit& u, int, int, int, int) const {
        EPI_IDS();
        const int row0 = u.pm * 256 + wr * 64 + fr, col0 = u.pn * 256 + wc * 32 + 8 * fq;
#pragma unroll
        for (int ai = 0; ai < 2; ++ai)
#pragma unroll
            for (int m = 0; m < 4; ++m) {
                const pg8::f32x4 a[2][2] = {{acc[ai][0][m][0], acc[ai][0][m][1]}, {acc[ai][1][m][0], acc[ai][1][m][1]}};
                rowgroup(a, row0 + ai * 128 + m * 16, col0, u.pn, wc, fq);
                if (m == 3) asm volatile("" ::: "memory");
            }
    }
};
struct EpiZ {
    static constexpr bool PERM = true;
    bf16* zmix; bf16* gates; const float* ss; const float* bias;
    __device__ __forceinline__ void operator()(const pg8::f32x4 (&acc)[2][2][4][2], const pg8::Unit& u, int, int, int, int) const {
        EPI_IDS();
        const int row0 = u.pm * 256 + wr * 64 + fr, col0 = u.pn * 256 + wc * 32 + 8 * fq; const bool isgate = u.pn >= NMIXP / 256;
        f32x4 bv[2][2];
#pragma unroll
        for (int bj = 0; bj < 2; ++bj)
#pragma unroll
            for (int n = 0; n < 2; ++n) bv[bj][n] = *(const f32x4*)(bias + col0 + bj * 128 + 4 * n);
#pragma unroll
        for (int ai = 0; ai < 2; ++ai)
#pragma unroll
            for (int m = 0; m < 4; ++m) {
                const int row = row0 + ai * 128 + m * 16; const float rstd = rstd_of(ss, row);
                if (isgate) {
                    f32x4 g[4];
#pragma unroll
                    for (int bj = 0; bj < 2; ++bj)
#pragma unroll
                        for (int n = 0; n < 2; ++n) { const f32x4 z = acc[ai][bj][m][n] * rstd + bv[bj][n];
#pragma unroll
                            for (int j = 0; j < 4; ++j) g[2 * bj + n][j] = fmaxf(sigmoidf_(z[j]), 9.094947017729282e-13f); }
                    const int d0 = 64 * (u.pn - NMIXP / 256) + 16 * wc + 4 * fq; bf16* gp = gates + (size_t)row * NGATE + d0;
#pragma unroll
                    for (int s = 0; s < 4; ++s) { f32x4 o = g[s];
                        if (s < 3) {
#pragma unroll
                            for (int j = 0; j < 4; ++j) o[j] = g[s][j] * __builtin_amdgcn_rcpf(g[s + 1][j]); }
                        *(unsigned long long*)(gp + s * D) = (unsigned long long)pg8::cvt_pk_bf16(o[0], o[1]) | ((unsigned long long)pg8::cvt_pk_bf16(o[2], o[3]) << 32); }
                } else {
#pragma unroll
                    for (int bj = 0; bj < 2; ++bj) {
                        const f32x4 v0 = acc[ai][bj][m][0] * rstd + bv[bj][0], v1 = acc[ai][bj][m][1] * rstd + bv[bj][1];
                        v4u w; w.x = pg8::cvt_pk_bf16(v0[0], v0[1]); w.y = pg8::cvt_pk_bf16(v0[2], v0[3]); w.z = pg8::cvt_pk_bf16(v1[0], v1[1]); w.w = pg8::cvt_pk_bf16(v1[2], v1[3]);
                        *(v4u*)(zmix + (size_t)row * NMIXP + col0 + bj * 128) = w;
                    }
                }
            }
    }
};
struct EpiPartial {
    static constexpr bool PERM = true;
    float* part;
    __device__ __forceinline__ void operator()(const pg8::f32x4 (&acc)[2][2][4][2], const pg8::Unit& u, int, int, int, int) const {
        int t_ = threadIdx.x; asm volatile("" : "+v"(t_));
        const int slot = blockIdx.x;
        float* p = part + (size_t)slot * 65536 + (size_t)t_ * 4;
#pragma unroll
        for (int ai = 0; ai < 2; ++ai)
#pragma unroll
            for (int bj = 0; bj < 2; ++bj)
#pragma unroll
                for (int m = 0; m < 4; ++m)
#pragma unroll
                    for (int n = 0; n < 2; ++n) *(pg8::f32x4*)(p + (size_t)((((ai * 2 + bj) * 4 + m) * 2 + n) * 2048)) = acc[ai][bj][m][n];
        (void)u;
    }
};
template <int NSPLIT, class Epi> __device__ __forceinline__ void ksp_finalize(const float* part, const pg8::StaticOrder& so, int limit, const Epi& E) {
    const int ntail = so.nwg - limit;
    for (int it = blockIdx.x; it < ntail * 8; it += gridDim.x) {
        const int tt = it >> 3, ai = (it >> 2) & 1, m = it & 3;
        EPI_IDS();
        pg8::f32x4 a[2][2];
#pragma unroll
        for (int bj = 0; bj < 2; ++bj)
#pragma unroll
            for (int n = 0; n < 2; ++n) { pg8::f32x4 s = {0.f, 0.f, 0.f, 0.f};
#pragma unroll
                for (int k = 0; k < NSPLIT; ++k) s = s + *(const pg8::f32x4*)(part + (size_t)(tt * NSPLIT + k) * 65536 + (size_t)((((ai * 2 + bj) * 4 + m) * 2 + n) * 2048) + (size_t)t_ * 4);
                a[bj][n] = s; }
        pg8::Unit u; so.unit_of(limit + tt, u);
        E.rowgroup(a, u.pm * 256 + wr * 64 + fr + ai * 128 + m * 16, u.pn * 256 + wc * 32 + 8 * fq, u.pn, wc, fq);
    }
}

struct EpiMergeR {
    static constexpr bool PERM = true;
    bf16* merged; const bf16* gates;
    __device__ __forceinline__ void mid(pg8::f32x4 (&acc)[2][2][4][2], const pg8::Unit& u, int seg, int) const {
        EPI_IDS();
        const int row0 = u.pm * 256 + wr * 64 + fr, col0 = u.pn * 256 + wc * 32 + 8 * fq;
#pragma unroll
        for (int ai = 0; ai < 2; ++ai) {
#pragma unroll
            for (int m = 0; m < 4; ++m) {
                const int row = row0 + ai * 128 + m * 16;
#pragma unroll
                for (int bj = 0; bj < 2; ++bj) {
                    const v4u r = *(const v4u*)(gates + (size_t)row * NGATE + (seg - 1) * D + col0 + bj * 128);
                    pg8::f32x4& a0 = acc[ai][bj][m][0]; pg8::f32x4& a1 = acc[ai][bj][m][1];
                    a0[0] *= bflo(r.x); a0[1] *= bfhi(r.x); a0[2] *= bflo(r.y); a0[3] *= bfhi(r.y); a1[0] *= bflo(r.z); a1[1] *= bfhi(r.z); a1[2] *= bflo(r.w); a1[3] *= bfhi(r.w);
                }
            }
        }
    }
    __device__ __forceinline__ void operator()(const pg8::f32x4 (&acc)[2][2][4][2], const pg8::Unit& u, int, int, int, int) const {
        EPI_IDS();
        const int row0 = u.pm * 256 + wr * 64 + fr, col0 = u.pn * 256 + wc * 32 + 8 * fq;
#pragma unroll
        for (int ai = 0; ai < 2; ++ai)
#pragma unroll
            for (int m = 0; m < 4; ++m) {
                const int row = row0 + ai * 128 + m * 16;
#pragma unroll
                for (int bj = 0; bj < 2; ++bj) {
                    const v4u g = *(const v4u*)(gates + (size_t)row * NGATE + 3 * D + col0 + bj * 128);
                    const pg8::f32x4 a0 = acc[ai][bj][m][0], a1 = acc[ai][bj][m][1];
                    v4u w; w.x = pg8::cvt_pk_bf16(a0[0] * bflo(g.x), a0[1] * bfhi(g.x)); w.y = pg8::cvt_pk_bf16(a0[2] * bflo(g.y), a0[3] * bfhi(g.y));
                    w.z = pg8::cvt_pk_bf16(a1[0] * bflo(g.z), a1[1] * bfhi(g.z)); w.w = pg8::cvt_pk_bf16(a1[2] * bflo(g.w), a1[3] * bfhi(g.w));
                    *(v4u*)(merged + (size_t)row * D + col0 + bj * 128) = w;
                }
            }
    }
};

__host__ __device__ __forceinline__ int gate_col(int m) { const int br = m >> 10, d = m & 1023, dd = d & 63; return 256 * (d >> 6) + 128 * (br >> 1) + 32 * (dd >> 4) + 8 * ((dd >> 2) & 3) + 4 * (br & 1) + (dd & 3); }
__host__ __device__ __forceinline__ int gate_src(int c) { const int ct = c & 255, br = 2 * (ct >> 7) + ((ct >> 2) & 1), d = 64 * (c >> 8) + 16 * ((ct >> 5) & 3) + 4 * ((ct >> 3) & 3) + (ct & 3); return br * 1024 + d; }
struct RowMap { int mode, a; __device__ __forceinline__ int operator()(int n) const { return mode == 0 ? n + a : (mode == 1 ? 256 * (n >> 7) + (n & 127) + a : (n < NMIX ? n : NMIXP + gate_col(n - NMIX))); } };
__device__ __forceinline__ void tr_item(const float* W, int K, int N, const float* gain, bf16* WT, int pitch, RowMap rm, LAS float* scr, int kb, int nb, int lane) {
    const int k0 = 64 * kb, n0 = 64 * nb; const int nn = n0 + 4 * (lane & 15), kr = lane >> 4;
    f32x4 v[16];
#pragma unroll
    for (int i = 0; i < 16; ++i) v[i] = (nn < N) ? *(const f32x4*)(W + (size_t)(k0 + 4 * i + kr) * N + nn) : (f32x4){0.f, 0.f, 0.f, 0.f};
#pragma unroll
    for (int i = 0; i < 16; ++i) { const int kk = 4 * i + kr; const float g = gain ? gain[k0 + kk] : 1.0f; LAS float* d = scr + kk * 65 + 4 * (lane & 15); d[0] = v[i][0] * g; d[1] = v[i][1] * g; d[2] = v[i][2] * g; d[3] = v[i][3] * g; }
    LDS_WAIT(); asm volatile("" ::: "memory");
    const int c = lane & 7;
#pragma unroll
    for (int j = 0; j < 8; ++j) { const int nl = (lane >> 3) + 8 * j; const int n = n0 + nl; const LAS float* s = scr + (8 * c) * 65 + nl;
        v4u o; o.x = pg8::cvt_pk_bf16(s[0 * 65], s[1 * 65]); o.y = pg8::cvt_pk_bf16(s[2 * 65], s[3 * 65]); o.z = pg8::cvt_pk_bf16(s[4 * 65], s[5 * 65]); o.w = pg8::cvt_pk_bf16(s[6 * 65], s[7 * 65]);
        if (n < N) *(v4u*)(WT + (size_t)rm(n) * pitch + k0 + 8 * c) = o; }
    LDS_WAIT(); asm volatile("" ::: "memory");
}
__device__ __forceinline__ void p0_prologue(const Ctx& C, const Params& P) {
    THREAD_IDS();
    LAS float* scr = (LAS float*)(C.lds + RING_OFF + wave * 16896);
    constexpr int I_FF = 16 * 44, I_DN = 44 * 16, I_IN = 16 * 113, I_BR = 4 * 4 * 16, I_OUT = 16 * 16;
    constexpr int PER_LAYER = 4 * I_FF + 2 * I_DN + I_IN + I_BR + I_OUT;
    for (int it = gw; it < DEPTH * PER_LAYER; it += NGW) {
        const int l = it / PER_LAYER; int r = it - l * PER_LAYER;
        bf16* W1a = WSP(bf16, WS_W1 + (size_t)(l * 2 + 0) * SZ_W1); bf16* W1b = WSP(bf16, WS_W1 + (size_t)(l * 2 + 1) * SZ_W1);
        bf16* Wda = WSP(bf16, WS_WD + (size_t)(l * 2 + 0) * SZ_WD); bf16* Wdb = WSP(bf16, WS_WD + (size_t)(l * 2 + 1) * SZ_WD);
        if (r < I_FF) { tr_item(C.in[I_F1G] + (size_t)l * D * DFF, D, DFF, C.in[I_NF1] + l * D, W1a, D, RowMap{1, 0}, scr, r / 44, r % 44, lane); continue; } r -= I_FF;
        if (r < I_FF) { tr_item(C.in[I_F1U] + (size_t)l * D * DFF, D, DFF, C.in[I_NF1] + l * D, W1a, D, RowMap{1, 128}, scr, r / 44, r % 44, lane); continue; } r -= I_FF;
        if (r < I_DN) { tr_item(C.in[I_F1D] + (size_t)l * D * DFF, DFF, D, nullptr, Wda, DFF, RowMap{0, 0}, scr, r / 16, r % 16, lane); continue; } r -= I_DN;
        if (r < I_FF) { tr_item(C.in[I_F2G] + (size_t)l * D * DFF, D, DFF, C.in[I_NF2] + l * D, W1b, D, RowMap{1, 0}, scr, r / 44, r % 44, lane); continue; } r -= I_FF;
        if (r < I_FF) { tr_item(C.in[I_F2U] + (size_t)l * D * DFF, D, DFF, C.in[I_NF2] + l * D, W1b, D, RowMap{1, 128}, scr, r / 44, r % 44, lane); continue; } r -= I_FF;
        if (r < I_DN) { tr_item(C.in[I_F2D] + (size_t)l * D * DFF, DFF, D, nullptr, Wdb, DFF, RowMap{0, 0}, scr, r / 16, r % 16, lane); continue; } r -= I_DN;
        if (r < I_IN) { tr_item(C.in[I_WIN] + (size_t)l * D * NIN, D, NIN, C.in[I_NMIX] + l * D, WSP(bf16, WS_WIN + (size_t)l * SZ_WIN), D, RowMap{2, 0}, scr, r / 113, r % 113, lane); continue; } r -= I_IN;
        if (r < I_BR) { const int n4 = r / 64, rr = r % 64; tr_item(C.in[I_WBR] + (size_t)(l * 4 + n4) * 256 * D, 256, D, nullptr, WSP(bf16, WS_WBR + (size_t)l * SZ_WBR) + n4 * 256, D, RowMap{0, 0}, scr, rr / 16, rr % 16, lane); continue; } r -= I_BR;
        tr_item(C.in[I_WOUT] + (size_t)l * D * D, D, D, nullptr, WSP(bf16, WS_WOUT + (size_t)l * SZ_WOUT), D, RowMap{0, 0}, scr, r / 16, r % 16, lane);
    }
    const int gt = gw * 64 + lane, NGT = NGW * 64;
    for (int i = gt; i < 2 * 240 * 128; i += NGT) { const int l = i / (240 * 128), r = i % (240 * 128); *(v4u*)(C.ws + WS_WIN + (size_t)l * SZ_WIN + ((size_t)NMIX * D) * 2 + (size_t)r * 16) = (v4u){0u, 0u, 0u, 0u}; }
    for (int i = gt; i < (M - MR) * 128; i += NGT) *(v4u*)(C.ws + WS_BR + (size_t)MR * D * 2 + (size_t)i * 16) = (v4u){0u, 0u, 0u, 0u};
    for (int i = gt; i < 2 * NINP; i += NGT) { const int l = i / NINP, j = i % NINP; float v = 0.f; if (j < NMIX) v = C.in[I_BIN][l * NIN + j]; else if (j >= NMIXP) v = C.in[I_BIN][l * NIN + NMIX + gate_src(j - NMIXP)]; WSP(float, WS_BINP)[i] = v; }
    for (int i = gt; i < NPOS * 32; i += NGT) { const int pi = i >> 5, fi = i & 31; const int pos = pi < L ? pi : PAST + (pi - L);
        const float angf = (float)pos * P.inv_freq[fi];
        const double a = (double)angf; const double k = rint(a * 0.15915494309189535); const double rr = (a - k * 6.283185307179586) - k * 2.4492935982947064e-16;
        const float rf = (float)rr; WSP(float, WS_ROPE)[i] = cosf(rf); WSP(float, WS_ROPE)[NPOS * 32 + i] = sinf(rf); }
    float* H = WSP(float, WS_H); bf16* HB = WSP(bf16, WS_HB); float* SS0 = WSP(float, WS_SS);
    for (int row = gw; row < M; row += NGW) {
        const float* src = nullptr;
        if (row < MP) { const int b = row / L, pos = row - b * L; src = pos < NMETA ? C.in[I_META] + (size_t)pos * D : C.in[I_XP] + ((size_t)b * SEQ + (pos - NMETA)) * D; }
        else if (row < MR) src = C.in[I_XS] + (size_t)(row - MP) * D;
        float s = 0.f;
#pragma unroll
        for (int j = 0; j < 4; ++j) { f32x4 v = src ? *(const f32x4*)(src + 256 * j + 4 * lane) : (f32x4){0.f, 0.f, 0.f, 0.f};
            *(f32x4*)(H + (size_t)row * D + 256 * j + 4 * lane) = v; s += (v[0] * v[0] + v[1] * v[1]) + (v[2] * v[2] + v[3] * v[3]);
            unsigned long long w = (unsigned long long)pk2(v[0], v[1]) | ((unsigned long long)pk2(v[2], v[3]) << 32);
            *(unsigned long long*)(HB + (size_t)row * D + 256 * j + 4 * lane) = w; }
        s = wave_sum(s); if (lane < 16) SS0[(size_t)row * 16 + lane] = lane == 0 ? s : 0.f;
    }
}

__device__ __forceinline__ float lam_of(const Ctx& C, int l, float lam_init) {
    THREAD_IDS();
    float a = 0.f, b = 0.f;
#pragma unroll 1
    for (int i = 0; i < 32; ++i) { a += C.in[I_LQ1][l * 32 + i] * C.in[I_LK1][l * 32 + i]; b += C.in[I_LQ2][l * 32 + i] * C.in[I_LK2][l * 32 + i]; }
    return __expf(a) - __expf(b) + lam_init;
}
__device__ __forceinline__ int t5_bucket(int n) {
    if (n < 16) return n;
    return 16 + (n >= 19) + (n >= 21) + (n >= 24) + (n >= 27) + (n >= 31) + (n >= 35) + (n >= 40) + (n >= 46) + (n >= 52) + (n >= 59) + (n >= 67) + (n >= 77) + (n >= 87) + (n >= 99) + (n >= 113);
}
__device__ __forceinline__ void unpack8(const v4u w, float (&x)[8]) { x[0] = bflo(w.x); x[1] = bfhi(w.x); x[2] = bflo(w.y); x[3] = bfhi(w.y); x[4] = bflo(w.z); x[5] = bfhi(w.z); x[6] = bflo(w.w); x[7] = bfhi(w.w); }
__device__ __forceinline__ v4u pack8(const float (&x)[8]) { v4u w; w.x = pg8::cvt_pk_bf16(x[0], x[1]); w.y = pg8::cvt_pk_bf16(x[2], x[3]); w.z = pg8::cvt_pk_bf16(x[4], x[5]); w.w = pg8::cvt_pk_bf16(x[6], x[7]); return w; }
__device__ __forceinline__ void n1_prep(const Ctx& C, int l) {
    THREAD_IDS();
    const bf16* ZM = WSP(bf16, WS_ZMIX); float* UB = WSP(float, WS_UBUF); float* RQ = WSP(float, WS_RQ); float* RK = WSP(float, WS_RK);
    float* LD = WSP(float, WS_LDEC); const float* COS = WSP(float, WS_ROPE); const float* SIN = COS + NPOS * 32; bf16* QNB = WSP(bf16, WS_QNB); bf16* KNB = WSP(bf16, WS_KNB);
    const int i = lane & 31;
    float qg[8], kg[8];
#pragma unroll
    for (int j = 0; j < 8; ++j) { qg[j] = C.in[I_QN][l * 32 + ((8 * i) & 31) + j] * (0.17677669529663687f * 1.4426950408889634f); kg[j] = C.in[I_KN][l * 32 + ((8 * i) & 31) + j]; }
    const int isk = i >> 4, hh = (i >> 2) & 3, jc = i & 3;
    for (int rp0 = gw * 2; rp0 < MR / 2; rp0 += NGW * 2) {
        v4u Wa[2], Wg[2], Wq[2], Wk[2], Wv[2], W1[2], W2[2], G0[2], G1[2];
#pragma unroll
        for (int u = 0; u < 2; ++u) { const int r = min(2 * (rp0 + u) + (lane >> 5), MR - 1); const bf16* z = ZM + (size_t)r * NMIXP; const bf16* zr = z + (isk ? R_K : R_Q) + hh * 64 + 8 * jc;
            Wa[u] = *(const v4u*)(z + C_A + 8 * i); Wg[u] = *(const v4u*)(z + C_G + 8 * i); Wq[u] = *(const v4u*)(z + D_Q + 8 * i); Wk[u] = *(const v4u*)(z + D_K + 8 * i); Wv[u] = *(const v4u*)(z + D_V + 8 * i);
            W1[u] = *(const v4u*)zr; W2[u] = *(const v4u*)(zr + 32); G0[u] = *(const v4u*)(z + G_LOW); G1[u] = *(const v4u*)(z + G_LOW + 8); }
#pragma unroll
        for (int u = 0; u < 2; ++u) {
        if (rp0 + u >= MR / 2) break;
        const int r = 2 * (rp0 + u) + (lane >> 5);
        const int pi = r < MP ? r % L : L + ((r - MP) & 7);
        float* kout = r < MP ? C.out + O_KP + ((size_t)l * MP + r) * 256 : C.out + O_KS + ((size_t)l * MS + (r - MP)) * 256;
        float* vout = r < MP ? C.out + O_VP + ((size_t)l * MP + r) * 256 : C.out + O_VS + ((size_t)l * MS + (r - MP)) * 256;
        const v4u wa = Wa[u], wg = Wg[u], wq = Wq[u], wk = Wk[u], wv = Wv[u], w1 = W1[u], w2 = W2[u], gl0 = G0[u], gl1 = G1[u];
        float x[8], y[8];
        unpack8(wa, x); unpack8(wg, y);
#pragma unroll
        for (int j = 0; j < 8; ++j) x[j] *= sigmoidf_(y[j]);
        *(f32x4*)(UB + (size_t)r * 256 + 8 * i) = (f32x4){x[0], x[1], x[2], x[3]}; *(f32x4*)(UB + (size_t)r * 256 + 8 * i + 4) = (f32x4){x[4], x[5], x[6], x[7]};
        unpack8(wv, x);
        *(f32x4*)(vout + 8 * i) = (f32x4){x[0], x[1], x[2], x[3]}; *(f32x4*)(vout + 8 * i + 4) = (f32x4){x[4], x[5], x[6], x[7]};
        unpack8(wq, x);
        { float s = 0.f;
#pragma unroll
          for (int j = 0; j < 8; ++j) s += x[j] * x[j];
          s += __shfl_xor(s, 1); s += __shfl_xor(s, 2); const float rs = rsqrtf(s * (1.0f / 32) + EPS);
#pragma unroll
          for (int j = 0; j < 8; ++j) x[j] = x[j] * rs * qg[j];
          *(v4u*)(QNB + (size_t)r * 256 + 8 * i) = pack8(x); }
        unpack8(wk, x);
        { float s = 0.f;
#pragma unroll
          for (int j = 0; j < 8; ++j) s += x[j] * x[j];
          s += __shfl_xor(s, 1); s += __shfl_xor(s, 2); const float rs = rsqrtf(s * (1.0f / 32) + EPS);
#pragma unroll
          for (int j = 0; j < 8; ++j) x[j] = x[j] * rs * kg[j];
          *(v4u*)(KNB + (size_t)r * 256 + 8 * i) = pack8(x);
          *(f32x4*)(kout + 8 * i) = (f32x4){x[0], x[1], x[2], x[3]}; *(f32x4*)(kout + 8 * i + 4) = (f32x4){x[4], x[5], x[6], x[7]}; }
        unpack8(w1, x); unpack8(w2, y);
        { const f32x4 c0 = *(const f32x4*)(COS + pi * 32 + 8 * jc), c1 = *(const f32x4*)(COS + pi * 32 + 8 * jc + 4), s0 = *(const f32x4*)(SIN + pi * 32 + 8 * jc), s1 = *(const f32x4*)(SIN + pi * 32 + 8 * jc + 4);
          const float sc = isk ? 0.125f : 1.0f; float o1[8], o2[8];
#pragma unroll
          for (int j = 0; j < 8; ++j) { const float cs = j < 4 ? c0[j & 3] : c1[j & 3], sn = j < 4 ? s0[j & 3] : s1[j & 3]; o1[j] = (x[j] * cs - y[j] * sn) * sc; o2[j] = (x[j] * sn + y[j] * cs) * sc; }
          float* ro = (isk ? RK : RQ) + (size_t)r * 256 + hh * 64 + 8 * jc;
          *(f32x4*)ro = (f32x4){o1[0], o1[1], o1[2], o1[3]}; *(f32x4*)(ro + 4) = (f32x4){o1[4], o1[5], o1[6], o1[7]}; *(f32x4*)(ro + 32) = (f32x4){o2[0], o2[1], o2[2], o2[3]}; *(f32x4*)(ro + 36) = (f32x4){o2[4], o2[5], o2[6], o2[7]}; }
        { float gv[16]; unpack8(gl0, x); unpack8(gl1, y);
#pragma unroll
          for (int j = 0; j < 8; ++j) { gv[j] = x[j]; gv[8 + j] = y[j]; }
          f32x4 gp = *(const f32x4*)(C.in[I_GAB] + l * 128 + 4 * i);
#pragma unroll
          for (int k = 0; k < 16; ++k) { const f32x4 aw = *(const f32x4*)(C.in[I_GAW] + (size_t)(l * 16 + k) * 128 + 4 * i); gp = gp + aw * gv[k]; }
          f32x4 ls;
#pragma unroll
          for (int j = 0; j < 4; ++j) ls[j] = (fminf(gp[j], 0.f) - log1pf(__expf(-fabsf(gp[j])))) * (1.0f / 16.0f);
          *(f32x4*)(LD + (size_t)r * 128 + 4 * i) = ls; }
        }
    }
}
__device__ __forceinline__ void conv_rows_item(const Ctx& C, int l, int item) {
    THREAD_IDS();
    const float* UB = WSP(float, WS_UBUF); bf16* BR = WSP(bf16, WS_BR);
    const float* cw = C.in[I_CW] + (size_t)l * 31 * 256; const float* sc = C.in[I_SCONV];
    LAS float* wl = (LAS float*)C.lds;
    for (int i = tid; i < 31 * 256; i += NWAVES * 64) wl[i] = cw[i];
    LDS_WAIT(); __builtin_amdgcn_s_barrier(); asm volatile("" ::: "memory");
    const int r0 = item * 64 + wave * 8;
    if (r0 < MR) {
        const bool smp = r0 >= MP; const int b = smp ? (r0 - MP) >> 3 : r0 / L; const int p0 = smp ? 0 : r0 - b * L; const int rb = smp ? MP + b * 8 : b * L;
        float acc[8][4];
#pragma unroll
        for (int i = 0; i < 8; ++i)
#pragma unroll
            for (int k = 0; k < 4; ++k) acc[i][k] = C.in[I_CB][l * 256 + lane + 64 * k];
#pragma unroll 1
        for (int jb = 0; jb < 40; jb += 8) {
            float uv[8][4];
#pragma unroll
            for (int jj = 0; jj < 8; ++jj) { const int j = jb + jj; const int q = p0 - 30 + j;
#pragma unroll
                for (int k = 0; k < 4; ++k) { const int c = lane + 64 * k;
                    uv[jj][k] = j >= 38 ? 0.f : (q >= 0 ? UB[(size_t)(rb + q) * 256 + c] : (smp ? sc[(((size_t)l * DB + b) * 30 + (q + 30)) * 256 + c] : 0.f)); } }
#pragma unroll
            for (int jj = 0; jj < 8; ++jj)
#pragma unroll
                for (int i = 0; i < 8; ++i) { const int t = jb + jj - i;
                    if (t >= 0 && t <= 30) {
#pragma unroll
                        for (int k = 0; k < 4; ++k) acc[i][k] += wl[t * 256 + lane + 64 * k] * uv[jj][k]; } }
        }
#pragma unroll
        for (int i = 0; i < 8; ++i) { const int r = r0 + i;
            float s = (acc[i][0] + acc[i][1]) + (acc[i][2] + acc[i][3]); const float mean = wave_sum(s) * (1.0f / 256);
            float q2 = 0.f;
#pragma unroll
            for (int k = 0; k < 4; ++k) { acc[i][k] -= mean; q2 += acc[i][k] * acc[i][k]; }
            const float rstd = rsqrtf(wave_sum(q2) * (1.0f / 256) + EPS);
#pragma unroll
            for (int k = 0; k < 4; ++k) { const int c = lane + 64 * k; const float y = acc[i][k] * rstd * C.in[I_CLG][l * 256 + c] + C.in[I_CLB][l * 256 + c]; BR[(size_t)r * D + c] = (bf16)f2bf(siluf_(y)); } }
    }
    LDS_WAIT(); __builtin_amdgcn_s_barrier(); asm volatile("" ::: "memory");
}
__device__ __forceinline__ void conv_state_item(const Ctx& C, int l, int part, int nparts) {
    THREAD_IDS();
    const float* UB = WSP(float, WS_UBUF); const float* sc = C.in[I_SCONV];
    for (int i = part * NWAVES * 64 + tid; i < BATCH * 30 * 256; i += nparts * NWAVES * 64) { const int c = i & 255, ii = (i >> 8) % 30, b = i / (30 * 256); C.out[O_CP + (size_t)l * BATCH * 30 * 256 + i] = UB[(size_t)(b * L + L - 30 + ii) * 256 + c]; }
    for (int i = part * NWAVES * 64 + tid; i < DB * 30 * 256; i += nparts * NWAVES * 64) { const int c = i & 255, ii = (i >> 8) % 30, b = i / (30 * 256);
        C.out[O_CS + (size_t)l * DB * 30 * 256 + i] = ii < 22 ? sc[(((size_t)l * DB + b) * 30 + 8 + ii) * 256 + c] : UB[(size_t)(MP + b * 8 + ii - 22) * 256 + c]; }
}
template <int DK, bool RET> __device__ __forceinline__ void la_seq(const Ctx& C, int l, bool smp, int b, int h) {
    THREAD_IDS();
    const bf16* ZM = WSP(bf16, WS_ZMIX); const float* RQ = WSP(float, WS_RQ); const float* RK = WSP(float, WS_RK); const float* LD = WSP(float, WS_LDEC); bf16* BR = WSP(bf16, WS_BR);
    const int nt = smp ? DS : L; const int row0 = smp ? MP + b * DS : b * L;
    float S[DK];
    if (smp) { const float* s0 = (RET ? C.in[I_SRET] : C.in[I_SGLA]) + (((size_t)l * DB + b) * 4 + h) * DK * 64;
#pragma unroll
        for (int k = 0; k < DK; ++k) S[k] = s0[k * 64 + lane]; }
    else {
#pragma unroll
        for (int k = 0; k < DK; ++k) S[k] = 0.f; }
    const float gamma = 1.0f - exp2f(-5.0f - (float)h);
    const float gn = RET ? C.in[I_RGN][(l * 4 + h) * 64 + lane] : C.in[I_GGN][(l * 4 + h) * 64 + lane];
    for (int t = 0; t < nt; ++t) {
        const int r = row0 + t; const bf16* z = ZM + (size_t)r * NMIXP;
        float ql, kl, dl = 1.f;
        if (RET) { ql = RQ[(size_t)r * 256 + h * 64 + lane]; kl = RK[(size_t)r * 256 + h * 64 + lane]; }
        else { const int lk = lane & 31; ql = bf2f(z[G_Q + h * 32 + lk]) * 0.17677669529663687f; kl = bf2f(z[G_K + h * 32 + lk]); dl = __expf(LD[(size_t)r * 128 + h * 32 + lk]); }
        const float v = bf2f(z[(RET ? R_V : G_V) + h * 64 + lane]);
        float o = 0.f;
#pragma unroll
        for (int k = 0; k < DK; ++k) { const float qk = __shfl(ql, k), kk = __shfl(kl, k); const float dk = RET ? gamma : __shfl(dl, k);
            S[k] = dk * S[k] + kk * v; o += qk * S[k]; if ((k & 7) == 7) __builtin_amdgcn_sched_barrier(0); }
        float y;
        if (RET) { const float mean = wave_sum(o) * (1.0f / 64); const float d = o - mean; const float var = wave_sum(d * d) * (1.0f / 64); y = d * rsqrtf(var + EPS) * gn; }
        else { const float ms = wave_sum(o * o) * (1.0f / 64); y = o * rsqrtf(ms + EPS) * gn; }
        const float g = bf2f(z[(RET ? R_G : G_R) + h * 64 + lane]);
        BR[(size_t)r * D + (RET ? 256 : 512) + h * 64 + lane] = (bf16)f2bf(siluf_(g) * y);
    }
    float* so = C.out + (RET ? (smp ? O_RS + (((size_t)l * DB + b) * 4 + h) * DK * 64 : O_RP + (((size_t)l * BATCH + b) * 4 + h) * DK * 64)
                             : (smp ? O_GS + (((size_t)l * DB + b) * 4 + h) * DK * 64 : O_GP + (((size_t)l * BATCH + b) * 4 + h) * DK * 64));
#pragma unroll
    for (int k = 0; k < DK; ++k) so[k * 64 + lane] = S[k];
}
typedef short bf16x8_t __attribute__((ext_vector_type(8)));
template <int DK, bool RET> __device__ __forceinline__ void la_chunked(const Ctx& C, int l, bool smp, int b, int h) {
    THREAD_IDS();
    constexpr int QS = DK + 8, TS = 72, NKB = DK / 16, NKS = DK / 32;
    constexpr int SB = 2 * 64 * QS + 64 * TS + DK * TS + 64 * TS + 64;
    LAS bf16* SB0 = (LAS bf16*)(C.lds);
    LAS bf16* AL = SB0 + 2 * SB;
    LAS bf16* ST = AL + 64 * TS;
    const bf16* ZM = WSP(bf16, WS_ZMIX); const float* RQ = WSP(float, WS_RQ); const float* RK = WSP(float, WS_RK); const float* LD = WSP(float, WS_LDEC); bf16* BR = WSP(bf16, WS_BR);
    const int nt = smp ? DS : L, row0 = smp ? MP + b * DS : b * L, nch = (nt + 63) >> 6;
    const float lg2 = RET ? log2f(1.0f - exp2f(-5.0f - (float)h)) : 0.f;
    const int g4 = lane >> 4, c16 = lane & 15;
    const bool qwave = wave < 4; const int w4 = wave & 3;
    float Sreg[NKB][4];
    if (wave >= 4) {
        const float* s0 = (RET ? C.in[I_SRET] : C.in[I_SGLA]) + (((size_t)l * DB + b) * 4 + h) * DK * 64;
#pragma unroll
        for (int cb = 0; cb < NKB; ++cb)
#pragma unroll
            for (int r = 0; r < 4; ++r) { const int dk = cb * 16 + c16, dv = (wave - 4) * 16 + 4 * g4 + r; const float v = smp ? s0[dk * 64 + dv] : 0.f; Sreg[cb][r] = v; ST[dv * QS + dk] = (bf16)f2bf(v); }
    }
    float gnv[4];
#pragma unroll
    for (int cb = 0; cb < 4; ++cb) gnv[cb] = (RET ? C.in[I_RGN] : C.in[I_GGN])[(l * 4 + h) * 64 + cb * 16 + c16];
    float a[16]; v4u vr;
#define LA_LOAD(c) do { const size_t r_ = (size_t)(row0 + (c) * 64 + lane); const bf16* z_ = ZM + r_ * NMIXP; \
        vr = *(const v4u*)(z_ + (RET ? R_V : G_V) + h * 64 + 8 * wave); \
        if (RET) { const float* p_ = (qwave ? RQ : RK) + r_ * 256 + h * 64 + 8 * w4; const f32x4 x0 = *(const f32x4*)p_, x1 = *(const f32x4*)(p_ + 4), x2 = *(const f32x4*)(p_ + 32), x3 = *(const f32x4*)(p_ + 36); \
            a[0] = x0[0]; a[1] = x0[1]; a[2] = x0[2]; a[3] = x0[3]; a[4] = x1[0]; a[5] = x1[1]; a[6] = x1[2]; a[7] = x1[3]; a[8] = x2[0]; a[9] = x2[1]; a[10] = x2[2]; a[11] = x2[3]; a[12] = x3[0]; a[13] = x3[1]; a[14] = x3[2]; a[15] = x3[3]; } \
        else { const v4u q_ = *(const v4u*)(z_ + (qwave ? G_Q : G_K) + h * 32 + 8 * w4); const float* p_ = LD + r_ * 128 + h * 32 + 8 * w4; const f32x4 x0 = *(const f32x4*)p_, x1 = *(const f32x4*)(p_ + 4); \
            a[0] = bflo(q_.x); a[1] = bfhi(q_.x); a[2] = bflo(q_.y); a[3] = bfhi(q_.y); a[4] = bflo(q_.z); a[5] = bfhi(q_.z); a[6] = bflo(q_.w); a[7] = bfhi(q_.w); \
            a[8] = x0[0]; a[9] = x0[1]; a[10] = x0[2]; a[11] = x0[3]; a[12] = x1[0]; a[13] = x1[1]; a[14] = x1[2]; a[15] = x1[3]; } } while (0)
    LA_LOAD(0);
    int cur = 0;
    for (int i = 0; i <= nch; ++i) {
        if (i < nch) {
            const int c = i; LAS bf16* QT = SB0 + (i & 1) * SB; LAS bf16* KT = QT + 64 * QS; LAS bf16* VT = KT + 64 * QS; LAS bf16* KE = VT + 64 * TS; LAS bf16* GT = KE + DK * TS; LAS float* WT = (LAS float*)(GT + 64 * TS);
            const int nvc = min(64, nt - c * 64); const bool valid = lane < nvc;
        if (RET) {
            const float tq = (float)(lane + 1);
            if (qwave) { const float e = valid ? __builtin_amdgcn_exp2f(lg2 * tq) : 0.f;
                v4u w0, w1; w0.x = pg8::cvt_pk_bf16(a[0] * e, a[1] * e); w0.y = pg8::cvt_pk_bf16(a[2] * e, a[3] * e); w0.z = pg8::cvt_pk_bf16(a[4] * e, a[5] * e); w0.w = pg8::cvt_pk_bf16(a[6] * e, a[7] * e);
                w1.x = pg8::cvt_pk_bf16(a[8] * e, a[9] * e); w1.y = pg8::cvt_pk_bf16(a[10] * e, a[11] * e); w1.z = pg8::cvt_pk_bf16(a[12] * e, a[13] * e); w1.w = pg8::cvt_pk_bf16(a[14] * e, a[15] * e);
                *(LAS v4u*)(QT + lane * QS + 8 * w4) = w0; *(LAS v4u*)(QT + lane * QS + 32 + 8 * w4) = w1; }
            else { const float e = valid ? __builtin_amdgcn_exp2f(-lg2 * tq) : 0.f, ee = valid ? __builtin_amdgcn_exp2f(lg2 * ((float)nvc - tq)) : 0.f;
                v4u w0, w1; w0.x = pg8::cvt_pk_bf16(a[0] * e, a[1] * e); w0.y = pg8::cvt_pk_bf16(a[2] * e, a[3] * e); w0.z = pg8::cvt_pk_bf16(a[4] * e, a[5] * e); w0.w = pg8::cvt_pk_bf16(a[6] * e, a[7] * e);
                w1.x = pg8::cvt_pk_bf16(a[8] * e, a[9] * e); w1.y = pg8::cvt_pk_bf16(a[10] * e, a[11] * e); w1.z = pg8::cvt_pk_bf16(a[12] * e, a[13] * e); w1.w = pg8::cvt_pk_bf16(a[14] * e, a[15] * e);
                *(LAS v4u*)(KT + lane * QS + 8 * w4) = w0; *(LAS v4u*)(KT + lane * QS + 32 + 8 * w4) = w1;
#pragma unroll
                for (int i = 0; i < 16; i += 2) { const unsigned mine = pg8::cvt_pk_bf16(a[i] * ee, a[i + 1] * ee); const unsigned pv = (unsigned)__shfl_xor((int)mine, 1);
                    const unsigned w = (lane & 1) ? ((pv >> 16) | (mine & 0xffff0000u)) : ((mine & 0xffffu) | (pv << 16));
                    const int row = (i < 8 ? 8 * w4 + i : 32 + 8 * w4 + (i - 8)) + (lane & 1);
                    *(LAS unsigned*)(KE + row * TS + (lane & ~1)) = w; } }
        } else {
            float bb[8];
#pragma unroll
            for (int i = 0; i < 8; ++i) bb[i] = valid ? a[8 + i] : 0.f;
#pragma unroll
            for (int i = 0; i < 8; ++i) { float x = bb[i];
                x += __builtin_bit_cast(float, __builtin_amdgcn_mov_dpp(__builtin_bit_cast(int, x), 0x111, 0xf, 0xf, true));
                x += __builtin_bit_cast(float, __builtin_amdgcn_mov_dpp(__builtin_bit_cast(int, x), 0x112, 0xf, 0xf, true));
                x += __builtin_bit_cast(float, __builtin_amdgcn_mov_dpp(__builtin_bit_cast(int, x), 0x114, 0xf, 0xf, true));
                x += __builtin_bit_cast(float, __builtin_amdgcn_mov_dpp(__builtin_bit_cast(int, x), 0x118, 0xf, 0xf, true));
                const float t0 = __builtin_bit_cast(float, __builtin_amdgcn_readlane(__builtin_bit_cast(int, x), 15)), t1 = __builtin_bit_cast(float, __builtin_amdgcn_readlane(__builtin_bit_cast(int, x), 31)), t2 = __builtin_bit_cast(float, __builtin_amdgcn_readlane(__builtin_bit_cast(int, x), 47));
                bb[i] = x + (lane >= 16 ? t0 : 0.f) + (lane >= 32 ? t1 : 0.f) + (lane >= 48 ? t2 : 0.f); }
            if (qwave) {
                if (lane == 63) {
#pragma unroll
                    for (int i = 0; i < 8; ++i) WT[8 * w4 + i] = bb[i]; }
                float o8[8];
#pragma unroll
                for (int i = 0; i < 8; ++i) o8[i] = valid ? a[i] * 0.17677669529663687f * __expf(bb[i]) : 0.f;
                v4u w0; w0.x = pg8::cvt_pk_bf16(o8[0], o8[1]); w0.y = pg8::cvt_pk_bf16(o8[2], o8[3]); w0.z = pg8::cvt_pk_bf16(o8[4], o8[5]); w0.w = pg8::cvt_pk_bf16(o8[6], o8[7]);
                *(LAS v4u*)(QT + lane * QS + 8 * w4) = w0;
            } else {
                float o8[8];
#pragma unroll
                for (int i = 0; i < 8; ++i) o8[i] = valid ? a[i] * __expf(-bb[i]) : 0.f;
#pragma unroll
                for (int i = 0; i < 8; i += 2) { const float t0 = __shfl(bb[i], 63), t1 = __shfl(bb[i + 1], 63);
                    const unsigned mine = pg8::cvt_pk_bf16(valid ? a[i] * __expf(t0 - bb[i]) : 0.f, valid ? a[i + 1] * __expf(t1 - bb[i + 1]) : 0.f); const unsigned pv = (unsigned)__shfl_xor((int)mine, 1);
                    const unsigned w = (lane & 1) ? ((pv >> 16) | (mine & 0xffff0000u)) : ((mine & 0xffffu) | (pv << 16));
                    *(LAS unsigned*)(KE + (8 * w4 + i + (lane & 1)) * TS + (lane & ~1)) = w; }
                v4u w0; w0.x = pg8::cvt_pk_bf16(o8[0], o8[1]); w0.y = pg8::cvt_pk_bf16(o8[2], o8[3]); w0.z = pg8::cvt_pk_bf16(o8[4], o8[5]); w0.w = pg8::cvt_pk_bf16(o8[6], o8[7]);
                *(LAS v4u*)(KT + lane * QS + 8 * w4) = w0;
            }
        }
        { const unsigned vv[4] = {valid ? vr.x : 0u, valid ? vr.y : 0u, valid ? vr.z : 0u, valid ? vr.w : 0u};
#pragma unroll
          for (int i = 0; i < 4; ++i) { const unsigned pv = (unsigned)__shfl_xor((int)vv[i], 1);
              const unsigned w = (lane & 1) ? ((pv >> 16) | (vv[i] & 0xffff0000u)) : ((vv[i] & 0xffffu) | (pv << 16));
              *(LAS unsigned*)(VT + (8 * wave + 2 * i + (lane & 1)) * TS + (lane & ~1)) = w; } }
            if (c + 1 < nch) LA_LOAD(c + 1);
        }
        if (i >= 1) {
            LAS bf16* QT = SB0 + ((i - 1) & 1) * SB; LAS bf16* KT = QT + 64 * QS;
        { const int rb = wave >> 1;
#pragma unroll
          for (int ci = 0; ci < 2; ++ci) { const int cb = (wave & 1) * 2 + ci; f32x4 acc = {0.f, 0.f, 0.f, 0.f};
              if (cb <= rb) {
#pragma unroll
                  for (int ks = 0; ks < NKS; ++ks) { const bf16x8_t af = *(const LAS bf16x8_t*)(QT + (rb * 16 + c16) * QS + ks * 32 + 8 * g4), bf = *(const LAS bf16x8_t*)(KT + (cb * 16 + c16) * QS + ks * 32 + 8 * g4);
                      acc = __builtin_amdgcn_mfma_f32_16x16x32_bf16(af, bf, acc, 0, 0, 0); } }
#pragma unroll
              for (int r = 0; r < 4; ++r) { const int tt = rb * 16 + 4 * g4 + r, ss = cb * 16 + c16; AL[tt * TS + ss] = (bf16)f2bf(ss <= tt ? acc[r] : 0.f); } } }
        }
        LDS_WAIT(); __builtin_amdgcn_s_barrier(); asm volatile("" ::: "memory");
        if (i >= 1) {
            const int c = i - 1; LAS bf16* QT = SB0 + (c & 1) * SB; LAS bf16* KT = QT + 64 * QS; LAS bf16* VT = KT + 64 * QS; LAS bf16* KE = VT + 64 * TS; LAS bf16* GT = KE + DK * TS; LAS float* WT = (LAS float*)(GT + 64 * TS);
            const int nvc = min(64, nt - c * 64); (void)KT;
        if (wave < 4) {
            const int rb = wave; const LAS bf16* STc = ST + cur * 64 * QS;
            f32x4 o[4];
#pragma unroll
            for (int cb = 0; cb < 4; ++cb) o[cb] = (f32x4){0.f, 0.f, 0.f, 0.f};
#pragma unroll
            for (int ks = 0; ks < 2; ++ks) { const bf16x8_t af = *(const LAS bf16x8_t*)(AL + (rb * 16 + c16) * TS + ks * 32 + 8 * g4);
#pragma unroll
                for (int cb = 0; cb < 4; ++cb) { const bf16x8_t bf = *(const LAS bf16x8_t*)(VT + (cb * 16 + c16) * TS + ks * 32 + 8 * g4); o[cb] = __builtin_amdgcn_mfma_f32_16x16x32_bf16(af, bf, o[cb], 0, 0, 0); } }
#pragma unroll
            for (int ks = 0; ks < NKS; ++ks) { const bf16x8_t af = *(const LAS bf16x8_t*)(QT + (rb * 16 + c16) * QS + ks * 32 + 8 * g4);
#pragma unroll
                for (int cb = 0; cb < 4; ++cb) { const bf16x8_t bf = *(const LAS bf16x8_t*)(STc + (cb * 16 + c16) * QS + ks * 32 + 8 * g4); o[cb] = __builtin_amdgcn_mfma_f32_16x16x32_bf16(af, bf, o[cb], 0, 0, 0); } }
            { float* LAO = WSP(float, WS_LAO);
#pragma unroll
              for (int r = 0; r < 4; ++r) { const int tok = c * 64 + rb * 16 + 4 * g4 + r;
                  if (tok < nt) { float* op = LAO + (size_t)(row0 + tok) * 512 + (RET ? 0 : 256) + h * 64 + c16;
#pragma unroll
                      for (int cb = 0; cb < 4; ++cb) op[cb * 16] = o[cb][r]; } } }
        } else {
            const int dvb = wave - 4; LAS bf16* STn = ST + (cur ^ 1) * 64 * QS;
            f32x4 ds[NKB];
#pragma unroll
            for (int cb = 0; cb < NKB; ++cb) ds[cb] = (f32x4){0.f, 0.f, 0.f, 0.f};
#pragma unroll
            for (int ks = 0; ks < 2; ++ks) { const bf16x8_t af = *(const LAS bf16x8_t*)(VT + (dvb * 16 + c16) * TS + ks * 32 + 8 * g4);
#pragma unroll
                for (int cb = 0; cb < NKB; ++cb) { const bf16x8_t bf = *(const LAS bf16x8_t*)(KE + (cb * 16 + c16) * TS + ks * 32 + 8 * g4); ds[cb] = __builtin_amdgcn_mfma_f32_16x16x32_bf16(af, bf, ds[cb], 0, 0, 0); } }
#pragma unroll
            for (int cb = 0; cb < NKB; ++cb) { const float eB = RET ? __builtin_amdgcn_exp2f(lg2 * (float)nvc) : __expf(WT[cb * 16 + c16]);
#pragma unroll
                for (int r = 0; r < 4; ++r) { Sreg[cb][r] = eB * Sreg[cb][r] + ds[cb][r]; STn[(dvb * 16 + 4 * g4 + r) * QS + cb * 16 + c16] = (bf16)f2bf(Sreg[cb][r]); } }
        }
            cur ^= 1;
        }
        LDS_WAIT(); __builtin_amdgcn_s_barrier(); asm volatile("" ::: "memory");
    }
#undef LA_LOAD
    if (wave >= 4) {
        float* so = C.out + (RET ? (smp ? O_RS + (((size_t)l * DB + b) * 4 + h) * DK * 64 : O_RP + (((size_t)l * BATCH + b) * 4 + h) * DK * 64)
                                 : (smp ? O_GS + (((size_t)l * DB + b) * 4 + h) * DK * 64 : O_GP + (((size_t)l * BATCH + b) * 4 + h) * DK * 64));
#pragma unroll
        for (int cb = 0; cb < NKB; ++cb)
#pragma unroll
            for (int r = 0; r < 4; ++r) so[(cb * 16 + c16) * 64 + (wave - 4) * 16 + 4 * g4 + r] = Sreg[cb][r];
    }
}
typedef float f32x16_t __attribute__((ext_vector_type(16)));
__device__ __forceinline__ int crow_(int r, int hi) { return (r & 3) + 8 * (r >> 2) + 4 * hi; }
__device__ __forceinline__ float swapmax32(float m) { auto rr = __builtin_amdgcn_permlane32_swap(__float_as_uint(m), __float_as_uint(m), false, false); return fmaxf(__uint_as_float(rr[0]), __uint_as_float(rr[1])); }
__device__ __forceinline__ float swapadd32(float m) { auto rr = __builtin_amdgcn_permlane32_swap(__float_as_uint(m), __float_as_uint(m), false, false); return __uint_as_float(rr[0]) + __uint_as_float(rr[1]); }
constexpr float LOG2E = 1.4426950408889634f;
__device__ __forceinline__ void attn_prompt_item(const Ctx& C, int l, int b, int h, int qb, float lam, float lam_init, float mb) {
    THREAD_IDS();
    constexpr int KS = 72;
    LAS bf16* Kt = (LAS bf16*)C.lds;
    LAS bf16* Vt = Kt + 2 * 64 * KS;
    LAS float* BT = (LAS float*)(Vt + 2 * 64 * KS);
    LAS float* OX = BT + 128;
    const bf16* ZM = WSP(bf16, WS_ZMIX); const bf16* QNB = WSP(bf16, WS_QNB); const bf16* KNB = WSP(bf16, WS_KNB); bf16* BR = WSP(bf16, WS_BR);
    const int r32 = lane & 31, hi = lane >> 5, qs = wave >> 1, s = wave & 1;
    const int q0 = qb * 128 + qs * 32; const int rowb = b * L;
    if (tid < 128) BT[tid] = (C.in[I_RELB][t5_bucket(tid) * 4 + h] - C.in[I_RELB][31 * 4 + h]) * LOG2E;
    pg8::bf16x8 qf[2];
#pragma unroll
    for (int d0 = 0; d0 < 2; ++d0) qf[d0] = *(const pg8::bf16x8*)(QNB + (size_t)(rowb + q0 + r32) * 256 + h * 64 + s * 32 + 16 * d0 + 8 * hi);
    const int pl = (lane & ~15) | ((lane & 8) >> 1) | ((lane & 4) << 1) | (lane & 3);
    const int NT = (min(128 * (qb + 1), L) + 63) >> 6;
    v4u kreg, vreg;
#define AT_LOAD(j) do { const size_t r_ = (size_t)(rowb + (j) * 64 + lane); kreg = *(const v4u*)(KNB + r_ * 256 + h * 64 + 8 * wave); vreg = *(const v4u*)(ZM + r_ * NMIXP + D_V + h * 64 + 8 * wave); } while (0)
#define AT_STORE(buf) do { *(LAS v4u*)(Kt + (buf) * 64 * KS + lane * KS + 8 * wave) = kreg; LAS bf16* v_ = Vt + (buf) * 64 * KS + (8 * wave) * KS + pl; \
        v_[0] = (bf16)(vreg.x & 0xffffu); v_[KS] = (bf16)(vreg.x >> 16); v_[2 * KS] = (bf16)(vreg.y & 0xffffu); v_[3 * KS] = (bf16)(vreg.y >> 16); \
        v_[4 * KS] = (bf16)(vreg.z & 0xffffu); v_[5 * KS] = (bf16)(vreg.z >> 16); v_[6 * KS] = (bf16)(vreg.w & 0xffffu); v_[7 * KS] = (bf16)(vreg.w >> 16); } while (0)
    AT_LOAD(0); AT_STORE(0); if (NT > 1) AT_LOAD(1);
    LDS_WAIT(); __builtin_amdgcn_s_barrier(); asm volatile("" ::: "memory");
    float lsum = 0.f; f32x16_t o[2]; f32x16_t negm;
#pragma unroll
    for (int i = 0; i < 16; ++i) negm[i] = -mb;
#pragma unroll
    for (int i = 0; i < 16; ++i) { o[0][i] = 0.f; o[1][i] = 0.f; }
    for (int j = 0; j < NT; ++j) {
        const int k0 = 64 * j, buf = j & 1;
        if (k0 <= q0 + 31) {
            const LAS bf16* kb = Kt + buf * 64 * KS; const LAS bf16* vb = Vt + buf * 64 * KS;
            f32x16_t p0 = negm, p1 = negm;
#pragma unroll
            for (int d0 = 0; d0 < 2; ++d0) { const pg8::bf16x8 a0 = *(const LAS pg8::bf16x8*)(kb + r32 * KS + s * 32 + 16 * d0 + 8 * hi), a1 = *(const LAS pg8::bf16x8*)(kb + (32 + r32) * KS + s * 32 + 16 * d0 + 8 * hi);
                p0 = __builtin_amdgcn_mfma_f32_32x32x16_bf16(a0, qf[d0], p0, 0, 0, 0); p1 = __builtin_amdgcn_mfma_f32_32x32x16_bf16(a1, qf[d0], p1, 0, 0, 0); }
            if (q0 - k0 - 63 < 113) {
#pragma unroll
                for (int r = 0; r < 16; ++r) { const int n0 = (q0 + r32) - (k0 + crow_(r, hi)), n1 = n0 - 32;
                    p0[r] = n0 < 0 ? -INFINITY : p0[r] + (n0 < 128 ? BT[n0] : 0.f); p1[r] = n1 < 0 ? -INFINITY : p1[r] + (n1 < 128 ? BT[n1] : 0.f); } }
            typedef float f32x2_t __attribute__((ext_vector_type(2)));
            f32x2_t ps2 = {0.f, 0.f};
#pragma unroll
            for (int r = 0; r < 16; r += 2) { p0[r] = __builtin_amdgcn_exp2f(p0[r]); p0[r + 1] = __builtin_amdgcn_exp2f(p0[r + 1]); p1[r] = __builtin_amdgcn_exp2f(p1[r]); p1[r + 1] = __builtin_amdgcn_exp2f(p1[r + 1]);
                ps2 = ps2 + (f32x2_t){p0[r], p0[r + 1]}; ps2 = ps2 + (f32x2_t){p1[r], p1[r + 1]}; }
            lsum += ps2[0] + ps2[1];
            pg8::bf16x8 pb[4];
#pragma unroll
            for (int ks = 0; ks < 4; ++ks) { v4u w;
                if (ks < 2) { w.x = pg8::cvt_pk_bf16(p0[8 * ks], p0[8 * ks + 1]); w.y = pg8::cvt_pk_bf16(p0[8 * ks + 2], p0[8 * ks + 3]); w.z = pg8::cvt_pk_bf16(p0[8 * ks + 4], p0[8 * ks + 5]); w.w = pg8::cvt_pk_bf16(p0[8 * ks + 6], p0[8 * ks + 7]); }
                else { w.x = pg8::cvt_pk_bf16(p1[8 * ks - 16], p1[8 * ks - 15]); w.y = pg8::cvt_pk_bf16(p1[8 * ks - 14], p1[8 * ks - 13]); w.z = pg8::cvt_pk_bf16(p1[8 * ks - 12], p1[8 * ks - 11]); w.w = pg8::cvt_pk_bf16(p1[8 * ks - 10], p1[8 * ks - 9]); }
                pb[ks] = __builtin_bit_cast(pg8::bf16x8, w); }
#pragma unroll
            for (int d0 = 0; d0 < 2; ++d0)
#pragma unroll
                for (int ks = 0; ks < 4; ++ks) { const pg8::bf16x8 af = *(const LAS pg8::bf16x8*)(vb + (32 * d0 + r32) * KS + 16 * ks + 8 * hi); o[d0] = __builtin_amdgcn_mfma_f32_32x32x16_bf16(af, pb[ks], o[d0], 0, 0, 0); }
        }
        if (j + 1 < NT) AT_STORE(buf ^ 1);
        if (j + 2 < NT) AT_LOAD(j + 2);
        LDS_WAIT(); __builtin_amdgcn_s_barrier(); asm volatile("" ::: "memory");
    }
#undef AT_LOAD
#undef AT_STORE
    lsum = swapadd32(lsum); const float inv = 1.0f / lsum;
    LAS float* ox = OX + (qs * 32 + r32) * 65;
    if (s == 1) {
#pragma unroll
        for (int d0 = 0; d0 < 2; ++d0)
#pragma unroll
            for (int r = 0; r < 16; ++r) ox[32 * d0 + crow_(r, hi)] = o[d0][r] * inv; }
    LDS_WAIT(); __builtin_amdgcn_s_barrier(); asm volatile("" ::: "memory");
    if (s == 0) {
        float ss = 0.f;
#pragma unroll
        for (int d0 = 0; d0 < 2; ++d0)
#pragma unroll
            for (int r = 0; r < 16; ++r) { const float v = o[d0][r] * inv - lam * ox[32 * d0 + crow_(r, hi)]; o[d0][r] = v; ss += v * v; }
        ss = swapadd32(ss); const float rs = rsqrtf(ss * (1.0f / 64) + EPS) * (1.0f - lam_init);
        const int qpos = q0 + r32;
        if (qpos < L) { bf16* brp = BR + (size_t)(rowb + qpos) * D + 768 + h * 64;
#pragma unroll
            for (int d0 = 0; d0 < 2; ++d0)
#pragma unroll
                for (int r4 = 0; r4 < 4; ++r4) { const int dv = 32 * d0 + 8 * r4 + 4 * hi; const float* sl = C.in[I_SUBLN] + l * 64 + dv;
                    const unsigned w0 = pk2(o[d0][4 * r4] * rs * sl[0], o[d0][4 * r4 + 1] * rs * sl[1]), w1 = pk2(o[d0][4 * r4 + 2] * rs * sl[2], o[d0][4 * r4 + 3] * rs * sl[3]);
                    *(unsigned long long*)(brp + dv) = (unsigned long long)w0 | ((unsigned long long)w1 << 32); } }
    }
    LDS_WAIT(); __builtin_amdgcn_s_barrier(); asm volatile("" ::: "memory");
}
constexpr int PSTR = 68;
__device__ __forceinline__ pg8::bf16x8 cvt8(const f32x4 a, const f32x4 b) { v4u w; w.x = pg8::cvt_pk_bf16(a[0], a[1]); w.y = pg8::cvt_pk_bf16(a[2], a[3]); w.z = pg8::cvt_pk_bf16(b[0], b[1]); w.w = pg8::cvt_pk_bf16(b[2], b[3]); return __builtin_bit_cast(pg8::bf16x8, w); }
__device__ __forceinline__ void attn_sample_item(const Ctx& C, int l, int b, int split) {
    THREAD_IDS();
    const int h = wave & 3, half = wave >> 2, c16 = lane & 15, g = lane >> 4, srow = c16 >> 3, t = c16 & 7;
    const bf16* QNB = WSP(bf16, WS_QNB); const int* PT = (const int*)C.in[I_PT];
    const float* CK = C.in[I_CK] + (size_t)l * NPOOL * PAGE * 256; const float* CV = C.in[I_CV] + (size_t)l * NPOOL * PAGE * 256;
    LAS float* BT = (LAS float*)C.lds;
    BT[tid] = (C.in[I_RELB][t5_bucket(tid & 127) * 4 + (tid >> 7)] - C.in[I_RELB][31 * 4 + (tid >> 7)]) * LOG2E;
    const v4u z4 = {0u, 0u, 0u, 0u};
    const v4u q0w = srow == 0 ? *(const v4u*)(QNB + (size_t)(MP + b * 8 + t) * 256 + h * 64 + 8 * g) : z4, q1w = srow == 1 ? *(const v4u*)(QNB + (size_t)(MP + b * 8 + t) * 256 + h * 64 + 32 + 8 * g) : z4;
    const pg8::bf16x8 qf0 = __builtin_bit_cast(pg8::bf16x8, q0w), qf1 = __builtin_bit_cast(pg8::bf16x8, q1w);
    LDS_WAIT(); __builtin_amdgcn_s_barrier(); asm volatile("" ::: "memory");
    float m = -INFINITY, lsum = 0.f; f32x4 o[4];
#pragma unroll
    for (int db = 0; db < 4; ++db) o[db] = (f32x4){0.f, 0.f, 0.f, 0.f};
    const int kk0 = split * 1024 + half * 512;
    const int pg0 = __builtin_amdgcn_readfirstlane(PT[b * NPAGES + (kk0 >> 7)]), pg1 = __builtin_amdgcn_readfirstlane(PT[b * NPAGES + (kk0 >> 7) + 1]), pg2 = __builtin_amdgcn_readfirstlane(PT[b * NPAGES + (kk0 >> 7) + 2]), pg3 = __builtin_amdgcn_readfirstlane(PT[b * NPAGES + (kk0 >> 7) + 3]);
#define SA_LOAD(KR, VR, st) do { const int kk_ = kk0 + 32 * (st); const int pi_ = (st) >> 2; const int page_ = pi_ == 0 ? pg0 : pi_ == 1 ? pg1 : pi_ == 2 ? pg2 : pg3; const size_t base_ = ((size_t)(page_ * PAGE + (kk_ & 127)) * 4 + h) * 64; \
        _Pragma("unroll") for (int T = 0; T < 2; ++T) _Pragma("unroll") for (int ks = 0; ks < 2; ++ks) { const float* p = CK + base_ + (size_t)(16 * T + c16) * 256 + 32 * ks + 8 * g; KR[T][ks][0] = *(const f32x4*)p; KR[T][ks][1] = *(const f32x4*)(p + 4); } \
        _Pragma("unroll") for (int db = 0; db < 4; ++db) _Pragma("unroll") for (int j = 0; j < 8; ++j) { const int kv = j < 4 ? 4 * g + j : 16 + 4 * g + (j - 4); VR[db][j] = CV[base_ + (size_t)kv * 256 + 16 * db + c16]; } } while (0)
#define SA_MATH(KR, VR, st) do { const int kk = kk0 + 32 * (st); f32x4 sv[2]; \
        _Pragma("unroll") for (int T = 0; T < 2; ++T) { sv[T] = (f32x4){0.f, 0.f, 0.f, 0.f}; \
            sv[T] = __builtin_amdgcn_mfma_f32_16x16x32_bf16(cvt8(KR[T][0][0], KR[T][0][1]), qf0, sv[T], 0, 0, 0); \
            sv[T] = __builtin_amdgcn_mfma_f32_16x16x32_bf16(cvt8(KR[T][1][0], KR[T][1][1]), qf1, sv[T], 0, 0, 0); } \
        if (kk + 31 + 128 > PAST) { \
            _Pragma("unroll") for (int T = 0; T < 2; ++T) _Pragma("unroll") for (int r = 0; r < 4; ++r) { const int n = PAST + t - (kk + 16 * T + 4 * g + r); if (n < 128) sv[T][r] += BT[h * 128 + n]; } } \
        float mt = fmaxf(fmaxf(fmaxf(sv[0][0], sv[0][1]), fmaxf(sv[0][2], sv[0][3])), fmaxf(fmaxf(sv[1][0], sv[1][1]), fmaxf(sv[1][2], sv[1][3]))); \
        mt = fmaxf(mt, __shfl_xor(mt, 16)); mt = fmaxf(mt, __shfl_xor(mt, 32)); \
        const float mn = fmaxf(m, mt); const float al = __builtin_amdgcn_exp2f(m - mn); m = mn; float ps = 0.f; \
        _Pragma("unroll") for (int T = 0; T < 2; ++T) _Pragma("unroll") for (int r = 0; r < 4; ++r) { sv[T][r] = __builtin_amdgcn_exp2f(sv[T][r] - m); ps += sv[T][r]; } \
        lsum = lsum * al + ps; const pg8::bf16x8 pf = cvt8(sv[0], sv[1]); \
        _Pragma("unroll") for (int db = 0; db < 4; ++db) { o[db] = o[db] * al; \
            const f32x4 va = {VR[db][0], VR[db][1], VR[db][2], VR[db][3]}, vb = {VR[db][4], VR[db][5], VR[db][6], VR[db][7]}; \
            o[db] = __builtin_amdgcn_mfma_f32_16x16x32_bf16(cvt8(va, vb), pf, o[db], 0, 0, 0); } } while (0)
    f32x4 krA[2][2][2], krB[2][2][2]; float vrA[4][8], vrB[4][8];
    SA_LOAD(krA, vrA, 0);
#pragma unroll 1
    for (int step = 0; step < 16; step += 2) {
        SA_LOAD(krB, vrB, step + 1);
        SA_MATH(krA, vrA, step);
        if (step + 2 < 16) SA_LOAD(krA, vrA, step + 2);
        SA_MATH(krB, vrB, step + 1);
    }
#undef SA_LOAD
#undef SA_MATH
    lsum += __shfl_xor(lsum, 16); lsum += __shfl_xor(lsum, 32);
    float* pp = WSP(float, WS_PART) + ((((size_t)b * 4 + h) * 16 + split * 2 + half) * 16 + c16) * PSTR;
#pragma unroll
    for (int db = 0; db < 4; ++db) *(f32x4*)(pp + 16 * db + 4 * g) = o[db];
    if (g == 0) { pp[64] = m; pp[65] = lsum; }
    LDS_WAIT(); __builtin_amdgcn_s_barrier(); asm volatile("" ::: "memory");
}
__device__ __forceinline__ void n3_attn_sample_combine(const Ctx& C, int l, float lam_init) {
    THREAD_IDS();
    const float lam = lam_of(C, l, lam_init);
    const bf16* QNB = WSP(bf16, WS_QNB); const bf16* KNB = WSP(bf16, WS_KNB); const bf16* ZM = WSP(bf16, WS_ZMIX); bf16* BR = WSP(bf16, WS_BR);
    for (int it = gw; it < DB * 4 * DS; it += NGW) {
        const int b = it >> 5, h = (it >> 3) & 3, t = it & 7; float os[2];
        const float far = C.in[I_RELB][31 * 4 + h];
        float sn[2][8];
        { const float qv = bf2f(QNB[(size_t)(MP + b * 8 + t) * 256 + h * 64 + lane]);
#pragma unroll
          for (int jj = 0; jj < 8; ++jj) { float p = qv * bf2f(KNB[(size_t)(MP + b * 8 + jj) * 256 + h * 64 + lane]);
              p += __shfl_xor(p, 1); p += __shfl_xor(p, 2); p += __shfl_xor(p, 4); p += __shfl_xor(p, 8); p += __shfl_xor(p, 16);
              const float bias = (C.in[I_RELB][t5_bucket(t - jj < 0 ? 0 : t - jj) * 4 + h] - far) * LOG2E;
              sn[0][jj] = jj <= t ? __shfl(p, 0) + bias : -INFINITY; sn[1][jj] = jj <= t ? __shfl(p, 32) + bias : -INFINITY; } }
#pragma unroll
        for (int s = 0; s < 2; ++s) {
            const float* pb = WSP(float, WS_PART) + ((((size_t)b * 4 + h) * 16) * 16 + s * 8 + t) * PSTR;
            float mm = -INFINITY; float pm[16];
#pragma unroll
            for (int pi = 0; pi < 16; ++pi) { pm[pi] = pb[(size_t)pi * 16 * PSTR + 64]; mm = fmaxf(mm, pm[pi]); }
#pragma unroll
            for (int jj = 0; jj < 8; ++jj) mm = fmaxf(mm, sn[s][jj]);
            float ll = 0.f, oo = 0.f;
#pragma unroll
            for (int pi = 0; pi < 16; ++pi) { const float* pr = pb + (size_t)pi * 16 * PSTR; const float w = __builtin_amdgcn_exp2f(pm[pi] - mm); ll += pr[65] * w; oo += pr[lane] * w; }
#pragma unroll
            for (int jj = 0; jj < 8; ++jj) { const float w = __builtin_amdgcn_exp2f(sn[s][jj] - mm); ll += w; oo += w * bf2f(ZM[(size_t)(MP + b * 8 + jj) * NMIXP + D_V + h * 64 + lane]); }
            os[s] = oo / ll;
        }
        const float o = os[0] - lam * os[1]; const float ms = wave_sum(o * o) * (1.0f / 64);
        BR[(size_t)(MP + b * 8 + t) * D + 768 + h * 64 + lane] = (bf16)f2bf(o * rsqrtf(ms + EPS) * C.in[I_SUBLN][l * 64 + lane] * (1.0f - lam_init));
    }
}

__device__ __forceinline__ void n3_la_finalize(const Ctx& C, int l) {
    THREAD_IDS();
    const float* LAO = WSP(float, WS_LAO); const bf16* ZM = WSP(bf16, WS_ZMIX); bf16* BR = WSP(bf16, WS_BR);
    const bool ret = lane < 32; const int hd = (lane >> 3) & 3, c8 = (lane & 7) * 8;
    float gn[8];
#pragma unroll
    for (int j = 0; j < 8; ++j) gn[j] = (ret ? C.in[I_RGN] : C.in[I_GGN])[(l * 4 + hd) * 64 + c8 + j];
    for (int r0 = gw * 4; r0 < MP; r0 += NGW * 4) {
        f32x4 a4[4], b4[4]; v4u g4[4];
#pragma unroll
        for (int u = 0; u < 4; ++u) { const int r = min(r0 + u, MP - 1); a4[u] = *(const f32x4*)(LAO + (size_t)r * 512 + 8 * lane); b4[u] = *(const f32x4*)(LAO + (size_t)r * 512 + 8 * lane + 4);
            g4[u] = *(const v4u*)(ZM + (size_t)r * NMIXP + (ret ? R_G : G_R) + hd * 64 + c8); }
#pragma unroll
        for (int u = 0; u < 4; ++u) { const int r = r0 + u; if (r >= MP) break;
            float x[8] = {a4[u][0], a4[u][1], a4[u][2], a4[u][3], b4[u][0], b4[u][1], b4[u][2], b4[u][3]}, g[8]; unpack8(g4[u], g);
            float s = ((x[0] + x[1]) + (x[2] + x[3])) + ((x[4] + x[5]) + (x[6] + x[7]));
            s += __shfl_xor(s, 1); s += __shfl_xor(s, 2); s += __shfl_xor(s, 4);
            const float mean = ret ? s * (1.0f / 64) : 0.f; float q2 = 0.f;
#pragma unroll
            for (int j = 0; j < 8; ++j) { x[j] -= mean; q2 += x[j] * x[j]; }
            q2 += __shfl_xor(q2, 1); q2 += __shfl_xor(q2, 2); q2 += __shfl_xor(q2, 4);
            const float rs = rsqrtf(q2 * (1.0f / 64) + EPS);
#pragma unroll
            for (int j = 0; j < 8; ++j) x[j] = siluf_(g[j]) * x[j] * rs * gn[j];
            *(v4u*)(BR + (size_t)r * D + 256 + 8 * lane) = pack8(x); }
    }
}

constexpr int NQB_ATT = (L + 127) / 128;
constexpr int IT_LA = 32, IT_SS = IT_LA + DB * 8, IT_AT = IT_SS + 16 * NQB_ATT, IT_LS = IT_AT + 32, IT_CV = IT_LS + (MR + 63) / 64, IT_END = IT_CV;
__device__ __forceinline__ void n2_phase(const Ctx& C, int l, float lam_init, int qslot) {
    THREAD_IDS();
    const float lam = lam_of(C, l, lam_init);
    float mb;
    { float mq = 0.f, mk = 0.f, mbias = 0.f;
#pragma unroll 1
      for (int i = 0; i < 32; ++i) { mq = fmaxf(mq, fabsf(C.in[I_QN][l * 32 + i])); mk = fmaxf(mk, fabsf(C.in[I_KN][l * 32 + i])); }
#pragma unroll 1
      for (int i = 0; i < 128; ++i) mbias = fmaxf(mbias, C.in[I_RELB][i] - C.in[I_RELB][31 * 4 + (i & 3)]);
      mb = 1.02f * 1.4426950408889634f * 5.656854249492381f * mq * mk + 1.4426950408889634f * mbias; }
    unsigned* qw = (unsigned*)(C.ws + WS_CTL) + CW_QUEUE + 64 * qslot;
    volatile LAS int* slot = (volatile LAS int*)(C.lds + MISC_OFF + 64);
    if (blockIdx.x < IT_LA) { const int it = blockIdx.x; const int b = (it >> 2) & 3, h = it & 3; if (it < 16) la_chunked<64, true>(C, l, false, b, h); else la_chunked<32, false>(C, l, false, b, h); }
    for (;;) {
        if (tid == 0) slot[0] = (int)__hip_atomic_fetch_add(qw, 1u, __ATOMIC_RELAXED, __HIP_MEMORY_SCOPE_AGENT);
        __syncthreads();
        const int qi = slot[0];
        const int it = qi < 3 * DB * 8 ? ((qi % 3) ? IT_SS + 2 * (qi / 3) + (qi % 3) - 1 : IT_LA + qi / 3) : qi + IT_LA;
        __syncthreads();
        if (it >= IT_END) break;
        if (it < IT_SS) { const int i2 = it - IT_LA; attn_sample_item(C, l, i2 >> 3, i2 & 7); }
        else if (it < IT_AT) { const int i2 = it - IT_SS; attn_prompt_item(C, l, (i2 & 15) >> 2, i2 & 3, NQB_ATT - 1 - (i2 >> 4), lam, lam_init, mb); }
        else if (it < IT_LS) { const int i2 = (it - IT_AT) * 8 + wave; const int b = (i2 >> 2) & 31, h = i2 & 3; if (i2 < 128) la_seq<64, true>(C, l, true, b, h); else la_seq<32, false>(C, l, true, b, h); }
        else { conv_rows_item(C, l, it - IT_LS); conv_state_item(C, l, it - IT_LS, IT_CV - IT_LS); }
    }
}

template <int l> __device__ __forceinline__ void layer_fwd(const Ctx& C, const XcdBarrier& bar) {
#define GRID_BAR() xcd_barrier<false>(bar)
    LAS unsigned char* ring = C.lds + RING_OFF;
    float* SS = WSP(float, WS_SS); float* H = WSP(float, WS_H); bf16* HB = WSP(bf16, WS_HB); bf16* ACT = WSP(bf16, WS_ACT); bf16* ZMIX = WSP(bf16, WS_ZMIX); bf16* GATES = WSP(bf16, WS_GATES);
    bf16* BR = WSP(bf16, WS_BR); bf16* MERGED = WSP(bf16, WS_MERGED);
    constexpr float lam_init = l == 0 ? 0.2f : 0.35550906759096926f;
    constexpr bool last = (l == DEPTH - 1);
    { pg8::Gemm g{HB, WSP(bf16, WS_W1 + (size_t)(l * 2 + 0) * SZ_W1), D, D, D}; pg8::StaticOrder S; S.init(M, 2 * DFF, C.G, (int)blockIdx.x);
      EpiGLU E{ACT, SS + (size_t)(l * 3 + 0) * M * 16}; pg8::gemm_phase<EpiGLU, pg8::StaticOrder, true, true>(ring, g, S, E); }
    GRID_BAR();
    { pg8::HeadOrder S; S.init(M, D, C.G, (int)blockIdx.x); S.limit = C.G; EpiRes<false, 1> E{H, HB, SS + (size_t)(l * 3 + 1) * M * 16, nullptr};
      { pg8::Gemm g{ACT, WSP(bf16, WS_WD + (size_t)(l * 2 + 0) * SZ_WD), DFF, DFF, DFF}; pg8::gemm_phase<EpiRes<false, 1>, pg8::HeadOrder, true, true>(ring, g, S, E); }
      { int kt = DFF / 11; asm volatile("" : "+s"(kt)); pg8::Gemm g{ACT, WSP(bf16, WS_WD + (size_t)(l * 2 + 0) * SZ_WD), DFF, DFF, kt}; pg8::TailOrder T; T.init(M, D, C.G, (int)blockIdx.x); T.limit = C.G; T.nsplit = 11; T.kper = DFF / 11;
        EpiPartial EP{WSP(float, WS_KSP)}; pg8::gemm_phase<EpiPartial, pg8::TailOrder, true, true>(ring, g, T, EP); }
      GRID_BAR();
      ksp_finalize<11>(WSP(float, WS_KSP), S, C.G, E); }
    GRID_BAR();
    { pg8::Gemm g{HB, WSP(bf16, WS_WIN + (size_t)l * SZ_WIN), D, D, D}; pg8::StaticOrder S; S.init(M, NINP, C.G, (int)blockIdx.x);
      EpiZ E{ZMIX, GATES, SS + (size_t)(l * 3 + 1) * M * 16, WSP(float, WS_BINP) + l * NINP}; pg8::gemm_phase<EpiZ, pg8::StaticOrder, true, true>(ring, g, S, E); }
    GRID_BAR();
    n1_prep(C, l);
    GRID_BAR();
    n2_phase(C, l, lam_init, l);
    GRID_BAR();
    n3_attn_sample_combine(C, l, lam_init);
    n3_la_finalize(C, l);
    GRID_BAR();
    { pg8::Gemm g{BR, WSP(bf16, WS_WBR + (size_t)l * SZ_WBR), D, D, D}; pg8::StaticOrder S; S.init(M, D, C.G, (int)blockIdx.x);
      EpiMergeR E{MERGED, GATES}; pg8::gemm_phase<EpiMergeR, pg8::StaticOrder, true, true, 4>(ring, g, S, E); }
    GRID_BAR();
    { pg8::HeadOrder S; S.init(M, D, C.G, (int)blockIdx.x); S.limit = C.G; EpiRes<false, 2> E{H, HB, SS + (size_t)(l * 3 + 2) * M * 16, nullptr};
      { pg8::Gemm g{MERGED, WSP(bf16, WS_WOUT + (size_t)l * SZ_WOUT), D, D, D}; pg8::gemm_phase<EpiRes<false, 2>, pg8::HeadOrder, true, true>(ring, g, S, E); }
      { int kt = D / 4; asm volatile("" : "+s"(kt)); pg8::Gemm g{MERGED, WSP(bf16, WS_WOUT + (size_t)l * SZ_WOUT), D, D, kt}; pg8::TailOrder T; T.init(M, D, C.G, (int)blockIdx.x); T.limit = C.G; T.nsplit = 4; T.kper = D / 4;
        EpiPartial EP{WSP(float, WS_KSP)}; pg8::gemm_phase<EpiPartial, pg8::TailOrder, true, true>(ring, g, T, EP); }
      GRID_BAR();
      ksp_finalize<4>(WSP(float, WS_KSP), S, C.G, E); }
    GRID_BAR();
    { pg8::Gemm g{HB, WSP(bf16, WS_W1 + (size_t)(l * 2 + 1) * SZ_W1), D, D, D}; pg8::StaticOrder S; S.init(M, 2 * DFF, C.G, (int)blockIdx.x);
      EpiGLU E{ACT, SS + (size_t)(l * 3 + 2) * M * 16}; pg8::gemm_phase<EpiGLU, pg8::StaticOrder, true, true>(ring, g, S, E); }
    GRID_BAR();
    { pg8::HeadOrder S; S.init(M, D, C.G, (int)blockIdx.x); S.limit = C.G; EpiRes<last, 1> E{H, HB, last ? nullptr : SS + (size_t)((l + 1) * 3) * M * 16, C.out};
      { pg8::Gemm g{ACT, WSP(bf16, WS_WD + (size_t)(l * 2 + 1) * SZ_WD), DFF, DFF, DFF}; pg8::gemm_phase<EpiRes<last, 1>, pg8::HeadOrder, true, true>(ring, g, S, E); }
      { int kt = DFF / 11; asm volatile("" : "+s"(kt)); pg8::Gemm g{ACT, WSP(bf16, WS_WD + (size_t)(l * 2 + 1) * SZ_WD), DFF, DFF, kt}; pg8::TailOrder T; T.init(M, D, C.G, (int)blockIdx.x); T.limit = C.G; T.nsplit = 11; T.kper = DFF / 11;
        EpiPartial EP{WSP(float, WS_KSP)}; pg8::gemm_phase<EpiPartial, pg8::TailOrder, true, true>(ring, g, T, EP); }
      GRID_BAR();
      ksp_finalize<11>(WSP(float, WS_KSP), S, C.G, E); }
#undef GRID_BAR
}

__global__ void __launch_bounds__(NWAVES * 64, 2) fwd(Params P) {
    extern __shared__ __attribute__((aligned(16))) unsigned char lds[];
    Ctx C;
    C.in = P.in; C.out = P.out; C.ws = P.ws; C.lds = (LAS unsigned char*)lds;
    C.G = gridDim.x;
    volatile LAS unsigned* MISC = (volatile LAS unsigned*)(C.lds + MISC_OFF);
    for (int u = threadIdx.x; u < (LDS_BYTES - LDSCTL_OFF) / 4; u += NWAVES * 64) ((LAS unsigned*)(C.lds + LDSCTL_OFF))[u] = 0u;
    __syncthreads();
    unsigned* ctl = (unsigned*)(C.ws + WS_CTL);
    XcdBarrier bar = xcd_barrier_post(ctl + CW_BAR, MISC + 8);
    p0_prologue(C, P);
    xcd_barrier<true>(bar);
    layer_fwd<0>(C, bar);
    xcd_barrier<false>(bar);
    layer_fwd<1>(C, bar);
}

extern "C" void kernel_launch(void* const* d_in, const int* in_sizes, int n_in, void* d_out, int out_size, void* d_ws, size_t ws_size, hipStream_t stream) {
    static int grid = 0;
    if (grid == 0) {
        if (n_in != N_INPUTS || (size_t)out_size != O_END || ws_size < WS_END) { fprintf(stderr, "kernel_launch: unexpected shapes: n_in %d out %d (want %zu) ws %zu (want %zu)\n", n_in, out_size, (size_t)O_END, ws_size, (size_t)WS_END); grid = -1; return; }
        int dev = 0, cus = 0, per_cu = 0;
        if (hipGetDevice(&dev) != hipSuccess || hipDeviceGetAttribute(&cus, hipDeviceAttributeMultiprocessorCount, dev) != hipSuccess) { grid = -1; return; }
        if (hipFuncSetAttribute((const void*)fwd, hipFuncAttributeMaxDynamicSharedMemorySize, LDS_BYTES) != hipSuccess) { fprintf(stderr, "kernel_launch: hipFuncSetAttribute failed\n"); grid = -1; return; }
        if (hipOccupancyMaxActiveBlocksPerMultiprocessor(&per_cu, (const void*)fwd, NWAVES * 64, LDS_BYTES) != hipSuccess || per_cu < 1) { fprintf(stderr, "kernel_launch: occupancy query says %d blocks per CU\n", per_cu); }
        (void)hipGetLastError();
        grid = cus;
    }
    if (grid < 0) return;
    if (hipMemsetAsync((char*)d_ws + WS_CTL, 0, CTL_ZERO_BYTES, stream) != hipSuccess) return;
    Params p{};
    for (int i = 0; i < N_INPUTS; ++i) p.in[i] = (const float*)d_in[i];
    p.out = (float*)d_out; p.ws = (unsigned char*)d_ws;
    for (int i = 0; i < 32; ++i) p.inv_freq[i] = (float)pow(10000.0, -(double)i / 32.0);
    hipLaunchKernelGGL(fwd, dim3(grid), dim3(NWAVES * 64), LDS_BYTES, stream, p);
}
```

```cpp
#include <hip/hip_runtime.h>
#include <cstdio>
#include <cstdint>
#include <cmath>

namespace pg8 {
#define PG8_LAS __attribute__((address_space(3)))
typedef unsigned short bf16_t;
typedef short bf16x8 __attribute__((ext_vector_type(8)));
typedef float f32x4 __attribute__((ext_vector_type(4)));
typedef unsigned u32x4 __attribute__((ext_vector_type(4)));
constexpr int BM = 256, BK = 64, HALF = 128, HTB = HALF * BK * 2  , STAGE_BYTES = 8 * HTB, NXCD = 8, WGM = 8;

__host__ __device__ __forceinline__ int lds_byte(int r, int c) { const int st = (r >> 4) * 2 + (c >> 5), rr = r & 15, cc = c & 31, ob = rr * 64 + cc * 2; return st * 1024 + (ob ^ (((ob >> 9) & 1) << 5)); }
__host__ __device__ __forceinline__ void stage_rc(int b, int& R, int& C) { const int st = b / 1024, sb = b % 1024, swz = sb ^ (((sb >> 9) & 1) << 5); R = (st >> 1) * 16 + swz / 64; C = (st & 1) * 32 + (swz % 64) / 2; }
__host__ __device__ __forceinline__ int perm32(int rho) { const int n = rho >> 4, i = rho & 15; return 8 * (i >> 2) + 4 * n + (i & 3); }

struct Unit { int pm, pn, acol, bcol; };
struct Gemm { const bf16_t* A; const bf16_t* Bt; int lda, ldb, K, kseg0; };

struct StaticOrder {
    int nM, nN, nwg, G, c;
    __host__ __device__ void init(int M, int N, int G_, int c_) { nM = M / BM; nN = N / BM; nwg = nM * nN; G = G_; c = c_; }
    __host__ __device__ void unit_of(int L, Unit& u) const {
        int wgid = L; { const int q = nwg / NXCD, r = nwg % NXCD, xcd = wgid % NXCD, off = wgid / NXCD; wgid = (xcd < r ? xcd * (q + 1) : r * (q + 1) + (xcd - r) * q) + off; }
        const int nig = WGM * nN, gid = wgid / nig, fm = gid * WGM, gsz = (nM - fm) < WGM ? (nM - fm) : WGM;
        u.pm = fm + ((wgid % nig) % gsz); u.pn = (wgid % nig) / gsz; u.acol = 0; u.bcol = 0;
    }
    __host__ __device__ bool next(int i, Unit& u) const { const long L = (long)i * G + c; if (L >= nwg) return false; unit_of((int)L, u); return true; }
};
struct HeadOrder : StaticOrder { int limit; __host__ __device__ bool next(int i, Unit& u) const { const long L = (long)i * G + c; if (L >= limit || L >= nwg) return false; unit_of((int)L, u); return true; } };
struct TailOrder : StaticOrder { int limit, nsplit, kper;
    __host__ __device__ bool next(int i, Unit& u) const {
        if (i > 0 || c >= (nwg - limit) * nsplit) return false;
        unit_of(limit + c / nsplit, u); u.acol = u.bcol = (c % nsplit) * kper; return true; } };
__device__ __forceinline__ unsigned cvt_pk_bf16(float lo, float hi) { unsigned r; asm volatile("v_cvt_pk_bf16_f32 %0, %1, %2" : "=v"(r) : "v"(lo), "v"(hi)); return r; }

template <class Epi, class Sched, bool ALIGN_EPI = false, bool SP2 = false, int SEG = 0>
__device__ __forceinline__ void gemm_phase(PG8_LAS unsigned char* lds, const Gemm g, const Sched& S, const Epi& E) {
    int tid_ = threadIdx.x; asm volatile("" : "+v"(tid_));
    const int tid = tid_, wid = __builtin_amdgcn_readfirstlane(tid >> 6), lane = tid & 63, wr = wid >> 2, wc = wid & 3, fr = lane & 15, fq = lane >> 4;
    const int nt = g.K / BK;
    unsigned voffA[2], voffB[2];
#pragma unroll
    for (int i = 0; i < 2; ++i) { int R, C; stage_rc(tid * 16 + i * 8192, R, C); const int Rb = Epi::PERM ? ((R & ~31) + perm32(R & 31)) : R;
        voffA[i] = (unsigned)(R * g.lda + C) * 2u; voffB[i] = (unsigned)(Rb * g.ldb + C) * 2u; }
    const size_t kstep = (size_t)(BK * 2);
    const size_t hstepA = (size_t)HALF * g.lda * 2, hstepB = (size_t)HALF * g.ldb * 2;
    const size_t tstepA = 2 * hstepA, tstepB = 2 * hstepB;
    const unsigned ldsw = (unsigned)wid * 1024u;
    const int aoff = lds_byte(wr * 64 + fr, fq * 8), boff = lds_byte(wc * 32 + fr, fq * 8);
#define PG8_SA(b, h) (((b) * 2 + (h)) * HTB)
#define PG8_SB(b, h) ((4 + (b) * 2 + (h)) * HTB)
#define PG8_STAGE(bufoff, gbase, voff) do { _Pragma("unroll") for (int _i = 0; _i < 2; ++_i) \
        __builtin_amdgcn_global_load_lds((const unsigned*)((const char*)(gbase) + (voff)[_i]), (PG8_LAS unsigned*)(lds + (bufoff) + ldsw + _i * 8192), 16, 0, 0); } while (0)
#define PG8_LDA(dst, b, h) do { _Pragma("unroll") for (int m = 0; m < 4; ++m) _Pragma("unroll") for (int k = 0; k < 2; ++k) dst[m][k] = *(const PG8_LAS bf16x8*)(lds + PG8_SA(b, h) + aoff + m * 2048 + k * 1024); } while (0)
#define PG8_LDB(dst, b, h) do { _Pragma("unroll") for (int n = 0; n < 2; ++n) _Pragma("unroll") for (int k = 0; k < 2; ++k) dst[n][k] = *(const PG8_LAS bf16x8*)(lds + PG8_SB(b, h) + boff + n * 2048 + k * 1024); } while (0)
#define PG8_MMA(ai, bj, At, Bt) do { __builtin_amdgcn_s_setprio(1); _Pragma("unroll") for (int m = 0; m < 4; ++m) _Pragma("unroll") for (int n = 0; n < 2; ++n) _Pragma("unroll") for (int k = 0; k < 2; ++k) \
        acc[ai][bj][m][n] = __builtin_amdgcn_mfma_f32_16x16x32_bf16(Bt[n][k], At[m][k], acc[ai][bj][m][n], 0, 0, 0); __builtin_amdgcn_s_setprio(0); } while (0)
#define PG8_WAIT_V(n) asm volatile("s_waitcnt vmcnt(" #n ")" ::: "memory")
#define PG8_WAIT_L(n) asm volatile("s_waitcnt lgkmcnt(" #n ")" ::: "memory")
#define PG8_BAR __builtin_amdgcn_s_barrier()
#define PG8_SCHED __builtin_amdgcn_sched_barrier(0)
    Unit cur, nxt; int ui = 0;
    if (!S.next(0, cur)) return;
    f32x4 acc[2][2][4][2];
#pragma unroll
    for (int a = 0; a < 2; ++a)
#pragma unroll
        for (int b = 0; b < 2; ++b)
#pragma unroll
            for (int m = 0; m < 4; ++m)
#pragma unroll
                for (int n = 0; n < 2; ++n) acc[a][b][m][n] = (f32x4){0.f, 0.f, 0.f, 0.f};
    bf16x8 At[4][2], B0[2][2], B1[2][2];
    const char* cA = (const char*)g.A + (size_t)cur.pm * tstepA + (size_t)cur.acol * 2; const char* cB = (const char*)g.Bt + (size_t)cur.pn * tstepB + (size_t)cur.bcol * 2;
#define PG8_KOFF(t) ((SEG > 0) ? (size_t)(((((t) / (SEG > 0 ? SEG : 1)) + g.kseg0) & (nt / (SEG > 0 ? SEG : 1) - 1)) * (SEG > 0 ? SEG : 1) + ((t) % (SEG > 0 ? SEG : 1))) * kstep : (size_t)(t) * kstep)
    const size_t K0 = PG8_KOFF(0);
    cA += K0; cB += K0;
    if constexpr (SP2) {
        PG8_STAGE(PG8_SB(0, 0), cB, voffB); PG8_STAGE(PG8_SB(0, 1), cB + hstepB, voffB); PG8_STAGE(PG8_SA(0, 0), cA, voffA); PG8_STAGE(PG8_SA(0, 1), cA + hstepA, voffA);
        if (wr == 1) PG8_BAR;
        PG8_WAIT_V(2); PG8_BAR;
        PG8_STAGE(PG8_SB(1, 0), cB + kstep, voffB); PG8_STAGE(PG8_SA(1, 0), cA + kstep, voffA); PG8_STAGE(PG8_SB(1, 1), cB + hstepB + kstep, voffB);
        PG8_WAIT_V(6); PG8_BAR;
    } else {
        PG8_STAGE(PG8_SB(0, 0), cB, voffB); PG8_STAGE(PG8_SA(0, 0), cA, voffA); PG8_STAGE(PG8_SB(0, 1), cB + hstepB, voffB); PG8_STAGE(PG8_SA(0, 1), cA + hstepA, voffA);
        if (wr == 1) PG8_BAR;
        PG8_WAIT_V(4); PG8_BAR;
        PG8_STAGE(PG8_SB(1, 0), cB + kstep, voffB); PG8_STAGE(PG8_SA(1, 0), cA + kstep, voffA); PG8_STAGE(PG8_SB(1, 1), cB + hstepB + kstep, voffB);
        PG8_WAIT_V(6); PG8_BAR;
    }
    for (;;) {
        const bool has_next = S.next(ui + 1, nxt);
        const char* nA = has_next ? (const char*)g.A + (size_t)nxt.pm * tstepA + (size_t)nxt.acol * 2 + K0 : cA; const char* nB = has_next ? (const char*)g.Bt + (size_t)nxt.pn * tstepB + (size_t)nxt.bcol * 2 + K0 : cB;
        for (int t = 0; t < nt; t += 2) {
            const bool last = (t == nt - 2);
            const char* a1 = cA - K0 + PG8_KOFF(t + 1);
            const char* a2 = last ? nA : cA - K0 + PG8_KOFF(t + 2); const char* b2 = last ? nB : cB - K0 + PG8_KOFF(t + 2);
            const char* a3 = a2 + kstep; const char* b3 = b2 + kstep;
            if constexpr (SP2) {
            PG8_LDB(B0, 0, 0); PG8_LDB(B1, 0, 1); PG8_SCHED; PG8_LDA(At, 0, 0); PG8_STAGE(PG8_SA(1, 1), a1 + hstepA, voffA);
            PG8_WAIT_V(8); PG8_WAIT_L(0); PG8_BAR; PG8_MMA(0, 0, At, B0); PG8_MMA(0, 1, At, B1); PG8_BAR; PG8_SCHED;
            PG8_LDA(At, 0, 1); PG8_STAGE(PG8_SB(0, 0), b2, voffB); PG8_STAGE(PG8_SB(0, 1), b2 + hstepB, voffB); PG8_STAGE(PG8_SA(0, 0), a2, voffA);
            PG8_WAIT_V(8); PG8_WAIT_L(0); PG8_BAR; PG8_MMA(1, 0, At, B0); PG8_MMA(1, 1, At, B1); PG8_BAR; PG8_SCHED;
            PG8_LDB(B0, 1, 0); PG8_LDB(B1, 1, 1); PG8_SCHED; PG8_LDA(At, 1, 0); PG8_STAGE(PG8_SA(0, 1), a2 + hstepA, voffA);
            PG8_WAIT_V(8); PG8_WAIT_L(0); PG8_BAR; PG8_MMA(0, 0, At, B0); PG8_MMA(0, 1, At, B1); PG8_BAR; PG8_SCHED;
            PG8_LDA(At, 1, 1); PG8_STAGE(PG8_SB(1, 0), b3, voffB); PG8_STAGE(PG8_SB(1, 1), b3 + hstepB, voffB); PG8_STAGE(PG8_SA(1, 0), a3, voffA);
            PG8_WAIT_V(8); PG8_WAIT_L(0); PG8_BAR; PG8_MMA(1, 0, At, B0); PG8_MMA(1, 1, At, B1); PG8_BAR; PG8_SCHED;
            } else {
            PG8_LDB(B0, 0, 0); PG8_SCHED; PG8_LDA(At, 0, 0); PG8_STAGE(PG8_SA(1, 1), a1 + hstepA, voffA);
            PG8_WAIT_L(8); PG8_BAR; PG8_WAIT_L(0); PG8_MMA(0, 0, At, B0); PG8_BAR; PG8_SCHED;
            PG8_LDB(B1, 0, 1); PG8_STAGE(PG8_SB(0, 0), b2, voffB);
            PG8_BAR; PG8_WAIT_L(0); PG8_MMA(0, 1, At, B1); PG8_BAR;
            PG8_LDA(At, 0, 1); PG8_STAGE(PG8_SA(0, 0), a2, voffA);
            PG8_BAR; PG8_WAIT_L(0); PG8_MMA(1, 0, At, B0); PG8_BAR; PG8_SCHED;
            PG8_STAGE(PG8_SB(0, 1), b2 + hstepB, voffB);
            PG8_WAIT_V(6); PG8_BAR; PG8_MMA(1, 1, At, B1); PG8_BAR;
            PG8_LDB(B0, 1, 0); PG8_SCHED; PG8_LDA(At, 1, 0); PG8_STAGE(PG8_SA(0, 1), a2 + hstepA, voffA);
            PG8_WAIT_L(8); PG8_BAR; PG8_WAIT_L(0); PG8_MMA(0, 0, At, B0); PG8_BAR; PG8_SCHED;
            PG8_LDB(B1, 1, 1); PG8_STAGE(PG8_SB(1, 0), b3, voffB);
            PG8_BAR; PG8_WAIT_L(0); PG8_MMA(0, 1, At, B1); PG8_BAR;
            PG8_LDA(At, 1, 1); PG8_STAGE(PG8_SA(1, 0), a3, voffA);
            PG8_BAR; PG8_WAIT_L(0); PG8_MMA(1, 0, At, B0); PG8_BAR; PG8_SCHED;
            PG8_STAGE(PG8_SB(1, 1), b3 + hstepB, voffB);
            PG8_WAIT_V(6); PG8_BAR; PG8_MMA(1, 1, At, B1); PG8_BAR;
            }
            if constexpr (SEG > 0) { if (((t + 2) % SEG) == 0 && (t + 2) < nt) E.mid(acc, cur, (t + 2) / SEG, g.kseg0); }
        }
        if constexpr (ALIGN_EPI) { if (wr == 0) PG8_BAR; }
        E(acc, cur, wr, wc, fr, fq);
        if (!has_next) break;
#pragma unroll
        for (int a = 0; a < 2; ++a)
#pragma unroll
            for (int b = 0; b < 2; ++b)
#pragma unroll
                for (int m = 0; m < 4; ++m)
#pragma unroll
                    for (int n = 0; n < 2; ++n) acc[a][b][m][n] = (f32x4){0.f, 0.f, 0.f, 0.f};
        cur = nxt; cA = nA; cB = nB; ++ui;
        if constexpr (ALIGN_EPI) { if (wr == 1) PG8_BAR; }
    }
    PG8_WAIT_V(0);
    if constexpr (!ALIGN_EPI) { if (wr == 0) PG8_BAR; }
    PG8_BAR;
#undef PG8_KOFF
#undef PG8_SA
#undef PG8_SB
#undef PG8_STAGE
#undef PG8_LDA
#undef PG8_LDB
#undef PG8_MMA
#undef PG8_WAIT_V
#undef PG8_WAIT_L
#undef PG8_BAR
#undef PG8_SCHED
}
}

constexpr int NWAVES = 8;
constexpr int D = 1024, DFF = 2816, NIN = 7184, NMIX = 3088, NMIXP = 3328, NGATE = 4096, NINP = NMIXP + NGATE;
constexpr int SEQ = 4096, NMETA = 16, L = SEQ + NMETA, BATCH = 4, DB = 32, DS = 8, PAST = 8192, PAGE = 128, NPAGES = PAST / PAGE, NPOOL = 2560, DEPTH = 2;
constexpr int MP = BATCH * L, MS = DB * DS, MR = MP + MS, M = 16896;
constexpr int NPOS = L + DS;
constexpr float EPS = 1e-6f;
constexpr int C_A = 0, C_G = 256, R_Q = 512, R_K = 768, R_V = 1024, R_G = 1280, G_Q = 1536, G_K = 1664, G_V = 1792, G_R = 2048, G_LOW = 2304, D_Q = 2320, D_K = 2576, D_V = 2832;
constexpr size_t O_YP = 0, O_YS = O_YP + (size_t)BATCH * SEQ * D, O_KP = O_YS + (size_t)MS * D, O_VP = O_KP + (size_t)DEPTH * MP * 256, O_KS = O_VP + (size_t)DEPTH * MP * 256,
                 O_VS = O_KS + (size_t)DEPTH * MS * 256, O_RP = O_VS + (size_t)DEPTH * MS * 256, O_RS = O_RP + (size_t)DEPTH * BATCH * 4 * 64 * 64, O_GP = O_RS + (size_t)DEPTH * DB * 4 * 64 * 64,
                 O_GS = O_GP + (size_t)DEPTH * BATCH * 4 * 32 * 64, O_CP = O_GS + (size_t)DEPTH * DB * 4 * 32 * 64, O_CS = O_CP + (size_t)DEPTH * BATCH * 30 * 256, O_END = O_CS + (size_t)DEPTH * DB * 30 * 256;
enum { I_XP = 0, I_XS, I_CK, I_CV, I_PT, I_SRET, I_SGLA, I_SCONV, I_META, I_RELB, I_NF1, I_F1G, I_F1U, I_F1D, I_NMIX, I_WIN, I_BIN, I_CW, I_CB, I_CLG, I_CLB, I_RGN, I_GAW, I_GAB, I_GGN,
       I_QN, I_KN, I_LQ1, I_LK1, I_LQ2, I_LK2, I_SUBLN, I_WBR, I_WOUT, I_NF2, I_F2G, I_F2U, I_F2D, N_INPUTS };

constexpr size_t MiB = 1u << 20;
constexpr size_t WS_CTL = 0, CTL_ZERO_BYTES = 64 * 1024;
constexpr size_t SZ_SS = (size_t)M * 16 * 4;
constexpr size_t SZ_W1 = (size_t)2 * DFF * D * 2, SZ_WD = (size_t)D * DFF * 2, SZ_WIN = (size_t)NINP * D * 2, SZ_WBR = (size_t)4 * D * 256 * 2, SZ_WOUT = (size_t)D * D * 2;
constexpr size_t WS_W1 = 4 * MiB;
constexpr size_t WS_WD = WS_W1 + 4 * SZ_W1;
constexpr size_t WS_WIN = WS_WD + 4 * SZ_WD;
constexpr size_t WS_WBR = WS_WIN + 2 * SZ_WIN;
constexpr size_t WS_WOUT = WS_WBR + 2 * SZ_WBR;
constexpr size_t WS_BINP = WS_WOUT + 2 * SZ_WOUT;
constexpr size_t WS_ROPE = WS_BINP + 64 * 1024;
constexpr size_t WS_SS = WS_ROPE + 2 * MiB;
constexpr size_t WS_H = 128 * MiB;
constexpr size_t WS_HB = WS_H + (size_t)M * D * 4;
constexpr size_t WS_ACT = WS_HB + (size_t)M * D * 2;
constexpr size_t WS_ZMIX = WS_ACT + (size_t)M * DFF * 2;
constexpr size_t WS_GATES = WS_ZMIX + (size_t)M * NMIXP * 2;
constexpr size_t WS_BR = WS_GATES + (size_t)M * NGATE * 2;
constexpr size_t WS_MERGED = WS_BR + (size_t)M * D * 2;
constexpr size_t WS_UBUF = WS_MERGED + (size_t)M * D * 2;
constexpr size_t WS_RQ = WS_UBUF + (size_t)M * 256 * 4, WS_RK = WS_RQ + (size_t)M * 256 * 4, WS_QN = WS_RK + (size_t)M * 256 * 4, WS_KN = WS_QN + (size_t)M * 256 * 4, WS_VB = WS_KN + (size_t)M * 256 * 4;
constexpr size_t WS_LDEC = WS_VB + (size_t)M * 256 * 4;
constexpr size_t WS_QNB = WS_LDEC + (size_t)M * 128 * 4;
constexpr size_t WS_KNB = WS_QNB + (size_t)M * 256 * 2;
constexpr size_t WS_PART = WS_KNB + (size_t)M * 256 * 2;
constexpr size_t WS_LAO = WS_PART + (size_t)DB * 4 * 16 * 16 * 68 * 4;
constexpr size_t WS_KSP = WS_LAO + (size_t)M * 512 * 4;
constexpr size_t WS_END = WS_KSP + (size_t)8 * 11 * 65536 * 4;
static_assert(WS_ROPE + 2 * NPOS * 32 * 4 <= WS_SS && WS_SS + 6 * SZ_SS <= WS_H, "weights region overflows");
constexpr int CW_BAR = 4096, CW_QUEUE = 8192;

constexpr int RING_OFF = 0, RING_BYTES = 131072;
constexpr int LDSCTL_OFF = 144384, MISC_OFF = LDSCTL_OFF + 320;
constexpr int LDS_BYTES = 147456;
static_assert(MISC_OFF + 128 <= LDS_BYTES, "LDS map");

#define GAS __attribute__((address_space(1)))
#define LAS __attribute__((address_space(3)))
typedef unsigned short bf16;
typedef unsigned v4u __attribute__((ext_vector_type(4)));
typedef float f32x4 __attribute__((ext_vector_type(4)));
#define LDS_WAIT() asm volatile("s_waitcnt lgkmcnt(0)" ::: "memory")
#define VM_WAIT() asm volatile("s_waitcnt vmcnt(0)" ::: "memory")
__device__ __forceinline__ unsigned f2bf(float f) { unsigned u = __builtin_bit_cast(unsigned, f); return (u + 0x7fffu + ((u >> 16) & 1u)) >> 16; }
__device__ __forceinline__ unsigned pk2(float lo, float hi) { return f2bf(lo) | (f2bf(hi) << 16); }
__device__ __forceinline__ float bf2f(bf16 b) { return __builtin_bit_cast(float, ((unsigned)b) << 16); }
__device__ __forceinline__ float bflo(unsigned w) { return __builtin_bit_cast(float, w << 16); }
__device__ __forceinline__ float bfhi(unsigned w) { return __builtin_bit_cast(float, w & 0xffff0000u); }
__device__ __forceinline__ float wave_sum(float v) {
#pragma unroll
    for (int o = 1; o < 64; o <<= 1) v += __shfl_xor(v, o);
    return v;
}
__device__ __forceinline__ float sigmoidf_(float x) { return __builtin_amdgcn_rcpf(1.0f + __expf(-x)); }
__device__ __forceinline__ float siluf_(float x) { return x * __builtin_amdgcn_rcpf(1.0f + __expf(-x)); }

#define XB_TMO      128
#define XB_XCNT(j)  (256  + 64 * (j))
#define XB_XSUB(j)  (1280 + 64 * (j))
#define XB_XGEN(j)  (2304 + 64 * (j))
#define XB_TOP      3328
#define XB_TOPGEN   3392
#define XCD_BAR_WORDS 3456
#define XB_SPIN_CAP (1u << 22)

__device__ __forceinline__ unsigned xb_ld(unsigned* p)              { return __hip_atomic_load(p, __ATOMIC_RELAXED, __HIP_MEMORY_SCOPE_AGENT); }
__device__ __forceinline__ unsigned xb_add(unsigned* p, unsigned v) { return __hip_atomic_fetch_add(p, v, __ATOMIC_RELAXED, __HIP_MEMORY_SCOPE_AGENT); }
__device__ __forceinline__ unsigned xb_xcc_id() { return (unsigned)__builtin_amdgcn_s_getreg((3 << 11) | 20) & 0xFu; }
#define XB_SPIN(cond, bar) do { unsigned _sp = 0; while (cond) { __builtin_amdgcn_s_sleep(1); \
    if ((++_sp & 255u) == 0u) { if (xb_ld(&(bar)[XB_TMO])) break; if (_sp > XB_SPIN_CAP) { atomicAdd(&(bar)[XB_TMO], 1u); break; } } } } while (0)

struct XcdBarrier { unsigned* bar; unsigned x; volatile LAS unsigned* st; };

__device__ __forceinline__ XcdBarrier xcd_barrier_post(unsigned* bar, volatile LAS unsigned* st) {
    XcdBarrier b; b.bar = bar; b.x = xb_xcc_id(); b.st = st;
    if (threadIdx.x == 0) (void)xb_add(&bar[XB_XCNT(b.x)], 1u);
    return b;
}
__device__ __forceinline__ void xcd_barrier_complete(unsigned* bar, unsigned x, unsigned& nloc, unsigned& nx) {
    const unsigned G = gridDim.x * gridDim.y * gridDim.z;
    unsigned sum, cnt, mine, sp = 0u;
    for (;;) {
        sum = 0u; cnt = 0u; mine = 0u;
#pragma unroll
        for (unsigned j = 0; j < 16; ++j) { const unsigned c = xb_ld(&bar[XB_XCNT(j)]); sum += c; cnt += (c > 0u) ? 1u : 0u; mine = (j == x) ? c : mine; }
        if (sum == G) break;
        __builtin_amdgcn_s_sleep(1);
        if ((++sp & 255u) == 0u) { if (xb_ld(&bar[XB_TMO])) break; if (sp > XB_SPIN_CAP) { atomicAdd(&bar[XB_TMO], 1u); break; } }
    }
    nloc = mine > 0u ? mine : 1u; nx = cnt > 0u ? cnt : 1u;
}
#ifndef FLAT_BAR
#define FLAT_BAR 0
#endif
__device__ __forceinline__ void flat_barrier(const XcdBarrier& b) {
    asm volatile("s_waitcnt vmcnt(0)" ::: "memory");
    __syncthreads();
    if (threadIdx.x == 0) {
        unsigned* bar = b.bar;
        asm volatile("" : "+s"(bar));
        const unsigned epoch = b.st[2] + 1u; b.st[2] = epoch; const unsigned target = epoch * gridDim.x;
        __builtin_amdgcn_fence(__ATOMIC_RELEASE, "agent");
        asm volatile("s_waitcnt vmcnt(0)" ::: "memory");
        (void)xb_add(&bar[XB_TOP], 1u);
        unsigned sp = 0u;
        while (xb_ld(&bar[XB_TOP]) < target) { __builtin_amdgcn_s_sleep(1); if ((++sp & 255u) == 0u) { if (xb_ld(&bar[XB_TMO])) break; if (sp > XB_SPIN_CAP) { atomicAdd(&bar[XB_TMO], 1u); break; } } }
        __builtin_amdgcn_fence(__ATOMIC_ACQUIRE, "agent");
        asm volatile("s_waitcnt vmcnt(0)" ::: "memory");
    }
    __syncthreads();
}
template <bool FIRST> __device__ __forceinline__ void xcd_barrier(const XcdBarrier& b) {
    if (FLAT_BAR) { flat_barrier(b); return; }
    asm volatile("s_waitcnt vmcnt(0)" ::: "memory");
    __syncthreads();
    if (threadIdx.x == 0) {
        unsigned* bar = b.bar;
        asm volatile("" : "+s"(bar));
        __builtin_amdgcn_s_waitcnt(0);
        unsigned nloc = b.st[0], nx = b.st[1];
        if (FIRST) { if (nloc == 0u) { xcd_barrier_complete(bar, b.x, nloc, nx); b.st[0] = nloc; b.st[1] = nx; } }
        const unsigned old = xb_add(&bar[XB_XSUB(b.x)], 1u);
        const unsigned gen = old / nloc;
        if (old + 1u == (gen + 1u) * nloc) {
            __builtin_amdgcn_fence(__ATOMIC_RELEASE, "agent");
            asm volatile("s_waitcnt vmcnt(0)" ::: "memory");
            const unsigned og = xb_add(&bar[XB_TOP], 1u);
            const unsigned tg = og / nx;
            if (og + 1u == (tg + 1u) * nx) {
#pragma unroll
                for (unsigned j = 0; j < 16; ++j) (void)__hip_atomic_fetch_add(&bar[XB_XGEN(j)], 1u, __ATOMIC_RELAXED, __HIP_MEMORY_SCOPE_AGENT);
            }
        }
        XB_SPIN(xb_ld(&bar[XB_XGEN(b.x)]) == gen, bar);
        __builtin_amdgcn_fence(__ATOMIC_ACQUIRE, "agent");
        asm volatile("s_waitcnt vmcnt(0)" ::: "memory");
    }
    __syncthreads();
}

struct Params { const float* in[N_INPUTS]; float* out; unsigned char* ws; float inv_freq[32]; };
static_assert(sizeof(Params) == N_INPUTS * 8 + 16 + 128, "Params has no padding");

struct Ctx {
    const float* const* in; float* out; unsigned char* ws;
    LAS unsigned char* lds;
    int G;
};
#define THREAD_IDS() int tid_ = threadIdx.x; asm volatile("" : "+v"(tid_)); const int tid = tid_, lane = tid & 63, wave = __builtin_amdgcn_readfirstlane(tid >> 6), gw = blockIdx.x * NWAVES + wave, NGW = C.G * NWAVES; (void)tid; (void)lane; (void)wave; (void)gw; (void)NGW
#define WSP(T, off) ((T*)(C.ws + (off)))

__device__ __forceinline__ float rstd_of(const float* ssp, int row) {
    const f32x4 a = *(const f32x4*)(ssp + (size_t)row * 16), b = *(const f32x4*)(ssp + (size_t)row * 16 + 4), c = *(const f32x4*)(ssp + (size_t)row * 16 + 8), d = *(const f32x4*)(ssp + (size_t)row * 16 + 12);
    const float s = (((a[0] + a[1]) + (a[2] + a[3])) + ((b[0] + b[1]) + (b[2] + b[3]))) + (((c[0] + c[1]) + (c[2] + c[3])) + ((d[0] + d[1]) + (d[2] + d[3])));
    return rsqrtf(s * (1.0f / D) + EPS);
}
#define EPI_IDS() int t_ = threadIdx.x; asm volatile("" : "+v"(t_)); const int wid_ = __builtin_amdgcn_readfirstlane(t_ >> 6), wr = wid_ >> 2, wc = wid_ & 3, fr = t_ & 15, fq = (t_ & 63) >> 4
struct EpiGLU {
    static constexpr bool PERM = true;
    bf16* act; const float* ss;
    __device__ __forceinline__ void operator()(const pg8::f32x4 (&acc)[2][2][4][2], const pg8::Unit& u, int, int, int, int) const {
        EPI_IDS();
        const int row0 = u.pm * 256 + wr * 64 + fr, col0 = u.pn * 128 + wc * 32 + 8 * fq;
#pragma unroll
        for (int ai = 0; ai < 2; ++ai)
#pragma unroll
            for (int m = 0; m < 4; ++m) {
                const int row = row0 + ai * 128 + m * 16; const float rstd = rstd_of(ss, row);
                float o[8];
#pragma unroll
                for (int n = 0; n < 2; ++n)
#pragma unroll
                    for (int j = 0; j < 4; ++j) { const float g = acc[ai][0][m][n][j] * rstd, up = acc[ai][1][m][n][j] * rstd; o[n * 4 + j] = siluf_(g) * up; }
                v4u w; w.x = pg8::cvt_pk_bf16(o[0], o[1]); w.y = pg8::cvt_pk_bf16(o[2], o[3]); w.z = pg8::cvt_pk_bf16(o[4], o[5]); w.w = pg8::cvt_pk_bf16(o[6], o[7]);
                *(v4u*)(act + (size_t)row * DFF + col0) = w;
            }
    }
};
template <bool FINAL, int SCALE2> struct EpiRes {
    static constexpr bool PERM = true;
    float* h; bf16* hb; float* ssout; float* out;
    __device__ __forceinline__ void rowgroup(const pg8::f32x4 (&a)[2][2], int row, int col0, int pn, int wc, int fq) const {
        constexpr float scale = 0.5f * SCALE2; float sq = 0.f;
        long yoff = -1;
        if (FINAL) { if (row < MP) { const int b = row / L, pos = row - b * L; if (pos >= NMETA) yoff = (long)O_YP + ((long)b * SEQ + (pos - NMETA)) * D; } else if (row < MR) yoff = (long)O_YS + (long)(row - MP) * D; }
#pragma unroll
        for (int bj = 0; bj < 2; ++bj) {
            const size_t off = (size_t)row * D + col0 + bj * 128;
            const v4u hw = *(const v4u*)(hb + off);
            f32x4 h0 = (f32x4){bflo(hw.x), bfhi(hw.x), bflo(hw.y), bfhi(hw.y)}, h1 = (f32x4){bflo(hw.z), bfhi(hw.z), bflo(hw.w), bfhi(hw.w)};
            h0 = h0 + a[bj][0] * scale; h1 = h1 + a[bj][1] * scale;
            v4u w; w.x = pg8::cvt_pk_bf16(h0[0], h0[1]); w.y = pg8::cvt_pk_bf16(h0[2], h0[3]); w.z = pg8::cvt_pk_bf16(h1[0], h1[1]); w.w = pg8::cvt_pk_bf16(h1[2], h1[3]);
            *(v4u*)(hb + off) = w;
            sq += (h0[0] * h0[0] + h0[1] * h0[1]) + (h0[2] * h0[2] + h0[3] * h0[3]) + (h1[0] * h1[0] + h1[1] * h1[1]) + (h1[2] * h1[2] + h1[3] * h1[3]);
            if (FINAL && yoff >= 0) { *(f32x4*)(out + yoff + col0 + bj * 128) = h0; *(f32x4*)(out + yoff + col0 + bj * 128 + 4) = h1; }
        }
        sq += __shfl_xor(sq, 16); sq += __shfl_xor(sq, 32);
        if (fq == 0 && ssout) ssout[(size_t)row * 16 + pn * 4 + wc] = sq;
    }
    __device__ __forceinline__ void operator()(const pg8::f32x4 (&acc)[2][2][4][2], const pg8::Unit& u, int, int, int, int) const {
        EPI_IDS();
        const int row0 = u.pm * 256 + wr * 64 + fr, col0 = u.pn * 256 + wc * 32 + 8 * fq;
#pragma unroll
        for (int ai = 0; ai < 2; ++ai)
#pragma unroll
            for (int m = 0; m < 4; ++m) {
                const pg8::f32x4 a[2][2] = {{acc[ai][0][m][0], acc[ai][0][m][1]}, {acc[ai][1][m][0], acc[ai][1][m][1]}};
                rowgroup(a, row0 + ai * 128 + m * 16, col0, u.pn, wc, fq);
                if (m == 3) asm volatile("" ::: "memory");
            }
    }
};
struct EpiZ {
    static constexpr bool PERM = true;
    bf16* zmix; bf16* gates; const float* ss; const float* bias;
    __device__ __forceinline__ void operator()(const pg8::f32x4 (&acc)[2][2][4][2], const pg8::Unit& u, int, int, int, int) const {
        EPI_IDS();
        const int row0 = u.pm * 256 + wr * 64 + fr, col0 = u.pn * 256 + wc * 32 + 8 * fq; const bool isgate = u.pn >= NMIXP / 256;
        f32x4 bv[2][2];
#pragma unroll
        for (int bj = 0; bj < 2; ++bj)
#pragma unroll
            for (int n = 0; n < 2; ++n) bv[bj][n] = *(const f32x4*)(bias + col0 + bj * 128 + 4 * n);
#pragma unroll
        for (int ai = 0; ai < 2; ++ai)
#pragma unroll
            for (int m = 0; m < 4; ++m) {
                const int row = row0 + ai * 128 + m * 16; const float rstd = rstd_of(ss, row);
                if (isgate) {
                    f32x4 g[4];
#pragma unroll
                    for (int bj = 0; bj < 2; ++bj)
#pragma unroll
                        for (int n = 0; n < 2; ++n) { const f32x4 z = acc[ai][bj][m][n] * rstd + bv[bj][n];
#pragma unroll
                            for (int j = 0; j < 4; ++j) g[2 * bj + n][j] = fmaxf(sigmoidf_(z[j]), 9.094947017729282e-13f); }
                    const int d0 = 64 * (u.pn - NMIXP / 256) + 16 * wc + 4 * fq; bf16* gp = gates + (size_t)row * NGATE + d0;
#pragma unroll
                    for (int s = 0; s < 4; ++s) { f32x4 o = g[s];
                        if (s < 3) {
#pragma unroll
                            for (int j = 0; j < 4; ++j) o[j] = g[s][j] * __builtin_amdgcn_rcpf(g[s + 1][j]); }
                        *(unsigned long long*)(gp + s * D) = (unsigned long long)pg8::cvt_pk_bf16(o[0], o[1]) | ((unsigned long long)pg8::cvt_pk_bf16(o[2], o[3]) << 32); }
                } else {
#pragma unroll
                    for (int bj = 0; bj < 2; ++bj) {
                        const f32x4 v0 = acc[ai][bj][m][0] * rstd + bv[bj][0], v1 = acc[ai][bj][m][1] * rstd + bv[bj][1];
                        v4u w; w.x = pg8::cvt_pk_bf16(v0[0], v0[1]); w.y = pg8::cvt_pk_bf16(v0[2], v0[3]); w.z = pg8::cvt_pk_bf16(v1[0], v1[1]); w.w = pg8::cvt_pk_bf16(v1[2], v1[3]);
                        *(v4u*)(zmix + (size_t)row * NMIXP + col0 + bj * 128) = w;
                    }
                }
            }
    }
};
struct EpiPartial {
    static constexpr bool PERM = true;
    float* part;
    __device__ __forceinline__ void operator()(const pg8::f32x4 (&acc)[2][2][4][2], const pg8::Unit& u, int, int, int, int) const {
        int t_ = threadIdx.x; asm volatile("" : "+v"(t_));
        const int slot = blockIdx.x;
        float* p = part + (size_t)slot * 65536 + (size_t)t_ * 4;
#pragma unroll
        for (int ai = 0; ai < 2; ++ai)
#pragma unroll
            for (int bj = 0; bj < 2; ++bj)
#pragma unroll
                for (int m = 0; m < 4; ++m)
#pragma unroll
                    for (int n = 0; n < 2; ++n) *(pg8::f32x4*)(p + (size_t)((((ai * 2 + bj) * 4 + m) * 2 + n) * 2048)) = acc[ai][bj][m][n];
        (void)u;
    }
};
template <int NSPLIT, class Epi> __device__ __forceinline__ void ksp_finalize(const float* part, const pg8::StaticOrder& so, int limit, const Epi& E) {
    const int ntail = so.nwg - limit;
    for (int it = blockIdx.x; it < ntail * 8; it += gridDim.x) {
        const int tt = it >> 3, ai = (it >> 2) & 1, m = it & 3;
        EPI_IDS();
        pg8::f32x4 a[2][2];
#pragma unroll
        for (int bj = 0; bj < 2; ++bj)
#pragma unroll
            for (int n = 0; n < 2; ++n) { pg8::f32x4 s = {0.f, 0.f, 0.f, 0.f};
#pragma unroll
                for (int k = 0; k < NSPLIT; ++k) s = s + *(const pg8::f32x4*)(part + (size_t)(tt * NSPLIT + k) * 65536 + (size_t)((((ai * 2 + bj) * 4 + m) * 2 + n) * 2048) + (size_t)t_ * 4);
                a[bj][n] = s; }
        pg8::Unit u; so.unit_of(limit + tt, u);
        E.rowgroup(a, u.pm * 256 + wr * 64 + fr + ai * 128 + m * 16, u.pn * 256 + wc * 32 + 8 * fq, u.pn, wc, fq);
    }
}

struct EpiMergeR {
    static constexpr bool PERM = true;
    bf16* merged; const bf16* gates;
    __device__ __forceinline__ void mid(pg8::f32x4 (&acc)[2][2][4][2], const pg8::Unit& u, int seg, int) const {
        EPI_IDS();
        const int row0 = u.pm * 256 + wr * 64 + fr, col0 = u.pn * 256 + wc * 32 + 8 * fq;
#pragma unroll
        for (int ai = 0; ai < 2; ++ai) {
#pragma unroll
            for (int m = 0; m < 4; ++m) {
                const int row = row0 + ai * 128 + m * 16;
#pragma unroll
                for (int bj = 0; bj < 2; ++bj) {
                    const v4u r = *(const v4u*)(gates + (size_t)row * NGATE + (seg - 1) * D + col0 + bj * 128);
                    pg8::f32x4& a0 = acc[ai][bj][m][0]; pg8::f32x4& a1 = acc[ai][bj][m][1];
                    a0[0] *= bflo(r.x); a0[1] *= bfhi(r.x); a0[2] *= bflo(r.y); a0[3] *= bfhi(r.y); a1[0] *= bflo(r.z); a1[1] *= bfhi(r.z); a1[2] *= bflo(r.w); a1[3] *= bfhi(r.w);
                }
            }
        }
    }
    __device__ __forceinline__ void operator()(const pg8::f32x4 (&acc)[2][2][4][2], const pg8::Unit& u, int, int, int, int) const {
        EPI_IDS();
        const int row0 = u.pm * 256 + wr * 64 + fr, col0 = u.pn * 256 + wc * 32 + 8 * fq;
#pragma unroll
        for (int ai = 0; ai < 2; ++ai)
#pragma unroll
            for (int m = 0; m < 4; ++m) {
                const int row = row0 + ai * 128 + m * 16;
#pragma unroll
                for (int bj = 0; bj < 2; ++bj) {
                    const v4u g = *(const v4u*)(gates + (size_t)row * NGATE + 3 * D + col0 + bj * 128);
                    const pg8::f32x4 a0 = acc[ai][bj][m][0], a1 = acc[ai][bj][m][1];
                    v4u w; w.x = pg8::cvt_pk_bf16(a0[0] * bflo(g.x), a0[1] * bfhi(g.x)); w.y = pg8::cvt_pk_bf16(a0[2] * bflo(g.y), a0[3] * bfhi(g.y));
                    w.z = pg8::cvt_pk_bf16(a1[0] * bflo(g.z), a1[1] * bfhi(g.z)); w.w = pg8::cvt_pk_bf16(a1[2] * bflo(g.w), a1[3] * bfhi(g.w));
                    *(v4u*)(merged + (size_t)row * D + col0 + bj * 128) = w;
                }
            }
    }
};

__host__ __device__ __forceinline__ int gate_col(int m) { const int br = m >> 10, d = m & 1023, dd = d & 63; return 256 * (d >> 6) + 128 * (br >> 1) + 32 * (dd >> 4) + 8 * ((dd >> 2) & 3) + 4 * (br & 1) + (dd & 3); }
__host__ __device__ __forceinline__ int gate_src(int c) { const int ct = c & 255, br = 2 * (ct >> 7) + ((ct >> 2) & 1), d = 64 * (c >> 8) + 16 * ((ct >> 5) & 3) + 4 * ((ct >> 3) & 3) + (ct & 3); return br * 1024 + d; }
struct RowMap { int mode, a; __device__ __forceinline__ int operator()(int n) const { return mode == 0 ? n + a : (mode == 1 ? 256 * (n >> 7) + (n & 127) + a : (n < NMIX ? n : NMIXP + gate_col(n - NMIX))); } };
__device__ __forceinline__ void tr_item(const float* W, int K, int N, const float* gain, bf16* WT, int pitch, RowMap rm, LAS float* scr, int kb, int nb, int lane) {
    const int k0 = 64 * kb, n0 = 64 * nb; const int nn = n0 + 4 * (lane & 15), kr = lane >> 4;
    f32x4 v[16];
#pragma unroll
    for (int i = 0; i < 16; ++i) v[i] = (nn < N) ? *(const f32x4*)(W + (size_t)(k0 + 4 * i + kr) * N + nn) : (f32x4){0.f, 0.f, 0.f, 0.f};
#pragma unroll
    for (int i = 0; i < 16; ++i) { const int kk = 4 * i + kr; const float g = gain ? gain[k0 + kk] : 1.0f; LAS float* d = scr + kk * 65 + 4 * (lane & 15); d[0] = v[i][0] * g; d[1] = v[i][1] * g; d[2] = v[i][2] * g; d[3] = v[i][3] * g; }
    LDS_WAIT(); asm volatile("" ::: "memory");
    const int c = lane & 7;
#pragma unroll
    for (int j = 0; j < 8; ++j) { const int nl = (lane >> 3) + 8 * j; const int n = n0 + nl; const LAS float* s = scr + (8 * c) * 65 + nl;
        v4u o; o.x = pg8::cvt_pk_bf16(s[0 * 65], s[1 * 65]); o.y = pg8::cvt_pk_bf16(s[2 * 65], s[3 * 65]); o.z = pg8::cvt_pk_bf16(s[4 * 65], s[5 * 65]); o.w = pg8::cvt_pk_bf16(s[6 * 65], s[7 * 65]);
        if (n < N) *(v4u*)(WT + (size_t)rm(n) * pitch + k0 + 8 * c) = o; }
    LDS_WAIT(); asm volatile("" ::: "memory");
}
__device__ __forceinline__ void p0_prologue(const Ctx& C, const Params& P) {
    THREAD_IDS();
    LAS float* scr = (LAS float*)(C.lds + RING_OFF + wave * 16896);
    constexpr int I_FF = 16 * 44, I_DN = 44 * 16, I_IN = 16 * 113, I_BR = 4 * 4 * 16, I_OUT = 16 * 16;
    constexpr int PER_LAYER = 4 * I_FF + 2 * I_DN + I_IN + I_BR + I_OUT;
    for (int it = gw; it < DEPTH * PER_LAYER; it += NGW) {
        const int l = it / PER_LAYER; int r = it - l * PER_LAYER;
        bf16* W1a = WSP(bf16, WS_W1 + (size_t)(l * 2 + 0) * SZ_W1); bf16* W1b = WSP(bf16, WS_W1 + (size_t)(l * 2 + 1) * SZ_W1);
        bf16* Wda = WSP(bf16, WS_WD + (size_t)(l * 2 + 0) * SZ_WD); bf16* Wdb = WSP(bf16, WS_WD + (size_t)(l * 2 + 1) * SZ_WD);
        if (r < I_FF) { tr_item(C.in[I_F1G] + (size_t)l * D * DFF, D, DFF, C.in[I_NF1] + l * D, W1a, D, RowMap{1, 0}, scr, r / 44, r % 44, lane); continue; } r -= I_FF;
        if (r < I_FF) { tr_item(C.in[I_F1U] + (size_t)l * D * DFF, D, DFF, C.in[I_NF1] + l * D, W1a, D, RowMap{1, 128}, scr, r / 44, r % 44, lane); continue; } r -= I_FF;
        if (r < I_DN) { tr_item(C.in[I_F1D] + (size_t)l * D * DFF, DFF, D, nullptr, Wda, DFF, RowMap{0, 0}, scr, r / 16, r % 16, lane); continue; } r -= I_DN;
        if (r < I_FF) { tr_item(C.in[I_F2G] + (size_t)l * D * DFF, D, DFF, C.in[I_NF2] + l * D, W1b, D, RowMap{1, 0}, scr, r / 44, r % 44, lane); continue; } r -= I_FF;
        if (r < I_FF) { tr_item(C.in[I_F2U] + (size_t)l * D * DFF, D, DFF, C.in[I_NF2] + l * D, W1b, D, RowMap{1, 128}, scr, r / 44, r % 44, lane); continue; } r -= I_FF;
        if (r < I_DN) { tr_item(C.in[I_F2D] + (size_t)l * D * DFF, DFF, D, nullptr, Wdb, DFF, RowMap{0, 0}, scr, r / 16, r % 16, lane); continue; } r -= I_DN;
        if (r < I_IN) { tr_item(C.in[I_WIN] + (size_t)l * D * NIN, D, NIN, C.in[I_NMIX] + l * D, WSP(bf16, WS_WIN + (size_t)l * SZ_WIN), D, RowMap{2, 0}, scr, r / 113, r % 113, lane); continue; } r -= I_IN;
        if (r < I_BR) { const int n4 = r / 64, rr = r % 64; tr_item(C.in[I_WBR] + (size_t)(l * 4 + n4) * 256 * D, 256, D, nullptr, WSP(bf16, WS_WBR + (size_t)l * SZ_WBR) + n4 * 256, D, RowMap{0, 0}, scr, rr / 16, rr % 16, lane); continue; } r -= I_BR;
        tr_item(C.in[I_WOUT] + (size_t)l * D * D, D, D, nullptr, WSP(bf16, WS_WOUT + (size_t)l * SZ_WOUT), D, RowMap{0, 0}, scr, r / 16, r % 16, lane);
    }
    const int gt = gw * 64 + lane, NGT = NGW * 64;
    for (int i = gt; i < 2 * 240 * 128; i += NGT) { const int l = i / (240 * 128), r = i % (240 * 128); *(v4u*)(C.ws + WS_WIN + (size_t)l * SZ_WIN + ((size_t)NMIX * D) * 2 + (size_t)r * 16) = (v4u){0u, 0u, 0u, 0u}; }
    for (int i = gt; i < (M - MR) * 128; i += NGT) *(v4u*)(C.ws + WS_BR + (size_t)MR * D * 2 + (size_t)i * 16) = (v4u){0u, 0u, 0u, 0u};
    for (int i = gt; i < 2 * NINP; i += NGT) { const int l = i / NINP, j = i % NINP; float v = 0.f; if (j < NMIX) v = C.in[I_BIN][l * NIN + j]; else if (j >= NMIXP) v = C.in[I_BIN][l * NIN + NMIX + gate_src(j - NMIXP)]; WSP(float, WS_BINP)[i] = v; }
    for (int i = gt; i < NPOS * 32; i += NGT) { const int pi = i >> 5, fi = i & 31; const int pos = pi < L ? pi : PAST + (pi - L);
        const float angf = (float)pos * P.inv_freq[fi];
        const double a = (double)angf; const double k = rint(a * 0.15915494309189535); const double rr = (a - k * 6.283185307179586) - k * 2.4492935982947064e-16;
        const float rf = (float)rr; WSP(float, WS_ROPE)[i] = cosf(rf); WSP(float, WS_ROPE)[NPOS * 32 + i] = sinf(rf); }
    float* H = WSP(float, WS_H); bf16* HB = WSP(bf16, WS_HB); float* SS0 = WSP(float, WS_SS);
    for (int row = gw; row < M; row += NGW) {
        const float* src = nullptr;
        if (row < MP) { const int b = row / L, pos = row - b * L; src = pos < NMETA ? C.in[I_META] + (size_t)pos * D : C.in[I_XP] + ((size_t)b * SEQ + (pos - NMETA)) * D; }
        else if (row < MR) src = C.in[I_XS] + (size_t)(row - MP) * D;
        float s = 0.f;
#pragma unroll
        for (int j = 0; j < 4; ++j) { f32x4 v = src ? *(const f32x4*)(src + 256 * j + 4 * lane) : (f32x4){0.f, 0.f, 0.f, 0.f};
            s += (v[0] * v[0] + v[1] * v[1]) + (v[2] * v[2] + v[3] * v[3]);
            unsigned long long w = (unsigned long long)pk2(v[0], v[1]) | ((unsigned long long)pk2(v[2], v[3]) << 32);
            *(unsigned long long*)(HB + (size_t)row * D + 256 * j + 4 * lane) = w; }
        s = wave_sum(s); if (lane < 16) SS0[(size_t)row * 16 + lane] = lane == 0 ? s : 0.f;
    }
}

__device__ __forceinline__ float lam_of(const Ctx& C, int l, float lam_init) {
    THREAD_IDS();
    float a = 0.f, b = 0.f;
#pragma unroll 1
    for (int i = 0; i < 32; ++i) { a += C.in[I_LQ1][l * 32 + i] * C.in[I_LK1][l * 32 + i]; b += C.in[I_LQ2][l * 32 + i] * C.in[I_LK2][l * 32 + i]; }
    return __expf(a) - __expf(b) + lam_init;
}
__device__ __forceinline__ int t5_bucket(int n) {
    if (n < 16) return n;
    return 16 + (n >= 19) + (n >= 21) + (n >= 24) + (n >= 27) + (n >= 31) + (n >= 35) + (n >= 40) + (n >= 46) + (n >= 52) + (n >= 59) + (n >= 67) + (n >= 77) + (n >= 87) + (n >= 99) + (n >= 113);
}
__device__ __forceinline__ void unpack8(const v4u w, float (&x)[8]) { x[0] = bflo(w.x); x[1] = bfhi(w.x); x[2] = bflo(w.y); x[3] = bfhi(w.y); x[4] = bflo(w.z); x[5] = bfhi(w.z); x[6] = bflo(w.w); x[7] = bfhi(w.w); }
__device__ __forceinline__ v4u pack8(const float (&x)[8]) { v4u w; w.x = pg8::cvt_pk_bf16(x[0], x[1]); w.y = pg8::cvt_pk_bf16(x[2], x[3]); w.z = pg8::cvt_pk_bf16(x[4], x[5]); w.w = pg8::cvt_pk_bf16(x[6], x[7]); return w; }
__device__ __forceinline__ void n1_prep(const Ctx& C, int l) {
    THREAD_IDS();
    const bf16* ZM = WSP(bf16, WS_ZMIX); float* UB = WSP(float, WS_UBUF); float* RQ = WSP(float, WS_RQ); float* RK = WSP(float, WS_RK);
    float* LD = WSP(float, WS_LDEC); const float* COS = WSP(float, WS_ROPE); const float* SIN = COS + NPOS * 32; bf16* QNB = WSP(bf16, WS_QNB); bf16* KNB = WSP(bf16, WS_KNB);
    const int i = lane & 31;
    float qg[8], kg[8];
#pragma unroll
    for (int j = 0; j < 8; ++j) { qg[j] = C.in[I_QN][l * 32 + ((8 * i) & 31) + j] * (0.17677669529663687f * 1.4426950408889634f); kg[j] = C.in[I_KN][l * 32 + ((8 * i) & 31) + j]; }
    const int isk = i >> 4, hh = (i >> 2) & 3, jc = i & 3;
    for (int rp0 = gw * 2; rp0 < MR / 2; rp0 += NGW * 2) {
        v4u Wa[2], Wg[2], Wq[2], Wk[2], Wv[2], W1[2], W2[2], G0[2], G1[2];
#pragma unroll
        for (int u = 0; u < 2; ++u) { const int r = min(2 * (rp0 + u) + (lane >> 5), MR - 1); const bf16* z = ZM + (size_t)r * NMIXP; const bf16* zr = z + (isk ? R_K : R_Q) + hh * 64 + 8 * jc;
            Wa[u] = *(const v4u*)(z + C_A + 8 * i); Wg[u] = *(const v4u*)(z + C_G + 8 * i); Wq[u] = *(const v4u*)(z + D_Q + 8 * i); Wk[u] = *(const v4u*)(z + D_K + 8 * i); Wv[u] = *(const v4u*)(z + D_V + 8 * i);
            W1[u] = *(const v4u*)zr; W2[u] = *(const v4u*)(zr + 32); G0[u] = *(const v4u*)(z + G_LOW); G1[u] = *(const v4u*)(z + G_LOW + 8); }
#pragma unroll
        for (int u = 0; u < 2; ++u) {
        if (rp0 + u >= MR / 2) break;
        const int r = 2 * (rp0 + u) + (lane >> 5);
        const int pi = r < MP ? r % L : L + ((r - MP) & 7);
        float* kout = r < MP ? C.out + O_KP + ((size_t)l * MP + r) * 256 : C.out + O_KS + ((size_t)l * MS + (r - MP)) * 256;
        float* vout = r < MP ? C.out + O_VP + ((size_t)l * MP + r) * 256 : C.out + O_VS + ((size_t)l * MS + (r - MP)) * 256;
        const v4u wa = Wa[u], wg = Wg[u], wq = Wq[u], wk = Wk[u], wv = Wv[u], w1 = W1[u], w2 = W2[u], gl0 = G0[u], gl1 = G1[u];
        float x[8], y[8];
        unpack8(wa, x); unpack8(wg, y);
#pragma unroll
        for (int j = 0; j < 8; ++j) x[j] *= sigmoidf_(y[j]);
        *(f32x4*)(UB + (size_t)r * 256 + 8 * i) = (f32x4){x[0], x[1], x[2], x[3]}; *(f32x4*)(UB + (size_t)r * 256 + 8 * i + 4) = (f32x4){x[4], x[5], x[6], x[7]};
        unpack8(wv, x);
        *(f32x4*)(vout + 8 * i) = (f32x4){x[0], x[1], x[2], x[3]}; *(f32x4*)(vout + 8 * i + 4) = (f32x4){x[4], x[5], x[6], x[7]};
        unpack8(wq, x);
        { float s = 0.f;
#pragma unroll
          for (int j = 0; j < 8; ++j) s += x[j] * x[j];
          s += __shfl_xor(s, 1); s += __shfl_xor(s, 2); const float rs = rsqrtf(s * (1.0f / 32) + EPS);
#pragma unroll
          for (int j = 0; j < 8; ++j) x[j] = x[j] * rs * qg[j];
          *(v4u*)(QNB + (size_t)r * 256 + 8 * i) = pack8(x); }
        unpack8(wk, x);
        { float s = 0.f;
#pragma unroll
          for (int j = 0; j < 8; ++j) s += x[j] * x[j];
          s += __shfl_xor(s, 1); s += __shfl_xor(s, 2); const float rs = rsqrtf(s * (1.0f / 32) + EPS);
#pragma unroll
          for (int j = 0; j < 8; ++j) x[j] = x[j] * rs * kg[j];
          *(v4u*)(KNB + (size_t)r * 256 + 8 * i) = pack8(x);
          *(f32x4*)(kout + 8 * i) = (f32x4){x[0], x[1], x[2], x[3]}; *(f32x4*)(kout + 8 * i + 4) = (f32x4){x[4], x[5], x[6], x[7]}; }
        unpack8(w1, x); unpack8(w2, y);
        { const f32x4 c0 = *(const f32x4*)(COS + pi * 32 + 8 * jc), c1 = *(const f32x4*)(COS + pi * 32 + 8 * jc + 4), s0 = *(const f32x4*)(SIN + pi * 32 + 8 * jc), s1 = *(const f32x4*)(SIN + pi * 32 + 8 * jc + 4);
          const float sc = isk ? 0.125f : 1.0f; float o1[8], o2[8];
#pragma unroll
          for (int j = 0; j < 8; ++j) { const float cs = j < 4 ? c0[j & 3] : c1[j & 3], sn = j < 4 ? s0[j & 3] : s1[j & 3]; o1[j] = (x[j] * cs - y[j] * sn) * sc; o2[j] = (x[j] * sn + y[j] * cs) * sc; }
          float* ro = (isk ? RK : RQ) + (size_t)r * 256 + hh * 64 + 8 * jc;
          *(f32x4*)ro = (f32x4){o1[0], o1[1], o1[2], o1[3]}; *(f32x4*)(ro + 4) = (f32x4){o1[4], o1[5], o1[6], o1[7]}; *(f32x4*)(ro + 32) = (f32x4){o2[0], o2[1], o2[2], o2[3]}; *(f32x4*)(ro + 36) = (f32x4){o2[4], o2[5], o2[6], o2[7]}; }
        { float gv[16]; unpack8(gl0, x); unpack8(gl1, y);
#pragma unroll
          for (int j = 0; j < 8; ++j) { gv[j] = x[j]; gv[8 + j] = y[j]; }
          f32x4 gp = *(const f32x4*)(C.in[I_GAB] + l * 128 + 4 * i);
#pragma unroll
          for (int k = 0; k < 16; ++k) { const f32x4 aw = *(const f32x4*)(C.in[I_GAW] + (size_t)(l * 16 + k) * 128 + 4 * i); gp = gp + aw * gv[k]; }
          f32x4 ls;
#pragma unroll
          for (int j = 0; j < 4; ++j) ls[j] = (fminf(gp[j], 0.f) - log1pf(__expf(-fabsf(gp[j])))) * (1.0f / 16.0f);
          *(f32x4*)(LD + (size_t)r * 128 + 4 * i) = ls; }
        }
    }
}
__device__ __forceinline__ void conv_rows_item(const Ctx& C, int l, int item) {
    THREAD_IDS();
    const float* UB = WSP(float, WS_UBUF); bf16* BR = WSP(bf16, WS_BR);
    const float* cw = C.in[I_CW] + (size_t)l * 31 * 256; const float* sc = C.in[I_SCONV];
    LAS float* wl = (LAS float*)C.lds;
    for (int i = tid; i < 31 * 256; i += NWAVES * 64) wl[i] = cw[i];
    LDS_WAIT(); __builtin_amdgcn_s_barrier(); asm volatile("" ::: "memory");
    const int r0 = item * 64 + wave * 8;
    if (r0 < MR) {
        const bool smp = r0 >= MP; const int b = smp ? (r0 - MP) >> 3 : r0 / L; const int p0 = smp ? 0 : r0 - b * L; const int rb = smp ? MP + b * 8 : b * L;
        float acc[8][4];
#pragma unroll
        for (int i = 0; i < 8; ++i)
#pragma unroll
            for (int k = 0; k < 4; ++k) acc[i][k] = C.in[I_CB][l * 256 + lane + 64 * k];
#pragma unroll 1
        for (int jb = 0; jb < 40; jb += 8) {
            float uv[8][4];
#pragma unroll
            for (int jj = 0; jj < 8; ++jj) { const int j = jb + jj; const int q = p0 - 30 + j;
#pragma unroll
                for (int k = 0; k < 4; ++k) { const int c = lane + 64 * k;
                    uv[jj][k] = j >= 38 ? 0.f : (q >= 0 ? UB[(size_t)(rb + q) * 256 + c] : (smp ? sc[(((size_t)l * DB + b) * 30 + (q + 30)) * 256 + c] : 0.f)); } }
#pragma unroll
            for (int jj = 0; jj < 8; ++jj)
#pragma unroll
                for (int i = 0; i < 8; ++i) { const int t = jb + jj - i;
                    if (t >= 0 && t <= 30) {
#pragma unroll
                        for (int k = 0; k < 4; ++k) acc[i][k] += wl[t * 256 + lane + 64 * k] * uv[jj][k]; } }
        }
#pragma unroll
        for (int i = 0; i < 8; ++i) { const int r = r0 + i;
            float s = (acc[i][0] + acc[i][1]) + (acc[i][2] + acc[i][3]); const float mean = wave_sum(s) * (1.0f / 256);
            float q2 = 0.f;
#pragma unroll
            for (int k = 0; k < 4; ++k) { acc[i][k] -= mean; q2 += acc[i][k] * acc[i][k]; }
            const float rstd = rsqrtf(wave_sum(q2) * (1.0f / 256) + EPS);
#pragma unroll
            for (int k = 0; k < 4; ++k) { const int c = lane + 64 * k; const float y = acc[i][k] * rstd * C.in[I_CLG][l * 256 + c] + C.in[I_CLB][l * 256 + c]; BR[(size_t)r * D + c] = (bf16)f2bf(siluf_(y)); } }
    }
    LDS_WAIT(); __builtin_amdgcn_s_barrier(); asm volatile("" ::: "memory");
}
__device__ __forceinline__ void conv_state_item(const Ctx& C, int l, int part, int nparts) {
    THREAD_IDS();
    const float* UB = WSP(float, WS_UBUF); const float* sc = C.in[I_SCONV];
    for (int i = part * NWAVES * 64 + tid; i < BATCH * 30 * 256; i += nparts * NWAVES * 64) { const int c = i & 255, ii = (i >> 8) % 30, b = i / (30 * 256); C.out[O_CP + (size_t)l * BATCH * 30 * 256 + i] = UB[(size_t)(b * L + L - 30 + ii) * 256 + c]; }
    for (int i = part * NWAVES * 64 + tid; i < DB * 30 * 256; i += nparts * NWAVES * 64) { const int c = i & 255, ii = (i >> 8) % 30, b = i / (30 * 256);
        C.out[O_CS + (size_t)l * DB * 30 * 256 + i] = ii < 22 ? sc[(((size_t)l * DB + b) * 30 + 8 + ii) * 256 + c] : UB[(size_t)(MP + b * 8 + ii - 22) * 256 + c]; }
}
template <int DK, bool RET> __device__ __forceinline__ void la_seq(const Ctx& C, int l, bool smp, int b, int h) {
    THREAD_IDS();
    const bf16* ZM = WSP(bf16, WS_ZMIX); const float* RQ = WSP(float, WS_RQ); const float* RK = WSP(float, WS_RK); const float* LD = WSP(float, WS_LDEC); bf16* BR = WSP(bf16, WS_BR);
    const int nt = smp ? DS : L; const int row0 = smp ? MP + b * DS : b * L;
    float S[DK];
    if (smp) { const float* s0 = (RET ? C.in[I_SRET] : C.in[I_SGLA]) + (((size_t)l * DB + b) * 4 + h) * DK * 64;
#pragma unroll
        for (int k = 0; k < DK; ++k) S[k] = s0[k * 64 + lane]; }
    else {
#pragma unroll
        for (int k = 0; k < DK; ++k) S[k] = 0.f; }
    const float gamma = 1.0f - exp2f(-5.0f - (float)h);
    const float gn = RET ? C.in[I_RGN][(l * 4 + h) * 64 + lane] : C.in[I_GGN][(l * 4 + h) * 64 + lane];
    for (int t = 0; t < nt; ++t) {
        const int r = row0 + t; const bf16* z = ZM + (size_t)r * NMIXP;
        float ql, kl, dl = 1.f;
        if (RET) { ql = RQ[(size_t)r * 256 + h * 64 + lane]; kl = RK[(size_t)r * 256 + h * 64 + lane]; }
        else { const int lk = lane & 31; ql = bf2f(z[G_Q + h * 32 + lk]) * 0.17677669529663687f; kl = bf2f(z[G_K + h * 32 + lk]); dl = __expf(LD[(size_t)r * 128 + h * 32 + lk]); }
        const float v = bf2f(z[(RET ? R_V : G_V) + h * 64 + lane]);
        float o = 0.f;
#pragma unroll
        for (int k = 0; k < DK; ++k) { const float qk = __shfl(ql, k), kk = __shfl(kl, k); const float dk = RET ? gamma : __shfl(dl, k);
            S[k] = dk * S[k] + kk * v; o += qk * S[k]; if ((k & 7) == 7) __builtin_amdgcn_sched_barrier(0); }
        float y;
        if (RET) { const float mean = wave_sum(o) * (1.0f / 64); const float d = o - mean; const float var = wave_sum(d * d) * (1.0f / 64); y = d * rsqrtf(var + EPS) * gn; }
        else { const float ms = wave_sum(o * o) * (1.0f / 64); y = o * rsqrtf(ms + EPS) * gn; }
        const float g = bf2f(z[(RET ? R_G : G_R) + h * 64 + lane]);
        BR[(size_t)r * D + (RET ? 256 : 512) + h * 64 + lane] = (bf16)f2bf(siluf_(g) * y);
    }
    float* so = C.out + (RET ? (smp ? O_RS + (((size_t)l * DB + b) * 4 + h) * DK * 64 : O_RP + (((size_t)l * BATCH + b) * 4 + h) * DK * 64)
                             : (smp ? O_GS + (((size_t)l * DB + b) * 4 + h) * DK * 64 : O_GP + (((size_t)l * BATCH + b) * 4 + h) * DK * 64));
#pragma unroll
    for (int k = 0; k < DK; ++k) so[k * 64 + lane] = S[k];
}
typedef short bf16x8_t __attribute__((ext_vector_type(8)));
template <int DK, bool RET> __device__ __forceinline__ void la_chunked(const Ctx& C, int l, bool smp, int b, int h) {
    THREAD_IDS();
    constexpr int QS = DK + 8, TS = 72, NKB = DK / 16, NKS = DK / 32;
    constexpr int SB = 2 * 64 * QS + 64 * TS + DK * TS + 64 * TS + 64;
    LAS bf16* SB0 = (LAS bf16*)(C.lds);
    LAS bf16* AL = SB0 + 2 * SB;
    LAS bf16* ST = AL + 64 * TS;
    const bf16* ZM = WSP(bf16, WS_ZMIX); const float* RQ = WSP(float, WS_RQ); const float* RK = WSP(float, WS_RK); const float* LD = WSP(float, WS_LDEC); bf16* BR = WSP(bf16, WS_BR);
    const int nt = smp ? DS : L, row0 = smp ? MP + b * DS : b * L, nch = (nt + 63) >> 6;
    const float lg2 = RET ? log2f(1.0f - exp2f(-5.0f - (float)h)) : 0.f;
    const int g4 = lane >> 4, c16 = lane & 15;
    const bool qwave = wave < 4; const int w4 = wave & 3;
    float Sreg[NKB][4];
    if (wave >= 4) {
        const float* s0 = (RET ? C.in[I_SRET] : C.in[I_SGLA]) + (((size_t)l * DB + b) * 4 + h) * DK * 64;
#pragma unroll
        for (int cb = 0; cb < NKB; ++cb)
#pragma unroll
            for (int r = 0; r < 4; ++r) { const int dk = cb * 16 + c16, dv = (wave - 4) * 16 + 4 * g4 + r; const float v = smp ? s0[dk * 64 + dv] : 0.f; Sreg[cb][r] = v; ST[dv * QS + dk] = (bf16)f2bf(v); }
    }
    float gnv[4];
#pragma unroll
    for (int cb = 0; cb < 4; ++cb) gnv[cb] = (RET ? C.in[I_RGN] : C.in[I_GGN])[(l * 4 + h) * 64 + cb * 16 + c16];
    float a[16]; v4u vr;
#define LA_LOAD(c) do { const size_t r_ = (size_t)(row0 + (c) * 64 + lane); const bf16* z_ = ZM + r_ * NMIXP; \
        vr = *(const v4u*)(z_ + (RET ? R_V : G_V) + h * 64 + 8 * wave); \
        if (RET) { const float* p_ = (qwave ? RQ : RK) + r_ * 256 + h * 64 + 8 * w4; const f32x4 x0 = *(const f32x4*)p_, x1 = *(const f32x4*)(p_ + 4), x2 = *(const f32x4*)(p_ + 32), x3 = *(const f32x4*)(p_ + 36); \
            a[0] = x0[0]; a[1] = x0[1]; a[2] = x0[2]; a[3] = x0[3]; a[4] = x1[0]; a[5] = x1[1]; a[6] = x1[2]; a[7] = x1[3]; a[8] = x2[0]; a[9] = x2[1]; a[10] = x2[2]; a[11] = x2[3]; a[12] = x3[0]; a[13] = x3[1]; a[14] = x3[2]; a[15] = x3[3]; } \
        else { const v4u q_ = *(const v4u*)(z_ + (qwave ? G_Q : G_K) + h * 32 + 8 * w4); const float* p_ = LD + r_ * 128 + h * 32 + 8 * w4; const f32x4 x0 = *(const f32x4*)p_, x1 = *(const f32x4*)(p_ + 4); \
            a[0] = bflo(q_.x); a[1] = bfhi(q_.x); a[2] = bflo(q_.y); a[3] = bfhi(q_.y); a[4] = bflo(q_.z); a[5] = bfhi(q_.z); a[6] = bflo(q_.w); a[7] = bfhi(q_.w); \
            a[8] = x0[0]; a[9] = x0[1]; a[10] = x0[2]; a[11] = x0[3]; a[12] = x1[0]; a[13] = x1[1]; a[14] = x1[2]; a[15] = x1[3]; } } while (0)
    LA_LOAD(0);
    int cur = 0;
    for (int i = 0; i <= nch; ++i) {
        if (i < nch) {
            const int c = i; LAS bf16* QT = SB0 + (i & 1) * SB; LAS bf16* KT = QT + 64 * QS; LAS bf16* VT = KT + 64 * QS; LAS bf16* KE = VT + 64 * TS; LAS bf16* GT = KE + DK * TS; LAS float* WT = (LAS float*)(GT + 64 * TS);
            const int nvc = min(64, nt - c * 64); const bool valid = lane < nvc;
        if (RET) {
            const float tq = (float)(lane + 1);
            if (qwave) { const float e = valid ? __builtin_amdgcn_exp2f(lg2 * tq) : 0.f;
                v4u w0, w1; w0.x = pg8::cvt_pk_bf16(a[0] * e, a[1] * e); w0.y = pg8::cvt_pk_bf16(a[2] * e, a[3] * e); w0.z = pg8::cvt_pk_bf16(a[4] * e, a[5] * e); w0.w = pg8::cvt_pk_bf16(a[6] * e, a[7] * e);
                w1.x = pg8::cvt_pk_bf16(a[8] * e, a[9] * e); w1.y = pg8::cvt_pk_bf16(a[10] * e, a[11] * e); w1.z = pg8::cvt_pk_bf16(a[12] * e, a[13] * e); w1.w = pg8::cvt_pk_bf16(a[14] * e, a[15] * e);
                *(LAS v4u*)(QT + lane * QS + 8 * w4) = w0; *(LAS v4u*)(QT + lane * QS + 32 + 8 * w4) = w1; }
            else { const float e = valid ? __builtin_amdgcn_exp2f(-lg2 * tq) : 0.f, ee = valid ? __builtin_amdgcn_exp2f(lg2 * ((float)nvc - tq)) : 0.f;
                v4u w0, w1; w0.x = pg8::cvt_pk_bf16(a[0] * e, a[1] * e); w0.y = pg8::cvt_pk_bf16(a[2] * e, a[3] * e); w0.z = pg8::cvt_pk_bf16(a[4] * e, a[5] * e); w0.w = pg8::cvt_pk_bf16(a[6] * e, a[7] * e);
                w1.x = pg8::cvt_pk_bf16(a[8] * e, a[9] * e); w1.y = pg8::cvt_pk_bf16(a[10] * e, a[11] * e); w1.z = pg8::cvt_pk_bf16(a[12] * e, a[13] * e); w1.w = pg8::cvt_pk_bf16(a[14] * e, a[15] * e);
                *(LAS v4u*)(KT + lane * QS + 8 * w4) = w0; *(LAS v4u*)(KT + lane * QS + 32 + 8 * w4) = w1;
#pragma unroll
                for (int i = 0; i < 16; i += 2) { const unsigned mine = pg8::cvt_pk_bf16(a[i] * ee, a[i + 1] * ee); const unsigned pv = (unsigned)__shfl_xor((int)mine, 1);
                    const unsigned w = (lane & 1) ? ((pv >> 16) | (mine & 0xffff0000u)) : ((mine & 0xffffu) | (pv << 16));
                    const int row = (i < 8 ? 8 * w4 + i : 32 + 8 * w4 + (i - 8)) + (lane & 1);
                    *(LAS unsigned*)(KE + row * TS + (lane & ~1)) = w; } }
        } else {
            float bb[8];
#pragma unroll
            for (int i = 0; i < 8; ++i) bb[i] = valid ? a[8 + i] : 0.f;
#pragma unroll
            for (int i = 0; i < 8; ++i) { float x = bb[i];
                x += __builtin_bit_cast(float, __builtin_amdgcn_mov_dpp(__builtin_bit_cast(int, x), 0x111, 0xf, 0xf, true));
                x += __builtin_bit_cast(float, __builtin_amdgcn_mov_dpp(__builtin_bit_cast(int, x), 0x112, 0xf, 0xf, true));
                x += __builtin_bit_cast(float, __builtin_amdgcn_mov_dpp(__builtin_bit_cast(int, x), 0x114, 0xf, 0xf, true));
                x += __builtin_bit_cast(float, __builtin_amdgcn_mov_dpp(__builtin_bit_cast(int, x), 0x118, 0xf, 0xf, true));
                const float t0 = __builtin_bit_cast(float, __builtin_amdgcn_readlane(__builtin_bit_cast(int, x), 15)), t1 = __builtin_bit_cast(float, __builtin_amdgcn_readlane(__builtin_bit_cast(int, x), 31)), t2 = __builtin_bit_cast(float, __builtin_amdgcn_readlane(__builtin_bit_cast(int, x), 47));
                bb[i] = x + (lane >= 16 ? t0 : 0.f) + (lane >= 32 ? t1 : 0.f) + (lane >= 48 ? t2 : 0.f); }
            if (qwave) {
                if (lane == 63) {
#pragma unroll
                    for (int i = 0; i < 8; ++i) WT[8 * w4 + i] = bb[i]; }
                float o8[8];
#pragma unroll
                for (int i = 0; i < 8; ++i) o8[i] = valid ? a[i] * 0.17677669529663687f * __expf(bb[i]) : 0.f;
                v4u w0; w0.x = pg8::cvt_pk_bf16(o8[0], o8[1]); w0.y = pg8::cvt_pk_bf16(o8[2], o8[3]); w0.z = pg8::cvt_pk_bf16(o8[4], o8[5]); w0.w = pg8::cvt_pk_bf16(o8[6], o8[7]);
                *(LAS v4u*)(QT + lane * QS + 8 * w4) = w0;
            } else {
                float o8[8];
#pragma unroll
                for (int i = 0; i < 8; ++i) o8[i] = valid ? a[i] * __expf(-bb[i]) : 0.f;
#pragma unroll
                for (int i = 0; i < 8; i += 2) { const float t0 = __shfl(bb[i], 63), t1 = __shfl(bb[i + 1], 63);
                    const unsigned mine = pg8::cvt_pk_bf16(valid ? a[i] * __expf(t0 - bb[i]) : 0.f, valid ? a[i + 1] * __expf(t1 - bb[i + 1]) : 0.f); const unsigned pv = (unsigned)__shfl_xor((int)mine, 1);
                    const unsigned w = (lane & 1) ? ((pv >> 16) | (mine & 0xffff0000u)) : ((mine & 0xffffu) | (pv << 16));
                    *(LAS unsigned*)(KE + (8 * w4 + i + (lane & 1)) * TS + (lane & ~1)) = w; }
                v4u w0; w0.x = pg8::cvt_pk_bf16(o8[0], o8[1]); w0.y = pg8::cvt_pk_bf16(o8[2], o8[3]); w0.z = pg8::cvt_pk_bf16(o8[4], o8[5]); w0.w = pg8::cvt_pk_bf16(o8[6], o8[7]);
                *(LAS v4u*)(KT + lane * QS + 8 * w4) = w0;
            }
        }
        { const unsigned vv[4] = {valid ? vr.x : 0u, valid ? vr.y : 0u, valid ? vr.z : 0u, valid ? vr.w : 0u};
#pragma unroll
          for (int i = 0; i < 4; ++i) { const unsigned pv = (unsigned)__shfl_xor((int)vv[i], 1);
              const unsigned w = (lane & 1) ? ((pv >> 16) | (vv[i] & 0xffff0000u)) : ((vv[i] & 0xffffu) | (pv << 16));
              *(LAS unsigned*)(VT + (8 * wave + 2 * i + (lane & 1)) * TS + (lane & ~1)) = w; } }
            if (c + 1 < nch) LA_LOAD(c + 1);
        }
        if (i >= 1) {
            LAS bf16* QT = SB0 + ((i - 1) & 1) * SB; LAS bf16* KT = QT + 64 * QS;
        { const int rb = wave >> 1;
#pragma unroll
          for (int ci = 0; ci < 2; ++ci) { const int cb = (wave & 1) * 2 + ci; f32x4 acc = {0.f, 0.f, 0.f, 0.f};
              if (cb <= rb) {
#pragma unroll
                  for (int ks = 0; ks < NKS; ++ks) { const bf16x8_t af = *(const LAS bf16x8_t*)(QT + (rb * 16 + c16) * QS + ks * 32 + 8 * g4), bf = *(const LAS bf16x8_t*)(KT + (cb * 16 + c16) * QS + ks * 32 + 8 * g4);
                      acc = __builtin_amdgcn_mfma_f32_16x16x32_bf16(af, bf, acc, 0, 0, 0); } }
#pragma unroll
              for (int r = 0; r < 4; ++r) { const int tt = rb * 16 + 4 * g4 + r, ss = cb * 16 + c16; AL[tt * TS + ss] = (bf16)f2bf(ss <= tt ? acc[r] : 0.f); } } }
        }
        LDS_WAIT(); __builtin_amdgcn_s_barrier(); asm volatile("" ::: "memory");
        if (i >= 1) {
            const int c = i - 1; LAS bf16* QT = SB0 + (c & 1) * SB; LAS bf16* KT = QT + 64 * QS; LAS bf16* VT = KT + 64 * QS; LAS bf16* KE = VT + 64 * TS; LAS bf16* GT = KE + DK * TS; LAS float* WT = (LAS float*)(GT + 64 * TS);
            const int nvc = min(64, nt - c * 64); (void)KT;
        if (wave < 4) {
            const int rb = wave; const LAS bf16* STc = ST + cur * 64 * QS;
            f32x4 o[4];
#pragma unroll
            for (int cb = 0; cb < 4; ++cb) o[cb] = (f32x4){0.f, 0.f, 0.f, 0.f};
#pragma unroll
            for (int ks = 0; ks < 2; ++ks) { const bf16x8_t af = *(const LAS bf16x8_t*)(AL + (rb * 16 + c16) * TS + ks * 32 + 8 * g4);
#pragma unroll
                for (int cb = 0; cb < 4; ++cb) { const bf16x8_t bf = *(const LAS bf16x8_t*)(VT + (cb * 16 + c16) * TS + ks * 32 + 8 * g4); o[cb] = __builtin_amdgcn_mfma_f32_16x16x32_bf16(af, bf, o[cb], 0, 0, 0); } }
#pragma unroll
            for (int ks = 0; ks < NKS; ++ks) { const bf16x8_t af = *(const LAS bf16x8_t*)(QT + (rb * 16 + c16) * QS + ks * 32 + 8 * g4);
#pragma unroll
                for (int cb = 0; cb < 4; ++cb) { const bf16x8_t bf = *(const LAS bf16x8_t*)(STc + (cb * 16 + c16) * QS + ks * 32 + 8 * g4); o[cb] = __builtin_amdgcn_mfma_f32_16x16x32_bf16(af, bf, o[cb], 0, 0, 0); } }
            { float* LAO = WSP(float, WS_LAO);
#pragma unroll
              for (int r = 0; r < 4; ++r) { const int tok = c * 64 + rb * 16 + 4 * g4 + r;
                  if (tok < nt) { float* op = LAO + (size_t)(row0 + tok) * 512 + (RET ? 0 : 256) + h * 64 + c16;
#pragma unroll
                      for (int cb = 0; cb < 4; ++cb) op[cb * 16] = o[cb][r]; } } }
        } else {
            const int dvb = wave - 4; LAS bf16* STn = ST + (cur ^ 1) * 64 * QS;
            f32x4 ds[NKB];
#pragma unroll
            for (int cb = 0; cb < NKB; ++cb) ds[cb] = (f32x4){0.f, 0.f, 0.f, 0.f};
#pragma unroll
            for (int ks = 0; ks < 2; ++ks) { const bf16x8_t af = *(const LAS bf16x8_t*)(VT + (dvb * 16 + c16) * TS + ks * 32 + 8 * g4);
#pragma unroll
                for (int cb = 0; cb < NKB; ++cb) { const bf16x8_t bf = *(const LAS bf16x8_t*)(KE + (cb * 16 + c16) * TS + ks * 32 + 8 * g4); ds[cb] = __builtin_amdgcn_mfma_f32_16x16x32_bf16(af, bf, ds[cb], 0, 0, 0); } }
#pragma unroll
            for (int cb = 0; cb < NKB; ++cb) { const float eB = RET ? __builtin_amdgcn_exp2f(lg2 * (float)nvc) : __expf(WT[cb * 16 + c16]);
#pragma unroll
                for (int r = 0; r < 4; ++r) { Sreg[cb][r] = eB * Sreg[cb][r] + ds[cb][r]; STn[(dvb * 16 + 4 * g4 + r) * QS + cb * 16 + c16] = (bf16)f2bf(Sreg[cb][r]); } }
        }
            cur ^= 1;
        }
        LDS_WAIT(); __builtin_amdgcn_s_barrier(); asm volatile("" ::: "memory");
    }
#undef LA_LOAD
    if (wave >= 4) {
        float* so = C.out + (RET ? (smp ? O_RS + (((size_t)l * DB + b) * 4 + h) * DK * 64 : O_RP + (((size_t)l * BATCH + b) * 4 + h) * DK * 64)
                                 : (smp ? O_GS + (((size_t)l * DB + b) * 4 + h) * DK * 64 : O_GP + (((size_t)l * BATCH + b) * 4 + h) * DK * 64));
#pragma unroll
        for (int cb = 0; cb < NKB; ++cb)
#pragma unroll
            for (int r = 0; r < 4; ++r) so[(cb * 16 + c16) * 64 + (wave - 4) * 16 + 4 * g4 + r] = Sreg[cb][r];
    }
}
typedef float f32x16_t __attribute__((ext_vector_type(16)));
__device__ __forceinline__ int crow_(int r, int hi) { return (r & 3) + 8 * (r >> 2) + 4 * hi; }
__device__ __forceinline__ float swapmax32(float m) { auto rr = __builtin_amdgcn_permlane32_swap(__float_as_uint(m), __float_as_uint(m), false, false); return fmaxf(__uint_as_float(rr[0]), __uint_as_float(rr[1])); }
__device__ __forceinline__ float swapadd32(float m) { auto rr = __builtin_amdgcn_permlane32_swap(__float_as_uint(m), __float_as_uint(m), false, false); return __uint_as_float(rr[0]) + __uint_as_float(rr[1]); }
constexpr float LOG2E = 1.4426950408889634f;
__device__ __forceinline__ void attn_prompt_item(const Ctx& C, int l, int b, int h, int qb, float lam, float lam_init, float mb) {
    THREAD_IDS();
    constexpr int KS = 72;
    LAS bf16* Kt = (LAS bf16*)C.lds;
    LAS bf16* Vt = Kt + 2 * 64 * KS;
    LAS float* BT = (LAS float*)(Vt + 2 * 64 * KS);
    LAS float* OX = BT + 128;
    const bf16* ZM = WSP(bf16, WS_ZMIX); const bf16* QNB = WSP(bf16, WS_QNB); const bf16* KNB = WSP(bf16, WS_KNB); bf16* BR = WSP(bf16, WS_BR);
    const int r32 = lane & 31, hi = lane >> 5, qs = wave >> 1, s = wave & 1;
    const int q0 = qb * 128 + qs * 32; const int rowb = b * L;
    if (tid < 128) BT[tid] = (C.in[I_RELB][t5_bucket(tid) * 4 + h] - C.in[I_RELB][31 * 4 + h]) * LOG2E;
    pg8::bf16x8 qf[2];
#pragma unroll
    for (int d0 = 0; d0 < 2; ++d0) qf[d0] = *(const pg8::bf16x8*)(QNB + (size_t)(rowb + q0 + r32) * 256 + h * 64 + s * 32 + 16 * d0 + 8 * hi);
    const int pl = (lane & ~15) | ((lane & 8) >> 1) | ((lane & 4) << 1) | (lane & 3);
    const int NT = (min(128 * (qb + 1), L) + 63) >> 6;
    v4u kreg, vreg;
#define AT_LOAD(j) do { const size_t r_ = (size_t)(rowb + (j) * 64 + lane); kreg = *(const v4u*)(KNB + r_ * 256 + h * 64 + 8 * wave); vreg = *(const v4u*)(ZM + r_ * NMIXP + D_V + h * 64 + 8 * wave); } while (0)
#define AT_STORE(buf) do { *(LAS v4u*)(Kt + (buf) * 64 * KS + lane * KS + 8 * wave) = kreg; LAS bf16* v_ = Vt + (buf) * 64 * KS + (8 * wave) * KS + pl; \
        v_[0] = (bf16)(vreg.x & 0xffffu); v_[KS] = (bf16)(vreg.x >> 16); v_[2 * KS] = (bf16)(vreg.y & 0xffffu); v_[3 * KS] = (bf16)(vreg.y >> 16); \
        v_[4 * KS] = (bf16)(vreg.z & 0xffffu); v_[5 * KS] = (bf16)(vreg.z >> 16); v_[6 * KS] = (bf16)(vreg.w & 0xffffu); v_[7 * KS] = (bf16)(vreg.w >> 16); } while (0)
    AT_LOAD(0); AT_STORE(0); if (NT > 1) AT_LOAD(1);
    LDS_WAIT(); __builtin_amdgcn_s_barrier(); asm volatile("" ::: "memory");
    float lsum = 0.f; f32x16_t o[2]; f32x16_t negm;
#pragma unroll
    for (int i = 0; i < 16; ++i) negm[i] = -mb;
#pragma unroll
    for (int i = 0; i < 16; ++i) { o[0][i] = 0.f; o[1][i] = 0.f; }
    for (int j = 0; j < NT; ++j) {
        const int k0 = 64 * j, buf = j & 1;
        if (k0 <= q0 + 31) {
            const LAS bf16* kb = Kt + buf * 64 * KS; const LAS bf16* vb = Vt + buf * 64 * KS;
            f32x16_t p0 = negm, p1 = negm;
#pragma unroll
            for (int d0 = 0; d0 < 2; ++d0) { const pg8::bf16x8 a0 = *(const LAS pg8::bf16x8*)(kb + r32 * KS + s * 32 + 16 * d0 + 8 * hi), a1 = *(const LAS pg8::bf16x8*)(kb + (32 + r32) * KS + s * 32 + 16 * d0 + 8 * hi);
                p0 = __builtin_amdgcn_mfma_f32_32x32x16_bf16(a0, qf[d0], p0, 0, 0, 0); p1 = __builtin_amdgcn_mfma_f32_32x32x16_bf16(a1, qf[d0], p1, 0, 0, 0); }
            if (q0 - k0 - 63 < 113) {
#pragma unroll
                for (int r = 0; r < 16; ++r) { const int n0 = (q0 + r32) - (k0 + crow_(r, hi)), n1 = n0 - 32;
                    p0[r] = n0 < 0 ? -INFINITY : p0[r] + (n0 < 128 ? BT[n0] : 0.f); p1[r] = n1 < 0 ? -INFINITY : p1[r] + (n1 < 128 ? BT[n1] : 0.f); } }
            typedef float f32x2_t __attribute__((ext_vector_type(2)));
            f32x2_t ps2 = {0.f, 0.f};
#pragma unroll
            for (int r = 0; r < 16; r += 2) { p0[r] = __builtin_amdgcn_exp2f(p0[r]); p0[r + 1] = __builtin_amdgcn_exp2f(p0[r + 1]); p1[r] = __builtin_amdgcn_exp2f(p1[r]); p1[r + 1] = __builtin_amdgcn_exp2f(p1[r + 1]);
                ps2 = ps2 + (f32x2_t){p0[r], p0[r + 1]}; ps2 = ps2 + (f32x2_t){p1[r], p1[r + 1]}; }
            lsum += ps2[0] + ps2[1];
            pg8::bf16x8 pb[4];
#pragma unroll
            for (int ks = 0; ks < 4; ++ks) { v4u w;
                if (ks < 2) { w.x = pg8::cvt_pk_bf16(p0[8 * ks], p0[8 * ks + 1]); w.y = pg8::cvt_pk_bf16(p0[8 * ks + 2], p0[8 * ks + 3]); w.z = pg8::cvt_pk_bf16(p0[8 * ks + 4], p0[8 * ks + 5]); w.w = pg8::cvt_pk_bf16(p0[8 * ks + 6], p0[8 * ks + 7]); }
                else { w.x = pg8::cvt_pk_bf16(p1[8 * ks - 16], p1[8 * ks - 15]); w.y = pg8::cvt_pk_bf16(p1[8 * ks - 14], p1[8 * ks - 13]); w.z = pg8::cvt_pk_bf16(p1[8 * ks - 12], p1[8 * ks - 11]); w.w = pg8::cvt_pk_bf16(p1[8 * ks - 10], p1[8 * ks - 9]); }
                pb[ks] = __builtin_bit_cast(pg8::bf16x8, w); }
#pragma unroll
            for (int d0 = 0; d0 < 2; ++d0)
#pragma unroll
                for (int ks = 0; ks < 4; ++ks) { const pg8::bf16x8 af = *(const LAS pg8::bf16x8*)(vb + (32 * d0 + r32) * KS + 16 * ks + 8 * hi); o[d0] = __builtin_amdgcn_mfma_f32_32x32x16_bf16(af, pb[ks], o[d0], 0, 0, 0); }
        }
        if (j + 1 < NT) AT_STORE(buf ^ 1);
        if (j + 2 < NT) AT_LOAD(j + 2);
        LDS_WAIT(); __builtin_amdgcn_s_barrier(); asm volatile("" ::: "memory");
    }
#undef AT_LOAD
#undef AT_STORE
    lsum = swapadd32(lsum); const float inv = 1.0f / lsum;
    LAS float* ox = OX + (qs * 32 + r32) * 65;
    if (s == 1) {
#pragma unroll
        for (int d0 = 0; d0 < 2; ++d0)
#pragma unroll
            for (int r = 0; r < 16; ++r) ox[32 * d0 + crow_(r, hi)] = o[d0][r] * inv; }
    LDS_WAIT(); __builtin_amdgcn_s_barrier(); asm volatile("" ::: "memory");
    if (s == 0) {
        float ss = 0.f;
#pragma unroll
        for (int d0 = 0; d0 < 2; ++d0)
#pragma unroll
            for (int r = 0; r < 16; ++r) { const float v = o[d0][r] * inv - lam * ox[32 * d0 + crow_(r, hi)]; o[d0][r] = v; ss += v * v; }
        ss = swapadd32(ss); const float rs = rsqrtf(ss * (1.0f / 64) + EPS) * (1.0f - lam_init);
        const int qpos = q0 + r32;
        if (qpos < L) { bf16* brp = BR + (size_t)(rowb + qpos) * D + 768 + h * 64;
#pragma unroll
            for (int d0 = 0; d0 < 2; ++d0)
#pragma unroll
                for (int r4 = 0; r4 < 4; ++r4) { const int dv = 32 * d0 + 8 * r4 + 4 * hi; const float* sl = C.in[I_SUBLN] + l * 64 + dv;
                    const unsigned w0 = pk2(o[d0][4 * r4] * rs * sl[0], o[d0][4 * r4 + 1] * rs * sl[1]), w1 = pk2(o[d0][4 * r4 + 2] * rs * sl[2], o[d0][4 * r4 + 3] * rs * sl[3]);
                    *(unsigned long long*)(brp + dv) = (unsigned long long)w0 | ((unsigned long long)w1 << 32); } }
    }
    LDS_WAIT(); __builtin_amdgcn_s_barrier(); asm volatile("" ::: "memory");
}
constexpr int PSTR = 68;
__device__ __forceinline__ pg8::bf16x8 cvt8(const f32x4 a, const f32x4 b) { v4u w; w.x = pg8::cvt_pk_bf16(a[0], a[1]); w.y = pg8::cvt_pk_bf16(a[2], a[3]); w.z = pg8::cvt_pk_bf16(b[0], b[1]); w.w = pg8::cvt_pk_bf16(b[2], b[3]); return __builtin_bit_cast(pg8::bf16x8, w); }
__device__ __forceinline__ void attn_sample_item(const Ctx& C, int l, int b, int split) {
    THREAD_IDS();
    const int h = wave & 3, half = wave >> 2, c16 = lane & 15, g = lane >> 4, srow = c16 >> 3, t = c16 & 7;
    const bf16* QNB = WSP(bf16, WS_QNB); const int* PT = (const int*)C.in[I_PT];
    const float* CK = C.in[I_CK] + (size_t)l * NPOOL * PAGE * 256; const float* CV = C.in[I_CV] + (size_t)l * NPOOL * PAGE * 256;
    LAS float* BT = (LAS float*)C.lds;
    BT[tid] = (C.in[I_RELB][t5_bucket(tid & 127) * 4 + (tid >> 7)] - C.in[I_RELB][31 * 4 + (tid >> 7)]) * LOG2E;
    const v4u z4 = {0u, 0u, 0u, 0u};
    const v4u q0w = srow == 0 ? *(const v4u*)(QNB + (size_t)(MP + b * 8 + t) * 256 + h * 64 + 8 * g) : z4, q1w = srow == 1 ? *(const v4u*)(QNB + (size_t)(MP + b * 8 + t) * 256 + h * 64 + 32 + 8 * g) : z4;
    const pg8::bf16x8 qf0 = __builtin_bit_cast(pg8::bf16x8, q0w), qf1 = __builtin_bit_cast(pg8::bf16x8, q1w);
    LDS_WAIT(); __builtin_amdgcn_s_barrier(); asm volatile("" ::: "memory");
    float m = -INFINITY, lsum = 0.f; f32x4 o[4];
#pragma unroll
    for (int db = 0; db < 4; ++db) o[db] = (f32x4){0.f, 0.f, 0.f, 0.f};
    const int kk0 = split * 1024 + half * 512;
    const int pg0 = __builtin_amdgcn_readfirstlane(PT[b * NPAGES + (kk0 >> 7)]), pg1 = __builtin_amdgcn_readfirstlane(PT[b * NPAGES + (kk0 >> 7) + 1]), pg2 = __builtin_amdgcn_readfirstlane(PT[b * NPAGES + (kk0 >> 7) + 2]), pg3 = __builtin_amdgcn_readfirstlane(PT[b * NPAGES + (kk0 >> 7) + 3]);
#define SA_LOAD(KR, VR, st) do { const int kk_ = kk0 + 32 * (st); const int pi_ = (st) >> 2; const int page_ = pi_ == 0 ? pg0 : pi_ == 1 ? pg1 : pi_ == 2 ? pg2 : pg3; const size_t base_ = ((size_t)(page_ * PAGE + (kk_ & 127)) * 4 + h) * 64; \
        _Pragma("unroll") for (int T = 0; T < 2; ++T) _Pragma("unroll") for (int ks = 0; ks < 2; ++ks) { const float* p = CK + base_ + (size_t)(16 * T + c16) * 256 + 32 * ks + 8 * g; KR[T][ks][0] = *(const f32x4*)p; KR[T][ks][1] = *(const f32x4*)(p + 4); } \
        _Pragma("unroll") for (int db = 0; db < 4; ++db) _Pragma("unroll") for (int j = 0; j < 8; ++j) { const int kv = j < 4 ? 4 * g + j : 16 + 4 * g + (j - 4); VR[db][j] = CV[base_ + (size_t)kv * 256 + 16 * db + c16]; } } while (0)
#define SA_MATH(KR, VR, st) do { const int kk = kk0 + 32 * (st); f32x4 sv[2]; \
        _Pragma("unroll") for (int T = 0; T < 2; ++T) { sv[T] = (f32x4){0.f, 0.f, 0.f, 0.f}; \
            sv[T] = __builtin_amdgcn_mfma_f32_16x16x32_bf16(cvt8(KR[T][0][0], KR[T][0][1]), qf0, sv[T], 0, 0, 0); \
            sv[T] = __builtin_amdgcn_mfma_f32_16x16x32_bf16(cvt8(KR[T][1][0], KR[T][1][1]), qf1, sv[T], 0, 0, 0); } \
        if (kk + 31 + 128 > PAST) { \
            _Pragma("unroll") for (int T = 0; T < 2; ++T) _Pragma("unroll") for (int r = 0; r < 4; ++r) { const int n = PAST + t - (kk + 16 * T + 4 * g + r); if (n < 128) sv[T][r] += BT[h * 128 + n]; } } \
        float mt = fmaxf(fmaxf(fmaxf(sv[0][0], sv[0][1]), fmaxf(sv[0][2], sv[0][3])), fmaxf(fmaxf(sv[1][0], sv[1][1]), fmaxf(sv[1][2], sv[1][3]))); \
        mt = fmaxf(mt, __shfl_xor(mt, 16)); mt = fmaxf(mt, __shfl_xor(mt, 32)); \
        const float mn = fmaxf(m, mt); const float al = __builtin_amdgcn_exp2f(m - mn); m = mn; float ps = 0.f; \
        _Pragma("unroll") for (int T = 0; T < 2; ++T) _Pragma("unroll") for (int r = 0; r < 4; ++r) { sv[T][r] = __builtin_amdgcn_exp2f(sv[T][r] - m); ps += sv[T][r]; } \
        lsum = lsum * al + ps; const pg8::bf16x8 pf = cvt8(sv[0], sv[1]); \
        _Pragma("unroll") for (int db = 0; db < 4; ++db) { o[db] = o[db] * al; \
            const f32x4 va = {VR[db][0], VR[db][1], VR[db][2], VR[db][3]}, vb = {VR[db][4], VR[db][5], VR[db][6], VR[db][7]}; \
            o[db] = __builtin_amdgcn_mfma_f32_16x16x32_bf16(cvt8(va, vb), pf, o[db], 0, 0, 0); } } while (0)
    f32x4 krA[2][2][2], krB[2][2][2]; float vrA[4][8], vrB[4][8];
    SA_LOAD(krA, vrA, 0);
#pragma unroll 1
    for (int step = 0; step < 16; step += 2) {
        SA_LOAD(krB, vrB, step + 1);
        SA_MATH(krA, vrA, step);
        if (step + 2 < 16) SA_LOAD(krA, vrA, step + 2);
        SA_MATH(krB, vrB, step + 1);
    }
#undef SA_LOAD
#undef SA_MATH
    lsum += __shfl_xor(lsum, 16); lsum += __shfl_xor(lsum, 32);
    float* pp = WSP(float, WS_PART) + ((((size_t)b * 4 + h) * 16 + split * 2 + half) * 16 + c16) * PSTR;
#pragma unroll
    for (int db = 0; db < 4; ++db) *(f32x4*)(pp + 16 * db + 4 * g) = o[db];
    if (g == 0) { pp[64] = m; pp[65] = lsum; }
    LDS_WAIT(); __builtin_amdgcn_s_barrier(); asm volatile("" ::: "memory");
}
__device__ __forceinline__ void n3_attn_sample_combine(const Ctx& C, int l, float lam_init) {
    THREAD_IDS();
    const float lam = lam_of(C, l, lam_init);
    const bf16* QNB = WSP(bf16, WS_QNB); const bf16* KNB = WSP(bf16, WS_KNB); const bf16* ZM = WSP(bf16, WS_ZMIX); bf16* BR = WSP(bf16, WS_BR);
    for (int it = gw; it < DB * 4 * DS; it += NGW) {
        const int b = it >> 5, h = (it >> 3) & 3, t = it & 7; float os[2];
        const float far = C.in[I_RELB][31 * 4 + h];
        float sn[2][8];
        { const float qv = bf2f(QNB[(size_t)(MP + b * 8 + t) * 256 + h * 64 + lane]);
#pragma unroll
          for (int jj = 0; jj < 8; ++jj) { float p = qv * bf2f(KNB[(size_t)(MP + b * 8 + jj) * 256 + h * 64 + lane]);
              p += __shfl_xor(p, 1); p += __shfl_xor(p, 2); p += __shfl_xor(p, 4); p += __shfl_xor(p, 8); p += __shfl_xor(p, 16);
              const float bias = (C.in[I_RELB][t5_bucket(t - jj < 0 ? 0 : t - jj) * 4 + h] - far) * LOG2E;
              sn[0][jj] = jj <= t ? __shfl(p, 0) + bias : -INFINITY; sn[1][jj] = jj <= t ? __shfl(p, 32) + bias : -INFINITY; } }
#pragma unroll
        for (int s = 0; s < 2; ++s) {
            const float* pb = WSP(float, WS_PART) + ((((size_t)b * 4 + h) * 16) * 16 + s * 8 + t) * PSTR;
            float mm = -INFINITY; float pm[16];
#pragma unroll
            for (int pi = 0; pi < 16; ++pi) { pm[pi] = pb[(size_t)pi * 16 * PSTR + 64]; mm = fmaxf(mm, pm[pi]); }
#pragma unroll
            for (int jj = 0; jj < 8; ++jj) mm = fmaxf(mm, sn[s][jj]);
            float ll = 0.f, oo = 0.f;
#pragma unroll
            for (int pi = 0; pi < 16; ++pi) { const float* pr = pb + (size_t)pi * 16 * PSTR; const float w = __builtin_amdgcn_exp2f(pm[pi] - mm); ll += pr[65] * w; oo += pr[lane] * w; }
#pragma unroll
            for (int jj = 0; jj < 8; ++jj) { const float w = __builtin_amdgcn_exp2f(sn[s][jj] - mm); ll += w; oo += w * bf2f(ZM[(size_t)(MP + b * 8 + jj) * NMIXP + D_V + h * 64 + lane]); }
            os[s] = oo / ll;
        }
        const float o = os[0] - lam * os[1]; const float ms = wave_sum(o * o) * (1.0f / 64);
        BR[(size_t)(MP + b * 8 + t) * D + 768 + h * 64 + lane] = (bf16)f2bf(o * rsqrtf(ms + EPS) * C.in[I_SUBLN][l * 64 + lane] * (1.0f - lam_init));
    }
}

__device__ __forceinline__ void n3_la_finalize(const Ctx& C, int l) {
    THREAD_IDS();
    const float* LAO = WSP(float, WS_LAO); const bf16* ZM = WSP(bf16, WS_ZMIX); bf16* BR = WSP(bf16, WS_BR);
    const bool ret = lane < 32; const int hd = (lane >> 3) & 3, c8 = (lane & 7) * 8;
    float gn[8];
#pragma unroll
    for (int j = 0; j < 8; ++j) gn[j] = (ret ? C.in[I_RGN] : C.in[I_GGN])[(l * 4 + hd) * 64 + c8 + j];
    for (int r0 = gw * 4; r0 < MP; r0 += NGW * 4) {
        f32x4 a4[4], b4[4]; v4u g4[4];
#pragma unroll
        for (int u = 0; u < 4; ++u) { const int r = min(r0 + u, MP - 1); a4[u] = *(const f32x4*)(LAO + (size_t)r * 512 + 8 * lane); b4[u] = *(const f32x4*)(LAO + (size_t)r * 512 + 8 * lane + 4);
            g4[u] = *(const v4u*)(ZM + (size_t)r * NMIXP + (ret ? R_G : G_R) + hd * 64 + c8); }
#pragma unroll
        for (int u = 0; u < 4; ++u) { const int r = r0 + u; if (r >= MP) break;
            float x[8] = {a4[u][0], a4[u][1], a4[u][2], a4[u][3], b4[u][0], b4[u][1], b4[u][2], b4[u][3]}, g[8]; unpack8(g4[u], g);
            float s = ((x[0] + x[1]) + (x[2] + x[3])) + ((x[4] + x[5]) + (x[6] + x[7]));
            s += __shfl_xor(s, 1); s += __shfl_xor(s, 2); s += __shfl_xor(s, 4);
            const float mean = ret ? s * (1.0f / 64) : 0.f; float q2 = 0.f;
#pragma unroll
            for (int j = 0; j < 8; ++j) { x[j] -= mean; q2 += x[j] * x[j]; }
            q2 += __shfl_xor(q2, 1); q2 += __shfl_xor(q2, 2); q2 += __shfl_xor(q2, 4);
            const float rs = rsqrtf(q2 * (1.0f / 64) + EPS);
#pragma unroll
            for (int j = 0; j < 8; ++j) x[j] = siluf_(g[j]) * x[j] * rs * gn[j];
            *(v4u*)(BR + (size_t)r * D + 256 + 8 * lane) = pack8(x); }
    }
}

constexpr int NQB_ATT = (L + 127) / 128;
constexpr int IT_LA = 32, IT_SS = IT_LA + DB * 8, IT_AT = IT_SS + 16 * NQB_ATT, IT_LS = IT_AT + 32, IT_CV = IT_LS + (MR + 63) / 64, IT_END = IT_CV;
__device__ __forceinline__ void n2_phase(const Ctx& C, int l, float lam_init, int qslot) {
    THREAD_IDS();
    const float lam = lam_of(C, l, lam_init);
    float mb;
    { float mq = 0.f, mk = 0.f, mbias = 0.f;
#pragma unroll 1
      for (int i = 0; i < 32; ++i) { mq = fmaxf(mq, fabsf(C.in[I_QN][l * 32 + i])); mk = fmaxf(mk, fabsf(C.in[I_KN][l * 32 + i])); }
#pragma unroll 1
      for (int i = 0; i < 128; ++i) mbias = fmaxf(mbias, C.in[I_RELB][i] - C.in[I_RELB][31 * 4 + (i & 3)]);
      mb = 1.02f * 1.4426950408889634f * 5.656854249492381f * mq * mk + 1.4426950408889634f * mbias; }
    unsigned* qw = (unsigned*)(C.ws + WS_CTL) + CW_QUEUE + 64 * qslot;
    volatile LAS int* slot = (volatile LAS int*)(C.lds + MISC_OFF + 64);
    if (blockIdx.x < IT_LA) { const int it = blockIdx.x; const int b = (it >> 2) & 3, h = it & 3; if (it < 16) la_chunked<64, true>(C, l, false, b, h); else la_chunked<32, false>(C, l, false, b, h); }
    for (;;) {
        if (tid == 0) slot[0] = (int)__hip_atomic_fetch_add(qw, 1u, __ATOMIC_RELAXED, __HIP_MEMORY_SCOPE_AGENT);
        __syncthreads();
        const int qi = slot[0];
        const int it = qi < 3 * DB * 8 ? ((qi % 3) ? IT_SS + 2 * (qi / 3) + (qi % 3) - 1 : IT_LA + qi / 3) : qi + IT_LA;
        __syncthreads();
        if (it >= IT_END) break;
        if (it < IT_SS) { const int i2 = it - IT_LA; attn_sample_item(C, l, i2 >> 3, i2 & 7); }
        else if (it < IT_AT) { const int i2 = it - IT_SS; attn_prompt_item(C, l, (i2 & 15) >> 2, i2 & 3, NQB_ATT - 1 - (i2 >> 4), lam, lam_init, mb); }
        else if (it < IT_LS) { const int i2 = (it - IT_AT) * 8 + wave; const int b = (i2 >> 2) & 31, h = i2 & 3; if (i2 < 128) la_seq<64, true>(C, l, true, b, h); else la_seq<32, false>(C, l, true, b, h); }
        else { conv_rows_item(C, l, it - IT_LS); conv_state_item(C, l, it - IT_LS, IT_CV - IT_LS); }
    }
}

template <int l> __device__ __forceinline__ void layer_fwd(const Ctx& C, const XcdBarrier& bar) {
#define GRID_BAR() xcd_barrier<false>(bar)
    LAS unsigned char* ring = C.lds + RING_OFF;
    float* SS = WSP(float, WS_SS); float* H = WSP(float, WS_H); bf16* HB = WSP(bf16, WS_HB); bf16* ACT = WSP(bf16, WS_ACT); bf16* ZMIX = WSP(bf16, WS_ZMIX); bf16* GATES = WSP(bf16, WS_GATES);
    bf16* BR = WSP(bf16, WS_BR); bf16* MERGED = WSP(bf16, WS_MERGED);
    constexpr float lam_init = l == 0 ? 0.2f : 0.35550906759096926f;
    constexpr bool last = (l == DEPTH - 1);
    { pg8::Gemm g{HB, WSP(bf16, WS_W1 + (size_t)(l * 2 + 0) * SZ_W1), D, D, D}; pg8::StaticOrder S; S.init(M, 2 * DFF, C.G, (int)blockIdx.x);
      EpiGLU E{ACT, SS + (size_t)(l * 3 + 0) * M * 16}; pg8::gemm_phase<EpiGLU, pg8::StaticOrder, true, true>(ring, g, S, E); }
    GRID_BAR();
    { pg8::HeadOrder S; S.init(M, D, C.G, (int)blockIdx.x); S.limit = C.G; EpiRes<false, 1> E{H, HB, SS + (size_t)(l * 3 + 1) * M * 16, nullptr};
      { pg8::Gemm g{ACT, WSP(bf16, WS_WD + (size_t)(l * 2 + 0) * SZ_WD), DFF, DFF, DFF}; pg8::gemm_phase<EpiRes<false, 1>, pg8::HeadOrder, true, true>(ring, g, S, E); }
      { int kt = DFF / 11; asm volatile("" : "+s"(kt)); pg8::Gemm g{ACT, WSP(bf16, WS_WD + (size_t)(l * 2 + 0) * SZ_WD), DFF, DFF, kt}; pg8::TailOrder T; T.init(M, D, C.G, (int)blockIdx.x); T.limit = C.G; T.nsplit = 11; T.kper = DFF / 11;
        EpiPartial EP{WSP(float, WS_KSP)}; pg8::gemm_phase<EpiPartial, pg8::TailOrder, true, true>(ring, g, T, EP); }
      GRID_BAR();
      ksp_finalize<11>(WSP(float, WS_KSP), S, C.G, E); }
    GRID_BAR();
    { pg8::Gemm g{HB, WSP(bf16, WS_WIN + (size_t)l * SZ_WIN), D, D, D}; pg8::StaticOrder S; S.init(M, NINP, C.G, (int)blockIdx.x);
      EpiZ E{ZMIX, GATES, SS + (size_t)(l * 3 + 1) * M * 16, WSP(float, WS_BINP) + l * NINP}; pg8::gemm_phase<EpiZ, pg8::StaticOrder, true, true>(ring, g, S, E); }
    GRID_BAR();
    n1_prep(C, l);
    GRID_BAR();
    n2_phase(C, l, lam_init, l);
    GRID_BAR();
    n3_attn_sample_combine(C, l, lam_init);
    n3_la_finalize(C, l);
    GRID_BAR();
    { pg8::Gemm g{BR, WSP(bf16, WS_WBR + (size_t)l * SZ_WBR), D, D, D}; pg8::StaticOrder S; S.init(M, D, C.G, (int)blockIdx.x);
      EpiMergeR E{MERGED, GATES}; pg8::gemm_phase<EpiMergeR, pg8::StaticOrder, true, true, 4>(ring, g, S, E); }
    GRID_BAR();
    { pg8::HeadOrder S; S.init(M, D, C.G, (int)blockIdx.x); S.limit = C.G; EpiRes<false, 2> E{H, HB, SS + (size_t)(l * 3 + 2) * M * 16, nullptr};
      { pg8::Gemm g{MERGED, WSP(bf16, WS_WOUT + (size_t)l * SZ_WOUT), D, D, D}; pg8::gemm_phase<EpiRes<false, 2>, pg8::HeadOrder, true, true>(ring, g, S, E); }
      { int kt = D / 4; asm volatile("" : "+s"(kt)); pg8::Gemm g{MERGED, WSP(bf16, WS_WOUT + (size_t)l * SZ_WOUT), D, D, kt}; pg8::TailOrder T; T.init(M, D, C.G, (int)blockIdx.x); T.limit = C.G; T.nsplit = 4; T.kper = D / 4;
        EpiPartial EP{WSP(float, WS_KSP)}; pg8::gemm_phase<EpiPartial, pg8::TailOrder, true, true>(ring, g, T, EP); }
      GRID_BAR();
      ksp_finalize<4>(WSP(float, WS_KSP), S, C.G, E); }
    GRID_BAR();
    { pg8::Gemm g{HB, WSP(bf16, WS_W1 + (size_t)(l * 2 + 1) * SZ_W1), D, D, D}; pg8::StaticOrder S; S.init(M, 2 * DFF, C.G, (int)blockIdx.x);
      EpiGLU E{ACT, SS + (size_t)(l * 3 + 2) * M * 16}; pg8::gemm_phase<EpiGLU, pg8::StaticOrder, true, true>(ring, g, S, E); }
    GRID_BAR();
    { pg8::HeadOrder S; S.init(M, D, C.G, (int)blockIdx.x); S.limit = C.G; EpiRes<last, 1> E{H, HB, last ? nullptr : SS + (size_t)((l + 1) * 3) * M * 16, C.out};
      { pg8::Gemm g{ACT, WSP(bf16, WS_WD + (size_t)(l * 2 + 1) * SZ_WD), DFF, DFF, DFF}; pg8::gemm_phase<EpiRes<last, 1>, pg8::HeadOrder, true, true>(ring, g, S, E); }
      { int kt = DFF / 11; asm volatile("" : "+s"(kt)); pg8::Gemm g{ACT, WSP(bf16, WS_WD + (size_t)(l * 2 + 1) * SZ_WD), DFF, DFF, kt}; pg8::TailOrder T; T.init(M, D, C.G, (int)blockIdx.x); T.limit = C.G; T.nsplit = 11; T.kper = DFF / 11;
        EpiPartial EP{WSP(float, WS_KSP)}; pg8::gemm_phase<EpiPartial, pg8::TailOrder, true, true>(ring, g, T, EP); }
      GRID_BAR();
      ksp_finalize<11>(WSP(float, WS_KSP), S, C.G, E); }
#undef GRID_BAR
}

__global__ void __launch_bounds__(NWAVES * 64, 2) fwd(Params P) {
    extern __shared__ __attribute__((aligned(16))) unsigned char lds[];
    Ctx C;
    C.in = P.in; C.out = P.out; C.ws = P.ws; C.lds = (LAS unsigned char*)lds;
    C.G = gridDim.x;
    volatile LAS unsigned* MISC = (volatile LAS unsigned*)(C.lds + MISC_OFF);
    for (int u = threadIdx.x; u < (LDS_BYTES - LDSCTL_OFF) / 4; u += NWAVES * 64) ((LAS unsigned*)(C.lds + LDSCTL_OFF))[u] = 0u;
    __syncthreads();
    unsigned* ctl = (unsigned*)(C.ws + WS_CTL);
    XcdBarrier bar = xcd_barrier_post(ctl + CW_BAR, MISC + 8);
    p0_prologue(C, P);
    xcd_barrier<true>(bar);
    layer_fwd<0>(C, bar);
    xcd_barrier<false>(bar);
    layer_fwd<1>(C, bar);
}

extern "C" void kernel_launch(void* const* d_in, const int* in_sizes, int n_in, void* d_out, int out_size, void* d_ws, size_t ws_size, hipStream_t stream) {
    static int grid = 0;
    if (grid == 0) {
        if (n_in != N_INPUTS || (size_t)out_size != O_END || ws_size < WS_END) { fprintf(stderr, "kernel_launch: unexpected shapes: n_in %d out %d (want %zu) ws %zu (want %zu)\n", n_in, out_size, (size_t)O_END, ws_size, (size_t)WS_END); grid = -1; return; }
        int dev = 0, cus = 0, per_cu = 0;
        if (hipGetDevice(&dev) != hipSuccess || hipDeviceGetAttribute(&cus, hipDeviceAttributeMultiprocessorCount, dev) != hipSuccess) { grid = -1; return; }
        if (hipFuncSetAttribute((const void*)fwd, hipFuncAttributeMaxDynamicSharedMemorySize, LDS_BYTES) != hipSuccess) { fprintf(stderr, "kernel_launch: hipFuncSetAttribute failed\n"); grid = -1; return; }
        if (hipOccupancyMaxActiveBlocksPerMultiprocessor(&per_cu, (const void*)fwd, NWAVES * 64, LDS_BYTES) != hipSuccess || per_cu < 1) { fprintf(stderr, "kernel_launch: occupancy query says %d blocks per CU\n", per_cu); }
        (void)hipGetLastError();
        grid = cus;
    }
    if (grid < 0) return;
    if (hipMemsetAsync((char*)d_ws + WS_CTL, 0, CTL_ZERO_BYTES, stream) != hipSuccess) return;
    Params p{};
    for (int i = 0; i < N_INPUTS; ++i) p.in[i] = (const float*)d_in[i];
    p.out = (float*)d_out; p.ws = (unsigned char*)d_ws;
    for (int i = 0; i < 32; ++i) p.inv_freq[i] = (float)pow(10000.0, -(double)i / 32.0);
    hipLaunchKernelGGL(fwd, dim3(grid), dim3(NWAVES * 64), LDS_BYTES, stream, p);
}
```

```cpp
#include <hip/hip_runtime.h>
#include <cstdio>
#include <cstdint>
#include <cmath>

namespace pg8 {
#define PG8_LAS __attribute__((address_space(3)))
typedef unsigned short bf16_t;
typedef short bf16x8 __attribute__((ext_vector_type(8)));
typedef float f32x4 __attribute__((ext_vector_type(4)));
typedef unsigned u32x4 __attribute__((ext_vector_type(4)));
constexpr int BM = 256, BK = 64, HALF = 128, HTB = HALF * BK * 2  , STAGE_BYTES = 8 * HTB, NXCD = 8, WGM = 8;

__host__ __device__ __forceinline__ int lds_byte(int r, int c) { const int st = (r >> 4) * 2 + (c >> 5), rr = r & 15, cc = c & 31, ob = rr * 64 + cc * 2; return st * 1024 + (ob ^ (((ob >> 9) & 1) << 5)); }
__host__ __device__ __forceinline__ void stage_rc(int b, int& R, int& C) { const int st = b / 1024, sb = b % 1024, swz = sb ^ (((sb >> 9) & 1) << 5); R = (st >> 1) * 16 + swz / 64; C = (st & 1) * 32 + (swz % 64) / 2; }
__host__ __device__ __forceinline__ int perm32(int rho) { const int n = rho >> 4, i = rho & 15; return 8 * (i >> 2) + 4 * n + (i & 3); }

struct Unit { int pm, pn, acol, bcol; };
struct Gemm { const bf16_t* A; const bf16_t* Bt; int lda, ldb, K, kseg0; };

struct StaticOrder {
    int nM, nN, nwg, G, c;
    __host__ __device__ void init(int M, int N, int G_, int c_) { nM = M / BM; nN = N / BM; nwg = nM * nN; G = G_; c = c_; }
    __host__ __device__ void unit_of(int L, Unit& u) const {
        int wgid = L; { const int q = nwg / NXCD, r = nwg % NXCD, xcd = wgid % NXCD, off = wgid / NXCD; wgid = (xcd < r ? xcd * (q + 1) : r * (q + 1) + (xcd - r) * q) + off; }
        const int nig = WGM * nN, gid = wgid / nig, fm = gid * WGM, gsz = (nM - fm) < WGM ? (nM - fm) : WGM;
        u.pm = fm + ((wgid % nig) % gsz); u.pn = (wgid % nig) / gsz; u.acol = 0; u.bcol = 0;
    }
    __host__ __device__ bool next(int i, Unit& u) const { const long L = (long)i * G + c; if (L >= nwg) return false; unit_of((int)L, u); return true; }
};
struct HeadOrder : StaticOrder { int limit; __host__ __device__ bool next(int i, Unit& u) const { const long L = (long)i * G + c; if (L >= limit || L >= nwg) return false; unit_of((int)L, u); return true; } };
struct TailOrder : StaticOrder { int limit, nsplit, kper;
    __host__ __device__ bool next(int i, Unit& u) const {
        if (i > 0 || c >= (nwg - limit) * nsplit) return false;
        unit_of(limit + c / nsplit, u); u.acol = u.bcol = (c % nsplit) * kper; return true; } };
__device__ __forceinline__ unsigned cvt_pk_bf16(float lo, float hi) { unsigned r; asm volatile("v_cvt_pk_bf16_f32 %0, %1, %2" : "=v"(r) : "v"(lo), "v"(hi)); return r; }

template <class Epi, class Sched, bool ALIGN_EPI = false, bool SP2 = false, int SEG = 0>
__device__ __forceinline__ void gemm_phase(PG8_LAS unsigned char* lds, const Gemm g, const Sched& S, const Epi& E) {
    int tid_ = threadIdx.x; asm volatile("" : "+v"(tid_));
    const int tid = tid_, wid = __builtin_amdgcn_readfirstlane(tid >> 6), lane = tid & 63, wr = wid >> 2, wc = wid & 3, fr = lane & 15, fq = lane >> 4;
    const int nt = g.K / BK;
    unsigned voffA[2], voffB[2];
#pragma unroll
    for (int i = 0; i < 2; ++i) { int R, C; stage_rc(tid * 16 + i * 8192, R, C); const int Rb = Epi::PERM ? ((R & ~31) + perm32(R & 31)) : R;
        voffA[i] = (unsigned)(R * g.lda + C) * 2u; voffB[i] = (unsigned)(Rb * g.ldb + C) * 2u; }
    const size_t kstep = (size_t)(BK * 2);
    const size_t hstepA = (size_t)HALF * g.lda * 2, hstepB = (size_t)HALF * g.ldb * 2;
    const size_t tstepA = 2 * hstepA, tstepB = 2 * hstepB;
    const unsigned ldsw = (unsigned)wid * 1024u;
    const int aoff = lds_byte(wr * 64 + fr, fq * 8), boff = lds_byte(wc * 32 + fr, fq * 8);
#define PG8_SA(b, h) (((b) * 2 + (h)) * HTB)
#define PG8_SB(b, h) ((4 + (b) * 2 + (h)) * HTB)
#define PG8_STAGE(bufoff, gbase, voff) do { _Pragma("unroll") for (int _i = 0; _i < 2; ++_i) \
        __builtin_amdgcn_global_load_lds((const unsigned*)((const char*)(gbase) + (voff)[_i]), (PG8_LAS unsigned*)(lds + (bufoff) + ldsw + _i * 8192), 16, 0, 0); } while (0)
#define PG8_LDA(dst, b, h) do { _Pragma("unroll") for (int m = 0; m < 4; ++m) _Pragma("unroll") for (int k = 0; k < 2; ++k) dst[m][k] = *(const PG8_LAS bf16x8*)(lds + PG8_SA(b, h) + aoff + m * 2048 + k * 1024); } while (0)
#define PG8_LDB(dst, b, h) do { _Pragma("unroll") for (int n = 0; n < 2; ++n) _Pragma("unroll") for (int k = 0; k < 2; ++k) dst[n][k] = *(const PG8_LAS bf16x8*)(lds + PG8_SB(b, h) + boff + n * 2048 + k * 1024); } while (0)
#define PG8_MMA(ai, bj, At, Bt) do { __builtin_amdgcn_s_setprio(1); _Pragma("unroll") for (int m = 0; m < 4; ++m) _Pragma("unroll") for (int n = 0; n < 2; ++n) _Pragma("unroll") for (int k = 0; k < 2; ++k) \
        acc[ai][bj][m][n] = __builtin_amdgcn_mfma_f32_16x16x32_bf16(Bt[n][k], At[m][k], acc[ai][bj][m][n], 0, 0, 0); __builtin_amdgcn_s_setprio(0); } while (0)
#define PG8_WAIT_V(n) asm volatile("s_waitcnt vmcnt(" #n ")" ::: "memory")
#define PG8_WAIT_L(n) asm volatile("s_waitcnt lgkmcnt(" #n ")" ::: "memory")
#define PG8_BAR __builtin_amdgcn_s_barrier()
#define PG8_SCHED __builtin_amdgcn_sched_barrier(0)
    Unit cur, nxt; int ui = 0;
    if (!S.next(0, cur)) return;
    f32x4 acc[2][2][4][2];
#pragma unroll
    for (int a = 0; a < 2; ++a)
#pragma unroll
        for (int b = 0; b < 2; ++b)
#pragma unroll
            for (int m = 0; m < 4; ++m)
#pragma unroll
                for (int n = 0; n < 2; ++n) acc[a][b][m][n] = (f32x4){0.f, 0.f, 0.f, 0.f};
    bf16x8 At[4][2], B0[2][2], B1[2][2];
    const char* cA = (const char*)g.A + (size_t)cur.pm * tstepA + (size_t)cur.acol * 2; const char* cB = (const char*)g.Bt + (size_t)cur.pn * tstepB + (size_t)cur.bcol * 2;
#define PG8_KOFF(t) ((SEG > 0) ? (size_t)(((((t) / (SEG > 0 ? SEG : 1)) + g.kseg0) & (nt / (SEG > 0 ? SEG : 1) - 1)) * (SEG > 0 ? SEG : 1) + ((t) % (SEG > 0 ? SEG : 1))) * kstep : (size_t)(t) * kstep)
    const size_t K0 = PG8_KOFF(0);
    cA += K0; cB += K0;
    if constexpr (SP2) {
        PG8_STAGE(PG8_SB(0, 0), cB, voffB); PG8_STAGE(PG8_SB(0, 1), cB + hstepB, voffB); PG8_STAGE(PG8_SA(0, 0), cA, voffA); PG8_STAGE(PG8_SA(0, 1), cA + hstepA, voffA);
        if (wr == 1) PG8_BAR;
        PG8_WAIT_V(2); PG8_BAR;
        PG8_STAGE(PG8_SB(1, 0), cB + kstep, voffB); PG8_STAGE(PG8_SA(1, 0), cA + kstep, voffA); PG8_STAGE(PG8_SB(1, 1), cB + hstepB + kstep, voffB);
        PG8_WAIT_V(6); PG8_BAR;
    } else {
        PG8_STAGE(PG8_SB(0, 0), cB, voffB); PG8_STAGE(PG8_SA(0, 0), cA, voffA); PG8_STAGE(PG8_SB(0, 1), cB + hstepB, voffB); PG8_STAGE(PG8_SA(0, 1), cA + hstepA, voffA);
        if (wr == 1) PG8_BAR;
        PG8_WAIT_V(4); PG8_BAR;
        PG8_STAGE(PG8_SB(1, 0), cB + kstep, voffB); PG8_STAGE(PG8_SA(1, 0), cA + kstep, voffA); PG8_STAGE(PG8_SB(1, 1), cB + hstepB + kstep, voffB);
        PG8_WAIT_V(6); PG8_BAR;
    }
    for (;;) {
        const bool has_next = S.next(ui + 1, nxt);
        const char* nA = has_next ? (const char*)g.A + (size_t)nxt.pm * tstepA + (size_t)nxt.acol * 2 + K0 : cA; const char* nB = has_next ? (const char*)g.Bt + (size_t)nxt.pn * tstepB + (size_t)nxt.bcol * 2 + K0 : cB;
        for (int t = 0; t < nt; t += 2) {
            const bool last = (t == nt - 2);
            const char* a1 = cA - K0 + PG8_KOFF(t + 1);
            const char* a2 = last ? nA : cA - K0 + PG8_KOFF(t + 2); const char* b2 = last ? nB : cB - K0 + PG8_KOFF(t + 2);
            const char* a3 = a2 + kstep; const char* b3 = b2 + kstep;
            if constexpr (SP2) {
            PG8_LDB(B0, 0, 0); PG8_LDB(B1, 0, 1); PG8_SCHED; PG8_LDA(At, 0, 0); PG8_STAGE(PG8_SA(1, 1), a1 + hstepA, voffA);
            PG8_WAIT_V(8); PG8_WAIT_L(0); PG8_BAR; PG8_MMA(0, 0, At, B0); PG8_MMA(0, 1, At, B1); PG8_BAR; PG8_SCHED;
            PG8_LDA(At, 0, 1); PG8_STAGE(PG8_SB(0, 0), b2, voffB); PG8_STAGE(PG8_SB(0, 1), b2 + hstepB, voffB); PG8_STAGE(PG8_SA(0, 0), a2, voffA);
            PG8_WAIT_V(8); PG8_WAIT_L(0); PG8_BAR; PG8_MMA(1, 0, At, B0); PG8_MMA(1, 1, At, B1); PG8_BAR; PG8_SCHED;
            PG8_LDB(B0, 1, 0); PG8_LDB(B1, 1, 1); PG8_SCHED; PG8_LDA(At, 1, 0); PG8_STAGE(PG8_SA(0, 1), a2 + hstepA, voffA);
            PG8_WAIT_V(8); PG8_WAIT_L(0); PG8_BAR; PG8_MMA(0, 0, At, B0); PG8_MMA(0, 1, At, B1); PG8_BAR; PG8_SCHED;
            PG8_LDA(At, 1, 1); PG8_STAGE(PG8_SB(1, 0), b3, voffB); PG8_STAGE(PG8_SB(1, 1), b3 + hstepB, voffB); PG8_STAGE(PG8_SA(1, 0), a3, voffA);
            PG8_WAIT_V(8); PG8_WAIT_L(0); PG8_BAR; PG8_MMA(1, 0, At, B0); PG8_MMA(1, 1, At, B1); PG8_BAR; PG8_SCHED;
            } else {
            PG8_LDB(B0, 0, 0); PG8_SCHED; PG8_LDA(At, 0, 0); PG8_STAGE(PG8_SA(1, 1), a1 + hstepA, voffA);
            PG8_WAIT_L(8); PG8_BAR; PG8_WAIT_L(0); PG8_MMA(0, 0, At, B0); PG8_BAR; PG8_SCHED;
            PG8_LDB(B1, 0, 1); PG8_STAGE(PG8_SB(0, 0), b2, voffB);
            PG8_BAR; PG8_WAIT_L(0); PG8_MMA(0, 1, At, B1); PG8_BAR;
            PG8_LDA(At, 0, 1); PG8_STAGE(PG8_SA(0, 0), a2, voffA);
            PG8_BAR; PG8_WAIT_L(0); PG8_MMA(1, 0, At, B0); PG8_BAR; PG8_SCHED;
            PG8_STAGE(PG8_SB(0, 1), b2 + hstepB, voffB);
            PG8_WAIT_V(6); PG8_BAR; PG8_MMA(1, 1, At, B1); PG8_BAR;
            PG8_LDB(B0, 1, 0); PG8_SCHED; PG8_LDA(At, 1, 0); PG8_STAGE(PG8_SA(0, 1), a2 + hstepA, voffA);
            PG8_WAIT_L(8); PG8_BAR; PG8_WAIT_L(0); PG8_MMA(0, 0, At, B0); PG8_BAR; PG8_SCHED;
            PG8_LDB(B1, 1, 1); PG8_STAGE(PG8_SB(1, 0), b3, voffB);
            PG8_BAR; PG8_WAIT_L(0); PG8_MMA(0, 1, At, B1); PG8_BAR;
            PG8_LDA(At, 1, 1); PG8_STAGE(PG8_SA(1, 0), a3, voffA);
            PG8_BAR; PG8_WAIT_L(0); PG8_MMA(1, 0, At, B0); PG8_BAR; PG8_SCHED;
            PG8_STAGE(PG8_SB(1, 1), b3 + hstepB, voffB);
            PG8_WAIT_V(6); PG8_BAR; PG8_MMA(1, 1, At, B1); PG8_BAR;
            }
            if constexpr (SEG > 0) { if (((t + 2) % SEG) == 0 && (t + 2) < nt) E.mid(acc, cur, (t + 2) / SEG, g.kseg0); }
        }
        if constexpr (ALIGN_EPI) { if (wr == 0) PG8_BAR; }
        E(acc, cur, wr, wc, fr, fq);
        if (!has_next) break;
#pragma unroll
        for (int a = 0; a < 2; ++a)
#pragma unroll
            for (int b = 0; b < 2; ++b)
#pragma unroll
                for (int m = 0; m < 4; ++m)
#pragma unroll
                    for (int n = 0; n < 2; ++n) acc[a][b][m][n] = (f32x4){0.f, 0.f, 0.f, 0.f};
        cur = nxt; cA = nA; cB = nB; ++ui;
        if constexpr (ALIGN_EPI) { if (wr == 1) PG8_BAR; }
    }
    PG8_WAIT_V(0);
    if constexpr (!ALIGN_EPI) { if (wr == 0) PG8_BAR; }
    PG8_BAR;
#undef PG8_KOFF
#undef PG8_SA
#undef PG8_SB
#undef PG8_STAGE
#undef PG8_LDA
#undef PG8_LDB
#undef PG8_MMA
#undef PG8_WAIT_V
#undef PG8_WAIT_L
#undef PG8_BAR
#undef PG8_SCHED
}
}

constexpr int NWAVES = 8;
constexpr int D = 1024, DFF = 2816, NIN = 7184, NMIX = 3088, NMIXP = 3328, NGATE = 4096, NINP = NMIXP + NGATE;
constexpr int SEQ = 4096, NMETA = 16, L = SEQ + NMETA, BATCH = 4, DB = 32, DS = 8, PAST = 8192, PAGE = 128, NPAGES = PAST / PAGE, NPOOL = 2560, DEPTH = 2;
constexpr int MP = BATCH * L, MS = DB * DS, MR = MP + MS, M = 16896;
constexpr int NPOS = L + DS;
constexpr float EPS = 1e-6f;
constexpr int C_A = 0, C_G = 256, R_Q = 512, R_K = 768, R_V = 1024, R_G = 1280, G_Q = 1536, G_K = 1664, G_V = 1792, G_R = 2048, G_LOW = 2304, D_Q = 2320, D_K = 2576, D_V = 2832;
constexpr size_t O_YP = 0, O_YS = O_YP + (size_t)BATCH * SEQ * D, O_KP = O_YS + (size_t)MS * D, O_VP = O_KP + (size_t)DEPTH * MP * 256, O_KS = O_VP + (size_t)DEPTH * MP * 256,
                 O_VS = O_KS + (size_t)DEPTH * MS * 256, O_RP = O_VS + (size_t)DEPTH * MS * 256, O_RS = O_RP + (size_t)DEPTH * BATCH * 4 * 64 * 64, O_GP = O_RS + (size_t)DEPTH * DB * 4 * 64 * 64,
                 O_GS = O_GP + (size_t)DEPTH * BATCH * 4 * 32 * 64, O_CP = O_GS + (size_t)DEPTH * DB * 4 * 32 * 64, O_CS = O_CP + (size_t)DEPTH * BATCH * 30 * 256, O_END = O_CS + (size_t)DEPTH * DB * 30 * 256;
enum { I_XP = 0, I_XS, I_CK, I_CV, I_PT, I_SRET, I_SGLA, I_SCONV, I_META, I_RELB, I_NF1, I_F1G, I_F1U, I_F1D, I_NMIX, I_WIN, I_BIN, I_CW, I_CB, I_CLG, I_CLB, I_RGN, I_GAW, I_GAB, I_GGN,
       I_QN, I_KN, I_LQ1, I_LK1, I_LQ2, I_LK2, I_SUBLN, I_WBR, I_WOUT, I_NF2, I_F2G, I_F2U, I_F2D, N_INPUTS };

constexpr size_t MiB = 1u << 20;
constexpr size_t WS_CTL = 0, CTL_ZERO_BYTES = 64 * 1024;
constexpr size_t SZ_SS = (size_t)M * 16 * 4;
constexpr size_t SZ_W1 = (size_t)2 * DFF * D * 2, SZ_WD = (size_t)D * DFF * 2, SZ_WIN = (size_t)NINP * D * 2, SZ_WBR = (size_t)4 * D * 256 * 2, SZ_WOUT = (size_t)D * D * 2;
constexpr size_t WS_W1 = 4 * MiB;
constexpr size_t WS_WD = WS_W1 + 4 * SZ_W1;
constexpr size_t WS_WIN = WS_WD + 4 * SZ_WD;
constexpr size_t WS_WBR = WS_WIN + 2 * SZ_WIN;
constexpr size_t WS_WOUT = WS_WBR + 2 * SZ_WBR;
constexpr size_t WS_BINP = WS_WOUT + 2 * SZ_WOUT;
constexpr size_t WS_ROPE = WS_BINP + 64 * 1024;
constexpr size_t WS_SS = WS_ROPE + 2 * MiB;
constexpr size_t WS_H = 128 * MiB;
constexpr size_t WS_HB = WS_H + (size_t)M * D * 4;
constexpr size_t WS_ACT = WS_HB + (size_t)M * D * 2;
constexpr size_t WS_ZMIX = WS_ACT + (size_t)M * DFF * 2;
constexpr size_t WS_GATES = WS_ZMIX + (size_t)M * NMIXP * 2;
constexpr size_t WS_BR = WS_GATES + (size_t)M * NGATE * 2;
constexpr size_t WS_MERGED = WS_BR + (size_t)M * D * 2;
constexpr size_t WS_UBUF = WS_MERGED + (size_t)M * D * 2;
constexpr size_t WS_RQ = WS_UBUF + (size_t)M * 256 * 4, WS_RK = WS_RQ + (size_t)M * 256 * 4, WS_QN = WS_RK + (size_t)M * 256 * 4, WS_KN = WS_QN + (size_t)M * 256 * 4, WS_VB = WS_KN + (size_t)M * 256 * 4;
constexpr size_t WS_LDEC = WS_VB + (size_t)M * 256 * 4;
constexpr size_t WS_QNB = WS_LDEC + (size_t)M * 128 * 4;
constexpr size_t WS_KNB = WS_QNB + (size_t)M * 256 * 2;
constexpr size_t WS_PART = WS_KNB + (size_t)M * 256 * 2;
constexpr size_t WS_LAO = WS_PART + (size_t)DB * 4 * 16 * 16 * 68 * 4;
constexpr size_t WS_KSP = WS_LAO + (size_t)M * 512 * 4;
constexpr size_t WS_END = WS_KSP + (size_t)8 * 11 * 65536 * 4;
static_assert(WS_ROPE + 2 * NPOS * 32 * 4 <= WS_SS && WS_SS + 6 * SZ_SS <= WS_H, "weights region overflows");
constexpr int CW_BAR = 4096, CW_QUEUE = 8192;

constexpr int RING_OFF = 0, RING_BYTES = 131072;
constexpr int LDSCTL_OFF = 144384, MISC_OFF = LDSCTL_OFF + 320;
constexpr int LDS_BYTES = 147456;
static_assert(MISC_OFF + 128 <= LDS_BYTES, "LDS map");

#define GAS __attribute__((address_space(1)))
#define LAS __attribute__((address_space(3)))
typedef unsigned short bf16;
typedef unsigned v4u __attribute__((ext_vector_type(4)));
typedef float f32x4 __attribute__((ext_vector_type(4)));
#define LDS_WAIT() asm volatile("s_waitcnt lgkmcnt(0)" ::: "memory")
#define VM_WAIT() asm volatile("s_waitcnt vmcnt(0)" ::: "memory")
__device__ __forceinline__ unsigned f2bf(float f) { unsigned u = __builtin_bit_cast(unsigned, f); return (u + 0x7fffu + ((u >> 16) & 1u)) >> 16; }
__device__ __forceinline__ unsigned pk2(float lo, float hi) { return f2bf(lo) | (f2bf(hi) << 16); }
__device__ __forceinline__ float bf2f(bf16 b) { return __builtin_bit_cast(float, ((unsigned)b) << 16); }
__device__ __forceinline__ float bflo(unsigned w) { return __builtin_bit_cast(float, w << 16); }
__device__ __forceinline__ float bfhi(unsigned w) { return __builtin_bit_cast(float, w & 0xffff0000u); }
__device__ __forceinline__ float wave_sum(float v) {
#pragma unroll
    for (int o = 1; o < 64; o <<= 1) v += __shfl_xor(v, o);
    return v;
}
__device__ __forceinline__ float sigmoidf_(float x) { return __builtin_amdgcn_rcpf(1.0f + __expf(-x)); }
__device__ __forceinline__ float siluf_(float x) { return x * __builtin_amdgcn_rcpf(1.0f + __expf(-x)); }

#define XB_TMO      128
#define XB_XCNT(j)  (256  + 64 * (j))
#define XB_XSUB(j)  (1280 + 64 * (j))
#define XB_XGEN(j)  (2304 + 64 * (j))
#define XB_TOP      3328
#define XB_TOPGEN   3392
#define XCD_BAR_WORDS 3456
#define XB_SPIN_CAP (1u << 22)

__device__ __forceinline__ unsigned xb_ld(unsigned* p)              { return __hip_atomic_load(p, __ATOMIC_RELAXED, __HIP_MEMORY_SCOPE_AGENT); }
__device__ __forceinline__ unsigned xb_add(unsigned* p, unsigned v) { return __hip_atomic_fetch_add(p, v, __ATOMIC_RELAXED, __HIP_MEMORY_SCOPE_AGENT); }
__device__ __forceinline__ unsigned xb_xcc_id() { return (unsigned)__builtin_amdgcn_s_getreg((3 << 11) | 20) & 0xFu; }
#define XB_SPIN(cond, bar) do { unsigned _sp = 0; while (cond) { __builtin_amdgcn_s_sleep(1); \
    if ((++_sp & 255u) == 0u) { if (xb_ld(&(bar)[XB_TMO])) break; if (_sp > XB_SPIN_CAP) { atomicAdd(&(bar)[XB_TMO], 1u); break; } } } } while (0)

struct XcdBarrier { unsigned* bar; unsigned x; volatile LAS unsigned* st; };

__device__ __forceinline__ XcdBarrier xcd_barrier_post(unsigned* bar, volatile LAS unsigned* st) {
    XcdBarrier b; b.bar = bar; b.x = xb_xcc_id(); b.st = st;
    if (threadIdx.x == 0) (void)xb_add(&bar[XB_XCNT(b.x)], 1u);
    return b;
}
__device__ __forceinline__ void xcd_barrier_complete(unsigned* bar, unsigned x, unsigned& nloc, unsigned& nx) {
    const unsigned G = gridDim.x * gridDim.y * gridDim.z;
    unsigned sum, cnt, mine, sp = 0u;
    for (;;) {
        sum = 0u; cnt = 0u; mine = 0u;
#pragma unroll
        for (unsigned j = 0; j < 16; ++j) { const unsigned c = xb_ld(&bar[XB_XCNT(j)]); sum += c; cnt += (c > 0u) ? 1u : 0u; mine = (j == x) ? c : mine; }
        if (sum == G) break;
        __builtin_amdgcn_s_sleep(1);
        if ((++sp & 255u) == 0u) { if (xb_ld(&bar[XB_TMO])) break; if (sp > XB_SPIN_CAP) { atomicAdd(&bar[XB_TMO], 1u); break; } }
    }
    nloc = mine > 0u ? mine : 1u; nx = cnt > 0u ? cnt : 1u;
}
#ifndef FLAT_BAR
#define FLAT_BAR 0
#endif
__device__ __forceinline__ void flat_barrier(const XcdBarrier& b) {
    asm volatile("s_waitcnt vmcnt(0)" ::: "memory");
    __syncthreads();
    if (threadIdx.x == 0) {
        unsigned* bar = b.bar;
        asm volatile("" : "+s"(bar));
        const unsigned epoch = b.st[2] + 1u; b.st[2] = epoch; const unsigned target = epoch * gridDim.x;
        __builtin_amdgcn_fence(__ATOMIC_RELEASE, "agent");
        asm volatile("s_waitcnt vmcnt(0)" ::: "memory");
        (void)xb_add(&bar[XB_TOP], 1u);
        unsigned sp = 0u;
        while (xb_ld(&bar[XB_TOP]) < target) { __builtin_amdgcn_s_sleep(1); if ((++sp & 255u) == 0u) { if (xb_ld(&bar[XB_TMO])) break; if (sp > XB_SPIN_CAP) { atomicAdd(&bar[XB_TMO], 1u); break; } } }
        __builtin_amdgcn_fence(__ATOMIC_ACQUIRE, "agent");
        asm volatile("s_waitcnt vmcnt(0)" ::: "memory");
    }
    __syncthreads();
}
template <bool FIRST> __device__ __forceinline__ void xcd_barrier(const XcdBarrier& b) {
    if (FLAT_BAR) { flat_barrier(b); return; }
    asm volatile("s_waitcnt vmcnt(0)" ::: "memory");
    __syncthreads();
    if (threadIdx.x == 0) {
        unsigned* bar = b.bar;
        asm volatile("" : "+s"(bar));
        __builtin_amdgcn_s_waitcnt(0);
        unsigned nloc = b.st[0], nx = b.st[1];
        if (FIRST) { if (nloc == 0u) { xcd_barrier_complete(bar, b.x, nloc, nx); b.st[0] = nloc; b.st[1] = nx; } }
        const unsigned old = xb_add(&bar[XB_XSUB(b.x)], 1u);
        const unsigned gen = old / nloc;
        if (old + 1u == (gen + 1u) * nloc) {
            __builtin_amdgcn_fence(__ATOMIC_RELEASE, "agent");
            asm volatile("s_waitcnt vmcnt(0)" ::: "memory");
            const unsigned og = xb_add(&bar[XB_TOP], 1u);
            const unsigned tg = og / nx;
            if (og + 1u == (tg + 1u) * nx) {
#pragma unroll
                for (unsigned j = 0; j < 16; ++j) (void)__hip_atomic_fetch_add(&bar[XB_XGEN(j)], 1u, __ATOMIC_RELAXED, __HIP_MEMORY_SCOPE_AGENT);
            }
        }
        XB_SPIN(xb_ld(&bar[XB_XGEN(b.x)]) == gen, bar);
        __builtin_amdgcn_fence(__ATOMIC_ACQUIRE, "agent");
        asm volatile("s_waitcnt vmcnt(0)" ::: "memory");
    }
    __syncthreads();
}

struct Params { const float* in[N_INPUTS]; float* out; unsigned char* ws; float inv_freq[32]; };
static_assert(sizeof(Params) == N_INPUTS * 8 + 16 + 128, "Params has no padding");

struct Ctx {
    const float* const* in; float* out; unsigned char* ws;
    LAS unsigned char* lds;
    int G;
};
#define THREAD_IDS() int tid_ = threadIdx.x; asm volatile("" : "+v"(tid_)); const int tid = tid_, lane = tid & 63, wave = __builtin_amdgcn_readfirstlane(tid >> 6), gw = blockIdx.x * NWAVES + wave, NGW = C.G * NWAVES; (void)tid; (void)lane; (void)wave; (void)gw; (void)NGW
#define WSP(T, off) ((T*)(C.ws + (off)))

__device__ __forceinline__ float rstd_of(const float* ssp, int row) {
    const f32x4 a = *(const f32x4*)(ssp + (size_t)row * 16), b = *(const f32x4*)(ssp + (size_t)row * 16 + 4), c = *(const f32x4*)(ssp + (size_t)row * 16 + 8), d = *(const f32x4*)(ssp + (size_t)row * 16 + 12);
    const float s = (((a[0] + a[1]) + (a[2] + a[3])) + ((b[0] + b[1]) + (b[2] + b[3]))) + (((c[0] + c[1]) + (c[2] + c[3])) + ((d[0] + d[1]) + (d[2] + d[3])));
    return rsqrtf(s * (1.0f / D) + EPS);
}
__device__ __forceinline__ void rstd8(const float* ssp, int row0, int fq, float (&rs)[8]) {
    f32x4 sv[8];
#pragma unroll
    for (int i = 0; i < 8; ++i) sv[i] = *(const f32x4*)(ssp + (size_t)(row0 + (i >> 2) * 128 + (i & 3) * 16) * 16 + 4 * fq);
#pragma unroll
    for (int i = 0; i < 8; ++i) { float s = (sv[i][0] + sv[i][1]) + (sv[i][2] + sv[i][3]); s += __shfl_xor(s, 16); s += __shfl_xor(s, 32); rs[i] = rsqrtf(s * (1.0f / D) + EPS); }
}
#define EPI_IDS() int t_ = threadIdx.x; asm volatile("" : "+v"(t_)); const int wid_ = __builtin_amdgcn_readfirstlane(t_ >> 6), wr = wid_ >> 2, wc = wid_ & 3, fr = t_ & 15, fq = (t_ & 63) >> 4
struct EpiGLU {
    static constexpr bool PERM = true;
    bf16* act; const float* ss;
    __device__ __forceinline__ void operator()(const pg8::f32x4 (&acc)[2][2][4][2], const pg8::Unit& u, int, int, int, int) const {
        EPI_IDS();
        const int row0 = u.pm * 256 + wr * 64 + fr, col0 = u.pn * 128 + wc * 32 + 8 * fq;
        float rs[8]; rstd8(ss, row0, fq, rs);
#pragma unroll
        for (int ai = 0; ai < 2; ++ai)
#pragma unroll
            for (int m = 0; m < 4; ++m) {
                const int row = row0 + ai * 128 + m * 16; const float rstd = rs[ai * 4 + m];
                float o[8];
#pragma unroll
                for (int n = 0; n < 2; ++n)
#pragma unroll
                    for (int j = 0; j < 4; ++j) { const float g = acc[ai][0][m][n][j] * rstd, up = acc[ai][1][m][n][j] * rstd; o[n * 4 + j] = siluf_(g) * up; }
                v4u w; w.x = pg8::cvt_pk_bf16(o[0], o[1]); w.y = pg8::cvt_pk_bf16(o[2], o[3]); w.z = pg8::cvt_pk_bf16(o[4], o[5]); w.w = pg8::cvt_pk_bf16(o[6], o[7]);
                *(v4u*)(act + (size_t)row * DFF + col0) = w;
            }
    }
};
template <bool FINAL, int SCALE2> struct EpiRes {
    static constexpr bool PERM = true;
    float* h; bf16* hb; float* ssout; float* out;
    __device__ __forceinline__ void rowgroup(const pg8::f32x4 (&a)[2][2], int row, int col0, int pn, int wc, int fq) const {
        constexpr float scale = 0.5f * SCALE2; float sq = 0.f;
        long yoff = -1;
        if (FINAL) { if (row < MP) { const int b = row / L, pos = row - b * L; if (pos >= NMETA) yoff = (long)O_YP + ((long)b * SEQ + (pos - NMETA)) * D; } else if (row < MR) yoff = (long)O_YS + (long)(row - MP) * D; }
#pragma unroll
        for (int bj = 0; bj < 2; ++bj) {
            const size_t off = (size_t)row * D + col0 + bj * 128;
            const v4u hw = *(const v4u*)(hb + off);
            f32x4 h0 = (f32x4){bflo(hw.x), bfhi(hw.x), bflo(hw.y), bfhi(hw.y)}, h1 = (f32x4){bflo(hw.z), bfhi(hw.z), bflo(hw.w), bfhi(hw.w)};
            h0 = h0 + a[bj][0] * scale; h1 = h1 + a[bj][1] * scale;
            v4u w; w.x = pg8::cvt_pk_bf16(h0[0], h0[1]); w.y = pg8::cvt_pk_bf16(h0[2], h0[3]); w.z = pg8::cvt_pk_bf16(h1[0], h1[1]); w.w = pg8::cvt_pk_bf16(h1[2], h1[3]);
            *(v4u*)(hb + off) = w;
            sq += (h0[0] * h0[0] + h0[1] * h0[1]) + (h0[2] * h0[2] + h0[3] * h0[3]) + (h1[0] * h1[0] + h1[1] * h1[1]) + (h1[2] * h1[2] + h1[3] * h1[3]);
            if (FINAL && yoff >= 0) { *(f32x4*)(out + yoff + col0 + bj * 128) = h0; *(f32x4*)(out + yoff + col0 + bj * 128 + 4) = h1; }
        }
        sq += __shfl_xor(sq, 16); sq += __shfl_xor(sq, 32);
        if (fq == 0 && ssout) ssout[(size_t)row * 16 + pn * 4 + wc] = sq;
    }
    __device__ __forceinline__ void operator()(const pg8::f32x4 (&acc)[2][2][4][2], const pg8::Unit& u, int, int, int, int) const {
        EPI_IDS();
        const int row0 = u.pm * 256 + wr * 64 + fr, col0 = u.pn * 256 + wc * 32 + 8 * fq;
#pragma unroll
        for (int ai = 0; ai < 2; ++ai)
#pragma unroll
            for (int m = 0; m < 4; ++m) {
                const pg8::f32x4 a[2][2] = {{acc[ai][0][m][0], acc[ai][0][m][1]}, {acc[ai][1][m][0], acc[ai][1][m][1]}};
                rowgroup(a, row0 + ai * 128 + m * 16, col0, u.pn, wc, fq);
                if (m == 3) asm volatile("" ::: "memory");
            }
    }
};
struct EpiZ {
    static constexpr bool PERM = true;
    bf16* zmix; bf16* gates; const float* ss; const float* bias;
    __device__ __forceinline__ void operator()(const pg8::f32x4 (&acc)[2][2][4][2], const pg8::Unit& u, int, int, int, int) const {
        EPI_IDS();
        const int row0 = u.pm * 256 + wr * 64 + fr, col0 = u.pn * 256 + wc * 32 + 8 * fq; const bool isgate = u.pn >= NMIXP / 256;
        f32x4 bv[2][2];
#pragma unroll
        for (int bj = 0; bj < 2; ++bj)
#pragma unroll
            for (int n = 0; n < 2; ++n) bv[bj][n] = *(const f32x4*)(bias + col0 + bj * 128 + 4 * n);
        float rs[8]; rstd8(ss, row0, fq, rs);
#pragma unroll
        for (int ai = 0; ai < 2; ++ai)
#pragma unroll
            for (int m = 0; m < 4; ++m) {
                const int row = row0 + ai * 128 + m * 16; const float rstd = rs[ai * 4 + m];
                if (isgate) {
                    f32x4 g[4];
#pragma unroll
                    for (int bj = 0; bj < 2; ++bj)
#pragma unroll
                        for (int n = 0; n < 2; ++n) { const f32x4 z = acc[ai][bj][m][n] * rstd + bv[bj][n];
#pragma unroll
                            for (int j = 0; j < 4; ++j) g[2 * bj + n][j] = fmaxf(sigmoidf_(z[j]), 9.094947017729282e-13f); }
                    const int d0 = 64 * (u.pn - NMIXP / 256) + 16 * wc + 4 * fq; bf16* gp = gates + (size_t)row * NGATE + d0;
#pragma unroll
                    for (int s = 0; s < 4; ++s) { f32x4 o = g[s];
                        if (s < 3) {
#pragma unroll
                            for (int j = 0; j < 4; ++j) o[j] = g[s][j] * __builtin_amdgcn_rcpf(g[s + 1][j]); }
                        *(unsigned long long*)(gp + s * D) = (unsigned long long)pg8::cvt_pk_bf16(o[0], o[1]) | ((unsigned long long)pg8::cvt_pk_bf16(o[2], o[3]) << 32); }
                } else {
#pragma unroll
                    for (int bj = 0; bj < 2; ++bj) {
                        const f32x4 v0 = acc[ai][bj][m][0] * rstd + bv[bj][0], v1 = acc[ai][bj][m][1] * rstd + bv[bj][1];
                        v4u w; w.x = pg8::cvt_pk_bf16(v0[0], v0[1]); w.y = pg8::cvt_pk_bf16(v0[2], v0[3]); w.z = pg8::cvt_pk_bf16(v1[0], v1[1]); w.w = pg8::cvt_pk_bf16(v1[2], v1[3]);
                        *(v4u*)(zmix + (size_t)row * NMIXP + col0 + bj * 128) = w;
                    }
                }
            }
    }
};
struct EpiPartial {
    static constexpr bool PERM = true;
    float* part;
    __device__ __forceinline__ void operator()(const pg8::f32x4 (&acc)[2][2][4][2], const pg8::Unit& u, int, int, int, int) const {
        int t_ = threadIdx.x; asm volatile("" : "+v"(t_));
        const int slot = blockIdx.x;
        float* p = part + (size_t)slot * 65536 + (size_t)t_ * 4;
#pragma unroll
        for (int ai = 0; ai < 2; ++ai)
#pragma unroll
            for (int bj = 0; bj < 2; ++bj)
#pragma unroll
                for (int m = 0; m < 4; ++m)
#pragma unroll
                    for (int n = 0; n < 2; ++n) *(pg8::f32x4*)(p + (size_t)((((ai * 2 + bj) * 4 + m) * 2 + n) * 2048)) = acc[ai][bj][m][n];
        (void)u;
    }
};
template <int NSPLIT, class Epi> __device__ __forceinline__ void ksp_finalize(const float* part, const pg8::StaticOrder& so, int limit, const Epi& E) {
    const int ntail = so.nwg - limit;
    for (int it = blockIdx.x; it < ntail * 8; it += gridDim.x) {
        const int tt = it >> 3, ai = (it >> 2) & 1, m = it & 3;
        EPI_IDS();
        pg8::f32x4 a[2][2];
#pragma unroll
        for (int bj = 0; bj < 2; ++bj)
#pragma unroll
            for (int n = 0; n < 2; ++n) { pg8::f32x4 s = {0.f, 0.f, 0.f, 0.f};
#pragma unroll
                for (int k = 0; k < NSPLIT; ++k) s = s + *(const pg8::f32x4*)(part + (size_t)(tt * NSPLIT + k) * 65536 + (size_t)((((ai * 2 + bj) * 4 + m) * 2 + n) * 2048) + (size_t)t_ * 4);
                a[bj][n] = s; }
        pg8::Unit u; so.unit_of(limit + tt, u);
        E.rowgroup(a, u.pm * 256 + wr * 64 + fr + ai * 128 + m * 16, u.pn * 256 + wc * 32 + 8 * fq, u.pn, wc, fq);
    }
}

struct EpiMergeR {
    static constexpr bool PERM = true;
    bf16* merged; const bf16* gates;
    __device__ __forceinline__ void mid(pg8::f32x4 (&acc)[2][2][4][2], const pg8::Unit& u, int seg, int) const {
        EPI_IDS();
        const int row0 = u.pm * 256 + wr * 64 + fr, col0 = u.pn * 256 + wc * 32 + 8 * fq;
#pragma unroll
        for (int ai = 0; ai < 2; ++ai) {
#pragma unroll
            for (int m = 0; m < 4; ++m) {
                const int row = row0 + ai * 128 + m * 16;
#pragma unroll
                for (int bj = 0; bj < 2; ++bj) {
                    const v4u r = *(const v4u*)(gates + (size_t)row * NGATE + (seg - 1) * D + col0 + bj * 128);
                    pg8::f32x4& a0 = acc[ai][bj][m][0]; pg8::f32x4& a1 = acc[ai][bj][m][1];
                    a0[0] *= bflo(r.x); a0[1] *= bfhi(r.x); a0[2] *= bflo(r.y); a0[3] *= bfhi(r.y); a1[0] *= bflo(r.z); a1[1] *= bfhi(r.z); a1[2] *= bflo(r.w); a1[3] *= bfhi(r.w);
                }
            }
        }
    }
    __device__ __forceinline__ void operator()(const pg8::f32x4 (&acc)[2][2][4][2], const pg8::Unit& u, int, int, int, int) const {
        EPI_IDS();
        const int row0 = u.pm * 256 + wr * 64 + fr, col0 = u.pn * 256 + wc * 32 + 8 * fq;
#pragma unroll
        for (int ai = 0; ai < 2; ++ai)
#pragma unroll
            for (int m = 0; m < 4; ++m) {
                const int row = row0 + ai * 128 + m * 16;
#pragma unroll
                for (int bj = 0; bj < 2; ++bj) {
                    const v4u g = *(const v4u*)(gates + (size_t)row * NGATE + 3 * D + col0 + bj * 128);
                    const pg8::f32x4 a0 = acc[ai][bj][m][0], a1 = acc[ai][bj][m][1];
                    v4u w; w.x = pg8::cvt_pk_bf16(a0[0] * bflo(g.x), a0[1] * bfhi(g.x)); w.y = pg8::cvt_pk_bf16(a0[2] * bflo(g.y), a0[3] * bfhi(g.y));
                    w.z = pg8::cvt_pk_bf16(a1[0] * bflo(g.z), a1[1] * bfhi(g.z)); w.w = pg8::cvt_pk_bf16(a1[2] * bflo(g.w), a1[3] * bfhi(g.w));
                    *(v4u*)(merged + (size_t)row * D + col0 + bj * 128) = w;
                }
            }
    }
};

__host__ __device__ __forceinline__ int gate_col(int m) { const int br = m >> 10, d = m & 1023, dd = d & 63; return 256 * (d >> 6) + 128 * (br >> 1) + 32 * (dd >> 4) + 8 * ((dd >> 2) & 3) + 4 * (br & 1) + (dd & 3); }
__host__ __device__ __forceinline__ int gate_src(int c) { const int ct = c & 255, br = 2 * (ct >> 7) + ((ct >> 2) & 1), d = 64 * (c >> 8) + 16 * ((ct >> 5) & 3) + 4 * ((ct >> 3) & 3) + (ct & 3); return br * 1024 + d; }
struct RowMap { int mode, a; __device__ __forceinline__ int operator()(int n) const { return mode == 0 ? n + a : (mode == 1 ? 256 * (n >> 7) + (n & 127) + a : (n < NMIX ? n : NMIXP + gate_col(n - NMIX))); } };
__device__ __forceinline__ void tr_item(const float* W, int K, int N, const float* gain, bf16* WT, int pitch, RowMap rm, LAS float* scr, int kb, int nb, int lane) {
    const int k0 = 64 * kb, n0 = 64 * nb; const int nn = n0 + 4 * (lane & 15), kr = lane >> 4;
    f32x4 v[16];
#pragma unroll
    for (int i = 0; i < 16; ++i) v[i] = (nn < N) ? *(const f32x4*)(W + (size_t)(k0 + 4 * i + kr) * N + nn) : (f32x4){0.f, 0.f, 0.f, 0.f};
#pragma unroll
    for (int i = 0; i < 16; ++i) { const int kk = 4 * i + kr; const float g = gain ? gain[k0 + kk] : 1.0f; LAS float* d = scr + kk * 65 + 4 * (lane & 15); d[0] = v[i][0] * g; d[1] = v[i][1] * g; d[2] = v[i][2] * g; d[3] = v[i][3] * g; }
    LDS_WAIT(); asm volatile("" ::: "memory");
    const int c = lane & 7;
#pragma unroll
    for (int j = 0; j < 8; ++j) { const int nl = (lane >> 3) + 8 * j; const int n = n0 + nl; const LAS float* s = scr + (8 * c) * 65 + nl;
        v4u o; o.x = pg8::cvt_pk_bf16(s[0 * 65], s[1 * 65]); o.y = pg8::cvt_pk_bf16(s[2 * 65], s[3 * 65]); o.z = pg8::cvt_pk_bf16(s[4 * 65], s[5 * 65]); o.w = pg8::cvt_pk_bf16(s[6 * 65], s[7 * 65]);
        if (n < N) *(v4u*)(WT + (size_t)rm(n) * pitch + k0 + 8 * c) = o; }
    LDS_WAIT(); asm volatile("" ::: "memory");
}
__device__ __forceinline__ void p0_prologue(const Ctx& C, const Params& P) {
    THREAD_IDS();
    LAS float* scr = (LAS float*)(C.lds + RING_OFF + wave * 16896);
    constexpr int I_FF = 16 * 44, I_DN = 44 * 16, I_IN = 16 * 113, I_BR = 4 * 4 * 16, I_OUT = 16 * 16;
    constexpr int PER_LAYER = 4 * I_FF + 2 * I_DN + I_IN + I_BR + I_OUT;
    for (int it = gw; it < DEPTH * PER_LAYER; it += NGW) {
        const int l = it / PER_LAYER; int r = it - l * PER_LAYER;
        bf16* W1a = WSP(bf16, WS_W1 + (size_t)(l * 2 + 0) * SZ_W1); bf16* W1b = WSP(bf16, WS_W1 + (size_t)(l * 2 + 1) * SZ_W1);
        bf16* Wda = WSP(bf16, WS_WD + (size_t)(l * 2 + 0) * SZ_WD); bf16* Wdb = WSP(bf16, WS_WD + (size_t)(l * 2 + 1) * SZ_WD);
        if (r < I_FF) { tr_item(C.in[I_F1G] + (size_t)l * D * DFF, D, DFF, C.in[I_NF1] + l * D, W1a, D, RowMap{1, 0}, scr, r / 44, r % 44, lane); continue; } r -= I_FF;
        if (r < I_FF) { tr_item(C.in[I_F1U] + (size_t)l * D * DFF, D, DFF, C.in[I_NF1] + l * D, W1a, D, RowMap{1, 128}, scr, r / 44, r % 44, lane); continue; } r -= I_FF;
        if (r < I_DN) { tr_item(C.in[I_F1D] + (size_t)l * D * DFF, DFF, D, nullptr, Wda, DFF, RowMap{0, 0}, scr, r / 16, r % 16, lane); continue; } r -= I_DN;
        if (r < I_FF) { tr_item(C.in[I_F2G] + (size_t)l * D * DFF, D, DFF, C.in[I_NF2] + l * D, W1b, D, RowMap{1, 0}, scr, r / 44, r % 44, lane); continue; } r -= I_FF;
        if (r < I_FF) { tr_item(C.in[I_F2U] + (size_t)l * D * DFF, D, DFF, C.in[I_NF2] + l * D, W1b, D, RowMap{1, 128}, scr, r / 44, r % 44, lane); continue; } r -= I_FF;
        if (r < I_DN) { tr_item(C.in[I_F2D] + (size_t)l * D * DFF, DFF, D, nullptr, Wdb, DFF, RowMap{0, 0}, scr, r / 16, r % 16, lane); continue; } r -= I_DN;
        if (r < I_IN) { tr_item(C.in[I_WIN] + (size_t)l * D * NIN, D, NIN, C.in[I_NMIX] + l * D, WSP(bf16, WS_WIN + (size_t)l * SZ_WIN), D, RowMap{2, 0}, scr, r / 113, r % 113, lane); continue; } r -= I_IN;
        if (r < I_BR) { const int n4 = r / 64, rr = r % 64; tr_item(C.in[I_WBR] + (size_t)(l * 4 + n4) * 256 * D, 256, D, nullptr, WSP(bf16, WS_WBR + (size_t)l * SZ_WBR) + n4 * 256, D, RowMap{0, 0}, scr, rr / 16, rr % 16, lane); continue; } r -= I_BR;
        tr_item(C.in[I_WOUT] + (size_t)l * D * D, D, D, nullptr, WSP(bf16, WS_WOUT + (size_t)l * SZ_WOUT), D, RowMap{0, 0}, scr, r / 16, r % 16, lane);
    }
    const int gt = gw * 64 + lane, NGT = NGW * 64;
    for (int i = gt; i < 2 * 240 * 128; i += NGT) { const int l = i / (240 * 128), r = i % (240 * 128); *(v4u*)(C.ws + WS_WIN + (size_t)l * SZ_WIN + ((size_t)NMIX * D) * 2 + (size_t)r * 16) = (v4u){0u, 0u, 0u, 0u}; }
    for (int i = gt; i < (M - MR) * 128; i += NGT) *(v4u*)(C.ws + WS_BR + (size_t)MR * D * 2 + (size_t)i * 16) = (v4u){0u, 0u, 0u, 0u};
    for (int i = gt; i < 2 * NINP; i += NGT) { const int l = i / NINP, j = i % NINP; float v = 0.f; if (j < NMIX) v = C.in[I_BIN][l * NIN + j]; else if (j >= NMIXP) v = C.in[I_BIN][l * NIN + NMIX + gate_src(j - NMIXP)]; WSP(float, WS_BINP)[i] = v; }
    for (int i = gt; i < NPOS * 32; i += NGT) { const int pi = i >> 5, fi = i & 31; const int pos = pi < L ? pi : PAST + (pi - L);
        const float angf = (float)pos * P.inv_freq[fi];
        const double a = (double)angf; const double k = rint(a * 0.15915494309189535); const double rr = (a - k * 6.283185307179586) - k * 2.4492935982947064e-16;
        const float rf = (float)rr; WSP(float, WS_ROPE)[i] = cosf(rf); WSP(float, WS_ROPE)[NPOS * 32 + i] = sinf(rf); }
    float* H = WSP(float, WS_H); bf16* HB = WSP(bf16, WS_HB); float* SS0 = WSP(float, WS_SS);
    for (int row = gw; row < M; row += NGW) {
        const float* src = nullptr;
        if (row < MP) { const int b = row / L, pos = row - b * L; src = pos < NMETA ? C.in[I_META] + (size_t)pos * D : C.in[I_XP] + ((size_t)b * SEQ + (pos - NMETA)) * D; }
        else if (row < MR) src = C.in[I_XS] + (size_t)(row - MP) * D;
        float s = 0.f;
#pragma unroll
        for (int j = 0; j < 4; ++j) { f32x4 v = src ? *(const f32x4*)(src + 256 * j + 4 * lane) : (f32x4){0.f, 0.f, 0.f, 0.f};
            s += (v[0] * v[0] + v[1] * v[1]) + (v[2] * v[2] + v[3] * v[3]);
            unsigned long long w = (unsigned long long)pk2(v[0], v[1]) | ((unsigned long long)pk2(v[2], v[3]) << 32);
            *(unsigned long long*)(HB + (size_t)row * D + 256 * j + 4 * lane) = w; }
        s = wave_sum(s); if (lane < 16) SS0[(size_t)row * 16 + lane] = lane == 0 ? s : 0.f;
    }
}

__device__ __forceinline__ float lam_of(const Ctx& C, int l, float lam_init) {
    THREAD_IDS();
    float a = 0.f, b = 0.f;
#pragma unroll 1
    for (int i = 0; i < 32; ++i) { a += C.in[I_LQ1][l * 32 + i] * C.in[I_LK1][l * 32 + i]; b += C.in[I_LQ2][l * 32 + i] * C.in[I_LK2][l * 32 + i]; }
    return __expf(a) - __expf(b) + lam_init;
}
__device__ __forceinline__ int t5_bucket(int n) {
    if (n < 16) return n;
    return 16 + (n >= 19) + (n >= 21) + (n >= 24) + (n >= 27) + (n >= 31) + (n >= 35) + (n >= 40) + (n >= 46) + (n >= 52) + (n >= 59) + (n >= 67) + (n >= 77) + (n >= 87) + (n >= 99) + (n >= 113);
}
__device__ __forceinline__ void unpack8(const v4u w, float (&x)[8]) { x[0] = bflo(w.x); x[1] = bfhi(w.x); x[2] = bflo(w.y); x[3] = bfhi(w.y); x[4] = bflo(w.z); x[5] = bfhi(w.z); x[6] = bflo(w.w); x[7] = bfhi(w.w); }
__device__ __forceinline__ v4u pack8(const float (&x)[8]) { v4u w; w.x = pg8::cvt_pk_bf16(x[0], x[1]); w.y = pg8::cvt_pk_bf16(x[2], x[3]); w.z = pg8::cvt_pk_bf16(x[4], x[5]); w.w = pg8::cvt_pk_bf16(x[6], x[7]); return w; }
__device__ __forceinline__ void n1_prep(const Ctx& C, int l) {
    THREAD_IDS();
    const bf16* ZM = WSP(bf16, WS_ZMIX); float* UB = WSP(float, WS_UBUF); float* RQ = WSP(float, WS_RQ); float* RK = WSP(float, WS_RK);
    float* LD = WSP(float, WS_LDEC); const float* COS = WSP(float, WS_ROPE); const float* SIN = COS + NPOS * 32; bf16* QNB = WSP(bf16, WS_QNB); bf16* KNB = WSP(bf16, WS_KNB);
    const int i = lane & 31;
    float qg[8], kg[8];
#pragma unroll
    for (int j = 0; j < 8; ++j) { qg[j] = C.in[I_QN][l * 32 + ((8 * i) & 31) + j] * (0.17677669529663687f * 1.4426950408889634f); kg[j] = C.in[I_KN][l * 32 + ((8 * i) & 31) + j]; }
    const int isk = i >> 4, hh = (i >> 2) & 3, jc = i & 3;
    for (int rp0 = gw * 2; rp0 < MR / 2; rp0 += NGW * 2) {
        v4u Wa[2], Wg[2], Wq[2], Wk[2], Wv[2], W1[2], W2[2], G0[2], G1[2];
#pragma unroll
        for (int u = 0; u < 2; ++u) { const int r = min(2 * (rp0 + u) + (lane >> 5), MR - 1); const bf16* z = ZM + (size_t)r * NMIXP; const bf16* zr = z + (isk ? R_K : R_Q) + hh * 64 + 8 * jc;
            Wa[u] = *(const v4u*)(z + C_A + 8 * i); Wg[u] = *(const v4u*)(z + C_G + 8 * i); Wq[u] = *(const v4u*)(z + D_Q + 8 * i); Wk[u] = *(const v4u*)(z + D_K + 8 * i); Wv[u] = *(const v4u*)(z + D_V + 8 * i);
            W1[u] = *(const v4u*)zr; W2[u] = *(const v4u*)(zr + 32); G0[u] = *(const v4u*)(z + G_LOW); G1[u] = *(const v4u*)(z + G_LOW + 8); }
#pragma unroll
        for (int u = 0; u < 2; ++u) {
        if (rp0 + u >= MR / 2) break;
        const int r = 2 * (rp0 + u) + (lane >> 5);
        const int pi = r < MP ? r % L : L + ((r - MP) & 7);
        float* kout = r < MP ? C.out + O_KP + ((size_t)l * MP + r) * 256 : C.out + O_KS + ((size_t)l * MS + (r - MP)) * 256;
        float* vout = r < MP ? C.out + O_VP + ((size_t)l * MP + r) * 256 : C.out + O_VS + ((size_t)l * MS + (r - MP)) * 256;
        const v4u wa = Wa[u], wg = Wg[u], wq = Wq[u], wk = Wk[u], wv = Wv[u], w1 = W1[u], w2 = W2[u], gl0 = G0[u], gl1 = G1[u];
        float x[8], y[8];
        unpack8(wa, x); unpack8(wg, y);
#pragma unroll
        for (int j = 0; j < 8; ++j) x[j] *= sigmoidf_(y[j]);
        *(f32x4*)(UB + (size_t)r * 256 + 8 * i) = (f32x4){x[0], x[1], x[2], x[3]}; *(f32x4*)(UB + (size_t)r * 256 + 8 * i + 4) = (f32x4){x[4], x[5], x[6], x[7]};
        unpack8(wv, x);
        *(f32x4*)(vout + 8 * i) = (f32x4){x[0], x[1], x[2], x[3]}; *(f32x4*)(vout + 8 * i + 4) = (f32x4){x[4], x[5], x[6], x[7]};
        unpack8(wq, x);
        { float s = 0.f;
#pragma unroll
          for (int j = 0; j < 8; ++j) s += x[j] * x[j];
          s += __shfl_xor(s, 1); s += __shfl_xor(s, 2); const float rs = rsqrtf(s * (1.0f / 32) + EPS);
#pragma unroll
          for (int j = 0; j < 8; ++j) x[j] = x[j] * rs * qg[j];
          *(v4u*)(QNB + (size_t)r * 256 + 8 * i) = pack8(x); }
        unpack8(wk, x);
        { float s = 0.f;
#pragma unroll
          for (int j = 0; j < 8; ++j) s += x[j] * x[j];
          s += __shfl_xor(s, 1); s += __shfl_xor(s, 2); const float rs = rsqrtf(s * (1.0f / 32) + EPS);
#pragma unroll
          for (int j = 0; j < 8; ++j) x[j] = x[j] * rs * kg[j];
          *(v4u*)(KNB + (size_t)r * 256 + 8 * i) = pack8(x);
          *(f32x4*)(kout + 8 * i) = (f32x4){x[0], x[1], x[2], x[3]}; *(f32x4*)(kout + 8 * i + 4) = (f32x4){x[4], x[5], x[6], x[7]}; }
        unpack8(w1, x); unpack8(w2, y);
        { const f32x4 c0 = *(const f32x4*)(COS + pi * 32 + 8 * jc), c1 = *(const f32x4*)(COS + pi * 32 + 8 * jc + 4), s0 = *(const f32x4*)(SIN + pi * 32 + 8 * jc), s1 = *(const f32x4*)(SIN + pi * 32 + 8 * jc + 4);
          const float sc = isk ? 0.125f : 1.0f; float o1[8], o2[8];
#pragma unroll
          for (int j = 0; j < 8; ++j) { const float cs = j < 4 ? c0[j & 3] : c1[j & 3], sn = j < 4 ? s0[j & 3] : s1[j & 3]; o1[j] = (x[j] * cs - y[j] * sn) * sc; o2[j] = (x[j] * sn + y[j] * cs) * sc; }
          float* ro = (isk ? RK : RQ) + (size_t)r * 256 + hh * 64 + 8 * jc;
          *(f32x4*)ro = (f32x4){o1[0], o1[1], o1[2], o1[3]}; *(f32x4*)(ro + 4) = (f32x4){o1[4], o1[5], o1[6], o1[7]}; *(f32x4*)(ro + 32) = (f32x4){o2[0], o2[1], o2[2], o2[3]}; *(f32x4*)(ro + 36) = (f32x4){o2[4], o2[5], o2[6], o2[7]}; }
        { float gv[16]; unpack8(gl0, x); unpack8(gl1, y);
#pragma unroll
          for (int j = 0; j < 8; ++j) { gv[j] = x[j]; gv[8 + j] = y[j]; }
          f32x4 gp = *(const f32x4*)(C.in[I_GAB] + l * 128 + 4 * i);
#pragma unroll
          for (int k = 0; k < 16; ++k) { const f32x4 aw = *(const f32x4*)(C.in[I_GAW] + (size_t)(l * 16 + k) * 128 + 4 * i); gp = gp + aw * gv[k]; }
          f32x4 ls;
#pragma unroll
          for (int j = 0; j < 4; ++j) ls[j] = (fminf(gp[j], 0.f) - log1pf(__expf(-fabsf(gp[j])))) * (1.0f / 16.0f);
          *(f32x4*)(LD + (size_t)r * 128 + 4 * i) = ls; }
        }
    }
}
__device__ __forceinline__ void conv_rows_item(const Ctx& C, int l, int item) {
    THREAD_IDS();
    const float* UB = WSP(float, WS_UBUF); bf16* BR = WSP(bf16, WS_BR);
    const float* cw = C.in[I_CW] + (size_t)l * 31 * 256; const float* sc = C.in[I_SCONV];
    LAS float* wl = (LAS float*)C.lds;
    for (int i = tid; i < 31 * 256; i += NWAVES * 64) wl[i] = cw[i];
    LDS_WAIT(); __builtin_amdgcn_s_barrier(); asm volatile("" ::: "memory");
    const int r0 = item * 64 + wave * 8;
    if (r0 < MR) {
        const bool smp = r0 >= MP; const int b = smp ? (r0 - MP) >> 3 : r0 / L; const int p0 = smp ? 0 : r0 - b * L; const int rb = smp ? MP + b * 8 : b * L;
        float acc[8][4];
#pragma unroll
        for (int i = 0; i < 8; ++i)
#pragma unroll
            for (int k = 0; k < 4; ++k) acc[i][k] = C.in[I_CB][l * 256 + lane + 64 * k];
#pragma unroll 1
        for (int jb = 0; jb < 40; jb += 8) {
            float uv[8][4];
#pragma unroll
            for (int jj = 0; jj < 8; ++jj) { const int j = jb + jj; const int q = p0 - 30 + j;
#pragma unroll
                for (int k = 0; k < 4; ++k) { const int c = lane + 64 * k;
                    uv[jj][k] = j >= 38 ? 0.f : (q >= 0 ? UB[(size_t)(rb + q) * 256 + c] : (smp ? sc[(((size_t)l * DB + b) * 30 + (q + 30)) * 256 + c] : 0.f)); } }
#pragma unroll
            for (int jj = 0; jj < 8; ++jj)
#pragma unroll
                for (int i = 0; i < 8; ++i) { const int t = jb + jj - i;
                    if (t >= 0 && t <= 30) {
#pragma unroll
                        for (int k = 0; k < 4; ++k) acc[i][k] += wl[t * 256 + lane + 64 * k] * uv[jj][k]; } }
        }
#pragma unroll
        for (int i = 0; i < 8; ++i) { const int r = r0 + i;
            float s = (acc[i][0] + acc[i][1]) + (acc[i][2] + acc[i][3]); const float mean = wave_sum(s) * (1.0f / 256);
            float q2 = 0.f;
#pragma unroll
            for (int k = 0; k < 4; ++k) { acc[i][k] -= mean; q2 += acc[i][k] * acc[i][k]; }
            const float rstd = rsqrtf(wave_sum(q2) * (1.0f / 256) + EPS);
#pragma unroll
            for (int k = 0; k < 4; ++k) { const int c = lane + 64 * k; const float y = acc[i][k] * rstd * C.in[I_CLG][l * 256 + c] + C.in[I_CLB][l * 256 + c]; BR[(size_t)r * D + c] = (bf16)f2bf(siluf_(y)); } }
    }
    LDS_WAIT(); __builtin_amdgcn_s_barrier(); asm volatile("" ::: "memory");
}
__device__ __forceinline__ void conv_state_item(const Ctx& C, int l, int part, int nparts) {
    THREAD_IDS();
    const float* UB = WSP(float, WS_UBUF); const float* sc = C.in[I_SCONV];
    for (int i = part * NWAVES * 64 + tid; i < BATCH * 30 * 256; i += nparts * NWAVES * 64) { const int c = i & 255, ii = (i >> 8) % 30, b = i / (30 * 256); C.out[O_CP + (size_t)l * BATCH * 30 * 256 + i] = UB[(size_t)(b * L + L - 30 + ii) * 256 + c]; }
    for (int i = part * NWAVES * 64 + tid; i < DB * 30 * 256; i += nparts * NWAVES * 64) { const int c = i & 255, ii = (i >> 8) % 30, b = i / (30 * 256);
        C.out[O_CS + (size_t)l * DB * 30 * 256 + i] = ii < 22 ? sc[(((size_t)l * DB + b) * 30 + 8 + ii) * 256 + c] : UB[(size_t)(MP + b * 8 + ii - 22) * 256 + c]; }
}
template <int DK, bool RET> __device__ __forceinline__ void la_seq(const Ctx& C, int l, bool smp, int b, int h) {
    THREAD_IDS();
    const bf16* ZM = WSP(bf16, WS_ZMIX); const float* RQ = WSP(float, WS_RQ); const float* RK = WSP(float, WS_RK); const float* LD = WSP(float, WS_LDEC); bf16* BR = WSP(bf16, WS_BR);
    const int nt = smp ? DS : L; const int row0 = smp ? MP + b * DS : b * L;
    float S[DK];
    if (smp) { const float* s0 = (RET ? C.in[I_SRET] : C.in[I_SGLA]) + (((size_t)l * DB + b) * 4 + h) * DK * 64;
#pragma unroll
        for (int k = 0; k < DK; ++k) S[k] = s0[k * 64 + lane]; }
    else {
#pragma unroll
        for (int k = 0; k < DK; ++k) S[k] = 0.f; }
    const float gamma = 1.0f - exp2f(-5.0f - (float)h);
    const float gn = RET ? C.in[I_RGN][(l * 4 + h) * 64 + lane] : C.in[I_GGN][(l * 4 + h) * 64 + lane];
    for (int t = 0; t < nt; ++t) {
        const int r = row0 + t; const bf16* z = ZM + (size_t)r * NMIXP;
        float ql, kl, dl = 1.f;
        if (RET) { ql = RQ[(size_t)r * 256 + h * 64 + lane]; kl = RK[(size_t)r * 256 + h * 64 + lane]; }
        else { const int lk = lane & 31; ql = bf2f(z[G_Q + h * 32 + lk]) * 0.17677669529663687f; kl = bf2f(z[G_K + h * 32 + lk]); dl = __expf(LD[(size_t)r * 128 + h * 32 + lk]); }
        const float v = bf2f(z[(RET ? R_V : G_V) + h * 64 + lane]);
        float o = 0.f;
#pragma unroll
        for (int k = 0; k < DK; ++k) { const float qk = __shfl(ql, k), kk = __shfl(kl, k); const float dk = RET ? gamma : __shfl(dl, k);
            S[k] = dk * S[k] + kk * v; o += qk * S[k]; if ((k & 7) == 7) __builtin_amdgcn_sched_barrier(0); }
        float y;
        if (RET) { const float mean = wave_sum(o) * (1.0f / 64); const float d = o - mean; const float var = wave_sum(d * d) * (1.0f / 64); y = d * rsqrtf(var + EPS) * gn; }
        else { const float ms = wave_sum(o * o) * (1.0f / 64); y = o * rsqrtf(ms + EPS) * gn; }
        const float g = bf2f(z[(RET ? R_G : G_R) + h * 64 + lane]);
        BR[(size_t)r * D + (RET ? 256 : 512) + h * 64 + lane] = (bf16)f2bf(siluf_(g) * y);
    }
    float* so = C.out + (RET ? (smp ? O_RS + (((size_t)l * DB + b) * 4 + h) * DK * 64 : O_RP + (((size_t)l * BATCH + b) * 4 + h) * DK * 64)
                             : (smp ? O_GS + (((size_t)l * DB + b) * 4 + h) * DK * 64 : O_GP + (((size_t)l * BATCH + b) * 4 + h) * DK * 64));
#pragma unroll
    for (int k = 0; k < DK; ++k) so[k * 64 + lane] = S[k];
}
typedef short bf16x8_t __attribute__((ext_vector_type(8)));
template <int DK, bool RET> __device__ __forceinline__ void la_chunked(const Ctx& C, int l, bool smp, int b, int h) {
    THREAD_IDS();
    constexpr int QS = DK + 8, TS = 72, NKB = DK / 16, NKS = DK / 32;
    constexpr int SB = 2 * 64 * QS + 64 * TS + DK * TS + 64 * TS + 64;
    LAS bf16* SB0 = (LAS bf16*)(C.lds);
    LAS bf16* AL = SB0 + 2 * SB;
    LAS bf16* ST = AL + 64 * TS;
    const bf16* ZM = WSP(bf16, WS_ZMIX); const float* RQ = WSP(float, WS_RQ); const float* RK = WSP(float, WS_RK); const float* LD = WSP(float, WS_LDEC); bf16* BR = WSP(bf16, WS_BR);
    const int nt = smp ? DS : L, row0 = smp ? MP + b * DS : b * L, nch = (nt + 63) >> 6;
    const float lg2 = RET ? log2f(1.0f - exp2f(-5.0f - (float)h)) : 0.f;
    const int g4 = lane >> 4, c16 = lane & 15;
    const bool qwave = wave < 4; const int w4 = wave & 3;
    float Sreg[NKB][4];
    if (wave >= 4) {
        const float* s0 = (RET ? C.in[I_SRET] : C.in[I_SGLA]) + (((size_t)l * DB + b) * 4 + h) * DK * 64;
#pragma unroll
        for (int cb = 0; cb < NKB; ++cb)
#pragma unroll
            for (int r = 0; r < 4; ++r) { const int dk = cb * 16 + c16, dv = (wave - 4) * 16 + 4 * g4 + r; const float v = smp ? s0[dk * 64 + dv] : 0.f; Sreg[cb][r] = v; ST[dv * QS + dk] = (bf16)f2bf(v); }
    }
    float gnv[4];
#pragma unroll
    for (int cb = 0; cb < 4; ++cb) gnv[cb] = (RET ? C.in[I_RGN] : C.in[I_GGN])[(l * 4 + h) * 64 + cb * 16 + c16];
    float a[16]; v4u vr;
#define LA_LOAD(c) do { const size_t r_ = (size_t)(row0 + (c) * 64 + lane); const bf16* z_ = ZM + r_ * NMIXP; \
        vr = *(const v4u*)(z_ + (RET ? R_V : G_V) + h * 64 + 8 * wave); \
        if (RET) { const float* p_ = (qwave ? RQ : RK) + r_ * 256 + h * 64 + 8 * w4; const f32x4 x0 = *(const f32x4*)p_, x1 = *(const f32x4*)(p_ + 4), x2 = *(const f32x4*)(p_ + 32), x3 = *(const f32x4*)(p_ + 36); \
            a[0] = x0[0]; a[1] = x0[1]; a[2] = x0[2]; a[3] = x0[3]; a[4] = x1[0]; a[5] = x1[1]; a[6] = x1[2]; a[7] = x1[3]; a[8] = x2[0]; a[9] = x2[1]; a[10] = x2[2]; a[11] = x2[3]; a[12] = x3[0]; a[13] = x3[1]; a[14] = x3[2]; a[15] = x3[3]; } \
        else { const v4u q_ = *(const v4u*)(z_ + (qwave ? G_Q : G_K) + h * 32 + 8 * w4); const float* p_ = LD + r_ * 128 + h * 32 + 8 * w4; const f32x4 x0 = *(const f32x4*)p_, x1 = *(const f32x4*)(p_ + 4); \
            a[0] = bflo(q_.x); a[1] = bfhi(q_.x); a[2] = bflo(q_.y); a[3] = bfhi(q_.y); a[4] = bflo(q_.z); a[5] = bfhi(q_.z); a[6] = bflo(q_.w); a[7] = bfhi(q_.w); \
            a[8] = x0[0]; a[9] = x0[1]; a[10] = x0[2]; a[11] = x0[3]; a[12] = x1[0]; a[13] = x1[1]; a[14] = x1[2]; a[15] = x1[3]; } } while (0)
    LA_LOAD(0);
    int cur = 0;
    for (int i = 0; i <= nch; ++i) {
        if (i < nch) {
            const int c = i; LAS bf16* QT = SB0 + (i & 1) * SB; LAS bf16* KT = QT + 64 * QS; LAS bf16* VT = KT + 64 * QS; LAS bf16* KE = VT + 64 * TS; LAS bf16* GT = KE + DK * TS; LAS float* WT = (LAS float*)(GT + 64 * TS);
            const int nvc = min(64, nt - c * 64); const bool valid = lane < nvc;
        if (RET) {
            const float tq = (float)(lane + 1);
            if (qwave) { const float e = valid ? __builtin_amdgcn_exp2f(lg2 * tq) : 0.f;
                v4u w0, w1; w0.x = pg8::cvt_pk_bf16(a[0] * e, a[1] * e); w0.y = pg8::cvt_pk_bf16(a[2] * e, a[3] * e); w0.z = pg8::cvt_pk_bf16(a[4] * e, a[5] * e); w0.w = pg8::cvt_pk_bf16(a[6] * e, a[7] * e);
                w1.x = pg8::cvt_pk_bf16(a[8] * e, a[9] * e); w1.y = pg8::cvt_pk_bf16(a[10] * e, a[11] * e); w1.z = pg8::cvt_pk_bf16(a[12] * e, a[13] * e); w1.w = pg8::cvt_pk_bf16(a[14] * e, a[15] * e);
                *(LAS v4u*)(QT + lane * QS + 8 * w4) = w0; *(LAS v4u*)(QT + lane * QS + 32 + 8 * w4) = w1; }
            else { const float e = valid ? __builtin_amdgcn_exp2f(-lg2 * tq) : 0.f, ee = valid ? __builtin_amdgcn_exp2f(lg2 * ((float)nvc - tq)) : 0.f;
                v4u w0, w1; w0.x = pg8::cvt_pk_bf16(a[0] * e, a[1] * e); w0.y = pg8::cvt_pk_bf16(a[2] * e, a[3] * e); w0.z = pg8::cvt_pk_bf16(a[4] * e, a[5] * e); w0.w = pg8::cvt_pk_bf16(a[6] * e, a[7] * e);
                w1.x = pg8::cvt_pk_bf16(a[8] * e, a[9] * e); w1.y = pg8::cvt_pk_bf16(a[10] * e, a[11] * e); w1.z = pg8::cvt_pk_bf16(a[12] * e, a[13] * e); w1.w = pg8::cvt_pk_bf16(a[14] * e, a[15] * e);
                *(LAS v4u*)(KT + lane * QS + 8 * w4) = w0; *(LAS v4u*)(KT + lane * QS + 32 + 8 * w4) = w1;
#pragma unroll
                for (int i = 0; i < 16; i += 2) { const unsigned mine = pg8::cvt_pk_bf16(a[i] * ee, a[i + 1] * ee); const unsigned pv = (unsigned)__shfl_xor((int)mine, 1);
                    const unsigned w = (lane & 1) ? ((pv >> 16) | (mine & 0xffff0000u)) : ((mine & 0xffffu) | (pv << 16));
                    const int row = (i < 8 ? 8 * w4 + i : 32 + 8 * w4 + (i - 8)) + (lane & 1);
                    *(LAS unsigned*)(KE + row * TS + (lane & ~1)) = w; } }
        } else {
            float bb[8];
#pragma unroll
            for (int i = 0; i < 8; ++i) bb[i] = valid ? a[8 + i] : 0.f;
#pragma unroll
            for (int i = 0; i < 8; ++i) { float x = bb[i];
                x += __builtin_bit_cast(float, __builtin_amdgcn_mov_dpp(__builtin_bit_cast(int, x), 0x111, 0xf, 0xf, true));
                x += __builtin_bit_cast(float, __builtin_amdgcn_mov_dpp(__builtin_bit_cast(int, x), 0x112, 0xf, 0xf, true));
                x += __builtin_bit_cast(float, __builtin_amdgcn_mov_dpp(__builtin_bit_cast(int, x), 0x114, 0xf, 0xf, true));
                x += __builtin_bit_cast(float, __builtin_amdgcn_mov_dpp(__builtin_bit_cast(int, x), 0x118, 0xf, 0xf, true));
                const float t0 = __builtin_bit_cast(float, __builtin_amdgcn_readlane(__builtin_bit_cast(int, x), 15)), t1 = __builtin_bit_cast(float, __builtin_amdgcn_readlane(__builtin_bit_cast(int, x), 31)), t2 = __builtin_bit_cast(float, __builtin_amdgcn_readlane(__builtin_bit_cast(int, x), 47));
                bb[i] = x + (lane >= 16 ? t0 : 0.f) + (lane >= 32 ? t1 : 0.f) + (lane >= 48 ? t2 : 0.f); }
            if (qwave) {
                if (lane == 63) {
#pragma unroll
                    for (int i = 0; i < 8; ++i) WT[8 * w4 + i] = bb[i]; }
                float o8[8];
#pragma unroll
                for (int i = 0; i < 8; ++i) o8[i] = valid ? a[i] * 0.17677669529663687f * __expf(bb[i]) : 0.f;
                v4u w0; w0.x = pg8::cvt_pk_bf16(o8[0], o8[1]); w0.y = pg8::cvt_pk_bf16(o8[2], o8[3]); w0.z = pg8::cvt_pk_bf16(o8[4], o8[5]); w0.w = pg8::cvt_pk_bf16(o8[6], o8[7]);
                *(LAS v4u*)(QT + lane * QS + 8 * w4) = w0;
            } else {
                float o8[8];
#pragma unroll
                for (int i = 0; i < 8; ++i) o8[i] = valid ? a[i] * __expf(-bb[i]) : 0.f;
#pragma unroll
                for (int i = 0; i < 8; i += 2) { const float t0 = __shfl(bb[i], 63), t1 = __shfl(bb[i + 1], 63);
                    const unsigned mine = pg8::cvt_pk_bf16(valid ? a[i] * __expf(t0 - bb[i]) : 0.f, valid ? a[i + 1] * __expf(t1 - bb[i + 1]) : 0.f); const unsigned pv = (unsigned)__shfl_xor((int)mine, 1);
                    const unsigned w = (lane & 1) ? ((pv >> 16) | (mine & 0xffff0000u)) : ((mine & 0xffffu) | (pv << 16));
                    *(LAS unsigned*)(KE + (8 * w4 + i + (lane & 1)) * TS + (lane & ~1)) = w; }
                v4u w0; w0.x = pg8::cvt_pk_bf16(o8[0], o8[1]); w0.y = pg8::cvt_pk_bf16(o8[2], o8[3]); w0.z = pg8::cvt_pk_bf16(o8[4], o8[5]); w0.w = pg8::cvt_pk_bf16(o8[6], o8[7]);
                *(LAS v4u*)(KT + lane * QS + 8 * w4) = w0;
            }
        }
        { const unsigned vv[4] = {valid ? vr.x : 0u, valid ? vr.y : 0u, valid ? vr.z : 0u, valid ? vr.w : 0u};
#pragma unroll
          for (int i = 0; i < 4; ++i) { const unsigned pv = (unsigned)__shfl_xor((int)vv[i], 1);
              const unsigned w = (lane & 1) ? ((pv >> 16) | (vv[i] & 0xffff0000u)) : ((vv[i] & 0xffffu) | (pv << 16));
              *(LAS unsigned*)(VT + (8 * wave + 2 * i + (lane & 1)) * TS + (lane & ~1)) = w; } }
            if (c + 1 < nch) LA_LOAD(c + 1);
        }
        if (i >= 1) {
            LAS bf16* QT = SB0 + ((i - 1) & 1) * SB; LAS bf16* KT = QT + 64 * QS;
        { const int rb = wave >> 1;
#pragma unroll
          for (int ci = 0; ci < 2; ++ci) { const int cb = (wave & 1) * 2 + ci; f32x4 acc = {0.f, 0.f, 0.f, 0.f};
              if (cb <= rb) {
#pragma unroll
                  for (int ks = 0; ks < NKS; ++ks) { const bf16x8_t af = *(const LAS bf16x8_t*)(QT + (rb * 16 + c16) * QS + ks * 32 + 8 * g4), bf = *(const LAS bf16x8_t*)(KT + (cb * 16 + c16) * QS + ks * 32 + 8 * g4);
                      acc = __builtin_amdgcn_mfma_f32_16x16x32_bf16(af, bf, acc, 0, 0, 0); } }
#pragma unroll
              for (int r = 0; r < 4; ++r) { const int tt = rb * 16 + 4 * g4 + r, ss = cb * 16 + c16; AL[tt * TS + ss] = (bf16)f2bf(ss <= tt ? acc[r] : 0.f); } } }
        }
        LDS_WAIT(); __builtin_amdgcn_s_barrier(); asm volatile("" ::: "memory");
        if (i >= 1) {
            const int c = i - 1; LAS bf16* QT = SB0 + (c & 1) * SB; LAS bf16* KT = QT + 64 * QS; LAS bf16* VT = KT + 64 * QS; LAS bf16* KE = VT + 64 * TS; LAS bf16* GT = KE + DK * TS; LAS float* WT = (LAS float*)(GT + 64 * TS);
            const int nvc = min(64, nt - c * 64); (void)KT;
        if (wave < 4) {
            const int rb = wave; const LAS bf16* STc = ST + cur * 64 * QS;
            f32x4 o[4];
#pragma unroll
            for (int cb = 0; cb < 4; ++cb) o[cb] = (f32x4){0.f, 0.f, 0.f, 0.f};
#pragma unroll
            for (int ks = 0; ks < 2; ++ks) { const bf16x8_t af = *(const LAS bf16x8_t*)(AL + (rb * 16 + c16) * TS + ks * 32 + 8 * g4);
#pragma unroll
                for (int cb = 0; cb < 4; ++cb) { const bf16x8_t bf = *(const LAS bf16x8_t*)(VT + (cb * 16 + c16) * TS + ks * 32 + 8 * g4); o[cb] = __builtin_amdgcn_mfma_f32_16x16x32_bf16(af, bf, o[cb], 0, 0, 0); } }
#pragma unroll
            for (int ks = 0; ks < NKS; ++ks) { const bf16x8_t af = *(const LAS bf16x8_t*)(QT + (rb * 16 + c16) * QS + ks * 32 + 8 * g4);
#pragma unroll
                for (int cb = 0; cb < 4; ++cb) { const bf16x8_t bf = *(const LAS bf16x8_t*)(STc + (cb * 16 + c16) * QS + ks * 32 + 8 * g4); o[cb] = __builtin_amdgcn_mfma_f32_16x16x32_bf16(af, bf, o[cb], 0, 0, 0); } }
            { float* LAO = WSP(float, WS_LAO);
#pragma unroll
              for (int r = 0; r < 4; ++r) { const int tok = c * 64 + rb * 16 + 4 * g4 + r;
                  if (tok < nt) { float* op = LAO + (size_t)(row0 + tok) * 512 + (RET ? 0 : 256) + h * 64 + c16;
#pragma unroll
                      for (int cb = 0; cb < 4; ++cb) op[cb * 16] = o[cb][r]; } } }
        } else {
            const int dvb = wave - 4; LAS bf16* STn = ST + (cur ^ 1) * 64 * QS;
            f32x4 ds[NKB];
#pragma unroll
            for (int cb = 0; cb < NKB; ++cb) ds[cb] = (f32x4){0.f, 0.f, 0.f, 0.f};
#pragma unroll
            for (int ks = 0; ks < 2; ++ks) { const bf16x8_t af = *(const LAS bf16x8_t*)(VT + (dvb * 16 + c16) * TS + ks * 32 + 8 * g4);
#pragma unroll
                for (int cb = 0; cb < NKB; ++cb) { const bf16x8_t bf = *(const LAS bf16x8_t*)(KE + (cb * 16 + c16) * TS + ks * 32 + 8 * g4); ds[cb] = __builtin_amdgcn_mfma_f32_16x16x32_bf16(af, bf, ds[cb], 0, 0, 0); } }
#pragma unroll
            for (int cb = 0; cb < NKB; ++cb) { const float eB = RET ? __builtin_amdgcn_exp2f(lg2 * (float)nvc) : __expf(WT[cb * 16 + c16]);
#pragma unroll
                for (int r = 0; r < 4; ++r) { Sreg[cb][r] = eB * Sreg[cb][r] + ds[cb][r]; STn[(dvb * 16 + 4 * g4 + r) * QS + cb * 16 + c16] = (bf16)f2bf(Sreg[cb][r]); } }
        }
            cur ^= 1;
        }
        LDS_WAIT(); __builtin_amdgcn_s_barrier(); asm volatile("" ::: "memory");
    }
#undef LA_LOAD
    if (wave >= 4) {
        float* so = C.out + (RET ? (smp ? O_RS + (((size_t)l * DB + b) * 4 + h) * DK * 64 : O_RP + (((size_t)l * BATCH + b) * 4 + h) * DK * 64)
                                 : (smp ? O_GS + (((size_t)l * DB + b) * 4 + h) * DK * 64 : O_GP + (((size_t)l * BATCH + b) * 4 + h) * DK * 64));
#pragma unroll
        for (int cb = 0; cb < NKB; ++cb)
#pragma unroll
            for (int r = 0; r < 4; ++r) so[(cb * 16 + c16) * 64 + (wave - 4) * 16 + 4 * g4 + r] = Sreg[cb][r];
    }
}
typedef float f32x16_t __attribute__((ext_vector_type(16)));
__device__ __forceinline__ int crow_(int r, int hi) { return (r & 3) + 8 * (r >> 2) + 4 * hi; }
__device__ __forceinline__ float swapmax32(float m) { auto rr = __builtin_amdgcn_permlane32_swap(__float_as_uint(m), __float_as_uint(m), false, false); return fmaxf(__uint_as_float(rr[0]), __uint_as_float(rr[1])); }
__device__ __forceinline__ float swapadd32(float m) { auto rr = __builtin_amdgcn_permlane32_swap(__float_as_uint(m), __float_as_uint(m), false, false); return __uint_as_float(rr[0]) + __uint_as_float(rr[1]); }
constexpr float LOG2E = 1.4426950408889634f;
__device__ __forceinline__ void attn_prompt_item(const Ctx& C, int l, int b, int h, int qb, float lam, float lam_init, float mb) {
    THREAD_IDS();
    constexpr int KS = 72;
    LAS bf16* Kt = (LAS bf16*)C.lds;
    LAS bf16* Vt = Kt + 2 * 64 * KS;
    LAS float* BT = (LAS float*)(Vt + 2 * 64 * KS);
    LAS float* OX = BT + 128;
    const bf16* ZM = WSP(bf16, WS_ZMIX); const bf16* QNB = WSP(bf16, WS_QNB); const bf16* KNB = WSP(bf16, WS_KNB); bf16* BR = WSP(bf16, WS_BR);
    const int r32 = lane & 31, hi = lane >> 5, qs = wave >> 1, s = wave & 1;
    const int q0 = qb * 128 + qs * 32; const int rowb = b * L;
    if (tid < 128) BT[tid] = (C.in[I_RELB][t5_bucket(tid) * 4 + h] - C.in[I_RELB][31 * 4 + h]) * LOG2E;
    pg8::bf16x8 qf[2];
#pragma unroll
    for (int d0 = 0; d0 < 2; ++d0) qf[d0] = *(const pg8::bf16x8*)(QNB + (size_t)(rowb + q0 + r32) * 256 + h * 64 + s * 32 + 16 * d0 + 8 * hi);
    const int pl = (lane & ~15) | ((lane & 8) >> 1) | ((lane & 4) << 1) | (lane & 3);
    const int NT = (min(128 * (qb + 1), L) + 63) >> 6;
    v4u kreg, vreg;
#define AT_LOAD(j) do { const size_t r_ = (size_t)(rowb + (j) * 64 + lane); kreg = *(const v4u*)(KNB + r_ * 256 + h * 64 + 8 * wave); vreg = *(const v4u*)(ZM + r_ * NMIXP + D_V + h * 64 + 8 * wave); } while (0)
#define AT_STORE(buf) do { *(LAS v4u*)(Kt + (buf) * 64 * KS + lane * KS + 8 * wave) = kreg; LAS bf16* v_ = Vt + (buf) * 64 * KS + (8 * wave) * KS + pl; \
        v_[0] = (bf16)(vreg.x & 0xffffu); v_[KS] = (bf16)(vreg.x >> 16); v_[2 * KS] = (bf16)(vreg.y & 0xffffu); v_[3 * KS] = (bf16)(vreg.y >> 16); \
        v_[4 * KS] = (bf16)(vreg.z & 0xffffu); v_[5 * KS] = (bf16)(vreg.z >> 16); v_[6 * KS] = (bf16)(vreg.w & 0xffffu); v_[7 * KS] = (bf16)(vreg.w >> 16); } while (0)
    AT_LOAD(0); AT_STORE(0); if (NT > 1) AT_LOAD(1);
    LDS_WAIT(); __builtin_amdgcn_s_barrier(); asm volatile("" ::: "memory");
    float lsum = 0.f; f32x16_t o[2]; f32x16_t negm;
#pragma unroll
    for (int i = 0; i < 16; ++i) negm[i] = -mb;
#pragma unroll
    for (int i = 0; i < 16; ++i) { o[0][i] = 0.f; o[1][i] = 0.f; }
    for (int j = 0; j < NT; ++j) {
        const int k0 = 64 * j, buf = j & 1;
        if (k0 <= q0 + 31) {
            const LAS bf16* kb = Kt + buf * 64 * KS; const LAS bf16* vb = Vt + buf * 64 * KS;
            f32x16_t p0 = negm, p1 = negm;
#pragma unroll
            for (int d0 = 0; d0 < 2; ++d0) { const pg8::bf16x8 a0 = *(const LAS pg8::bf16x8*)(kb + r32 * KS + s * 32 + 16 * d0 + 8 * hi), a1 = *(const LAS pg8::bf16x8*)(kb + (32 + r32) * KS + s * 32 + 16 * d0 + 8 * hi);
                p0 = __builtin_amdgcn_mfma_f32_32x32x16_bf16(a0, qf[d0], p0, 0, 0, 0); p1 = __builtin_amdgcn_mfma_f32_32x32x16_bf16(a1, qf[d0], p1, 0, 0, 0); }
            if (q0 - k0 - 63 < 113) {
#pragma unroll
                for (int r = 0; r < 16; ++r) { const int n0 = (q0 + r32) - (k0 + crow_(r, hi)), n1 = n0 - 32;
                    p0[r] = n0 < 0 ? -INFINITY : p0[r] + (n0 < 128 ? BT[n0] : 0.f); p1[r] = n1 < 0 ? -INFINITY : p1[r] + (n1 < 128 ? BT[n1] : 0.f); } }
            typedef float f32x2_t __attribute__((ext_vector_type(2)));
            f32x2_t ps2 = {0.f, 0.f};
#pragma unroll
            for (int r = 0; r < 16; r += 2) { p0[r] = __builtin_amdgcn_exp2f(p0[r]); p0[r + 1] = __builtin_amdgcn_exp2f(p0[r + 1]); p1[r] = __builtin_amdgcn_exp2f(p1[r]); p1[r + 1] = __builtin_amdgcn_exp2f(p1[r + 1]);
                ps2 = ps2 + (f32x2_t){p0[r], p0[r + 1]}; ps2 = ps2 + (f32x2_t){p1[r], p1[r + 1]}; }
            lsum += ps2[0] + ps2[1];
            pg8::bf16x8 pb[4];
#pragma unroll
            for (int ks = 0; ks < 4; ++ks) { v4u w;
                if (ks < 2) { w.x = pg8::cvt_pk_bf16(p0[8 * ks], p0[8 * ks + 1]); w.y = pg8::cvt_pk_bf16(p0[8 * ks + 2], p0[8 * ks + 3]); w.z = pg8::cvt_pk_bf16(p0[8 * ks + 4], p0[8 * ks + 5]); w.w = pg8::cvt_pk_bf16(p0[8 * ks + 6], p0[8 * ks + 7]); }
                else { w.x = pg8::cvt_pk_bf16(p1[8 * ks - 16], p1[8 * ks - 15]); w.y = pg8::cvt_pk_bf16(p1[8 * ks - 14], p1[8 * ks - 13]); w.z = pg8::cvt_pk_bf16(p1[8 * ks - 12], p1[8 * ks - 11]); w.w = pg8::cvt_pk_bf16(p1[8 * ks - 10], p1[8 * ks - 9]); }
                pb[ks] = __builtin_bit_cast(pg8::bf16x8, w); }
#pragma unroll
            for (int d0 = 0; d0 < 2; ++d0)
#pragma unroll
                for (int ks = 0; ks < 4; ++ks) { const pg8::bf16x8 af = *(const LAS pg8::bf16x8*)(vb + (32 * d0 + r32) * KS + 16 * ks + 8 * hi); o[d0] = __builtin_amdgcn_mfma_f32_32x32x16_bf16(af, pb[ks], o[d0], 0, 0, 0); }
        }
        if (j + 1 < NT) AT_STORE(buf ^ 1);
        if (j + 2 < NT) AT_LOAD(j + 2);
        LDS_WAIT(); __builtin_amdgcn_s_barrier(); asm volatile("" ::: "memory");
    }
#undef AT_LOAD
#undef AT_STORE
    lsum = swapadd32(lsum); const float inv = 1.0f / lsum;
    LAS float* ox = OX + (qs * 32 + r32) * 65;
    if (s == 1) {
#pragma unroll
        for (int d0 = 0; d0 < 2; ++d0)
#pragma unroll
            for (int r = 0; r < 16; ++r) ox[32 * d0 + crow_(r, hi)] = o[d0][r] * inv; }
    LDS_WAIT(); __builtin_amdgcn_s_barrier(); asm volatile("" ::: "memory");
    if (s == 0) {
        float ss = 0.f;
#pragma unroll
        for (int d0 = 0; d0 < 2; ++d0)
#pragma unroll
            for (int r = 0; r < 16; ++r) { const float v = o[d0][r] * inv - lam * ox[32 * d0 + crow_(r, hi)]; o[d0][r] = v; ss += v * v; }
        ss = swapadd32(ss); const float rs = rsqrtf(ss * (1.0f / 64) + EPS) * (1.0f - lam_init);
        const int qpos = q0 + r32;
        if (qpos < L) { bf16* brp = BR + (size_t)(rowb + qpos) * D + 768 + h * 64;
#pragma unroll
            for (int d0 = 0; d0 < 2; ++d0)
#pragma unroll
                for (int r4 = 0; r4 < 4; ++r4) { const int dv = 32 * d0 + 8 * r4 + 4 * hi; const float* sl = C.in[I_SUBLN] + l * 64 + dv;
                    const unsigned w0 = pk2(o[d0][4 * r4] * rs * sl[0], o[d0][4 * r4 + 1] * rs * sl[1]), w1 = pk2(o[d0][4 * r4 + 2] * rs * sl[2], o[d0][4 * r4 + 3] * rs * sl[3]);
                    *(unsigned long long*)(brp + dv) = (unsigned long long)w0 | ((unsigned long long)w1 << 32); } }
    }
    LDS_WAIT(); __builtin_amdgcn_s_barrier(); asm volatile("" ::: "memory");
}
constexpr int PSTR = 68;
__device__ __forceinline__ pg8::bf16x8 cvt8(const f32x4 a, const f32x4 b) { v4u w; w.x = pg8::cvt_pk_bf16(a[0], a[1]); w.y = pg8::cvt_pk_bf16(a[2], a[3]); w.z = pg8::cvt_pk_bf16(b[0], b[1]); w.w = pg8::cvt_pk_bf16(b[2], b[3]); return __builtin_bit_cast(pg8::bf16x8, w); }
__device__ __forceinline__ void attn_sample_item(const Ctx& C, int l, int b, int split) {
    THREAD_IDS();
    const int h = wave & 3, half = wave >> 2, c16 = lane & 15, g = lane >> 4, srow = c16 >> 3, t = c16 & 7;
    const bf16* QNB = WSP(bf16, WS_QNB); const int* PT = (const int*)C.in[I_PT];
    const float* CK = C.in[I_CK] + (size_t)l * NPOOL * PAGE * 256; const float* CV = C.in[I_CV] + (size_t)l * NPOOL * PAGE * 256;
    LAS float* BT = (LAS float*)C.lds;
    BT[tid] = (C.in[I_RELB][t5_bucket(tid & 127) * 4 + (tid >> 7)] - C.in[I_RELB][31 * 4 + (tid >> 7)]) * LOG2E;
    const v4u z4 = {0u, 0u, 0u, 0u};
    const v4u q0w = srow == 0 ? *(const v4u*)(QNB + (size_t)(MP + b * 8 + t) * 256 + h * 64 + 8 * g) : z4, q1w = srow == 1 ? *(const v4u*)(QNB + (size_t)(MP + b * 8 + t) * 256 + h * 64 + 32 + 8 * g) : z4;
    const pg8::bf16x8 qf0 = __builtin_bit_cast(pg8::bf16x8, q0w), qf1 = __builtin_bit_cast(pg8::bf16x8, q1w);
    LDS_WAIT(); __builtin_amdgcn_s_barrier(); asm volatile("" ::: "memory");
    float m = -INFINITY, lsum = 0.f; f32x4 o[4];
#pragma unroll
    for (int db = 0; db < 4; ++db) o[db] = (f32x4){0.f, 0.f, 0.f, 0.f};
    const int kk0 = split * 1024 + half * 512;
    const int pg0 = __builtin_amdgcn_readfirstlane(PT[b * NPAGES + (kk0 >> 7)]), pg1 = __builtin_amdgcn_readfirstlane(PT[b * NPAGES + (kk0 >> 7) + 1]), pg2 = __builtin_amdgcn_readfirstlane(PT[b * NPAGES + (kk0 >> 7) + 2]), pg3 = __builtin_amdgcn_readfirstlane(PT[b * NPAGES + (kk0 >> 7) + 3]);
#define SA_LOAD(KR, VR, st) do { const int kk_ = kk0 + 32 * (st); const int pi_ = (st) >> 2; const int page_ = pi_ == 0 ? pg0 : pi_ == 1 ? pg1 : pi_ == 2 ? pg2 : pg3; const size_t base_ = ((size_t)(page_ * PAGE + (kk_ & 127)) * 4 + h) * 64; \
        _Pragma("unroll") for (int T = 0; T < 2; ++T) _Pragma("unroll") for (int ks = 0; ks < 2; ++ks) { const float* p = CK + base_ + (size_t)(16 * T + c16) * 256 + 32 * ks + 8 * g; KR[T][ks][0] = *(const f32x4*)p; KR[T][ks][1] = *(const f32x4*)(p + 4); } \
        _Pragma("unroll") for (int db = 0; db < 4; ++db) _Pragma("unroll") for (int j = 0; j < 8; ++j) { const int kv = j < 4 ? 4 * g + j : 16 + 4 * g + (j - 4); VR[db][j] = CV[base_ + (size_t)kv * 256 + 16 * db + c16]; } } while (0)
#define SA_MATH(KR, VR, st) do { const int kk = kk0 + 32 * (st); f32x4 sv[2]; \
        _Pragma("unroll") for (int T = 0; T < 2; ++T) { sv[T] = (f32x4){0.f, 0.f, 0.f, 0.f}; \
            sv[T] = __builtin_amdgcn_mfma_f32_16x16x32_bf16(cvt8(KR[T][0][0], KR[T][0][1]), qf0, sv[T], 0, 0, 0); \
            sv[T] = __builtin_amdgcn_mfma_f32_16x16x32_bf16(cvt8(KR[T][1][0], KR[T][1][1]), qf1, sv[T], 0, 0, 0); } \
        if (kk + 31 + 128 > PAST) { \
            _Pragma("unroll") for (int T = 0; T < 2; ++T) _Pragma("unroll") for (int r = 0; r < 4; ++r) { const int n = PAST + t - (kk + 16 * T + 4 * g + r); if (n < 128) sv[T][r] += BT[h * 128 + n]; } } \
        float mt = fmaxf(fmaxf(fmaxf(sv[0][0], sv[0][1]), fmaxf(sv[0][2], sv[0][3])), fmaxf(fmaxf(sv[1][0], sv[1][1]), fmaxf(sv[1][2], sv[1][3]))); \
        mt = fmaxf(mt, __shfl_xor(mt, 16)); mt = fmaxf(mt, __shfl_xor(mt, 32)); \
        const float mn = fmaxf(m, mt); const float al = __builtin_amdgcn_exp2f(m - mn); m = mn; float ps = 0.f; \
        _Pragma("unroll") for (int T = 0; T < 2; ++T) _Pragma("unroll") for (int r = 0; r < 4; ++r) { sv[T][r] = __builtin_amdgcn_exp2f(sv[T][r] - m); ps += sv[T][r]; } \
        lsum = lsum * al + ps; const pg8::bf16x8 pf = cvt8(sv[0], sv[1]); \
        _Pragma("unroll") for (int db = 0; db < 4; ++db) { o[db] = o[db] * al; \
            const f32x4 va = {VR[db][0], VR[db][1], VR[db][2], VR[db][3]}, vb = {VR[db][4], VR[db][5], VR[db][6], VR[db][7]}; \
            o[db] = __builtin_amdgcn_mfma_f32_16x16x32_bf16(cvt8(va, vb), pf, o[db], 0, 0, 0); } } while (0)
    f32x4 krA[2][2][2], krB[2][2][2]; float vrA[4][8], vrB[4][8];
    SA_LOAD(krA, vrA, 0);
#pragma unroll 1
    for (int step = 0; step < 16; step += 2) {
        SA_LOAD(krB, vrB, step + 1);
        SA_MATH(krA, vrA, step);
        if (step + 2 < 16) SA_LOAD(krA, vrA, step + 2);
        SA_MATH(krB, vrB, step + 1);
    }
#undef SA_LOAD
#undef SA_MATH
    lsum += __shfl_xor(lsum, 16); lsum += __shfl_xor(lsum, 32);
    float* pp = WSP(float, WS_PART) + ((((size_t)b * 4 + h) * 16 + split * 2 + half) * 16 + c16) * PSTR;
#pragma unroll
    for (int db = 0; db < 4; ++db) *(f32x4*)(pp + 16 * db + 4 * g) = o[db];
    if (g == 0) { pp[64] = m; pp[65] = lsum; }
    LDS_WAIT(); __builtin_amdgcn_s_barrier(); asm volatile("" ::: "memory");
}
__device__ __forceinline__ void n3_attn_sample_combine(const Ctx& C, int l, float lam_init) {
    THREAD_IDS();
    const float lam = lam_of(C, l, lam_init);
    const bf16* QNB = WSP(bf16, WS_QNB); const bf16* KNB = WSP(bf16, WS_KNB); const bf16* ZM = WSP(bf16, WS_ZMIX); bf16* BR = WSP(bf16, WS_BR);
    for (int it = gw; it < DB * 4 * DS; it += NGW) {
        const int b = it >> 5, h = (it >> 3) & 3, t = it & 7; float os[2];
        const float far = C.in[I_RELB][31 * 4 + h];
        float sn[2][8];
        { const float qv = bf2f(QNB[(size_t)(MP + b * 8 + t) * 256 + h * 64 + lane]);
#pragma unroll
          for (int jj = 0; jj < 8; ++jj) { float p = qv * bf2f(KNB[(size_t)(MP + b * 8 + jj) * 256 + h * 64 + lane]);
              p += __shfl_xor(p, 1); p += __shfl_xor(p, 2); p += __shfl_xor(p, 4); p += __shfl_xor(p, 8); p += __shfl_xor(p, 16);
              const float bias = (C.in[I_RELB][t5_bucket(t - jj < 0 ? 0 : t - jj) * 4 + h] - far) * LOG2E;
              sn[0][jj] = jj <= t ? __shfl(p, 0) + bias : -INFINITY; sn[1][jj] = jj <= t ? __shfl(p, 32) + bias : -INFINITY; } }
#pragma unroll
        for (int s = 0; s < 2; ++s) {
            const float* pb = WSP(float, WS_PART) + ((((size_t)b * 4 + h) * 16) * 16 + s * 8 + t) * PSTR;
            float mm = -INFINITY; float pm[16];
#pragma unroll
            for (int pi = 0; pi < 16; ++pi) { pm[pi] = pb[(size_t)pi * 16 * PSTR + 64]; mm = fmaxf(mm, pm[pi]); }
#pragma unroll
            for (int jj = 0; jj < 8; ++jj) mm = fmaxf(mm, sn[s][jj]);
            float ll = 0.f, oo = 0.f;
#pragma unroll
            for (int pi = 0; pi < 16; ++pi) { const float* pr = pb + (size_t)pi * 16 * PSTR; const float w = __builtin_amdgcn_exp2f(pm[pi] - mm); ll += pr[65] * w; oo += pr[lane] * w; }
#pragma unroll
            for (int jj = 0; jj < 8; ++jj) { const float w = __builtin_amdgcn_exp2f(sn[s][jj] - mm); ll += w; oo += w * bf2f(ZM[(size_t)(MP + b * 8 + jj) * NMIXP + D_V + h * 64 + lane]); }
            os[s] = oo / ll;
        }
        const float o = os[0] - lam * os[1]; const float ms = wave_sum(o * o) * (1.0f / 64);
        BR[(size_t)(MP + b * 8 + t) * D + 768 + h * 64 + lane] = (bf16)f2bf(o * rsqrtf(ms + EPS) * C.in[I_SUBLN][l * 64 + lane] * (1.0f - lam_init));
    }
}

__device__ __forceinline__ void n3_la_finalize(const Ctx& C, int l) {
    THREAD_IDS();
    const float* LAO = WSP(float, WS_LAO); const bf16* ZM = WSP(bf16, WS_ZMIX); bf16* BR = WSP(bf16, WS_BR);
    const bool ret = lane < 32; const int hd = (lane >> 3) & 3, c8 = (lane & 7) * 8;
    float gn[8];
#pragma unroll
    for (int j = 0; j < 8; ++j) gn[j] = (ret ? C.in[I_RGN] : C.in[I_GGN])[(l * 4 + hd) * 64 + c8 + j];
    for (int r0 = gw * 4; r0 < MP; r0 += NGW * 4) {
        f32x4 a4[4], b4[4]; v4u g4[4];
#pragma unroll
        for (int u = 0; u < 4; ++u) { const int r = min(r0 + u, MP - 1); a4[u] = *(const f32x4*)(LAO + (size_t)r * 512 + 8 * lane); b4[u] = *(const f32x4*)(LAO + (size_t)r * 512 + 8 * lane + 4);
            g4[u] = *(const v4u*)(ZM + (size_t)r * NMIXP + (ret ? R_G : G_R) + hd * 64 + c8); }
#pragma unroll
        for (int u = 0; u < 4; ++u) { const int r = r0 + u; if (r >= MP) break;
            float x[8] = {a4[u][0], a4[u][1], a4[u][2], a4[u][3], b4[u][0], b4[u][1], b4[u][2], b4[u][3]}, g[8]; unpack8(g4[u], g);
            float s = ((x[0] + x[1]) + (x[2] + x[3])) + ((x[4] + x[5]) + (x[6] + x[7]));
            s += __shfl_xor(s, 1); s += __shfl_xor(s, 2); s += __shfl_xor(s, 4);
            const float mean = ret ? s * (1.0f / 64) : 0.f; float q2 = 0.f;
#pragma unroll
            for (int j = 0; j < 8; ++j) { x[j] -= mean; q2 += x[j] * x[j]; }
            q2 += __shfl_xor(q2, 1); q2 += __shfl_xor(q2, 2); q2 += __shfl_xor(q2, 4);
            const float rs = rsqrtf(q2 * (1.0f / 64) + EPS);
#pragma unroll
            for (int j = 0; j < 8; ++j) x[j] = siluf_(g[j]) * x[j] * rs * gn[j];
            *(v4u*)(BR + (size_t)r * D + 256 + 8 * lane) = pack8(x); }
    }
}

constexpr int NQB_ATT = (L + 127) / 128;
constexpr int IT_LA = 32, IT_SS = IT_LA + DB * 8, IT_AT = IT_SS + 16 * NQB_ATT, IT_LS = IT_AT + 32, IT_CV = IT_LS + (MR + 63) / 64, IT_END = IT_CV;
__device__ __forceinline__ void n2_phase(const Ctx& C, int l, float lam_init, int qslot) {
    THREAD_IDS();
    const float lam = lam_of(C, l, lam_init);
    float mb;
    { float mq = 0.f, mk = 0.f, mbias = 0.f;
#pragma unroll 1
      for (int i = 0; i < 32; ++i) { mq = fmaxf(mq, fabsf(C.in[I_QN][l * 32 + i])); mk = fmaxf(mk, fabsf(C.in[I_KN][l * 32 + i])); }
#pragma unroll 1
      for (int i = 0; i < 128; ++i) mbias = fmaxf(mbias, C.in[I_RELB][i] - C.in[I_RELB][31 * 4 + (i & 3)]);
      mb = 1.02f * 1.4426950408889634f * 5.656854249492381f * mq * mk + 1.4426950408889634f * mbias; }
    unsigned* qw = (unsigned*)(C.ws + WS_CTL) + CW_QUEUE + 64 * qslot;
    volatile LAS int* slot = (volatile LAS int*)(C.lds + MISC_OFF + 64);
    if (blockIdx.x < IT_LA) { const int it = blockIdx.x; const int b = (it >> 2) & 3, h = it & 3; if (it < 16) la_chunked<64, true>(C, l, false, b, h); else la_chunked<32, false>(C, l, false, b, h); }
    for (;;) {
        if (tid == 0) slot[0] = (int)__hip_atomic_fetch_add(qw, 1u, __ATOMIC_RELAXED, __HIP_MEMORY_SCOPE_AGENT);
        __syncthreads();
        const int qi = slot[0];
        const int it = qi < 3 * DB * 8 ? ((qi % 3) ? IT_SS + 2 * (qi / 3) + (qi % 3) - 1 : IT_LA + qi / 3) : qi + IT_LA;
        __syncthreads();
        if (it >= IT_END) break;
        if (it < IT_SS) { const int i2 = it - IT_LA; attn_sample_item(C, l, i2 >> 3, i2 & 7); }
        else if (it < IT_AT) { const int i2 = it - IT_SS; attn_prompt_item(C, l, (i2 & 15) >> 2, i2 & 3, NQB_ATT - 1 - (i2 >> 4), lam, lam_init, mb); }
        else if (it < IT_LS) { const int i2 = (it - IT_AT) * 8 + wave; const int b = (i2 >> 2) & 31, h = i2 & 3; if (i2 < 128) la_seq<64, true>(C, l, true, b, h); else la_seq<32, false>(C, l, true, b, h); }
        else { conv_rows_item(C, l, it - IT_LS); conv_state_item(C, l, it - IT_LS, IT_CV - IT_LS); }
    }
}

template <int l> __device__ __forceinline__ void layer_fwd(const Ctx& C, const XcdBarrier& bar) {
#define GRID_BAR() xcd_barrier<false>(bar)
    LAS unsigned char* ring = C.lds + RING_OFF;
    float* SS = WSP(float, WS_SS); float* H = WSP(float, WS_H); bf16* HB = WSP(bf16, WS_HB); bf16* ACT = WSP(bf16, WS_ACT); bf16* ZMIX = WSP(bf16, WS_ZMIX); bf16* GATES = WSP(bf16, WS_GATES);
    bf16* BR = WSP(bf16, WS_BR); bf16* MERGED = WSP(bf16, WS_MERGED);
    constexpr float lam_init = l == 0 ? 0.2f : 0.35550906759096926f;
    constexpr bool last = (l == DEPTH - 1);
    { pg8::Gemm g{HB, WSP(bf16, WS_W1 + (size_t)(l * 2 + 0) * SZ_W1), D, D, D}; pg8::StaticOrder S; S.init(M, 2 * DFF, C.G, (int)blockIdx.x);
      EpiGLU E{ACT, SS + (size_t)(l * 3 + 0) * M * 16}; pg8::gemm_phase<EpiGLU, pg8::StaticOrder, true, true>(ring, g, S, E); }
    GRID_BAR();
    { pg8::HeadOrder S; S.init(M, D, C.G, (int)blockIdx.x); S.limit = C.G; EpiRes<false, 1> E{H, HB, SS + (size_t)(l * 3 + 1) * M * 16, nullptr};
      { pg8::Gemm g{ACT, WSP(bf16, WS_WD + (size_t)(l * 2 + 0) * SZ_WD), DFF, DFF, DFF}; pg8::gemm_phase<EpiRes<false, 1>, pg8::HeadOrder, true, true>(ring, g, S, E); }
      { int kt = DFF / 11; asm volatile("" : "+s"(kt)); pg8::Gemm g{ACT, WSP(bf16, WS_WD + (size_t)(l * 2 + 0) * SZ_WD), DFF, DFF, kt}; pg8::TailOrder T; T.init(M, D, C.G, (int)blockIdx.x); T.limit = C.G; T.nsplit = 11; T.kper = DFF / 11;
        EpiPartial EP{WSP(float, WS_KSP)}; pg8::gemm_phase<EpiPartial, pg8::TailOrder, true, true>(ring, g, T, EP); }
      GRID_BAR();
      ksp_finalize<11>(WSP(float, WS_KSP), S, C.G, E); }
    GRID_BAR();
    { pg8::Gemm g{HB, WSP(bf16, WS_WIN + (size_t)l * SZ_WIN), D, D, D}; pg8::StaticOrder S; S.init(M, NINP, C.G, (int)blockIdx.x);
      EpiZ E{ZMIX, GATES, SS + (size_t)(l * 3 + 1) * M * 16, WSP(float, WS_BINP) + l * NINP}; pg8::gemm_phase<EpiZ, pg8::StaticOrder, true, true>(ring, g, S, E); }
    GRID_BAR();
    n1_prep(C, l);
    GRID_BAR();
    n2_phase(C, l, lam_init, l);
    GRID_BAR();
    n3_attn_sample_combine(C, l, lam_init);
    n3_la_finalize(C, l);
    GRID_BAR();
    { pg8::Gemm g{BR, WSP(bf16, WS_WBR + (size_t)l * SZ_WBR), D, D, D}; pg8::StaticOrder S; S.init(M, D, C.G, (int)blockIdx.x);
      EpiMergeR E{MERGED, GATES}; pg8::gemm_phase<EpiMergeR, pg8::StaticOrder, true, true, 4>(ring, g, S, E); }
    GRID_BAR();
    { pg8::HeadOrder S; S.init(M, D, C.G, (int)blockIdx.x); S.limit = C.G; EpiRes<false, 2> E{H, HB, SS + (size_t)(l * 3 + 2) * M * 16, nullptr};
      { pg8::Gemm g{MERGED, WSP(bf16, WS_WOUT + (size_t)l * SZ_WOUT), D, D, D}; pg8::gemm_phase<EpiRes<false, 2>, pg8::HeadOrder, true, true>(ring, g, S, E); }
      { int kt = D / 4; asm volatile("" : "+s"(kt)); pg8::Gemm g{MERGED, WSP(bf16, WS_WOUT + (size_t)l * SZ_WOUT), D, D, kt}; pg8::TailOrder T; T.init(M, D, C.G, (int)blockIdx.x); T.limit = C.G; T.nsplit = 4; T.kper = D / 4;
        EpiPartial EP{WSP(float, WS_KSP)}; pg8::gemm_phase<EpiPartial, pg8::TailOrder, true, true>(ring, g, T, EP); }
      GRID_BAR();
      ksp_finalize<4>(WSP(float, WS_KSP), S, C.G, E); }
    GRID_BAR();
    { pg8::Gemm g{HB, WSP(bf16, WS_W1 + (size_t)(l * 2 + 1) * SZ_W1), D, D, D}; pg8::StaticOrder S; S.init(M, 2 * DFF, C.G, (int)blockIdx.x);
      EpiGLU E{ACT, SS + (size_t)(l * 3 + 2) * M * 16}; pg8::gemm_phase<EpiGLU, pg8::StaticOrder, true, true>(ring, g, S, E); }
    GRID_BAR();
    { pg8::HeadOrder S; S.init(M, D, C.G, (int)blockIdx.x); S.limit = C.G; EpiRes<last, 1> E{H, HB, last ? nullptr : SS + (size_t)((l + 1) * 3) * M * 16, C.out};
      { pg8::Gemm g{ACT, WSP(bf16, WS_WD + (size_t)(l * 2 + 1) * SZ_WD), DFF, DFF, DFF}; pg8::gemm_phase<EpiRes<last, 1>, pg8::HeadOrder, true, true>(ring, g, S, E); }
      { int kt = DFF / 11; asm volatile("" : "+s"(kt)); pg8::Gemm g{ACT, WSP(bf16, WS_WD + (size_t)(l * 2 + 1) * SZ_WD), DFF, DFF, kt}; pg8::TailOrder T; T.init(M, D, C.G, (int)blockIdx.x); T.limit = C.G; T.nsplit = 11; T.kper = DFF / 11;
        EpiPartial EP{WSP(float, WS_KSP)}; pg8::gemm_phase<EpiPartial, pg8::TailOrder, true, true>(ring, g, T, EP); }
      GRID_BAR();
      ksp_finalize<11>(WSP(float, WS_KSP), S, C.G, E); }
#undef GRID_BAR
}

__global__ void __launch_bounds__(NWAVES * 64, 2) fwd(Params P) {
    extern __shared__ __attribute__((aligned(16))) unsigned char lds[];
    Ctx C;
    C.in = P.in; C.out = P.out; C.ws = P.ws; C.lds = (LAS unsigned char*)lds;
    C.G = gridDim.x;
    volatile LAS unsigned* MISC = (volatile LAS unsigned*)(C.lds + MISC_OFF);
    for (int u = threadIdx.x; u < (LDS_BYTES - LDSCTL_OFF) / 4; u += NWAVES * 64) ((LAS unsigned*)(C.lds + LDSCTL_OFF))[u] = 0u;
    __syncthreads();
    unsigned* ctl = (unsigned*)(C.ws + WS_CTL);
    XcdBarrier bar = xcd_barrier_post(ctl + CW_BAR, MISC + 8);
    p0_prologue(C, P);
    xcd_barrier<true>(bar);
    layer_fwd<0>(C, bar);
    xcd_barrier<false>(bar);
    layer_fwd<1>(C, bar);
}

extern "C" void kernel_launch(void* const* d_in, const int* in_sizes, int n_in, void* d_out, int out_size, void* d_ws, size_t ws_size, hipStream_t stream) {
    static int grid = 0;
    if (grid == 0) {
        if (n_in != N_INPUTS || (size_t)out_size != O_END || ws_size < WS_END) { fprintf(stderr, "kernel_launch: unexpected shapes: n_in %d out %d (want %zu) ws %zu (want %zu)\n", n_in, out_size, (size_t)O_END, ws_size, (size_t)WS_END); grid = -1; return; }
        int dev = 0, cus = 0, per_cu = 0;
        if (hipGetDevice(&dev) != hipSuccess || hipDeviceGetAttribute(&cus, hipDeviceAttributeMultiprocessorCount, dev) != hipSuccess) { grid = -1; return; }
        if (hipFuncSetAttribute((const void*)fwd, hipFuncAttributeMaxDynamicSharedMemorySize, LDS_BYTES) != hipSuccess) { fprintf(stderr, "kernel_launch: hipFuncSetAttribute failed\n"); grid = -1; return; }
        if (hipOccupancyMaxActiveBlocksPerMultiprocessor(&per_cu, (const void*)fwd, NWAVES * 64, LDS_BYTES) != hipSuccess || per_cu < 1) { fprintf(stderr, "kernel_launch: occupancy query says %d blocks per CU\n", per_cu); }
        (void)hipGetLastError();
        grid = cus;
    }
    if (grid < 0) return;
    if (hipMemsetAsync((char*)d_ws + WS_CTL, 0, CTL_ZERO_BYTES, stream) != hipSuccess) return;
    Params p{};
    for (int i = 0; i < N_INPUTS; ++i) p.in[i] = (const float*)d_in[i];
    p.out = (float*)d_out; p.ws = (unsigned char*)d_ws;
    for (int i = 0; i < 32; ++i) p.inv_freq[i] = (float)pow(10000.0, -(double)i / 32.0);
    hipLaunchKernelGGL(fwd, dim3(grid), dim3(NWAVES * 64), LDS_BYTES, stream, p);
}
```

```cpp
#include <hip/hip_runtime.h>
#include <cstdio>
#include <cstdint>
#include <cmath>

namespace pg8 {
#define PG8_LAS __attribute__((address_space(3)))
typedef unsigned short bf16_t;
typedef short bf16x8 __attribute__((ext_vector_type(8)));
typedef float f32x4 __attribute__((ext_vector_type(4)));
typedef unsigned u32x4 __attribute__((ext_vector_type(4)));
constexpr int BM = 256, BK = 64, HALF = 128, HTB = HALF * BK * 2  , STAGE_BYTES = 8 * HTB, NXCD = 8, WGM = 8;

__host__ __device__ __forceinline__ int lds_byte(int r, int c) { const int st = (r >> 4) * 2 + (c >> 5), rr = r & 15, cc = c & 31, ob = rr * 64 + cc * 2; return st * 1024 + (ob ^ (((ob >> 9) & 1) << 5)); }
__host__ __device__ __forceinline__ void stage_rc(int b, int& R, int& C) { const int st = b / 1024, sb = b % 1024, swz = sb ^ (((sb >> 9) & 1) << 5); R = (st >> 1) * 16 + swz / 64; C = (st & 1) * 32 + (swz % 64) / 2; }
__host__ __device__ __forceinline__ int perm32(int rho) { const int n = rho >> 4, i = rho & 15; return 8 * (i >> 2) + 4 * n + (i & 3); }

struct Unit { int pm, pn, acol, bcol; };
struct Gemm { const bf16_t* A; const bf16_t* Bt; int lda, ldb, K, kseg0; };

struct StaticOrder {
    int nM, nN, nwg, G, c;
    __host__ __device__ void init(int M, int N, int G_, int c_) { nM = M / BM; nN = N / BM; nwg = nM * nN; G = G_; c = c_; }
    __host__ __device__ void unit_of(int L, Unit& u) const {
        int wgid = L; { const int q = nwg / NXCD, r = nwg % NXCD, xcd = wgid % NXCD, off = wgid / NXCD; wgid = (xcd < r ? xcd * (q + 1) : r * (q + 1) + (xcd - r) * q) + off; }
        const int nig = WGM * nN, gid = wgid / nig, fm = gid * WGM, gsz = (nM - fm) < WGM ? (nM - fm) : WGM;
        u.pm = fm + ((wgid % nig) % gsz); u.pn = (wgid % nig) / gsz; u.acol = 0; u.bcol = 0;
    }
    __host__ __device__ bool next(int i, Unit& u) const { const long L = (long)i * G + c; if (L >= nwg) return false; unit_of((int)L, u); return true; }
};
struct HeadOrder : StaticOrder { int limit; __host__ __device__ bool next(int i, Unit& u) const { const long L = (long)i * G + c; if (L >= limit || L >= nwg) return false; unit_of((int)L, u); return true; } };
struct TailOrder : StaticOrder { int limit, nsplit, kper;
    __host__ __device__ bool next(int i, Unit& u) const {
        if (i > 0 || c >= (nwg - limit) * nsplit) return false;
        unit_of(limit + c / nsplit, u); u.acol = u.bcol = (c % nsplit) * kper; return true; } };
__device__ __forceinline__ unsigned cvt_pk_bf16(float lo, float hi) { unsigned r; asm volatile("v_cvt_pk_bf16_f32 %0, %1, %2" : "=v"(r) : "v"(lo), "v"(hi)); return r; }

template <class Epi, class Sched, bool ALIGN_EPI = false, bool SP2 = false, int SEG = 0>
__device__ __forceinline__ void gemm_phase(PG8_LAS unsigned char* lds, const Gemm g, const Sched& S, const Epi& E) {
    int tid_ = threadIdx.x; asm volatile("" : "+v"(tid_));
    const int tid = tid_, wid = __builtin_amdgcn_readfirstlane(tid >> 6), lane = tid & 63, wr = wid >> 2, wc = wid & 3, fr = lane & 15, fq = lane >> 4;
    const int nt = g.K / BK;
    unsigned voffA[2], voffB[2];
#pragma unroll
    for (int i = 0; i < 2; ++i) { int R, C; stage_rc(tid * 16 + i * 8192, R, C); const int Rb = Epi::PERM ? ((R & ~31) + perm32(R & 31)) : R;
        voffA[i] = (unsigned)(R * g.lda + C) * 2u; voffB[i] = (unsigned)(Rb * g.ldb + C) * 2u; }
    const size_t kstep = (size_t)(BK * 2);
    const size_t hstepA = (size_t)HALF * g.lda * 2, hstepB = (size_t)HALF * g.ldb * 2;
    const size_t tstepA = 2 * hstepA, tstepB = 2 * hstepB;
    const unsigned ldsw = (unsigned)wid * 1024u;
    const int aoff = lds_byte(wr * 64 + fr, fq * 8), boff = lds_byte(wc * 32 + fr, fq * 8);
#define PG8_SA(b, h) (((b) * 2 + (h)) * HTB)
#define PG8_SB(b, h) ((4 + (b) * 2 + (h)) * HTB)
#define PG8_STAGE(bufoff, gbase, voff) do { _Pragma("unroll") for (int _i = 0; _i < 2; ++_i) \
        __builtin_amdgcn_global_load_lds((const unsigned*)((const char*)(gbase) + (voff)[_i]), (PG8_LAS unsigned*)(lds + (bufoff) + ldsw + _i * 8192), 16, 0, 0); } while (0)
#define PG8_LDA(dst, b, h) do { _Pragma("unroll") for (int m = 0; m < 4; ++m) _Pragma("unroll") for (int k = 0; k < 2; ++k) dst[m][k] = *(const PG8_LAS bf16x8*)(lds + PG8_SA(b, h) + aoff + m * 2048 + k * 1024); } while (0)
#define PG8_LDB(dst, b, h) do { _Pragma("unroll") for (int n = 0; n < 2; ++n) _Pragma("unroll") for (int k = 0; k < 2; ++k) dst[n][k] = *(const PG8_LAS bf16x8*)(lds + PG8_SB(b, h) + boff + n * 2048 + k * 1024); } while (0)
#define PG8_MMA(ai, bj, At, Bt) do { __builtin_amdgcn_s_setprio(1); _Pragma("unroll") for (int m = 0; m < 4; ++m) _Pragma("unroll") for (int n = 0; n < 2; ++n) _Pragma("unroll") for (int k = 0; k < 2; ++k) \
        acc[ai][bj][m][n] = __builtin_amdgcn_mfma_f32_16x16x32_bf16(Bt[n][k], At[m][k], acc[ai][bj][m][n], 0, 0, 0); __builtin_amdgcn_s_setprio(0); } while (0)
#define PG8_WAIT_V(n) asm volatile("s_waitcnt vmcnt(" #n ")" ::: "memory")
#define PG8_WAIT_L(n) asm volatile("s_waitcnt lgkmcnt(" #n ")" ::: "memory")
#define PG8_BAR __builtin_amdgcn_s_barrier()
#define PG8_SCHED __builtin_amdgcn_sched_barrier(0)
    Unit cur, nxt; int ui = 0;
    if (!S.next(0, cur)) return;
    f32x4 acc[2][2][4][2];
#pragma unroll
    for (int a = 0; a < 2; ++a)
#pragma unroll
        for (int b = 0; b < 2; ++b)
#pragma unroll
            for (int m = 0; m < 4; ++m)
#pragma unroll
                for (int n = 0; n < 2; ++n) acc[a][b][m][n] = (f32x4){0.f, 0.f, 0.f, 0.f};
    bf16x8 At[4][2], B0[2][2], B1[2][2];
    const char* cA = (const char*)g.A + (size_t)cur.pm * tstepA + (size_t)cur.acol * 2; const char* cB = (const char*)g.Bt + (size_t)cur.pn * tstepB + (size_t)cur.bcol * 2;
#define PG8_KOFF(t) ((SEG > 0) ? (size_t)(((((t) / (SEG > 0 ? SEG : 1)) + g.kseg0) & (nt / (SEG > 0 ? SEG : 1) - 1)) * (SEG > 0 ? SEG : 1) + ((t) % (SEG > 0 ? SEG : 1))) * kstep : (size_t)(t) * kstep)
    const size_t K0 = PG8_KOFF(0);
    cA += K0; cB += K0;
    if constexpr (SP2) {
        PG8_STAGE(PG8_SB(0, 0), cB, voffB); PG8_STAGE(PG8_SB(0, 1), cB + hstepB, voffB); PG8_STAGE(PG8_SA(0, 0), cA, voffA); PG8_STAGE(PG8_SA(0, 1), cA + hstepA, voffA);
        if (wr == 1) PG8_BAR;
        PG8_WAIT_V(2); PG8_BAR;
        PG8_STAGE(PG8_SB(1, 0), cB + kstep, voffB); PG8_STAGE(PG8_SA(1, 0), cA + kstep, voffA); PG8_STAGE(PG8_SB(1, 1), cB + hstepB + kstep, voffB);
        PG8_WAIT_V(6); PG8_BAR;
    } else {
        PG8_STAGE(PG8_SB(0, 0), cB, voffB); PG8_STAGE(PG8_SA(0, 0), cA, voffA); PG8_STAGE(PG8_SB(0, 1), cB + hstepB, voffB); PG8_STAGE(PG8_SA(0, 1), cA + hstepA, voffA);
        if (wr == 1) PG8_BAR;
        PG8_WAIT_V(4); PG8_BAR;
        PG8_STAGE(PG8_SB(1, 0), cB + kstep, voffB); PG8_STAGE(PG8_SA(1, 0), cA + kstep, voffA); PG8_STAGE(PG8_SB(1, 1), cB + hstepB + kstep, voffB);
        PG8_WAIT_V(6); PG8_BAR;
    }
    for (;;) {
        const bool has_next = S.next(ui + 1, nxt);
        const char* nA = has_next ? (const char*)g.A + (size_t)nxt.pm * tstepA + (size_t)nxt.acol * 2 + K0 : cA; const char* nB = has_next ? (const char*)g.Bt + (size_t)nxt.pn * tstepB + (size_t)nxt.bcol * 2 + K0 : cB;
        for (int t = 0; t < nt; t += 2) {
            const bool last = (t == nt - 2);
            const char* a1 = cA - K0 + PG8_KOFF(t + 1);
            const char* a2 = last ? nA : cA - K0 + PG8_KOFF(t + 2); const char* b2 = last ? nB : cB - K0 + PG8_KOFF(t + 2);
            const char* a3 = a2 + kstep; const char* b3 = b2 + kstep;
            if constexpr (SP2) {
            PG8_LDB(B0, 0, 0); PG8_LDB(B1, 0, 1); PG8_SCHED; PG8_LDA(At, 0, 0); PG8_STAGE(PG8_SA(1, 1), a1 + hstepA, voffA);
            PG8_WAIT_V(8); PG8_WAIT_L(0); PG8_BAR; PG8_MMA(0, 0, At, B0); PG8_MMA(0, 1, At, B1); PG8_BAR; PG8_SCHED;
            PG8_LDA(At, 0, 1); PG8_STAGE(PG8_SB(0, 0), b2, voffB); PG8_STAGE(PG8_SB(0, 1), b2 + hstepB, voffB); PG8_STAGE(PG8_SA(0, 0), a2, voffA);
            PG8_WAIT_V(8); PG8_WAIT_L(0); PG8_BAR; PG8_MMA(1, 0, At, B0); PG8_MMA(1, 1, At, B1); PG8_BAR; PG8_SCHED;
            PG8_LDB(B0, 1, 0); PG8_LDB(B1, 1, 1); PG8_SCHED; PG8_LDA(At, 1, 0); PG8_STAGE(PG8_SA(0, 1), a2 + hstepA, voffA);
            PG8_WAIT_V(8); PG8_WAIT_L(0); PG8_BAR; PG8_MMA(0, 0, At, B0); PG8_MMA(0, 1, At, B1); PG8_BAR; PG8_SCHED;
            PG8_LDA(At, 1, 1); PG8_STAGE(PG8_SB(1, 0), b3, voffB); PG8_STAGE(PG8_SB(1, 1), b3 + hstepB, voffB); PG8_STAGE(PG8_SA(1, 0), a3, voffA);
            PG8_WAIT_V(8); PG8_WAIT_L(0); PG8_BAR; PG8_MMA(1, 0, At, B0); PG8_MMA(1, 1, At, B1); PG8_BAR; PG8_SCHED;
            } else {
            PG8_LDB(B0, 0, 0); PG8_SCHED; PG8_LDA(At, 0, 0); PG8_STAGE(PG8_SA(1, 1), a1 + hstepA, voffA);
            PG8_WAIT_L(8); PG8_BAR; PG8_WAIT_L(0); PG8_MMA(0, 0, At, B0); PG8_BAR; PG8_SCHED;
            PG8_LDB(B1, 0, 1); PG8_STAGE(PG8_SB(0, 0), b2, voffB);
            PG8_BAR; PG8_WAIT_L(0); PG8_MMA(0, 1, At, B1); PG8_BAR;
            PG8_LDA(At, 0, 1); PG8_STAGE(PG8_SA(0, 0), a2, voffA);
            PG8_BAR; PG8_WAIT_L(0); PG8_MMA(1, 0, At, B0); PG8_BAR; PG8_SCHED;
            PG8_STAGE(PG8_SB(0, 1), b2 + hstepB, voffB);
            PG8_WAIT_V(6); PG8_BAR; PG8_MMA(1, 1, At, B1); PG8_BAR;
            PG8_LDB(B0, 1, 0); PG8_SCHED; PG8_LDA(At, 1, 0); PG8_STAGE(PG8_SA(0, 1), a2 + hstepA, voffA);
            PG8_WAIT_L(8); PG8_BAR; PG8_WAIT_L(0); PG8_MMA(0, 0, At, B0); PG8_BAR; PG8_SCHED;
            PG8_LDB(B1, 1, 1); PG8_STAGE(PG8_SB(1, 0), b3, voffB);
            PG8_BAR; PG8_WAIT_L(0); PG8_MMA(0, 1, At, B1); PG8_BAR;
            PG8_LDA(At, 1, 1); PG8_STAGE(PG8_SA(1, 0), a3, voffA);
            PG8_BAR; PG8_WAIT_L(0); PG8_MMA(1, 0, At, B0); PG8_BAR; PG8_SCHED;
            PG8_STAGE(PG8_SB(1, 1), b3 + hstepB, voffB);
            PG8_WAIT_V(6); PG8_BAR; PG8_MMA(1, 1, At, B1); PG8_BAR;
            }
            if constexpr (SEG > 0) { if (((t + 2) % SEG) == 0 && (t + 2) < nt) E.mid(acc, cur, (t + 2) / SEG, g.kseg0); }
        }
        if constexpr (ALIGN_EPI) { if (wr == 0) PG8_BAR; }
        E(acc, cur, wr, wc, fr, fq);
        if (!has_next) break;
#pragma unroll
        for (int a = 0; a < 2; ++a)
#pragma unroll
            for (int b = 0; b < 2; ++b)
#pragma unroll
                for (int m = 0; m < 4; ++m)
#pragma unroll
                    for (int n = 0; n < 2; ++n) acc[a][b][m][n] = (f32x4){0.f, 0.f, 0.f, 0.f};
        cur = nxt; cA = nA; cB = nB; ++ui;
        if constexpr (ALIGN_EPI) { if (wr == 1) PG8_BAR; }
    }
    PG8_WAIT_V(0);
    if constexpr (!ALIGN_EPI) { if (wr == 0) PG8_BAR; }
    PG8_BAR;
#undef PG8_KOFF
#undef PG8_SA
#undef PG8_SB
#undef PG8_STAGE
#undef PG8_LDA
#undef PG8_LDB
#undef PG8_MMA
#undef PG8_WAIT_V
#undef PG8_WAIT_L
#undef PG8_BAR
#undef PG8_SCHED
}
}

constexpr int NWAVES = 8;
constexpr int D = 1024, DFF = 2816, NIN = 7184, NMIX = 3088, NMIXP = 3328, NGATE = 4096, NINP = NMIXP + NGATE;
constexpr int SEQ = 4096, NMETA = 16, L = SEQ + NMETA, BATCH = 4, DB = 32, DS = 8, PAST = 8192, PAGE = 128, NPAGES = PAST / PAGE, NPOOL = 2560, DEPTH = 2;
constexpr int MP = BATCH * L, MS = DB * DS, MR = MP + MS, M = 16896;
constexpr int NPOS = L + DS;
constexpr float EPS = 1e-6f;
constexpr int C_A = 0, C_G = 256, R_Q = 512, R_K = 768, R_V = 1024, R_G = 1280, G_Q = 1536, G_K = 1664, G_V = 1792, G_R = 2048, G_LOW = 2304, D_Q = 2320, D_K = 2576, D_V = 2832;
constexpr size_t O_YP = 0, O_YS = O_YP + (size_t)BATCH * SEQ * D, O_KP = O_YS + (size_t)MS * D, O_VP = O_KP + (size_t)DEPTH * MP * 256, O_KS = O_VP + (size_t)DEPTH * MP * 256,
                 O_VS = O_KS + (size_t)DEPTH * MS * 256, O_RP = O_VS + (size_t)DEPTH * MS * 256, O_RS = O_RP + (size_t)DEPTH * BATCH * 4 * 64 * 64, O_GP = O_RS + (size_t)DEPTH * DB * 4 * 64 * 64,
                 O_GS = O_GP + (size_t)DEPTH * BATCH * 4 * 32 * 64, O_CP = O_GS + (size_t)DEPTH * DB * 4 * 32 * 64, O_CS = O_CP + (size_t)DEPTH * BATCH * 30 * 256, O_END = O_CS + (size_t)DEPTH * DB * 30 * 256;
enum { I_XP = 0, I_XS, I_CK, I_CV, I_PT, I_SRET, I_SGLA, I_SCONV, I_META, I_RELB, I_NF1, I_F1G, I_F1U, I_F1D, I_NMIX, I_WIN, I_BIN, I_CW, I_CB, I_CLG, I_CLB, I_RGN, I_GAW, I_GAB, I_GGN,
       I_QN, I_KN, I_LQ1, I_LK1, I_LQ2, I_LK2, I_SUBLN, I_WBR, I_WOUT, I_NF2, I_F2G, I_F2U, I_F2D, N_INPUTS };

constexpr size_t MiB = 1u << 20;
constexpr size_t WS_CTL = 0, CTL_ZERO_BYTES = 64 * 1024;
constexpr size_t SZ_SS = (size_t)M * 16 * 4;
constexpr size_t SZ_W1 = (size_t)2 * DFF * D * 2, SZ_WD = (size_t)D * DFF * 2, SZ_WIN = (size_t)NINP * D * 2, SZ_WBR = (size_t)4 * D * 256 * 2, SZ_WOUT = (size_t)D * D * 2;
constexpr size_t WS_W1 = 4 * MiB;
constexpr size_t WS_WD = WS_W1 + 4 * SZ_W1;
constexpr size_t WS_WIN = WS_WD + 4 * SZ_WD;
constexpr size_t WS_WBR = WS_WIN + 2 * SZ_WIN;
constexpr size_t WS_WOUT = WS_WBR + 2 * SZ_WBR;
constexpr size_t WS_BINP = WS_WOUT + 2 * SZ_WOUT;
constexpr size_t WS_ROPE = WS_BINP + 64 * 1024;
constexpr size_t WS_SS = WS_ROPE + 2 * MiB;
constexpr size_t WS_H = 128 * MiB;
constexpr size_t WS_HB = WS_H + (size_t)M * D * 4;
constexpr size_t WS_ACT = WS_HB + (size_t)M * D * 2;
constexpr size_t WS_ZMIX = WS_ACT + (size_t)M * DFF * 2;
constexpr size_t WS_GATES = WS_ZMIX + (size_t)M * NMIXP * 2;
constexpr size_t WS_BR = WS_GATES + (size_t)M * NGATE * 2;
constexpr size_t WS_MERGED = WS_BR + (size_t)M * D * 2;
constexpr size_t WS_UBUF = WS_MERGED + (size_t)M * D * 2;
constexpr size_t WS_RQ = WS_UBUF + (size_t)M * 256 * 4, WS_RK = WS_RQ + (size_t)M * 256 * 4, WS_QN = WS_RK + (size_t)M * 256 * 4, WS_KN = WS_QN + (size_t)M * 256 * 4, WS_VB = WS_KN + (size_t)M * 256 * 4;
constexpr size_t WS_LDEC = WS_VB + (size_t)M * 256 * 4;
constexpr size_t WS_QNB = WS_LDEC + (size_t)M * 128 * 4;
constexpr size_t WS_KNB = WS_QNB + (size_t)M * 256 * 2;
constexpr size_t WS_PART = WS_KNB + (size_t)M * 256 * 2;
constexpr size_t WS_LAO = WS_PART + (size_t)DB * 4 * 16 * 16 * 68 * 4;
constexpr size_t WS_KSP = WS_LAO + (size_t)M * 512 * 4;
constexpr size_t WS_END = WS_KSP + (size_t)8 * 11 * 65536 * 4;
static_assert(WS_ROPE + 2 * NPOS * 32 * 4 <= WS_SS && WS_SS + 6 * SZ_SS <= WS_H, "weights region overflows");
constexpr int CW_BAR = 4096, CW_QUEUE = 8192, CW_TAIL = 12288;

constexpr int RING_OFF = 0, RING_BYTES = 131072;
constexpr int LDSCTL_OFF = 144384, MISC_OFF = LDSCTL_OFF + 320;
constexpr int LDS_BYTES = 147456;
static_assert(MISC_OFF + 128 <= LDS_BYTES, "LDS map");

#define GAS __attribute__((address_space(1)))
#define LAS __attribute__((address_space(3)))
typedef unsigned short bf16;
typedef unsigned v4u __attribute__((ext_vector_type(4)));
typedef float f32x4 __attribute__((ext_vector_type(4)));
#define LDS_WAIT() asm volatile("s_waitcnt lgkmcnt(0)" ::: "memory")
#define VM_WAIT() asm volatile("s_waitcnt vmcnt(0)" ::: "memory")
__device__ __forceinline__ unsigned f2bf(float f) { unsigned u = __builtin_bit_cast(unsigned, f); return (u + 0x7fffu + ((u >> 16) & 1u)) >> 16; }
__device__ __forceinline__ unsigned pk2(float lo, float hi) { return f2bf(lo) | (f2bf(hi) << 16); }
__device__ __forceinline__ float bf2f(bf16 b) { return __builtin_bit_cast(float, ((unsigned)b) << 16); }
__device__ __forceinline__ float bflo(unsigned w) { return __builtin_bit_cast(float, w << 16); }
__device__ __forceinline__ float bfhi(unsigned w) { return __builtin_bit_cast(float, w & 0xffff0000u); }
__device__ __forceinline__ float wave_sum(float v) {
#pragma unroll
    for (int o = 1; o < 64; o <<= 1) v += __shfl_xor(v, o);
    return v;
}
__device__ __forceinline__ float sigmoidf_(float x) { return __builtin_amdgcn_rcpf(1.0f + __expf(-x)); }
__device__ __forceinline__ float siluf_(float x) { return x * __builtin_amdgcn_rcpf(1.0f + __expf(-x)); }

#define XB_TMO      128
#define XB_XCNT(j)  (256  + 64 * (j))
#define XB_XSUB(j)  (1280 + 64 * (j))
#define XB_XGEN(j)  (2304 + 64 * (j))
#define XB_TOP      3328
#define XB_TOPGEN   3392
#define XCD_BAR_WORDS 3456
#define XB_SPIN_CAP (1u << 22)

__device__ __forceinline__ unsigned xb_ld(unsigned* p)              { return __hip_atomic_load(p, __ATOMIC_RELAXED, __HIP_MEMORY_SCOPE_AGENT); }
__device__ __forceinline__ unsigned xb_add(unsigned* p, unsigned v) { return __hip_atomic_fetch_add(p, v, __ATOMIC_RELAXED, __HIP_MEMORY_SCOPE_AGENT); }
__device__ __forceinline__ unsigned xb_xcc_id() { return (unsigned)__builtin_amdgcn_s_getreg((3 << 11) | 20) & 0xFu; }
#define XB_SPIN(cond, bar) do { unsigned _sp = 0; while (cond) { __builtin_amdgcn_s_sleep(1); \
    if ((++_sp & 255u) == 0u) { if (xb_ld(&(bar)[XB_TMO])) break; if (_sp > XB_SPIN_CAP) { atomicAdd(&(bar)[XB_TMO], 1u); break; } } } } while (0)

struct XcdBarrier { unsigned* bar; unsigned x; volatile LAS unsigned* st; };

__device__ __forceinline__ XcdBarrier xcd_barrier_post(unsigned* bar, volatile LAS unsigned* st) {
    XcdBarrier b; b.bar = bar; b.x = xb_xcc_id(); b.st = st;
    if (threadIdx.x == 0) (void)xb_add(&bar[XB_XCNT(b.x)], 1u);
    return b;
}
__device__ __forceinline__ void xcd_barrier_complete(unsigned* bar, unsigned x, unsigned& nloc, unsigned& nx) {
    const unsigned G = gridDim.x * gridDim.y * gridDim.z;
    unsigned sum, cnt, mine, sp = 0u;
    for (;;) {
        sum = 0u; cnt = 0u; mine = 0u;
#pragma unroll
        for (unsigned j = 0; j < 16; ++j) { const unsigned c = xb_ld(&bar[XB_XCNT(j)]); sum += c; cnt += (c > 0u) ? 1u : 0u; mine = (j == x) ? c : mine; }
        if (sum == G) break;
        __builtin_amdgcn_s_sleep(1);
        if ((++sp & 255u) == 0u) { if (xb_ld(&bar[XB_TMO])) break; if (sp > XB_SPIN_CAP) { atomicAdd(&bar[XB_TMO], 1u); break; } }
    }
    nloc = mine > 0u ? mine : 1u; nx = cnt > 0u ? cnt : 1u;
}
#ifndef FLAT_BAR
#define FLAT_BAR 0
#endif
__device__ __forceinline__ void flat_barrier(const XcdBarrier& b) {
    asm volatile("s_waitcnt vmcnt(0)" ::: "memory");
    __syncthreads();
    if (threadIdx.x == 0) {
        unsigned* bar = b.bar;
        asm volatile("" : "+s"(bar));
        const unsigned epoch = b.st[2] + 1u; b.st[2] = epoch; const unsigned target = epoch * gridDim.x;
        __builtin_amdgcn_fence(__ATOMIC_RELEASE, "agent");
        asm volatile("s_waitcnt vmcnt(0)" ::: "memory");
        (void)xb_add(&bar[XB_TOP], 1u);
        unsigned sp = 0u;
        while (xb_ld(&bar[XB_TOP]) < target) { __builtin_amdgcn_s_sleep(1); if ((++sp & 255u) == 0u) { if (xb_ld(&bar[XB_TMO])) break; if (sp > XB_SPIN_CAP) { atomicAdd(&bar[XB_TMO], 1u); break; } } }
        __builtin_amdgcn_fence(__ATOMIC_ACQUIRE, "agent");
        asm volatile("s_waitcnt vmcnt(0)" ::: "memory");
    }
    __syncthreads();
}
template <bool FIRST> __device__ __forceinline__ void xcd_barrier(const XcdBarrier& b) {
    if (FLAT_BAR) { flat_barrier(b); return; }
    asm volatile("s_waitcnt vmcnt(0)" ::: "memory");
    __syncthreads();
    if (threadIdx.x == 0) {
        unsigned* bar = b.bar;
        asm volatile("" : "+s"(bar));
        __builtin_amdgcn_s_waitcnt(0);
        unsigned nloc = b.st[0], nx = b.st[1];
        if (FIRST) { if (nloc == 0u) { xcd_barrier_complete(bar, b.x, nloc, nx); b.st[0] = nloc; b.st[1] = nx; } }
        const unsigned old = xb_add(&bar[XB_XSUB(b.x)], 1u);
        const unsigned gen = old / nloc;
        if (old + 1u == (gen + 1u) * nloc) {
            __builtin_amdgcn_fence(__ATOMIC_RELEASE, "agent");
            asm volatile("s_waitcnt vmcnt(0)" ::: "memory");
            const unsigned og = xb_add(&bar[XB_TOP], 1u);
            const unsigned tg = og / nx;
            if (og + 1u == (tg + 1u) * nx) {
#pragma unroll
                for (unsigned j = 0; j < 16; ++j) (void)__hip_atomic_fetch_add(&bar[XB_XGEN(j)], 1u, __ATOMIC_RELAXED, __HIP_MEMORY_SCOPE_AGENT);
            }
        }
        XB_SPIN(xb_ld(&bar[XB_XGEN(b.x)]) == gen, bar);
        __builtin_amdgcn_fence(__ATOMIC_ACQUIRE, "agent");
        asm volatile("s_waitcnt vmcnt(0)" ::: "memory");
    }
    __syncthreads();
}

struct Params { const float* in[N_INPUTS]; float* out; unsigned char* ws; float inv_freq[32]; };
static_assert(sizeof(Params) == N_INPUTS * 8 + 16 + 128, "Params has no padding");

struct Ctx {
    const float* const* in; float* out; unsigned char* ws;
    LAS unsigned char* lds;
    int G;
};
#define THREAD_IDS() int tid_ = threadIdx.x; asm volatile("" : "+v"(tid_)); const int tid = tid_, lane = tid & 63, wave = __builtin_amdgcn_readfirstlane(tid >> 6), gw = blockIdx.x * NWAVES + wave, NGW = C.G * NWAVES; (void)tid; (void)lane; (void)wave; (void)gw; (void)NGW
#define WSP(T, off) ((T*)(C.ws + (off)))

__device__ __forceinline__ float rstd_of(const float* ssp, int row) {
    const f32x4 a = *(const f32x4*)(ssp + (size_t)row * 16), b = *(const f32x4*)(ssp + (size_t)row * 16 + 4), c = *(const f32x4*)(ssp + (size_t)row * 16 + 8), d = *(const f32x4*)(ssp + (size_t)row * 16 + 12);
    const float s = (((a[0] + a[1]) + (a[2] + a[3])) + ((b[0] + b[1]) + (b[2] + b[3]))) + (((c[0] + c[1]) + (c[2] + c[3])) + ((d[0] + d[1]) + (d[2] + d[3])));
    return rsqrtf(s * (1.0f / D) + EPS);
}
__device__ __forceinline__ void rstd8(const float* ssp, int row0, int fq, float (&rs)[8]) {
    f32x4 sv[8];
#pragma unroll
    for (int i = 0; i < 8; ++i) sv[i] = *(const f32x4*)(ssp + (size_t)(row0 + (i >> 2) * 128 + (i & 3) * 16) * 16 + 4 * fq);
#pragma unroll
    for (int i = 0; i < 8; ++i) { float s = (sv[i][0] + sv[i][1]) + (sv[i][2] + sv[i][3]); s += __shfl_xor(s, 16); s += __shfl_xor(s, 32); rs[i] = rsqrtf(s * (1.0f / D) + EPS); }
}
#define EPI_IDS() int t_ = threadIdx.x; asm volatile("" : "+v"(t_)); const int wid_ = __builtin_amdgcn_readfirstlane(t_ >> 6), wr = wid_ >> 2, wc = wid_ & 3, fr = t_ & 15, fq = (t_ & 63) >> 4
struct EpiGLU {
    static constexpr bool PERM = true;
    bf16* act; const float* ss;
    __device__ __forceinline__ void operator()(const pg8::f32x4 (&acc)[2][2][4][2], const pg8::Unit& u, int, int, int, int) const {
        EPI_IDS();
        const int row0 = u.pm * 256 + wr * 64 + fr, col0 = u.pn * 128 + wc * 32 + 8 * fq;
        float rs[8]; rstd8(ss, row0, fq, rs);
#pragma unroll
        for (int ai = 0; ai < 2; ++ai)
#pragma unroll
            for (int m = 0; m < 4; ++m) {
                const int row = row0 + ai * 128 + m * 16; const float rstd = rs[ai * 4 + m];
                float o[8];
#pragma unroll
                for (int n = 0; n < 2; ++n)
#pragma unroll
                    for (int j = 0; j < 4; ++j) { const float g = acc[ai][0][m][n][j] * rstd, up = acc[ai][1][m][n][j] * rstd; o[n * 4 + j] = siluf_(g) * up; }
                v4u w; w.x = pg8::cvt_pk_bf16(o[0], o[1]); w.y = pg8::cvt_pk_bf16(o[2], o[3]); w.z = pg8::cvt_pk_bf16(o[4], o[5]); w.w = pg8::cvt_pk_bf16(o[6], o[7]);
                *(v4u*)(act + (size_t)row * DFF + col0) = w;
            }
    }
};
template <bool FINAL, int SCALE2> struct EpiRes {
    static constexpr bool PERM = true;
    float* h; bf16* hb; float* ssout; float* out;
    __device__ __forceinline__ void rowgroup(const pg8::f32x4 (&a)[2][2], int row, int col0, int pn, int wc, int fq) const {
        constexpr float scale = 0.5f * SCALE2; float sq = 0.f;
        long yoff = -1;
        if (FINAL) { if (row < MP) { const int b = row / L, pos = row - b * L; if (pos >= NMETA) yoff = (long)O_YP + ((long)b * SEQ + (pos - NMETA)) * D; } else if (row < MR) yoff = (long)O_YS + (long)(row - MP) * D; }
#pragma unroll
        for (int bj = 0; bj < 2; ++bj) {
            const size_t off = (size_t)row * D + col0 + bj * 128;
            const v4u hw = *(const v4u*)(hb + off);
            f32x4 h0 = (f32x4){bflo(hw.x), bfhi(hw.x), bflo(hw.y), bfhi(hw.y)}, h1 = (f32x4){bflo(hw.z), bfhi(hw.z), bflo(hw.w), bfhi(hw.w)};
            h0 = h0 + a[bj][0] * scale; h1 = h1 + a[bj][1] * scale;
            v4u w; w.x = pg8::cvt_pk_bf16(h0[0], h0[1]); w.y = pg8::cvt_pk_bf16(h0[2], h0[3]); w.z = pg8::cvt_pk_bf16(h1[0], h1[1]); w.w = pg8::cvt_pk_bf16(h1[2], h1[3]);
            *(v4u*)(hb + off) = w;
            sq += (h0[0] * h0[0] + h0[1] * h0[1]) + (h0[2] * h0[2] + h0[3] * h0[3]) + (h1[0] * h1[0] + h1[1] * h1[1]) + (h1[2] * h1[2] + h1[3] * h1[3]);
            if (FINAL && yoff >= 0) { *(f32x4*)(out + yoff + col0 + bj * 128) = h0; *(f32x4*)(out + yoff + col0 + bj * 128 + 4) = h1; }
        }
        sq += __shfl_xor(sq, 16); sq += __shfl_xor(sq, 32);
        if (fq == 0 && ssout) ssout[(size_t)row * 16 + pn * 4 + wc] = sq;
    }
    __device__ __forceinline__ void operator()(const pg8::f32x4 (&acc)[2][2][4][2], const pg8::Unit& u, int, int, int, int) const {
        EPI_IDS();
        const int row0 = u.pm * 256 + wr * 64 + fr, col0 = u.pn * 256 + wc * 32 + 8 * fq;
#pragma unroll
        for (int ai = 0; ai < 2; ++ai)
#pragma unroll
            for (int m = 0; m < 4; ++m) {
                const pg8::f32x4 a[2][2] = {{acc[ai][0][m][0], acc[ai][0][m][1]}, {acc[ai][1][m][0], acc[ai][1][m][1]}};
                rowgroup(a, row0 + ai * 128 + m * 16, col0, u.pn, wc, fq);
                if (m == 3) asm volatile("" ::: "memory");
            }
    }
};
struct EpiZ {
    static constexpr bool PERM = true;
    bf16* zmix; bf16* gates; const float* ss; const float* bias;
    __device__ __forceinline__ void operator()(const pg8::f32x4 (&acc)[2][2][4][2], const pg8::Unit& u, int, int, int, int) const {
        EPI_IDS();
        const int row0 = u.pm * 256 + wr * 64 + fr, col0 = u.pn * 256 + wc * 32 + 8 * fq; const bool isgate = u.pn >= NMIXP / 256;
        f32x4 bv[2][2];
#pragma unroll
        for (int bj = 0; bj < 2; ++bj)
#pragma unroll
            for (int n = 0; n < 2; ++n) bv[bj][n] = *(const f32x4*)(bias + col0 + bj * 128 + 4 * n);
        float rs[8]; rstd8(ss, row0, fq, rs);
#pragma unroll
        for (int ai = 0; ai < 2; ++ai)
#pragma unroll
            for (int m = 0; m < 4; ++m) {
                const int row = row0 + ai * 128 + m * 16; const float rstd = rs[ai * 4 + m];
                if (isgate) {
                    f32x4 g[4];
#pragma unroll
                    for (int bj = 0; bj < 2; ++bj)
#pragma unroll
                        for (int n = 0; n < 2; ++n) { const f32x4 z = acc[ai][bj][m][n] * rstd + bv[bj][n];
#pragma unroll
                            for (int j = 0; j < 4; ++j) g[2 * bj + n][j] = fmaxf(sigmoidf_(z[j]), 9.094947017729282e-13f); }
                    const int d0 = 64 * (u.pn - NMIXP / 256) + 16 * wc + 4 * fq; bf16* gp = gates + (size_t)row * NGATE + d0;
#pragma unroll
                    for (int s = 0; s < 4; ++s) { f32x4 o = g[s];
                        if (s < 3) {
#pragma unroll
                            for (int j = 0; j < 4; ++j) o[j] = g[s][j] * __builtin_amdgcn_rcpf(g[s + 1][j]); }
                        *(unsigned long long*)(gp + s * D) = (unsigned long long)pg8::cvt_pk_bf16(o[0], o[1]) | ((unsigned long long)pg8::cvt_pk_bf16(o[2], o[3]) << 32); }
                } else {
#pragma unroll
                    for (int bj = 0; bj < 2; ++bj) {
                        const f32x4 v0 = acc[ai][bj][m][0] * rstd + bv[bj][0], v1 = acc[ai][bj][m][1] * rstd + bv[bj][1];
                        v4u w; w.x = pg8::cvt_pk_bf16(v0[0], v0[1]); w.y = pg8::cvt_pk_bf16(v0[2], v0[3]); w.z = pg8::cvt_pk_bf16(v1[0], v1[1]); w.w = pg8::cvt_pk_bf16(v1[2], v1[3]);
                        *(v4u*)(zmix + (size_t)row * NMIXP + col0 + bj * 128) = w;
                    }
                }
            }
    }
};
struct EpiPartial {
    static constexpr bool PERM = true;
    float* part;
    __device__ __forceinline__ void operator()(const pg8::f32x4 (&acc)[2][2][4][2], const pg8::Unit& u, int, int, int, int) const {
        int t_ = threadIdx.x; asm volatile("" : "+v"(t_));
        const int slot = blockIdx.x;
        float* p = part + (size_t)slot * 65536 + (size_t)t_ * 4;
#pragma unroll
        for (int ai = 0; ai < 2; ++ai)
#pragma unroll
            for (int bj = 0; bj < 2; ++bj)
#pragma unroll
                for (int m = 0; m < 4; ++m)
#pragma unroll
                    for (int n = 0; n < 2; ++n) *(pg8::f32x4*)(p + (size_t)((((ai * 2 + bj) * 4 + m) * 2 + n) * 2048)) = acc[ai][bj][m][n];
        (void)u;
    }
};
__device__ __forceinline__ void tail_group_sync(unsigned* cnt, unsigned target, unsigned* bar) {
    asm volatile("s_waitcnt vmcnt(0)" ::: "memory");
    __syncthreads();
    if (threadIdx.x == 0) {
        __builtin_amdgcn_fence(__ATOMIC_RELEASE, "agent");
        asm volatile("s_waitcnt vmcnt(0)" ::: "memory");
        (void)xb_add(cnt, 1u);
        XB_SPIN(xb_ld(cnt) < target, bar);
        __builtin_amdgcn_fence(__ATOMIC_ACQUIRE, "agent");
        asm volatile("s_waitcnt vmcnt(0)" ::: "memory");
    }
    __syncthreads();
}
template <int NSPLIT, class Epi> __device__ __forceinline__ void ksp_finalize_local(const float* part, const pg8::StaticOrder& so, int limit, const Epi& E, unsigned* cnt0, unsigned* bar) {
    const int ntail = so.nwg - limit, c = blockIdx.x;
    if (c >= ntail * NSPLIT) return;
    const int tt = c / NSPLIT;
    tail_group_sync(cnt0 + 64 * tt, (unsigned)NSPLIT, bar);
    for (int j = c % NSPLIT; j < 8; j += NSPLIT) {
        const int ai = (j >> 2) & 1, m = j & 3;
        EPI_IDS();
        pg8::f32x4 a[2][2];
#pragma unroll
        for (int bj = 0; bj < 2; ++bj)
#pragma unroll
            for (int n = 0; n < 2; ++n) { pg8::f32x4 s = {0.f, 0.f, 0.f, 0.f};
#pragma unroll
                for (int k = 0; k < NSPLIT; ++k) s = s + *(const pg8::f32x4*)(part + (size_t)(tt * NSPLIT + k) * 65536 + (size_t)((((ai * 2 + bj) * 4 + m) * 2 + n) * 2048) + (size_t)t_ * 4);
                a[bj][n] = s; }
        pg8::Unit u; so.unit_of(limit + tt, u);
        E.rowgroup(a, u.pm * 256 + wr * 64 + fr + ai * 128 + m * 16, u.pn * 256 + wc * 32 + 8 * fq, u.pn, wc, fq);
    }
}
template <int NSPLIT, class Epi> __device__ __forceinline__ void ksp_finalize(const float* part, const pg8::StaticOrder& so, int limit, const Epi& E) {
    const int ntail = so.nwg - limit;
    for (int it = blockIdx.x; it < ntail * 8; it += gridDim.x) {
        const int tt = it >> 3, ai = (it >> 2) & 1, m = it & 3;
        EPI_IDS();
        pg8::f32x4 a[2][2];
#pragma unroll
        for (int bj = 0; bj < 2; ++bj)
#pragma unroll
            for (int n = 0; n < 2; ++n) { pg8::f32x4 s = {0.f, 0.f, 0.f, 0.f};
#pragma unroll
                for (int k = 0; k < NSPLIT; ++k) s = s + *(const pg8::f32x4*)(part + (size_t)(tt * NSPLIT + k) * 65536 + (size_t)((((ai * 2 + bj) * 4 + m) * 2 + n) * 2048) + (size_t)t_ * 4);
                a[bj][n] = s; }
        pg8::Unit u; so.unit_of(limit + tt, u);
        E.rowgroup(a, u.pm * 256 + wr * 64 + fr + ai * 128 + m * 16, u.pn * 256 + wc * 32 + 8 * fq, u.pn, wc, fq);
    }
}

struct EpiMergeR {
    static constexpr bool PERM = true;
    bf16* merged; const bf16* gates;
    __device__ __forceinline__ void mid(pg8::f32x4 (&acc)[2][2][4][2], const pg8::Unit& u, int seg, int) const {
        EPI_IDS();
        const int row0 = u.pm * 256 + wr * 64 + fr, col0 = u.pn * 256 + wc * 32 + 8 * fq;
#pragma unroll
        for (int ai = 0; ai < 2; ++ai) {
#pragma unroll
            for (int m = 0; m < 4; ++m) {
                const int row = row0 + ai * 128 + m * 16;
#pragma unroll
                for (int bj = 0; bj < 2; ++bj) {
                    const v4u r = *(const v4u*)(gates + (size_t)row * NGATE + (seg - 1) * D + col0 + bj * 128);
                    pg8::f32x4& a0 = acc[ai][bj][m][0]; pg8::f32x4& a1 = acc[ai][bj][m][1];
                    a0[0] *= bflo(r.x); a0[1] *= bfhi(r.x); a0[2] *= bflo(r.y); a0[3] *= bfhi(r.y); a1[0] *= bflo(r.z); a1[1] *= bfhi(r.z); a1[2] *= bflo(r.w); a1[3] *= bfhi(r.w);
                }
            }
        }
    }
    __device__ __forceinline__ void operator()(const pg8::f32x4 (&acc)[2][2][4][2], const pg8::Unit& u, int, int, int, int) const {
        EPI_IDS();
        const int row0 = u.pm * 256 + wr * 64 + fr, col0 = u.pn * 256 + wc * 32 + 8 * fq;
#pragma unroll
        for (int ai = 0; ai < 2; ++ai)
#pragma unroll
            for (int m = 0; m < 4; ++m) {
                const int row = row0 + ai * 128 + m * 16;
#pragma unroll
                for (int bj = 0; bj < 2; ++bj) {
                    const v4u g = *(const v4u*)(gates + (size_t)row * NGATE + 3 * D + col0 + bj * 128);
                    const pg8::f32x4 a0 = acc[ai][bj][m][0], a1 = acc[ai][bj][m][1];
                    v4u w; w.x = pg8::cvt_pk_bf16(a0[0] * bflo(g.x), a0[1] * bfhi(g.x)); w.y = pg8::cvt_pk_bf16(a0[2] * bflo(g.y), a0[3] * bfhi(g.y));
                    w.z = pg8::cvt_pk_bf16(a1[0] * bflo(g.z), a1[1] * bfhi(g.z)); w.w = pg8::cvt_pk_bf16(a1[2] * bflo(g.w), a1[3] * bfhi(g.w));
                    *(v4u*)(merged + (size_t)row * D + col0 + bj * 128) = w;
                }
            }
    }
};

__device__ __forceinline__ void merge_finalize_local(const float* part, const pg8::StaticOrder& so, int limit, bf16* merged, const bf16* gates, unsigned* cnt0, unsigned* bar) {
    const int ntail = so.nwg - limit, c = blockIdx.x;
    if (c >= ntail * 4) return;
    const int tt = c >> 2;
    tail_group_sync(cnt0 + 64 * tt, 4u, bar);
    pg8::Unit u; so.unit_of(limit + tt, u);
    for (int j = c & 3; j < 8; j += 4) {
        const int ai = (j >> 2) & 1, m = j & 3;
        EPI_IDS();
        const int row = u.pm * 256 + wr * 64 + fr + ai * 128 + m * 16, col0 = u.pn * 256 + wc * 32 + 8 * fq;
#pragma unroll
        for (int bj = 0; bj < 2; ++bj) {
            pg8::f32x4 a0 = {0.f, 0.f, 0.f, 0.f}, a1 = {0.f, 0.f, 0.f, 0.f};
#pragma unroll
            for (int k = 0; k < 4; ++k) {
                const float* pp = part + (size_t)(tt * 4 + k) * 65536 + (size_t)t_ * 4;
                a0 = a0 + *(const pg8::f32x4*)(pp + (size_t)((((ai * 2 + bj) * 4 + m) * 2 + 0) * 2048)); a1 = a1 + *(const pg8::f32x4*)(pp + (size_t)((((ai * 2 + bj) * 4 + m) * 2 + 1) * 2048));
                const v4u r = *(const v4u*)(gates + (size_t)row * NGATE + k * D + col0 + bj * 128);
                a0[0] *= bflo(r.x); a0[1] *= bfhi(r.x); a0[2] *= bflo(r.y); a0[3] *= bfhi(r.y); a1[0] *= bflo(r.z); a1[1] *= bfhi(r.z); a1[2] *= bflo(r.w); a1[3] *= bfhi(r.w);
            }
            v4u w; w.x = pg8::cvt_pk_bf16(a0[0], a0[1]); w.y = pg8::cvt_pk_bf16(a0[2], a0[3]); w.z = pg8::cvt_pk_bf16(a1[0], a1[1]); w.w = pg8::cvt_pk_bf16(a1[2], a1[3]);
            *(v4u*)(merged + (size_t)row * D + col0 + bj * 128) = w;
        }
    }
}
__host__ __device__ __forceinline__ int gate_col(int m) { const int br = m >> 10, d = m & 1023, dd = d & 63; return 256 * (d >> 6) + 128 * (br >> 1) + 32 * (dd >> 4) + 8 * ((dd >> 2) & 3) + 4 * (br & 1) + (dd & 3); }
__host__ __device__ __forceinline__ int gate_src(int c) { const int ct = c & 255, br = 2 * (ct >> 7) + ((ct >> 2) & 1), d = 64 * (c >> 8) + 16 * ((ct >> 5) & 3) + 4 * ((ct >> 3) & 3) + (ct & 3); return br * 1024 + d; }
struct RowMap { int mode, a; __device__ __forceinline__ int operator()(int n) const { return mode == 0 ? n + a : (mode == 1 ? 256 * (n >> 7) + (n & 127) + a : (n < NMIX ? n : NMIXP + gate_col(n - NMIX))); } };
__device__ __forceinline__ void tr_item(const float* W, int K, int N, const float* gain, bf16* WT, int pitch, RowMap rm, LAS float* scr, int kb, int nb, int lane) {
    const int k0 = 64 * kb, n0 = 64 * nb; const int nn = n0 + 4 * (lane & 15), kr = lane >> 4;
    f32x4 v[16];
#pragma unroll
    for (int i = 0; i < 16; ++i) v[i] = (nn < N) ? *(const f32x4*)(W + (size_t)(k0 + 4 * i + kr) * N + nn) : (f32x4){0.f, 0.f, 0.f, 0.f};
#pragma unroll
    for (int i = 0; i < 16; ++i) { const int kk = 4 * i + kr; const float g = gain ? gain[k0 + kk] : 1.0f; LAS float* d = scr + kk * 65 + 4 * (lane & 15); d[0] = v[i][0] * g; d[1] = v[i][1] * g; d[2] = v[i][2] * g; d[3] = v[i][3] * g; }
    LDS_WAIT(); asm volatile("" ::: "memory");
    const int c = lane & 7;
#pragma unroll
    for (int j = 0; j < 8; ++j) { const int nl = (lane >> 3) + 8 * j; const int n = n0 + nl; const LAS float* s = scr + (8 * c) * 65 + nl;
        v4u o; o.x = pg8::cvt_pk_bf16(s[0 * 65], s[1 * 65]); o.y = pg8::cvt_pk_bf16(s[2 * 65], s[3 * 65]); o.z = pg8::cvt_pk_bf16(s[4 * 65], s[5 * 65]); o.w = pg8::cvt_pk_bf16(s[6 * 65], s[7 * 65]);
        if (n < N) *(v4u*)(WT + (size_t)rm(n) * pitch + k0 + 8 * c) = o; }
    LDS_WAIT(); asm volatile("" ::: "memory");
}
__device__ __forceinline__ void p0_prologue(const Ctx& C, const Params& P) {
    THREAD_IDS();
    LAS float* scr = (LAS float*)(C.lds + RING_OFF + wave * 16896);
    constexpr int I_FF = 16 * 44, I_DN = 44 * 16, I_IN = 16 * 113, I_BR = 4 * 4 * 16, I_OUT = 16 * 16;
    constexpr int PER_LAYER = 4 * I_FF + 2 * I_DN + I_IN + I_BR + I_OUT;
    for (int it = gw; it < DEPTH * PER_LAYER; it += NGW) {
        const int l = it / PER_LAYER; int r = it - l * PER_LAYER;
        bf16* W1a = WSP(bf16, WS_W1 + (size_t)(l * 2 + 0) * SZ_W1); bf16* W1b = WSP(bf16, WS_W1 + (size_t)(l * 2 + 1) * SZ_W1);
        bf16* Wda = WSP(bf16, WS_WD + (size_t)(l * 2 + 0) * SZ_WD); bf16* Wdb = WSP(bf16, WS_WD + (size_t)(l * 2 + 1) * SZ_WD);
        if (r < I_FF) { tr_item(C.in[I_F1G] + (size_t)l * D * DFF, D, DFF, C.in[I_NF1] + l * D, W1a, D, RowMap{1, 0}, scr, r / 44, r % 44, lane); continue; } r -= I_FF;
        if (r < I_FF) { tr_item(C.in[I_F1U] + (size_t)l * D * DFF, D, DFF, C.in[I_NF1] + l * D, W1a, D, RowMap{1, 128}, scr, r / 44, r % 44, lane); continue; } r -= I_FF;
        if (r < I_DN) { tr_item(C.in[I_F1D] + (size_t)l * D * DFF, DFF, D, nullptr, Wda, DFF, RowMap{0, 0}, scr, r / 16, r % 16, lane); continue; } r -= I_DN;
        if (r < I_FF) { tr_item(C.in[I_F2G] + (size_t)l * D * DFF, D, DFF, C.in[I_NF2] + l * D, W1b, D, RowMap{1, 0}, scr, r / 44, r % 44, lane); continue; } r -= I_FF;
        if (r < I_FF) { tr_item(C.in[I_F2U] + (size_t)l * D * DFF, D, DFF, C.in[I_NF2] + l * D, W1b, D, RowMap{1, 128}, scr, r / 44, r % 44, lane); continue; } r -= I_FF;
        if (r < I_DN) { tr_item(C.in[I_F2D] + (size_t)l * D * DFF, DFF, D, nullptr, Wdb, DFF, RowMap{0, 0}, scr, r / 16, r % 16, lane); continue; } r -= I_DN;
        if (r < I_IN) { tr_item(C.in[I_WIN] + (size_t)l * D * NIN, D, NIN, C.in[I_NMIX] + l * D, WSP(bf16, WS_WIN + (size_t)l * SZ_WIN), D, RowMap{2, 0}, scr, r / 113, r % 113, lane); continue; } r -= I_IN;
        if (r < I_BR) { const int n4 = r / 64, rr = r % 64; tr_item(C.in[I_WBR] + (size_t)(l * 4 + n4) * 256 * D, 256, D, nullptr, WSP(bf16, WS_WBR + (size_t)l * SZ_WBR) + n4 * 256, D, RowMap{0, 0}, scr, rr / 16, rr % 16, lane); continue; } r -= I_BR;
        tr_item(C.in[I_WOUT] + (size_t)l * D * D, D, D, nullptr, WSP(bf16, WS_WOUT + (size_t)l * SZ_WOUT), D, RowMap{0, 0}, scr, r / 16, r % 16, lane);
    }
    const int gt = gw * 64 + lane, NGT = NGW * 64;
    for (int i = gt; i < 2 * 240 * 128; i += NGT) { const int l = i / (240 * 128), r = i % (240 * 128); *(v4u*)(C.ws + WS_WIN + (size_t)l * SZ_WIN + ((size_t)NMIX * D) * 2 + (size_t)r * 16) = (v4u){0u, 0u, 0u, 0u}; }
    for (int i = gt; i < (M - MR) * 128; i += NGT) *(v4u*)(C.ws + WS_BR + (size_t)MR * D * 2 + (size_t)i * 16) = (v4u){0u, 0u, 0u, 0u};
    for (int i = gt; i < 2 * NINP; i += NGT) { const int l = i / NINP, j = i % NINP; float v = 0.f; if (j < NMIX) v = C.in[I_BIN][l * NIN + j]; else if (j >= NMIXP) v = C.in[I_BIN][l * NIN + NMIX + gate_src(j - NMIXP)]; WSP(float, WS_BINP)[i] = v; }
    for (int i = gt; i < NPOS * 32; i += NGT) { const int pi = i >> 5, fi = i & 31; const int pos = pi < L ? pi : PAST + (pi - L);
        const float angf = (float)pos * P.inv_freq[fi];
        const double a = (double)angf; const double k = rint(a * 0.15915494309189535); const double rr = (a - k * 6.283185307179586) - k * 2.4492935982947064e-16;
        const float rf = (float)rr; WSP(float, WS_ROPE)[i] = cosf(rf); WSP(float, WS_ROPE)[NPOS * 32 + i] = sinf(rf); }
    float* H = WSP(float, WS_H); bf16* HB = WSP(bf16, WS_HB); float* SS0 = WSP(float, WS_SS);
    for (int row = gw; row < M; row += NGW) {
        const float* src = nullptr;
        if (row < MP) { const int b = row / L, pos = row - b * L; src = pos < NMETA ? C.in[I_META] + (size_t)pos * D : C.in[I_XP] + ((size_t)b * SEQ + (pos - NMETA)) * D; }
        else if (row < MR) src = C.in[I_XS] + (size_t)(row - MP) * D;
        float s = 0.f;
#pragma unroll
        for (int j = 0; j < 4; ++j) { f32x4 v = src ? *(const f32x4*)(src + 256 * j + 4 * lane) : (f32x4){0.f, 0.f, 0.f, 0.f};
            s += (v[0] * v[0] + v[1] * v[1]) + (v[2] * v[2] + v[3] * v[3]);
            unsigned long long w = (unsigned long long)pk2(v[0], v[1]) | ((unsigned long long)pk2(v[2], v[3]) << 32);
            *(unsigned long long*)(HB + (size_t)row * D + 256 * j + 4 * lane) = w; }
        s = wave_sum(s); if (lane < 16) SS0[(size_t)row * 16 + lane] = lane == 0 ? s : 0.f;
    }
}

__device__ __forceinline__ float lam_of(const Ctx& C, int l, float lam_init) {
    THREAD_IDS();
    float a = 0.f, b = 0.f;
#pragma unroll 1
    for (int i = 0; i < 32; ++i) { a += C.in[I_LQ1][l * 32 + i] * C.in[I_LK1][l * 32 + i]; b += C.in[I_LQ2][l * 32 + i] * C.in[I_LK2][l * 32 + i]; }
    return __expf(a) - __expf(b) + lam_init;
}
__device__ __forceinline__ int t5_bucket(int n) {
    if (n < 16) return n;
    return 16 + (n >= 19) + (n >= 21) + (n >= 24) + (n >= 27) + (n >= 31) + (n >= 35) + (n >= 40) + (n >= 46) + (n >= 52) + (n >= 59) + (n >= 67) + (n >= 77) + (n >= 87) + (n >= 99) + (n >= 113);
}
__device__ __forceinline__ void unpack8(const v4u w, float (&x)[8]) { x[0] = bflo(w.x); x[1] = bfhi(w.x); x[2] = bflo(w.y); x[3] = bfhi(w.y); x[4] = bflo(w.z); x[5] = bfhi(w.z); x[6] = bflo(w.w); x[7] = bfhi(w.w); }
__device__ __forceinline__ v4u pack8(const float (&x)[8]) { v4u w; w.x = pg8::cvt_pk_bf16(x[0], x[1]); w.y = pg8::cvt_pk_bf16(x[2], x[3]); w.z = pg8::cvt_pk_bf16(x[4], x[5]); w.w = pg8::cvt_pk_bf16(x[6], x[7]); return w; }
__device__ __forceinline__ void n1_prep(const Ctx& C, int l) {
    THREAD_IDS();
    const bf16* ZM = WSP(bf16, WS_ZMIX); float* UB = WSP(float, WS_UBUF); float* RQ = WSP(float, WS_RQ); float* RK = WSP(float, WS_RK);
    float* LD = WSP(float, WS_LDEC); const float* COS = WSP(float, WS_ROPE); const float* SIN = COS + NPOS * 32; bf16* QNB = WSP(bf16, WS_QNB); bf16* KNB = WSP(bf16, WS_KNB);
    const int i = lane & 31;
    float qg[8], kg[8];
#pragma unroll
    for (int j = 0; j < 8; ++j) { qg[j] = C.in[I_QN][l * 32 + ((8 * i) & 31) + j] * (0.17677669529663687f * 1.4426950408889634f); kg[j] = C.in[I_KN][l * 32 + ((8 * i) & 31) + j]; }
    const int isk = i >> 4, hh = (i >> 2) & 3, jc = i & 3;
    for (int rp0 = gw * 2; rp0 < MR / 2; rp0 += NGW * 2) {
        v4u Wa[2], Wg[2], Wq[2], Wk[2], Wv[2], W1[2], W2[2], G0[2], G1[2];
#pragma unroll
        for (int u = 0; u < 2; ++u) { const int r = min(2 * (rp0 + u) + (lane >> 5), MR - 1); const bf16* z = ZM + (size_t)r * NMIXP; const bf16* zr = z + (isk ? R_K : R_Q) + hh * 64 + 8 * jc;
            Wa[u] = *(const v4u*)(z + C_A + 8 * i); Wg[u] = *(const v4u*)(z + C_G + 8 * i); Wq[u] = *(const v4u*)(z + D_Q + 8 * i); Wk[u] = *(const v4u*)(z + D_K + 8 * i); Wv[u] = *(const v4u*)(z + D_V + 8 * i);
            W1[u] = *(const v4u*)zr; W2[u] = *(const v4u*)(zr + 32); G0[u] = *(const v4u*)(z + G_LOW); G1[u] = *(const v4u*)(z + G_LOW + 8); }
#pragma unroll
        for (int u = 0; u < 2; ++u) {
        if (rp0 + u >= MR / 2) break;
        const int r = 2 * (rp0 + u) + (lane >> 5);
        const int pi = r < MP ? r % L : L + ((r - MP) & 7);
        float* kout = r < MP ? C.out + O_KP + ((size_t)l * MP + r) * 256 : C.out + O_KS + ((size_t)l * MS + (r - MP)) * 256;
        float* vout = r < MP ? C.out + O_VP + ((size_t)l * MP + r) * 256 : C.out + O_VS + ((size_t)l * MS + (r - MP)) * 256;
        const v4u wa = Wa[u], wg = Wg[u], wq = Wq[u], wk = Wk[u], wv = Wv[u], w1 = W1[u], w2 = W2[u], gl0 = G0[u], gl1 = G1[u];
        float x[8], y[8];
        unpack8(wa, x); unpack8(wg, y);
#pragma unroll
        for (int j = 0; j < 8; ++j) x[j] *= sigmoidf_(y[j]);
        *(f32x4*)(UB + (size_t)r * 256 + 8 * i) = (f32x4){x[0], x[1], x[2], x[3]}; *(f32x4*)(UB + (size_t)r * 256 + 8 * i + 4) = (f32x4){x[4], x[5], x[6], x[7]};
        unpack8(wv, x);
        *(f32x4*)(vout + 8 * i) = (f32x4){x[0], x[1], x[2], x[3]}; *(f32x4*)(vout + 8 * i + 4) = (f32x4){x[4], x[5], x[6], x[7]};
        unpack8(wq, x);
        { float s = 0.f;
#pragma unroll
          for (int j = 0; j < 8; ++j) s += x[j] * x[j];
          s += __shfl_xor(s, 1); s += __shfl_xor(s, 2); const float rs = rsqrtf(s * (1.0f / 32) + EPS);
#pragma unroll
          for (int j = 0; j < 8; ++j) x[j] = x[j] * rs * qg[j];
          *(v4u*)(QNB + (size_t)r * 256 + 8 * i) = pack8(x); }
        unpack8(wk, x);
        { float s = 0.f;
#pragma unroll
          for (int j = 0; j < 8; ++j) s += x[j] * x[j];
          s += __shfl_xor(s, 1); s += __shfl_xor(s, 2); const float rs = rsqrtf(s * (1.0f / 32) + EPS);
#pragma unroll
          for (int j = 0; j < 8; ++j) x[j] = x[j] * rs * kg[j];
          *(v4u*)(KNB + (size_t)r * 256 + 8 * i) = pack8(x);
          *(f32x4*)(kout + 8 * i) = (f32x4){x[0], x[1], x[2], x[3]}; *(f32x4*)(kout + 8 * i + 4) = (f32x4){x[4], x[5], x[6], x[7]}; }
        unpack8(w1, x); unpack8(w2, y);
        { const f32x4 c0 = *(const f32x4*)(COS + pi * 32 + 8 * jc), c1 = *(const f32x4*)(COS + pi * 32 + 8 * jc + 4), s0 = *(const f32x4*)(SIN + pi * 32 + 8 * jc), s1 = *(const f32x4*)(SIN + pi * 32 + 8 * jc + 4);
          const float sc = isk ? 0.125f : 1.0f; float o1[8], o2[8];
#pragma unroll
          for (int j = 0; j < 8; ++j) { const float cs = j < 4 ? c0[j & 3] : c1[j & 3], sn = j < 4 ? s0[j & 3] : s1[j & 3]; o1[j] = (x[j] * cs - y[j] * sn) * sc; o2[j] = (x[j] * sn + y[j] * cs) * sc; }
          float* ro = (isk ? RK : RQ) + (size_t)r * 256 + hh * 64 + 8 * jc;
          *(f32x4*)ro = (f32x4){o1[0], o1[1], o1[2], o1[3]}; *(f32x4*)(ro + 4) = (f32x4){o1[4], o1[5], o1[6], o1[7]}; *(f32x4*)(ro + 32) = (f32x4){o2[0], o2[1], o2[2], o2[3]}; *(f32x4*)(ro + 36) = (f32x4){o2[4], o2[5], o2[6], o2[7]}; }
        { float gv[16]; unpack8(gl0, x); unpack8(gl1, y);
#pragma unroll
          for (int j = 0; j < 8; ++j) { gv[j] = x[j]; gv[8 + j] = y[j]; }
          f32x4 gp = *(const f32x4*)(C.in[I_GAB] + l * 128 + 4 * i);
#pragma unroll
          for (int k = 0; k < 16; ++k) { const f32x4 aw = *(const f32x4*)(C.in[I_GAW] + (size_t)(l * 16 + k) * 128 + 4 * i); gp = gp + aw * gv[k]; }
          f32x4 ls;
#pragma unroll
          for (int j = 0; j < 4; ++j) ls[j] = (fminf(gp[j], 0.f) - log1pf(__expf(-fabsf(gp[j])))) * (1.0f / 16.0f);
          *(f32x4*)(LD + (size_t)r * 128 + 4 * i) = ls; }
        }
    }
}
__device__ __forceinline__ void conv_rows_item(const Ctx& C, int l, int item) {
    THREAD_IDS();
    const float* UB = WSP(float, WS_UBUF); bf16* BR = WSP(bf16, WS_BR);
    const float* cw = C.in[I_CW] + (size_t)l * 31 * 256; const float* sc = C.in[I_SCONV];
    LAS float* wl = (LAS float*)C.lds;
    for (int i = tid; i < 31 * 256; i += NWAVES * 64) wl[i] = cw[i];
    LDS_WAIT(); __builtin_amdgcn_s_barrier(); asm volatile("" ::: "memory");
    const int r0 = item * 64 + wave * 8;
    if (r0 < MR) {
        const bool smp = r0 >= MP; const int b = smp ? (r0 - MP) >> 3 : r0 / L; const int p0 = smp ? 0 : r0 - b * L; const int rb = smp ? MP + b * 8 : b * L;
        float acc[8][4];
#pragma unroll
        for (int i = 0; i < 8; ++i)
#pragma unroll
            for (int k = 0; k < 4; ++k) acc[i][k] = C.in[I_CB][l * 256 + lane + 64 * k];
#pragma unroll 1
        for (int jb = 0; jb < 40; jb += 8) {
            float uv[8][4];
#pragma unroll
            for (int jj = 0; jj < 8; ++jj) { const int j = jb + jj; const int q = p0 - 30 + j;
#pragma unroll
                for (int k = 0; k < 4; ++k) { const int c = lane + 64 * k;
                    uv[jj][k] = j >= 38 ? 0.f : (q >= 0 ? UB[(size_t)(rb + q) * 256 + c] : (smp ? sc[(((size_t)l * DB + b) * 30 + (q + 30)) * 256 + c] : 0.f)); } }
#pragma unroll
            for (int jj = 0; jj < 8; ++jj)
#pragma unroll
                for (int i = 0; i < 8; ++i) { const int t = jb + jj - i;
                    if (t >= 0 && t <= 30) {
#pragma unroll
                        for (int k = 0; k < 4; ++k) acc[i][k] += wl[t * 256 + lane + 64 * k] * uv[jj][k]; } }
        }
#pragma unroll
        for (int i = 0; i < 8; ++i) { const int r = r0 + i;
            float s = (acc[i][0] + acc[i][1]) + (acc[i][2] + acc[i][3]); const float mean = wave_sum(s) * (1.0f / 256);
            float q2 = 0.f;
#pragma unroll
            for (int k = 0; k < 4; ++k) { acc[i][k] -= mean; q2 += acc[i][k] * acc[i][k]; }
            const float rstd = rsqrtf(wave_sum(q2) * (1.0f / 256) + EPS);
#pragma unroll
            for (int k = 0; k < 4; ++k) { const int c = lane + 64 * k; const float y = acc[i][k] * rstd * C.in[I_CLG][l * 256 + c] + C.in[I_CLB][l * 256 + c]; BR[(size_t)r * D + c] = (bf16)f2bf(siluf_(y)); } }
    }
    LDS_WAIT(); __builtin_amdgcn_s_barrier(); asm volatile("" ::: "memory");
}
__device__ __forceinline__ void conv_state_item(const Ctx& C, int l, int part, int nparts) {
    THREAD_IDS();
    const float* UB = WSP(float, WS_UBUF); const float* sc = C.in[I_SCONV];
    for (int i = part * NWAVES * 64 + tid; i < BATCH * 30 * 256; i += nparts * NWAVES * 64) { const int c = i & 255, ii = (i >> 8) % 30, b = i / (30 * 256); C.out[O_CP + (size_t)l * BATCH * 30 * 256 + i] = UB[(size_t)(b * L + L - 30 + ii) * 256 + c]; }
    for (int i = part * NWAVES * 64 + tid; i < DB * 30 * 256; i += nparts * NWAVES * 64) { const int c = i & 255, ii = (i >> 8) % 30, b = i / (30 * 256);
        C.out[O_CS + (size_t)l * DB * 30 * 256 + i] = ii < 22 ? sc[(((size_t)l * DB + b) * 30 + 8 + ii) * 256 + c] : UB[(size_t)(MP + b * 8 + ii - 22) * 256 + c]; }
}
template <int DK, bool RET> __device__ __forceinline__ void la_seq(const Ctx& C, int l, bool smp, int b, int h) {
    THREAD_IDS();
    const bf16* ZM = WSP(bf16, WS_ZMIX); const float* RQ = WSP(float, WS_RQ); const float* RK = WSP(float, WS_RK); const float* LD = WSP(float, WS_LDEC); bf16* BR = WSP(bf16, WS_BR);
    const int nt = smp ? DS : L; const int row0 = smp ? MP + b * DS : b * L;
    float S[DK];
    if (smp) { const float* s0 = (RET ? C.in[I_SRET] : C.in[I_SGLA]) + (((size_t)l * DB + b) * 4 + h) * DK * 64;
#pragma unroll
        for (int k = 0; k < DK; ++k) S[k] = s0[k * 64 + lane]; }
    else {
#pragma unroll
        for (int k = 0; k < DK; ++k) S[k] = 0.f; }
    const float gamma = 1.0f - exp2f(-5.0f - (float)h);
    const float gn = RET ? C.in[I_RGN][(l * 4 + h) * 64 + lane] : C.in[I_GGN][(l * 4 + h) * 64 + lane];
    for (int t = 0; t < nt; ++t) {
        const int r = row0 + t; const bf16* z = ZM + (size_t)r * NMIXP;
        float ql, kl, dl = 1.f;
        if (RET) { ql = RQ[(size_t)r * 256 + h * 64 + lane]; kl = RK[(size_t)r * 256 + h * 64 + lane]; }
        else { const int lk = lane & 31; ql = bf2f(z[G_Q + h * 32 + lk]) * 0.17677669529663687f; kl = bf2f(z[G_K + h * 32 + lk]); dl = __expf(LD[(size_t)r * 128 + h * 32 + lk]); }
        const float v = bf2f(z[(RET ? R_V : G_V) + h * 64 + lane]);
        float o = 0.f;
#pragma unroll
        for (int k = 0; k < DK; ++k) { const float qk = __shfl(ql, k), kk = __shfl(kl, k); const float dk = RET ? gamma : __shfl(dl, k);
            S[k] = dk * S[k] + kk * v; o += qk * S[k]; if ((k & 7) == 7) __builtin_amdgcn_sched_barrier(0); }
        float y;
        if (RET) { const float mean = wave_sum(o) * (1.0f / 64); const float d = o - mean; const float var = wave_sum(d * d) * (1.0f / 64); y = d * rsqrtf(var + EPS) * gn; }
        else { const float ms = wave_sum(o * o) * (1.0f / 64); y = o * rsqrtf(ms + EPS) * gn; }
        const float g = bf2f(z[(RET ? R_G : G_R) + h * 64 + lane]);
        BR[(size_t)r * D + (RET ? 256 : 512) + h * 64 + lane] = (bf16)f2bf(siluf_(g) * y);
    }
    float* so = C.out + (RET ? (smp ? O_RS + (((size_t)l * DB + b) * 4 + h) * DK * 64 : O_RP + (((size_t)l * BATCH + b) * 4 + h) * DK * 64)
                             : (smp ? O_GS + (((size_t)l * DB + b) * 4 + h) * DK * 64 : O_GP + (((size_t)l * BATCH + b) * 4 + h) * DK * 64));
#pragma unroll
    for (int k = 0; k < DK; ++k) so[k * 64 + lane] = S[k];
}
typedef short bf16x8_t __attribute__((ext_vector_type(8)));
template <int DK, bool RET> __device__ __forceinline__ void la_chunked(const Ctx& C, int l, bool smp, int b, int h) {
    THREAD_IDS();
    constexpr int QS = DK + 8, TS = 72, NKB = DK / 16, NKS = DK / 32;
    constexpr int SB = 2 * 64 * QS + 64 * TS + DK * TS + 64 * TS + 64;
    LAS bf16* SB0 = (LAS bf16*)(C.lds);
    LAS bf16* AL = SB0 + 2 * SB;
    LAS bf16* ST = AL + 64 * TS;
    const bf16* ZM = WSP(bf16, WS_ZMIX); const float* RQ = WSP(float, WS_RQ); const float* RK = WSP(float, WS_RK); const float* LD = WSP(float, WS_LDEC); bf16* BR = WSP(bf16, WS_BR);
    const int nt = smp ? DS : L, row0 = smp ? MP + b * DS : b * L, nch = (nt + 63) >> 6;
    const float lg2 = RET ? log2f(1.0f - exp2f(-5.0f - (float)h)) : 0.f;
    const int g4 = lane >> 4, c16 = lane & 15;
    const bool qwave = wave < 4; const int w4 = wave & 3;
    float Sreg[NKB][4];
    if (wave >= 4) {
        const float* s0 = (RET ? C.in[I_SRET] : C.in[I_SGLA]) + (((size_t)l * DB + b) * 4 + h) * DK * 64;
#pragma unroll
        for (int cb = 0; cb < NKB; ++cb)
#pragma unroll
            for (int r = 0; r < 4; ++r) { const int dk = cb * 16 + c16, dv = (wave - 4) * 16 + 4 * g4 + r; const float v = smp ? s0[dk * 64 + dv] : 0.f; Sreg[cb][r] = v; ST[dv * QS + dk] = (bf16)f2bf(v); }
    }
    float gnv[4];
#pragma unroll
    for (int cb = 0; cb < 4; ++cb) gnv[cb] = (RET ? C.in[I_RGN] : C.in[I_GGN])[(l * 4 + h) * 64 + cb * 16 + c16];
    float a[16]; v4u vr;
#define LA_LOAD(c) do { const size_t r_ = (size_t)(row0 + (c) * 64 + lane); const bf16* z_ = ZM + r_ * NMIXP; \
        vr = *(const v4u*)(z_ + (RET ? R_V : G_V) + h * 64 + 8 * wave); \
        if (RET) { const float* p_ = (qwave ? RQ : RK) + r_ * 256 + h * 64 + 8 * w4; const f32x4 x0 = *(const f32x4*)p_, x1 = *(const f32x4*)(p_ + 4), x2 = *(const f32x4*)(p_ + 32), x3 = *(const f32x4*)(p_ + 36); \
            a[0] = x0[0]; a[1] = x0[1]; a[2] = x0[2]; a[3] = x0[3]; a[4] = x1[0]; a[5] = x1[1]; a[6] = x1[2]; a[7] = x1[3]; a[8] = x2[0]; a[9] = x2[1]; a[10] = x2[2]; a[11] = x2[3]; a[12] = x3[0]; a[13] = x3[1]; a[14] = x3[2]; a[15] = x3[3]; } \
        else { const v4u q_ = *(const v4u*)(z_ + (qwave ? G_Q : G_K) + h * 32 + 8 * w4); const float* p_ = LD + r_ * 128 + h * 32 + 8 * w4; const f32x4 x0 = *(const f32x4*)p_, x1 = *(const f32x4*)(p_ + 4); \
            a[0] = bflo(q_.x); a[1] = bfhi(q_.x); a[2] = bflo(q_.y); a[3] = bfhi(q_.y); a[4] = bflo(q_.z); a[5] = bfhi(q_.z); a[6] = bflo(q_.w); a[7] = bfhi(q_.w); \
            a[8] = x0[0]; a[9] = x0[1]; a[10] = x0[2]; a[11] = x0[3]; a[12] = x1[0]; a[13] = x1[1]; a[14] = x1[2]; a[15] = x1[3]; } } while (0)
    LA_LOAD(0);
    int cur = 0;
    for (int i = 0; i <= nch; ++i) {
        if (i < nch) {
            const int c = i; LAS bf16* QT = SB0 + (i & 1) * SB; LAS bf16* KT = QT + 64 * QS; LAS bf16* VT = KT + 64 * QS; LAS bf16* KE = VT + 64 * TS; LAS bf16* GT = KE + DK * TS; LAS float* WT = (LAS float*)(GT + 64 * TS);
            const int nvc = min(64, nt - c * 64); const bool valid = lane < nvc;
        if (RET) {
            const float tq = (float)(lane + 1);
            if (qwave) { const float e = valid ? __builtin_amdgcn_exp2f(lg2 * tq) : 0.f;
                v4u w0, w1; w0.x = pg8::cvt_pk_bf16(a[0] * e, a[1] * e); w0.y = pg8::cvt_pk_bf16(a[2] * e, a[3] * e); w0.z = pg8::cvt_pk_bf16(a[4] * e, a[5] * e); w0.w = pg8::cvt_pk_bf16(a[6] * e, a[7] * e);
                w1.x = pg8::cvt_pk_bf16(a[8] * e, a[9] * e); w1.y = pg8::cvt_pk_bf16(a[10] * e, a[11] * e); w1.z = pg8::cvt_pk_bf16(a[12] * e, a[13] * e); w1.w = pg8::cvt_pk_bf16(a[14] * e, a[15] * e);
                *(LAS v4u*)(QT + lane * QS + 8 * w4) = w0; *(LAS v4u*)(QT + lane * QS + 32 + 8 * w4) = w1; }
            else { const float e = valid ? __builtin_amdgcn_exp2f(-lg2 * tq) : 0.f, ee = valid ? __builtin_amdgcn_exp2f(lg2 * ((float)nvc - tq)) : 0.f;
                v4u w0, w1; w0.x = pg8::cvt_pk_bf16(a[0] * e, a[1] * e); w0.y = pg8::cvt_pk_bf16(a[2] * e, a[3] * e); w0.z = pg8::cvt_pk_bf16(a[4] * e, a[5] * e); w0.w = pg8::cvt_pk_bf16(a[6] * e, a[7] * e);
                w1.x = pg8::cvt_pk_bf16(a[8] * e, a[9] * e); w1.y = pg8::cvt_pk_bf16(a[10] * e, a[11] * e); w1.z = pg8::cvt_pk_bf16(a[12] * e, a[13] * e); w1.w = pg8::cvt_pk_bf16(a[14] * e, a[15] * e);
                *(LAS v4u*)(KT + lane * QS + 8 * w4) = w0; *(LAS v4u*)(KT + lane * QS + 32 + 8 * w4) = w1;
#pragma unroll
                for (int i = 0; i < 16; i += 2) { const unsigned mine = pg8::cvt_pk_bf16(a[i] * ee, a[i + 1] * ee); const unsigned pv = (unsigned)__shfl_xor((int)mine, 1);
                    const unsigned w = (lane & 1) ? ((pv >> 16) | (mine & 0xffff0000u)) : ((mine & 0xffffu) | (pv << 16));
                    const int row = (i < 8 ? 8 * w4 + i : 32 + 8 * w4 + (i - 8)) + (lane & 1);
                    *(LAS unsigned*)(KE + row * TS + (lane & ~1)) = w; } }
        } else {
            float bb[8];
#pragma unroll
            for (int i = 0; i < 8; ++i) bb[i] = valid ? a[8 + i] : 0.f;
#pragma unroll
            for (int i = 0; i < 8; ++i) { float x = bb[i];
                x += __builtin_bit_cast(float, __builtin_amdgcn_mov_dpp(__builtin_bit_cast(int, x), 0x111, 0xf, 0xf, true));
                x += __builtin_bit_cast(float, __builtin_amdgcn_mov_dpp(__builtin_bit_cast(int, x), 0x112, 0xf, 0xf, true));
                x += __builtin_bit_cast(float, __builtin_amdgcn_mov_dpp(__builtin_bit_cast(int, x), 0x114, 0xf, 0xf, true));
                x += __builtin_bit_cast(float, __builtin_amdgcn_mov_dpp(__builtin_bit_cast(int, x), 0x118, 0xf, 0xf, true));
                const float t0 = __builtin_bit_cast(float, __builtin_amdgcn_readlane(__builtin_bit_cast(int, x), 15)), t1 = __builtin_bit_cast(float, __builtin_amdgcn_readlane(__builtin_bit_cast(int, x), 31)), t2 = __builtin_bit_cast(float, __builtin_amdgcn_readlane(__builtin_bit_cast(int, x), 47));
                bb[i] = x + (lane >= 16 ? t0 : 0.f) + (lane >= 32 ? t1 : 0.f) + (lane >= 48 ? t2 : 0.f); }
            if (qwave) {
                if (lane == 63) {
#pragma unroll
                    for (int i = 0; i < 8; ++i) WT[8 * w4 + i] = bb[i]; }
                float o8[8];
#pragma unroll
                for (int i = 0; i < 8; ++i) o8[i] = valid ? a[i] * 0.17677669529663687f * __expf(bb[i]) : 0.f;
                v4u w0; w0.x = pg8::cvt_pk_bf16(o8[0], o8[1]); w0.y = pg8::cvt_pk_bf16(o8[2], o8[3]); w0.z = pg8::cvt_pk_bf16(o8[4], o8[5]); w0.w = pg8::cvt_pk_bf16(o8[6], o8[7]);
                *(LAS v4u*)(QT + lane * QS + 8 * w4) = w0;
            } else {
                float o8[8];
#pragma unroll
                for (int i = 0; i < 8; ++i) o8[i] = valid ? a[i] * __expf(-bb[i]) : 0.f;
#pragma unroll
                for (int i = 0; i < 8; i += 2) { const float t0 = __shfl(bb[i], 63), t1 = __shfl(bb[i + 1], 63);
                    const unsigned mine = pg8::cvt_pk_bf16(valid ? a[i] * __expf(t0 - bb[i]) : 0.f, valid ? a[i + 1] * __expf(t1 - bb[i + 1]) : 0.f); const unsigned pv = (unsigned)__shfl_xor((int)mine, 1);
                    const unsigned w = (lane & 1) ? ((pv >> 16) | (mine & 0xffff0000u)) : ((mine & 0xffffu) | (pv << 16));
                    *(LAS unsigned*)(KE + (8 * w4 + i + (lane & 1)) * TS + (lane & ~1)) = w; }
                v4u w0; w0.x = pg8::cvt_pk_bf16(o8[0], o8[1]); w0.y = pg8::cvt_pk_bf16(o8[2], o8[3]); w0.z = pg8::cvt_pk_bf16(o8[4], o8[5]); w0.w = pg8::cvt_pk_bf16(o8[6], o8[7]);
                *(LAS v4u*)(KT + lane * QS + 8 * w4) = w0;
            }
        }
        { const unsigned vv[4] = {valid ? vr.x : 0u, valid ? vr.y : 0u, valid ? vr.z : 0u, valid ? vr.w : 0u};
#pragma unroll
          for (int i = 0; i < 4; ++i) { const unsigned pv = (unsigned)__shfl_xor((int)vv[i], 1);
              const unsigned w = (lane & 1) ? ((pv >> 16) | (vv[i] & 0xffff0000u)) : ((vv[i] & 0xffffu) | (pv << 16));
              *(LAS unsigned*)(VT + (8 * wave + 2 * i + (lane & 1)) * TS + (lane & ~1)) = w; } }
            if (c + 1 < nch) LA_LOAD(c + 1);
        }
        if (i >= 1) {
            LAS bf16* QT = SB0 + ((i - 1) & 1) * SB; LAS bf16* KT = QT + 64 * QS;
        { const int rb = wave >> 1;
#pragma unroll
          for (int ci = 0; ci < 2; ++ci) { const int cb = (wave & 1) * 2 + ci; f32x4 acc = {0.f, 0.f, 0.f, 0.f};
              if (cb <= rb) {
#pragma unroll
                  for (int ks = 0; ks < NKS; ++ks) { const bf16x8_t af = *(const LAS bf16x8_t*)(QT + (rb * 16 + c16) * QS + ks * 32 + 8 * g4), bf = *(const LAS bf16x8_t*)(KT + (cb * 16 + c16) * QS + ks * 32 + 8 * g4);
                      acc = __builtin_amdgcn_mfma_f32_16x16x32_bf16(af, bf, acc, 0, 0, 0); } }
#pragma unroll
              for (int r = 0; r < 4; ++r) { const int tt = rb * 16 + 4 * g4 + r, ss = cb * 16 + c16; AL[tt * TS + ss] = (bf16)f2bf(ss <= tt ? acc[r] : 0.f); } } }
        }
        LDS_WAIT(); __builtin_amdgcn_s_barrier(); asm volatile("" ::: "memory");
        if (i >= 1) {
            const int c = i - 1; LAS bf16* QT = SB0 + (c & 1) * SB; LAS bf16* KT = QT + 64 * QS; LAS bf16* VT = KT + 64 * QS; LAS bf16* KE = VT + 64 * TS; LAS bf16* GT = KE + DK * TS; LAS float* WT = (LAS float*)(GT + 64 * TS);
            const int nvc = min(64, nt - c * 64); (void)KT;
        if (wave < 4) {
            const int rb = wave; const LAS bf16* STc = ST + cur * 64 * QS;
            f32x4 o[4];
#pragma unroll
            for (int cb = 0; cb < 4; ++cb) o[cb] = (f32x4){0.f, 0.f, 0.f, 0.f};
#pragma unroll
            for (int ks = 0; ks < 2; ++ks) { const bf16x8_t af = *(const LAS bf16x8_t*)(AL + (rb * 16 + c16) * TS + ks * 32 + 8 * g4);
#pragma unroll
                for (int cb = 0; cb < 4; ++cb) { const bf16x8_t bf = *(const LAS bf16x8_t*)(VT + (cb * 16 + c16) * TS + ks * 32 + 8 * g4); o[cb] = __builtin_amdgcn_mfma_f32_16x16x32_bf16(af, bf, o[cb], 0, 0, 0); } }
#pragma unroll
            for (int ks = 0; ks < NKS; ++ks) { const bf16x8_t af = *(const LAS bf16x8_t*)(QT + (rb * 16 + c16) * QS + ks * 32 + 8 * g4);
#pragma unroll
                for (int cb = 0; cb < 4; ++cb) { const bf16x8_t bf = *(const LAS bf16x8_t*)(STc + (cb * 16 + c16) * QS + ks * 32 + 8 * g4); o[cb] = __builtin_amdgcn_mfma_f32_16x16x32_bf16(af, bf, o[cb], 0, 0, 0); } }
            { float* LAO = WSP(float, WS_LAO);
#pragma unroll
              for (int r = 0; r < 4; ++r) { const int tok = c * 64 + rb * 16 + 4 * g4 + r;
                  if (tok < nt) { float* op = LAO + (size_t)(row0 + tok) * 512 + (RET ? 0 : 256) + h * 64 + c16;
#pragma unroll
                      for (int cb = 0; cb < 4; ++cb) op[cb * 16] = o[cb][r]; } } }
        } else {
            const int dvb = wave - 4; LAS bf16* STn = ST + (cur ^ 1) * 64 * QS;
            f32x4 ds[NKB];
#pragma unroll
            for (int cb = 0; cb < NKB; ++cb) ds[cb] = (f32x4){0.f, 0.f, 0.f, 0.f};
#pragma unroll
            for (int ks = 0; ks < 2; ++ks) { const bf16x8_t af = *(const LAS bf16x8_t*)(VT + (dvb * 16 + c16) * TS + ks * 32 + 8 * g4);
#pragma unroll
                for (int cb = 0; cb < NKB; ++cb) { const bf16x8_t bf = *(const LAS bf16x8_t*)(KE + (cb * 16 + c16) * TS + ks * 32 + 8 * g4); ds[cb] = __builtin_amdgcn_mfma_f32_16x16x32_bf16(af, bf, ds[cb], 0, 0, 0); } }
#pragma unroll
            for (int cb = 0; cb < NKB; ++cb) { const float eB = RET ? __builtin_amdgcn_exp2f(lg2 * (float)nvc) : __expf(WT[cb * 16 + c16]);
#pragma unroll
                for (int r = 0; r < 4; ++r) { Sreg[cb][r] = eB * Sreg[cb][r] + ds[cb][r]; STn[(dvb * 16 + 4 * g4 + r) * QS + cb * 16 + c16] = (bf16)f2bf(Sreg[cb][r]); } }
        }
            cur ^= 1;
        }
        LDS_WAIT(); __builtin_amdgcn_s_barrier(); asm volatile("" ::: "memory");
    }
#undef LA_LOAD
    if (wave >= 4) {
        float* so = C.out + (RET ? (smp ? O_RS + (((size_t)l * DB + b) * 4 + h) * DK * 64 : O_RP + (((size_t)l * BATCH + b) * 4 + h) * DK * 64)
                                 : (smp ? O_GS + (((size_t)l * DB + b) * 4 + h) * DK * 64 : O_GP + (((size_t)l * BATCH + b) * 4 + h) * DK * 64));
#pragma unroll
        for (int cb = 0; cb < NKB; ++cb)
#pragma unroll
            for (int r = 0; r < 4; ++r) so[(cb * 16 + c16) * 64 + (wave - 4) * 16 + 4 * g4 + r] = Sreg[cb][r];
    }
}
typedef float f32x16_t __attribute__((ext_vector_type(16)));
__device__ __forceinline__ int crow_(int r, int hi) { return (r & 3) + 8 * (r >> 2) + 4 * hi; }
__device__ __forceinline__ float swapmax32(float m) { auto rr = __builtin_amdgcn_permlane32_swap(__float_as_uint(m), __float_as_uint(m), false, false); return fmaxf(__uint_as_float(rr[0]), __uint_as_float(rr[1])); }
__device__ __forceinline__ float swapadd32(float m) { auto rr = __builtin_amdgcn_permlane32_swap(__float_as_uint(m), __float_as_uint(m), false, false); return __uint_as_float(rr[0]) + __uint_as_float(rr[1]); }
constexpr float LOG2E = 1.4426950408889634f;
__device__ __forceinline__ void attn_prompt_item(const Ctx& C, int l, int b, int h, int qb, float lam, float lam_init, float mb) {
    THREAD_IDS();
    constexpr int KS = 72;
    LAS bf16* Kt = (LAS bf16*)C.lds;
    LAS bf16* Vt = Kt + 2 * 64 * KS;
    LAS float* BT = (LAS float*)(Vt + 2 * 64 * KS);
    LAS float* OX = BT + 128;
    const bf16* ZM = WSP(bf16, WS_ZMIX); const bf16* QNB = WSP(bf16, WS_QNB); const bf16* KNB = WSP(bf16, WS_KNB); bf16* BR = WSP(bf16, WS_BR);
    const int r32 = lane & 31, hi = lane >> 5, qs = wave >> 1, s = wave & 1;
    const int q0 = qb * 128 + qs * 32; const int rowb = b * L;
    if (tid < 128) BT[tid] = (C.in[I_RELB][t5_bucket(tid) * 4 + h] - C.in[I_RELB][31 * 4 + h]) * LOG2E;
    pg8::bf16x8 qf[2];
#pragma unroll
    for (int d0 = 0; d0 < 2; ++d0) qf[d0] = *(const pg8::bf16x8*)(QNB + (size_t)(rowb + q0 + r32) * 256 + h * 64 + s * 32 + 16 * d0 + 8 * hi);
    const int pl = (lane & ~15) | ((lane & 8) >> 1) | ((lane & 4) << 1) | (lane & 3);
    const int NT = (min(128 * (qb + 1), L) + 63) >> 6;
    v4u kreg, vreg;
#define AT_LOAD(j) do { const size_t r_ = (size_t)(rowb + (j) * 64 + lane); kreg = *(const v4u*)(KNB + r_ * 256 + h * 64 + 8 * wave); vreg = *(const v4u*)(ZM + r_ * NMIXP + D_V + h * 64 + 8 * wave); } while (0)
#define AT_STORE(buf) do { *(LAS v4u*)(Kt + (buf) * 64 * KS + lane * KS + 8 * wave) = kreg; LAS bf16* v_ = Vt + (buf) * 64 * KS + (8 * wave) * KS + pl; \
        v_[0] = (bf16)(vreg.x & 0xffffu); v_[KS] = (bf16)(vreg.x >> 16); v_[2 * KS] = (bf16)(vreg.y & 0xffffu); v_[3 * KS] = (bf16)(vreg.y >> 16); \
        v_[4 * KS] = (bf16)(vreg.z & 0xffffu); v_[5 * KS] = (bf16)(vreg.z >> 16); v_[6 * KS] = (bf16)(vreg.w & 0xffffu); v_[7 * KS] = (bf16)(vreg.w >> 16); } while (0)
    AT_LOAD(0); AT_STORE(0); if (NT > 1) AT_LOAD(1);
    LDS_WAIT(); __builtin_amdgcn_s_barrier(); asm volatile("" ::: "memory");
    float lsum = 0.f; f32x16_t o[2]; f32x16_t negm;
#pragma unroll
    for (int i = 0; i < 16; ++i) negm[i] = -mb;
#pragma unroll
    for (int i = 0; i < 16; ++i) { o[0][i] = 0.f; o[1][i] = 0.f; }
    for (int j = 0; j < NT; ++j) {
        const int k0 = 64 * j, buf = j & 1;
        if (k0 <= q0 + 31) {
            const LAS bf16* kb = Kt + buf * 64 * KS; const LAS bf16* vb = Vt + buf * 64 * KS;
            f32x16_t p0 = negm, p1 = negm;
#pragma unroll
            for (int d0 = 0; d0 < 2; ++d0) { const pg8::bf16x8 a0 = *(const LAS pg8::bf16x8*)(kb + r32 * KS + s * 32 + 16 * d0 + 8 * hi), a1 = *(const LAS pg8::bf16x8*)(kb + (32 + r32) * KS + s * 32 + 16 * d0 + 8 * hi);
                p0 = __builtin_amdgcn_mfma_f32_32x32x16_bf16(a0, qf[d0], p0, 0, 0, 0); p1 = __builtin_amdgcn_mfma_f32_32x32x16_bf16(a1, qf[d0], p1, 0, 0, 0); }
            if (q0 - k0 - 63 < 113) {
#pragma unroll
                for (int r = 0; r < 16; ++r) { const int n0 = (q0 + r32) - (k0 + crow_(r, hi)), n1 = n0 - 32;
                    p0[r] = n0 < 0 ? -INFINITY : p0[r] + (n0 < 128 ? BT[n0] : 0.f); p1[r] = n1 < 0 ? -INFINITY : p1[r] + (n1 < 128 ? BT[n1] : 0.f); } }
            typedef float f32x2_t __attribute__((ext_vector_type(2)));
            f32x2_t ps2 = {0.f, 0.f};
#pragma unroll
            for (int r = 0; r < 16; r += 2) { p0[r] = __builtin_amdgcn_exp2f(p0[r]); p0[r + 1] = __builtin_amdgcn_exp2f(p0[r + 1]); p1[r] = __builtin_amdgcn_exp2f(p1[r]); p1[r + 1] = __builtin_amdgcn_exp2f(p1[r + 1]);
                ps2 = ps2 + (f32x2_t){p0[r], p0[r + 1]}; ps2 = ps2 + (f32x2_t){p1[r], p1[r + 1]}; }
            lsum += ps2[0] + ps2[1];
            pg8::bf16x8 pb[4];
#pragma unroll
            for (int ks = 0; ks < 4; ++ks) { v4u w;
                if (ks < 2) { w.x = pg8::cvt_pk_bf16(p0[8 * ks], p0[8 * ks + 1]); w.y = pg8::cvt_pk_bf16(p0[8 * ks + 2], p0[8 * ks + 3]); w.z = pg8::cvt_pk_bf16(p0[8 * ks + 4], p0[8 * ks + 5]); w.w = pg8::cvt_pk_bf16(p0[8 * ks + 6], p0[8 * ks + 7]); }
                else { w.x = pg8::cvt_pk_bf16(p1[8 * ks - 16], p1[8 * ks - 15]); w.y = pg8::cvt_pk_bf16(p1[8 * ks - 14], p1[8 * ks - 13]); w.z = pg8::cvt_pk_bf16(p1[8 * ks - 12], p1[8 * ks - 11]); w.w = pg8::cvt_pk_bf16(p1[8 * ks - 10], p1[8 * ks - 9]); }
                pb[ks] = __builtin_bit_cast(pg8::bf16x8, w); }
#pragma unroll
            for (int d0 = 0; d0 < 2; ++d0)
#pragma unroll
                for (int ks = 0; ks < 4; ++ks) { const pg8::bf16x8 af = *(const LAS pg8::bf16x8*)(vb + (32 * d0 + r32) * KS + 16 * ks + 8 * hi); o[d0] = __builtin_amdgcn_mfma_f32_32x32x16_bf16(af, pb[ks], o[d0], 0, 0, 0); }
        }
        if (j + 1 < NT) AT_STORE(buf ^ 1);
        if (j + 2 < NT) AT_LOAD(j + 2);
        LDS_WAIT(); __builtin_amdgcn_s_barrier(); asm volatile("" ::: "memory");
    }
#undef AT_LOAD
#undef AT_STORE
    lsum = swapadd32(lsum); const float inv = 1.0f / lsum;
    LAS float* ox = OX + (qs * 32 + r32) * 65;
    if (s == 1) {
#pragma unroll
        for (int d0 = 0; d0 < 2; ++d0)
#pragma unroll
            for (int r = 0; r < 16; ++r) ox[32 * d0 + crow_(r, hi)] = o[d0][r] * inv; }
    LDS_WAIT(); __builtin_amdgcn_s_barrier(); asm volatile("" ::: "memory");
    if (s == 0) {
        float ss = 0.f;
#pragma unroll
        for (int d0 = 0; d0 < 2; ++d0)
#pragma unroll
            for (int r = 0; r < 16; ++r) { const float v = o[d0][r] * inv - lam * ox[32 * d0 + crow_(r, hi)]; o[d0][r] = v; ss += v * v; }
        ss = swapadd32(ss); const float rs = rsqrtf(ss * (1.0f / 64) + EPS) * (1.0f - lam_init);
        const int qpos = q0 + r32;
        if (qpos < L) { bf16* brp = BR + (size_t)(rowb + qpos) * D + 768 + h * 64;
#pragma unroll
            for (int d0 = 0; d0 < 2; ++d0)
#pragma unroll
                for (int r4 = 0; r4 < 4; ++r4) { const int dv = 32 * d0 + 8 * r4 + 4 * hi; const float* sl = C.in[I_SUBLN] + l * 64 + dv;
                    const unsigned w0 = pk2(o[d0][4 * r4] * rs * sl[0], o[d0][4 * r4 + 1] * rs * sl[1]), w1 = pk2(o[d0][4 * r4 + 2] * rs * sl[2], o[d0][4 * r4 + 3] * rs * sl[3]);
                    *(unsigned long long*)(brp + dv) = (unsigned long long)w0 | ((unsigned long long)w1 << 32); } }
    }
    LDS_WAIT(); __builtin_amdgcn_s_barrier(); asm volatile("" ::: "memory");
}
constexpr int PSTR = 68;
__device__ __forceinline__ pg8::bf16x8 cvt8(const f32x4 a, const f32x4 b) { v4u w; w.x = pg8::cvt_pk_bf16(a[0], a[1]); w.y = pg8::cvt_pk_bf16(a[2], a[3]); w.z = pg8::cvt_pk_bf16(b[0], b[1]); w.w = pg8::cvt_pk_bf16(b[2], b[3]); return __builtin_bit_cast(pg8::bf16x8, w); }
__device__ __forceinline__ void attn_sample_item(const Ctx& C, int l, int b, int split) {
    THREAD_IDS();
    const int h = wave & 3, half = wave >> 2, c16 = lane & 15, g = lane >> 4, srow = c16 >> 3, t = c16 & 7;
    const bf16* QNB = WSP(bf16, WS_QNB); const int* PT = (const int*)C.in[I_PT];
    const float* CK = C.in[I_CK] + (size_t)l * NPOOL * PAGE * 256; const float* CV = C.in[I_CV] + (size_t)l * NPOOL * PAGE * 256;
    LAS float* BT = (LAS float*)C.lds;
    BT[tid] = (C.in[I_RELB][t5_bucket(tid & 127) * 4 + (tid >> 7)] - C.in[I_RELB][31 * 4 + (tid >> 7)]) * LOG2E;
    const v4u z4 = {0u, 0u, 0u, 0u};
    const v4u q0w = srow == 0 ? *(const v4u*)(QNB + (size_t)(MP + b * 8 + t) * 256 + h * 64 + 8 * g) : z4, q1w = srow == 1 ? *(const v4u*)(QNB + (size_t)(MP + b * 8 + t) * 256 + h * 64 + 32 + 8 * g) : z4;
    const pg8::bf16x8 qf0 = __builtin_bit_cast(pg8::bf16x8, q0w), qf1 = __builtin_bit_cast(pg8::bf16x8, q1w);
    LDS_WAIT(); __builtin_amdgcn_s_barrier(); asm volatile("" ::: "memory");
    float m = -INFINITY, lsum = 0.f; f32x4 o[4];
#pragma unroll
    for (int db = 0; db < 4; ++db) o[db] = (f32x4){0.f, 0.f, 0.f, 0.f};
    const int kk0 = split * 1024 + half * 512;
    const int pg0 = __builtin_amdgcn_readfirstlane(PT[b * NPAGES + (kk0 >> 7)]), pg1 = __builtin_amdgcn_readfirstlane(PT[b * NPAGES + (kk0 >> 7) + 1]), pg2 = __builtin_amdgcn_readfirstlane(PT[b * NPAGES + (kk0 >> 7) + 2]), pg3 = __builtin_amdgcn_readfirstlane(PT[b * NPAGES + (kk0 >> 7) + 3]);
#define SA_LOAD(KR, VR, st) do { const int kk_ = kk0 + 32 * (st); const int pi_ = (st) >> 2; const int page_ = pi_ == 0 ? pg0 : pi_ == 1 ? pg1 : pi_ == 2 ? pg2 : pg3; const size_t base_ = ((size_t)(page_ * PAGE + (kk_ & 127)) * 4 + h) * 64; \
        _Pragma("unroll") for (int T = 0; T < 2; ++T) _Pragma("unroll") for (int ks = 0; ks < 2; ++ks) { const float* p = CK + base_ + (size_t)(16 * T + c16) * 256 + 32 * ks + 8 * g; KR[T][ks][0] = *(const f32x4*)p; KR[T][ks][1] = *(const f32x4*)(p + 4); } \
        _Pragma("unroll") for (int db = 0; db < 4; ++db) _Pragma("unroll") for (int j = 0; j < 8; ++j) { const int kv = j < 4 ? 4 * g + j : 16 + 4 * g + (j - 4); VR[db][j] = CV[base_ + (size_t)kv * 256 + 16 * db + c16]; } } while (0)
#define SA_MATH(KR, VR, st) do { const int kk = kk0 + 32 * (st); f32x4 sv[2]; \
        _Pragma("unroll") for (int T = 0; T < 2; ++T) { sv[T] = (f32x4){0.f, 0.f, 0.f, 0.f}; \
            sv[T] = __builtin_amdgcn_mfma_f32_16x16x32_bf16(cvt8(KR[T][0][0], KR[T][0][1]), qf0, sv[T], 0, 0, 0); \
            sv[T] = __builtin_amdgcn_mfma_f32_16x16x32_bf16(cvt8(KR[T][1][0], KR[T][1][1]), qf1, sv[T], 0, 0, 0); } \
        if (kk + 31 + 128 > PAST) { \
            _Pragma("unroll") for (int T = 0; T < 2; ++T) _Pragma("unroll") for (int r = 0; r < 4; ++r) { const int n = PAST + t - (kk + 16 * T + 4 * g + r); if (n < 128) sv[T][r] += BT[h * 128 + n]; } } \
        float mt = fmaxf(fmaxf(fmaxf(sv[0][0], sv[0][1]), fmaxf(sv[0][2], sv[0][3])), fmaxf(fmaxf(sv[1][0], sv[1][1]), fmaxf(sv[1][2], sv[1][3]))); \
        mt = fmaxf(mt, __shfl_xor(mt, 16)); mt = fmaxf(mt, __shfl_xor(mt, 32)); \
        const float mn = fmaxf(m, mt); const float al = __builtin_amdgcn_exp2f(m - mn); m = mn; float ps = 0.f; \
        _Pragma("unroll") for (int T = 0; T < 2; ++T) _Pragma("unroll") for (int r = 0; r < 4; ++r) { sv[T][r] = __builtin_amdgcn_exp2f(sv[T][r] - m); ps += sv[T][r]; } \
        lsum = lsum * al + ps; const pg8::bf16x8 pf = cvt8(sv[0], sv[1]); \
        _Pragma("unroll") for (int db = 0; db < 4; ++db) { o[db] = o[db] * al; \
            const f32x4 va = {VR[db][0], VR[db][1], VR[db][2], VR[db][3]}, vb = {VR[db][4], VR[db][5], VR[db][6], VR[db][7]}; \
            o[db] = __builtin_amdgcn_mfma_f32_16x16x32_bf16(cvt8(va, vb), pf, o[db], 0, 0, 0); } } while (0)
    f32x4 krA[2][2][2], krB[2][2][2]; float vrA[4][8], vrB[4][8];
    SA_LOAD(krA, vrA, 0);
#pragma unroll 1
    for (int step = 0; step < 16; step += 2) {
        SA_LOAD(krB, vrB, step + 1);
        SA_MATH(krA, vrA, step);
        if (step + 2 < 16) SA_LOAD(krA, vrA, step + 2);
        SA_MATH(krB, vrB, step + 1);
    }
#undef SA_LOAD
#undef SA_MATH
    lsum += __shfl_xor(lsum, 16); lsum += __shfl_xor(lsum, 32);
    float* pp = WSP(float, WS_PART) + ((((size_t)b * 4 + h) * 16 + split * 2 + half) * 16 + c16) * PSTR;
#pragma unroll
    for (int db = 0; db < 4; ++db) *(f32x4*)(pp + 16 * db + 4 * g) = o[db];
    if (g == 0) { pp[64] = m; pp[65] = lsum; }
    LDS_WAIT(); __builtin_amdgcn_s_barrier(); asm volatile("" ::: "memory");
}
__device__ __forceinline__ void n3_attn_sample_combine(const Ctx& C, int l, float lam_init) {
    THREAD_IDS();
    const float lam = lam_of(C, l, lam_init);
    const bf16* QNB = WSP(bf16, WS_QNB); const bf16* KNB = WSP(bf16, WS_KNB); const bf16* ZM = WSP(bf16, WS_ZMIX); bf16* BR = WSP(bf16, WS_BR);
    for (int it = gw; it < DB * 4 * DS; it += NGW) {
        const int b = it >> 5, h = (it >> 3) & 3, t = it & 7; float os[2];
        const float far = C.in[I_RELB][31 * 4 + h];
        float sn[2][8];
        { const float qv = bf2f(QNB[(size_t)(MP + b * 8 + t) * 256 + h * 64 + lane]);
#pragma unroll
          for (int jj = 0; jj < 8; ++jj) { float p = qv * bf2f(KNB[(size_t)(MP + b * 8 + jj) * 256 + h * 64 + lane]);
              p += __shfl_xor(p, 1); p += __shfl_xor(p, 2); p += __shfl_xor(p, 4); p += __shfl_xor(p, 8); p += __shfl_xor(p, 16);
              const float bias = (C.in[I_RELB][t5_bucket(t - jj < 0 ? 0 : t - jj) * 4 + h] - far) * LOG2E;
              sn[0][jj] = jj <= t ? __shfl(p, 0) + bias : -INFINITY; sn[1][jj] = jj <= t ? __shfl(p, 32) + bias : -INFINITY; } }
#pragma unroll
        for (int s = 0; s < 2; ++s) {
            const float* pb = WSP(float, WS_PART) + ((((size_t)b * 4 + h) * 16) * 16 + s * 8 + t) * PSTR;
            float mm = -INFINITY; float pm[16];
#pragma unroll
            for (int pi = 0; pi < 16; ++pi) { pm[pi] = pb[(size_t)pi * 16 * PSTR + 64]; mm = fmaxf(mm, pm[pi]); }
#pragma unroll
            for (int jj = 0; jj < 8; ++jj) mm = fmaxf(mm, sn[s][jj]);
            float ll = 0.f, oo = 0.f;
#pragma unroll
            for (int pi = 0; pi < 16; ++pi) { const float* pr = pb + (size_t)pi * 16 * PSTR; const float w = __builtin_amdgcn_exp2f(pm[pi] - mm); ll += pr[65] * w; oo += pr[lane] * w; }
#pragma unroll
            for (int jj = 0; jj < 8; ++jj) { const float w = __builtin_amdgcn_exp2f(sn[s][jj] - mm); ll += w; oo += w * bf2f(ZM[(size_t)(MP + b * 8 + jj) * NMIXP + D_V + h * 64 + lane]); }
            os[s] = oo / ll;
        }
        const float o = os[0] - lam * os[1]; const float ms = wave_sum(o * o) * (1.0f / 64);
        BR[(size_t)(MP + b * 8 + t) * D + 768 + h * 64 + lane] = (bf16)f2bf(o * rsqrtf(ms + EPS) * C.in[I_SUBLN][l * 64 + lane] * (1.0f - lam_init));
    }
}

__device__ __forceinline__ void n3_la_finalize(const Ctx& C, int l) {
    THREAD_IDS();
    const float* LAO = WSP(float, WS_LAO); const bf16* ZM = WSP(bf16, WS_ZMIX); bf16* BR = WSP(bf16, WS_BR);
    const bool ret = lane < 32; const int hd = (lane >> 3) & 3, c8 = (lane & 7) * 8;
    float gn[8];
#pragma unroll
    for (int j = 0; j < 8; ++j) gn[j] = (ret ? C.in[I_RGN] : C.in[I_GGN])[(l * 4 + hd) * 64 + c8 + j];
    for (int r0 = gw * 4; r0 < MP; r0 += NGW * 4) {
        f32x4 a4[4], b4[4]; v4u g4[4];
#pragma unroll
        for (int u = 0; u < 4; ++u) { const int r = min(r0 + u, MP - 1); a4[u] = *(const f32x4*)(LAO + (size_t)r * 512 + 8 * lane); b4[u] = *(const f32x4*)(LAO + (size_t)r * 512 + 8 * lane + 4);
            g4[u] = *(const v4u*)(ZM + (size_t)r * NMIXP + (ret ? R_G : G_R) + hd * 64 + c8); }
#pragma unroll
        for (int u = 0; u < 4; ++u) { const int r = r0 + u; if (r >= MP) break;
            float x[8] = {a4[u][0], a4[u][1], a4[u][2], a4[u][3], b4[u][0], b4[u][1], b4[u][2], b4[u][3]}, g[8]; unpack8(g4[u], g);
            float s = ((x[0] + x[1]) + (x[2] + x[3])) + ((x[4] + x[5]) + (x[6] + x[7]));
            s += __shfl_xor(s, 1); s += __shfl_xor(s, 2); s += __shfl_xor(s, 4);
            const float mean = ret ? s * (1.0f / 64) : 0.f; float q2 = 0.f;
#pragma unroll
            for (int j = 0; j < 8; ++j) { x[j] -= mean; q2 += x[j] * x[j]; }
            q2 += __shfl_xor(q2, 1); q2 += __shfl_xor(q2, 2); q2 += __shfl_xor(q2, 4);
            const float rs = rsqrtf(q2 * (1.0f / 64) + EPS);
#pragma unroll
            for (int j = 0; j < 8; ++j) x[j] = siluf_(g[j]) * x[j] * rs * gn[j];
            *(v4u*)(BR + (size_t)r * D + 256 + 8 * lane) = pack8(x); }
    }
}

constexpr int NQB_ATT = (L + 127) / 128;
constexpr int IT_LA = 32, IT_SS = IT_LA + DB * 8, IT_AT = IT_SS + 16 * NQB_ATT, IT_LS = IT_AT + 32, IT_CV = IT_LS + (MR + 63) / 64, IT_END = IT_CV;
__device__ __forceinline__ void n2_phase(const Ctx& C, int l, float lam_init, int qslot) {
    THREAD_IDS();
    const float lam = lam_of(C, l, lam_init);
    float mb;
    { float mq = 0.f, mk = 0.f, mbias = 0.f;
#pragma unroll 1
      for (int i = 0; i < 32; ++i) { mq = fmaxf(mq, fabsf(C.in[I_QN][l * 32 + i])); mk = fmaxf(mk, fabsf(C.in[I_KN][l * 32 + i])); }
#pragma unroll 1
      for (int i = 0; i < 128; ++i) mbias = fmaxf(mbias, C.in[I_RELB][i] - C.in[I_RELB][31 * 4 + (i & 3)]);
      mb = 1.02f * 1.4426950408889634f * 5.656854249492381f * mq * mk + 1.4426950408889634f * mbias; }
    unsigned* qw = (unsigned*)(C.ws + WS_CTL) + CW_QUEUE + 64 * qslot;
    volatile LAS int* slot = (volatile LAS int*)(C.lds + MISC_OFF + 64);
    if (blockIdx.x < IT_LA) { const int it = blockIdx.x; const int b = (it >> 2) & 3, h = it & 3; if (it < 16) la_chunked<64, true>(C, l, false, b, h); else la_chunked<32, false>(C, l, false, b, h); }
    for (;;) {
        if (tid == 0) slot[0] = (int)__hip_atomic_fetch_add(qw, 1u, __ATOMIC_RELAXED, __HIP_MEMORY_SCOPE_AGENT);
        __syncthreads();
        const int qi = slot[0];
        const int it = qi < 3 * DB * 8 ? ((qi % 3) ? IT_SS + 2 * (qi / 3) + (qi % 3) - 1 : IT_LA + qi / 3) : qi + IT_LA;
        __syncthreads();
        if (it >= IT_END) break;
        if (it < IT_SS) { const int i2 = it - IT_LA; attn_sample_item(C, l, i2 >> 3, i2 & 7); }
        else if (it < IT_AT) { const int i2 = it - IT_SS; attn_prompt_item(C, l, (i2 & 15) >> 2, i2 & 3, NQB_ATT - 1 - (i2 >> 4), lam, lam_init, mb); }
        else if (it < IT_LS) { const int i2 = (it - IT_AT) * 8 + wave; const int b = (i2 >> 2) & 31, h = i2 & 3; if (i2 < 128) la_seq<64, true>(C, l, true, b, h); else la_seq<32, false>(C, l, true, b, h); }
        else { conv_rows_item(C, l, it - IT_LS); conv_state_item(C, l, it - IT_LS, IT_CV - IT_LS); }
    }
}

template <int l> __device__ __forceinline__ void layer_fwd(const Ctx& C, const XcdBarrier& bar) {
#define GRID_BAR() xcd_barrier<false>(bar)
    LAS unsigned char* ring = C.lds + RING_OFF;
    float* SS = WSP(float, WS_SS); float* H = WSP(float, WS_H); bf16* HB = WSP(bf16, WS_HB); bf16* ACT = WSP(bf16, WS_ACT); bf16* ZMIX = WSP(bf16, WS_ZMIX); bf16* GATES = WSP(bf16, WS_GATES);
    bf16* BR = WSP(bf16, WS_BR); bf16* MERGED = WSP(bf16, WS_MERGED);
    constexpr float lam_init = l == 0 ? 0.2f : 0.35550906759096926f;
    constexpr bool last = (l == DEPTH - 1);
    { pg8::Gemm g{HB, WSP(bf16, WS_W1 + (size_t)(l * 2 + 0) * SZ_W1), D, D, D}; pg8::StaticOrder S; S.init(M, 2 * DFF, C.G, (int)blockIdx.x);
      EpiGLU E{ACT, SS + (size_t)(l * 3 + 0) * M * 16}; pg8::gemm_phase<EpiGLU, pg8::StaticOrder, true, true>(ring, g, S, E); }
    GRID_BAR();
    { pg8::HeadOrder S; S.init(M, D, C.G, (int)blockIdx.x); S.limit = C.G; EpiRes<false, 1> E{H, HB, SS + (size_t)(l * 3 + 1) * M * 16, nullptr};
      { pg8::Gemm g{ACT, WSP(bf16, WS_WD + (size_t)(l * 2 + 0) * SZ_WD), DFF, DFF, DFF}; pg8::gemm_phase<EpiRes<false, 1>, pg8::HeadOrder, true, true>(ring, g, S, E); }
      { int kt = DFF / 11; asm volatile("" : "+s"(kt)); pg8::Gemm g{ACT, WSP(bf16, WS_WD + (size_t)(l * 2 + 0) * SZ_WD), DFF, DFF, kt}; pg8::TailOrder T; T.init(M, D, C.G, (int)blockIdx.x); T.limit = C.G; T.nsplit = 11; T.kper = DFF / 11;
        EpiPartial EP{WSP(float, WS_KSP)}; pg8::gemm_phase<EpiPartial, pg8::TailOrder, true, true>(ring, g, T, EP); }
      ksp_finalize_local<11>(WSP(float, WS_KSP), S, C.G, E, (unsigned*)(C.ws + WS_CTL) + CW_TAIL + 512 * (l * 3 + 0), (unsigned*)(C.ws + WS_CTL) + CW_BAR); }
    GRID_BAR();
    { pg8::Gemm g{HB, WSP(bf16, WS_WIN + (size_t)l * SZ_WIN), D, D, D}; pg8::StaticOrder S; S.init(M, NINP, C.G, (int)blockIdx.x);
      EpiZ E{ZMIX, GATES, SS + (size_t)(l * 3 + 1) * M * 16, WSP(float, WS_BINP) + l * NINP}; pg8::gemm_phase<EpiZ, pg8::StaticOrder, true, true>(ring, g, S, E); }
    GRID_BAR();
    n1_prep(C, l);
    GRID_BAR();
    n2_phase(C, l, lam_init, l);
    GRID_BAR();
    n3_attn_sample_combine(C, l, lam_init);
    n3_la_finalize(C, l);
    GRID_BAR();
    { pg8::HeadOrder S; S.init(M, D, C.G, (int)blockIdx.x); S.limit = C.G;
      { pg8::Gemm g{BR, WSP(bf16, WS_WBR + (size_t)l * SZ_WBR), D, D, D}; EpiMergeR E{MERGED, GATES}; pg8::gemm_phase<EpiMergeR, pg8::HeadOrder, true, true, 4>(ring, g, S, E); }
      { int kt = D / 4; asm volatile("" : "+s"(kt)); pg8::Gemm g{BR, WSP(bf16, WS_WBR + (size_t)l * SZ_WBR), D, D, kt}; pg8::TailOrder T; T.init(M, D, C.G, (int)blockIdx.x); T.limit = C.G; T.nsplit = 4; T.kper = D / 4;
        EpiPartial EP{WSP(float, WS_KSP)}; pg8::gemm_phase<EpiPartial, pg8::TailOrder, true, true>(ring, g, T, EP); }
      merge_finalize_local(WSP(float, WS_KSP), S, C.G, MERGED, GATES, (unsigned*)(C.ws + WS_CTL) + CW_TAIL + 512 * (6 + l), (unsigned*)(C.ws + WS_CTL) + CW_BAR); }
    GRID_BAR();
    { pg8::HeadOrder S; S.init(M, D, C.G, (int)blockIdx.x); S.limit = C.G; EpiRes<false, 2> E{H, HB, SS + (size_t)(l * 3 + 2) * M * 16, nullptr};
      { pg8::Gemm g{MERGED, WSP(bf16, WS_WOUT + (size_t)l * SZ_WOUT), D, D, D}; pg8::gemm_phase<EpiRes<false, 2>, pg8::HeadOrder, true, true>(ring, g, S, E); }
      { int kt = D / 4; asm volatile("" : "+s"(kt)); pg8::Gemm g{MERGED, WSP(bf16, WS_WOUT + (size_t)l * SZ_WOUT), D, D, kt}; pg8::TailOrder T; T.init(M, D, C.G, (int)blockIdx.x); T.limit = C.G; T.nsplit = 4; T.kper = D / 4;
        EpiPartial EP{WSP(float, WS_KSP)}; pg8::gemm_phase<EpiPartial, pg8::TailOrder, true, true>(ring, g, T, EP); }
      ksp_finalize_local<4>(WSP(float, WS_KSP), S, C.G, E, (unsigned*)(C.ws + WS_CTL) + CW_TAIL + 512 * (l * 3 + 1), (unsigned*)(C.ws + WS_CTL) + CW_BAR); }
    GRID_BAR();
    { pg8::Gemm g{HB, WSP(bf16, WS_W1 + (size_t)(l * 2 + 1) * SZ_W1), D, D, D}; pg8::StaticOrder S; S.init(M, 2 * DFF, C.G, (int)blockIdx.x);
      EpiGLU E{ACT, SS + (size_t)(l * 3 + 2) * M * 16}; pg8::gemm_phase<EpiGLU, pg8::StaticOrder, true, true>(ring, g, S, E); }
    GRID_BAR();
    { pg8::HeadOrder S; S.init(M, D, C.G, (int)blockIdx.x); S.limit = C.G; EpiRes<last, 1> E{H, HB, last ? nullptr : SS + (size_t)((l + 1) * 3) * M * 16, C.out};
      { pg8::Gemm g{ACT, WSP(bf16, WS_WD + (size_t)(l * 2 + 1) * SZ_WD), DFF, DFF, DFF}; pg8::gemm_phase<EpiRes<last, 1>, pg8::HeadOrder, true, true>(ring, g, S, E); }
      { int kt = DFF / 11; asm volatile("" : "+s"(kt)); pg8::Gemm g{ACT, WSP(bf16, WS_WD + (size_t)(l * 2 + 1) * SZ_WD), DFF, DFF, kt}; pg8::TailOrder T; T.init(M, D, C.G, (int)blockIdx.x); T.limit = C.G; T.nsplit = 11; T.kper = DFF / 11;
        EpiPartial EP{WSP(float, WS_KSP)}; pg8::gemm_phase<EpiPartial, pg8::TailOrder, true, true>(ring, g, T, EP); }
      ksp_finalize_local<11>(WSP(float, WS_KSP), S, C.G, E, (unsigned*)(C.ws + WS_CTL) + CW_TAIL + 512 * (l * 3 + 2), (unsigned*)(C.ws + WS_CTL) + CW_BAR); }
#undef GRID_BAR
}

__global__ void __launch_bounds__(NWAVES * 64, 2) fwd(Params P) {
    extern __shared__ __attribute__((aligned(16))) unsigned char lds[];
    Ctx C;
    C.in = P.in; C.out = P.out; C.ws = P.ws; C.lds = (LAS unsigned char*)lds;
    C.G = gridDim.x;
    volatile LAS unsigned* MISC = (volatile LAS unsigned*)(C.lds + MISC_OFF);
    for (int u = threadIdx.x; u < (LDS_BYTES - LDSCTL_OFF) / 4; u += NWAVES * 64) ((LAS unsigned*)(C.lds + LDSCTL_OFF))[u] = 0u;
    __syncthreads();
    unsigned* ctl = (unsigned*)(C.ws + WS_CTL);
    XcdBarrier bar = xcd_barrier_post(ctl + CW_BAR, MISC + 8);
    p0_prologue(C, P);
    xcd_barrier<true>(bar);
    layer_fwd<0>(C, bar);
    xcd_barrier<false>(bar);
    layer_fwd<1>(C, bar);
}

extern "C" void kernel_launch(void* const* d_in, const int* in_sizes, int n_in, void* d_out, int out_size, void* d_ws, size_t ws_size, hipStream_t stream) {
    static int grid = 0;
    if (grid == 0) {
        if (n_in != N_INPUTS || (size_t)out_size != O_END || ws_size < WS_END) { fprintf(stderr, "kernel_launch: unexpected shapes: n_in %d out %d (want %zu) ws %zu (want %zu)\n", n_in, out_size, (size_t)O_END, ws_size, (size_t)WS_END); grid = -1; return; }
        int dev = 0, cus = 0, per_cu = 0;
        if (hipGetDevice(&dev) != hipSuccess || hipDeviceGetAttribute(&cus, hipDeviceAttributeMultiprocessorCount, dev) != hipSuccess) { grid = -1; return; }
        if (hipFuncSetAttribute((const void*)fwd, hipFuncAttributeMaxDynamicSharedMemorySize, LDS_BYTES) != hipSuccess) { fprintf(stderr, "kernel_launch: hipFuncSetAttribute failed\n"); grid = -1; return; }
        if (hipOccupancyMaxActiveBlocksPerMultiprocessor(&per_cu, (const void*)fwd, NWAVES * 64, LDS_BYTES) != hipSuccess || per_cu < 1) { fprintf(stderr, "kernel_launch: occupancy query says %d blocks per CU\n", per_cu); }
        (void)hipGetLastError();
        grid = cus;
    }
    if (grid < 0) return;
    if (hipMemsetAsync((char*)d_ws + WS_CTL, 0, CTL_ZERO_BYTES, stream) != hipSuccess) return;
    Params p{};
    for (int i = 0; i < N_INPUTS; ++i) p.in[i] = (const float*)d_in[i];
    p.out = (float*)d_out; p.ws = (unsigned char*)d_ws;
    for (int i = 0; i < 32; ++i) p.inv_freq[i] = (float)pow(10000.0, -(double)i / 32.0);
    hipLaunchKernelGGL(fwd, dim3(grid), dim3(NWAVES * 64), LDS_BYTES, stream, p);
}
```

```cpp
#include <hip/hip_runtime.h>
#include <cstdio>
#include <cstdint>
#include <cmath>

namespace pg8 {
#define PG8_LAS __attribute__((address_space(3)))
typedef unsigned short bf16_t;
typedef short bf16x8 __attribute__((ext_vector_type(8)));
typedef float f32x4 __attribute__((ext_vector_type(4)));
typedef unsigned u32x4 __attribute__((ext_vector_type(4)));
constexpr int BM = 256, BK = 64, HALF = 128, HTB = HALF * BK * 2  , STAGE_BYTES = 8 * HTB, NXCD = 8, WGM = 8;

__host__ __device__ __forceinline__ int lds_byte(int r, int c) { const int st = (r >> 4) * 2 + (c >> 5), rr = r & 15, cc = c & 31, ob = rr * 64 + cc * 2; return st * 1024 + (ob ^ (((ob >> 9) & 1) << 5)); }
__host__ __device__ __forceinline__ void stage_rc(int b, int& R, int& C) { const int st = b / 1024, sb = b % 1024, swz = sb ^ (((sb >> 9) & 1) << 5); R = (st >> 1) * 16 + swz / 64; C = (st & 1) * 32 + (swz % 64) / 2; }
__host__ __device__ __forceinline__ int perm32(int rho) { const int n = rho >> 4, i = rho & 15; return 8 * (i >> 2) + 4 * n + (i & 3); }

struct Unit { int pm, pn, acol, bcol; };
struct Gemm { const bf16_t* A; const bf16_t* Bt; int lda, ldb, K, kseg0; };

struct StaticOrder {
    int nM, nN, nwg, G, c;
    __host__ __device__ void init(int M, int N, int G_, int c_) { nM = M / BM; nN = N / BM; nwg = nM * nN; G = G_; c = c_; }
    __host__ __device__ void unit_of(int L, Unit& u) const {
        int wgid = L; { const int q = nwg / NXCD, r = nwg % NXCD, xcd = wgid % NXCD, off = wgid / NXCD; wgid = (xcd < r ? xcd * (q + 1) : r * (q + 1) + (xcd - r) * q) + off; }
        const int nig = WGM * nN, gid = wgid / nig, fm = gid * WGM, gsz = (nM - fm) < WGM ? (nM - fm) : WGM;
        u.pm = fm + ((wgid % nig) % gsz); u.pn = (wgid % nig) / gsz; u.acol = 0; u.bcol = 0;
    }
    __host__ __device__ bool next(int i, Unit& u) const { const long L = (long)i * G + c; if (L >= nwg) return false; unit_of((int)L, u); return true; }
};
struct HeadOrder : StaticOrder { int limit; __host__ __device__ bool next(int i, Unit& u) const { const long L = (long)i * G + c; if (L >= limit || L >= nwg) return false; unit_of((int)L, u); return true; } };
struct TailOrder : StaticOrder { int limit, nsplit, kper;
    __host__ __device__ bool next(int i, Unit& u) const {
        if (i > 0 || c >= (nwg - limit) * nsplit) return false;
        unit_of(limit + c / nsplit, u); u.acol = u.bcol = (c % nsplit) * kper; return true; } };
__device__ __forceinline__ unsigned cvt_pk_bf16(float lo, float hi) { unsigned r; asm volatile("v_cvt_pk_bf16_f32 %0, %1, %2" : "=v"(r) : "v"(lo), "v"(hi)); return r; }

template <class Epi, class Sched, bool ALIGN_EPI = false, bool SP2 = false, int SEG = 0>
__device__ __forceinline__ void gemm_phase(PG8_LAS unsigned char* lds, const Gemm g, const Sched& S, const Epi& E) {
    int tid_ = threadIdx.x; asm volatile("" : "+v"(tid_));
    const int tid = tid_, wid = __builtin_amdgcn_readfirstlane(tid >> 6), lane = tid & 63, wr = wid >> 2, wc = wid & 3, fr = lane & 15, fq = lane >> 4;
    const int nt = g.K / BK;
    unsigned voffA[2], voffB[2];
#pragma unroll
    for (int i = 0; i < 2; ++i) { int R, C; stage_rc(tid * 16 + i * 8192, R, C); const int Rb = Epi::PERM ? ((R & ~31) + perm32(R & 31)) : R;
        voffA[i] = (unsigned)(R * g.lda + C) * 2u; voffB[i] = (unsigned)(Rb * g.ldb + C) * 2u; }
    const size_t kstep = (size_t)(BK * 2);
    const size_t hstepA = (size_t)HALF * g.lda * 2, hstepB = (size_t)HALF * g.ldb * 2;
    const size_t tstepA = 2 * hstepA, tstepB = 2 * hstepB;
    const unsigned ldsw = (unsigned)wid * 1024u;
    const int aoff = lds_byte(wr * 64 + fr, fq * 8), boff = lds_byte(wc * 32 + fr, fq * 8);
#define PG8_SA(b, h) (((b) * 2 + (h)) * HTB)
#define PG8_SB(b, h) ((4 + (b) * 2 + (h)) * HTB)
#define PG8_STAGE(bufoff, gbase, voff) do { _Pragma("unroll") for (int _i = 0; _i < 2; ++_i) \
        __builtin_amdgcn_global_load_lds((const unsigned*)((const char*)(gbase) + (voff)[_i]), (PG8_LAS unsigned*)(lds + (bufoff) + ldsw + _i * 8192), 16, 0, 0); } while (0)
#define PG8_LDA(dst, b, h) do { _Pragma("unroll") for (int m = 0; m < 4; ++m) _Pragma("unroll") for (int k = 0; k < 2; ++k) dst[m][k] = *(const PG8_LAS bf16x8*)(lds + PG8_SA(b, h) + aoff + m * 2048 + k * 1024); } while (0)
#define PG8_LDB(dst, b, h) do { _Pragma("unroll") for (int n = 0; n < 2; ++n) _Pragma("unroll") for (int k = 0; k < 2; ++k) dst[n][k] = *(const PG8_LAS bf16x8*)(lds + PG8_SB(b, h) + boff + n * 2048 + k * 1024); } while (0)
#define PG8_MMA(ai, bj, At, Bt) do { __builtin_amdgcn_s_setprio(1); _Pragma("unroll") for (int m = 0; m < 4; ++m) _Pragma("unroll") for (int n = 0; n < 2; ++n) _Pragma("unroll") for (int k = 0; k < 2; ++k) \
        acc[ai][bj][m][n] = __builtin_amdgcn_mfma_f32_16x16x32_bf16(Bt[n][k], At[m][k], acc[ai][bj][m][n], 0, 0, 0); __builtin_amdgcn_s_setprio(0); } while (0)
#define PG8_WAIT_V(n) asm volatile("s_waitcnt vmcnt(" #n ")" ::: "memory")
#define PG8_WAIT_L(n) asm volatile("s_waitcnt lgkmcnt(" #n ")" ::: "memory")
#define PG8_BAR __builtin_amdgcn_s_barrier()
#define PG8_SCHED __builtin_amdgcn_sched_barrier(0)
    Unit cur, nxt; int ui = 0;
    if (!S.next(0, cur)) return;
    f32x4 acc[2][2][4][2];
#pragma unroll
    for (int a = 0; a < 2; ++a)
#pragma unroll
        for (int b = 0; b < 2; ++b)
#pragma unroll
            for (int m = 0; m < 4; ++m)
#pragma unroll
                for (int n = 0; n < 2; ++n) acc[a][b][m][n] = (f32x4){0.f, 0.f, 0.f, 0.f};
    bf16x8 At[4][2], B0[2][2], B1[2][2];
    const char* cA = (const char*)g.A + (size_t)cur.pm * tstepA + (size_t)cur.acol * 2; const char* cB = (const char*)g.Bt + (size_t)cur.pn * tstepB + (size_t)cur.bcol * 2;
#define PG8_KOFF(t) ((SEG > 0) ? (size_t)(((((t) / (SEG > 0 ? SEG : 1)) + g.kseg0) & (nt / (SEG > 0 ? SEG : 1) - 1)) * (SEG > 0 ? SEG : 1) + ((t) % (SEG > 0 ? SEG : 1))) * kstep : (size_t)(t) * kstep)
    const size_t K0 = PG8_KOFF(0);
    cA += K0; cB += K0;
    if constexpr (SP2) {
        PG8_STAGE(PG8_SB(0, 0), cB, voffB); PG8_STAGE(PG8_SB(0, 1), cB + hstepB, voffB); PG8_STAGE(PG8_SA(0, 0), cA, voffA); PG8_STAGE(PG8_SA(0, 1), cA + hstepA, voffA);
        if (wr == 1) PG8_BAR;
        PG8_WAIT_V(2); PG8_BAR;
        PG8_STAGE(PG8_SB(1, 0), cB + kstep, voffB); PG8_STAGE(PG8_SA(1, 0), cA + kstep, voffA); PG8_STAGE(PG8_SB(1, 1), cB + hstepB + kstep, voffB);
        PG8_WAIT_V(6); PG8_BAR;
    } else {
        PG8_STAGE(PG8_SB(0, 0), cB, voffB); PG8_STAGE(PG8_SA(0, 0), cA, voffA); PG8_STAGE(PG8_SB(0, 1), cB + hstepB, voffB); PG8_STAGE(PG8_SA(0, 1), cA + hstepA, voffA);
        if (wr == 1) PG8_BAR;
        PG8_WAIT_V(4); PG8_BAR;
        PG8_STAGE(PG8_SB(1, 0), cB + kstep, voffB); PG8_STAGE(PG8_SA(1, 0), cA + kstep, voffA); PG8_STAGE(PG8_SB(1, 1), cB + hstepB + kstep, voffB);
        PG8_WAIT_V(6); PG8_BAR;
    }
    for (;;) {
        const bool has_next = S.next(ui + 1, nxt);
        const char* nA = has_next ? (const char*)g.A + (size_t)nxt.pm * tstepA + (size_t)nxt.acol * 2 + K0 : cA; const char* nB = has_next ? (const char*)g.Bt + (size_t)nxt.pn * tstepB + (size_t)nxt.bcol * 2 + K0 : cB;
        for (int t = 0; t < nt; t += 2) {
            const bool last = (t == nt - 2);
            const char* a1 = cA - K0 + PG8_KOFF(t + 1);
            const char* a2 = last ? nA : cA - K0 + PG8_KOFF(t + 2); const char* b2 = last ? nB : cB - K0 + PG8_KOFF(t + 2);
            const char* a3 = a2 + kstep; const char* b3 = b2 + kstep;
            if constexpr (SP2) {
            PG8_LDB(B0, 0, 0); PG8_LDB(B1, 0, 1); PG8_SCHED; PG8_LDA(At, 0, 0); PG8_STAGE(PG8_SA(1, 1), a1 + hstepA, voffA);
            PG8_WAIT_V(8); PG8_WAIT_L(0); PG8_BAR; PG8_MMA(0, 0, At, B0); PG8_MMA(0, 1, At, B1); PG8_BAR; PG8_SCHED;
            PG8_LDA(At, 0, 1); PG8_STAGE(PG8_SB(0, 0), b2, voffB); PG8_STAGE(PG8_SB(0, 1), b2 + hstepB, voffB); PG8_STAGE(PG8_SA(0, 0), a2, voffA);
            PG8_WAIT_V(8); PG8_WAIT_L(0); PG8_BAR; PG8_MMA(1, 0, At, B0); PG8_MMA(1, 1, At, B1); PG8_BAR; PG8_SCHED;
            PG8_LDB(B0, 1, 0); PG8_LDB(B1, 1, 1); PG8_SCHED; PG8_LDA(At, 1, 0); PG8_STAGE(PG8_SA(0, 1), a2 + hstepA, voffA);
            PG8_WAIT_V(8); PG8_WAIT_L(0); PG8_BAR; PG8_MMA(0, 0, At, B0); PG8_MMA(0, 1, At, B1); PG8_BAR; PG8_SCHED;
            PG8_LDA(At, 1, 1); PG8_STAGE(PG8_SB(1, 0), b3, voffB); PG8_STAGE(PG8_SB(1, 1), b3 + hstepB, voffB); PG8_STAGE(PG8_SA(1, 0), a3, voffA);
            PG8_WAIT_V(8); PG8_WAIT_L(0); PG8_BAR; PG8_MMA(1, 0, At, B0); PG8_MMA(1, 1, At, B1); PG8_BAR; PG8_SCHED;
            } else {
            PG8_LDB(B0, 0, 0); PG8_SCHED; PG8_LDA(At, 0, 0); PG8_STAGE(PG8_SA(1, 1), a1 + hstepA, voffA);
            PG8_WAIT_L(8); PG8_BAR; PG8_WAIT_L(0); PG8_MMA(0, 0, At, B0); PG8_BAR; PG8_SCHED;
            PG8_LDB(B1, 0, 1); PG8_STAGE(PG8_SB(0, 0), b2, voffB);
            PG8_BAR; PG8_WAIT_L(0); PG8_MMA(0, 1, At, B1); PG8_BAR;
            PG8_LDA(At, 0, 1); PG8_STAGE(PG8_SA(0, 0), a2, voffA);
            PG8_BAR; PG8_WAIT_L(0); PG8_MMA(1, 0, At, B0); PG8_BAR; PG8_SCHED;
            PG8_STAGE(PG8_SB(0, 1), b2 + hstepB, voffB);
            PG8_WAIT_V(6); PG8_BAR; PG8_MMA(1, 1, At, B1); PG8_BAR;
            PG8_LDB(B0, 1, 0); PG8_SCHED; PG8_LDA(At, 1, 0); PG8_STAGE(PG8_SA(0, 1), a2 + hstepA, voffA);
            PG8_WAIT_L(8); PG8_BAR; PG8_WAIT_L(0); PG8_MMA(0, 0, At, B0); PG8_BAR; PG8_SCHED;
            PG8_LDB(B1, 1, 1); PG8_STAGE(PG8_SB(1, 0), b3, voffB);
            PG8_BAR; PG8_WAIT_L(0); PG8_MMA(0, 1, At, B1); PG8_BAR;
            PG8_LDA(At, 1, 1); PG8_STAGE(PG8_SA(1, 0), a3, voffA);
            PG8_BAR; PG8_WAIT_L(0); PG8_MMA(1, 0, At, B0); PG8_BAR; PG8_SCHED;
            PG8_STAGE(PG8_SB(1, 1), b3 + hstepB, voffB);
            PG8_WAIT_V(6); PG8_BAR; PG8_MMA(1, 1, At, B1); PG8_BAR;
            }
            if constexpr (SEG > 0) { if (((t + 2) % SEG) == 0 && (t + 2) < nt) E.mid(acc, cur, (t + 2) / SEG, g.kseg0); }
        }
        if constexpr (ALIGN_EPI) { if (wr == 0) PG8_BAR; }
        E(acc, cur, wr, wc, fr, fq);
        if (!has_next) break;
#pragma unroll
        for (int a = 0; a < 2; ++a)
#pragma unroll
            for (int b = 0; b < 2; ++b)
#pragma unroll
                for (int m = 0; m < 4; ++m)
#pragma unroll
                    for (int n = 0; n < 2; ++n) acc[a][b][m][n] = (f32x4){0.f, 0.f, 0.f, 0.f};
        cur = nxt; cA = nA; cB = nB; ++ui;
        if constexpr (ALIGN_EPI) { if (wr == 1) PG8_BAR; }
    }
    PG8_WAIT_V(0);
    if constexpr (!ALIGN_EPI) { if (wr == 0) PG8_BAR; }
    PG8_BAR;
#undef PG8_KOFF
#undef PG8_SA
#undef PG8_SB
#undef PG8_STAGE
#undef PG8_LDA
#undef PG8_LDB
#undef PG8_MMA
#undef PG8_WAIT_V
#undef PG8_WAIT_L
#undef PG8_BAR
#undef PG8_SCHED
}
}

constexpr int NWAVES = 8;
constexpr int D = 1024, DFF = 2816, NIN = 7184, NMIX = 3088, NMIXP = 3328, NGATE = 4096, NINP = NMIXP + NGATE;
constexpr int SEQ = 4096, NMETA = 16, L = SEQ + NMETA, BATCH = 4, DB = 32, DS = 8, PAST = 8192, PAGE = 128, NPAGES = PAST / PAGE, NPOOL = 2560, DEPTH = 2;
constexpr int MP = BATCH * L, MS = DB * DS, MR = MP + MS, M = 16896;
constexpr int NPOS = L + DS;
constexpr float EPS = 1e-6f;
constexpr int C_A = 0, C_G = 256, R_Q = 512, R_K = 768, R_V = 1024, R_G = 1280, G_Q = 1536, G_K = 1664, G_V = 1792, G_R = 2048, G_LOW = 2304, D_Q = 2320, D_K = 2576, D_V = 2832;
constexpr size_t O_YP = 0, O_YS = O_YP + (size_t)BATCH * SEQ * D, O_KP = O_YS + (size_t)MS * D, O_VP = O_KP + (size_t)DEPTH * MP * 256, O_KS = O_VP + (size_t)DEPTH * MP * 256,
                 O_VS = O_KS + (size_t)DEPTH * MS * 256, O_RP = O_VS + (size_t)DEPTH * MS * 256, O_RS = O_RP + (size_t)DEPTH * BATCH * 4 * 64 * 64, O_GP = O_RS + (size_t)DEPTH * DB * 4 * 64 * 64,
                 O_GS = O_GP + (size_t)DEPTH * BATCH * 4 * 32 * 64, O_CP = O_GS + (size_t)DEPTH * DB * 4 * 32 * 64, O_CS = O_CP + (size_t)DEPTH * BATCH * 30 * 256, O_END = O_CS + (size_t)DEPTH * DB * 30 * 256;
enum { I_XP = 0, I_XS, I_CK, I_CV, I_PT, I_SRET, I_SGLA, I_SCONV, I_META, I_RELB, I_NF1, I_F1G, I_F1U, I_F1D, I_NMIX, I_WIN, I_BIN, I_CW, I_CB, I_CLG, I_CLB, I_RGN, I_GAW, I_GAB, I_GGN,
       I_QN, I_KN, I_LQ1, I_LK1, I_LQ2, I_LK2, I_SUBLN, I_WBR, I_WOUT, I_NF2, I_F2G, I_F2U, I_F2D, N_INPUTS };

constexpr size_t MiB = 1u << 20;
constexpr size_t WS_CTL = 0, CTL_ZERO_BYTES = 64 * 1024;
constexpr size_t SZ_SS = (size_t)M * 16 * 4;
constexpr size_t SZ_W1 = (size_t)2 * DFF * D * 2, SZ_WD = (size_t)D * DFF * 2, SZ_WIN = (size_t)NINP * D * 2, SZ_WBR = (size_t)4 * D * 256 * 2, SZ_WOUT = (size_t)D * D * 2;
constexpr size_t WS_W1 = 4 * MiB;
constexpr size_t WS_WD = WS_W1 + 4 * SZ_W1;
constexpr size_t WS_WIN = WS_WD + 4 * SZ_WD;
constexpr size_t WS_WBR = WS_WIN + 2 * SZ_WIN;
constexpr size_t WS_WOUT = WS_WBR + 2 * SZ_WBR;
constexpr size_t WS_BINP = WS_WOUT + 2 * SZ_WOUT;
constexpr size_t WS_ROPE = WS_BINP + 64 * 1024;
constexpr size_t WS_SS = WS_ROPE + 2 * MiB;
constexpr size_t WS_H = 128 * MiB;
constexpr size_t WS_HB = WS_H + (size_t)M * D * 4;
constexpr size_t WS_ACT = WS_HB + (size_t)M * D * 2;
constexpr size_t WS_ZMIX = WS_ACT + (size_t)M * DFF * 2;
constexpr size_t WS_GATES = WS_ZMIX + (size_t)M * NMIXP * 2;
constexpr size_t WS_BR = WS_GATES + (size_t)M * NGATE * 2;
constexpr size_t WS_MERGED = WS_BR + (size_t)M * D * 2;
constexpr size_t WS_UBUF = WS_MERGED + (size_t)M * D * 2;
constexpr size_t WS_RQ = WS_UBUF + (size_t)M * 256 * 4, WS_RK = WS_RQ + (size_t)M * 256 * 4, WS_QN = WS_RK + (size_t)M * 256 * 4, WS_KN = WS_QN + (size_t)M * 256 * 4, WS_VB = WS_KN + (size_t)M * 256 * 4;
constexpr size_t WS_LDEC = WS_VB + (size_t)M * 256 * 4;
constexpr size_t WS_QNB = WS_LDEC + (size_t)M * 128 * 4;
constexpr size_t WS_KNB = WS_QNB + (size_t)M * 256 * 2;
constexpr size_t WS_PART = WS_KNB + (size_t)M * 256 * 2;
constexpr size_t WS_LAO = WS_PART + (size_t)DB * 4 * 16 * 16 * 68 * 4;
constexpr size_t WS_KSP = WS_LAO + (size_t)M * 512 * 4;
constexpr size_t WS_END = WS_KSP + (size_t)8 * 11 * 65536 * 4;
static_assert(WS_ROPE + 2 * NPOS * 32 * 4 <= WS_SS && WS_SS + 6 * SZ_SS <= WS_H, "weights region overflows");
constexpr int CW_BAR = 4096, CW_QUEUE = 8192, CW_TAIL = 12288;

constexpr int RING_OFF = 0, RING_BYTES = 131072;
constexpr int LDSCTL_OFF = 144384, MISC_OFF = LDSCTL_OFF + 320;
constexpr int LDS_BYTES = 147456;
static_assert(MISC_OFF + 128 <= LDS_BYTES, "LDS map");

#define GAS __attribute__((address_space(1)))
#define LAS __attribute__((address_space(3)))
typedef unsigned short bf16;
typedef unsigned v4u __attribute__((ext_vector_type(4)));
typedef float f32x4 __attribute__((ext_vector_type(4)));
#define LDS_WAIT() asm volatile("s_waitcnt lgkmcnt(0)" ::: "memory")
#define VM_WAIT() asm volatile("s_waitcnt vmcnt(0)" ::: "memory")
__device__ __forceinline__ unsigned f2bf(float f) { unsigned u = __builtin_bit_cast(unsigned, f); return (u + 0x7fffu + ((u >> 16) & 1u)) >> 16; }
__device__ __forceinline__ unsigned pk2(float lo, float hi) { return f2bf(lo) | (f2bf(hi) << 16); }
__device__ __forceinline__ float bf2f(bf16 b) { return __builtin_bit_cast(float, ((unsigned)b) << 16); }
__device__ __forceinline__ float bflo(unsigned w) { return __builtin_bit_cast(float, w << 16); }
__device__ __forceinline__ float bfhi(unsigned w) { return __builtin_bit_cast(float, w & 0xffff0000u); }
__device__ __forceinline__ float wave_sum(float v) {
#pragma unroll
    for (int o = 1; o < 64; o <<= 1) v += __shfl_xor(v, o);
    return v;
}
__device__ __forceinline__ float sigmoidf_(float x) { return __builtin_amdgcn_rcpf(1.0f + __expf(-x)); }
__device__ __forceinline__ float siluf_(float x) { return x * __builtin_amdgcn_rcpf(1.0f + __expf(-x)); }

#define XB_TMO      128
#define XB_XCNT(j)  (256  + 64 * (j))
#define XB_XSUB(j)  (1280 + 64 * (j))
#define XB_XGEN(j)  (2304 + 64 * (j))
#define XB_TOP      3328
#define XB_TOPGEN   3392
#define XCD_BAR_WORDS 3456
#define XB_SPIN_CAP (1u << 22)

__device__ __forceinline__ unsigned xb_ld(unsigned* p)              { return __hip_atomic_load(p, __ATOMIC_RELAXED, __HIP_MEMORY_SCOPE_AGENT); }
__device__ __forceinline__ unsigned xb_add(unsigned* p, unsigned v) { return __hip_atomic_fetch_add(p, v, __ATOMIC_RELAXED, __HIP_MEMORY_SCOPE_AGENT); }
__device__ __forceinline__ unsigned xb_xcc_id() { return (unsigned)__builtin_amdgcn_s_getreg((3 << 11) | 20) & 0xFu; }
#define XB_SPIN(cond, bar) do { unsigned _sp = 0; while (cond) { __builtin_amdgcn_s_sleep(1); \
    if ((++_sp & 255u) == 0u) { if (xb_ld(&(bar)[XB_TMO])) break; if (_sp > XB_SPIN_CAP) { atomicAdd(&(bar)[XB_TMO], 1u); break; } } } } while (0)

struct XcdBarrier { unsigned* bar; unsigned x; volatile LAS unsigned* st; };

__device__ __forceinline__ XcdBarrier xcd_barrier_post(unsigned* bar, volatile LAS unsigned* st) {
    XcdBarrier b; b.bar = bar; b.x = xb_xcc_id(); b.st = st;
    if (threadIdx.x == 0) (void)xb_add(&bar[XB_XCNT(b.x)], 1u);
    return b;
}
__device__ __forceinline__ void xcd_barrier_complete(unsigned* bar, unsigned x, unsigned& nloc, unsigned& nx) {
    const unsigned G = gridDim.x * gridDim.y * gridDim.z;
    unsigned sum, cnt, mine, sp = 0u;
    for (;;) {
        sum = 0u; cnt = 0u; mine = 0u;
#pragma unroll
        for (unsigned j = 0; j < 16; ++j) { const unsigned c = xb_ld(&bar[XB_XCNT(j)]); sum += c; cnt += (c > 0u) ? 1u : 0u; mine = (j == x) ? c : mine; }
        if (sum == G) break;
        __builtin_amdgcn_s_sleep(1);
        if ((++sp & 255u) == 0u) { if (xb_ld(&bar[XB_TMO])) break; if (sp > XB_SPIN_CAP) { atomicAdd(&bar[XB_TMO], 1u); break; } }
    }
    nloc = mine > 0u ? mine : 1u; nx = cnt > 0u ? cnt : 1u;
}
#ifndef FLAT_BAR
#define FLAT_BAR 0
#endif
__device__ __forceinline__ void flat_barrier(const XcdBarrier& b) {
    asm volatile("s_waitcnt vmcnt(0)" ::: "memory");
    __syncthreads();
    if (threadIdx.x == 0) {
        unsigned* bar = b.bar;
        asm volatile("" : "+s"(bar));
        const unsigned epoch = b.st[2] + 1u; b.st[2] = epoch; const unsigned target = epoch * gridDim.x;
        __builtin_amdgcn_fence(__ATOMIC_RELEASE, "agent");
        asm volatile("s_waitcnt vmcnt(0)" ::: "memory");
        (void)xb_add(&bar[XB_TOP], 1u);
        unsigned sp = 0u;
        while (xb_ld(&bar[XB_TOP]) < target) { __builtin_amdgcn_s_sleep(1); if ((++sp & 255u) == 0u) { if (xb_ld(&bar[XB_TMO])) break; if (sp > XB_SPIN_CAP) { atomicAdd(&bar[XB_TMO], 1u); break; } } }
        __builtin_amdgcn_fence(__ATOMIC_ACQUIRE, "agent");
        asm volatile("s_waitcnt vmcnt(0)" ::: "memory");
    }
    __syncthreads();
}
template <bool FIRST> __device__ __forceinline__ void xcd_barrier(const XcdBarrier& b) {
    if (FLAT_BAR) { flat_barrier(b); return; }
    asm volatile("s_waitcnt vmcnt(0)" ::: "memory");
    __syncthreads();
    if (threadIdx.x == 0) {
        unsigned* bar = b.bar;
        asm volatile("" : "+s"(bar));
        __builtin_amdgcn_s_waitcnt(0);
        unsigned nloc = b.st[0], nx = b.st[1];
        if (FIRST) { if (nloc == 0u) { xcd_barrier_complete(bar, b.x, nloc, nx); b.st[0] = nloc; b.st[1] = nx; } }
        const unsigned old = xb_add(&bar[XB_XSUB(b.x)], 1u);
        const unsigned gen = old / nloc;
        if (old + 1u == (gen + 1u) * nloc) {
            __builtin_amdgcn_fence(__ATOMIC_RELEASE, "agent");
            asm volatile("s_waitcnt vmcnt(0)" ::: "memory");
            const unsigned og = xb_add(&bar[XB_TOP], 1u);
            const unsigned tg = og / nx;
            if (og + 1u == (tg + 1u) * nx) {
#pragma unroll
                for (unsigned j = 0; j < 16; ++j) (void)__hip_atomic_fetch_add(&bar[XB_XGEN(j)], 1u, __ATOMIC_RELAXED, __HIP_MEMORY_SCOPE_AGENT);
            }
        }
        XB_SPIN(xb_ld(&bar[XB_XGEN(b.x)]) == gen, bar);
        __builtin_amdgcn_fence(__ATOMIC_ACQUIRE, "agent");
        asm volatile("s_waitcnt vmcnt(0)" ::: "memory");
    }
    __syncthreads();
}

struct Params { const float* in[N_INPUTS]; float* out; unsigned char* ws; float inv_freq[32]; };
static_assert(sizeof(Params) == N_INPUTS * 8 + 16 + 128, "Params has no padding");

struct Ctx {
    const float* const* in; float* out; unsigned char* ws;
    LAS unsigned char* lds;
    int G;
};
#define THREAD_IDS() int tid_ = threadIdx.x; asm volatile("" : "+v"(tid_)); const int tid = tid_, lane = tid & 63, wave = __builtin_amdgcn_readfirstlane(tid >> 6), gw = blockIdx.x * NWAVES + wave, NGW = C.G * NWAVES; (void)tid; (void)lane; (void)wave; (void)gw; (void)NGW
#define WSP(T, off) ((T*)(C.ws + (off)))

__device__ __forceinline__ float rstd_of(const float* ssp, int row) {
    const f32x4 a = *(const f32x4*)(ssp + (size_t)row * 16), b = *(const f32x4*)(ssp + (size_t)row * 16 + 4), c = *(const f32x4*)(ssp + (size_t)row * 16 + 8), d = *(const f32x4*)(ssp + (size_t)row * 16 + 12);
    const float s = (((a[0] + a[1]) + (a[2] + a[3])) + ((b[0] + b[1]) + (b[2] + b[3]))) + (((c[0] + c[1]) + (c[2] + c[3])) + ((d[0] + d[1]) + (d[2] + d[3])));
    return rsqrtf(s * (1.0f / D) + EPS);
}
__device__ __forceinline__ void rstd8(const float* ssp, int row0, int fq, float (&rs)[8]) {
    f32x4 sv[8];
#pragma unroll
    for (int i = 0; i < 8; ++i) sv[i] = *(const f32x4*)(ssp + (size_t)(row0 + (i >> 2) * 128 + (i & 3) * 16) * 16 + 4 * fq);
#pragma unroll
    for (int i = 0; i < 8; ++i) { float s = (sv[i][0] + sv[i][1]) + (sv[i][2] + sv[i][3]); s += __shfl_xor(s, 16); s += __shfl_xor(s, 32); rs[i] = rsqrtf(s * (1.0f / D) + EPS); }
}
#define EPI_IDS() int t_ = threadIdx.x; asm volatile("" : "+v"(t_)); const int wid_ = __builtin_amdgcn_readfirstlane(t_ >> 6), wr = wid_ >> 2, wc = wid_ & 3, fr = t_ & 15, fq = (t_ & 63) >> 4
struct EpiGLU {
    static constexpr bool PERM = true;
    bf16* act; const float* ss;
    __device__ __forceinline__ void operator()(const pg8::f32x4 (&acc)[2][2][4][2], const pg8::Unit& u, int, int, int, int) const {
        EPI_IDS();
        const int row0 = u.pm * 256 + wr * 64 + fr, col0 = u.pn * 128 + wc * 32 + 8 * fq;
        float rs[8]; rstd8(ss, row0, fq, rs);
#pragma unroll
        for (int ai = 0; ai < 2; ++ai)
#pragma unroll
            for (int m = 0; m < 4; ++m) {
                const int row = row0 + ai * 128 + m * 16; const float rstd = rs[ai * 4 + m];
                float o[8];
#pragma unroll
                for (int n = 0; n < 2; ++n)
#pragma unroll
                    for (int j = 0; j < 4; ++j) { const float g = acc[ai][0][m][n][j] * rstd, up = acc[ai][1][m][n][j] * rstd; o[n * 4 + j] = siluf_(g) * up; }
                v4u w; w.x = pg8::cvt_pk_bf16(o[0], o[1]); w.y = pg8::cvt_pk_bf16(o[2], o[3]); w.z = pg8::cvt_pk_bf16(o[4], o[5]); w.w = pg8::cvt_pk_bf16(o[6], o[7]);
                *(v4u*)(act + (size_t)row * DFF + col0) = w;
            }
    }
};
template <bool FINAL, int SCALE2> struct EpiRes {
    static constexpr bool PERM = true;
    float* h; bf16* hb; float* ssout; float* out;
    __device__ __forceinline__ void rowgroup(const pg8::f32x4 (&a)[2][2], int row, int col0, int pn, int wc, int fq) const {
        constexpr float scale = 0.5f * SCALE2; float sq = 0.f;
        long yoff = -1;
        if (FINAL) { if (row < MP) { const int b = row / L, pos = row - b * L; if (pos >= NMETA) yoff = (long)O_YP + ((long)b * SEQ + (pos - NMETA)) * D; } else if (row < MR) yoff = (long)O_YS + (long)(row - MP) * D; }
#pragma unroll
        for (int bj = 0; bj < 2; ++bj) {
            const size_t off = (size_t)row * D + col0 + bj * 128;
            const v4u hw = *(const v4u*)(hb + off);
            f32x4 h0 = (f32x4){bflo(hw.x), bfhi(hw.x), bflo(hw.y), bfhi(hw.y)}, h1 = (f32x4){bflo(hw.z), bfhi(hw.z), bflo(hw.w), bfhi(hw.w)};
            h0 = h0 + a[bj][0] * scale; h1 = h1 + a[bj][1] * scale;
            v4u w; w.x = pg8::cvt_pk_bf16(h0[0], h0[1]); w.y = pg8::cvt_pk_bf16(h0[2], h0[3]); w.z = pg8::cvt_pk_bf16(h1[0], h1[1]); w.w = pg8::cvt_pk_bf16(h1[2], h1[3]);
            *(v4u*)(hb + off) = w;
            sq += (h0[0] * h0[0] + h0[1] * h0[1]) + (h0[2] * h0[2] + h0[3] * h0[3]) + (h1[0] * h1[0] + h1[1] * h1[1]) + (h1[2] * h1[2] + h1[3] * h1[3]);
            if (FINAL && yoff >= 0) { *(f32x4*)(out + yoff + col0 + bj * 128) = h0; *(f32x4*)(out + yoff + col0 + bj * 128 + 4) = h1; }
        }
        sq += __shfl_xor(sq, 16); sq += __shfl_xor(sq, 32);
        if (fq == 0 && ssout) ssout[(size_t)row * 16 + pn * 4 + wc] = sq;
    }
    __device__ __forceinline__ void operator()(const pg8::f32x4 (&acc)[2][2][4][2], const pg8::Unit& u, int, int, int, int) const {
        EPI_IDS();
        const int row0 = u.pm * 256 + wr * 64 + fr, col0 = u.pn * 256 + wc * 32 + 8 * fq;
#pragma unroll
        for (int ai = 0; ai < 2; ++ai)
#pragma unroll
            for (int m = 0; m < 4; ++m) {
                const pg8::f32x4 a[2][2] = {{acc[ai][0][m][0], acc[ai][0][m][1]}, {acc[ai][1][m][0], acc[ai][1][m][1]}};
                rowgroup(a, row0 + ai * 128 + m * 16, col0, u.pn, wc, fq);
                if (m == 3) asm volatile("" ::: "memory");
            }
    }
};
struct EpiZ {
    static constexpr bool PERM = true;
    bf16* zmix; bf16* gates; const float* ss; const float* bias;
    __device__ __forceinline__ void operator()(const pg8::f32x4 (&acc)[2][2][4][2], const pg8::Unit& u, int, int, int, int) const {
        EPI_IDS();
        const int row0 = u.pm * 256 + wr * 64 + fr, col0 = u.pn * 256 + wc * 32 + 8 * fq; const bool isgate = u.pn >= NMIXP / 256;
        f32x4 bv[2][2];
#pragma unroll
        for (int bj = 0; bj < 2; ++bj)
#pragma unroll
            for (int n = 0; n < 2; ++n) bv[bj][n] = *(const f32x4*)(bias + col0 + bj * 128 + 4 * n);
        float rs[8]; rstd8(ss, row0, fq, rs);
#pragma unroll
        for (int ai = 0; ai < 2; ++ai)
#pragma unroll
            for (int m = 0; m < 4; ++m) {
                const int row = row0 + ai * 128 + m * 16; const float rstd = rs[ai * 4 + m];
                if (isgate) {
                    f32x4 g[4];
#pragma unroll
                    for (int bj = 0; bj < 2; ++bj)
#pragma unroll
                        for (int n = 0; n < 2; ++n) { const f32x4 z = acc[ai][bj][m][n] * rstd + bv[bj][n];
#pragma unroll
                            for (int j = 0; j < 4; ++j) g[2 * bj + n][j] = fmaxf(sigmoidf_(z[j]), 9.094947017729282e-13f); }
                    const int d0 = 64 * (u.pn - NMIXP / 256) + 16 * wc + 4 * fq; bf16* gp = gates + (size_t)row * NGATE + d0;
#pragma unroll
                    for (int s = 0; s < 4; ++s) { f32x4 o = g[s];
                        if (s < 3) {
#pragma unroll
                            for (int j = 0; j < 4; ++j) o[j] = g[s][j] * __builtin_amdgcn_rcpf(g[s + 1][j]); }
                        *(unsigned long long*)(gp + s * D) = (unsigned long long)pg8::cvt_pk_bf16(o[0], o[1]) | ((unsigned long long)pg8::cvt_pk_bf16(o[2], o[3]) << 32); }
                } else {
#pragma unroll
                    for (int bj = 0; bj < 2; ++bj) {
                        const f32x4 v0 = acc[ai][bj][m][0] * rstd + bv[bj][0], v1 = acc[ai][bj][m][1] * rstd + bv[bj][1];
                        v4u w; w.x = pg8::cvt_pk_bf16(v0[0], v0[1]); w.y = pg8::cvt_pk_bf16(v0[2], v0[3]); w.z = pg8::cvt_pk_bf16(v1[0], v1[1]); w.w = pg8::cvt_pk_bf16(v1[2], v1[3]);
                        *(v4u*)(zmix + (size_t)row * NMIXP + col0 + bj * 128) = w;
                    }
                }
            }
    }
};
struct EpiPartial {
    static constexpr bool PERM = true;
    float* part;
    __device__ __forceinline__ void operator()(const pg8::f32x4 (&acc)[2][2][4][2], const pg8::Unit& u, int, int, int, int) const {
        int t_ = threadIdx.x; asm volatile("" : "+v"(t_));
        const int slot = blockIdx.x;
        float* p = part + (size_t)slot * 65536 + (size_t)t_ * 4;
#pragma unroll
        for (int ai = 0; ai < 2; ++ai)
#pragma unroll
            for (int bj = 0; bj < 2; ++bj)
#pragma unroll
                for (int m = 0; m < 4; ++m)
#pragma unroll
                    for (int n = 0; n < 2; ++n) *(pg8::f32x4*)(p + (size_t)((((ai * 2 + bj) * 4 + m) * 2 + n) * 2048)) = acc[ai][bj][m][n];
        (void)u;
    }
};
__device__ __forceinline__ void tail_group_sync(unsigned* cnt, unsigned target, unsigned* bar) {
    asm volatile("s_waitcnt vmcnt(0)" ::: "memory");
    __syncthreads();
    if (threadIdx.x == 0) {
        __builtin_amdgcn_fence(__ATOMIC_RELEASE, "agent");
        asm volatile("s_waitcnt vmcnt(0)" ::: "memory");
        (void)xb_add(cnt, 1u);
        XB_SPIN(xb_ld(cnt) < target, bar);
        __builtin_amdgcn_fence(__ATOMIC_ACQUIRE, "agent");
        asm volatile("s_waitcnt vmcnt(0)" ::: "memory");
    }
    __syncthreads();
}
template <int NSPLIT, class Epi> __device__ __forceinline__ void ksp_finalize_local(const float* part, const pg8::StaticOrder& so, int limit, const Epi& E, unsigned* cnt0, unsigned* bar) {
    const int ntail = so.nwg - limit, c = blockIdx.x;
    if (c >= ntail * NSPLIT) return;
    const int tt = c / NSPLIT;
    tail_group_sync(cnt0 + 64 * tt, (unsigned)NSPLIT, bar);
    for (int j = c % NSPLIT; j < 8; j += NSPLIT) {
        const int ai = (j >> 2) & 1, m = j & 3;
        EPI_IDS();
        pg8::f32x4 a[2][2];
#pragma unroll
        for (int bj = 0; bj < 2; ++bj)
#pragma unroll
            for (int n = 0; n < 2; ++n) { pg8::f32x4 s = {0.f, 0.f, 0.f, 0.f};
#pragma unroll
                for (int k = 0; k < NSPLIT; ++k) s = s + *(const pg8::f32x4*)(part + (size_t)(tt * NSPLIT + k) * 65536 + (size_t)((((ai * 2 + bj) * 4 + m) * 2 + n) * 2048) + (size_t)t_ * 4);
                a[bj][n] = s; }
        pg8::Unit u; so.unit_of(limit + tt, u);
        E.rowgroup(a, u.pm * 256 + wr * 64 + fr + ai * 128 + m * 16, u.pn * 256 + wc * 32 + 8 * fq, u.pn, wc, fq);
    }
}
template <int NSPLIT, class Epi> __device__ __forceinline__ void ksp_finalize(const float* part, const pg8::StaticOrder& so, int limit, const Epi& E) {
    const int ntail = so.nwg - limit;
    for (int it = blockIdx.x; it < ntail * 8; it += gridDim.x) {
        const int tt = it >> 3, ai = (it >> 2) & 1, m = it & 3;
        EPI_IDS();
        pg8::f32x4 a[2][2];
#pragma unroll
        for (int bj = 0; bj < 2; ++bj)
#pragma unroll
            for (int n = 0; n < 2; ++n) { pg8::f32x4 s = {0.f, 0.f, 0.f, 0.f};
#pragma unroll
                for (int k = 0; k < NSPLIT; ++k) s = s + *(const pg8::f32x4*)(part + (size_t)(tt * NSPLIT + k) * 65536 + (size_t)((((ai * 2 + bj) * 4 + m) * 2 + n) * 2048) + (size_t)t_ * 4);
                a[bj][n] = s; }
        pg8::Unit u; so.unit_of(limit + tt, u);
        E.rowgroup(a, u.pm * 256 + wr * 64 + fr + ai * 128 + m * 16, u.pn * 256 + wc * 32 + 8 * fq, u.pn, wc, fq);
    }
}

struct EpiMergeR {
    static constexpr bool PERM = true;
    bf16* merged; const bf16* gates;
    __device__ __forceinline__ void mid(pg8::f32x4 (&acc)[2][2][4][2], const pg8::Unit& u, int seg, int) const {
        EPI_IDS();
        const int row0 = u.pm * 256 + wr * 64 + fr, col0 = u.pn * 256 + wc * 32 + 8 * fq;
#pragma unroll
        for (int ai = 0; ai < 2; ++ai) {
            v4u r[4][2];
#pragma unroll
            for (int m = 0; m < 4; ++m)
#pragma unroll
                for (int bj = 0; bj < 2; ++bj) r[m][bj] = *(const v4u*)(gates + (size_t)(row0 + ai * 128 + m * 16) * NGATE + (seg - 1) * D + col0 + bj * 128);
            __builtin_amdgcn_sched_barrier(0);
#pragma unroll
            for (int m = 0; m < 4; ++m)
#pragma unroll
                for (int bj = 0; bj < 2; ++bj) {
                    const v4u q = r[m][bj];
                    pg8::f32x4& a0 = acc[ai][bj][m][0]; pg8::f32x4& a1 = acc[ai][bj][m][1];
                    a0[0] *= bflo(q.x); a0[1] *= bfhi(q.x); a0[2] *= bflo(q.y); a0[3] *= bfhi(q.y); a1[0] *= bflo(q.z); a1[1] *= bfhi(q.z); a1[2] *= bflo(q.w); a1[3] *= bfhi(q.w);
                }
            __builtin_amdgcn_sched_barrier(0);
        }
    }
    __device__ __forceinline__ void operator()(const pg8::f32x4 (&acc)[2][2][4][2], const pg8::Unit& u, int, int, int, int) const {
        EPI_IDS();
        const int row0 = u.pm * 256 + wr * 64 + fr, col0 = u.pn * 256 + wc * 32 + 8 * fq;
#pragma unroll
        for (int ai = 0; ai < 2; ++ai) {
            v4u r[4][2];
#pragma unroll
            for (int m = 0; m < 4; ++m)
#pragma unroll
                for (int bj = 0; bj < 2; ++bj) r[m][bj] = *(const v4u*)(gates + (size_t)(row0 + ai * 128 + m * 16) * NGATE + 3 * D + col0 + bj * 128);
            __builtin_amdgcn_sched_barrier(0);
#pragma unroll
            for (int m = 0; m < 4; ++m) {
                const int row = row0 + ai * 128 + m * 16;
#pragma unroll
                for (int bj = 0; bj < 2; ++bj) {
                    const v4u g = r[m][bj];
                    const pg8::f32x4 a0 = acc[ai][bj][m][0], a1 = acc[ai][bj][m][1];
                    v4u w; w.x = pg8::cvt_pk_bf16(a0[0] * bflo(g.x), a0[1] * bfhi(g.x)); w.y = pg8::cvt_pk_bf16(a0[2] * bflo(g.y), a0[3] * bfhi(g.y));
                    w.z = pg8::cvt_pk_bf16(a1[0] * bflo(g.z), a1[1] * bfhi(g.z)); w.w = pg8::cvt_pk_bf16(a1[2] * bflo(g.w), a1[3] * bfhi(g.w));
                    *(v4u*)(merged + (size_t)row * D + col0 + bj * 128) = w;
                }
            }
            __builtin_amdgcn_sched_barrier(0);
        }
    }
};

__device__ __forceinline__ void merge_finalize_local(const float* part, const pg8::StaticOrder& so, int limit, bf16* merged, const bf16* gates, unsigned* cnt0, unsigned* bar) {
    const int ntail = so.nwg - limit, c = blockIdx.x;
    if (c >= ntail * 4) return;
    const int tt = c >> 2;
    tail_group_sync(cnt0 + 64 * tt, 4u, bar);
    pg8::Unit u; so.unit_of(limit + tt, u);
    for (int j = c & 3; j < 8; j += 4) {
        const int ai = (j >> 2) & 1, m = j & 3;
        EPI_IDS();
        const int row = u.pm * 256 + wr * 64 + fr + ai * 128 + m * 16, col0 = u.pn * 256 + wc * 32 + 8 * fq;
#pragma unroll
        for (int bj = 0; bj < 2; ++bj) {
            pg8::f32x4 a0 = {0.f, 0.f, 0.f, 0.f}, a1 = {0.f, 0.f, 0.f, 0.f};
#pragma unroll
            for (int k = 0; k < 4; ++k) {
                const float* pp = part + (size_t)(tt * 4 + k) * 65536 + (size_t)t_ * 4;
                a0 = a0 + *(const pg8::f32x4*)(pp + (size_t)((((ai * 2 + bj) * 4 + m) * 2 + 0) * 2048)); a1 = a1 + *(const pg8::f32x4*)(pp + (size_t)((((ai * 2 + bj) * 4 + m) * 2 + 1) * 2048));
                const v4u r = *(const v4u*)(gates + (size_t)row * NGATE + k * D + col0 + bj * 128);
                a0[0] *= bflo(r.x); a0[1] *= bfhi(r.x); a0[2] *= bflo(r.y); a0[3] *= bfhi(r.y); a1[0] *= bflo(r.z); a1[1] *= bfhi(r.z); a1[2] *= bflo(r.w); a1[3] *= bfhi(r.w);
            }
            v4u w; w.x = pg8::cvt_pk_bf16(a0[0], a0[1]); w.y = pg8::cvt_pk_bf16(a0[2], a0[3]); w.z = pg8::cvt_pk_bf16(a1[0], a1[1]); w.w = pg8::cvt_pk_bf16(a1[2], a1[3]);
            *(v4u*)(merged + (size_t)row * D + col0 + bj * 128) = w;
        }
    }
}
__host__ __device__ __forceinline__ int gate_col(int m) { const int br = m >> 10, d = m & 1023, dd = d & 63; return 256 * (d >> 6) + 128 * (br >> 1) + 32 * (dd >> 4) + 8 * ((dd >> 2) & 3) + 4 * (br & 1) + (dd & 3); }
__host__ __device__ __forceinline__ int gate_src(int c) { const int ct = c & 255, br = 2 * (ct >> 7) + ((ct >> 2) & 1), d = 64 * (c >> 8) + 16 * ((ct >> 5) & 3) + 4 * ((ct >> 3) & 3) + (ct & 3); return br * 1024 + d; }
struct RowMap { int mode, a; __device__ __forceinline__ int operator()(int n) const { return mode == 0 ? n + a : (mode == 1 ? 256 * (n >> 7) + (n & 127) + a : (n < NMIX ? n : NMIXP + gate_col(n - NMIX))); } };
__device__ __forceinline__ void tr_item(const float* W, int K, int N, const float* gain, bf16* WT, int pitch, RowMap rm, LAS float* scr, int kb, int nb, int lane) {
    const int k0 = 64 * kb, n0 = 64 * nb; const int nn = n0 + 4 * (lane & 15), kr = lane >> 4;
    f32x4 v[16];
#pragma unroll
    for (int i = 0; i < 16; ++i) v[i] = (nn < N) ? *(const f32x4*)(W + (size_t)(k0 + 4 * i + kr) * N + nn) : (f32x4){0.f, 0.f, 0.f, 0.f};
#pragma unroll
    for (int i = 0; i < 16; ++i) { const int kk = 4 * i + kr; const float g = gain ? gain[k0 + kk] : 1.0f; LAS float* d = scr + kk * 65 + 4 * (lane & 15); d[0] = v[i][0] * g; d[1] = v[i][1] * g; d[2] = v[i][2] * g; d[3] = v[i][3] * g; }
    LDS_WAIT(); asm volatile("" ::: "memory");
    const int c = lane & 7;
#pragma unroll
    for (int j = 0; j < 8; ++j) { const int nl = (lane >> 3) + 8 * j; const int n = n0 + nl; const LAS float* s = scr + (8 * c) * 65 + nl;
        v4u o; o.x = pg8::cvt_pk_bf16(s[0 * 65], s[1 * 65]); o.y = pg8::cvt_pk_bf16(s[2 * 65], s[3 * 65]); o.z = pg8::cvt_pk_bf16(s[4 * 65], s[5 * 65]); o.w = pg8::cvt_pk_bf16(s[6 * 65], s[7 * 65]);
        if (n < N) *(v4u*)(WT + (size_t)rm(n) * pitch + k0 + 8 * c) = o; }
    LDS_WAIT(); asm volatile("" ::: "memory");
}
__device__ __forceinline__ void p0_prologue(const Ctx& C, const Params& P) {
    THREAD_IDS();
    LAS float* scr = (LAS float*)(C.lds + RING_OFF + wave * 16896);
    constexpr int I_FF = 16 * 44, I_DN = 44 * 16, I_IN = 16 * 113, I_BR = 4 * 4 * 16, I_OUT = 16 * 16;
    constexpr int PER_LAYER = 4 * I_FF + 2 * I_DN + I_IN + I_BR + I_OUT;
    for (int it = gw; it < DEPTH * PER_LAYER; it += NGW) {
        const int l = it / PER_LAYER; int r = it - l * PER_LAYER;
        bf16* W1a = WSP(bf16, WS_W1 + (size_t)(l * 2 + 0) * SZ_W1); bf16* W1b = WSP(bf16, WS_W1 + (size_t)(l * 2 + 1) * SZ_W1);
        bf16* Wda = WSP(bf16, WS_WD + (size_t)(l * 2 + 0) * SZ_WD); bf16* Wdb = WSP(bf16, WS_WD + (size_t)(l * 2 + 1) * SZ_WD);
        if (r < I_FF) { tr_item(C.in[I_F1G] + (size_t)l * D * DFF, D, DFF, C.in[I_NF1] + l * D, W1a, D, RowMap{1, 0}, scr, r / 44, r % 44, lane); continue; } r -= I_FF;
        if (r < I_FF) { tr_item(C.in[I_F1U] + (size_t)l * D * DFF, D, DFF, C.in[I_NF1] + l * D, W1a, D, RowMap{1, 128}, scr, r / 44, r % 44, lane); continue; } r -= I_FF;
        if (r < I_DN) { tr_item(C.in[I_F1D] + (size_t)l * D * DFF, DFF, D, nullptr, Wda, DFF, RowMap{0, 0}, scr, r / 16, r % 16, lane); continue; } r -= I_DN;
        if (r < I_FF) { tr_item(C.in[I_F2G] + (size_t)l * D * DFF, D, DFF, C.in[I_NF2] + l * D, W1b, D, RowMap{1, 0}, scr, r / 44, r % 44, lane); continue; } r -= I_FF;
        if (r < I_FF) { tr_item(C.in[I_F2U] + (size_t)l * D * DFF, D, DFF, C.in[I_NF2] + l * D, W1b, D, RowMap{1, 128}, scr, r / 44, r % 44, lane); continue; } r -= I_FF;
        if (r < I_DN) { tr_item(C.in[I_F2D] + (size_t)l * D * DFF, DFF, D, nullptr, Wdb, DFF, RowMap{0, 0}, scr, r / 16, r % 16, lane); continue; } r -= I_DN;
        if (r < I_IN) { tr_item(C.in[I_WIN] + (size_t)l * D * NIN, D, NIN, C.in[I_NMIX] + l * D, WSP(bf16, WS_WIN + (size_t)l * SZ_WIN), D, RowMap{2, 0}, scr, r / 113, r % 113, lane); continue; } r -= I_IN;
        if (r < I_BR) { const int n4 = r / 64, rr = r % 64; tr_item(C.in[I_WBR] + (size_t)(l * 4 + n4) * 256 * D, 256, D, nullptr, WSP(bf16, WS_WBR + (size_t)l * SZ_WBR) + n4 * 256, D, RowMap{0, 0}, scr, rr / 16, rr % 16, lane); continue; } r -= I_BR;
        tr_item(C.in[I_WOUT] + (size_t)l * D * D, D, D, nullptr, WSP(bf16, WS_WOUT + (size_t)l * SZ_WOUT), D, RowMap{0, 0}, scr, r / 16, r % 16, lane);
    }
    const int gt = gw * 64 + lane, NGT = NGW * 64;
    for (int i = gt; i < 2 * 240 * 128; i += NGT) { const int l = i / (240 * 128), r = i % (240 * 128); *(v4u*)(C.ws + WS_WIN + (size_t)l * SZ_WIN + ((size_t)NMIX * D) * 2 + (size_t)r * 16) = (v4u){0u, 0u, 0u, 0u}; }
    for (int i = gt; i < (M - MR) * 128; i += NGT) *(v4u*)(C.ws + WS_BR + (size_t)MR * D * 2 + (size_t)i * 16) = (v4u){0u, 0u, 0u, 0u};
    for (int i = gt; i < 2 * NINP; i += NGT) { const int l = i / NINP, j = i % NINP; float v = 0.f; if (j < NMIX) v = C.in[I_BIN][l * NIN + j]; else if (j >= NMIXP) v = C.in[I_BIN][l * NIN + NMIX + gate_src(j - NMIXP)]; WSP(float, WS_BINP)[i] = v; }
    for (int i = gt; i < NPOS * 32; i += NGT) { const int pi = i >> 5, fi = i & 31; const int pos = pi < L ? pi : PAST + (pi - L);
        const float angf = (float)pos * P.inv_freq[fi];
        const double a = (double)angf; const double k = rint(a * 0.15915494309189535); const double rr = (a - k * 6.283185307179586) - k * 2.4492935982947064e-16;
        const float rf = (float)rr; WSP(float, WS_ROPE)[i] = cosf(rf); WSP(float, WS_ROPE)[NPOS * 32 + i] = sinf(rf); }
    float* H = WSP(float, WS_H); bf16* HB = WSP(bf16, WS_HB); float* SS0 = WSP(float, WS_SS);
    for (int row = gw; row < M; row += NGW) {
        const float* src = nullptr;
        if (row < MP) { const int b = row / L, pos = row - b * L; src = pos < NMETA ? C.in[I_META] + (size_t)pos * D : C.in[I_XP] + ((size_t)b * SEQ + (pos - NMETA)) * D; }
        else if (row < MR) src = C.in[I_XS] + (size_t)(row - MP) * D;
        float s = 0.f;
#pragma unroll
        for (int j = 0; j < 4; ++j) { f32x4 v = src ? *(const f32x4*)(src + 256 * j + 4 * lane) : (f32x4){0.f, 0.f, 0.f, 0.f};
            s += (v[0] * v[0] + v[1] * v[1]) + (v[2] * v[2] + v[3] * v[3]);
            unsigned long long w = (unsigned long long)pk2(v[0], v[1]) | ((unsigned long long)pk2(v[2], v[3]) << 32);
            *(unsigned long long*)(HB + (size_t)row * D + 256 * j + 4 * lane) = w; }
        s = wave_sum(s); if (lane < 16) SS0[(size_t)row * 16 + lane] = lane == 0 ? s : 0.f;
    }
}

__device__ __forceinline__ float lam_of(const Ctx& C, int l, float lam_init) {
    THREAD_IDS();
    float a = 0.f, b = 0.f;
#pragma unroll 1
    for (int i = 0; i < 32; ++i) { a += C.in[I_LQ1][l * 32 + i] * C.in[I_LK1][l * 32 + i]; b += C.in[I_LQ2][l * 32 + i] * C.in[I_LK2][l * 32 + i]; }
    return __expf(a) - __expf(b) + lam_init;
}
__device__ __forceinline__ int t5_bucket(int n) {
    if (n < 16) return n;
    return 16 + (n >= 19) + (n >= 21) + (n >= 24) + (n >= 27) + (n >= 31) + (n >= 35) + (n >= 40) + (n >= 46) + (n >= 52) + (n >= 59) + (n >= 67) + (n >= 77) + (n >= 87) + (n >= 99) + (n >= 113);
}
__device__ __forceinline__ void unpack8(const v4u w, float (&x)[8]) { x[0] = bflo(w.x); x[1] = bfhi(w.x); x[2] = bflo(w.y); x[3] = bfhi(w.y); x[4] = bflo(w.z); x[5] = bfhi(w.z); x[6] = bflo(w.w); x[7] = bfhi(w.w); }
__device__ __forceinline__ v4u pack8(const float (&x)[8]) { v4u w; w.x = pg8::cvt_pk_bf16(x[0], x[1]); w.y = pg8::cvt_pk_bf16(x[2], x[3]); w.z = pg8::cvt_pk_bf16(x[4], x[5]); w.w = pg8::cvt_pk_bf16(x[6], x[7]); return w; }
__device__ __forceinline__ void n1_prep(const Ctx& C, int l) {
    THREAD_IDS();
    const bf16* ZM = WSP(bf16, WS_ZMIX); float* UB = WSP(float, WS_UBUF); float* RQ = WSP(float, WS_RQ); float* RK = WSP(float, WS_RK);
    float* LD = WSP(float, WS_LDEC); const float* COS = WSP(float, WS_ROPE); const float* SIN = COS + NPOS * 32; bf16* QNB = WSP(bf16, WS_QNB); bf16* KNB = WSP(bf16, WS_KNB);
    const int i = lane & 31;
    float qg[8], kg[8];
#pragma unroll
    for (int j = 0; j < 8; ++j) { qg[j] = C.in[I_QN][l * 32 + ((8 * i) & 31) + j] * (0.17677669529663687f * 1.4426950408889634f); kg[j] = C.in[I_KN][l * 32 + ((8 * i) & 31) + j]; }
    const int isk = i >> 4, hh = (i >> 2) & 3, jc = i & 3;
    for (int rp0 = gw * 2; rp0 < MR / 2; rp0 += NGW * 2) {
        v4u Wa[2], Wg[2], Wq[2], Wk[2], Wv[2], W1[2], W2[2], G0[2], G1[2];
#pragma unroll
        for (int u = 0; u < 2; ++u) { const int r = min(2 * (rp0 + u) + (lane >> 5), MR - 1); const bf16* z = ZM + (size_t)r * NMIXP; const bf16* zr = z + (isk ? R_K : R_Q) + hh * 64 + 8 * jc;
            Wa[u] = *(const v4u*)(z + C_A + 8 * i); Wg[u] = *(const v4u*)(z + C_G + 8 * i); Wq[u] = *(const v4u*)(z + D_Q + 8 * i); Wk[u] = *(const v4u*)(z + D_K + 8 * i); Wv[u] = *(const v4u*)(z + D_V + 8 * i);
            W1[u] = *(const v4u*)zr; W2[u] = *(const v4u*)(zr + 32); G0[u] = *(const v4u*)(z + G_LOW); G1[u] = *(const v4u*)(z + G_LOW + 8); }
#pragma unroll
        for (int u = 0; u < 2; ++u) {
        if (rp0 + u >= MR / 2) break;
        const int r = 2 * (rp0 + u) + (lane >> 5);
        const int pi = r < MP ? r % L : L + ((r - MP) & 7);
        float* kout = r < MP ? C.out + O_KP + ((size_t)l * MP + r) * 256 : C.out + O_KS + ((size_t)l * MS + (r - MP)) * 256;
        float* vout = r < MP ? C.out + O_VP + ((size_t)l * MP + r) * 256 : C.out + O_VS + ((size_t)l * MS + (r - MP)) * 256;
        const v4u wa = Wa[u], wg = Wg[u], wq = Wq[u], wk = Wk[u], wv = Wv[u], w1 = W1[u], w2 = W2[u], gl0 = G0[u], gl1 = G1[u];
        float x[8], y[8];
        unpack8(wa, x); unpack8(wg, y);
#pragma unroll
        for (int j = 0; j < 8; ++j) x[j] *= sigmoidf_(y[j]);
        *(f32x4*)(UB + (size_t)r * 256 + 8 * i) = (f32x4){x[0], x[1], x[2], x[3]}; *(f32x4*)(UB + (size_t)r * 256 + 8 * i + 4) = (f32x4){x[4], x[5], x[6], x[7]};
        unpack8(wv, x);
        *(f32x4*)(vout + 8 * i) = (f32x4){x[0], x[1], x[2], x[3]}; *(f32x4*)(vout + 8 * i + 4) = (f32x4){x[4], x[5], x[6], x[7]};
        unpack8(wq, x);
        { float s = 0.f;
#pragma unroll
          for (int j = 0; j < 8; ++j) s += x[j] * x[j];
          s += __shfl_xor(s, 1); s += __shfl_xor(s, 2); const float rs = rsqrtf(s * (1.0f / 32) + EPS);
#pragma unroll
          for (int j = 0; j < 8; ++j) x[j] = x[j] * rs * qg[j];
          *(v4u*)(QNB + (size_t)r * 256 + 8 * i) = pack8(x); }
        unpack8(wk, x);
        { float s = 0.f;
#pragma unroll
          for (int j = 0; j < 8; ++j) s += x[j] * x[j];
          s += __shfl_xor(s, 1); s += __shfl_xor(s, 2); const float rs = rsqrtf(s * (1.0f / 32) + EPS);
#pragma unroll
          for (int j = 0; j < 8; ++j) x[j] = x[j] * rs * kg[j];
          *(v4u*)(KNB + (size_t)r * 256 + 8 * i) = pack8(x);
          *(f32x4*)(kout + 8 * i) = (f32x4){x[0], x[1], x[2], x[3]}; *(f32x4*)(kout + 8 * i + 4) = (f32x4){x[4], x[5], x[6], x[7]}; }
        unpack8(w1, x); unpack8(w2, y);
        { const f32x4 c0 = *(const f32x4*)(COS + pi * 32 + 8 * jc), c1 = *(const f32x4*)(COS + pi * 32 + 8 * jc + 4), s0 = *(const f32x4*)(SIN + pi * 32 + 8 * jc), s1 = *(const f32x4*)(SIN + pi * 32 + 8 * jc + 4);
          const float sc = isk ? 0.125f : 1.0f; float o1[8], o2[8];
#pragma unroll
          for (int j = 0; j < 8; ++j) { const float cs = j < 4 ? c0[j & 3] : c1[j & 3], sn = j < 4 ? s0[j & 3] : s1[j & 3]; o1[j] = (x[j] * cs - y[j] * sn) * sc; o2[j] = (x[j] * sn + y[j] * cs) * sc; }
          float* ro = (isk ? RK : RQ) + (size_t)r * 256 + hh * 64 + 8 * jc;
          *(f32x4*)ro = (f32x4){o1[0], o1[1], o1[2], o1[3]}; *(f32x4*)(ro + 4) = (f32x4){o1[4], o1[5], o1[6], o1[7]}; *(f32x4*)(ro + 32) = (f32x4){o2[0], o2[1], o2[2], o2[3]}; *(f32x4*)(ro + 36) = (f32x4){o2[4], o2[5], o2[6], o2[7]}; }
        { float gv[16]; unpack8(gl0, x); unpack8(gl1, y);
#pragma unroll
          for (int j = 0; j < 8; ++j) { gv[j] = x[j]; gv[8 + j] = y[j]; }
          f32x4 gp = *(const f32x4*)(C.in[I_GAB] + l * 128 + 4 * i);
#pragma unroll
          for (int k = 0; k < 16; ++k) { const f32x4 aw = *(const f32x4*)(C.in[I_GAW] + (size_t)(l * 16 + k) * 128 + 4 * i); gp = gp + aw * gv[k]; }
          f32x4 ls;
#pragma unroll
          for (int j = 0; j < 4; ++j) ls[j] = (fminf(gp[j], 0.f) - log1pf(__expf(-fabsf(gp[j])))) * (1.0f / 16.0f);
          *(f32x4*)(LD + (size_t)r * 128 + 4 * i) = ls; }
        }
    }
}
__device__ __forceinline__ void conv_rows_item(const Ctx& C, int l, int item) {
    THREAD_IDS();
    const float* UB = WSP(float, WS_UBUF); bf16* BR = WSP(bf16, WS_BR);
    const float* cw = C.in[I_CW] + (size_t)l * 31 * 256; const float* sc = C.in[I_SCONV];
    LAS float* wl = (LAS float*)C.lds;
    for (int i = tid; i < 31 * 256; i += NWAVES * 64) wl[i] = cw[i];
    LDS_WAIT(); __builtin_amdgcn_s_barrier(); asm volatile("" ::: "memory");
    const int r0 = item * 64 + wave * 8;
    if (r0 < MR) {
        const bool smp = r0 >= MP; const int b = smp ? (r0 - MP) >> 3 : r0 / L; const int p0 = smp ? 0 : r0 - b * L; const int rb = smp ? MP + b * 8 : b * L;
        float acc[8][4];
#pragma unroll
        for (int i = 0; i < 8; ++i)
#pragma unroll
            for (int k = 0; k < 4; ++k) acc[i][k] = C.in[I_CB][l * 256 + lane + 64 * k];
#pragma unroll 1
        for (int jb = 0; jb < 40; jb += 8) {
            float uv[8][4];
#pragma unroll
            for (int jj = 0; jj < 8; ++jj) { const int j = jb + jj; const int q = p0 - 30 + j;
#pragma unroll
                for (int k = 0; k < 4; ++k) { const int c = lane + 64 * k;
                    uv[jj][k] = j >= 38 ? 0.f : (q >= 0 ? UB[(size_t)(rb + q) * 256 + c] : (smp ? sc[(((size_t)l * DB + b) * 30 + (q + 30)) * 256 + c] : 0.f)); } }
#pragma unroll
            for (int jj = 0; jj < 8; ++jj)
#pragma unroll
                for (int i = 0; i < 8; ++i) { const int t = jb + jj - i;
                    if (t >= 0 && t <= 30) {
#pragma unroll
                        for (int k = 0; k < 4; ++k) acc[i][k] += wl[t * 256 + lane + 64 * k] * uv[jj][k]; } }
        }
#pragma unroll
        for (int i = 0; i < 8; ++i) { const int r = r0 + i;
            float s = (acc[i][0] + acc[i][1]) + (acc[i][2] + acc[i][3]); const float mean = wave_sum(s) * (1.0f / 256);
            float q2 = 0.f;
#pragma unroll
            for (int k = 0; k < 4; ++k) { acc[i][k] -= mean; q2 += acc[i][k] * acc[i][k]; }
            const float rstd = rsqrtf(wave_sum(q2) * (1.0f / 256) + EPS);
#pragma unroll
            for (int k = 0; k < 4; ++k) { const int c = lane + 64 * k; const float y = acc[i][k] * rstd * C.in[I_CLG][l * 256 + c] + C.in[I_CLB][l * 256 + c]; BR[(size_t)r * D + c] = (bf16)f2bf(siluf_(y)); } }
    }
    LDS_WAIT(); __builtin_amdgcn_s_barrier(); asm volatile("" ::: "memory");
}
__device__ __forceinline__ void conv_state_item(const Ctx& C, int l, int part, int nparts) {
    THREAD_IDS();
    const float* UB = WSP(float, WS_UBUF); const float* sc = C.in[I_SCONV];
    for (int i = part * NWAVES * 64 + tid; i < BATCH * 30 * 256; i += nparts * NWAVES * 64) { const int c = i & 255, ii = (i >> 8) % 30, b = i / (30 * 256); C.out[O_CP + (size_t)l * BATCH * 30 * 256 + i] = UB[(size_t)(b * L + L - 30 + ii) * 256 + c]; }
    for (int i = part * NWAVES * 64 + tid; i < DB * 30 * 256; i += nparts * NWAVES * 64) { const int c = i & 255, ii = (i >> 8) % 30, b = i / (30 * 256);
        C.out[O_CS + (size_t)l * DB * 30 * 256 + i] = ii < 22 ? sc[(((size_t)l * DB + b) * 30 + 8 + ii) * 256 + c] : UB[(size_t)(MP + b * 8 + ii - 22) * 256 + c]; }
}
template <int DK, bool RET> __device__ __forceinline__ void la_seq(const Ctx& C, int l, bool smp, int b, int h) {
    THREAD_IDS();
    const bf16* ZM = WSP(bf16, WS_ZMIX); const float* RQ = WSP(float, WS_RQ); const float* RK = WSP(float, WS_RK); const float* LD = WSP(float, WS_LDEC); bf16* BR = WSP(bf16, WS_BR);
    const int nt = smp ? DS : L; const int row0 = smp ? MP + b * DS : b * L;
    float S[DK];
    if (smp) { const float* s0 = (RET ? C.in[I_SRET] : C.in[I_SGLA]) + (((size_t)l * DB + b) * 4 + h) * DK * 64;
#pragma unroll
        for (int k = 0; k < DK; ++k) S[k] = s0[k * 64 + lane]; }
    else {
#pragma unroll
        for (int k = 0; k < DK; ++k) S[k] = 0.f; }
    const float gamma = 1.0f - exp2f(-5.0f - (float)h);
    const float gn = RET ? C.in[I_RGN][(l * 4 + h) * 64 + lane] : C.in[I_GGN][(l * 4 + h) * 64 + lane];
    for (int t = 0; t < nt; ++t) {
        const int r = row0 + t; const bf16* z = ZM + (size_t)r * NMIXP;
        float ql, kl, dl = 1.f;
        if (RET) { ql = RQ[(size_t)r * 256 + h * 64 + lane]; kl = RK[(size_t)r * 256 + h * 64 + lane]; }
        else { const int lk = lane & 31; ql = bf2f(z[G_Q + h * 32 + lk]) * 0.17677669529663687f; kl = bf2f(z[G_K + h * 32 + lk]); dl = __expf(LD[(size_t)r * 128 + h * 32 + lk]); }
        const float v = bf2f(z[(RET ? R_V : G_V) + h * 64 + lane]);
        float o = 0.f;
#pragma unroll
        for (int k = 0; k < DK; ++k) { const float qk = __shfl(ql, k), kk = __shfl(kl, k); const float dk = RET ? gamma : __shfl(dl, k);
            S[k] = dk * S[k] + kk * v; o += qk * S[k]; if ((k & 7) == 7) __builtin_amdgcn_sched_barrier(0); }
        float y;
        if (RET) { const float mean = wave_sum(o) * (1.0f / 64); const float d = o - mean; const float var = wave_sum(d * d) * (1.0f / 64); y = d * rsqrtf(var + EPS) * gn; }
        else { const float ms = wave_sum(o * o) * (1.0f / 64); y = o * rsqrtf(ms + EPS) * gn; }
        const float g = bf2f(z[(RET ? R_G : G_R) + h * 64 + lane]);
        BR[(size_t)r * D + (RET ? 256 : 512) + h * 64 + lane] = (bf16)f2bf(siluf_(g) * y);
    }
    float* so = C.out + (RET ? (smp ? O_RS + (((size_t)l * DB + b) * 4 + h) * DK * 64 : O_RP + (((size_t)l * BATCH + b) * 4 + h) * DK * 64)
                             : (smp ? O_GS + (((size_t)l * DB + b) * 4 + h) * DK * 64 : O_GP + (((size_t)l * BATCH + b) * 4 + h) * DK * 64));
#pragma unroll
    for (int k = 0; k < DK; ++k) so[k * 64 + lane] = S[k];
}
typedef short bf16x8_t __attribute__((ext_vector_type(8)));
template <int DK, bool RET> __device__ __forceinline__ void la_chunked(const Ctx& C, int l, bool smp, int b, int h) {
    THREAD_IDS();
    constexpr int QS = DK + 8, TS = 72, NKB = DK / 16, NKS = DK / 32;
    constexpr int SB = 2 * 64 * QS + 64 * TS + DK * TS + 64 * TS + 64;
    LAS bf16* SB0 = (LAS bf16*)(C.lds);
    LAS bf16* AL = SB0 + 2 * SB;
    LAS bf16* ST = AL + 64 * TS;
    const bf16* ZM = WSP(bf16, WS_ZMIX); const float* RQ = WSP(float, WS_RQ); const float* RK = WSP(float, WS_RK); const float* LD = WSP(float, WS_LDEC); bf16* BR = WSP(bf16, WS_BR);
    const int nt = smp ? DS : L, row0 = smp ? MP + b * DS : b * L, nch = (nt + 63) >> 6;
    const float lg2 = RET ? log2f(1.0f - exp2f(-5.0f - (float)h)) : 0.f;
    const int g4 = lane >> 4, c16 = lane & 15;
    const bool qwave = wave < 4; const int w4 = wave & 3;
    float Sreg[NKB][4];
    if (wave >= 4) {
        const float* s0 = (RET ? C.in[I_SRET] : C.in[I_SGLA]) + (((size_t)l * DB + b) * 4 + h) * DK * 64;
#pragma unroll
        for (int cb = 0; cb < NKB; ++cb)
#pragma unroll
            for (int r = 0; r < 4; ++r) { const int dk = cb * 16 + c16, dv = (wave - 4) * 16 + 4 * g4 + r; const float v = smp ? s0[dk * 64 + dv] : 0.f; Sreg[cb][r] = v; ST[dv * QS + dk] = (bf16)f2bf(v); }
    }
    float gnv[4];
#pragma unroll
    for (int cb = 0; cb < 4; ++cb) gnv[cb] = (RET ? C.in[I_RGN] : C.in[I_GGN])[(l * 4 + h) * 64 + cb * 16 + c16];
    float a[16]; v4u vr;
#define LA_LOAD(c) do { const size_t r_ = (size_t)(row0 + (c) * 64 + lane); const bf16* z_ = ZM + r_ * NMIXP; \
        vr = *(const v4u*)(z_ + (RET ? R_V : G_V) + h * 64 + 8 * wave); \
        if (RET) { const float* p_ = (qwave ? RQ : RK) + r_ * 256 + h * 64 + 8 * w4; const f32x4 x0 = *(const f32x4*)p_, x1 = *(const f32x4*)(p_ + 4), x2 = *(const f32x4*)(p_ + 32), x3 = *(const f32x4*)(p_ + 36); \
            a[0] = x0[0]; a[1] = x0[1]; a[2] = x0[2]; a[3] = x0[3]; a[4] = x1[0]; a[5] = x1[1]; a[6] = x1[2]; a[7] = x1[3]; a[8] = x2[0]; a[9] = x2[1]; a[10] = x2[2]; a[11] = x2[3]; a[12] = x3[0]; a[13] = x3[1]; a[14] = x3[2]; a[15] = x3[3]; } \
        else { const v4u q_ = *(const v4u*)(z_ + (qwave ? G_Q : G_K) + h * 32 + 8 * w4); const float* p_ = LD + r_ * 128 + h * 32 + 8 * w4; const f32x4 x0 = *(const f32x4*)p_, x1 = *(const f32x4*)(p_ + 4); \
            a[0] = bflo(q_.x); a[1] = bfhi(q_.x); a[2] = bflo(q_.y); a[3] = bfhi(q_.y); a[4] = bflo(q_.z); a[5] = bfhi(q_.z); a[6] = bflo(q_.w); a[7] = bfhi(q_.w); \
            a[8] = x0[0]; a[9] = x0[1]; a[10] = x0[2]; a[11] = x0[3]; a[12] = x1[0]; a[13] = x1[1]; a[14] = x1[2]; a[15] = x1[3]; } } while (0)
    LA_LOAD(0);
    int cur = 0;
    for (int i = 0; i <= nch; ++i) {
        if (i < nch) {
            const int c = i; LAS bf16* QT = SB0 + (i & 1) * SB; LAS bf16* KT = QT + 64 * QS; LAS bf16* VT = KT + 64 * QS; LAS bf16* KE = VT + 64 * TS; LAS bf16* GT = KE + DK * TS; LAS float* WT = (LAS float*)(GT + 64 * TS);
            const int nvc = min(64, nt - c * 64); const bool valid = lane < nvc;
        if (RET) {
            const float tq = (float)(lane + 1);
            if (qwave) { const float e = valid ? __builtin_amdgcn_exp2f(lg2 * tq) : 0.f;
                v4u w0, w1; w0.x = pg8::cvt_pk_bf16(a[0] * e, a[1] * e); w0.y = pg8::cvt_pk_bf16(a[2] * e, a[3] * e); w0.z = pg8::cvt_pk_bf16(a[4] * e, a[5] * e); w0.w = pg8::cvt_pk_bf16(a[6] * e, a[7] * e);
                w1.x = pg8::cvt_pk_bf16(a[8] * e, a[9] * e); w1.y = pg8::cvt_pk_bf16(a[10] * e, a[11] * e); w1.z = pg8::cvt_pk_bf16(a[12] * e, a[13] * e); w1.w = pg8::cvt_pk_bf16(a[14] * e, a[15] * e);
                *(LAS v4u*)(QT + lane * QS + 8 * w4) = w0; *(LAS v4u*)(QT + lane * QS + 32 + 8 * w4) = w1; }
            else { const float e = valid ? __builtin_amdgcn_exp2f(-lg2 * tq) : 0.f, ee = valid ? __builtin_amdgcn_exp2f(lg2 * ((float)nvc - tq)) : 0.f;
                v4u w0, w1; w0.x = pg8::cvt_pk_bf16(a[0] * e, a[1] * e); w0.y = pg8::cvt_pk_bf16(a[2] * e, a[3] * e); w0.z = pg8::cvt_pk_bf16(a[4] * e, a[5] * e); w0.w = pg8::cvt_pk_bf16(a[6] * e, a[7] * e);
                w1.x = pg8::cvt_pk_bf16(a[8] * e, a[9] * e); w1.y = pg8::cvt_pk_bf16(a[10] * e, a[11] * e); w1.z = pg8::cvt_pk_bf16(a[12] * e, a[13] * e); w1.w = pg8::cvt_pk_bf16(a[14] * e, a[15] * e);
                *(LAS v4u*)(KT + lane * QS + 8 * w4) = w0; *(LAS v4u*)(KT + lane * QS + 32 + 8 * w4) = w1;
#pragma unroll
                for (int i = 0; i < 16; i += 2) { const unsigned mine = pg8::cvt_pk_bf16(a[i] * ee, a[i + 1] * ee); const unsigned pv = (unsigned)__shfl_xor((int)mine, 1);
                    const unsigned w = (lane & 1) ? ((pv >> 16) | (mine & 0xffff0000u)) : ((mine & 0xffffu) | (pv << 16));
                    const int row = (i < 8 ? 8 * w4 + i : 32 + 8 * w4 + (i - 8)) + (lane & 1);
                    *(LAS unsigned*)(KE + row * TS + (lane & ~1)) = w; } }
        } else {
            float bb[8];
#pragma unroll
            for (int i = 0; i < 8; ++i) bb[i] = valid ? a[8 + i] : 0.f;
#pragma unroll
            for (int i = 0; i < 8; ++i) { float x = bb[i];
                x += __builtin_bit_cast(float, __builtin_amdgcn_mov_dpp(__builtin_bit_cast(int, x), 0x111, 0xf, 0xf, true));
                x += __builtin_bit_cast(float, __builtin_amdgcn_mov_dpp(__builtin_bit_cast(int, x), 0x112, 0xf, 0xf, true));
                x += __builtin_bit_cast(float, __builtin_amdgcn_mov_dpp(__builtin_bit_cast(int, x), 0x114, 0xf, 0xf, true));
                x += __builtin_bit_cast(float, __builtin_amdgcn_mov_dpp(__builtin_bit_cast(int, x), 0x118, 0xf, 0xf, true));
                const float t0 = __builtin_bit_cast(float, __builtin_amdgcn_readlane(__builtin_bit_cast(int, x), 15)), t1 = __builtin_bit_cast(float, __builtin_amdgcn_readlane(__builtin_bit_cast(int, x), 31)), t2 = __builtin_bit_cast(float, __builtin_amdgcn_readlane(__builtin_bit_cast(int, x), 47));
                bb[i] = x + (lane >= 16 ? t0 : 0.f) + (lane >= 32 ? t1 : 0.f) + (lane >= 48 ? t2 : 0.f); }
            if (qwave) {
                if (lane == 63) {
#pragma unroll
                    for (int i = 0; i < 8; ++i) WT[8 * w4 + i] = bb[i]; }
                float o8[8];
#pragma unroll
                for (int i = 0; i < 8; ++i) o8[i] = valid ? a[i] * 0.17677669529663687f * __expf(bb[i]) : 0.f;
                v4u w0; w0.x = pg8::cvt_pk_bf16(o8[0], o8[1]); w0.y = pg8::cvt_pk_bf16(o8[2], o8[3]); w0.z = pg8::cvt_pk_bf16(o8[4], o8[5]); w0.w = pg8::cvt_pk_bf16(o8[6], o8[7]);
                *(LAS v4u*)(QT + lane * QS + 8 * w4) = w0;
            } else {
                float o8[8];
#pragma unroll
                for (int i = 0; i < 8; ++i) o8[i] = valid ? a[i] * __expf(-bb[i]) : 0.f;
#pragma unroll
                for (int i = 0; i < 8; i += 2) { const float t0 = __shfl(bb[i], 63), t1 = __shfl(bb[i + 1], 63);
                    const unsigned mine = pg8::cvt_pk_bf16(valid ? a[i] * __expf(t0 - bb[i]) : 0.f, valid ? a[i + 1] * __expf(t1 - bb[i + 1]) : 0.f); const unsigned pv = (unsigned)__shfl_xor((int)mine, 1);
                    const unsigned w = (lane & 1) ? ((pv >> 16) | (mine & 0xffff0000u)) : ((mine & 0xffffu) | (pv << 16));
                    *(LAS unsigned*)(KE + (8 * w4 + i + (lane & 1)) * TS + (lane & ~1)) = w; }
                v4u w0; w0.x = pg8::cvt_pk_bf16(o8[0], o8[1]); w0.y = pg8::cvt_pk_bf16(o8[2], o8[3]); w0.z = pg8::cvt_pk_bf16(o8[4], o8[5]); w0.w = pg8::cvt_pk_bf16(o8[6], o8[7]);
                *(LAS v4u*)(KT + lane * QS + 8 * w4) = w0;
            }
        }
        { const unsigned vv[4] = {valid ? vr.x : 0u, valid ? vr.y : 0u, valid ? vr.z : 0u, valid ? vr.w : 0u};
#pragma unroll
          for (int i = 0; i < 4; ++i) { const unsigned pv = (unsigned)__shfl_xor((int)vv[i], 1);
              const unsigned w = (lane & 1) ? ((pv >> 16) | (vv[i] & 0xffff0000u)) : ((vv[i] & 0xffffu) | (pv << 16));
              *(LAS unsigned*)(VT + (8 * wave + 2 * i + (lane & 1)) * TS + (lane & ~1)) = w; } }
            if (c + 1 < nch) LA_LOAD(c + 1);
        }
        if (i >= 1) {
            LAS bf16* QT = SB0 + ((i - 1) & 1) * SB; LAS bf16* KT = QT + 64 * QS;
        { const int rb = wave >> 1;
#pragma unroll
          for (int ci = 0; ci < 2; ++ci) { const int cb = (wave & 1) * 2 + ci; f32x4 acc = {0.f, 0.f, 0.f, 0.f};
              if (cb <= rb) {
#pragma unroll
                  for (int ks = 0; ks < NKS; ++ks) { const bf16x8_t af = *(const LAS bf16x8_t*)(QT + (rb * 16 + c16) * QS + ks * 32 + 8 * g4), bf = *(const LAS bf16x8_t*)(KT + (cb * 16 + c16) * QS + ks * 32 + 8 * g4);
                      acc = __builtin_amdgcn_mfma_f32_16x16x32_bf16(af, bf, acc, 0, 0, 0); } }
#pragma unroll
              for (int r = 0; r < 4; ++r) { const int tt = rb * 16 + 4 * g4 + r, ss = cb * 16 + c16; AL[tt * TS + ss] = (bf16)f2bf(ss <= tt ? acc[r] : 0.f); } } }
        }
        LDS_WAIT(); __builtin_amdgcn_s_barrier(); asm volatile("" ::: "memory");
        if (i >= 1) {
            const int c = i - 1; LAS bf16* QT = SB0 + (c & 1) * SB; LAS bf16* KT = QT + 64 * QS; LAS bf16* VT = KT + 64 * QS; LAS bf16* KE = VT + 64 * TS; LAS bf16* GT = KE + DK * TS; LAS float* WT = (LAS float*)(GT + 64 * TS);
            const int nvc = min(64, nt - c * 64); (void)KT;
        if (wave < 4) {
            const int rb = wave; const LAS bf16* STc = ST + cur * 64 * QS;
            f32x4 o[4];
#pragma unroll
            for (int cb = 0; cb < 4; ++cb) o[cb] = (f32x4){0.f, 0.f, 0.f, 0.f};
#pragma unroll
            for (int ks = 0; ks < 2; ++ks) { const bf16x8_t af = *(const LAS bf16x8_t*)(AL + (rb * 16 + c16) * TS + ks * 32 + 8 * g4);
#pragma unroll
                for (int cb = 0; cb < 4; ++cb) { const bf16x8_t bf = *(const LAS bf16x8_t*)(VT + (cb * 16 + c16) * TS + ks * 32 + 8 * g4); o[cb] = __builtin_amdgcn_mfma_f32_16x16x32_bf16(af, bf, o[cb], 0, 0, 0); } }
#pragma unroll
            for (int ks = 0; ks < NKS; ++ks) { const bf16x8_t af = *(const LAS bf16x8_t*)(QT + (rb * 16 + c16) * QS + ks * 32 + 8 * g4);
#pragma unroll
                for (int cb = 0; cb < 4; ++cb) { const bf16x8_t bf = *(const LAS bf16x8_t*)(STc + (cb * 16 + c16) * QS + ks * 32 + 8 * g4); o[cb] = __builtin_amdgcn_mfma_f32_16x16x32_bf16(af, bf, o[cb], 0, 0, 0); } }
            { float* LAO = WSP(float, WS_LAO);
#pragma unroll
              for (int r = 0; r < 4; ++r) { const int tok = c * 64 + rb * 16 + 4 * g4 + r;
                  if (tok < nt) { float* op = LAO + (size_t)(row0 + tok) * 512 + (RET ? 0 : 256) + h * 64 + c16;
#pragma unroll
                      for (int cb = 0; cb < 4; ++cb) op[cb * 16] = o[cb][r]; } } }
        } else {
            const int dvb = wave - 4; LAS bf16* STn = ST + (cur ^ 1) * 64 * QS;
            f32x4 ds[NKB];
#pragma unroll
            for (int cb = 0; cb < NKB; ++cb) ds[cb] = (f32x4){0.f, 0.f, 0.f, 0.f};
#pragma unroll
            for (int ks = 0; ks < 2; ++ks) { const bf16x8_t af = *(const LAS bf16x8_t*)(VT + (dvb * 16 + c16) * TS + ks * 32 + 8 * g4);
#pragma unroll
                for (int cb = 0; cb < NKB; ++cb) { const bf16x8_t bf = *(const LAS bf16x8_t*)(KE + (cb * 16 + c16) * TS + ks * 32 + 8 * g4); ds[cb] = __builtin_amdgcn_mfma_f32_16x16x32_bf16(af, bf, ds[cb], 0, 0, 0); } }
#pragma unroll
            for (int cb = 0; cb < NKB; ++cb) { const float eB = RET ? __builtin_amdgcn_exp2f(lg2 * (float)nvc) : __expf(WT[cb * 16 + c16]);
#pragma unroll
                for (int r = 0; r < 4; ++r) { Sreg[cb][r] = eB * Sreg[cb][r] + ds[cb][r]; STn[(dvb * 16 + 4 * g4 + r) * QS + cb * 16 + c16] = (bf16)f2bf(Sreg[cb][r]); } }
        }
            cur ^= 1;
        }
        LDS_WAIT(); __builtin_amdgcn_s_barrier(); asm volatile("" ::: "memory");
    }
#undef LA_LOAD
    if (wave >= 4) {
        float* so = C.out + (RET ? (smp ? O_RS + (((size_t)l * DB + b) * 4 + h) * DK * 64 : O_RP + (((size_t)l * BATCH + b) * 4 + h) * DK * 64)
                                 : (smp ? O_GS + (((size_t)l * DB + b) * 4 + h) * DK * 64 : O_GP + (((size_t)l * BATCH + b) * 4 + h) * DK * 64));
#pragma unroll
        for (int cb = 0; cb < NKB; ++cb)
#pragma unroll
            for (int r = 0; r < 4; ++r) so[(cb * 16 + c16) * 64 + (wave - 4) * 16 + 4 * g4 + r] = Sreg[cb][r];
    }
}
typedef float f32x16_t __attribute__((ext_vector_type(16)));
__device__ __forceinline__ int crow_(int r, int hi) { return (r & 3) + 8 * (r >> 2) + 4 * hi; }
__device__ __forceinline__ float swapmax32(float m) { auto rr = __builtin_amdgcn_permlane32_swap(__float_as_uint(m), __float_as_uint(m), false, false); return fmaxf(__uint_as_float(rr[0]), __uint_as_float(rr[1])); }
__device__ __forceinline__ float swapadd32(float m) { auto rr = __builtin_amdgcn_permlane32_swap(__float_as_uint(m), __float_as_uint(m), false, false); return __uint_as_float(rr[0]) + __uint_as_float(rr[1]); }
constexpr float LOG2E = 1.4426950408889634f;
__device__ __forceinline__ void attn_prompt_item(const Ctx& C, int l, int b, int h, int qb, float lam, float lam_init, float mb) {
    THREAD_IDS();
    constexpr int KS = 72;
    LAS bf16* Kt = (LAS bf16*)C.lds;
    LAS bf16* Vt = Kt + 2 * 64 * KS;
    LAS float* BT = (LAS float*)(Vt + 2 * 64 * KS);
    LAS float* OX = BT + 128;
    const bf16* ZM = WSP(bf16, WS_ZMIX); const bf16* QNB = WSP(bf16, WS_QNB); const bf16* KNB = WSP(bf16, WS_KNB); bf16* BR = WSP(bf16, WS_BR);
    const int r32 = lane & 31, hi = lane >> 5, qs = wave >> 1, s = wave & 1;
    const int q0 = qb * 128 + qs * 32; const int rowb = b * L;
    if (tid < 128) BT[tid] = (C.in[I_RELB][t5_bucket(tid) * 4 + h] - C.in[I_RELB][31 * 4 + h]) * LOG2E;
    pg8::bf16x8 qf[2];
#pragma unroll
    for (int d0 = 0; d0 < 2; ++d0) qf[d0] = *(const pg8::bf16x8*)(QNB + (size_t)(rowb + q0 + r32) * 256 + h * 64 + s * 32 + 16 * d0 + 8 * hi);
    const int pl = (lane & ~15) | ((lane & 8) >> 1) | ((lane & 4) << 1) | (lane & 3);
    const int NT = (min(128 * (qb + 1), L) + 63) >> 6;
    v4u kreg, vreg;
#define AT_LOAD(j) do { const size_t r_ = (size_t)(rowb + (j) * 64 + lane); kreg = *(const v4u*)(KNB + r_ * 256 + h * 64 + 8 * wave); vreg = *(const v4u*)(ZM + r_ * NMIXP + D_V + h * 64 + 8 * wave); } while (0)
#define AT_STORE(buf) do { *(LAS v4u*)(Kt + (buf) * 64 * KS + lane * KS + 8 * wave) = kreg; LAS bf16* v_ = Vt + (buf) * 64 * KS + (8 * wave) * KS + pl; \
        v_[0] = (bf16)(vreg.x & 0xffffu); v_[KS] = (bf16)(vreg.x >> 16); v_[2 * KS] = (bf16)(vreg.y & 0xffffu); v_[3 * KS] = (bf16)(vreg.y >> 16); \
        v_[4 * KS] = (bf16)(vreg.z & 0xffffu); v_[5 * KS] = (bf16)(vreg.z >> 16); v_[6 * KS] = (bf16)(vreg.w & 0xffffu); v_[7 * KS] = (bf16)(vreg.w >> 16); } while (0)
    AT_LOAD(0); AT_STORE(0); if (NT > 1) AT_LOAD(1);
    LDS_WAIT(); __builtin_amdgcn_s_barrier(); asm volatile("" ::: "memory");
    float lsum = 0.f; f32x16_t o[2]; f32x16_t negm;
#pragma unroll
    for (int i = 0; i < 16; ++i) negm[i] = -mb;
#pragma unroll
    for (int i = 0; i < 16; ++i) { o[0][i] = 0.f; o[1][i] = 0.f; }
    for (int j = 0; j < NT; ++j) {
        const int k0 = 64 * j, buf = j & 1;
        if (k0 <= q0 + 31) {
            const LAS bf16* kb = Kt + buf * 64 * KS; const LAS bf16* vb = Vt + buf * 64 * KS;
            f32x16_t p0 = negm, p1 = negm;
#pragma unroll
            for (int d0 = 0; d0 < 2; ++d0) { const pg8::bf16x8 a0 = *(const LAS pg8::bf16x8*)(kb + r32 * KS + s * 32 + 16 * d0 + 8 * hi), a1 = *(const LAS pg8::bf16x8*)(kb + (32 + r32) * KS + s * 32 + 16 * d0 + 8 * hi);
                p0 = __builtin_amdgcn_mfma_f32_32x32x16_bf16(a0, qf[d0], p0, 0, 0, 0); p1 = __builtin_amdgcn_mfma_f32_32x32x16_bf16(a1, qf[d0], p1, 0, 0, 0); }
            if (q0 - k0 - 63 < 113) {
#pragma unroll
                for (int r = 0; r < 16; ++r) { const int n0 = (q0 + r32) - (k0 + crow_(r, hi)), n1 = n0 - 32;
                    p0[r] = n0 < 0 ? -INFINITY : p0[r] + (n0 < 128 ? BT[n0] : 0.f); p1[r] = n1 < 0 ? -INFINITY : p1[r] + (n1 < 128 ? BT[n1] : 0.f); } }
            typedef float f32x2_t __attribute__((ext_vector_type(2)));
            f32x2_t ps2 = {0.f, 0.f};
#pragma unroll
            for (int r = 0; r < 16; r += 2) { p0[r] = __builtin_amdgcn_exp2f(p0[r]); p0[r + 1] = __builtin_amdgcn_exp2f(p0[r + 1]); p1[r] = __builtin_amdgcn_exp2f(p1[r]); p1[r + 1] = __builtin_amdgcn_exp2f(p1[r + 1]);
                ps2 = ps2 + (f32x2_t){p0[r], p0[r + 1]}; ps2 = ps2 + (f32x2_t){p1[r], p1[r + 1]}; }
            lsum += ps2[0] + ps2[1];
            pg8::bf16x8 pb[4];
#pragma unroll
            for (int ks = 0; ks < 4; ++ks) { v4u w;
                if (ks < 2) { w.x = pg8::cvt_pk_bf16(p0[8 * ks], p0[8 * ks + 1]); w.y = pg8::cvt_pk_bf16(p0[8 * ks + 2], p0[8 * ks + 3]); w.z = pg8::cvt_pk_bf16(p0[8 * ks + 4], p0[8 * ks + 5]); w.w = pg8::cvt_pk_bf16(p0[8 * ks + 6], p0[8 * ks + 7]); }
                else { w.x = pg8::cvt_pk_bf16(p1[8 * ks - 16], p1[8 * ks - 15]); w.y = pg8::cvt_pk_bf16(p1[8 * ks - 14], p1[8 * ks - 13]); w.z = pg8::cvt_pk_bf16(p1[8 * ks - 12], p1[8 * ks - 11]); w.w = pg8::cvt_pk_bf16(p1[8 * ks - 10], p1[8 * ks - 9]); }
                pb[ks] = __builtin_bit_cast(pg8::bf16x8, w); }
#pragma unroll
            for (int d0 = 0; d0 < 2; ++d0)
#pragma unroll
                for (int ks = 0; ks < 4; ++ks) { const pg8::bf16x8 af = *(const LAS pg8::bf16x8*)(vb + (32 * d0 + r32) * KS + 16 * ks + 8 * hi); o[d0] = __builtin_amdgcn_mfma_f32_32x32x16_bf16(af, pb[ks], o[d0], 0, 0, 0); }
        }
        if (j + 1 < NT) AT_STORE(buf ^ 1);
        if (j + 2 < NT) AT_LOAD(j + 2);
        LDS_WAIT(); __builtin_amdgcn_s_barrier(); asm volatile("" ::: "memory");
    }
#undef AT_LOAD
#undef AT_STORE
    lsum = swapadd32(lsum); const float inv = 1.0f / lsum;
    LAS float* ox = OX + (qs * 32 + r32) * 65;
    if (s == 1) {
#pragma unroll
        for (int d0 = 0; d0 < 2; ++d0)
#pragma unroll
            for (int r = 0; r < 16; ++r) ox[32 * d0 + crow_(r, hi)] = o[d0][r] * inv; }
    LDS_WAIT(); __builtin_amdgcn_s_barrier(); asm volatile("" ::: "memory");
    if (s == 0) {
        float ss = 0.f;
#pragma unroll
        for (int d0 = 0; d0 < 2; ++d0)
#pragma unroll
            for (int r = 0; r < 16; ++r) { const float v = o[d0][r] * inv - lam * ox[32 * d0 + crow_(r, hi)]; o[d0][r] = v; ss += v * v; }
        ss = swapadd32(ss); const float rs = rsqrtf(ss * (1.0f / 64) + EPS) * (1.0f - lam_init);
        const int qpos = q0 + r32;
        if (qpos < L) { bf16* brp = BR + (size_t)(rowb + qpos) * D + 768 + h * 64;
#pragma unroll
            for (int d0 = 0; d0 < 2; ++d0)
#pragma unroll
                for (int r4 = 0; r4 < 4; ++r4) { const int dv = 32 * d0 + 8 * r4 + 4 * hi; const float* sl = C.in[I_SUBLN] + l * 64 + dv;
                    const unsigned w0 = pk2(o[d0][4 * r4] * rs * sl[0], o[d0][4 * r4 + 1] * rs * sl[1]), w1 = pk2(o[d0][4 * r4 + 2] * rs * sl[2], o[d0][4 * r4 + 3] * rs * sl[3]);
                    *(unsigned long long*)(brp + dv) = (unsigned long long)w0 | ((unsigned long long)w1 << 32); } }
    }
    LDS_WAIT(); __builtin_amdgcn_s_barrier(); asm volatile("" ::: "memory");
}
constexpr int PSTR = 68;
__device__ __forceinline__ pg8::bf16x8 cvt8(const f32x4 a, const f32x4 b) { v4u w; w.x = pg8::cvt_pk_bf16(a[0], a[1]); w.y = pg8::cvt_pk_bf16(a[2], a[3]); w.z = pg8::cvt_pk_bf16(b[0], b[1]); w.w = pg8::cvt_pk_bf16(b[2], b[3]); return __builtin_bit_cast(pg8::bf16x8, w); }
__device__ __forceinline__ void attn_sample_item(const Ctx& C, int l, int b, int split) {
    THREAD_IDS();
    const int h = wave & 3, half = wave >> 2, c16 = lane & 15, g = lane >> 4, srow = c16 >> 3, t = c16 & 7;
    const bf16* QNB = WSP(bf16, WS_QNB); const int* PT = (const int*)C.in[I_PT];
    const float* CK = C.in[I_CK] + (size_t)l * NPOOL * PAGE * 256; const float* CV = C.in[I_CV] + (size_t)l * NPOOL * PAGE * 256;
    LAS float* BT = (LAS float*)C.lds;
    BT[tid] = (C.in[I_RELB][t5_bucket(tid & 127) * 4 + (tid >> 7)] - C.in[I_RELB][31 * 4 + (tid >> 7)]) * LOG2E;
    const v4u z4 = {0u, 0u, 0u, 0u};
    const v4u q0w = srow == 0 ? *(const v4u*)(QNB + (size_t)(MP + b * 8 + t) * 256 + h * 64 + 8 * g) : z4, q1w = srow == 1 ? *(const v4u*)(QNB + (size_t)(MP + b * 8 + t) * 256 + h * 64 + 32 + 8 * g) : z4;
    const pg8::bf16x8 qf0 = __builtin_bit_cast(pg8::bf16x8, q0w), qf1 = __builtin_bit_cast(pg8::bf16x8, q1w);
    LDS_WAIT(); __builtin_amdgcn_s_barrier(); asm volatile("" ::: "memory");
    float m = -INFINITY, lsum = 0.f; f32x4 o[4];
#pragma unroll
    for (int db = 0; db < 4; ++db) o[db] = (f32x4){0.f, 0.f, 0.f, 0.f};
    const int kk0 = split * 1024 + half * 512;
    const int pg0 = __builtin_amdgcn_readfirstlane(PT[b * NPAGES + (kk0 >> 7)]), pg1 = __builtin_amdgcn_readfirstlane(PT[b * NPAGES + (kk0 >> 7) + 1]), pg2 = __builtin_amdgcn_readfirstlane(PT[b * NPAGES + (kk0 >> 7) + 2]), pg3 = __builtin_amdgcn_readfirstlane(PT[b * NPAGES + (kk0 >> 7) + 3]);
#define SA_LOAD(KR, VR, st) do { const int kk_ = kk0 + 32 * (st); const int pi_ = (st) >> 2; const int page_ = pi_ == 0 ? pg0 : pi_ == 1 ? pg1 : pi_ == 2 ? pg2 : pg3; const size_t base_ = ((size_t)(page_ * PAGE + (kk_ & 127)) * 4 + h) * 64; \
        _Pragma("unroll") for (int T = 0; T < 2; ++T) _Pragma("unroll") for (int ks = 0; ks < 2; ++ks) { const float* p = CK + base_ + (size_t)(16 * T + c16) * 256 + 32 * ks + 8 * g; KR[T][ks][0] = *(const f32x4*)p; KR[T][ks][1] = *(const f32x4*)(p + 4); } \
        _Pragma("unroll") for (int db = 0; db < 4; ++db) _Pragma("unroll") for (int j = 0; j < 8; ++j) { const int kv = j < 4 ? 4 * g + j : 16 + 4 * g + (j - 4); VR[db][j] = CV[base_ + (size_t)kv * 256 + 16 * db + c16]; } } while (0)
#define SA_MATH(KR, VR, st) do { const int kk = kk0 + 32 * (st); f32x4 sv[2]; \
        _Pragma("unroll") for (int T = 0; T < 2; ++T) { sv[T] = (f32x4){0.f, 0.f, 0.f, 0.f}; \
            sv[T] = __builtin_amdgcn_mfma_f32_16x16x32_bf16(cvt8(KR[T][0][0], KR[T][0][1]), qf0, sv[T], 0, 0, 0); \
            sv[T] = __builtin_amdgcn_mfma_f32_16x16x32_bf16(cvt8(KR[T][1][0], KR[T][1][1]), qf1, sv[T], 0, 0, 0); } \
        if (kk + 31 + 128 > PAST) { \
            _Pragma("unroll") for (int T = 0; T < 2; ++T) _Pragma("unroll") for (int r = 0; r < 4; ++r) { const int n = PAST + t - (kk + 16 * T + 4 * g + r); if (n < 128) sv[T][r] += BT[h * 128 + n]; } } \
        float mt = fmaxf(fmaxf(fmaxf(sv[0][0], sv[0][1]), fmaxf(sv[0][2], sv[0][3])), fmaxf(fmaxf(sv[1][0], sv[1][1]), fmaxf(sv[1][2], sv[1][3]))); \
        mt = fmaxf(mt, __shfl_xor(mt, 16)); mt = fmaxf(mt, __shfl_xor(mt, 32)); \
        const float mn = fmaxf(m, mt); const float al = __builtin_amdgcn_exp2f(m - mn); m = mn; float ps = 0.f; \
        _Pragma("unroll") for (int T = 0; T < 2; ++T) _Pragma("unroll") for (int r = 0; r < 4; ++r) { sv[T][r] = __builtin_amdgcn_exp2f(sv[T][r] - m); ps += sv[T][r]; } \
        lsum = lsum * al + ps; const pg8::bf16x8 pf = cvt8(sv[0], sv[1]); \
        _Pragma("unroll") for (int db = 0; db < 4; ++db) { o[db] = o[db] * al; \
            const f32x4 va = {VR[db][0], VR[db][1], VR[db][2], VR[db][3]}, vb = {VR[db][4], VR[db][5], VR[db][6], VR[db][7]}; \
            o[db] = __builtin_amdgcn_mfma_f32_16x16x32_bf16(cvt8(va, vb), pf, o[db], 0, 0, 0); } } while (0)
    f32x4 krA[2][2][2], krB[2][2][2]; float vrA[4][8], vrB[4][8];
    SA_LOAD(krA, vrA, 0);
#pragma unroll 1
    for (int step = 0; step < 16; step += 2) {
        SA_LOAD(krB, vrB, step + 1);
        SA_MATH(krA, vrA, step);
        if (step + 2 < 16) SA_LOAD(krA, vrA, step + 2);
        SA_MATH(krB, vrB, step + 1);
    }
#undef SA_LOAD
#undef SA_MATH
    lsum += __shfl_xor(lsum, 16); lsum += __shfl_xor(lsum, 32);
    float* pp = WSP(float, WS_PART) + ((((size_t)b * 4 + h) * 16 + split * 2 + half) * 16 + c16) * PSTR;
#pragma unroll
    for (int db = 0; db < 4; ++db) *(f32x4*)(pp + 16 * db + 4 * g) = o[db];
    if (g == 0) { pp[64] = m; pp[65] = lsum; }
    LDS_WAIT(); __builtin_amdgcn_s_barrier(); asm volatile("" ::: "memory");
}
__device__ __forceinline__ void n3_attn_sample_combine(const Ctx& C, int l, float lam_init) {
    THREAD_IDS();
    const float lam = lam_of(C, l, lam_init);
    const bf16* QNB = WSP(bf16, WS_QNB); const bf16* KNB = WSP(bf16, WS_KNB); const bf16* ZM = WSP(bf16, WS_ZMIX); bf16* BR = WSP(bf16, WS_BR);
    for (int it = gw; it < DB * 4 * DS; it += NGW) {
        const int b = it >> 5, h = (it >> 3) & 3, t = it & 7; float os[2];
        const float far = C.in[I_RELB][31 * 4 + h];
        float sn[2][8];
        { const float qv = bf2f(QNB[(size_t)(MP + b * 8 + t) * 256 + h * 64 + lane]);
#pragma unroll
          for (int jj = 0; jj < 8; ++jj) { float p = qv * bf2f(KNB[(size_t)(MP + b * 8 + jj) * 256 + h * 64 + lane]);
              p += __shfl_xor(p, 1); p += __shfl_xor(p, 2); p += __shfl_xor(p, 4); p += __shfl_xor(p, 8); p += __shfl_xor(p, 16);
              const float bias = (C.in[I_RELB][t5_bucket(t - jj < 0 ? 0 : t - jj) * 4 + h] - far) * LOG2E;
              sn[0][jj] = jj <= t ? __shfl(p, 0) + bias : -INFINITY; sn[1][jj] = jj <= t ? __shfl(p, 32) + bias : -INFINITY; } }
#pragma unroll
        for (int s = 0; s < 2; ++s) {
            const float* pb = WSP(float, WS_PART) + ((((size_t)b * 4 + h) * 16) * 16 + s * 8 + t) * PSTR;
            float mm = -INFINITY; float pm[16];
#pragma unroll
            for (int pi = 0; pi < 16; ++pi) { pm[pi] = pb[(size_t)pi * 16 * PSTR + 64]; mm = fmaxf(mm, pm[pi]); }
#pragma unroll
            for (int jj = 0; jj < 8; ++jj) mm = fmaxf(mm, sn[s][jj]);
            float ll = 0.f, oo = 0.f;
#pragma unroll
            for (int pi = 0; pi < 16; ++pi) { const float* pr = pb + (size_t)pi * 16 * PSTR; const float w = __builtin_amdgcn_exp2f(pm[pi] - mm); ll += pr[65] * w; oo += pr[lane] * w; }
#pragma unroll
            for (int jj = 0; jj < 8; ++jj) { const float w = __builtin_amdgcn_exp2f(sn[s][jj] - mm); ll += w; oo += w * bf2f(ZM[(size_t)(MP + b * 8 + jj) * NMIXP + D_V + h * 64 + lane]); }
            os[s] = oo / ll;
        }
        const float o = os[0] - lam * os[1]; const float ms = wave_sum(o * o) * (1.0f / 64);
        BR[(size_t)(MP + b * 8 + t) * D + 768 + h * 64 + lane] = (bf16)f2bf(o * rsqrtf(ms + EPS) * C.in[I_SUBLN][l * 64 + lane] * (1.0f - lam_init));
    }
}

__device__ __forceinline__ void n3_la_finalize(const Ctx& C, int l) {
    THREAD_IDS();
    const float* LAO = WSP(float, WS_LAO); const bf16* ZM = WSP(bf16, WS_ZMIX); bf16* BR = WSP(bf16, WS_BR);
    const bool ret = lane < 32; const int hd = (lane >> 3) & 3, c8 = (lane & 7) * 8;
    float gn[8];
#pragma unroll
    for (int j = 0; j < 8; ++j) gn[j] = (ret ? C.in[I_RGN] : C.in[I_GGN])[(l * 4 + hd) * 64 + c8 + j];
    for (int r0 = gw * 4; r0 < MP; r0 += NGW * 4) {
        f32x4 a4[4], b4[4]; v4u g4[4];
#pragma unroll
        for (int u = 0; u < 4; ++u) { const int r = min(r0 + u, MP - 1); a4[u] = *(const f32x4*)(LAO + (size_t)r * 512 + 8 * lane); b4[u] = *(const f32x4*)(LAO + (size_t)r * 512 + 8 * lane + 4);
            g4[u] = *(const v4u*)(ZM + (size_t)r * NMIXP + (ret ? R_G : G_R) + hd * 64 + c8); }
#pragma unroll
        for (int u = 0; u < 4; ++u) { const int r = r0 + u; if (r >= MP) break;
            float x[8] = {a4[u][0], a4[u][1], a4[u][2], a4[u][3], b4[u][0], b4[u][1], b4[u][2], b4[u][3]}, g[8]; unpack8(g4[u], g);
            float s = ((x[0] + x[1]) + (x[2] + x[3])) + ((x[4] + x[5]) + (x[6] + x[7]));
            s += __shfl_xor(s, 1); s += __shfl_xor(s, 2); s += __shfl_xor(s, 4);
            const float mean = ret ? s * (1.0f / 64) : 0.f; float q2 = 0.f;
#pragma unroll
            for (int j = 0; j < 8; ++j) { x[j] -= mean; q2 += x[j] * x[j]; }
            q2 += __shfl_xor(q2, 1); q2 += __shfl_xor(q2, 2); q2 += __shfl_xor(q2, 4);
            const float rs = rsqrtf(q2 * (1.0f / 64) + EPS);
#pragma unroll
            for (int j = 0; j < 8; ++j) x[j] = siluf_(g[j]) * x[j] * rs * gn[j];
            *(v4u*)(BR + (size_t)r * D + 256 + 8 * lane) = pack8(x); }
    }
}

constexpr int NQB_ATT = (L + 127) / 128;
constexpr int IT_LA = 32, IT_SS = IT_LA + DB * 8, IT_AT = IT_SS + 16 * NQB_ATT, IT_LS = IT_AT + 32, IT_CV = IT_LS + (MR + 63) / 64, IT_END = IT_CV;
__device__ __forceinline__ void n2_phase(const Ctx& C, int l, float lam_init, int qslot) {
    THREAD_IDS();
    const float lam = lam_of(C, l, lam_init);
    float mb;
    { float mq = 0.f, mk = 0.f, mbias = 0.f;
#pragma unroll 1
      for (int i = 0; i < 32; ++i) { mq = fmaxf(mq, fabsf(C.in[I_QN][l * 32 + i])); mk = fmaxf(mk, fabsf(C.in[I_KN][l * 32 + i])); }
#pragma unroll 1
      for (int i = 0; i < 128; ++i) mbias = fmaxf(mbias, C.in[I_RELB][i] - C.in[I_RELB][31 * 4 + (i & 3)]);
      mb = 1.02f * 1.4426950408889634f * 5.656854249492381f * mq * mk + 1.4426950408889634f * mbias; }
    unsigned* qw = (unsigned*)(C.ws + WS_CTL) + CW_QUEUE + 64 * qslot;
    volatile LAS int* slot = (volatile LAS int*)(C.lds + MISC_OFF + 64);
    if (blockIdx.x < IT_LA) { const int it = blockIdx.x; const int b = (it >> 2) & 3, h = it & 3; if (it < 16) la_chunked<64, true>(C, l, false, b, h); else la_chunked<32, false>(C, l, false, b, h); }
    for (;;) {
        if (tid == 0) slot[0] = (int)__hip_atomic_fetch_add(qw, 1u, __ATOMIC_RELAXED, __HIP_MEMORY_SCOPE_AGENT);
        __syncthreads();
        const int qi = slot[0];
        const int it = qi < 3 * DB * 8 ? ((qi % 3) ? IT_SS + 2 * (qi / 3) + (qi % 3) - 1 : IT_LA + qi / 3) : qi + IT_LA;
        __syncthreads();
        if (it >= IT_END) break;
        if (it < IT_SS) { const int i2 = it - IT_LA; attn_sample_item(C, l, i2 >> 3, i2 & 7); }
        else if (it < IT_AT) { const int i2 = it - IT_SS; attn_prompt_item(C, l, (i2 & 15) >> 2, i2 & 3, NQB_ATT - 1 - (i2 >> 4), lam, lam_init, mb); }
        else if (it < IT_LS) { const int i2 = (it - IT_AT) * 8 + wave; const int b = (i2 >> 2) & 31, h = i2 & 3; if (i2 < 128) la_seq<64, true>(C, l, true, b, h); else la_seq<32, false>(C, l, true, b, h); }
        else { conv_rows_item(C, l, it - IT_LS); conv_state_item(C, l, it - IT_LS, IT_CV - IT_LS); }
    }
}

template <int l> __device__ __forceinline__ void layer_fwd(const Ctx& C, const XcdBarrier& bar) {
#define GRID_BAR() xcd_barrier<false>(bar)
    LAS unsigned char* ring = C.lds + RING_OFF;
    float* SS = WSP(float, WS_SS); float* H = WSP(float, WS_H); bf16* HB = WSP(bf16, WS_HB); bf16* ACT = WSP(bf16, WS_ACT); bf16* ZMIX = WSP(bf16, WS_ZMIX); bf16* GATES = WSP(bf16, WS_GATES);
    bf16* BR = WSP(bf16, WS_BR); bf16* MERGED = WSP(bf16, WS_MERGED);
    constexpr float lam_init = l == 0 ? 0.2f : 0.35550906759096926f;
    constexpr bool last = (l == DEPTH - 1);
    { pg8::Gemm g{HB, WSP(bf16, WS_W1 + (size_t)(l * 2 + 0) * SZ_W1), D, D, D}; pg8::StaticOrder S; S.init(M, 2 * DFF, C.G, (int)blockIdx.x);
      EpiGLU E{ACT, SS + (size_t)(l * 3 + 0) * M * 16}; pg8::gemm_phase<EpiGLU, pg8::StaticOrder, true, true>(ring, g, S, E); }
    GRID_BAR();
    { pg8::HeadOrder S; S.init(M, D, C.G, (int)blockIdx.x); S.limit = C.G; EpiRes<false, 1> E{H, HB, SS + (size_t)(l * 3 + 1) * M * 16, nullptr};
      { pg8::Gemm g{ACT, WSP(bf16, WS_WD + (size_t)(l * 2 + 0) * SZ_WD), DFF, DFF, DFF}; pg8::gemm_phase<EpiRes<false, 1>, pg8::HeadOrder, true, true>(ring, g, S, E); }
      { int kt = DFF / 11; asm volatile("" : "+s"(kt)); pg8::Gemm g{ACT, WSP(bf16, WS_WD + (size_t)(l * 2 + 0) * SZ_WD), DFF, DFF, kt}; pg8::TailOrder T; T.init(M, D, C.G, (int)blockIdx.x); T.limit = C.G; T.nsplit = 11; T.kper = DFF / 11;
        EpiPartial EP{WSP(float, WS_KSP)}; pg8::gemm_phase<EpiPartial, pg8::TailOrder, true, true>(ring, g, T, EP); }
      ksp_finalize_local<11>(WSP(float, WS_KSP), S, C.G, E, (unsigned*)(C.ws + WS_CTL) + CW_TAIL + 512 * (l * 3 + 0), (unsigned*)(C.ws + WS_CTL) + CW_BAR); }
    GRID_BAR();
    { pg8::Gemm g{HB, WSP(bf16, WS_WIN + (size_t)l * SZ_WIN), D, D, D}; pg8::StaticOrder S; S.init(M, NINP, C.G, (int)blockIdx.x);
      EpiZ E{ZMIX, GATES, SS + (size_t)(l * 3 + 1) * M * 16, WSP(float, WS_BINP) + l * NINP}; pg8::gemm_phase<EpiZ, pg8::StaticOrder, true, true>(ring, g, S, E); }
    GRID_BAR();
    n1_prep(C, l);
    GRID_BAR();
    n2_phase(C, l, lam_init, l);
    GRID_BAR();
    n3_attn_sample_combine(C, l, lam_init);
    n3_la_finalize(C, l);
    GRID_BAR();
    { pg8::HeadOrder S; S.init(M, D, C.G, (int)blockIdx.x); S.limit = C.G;
      { pg8::Gemm g{BR, WSP(bf16, WS_WBR + (size_t)l * SZ_WBR), D, D, D}; EpiMergeR E{MERGED, GATES}; pg8::gemm_phase<EpiMergeR, pg8::HeadOrder, true, true, 4>(ring, g, S, E); }
      { int kt = D / 4; asm volatile("" : "+s"(kt)); pg8::Gemm g{BR, WSP(bf16, WS_WBR + (size_t)l * SZ_WBR), D, D, kt}; pg8::TailOrder T; T.init(M, D, C.G, (int)blockIdx.x); T.limit = C.G; T.nsplit = 4; T.kper = D / 4;
        EpiPartial EP{WSP(float, WS_KSP)}; pg8::gemm_phase<EpiPartial, pg8::TailOrder, true, true>(ring, g, T, EP); }
      merge_finalize_local(WSP(float, WS_KSP), S, C.G, MERGED, GATES, (unsigned*)(C.ws + WS_CTL) + CW_TAIL + 512 * (6 + l), (unsigned*)(C.ws + WS_CTL) + CW_BAR); }
    GRID_BAR();
    { pg8::HeadOrder S; S.init(M, D, C.G, (int)blockIdx.x); S.limit = C.G; EpiRes<false, 2> E{H, HB, SS + (size_t)(l * 3 + 2) * M * 16, nullptr};
      { pg8::Gemm g{MERGED, WSP(bf16, WS_WOUT + (size_t)l * SZ_WOUT), D, D, D}; pg8::gemm_phase<EpiRes<false, 2>, pg8::HeadOrder, true, true>(ring, g, S, E); }
      { int kt = D / 4; asm volatile("" : "+s"(kt)); pg8::Gemm g{MERGED, WSP(bf16, WS_WOUT + (size_t)l * SZ_WOUT), D, D, kt}; pg8::TailOrder T; T.init(M, D, C.G, (int)blockIdx.x); T.limit = C.G; T.nsplit = 4; T.kper = D / 4;
        EpiPartial EP{WSP(float, WS_KSP)}; pg8::gemm_phase<EpiPartial, pg8::TailOrder, true, true>(ring, g, T, EP); }
      ksp_finalize_local<4>(WSP(float, WS_KSP), S, C.G, E, (unsigned*)(C.ws + WS_CTL) + CW_TAIL + 512 * (l * 3 + 1), (unsigned*)(C.ws + WS_CTL) + CW_BAR); }
    GRID_BAR();
    { pg8::Gemm g{HB, WSP(bf16, WS_W1 + (size_t)(l * 2 + 1) * SZ_W1), D, D, D}; pg8::StaticOrder S; S.init(M, 2 * DFF, C.G, (int)blockIdx.x);
      EpiGLU E{ACT, SS + (size_t)(l * 3 + 2) * M * 16}; pg8::gemm_phase<EpiGLU, pg8::StaticOrder, true, true>(ring, g, S, E); }
    GRID_BAR();
    { pg8::HeadOrder S; S.init(M, D, C.G, (int)blockIdx.x); S.limit = C.G; EpiRes<last, 1> E{H, HB, last ? nullptr : SS + (size_t)((l + 1) * 3) * M * 16, C.out};
      { pg8::Gemm g{ACT, WSP(bf16, WS_WD + (size_t)(l * 2 + 1) * SZ_WD), DFF, DFF, DFF}; pg8::gemm_phase<EpiRes<last, 1>, pg8::HeadOrder, true, true>(ring, g, S, E); }
      { int kt = DFF / 11; asm volatile("" : "+s"(kt)); pg8::Gemm g{ACT, WSP(bf16, WS_WD + (size_t)(l * 2 + 1) * SZ_WD), DFF, DFF, kt}; pg8::TailOrder T; T.init(M, D, C.G, (int)blockIdx.x); T.limit = C.G; T.nsplit = 11; T.kper = DFF / 11;
        EpiPartial EP{WSP(float, WS_KSP)}; pg8::gemm_phase<EpiPartial, pg8::TailOrder, true, true>(ring, g, T, EP); }
      ksp_finalize_local<11>(WSP(float, WS_KSP), S, C.G, E, (unsigned*)(C.ws + WS_CTL) + CW_TAIL + 512 * (l * 3 + 2), (unsigned*)(C.ws + WS_CTL) + CW_BAR); }
#undef GRID_BAR
}

__global__ void __launch_bounds__(NWAVES * 64, 2) fwd(Params P) {
    extern __shared__ __attribute__((aligned(16))) unsigned char lds[];
    Ctx C;
    C.in = P.in; C.out = P.out; C.ws = P.ws; C.lds = (LAS unsigned char*)lds;
    C.G = gridDim.x;
    volatile LAS unsigned* MISC = (volatile LAS unsigned*)(C.lds + MISC_OFF);
    for (int u = threadIdx.x; u < (LDS_BYTES - LDSCTL_OFF) / 4; u += NWAVES * 64) ((LAS unsigned*)(C.lds + LDSCTL_OFF))[u] = 0u;
    __syncthreads();
    unsigned* ctl = (unsigned*)(C.ws + WS_CTL);
    XcdBarrier bar = xcd_barrier_post(ctl + CW_BAR, MISC + 8);
    p0_prologue(C, P);
    xcd_barrier<true>(bar);
    layer_fwd<0>(C, bar);
    xcd_barrier<false>(bar);
    layer_fwd<1>(C, bar);
}

extern "C" void kernel_launch(void* const* d_in, const int* in_sizes, int n_in, void* d_out, int out_size, void* d_ws, size_t ws_size, hipStream_t stream) {
    static int grid = 0;
    if (grid == 0) {
        if (n_in != N_INPUTS || (size_t)out_size != O_END || ws_size < WS_END) { fprintf(stderr, "kernel_launch: unexpected shapes: n_in %d out %d (want %zu) ws %zu (want %zu)\n", n_in, out_size, (size_t)O_END, ws_size, (size_t)WS_END); grid = -1; return; }
        int dev = 0, cus = 0, per_cu = 0;
        if (hipGetDevice(&dev) != hipSuccess || hipDeviceGetAttribute(&cus, hipDeviceAttributeMultiprocessorCount, dev) != hipSuccess) { grid = -1; return; }
        if (hipFuncSetAttribute((const void*)fwd, hipFuncAttributeMaxDynamicSharedMemorySize, LDS_BYTES) != hipSuccess) { fprintf(stderr, "kernel_launch: hipFuncSetAttribute failed\n"); grid = -1; return; }
        if (hipOccupancyMaxActiveBlocksPerMultiprocessor(&per_cu, (const void*)fwd, NWAVES * 64, LDS_BYTES) != hipSuccess || per_cu < 1) { fprintf(stderr, "kernel_launch: occupancy query says %d blocks per CU\n", per_cu); }
        (void)hipGetLastError();
        grid = cus;
    }
    if (grid < 0) return;
    if (hipMemsetAsync((char*)d_ws + WS_CTL, 0, CTL_ZERO_BYTES, stream) != hipSuccess) return;
    Params p{};
    for (int i = 0; i < N_INPUTS; ++i) p.in[i] = (const float*)d_in[i];
    p.out = (float*)d_out; p.ws = (unsigned char*)d_ws;
    for (int i = 0; i < 32; ++i) p.inv_freq[i] = (float)pow(10000.0, -(double)i / 32.0);
    hipLaunchKernelGGL(fwd, dim3(grid), dim3(NWAVES * 64), LDS_BYTES, stream, p);
}
```

```cpp
#include <hip/hip_runtime.h>
#include <cstdio>
#include <cstdint>
#include <cmath>

namespace pg8 {
#define PG8_LAS __attribute__((address_space(3)))
typedef unsigned short bf16_t;
typedef short bf16x8 __attribute__((ext_vector_type(8)));
typedef float f32x4 __attribute__((ext_vector_type(4)));
typedef unsigned u32x4 __attribute__((ext_vector_type(4)));
constexpr int BM = 256, BK = 64, HALF = 128, HTB = HALF * BK * 2  , STAGE_BYTES = 8 * HTB, NXCD = 8, WGM = 8;

__host__ __device__ __forceinline__ int lds_byte(int r, int c) { const int st = (r >> 4) * 2 + (c >> 5), rr = r & 15, cc = c & 31, ob = rr * 64 + cc * 2; return st * 1024 + (ob ^ (((ob >> 9) & 1) << 5)); }
__host__ __device__ __forceinline__ void stage_rc(int b, int& R, int& C) { const int st = b / 1024, sb = b % 1024, swz = sb ^ (((sb >> 9) & 1) << 5); R = (st >> 1) * 16 + swz / 64; C = (st & 1) * 32 + (swz % 64) / 2; }
__host__ __device__ __forceinline__ int perm32(int rho) { const int n = rho >> 4, i = rho & 15; return 8 * (i >> 2) + 4 * n + (i & 3); }

struct Unit { int pm, pn, acol, bcol; };
struct Gemm { const bf16_t* A; const bf16_t* Bt; int lda, ldb, K, kseg0; };

struct StaticOrder {
    int nM, nN, nwg, G, c;
    __host__ __device__ void init(int M, int N, int G_, int c_) { nM = M / BM; nN = N / BM; nwg = nM * nN; G = G_; c = c_; }
    __host__ __device__ void unit_of(int L, Unit& u) const {
        int wgid = L; { const int q = nwg / NXCD, r = nwg % NXCD, xcd = wgid % NXCD, off = wgid / NXCD; wgid = (xcd < r ? xcd * (q + 1) : r * (q + 1) + (xcd - r) * q) + off; }
        const int nig = WGM * nN, gid = wgid / nig, fm = gid * WGM, gsz = (nM - fm) < WGM ? (nM - fm) : WGM;
        u.pm = fm + ((wgid % nig) % gsz); u.pn = (wgid % nig) / gsz; u.acol = 0; u.bcol = 0;
    }
    __host__ __device__ bool next(int i, Unit& u) const { const long L = (long)i * G + c; if (L >= nwg) return false; unit_of((int)L, u); return true; }
};
struct HeadOrder : StaticOrder { int limit; __host__ __device__ bool next(int i, Unit& u) const { const long L = (long)i * G + c; if (L >= limit || L >= nwg) return false; unit_of((int)L, u); return true; } };
struct TailOrder : StaticOrder { int limit, nsplit, kper;
    __host__ __device__ bool next(int i, Unit& u) const {
        if (i > 0 || c >= (nwg - limit) * nsplit) return false;
        unit_of(limit + c / nsplit, u); u.acol = u.bcol = (c % nsplit) * kper; return true; } };
__device__ __forceinline__ unsigned cvt_pk_bf16(float lo, float hi) { unsigned r; asm volatile("v_cvt_pk_bf16_f32 %0, %1, %2" : "=v"(r) : "v"(lo), "v"(hi)); return r; }

template <class Epi, class Sched, bool ALIGN_EPI = false, bool SP2 = false, int SEG = 0>
__device__ __forceinline__ void gemm_phase(PG8_LAS unsigned char* lds, const Gemm g, const Sched& S, const Epi& E) {
    int tid_ = threadIdx.x; asm volatile("" : "+v"(tid_));
    const int tid = tid_, wid = __builtin_amdgcn_readfirstlane(tid >> 6), lane = tid & 63, wr = wid >> 2, wc = wid & 3, fr = lane & 15, fq = lane >> 4;
    const int nt = g.K / BK;
    unsigned voffA[2], voffB[2];
#pragma unroll
    for (int i = 0; i < 2; ++i) { int R, C; stage_rc(tid * 16 + i * 8192, R, C); const int Rb = Epi::PERM ? ((R & ~31) + perm32(R & 31)) : R;
        voffA[i] = (unsigned)(R * g.lda + C) * 2u; voffB[i] = (unsigned)(Rb * g.ldb + C) * 2u; }
    const size_t kstep = (size_t)(BK * 2);
    const size_t hstepA = (size_t)HALF * g.lda * 2, hstepB = (size_t)HALF * g.ldb * 2;
    const size_t tstepA = 2 * hstepA, tstepB = 2 * hstepB;
    const unsigned ldsw = (unsigned)wid * 1024u;
    const int aoff = lds_byte(wr * 64 + fr, fq * 8), boff = lds_byte(wc * 32 + fr, fq * 8);
#define PG8_SA(b, h) (((b) * 2 + (h)) * HTB)
#define PG8_SB(b, h) ((4 + (b) * 2 + (h)) * HTB)
#define PG8_STAGE(bufoff, gbase, voff) do { _Pragma("unroll") for (int _i = 0; _i < 2; ++_i) \
        __builtin_amdgcn_global_load_lds((const unsigned*)((const char*)(gbase) + (voff)[_i]), (PG8_LAS unsigned*)(lds + (bufoff) + ldsw + _i * 8192), 16, 0, 0); } while (0)
#define PG8_LDA(dst, b, h) do { _Pragma("unroll") for (int m = 0; m < 4; ++m) _Pragma("unroll") for (int k = 0; k < 2; ++k) dst[m][k] = *(const PG8_LAS bf16x8*)(lds + PG8_SA(b, h) + aoff + m * 2048 + k * 1024); } while (0)
#define PG8_LDB(dst, b, h) do { _Pragma("unroll") for (int n = 0; n < 2; ++n) _Pragma("unroll") for (int k = 0; k < 2; ++k) dst[n][k] = *(const PG8_LAS bf16x8*)(lds + PG8_SB(b, h) + boff + n * 2048 + k * 1024); } while (0)
#define PG8_MMA(ai, bj, At, Bt) do { __builtin_amdgcn_s_setprio(1); _Pragma("unroll") for (int m = 0; m < 4; ++m) _Pragma("unroll") for (int n = 0; n < 2; ++n) _Pragma("unroll") for (int k = 0; k < 2; ++k) \
        acc[ai][bj][m][n] = __builtin_amdgcn_mfma_f32_16x16x32_bf16(Bt[n][k], At[m][k], acc[ai][bj][m][n], 0, 0, 0); __builtin_amdgcn_s_setprio(0); } while (0)
#define PG8_WAIT_V(n) asm volatile("s_waitcnt vmcnt(" #n ")" ::: "memory")
#define PG8_WAIT_L(n) asm volatile("s_waitcnt lgkmcnt(" #n ")" ::: "memory")
#define PG8_BAR __builtin_amdgcn_s_barrier()
#define PG8_SCHED __builtin_amdgcn_sched_barrier(0)
    Unit cur, nxt; int ui = 0;
    if (!S.next(0, cur)) return;
    f32x4 acc[2][2][4][2];
#pragma unroll
    for (int a = 0; a < 2; ++a)
#pragma unroll
        for (int b = 0; b < 2; ++b)
#pragma unroll
            for (int m = 0; m < 4; ++m)
#pragma unroll
                for (int n = 0; n < 2; ++n) acc[a][b][m][n] = (f32x4){0.f, 0.f, 0.f, 0.f};
    bf16x8 At[4][2], B0[2][2], B1[2][2];
    const char* cA = (const char*)g.A + (size_t)cur.pm * tstepA + (size_t)cur.acol * 2; const char* cB = (const char*)g.Bt + (size_t)cur.pn * tstepB + (size_t)cur.bcol * 2;
#define PG8_KOFF(t) ((SEG > 0) ? (size_t)(((((t) / (SEG > 0 ? SEG : 1)) + g.kseg0) & (nt / (SEG > 0 ? SEG : 1) - 1)) * (SEG > 0 ? SEG : 1) + ((t) % (SEG > 0 ? SEG : 1))) * kstep : (size_t)(t) * kstep)
    const size_t K0 = PG8_KOFF(0);
    cA += K0; cB += K0;
    if constexpr (SP2) {
        PG8_STAGE(PG8_SB(0, 0), cB, voffB); PG8_STAGE(PG8_SB(0, 1), cB + hstepB, voffB); PG8_STAGE(PG8_SA(0, 0), cA, voffA); PG8_STAGE(PG8_SA(0, 1), cA + hstepA, voffA);
        if (wr == 1) PG8_BAR;
        PG8_WAIT_V(2); PG8_BAR;
        PG8_STAGE(PG8_SB(1, 0), cB + kstep, voffB); PG8_STAGE(PG8_SA(1, 0), cA + kstep, voffA); PG8_STAGE(PG8_SB(1, 1), cB + hstepB + kstep, voffB);
        PG8_WAIT_V(6); PG8_BAR;
    } else {
        PG8_STAGE(PG8_SB(0, 0), cB, voffB); PG8_STAGE(PG8_SA(0, 0), cA, voffA); PG8_STAGE(PG8_SB(0, 1), cB + hstepB, voffB); PG8_STAGE(PG8_SA(0, 1), cA + hstepA, voffA);
        if (wr == 1) PG8_BAR;
        PG8_WAIT_V(4); PG8_BAR;
        PG8_STAGE(PG8_SB(1, 0), cB + kstep, voffB); PG8_STAGE(PG8_SA(1, 0), cA + kstep, voffA); PG8_STAGE(PG8_SB(1, 1), cB + hstepB + kstep, voffB);
        PG8_WAIT_V(6); PG8_BAR;
    }
    for (;;) {
        const bool has_next = S.next(ui + 1, nxt);
        const char* nA = has_next ? (const char*)g.A + (size_t)nxt.pm * tstepA + (size_t)nxt.acol * 2 + K0 : cA; const char* nB = has_next ? (const char*)g.Bt + (size_t)nxt.pn * tstepB + (size_t)nxt.bcol * 2 + K0 : cB;
        for (int t = 0; t < nt; t += 2) {
            const bool last = (t == nt - 2);
            const char* a1 = cA - K0 + PG8_KOFF(t + 1);
            const char* a2 = last ? nA : cA - K0 + PG8_KOFF(t + 2); const char* b2 = last ? nB : cB - K0 + PG8_KOFF(t + 2);
            const char* a3 = a2 + kstep; const char* b3 = b2 + kstep;
            if constexpr (SP2) {
            PG8_LDB(B0, 0, 0); PG8_LDB(B1, 0, 1); PG8_SCHED; PG8_LDA(At, 0, 0); PG8_STAGE(PG8_SA(1, 1), a1 + hstepA, voffA);
            PG8_WAIT_V(8); PG8_WAIT_L(0); PG8_BAR; PG8_MMA(0, 0, At, B0); PG8_MMA(0, 1, At, B1); PG8_BAR; PG8_SCHED;
            PG8_LDA(At, 0, 1); PG8_STAGE(PG8_SB(0, 0), b2, voffB); PG8_STAGE(PG8_SB(0, 1), b2 + hstepB, voffB); PG8_STAGE(PG8_SA(0, 0), a2, voffA);
            PG8_WAIT_V(8); PG8_WAIT_L(0); PG8_BAR; PG8_MMA(1, 0, At, B0); PG8_MMA(1, 1, At, B1); PG8_BAR; PG8_SCHED;
            PG8_LDB(B0, 1, 0); PG8_LDB(B1, 1, 1); PG8_SCHED; PG8_LDA(At, 1, 0); PG8_STAGE(PG8_SA(0, 1), a2 + hstepA, voffA);
            PG8_WAIT_V(8); PG8_WAIT_L(0); PG8_BAR; PG8_MMA(0, 0, At, B0); PG8_MMA(0, 1, At, B1); PG8_BAR; PG8_SCHED;
            PG8_LDA(At, 1, 1); PG8_STAGE(PG8_SB(1, 0), b3, voffB); PG8_STAGE(PG8_SB(1, 1), b3 + hstepB, voffB); PG8_STAGE(PG8_SA(1, 0), a3, voffA);
            PG8_WAIT_V(8); PG8_WAIT_L(0); PG8_BAR; PG8_MMA(1, 0, At, B0); PG8_MMA(1, 1, At, B1); PG8_BAR; PG8_SCHED;
            } else {
            PG8_LDB(B0, 0, 0); PG8_SCHED; PG8_LDA(At, 0, 0); PG8_STAGE(PG8_SA(1, 1), a1 + hstepA, voffA);
            PG8_WAIT_L(8); PG8_BAR; PG8_WAIT_L(0); PG8_MMA(0, 0, At, B0); PG8_BAR; PG8_SCHED;
            PG8_LDB(B1, 0, 1); PG8_STAGE(PG8_SB(0, 0), b2, voffB);
            PG8_BAR; PG8_WAIT_L(0); PG8_MMA(0, 1, At, B1); PG8_BAR;
            PG8_LDA(At, 0, 1); PG8_STAGE(PG8_SA(0, 0), a2, voffA);
            PG8_BAR; PG8_WAIT_L(0); PG8_MMA(1, 0, At, B0); PG8_BAR; PG8_SCHED;
            PG8_STAGE(PG8_SB(0, 1), b2 + hstepB, voffB);
            PG8_WAIT_V(6); PG8_BAR; PG8_MMA(1, 1, At, B1); PG8_BAR;
            PG8_LDB(B0, 1, 0); PG8_SCHED; PG8_LDA(At, 1, 0); PG8_STAGE(PG8_SA(0, 1), a2 + hstepA, voffA);
            PG8_WAIT_L(8); PG8_BAR; PG8_WAIT_L(0); PG8_MMA(0, 0, At, B0); PG8_BAR; PG8_SCHED;
            PG8_LDB(B1, 1, 1); PG8_STAGE(PG8_SB(1, 0), b3, voffB);
            PG8_BAR; PG8_WAIT_L(0); PG8_MMA(0, 1, At, B1); PG8_BAR;
            PG8_LDA(At, 1, 1); PG8_STAGE(PG8_SA(1, 0), a3, voffA);
            PG8_BAR; PG8_WAIT_L(0); PG8_MMA(1, 0, At, B0); PG8_BAR; PG8_SCHED;
            PG8_STAGE(PG8_SB(1, 1), b3 + hstepB, voffB);
            PG8_WAIT_V(6); PG8_BAR; PG8_MMA(1, 1, At, B1); PG8_BAR;
            }
            if constexpr (SEG > 0) { if (((t + 2) % SEG) == 0 && (t + 2) < nt) E.mid(acc, cur, (t + 2) / SEG, g.kseg0); }
        }
        if constexpr (ALIGN_EPI) { if (wr == 0) PG8_BAR; }
        E(acc, cur, wr, wc, fr, fq);
        if (!has_next) break;
#pragma unroll
        for (int a = 0; a < 2; ++a)
#pragma unroll
            for (int b = 0; b < 2; ++b)
#pragma unroll
                for (int m = 0; m < 4; ++m)
#pragma unroll
                    for (int n = 0; n < 2; ++n) acc[a][b][m][n] = (f32x4){0.f, 0.f, 0.f, 0.f};
        cur = nxt; cA = nA; cB = nB; ++ui;
        if constexpr (ALIGN_EPI) { if (wr == 1) PG8_BAR; }
    }
    PG8_WAIT_V(0);
    if constexpr (!ALIGN_EPI) { if (wr == 0) PG8_BAR; }
    PG8_BAR;
#undef PG8_KOFF
#undef PG8_SA
#undef PG8_SB
#undef PG8_STAGE
#undef PG8_LDA
#undef PG8_LDB
#undef PG8_MMA
#undef PG8_WAIT_V
#undef PG8_WAIT_L
#undef PG8_BAR
#undef PG8_SCHED
}
}

constexpr int NWAVES = 8;
constexpr int D = 1024, DFF = 2816, NIN = 7184, NMIX = 3088, NMIXP = 3328, NGATE = 4096, NINP = NMIXP + NGATE;
constexpr int SEQ = 4096, NMETA = 16, L = SEQ + NMETA, BATCH = 4, DB = 32, DS = 8, PAST = 8192, PAGE = 128, NPAGES = PAST / PAGE, NPOOL = 2560, DEPTH = 2;
constexpr int MP = BATCH * L, MS = DB * DS, MR = MP + MS, M = 16896;
constexpr int NPOS = L + DS;
constexpr float EPS = 1e-6f;
constexpr int C_A = 0, C_G = 256, R_Q = 512, R_K = 768, R_V = 1024, R_G = 1280, G_Q = 1536, G_K = 1664, G_V = 1792, G_R = 2048, G_LOW = 2304, D_Q = 2320, D_K = 2576, D_V = 2832;
constexpr size_t O_YP = 0, O_YS = O_YP + (size_t)BATCH * SEQ * D, O_KP = O_YS + (size_t)MS * D, O_VP = O_KP + (size_t)DEPTH * MP * 256, O_KS = O_VP + (size_t)DEPTH * MP * 256,
                 O_VS = O_KS + (size_t)DEPTH * MS * 256, O_RP = O_VS + (size_t)DEPTH * MS * 256, O_RS = O_RP + (size_t)DEPTH * BATCH * 4 * 64 * 64, O_GP = O_RS + (size_t)DEPTH * DB * 4 * 64 * 64,
                 O_GS = O_GP + (size_t)DEPTH * BATCH * 4 * 32 * 64, O_CP = O_GS + (size_t)DEPTH * DB * 4 * 32 * 64, O_CS = O_CP + (size_t)DEPTH * BATCH * 30 * 256, O_END = O_CS + (size_t)DEPTH * DB * 30 * 256;
enum { I_XP = 0, I_XS, I_CK, I_CV, I_PT, I_SRET, I_SGLA, I_SCONV, I_META, I_RELB, I_NF1, I_F1G, I_F1U, I_F1D, I_NMIX, I_WIN, I_BIN, I_CW, I_CB, I_CLG, I_CLB, I_RGN, I_GAW, I_GAB, I_GGN,
       I_QN, I_KN, I_LQ1, I_LK1, I_LQ2, I_LK2, I_SUBLN, I_WBR, I_WOUT, I_NF2, I_F2G, I_F2U, I_F2D, N_INPUTS };

constexpr size_t MiB = 1u << 20;
constexpr size_t WS_CTL = 0, CTL_ZERO_BYTES = 64 * 1024;
constexpr size_t SZ_SS = (size_t)M * 16 * 4;
constexpr size_t SZ_W1 = (size_t)2 * DFF * D * 2, SZ_WD = (size_t)D * DFF * 2, SZ_WIN = (size_t)NINP * D * 2, SZ_WBR = (size_t)4 * D * 256 * 2, SZ_WOUT = (size_t)D * D * 2;
constexpr size_t WS_W1 = 4 * MiB;
constexpr size_t WS_WD = WS_W1 + 4 * SZ_W1;
constexpr size_t WS_WIN = WS_WD + 4 * SZ_WD;
constexpr size_t WS_WBR = WS_WIN + 2 * SZ_WIN;
constexpr size_t WS_WOUT = WS_WBR + 2 * SZ_WBR;
constexpr size_t WS_BINP = WS_WOUT + 2 * SZ_WOUT;
constexpr size_t WS_ROPE = WS_BINP + 64 * 1024;
constexpr size_t WS_SS = WS_ROPE + 2 * MiB;
constexpr size_t WS_H = 128 * MiB;
constexpr size_t WS_HB = WS_H + (size_t)M * D * 4;
constexpr size_t WS_ACT = WS_HB + (size_t)M * D * 2;
constexpr size_t WS_ZMIX = WS_ACT + (size_t)M * DFF * 2;
constexpr size_t WS_GATES = WS_ZMIX + (size_t)M * NMIXP * 2;
constexpr size_t WS_BR = WS_GATES + (size_t)M * NGATE * 2;
constexpr size_t WS_MERGED = WS_BR + (size_t)M * D * 2;
constexpr size_t WS_UBUF = WS_MERGED + (size_t)M * D * 2;
constexpr size_t WS_RQ = WS_UBUF + (size_t)M * 256 * 4, WS_RK = WS_RQ + (size_t)M * 256 * 4, WS_QN = WS_RK + (size_t)M * 256 * 4, WS_KN = WS_QN + (size_t)M * 256 * 4, WS_VB = WS_KN + (size_t)M * 256 * 4;
constexpr size_t WS_LDEC = WS_VB + (size_t)M * 256 * 4;
constexpr size_t WS_QNB = WS_LDEC + (size_t)M * 128 * 4;
constexpr size_t WS_KNB = WS_QNB + (size_t)M * 256 * 2;
constexpr size_t WS_PART = WS_KNB + (size_t)M * 256 * 2;
constexpr size_t WS_LAO = WS_PART + (size_t)DB * 4 * 16 * 16 * 68 * 4;
constexpr size_t WS_KSP = WS_LAO + (size_t)M * 512 * 4;
constexpr size_t WS_END = WS_KSP + (size_t)8 * 11 * 65536 * 4;
static_assert(WS_ROPE + 2 * NPOS * 32 * 4 <= WS_SS && WS_SS + 6 * SZ_SS <= WS_H, "weights region overflows");
constexpr int CW_BAR = 4096, CW_QUEUE = 8192, CW_TAIL = 12288;

constexpr int RING_OFF = 0, RING_BYTES = 131072;
constexpr int LDSCTL_OFF = 144384, MISC_OFF = LDSCTL_OFF + 320;
constexpr int LDS_BYTES = 147456;
static_assert(MISC_OFF + 128 <= LDS_BYTES, "LDS map");

#define GAS __attribute__((address_space(1)))
#define LAS __attribute__((address_space(3)))
typedef unsigned short bf16;
typedef unsigned v4u __attribute__((ext_vector_type(4)));
typedef float f32x4 __attribute__((ext_vector_type(4)));
#define LDS_WAIT() asm volatile("s_waitcnt lgkmcnt(0)" ::: "memory")
#define VM_WAIT() asm volatile("s_waitcnt vmcnt(0)" ::: "memory")
__device__ __forceinline__ unsigned f2bf(float f) { unsigned u = __builtin_bit_cast(unsigned, f); return (u + 0x7fffu + ((u >> 16) & 1u)) >> 16; }
__device__ __forceinline__ unsigned pk2(float lo, float hi) { return f2bf(lo) | (f2bf(hi) << 16); }
__device__ __forceinline__ float bf2f(bf16 b) { return __builtin_bit_cast(float, ((unsigned)b) << 16); }
__device__ __forceinline__ float bflo(unsigned w) { return __builtin_bit_cast(float, w << 16); }
__device__ __forceinline__ float bfhi(unsigned w) { return __builtin_bit_cast(float, w & 0xffff0000u); }
__device__ __forceinline__ float wave_sum(float v) {
#pragma unroll
    for (int o = 1; o < 64; o <<= 1) v += __shfl_xor(v, o);
    return v;
}
__device__ __forceinline__ float sigmoidf_(float x) { return __builtin_amdgcn_rcpf(1.0f + __expf(-x)); }
__device__ __forceinline__ float siluf_(float x) { return x * __builtin_amdgcn_rcpf(1.0f + __expf(-x)); }

#define XB_TMO      128
#define XB_XCNT(j)  (256  + 64 * (j))
#define XB_XSUB(j)  (1280 + 64 * (j))
#define XB_XGEN(j)  (2304 + 64 * (j))
#define XB_TOP      3328
#define XB_TOPGEN   3392
#define XCD_BAR_WORDS 3456
#define XB_SPIN_CAP (1u << 22)

__device__ __forceinline__ unsigned xb_ld(unsigned* p)              { return __hip_atomic_load(p, __ATOMIC_RELAXED, __HIP_MEMORY_SCOPE_AGENT); }
__device__ __forceinline__ unsigned xb_add(unsigned* p, unsigned v) { return __hip_atomic_fetch_add(p, v, __ATOMIC_RELAXED, __HIP_MEMORY_SCOPE_AGENT); }
__device__ __forceinline__ unsigned xb_xcc_id() { return (unsigned)__builtin_amdgcn_s_getreg((3 << 11) | 20) & 0xFu; }
#define XB_SPIN(cond, bar) do { unsigned _sp = 0; while (cond) { __builtin_amdgcn_s_sleep(1); \
    if ((++_sp & 255u) == 0u) { if (xb_ld(&(bar)[XB_TMO])) break; if (_sp > XB_SPIN_CAP) { atomicAdd(&(bar)[XB_TMO], 1u); break; } } } } while (0)

struct XcdBarrier { unsigned* bar; unsigned x; volatile LAS unsigned* st; };

__device__ __forceinline__ XcdBarrier xcd_barrier_post(unsigned* bar, volatile LAS unsigned* st) {
    XcdBarrier b; b.bar = bar; b.x = xb_xcc_id(); b.st = st;
    if (threadIdx.x == 0) (void)xb_add(&bar[XB_XCNT(b.x)], 1u);
    return b;
}
__device__ __forceinline__ void xcd_barrier_complete(unsigned* bar, unsigned x, unsigned& nloc, unsigned& nx) {
    const unsigned G = gridDim.x * gridDim.y * gridDim.z;
    unsigned sum, cnt, mine, sp = 0u;
    for (;;) {
        sum = 0u; cnt = 0u; mine = 0u;
#pragma unroll
        for (unsigned j = 0; j < 16; ++j) { const unsigned c = xb_ld(&bar[XB_XCNT(j)]); sum += c; cnt += (c > 0u) ? 1u : 0u; mine = (j == x) ? c : mine; }
        if (sum == G) break;
        __builtin_amdgcn_s_sleep(1);
        if ((++sp & 255u) == 0u) { if (xb_ld(&bar[XB_TMO])) break; if (sp > XB_SPIN_CAP) { atomicAdd(&bar[XB_TMO], 1u); break; } }
    }
    nloc = mine > 0u ? mine : 1u; nx = cnt > 0u ? cnt : 1u;
}
#ifndef FLAT_BAR
#define FLAT_BAR 0
#endif
__device__ __forceinline__ void flat_barrier(const XcdBarrier& b) {
    asm volatile("s_waitcnt vmcnt(0)" ::: "memory");
    __syncthreads();
    if (threadIdx.x == 0) {
        unsigned* bar = b.bar;
        asm volatile("" : "+s"(bar));
        const unsigned epoch = b.st[2] + 1u; b.st[2] = epoch; const unsigned target = epoch * gridDim.x;
        __builtin_amdgcn_fence(__ATOMIC_RELEASE, "agent");
        asm volatile("s_waitcnt vmcnt(0)" ::: "memory");
        (void)xb_add(&bar[XB_TOP], 1u);
        unsigned sp = 0u;
        while (xb_ld(&bar[XB_TOP]) < target) { __builtin_amdgcn_s_sleep(1); if ((++sp & 255u) == 0u) { if (xb_ld(&bar[XB_TMO])) break; if (sp > XB_SPIN_CAP) { atomicAdd(&bar[XB_TMO], 1u); break; } } }
        __builtin_amdgcn_fence(__ATOMIC_ACQUIRE, "agent");
        asm volatile("s_waitcnt vmcnt(0)" ::: "memory");
    }
    __syncthreads();
}
template <bool FIRST> __device__ __forceinline__ void xcd_barrier(const XcdBarrier& b) {
    if (FLAT_BAR) { flat_barrier(b); return; }
    asm volatile("s_waitcnt vmcnt(0)" ::: "memory");
    __syncthreads();
    if (threadIdx.x == 0) {
        unsigned* bar = b.bar;
        asm volatile("" : "+s"(bar));
        __builtin_amdgcn_s_waitcnt(0);
        unsigned nloc = b.st[0], nx = b.st[1];
        if (FIRST) { if (nloc == 0u) { xcd_barrier_complete(bar, b.x, nloc, nx); b.st[0] = nloc; b.st[1] = nx; } }
        const unsigned old = xb_add(&bar[XB_XSUB(b.x)], 1u);
        const unsigned gen = old / nloc;
        if (old + 1u == (gen + 1u) * nloc) {
            __builtin_amdgcn_fence(__ATOMIC_RELEASE, "agent");
            asm volatile("s_waitcnt vmcnt(0)" ::: "memory");
            const unsigned og = xb_add(&bar[XB_TOP], 1u);
            const unsigned tg = og / nx;
            if (og + 1u == (tg + 1u) * nx) {
#pragma unroll
                for (unsigned j = 0; j < 16; ++j) (void)__hip_atomic_fetch_add(&bar[XB_XGEN(j)], 1u, __ATOMIC_RELAXED, __HIP_MEMORY_SCOPE_AGENT);
            }
        }
        XB_SPIN(xb_ld(&bar[XB_XGEN(b.x)]) == gen, bar);
        __builtin_amdgcn_fence(__ATOMIC_ACQUIRE, "agent");
        asm volatile("s_waitcnt vmcnt(0)" ::: "memory");
    }
    __syncthreads();
}

struct Params { const float* in[N_INPUTS]; float* out; unsigned char* ws; float inv_freq[32]; };
static_assert(sizeof(Params) == N_INPUTS * 8 + 16 + 128, "Params has no padding");

struct Ctx {
    const float* const* in; float* out; unsigned char* ws;
    LAS unsigned char* lds;
    int G;
};
#define THREAD_IDS() int tid_ = threadIdx.x; asm volatile("" : "+v"(tid_)); const int tid = tid_, lane = tid & 63, wave = __builtin_amdgcn_readfirstlane(tid >> 6), gw = blockIdx.x * NWAVES + wave, NGW = C.G * NWAVES; (void)tid; (void)lane; (void)wave; (void)gw; (void)NGW
#define WSP(T, off) ((T*)(C.ws + (off)))

__device__ __forceinline__ float rstd_of(const float* ssp, int row) {
    const f32x4 a = *(const f32x4*)(ssp + (size_t)row * 16), b = *(const f32x4*)(ssp + (size_t)row * 16 + 4), c = *(const f32x4*)(ssp + (size_t)row * 16 + 8), d = *(const f32x4*)(ssp + (size_t)row * 16 + 12);
    const float s = (((a[0] + a[1]) + (a[2] + a[3])) + ((b[0] + b[1]) + (b[2] + b[3]))) + (((c[0] + c[1]) + (c[2] + c[3])) + ((d[0] + d[1]) + (d[2] + d[3])));
    return rsqrtf(s * (1.0f / D) + EPS);
}
__device__ __forceinline__ void rstd8(const float* ssp, int row0, int fq, float (&rs)[8]) {
    f32x4 sv[8];
#pragma unroll
    for (int i = 0; i < 8; ++i) sv[i] = *(const f32x4*)(ssp + (size_t)(row0 + (i >> 2) * 128 + (i & 3) * 16) * 16 + 4 * fq);
#pragma unroll
    for (int i = 0; i < 8; ++i) { float s = (sv[i][0] + sv[i][1]) + (sv[i][2] + sv[i][3]); s += __shfl_xor(s, 16); s += __shfl_xor(s, 32); rs[i] = rsqrtf(s * (1.0f / D) + EPS); }
}
#define EPI_IDS() int t_ = threadIdx.x; asm volatile("" : "+v"(t_)); const int wid_ = __builtin_amdgcn_readfirstlane(t_ >> 6), wr = wid_ >> 2, wc = wid_ & 3, fr = t_ & 15, fq = (t_ & 63) >> 4
struct EpiGLU {
    static constexpr bool PERM = true;
    bf16* act; const float* ss;
    __device__ __forceinline__ void operator()(const pg8::f32x4 (&acc)[2][2][4][2], const pg8::Unit& u, int, int, int, int) const {
        EPI_IDS();
        const int row0 = u.pm * 256 + wr * 64 + fr, col0 = u.pn * 128 + wc * 32 + 8 * fq;
        float rs[8]; rstd8(ss, row0, fq, rs);
#pragma unroll
        for (int ai = 0; ai < 2; ++ai)
#pragma unroll
            for (int m = 0; m < 4; ++m) {
                const int row = row0 + ai * 128 + m * 16; const float rstd = rs[ai * 4 + m];
                float o[8];
#pragma unroll
                for (int n = 0; n < 2; ++n)
#pragma unroll
                    for (int j = 0; j < 4; ++j) { const float g = acc[ai][0][m][n][j] * rstd, up = acc[ai][1][m][n][j] * rstd; o[n * 4 + j] = siluf_(g) * up; }
                v4u w; w.x = pg8::cvt_pk_bf16(o[0], o[1]); w.y = pg8::cvt_pk_bf16(o[2], o[3]); w.z = pg8::cvt_pk_bf16(o[4], o[5]); w.w = pg8::cvt_pk_bf16(o[6], o[7]);
                *(v4u*)(act + (size_t)row * DFF + col0) = w;
            }
    }
};
template <bool FINAL, int SCALE2> struct EpiRes {
    static constexpr bool PERM = true;
    float* h; bf16* hb; float* ssout; float* out;
    __device__ __forceinline__ void rowgroup(const pg8::f32x4 (&a)[2][2], int row, int col0, int pn, int wc, int fq) const {
        constexpr float scale = 0.5f * SCALE2; float sq = 0.f;
        long yoff = -1;
        if (FINAL) { if (row < MP) { const int b = row / L, pos = row - b * L; if (pos >= NMETA) yoff = (long)O_YP + ((long)b * SEQ + (pos - NMETA)) * D; } else if (row < MR) yoff = (long)O_YS + (long)(row - MP) * D; }
#pragma unroll
        for (int bj = 0; bj < 2; ++bj) {
            const size_t off = (size_t)row * D + col0 + bj * 128;
            const v4u hw = *(const v4u*)(hb + off);
            f32x4 h0 = (f32x4){bflo(hw.x), bfhi(hw.x), bflo(hw.y), bfhi(hw.y)}, h1 = (f32x4){bflo(hw.z), bfhi(hw.z), bflo(hw.w), bfhi(hw.w)};
            h0 = h0 + a[bj][0] * scale; h1 = h1 + a[bj][1] * scale;
            v4u w; w.x = pg8::cvt_pk_bf16(h0[0], h0[1]); w.y = pg8::cvt_pk_bf16(h0[2], h0[3]); w.z = pg8::cvt_pk_bf16(h1[0], h1[1]); w.w = pg8::cvt_pk_bf16(h1[2], h1[3]);
            *(v4u*)(hb + off) = w;
            sq += (h0[0] * h0[0] + h0[1] * h0[1]) + (h0[2] * h0[2] + h0[3] * h0[3]) + (h1[0] * h1[0] + h1[1] * h1[1]) + (h1[2] * h1[2] + h1[3] * h1[3]);
            if (FINAL && yoff >= 0) { *(f32x4*)(out + yoff + col0 + bj * 128) = h0; *(f32x4*)(out + yoff + col0 + bj * 128 + 4) = h1; }
        }
        sq += __shfl_xor(sq, 16); sq += __shfl_xor(sq, 32);
        if (fq == 0 && ssout) ssout[(size_t)row * 16 + pn * 4 + wc] = sq;
    }
    __device__ __forceinline__ void operator()(const pg8::f32x4 (&acc)[2][2][4][2], const pg8::Unit& u, int, int, int, int) const {
        EPI_IDS();
        const int row0 = u.pm * 256 + wr * 64 + fr, col0 = u.pn * 256 + wc * 32 + 8 * fq;
#pragma unroll
        for (int ai = 0; ai < 2; ++ai)
#pragma unroll
            for (int m = 0; m < 4; ++m) {
                const pg8::f32x4 a[2][2] = {{acc[ai][0][m][0], acc[ai][0][m][1]}, {acc[ai][1][m][0], acc[ai][1][m][1]}};
                rowgroup(a, row0 + ai * 128 + m * 16, col0, u.pn, wc, fq);
                if (m == 3) asm volatile("" ::: "memory");
            }
    }
};
struct EpiZ {
    static constexpr bool PERM = true;
    bf16* zmix; bf16* gates; const float* ss; const float* bias;
    __device__ __forceinline__ void operator()(const pg8::f32x4 (&acc)[2][2][4][2], const pg8::Unit& u, int, int, int, int) const {
        EPI_IDS();
        const int row0 = u.pm * 256 + wr * 64 + fr, col0 = u.pn * 256 + wc * 32 + 8 * fq; const bool isgate = u.pn >= NMIXP / 256;
        f32x4 bv[2][2];
#pragma unroll
        for (int bj = 0; bj < 2; ++bj)
#pragma unroll
            for (int n = 0; n < 2; ++n) bv[bj][n] = *(const f32x4*)(bias + col0 + bj * 128 + 4 * n);
        float rs[8]; rstd8(ss, row0, fq, rs);
#pragma unroll
        for (int ai = 0; ai < 2; ++ai)
#pragma unroll
            for (int m = 0; m < 4; ++m) {
                const int row = row0 + ai * 128 + m * 16; const float rstd = rs[ai * 4 + m];
                if (isgate) {
                    f32x4 E4[4], I4[4];
#pragma unroll
                    for (int bj = 0; bj < 2; ++bj)
#pragma unroll
                        for (int n = 0; n < 2; ++n) { const f32x4 z = acc[ai][bj][m][n] * rstd + bv[bj][n];
#pragma unroll
                            for (int j = 0; j < 4; ++j) { const float e = fminf(1.0f + __expf(-z[j]), 1099511627776.0f); E4[2 * bj + n][j] = e; I4[2 * bj + n][j] = __builtin_amdgcn_rcpf(e); } }
                    const int d0 = 64 * (u.pn - NMIXP / 256) + 16 * wc + 4 * fq; bf16* gp = gates + (size_t)row * NGATE + d0;
#pragma unroll
                    for (int s = 0; s < 4; ++s) { f32x4 o = I4[s];
                        if (s < 3) o = E4[s + 1] * I4[s];
                        *(unsigned long long*)(gp + s * D) = (unsigned long long)pg8::cvt_pk_bf16(o[0], o[1]) | ((unsigned long long)pg8::cvt_pk_bf16(o[2], o[3]) << 32); }
                } else {
#pragma unroll
                    for (int bj = 0; bj < 2; ++bj) {
                        const f32x4 v0 = acc[ai][bj][m][0] * rstd + bv[bj][0], v1 = acc[ai][bj][m][1] * rstd + bv[bj][1];
                        v4u w; w.x = pg8::cvt_pk_bf16(v0[0], v0[1]); w.y = pg8::cvt_pk_bf16(v0[2], v0[3]); w.z = pg8::cvt_pk_bf16(v1[0], v1[1]); w.w = pg8::cvt_pk_bf16(v1[2], v1[3]);
                        *(v4u*)(zmix + (size_t)row * NMIXP + col0 + bj * 128) = w;
                    }
                }
            }
    }
};
struct EpiPartial {
    static constexpr bool PERM = true;
    float* part;
    __device__ __forceinline__ void operator()(const pg8::f32x4 (&acc)[2][2][4][2], const pg8::Unit& u, int, int, int, int) const {
        int t_ = threadIdx.x; asm volatile("" : "+v"(t_));
        const int slot = blockIdx.x;
        float* p = part + (size_t)slot * 65536 + (size_t)t_ * 4;
#pragma unroll
        for (int ai = 0; ai < 2; ++ai)
#pragma unroll
            for (int bj = 0; bj < 2; ++bj)
#pragma unroll
                for (int m = 0; m < 4; ++m)
#pragma unroll
                    for (int n = 0; n < 2; ++n) *(pg8::f32x4*)(p + (size_t)((((ai * 2 + bj) * 4 + m) * 2 + n) * 2048)) = acc[ai][bj][m][n];
        (void)u;
    }
};
__device__ __forceinline__ void tail_group_sync(unsigned* cnt, unsigned target, unsigned* bar) {
    asm volatile("s_waitcnt vmcnt(0)" ::: "memory");
    __syncthreads();
    if (threadIdx.x == 0) {
        __builtin_amdgcn_fence(__ATOMIC_RELEASE, "agent");
        asm volatile("s_waitcnt vmcnt(0)" ::: "memory");
        (void)xb_add(cnt, 1u);
        XB_SPIN(xb_ld(cnt) < target, bar);
        __builtin_amdgcn_fence(__ATOMIC_ACQUIRE, "agent");
        asm volatile("s_waitcnt vmcnt(0)" ::: "memory");
    }
    __syncthreads();
}
template <int NSPLIT, class Epi> __device__ __forceinline__ void ksp_finalize_local(const float* part, const pg8::StaticOrder& so, int limit, const Epi& E, unsigned* cnt0, unsigned* bar) {
    const int ntail = so.nwg - limit, c = blockIdx.x;
    if (c >= ntail * NSPLIT) return;
    const int tt = c / NSPLIT;
    tail_group_sync(cnt0 + 64 * tt, (unsigned)NSPLIT, bar);
    for (int j = c % NSPLIT; j < 8; j += NSPLIT) {
        const int ai = (j >> 2) & 1, m = j & 3;
        EPI_IDS();
        pg8::f32x4 a[2][2];
#pragma unroll
        for (int bj = 0; bj < 2; ++bj)
#pragma unroll
            for (int n = 0; n < 2; ++n) { pg8::f32x4 s = {0.f, 0.f, 0.f, 0.f};
#pragma unroll
                for (int k = 0; k < NSPLIT; ++k) s = s + *(const pg8::f32x4*)(part + (size_t)(tt * NSPLIT + k) * 65536 + (size_t)((((ai * 2 + bj) * 4 + m) * 2 + n) * 2048) + (size_t)t_ * 4);
                a[bj][n] = s; }
        pg8::Unit u; so.unit_of(limit + tt, u);
        E.rowgroup(a, u.pm * 256 + wr * 64 + fr + ai * 128 + m * 16, u.pn * 256 + wc * 32 + 8 * fq, u.pn, wc, fq);
    }
}
template <int NSPLIT, class Epi> __device__ __forceinline__ void ksp_finalize(const float* part, const pg8::StaticOrder& so, int limit, const Epi& E) {
    const int ntail = so.nwg - limit;
    for (int it = blockIdx.x; it < ntail * 8; it += gridDim.x) {
        const int tt = it >> 3, ai = (it >> 2) & 1, m = it & 3;
        EPI_IDS();
        pg8::f32x4 a[2][2];
#pragma unroll
        for (int bj = 0; bj < 2; ++bj)
#pragma unroll
            for (int n = 0; n < 2; ++n) { pg8::f32x4 s = {0.f, 0.f, 0.f, 0.f};
#pragma unroll
                for (int k = 0; k < NSPLIT; ++k) s = s + *(const pg8::f32x4*)(part + (size_t)(tt * NSPLIT + k) * 65536 + (size_t)((((ai * 2 + bj) * 4 + m) * 2 + n) * 2048) + (size_t)t_ * 4);
                a[bj][n] = s; }
        pg8::Unit u; so.unit_of(limit + tt, u);
        E.rowgroup(a, u.pm * 256 + wr * 64 + fr + ai * 128 + m * 16, u.pn * 256 + wc * 32 + 8 * fq, u.pn, wc, fq);
    }
}

struct EpiMergeR {
    static constexpr bool PERM = true;
    bf16* merged; const bf16* gates;
    __device__ __forceinline__ void mid(pg8::f32x4 (&acc)[2][2][4][2], const pg8::Unit& u, int seg, int) const {
        EPI_IDS();
        const int row0 = u.pm * 256 + wr * 64 + fr, col0 = u.pn * 256 + wc * 32 + 8 * fq;
#pragma unroll
        for (int ai = 0; ai < 2; ++ai) {
            v4u r[4][2];
#pragma unroll
            for (int m = 0; m < 4; ++m)
#pragma unroll
                for (int bj = 0; bj < 2; ++bj) r[m][bj] = *(const v4u*)(gates + (size_t)(row0 + ai * 128 + m * 16) * NGATE + (seg - 1) * D + col0 + bj * 128);
            __builtin_amdgcn_sched_barrier(0);
#pragma unroll
            for (int m = 0; m < 4; ++m)
#pragma unroll
                for (int bj = 0; bj < 2; ++bj) {
                    const v4u q = r[m][bj];
                    pg8::f32x4& a0 = acc[ai][bj][m][0]; pg8::f32x4& a1 = acc[ai][bj][m][1];
                    a0[0] *= bflo(q.x); a0[1] *= bfhi(q.x); a0[2] *= bflo(q.y); a0[3] *= bfhi(q.y); a1[0] *= bflo(q.z); a1[1] *= bfhi(q.z); a1[2] *= bflo(q.w); a1[3] *= bfhi(q.w);
                }
            __builtin_amdgcn_sched_barrier(0);
        }
    }
    __device__ __forceinline__ void operator()(const pg8::f32x4 (&acc)[2][2][4][2], const pg8::Unit& u, int, int, int, int) const {
        EPI_IDS();
        const int row0 = u.pm * 256 + wr * 64 + fr, col0 = u.pn * 256 + wc * 32 + 8 * fq;
#pragma unroll
        for (int ai = 0; ai < 2; ++ai) {
            v4u r[4][2];
#pragma unroll
            for (int m = 0; m < 4; ++m)
#pragma unroll
                for (int bj = 0; bj < 2; ++bj) r[m][bj] = *(const v4u*)(gates + (size_t)(row0 + ai * 128 + m * 16) * NGATE + 3 * D + col0 + bj * 128);
            __builtin_amdgcn_sched_barrier(0);
#pragma unroll
            for (int m = 0; m < 4; ++m) {
                const int row = row0 + ai * 128 + m * 16;
#pragma unroll
                for (int bj = 0; bj < 2; ++bj) {
                    const v4u g = r[m][bj];
                    const pg8::f32x4 a0 = acc[ai][bj][m][0], a1 = acc[ai][bj][m][1];
                    v4u w; w.x = pg8::cvt_pk_bf16(a0[0] * bflo(g.x), a0[1] * bfhi(g.x)); w.y = pg8::cvt_pk_bf16(a0[2] * bflo(g.y), a0[3] * bfhi(g.y));
                    w.z = pg8::cvt_pk_bf16(a1[0] * bflo(g.z), a1[1] * bfhi(g.z)); w.w = pg8::cvt_pk_bf16(a1[2] * bflo(g.w), a1[3] * bfhi(g.w));
                    *(v4u*)(merged + (size_t)row * D + col0 + bj * 128) = w;
                }
            }
            __builtin_amdgcn_sched_barrier(0);
        }
    }
};

__device__ __forceinline__ void merge_finalize_local(const float* part, const pg8::StaticOrder& so, int limit, bf16* merged, const bf16* gates, unsigned* cnt0, unsigned* bar) {
    const int ntail = so.nwg - limit, c = blockIdx.x;
    if (c >= ntail * 4) return;
    const int tt = c >> 2;
    tail_group_sync(cnt0 + 64 * tt, 4u, bar);
    pg8::Unit u; so.unit_of(limit + tt, u);
    for (int j = c & 3; j < 8; j += 4) {
        const int ai = (j >> 2) & 1, m = j & 3;
        EPI_IDS();
        const int row = u.pm * 256 + wr * 64 + fr + ai * 128 + m * 16, col0 = u.pn * 256 + wc * 32 + 8 * fq;
#pragma unroll
        for (int bj = 0; bj < 2; ++bj) {
            pg8::f32x4 a0 = {0.f, 0.f, 0.f, 0.f}, a1 = {0.f, 0.f, 0.f, 0.f};
#pragma unroll
            for (int k = 0; k < 4; ++k) {
                const float* pp = part + (size_t)(tt * 4 + k) * 65536 + (size_t)t_ * 4;
                a0 = a0 + *(const pg8::f32x4*)(pp + (size_t)((((ai * 2 + bj) * 4 + m) * 2 + 0) * 2048)); a1 = a1 + *(const pg8::f32x4*)(pp + (size_t)((((ai * 2 + bj) * 4 + m) * 2 + 1) * 2048));
                const v4u r = *(const v4u*)(gates + (size_t)row * NGATE + k * D + col0 + bj * 128);
                a0[0] *= bflo(r.x); a0[1] *= bfhi(r.x); a0[2] *= bflo(r.y); a0[3] *= bfhi(r.y); a1[0] *= bflo(r.z); a1[1] *= bfhi(r.z); a1[2] *= bflo(r.w); a1[3] *= bfhi(r.w);
            }
            v4u w; w.x = pg8::cvt_pk_bf16(a0[0], a0[1]); w.y = pg8::cvt_pk_bf16(a0[2], a0[3]); w.z = pg8::cvt_pk_bf16(a1[0], a1[1]); w.w = pg8::cvt_pk_bf16(a1[2], a1[3]);
            *(v4u*)(merged + (size_t)row * D + col0 + bj * 128) = w;
        }
    }
}
__host__ __device__ __forceinline__ int gate_col(int m) { const int br = m >> 10, d = m & 1023, dd = d & 63; return 256 * (d >> 6) + 128 * (br >> 1) + 32 * (dd >> 4) + 8 * ((dd >> 2) & 3) + 4 * (br & 1) + (dd & 3); }
__host__ __device__ __forceinline__ int gate_src(int c) { const int ct = c & 255, br = 2 * (ct >> 7) + ((ct >> 2) & 1), d = 64 * (c >> 8) + 16 * ((ct >> 5) & 3) + 4 * ((ct >> 3) & 3) + (ct & 3); return br * 1024 + d; }
struct RowMap { int mode, a; __device__ __forceinline__ int operator()(int n) const { return mode == 0 ? n + a : (mode == 1 ? 256 * (n >> 7) + (n & 127) + a : (n < NMIX ? n : NMIXP + gate_col(n - NMIX))); } };
__device__ __forceinline__ void tr_item(const float* W, int K, int N, const float* gain, bf16* WT, int pitch, RowMap rm, LAS float* scr, int kb, int nb, int lane) {
    const int k0 = 64 * kb, n0 = 64 * nb; const int nn = n0 + 4 * (lane & 15), kr = lane >> 4;
    f32x4 v[16];
#pragma unroll
    for (int i = 0; i < 16; ++i) v[i] = (nn < N) ? *(const f32x4*)(W + (size_t)(k0 + 4 * i + kr) * N + nn) : (f32x4){0.f, 0.f, 0.f, 0.f};
#pragma unroll
    for (int i = 0; i < 16; ++i) { const int kk = 4 * i + kr; const float g = gain ? gain[k0 + kk] : 1.0f; LAS float* d = scr + kk * 65 + 4 * (lane & 15); d[0] = v[i][0] * g; d[1] = v[i][1] * g; d[2] = v[i][2] * g; d[3] = v[i][3] * g; }
    LDS_WAIT(); asm volatile("" ::: "memory");
    const int c = lane & 7;
#pragma unroll
    for (int j = 0; j < 8; ++j) { const int nl = (lane >> 3) + 8 * j; const int n = n0 + nl; const LAS float* s = scr + (8 * c) * 65 + nl;
        v4u o; o.x = pg8::cvt_pk_bf16(s[0 * 65], s[1 * 65]); o.y = pg8::cvt_pk_bf16(s[2 * 65], s[3 * 65]); o.z = pg8::cvt_pk_bf16(s[4 * 65], s[5 * 65]); o.w = pg8::cvt_pk_bf16(s[6 * 65], s[7 * 65]);
        if (n < N) *(v4u*)(WT + (size_t)rm(n) * pitch + k0 + 8 * c) = o; }
    LDS_WAIT(); asm volatile("" ::: "memory");
}
__device__ __forceinline__ void p0_prologue(const Ctx& C, const Params& P) {
    THREAD_IDS();
    LAS float* scr = (LAS float*)(C.lds + RING_OFF + wave * 16896);
    constexpr int I_FF = 16 * 44, I_DN = 44 * 16, I_IN = 16 * 113, I_BR = 4 * 4 * 16, I_OUT = 16 * 16;
    constexpr int PER_LAYER = 4 * I_FF + 2 * I_DN + I_IN + I_BR + I_OUT;
    for (int it = gw; it < DEPTH * PER_LAYER; it += NGW) {
        const int l = it / PER_LAYER; int r = it - l * PER_LAYER;
        bf16* W1a = WSP(bf16, WS_W1 + (size_t)(l * 2 + 0) * SZ_W1); bf16* W1b = WSP(bf16, WS_W1 + (size_t)(l * 2 + 1) * SZ_W1);
        bf16* Wda = WSP(bf16, WS_WD + (size_t)(l * 2 + 0) * SZ_WD); bf16* Wdb = WSP(bf16, WS_WD + (size_t)(l * 2 + 1) * SZ_WD);
        if (r < I_FF) { tr_item(C.in[I_F1G] + (size_t)l * D * DFF, D, DFF, C.in[I_NF1] + l * D, W1a, D, RowMap{1, 0}, scr, r / 44, r % 44, lane); continue; } r -= I_FF;
        if (r < I_FF) { tr_item(C.in[I_F1U] + (size_t)l * D * DFF, D, DFF, C.in[I_NF1] + l * D, W1a, D, RowMap{1, 128}, scr, r / 44, r % 44, lane); continue; } r -= I_FF;
        if (r < I_DN) { tr_item(C.in[I_F1D] + (size_t)l * D * DFF, DFF, D, nullptr, Wda, DFF, RowMap{0, 0}, scr, r / 16, r % 16, lane); continue; } r -= I_DN;
        if (r < I_FF) { tr_item(C.in[I_F2G] + (size_t)l * D * DFF, D, DFF, C.in[I_NF2] + l * D, W1b, D, RowMap{1, 0}, scr, r / 44, r % 44, lane); continue; } r -= I_FF;
        if (r < I_FF) { tr_item(C.in[I_F2U] + (size_t)l * D * DFF, D, DFF, C.in[I_NF2] + l * D, W1b, D, RowMap{1, 128}, scr, r / 44, r % 44, lane); continue; } r -= I_FF;
        if (r < I_DN) { tr_item(C.in[I_F2D] + (size_t)l * D * DFF, DFF, D, nullptr, Wdb, DFF, RowMap{0, 0}, scr, r / 16, r % 16, lane); continue; } r -= I_DN;
        if (r < I_IN) { tr_item(C.in[I_WIN] + (size_t)l * D * NIN, D, NIN, C.in[I_NMIX] + l * D, WSP(bf16, WS_WIN + (size_t)l * SZ_WIN), D, RowMap{2, 0}, scr, r / 113, r % 113, lane); continue; } r -= I_IN;
        if (r < I_BR) { const int n4 = r / 64, rr = r % 64; tr_item(C.in[I_WBR] + (size_t)(l * 4 + n4) * 256 * D, 256, D, nullptr, WSP(bf16, WS_WBR + (size_t)l * SZ_WBR) + n4 * 256, D, RowMap{0, 0}, scr, rr / 16, rr % 16, lane); continue; } r -= I_BR;
        tr_item(C.in[I_WOUT] + (size_t)l * D * D, D, D, nullptr, WSP(bf16, WS_WOUT + (size_t)l * SZ_WOUT), D, RowMap{0, 0}, scr, r / 16, r % 16, lane);
    }
    const int gt = gw * 64 + lane, NGT = NGW * 64;
    for (int i = gt; i < 2 * 240 * 128; i += NGT) { const int l = i / (240 * 128), r = i % (240 * 128); *(v4u*)(C.ws + WS_WIN + (size_t)l * SZ_WIN + ((size_t)NMIX * D) * 2 + (size_t)r * 16) = (v4u){0u, 0u, 0u, 0u}; }
    for (int i = gt; i < (M - MR) * 128; i += NGT) *(v4u*)(C.ws + WS_BR + (size_t)MR * D * 2 + (size_t)i * 16) = (v4u){0u, 0u, 0u, 0u};
    for (int i = gt; i < 2 * NINP; i += NGT) { const int l = i / NINP, j = i % NINP; float v = 0.f; if (j < NMIX) v = C.in[I_BIN][l * NIN + j]; else if (j >= NMIXP) v = C.in[I_BIN][l * NIN + NMIX + gate_src(j - NMIXP)]; WSP(float, WS_BINP)[i] = v; }
    for (int i = gt; i < NPOS * 32; i += NGT) { const int pi = i >> 5, fi = i & 31; const int pos = pi < L ? pi : PAST + (pi - L);
        const float angf = (float)pos * P.inv_freq[fi];
        const double a = (double)angf; const double k = rint(a * 0.15915494309189535); const double rr = (a - k * 6.283185307179586) - k * 2.4492935982947064e-16;
        const float rf = (float)rr; WSP(float, WS_ROPE)[i] = cosf(rf); WSP(float, WS_ROPE)[NPOS * 32 + i] = sinf(rf); }
    float* H = WSP(float, WS_H); bf16* HB = WSP(bf16, WS_HB); float* SS0 = WSP(float, WS_SS);
    for (int row = gw; row < M; row += NGW) {
        const float* src = nullptr;
        if (row < MP) { const int b = row / L, pos = row - b * L; src = pos < NMETA ? C.in[I_META] + (size_t)pos * D : C.in[I_XP] + ((size_t)b * SEQ + (pos - NMETA)) * D; }
        else if (row < MR) src = C.in[I_XS] + (size_t)(row - MP) * D;
        float s = 0.f;
#pragma unroll
        for (int j = 0; j < 4; ++j) { f32x4 v = src ? *(const f32x4*)(src + 256 * j + 4 * lane) : (f32x4){0.f, 0.f, 0.f, 0.f};
            s += (v[0] * v[0] + v[1] * v[1]) + (v[2] * v[2] + v[3] * v[3]);
            unsigned long long w = (unsigned long long)pk2(v[0], v[1]) | ((unsigned long long)pk2(v[2], v[3]) << 32);
            *(unsigned long long*)(HB + (size_t)row * D + 256 * j + 4 * lane) = w; }
        s = wave_sum(s); if (lane < 16) SS0[(size_t)row * 16 + lane] = lane == 0 ? s : 0.f;
    }
}

__device__ __forceinline__ float lam_of(const Ctx& C, int l, float lam_init) {
    THREAD_IDS();
    float a = 0.f, b = 0.f;
#pragma unroll 1
    for (int i = 0; i < 32; ++i) { a += C.in[I_LQ1][l * 32 + i] * C.in[I_LK1][l * 32 + i]; b += C.in[I_LQ2][l * 32 + i] * C.in[I_LK2][l * 32 + i]; }
    return __expf(a) - __expf(b) + lam_init;
}
__device__ __forceinline__ int t5_bucket(int n) {
    if (n < 16) return n;
    return 16 + (n >= 19) + (n >= 21) + (n >= 24) + (n >= 27) + (n >= 31) + (n >= 35) + (n >= 40) + (n >= 46) + (n >= 52) + (n >= 59) + (n >= 67) + (n >= 77) + (n >= 87) + (n >= 99) + (n >= 113);
}
__device__ __forceinline__ void unpack8(const v4u w, float (&x)[8]) { x[0] = bflo(w.x); x[1] = bfhi(w.x); x[2] = bflo(w.y); x[3] = bfhi(w.y); x[4] = bflo(w.z); x[5] = bfhi(w.z); x[6] = bflo(w.w); x[7] = bfhi(w.w); }
__device__ __forceinline__ v4u pack8(const float (&x)[8]) { v4u w; w.x = pg8::cvt_pk_bf16(x[0], x[1]); w.y = pg8::cvt_pk_bf16(x[2], x[3]); w.z = pg8::cvt_pk_bf16(x[4], x[5]); w.w = pg8::cvt_pk_bf16(x[6], x[7]); return w; }
__device__ __forceinline__ void n1_prep(const Ctx& C, int l) {
    THREAD_IDS();
    const bf16* ZM = WSP(bf16, WS_ZMIX); float* UB = WSP(float, WS_UBUF); float* RQ = WSP(float, WS_RQ); float* RK = WSP(float, WS_RK);
    float* LD = WSP(float, WS_LDEC); const float* COS = WSP(float, WS_ROPE); const float* SIN = COS + NPOS * 32; bf16* QNB = WSP(bf16, WS_QNB); bf16* KNB = WSP(bf16, WS_KNB);
    const int i = lane & 31;
    float qg[8], kg[8];
#pragma unroll
    for (int j = 0; j < 8; ++j) { qg[j] = C.in[I_QN][l * 32 + ((8 * i) & 31) + j] * (0.17677669529663687f * 1.4426950408889634f); kg[j] = C.in[I_KN][l * 32 + ((8 * i) & 31) + j]; }
    const int isk = i >> 4, hh = (i >> 2) & 3, jc = i & 3;
    for (int rp0 = gw * 2; rp0 < MR / 2; rp0 += NGW * 2) {
        v4u Wa[2], Wg[2], Wq[2], Wk[2], Wv[2], W1[2], W2[2], G0[2], G1[2];
#pragma unroll
        for (int u = 0; u < 2; ++u) { const int r = min(2 * (rp0 + u) + (lane >> 5), MR - 1); const bf16* z = ZM + (size_t)r * NMIXP; const bf16* zr = z + (isk ? R_K : R_Q) + hh * 64 + 8 * jc;
            Wa[u] = *(const v4u*)(z + C_A + 8 * i); Wg[u] = *(const v4u*)(z + C_G + 8 * i); Wq[u] = *(const v4u*)(z + D_Q + 8 * i); Wk[u] = *(const v4u*)(z + D_K + 8 * i); Wv[u] = *(const v4u*)(z + D_V + 8 * i);
            W1[u] = *(const v4u*)zr; W2[u] = *(const v4u*)(zr + 32); G0[u] = *(const v4u*)(z + G_LOW); G1[u] = *(const v4u*)(z + G_LOW + 8); }
#pragma unroll
        for (int u = 0; u < 2; ++u) {
        if (rp0 + u >= MR / 2) break;
        const int r = 2 * (rp0 + u) + (lane >> 5);
        const int pi = r < MP ? r % L : L + ((r - MP) & 7);
        float* kout = r < MP ? C.out + O_KP + ((size_t)l * MP + r) * 256 : C.out + O_KS + ((size_t)l * MS + (r - MP)) * 256;
        float* vout = r < MP ? C.out + O_VP + ((size_t)l * MP + r) * 256 : C.out + O_VS + ((size_t)l * MS + (r - MP)) * 256;
        const v4u wa = Wa[u], wg = Wg[u], wq = Wq[u], wk = Wk[u], wv = Wv[u], w1 = W1[u], w2 = W2[u], gl0 = G0[u], gl1 = G1[u];
        float x[8], y[8];
        unpack8(wa, x); unpack8(wg, y);
#pragma unroll
        for (int j = 0; j < 8; ++j) x[j] *= sigmoidf_(y[j]);
        *(f32x4*)(UB + (size_t)r * 256 + 8 * i) = (f32x4){x[0], x[1], x[2], x[3]}; *(f32x4*)(UB + (size_t)r * 256 + 8 * i + 4) = (f32x4){x[4], x[5], x[6], x[7]};
        unpack8(wv, x);
        *(f32x4*)(vout + 8 * i) = (f32x4){x[0], x[1], x[2], x[3]}; *(f32x4*)(vout + 8 * i + 4) = (f32x4){x[4], x[5], x[6], x[7]};
        unpack8(wq, x);
        { float s = 0.f;
#pragma unroll
          for (int j = 0; j < 8; ++j) s += x[j] * x[j];
          s += __shfl_xor(s, 1); s += __shfl_xor(s, 2); const float rs = rsqrtf(s * (1.0f / 32) + EPS);
#pragma unroll
          for (int j = 0; j < 8; ++j) x[j] = x[j] * rs * qg[j];
          *(v4u*)(QNB + (size_t)r * 256 + 8 * i) = pack8(x); }
        unpack8(wk, x);
        { float s = 0.f;
#pragma unroll
          for (int j = 0; j < 8; ++j) s += x[j] * x[j];
          s += __shfl_xor(s, 1); s += __shfl_xor(s, 2); const float rs = rsqrtf(s * (1.0f / 32) + EPS);
#pragma unroll
          for (int j = 0; j < 8; ++j) x[j] = x[j] * rs * kg[j];
          *(v4u*)(KNB + (size_t)r * 256 + 8 * i) = pack8(x);
          *(f32x4*)(kout + 8 * i) = (f32x4){x[0], x[1], x[2], x[3]}; *(f32x4*)(kout + 8 * i + 4) = (f32x4){x[4], x[5], x[6], x[7]}; }
        unpack8(w1, x); unpack8(w2, y);
        { const f32x4 c0 = *(const f32x4*)(COS + pi * 32 + 8 * jc), c1 = *(const f32x4*)(COS + pi * 32 + 8 * jc + 4), s0 = *(const f32x4*)(SIN + pi * 32 + 8 * jc), s1 = *(const f32x4*)(SIN + pi * 32 + 8 * jc + 4);
          const float sc = isk ? 0.125f : 1.0f; float o1[8], o2[8];
#pragma unroll
          for (int j = 0; j < 8; ++j) { const float cs = j < 4 ? c0[j & 3] : c1[j & 3], sn = j < 4 ? s0[j & 3] : s1[j & 3]; o1[j] = (x[j] * cs - y[j] * sn) * sc; o2[j] = (x[j] * sn + y[j] * cs) * sc; }
          float* ro = (isk ? RK : RQ) + (size_t)r * 256 + hh * 64 + 8 * jc;
          *(f32x4*)ro = (f32x4){o1[0], o1[1], o1[2], o1[3]}; *(f32x4*)(ro + 4) = (f32x4){o1[4], o1[5], o1[6], o1[7]}; *(f32x4*)(ro + 32) = (f32x4){o2[0], o2[1], o2[2], o2[3]}; *(f32x4*)(ro + 36) = (f32x4){o2[4], o2[5], o2[6], o2[7]}; }
        { float gv[16]; unpack8(gl0, x); unpack8(gl1, y);
#pragma unroll
          for (int j = 0; j < 8; ++j) { gv[j] = x[j]; gv[8 + j] = y[j]; }
          f32x4 gp = *(const f32x4*)(C.in[I_GAB] + l * 128 + 4 * i);
#pragma unroll
          for (int k = 0; k < 16; ++k) { const f32x4 aw = *(const f32x4*)(C.in[I_GAW] + (size_t)(l * 16 + k) * 128 + 4 * i); gp = gp + aw * gv[k]; }
          f32x4 ls;
#pragma unroll
          for (int j = 0; j < 4; ++j) ls[j] = (fminf(gp[j], 0.f) - log1pf(__expf(-fabsf(gp[j])))) * (1.0f / 16.0f);
          *(f32x4*)(LD + (size_t)r * 128 + 4 * i) = ls; }
        }
    }
}
__device__ __forceinline__ void conv_rows_item(const Ctx& C, int l, int item) {
    THREAD_IDS();
    const float* UB = WSP(float, WS_UBUF); bf16* BR = WSP(bf16, WS_BR);
    const float* cw = C.in[I_CW] + (size_t)l * 31 * 256; const float* sc = C.in[I_SCONV];
    LAS float* wl = (LAS float*)C.lds;
    for (int i = tid; i < 31 * 256; i += NWAVES * 64) wl[i] = cw[i];
    LDS_WAIT(); __builtin_amdgcn_s_barrier(); asm volatile("" ::: "memory");
    const int r0 = item * 64 + wave * 8;
    if (r0 < MR) {
        const bool smp = r0 >= MP; const int b = smp ? (r0 - MP) >> 3 : r0 / L; const int p0 = smp ? 0 : r0 - b * L; const int rb = smp ? MP + b * 8 : b * L;
        const LAS f32x4* wl4 = (const LAS f32x4*)wl + lane;
        float acc[8][4];
        { const f32x4 cb = *(const f32x4*)(C.in[I_CB] + l * 256 + 4 * lane);
#pragma unroll
          for (int i = 0; i < 8; ++i)
#pragma unroll
              for (int k = 0; k < 4; ++k) acc[i][k] = cb[k]; }
#pragma unroll 1
        for (int jb = 0; jb < 40; jb += 8) {
            float uv[8][4];
#pragma unroll
            for (int jj = 0; jj < 8; ++jj) { const int j = jb + jj; const int q = p0 - 30 + j;
                const float* src = q >= 0 ? UB + (size_t)(rb + q) * 256 + 4 * lane : sc + (((size_t)l * DB + b) * 30 + (q + 30)) * 256 + 4 * lane;
                const bool ok = j < 38 && (q >= 0 || smp);
                const f32x4 v = ok ? *(const f32x4*)src : (f32x4){0.f, 0.f, 0.f, 0.f};
#pragma unroll
                for (int k = 0; k < 4; ++k) uv[jj][k] = v[k]; }
#pragma unroll
            for (int jj = 0; jj < 8; ++jj)
#pragma unroll
                for (int i = 0; i < 8; ++i) { const int t = jb + jj - i;
                    if (t >= 0 && t <= 30) { const f32x4 w = wl4[t * 64];
#pragma unroll
                        for (int k = 0; k < 4; ++k) acc[i][k] += w[k] * uv[jj][k]; } }
        }
        const f32x4 lg = *(const f32x4*)(C.in[I_CLG] + l * 256 + 4 * lane), lb = *(const f32x4*)(C.in[I_CLB] + l * 256 + 4 * lane);
#pragma unroll
        for (int i = 0; i < 8; ++i) { const int r = r0 + i;
            float s = (acc[i][0] + acc[i][1]) + (acc[i][2] + acc[i][3]); const float mean = wave_sum(s) * (1.0f / 256);
            float q2 = 0.f;
#pragma unroll
            for (int k = 0; k < 4; ++k) { acc[i][k] -= mean; q2 += acc[i][k] * acc[i][k]; }
            const float rstd = rsqrtf(wave_sum(q2) * (1.0f / 256) + EPS);
            float y[4];
#pragma unroll
            for (int k = 0; k < 4; ++k) y[k] = siluf_(acc[i][k] * rstd * lg[k] + lb[k]);
            *(unsigned long long*)(BR + (size_t)r * D + 4 * lane) = (unsigned long long)pk2(y[0], y[1]) | ((unsigned long long)pk2(y[2], y[3]) << 32); }
    }
    LDS_WAIT(); __builtin_amdgcn_s_barrier(); asm volatile("" ::: "memory");
}
__device__ __forceinline__ void conv_state_item(const Ctx& C, int l, int part, int nparts) {
    THREAD_IDS();
    const float* UB = WSP(float, WS_UBUF); const float* sc = C.in[I_SCONV];
    for (int i = part * NWAVES * 64 + tid; i < BATCH * 30 * 256; i += nparts * NWAVES * 64) { const int c = i & 255, ii = (i >> 8) % 30, b = i / (30 * 256); C.out[O_CP + (size_t)l * BATCH * 30 * 256 + i] = UB[(size_t)(b * L + L - 30 + ii) * 256 + c]; }
    for (int i = part * NWAVES * 64 + tid; i < DB * 30 * 256; i += nparts * NWAVES * 64) { const int c = i & 255, ii = (i >> 8) % 30, b = i / (30 * 256);
        C.out[O_CS + (size_t)l * DB * 30 * 256 + i] = ii < 22 ? sc[(((size_t)l * DB + b) * 30 + 8 + ii) * 256 + c] : UB[(size_t)(MP + b * 8 + ii - 22) * 256 + c]; }
}
template <int DK, bool RET> __device__ __forceinline__ void la_seq(const Ctx& C, int l, bool smp, int b, int h) {
    THREAD_IDS();
    const bf16* ZM = WSP(bf16, WS_ZMIX); const float* RQ = WSP(float, WS_RQ); const float* RK = WSP(float, WS_RK); const float* LD = WSP(float, WS_LDEC); bf16* BR = WSP(bf16, WS_BR);
    const int nt = smp ? DS : L; const int row0 = smp ? MP + b * DS : b * L;
    float S[DK];
    if (smp) { const float* s0 = (RET ? C.in[I_SRET] : C.in[I_SGLA]) + (((size_t)l * DB + b) * 4 + h) * DK * 64;
#pragma unroll
        for (int k = 0; k < DK; ++k) S[k] = s0[k * 64 + lane]; }
    else {
#pragma unroll
        for (int k = 0; k < DK; ++k) S[k] = 0.f; }
    const float gamma = 1.0f - exp2f(-5.0f - (float)h);
    const float gn = RET ? C.in[I_RGN][(l * 4 + h) * 64 + lane] : C.in[I_GGN][(l * 4 + h) * 64 + lane];
    for (int t = 0; t < nt; ++t) {
        const int r = row0 + t; const bf16* z = ZM + (size_t)r * NMIXP;
        float ql, kl, dl = 1.f;
        if (RET) { ql = RQ[(size_t)r * 256 + h * 64 + lane]; kl = RK[(size_t)r * 256 + h * 64 + lane]; }
        else { const int lk = lane & 31; ql = bf2f(z[G_Q + h * 32 + lk]) * 0.17677669529663687f; kl = bf2f(z[G_K + h * 32 + lk]); dl = __expf(LD[(size_t)r * 128 + h * 32 + lk]); }
        const float v = bf2f(z[(RET ? R_V : G_V) + h * 64 + lane]);
        float o = 0.f;
#pragma unroll
        for (int k = 0; k < DK; ++k) { const float qk = __shfl(ql, k), kk = __shfl(kl, k); const float dk = RET ? gamma : __shfl(dl, k);
            S[k] = dk * S[k] + kk * v; o += qk * S[k]; if ((k & 7) == 7) __builtin_amdgcn_sched_barrier(0); }
        float y;
        if (RET) { const float mean = wave_sum(o) * (1.0f / 64); const float d = o - mean; const float var = wave_sum(d * d) * (1.0f / 64); y = d * rsqrtf(var + EPS) * gn; }
        else { const float ms = wave_sum(o * o) * (1.0f / 64); y = o * rsqrtf(ms + EPS) * gn; }
        const float g = bf2f(z[(RET ? R_G : G_R) + h * 64 + lane]);
        BR[(size_t)r * D + (RET ? 256 : 512) + h * 64 + lane] = (bf16)f2bf(siluf_(g) * y);
    }
    float* so = C.out + (RET ? (smp ? O_RS + (((size_t)l * DB + b) * 4 + h) * DK * 64 : O_RP + (((size_t)l * BATCH + b) * 4 + h) * DK * 64)
                             : (smp ? O_GS + (((size_t)l * DB + b) * 4 + h) * DK * 64 : O_GP + (((size_t)l * BATCH + b) * 4 + h) * DK * 64));
#pragma unroll
    for (int k = 0; k < DK; ++k) so[k * 64 + lane] = S[k];
}
typedef short bf16x8_t __attribute__((ext_vector_type(8)));
template <int DK, bool RET> __device__ __forceinline__ void la_chunked(const Ctx& C, int l, bool smp, int b, int h) {
    THREAD_IDS();
    constexpr int QS = DK + 8, TS = 72, NKB = DK / 16, NKS = DK / 32;
    constexpr int SB = 2 * 64 * QS + 64 * TS + DK * TS + 64 * TS + 64;
    LAS bf16* SB0 = (LAS bf16*)(C.lds);
    LAS bf16* AL = SB0 + 2 * SB;
    LAS bf16* ST = AL + 64 * TS;
    const bf16* ZM = WSP(bf16, WS_ZMIX); const float* RQ = WSP(float, WS_RQ); const float* RK = WSP(float, WS_RK); const float* LD = WSP(float, WS_LDEC); bf16* BR = WSP(bf16, WS_BR);
    const int nt = smp ? DS : L, row0 = smp ? MP + b * DS : b * L, nch = (nt + 63) >> 6;
    const float lg2 = RET ? log2f(1.0f - exp2f(-5.0f - (float)h)) : 0.f;
    const int g4 = lane >> 4, c16 = lane & 15;
    const bool qwave = wave < 4; const int w4 = wave & 3;
    float Sreg[NKB][4];
    if (wave >= 4) {
        const float* s0 = (RET ? C.in[I_SRET] : C.in[I_SGLA]) + (((size_t)l * DB + b) * 4 + h) * DK * 64;
#pragma unroll
        for (int cb = 0; cb < NKB; ++cb)
#pragma unroll
            for (int r = 0; r < 4; ++r) { const int dk = cb * 16 + c16, dv = (wave - 4) * 16 + 4 * g4 + r; const float v = smp ? s0[dk * 64 + dv] : 0.f; Sreg[cb][r] = v; ST[dv * QS + dk] = (bf16)f2bf(v); }
    }
    float gnv[4];
#pragma unroll
    for (int cb = 0; cb < 4; ++cb) gnv[cb] = (RET ? C.in[I_RGN] : C.in[I_GGN])[(l * 4 + h) * 64 + cb * 16 + c16];
    float a[16]; v4u vr;
#define LA_LOAD(c) do { const size_t r_ = (size_t)(row0 + (c) * 64 + lane); const bf16* z_ = ZM + r_ * NMIXP; \
        vr = *(const v4u*)(z_ + (RET ? R_V : G_V) + h * 64 + 8 * wave); \
        if (RET) { const float* p_ = (qwave ? RQ : RK) + r_ * 256 + h * 64 + 8 * w4; const f32x4 x0 = *(const f32x4*)p_, x1 = *(const f32x4*)(p_ + 4), x2 = *(const f32x4*)(p_ + 32), x3 = *(const f32x4*)(p_ + 36); \
            a[0] = x0[0]; a[1] = x0[1]; a[2] = x0[2]; a[3] = x0[3]; a[4] = x1[0]; a[5] = x1[1]; a[6] = x1[2]; a[7] = x1[3]; a[8] = x2[0]; a[9] = x2[1]; a[10] = x2[2]; a[11] = x2[3]; a[12] = x3[0]; a[13] = x3[1]; a[14] = x3[2]; a[15] = x3[3]; } \
        else { const v4u q_ = *(const v4u*)(z_ + (qwave ? G_Q : G_K) + h * 32 + 8 * w4); const float* p_ = LD + r_ * 128 + h * 32 + 8 * w4; const f32x4 x0 = *(const f32x4*)p_, x1 = *(const f32x4*)(p_ + 4); \
            a[0] = bflo(q_.x); a[1] = bfhi(q_.x); a[2] = bflo(q_.y); a[3] = bfhi(q_.y); a[4] = bflo(q_.z); a[5] = bfhi(q_.z); a[6] = bflo(q_.w); a[7] = bfhi(q_.w); \
            a[8] = x0[0]; a[9] = x0[1]; a[10] = x0[2]; a[11] = x0[3]; a[12] = x1[0]; a[13] = x1[1]; a[14] = x1[2]; a[15] = x1[3]; } } while (0)
    LA_LOAD(0);
    int cur = 0;
    for (int i = 0; i <= nch; ++i) {
        if (i < nch) {
            const int c = i; LAS bf16* QT = SB0 + (i & 1) * SB; LAS bf16* KT = QT + 64 * QS; LAS bf16* VT = KT + 64 * QS; LAS bf16* KE = VT + 64 * TS; LAS bf16* GT = KE + DK * TS; LAS float* WT = (LAS float*)(GT + 64 * TS);
            const int nvc = min(64, nt - c * 64); const bool valid = lane < nvc;
        if (RET) {
            const float tq = (float)(lane + 1);
            if (qwave) { const float e = valid ? __builtin_amdgcn_exp2f(lg2 * tq) : 0.f;
                v4u w0, w1; w0.x = pg8::cvt_pk_bf16(a[0] * e, a[1] * e); w0.y = pg8::cvt_pk_bf16(a[2] * e, a[3] * e); w0.z = pg8::cvt_pk_bf16(a[4] * e, a[5] * e); w0.w = pg8::cvt_pk_bf16(a[6] * e, a[7] * e);
                w1.x = pg8::cvt_pk_bf16(a[8] * e, a[9] * e); w1.y = pg8::cvt_pk_bf16(a[10] * e, a[11] * e); w1.z = pg8::cvt_pk_bf16(a[12] * e, a[13] * e); w1.w = pg8::cvt_pk_bf16(a[14] * e, a[15] * e);
                *(LAS v4u*)(QT + lane * QS + 8 * w4) = w0; *(LAS v4u*)(QT + lane * QS + 32 + 8 * w4) = w1; }
            else { const float e = valid ? __builtin_amdgcn_exp2f(-lg2 * tq) : 0.f, ee = valid ? __builtin_amdgcn_exp2f(lg2 * ((float)nvc - tq)) : 0.f;
                v4u w0, w1; w0.x = pg8::cvt_pk_bf16(a[0] * e, a[1] * e); w0.y = pg8::cvt_pk_bf16(a[2] * e, a[3] * e); w0.z = pg8::cvt_pk_bf16(a[4] * e, a[5] * e); w0.w = pg8::cvt_pk_bf16(a[6] * e, a[7] * e);
                w1.x = pg8::cvt_pk_bf16(a[8] * e, a[9] * e); w1.y = pg8::cvt_pk_bf16(a[10] * e, a[11] * e); w1.z = pg8::cvt_pk_bf16(a[12] * e, a[13] * e); w1.w = pg8::cvt_pk_bf16(a[14] * e, a[15] * e);
                *(LAS v4u*)(KT + lane * QS + 8 * w4) = w0; *(LAS v4u*)(KT + lane * QS + 32 + 8 * w4) = w1;
#pragma unroll
                for (int i = 0; i < 16; i += 2) { const unsigned mine = pg8::cvt_pk_bf16(a[i] * ee, a[i + 1] * ee); const unsigned pv = (unsigned)__shfl_xor((int)mine, 1);
                    const unsigned w = (lane & 1) ? ((pv >> 16) | (mine & 0xffff0000u)) : ((mine & 0xffffu) | (pv << 16));
                    const int row = (i < 8 ? 8 * w4 + i : 32 + 8 * w4 + (i - 8)) + (lane & 1);
                    *(LAS unsigned*)(KE + row * TS + (lane & ~1)) = w; } }
        } else {
            float bb[8];
#pragma unroll
            for (int i = 0; i < 8; ++i) bb[i] = valid ? a[8 + i] : 0.f;
#pragma unroll
            for (int i = 0; i < 8; ++i) { float x = bb[i];
                x += __builtin_bit_cast(float, __builtin_amdgcn_mov_dpp(__builtin_bit_cast(int, x), 0x111, 0xf, 0xf, true));
                x += __builtin_bit_cast(float, __builtin_amdgcn_mov_dpp(__builtin_bit_cast(int, x), 0x112, 0xf, 0xf, true));
                x += __builtin_bit_cast(float, __builtin_amdgcn_mov_dpp(__builtin_bit_cast(int, x), 0x114, 0xf, 0xf, true));
                x += __builtin_bit_cast(float, __builtin_amdgcn_mov_dpp(__builtin_bit_cast(int, x), 0x118, 0xf, 0xf, true));
                const float t0 = __builtin_bit_cast(float, __builtin_amdgcn_readlane(__builtin_bit_cast(int, x), 15)), t1 = __builtin_bit_cast(float, __builtin_amdgcn_readlane(__builtin_bit_cast(int, x), 31)), t2 = __builtin_bit_cast(float, __builtin_amdgcn_readlane(__builtin_bit_cast(int, x), 47));
                bb[i] = x + (lane >= 16 ? t0 : 0.f) + (lane >= 32 ? t1 : 0.f) + (lane >= 48 ? t2 : 0.f); }
            if (qwave) {
                if (lane == 63) {
#pragma unroll
                    for (int i = 0; i < 8; ++i) WT[8 * w4 + i] = bb[i]; }
                float o8[8];
#pragma unroll
                for (int i = 0; i < 8; ++i) o8[i] = valid ? a[i] * 0.17677669529663687f * __expf(bb[i]) : 0.f;
                v4u w0; w0.x = pg8::cvt_pk_bf16(o8[0], o8[1]); w0.y = pg8::cvt_pk_bf16(o8[2], o8[3]); w0.z = pg8::cvt_pk_bf16(o8[4], o8[5]); w0.w = pg8::cvt_pk_bf16(o8[6], o8[7]);
                *(LAS v4u*)(QT + lane * QS + 8 * w4) = w0;
            } else {
                float o8[8];
#pragma unroll
                for (int i = 0; i < 8; ++i) o8[i] = valid ? a[i] * __expf(-bb[i]) : 0.f;
#pragma unroll
                for (int i = 0; i < 8; i += 2) { const float t0 = __shfl(bb[i], 63), t1 = __shfl(bb[i + 1], 63);
                    const unsigned mine = pg8::cvt_pk_bf16(valid ? a[i] * __expf(t0 - bb[i]) : 0.f, valid ? a[i + 1] * __expf(t1 - bb[i + 1]) : 0.f); const unsigned pv = (unsigned)__shfl_xor((int)mine, 1);
                    const unsigned w = (lane & 1) ? ((pv >> 16) | (mine & 0xffff0000u)) : ((mine & 0xffffu) | (pv << 16));
                    *(LAS unsigned*)(KE + (8 * w4 + i + (lane & 1)) * TS + (lane & ~1)) = w; }
                v4u w0; w0.x = pg8::cvt_pk_bf16(o8[0], o8[1]); w0.y = pg8::cvt_pk_bf16(o8[2], o8[3]); w0.z = pg8::cvt_pk_bf16(o8[4], o8[5]); w0.w = pg8::cvt_pk_bf16(o8[6], o8[7]);
                *(LAS v4u*)(KT + lane * QS + 8 * w4) = w0;
            }
        }
        { const unsigned vv[4] = {valid ? vr.x : 0u, valid ? vr.y : 0u, valid ? vr.z : 0u, valid ? vr.w : 0u};
#pragma unroll
          for (int i = 0; i < 4; ++i) { const unsigned pv = (unsigned)__shfl_xor((int)vv[i], 1);
              const unsigned w = (lane & 1) ? ((pv >> 16) | (vv[i] & 0xffff0000u)) : ((vv[i] & 0xffffu) | (pv << 16));
              *(LAS unsigned*)(VT + (8 * wave + 2 * i + (lane & 1)) * TS + (lane & ~1)) = w; } }
            if (c + 1 < nch) LA_LOAD(c + 1);
        }
        if (i >= 1) {
            LAS bf16* QT = SB0 + ((i - 1) & 1) * SB; LAS bf16* KT = QT + 64 * QS;
        { const int rb = wave >> 1;
#pragma unroll
          for (int ci = 0; ci < 2; ++ci) { const int cb = (wave & 1) * 2 + ci; f32x4 acc = {0.f, 0.f, 0.f, 0.f};
              if (cb <= rb) {
#pragma unroll
                  for (int ks = 0; ks < NKS; ++ks) { const bf16x8_t af = *(const LAS bf16x8_t*)(QT + (rb * 16 + c16) * QS + ks * 32 + 8 * g4), bf = *(const LAS bf16x8_t*)(KT + (cb * 16 + c16) * QS + ks * 32 + 8 * g4);
                      acc = __builtin_amdgcn_mfma_f32_16x16x32_bf16(af, bf, acc, 0, 0, 0); } }
#pragma unroll
              for (int r = 0; r < 4; ++r) { const int tt = rb * 16 + 4 * g4 + r, ss = cb * 16 + c16; AL[tt * TS + ss] = (bf16)f2bf(ss <= tt ? acc[r] : 0.f); } } }
        }
        LDS_WAIT(); __builtin_amdgcn_s_barrier(); asm volatile("" ::: "memory");
        if (i >= 1) {
            const int c = i - 1; LAS bf16* QT = SB0 + (c & 1) * SB; LAS bf16* KT = QT + 64 * QS; LAS bf16* VT = KT + 64 * QS; LAS bf16* KE = VT + 64 * TS; LAS bf16* GT = KE + DK * TS; LAS float* WT = (LAS float*)(GT + 64 * TS);
            const int nvc = min(64, nt - c * 64); (void)KT;
        if (wave < 4) {
            const int rb = wave; const LAS bf16* STc = ST + cur * 64 * QS;
            f32x4 o[4];
#pragma unroll
            for (int cb = 0; cb < 4; ++cb) o[cb] = (f32x4){0.f, 0.f, 0.f, 0.f};
#pragma unroll
            for (int ks = 0; ks < 2; ++ks) { const bf16x8_t af = *(const LAS bf16x8_t*)(AL + (rb * 16 + c16) * TS + ks * 32 + 8 * g4);
#pragma unroll
                for (int cb = 0; cb < 4; ++cb) { const bf16x8_t bf = *(const LAS bf16x8_t*)(VT + (cb * 16 + c16) * TS + ks * 32 + 8 * g4); o[cb] = __builtin_amdgcn_mfma_f32_16x16x32_bf16(af, bf, o[cb], 0, 0, 0); } }
#pragma unroll
            for (int ks = 0; ks < NKS; ++ks) { const bf16x8_t af = *(const LAS bf16x8_t*)(QT + (rb * 16 + c16) * QS + ks * 32 + 8 * g4);
#pragma unroll
                for (int cb = 0; cb < 4; ++cb) { const bf16x8_t bf = *(const LAS bf16x8_t*)(STc + (cb * 16 + c16) * QS + ks * 32 + 8 * g4); o[cb] = __builtin_amdgcn_mfma_f32_16x16x32_bf16(af, bf, o[cb], 0, 0, 0); } }
            { float* LAO = WSP(float, WS_LAO);
#pragma unroll
              for (int r = 0; r < 4; ++r) { const int tok = c * 64 + rb * 16 + 4 * g4 + r;
                  if (tok < nt) { float* op = LAO + (size_t)(row0 + tok) * 512 + (RET ? 0 : 256) + h * 64 + c16;
#pragma unroll
                      for (int cb = 0; cb < 4; ++cb) op[cb * 16] = o[cb][r]; } } }
        } else {
            const int dvb = wave - 4; LAS bf16* STn = ST + (cur ^ 1) * 64 * QS;
            f32x4 ds[NKB];
#pragma unroll
            for (int cb = 0; cb < NKB; ++cb) ds[cb] = (f32x4){0.f, 0.f, 0.f, 0.f};
#pragma unroll
            for (int ks = 0; ks < 2; ++ks) { const bf16x8_t af = *(const LAS bf16x8_t*)(VT + (dvb * 16 + c16) * TS + ks * 32 + 8 * g4);
#pragma unroll
                for (int cb = 0; cb < NKB; ++cb) { const bf16x8_t bf = *(const LAS bf16x8_t*)(KE + (cb * 16 + c16) * TS + ks * 32 + 8 * g4); ds[cb] = __builtin_amdgcn_mfma_f32_16x16x32_bf16(af, bf, ds[cb], 0, 0, 0); } }
#pragma unroll
            for (int cb = 0; cb < NKB; ++cb) { const float eB = RET ? __builtin_amdgcn_exp2f(lg2 * (float)nvc) : __expf(WT[cb * 16 + c16]);
#pragma unroll
                for (int r = 0; r < 4; ++r) { Sreg[cb][r] = eB * Sreg[cb][r] + ds[cb][r]; STn[(dvb * 16 + 4 * g4 + r) * QS + cb * 16 + c16] = (bf16)f2bf(Sreg[cb][r]); } }
        }
            cur ^= 1;
        }
        LDS_WAIT(); __builtin_amdgcn_s_barrier(); asm volatile("" ::: "memory");
    }
#undef LA_LOAD
    if (wave >= 4) {
        float* so = C.out + (RET ? (smp ? O_RS + (((size_t)l * DB + b) * 4 + h) * DK * 64 : O_RP + (((size_t)l * BATCH + b) * 4 + h) * DK * 64)
                                 : (smp ? O_GS + (((size_t)l * DB + b) * 4 + h) * DK * 64 : O_GP + (((size_t)l * BATCH + b) * 4 + h) * DK * 64));
#pragma unroll
        for (int cb = 0; cb < NKB; ++cb)
#pragma unroll
            for (int r = 0; r < 4; ++r) so[(cb * 16 + c16) * 64 + (wave - 4) * 16 + 4 * g4 + r] = Sreg[cb][r];
    }
}
typedef float f32x16_t __attribute__((ext_vector_type(16)));
__device__ __forceinline__ int crow_(int r, int hi) { return (r & 3) + 8 * (r >> 2) + 4 * hi; }
__device__ __forceinline__ float swapmax32(float m) { auto rr = __builtin_amdgcn_permlane32_swap(__float_as_uint(m), __float_as_uint(m), false, false); return fmaxf(__uint_as_float(rr[0]), __uint_as_float(rr[1])); }
__device__ __forceinline__ float swapadd32(float m) { auto rr = __builtin_amdgcn_permlane32_swap(__float_as_uint(m), __float_as_uint(m), false, false); return __uint_as_float(rr[0]) + __uint_as_float(rr[1]); }
constexpr float LOG2E = 1.4426950408889634f;
__device__ __forceinline__ void attn_prompt_item(const Ctx& C, int l, int b, int h, int qb, float lam, float lam_init, float mb) {
    THREAD_IDS();
    constexpr int KS = 72;
    LAS bf16* Kt = (LAS bf16*)C.lds;
    LAS bf16* Vt = Kt + 2 * 64 * KS;
    LAS float* BT = (LAS float*)(Vt + 2 * 64 * KS);
    LAS float* OX = BT + 128;
    const bf16* ZM = WSP(bf16, WS_ZMIX); const bf16* QNB = WSP(bf16, WS_QNB); const bf16* KNB = WSP(bf16, WS_KNB); bf16* BR = WSP(bf16, WS_BR);
    const int r32 = lane & 31, hi = lane >> 5, qs = wave >> 1, s = wave & 1;
    const int q0 = qb * 128 + qs * 32; const int rowb = b * L;
    if (tid < 128) BT[tid] = (C.in[I_RELB][t5_bucket(tid) * 4 + h] - C.in[I_RELB][31 * 4 + h]) * LOG2E;
    pg8::bf16x8 qf[2];
#pragma unroll
    for (int d0 = 0; d0 < 2; ++d0) qf[d0] = *(const pg8::bf16x8*)(QNB + (size_t)(rowb + q0 + r32) * 256 + h * 64 + s * 32 + 16 * d0 + 8 * hi);
    const int pl = (lane & ~15) | ((lane & 8) >> 1) | ((lane & 4) << 1) | (lane & 3);
    const int NT = (min(128 * (qb + 1), L) + 63) >> 6;
    v4u kreg, vreg;
#define AT_LOAD(j) do { const size_t r_ = (size_t)(rowb + (j) * 64 + lane); kreg = *(const v4u*)(KNB + r_ * 256 + h * 64 + 8 * wave); vreg = *(const v4u*)(ZM + r_ * NMIXP + D_V + h * 64 + 8 * wave); } while (0)
#define AT_STORE(buf) do { *(LAS v4u*)(Kt + (buf) * 64 * KS + lane * KS + 8 * wave) = kreg; LAS bf16* v_ = Vt + (buf) * 64 * KS + (8 * wave) * KS + pl; \
        v_[0] = (bf16)(vreg.x & 0xffffu); v_[KS] = (bf16)(vreg.x >> 16); v_[2 * KS] = (bf16)(vreg.y & 0xffffu); v_[3 * KS] = (bf16)(vreg.y >> 16); \
        v_[4 * KS] = (bf16)(vreg.z & 0xffffu); v_[5 * KS] = (bf16)(vreg.z >> 16); v_[6 * KS] = (bf16)(vreg.w & 0xffffu); v_[7 * KS] = (bf16)(vreg.w >> 16); } while (0)
    AT_LOAD(0); AT_STORE(0); if (NT > 1) AT_LOAD(1);
    LDS_WAIT(); __builtin_amdgcn_s_barrier(); asm volatile("" ::: "memory");
    float lsum = 0.f; f32x16_t o[2]; f32x16_t negm;
#pragma unroll
    for (int i = 0; i < 16; ++i) negm[i] = -mb;
#pragma unroll
    for (int i = 0; i < 16; ++i) { o[0][i] = 0.f; o[1][i] = 0.f; }
    for (int j = 0; j < NT; ++j) {
        const int k0 = 64 * j, buf = j & 1;
        if (k0 <= q0 + 31) {
            const LAS bf16* kb = Kt + buf * 64 * KS; const LAS bf16* vb = Vt + buf * 64 * KS;
            f32x16_t p0 = negm, p1 = negm;
#pragma unroll
            for (int d0 = 0; d0 < 2; ++d0) { const pg8::bf16x8 a0 = *(const LAS pg8::bf16x8*)(kb + r32 * KS + s * 32 + 16 * d0 + 8 * hi), a1 = *(const LAS pg8::bf16x8*)(kb + (32 + r32) * KS + s * 32 + 16 * d0 + 8 * hi);
                p0 = __builtin_amdgcn_mfma_f32_32x32x16_bf16(a0, qf[d0], p0, 0, 0, 0); p1 = __builtin_amdgcn_mfma_f32_32x32x16_bf16(a1, qf[d0], p1, 0, 0, 0); }
            if (q0 - k0 - 63 < 113) {
#pragma unroll
                for (int r = 0; r < 16; ++r) { const int n0 = (q0 + r32) - (k0 + crow_(r, hi)), n1 = n0 - 32;
                    p0[r] = n0 < 0 ? -INFINITY : p0[r] + (n0 < 128 ? BT[n0] : 0.f); p1[r] = n1 < 0 ? -INFINITY : p1[r] + (n1 < 128 ? BT[n1] : 0.f); } }
            typedef float f32x2_t __attribute__((ext_vector_type(2)));
            f32x2_t ps2 = {0.f, 0.f};
#pragma unroll
            for (int r = 0; r < 16; r += 2) { p0[r] = __builtin_amdgcn_exp2f(p0[r]); p0[r + 1] = __builtin_amdgcn_exp2f(p0[r + 1]); p1[r] = __builtin_amdgcn_exp2f(p1[r]); p1[r + 1] = __builtin_amdgcn_exp2f(p1[r + 1]);
                ps2 = ps2 + (f32x2_t){p0[r], p0[r + 1]}; ps2 = ps2 + (f32x2_t){p1[r], p1[r + 1]}; }
            lsum += ps2[0] + ps2[1];
            pg8::bf16x8 pb[4];
#pragma unroll
            for (int ks = 0; ks < 4; ++ks) { v4u w;
                if (ks < 2) { w.x = pg8::cvt_pk_bf16(p0[8 * ks], p0[8 * ks + 1]); w.y = pg8::cvt_pk_bf16(p0[8 * ks + 2], p0[8 * ks + 3]); w.z = pg8::cvt_pk_bf16(p0[8 * ks + 4], p0[8 * ks + 5]); w.w = pg8::cvt_pk_bf16(p0[8 * ks + 6], p0[8 * ks + 7]); }
                else { w.x = pg8::cvt_pk_bf16(p1[8 * ks - 16], p1[8 * ks - 15]); w.y = pg8::cvt_pk_bf16(p1[8 * ks - 14], p1[8 * ks - 13]); w.z = pg8::cvt_pk_bf16(p1[8 * ks - 12], p1[8 * ks - 11]); w.w = pg8::cvt_pk_bf16(p1[8 * ks - 10], p1[8 * ks - 9]); }
                pb[ks] = __builtin_bit_cast(pg8::bf16x8, w); }
#pragma unroll
            for (int d0 = 0; d0 < 2; ++d0)
#pragma unroll
                for (int ks = 0; ks < 4; ++ks) { const pg8::bf16x8 af = *(const LAS pg8::bf16x8*)(vb + (32 * d0 + r32) * KS + 16 * ks + 8 * hi); o[d0] = __builtin_amdgcn_mfma_f32_32x32x16_bf16(af, pb[ks], o[d0], 0, 0, 0); }
        }
        if (j + 1 < NT) AT_STORE(buf ^ 1);
        if (j + 2 < NT) AT_LOAD(j + 2);
        LDS_WAIT(); __builtin_amdgcn_s_barrier(); asm volatile("" ::: "memory");
    }
#undef AT_LOAD
#undef AT_STORE
    lsum = swapadd32(lsum); const float inv = 1.0f / lsum;
    LAS float* ox = OX + (qs * 32 + r32) * 65;
    if (s == 1) {
#pragma unroll
        for (int d0 = 0; d0 < 2; ++d0)
#pragma unroll
            for (int r = 0; r < 16; ++r) ox[32 * d0 + crow_(r, hi)] = o[d0][r] * inv; }
    LDS_WAIT(); __builtin_amdgcn_s_barrier(); asm volatile("" ::: "memory");
    if (s == 0) {
        float ss = 0.f;
#pragma unroll
        for (int d0 = 0; d0 < 2; ++d0)
#pragma unroll
            for (int r = 0; r < 16; ++r) { const float v = o[d0][r] * inv - lam * ox[32 * d0 + crow_(r, hi)]; o[d0][r] = v; ss += v * v; }
        ss = swapadd32(ss); const float rs = rsqrtf(ss * (1.0f / 64) + EPS) * (1.0f - lam_init);
        const int qpos = q0 + r32;
        if (qpos < L) { bf16* brp = BR + (size_t)(rowb + qpos) * D + 768 + h * 64;
#pragma unroll
            for (int d0 = 0; d0 < 2; ++d0)
#pragma unroll
                for (int r4 = 0; r4 < 4; ++r4) { const int dv = 32 * d0 + 8 * r4 + 4 * hi; const float* sl = C.in[I_SUBLN] + l * 64 + dv;
                    const unsigned w0 = pk2(o[d0][4 * r4] * rs * sl[0], o[d0][4 * r4 + 1] * rs * sl[1]), w1 = pk2(o[d0][4 * r4 + 2] * rs * sl[2], o[d0][4 * r4 + 3] * rs * sl[3]);
                    *(unsigned long long*)(brp + dv) = (unsigned long long)w0 | ((unsigned long long)w1 << 32); } }
    }
    LDS_WAIT(); __builtin_amdgcn_s_barrier(); asm volatile("" ::: "memory");
}
constexpr int PSTR = 68;
__device__ __forceinline__ pg8::bf16x8 cvt8(const f32x4 a, const f32x4 b) { v4u w; w.x = pg8::cvt_pk_bf16(a[0], a[1]); w.y = pg8::cvt_pk_bf16(a[2], a[3]); w.z = pg8::cvt_pk_bf16(b[0], b[1]); w.w = pg8::cvt_pk_bf16(b[2], b[3]); return __builtin_bit_cast(pg8::bf16x8, w); }
__device__ __forceinline__ void attn_sample_item(const Ctx& C, int l, int b, int split) {
    THREAD_IDS();
    const int h = wave & 3, half = wave >> 2, c16 = lane & 15, g = lane >> 4, srow = c16 >> 3, t = c16 & 7;
    const bf16* QNB = WSP(bf16, WS_QNB); const int* PT = (const int*)C.in[I_PT];
    const float* CK = C.in[I_CK] + (size_t)l * NPOOL * PAGE * 256; const float* CV = C.in[I_CV] + (size_t)l * NPOOL * PAGE * 256;
    LAS float* BT = (LAS float*)C.lds;
    BT[tid] = (C.in[I_RELB][t5_bucket(tid & 127) * 4 + (tid >> 7)] - C.in[I_RELB][31 * 4 + (tid >> 7)]) * LOG2E;
    const v4u z4 = {0u, 0u, 0u, 0u};
    const v4u q0w = srow == 0 ? *(const v4u*)(QNB + (size_t)(MP + b * 8 + t) * 256 + h * 64 + 8 * g) : z4, q1w = srow == 1 ? *(const v4u*)(QNB + (size_t)(MP + b * 8 + t) * 256 + h * 64 + 32 + 8 * g) : z4;
    const pg8::bf16x8 qf0 = __builtin_bit_cast(pg8::bf16x8, q0w), qf1 = __builtin_bit_cast(pg8::bf16x8, q1w);
    LDS_WAIT(); __builtin_amdgcn_s_barrier(); asm volatile("" ::: "memory");
    float m = -INFINITY, lsum = 0.f; f32x4 o[4];
#pragma unroll
    for (int db = 0; db < 4; ++db) o[db] = (f32x4){0.f, 0.f, 0.f, 0.f};
    const int kk0 = split * 1024 + half * 512;
    const int pg0 = __builtin_amdgcn_readfirstlane(PT[b * NPAGES + (kk0 >> 7)]), pg1 = __builtin_amdgcn_readfirstlane(PT[b * NPAGES + (kk0 >> 7) + 1]), pg2 = __builtin_amdgcn_readfirstlane(PT[b * NPAGES + (kk0 >> 7) + 2]), pg3 = __builtin_amdgcn_readfirstlane(PT[b * NPAGES + (kk0 >> 7) + 3]);
#define SA_LOAD(KR, VR, st) do { const int kk_ = kk0 + 32 * (st); const int pi_ = (st) >> 2; const int page_ = pi_ == 0 ? pg0 : pi_ == 1 ? pg1 : pi_ == 2 ? pg2 : pg3; const size_t base_ = ((size_t)(page_ * PAGE + (kk_ & 127)) * 4 + h) * 64; \
        _Pragma("unroll") for (int T = 0; T < 2; ++T) _Pragma("unroll") for (int ks = 0; ks < 2; ++ks) { const float* p = CK + base_ + (size_t)(16 * T + c16) * 256 + 32 * ks + 8 * g; KR[T][ks][0] = *(const f32x4*)p; KR[T][ks][1] = *(const f32x4*)(p + 4); } \
        _Pragma("unroll") for (int db = 0; db < 4; ++db) _Pragma("unroll") for (int j = 0; j < 8; ++j) { const int kv = j < 4 ? 4 * g + j : 16 + 4 * g + (j - 4); VR[db][j] = CV[base_ + (size_t)kv * 256 + 16 * db + c16]; } } while (0)
#define SA_MATH(KR, VR, st) do { const int kk = kk0 + 32 * (st); f32x4 sv[2]; \
        _Pragma("unroll") for (int T = 0; T < 2; ++T) { sv[T] = (f32x4){0.f, 0.f, 0.f, 0.f}; \
            sv[T] = __builtin_amdgcn_mfma_f32_16x16x32_bf16(cvt8(KR[T][0][0], KR[T][0][1]), qf0, sv[T], 0, 0, 0); \
            sv[T] = __builtin_amdgcn_mfma_f32_16x16x32_bf16(cvt8(KR[T][1][0], KR[T][1][1]), qf1, sv[T], 0, 0, 0); } \
        if (kk + 31 + 128 > PAST) { \
            _Pragma("unroll") for (int T = 0; T < 2; ++T) _Pragma("unroll") for (int r = 0; r < 4; ++r) { const int n = PAST + t - (kk + 16 * T + 4 * g + r); if (n < 128) sv[T][r] += BT[h * 128 + n]; } } \
        float mt = fmaxf(fmaxf(fmaxf(sv[0][0], sv[0][1]), fmaxf(sv[0][2], sv[0][3])), fmaxf(fmaxf(sv[1][0], sv[1][1]), fmaxf(sv[1][2], sv[1][3]))); \
        mt = fmaxf(mt, __shfl_xor(mt, 16)); mt = fmaxf(mt, __shfl_xor(mt, 32)); \
        const float mn = fmaxf(m, mt); const float al = __builtin_amdgcn_exp2f(m - mn); m = mn; float ps = 0.f; \
        _Pragma("unroll") for (int T = 0; T < 2; ++T) _Pragma("unroll") for (int r = 0; r < 4; ++r) { sv[T][r] = __builtin_amdgcn_exp2f(sv[T][r] - m); ps += sv[T][r]; } \
        lsum = lsum * al + ps; const pg8::bf16x8 pf = cvt8(sv[0], sv[1]); \
        _Pragma("unroll") for (int db = 0; db < 4; ++db) { o[db] = o[db] * al; \
            const f32x4 va = {VR[db][0], VR[db][1], VR[db][2], VR[db][3]}, vb = {VR[db][4], VR[db][5], VR[db][6], VR[db][7]}; \
            o[db] = __builtin_amdgcn_mfma_f32_16x16x32_bf16(cvt8(va, vb), pf, o[db], 0, 0, 0); } } while (0)
    f32x4 krA[2][2][2], krB[2][2][2]; float vrA[4][8], vrB[4][8];
    SA_LOAD(krA, vrA, 0);
#pragma unroll 1
    for (int step = 0; step < 16; step += 2) {
        SA_LOAD(krB, vrB, step + 1);
        SA_MATH(krA, vrA, step);
        if (step + 2 < 16) SA_LOAD(krA, vrA, step + 2);
        SA_MATH(krB, vrB, step + 1);
    }
#undef SA_LOAD
#undef SA_MATH
    lsum += __shfl_xor(lsum, 16); lsum += __shfl_xor(lsum, 32);
    float* pp = WSP(float, WS_PART) + ((((size_t)b * 4 + h) * 16 + split * 2 + half) * 16 + c16) * PSTR;
#pragma unroll
    for (int db = 0; db < 4; ++db) *(f32x4*)(pp + 16 * db + 4 * g) = o[db];
    if (g == 0) { pp[64] = m; pp[65] = lsum; }
    LDS_WAIT(); __builtin_amdgcn_s_barrier(); asm volatile("" ::: "memory");
}
__device__ __forceinline__ void n3_attn_sample_combine(const Ctx& C, int l, float lam_init) {
    THREAD_IDS();
    const float lam = lam_of(C, l, lam_init);
    const bf16* QNB = WSP(bf16, WS_QNB); const bf16* KNB = WSP(bf16, WS_KNB); const bf16* ZM = WSP(bf16, WS_ZMIX); bf16* BR = WSP(bf16, WS_BR);
    for (int it = gw; it < DB * 4 * DS; it += NGW) {
        const int b = it >> 5, h = (it >> 3) & 3, t = it & 7; float os[2];
        const float far = C.in[I_RELB][31 * 4 + h];
        float sn[2][8];
        { const float qv = bf2f(QNB[(size_t)(MP + b * 8 + t) * 256 + h * 64 + lane]);
#pragma unroll
          for (int jj = 0; jj < 8; ++jj) { float p = qv * bf2f(KNB[(size_t)(MP + b * 8 + jj) * 256 + h * 64 + lane]);
              p += __shfl_xor(p, 1); p += __shfl_xor(p, 2); p += __shfl_xor(p, 4); p += __shfl_xor(p, 8); p += __shfl_xor(p, 16);
              const float bias = (C.in[I_RELB][t5_bucket(t - jj < 0 ? 0 : t - jj) * 4 + h] - far) * LOG2E;
              sn[0][jj] = jj <= t ? __shfl(p, 0) + bias : -INFINITY; sn[1][jj] = jj <= t ? __shfl(p, 32) + bias : -INFINITY; } }
#pragma unroll
        for (int s = 0; s < 2; ++s) {
            const float* pb = WSP(float, WS_PART) + ((((size_t)b * 4 + h) * 16) * 16 + s * 8 + t) * PSTR;
            float mm = -INFINITY; float pm[16];
#pragma unroll
            for (int pi = 0; pi < 16; ++pi) { pm[pi] = pb[(size_t)pi * 16 * PSTR + 64]; mm = fmaxf(mm, pm[pi]); }
#pragma unroll
            for (int jj = 0; jj < 8; ++jj) mm = fmaxf(mm, sn[s][jj]);
            float ll = 0.f, oo = 0.f;
#pragma unroll
            for (int pi = 0; pi < 16; ++pi) { const float* pr = pb + (size_t)pi * 16 * PSTR; const float w = __builtin_amdgcn_exp2f(pm[pi] - mm); ll += pr[65] * w; oo += pr[lane] * w; }
#pragma unroll
            for (int jj = 0; jj < 8; ++jj) { const float w = __builtin_amdgcn_exp2f(sn[s][jj] - mm); ll += w; oo += w * bf2f(ZM[(size_t)(MP + b * 8 + jj) * NMIXP + D_V + h * 64 + lane]); }
            os[s] = oo / ll;
        }
        const float o = os[0] - lam * os[1]; const float ms = wave_sum(o * o) * (1.0f / 64);
        BR[(size_t)(MP + b * 8 + t) * D + 768 + h * 64 + lane] = (bf16)f2bf(o * rsqrtf(ms + EPS) * C.in[I_SUBLN][l * 64 + lane] * (1.0f - lam_init));
    }
}

__device__ __forceinline__ void n3_la_finalize(const Ctx& C, int l) {
    THREAD_IDS();
    const float* LAO = WSP(float, WS_LAO); const bf16* ZM = WSP(bf16, WS_ZMIX); bf16* BR = WSP(bf16, WS_BR);
    const bool ret = lane < 32; const int hd = (lane >> 3) & 3, c8 = (lane & 7) * 8;
    float gn[8];
#pragma unroll
    for (int j = 0; j < 8; ++j) gn[j] = (ret ? C.in[I_RGN] : C.in[I_GGN])[(l * 4 + hd) * 64 + c8 + j];
    for (int r0 = gw * 4; r0 < MP; r0 += NGW * 4) {
        f32x4 a4[4], b4[4]; v4u g4[4];
#pragma unroll
        for (int u = 0; u < 4; ++u) { const int r = min(r0 + u, MP - 1); a4[u] = *(const f32x4*)(LAO + (size_t)r * 512 + 8 * lane); b4[u] = *(const f32x4*)(LAO + (size_t)r * 512 + 8 * lane + 4);
            g4[u] = *(const v4u*)(ZM + (size_t)r * NMIXP + (ret ? R_G : G_R) + hd * 64 + c8); }
#pragma unroll
        for (int u = 0; u < 4; ++u) { const int r = r0 + u; if (r >= MP) break;
            float x[8] = {a4[u][0], a4[u][1], a4[u][2], a4[u][3], b4[u][0], b4[u][1], b4[u][2], b4[u][3]}, g[8]; unpack8(g4[u], g);
            float s = ((x[0] + x[1]) + (x[2] + x[3])) + ((x[4] + x[5]) + (x[6] + x[7]));
            s += __shfl_xor(s, 1); s += __shfl_xor(s, 2); s += __shfl_xor(s, 4);
            const float mean = ret ? s * (1.0f / 64) : 0.f; float q2 = 0.f;
#pragma unroll
            for (int j = 0; j < 8; ++j) { x[j] -= mean; q2 += x[j] * x[j]; }
            q2 += __shfl_xor(q2, 1); q2 += __shfl_xor(q2, 2); q2 += __shfl_xor(q2, 4);
            const float rs = rsqrtf(q2 * (1.0f / 64) + EPS);
#pragma unroll
            for (int j = 0; j < 8; ++j) x[j] = siluf_(g[j]) * x[j] * rs * gn[j];
            *(v4u*)(BR + (size_t)r * D + 256 + 8 * lane) = pack8(x); }
    }
}

constexpr int NQB_ATT = (L + 127) / 128;
constexpr int IT_LA = 32, IT_SS = IT_LA + DB * 8, IT_AT = IT_SS + 16 * NQB_ATT, IT_LS = IT_AT + 32, IT_CV = IT_LS + (MR + 63) / 64, IT_END = IT_CV;
__device__ __forceinline__ void n2_phase(const Ctx& C, int l, float lam_init, int qslot) {
    THREAD_IDS();
    const float lam = lam_of(C, l, lam_init);
    float mb;
    { float mq = 0.f, mk = 0.f, mbias = 0.f;
#pragma unroll 1
      for (int i = 0; i < 32; ++i) { mq = fmaxf(mq, fabsf(C.in[I_QN][l * 32 + i])); mk = fmaxf(mk, fabsf(C.in[I_KN][l * 32 + i])); }
#pragma unroll 1
      for (int i = 0; i < 128; ++i) mbias = fmaxf(mbias, C.in[I_RELB][i] - C.in[I_RELB][31 * 4 + (i & 3)]);
      mb = 1.02f * 1.4426950408889634f * 5.656854249492381f * mq * mk + 1.4426950408889634f * mbias; }
    unsigned* qw = (unsigned*)(C.ws + WS_CTL) + CW_QUEUE + 64 * qslot;
    volatile LAS int* slot = (volatile LAS int*)(C.lds + MISC_OFF + 64);
    if (blockIdx.x < IT_LA) { const int it = blockIdx.x; const int b = (it >> 2) & 3, h = it & 3; if (it < 16) la_chunked<64, true>(C, l, false, b, h); else la_chunked<32, false>(C, l, false, b, h); }
    for (;;) {
        if (tid == 0) slot[0] = (int)__hip_atomic_fetch_add(qw, 1u, __ATOMIC_RELAXED, __HIP_MEMORY_SCOPE_AGENT);
        __syncthreads();
        const int qi = slot[0];
        const int it = qi < 3 * DB * 8 ? ((qi % 3) ? IT_SS + 2 * (qi / 3) + (qi % 3) - 1 : IT_LA + qi / 3) : qi + IT_LA;
        __syncthreads();
        if (it >= IT_END) break;
        if (it < IT_SS) { const int i2 = it - IT_LA; attn_sample_item(C, l, i2 >> 3, i2 & 7); }
        else if (it < IT_AT) { const int i2 = it - IT_SS; attn_prompt_item(C, l, (i2 & 15) >> 2, i2 & 3, NQB_ATT - 1 - (i2 >> 4), lam, lam_init, mb); }
        else if (it < IT_LS) { const int i2 = (it - IT_AT) * 8 + wave; const int b = (i2 >> 2) & 31, h = i2 & 3; if (i2 < 128) la_seq<64, true>(C, l, true, b, h); else la_seq<32, false>(C, l, true, b, h); }
        else { conv_rows_item(C, l, it - IT_LS); conv_state_item(C, l, it - IT_LS, IT_CV - IT_LS); }
    }
}

template <int l> __device__ __forceinline__ void layer_fwd(const Ctx& C, const XcdBarrier& bar) {
#define GRID_BAR() xcd_barrier<false>(bar)
    LAS unsigned char* ring = C.lds + RING_OFF;
    float* SS = WSP(float, WS_SS); float* H = WSP(float, WS_H); bf16* HB = WSP(bf16, WS_HB); bf16* ACT = WSP(bf16, WS_ACT); bf16* ZMIX = WSP(bf16, WS_ZMIX); bf16* GATES = WSP(bf16, WS_GATES);
    bf16* BR = WSP(bf16, WS_BR); bf16* MERGED = WSP(bf16, WS_MERGED);
    constexpr float lam_init = l == 0 ? 0.2f : 0.35550906759096926f;
    constexpr bool last = (l == DEPTH - 1);
    { pg8::Gemm g{HB, WSP(bf16, WS_W1 + (size_t)(l * 2 + 0) * SZ_W1), D, D, D}; pg8::StaticOrder S; S.init(M, 2 * DFF, C.G, (int)blockIdx.x);
      EpiGLU E{ACT, SS + (size_t)(l * 3 + 0) * M * 16}; pg8::gemm_phase<EpiGLU, pg8::StaticOrder, true, true>(ring, g, S, E); }
    GRID_BAR();
    { pg8::HeadOrder S; S.init(M, D, C.G, (int)blockIdx.x); S.limit = C.G; EpiRes<false, 1> E{H, HB, SS + (size_t)(l * 3 + 1) * M * 16, nullptr};
      { pg8::Gemm g{ACT, WSP(bf16, WS_WD + (size_t)(l * 2 + 0) * SZ_WD), DFF, DFF, DFF}; pg8::gemm_phase<EpiRes<false, 1>, pg8::HeadOrder, true, true>(ring, g, S, E); }
      { int kt = DFF / 11; asm volatile("" : "+s"(kt)); pg8::Gemm g{ACT, WSP(bf16, WS_WD + (size_t)(l * 2 + 0) * SZ_WD), DFF, DFF, kt}; pg8::TailOrder T; T.init(M, D, C.G, (int)blockIdx.x); T.limit = C.G; T.nsplit = 11; T.kper = DFF / 11;
        EpiPartial EP{WSP(float, WS_KSP)}; pg8::gemm_phase<EpiPartial, pg8::TailOrder, true, true>(ring, g, T, EP); }
      ksp_finalize_local<11>(WSP(float, WS_KSP), S, C.G, E, (unsigned*)(C.ws + WS_CTL) + CW_TAIL + 512 * (l * 3 + 0), (unsigned*)(C.ws + WS_CTL) + CW_BAR); }
    GRID_BAR();
    { pg8::Gemm g{HB, WSP(bf16, WS_WIN + (size_t)l * SZ_WIN), D, D, D}; pg8::StaticOrder S; S.init(M, NINP, C.G, (int)blockIdx.x);
      EpiZ E{ZMIX, GATES, SS + (size_t)(l * 3 + 1) * M * 16, WSP(float, WS_BINP) + l * NINP}; pg8::gemm_phase<EpiZ, pg8::StaticOrder, true, true>(ring, g, S, E); }
    GRID_BAR();
    n1_prep(C, l);
    GRID_BAR();
    n2_phase(C, l, lam_init, l);
    GRID_BAR();
    n3_attn_sample_combine(C, l, lam_init);
    n3_la_finalize(C, l);
    GRID_BAR();
    { pg8::HeadOrder S; S.init(M, D, C.G, (int)blockIdx.x); S.limit = C.G;
      { pg8::Gemm g{BR, WSP(bf16, WS_WBR + (size_t)l * SZ_WBR), D, D, D}; EpiMergeR E{MERGED, GATES}; pg8::gemm_phase<EpiMergeR, pg8::HeadOrder, true, true, 4>(ring, g, S, E); }
      { int kt = D / 4; asm volatile("" : "+s"(kt)); pg8::Gemm g{BR, WSP(bf16, WS_WBR + (size_t)l * SZ_WBR), D, D, kt}; pg8::TailOrder T; T.init(M, D, C.G, (int)blockIdx.x); T.limit = C.G; T.nsplit = 4; T.kper = D / 4;
        EpiPartial EP{WSP(float, WS_KSP)}; pg8::gemm_phase<EpiPartial, pg8::TailOrder, true, true>(ring, g, T, EP); }
      merge_finalize_local(WSP(float, WS_KSP), S, C.G, MERGED, GATES, (unsigned*)(C.ws + WS_CTL) + CW_TAIL + 512 * (6 + l), (unsigned*)(C.ws + WS_CTL) + CW_BAR); }
    GRID_BAR();
    { pg8::HeadOrder S; S.init(M, D, C.G, (int)blockIdx.x); S.limit = C.G; EpiRes<false, 2> E{H, HB, SS + (size_t)(l * 3 + 2) * M * 16, nullptr};
      { pg8::Gemm g{MERGED, WSP(bf16, WS_WOUT + (size_t)l * SZ_WOUT), D, D, D}; pg8::gemm_phase<EpiRes<false, 2>, pg8::HeadOrder, true, true>(ring, g, S, E); }
      { int kt = D / 4; asm volatile("" : "+s"(kt)); pg8::Gemm g{MERGED, WSP(bf16, WS_WOUT + (size_t)l * SZ_WOUT), D, D, kt}; pg8::TailOrder T; T.init(M, D, C.G, (int)blockIdx.x); T.limit = C.G; T.nsplit = 4; T.kper = D / 4;
        EpiPartial EP{WSP(float, WS_KSP)}; pg8::gemm_phase<EpiPartial, pg8::TailOrder, true, true>(ring, g, T, EP); }
      ksp_finalize_local<4>(WSP(float, WS_KSP), S, C.G, E, (unsigned*)(C.ws + WS_CTL) + CW_TAIL + 512 * (l * 3 + 1), (unsigned*)(C.ws + WS_CTL) + CW_BAR); }
    GRID_BAR();
    { pg8::Gemm g{HB, WSP(bf16, WS_W1 + (size_t)(l * 2 + 1) * SZ_W1), D, D, D}; pg8::StaticOrder S; S.init(M, 2 * DFF, C.G, (int)blockIdx.x);
      EpiGLU E{ACT, SS + (size_t)(l * 3 + 2) * M * 16}; pg8::gemm_phase<EpiGLU, pg8::StaticOrder, true, true>(ring, g, S, E); }
    GRID_BAR();
    { pg8::HeadOrder S; S.init(M, D, C.G, (int)blockIdx.x); S.limit = C.G; EpiRes<last, 1> E{H, HB, last ? nullptr : SS + (size_t)((l + 1) * 3) * M * 16, C.out};
      { pg8::Gemm g{ACT, WSP(bf16, WS_WD + (size_t)(l * 2 + 1) * SZ_WD), DFF, DFF, DFF}; pg8::gemm_phase<EpiRes<last, 1>, pg8::HeadOrder, true, true>(ring, g, S, E); }
      { int kt = DFF / 11; asm volatile("" : "+s"(kt)); pg8::Gemm g{ACT, WSP(bf16, WS_WD + (size_t)(l * 2 + 1) * SZ_WD), DFF, DFF, kt}; pg8::TailOrder T; T.init(M, D, C.G, (int)blockIdx.x); T.limit = C.G; T.nsplit = 11; T.kper = DFF / 11;
        EpiPartial EP{WSP(float, WS_KSP)}; pg8::gemm_phase<EpiPartial, pg8::TailOrder, true, true>(ring, g, T, EP); }
      ksp_finalize_local<11>(WSP(float, WS_KSP), S, C.G, E, (unsigned*)(C.ws + WS_CTL) + CW_TAIL + 512 * (l * 3 + 2), (unsigned*)(C.ws + WS_CTL) + CW_BAR); }
#undef GRID_BAR
}

__global__ void __launch_bounds__(NWAVES * 64, 2) fwd(Params P) {
    extern __shared__ __attribute__((aligned(16))) unsigned char lds[];
    Ctx C;
    C.in = P.in; C.out = P.out; C.ws = P.ws; C.lds = (LAS unsigned char*)lds;
    C.G = gridDim.x;
    volatile LAS unsigned* MISC = (volatile LAS unsigned*)(C.lds + MISC_OFF);
    for (int u = threadIdx.x; u < (LDS_BYTES - LDSCTL_OFF) / 4; u += NWAVES * 64) ((LAS unsigned*)(C.lds + LDSCTL_OFF))[u] = 0u;
    __syncthreads();
    unsigned* ctl = (unsigned*)(C.ws + WS_CTL);
    XcdBarrier bar = xcd_barrier_post(ctl + CW_BAR, MISC + 8);
    p0_prologue(C, P);
    xcd_barrier<true>(bar);
    layer_fwd<0>(C, bar);
    xcd_barrier<false>(bar);
    layer_fwd<1>(C, bar);
}

extern "C" void kernel_launch(void* const* d_in, const int* in_sizes, int n_in, void* d_out, int out_size, void* d_ws, size_t ws_size, hipStream_t stream) {
    static int grid = 0;
    if (grid == 0) {
        if (n_in != N_INPUTS || (size_t)out_size != O_END || ws_size < WS_END) { fprintf(stderr, "kernel_launch: unexpected shapes: n_in %d out %d (want %zu) ws %zu (want %zu)\n", n_in, out_size, (size_t)O_END, ws_size, (size_t)WS_END); grid = -1; return; }
        int dev = 0, cus = 0, per_cu = 0;
        if (hipGetDevice(&dev) != hipSuccess || hipDeviceGetAttribute(&cus, hipDeviceAttributeMultiprocessorCount, dev) != hipSuccess) { grid = -1; return; }
        if (hipFuncSetAttribute((const void*)fwd, hipFuncAttributeMaxDynamicSharedMemorySize, LDS_BYTES) != hipSuccess) { fprintf(stderr, "kernel_launch: hipFuncSetAttribute failed\n"); grid = -1; return; }
        if (hipOccupancyMaxActiveBlocksPerMultiprocessor(&per_cu, (const void*)fwd, NWAVES * 64, LDS_BYTES) != hipSuccess || per_cu < 1) { fprintf(stderr, "kernel_launch: occupancy query says %d blocks per CU\n", per_cu); }
        (void)hipGetLastError();
        grid = cus;
    }
    if (grid < 0) return;
    if (hipMemsetAsync((char*)d_ws + WS_CTL, 0, CTL_ZERO_BYTES, stream) != hipSuccess) return;
    Params p{};
    for (int i = 0; i < N_INPUTS; ++i) p.in[i] = (const float*)d_in[i];
    p.out = (float*)d_out; p.ws = (unsigned char*)d_ws;
    for (int i = 0; i < 32; ++i) p.inv_freq[i] = (float)pow(10000.0, -(double)i / 32.0);
    hipLaunchKernelGGL(fwd, dim3(grid), dim3(NWAVES * 64), LDS_BYTES, stream, p);
}
```

```cpp
#include <hip/hip_runtime.h>
#include <cstdio>
#include <cstdint>
#include <cmath>

namespace pg8 {
#define PG8_LAS __attribute__((address_space(3)))
typedef unsigned short bf16_t;
typedef short bf16x8 __attribute__((ext_vector_type(8)));
typedef float f32x4 __attribute__((ext_vector_type(4)));
typedef unsigned u32x4 __attribute__((ext_vector_type(4)));
constexpr int BM = 256, BK = 64, HALF = 128, HTB = HALF * BK * 2  , STAGE_BYTES = 8 * HTB, NXCD = 8, WGM = 8;

__host__ __device__ __forceinline__ int lds_byte(int r, int c) { const int st = (r >> 4) * 2 + (c >> 5), rr = r & 15, cc = c & 31, ob = rr * 64 + cc * 2; return st * 1024 + (ob ^ (((ob >> 9) & 1) << 5)); }
__host__ __device__ __forceinline__ void stage_rc(int b, int& R, int& C) { const int st = b / 1024, sb = b % 1024, swz = sb ^ (((sb >> 9) & 1) << 5); R = (st >> 1) * 16 + swz / 64; C = (st & 1) * 32 + (swz % 64) / 2; }
__host__ __device__ __forceinline__ int perm32(int rho) { const int n = rho >> 4, i = rho & 15; return 8 * (i >> 2) + 4 * n + (i & 3); }

struct Unit { int pm, pn, acol, bcol; };
struct Gemm { const bf16_t* A; const bf16_t* Bt; int lda, ldb, K, kseg0; };

struct StaticOrder {
    int nM, nN, nwg, G, c;
    __host__ __device__ void init(int M, int N, int G_, int c_) { nM = M / BM; nN = N / BM; nwg = nM * nN; G = G_; c = c_; }
    __host__ __device__ void unit_of(int L, Unit& u) const {
        int wgid = L; { const int q = nwg / NXCD, r = nwg % NXCD, xcd = wgid % NXCD, off = wgid / NXCD; wgid = (xcd < r ? xcd * (q + 1) : r * (q + 1) + (xcd - r) * q) + off; }
        const int nig = WGM * nN, gid = wgid / nig, fm = gid * WGM, gsz = (nM - fm) < WGM ? (nM - fm) : WGM;
        u.pm = fm + ((wgid % nig) % gsz); u.pn = (wgid % nig) / gsz; u.acol = 0; u.bcol = 0;
    }
    __host__ __device__ bool next(int i, Unit& u) const { const long L = (long)i * G + c; if (L >= nwg) return false; unit_of((int)L, u); return true; }
};
struct HeadOrder : StaticOrder { int limit; __host__ __device__ bool next(int i, Unit& u) const { const long L = (long)i * G + c; if (L >= limit || L >= nwg) return false; unit_of((int)L, u); return true; } };
struct TailOrder : StaticOrder { int limit, nsplit, kper;
    __host__ __device__ bool next(int i, Unit& u) const {
        if (i > 0 || c >= (nwg - limit) * nsplit) return false;
        unit_of(limit + c / nsplit, u); u.acol = u.bcol = (c % nsplit) * kper; return true; } };
__device__ __forceinline__ unsigned cvt_pk_bf16(float lo, float hi) { unsigned r; asm volatile("v_cvt_pk_bf16_f32 %0, %1, %2" : "=v"(r) : "v"(lo), "v"(hi)); return r; }

template <class Epi, class Sched, bool ALIGN_EPI = false, bool SP2 = false, int SEG = 0>
__device__ __forceinline__ void gemm_phase(PG8_LAS unsigned char* lds, const Gemm g, const Sched& S, const Epi& E) {
    int tid_ = threadIdx.x; asm volatile("" : "+v"(tid_));
    const int tid = tid_, wid = __builtin_amdgcn_readfirstlane(tid >> 6), lane = tid & 63, wr = wid >> 2, wc = wid & 3, fr = lane & 15, fq = lane >> 4;
    const int nt = g.K / BK;
    unsigned voffA[2], voffB[2];
#pragma unroll
    for (int i = 0; i < 2; ++i) { int R, C; stage_rc(tid * 16 + i * 8192, R, C); const int Rb = Epi::PERM ? ((R & ~31) + perm32(R & 31)) : R;
        voffA[i] = (unsigned)(R * g.lda + C) * 2u; voffB[i] = (unsigned)(Rb * g.ldb + C) * 2u; }
    const size_t kstep = (size_t)(BK * 2);
    const size_t hstepA = (size_t)HALF * g.lda * 2, hstepB = (size_t)HALF * g.ldb * 2;
    const size_t tstepA = 2 * hstepA, tstepB = 2 * hstepB;
    const unsigned ldsw = (unsigned)wid * 1024u;
    const int aoff = lds_byte(wr * 64 + fr, fq * 8), boff = lds_byte(wc * 32 + fr, fq * 8);
#define PG8_SA(b, h) (((b) * 2 + (h)) * HTB)
#define PG8_SB(b, h) ((4 + (b) * 2 + (h)) * HTB)
#define PG8_STAGE(bufoff, gbase, voff) do { _Pragma("unroll") for (int _i = 0; _i < 2; ++_i) \
        __builtin_amdgcn_global_load_lds((const unsigned*)((const char*)(gbase) + (voff)[_i]), (PG8_LAS unsigned*)(lds + (bufoff) + ldsw + _i * 8192), 16, 0, 0); } while (0)
#define PG8_LDA(dst, b, h) do { _Pragma("unroll") for (int m = 0; m < 4; ++m) _Pragma("unroll") for (int k = 0; k < 2; ++k) dst[m][k] = *(const PG8_LAS bf16x8*)(lds + PG8_SA(b, h) + aoff + m * 2048 + k * 1024); } while (0)
#define PG8_LDB(dst, b, h) do { _Pragma("unroll") for (int n = 0; n < 2; ++n) _Pragma("unroll") for (int k = 0; k < 2; ++k) dst[n][k] = *(const PG8_LAS bf16x8*)(lds + PG8_SB(b, h) + boff + n * 2048 + k * 1024); } while (0)
#define PG8_MMA(ai, bj, At, Bt) do { __builtin_amdgcn_s_setprio(1); _Pragma("unroll") for (int m = 0; m < 4; ++m) _Pragma("unroll") for (int n = 0; n < 2; ++n) _Pragma("unroll") for (int k = 0; k < 2; ++k) \
        acc[ai][bj][m][n] = __builtin_amdgcn_mfma_f32_16x16x32_bf16(Bt[n][k], At[m][k], acc[ai][bj][m][n], 0, 0, 0); __builtin_amdgcn_s_setprio(0); } while (0)
#define PG8_WAIT_V(n) asm volatile("s_waitcnt vmcnt(" #n ")" ::: "memory")
#define PG8_WAIT_L(n) asm volatile("s_waitcnt lgkmcnt(" #n ")" ::: "memory")
#define PG8_BAR __builtin_amdgcn_s_barrier()
#define PG8_SCHED __builtin_amdgcn_sched_barrier(0)
    Unit cur, nxt; int ui = 0;
    if (!S.next(0, cur)) return;
    f32x4 acc[2][2][4][2];
#pragma unroll
    for (int a = 0; a < 2; ++a)
#pragma unroll
        for (int b = 0; b < 2; ++b)
#pragma unroll
            for (int m = 0; m < 4; ++m)
#pragma unroll
                for (int n = 0; n < 2; ++n) acc[a][b][m][n] = (f32x4){0.f, 0.f, 0.f, 0.f};
    bf16x8 At[4][2], B0[2][2], B1[2][2];
    const char* cA = (const char*)g.A + (size_t)cur.pm * tstepA + (size_t)cur.acol * 2; const char* cB = (const char*)g.Bt + (size_t)cur.pn * tstepB + (size_t)cur.bcol * 2;
#define PG8_KOFF(t) ((SEG > 0) ? (size_t)(((((t) / (SEG > 0 ? SEG : 1)) + g.kseg0) & (nt / (SEG > 0 ? SEG : 1) - 1)) * (SEG > 0 ? SEG : 1) + ((t) % (SEG > 0 ? SEG : 1))) * kstep : (size_t)(t) * kstep)
    const size_t K0 = PG8_KOFF(0);
    cA += K0; cB += K0;
    if constexpr (SP2) {
        PG8_STAGE(PG8_SB(0, 0), cB, voffB); PG8_STAGE(PG8_SB(0, 1), cB + hstepB, voffB); PG8_STAGE(PG8_SA(0, 0), cA, voffA); PG8_STAGE(PG8_SA(0, 1), cA + hstepA, voffA);
        if (wr == 1) PG8_BAR;
        PG8_WAIT_V(2); PG8_BAR;
        PG8_STAGE(PG8_SB(1, 0), cB + kstep, voffB); PG8_STAGE(PG8_SA(1, 0), cA + kstep, voffA); PG8_STAGE(PG8_SB(1, 1), cB + hstepB + kstep, voffB);
        PG8_WAIT_V(6); PG8_BAR;
    } else {
        PG8_STAGE(PG8_SB(0, 0), cB, voffB); PG8_STAGE(PG8_SA(0, 0), cA, voffA); PG8_STAGE(PG8_SB(0, 1), cB + hstepB, voffB); PG8_STAGE(PG8_SA(0, 1), cA + hstepA, voffA);
        if (wr == 1) PG8_BAR;
        PG8_WAIT_V(4); PG8_BAR;
        PG8_STAGE(PG8_SB(1, 0), cB + kstep, voffB); PG8_STAGE(PG8_SA(1, 0), cA + kstep, voffA); PG8_STAGE(PG8_SB(1, 1), cB + hstepB + kstep, voffB);
        PG8_WAIT_V(6); PG8_BAR;
    }
    for (;;) {
        const bool has_next = S.next(ui + 1, nxt);
        const char* nA = has_next ? (const char*)g.A + (size_t)nxt.pm * tstepA + (size_t)nxt.acol * 2 + K0 : cA; const char* nB = has_next ? (const char*)g.Bt + (size_t)nxt.pn * tstepB + (size_t)nxt.bcol * 2 + K0 : cB;
        for (int t = 0; t < nt; t += 2) {
            const bool last = (t == nt - 2);
            const char* a1 = cA - K0 + PG8_KOFF(t + 1);
            const char* a2 = last ? nA : cA - K0 + PG8_KOFF(t + 2); const char* b2 = last ? nB : cB - K0 + PG8_KOFF(t + 2);
            const char* a3 = a2 + kstep; const char* b3 = b2 + kstep;
            if constexpr (SP2) {
            PG8_LDB(B0, 0, 0); PG8_LDB(B1, 0, 1); PG8_SCHED; PG8_LDA(At, 0, 0); PG8_STAGE(PG8_SA(1, 1), a1 + hstepA, voffA);
            PG8_WAIT_V(8); PG8_WAIT_L(0); PG8_BAR; PG8_MMA(0, 0, At, B0); PG8_MMA(0, 1, At, B1); PG8_BAR; PG8_SCHED;
            PG8_LDA(At, 0, 1); PG8_STAGE(PG8_SB(0, 0), b2, voffB); PG8_STAGE(PG8_SB(0, 1), b2 + hstepB, voffB); PG8_STAGE(PG8_SA(0, 0), a2, voffA);
            PG8_WAIT_V(8); PG8_WAIT_L(0); PG8_BAR; PG8_MMA(1, 0, At, B0); PG8_MMA(1, 1, At, B1); PG8_BAR; PG8_SCHED;
            PG8_LDB(B0, 1, 0); PG8_LDB(B1, 1, 1); PG8_SCHED; PG8_LDA(At, 1, 0); PG8_STAGE(PG8_SA(0, 1), a2 + hstepA, voffA);
            PG8_WAIT_V(8); PG8_WAIT_L(0); PG8_BAR; PG8_MMA(0, 0, At, B0); PG8_MMA(0, 1, At, B1); PG8_BAR; PG8_SCHED;
            PG8_LDA(At, 1, 1); PG8_STAGE(PG8_SB(1, 0), b3, voffB); PG8_STAGE(PG8_SB(1, 1), b3 + hstepB, voffB); PG8_STAGE(PG8_SA(1, 0), a3, voffA);
            PG8_WAIT_V(8); PG8_WAIT_L(0); PG8_BAR; PG8_MMA(1, 0, At, B0); PG8_MMA(1, 1, At, B1); PG8_BAR; PG8_SCHED;
            } else {
            PG8_LDB(B0, 0, 0); PG8_SCHED; PG8_LDA(At, 0, 0); PG8_STAGE(PG8_SA(1, 1), a1 + hstepA, voffA);
            PG8_WAIT_L(8); PG8_BAR; PG8_WAIT_L(0); PG8_MMA(0, 0, At, B0); PG8_BAR; PG8_SCHED;
            PG8_LDB(B1, 0, 1); PG8_STAGE(PG8_SB(0, 0), b2, voffB);
            PG8_BAR; PG8_WAIT_L(0); PG8_MMA(0, 1, At, B1); PG8_BAR;
            PG8_LDA(At, 0, 1); PG8_STAGE(PG8_SA(0, 0), a2, voffA);
            PG8_BAR; PG8_WAIT_L(0); PG8_MMA(1, 0, At, B0); PG8_BAR; PG8_SCHED;
            PG8_STAGE(PG8_SB(0, 1), b2 + hstepB, voffB);
            PG8_WAIT_V(6); PG8_BAR; PG8_MMA(1, 1, At, B1); PG8_BAR;
            PG8_LDB(B0, 1, 0); PG8_SCHED; PG8_LDA(At, 1, 0); PG8_STAGE(PG8_SA(0, 1), a2 + hstepA, voffA);
            PG8_WAIT_L(8); PG8_BAR; PG8_WAIT_L(0); PG8_MMA(0, 0, At, B0); PG8_BAR; PG8_SCHED;
            PG8_LDB(B1, 1, 1); PG8_STAGE(PG8_SB(1, 0), b3, voffB);
            PG8_BAR; PG8_WAIT_L(0); PG8_MMA(0, 1, At, B1); PG8_BAR;
            PG8_LDA(At, 1, 1); PG8_STAGE(PG8_SA(1, 0), a3, voffA);
            PG8_BAR; PG8_WAIT_L(0); PG8_MMA(1, 0, At, B0); PG8_BAR; PG8_SCHED;
            PG8_STAGE(PG8_SB(1, 1), b3 + hstepB, voffB);
            PG8_WAIT_V(6); PG8_BAR; PG8_MMA(1, 1, At, B1); PG8_BAR;
            }
            if constexpr (SEG > 0) { if (((t + 2) % SEG) == 0 && (t + 2) < nt) E.mid(acc, cur, (t + 2) / SEG, g.kseg0); }
        }
        if constexpr (ALIGN_EPI) { if (wr == 0) PG8_BAR; }
        E(acc, cur, wr, wc, fr, fq);
        if (!has_next) break;
#pragma unroll
        for (int a = 0; a < 2; ++a)
#pragma unroll
            for (int b = 0; b < 2; ++b)
#pragma unroll
                for (int m = 0; m < 4; ++m)
#pragma unroll
                    for (int n = 0; n < 2; ++n) acc[a][b][m][n] = (f32x4){0.f, 0.f, 0.f, 0.f};
        cur = nxt; cA = nA; cB = nB; ++ui;
        if constexpr (ALIGN_EPI) { if (wr == 1) PG8_BAR; }
    }
    PG8_WAIT_V(0);
    if constexpr (!ALIGN_EPI) { if (wr == 0) PG8_BAR; }
    PG8_BAR;
#undef PG8_KOFF
#undef PG8_SA
#undef PG8_SB
#undef PG8_STAGE
#undef PG8_LDA
#undef PG8_LDB
#undef PG8_MMA
#undef PG8_WAIT_V
#undef PG8_WAIT_L
#undef PG8_BAR
#undef PG8_SCHED
}
}

constexpr int NWAVES = 8;
constexpr int D = 1024, DFF = 2816, NIN = 7184, NMIX = 3088, NMIXP = 3328, NGATE = 4096, NINP = NMIXP + NGATE;
constexpr int SEQ = 4096, NMETA = 16, L = SEQ + NMETA, BATCH = 4, DB = 32, DS = 8, PAST = 8192, PAGE = 128, NPAGES = PAST / PAGE, NPOOL = 2560, DEPTH = 2;
constexpr int MP = BATCH * L, MS = DB * DS, MR = MP + MS, M = 16896;
constexpr int NPOS = L + DS;
constexpr float EPS = 1e-6f;
constexpr int C_A = 0, C_G = 256, R_Q = 512, R_K = 768, R_V = 1024, R_G = 1280, G_Q = 1536, G_K = 1664, G_V = 1792, G_R = 2048, G_LOW = 2304, D_Q = 2320, D_K = 2576, D_V = 2832;
constexpr size_t O_YP = 0, O_YS = O_YP + (size_t)BATCH * SEQ * D, O_KP = O_YS + (size_t)MS * D, O_VP = O_KP + (size_t)DEPTH * MP * 256, O_KS = O_VP + (size_t)DEPTH * MP * 256,
                 O_VS = O_KS + (size_t)DEPTH * MS * 256, O_RP = O_VS + (size_t)DEPTH * MS * 256, O_RS = O_RP + (size_t)DEPTH * BATCH * 4 * 64 * 64, O_GP = O_RS + (size_t)DEPTH * DB * 4 * 64 * 64,
                 O_GS = O_GP + (size_t)DEPTH * BATCH * 4 * 32 * 64, O_CP = O_GS + (size_t)DEPTH * DB * 4 * 32 * 64, O_CS = O_CP + (size_t)DEPTH * BATCH * 30 * 256, O_END = O_CS + (size_t)DEPTH * DB * 30 * 256;
enum { I_XP = 0, I_XS, I_CK, I_CV, I_PT, I_SRET, I_SGLA, I_SCONV, I_META, I_RELB, I_NF1, I_F1G, I_F1U, I_F1D, I_NMIX, I_WIN, I_BIN, I_CW, I_CB, I_CLG, I_CLB, I_RGN, I_GAW, I_GAB, I_GGN,
       I_QN, I_KN, I_LQ1, I_LK1, I_LQ2, I_LK2, I_SUBLN, I_WBR, I_WOUT, I_NF2, I_F2G, I_F2U, I_F2D, N_INPUTS };

constexpr size_t MiB = 1u << 20;
constexpr size_t WS_CTL = 0, CTL_ZERO_BYTES = 64 * 1024;
constexpr size_t SZ_SS = (size_t)M * 16 * 4;
constexpr size_t SZ_W1 = (size_t)2 * DFF * D * 2, SZ_WD = (size_t)D * DFF * 2, SZ_WIN = (size_t)NINP * D * 2, SZ_WBR = (size_t)4 * D * 256 * 2, SZ_WOUT = (size_t)D * D * 2;
constexpr size_t WS_W1 = 4 * MiB;
constexpr size_t WS_WD = WS_W1 + 4 * SZ_W1;
constexpr size_t WS_WIN = WS_WD + 4 * SZ_WD;
constexpr size_t WS_WBR = WS_WIN + 2 * SZ_WIN;
constexpr size_t WS_WOUT = WS_WBR + 2 * SZ_WBR;
constexpr size_t WS_BINP = WS_WOUT + 2 * SZ_WOUT;
constexpr size_t WS_ROPE = WS_BINP + 64 * 1024;
constexpr size_t WS_SS = WS_ROPE + 2 * MiB;
constexpr size_t WS_H = 128 * MiB;
constexpr size_t WS_HB = WS_H + (size_t)M * D * 4;
constexpr size_t WS_ACT = WS_HB + (size_t)M * D * 2;
constexpr size_t WS_ZMIX = WS_ACT + (size_t)M * DFF * 2;
constexpr size_t WS_GATES = WS_ZMIX + (size_t)M * NMIXP * 2;
constexpr size_t WS_BR = WS_GATES + (size_t)M * NGATE * 2;
constexpr size_t WS_MERGED = WS_BR + (size_t)M * D * 2;
constexpr size_t WS_UBUF = WS_MERGED + (size_t)M * D * 2;
constexpr size_t WS_RQ = WS_UBUF + (size_t)M * 256 * 4, WS_RK = WS_RQ + (size_t)M * 256 * 4, WS_QN = WS_RK + (size_t)M * 256 * 4, WS_KN = WS_QN + (size_t)M * 256 * 4, WS_VB = WS_KN + (size_t)M * 256 * 4;
constexpr size_t WS_LDEC = WS_VB + (size_t)M * 256 * 4;
constexpr size_t WS_QNB = WS_LDEC + (size_t)M * 128 * 4;
constexpr size_t WS_KNB = WS_QNB + (size_t)M * 256 * 2;
constexpr size_t WS_PART = WS_KNB + (size_t)M * 256 * 2;
constexpr size_t WS_LAO = WS_PART + (size_t)DB * 4 * 16 * 16 * 68 * 4;
constexpr size_t WS_KSP = WS_LAO + (size_t)M * 512 * 4;
constexpr size_t WS_END = WS_KSP + (size_t)8 * 11 * 65536 * 4;
static_assert(WS_ROPE + 2 * NPOS * 32 * 4 <= WS_SS && WS_SS + 6 * SZ_SS <= WS_H, "weights region overflows");
constexpr int CW_BAR = 4096, CW_QUEUE = 8192, CW_TAIL = 12288;

constexpr int RING_OFF = 0, RING_BYTES = 131072;
constexpr int LDSCTL_OFF = 144384, MISC_OFF = LDSCTL_OFF + 320;
constexpr int LDS_BYTES = 147456;
static_assert(MISC_OFF + 128 <= LDS_BYTES, "LDS map");

#define GAS __attribute__((address_space(1)))
#define LAS __attribute__((address_space(3)))
typedef unsigned short bf16;
typedef unsigned v4u __attribute__((ext_vector_type(4)));
typedef float f32x4 __attribute__((ext_vector_type(4)));
#define LDS_WAIT() asm volatile("s_waitcnt lgkmcnt(0)" ::: "memory")
#define VM_WAIT() asm volatile("s_waitcnt vmcnt(0)" ::: "memory")
__device__ __forceinline__ unsigned f2bf(float f) { unsigned u = __builtin_bit_cast(unsigned, f); return (u + 0x7fffu + ((u >> 16) & 1u)) >> 16; }
__device__ __forceinline__ unsigned pk2(float lo, float hi) { return f2bf(lo) | (f2bf(hi) << 16); }
__device__ __forceinline__ float bf2f(bf16 b) { return __builtin_bit_cast(float, ((unsigned)b) << 16); }
__device__ __forceinline__ float bflo(unsigned w) { return __builtin_bit_cast(float, w << 16); }
__device__ __forceinline__ float bfhi(unsigned w) { return __builtin_bit_cast(float, w & 0xffff0000u); }
__device__ __forceinline__ float wave_sum(float v) {
#pragma unroll
    for (int o = 1; o < 64; o <<= 1) v += __shfl_xor(v, o);
    return v;
}
__device__ __forceinline__ float sigmoidf_(float x) { return __builtin_amdgcn_rcpf(1.0f + __expf(-x)); }
__device__ __forceinline__ float siluf_(float x) { return x * __builtin_amdgcn_rcpf(1.0f + __expf(-x)); }

#define XB_TMO      128
#define XB_XCNT(j)  (256  + 64 * (j))
#define XB_XSUB(j)  (1280 + 64 * (j))
#define XB_XGEN(j)  (2304 + 64 * (j))
#define XB_TOP      3328
#define XB_TOPGEN   3392
#define XCD_BAR_WORDS 3456
#define XB_SPIN_CAP (1u << 22)

__device__ __forceinline__ unsigned xb_ld(unsigned* p)              { return __hip_atomic_load(p, __ATOMIC_RELAXED, __HIP_MEMORY_SCOPE_AGENT); }
__device__ __forceinline__ unsigned xb_add(unsigned* p, unsigned v) { return __hip_atomic_fetch_add(p, v, __ATOMIC_RELAXED, __HIP_MEMORY_SCOPE_AGENT); }
__device__ __forceinline__ unsigned xb_xcc_id() { return (unsigned)__builtin_amdgcn_s_getreg((3 << 11) | 20) & 0xFu; }
#define XB_SPIN(cond, bar) do { unsigned _sp = 0; while (cond) { __builtin_amdgcn_s_sleep(1); \
    if ((++_sp & 255u) == 0u) { if (xb_ld(&(bar)[XB_TMO])) break; if (_sp > XB_SPIN_CAP) { atomicAdd(&(bar)[XB_TMO], 1u); break; } } } } while (0)

struct XcdBarrier { unsigned* bar; unsigned x; volatile LAS unsigned* st; };

__device__ __forceinline__ XcdBarrier xcd_barrier_post(unsigned* bar, volatile LAS unsigned* st) {
    XcdBarrier b; b.bar = bar; b.x = xb_xcc_id(); b.st = st;
    if (threadIdx.x == 0) (void)xb_add(&bar[XB_XCNT(b.x)], 1u);
    return b;
}
__device__ __forceinline__ void xcd_barrier_complete(unsigned* bar, unsigned x, unsigned& nloc, unsigned& nx) {
    const unsigned G = gridDim.x * gridDim.y * gridDim.z;
    unsigned sum, cnt, mine, sp = 0u;
    for (;;) {
        sum = 0u; cnt = 0u; mine = 0u;
#pragma unroll
        for (unsigned j = 0; j < 16; ++j) { const unsigned c = xb_ld(&bar[XB_XCNT(j)]); sum += c; cnt += (c > 0u) ? 1u : 0u; mine = (j == x) ? c : mine; }
        if (sum == G) break;
        __builtin_amdgcn_s_sleep(1);
        if ((++sp & 255u) == 0u) { if (xb_ld(&bar[XB_TMO])) break; if (sp > XB_SPIN_CAP) { atomicAdd(&bar[XB_TMO], 1u); break; } }
    }
    nloc = mine > 0u ? mine : 1u; nx = cnt > 0u ? cnt : 1u;
}
#ifndef FLAT_BAR
#define FLAT_BAR 0
#endif
__device__ __forceinline__ void flat_barrier(const XcdBarrier& b) {
    asm volatile("s_waitcnt vmcnt(0)" ::: "memory");
    __syncthreads();
    if (threadIdx.x == 0) {
        unsigned* bar = b.bar;
        asm volatile("" : "+s"(bar));
        const unsigned epoch = b.st[2] + 1u; b.st[2] = epoch; const unsigned target = epoch * gridDim.x;
        __builtin_amdgcn_fence(__ATOMIC_RELEASE, "agent");
        asm volatile("s_waitcnt vmcnt(0)" ::: "memory");
        (void)xb_add(&bar[XB_TOP], 1u);
        unsigned sp = 0u;
        while (xb_ld(&bar[XB_TOP]) < target) { __builtin_amdgcn_s_sleep(1); if ((++sp & 255u) == 0u) { if (xb_ld(&bar[XB_TMO])) break; if (sp > XB_SPIN_CAP) { atomicAdd(&bar[XB_TMO], 1u); break; } } }
        __builtin_amdgcn_fence(__ATOMIC_ACQUIRE, "agent");
        asm volatile("s_waitcnt vmcnt(0)" ::: "memory");
    }
    __syncthreads();
}
template <bool FIRST> __device__ __forceinline__ void xcd_barrier(const XcdBarrier& b) {
    if (FLAT_BAR) { flat_barrier(b); return; }
    asm volatile("s_waitcnt vmcnt(0)" ::: "memory");
    __syncthreads();
    if (threadIdx.x == 0) {
        unsigned* bar = b.bar;
        asm volatile("" : "+s"(bar));
        __builtin_amdgcn_s_waitcnt(0);
        unsigned nloc = b.st[0], nx = b.st[1];
        if (FIRST) { if (nloc == 0u) { xcd_barrier_complete(bar, b.x, nloc, nx); b.st[0] = nloc; b.st[1] = nx; } }
        const unsigned old = xb_add(&bar[XB_XSUB(b.x)], 1u);
        const unsigned gen = old / nloc;
        if (old + 1u == (gen + 1u) * nloc) {
            __builtin_amdgcn_fence(__ATOMIC_RELEASE, "agent");
            asm volatile("s_waitcnt vmcnt(0)" ::: "memory");
            const unsigned og = xb_add(&bar[XB_TOP], 1u);
            const unsigned tg = og / nx;
            if (og + 1u == (tg + 1u) * nx) {
#pragma unroll
                for (unsigned j = 0; j < 16; ++j) (void)__hip_atomic_fetch_add(&bar[XB_XGEN(j)], 1u, __ATOMIC_RELAXED, __HIP_MEMORY_SCOPE_AGENT);
            }
        }
        XB_SPIN(xb_ld(&bar[XB_XGEN(b.x)]) == gen, bar);
        __builtin_amdgcn_fence(__ATOMIC_ACQUIRE, "agent");
        asm volatile("s_waitcnt vmcnt(0)" ::: "memory");
    }
    __syncthreads();
}

struct Params { const float* in[N_INPUTS]; float* out; unsigned char* ws; float inv_freq[32]; };
static_assert(sizeof(Params) == N_INPUTS * 8 + 16 + 128, "Params has no padding");

struct Ctx {
    const float* const* in; float* out; unsigned char* ws;
    LAS unsigned char* lds;
    int G;
};
#define THREAD_IDS() int tid_ = threadIdx.x; asm volatile("" : "+v"(tid_)); const int tid = tid_, lane = tid & 63, wave = __builtin_amdgcn_readfirstlane(tid >> 6), gw = blockIdx.x * NWAVES + wave, NGW = C.G * NWAVES; (void)tid; (void)lane; (void)wave; (void)gw; (void)NGW
#define WSP(T, off) ((T*)(C.ws + (off)))

__device__ __forceinline__ float rstd_of(const float* ssp, int row) {
    const f32x4 a = *(const f32x4*)(ssp + (size_t)row * 16), b = *(const f32x4*)(ssp + (size_t)row * 16 + 4), c = *(const f32x4*)(ssp + (size_t)row * 16 + 8), d = *(const f32x4*)(ssp + (size_t)row * 16 + 12);
    const float s = (((a[0] + a[1]) + (a[2] + a[3])) + ((b[0] + b[1]) + (b[2] + b[3]))) + (((c[0] + c[1]) + (c[2] + c[3])) + ((d[0] + d[1]) + (d[2] + d[3])));
    return rsqrtf(s * (1.0f / D) + EPS);
}
__device__ __forceinline__ void rstd8(const float* ssp, int row0, int fq, float (&rs)[8]) {
    f32x4 sv[8];
#pragma unroll
    for (int i = 0; i < 8; ++i) sv[i] = *(const f32x4*)(ssp + (size_t)(row0 + (i >> 2) * 128 + (i & 3) * 16) * 16 + 4 * fq);
#pragma unroll
    for (int i = 0; i < 8; ++i) { float s = (sv[i][0] + sv[i][1]) + (sv[i][2] + sv[i][3]); s += __shfl_xor(s, 16); s += __shfl_xor(s, 32); rs[i] = rsqrtf(s * (1.0f / D) + EPS); }
}
#define EPI_IDS() int t_ = threadIdx.x; asm volatile("" : "+v"(t_)); const int wid_ = __builtin_amdgcn_readfirstlane(t_ >> 6), wr = wid_ >> 2, wc = wid_ & 3, fr = t_ & 15, fq = (t_ & 63) >> 4
struct EpiGLU {
    static constexpr bool PERM = true;
    bf16* act; const float* ss;
    __device__ __forceinline__ void operator()(const pg8::f32x4 (&acc)[2][2][4][2], const pg8::Unit& u, int, int, int, int) const {
        EPI_IDS();
        const int row0 = u.pm * 256 + wr * 64 + fr, col0 = u.pn * 128 + wc * 32 + 8 * fq;
        float rs[8]; rstd8(ss, row0, fq, rs);
#pragma unroll
        for (int ai = 0; ai < 2; ++ai)
#pragma unroll
            for (int m = 0; m < 4; ++m) {
                const int row = row0 + ai * 128 + m * 16; const float rstd = rs[ai * 4 + m];
                float o[8];
#pragma unroll
                for (int n = 0; n < 2; ++n)
#pragma unroll
                    for (int j = 0; j < 4; ++j) { const float g = acc[ai][0][m][n][j] * rstd, up = acc[ai][1][m][n][j] * rstd; o[n * 4 + j] = siluf_(g) * up; }
                v4u w; w.x = pg8::cvt_pk_bf16(o[0], o[1]); w.y = pg8::cvt_pk_bf16(o[2], o[3]); w.z = pg8::cvt_pk_bf16(o[4], o[5]); w.w = pg8::cvt_pk_bf16(o[6], o[7]);
                *(v4u*)(act + (size_t)row * DFF + col0) = w;
            }
    }
};
template <bool FINAL, int SCALE2> struct EpiRes {
    static constexpr bool PERM = true;
    float* h; bf16* hb; float* ssout; float* out;
    __device__ __forceinline__ void rowgroup(const pg8::f32x4 (&a)[2][2], int row, int col0, int pn, int wc, int fq) const {
        v4u hw2[2];
#pragma unroll
        for (int bj = 0; bj < 2; ++bj) hw2[bj] = *(const v4u*)(hb + (size_t)row * D + col0 + bj * 128);
        rowgroup_pre(a, hw2, row, col0, pn, wc, fq);
    }
    __device__ __forceinline__ void rowgroup_pre(const pg8::f32x4 (&a)[2][2], const v4u (&hw2)[2], int row, int col0, int pn, int wc, int fq) const {
        constexpr float scale = 0.5f * SCALE2; float sq = 0.f;
        long yoff = -1;
        if (FINAL) { if (row < MP) { const int b = row / L, pos = row - b * L; if (pos >= NMETA) yoff = (long)O_YP + ((long)b * SEQ + (pos - NMETA)) * D; } else if (row < MR) yoff = (long)O_YS + (long)(row - MP) * D; }
#pragma unroll
        for (int bj = 0; bj < 2; ++bj) {
            const size_t off = (size_t)row * D + col0 + bj * 128;
            const v4u hw = hw2[bj];
            f32x4 h0 = (f32x4){bflo(hw.x), bfhi(hw.x), bflo(hw.y), bfhi(hw.y)}, h1 = (f32x4){bflo(hw.z), bfhi(hw.z), bflo(hw.w), bfhi(hw.w)};
            h0 = h0 + a[bj][0] * scale; h1 = h1 + a[bj][1] * scale;
            v4u w; w.x = pg8::cvt_pk_bf16(h0[0], h0[1]); w.y = pg8::cvt_pk_bf16(h0[2], h0[3]); w.z = pg8::cvt_pk_bf16(h1[0], h1[1]); w.w = pg8::cvt_pk_bf16(h1[2], h1[3]);
            *(v4u*)(hb + off) = w;
            sq += (h0[0] * h0[0] + h0[1] * h0[1]) + (h0[2] * h0[2] + h0[3] * h0[3]) + (h1[0] * h1[0] + h1[1] * h1[1]) + (h1[2] * h1[2] + h1[3] * h1[3]);
            if (FINAL && yoff >= 0) { *(f32x4*)(out + yoff + col0 + bj * 128) = h0; *(f32x4*)(out + yoff + col0 + bj * 128 + 4) = h1; }
        }
        sq += __shfl_xor(sq, 16); sq += __shfl_xor(sq, 32);
        if (fq == 0 && ssout) ssout[(size_t)row * 16 + pn * 4 + wc] = sq;
    }
    __device__ __forceinline__ void operator()(const pg8::f32x4 (&acc)[2][2][4][2], const pg8::Unit& u, int, int, int, int) const {
        EPI_IDS();
        const int row0 = u.pm * 256 + wr * 64 + fr, col0 = u.pn * 256 + wc * 32 + 8 * fq;
#pragma unroll
        for (int ai = 0; ai < 2; ++ai) {
            v4u hw[4][2];
#pragma unroll
            for (int m = 0; m < 4; ++m)
#pragma unroll
                for (int bj = 0; bj < 2; ++bj) hw[m][bj] = *(const v4u*)(hb + (size_t)(row0 + ai * 128 + m * 16) * D + col0 + bj * 128);
            __builtin_amdgcn_sched_barrier(0);
#pragma unroll
            for (int m = 0; m < 4; ++m) {
                const pg8::f32x4 a[2][2] = {{acc[ai][0][m][0], acc[ai][0][m][1]}, {acc[ai][1][m][0], acc[ai][1][m][1]}};
                rowgroup_pre(a, hw[m], row0 + ai * 128 + m * 16, col0, u.pn, wc, fq);
            }
            __builtin_amdgcn_sched_barrier(0);
        }
    }
};
struct EpiZ {
    static constexpr bool PERM = true;
    bf16* zmix; bf16* gates; const float* ss; const float* bias;
    __device__ __forceinline__ void operator()(const pg8::f32x4 (&acc)[2][2][4][2], const pg8::Unit& u, int, int, int, int) const {
        EPI_IDS();
        const int row0 = u.pm * 256 + wr * 64 + fr, col0 = u.pn * 256 + wc * 32 + 8 * fq; const bool isgate = u.pn >= NMIXP / 256;
        f32x4 bv[2][2];
#pragma unroll
        for (int bj = 0; bj < 2; ++bj)
#pragma unroll
            for (int n = 0; n < 2; ++n) bv[bj][n] = *(const f32x4*)(bias + col0 + bj * 128 + 4 * n);
        float rs[8]; rstd8(ss, row0, fq, rs);
#pragma unroll
        for (int ai = 0; ai < 2; ++ai)
#pragma unroll
            for (int m = 0; m < 4; ++m) {
                const int row = row0 + ai * 128 + m * 16; const float rstd = rs[ai * 4 + m];
                if (isgate) {
                    f32x4 E4[4], I4[4];
#pragma unroll
                    for (int bj = 0; bj < 2; ++bj)
#pragma unroll
                        for (int n = 0; n < 2; ++n) { const f32x4 z = acc[ai][bj][m][n] * rstd + bv[bj][n];
#pragma unroll
                            for (int j = 0; j < 4; ++j) { const float e = fminf(1.0f + __expf(-z[j]), 1099511627776.0f); E4[2 * bj + n][j] = e; I4[2 * bj + n][j] = __builtin_amdgcn_rcpf(e); } }
                    const int d0 = 64 * (u.pn - NMIXP / 256) + 16 * wc + 4 * fq; bf16* gp = gates + (size_t)row * NGATE + d0;
#pragma unroll
                    for (int s = 0; s < 4; ++s) { f32x4 o = I4[s];
                        if (s < 3) o = E4[s + 1] * I4[s];
                        *(unsigned long long*)(gp + s * D) = (unsigned long long)pg8::cvt_pk_bf16(o[0], o[1]) | ((unsigned long long)pg8::cvt_pk_bf16(o[2], o[3]) << 32); }
                } else {
#pragma unroll
                    for (int bj = 0; bj < 2; ++bj) {
                        const f32x4 v0 = acc[ai][bj][m][0] * rstd + bv[bj][0], v1 = acc[ai][bj][m][1] * rstd + bv[bj][1];
                        v4u w; w.x = pg8::cvt_pk_bf16(v0[0], v0[1]); w.y = pg8::cvt_pk_bf16(v0[2], v0[3]); w.z = pg8::cvt_pk_bf16(v1[0], v1[1]); w.w = pg8::cvt_pk_bf16(v1[2], v1[3]);
                        *(v4u*)(zmix + (size_t)row * NMIXP + col0 + bj * 128) = w;
                    }
                }
            }
    }
};
struct EpiPartial {
    static constexpr bool PERM = true;
    float* part;
    __device__ __forceinline__ void operator()(const pg8::f32x4 (&acc)[2][2][4][2], const pg8::Unit& u, int, int, int, int) const {
        int t_ = threadIdx.x; asm volatile("" : "+v"(t_));
        const int slot = blockIdx.x;
        float* p = part + (size_t)slot * 65536 + (size_t)t_ * 4;
#pragma unroll
        for (int ai = 0; ai < 2; ++ai)
#pragma unroll
            for (int bj = 0; bj < 2; ++bj)
#pragma unroll
                for (int m = 0; m < 4; ++m)
#pragma unroll
                    for (int n = 0; n < 2; ++n) *(pg8::f32x4*)(p + (size_t)((((ai * 2 + bj) * 4 + m) * 2 + n) * 2048)) = acc[ai][bj][m][n];
        (void)u;
    }
};
__device__ __forceinline__ void tail_group_sync(unsigned* cnt, unsigned target, unsigned* bar) {
    asm volatile("s_waitcnt vmcnt(0)" ::: "memory");
    __syncthreads();
    if (threadIdx.x == 0) {
        __builtin_amdgcn_fence(__ATOMIC_RELEASE, "agent");
        asm volatile("s_waitcnt vmcnt(0)" ::: "memory");
        (void)xb_add(cnt, 1u);
        XB_SPIN(xb_ld(cnt) < target, bar);
        __builtin_amdgcn_fence(__ATOMIC_ACQUIRE, "agent");
        asm volatile("s_waitcnt vmcnt(0)" ::: "memory");
    }
    __syncthreads();
}
template <int NSPLIT, class Epi> __device__ __forceinline__ void ksp_finalize_local(const float* part, const pg8::StaticOrder& so, int limit, const Epi& E, unsigned* cnt0, unsigned* bar) {
    const int ntail = so.nwg - limit, c = blockIdx.x;
    if (c >= ntail * NSPLIT) return;
    const int tt = c / NSPLIT;
    tail_group_sync(cnt0 + 64 * tt, (unsigned)NSPLIT, bar);
    for (int j = c % NSPLIT; j < 8; j += NSPLIT) {
        const int ai = (j >> 2) & 1, m = j & 3;
        EPI_IDS();
        pg8::f32x4 a[2][2];
#pragma unroll
        for (int bj = 0; bj < 2; ++bj)
#pragma unroll
            for (int n = 0; n < 2; ++n) { pg8::f32x4 s = {0.f, 0.f, 0.f, 0.f};
#pragma unroll
                for (int k = 0; k < NSPLIT; ++k) s = s + *(const pg8::f32x4*)(part + (size_t)(tt * NSPLIT + k) * 65536 + (size_t)((((ai * 2 + bj) * 4 + m) * 2 + n) * 2048) + (size_t)t_ * 4);
                a[bj][n] = s; }
        pg8::Unit u; so.unit_of(limit + tt, u);
        E.rowgroup(a, u.pm * 256 + wr * 64 + fr + ai * 128 + m * 16, u.pn * 256 + wc * 32 + 8 * fq, u.pn, wc, fq);
    }
}
template <int NSPLIT, class Epi> __device__ __forceinline__ void ksp_finalize(const float* part, const pg8::StaticOrder& so, int limit, const Epi& E) {
    const int ntail = so.nwg - limit;
    for (int it = blockIdx.x; it < ntail * 8; it += gridDim.x) {
        const int tt = it >> 3, ai = (it >> 2) & 1, m = it & 3;
        EPI_IDS();
        pg8::f32x4 a[2][2];
#pragma unroll
        for (int bj = 0; bj < 2; ++bj)
#pragma unroll
            for (int n = 0; n < 2; ++n) { pg8::f32x4 s = {0.f, 0.f, 0.f, 0.f};
#pragma unroll
                for (int k = 0; k < NSPLIT; ++k) s = s + *(const pg8::f32x4*)(part + (size_t)(tt * NSPLIT + k) * 65536 + (size_t)((((ai * 2 + bj) * 4 + m) * 2 + n) * 2048) + (size_t)t_ * 4);
                a[bj][n] = s; }
        pg8::Unit u; so.unit_of(limit + tt, u);
        E.rowgroup(a, u.pm * 256 + wr * 64 + fr + ai * 128 + m * 16, u.pn * 256 + wc * 32 + 8 * fq, u.pn, wc, fq);
    }
}

struct EpiMergeR {
    static constexpr bool PERM = true;
    bf16* merged; const bf16* gates;
    __device__ __forceinline__ void mid(pg8::f32x4 (&acc)[2][2][4][2], const pg8::Unit& u, int seg, int) const {
        EPI_IDS();
        const int row0 = u.pm * 256 + wr * 64 + fr, col0 = u.pn * 256 + wc * 32 + 8 * fq;
#pragma unroll
        for (int ai = 0; ai < 2; ++ai) {
            v4u r[4][2];
#pragma unroll
            for (int m = 0; m < 4; ++m)
#pragma unroll
                for (int bj = 0; bj < 2; ++bj) r[m][bj] = *(const v4u*)(gates + (size_t)(row0 + ai * 128 + m * 16) * NGATE + (seg - 1) * D + col0 + bj * 128);
            __builtin_amdgcn_sched_barrier(0);
#pragma unroll
            for (int m = 0; m < 4; ++m)
#pragma unroll
                for (int bj = 0; bj < 2; ++bj) {
                    const v4u q = r[m][bj];
                    pg8::f32x4& a0 = acc[ai][bj][m][0]; pg8::f32x4& a1 = acc[ai][bj][m][1];
                    a0[0] *= bflo(q.x); a0[1] *= bfhi(q.x); a0[2] *= bflo(q.y); a0[3] *= bfhi(q.y); a1[0] *= bflo(q.z); a1[1] *= bfhi(q.z); a1[2] *= bflo(q.w); a1[3] *= bfhi(q.w);
                }
            __builtin_amdgcn_sched_barrier(0);
        }
    }
    __device__ __forceinline__ void operator()(const pg8::f32x4 (&acc)[2][2][4][2], const pg8::Unit& u, int, int, int, int) const {
        EPI_IDS();
        const int row0 = u.pm * 256 + wr * 64 + fr, col0 = u.pn * 256 + wc * 32 + 8 * fq;
#pragma unroll
        for (int ai = 0; ai < 2; ++ai) {
            v4u r[4][2];
#pragma unroll
            for (int m = 0; m < 4; ++m)
#pragma unroll
                for (int bj = 0; bj < 2; ++bj) r[m][bj] = *(const v4u*)(gates + (size_t)(row0 + ai * 128 + m * 16) * NGATE + 3 * D + col0 + bj * 128);
            __builtin_amdgcn_sched_barrier(0);
#pragma unroll
            for (int m = 0; m < 4; ++m) {
                const int row = row0 + ai * 128 + m * 16;
#pragma unroll
                for (int bj = 0; bj < 2; ++bj) {
                    const v4u g = r[m][bj];
                    const pg8::f32x4 a0 = acc[ai][bj][m][0], a1 = acc[ai][bj][m][1];
                    v4u w; w.x = pg8::cvt_pk_bf16(a0[0] * bflo(g.x), a0[1] * bfhi(g.x)); w.y = pg8::cvt_pk_bf16(a0[2] * bflo(g.y), a0[3] * bfhi(g.y));
                    w.z = pg8::cvt_pk_bf16(a1[0] * bflo(g.z), a1[1] * bfhi(g.z)); w.w = pg8::cvt_pk_bf16(a1[2] * bflo(g.w), a1[3] * bfhi(g.w));
                    *(v4u*)(merged + (size_t)row * D + col0 + bj * 128) = w;
                }
            }
            __builtin_amdgcn_sched_barrier(0);
        }
    }
};

__device__ __forceinline__ void merge_finalize_local(const float* part, const pg8::StaticOrder& so, int limit, bf16* merged, const bf16* gates, unsigned* cnt0, unsigned* bar) {
    const int ntail = so.nwg - limit, c = blockIdx.x;
    if (c >= ntail * 4) return;
    const int tt = c >> 2;
    tail_group_sync(cnt0 + 64 * tt, 4u, bar);
    pg8::Unit u; so.unit_of(limit + tt, u);
    for (int j = c & 3; j < 8; j += 4) {
        const int ai = (j >> 2) & 1, m = j & 3;
        EPI_IDS();
        const int row = u.pm * 256 + wr * 64 + fr + ai * 128 + m * 16, col0 = u.pn * 256 + wc * 32 + 8 * fq;
#pragma unroll
        for (int bj = 0; bj < 2; ++bj) {
            pg8::f32x4 a0 = {0.f, 0.f, 0.f, 0.f}, a1 = {0.f, 0.f, 0.f, 0.f};
#pragma unroll
            for (int k = 0; k < 4; ++k) {
                const float* pp = part + (size_t)(tt * 4 + k) * 65536 + (size_t)t_ * 4;
                a0 = a0 + *(const pg8::f32x4*)(pp + (size_t)((((ai * 2 + bj) * 4 + m) * 2 + 0) * 2048)); a1 = a1 + *(const pg8::f32x4*)(pp + (size_t)((((ai * 2 + bj) * 4 + m) * 2 + 1) * 2048));
                const v4u r = *(const v4u*)(gates + (size_t)row * NGATE + k * D + col0 + bj * 128);
                a0[0] *= bflo(r.x); a0[1] *= bfhi(r.x); a0[2] *= bflo(r.y); a0[3] *= bfhi(r.y); a1[0] *= bflo(r.z); a1[1] *= bfhi(r.z); a1[2] *= bflo(r.w); a1[3] *= bfhi(r.w);
            }
            v4u w; w.x = pg8::cvt_pk_bf16(a0[0], a0[1]); w.y = pg8::cvt_pk_bf16(a0[2], a0[3]); w.z = pg8::cvt_pk_bf16(a1[0], a1[1]); w.w = pg8::cvt_pk_bf16(a1[2], a1[3]);
            *(v4u*)(merged + (size_t)row * D + col0 + bj * 128) = w;
        }
    }
}
__host__ __device__ __forceinline__ int gate_col(int m) { const int br = m >> 10, d = m & 1023, dd = d & 63; return 256 * (d >> 6) + 128 * (br >> 1) + 32 * (dd >> 4) + 8 * ((dd >> 2) & 3) + 4 * (br & 1) + (dd & 3); }
__host__ __device__ __forceinline__ int gate_src(int c) { const int ct = c & 255, br = 2 * (ct >> 7) + ((ct >> 2) & 1), d = 64 * (c >> 8) + 16 * ((ct >> 5) & 3) + 4 * ((ct >> 3) & 3) + (ct & 3); return br * 1024 + d; }
struct RowMap { int mode, a; __device__ __forceinline__ int operator()(int n) const { return mode == 0 ? n + a : (mode == 1 ? 256 * (n >> 7) + (n & 127) + a : (n < NMIX ? n : NMIXP + gate_col(n - NMIX))); } };
__device__ __forceinline__ void tr_item(const float* W, int K, int N, const float* gain, bf16* WT, int pitch, RowMap rm, LAS float* scr, int kb, int nb, int lane) {
    const int k0 = 64 * kb, n0 = 64 * nb; const int nn = n0 + 4 * (lane & 15), kr = lane >> 4;
    f32x4 v[16];
#pragma unroll
    for (int i = 0; i < 16; ++i) v[i] = (nn < N) ? *(const f32x4*)(W + (size_t)(k0 + 4 * i + kr) * N + nn) : (f32x4){0.f, 0.f, 0.f, 0.f};
#pragma unroll
    for (int i = 0; i < 16; ++i) { const int kk = 4 * i + kr; const float g = gain ? gain[k0 + kk] : 1.0f; LAS float* d = scr + kk * 65 + 4 * (lane & 15); d[0] = v[i][0] * g; d[1] = v[i][1] * g; d[2] = v[i][2] * g; d[3] = v[i][3] * g; }
    LDS_WAIT(); asm volatile("" ::: "memory");
    const int c = lane & 7;
#pragma unroll
    for (int j = 0; j < 8; ++j) { const int nl = (lane >> 3) + 8 * j; const int n = n0 + nl; const LAS float* s = scr + (8 * c) * 65 + nl;
        v4u o; o.x = pg8::cvt_pk_bf16(s[0 * 65], s[1 * 65]); o.y = pg8::cvt_pk_bf16(s[2 * 65], s[3 * 65]); o.z = pg8::cvt_pk_bf16(s[4 * 65], s[5 * 65]); o.w = pg8::cvt_pk_bf16(s[6 * 65], s[7 * 65]);
        if (n < N) *(v4u*)(WT + (size_t)rm(n) * pitch + k0 + 8 * c) = o; }
    LDS_WAIT(); asm volatile("" ::: "memory");
}
__device__ __forceinline__ void p0_prologue(const Ctx& C, const Params& P) {
    THREAD_IDS();
    LAS float* scr = (LAS float*)(C.lds + RING_OFF + wave * 16896);
    constexpr int I_FF = 16 * 44, I_DN = 44 * 16, I_IN = 16 * 113, I_BR = 4 * 4 * 16, I_OUT = 16 * 16;
    constexpr int PER_LAYER = 4 * I_FF + 2 * I_DN + I_IN + I_BR + I_OUT;
    for (int it = gw; it < DEPTH * PER_LAYER; it += NGW) {
        const int l = it / PER_LAYER; int r = it - l * PER_LAYER;
        bf16* W1a = WSP(bf16, WS_W1 + (size_t)(l * 2 + 0) * SZ_W1); bf16* W1b = WSP(bf16, WS_W1 + (size_t)(l * 2 + 1) * SZ_W1);
        bf16* Wda = WSP(bf16, WS_WD + (size_t)(l * 2 + 0) * SZ_WD); bf16* Wdb = WSP(bf16, WS_WD + (size_t)(l * 2 + 1) * SZ_WD);
        if (r < I_FF) { tr_item(C.in[I_F1G] + (size_t)l * D * DFF, D, DFF, C.in[I_NF1] + l * D, W1a, D, RowMap{1, 0}, scr, r / 44, r % 44, lane); continue; } r -= I_FF;
        if (r < I_FF) { tr_item(C.in[I_F1U] + (size_t)l * D * DFF, D, DFF, C.in[I_NF1] + l * D, W1a, D, RowMap{1, 128}, scr, r / 44, r % 44, lane); continue; } r -= I_FF;
        if (r < I_DN) { tr_item(C.in[I_F1D] + (size_t)l * D * DFF, DFF, D, nullptr, Wda, DFF, RowMap{0, 0}, scr, r / 16, r % 16, lane); continue; } r -= I_DN;
        if (r < I_FF) { tr_item(C.in[I_F2G] + (size_t)l * D * DFF, D, DFF, C.in[I_NF2] + l * D, W1b, D, RowMap{1, 0}, scr, r / 44, r % 44, lane); continue; } r -= I_FF;
        if (r < I_FF) { tr_item(C.in[I_F2U] + (size_t)l * D * DFF, D, DFF, C.in[I_NF2] + l * D, W1b, D, RowMap{1, 128}, scr, r / 44, r % 44, lane); continue; } r -= I_FF;
        if (r < I_DN) { tr_item(C.in[I_F2D] + (size_t)l * D * DFF, DFF, D, nullptr, Wdb, DFF, RowMap{0, 0}, scr, r / 16, r % 16, lane); continue; } r -= I_DN;
        if (r < I_IN) { tr_item(C.in[I_WIN] + (size_t)l * D * NIN, D, NIN, C.in[I_NMIX] + l * D, WSP(bf16, WS_WIN + (size_t)l * SZ_WIN), D, RowMap{2, 0}, scr, r / 113, r % 113, lane); continue; } r -= I_IN;
        if (r < I_BR) { const int n4 = r / 64, rr = r % 64; tr_item(C.in[I_WBR] + (size_t)(l * 4 + n4) * 256 * D, 256, D, nullptr, WSP(bf16, WS_WBR + (size_t)l * SZ_WBR) + n4 * 256, D, RowMap{0, 0}, scr, rr / 16, rr % 16, lane); continue; } r -= I_BR;
        tr_item(C.in[I_WOUT] + (size_t)l * D * D, D, D, nullptr, WSP(bf16, WS_WOUT + (size_t)l * SZ_WOUT), D, RowMap{0, 0}, scr, r / 16, r % 16, lane);
    }
    const int gt = gw * 64 + lane, NGT = NGW * 64;
    for (int i = gt; i < 2 * 240 * 128; i += NGT) { const int l = i / (240 * 128), r = i % (240 * 128); *(v4u*)(C.ws + WS_WIN + (size_t)l * SZ_WIN + ((size_t)NMIX * D) * 2 + (size_t)r * 16) = (v4u){0u, 0u, 0u, 0u}; }
    for (int i = gt; i < (M - MR) * 128; i += NGT) *(v4u*)(C.ws + WS_BR + (size_t)MR * D * 2 + (size_t)i * 16) = (v4u){0u, 0u, 0u, 0u};
    for (int i = gt; i < 2 * NINP; i += NGT) { const int l = i / NINP, j = i % NINP; float v = 0.f; if (j < NMIX) v = C.in[I_BIN][l * NIN + j]; else if (j >= NMIXP) v = C.in[I_BIN][l * NIN + NMIX + gate_src(j - NMIXP)]; WSP(float, WS_BINP)[i] = v; }
    for (int i = gt; i < NPOS * 32; i += NGT) { const int pi = i >> 5, fi = i & 31; const int pos = pi < L ? pi : PAST + (pi - L);
        const float angf = (float)pos * P.inv_freq[fi];
        const double a = (double)angf; const double k = rint(a * 0.15915494309189535); const double rr = (a - k * 6.283185307179586) - k * 2.4492935982947064e-16;
        const float rf = (float)rr; WSP(float, WS_ROPE)[i] = cosf(rf); WSP(float, WS_ROPE)[NPOS * 32 + i] = sinf(rf); }
    float* H = WSP(float, WS_H); bf16* HB = WSP(bf16, WS_HB); float* SS0 = WSP(float, WS_SS);
    for (int row = gw; row < M; row += NGW) {
        const float* src = nullptr;
        if (row < MP) { const int b = row / L, pos = row - b * L; src = pos < NMETA ? C.in[I_META] + (size_t)pos * D : C.in[I_XP] + ((size_t)b * SEQ + (pos - NMETA)) * D; }
        else if (row < MR) src = C.in[I_XS] + (size_t)(row - MP) * D;
        float s = 0.f;
#pragma unroll
        for (int j = 0; j < 4; ++j) { f32x4 v = src ? *(const f32x4*)(src + 256 * j + 4 * lane) : (f32x4){0.f, 0.f, 0.f, 0.f};
            s += (v[0] * v[0] + v[1] * v[1]) + (v[2] * v[2] + v[3] * v[3]);
            unsigned long long w = (unsigned long long)pk2(v[0], v[1]) | ((unsigned long long)pk2(v[2], v[3]) << 32);
            *(unsigned long long*)(HB + (size_t)row * D + 256 * j + 4 * lane) = w; }
        s = wave_sum(s); if (lane < 16) SS0[(size_t)row * 16 + lane] = lane == 0 ? s : 0.f;
    }
}

__device__ __forceinline__ float lam_of(const Ctx& C, int l, float lam_init) {
    THREAD_IDS();
    float a = 0.f, b = 0.f;
#pragma unroll 1
    for (int i = 0; i < 32; ++i) { a += C.in[I_LQ1][l * 32 + i] * C.in[I_LK1][l * 32 + i]; b += C.in[I_LQ2][l * 32 + i] * C.in[I_LK2][l * 32 + i]; }
    return __expf(a) - __expf(b) + lam_init;
}
__device__ __forceinline__ int t5_bucket(int n) {
    if (n < 16) return n;
    return 16 + (n >= 19) + (n >= 21) + (n >= 24) + (n >= 27) + (n >= 31) + (n >= 35) + (n >= 40) + (n >= 46) + (n >= 52) + (n >= 59) + (n >= 67) + (n >= 77) + (n >= 87) + (n >= 99) + (n >= 113);
}
__device__ __forceinline__ void unpack8(const v4u w, float (&x)[8]) { x[0] = bflo(w.x); x[1] = bfhi(w.x); x[2] = bflo(w.y); x[3] = bfhi(w.y); x[4] = bflo(w.z); x[5] = bfhi(w.z); x[6] = bflo(w.w); x[7] = bfhi(w.w); }
__device__ __forceinline__ v4u pack8(const float (&x)[8]) { v4u w; w.x = pg8::cvt_pk_bf16(x[0], x[1]); w.y = pg8::cvt_pk_bf16(x[2], x[3]); w.z = pg8::cvt_pk_bf16(x[4], x[5]); w.w = pg8::cvt_pk_bf16(x[6], x[7]); return w; }
__device__ __forceinline__ void n1_prep(const Ctx& C, int l) {
    THREAD_IDS();
    const bf16* ZM = WSP(bf16, WS_ZMIX); float* UB = WSP(float, WS_UBUF); float* RQ = WSP(float, WS_RQ); float* RK = WSP(float, WS_RK);
    float* LD = WSP(float, WS_LDEC); const float* COS = WSP(float, WS_ROPE); const float* SIN = COS + NPOS * 32; bf16* QNB = WSP(bf16, WS_QNB); bf16* KNB = WSP(bf16, WS_KNB);
    const int i = lane & 31;
    float qg[8], kg[8];
#pragma unroll
    for (int j = 0; j < 8; ++j) { qg[j] = C.in[I_QN][l * 32 + ((8 * i) & 31) + j] * (0.17677669529663687f * 1.4426950408889634f); kg[j] = C.in[I_KN][l * 32 + ((8 * i) & 31) + j]; }
    const int isk = i >> 4, hh = (i >> 2) & 3, jc = i & 3;
    for (int rp0 = gw * 2; rp0 < MR / 2; rp0 += NGW * 2) {
        v4u Wa[2], Wg[2], Wq[2], Wk[2], Wv[2], W1[2], W2[2], G0[2], G1[2];
#pragma unroll
        for (int u = 0; u < 2; ++u) { const int r = min(2 * (rp0 + u) + (lane >> 5), MR - 1); const bf16* z = ZM + (size_t)r * NMIXP; const bf16* zr = z + (isk ? R_K : R_Q) + hh * 64 + 8 * jc;
            Wa[u] = *(const v4u*)(z + C_A + 8 * i); Wg[u] = *(const v4u*)(z + C_G + 8 * i); Wq[u] = *(const v4u*)(z + D_Q + 8 * i); Wk[u] = *(const v4u*)(z + D_K + 8 * i); Wv[u] = *(const v4u*)(z + D_V + 8 * i);
            W1[u] = *(const v4u*)zr; W2[u] = *(const v4u*)(zr + 32); G0[u] = *(const v4u*)(z + G_LOW); G1[u] = *(const v4u*)(z + G_LOW + 8); }
#pragma unroll
        for (int u = 0; u < 2; ++u) {
        if (rp0 + u >= MR / 2) break;
        const int r = 2 * (rp0 + u) + (lane >> 5);
        const int pi = r < MP ? r % L : L + ((r - MP) & 7);
        float* kout = r < MP ? C.out + O_KP + ((size_t)l * MP + r) * 256 : C.out + O_KS + ((size_t)l * MS + (r - MP)) * 256;
        float* vout = r < MP ? C.out + O_VP + ((size_t)l * MP + r) * 256 : C.out + O_VS + ((size_t)l * MS + (r - MP)) * 256;
        const v4u wa = Wa[u], wg = Wg[u], wq = Wq[u], wk = Wk[u], wv = Wv[u], w1 = W1[u], w2 = W2[u], gl0 = G0[u], gl1 = G1[u];
        float x[8], y[8];
        unpack8(wa, x); unpack8(wg, y);
#pragma unroll
        for (int j = 0; j < 8; ++j) x[j] *= sigmoidf_(y[j]);
        *(f32x4*)(UB + (size_t)r * 256 + 8 * i) = (f32x4){x[0], x[1], x[2], x[3]}; *(f32x4*)(UB + (size_t)r * 256 + 8 * i + 4) = (f32x4){x[4], x[5], x[6], x[7]};
        unpack8(wv, x);
        *(f32x4*)(vout + 8 * i) = (f32x4){x[0], x[1], x[2], x[3]}; *(f32x4*)(vout + 8 * i + 4) = (f32x4){x[4], x[5], x[6], x[7]};
        unpack8(wq, x);
        { float s = 0.f;
#pragma unroll
          for (int j = 0; j < 8; ++j) s += x[j] * x[j];
          s += __shfl_xor(s, 1); s += __shfl_xor(s, 2); const float rs = rsqrtf(s * (1.0f / 32) + EPS);
#pragma unroll
          for (int j = 0; j < 8; ++j) x[j] = x[j] * rs * qg[j];
          *(v4u*)(QNB + (size_t)r * 256 + 8 * i) = pack8(x); }
        unpack8(wk, x);
        { float s = 0.f;
#pragma unroll
          for (int j = 0; j < 8; ++j) s += x[j] * x[j];
          s += __shfl_xor(s, 1); s += __shfl_xor(s, 2); const float rs = rsqrtf(s * (1.0f / 32) + EPS);
#pragma unroll
          for (int j = 0; j < 8; ++j) x[j] = x[j] * rs * kg[j];
          *(v4u*)(KNB + (size_t)r * 256 + 8 * i) = pack8(x);
          *(f32x4*)(kout + 8 * i) = (f32x4){x[0], x[1], x[2], x[3]}; *(f32x4*)(kout + 8 * i + 4) = (f32x4){x[4], x[5], x[6], x[7]}; }
        unpack8(w1, x); unpack8(w2, y);
        { const f32x4 c0 = *(const f32x4*)(COS + pi * 32 + 8 * jc), c1 = *(const f32x4*)(COS + pi * 32 + 8 * jc + 4), s0 = *(const f32x4*)(SIN + pi * 32 + 8 * jc), s1 = *(const f32x4*)(SIN + pi * 32 + 8 * jc + 4);
          const float sc = isk ? 0.125f : 1.0f; float o1[8], o2[8];
#pragma unroll
          for (int j = 0; j < 8; ++j) { const float cs = j < 4 ? c0[j & 3] : c1[j & 3], sn = j < 4 ? s0[j & 3] : s1[j & 3]; o1[j] = (x[j] * cs - y[j] * sn) * sc; o2[j] = (x[j] * sn + y[j] * cs) * sc; }
          float* ro = (isk ? RK : RQ) + (size_t)r * 256 + hh * 64 + 8 * jc;
          *(f32x4*)ro = (f32x4){o1[0], o1[1], o1[2], o1[3]}; *(f32x4*)(ro + 4) = (f32x4){o1[4], o1[5], o1[6], o1[7]}; *(f32x4*)(ro + 32) = (f32x4){o2[0], o2[1], o2[2], o2[3]}; *(f32x4*)(ro + 36) = (f32x4){o2[4], o2[5], o2[6], o2[7]}; }
        { float gv[16]; unpack8(gl0, x); unpack8(gl1, y);
#pragma unroll
          for (int j = 0; j < 8; ++j) { gv[j] = x[j]; gv[8 + j] = y[j]; }
          f32x4 gp = *(const f32x4*)(C.in[I_GAB] + l * 128 + 4 * i);
#pragma unroll
          for (int k = 0; k < 16; ++k) { const f32x4 aw = *(const f32x4*)(C.in[I_GAW] + (size_t)(l * 16 + k) * 128 + 4 * i); gp = gp + aw * gv[k]; }
          f32x4 ls;
#pragma unroll
          for (int j = 0; j < 4; ++j) ls[j] = (fminf(gp[j], 0.f) - log1pf(__expf(-fabsf(gp[j])))) * (1.0f / 16.0f);
          *(f32x4*)(LD + (size_t)r * 128 + 4 * i) = ls; }
        }
    }
}
__device__ __forceinline__ void conv_rows_item(const Ctx& C, int l, int item) {
    THREAD_IDS();
    const float* UB = WSP(float, WS_UBUF); bf16* BR = WSP(bf16, WS_BR);
    const float* cw = C.in[I_CW] + (size_t)l * 31 * 256; const float* sc = C.in[I_SCONV];
    LAS float* wl = (LAS float*)C.lds;
    for (int i = tid; i < 31 * 256; i += NWAVES * 64) wl[i] = cw[i];
    LDS_WAIT(); __builtin_amdgcn_s_barrier(); asm volatile("" ::: "memory");
    const int r0 = item * 64 + wave * 8;
    if (r0 < MR) {
        const bool smp = r0 >= MP; const int b = smp ? (r0 - MP) >> 3 : r0 / L; const int p0 = smp ? 0 : r0 - b * L; const int rb = smp ? MP + b * 8 : b * L;
        const LAS f32x4* wl4 = (const LAS f32x4*)wl + lane;
        float acc[8][4];
        { const f32x4 cb = *(const f32x4*)(C.in[I_CB] + l * 256 + 4 * lane);
#pragma unroll
          for (int i = 0; i < 8; ++i)
#pragma unroll
              for (int k = 0; k < 4; ++k) acc[i][k] = cb[k]; }
#pragma unroll 1
        for (int jb = 0; jb < 40; jb += 8) {
            float uv[8][4];
#pragma unroll
            for (int jj = 0; jj < 8; ++jj) { const int j = jb + jj; const int q = p0 - 30 + j;
                const float* src = q >= 0 ? UB + (size_t)(rb + q) * 256 + 4 * lane : sc + (((size_t)l * DB + b) * 30 + (q + 30)) * 256 + 4 * lane;
                const bool ok = j < 38 && (q >= 0 || smp);
                const f32x4 v = ok ? *(const f32x4*)src : (f32x4){0.f, 0.f, 0.f, 0.f};
#pragma unroll
                for (int k = 0; k < 4; ++k) uv[jj][k] = v[k]; }
#pragma unroll
            for (int jj = 0; jj < 8; ++jj)
#pragma unroll
                for (int i = 0; i < 8; ++i) { const int t = jb + jj - i;
                    if (t >= 0 && t <= 30) { const f32x4 w = wl4[t * 64];
#pragma unroll
                        for (int k = 0; k < 4; ++k) acc[i][k] += w[k] * uv[jj][k]; } }
        }
        const f32x4 lg = *(const f32x4*)(C.in[I_CLG] + l * 256 + 4 * lane), lb = *(const f32x4*)(C.in[I_CLB] + l * 256 + 4 * lane);
#pragma unroll
        for (int i = 0; i < 8; ++i) { const int r = r0 + i;
            float s = (acc[i][0] + acc[i][1]) + (acc[i][2] + acc[i][3]); const float mean = wave_sum(s) * (1.0f / 256);
            float q2 = 0.f;
#pragma unroll
            for (int k = 0; k < 4; ++k) { acc[i][k] -= mean; q2 += acc[i][k] * acc[i][k]; }
            const float rstd = rsqrtf(wave_sum(q2) * (1.0f / 256) + EPS);
            float y[4];
#pragma unroll
            for (int k = 0; k < 4; ++k) y[k] = siluf_(acc[i][k] * rstd * lg[k] + lb[k]);
            *(unsigned long long*)(BR + (size_t)r * D + 4 * lane) = (unsigned long long)pk2(y[0], y[1]) | ((unsigned long long)pk2(y[2], y[3]) << 32); }
    }
    LDS_WAIT(); __builtin_amdgcn_s_barrier(); asm volatile("" ::: "memory");
}
__device__ __forceinline__ void conv_state_item(const Ctx& C, int l, int part, int nparts) {
    THREAD_IDS();
    const float* UB = WSP(float, WS_UBUF); const float* sc = C.in[I_SCONV];
    for (int i = part * NWAVES * 64 + tid; i < BATCH * 30 * 256; i += nparts * NWAVES * 64) { const int c = i & 255, ii = (i >> 8) % 30, b = i / (30 * 256); C.out[O_CP + (size_t)l * BATCH * 30 * 256 + i] = UB[(size_t)(b * L + L - 30 + ii) * 256 + c]; }
    for (int i = part * NWAVES * 64 + tid; i < DB * 30 * 256; i += nparts * NWAVES * 64) { const int c = i & 255, ii = (i >> 8) % 30, b = i / (30 * 256);
        C.out[O_CS + (size_t)l * DB * 30 * 256 + i] = ii < 22 ? sc[(((size_t)l * DB + b) * 30 + 8 + ii) * 256 + c] : UB[(size_t)(MP + b * 8 + ii - 22) * 256 + c]; }
}
template <int DK, bool RET> __device__ __forceinline__ void la_seq(const Ctx& C, int l, bool smp, int b, int h) {
    THREAD_IDS();
    const bf16* ZM = WSP(bf16, WS_ZMIX); const float* RQ = WSP(float, WS_RQ); const float* RK = WSP(float, WS_RK); const float* LD = WSP(float, WS_LDEC); bf16* BR = WSP(bf16, WS_BR);
    const int nt = smp ? DS : L; const int row0 = smp ? MP + b * DS : b * L;
    float S[DK];
    if (smp) { const float* s0 = (RET ? C.in[I_SRET] : C.in[I_SGLA]) + (((size_t)l * DB + b) * 4 + h) * DK * 64;
#pragma unroll
        for (int k = 0; k < DK; ++k) S[k] = s0[k * 64 + lane]; }
    else {
#pragma unroll
        for (int k = 0; k < DK; ++k) S[k] = 0.f; }
    const float gamma = 1.0f - exp2f(-5.0f - (float)h);
    const float gn = RET ? C.in[I_RGN][(l * 4 + h) * 64 + lane] : C.in[I_GGN][(l * 4 + h) * 64 + lane];
    for (int t = 0; t < nt; ++t) {
        const int r = row0 + t; const bf16* z = ZM + (size_t)r * NMIXP;
        float ql, kl, dl = 1.f;
        if (RET) { ql = RQ[(size_t)r * 256 + h * 64 + lane]; kl = RK[(size_t)r * 256 + h * 64 + lane]; }
        else { const int lk = lane & 31; ql = bf2f(z[G_Q + h * 32 + lk]) * 0.17677669529663687f; kl = bf2f(z[G_K + h * 32 + lk]); dl = __expf(LD[(size_t)r * 128 + h * 32 + lk]); }
        const float v = bf2f(z[(RET ? R_V : G_V) + h * 64 + lane]);
        float o = 0.f;
#pragma unroll
        for (int k = 0; k < DK; ++k) { const float qk = __shfl(ql, k), kk = __shfl(kl, k); const float dk = RET ? gamma : __shfl(dl, k);
            S[k] = dk * S[k] + kk * v; o += qk * S[k]; if ((k & 7) == 7) __builtin_amdgcn_sched_barrier(0); }
        float y;
        if (RET) { const float mean = wave_sum(o) * (1.0f / 64); const float d = o - mean; const float var = wave_sum(d * d) * (1.0f / 64); y = d * rsqrtf(var + EPS) * gn; }
        else { const float ms = wave_sum(o * o) * (1.0f / 64); y = o * rsqrtf(ms + EPS) * gn; }
        const float g = bf2f(z[(RET ? R_G : G_R) + h * 64 + lane]);
        BR[(size_t)r * D + (RET ? 256 : 512) + h * 64 + lane] = (bf16)f2bf(siluf_(g) * y);
    }
    float* so = C.out + (RET ? (smp ? O_RS + (((size_t)l * DB + b) * 4 + h) * DK * 64 : O_RP + (((size_t)l * BATCH + b) * 4 + h) * DK * 64)
                             : (smp ? O_GS + (((size_t)l * DB + b) * 4 + h) * DK * 64 : O_GP + (((size_t)l * BATCH + b) * 4 + h) * DK * 64));
#pragma unroll
    for (int k = 0; k < DK; ++k) so[k * 64 + lane] = S[k];
}
typedef short bf16x8_t __attribute__((ext_vector_type(8)));
template <int DK, bool RET> __device__ __forceinline__ void la_chunked(const Ctx& C, int l, bool smp, int b, int h) {
    THREAD_IDS();
    constexpr int QS = DK + 8, TS = 72, NKB = DK / 16, NKS = DK / 32;
    constexpr int SB = 2 * 64 * QS + 64 * TS + DK * TS + 64 * TS + 64;
    LAS bf16* SB0 = (LAS bf16*)(C.lds);
    LAS bf16* AL = SB0 + 2 * SB;
    LAS bf16* ST = AL + 64 * TS;
    const bf16* ZM = WSP(bf16, WS_ZMIX); const float* RQ = WSP(float, WS_RQ); const float* RK = WSP(float, WS_RK); const float* LD = WSP(float, WS_LDEC); bf16* BR = WSP(bf16, WS_BR);
    const int nt = smp ? DS : L, row0 = smp ? MP + b * DS : b * L, nch = (nt + 63) >> 6;
    const float lg2 = RET ? log2f(1.0f - exp2f(-5.0f - (float)h)) : 0.f;
    const int g4 = lane >> 4, c16 = lane & 15;
    const bool qwave = wave < 4; const int w4 = wave & 3;
    float Sreg[NKB][4];
    if (wave >= 4) {
        const float* s0 = (RET ? C.in[I_SRET] : C.in[I_SGLA]) + (((size_t)l * DB + b) * 4 + h) * DK * 64;
#pragma unroll
        for (int cb = 0; cb < NKB; ++cb)
#pragma unroll
            for (int r = 0; r < 4; ++r) { const int dk = cb * 16 + c16, dv = (wave - 4) * 16 + 4 * g4 + r; const float v = smp ? s0[dk * 64 + dv] : 0.f; Sreg[cb][r] = v; ST[dv * QS + dk] = (bf16)f2bf(v); }
    }
    float gnv[4];
#pragma unroll
    for (int cb = 0; cb < 4; ++cb) gnv[cb] = (RET ? C.in[I_RGN] : C.in[I_GGN])[(l * 4 + h) * 64 + cb * 16 + c16];
    float a[16]; v4u vr;
#define LA_LOAD(c) do { const size_t r_ = (size_t)(row0 + (c) * 64 + lane); const bf16* z_ = ZM + r_ * NMIXP; \
        vr = *(const v4u*)(z_ + (RET ? R_V : G_V) + h * 64 + 8 * wave); \
        if (RET) { const float* p_ = (qwave ? RQ : RK) + r_ * 256 + h * 64 + 8 * w4; const f32x4 x0 = *(const f32x4*)p_, x1 = *(const f32x4*)(p_ + 4), x2 = *(const f32x4*)(p_ + 32), x3 = *(const f32x4*)(p_ + 36); \
            a[0] = x0[0]; a[1] = x0[1]; a[2] = x0[2]; a[3] = x0[3]; a[4] = x1[0]; a[5] = x1[1]; a[6] = x1[2]; a[7] = x1[3]; a[8] = x2[0]; a[9] = x2[1]; a[10] = x2[2]; a[11] = x2[3]; a[12] = x3[0]; a[13] = x3[1]; a[14] = x3[2]; a[15] = x3[3]; } \
        else { const v4u q_ = *(const v4u*)(z_ + (qwave ? G_Q : G_K) + h * 32 + 8 * w4); const float* p_ = LD + r_ * 128 + h * 32 + 8 * w4; const f32x4 x0 = *(const f32x4*)p_, x1 = *(const f32x4*)(p_ + 4); \
            a[0] = bflo(q_.x); a[1] = bfhi(q_.x); a[2] = bflo(q_.y); a[3] = bfhi(q_.y); a[4] = bflo(q_.z); a[5] = bfhi(q_.z); a[6] = bflo(q_.w); a[7] = bfhi(q_.w); \
            a[8] = x0[0]; a[9] = x0[1]; a[10] = x0[2]; a[11] = x0[3]; a[12] = x1[0]; a[13] = x1[1]; a[14] = x1[2]; a[15] = x1[3]; } } while (0)
    LA_LOAD(0);
    int cur = 0;
    for (int i = 0; i <= nch; ++i) {
        if (i < nch) {
            const int c = i; LAS bf16* QT = SB0 + (i & 1) * SB; LAS bf16* KT = QT + 64 * QS; LAS bf16* VT = KT + 64 * QS; LAS bf16* KE = VT + 64 * TS; LAS bf16* GT = KE + DK * TS; LAS float* WT = (LAS float*)(GT + 64 * TS);
            const int nvc = min(64, nt - c * 64); const bool valid = lane < nvc;
        if (RET) {
            const float tq = (float)(lane + 1);
            if (qwave) { const float e = valid ? __builtin_amdgcn_exp2f(lg2 * tq) : 0.f;
                v4u w0, w1; w0.x = pg8::cvt_pk_bf16(a[0] * e, a[1] * e); w0.y = pg8::cvt_pk_bf16(a[2] * e, a[3] * e); w0.z = pg8::cvt_pk_bf16(a[4] * e, a[5] * e); w0.w = pg8::cvt_pk_bf16(a[6] * e, a[7] * e);
                w1.x = pg8::cvt_pk_bf16(a[8] * e, a[9] * e); w1.y = pg8::cvt_pk_bf16(a[10] * e, a[11] * e); w1.z = pg8::cvt_pk_bf16(a[12] * e, a[13] * e); w1.w = pg8::cvt_pk_bf16(a[14] * e, a[15] * e);
                *(LAS v4u*)(QT + lane * QS + 8 * w4) = w0; *(LAS v4u*)(QT + lane * QS + 32 + 8 * w4) = w1; }
            else { const float e = valid ? __builtin_amdgcn_exp2f(-lg2 * tq) : 0.f, ee = valid ? __builtin_amdgcn_exp2f(lg2 * ((float)nvc - tq)) : 0.f;
                v4u w0, w1; w0.x = pg8::cvt_pk_bf16(a[0] * e, a[1] * e); w0.y = pg8::cvt_pk_bf16(a[2] * e, a[3] * e); w0.z = pg8::cvt_pk_bf16(a[4] * e, a[5] * e); w0.w = pg8::cvt_pk_bf16(a[6] * e, a[7] * e);
                w1.x = pg8::cvt_pk_bf16(a[8] * e, a[9] * e); w1.y = pg8::cvt_pk_bf16(a[10] * e, a[11] * e); w1.z = pg8::cvt_pk_bf16(a[12] * e, a[13] * e); w1.w = pg8::cvt_pk_bf16(a[14] * e, a[15] * e);
                *(LAS v4u*)(KT + lane * QS + 8 * w4) = w0; *(LAS v4u*)(KT + lane * QS + 32 + 8 * w4) = w1;
#pragma unroll
                for (int i = 0; i < 16; i += 2) { const unsigned mine = pg8::cvt_pk_bf16(a[i] * ee, a[i + 1] * ee); const unsigned pv = (unsigned)__shfl_xor((int)mine, 1);
                    const unsigned w = (lane & 1) ? ((pv >> 16) | (mine & 0xffff0000u)) : ((mine & 0xffffu) | (pv << 16));
                    const int row = (i < 8 ? 8 * w4 + i : 32 + 8 * w4 + (i - 8)) + (lane & 1);
                    *(LAS unsigned*)(KE + row * TS + (lane & ~1)) = w; } }
        } else {
            float bb[8];
#pragma unroll
            for (int i = 0; i < 8; ++i) bb[i] = valid ? a[8 + i] : 0.f;
#pragma unroll
            for (int i = 0; i < 8; ++i) { float x = bb[i];
                x += __builtin_bit_cast(float, __builtin_amdgcn_mov_dpp(__builtin_bit_cast(int, x), 0x111, 0xf, 0xf, true));
                x += __builtin_bit_cast(float, __builtin_amdgcn_mov_dpp(__builtin_bit_cast(int, x), 0x112, 0xf, 0xf, true));
                x += __builtin_bit_cast(float, __builtin_amdgcn_mov_dpp(__builtin_bit_cast(int, x), 0x114, 0xf, 0xf, true));
                x += __builtin_bit_cast(float, __builtin_amdgcn_mov_dpp(__builtin_bit_cast(int, x), 0x118, 0xf, 0xf, true));
                const float t0 = __builtin_bit_cast(float, __builtin_amdgcn_readlane(__builtin_bit_cast(int, x), 15)), t1 = __builtin_bit_cast(float, __builtin_amdgcn_readlane(__builtin_bit_cast(int, x), 31)), t2 = __builtin_bit_cast(float, __builtin_amdgcn_readlane(__builtin_bit_cast(int, x), 47));
                bb[i] = x + (lane >= 16 ? t0 : 0.f) + (lane >= 32 ? t1 : 0.f) + (lane >= 48 ? t2 : 0.f); }
            if (qwave) {
                if (lane == 63) {
#pragma unroll
                    for (int i = 0; i < 8; ++i) WT[8 * w4 + i] = bb[i]; }
                float o8[8];
#pragma unroll
                for (int i = 0; i < 8; ++i) o8[i] = valid ? a[i] * 0.17677669529663687f * __expf(bb[i]) : 0.f;
                v4u w0; w0.x = pg8::cvt_pk_bf16(o8[0], o8[1]); w0.y = pg8::cvt_pk_bf16(o8[2], o8[3]); w0.z = pg8::cvt_pk_bf16(o8[4], o8[5]); w0.w = pg8::cvt_pk_bf16(o8[6], o8[7]);
                *(LAS v4u*)(QT + lane * QS + 8 * w4) = w0;
            } else {
                float o8[8];
#pragma unroll
                for (int i = 0; i < 8; ++i) o8[i] = valid ? a[i] * __expf(-bb[i]) : 0.f;
#pragma unroll
                for (int i = 0; i < 8; i += 2) { const float t0 = __shfl(bb[i], 63), t1 = __shfl(bb[i + 1], 63);
                    const unsigned mine = pg8::cvt_pk_bf16(valid ? a[i] * __expf(t0 - bb[i]) : 0.f, valid ? a[i + 1] * __expf(t1 - bb[i + 1]) : 0.f); const unsigned pv = (unsigned)__shfl_xor((int)mine, 1);
                    const unsigned w = (lane & 1) ? ((pv >> 16) | (mine & 0xffff0000u)) : ((mine & 0xffffu) | (pv << 16));
                    *(LAS unsigned*)(KE + (8 * w4 + i + (lane & 1)) * TS + (lane & ~1)) = w; }
                v4u w0; w0.x = pg8::cvt_pk_bf16(o8[0], o8[1]); w0.y = pg8::cvt_pk_bf16(o8[2], o8[3]); w0.z = pg8::cvt_pk_bf16(o8[4], o8[5]); w0.w = pg8::cvt_pk_bf16(o8[6], o8[7]);
                *(LAS v4u*)(KT + lane * QS + 8 * w4) = w0;
            }
        }
        { const unsigned vv[4] = {valid ? vr.x : 0u, valid ? vr.y : 0u, valid ? vr.z : 0u, valid ? vr.w : 0u};
#pragma unroll
          for (int i = 0; i < 4; ++i) { const unsigned pv = (unsigned)__shfl_xor((int)vv[i], 1);
              const unsigned w = (lane & 1) ? ((pv >> 16) | (vv[i] & 0xffff0000u)) : ((vv[i] & 0xffffu) | (pv << 16));
              *(LAS unsigned*)(VT + (8 * wave + 2 * i + (lane & 1)) * TS + (lane & ~1)) = w; } }
            if (c + 1 < nch) LA_LOAD(c + 1);
        }
        if (i >= 1) {
            LAS bf16* QT = SB0 + ((i - 1) & 1) * SB; LAS bf16* KT = QT + 64 * QS;
        { const int rb = wave >> 1;
#pragma unroll
          for (int ci = 0; ci < 2; ++ci) { const int cb = (wave & 1) * 2 + ci; f32x4 acc = {0.f, 0.f, 0.f, 0.f};
              if (cb <= rb) {
#pragma unroll
                  for (int ks = 0; ks < NKS; ++ks) { const bf16x8_t af = *(const LAS bf16x8_t*)(QT + (rb * 16 + c16) * QS + ks * 32 + 8 * g4), bf = *(const LAS bf16x8_t*)(KT + (cb * 16 + c16) * QS + ks * 32 + 8 * g4);
                      acc = __builtin_amdgcn_mfma_f32_16x16x32_bf16(af, bf, acc, 0, 0, 0); } }
#pragma unroll
              for (int r = 0; r < 4; ++r) { const int tt = rb * 16 + 4 * g4 + r, ss = cb * 16 + c16; AL[tt * TS + ss] = (bf16)f2bf(ss <= tt ? acc[r] : 0.f); } } }
        }
        LDS_WAIT(); __builtin_amdgcn_s_barrier(); asm volatile("" ::: "memory");
        if (i >= 1) {
            const int c = i - 1; LAS bf16* QT = SB0 + (c & 1) * SB; LAS bf16* KT = QT + 64 * QS; LAS bf16* VT = KT + 64 * QS; LAS bf16* KE = VT + 64 * TS; LAS bf16* GT = KE + DK * TS; LAS float* WT = (LAS float*)(GT + 64 * TS);
            const int nvc = min(64, nt - c * 64); (void)KT;
        if (wave < 4) {
            const int rb = wave; const LAS bf16* STc = ST + cur * 64 * QS;
            f32x4 o[4];
#pragma unroll
            for (int cb = 0; cb < 4; ++cb) o[cb] = (f32x4){0.f, 0.f, 0.f, 0.f};
#pragma unroll
            for (int ks = 0; ks < 2; ++ks) { const bf16x8_t af = *(const LAS bf16x8_t*)(AL + (rb * 16 + c16) * TS + ks * 32 + 8 * g4);
#pragma unroll
                for (int cb = 0; cb < 4; ++cb) { const bf16x8_t bf = *(const LAS bf16x8_t*)(VT + (cb * 16 + c16) * TS + ks * 32 + 8 * g4); o[cb] = __builtin_amdgcn_mfma_f32_16x16x32_bf16(af, bf, o[cb], 0, 0, 0); } }
#pragma unroll
            for (int ks = 0; ks < NKS; ++ks) { const bf16x8_t af = *(const LAS bf16x8_t*)(QT + (rb * 16 + c16) * QS + ks * 32 + 8 * g4);
#pragma unroll
                for (int cb = 0; cb < 4; ++cb) { const bf16x8_t bf = *(const LAS bf16x8_t*)(STc + (cb * 16 + c16) * QS + ks * 32 + 8 * g4); o[cb] = __builtin_amdgcn_mfma_f32_16x16x32_bf16(af, bf, o[cb], 0, 0, 0); } }
            { float* LAO = WSP(float, WS_LAO);
#pragma unroll
              for (int r = 0; r < 4; ++r) { const int tok = c * 64 + rb * 16 + 4 * g4 + r;
                  if (tok < nt) { float* op = LAO + (size_t)(row0 + tok) * 512 + (RET ? 0 : 256) + h * 64 + c16;
#pragma unroll
                      for (int cb = 0; cb < 4; ++cb) op[cb * 16] = o[cb][r]; } } }
        } else {
            const int dvb = wave - 4; LAS bf16* STn = ST + (cur ^ 1) * 64 * QS;
            f32x4 ds[NKB];
#pragma unroll
            for (int cb = 0; cb < NKB; ++cb) ds[cb] = (f32x4){0.f, 0.f, 0.f, 0.f};
#pragma unroll
            for (int ks = 0; ks < 2; ++ks) { const bf16x8_t af = *(const LAS bf16x8_t*)(VT + (dvb * 16 + c16) * TS + ks * 32 + 8 * g4);
#pragma unroll
                for (int cb = 0; cb < NKB; ++cb) { const bf16x8_t bf = *(const LAS bf16x8_t*)(KE + (cb * 16 + c16) * TS + ks * 32 + 8 * g4); ds[cb] = __builtin_amdgcn_mfma_f32_16x16x32_bf16(af, bf, ds[cb], 0, 0, 0); } }
#pragma unroll
            for (int cb = 0; cb < NKB; ++cb) { const float eB = RET ? __builtin_amdgcn_exp2f(lg2 * (float)nvc) : __expf(WT[cb * 16 + c16]);
#pragma unroll
                for (int r = 0; r < 4; ++r) { Sreg[cb][r] = eB * Sreg[cb][r] + ds[cb][r]; STn[(dvb * 16 + 4 * g4 + r) * QS + cb * 16 + c16] = (bf16)f2bf(Sreg[cb][r]); } }
        }
            cur ^= 1;
        }
        LDS_WAIT(); __builtin_amdgcn_s_barrier(); asm volatile("" ::: "memory");
    }
#undef LA_LOAD
    if (wave >= 4) {
        float* so = C.out + (RET ? (smp ? O_RS + (((size_t)l * DB + b) * 4 + h) * DK * 64 : O_RP + (((size_t)l * BATCH + b) * 4 + h) * DK * 64)
                                 : (smp ? O_GS + (((size_t)l * DB + b) * 4 + h) * DK * 64 : O_GP + (((size_t)l * BATCH + b) * 4 + h) * DK * 64));
#pragma unroll
        for (int cb = 0; cb < NKB; ++cb)
#pragma unroll
            for (int r = 0; r < 4; ++r) so[(cb * 16 + c16) * 64 + (wave - 4) * 16 + 4 * g4 + r] = Sreg[cb][r];
    }
}
typedef float f32x16_t __attribute__((ext_vector_type(16)));
__device__ __forceinline__ int crow_(int r, int hi) { return (r & 3) + 8 * (r >> 2) + 4 * hi; }
__device__ __forceinline__ float swapmax32(float m) { auto rr = __builtin_amdgcn_permlane32_swap(__float_as_uint(m), __float_as_uint(m), false, false); return fmaxf(__uint_as_float(rr[0]), __uint_as_float(rr[1])); }
__device__ __forceinline__ float swapadd32(float m) { auto rr = __builtin_amdgcn_permlane32_swap(__float_as_uint(m), __float_as_uint(m), false, false); return __uint_as_float(rr[0]) + __uint_as_float(rr[1]); }
constexpr float LOG2E = 1.4426950408889634f;
__device__ __forceinline__ void attn_prompt_item(const Ctx& C, int l, int b, int h, int qb, float lam, float lam_init, float mb) {
    THREAD_IDS();
    constexpr int KS = 72;
    LAS bf16* Kt = (LAS bf16*)C.lds;
    LAS bf16* Vt = Kt + 2 * 64 * KS;
    LAS float* BT = (LAS float*)(Vt + 2 * 64 * KS);
    LAS float* OX = BT + 128;
    const bf16* ZM = WSP(bf16, WS_ZMIX); const bf16* QNB = WSP(bf16, WS_QNB); const bf16* KNB = WSP(bf16, WS_KNB); bf16* BR = WSP(bf16, WS_BR);
    const int r32 = lane & 31, hi = lane >> 5, qs = wave >> 1, s = wave & 1;
    const int q0 = qb * 128 + qs * 32; const int rowb = b * L;
    if (tid < 128) BT[tid] = (C.in[I_RELB][t5_bucket(tid) * 4 + h] - C.in[I_RELB][31 * 4 + h]) * LOG2E;
    pg8::bf16x8 qf[2];
#pragma unroll
    for (int d0 = 0; d0 < 2; ++d0) qf[d0] = *(const pg8::bf16x8*)(QNB + (size_t)(rowb + q0 + r32) * 256 + h * 64 + s * 32 + 16 * d0 + 8 * hi);
    const int pl = (lane & ~15) | ((lane & 8) >> 1) | ((lane & 4) << 1) | (lane & 3);
    const int NT = (min(128 * (qb + 1), L) + 63) >> 6;
    v4u kreg, vreg;
#define AT_LOAD(j) do { const size_t r_ = (size_t)(rowb + (j) * 64 + lane); kreg = *(const v4u*)(KNB + r_ * 256 + h * 64 + 8 * wave); vreg = *(const v4u*)(ZM + r_ * NMIXP + D_V + h * 64 + 8 * wave); } while (0)
#define AT_STORE(buf) do { *(LAS v4u*)(Kt + (buf) * 64 * KS + lane * KS + 8 * wave) = kreg; LAS bf16* v_ = Vt + (buf) * 64 * KS + (8 * wave) * KS + pl; \
        v_[0] = (bf16)(vreg.x & 0xffffu); v_[KS] = (bf16)(vreg.x >> 16); v_[2 * KS] = (bf16)(vreg.y & 0xffffu); v_[3 * KS] = (bf16)(vreg.y >> 16); \
        v_[4 * KS] = (bf16)(vreg.z & 0xffffu); v_[5 * KS] = (bf16)(vreg.z >> 16); v_[6 * KS] = (bf16)(vreg.w & 0xffffu); v_[7 * KS] = (bf16)(vreg.w >> 16); } while (0)
    AT_LOAD(0); AT_STORE(0); if (NT > 1) AT_LOAD(1);
    LDS_WAIT(); __builtin_amdgcn_s_barrier(); asm volatile("" ::: "memory");
    float lsum = 0.f; f32x16_t o[2]; f32x16_t negm;
#pragma unroll
    for (int i = 0; i < 16; ++i) negm[i] = -mb;
#pragma unroll
    for (int i = 0; i < 16; ++i) { o[0][i] = 0.f; o[1][i] = 0.f; }
    for (int j = 0; j < NT; ++j) {
        const int k0 = 64 * j, buf = j & 1;
        if (k0 <= q0 + 31) {
            const LAS bf16* kb = Kt + buf * 64 * KS; const LAS bf16* vb = Vt + buf * 64 * KS;
            f32x16_t p0 = negm, p1 = negm;
#pragma unroll
            for (int d0 = 0; d0 < 2; ++d0) { const pg8::bf16x8 a0 = *(const LAS pg8::bf16x8*)(kb + r32 * KS + s * 32 + 16 * d0 + 8 * hi), a1 = *(const LAS pg8::bf16x8*)(kb + (32 + r32) * KS + s * 32 + 16 * d0 + 8 * hi);
                p0 = __builtin_amdgcn_mfma_f32_32x32x16_bf16(a0, qf[d0], p0, 0, 0, 0); p1 = __builtin_amdgcn_mfma_f32_32x32x16_bf16(a1, qf[d0], p1, 0, 0, 0); }
            if (q0 - k0 - 63 < 113) {
#pragma unroll
                for (int r = 0; r < 16; ++r) { const int n0 = (q0 + r32) - (k0 + crow_(r, hi)), n1 = n0 - 32;
                    p0[r] = n0 < 0 ? -INFINITY : p0[r] + (n0 < 128 ? BT[n0] : 0.f); p1[r] = n1 < 0 ? -INFINITY : p1[r] + (n1 < 128 ? BT[n1] : 0.f); } }
            typedef float f32x2_t __attribute__((ext_vector_type(2)));
            f32x2_t ps2 = {0.f, 0.f};
#pragma unroll
            for (int r = 0; r < 16; r += 2) { p0[r] = __builtin_amdgcn_exp2f(p0[r]); p0[r + 1] = __builtin_amdgcn_exp2f(p0[r + 1]); p1[r] = __builtin_amdgcn_exp2f(p1[r]); p1[r + 1] = __builtin_amdgcn_exp2f(p1[r + 1]);
                ps2 = ps2 + (f32x2_t){p0[r], p0[r + 1]}; ps2 = ps2 + (f32x2_t){p1[r], p1[r + 1]}; }
            lsum += ps2[0] + ps2[1];
            pg8::bf16x8 pb[4];
#pragma unroll
            for (int ks = 0; ks < 4; ++ks) { v4u w;
                if (ks < 2) { w.x = pg8::cvt_pk_bf16(p0[8 * ks], p0[8 * ks + 1]); w.y = pg8::cvt_pk_bf16(p0[8 * ks + 2], p0[8 * ks + 3]); w.z = pg8::cvt_pk_bf16(p0[8 * ks + 4], p0[8 * ks + 5]); w.w = pg8::cvt_pk_bf16(p0[8 * ks + 6], p0[8 * ks + 7]); }
                else { w.x = pg8::cvt_pk_bf16(p1[8 * ks - 16], p1[8 * ks - 15]); w.y = pg8::cvt_pk_bf16(p1[8 * ks - 14], p1[8 * ks - 13]); w.z = pg8::cvt_pk_bf16(p1[8 * ks - 12], p1[8 * ks - 11]); w.w = pg8::cvt_pk_bf16(p1[8 * ks - 10], p1[8 * ks - 9]); }
                pb[ks] = __builtin_bit_cast(pg8::bf16x8, w); }
#pragma unroll
            for (int d0 = 0; d0 < 2; ++d0)
#pragma unroll
                for (int ks = 0; ks < 4; ++ks) { const pg8::bf16x8 af = *(const LAS pg8::bf16x8*)(vb + (32 * d0 + r32) * KS + 16 * ks + 8 * hi); o[d0] = __builtin_amdgcn_mfma_f32_32x32x16_bf16(af, pb[ks], o[d0], 0, 0, 0); }
        }
        if (j + 1 < NT) AT_STORE(buf ^ 1);
        if (j + 2 < NT) AT_LOAD(j + 2);
        LDS_WAIT(); __builtin_amdgcn_s_barrier(); asm volatile("" ::: "memory");
    }
#undef AT_LOAD
#undef AT_STORE
    lsum = swapadd32(lsum); const float inv = 1.0f / lsum;
    LAS float* ox = OX + (qs * 32 + r32) * 65;
    if (s == 1) {
#pragma unroll
        for (int d0 = 0; d0 < 2; ++d0)
#pragma unroll
            for (int r = 0; r < 16; ++r) ox[32 * d0 + crow_(r, hi)] = o[d0][r] * inv; }
    LDS_WAIT(); __builtin_amdgcn_s_barrier(); asm volatile("" ::: "memory");
    if (s == 0) {
        float ss = 0.f;
#pragma unroll
        for (int d0 = 0; d0 < 2; ++d0)
#pragma unroll
            for (int r = 0; r < 16; ++r) { const float v = o[d0][r] * inv - lam * ox[32 * d0 + crow_(r, hi)]; o[d0][r] = v; ss += v * v; }
        ss = swapadd32(ss); const float rs = rsqrtf(ss * (1.0f / 64) + EPS) * (1.0f - lam_init);
        const int qpos = q0 + r32;
        if (qpos < L) { bf16* brp = BR + (size_t)(rowb + qpos) * D + 768 + h * 64;
#pragma unroll
            for (int d0 = 0; d0 < 2; ++d0)
#pragma unroll
                for (int r4 = 0; r4 < 4; ++r4) { const int dv = 32 * d0 + 8 * r4 + 4 * hi; const float* sl = C.in[I_SUBLN] + l * 64 + dv;
                    const unsigned w0 = pk2(o[d0][4 * r4] * rs * sl[0], o[d0][4 * r4 + 1] * rs * sl[1]), w1 = pk2(o[d0][4 * r4 + 2] * rs * sl[2], o[d0][4 * r4 + 3] * rs * sl[3]);
                    *(unsigned long long*)(brp + dv) = (unsigned long long)w0 | ((unsigned long long)w1 << 32); } }
    }
    LDS_WAIT(); __builtin_amdgcn_s_barrier(); asm volatile("" ::: "memory");
}
constexpr int PSTR = 68;
__device__ __forceinline__ pg8::bf16x8 cvt8(const f32x4 a, const f32x4 b) { v4u w; w.x = pg8::cvt_pk_bf16(a[0], a[1]); w.y = pg8::cvt_pk_bf16(a[2], a[3]); w.z = pg8::cvt_pk_bf16(b[0], b[1]); w.w = pg8::cvt_pk_bf16(b[2], b[3]); return __builtin_bit_cast(pg8::bf16x8, w); }
__device__ __forceinline__ void attn_sample_item(const Ctx& C, int l, int b, int split) {
    THREAD_IDS();
    const int h = wave & 3, half = wave >> 2, c16 = lane & 15, g = lane >> 4, srow = c16 >> 3, t = c16 & 7;
    const bf16* QNB = WSP(bf16, WS_QNB); const int* PT = (const int*)C.in[I_PT];
    const float* CK = C.in[I_CK] + (size_t)l * NPOOL * PAGE * 256; const float* CV = C.in[I_CV] + (size_t)l * NPOOL * PAGE * 256;
    LAS float* BT = (LAS float*)C.lds;
    BT[tid] = (C.in[I_RELB][t5_bucket(tid & 127) * 4 + (tid >> 7)] - C.in[I_RELB][31 * 4 + (tid >> 7)]) * LOG2E;
    const v4u z4 = {0u, 0u, 0u, 0u};
    const v4u q0w = srow == 0 ? *(const v4u*)(QNB + (size_t)(MP + b * 8 + t) * 256 + h * 64 + 8 * g) : z4, q1w = srow == 1 ? *(const v4u*)(QNB + (size_t)(MP + b * 8 + t) * 256 + h * 64 + 32 + 8 * g) : z4;
    const pg8::bf16x8 qf0 = __builtin_bit_cast(pg8::bf16x8, q0w), qf1 = __builtin_bit_cast(pg8::bf16x8, q1w);
    LDS_WAIT(); __builtin_amdgcn_s_barrier(); asm volatile("" ::: "memory");
    float m = -INFINITY, lsum = 0.f; f32x4 o[4];
#pragma unroll
    for (int db = 0; db < 4; ++db) o[db] = (f32x4){0.f, 0.f, 0.f, 0.f};
    const int kk0 = split * 1024 + half * 512;
    const int pg0 = __builtin_amdgcn_readfirstlane(PT[b * NPAGES + (kk0 >> 7)]), pg1 = __builtin_amdgcn_readfirstlane(PT[b * NPAGES + (kk0 >> 7) + 1]), pg2 = __builtin_amdgcn_readfirstlane(PT[b * NPAGES + (kk0 >> 7) + 2]), pg3 = __builtin_amdgcn_readfirstlane(PT[b * NPAGES + (kk0 >> 7) + 3]);
#define SA_LOAD(KR, VR, st) do { const int kk_ = kk0 + 32 * (st); const int pi_ = (st) >> 2; const int page_ = pi_ == 0 ? pg0 : pi_ == 1 ? pg1 : pi_ == 2 ? pg2 : pg3; const size_t base_ = ((size_t)(page_ * PAGE + (kk_ & 127)) * 4 + h) * 64; \
        _Pragma("unroll") for (int T = 0; T < 2; ++T) _Pragma("unroll") for (int ks = 0; ks < 2; ++ks) { const float* p = CK + base_ + (size_t)(16 * T + c16) * 256 + 32 * ks + 8 * g; KR[T][ks][0] = *(const f32x4*)p; KR[T][ks][1] = *(const f32x4*)(p + 4); } \
        _Pragma("unroll") for (int db = 0; db < 4; ++db) _Pragma("unroll") for (int j = 0; j < 8; ++j) { const int kv = j < 4 ? 4 * g + j : 16 + 4 * g + (j - 4); VR[db][j] = CV[base_ + (size_t)kv * 256 + 16 * db + c16]; } } while (0)
#define SA_MATH(KR, VR, st) do { const int kk = kk0 + 32 * (st); f32x4 sv[2]; \
        _Pragma("unroll") for (int T = 0; T < 2; ++T) { sv[T] = (f32x4){0.f, 0.f, 0.f, 0.f}; \
            sv[T] = __builtin_amdgcn_mfma_f32_16x16x32_bf16(cvt8(KR[T][0][0], KR[T][0][1]), qf0, sv[T], 0, 0, 0); \
            sv[T] = __builtin_amdgcn_mfma_f32_16x16x32_bf16(cvt8(KR[T][1][0], KR[T][1][1]), qf1, sv[T], 0, 0, 0); } \
        if (kk + 31 + 128 > PAST) { \
            _Pragma("unroll") for (int T = 0; T < 2; ++T) _Pragma("unroll") for (int r = 0; r < 4; ++r) { const int n = PAST + t - (kk + 16 * T + 4 * g + r); if (n < 128) sv[T][r] += BT[h * 128 + n]; } } \
        float mt = fmaxf(fmaxf(fmaxf(sv[0][0], sv[0][1]), fmaxf(sv[0][2], sv[0][3])), fmaxf(fmaxf(sv[1][0], sv[1][1]), fmaxf(sv[1][2], sv[1][3]))); \
        mt = fmaxf(mt, __shfl_xor(mt, 16)); mt = fmaxf(mt, __shfl_xor(mt, 32)); \
        const float mn = fmaxf(m, mt); const float al = __builtin_amdgcn_exp2f(m - mn); m = mn; float ps = 0.f; \
        _Pragma("unroll") for (int T = 0; T < 2; ++T) _Pragma("unroll") for (int r = 0; r < 4; ++r) { sv[T][r] = __builtin_amdgcn_exp2f(sv[T][r] - m); ps += sv[T][r]; } \
        lsum = lsum * al + ps; const pg8::bf16x8 pf = cvt8(sv[0], sv[1]); \
        _Pragma("unroll") for (int db = 0; db < 4; ++db) { o[db] = o[db] * al; \
            const f32x4 va = {VR[db][0], VR[db][1], VR[db][2], VR[db][3]}, vb = {VR[db][4], VR[db][5], VR[db][6], VR[db][7]}; \
            o[db] = __builtin_amdgcn_mfma_f32_16x16x32_bf16(cvt8(va, vb), pf, o[db], 0, 0, 0); } } while (0)
    f32x4 krA[2][2][2], krB[2][2][2]; float vrA[4][8], vrB[4][8];
    SA_LOAD(krA, vrA, 0);
#pragma unroll 1
    for (int step = 0; step < 16; step += 2) {
        SA_LOAD(krB, vrB, step + 1);
        SA_MATH(krA, vrA, step);
        if (step + 2 < 16) SA_LOAD(krA, vrA, step + 2);
        SA_MATH(krB, vrB, step + 1);
    }
#undef SA_LOAD
#undef SA_MATH
    lsum += __shfl_xor(lsum, 16); lsum += __shfl_xor(lsum, 32);
    float* pp = WSP(float, WS_PART) + ((((size_t)b * 4 + h) * 16 + split * 2 + half) * 16 + c16) * PSTR;
#pragma unroll
    for (int db = 0; db < 4; ++db) *(f32x4*)(pp + 16 * db + 4 * g) = o[db];
    if (g == 0) { pp[64] = m; pp[65] = lsum; }
    LDS_WAIT(); __builtin_amdgcn_s_barrier(); asm volatile("" ::: "memory");
}
__device__ __forceinline__ void n3_attn_sample_combine(const Ctx& C, int l, float lam_init) {
    THREAD_IDS();
    const float lam = lam_of(C, l, lam_init);
    const bf16* QNB = WSP(bf16, WS_QNB); const bf16* KNB = WSP(bf16, WS_KNB); const bf16* ZM = WSP(bf16, WS_ZMIX); bf16* BR = WSP(bf16, WS_BR);
    for (int it = gw; it < DB * 4 * DS; it += NGW) {
        const int b = it >> 5, h = (it >> 3) & 3, t = it & 7; float os[2];
        const float far = C.in[I_RELB][31 * 4 + h];
        float sn[2][8];
        { const float qv = bf2f(QNB[(size_t)(MP + b * 8 + t) * 256 + h * 64 + lane]);
#pragma unroll
          for (int jj = 0; jj < 8; ++jj) { float p = qv * bf2f(KNB[(size_t)(MP + b * 8 + jj) * 256 + h * 64 + lane]);
              p += __shfl_xor(p, 1); p += __shfl_xor(p, 2); p += __shfl_xor(p, 4); p += __shfl_xor(p, 8); p += __shfl_xor(p, 16);
              const float bias = (C.in[I_RELB][t5_bucket(t - jj < 0 ? 0 : t - jj) * 4 + h] - far) * LOG2E;
              sn[0][jj] = jj <= t ? __shfl(p, 0) + bias : -INFINITY; sn[1][jj] = jj <= t ? __shfl(p, 32) + bias : -INFINITY; } }
#pragma unroll
        for (int s = 0; s < 2; ++s) {
            const float* pb = WSP(float, WS_PART) + ((((size_t)b * 4 + h) * 16) * 16 + s * 8 + t) * PSTR;
            float mm = -INFINITY; float pm[16];
#pragma unroll
            for (int pi = 0; pi < 16; ++pi) { pm[pi] = pb[(size_t)pi * 16 * PSTR + 64]; mm = fmaxf(mm, pm[pi]); }
#pragma unroll
            for (int jj = 0; jj < 8; ++jj) mm = fmaxf(mm, sn[s][jj]);
            float ll = 0.f, oo = 0.f;
#pragma unroll
            for (int pi = 0; pi < 16; ++pi) { const float* pr = pb + (size_t)pi * 16 * PSTR; const float w = __builtin_amdgcn_exp2f(pm[pi] - mm); ll += pr[65] * w; oo += pr[lane] * w; }
#pragma unroll
            for (int jj = 0; jj < 8; ++jj) { const float w = __builtin_amdgcn_exp2f(sn[s][jj] - mm); ll += w; oo += w * bf2f(ZM[(size_t)(MP + b * 8 + jj) * NMIXP + D_V + h * 64 + lane]); }
            os[s] = oo / ll;
        }
        const float o = os[0] - lam * os[1]; const float ms = wave_sum(o * o) * (1.0f / 64);
        BR[(size_t)(MP + b * 8 + t) * D + 768 + h * 64 + lane] = (bf16)f2bf(o * rsqrtf(ms + EPS) * C.in[I_SUBLN][l * 64 + lane] * (1.0f - lam_init));
    }
}

__device__ __forceinline__ void n3_la_finalize(const Ctx& C, int l) {
    THREAD_IDS();
    const float* LAO = WSP(float, WS_LAO); const bf16* ZM = WSP(bf16, WS_ZMIX); bf16* BR = WSP(bf16, WS_BR);
    const bool ret = lane < 32; const int hd = (lane >> 3) & 3, c8 = (lane & 7) * 8;
    float gn[8];
#pragma unroll
    for (int j = 0; j < 8; ++j) gn[j] = (ret ? C.in[I_RGN] : C.in[I_GGN])[(l * 4 + hd) * 64 + c8 + j];
    for (int r0 = gw * 4; r0 < MP; r0 += NGW * 4) {
        f32x4 a4[4], b4[4]; v4u g4[4];
#pragma unroll
        for (int u = 0; u < 4; ++u) { const int r = min(r0 + u, MP - 1); a4[u] = *(const f32x4*)(LAO + (size_t)r * 512 + 8 * lane); b4[u] = *(const f32x4*)(LAO + (size_t)r * 512 + 8 * lane + 4);
            g4[u] = *(const v4u*)(ZM + (size_t)r * NMIXP + (ret ? R_G : G_R) + hd * 64 + c8); }
#pragma unroll
        for (int u = 0; u < 4; ++u) { const int r = r0 + u; if (r >= MP) break;
            float x[8] = {a4[u][0], a4[u][1], a4[u][2], a4[u][3], b4[u][0], b4[u][1], b4[u][2], b4[u][3]}, g[8]; unpack8(g4[u], g);
            float s = ((x[0] + x[1]) + (x[2] + x[3])) + ((x[4] + x[5]) + (x[6] + x[7]));
            s += __shfl_xor(s, 1); s += __shfl_xor(s, 2); s += __shfl_xor(s, 4);
            const float mean = ret ? s * (1.0f / 64) : 0.f; float q2 = 0.f;
#pragma unroll
            for (int j = 0; j < 8; ++j) { x[j] -= mean; q2 += x[j] * x[j]; }
            q2 += __shfl_xor(q2, 1); q2 += __shfl_xor(q2, 2); q2 += __shfl_xor(q2, 4);
            const float rs = rsqrtf(q2 * (1.0f / 64) + EPS);
#pragma unroll
            for (int j = 0; j < 8; ++j) x[j] = siluf_(g[j]) * x[j] * rs * gn[j];
            *(v4u*)(BR + (size_t)r * D + 256 + 8 * lane) = pack8(x); }
    }
}

constexpr int NQB_ATT = (L + 127) / 128;
constexpr int IT_LA = 32, IT_SS = IT_LA + DB * 8, IT_AT = IT_SS + 16 * NQB_ATT, IT_LS = IT_AT + 32, IT_CV = IT_LS + (MR + 63) / 64, IT_END = IT_CV;
__device__ __forceinline__ void n2_phase(const Ctx& C, int l, float lam_init, int qslot) {
    THREAD_IDS();
    const float lam = lam_of(C, l, lam_init);
    float mb;
    { float mq = 0.f, mk = 0.f, mbias = 0.f;
#pragma unroll 1
      for (int i = 0; i < 32; ++i) { mq = fmaxf(mq, fabsf(C.in[I_QN][l * 32 + i])); mk = fmaxf(mk, fabsf(C.in[I_KN][l * 32 + i])); }
#pragma unroll 1
      for (int i = 0; i < 128; ++i) mbias = fmaxf(mbias, C.in[I_RELB][i] - C.in[I_RELB][31 * 4 + (i & 3)]);
      mb = 1.02f * 1.4426950408889634f * 5.656854249492381f * mq * mk + 1.4426950408889634f * mbias; }
    unsigned* qw = (unsigned*)(C.ws + WS_CTL) + CW_QUEUE + 64 * qslot;
    volatile LAS int* slot = (volatile LAS int*)(C.lds + MISC_OFF + 64);
    if (blockIdx.x < IT_LA) { const int it = blockIdx.x; const int b = (it >> 2) & 3, h = it & 3; if (it < 16) la_chunked<64, true>(C, l, false, b, h); else la_chunked<32, false>(C, l, false, b, h); }
    for (;;) {
        if (tid == 0) slot[0] = (int)__hip_atomic_fetch_add(qw, 1u, __ATOMIC_RELAXED, __HIP_MEMORY_SCOPE_AGENT);
        __syncthreads();
        const int qi = slot[0];
        const int it = qi < 3 * DB * 8 ? ((qi % 3) ? IT_SS + 2 * (qi / 3) + (qi % 3) - 1 : IT_LA + qi / 3) : qi + IT_LA;
        __syncthreads();
        if (it >= IT_END) break;
        if (it < IT_SS) { const int i2 = it - IT_LA; attn_sample_item(C, l, i2 >> 3, i2 & 7); }
        else if (it < IT_AT) { const int i2 = it - IT_SS; attn_prompt_item(C, l, (i2 & 15) >> 2, i2 & 3, NQB_ATT - 1 - (i2 >> 4), lam, lam_init, mb); }
        else if (it < IT_LS) { const int i2 = (it - IT_AT) * 8 + wave; const int b = (i2 >> 2) & 31, h = i2 & 3; if (i2 < 128) la_seq<64, true>(C, l, true, b, h); else la_seq<32, false>(C, l, true, b, h); }
        else { conv_rows_item(C, l, it - IT_LS); conv_state_item(C, l, it - IT_LS, IT_CV - IT_LS); }
    }
}

template <int l> __device__ __forceinline__ void layer_fwd(const Ctx& C, const XcdBarrier& bar) {
#define GRID_BAR() xcd_barrier<false>(bar)
    LAS unsigned char* ring = C.lds + RING_OFF;
    float* SS = WSP(float, WS_SS); float* H = WSP(float, WS_H); bf16* HB = WSP(bf16, WS_HB); bf16* ACT = WSP(bf16, WS_ACT); bf16* ZMIX = WSP(bf16, WS_ZMIX); bf16* GATES = WSP(bf16, WS_GATES);
    bf16* BR = WSP(bf16, WS_BR); bf16* MERGED = WSP(bf16, WS_MERGED);
    constexpr float lam_init = l == 0 ? 0.2f : 0.35550906759096926f;
    constexpr bool last = (l == DEPTH - 1);
    { pg8::Gemm g{HB, WSP(bf16, WS_W1 + (size_t)(l * 2 + 0) * SZ_W1), D, D, D}; pg8::StaticOrder S; S.init(M, 2 * DFF, C.G, (int)blockIdx.x);
      EpiGLU E{ACT, SS + (size_t)(l * 3 + 0) * M * 16}; pg8::gemm_phase<EpiGLU, pg8::StaticOrder, true, true>(ring, g, S, E); }
    GRID_BAR();
    { pg8::HeadOrder S; S.init(M, D, C.G, (int)blockIdx.x); S.limit = C.G; EpiRes<false, 1> E{H, HB, SS + (size_t)(l * 3 + 1) * M * 16, nullptr};
      { pg8::Gemm g{ACT, WSP(bf16, WS_WD + (size_t)(l * 2 + 0) * SZ_WD), DFF, DFF, DFF}; pg8::gemm_phase<EpiRes<false, 1>, pg8::HeadOrder, true, true>(ring, g, S, E); }
      { int kt = DFF / 11; asm volatile("" : "+s"(kt)); pg8::Gemm g{ACT, WSP(bf16, WS_WD + (size_t)(l * 2 + 0) * SZ_WD), DFF, DFF, kt}; pg8::TailOrder T; T.init(M, D, C.G, (int)blockIdx.x); T.limit = C.G; T.nsplit = 11; T.kper = DFF / 11;
        EpiPartial EP{WSP(float, WS_KSP)}; pg8::gemm_phase<EpiPartial, pg8::TailOrder, true, true>(ring, g, T, EP); }
      ksp_finalize_local<11>(WSP(float, WS_KSP), S, C.G, E, (unsigned*)(C.ws + WS_CTL) + CW_TAIL + 512 * (l * 3 + 0), (unsigned*)(C.ws + WS_CTL) + CW_BAR); }
    GRID_BAR();
    { pg8::Gemm g{HB, WSP(bf16, WS_WIN + (size_t)l * SZ_WIN), D, D, D}; pg8::StaticOrder S; S.init(M, NINP, C.G, (int)blockIdx.x);
      EpiZ E{ZMIX, GATES, SS + (size_t)(l * 3 + 1) * M * 16, WSP(float, WS_BINP) + l * NINP}; pg8::gemm_phase<EpiZ, pg8::StaticOrder, true, true>(ring, g, S, E); }
    GRID_BAR();
    n1_prep(C, l);
    GRID_BAR();
    n2_phase(C, l, lam_init, l);
    GRID_BAR();
    n3_attn_sample_combine(C, l, lam_init);
    n3_la_finalize(C, l);
    GRID_BAR();
    { pg8::HeadOrder S; S.init(M, D, C.G, (int)blockIdx.x); S.limit = C.G;
      { pg8::Gemm g{BR, WSP(bf16, WS_WBR + (size_t)l * SZ_WBR), D, D, D}; EpiMergeR E{MERGED, GATES}; pg8::gemm_phase<EpiMergeR, pg8::HeadOrder, true, true, 4>(ring, g, S, E); }
      { int kt = D / 4; asm volatile("" : "+s"(kt)); pg8::Gemm g{BR, WSP(bf16, WS_WBR + (size_t)l * SZ_WBR), D, D, kt}; pg8::TailOrder T; T.init(M, D, C.G, (int)blockIdx.x); T.limit = C.G; T.nsplit = 4; T.kper = D / 4;
        EpiPartial EP{WSP(float, WS_KSP)}; pg8::gemm_phase<EpiPartial, pg8::TailOrder, true, true>(ring, g, T, EP); }
      merge_finalize_local(WSP(float, WS_KSP), S, C.G, MERGED, GATES, (unsigned*)(C.ws + WS_CTL) + CW_TAIL + 512 * (6 + l), (unsigned*)(C.ws + WS_CTL) + CW_BAR); }
    GRID_BAR();
    { pg8::HeadOrder S; S.init(M, D, C.G, (int)blockIdx.x); S.limit = C.G; EpiRes<false, 2> E{H, HB, SS + (size_t)(l * 3 + 2) * M * 16, nullptr};
      { pg8::Gemm g{MERGED, WSP(bf16, WS_WOUT + (size_t)l * SZ_WOUT), D, D, D}; pg8::gemm_phase<EpiRes<false, 2>, pg8::HeadOrder, true, true>(ring, g, S, E); }
      { int kt = D / 4; asm volatile("" : "+s"(kt)); pg8::Gemm g{MERGED, WSP(bf16, WS_WOUT + (size_t)l * SZ_WOUT), D, D, kt}; pg8::TailOrder T; T.init(M, D, C.G, (int)blockIdx.x); T.limit = C.G; T.nsplit = 4; T.kper = D / 4;
        EpiPartial EP{WSP(float, WS_KSP)}; pg8::gemm_phase<EpiPartial, pg8::TailOrder, true, true>(ring, g, T, EP); }
      ksp_finalize_local<4>(WSP(float, WS_KSP), S, C.G, E, (unsigned*)(C.ws + WS_CTL) + CW_TAIL + 512 * (l * 3 + 1), (unsigned*)(C.ws + WS_CTL) + CW_BAR); }
    GRID_BAR();
    { pg8::Gemm g{HB, WSP(bf16, WS_W1 + (size_t)(l * 2 + 1) * SZ_W1), D, D, D}; pg8::StaticOrder S; S.init(M, 2 * DFF, C.G, (int)blockIdx.x);
      EpiGLU E{ACT, SS + (size_t)(l * 3 + 2) * M * 16}; pg8::gemm_phase<EpiGLU, pg8::StaticOrder, true, true>(ring, g, S, E); }
    GRID_BAR();
    { pg8::HeadOrder S; S.init(M, D, C.G, (int)blockIdx.x); S.limit = C.G; EpiRes<last, 1> E{H, HB, last ? nullptr : SS + (size_t)((l + 1) * 3) * M * 16, C.out};
      { pg8::Gemm g{ACT, WSP(bf16, WS_WD + (size_t)(l * 2 + 1) * SZ_WD), DFF, DFF, DFF}; pg8::gemm_phase<EpiRes<last, 1>, pg8::HeadOrder, true, true>(ring, g, S, E); }
      { int kt = DFF / 11; asm volatile("" : "+s"(kt)); pg8::Gemm g{ACT, WSP(bf16, WS_WD + (size_t)(l * 2 + 1) * SZ_WD), DFF, DFF, kt}; pg8::TailOrder T; T.init(M, D, C.G, (int)blockIdx.x); T.limit = C.G; T.nsplit = 11; T.kper = DFF / 11;
        EpiPartial EP{WSP(float, WS_KSP)}; pg8::gemm_phase<EpiPartial, pg8::TailOrder, true, true>(ring, g, T, EP); }
      ksp_finalize_local<11>(WSP(float, WS_KSP), S, C.G, E, (unsigned*)(C.ws + WS_CTL) + CW_TAIL + 512 * (l * 3 + 2), (unsigned*)(C.ws + WS_CTL) + CW_BAR); }
#undef GRID_BAR
}

__global__ void __launch_bounds__(NWAVES * 64, 2) fwd(Params P) {
    extern __shared__ __attribute__((aligned(16))) unsigned char lds[];
    Ctx C;
    C.in = P.in; C.out = P.out; C.ws = P.ws; C.lds = (LAS unsigned char*)lds;
    C.G = gridDim.x;
    volatile LAS unsigned* MISC = (volatile LAS unsigned*)(C.lds + MISC_OFF);
    for (int u = threadIdx.x; u < (LDS_BYTES - LDSCTL_OFF) / 4; u += NWAVES * 64) ((LAS unsigned*)(C.lds + LDSCTL_OFF))[u] = 0u;
    __syncthreads();
    unsigned* ctl = (unsigned*)(C.ws + WS_CTL);
    XcdBarrier bar = xcd_barrier_post(ctl + CW_BAR, MISC + 8);
    p0_prologue(C, P);
    xcd_barrier<true>(bar);
    layer_fwd<0>(C, bar);
    xcd_barrier<false>(bar);
    layer_fwd<1>(C, bar);
}

extern "C" void kernel_launch(void* const* d_in, const int* in_sizes, int n_in, void* d_out, int out_size, void* d_ws, size_t ws_size, hipStream_t stream) {
    static int grid = 0;
    if (grid == 0) {
        if (n_in != N_INPUTS || (size_t)out_size != O_END || ws_size < WS_END) { fprintf(stderr, "kernel_launch: unexpected shapes: n_in %d out %d (want %zu) ws %zu (want %zu)\n", n_in, out_size, (size_t)O_END, ws_size, (size_t)WS_END); grid = -1; return; }
        int dev = 0, cus = 0, per_cu = 0;
        if (hipGetDevice(&dev) != hipSuccess || hipDeviceGetAttribute(&cus, hipDeviceAttributeMultiprocessorCount, dev) != hipSuccess) { grid = -1; return; }
        if (hipFuncSetAttribute((const void*)fwd, hipFuncAttributeMaxDynamicSharedMemorySize, LDS_BYTES) != hipSuccess) { fprintf(stderr, "kernel_launch: hipFuncSetAttribute failed\n"); grid = -1; return; }
        if (hipOccupancyMaxActiveBlocksPerMultiprocessor(&per_cu, (const void*)fwd, NWAVES * 64, LDS_BYTES) != hipSuccess || per_cu < 1) { fprintf(stderr, "kernel_launch: occupancy query says %d blocks per CU\n", per_cu); }
        (void)hipGetLastError();
        grid = cus;
    }
    if (grid < 0) return;
    if (hipMemsetAsync((char*)d_ws + WS_CTL, 0, CTL_ZERO_BYTES, stream) != hipSuccess) return;
    Params p{};
    for (int i = 0; i < N_INPUTS; ++i) p.in[i] = (const float*)d_in[i];
    p.out = (float*)d_out; p.ws = (unsigned char*)d_ws;
    for (int i = 0; i < 32; ++i) p.inv_freq[i] = (float)pow(10000.0, -(double)i / 32.0);
    hipLaunchKernelGGL(fwd, dim3(grid), dim3(NWAVES * 64), LDS_BYTES, stream, p);
}
```
